# Optimizing an MI355X kernel written in HIP

```python
import math
import jax
import jax.numpy as jnp
from jax import lax
import numpy as np

D_MODEL = 1024
BATCH = 8
SEQ = 4096
DEPTH = 2

GRID_W = 64
CTX_LEN = 256
EPS = 1e-6
N_MOD = 6
BRANCH_W = 512
N_BRANCH = 3

DA_HEADS = 4
DA_HD = 64
DA_VD = 2 * DA_HD
ATTN_BLOCK = 128
ROPE_BASE = 10000.0

ML_HEADS = 4
ML_HD = BRANCH_W // ML_HEADS
ML_CONV = 3
ML_CHUNK = 128
ML_NGATE = 2 * 2 * ML_HEADS

S5_P = 16
S5_G = BRANCH_W // S5_P
S5_N = 64

PEER_HEADS = 8
PEER_NKEYS = 128
PEER_EXPERTS = PEER_NKEYS * PEER_NKEYS
PEER_QD = 256
PEER_TOPK = 16
PEER_BLOCK = 128

IN_SPLITS = (DA_HEADS * 2 * DA_HD, DA_HEADS * 2 * DA_HD, DA_HEADS * DA_VD,
             BRANCH_W, BRANCH_W, BRANCH_W, ML_NGATE,
             BRANCH_W,
             N_BRANCH * D_MODEL)
IN_WIDTH = sum(IN_SPLITS)
IN_IDX = tuple(int(v) for v in np.cumsum(IN_SPLITS)[:-1])

kernel_name = 'hybrid_diffattn_mlstm_s5_peer_block'


def rms_norm(x, g):
    xf = x.astype(jnp.float32)
    y = xf * lax.rsqrt(jnp.mean(xf * xf, axis=-1, keepdims=True) + EPS)
    return (y * g.astype(jnp.float32)).astype(x.dtype)


def axial_rope_tables(n_tokens):
    rows = n_tokens // GRID_W
    n_freq = DA_HD // 4
    inv = ROPE_BASE ** (-jnp.arange(n_freq, dtype=jnp.float32) / n_freq)
    r = jnp.repeat(jnp.arange(rows, dtype=jnp.float32), GRID_W)
    col = jnp.tile(jnp.arange(GRID_W, dtype=jnp.float32), rows)
    ang = jnp.concatenate([r[:, None] * inv, col[:, None] * inv], axis=-1)
    return jnp.cos(ang), jnp.sin(ang)


def apply_rope(x, cos, sin):
    half = x.shape[-1] // 2
    xf = x.astype(jnp.float32)
    x1, x2 = xf[..., :half], xf[..., half:]
    c = cos[:, None, None, :]
    s = sin[:, None, None, :]
    return jnp.concatenate([x1 * c - x2 * s, x1 * s + x2 * c], axis=-1).astype(x.dtype)


def dwconv_centred(x, w, b):
    ch = x.shape[-1]
    pad = w.shape[0] // 2
    y = lax.conv_general_dilated(x, w[:, None, :].astype(x.dtype), (1,), [(pad, pad)],
                                 dimension_numbers=('NWC', 'WIO', 'NWC'),
                                 feature_group_count=ch)
    return y + b


def _diff_attend(q, k, v, lam):
    s = jnp.einsum('bqhmd,bkhmd->bhmqk', q, k, preferred_element_type=jnp.float32) * (DA_HD ** -0.5)
    p = jax.nn.softmax(s, axis=-1)
    w = p[:, :, 0] - lam * p[:, :, 1]
    return jnp.einsum('bhqk,bkhe->bqhe', w.astype(v.dtype), v)


def _diff_head_out(o, sub_g, lam_init):
    bsz, n = o.shape[:2]
    y = rms_norm(o, sub_g.reshape(DA_HEADS, DA_VD)) * (1.0 - lam_init)
    return y.reshape(bsz, n, DA_HEADS * DA_VD)


def diff_attention_branch(q, k, v, q_c, k_c, v_c, lam_q1, lam_k1, lam_q2, lam_k2, sub_g,
                          rope_cos, rope_sin, lam_init, need_ctx):
    bsz, n = q.shape[:2]
    n_c = k_c.shape[1]
    shp = (DA_HEADS, 2, DA_HD)
    q = apply_rope(q.reshape(bsz, n, *shp), rope_cos, rope_sin)
    k = apply_rope(k.reshape(bsz, n, *shp), rope_cos, rope_sin)
    v = v.reshape(bsz, n, DA_HEADS, DA_VD)
    k_c = k_c.reshape(bsz, n_c, *shp)
    v_c = v_c.reshape(bsz, n_c, DA_HEADS, DA_VD)
    f32 = jnp.float32
    lam = (jnp.exp(jnp.sum(lam_q1.astype(f32) * lam_k1.astype(f32)))
           - jnp.exp(jnp.sum(lam_q2.astype(f32) * lam_k2.astype(f32))) + lam_init)
    k_all = jnp.concatenate([k, k_c], axis=1)
    v_all = jnp.concatenate([v, v_c], axis=1)
    nb = n // ATTN_BLOCK
    q_blocks = jnp.moveaxis(q.reshape(bsz, nb, ATTN_BLOCK, *shp), 1, 0)
    o = lax.map(lambda qb: _diff_attend(qb, k_all, v_all, lam), q_blocks)
    o = jnp.moveaxis(o, 0, 1).reshape(bsz, n, DA_HEADS, DA_VD)
    y = _diff_head_out(o, sub_g, lam_init)
    y_c = None
    if need_ctx:
        q_c = q_c.reshape(bsz, n_c, *shp)
        y_c = _diff_head_out(_diff_attend(q_c, k_c, v_c, lam), sub_g, lam_init)
    return y, y_c


def _mlstm_chunks(q, k, v, log_i, log_f, state):
    bsz, nh, n, d = q.shape
    nc = n // ML_CHUNK

    def chunked(a):
        return jnp.moveaxis(a.reshape(bsz, nh, nc, ML_CHUNK, *a.shape[3:]), 2, 0)

    tri = jnp.tril(jnp.ones((ML_CHUNK, ML_CHUNK), dtype=bool))

    def step(carry, blk):
        C, nrm, m = carry
        qq, kk, vv, li, lf = blk
        b = jnp.cumsum(lf, axis=-1)
        dmat = jnp.where(tri, b[..., :, None] - b[..., None, :] + li[..., None, :], -jnp.inf)
        inter = b + m[..., None]
        m_t = jnp.maximum(inter, jnp.max(dmat, axis=-1))
        s = jnp.einsum('bhtd,bhsd->bhts', qq, kk) * jnp.exp(dmat - m_t[..., None])
        w_prev = jnp.exp(inter - m_t)
        num = (jnp.einsum('bhts,bhse->bhte', s, vv)
               + w_prev[..., None] * jnp.einsum('bhtd,bhed->bhte', qq, C))
        den = jnp.sum(s, axis=-1) + w_prev * jnp.einsum('bhtd,bhd->bht', qq, nrm)
        h = num / jnp.maximum(jnp.abs(den), jnp.exp(-m_t))[..., None]
        b_end = b[..., -1]
        g = b_end[..., None] - b + li
        m_new = jnp.maximum(b_end + m, jnp.max(g, axis=-1))
        wg = jnp.exp(g - m_new[..., None])
        decay = jnp.exp(b_end + m - m_new)
        C = decay[..., None, None] * C + jnp.einsum('bhse,bhsd->bhed', vv * wg[..., None], kk)
        nrm = decay[..., None] * nrm + jnp.einsum('bhs,bhsd->bhd', wg, kk)
        return (C, nrm, m_new), h

    xs = (chunked(q), chunked(k), chunked(v), chunked(log_i), chunked(log_f))
    state, hs = lax.scan(step, state, xs)
    return jnp.moveaxis(hs, 0, 2).reshape(bsz, nh, n, d), state


def _mlstm_out(h, o, norm_g):
    bsz, nh, n, d = h.shape
    hn = rms_norm(jnp.transpose(h, (0, 2, 1, 3)), norm_g.reshape(nh, d))
    og = jax.nn.sigmoid(o.astype(jnp.float32)).reshape(bsz, n, nh, d)
    return (hn * og).reshape(bsz, n, nh * d).astype(o.dtype)


def mlstm_branch(xm, v, o, g, xm_c, v_c, o_c, g_c, conv_w, conv_b, wq, wk, gate_b, norm_g,
                 need_ctx):
    f32 = jnp.float32

    def prepare(xm_, v_, g_):
        bsz, n = xm_.shape[:2]
        xconv = jax.nn.silu(dwconv_centred(xm_, conv_w, conv_b)).astype(f32)
        xh = xconv.reshape(bsz, n, ML_HEADS, ML_HD)
        q = jnp.einsum('blhd,hde->bhle', xh, wq.astype(f32)) * (ML_HD ** -0.5)
        k = jnp.einsum('blhd,hde->bhle', xh, wk.astype(f32))
        vh = jnp.transpose(v_.astype(f32).reshape(bsz, n, ML_HEADS, ML_HD), (0, 2, 1, 3))
        gg = (g_.astype(f32) + gate_b.astype(f32)).reshape(bsz, n, 2, 2, ML_HEADS)
        gg = jnp.transpose(gg, (2, 3, 0, 4, 1))
        return q, k, vh, gg[:, 0], jax.nn.log_sigmoid(gg[:, 1])

    q, k, vh, log_i, log_f = prepare(xm, v, g)
    q_c, k_c, vh_c, log_ic, log_fc = prepare(xm_c, v_c, g_c)
    bsz = q.shape[0]
    zero = (jnp.zeros((bsz, ML_HEADS, ML_HD, ML_HD), f32),
            jnp.zeros((bsz, ML_HEADS, ML_HD), f32),
            jnp.zeros((bsz, ML_HEADS), f32))

    def flip(a):
        return jnp.flip(a, axis=2)

    h_cf, st_f = _mlstm_chunks(q_c, k_c, vh_c, log_ic[0], log_fc[0], zero)
    h_cb, st_b = _mlstm_chunks(flip(q_c), flip(k_c), flip(vh_c), flip(log_ic[1]), flip(log_fc[1]), zero)
    h_f, _ = _mlstm_chunks(q, k, vh, log_i[0], log_f[0], st_f)
    h_b, _ = _mlstm_chunks(flip(q), flip(k), flip(vh), flip(log_i[1]), flip(log_f[1]), st_b)
    y = _mlstm_out(h_f + flip(h_b), o, norm_g)
    y_c = _mlstm_out(h_cf + flip(h_cb), o_c, norm_g) if need_ctx else None
    return y, y_c


def _s5_discretise(lam_re, lam_im, log_dt, b_re, b_im):
    f32 = jnp.float32
    lam_re, lam_im = lam_re.astype(f32), lam_im.astype(f32)
    b_re, b_im = b_re.astype(f32), b_im.astype(f32)
    dt = jnp.exp(log_dt.astype(f32))[:, None]
    mag = jnp.exp(lam_re * dt)
    ab_re = mag * jnp.cos(lam_im * dt)
    ab_im = mag * jnp.sin(lam_im * dt)
    den = lam_re * lam_re + lam_im * lam_im
    z_re = ((ab_re - 1.0) * lam_re + ab_im * lam_im) / den
    z_im = (ab_im * lam_re - (ab_re - 1.0) * lam_im) / den
    bb_re = z_re[..., None] * b_re - z_im[..., None] * b_im
    bb_im = z_re[..., None] * b_im + z_im[..., None] * b_re
    return ab_re, ab_im, bb_re, bb_im


def _complex_affine_combine(e1, e2):
    a1r, a1i, b1r, b1i = e1
    a2r, a2i, b2r, b2i = e2
    return (a1r * a2r - a1i * a2i, a1r * a2i + a1i * a2r,
            a2r * b1r - a2i * b1i + b2r, a2r * b1i + a2i * b1r + b2i)


def _s5_states(u, ab_re, ab_im, bb_re, bb_im, s0_re, s0_im, reverse):
    bu_re = jnp.einsum('blgp,gnp->blgn', u, bb_re)
    bu_im = jnp.einsum('blgp,gnp->blgn', u, bb_im)
    first = -1 if reverse else 0
    bu_re = bu_re.at[:, first].add(ab_re * s0_re - ab_im * s0_im)
    bu_im = bu_im.at[:, first].add(ab_re * s0_im + ab_im * s0_re)
    a_re = jnp.broadcast_to(ab_re, bu_re.shape)
    a_im = jnp.broadcast_to(ab_im, bu_im.shape)
    _, _, x_re, x_im = lax.associative_scan(_complex_affine_combine, (a_re, a_im, bu_re, bu_im),
                                            reverse=reverse, axis=1)
    return x_re, x_im


def _s5_readout(x_re, x_im, c_re, c_im):
    return (jnp.einsum('blgn,gpn->blgp', x_re, c_re.astype(jnp.float32))
            - jnp.einsum('blgn,gpn->blgp', x_im, c_im.astype(jnp.float32)))


def _s5_glu(y, glu_w, glu_b):
    g = jax.nn.gelu(y, approximate=False)
    return g * jax.nn.sigmoid(g @ glu_w.astype(jnp.float32) + glu_b.astype(jnp.float32))


def s5_branch(u, u_c, lam_re, lam_im, log_dt, b_re, b_im, c_re, c_im, d_skip, glu_w, glu_b,
              need_ctx):
    f32 = jnp.float32
    bsz, n = u.shape[:2]
    n_c = u_c.shape[1]
    ug = u.astype(f32).reshape(bsz, n, S5_G, S5_P)
    ucg = u_c.astype(f32).reshape(bsz, n_c, S5_G, S5_P)
    dsk = d_skip.astype(f32).reshape(S5_G, S5_P)
    y = dsk * ug
    y_c = dsk * ucg if need_ctx else None
    zeros = jnp.zeros((bsz, S5_G, S5_N), f32)
    for r in range(2):
        rev = r == 1
        ab_re, ab_im, bb_re, bb_im = _s5_discretise(lam_re[r], lam_im[r], log_dt[r], b_re[r], b_im[r])
        xc_re, xc_im = _s5_states(ucg, ab_re, ab_im, bb_re, bb_im, zeros, zeros, rev)
        end = 0 if rev else -1
        x_re, x_im = _s5_states(ug, ab_re, ab_im, bb_re, bb_im, xc_re[:, end], xc_im[:, end], rev)
        y = y + _s5_readout(x_re, x_im, c_re[r], c_im[r])
        if need_ctx:
            y_c = y_c + _s5_readout(xc_re, xc_im, c_re[r], c_im[r])
    out = _s5_glu(y.reshape(bsz, n, S5_G * S5_P), glu_w, glu_b).astype(u.dtype)
    out_c = None
    if need_ctx:
        out_c = _s5_glu(y_c.reshape(bsz, n_c, S5_G * S5_P), glu_w, glu_b).astype(u.dtype)
    return out, out_c


def merge_branches(ya, yb, ys, gate_pre, w_br, w_out):
    ys_all = jnp.stack([ya, yb, ys], axis=-2)
    proj = jnp.einsum('blrc,rcd->blrd', ys_all, w_br)
    d_model = gate_pre.shape[-1] // N_BRANCH
    gates = jax.nn.sigmoid(gate_pre.astype(jnp.float32).reshape(*gate_pre.shape[:-1], N_BRANCH, d_model))
    merged = jnp.sum(gates * proj.astype(jnp.float32), axis=-2).astype(ya.dtype)
    return merged @ w_out


def token_mixer(h, hc, p, rope_cos, rope_sin, lam_init, need_ctx):
    z = jnp.split(h @ p['w_in'], IN_IDX, axis=-1)
    zc = jnp.split(hc @ p['w_in'], IN_IDX, axis=-1)
    ya, ya_c = diff_attention_branch(z[0], z[1], z[2], zc[0], zc[1], zc[2],
                                     p['da_lam_q1'], p['da_lam_k1'], p['da_lam_q2'], p['da_lam_k2'],
                                     p['da_sub_g'], rope_cos, rope_sin, lam_init, need_ctx)
    yb, yb_c = mlstm_branch(z[3], z[4], z[5], z[6], zc[3], zc[4], zc[5], zc[6],
                            p['ml_conv_w'], p['ml_conv_b'], p['ml_wq'], p['ml_wk'],
                            p['ml_gate_b'], p['ml_norm_g'], need_ctx)
    ys, ys_c = s5_branch(z[7], zc[7], p['s5_lam_re'], p['s5_lam_im'], p['s5_log_dt'],
                         p['s5_b_re'], p['s5_b_im'], p['s5_c_re'], p['s5_c_im'], p['s5_d'],
                         p['s5_glu_w'], p['s5_glu_b'], need_ctx)
    y = merge_branches(ya, yb, ys, z[8], p['w_br'], p['w_out'])
    y_c = merge_branches(ya_c, yb_c, ys_c, zc[8], p['w_br'], p['w_out']) if need_ctx else None
    return y, y_c


def peer_ffn(h, wq, sub_k, u_tab, v_tab):
    n_tok = h.shape[0]
    half = PEER_QD // 2
    q = (h @ wq).astype(jnp.float32).reshape(n_tok, PEER_HEADS, 2, half)
    s1 = jnp.einsum('thc,kc->thk', q[:, :, 0], sub_k[0].astype(jnp.float32))
    s2 = jnp.einsum('thc,kc->thk', q[:, :, 1], sub_k[1].astype(jnp.float32))
    v1, i1 = lax.top_k(s1, PEER_TOPK)
    v2, i2 = lax.top_k(s2, PEER_TOPK)
    cand_s = (v1[..., :, None] + v2[..., None, :]).reshape(n_tok, PEER_HEADS, PEER_TOPK * PEER_TOPK)
    cand_i = (i1[..., :, None] * PEER_NKEYS + i2[..., None, :]).reshape(n_tok, PEER_HEADS, PEER_TOPK * PEER_TOPK)
    top_s, top_j = lax.top_k(cand_s, PEER_TOPK)
    experts = jnp.take_along_axis(cand_i, top_j, axis=-1)
    gates = jax.nn.softmax(top_s, axis=-1)
    nb = n_tok // PEER_BLOCK

    def block(args):
        hb, eb, gb = args
        act = jax.nn.gelu(jnp.einsum('td,thkd->thk', hb, u_tab[eb]).astype(jnp.float32), approximate=False)
        return jnp.einsum('thk,thkd->td', (gb * act).astype(hb.dtype), v_tab[eb])

    out = lax.map(block, (h.reshape(nb, PEER_BLOCK, -1),
                          experts.reshape(nb, PEER_BLOCK, PEER_HEADS, PEER_TOPK),
                          gates.reshape(nb, PEER_BLOCK, PEER_HEADS, PEER_TOPK)))
    return out.reshape(n_tok, -1)


def setup_inputs(seed: int = 0) -> dict:
    key = jax.random.key(seed)
    ks = iter(jax.random.split(key, 48))
    f32 = jnp.float32

    def nrm(shape, std):
        return std * jax.random.normal(next(ks), shape, f32)

    D = D_MODEL
    x = nrm((BATCH, SEQ, D), 1.0)
    c = nrm((BATCH, D), 1.0)
    ctx = nrm((BATCH, CTX_LEN, D), 1.0)
    c_ctx = nrm((D,), 1.0)
    w_mod = nrm((DEPTH, D, N_MOD * D), 0.5 * D ** -0.5)
    b_mod = nrm((DEPTH, N_MOD * D), 0.02)
    norm1_g = 1.0 + nrm((DEPTH, D), 0.02)
    norm2_g = 1.0 + nrm((DEPTH, D), 0.02)
    w_in = nrm((DEPTH, D, IN_WIDTH), D ** -0.5)
    da_lam_q1 = nrm((DEPTH, DA_HD), 0.1)
    da_lam_k1 = nrm((DEPTH, DA_HD), 0.1)
    da_lam_q2 = nrm((DEPTH, DA_HD), 0.1)
    da_lam_k2 = nrm((DEPTH, DA_HD), 0.1)
    da_sub_g = 1.0 + nrm((DEPTH, DA_HEADS * DA_VD), 0.02)
    ml_conv_w = nrm((DEPTH, ML_CONV, BRANCH_W), ML_CONV ** -0.5)
    ml_conv_b = nrm((DEPTH, BRANCH_W), 0.02)
    ml_wq = nrm((DEPTH, ML_HEADS, ML_HD, ML_HD), ML_HD ** -0.5)
    ml_wk = nrm((DEPTH, ML_HEADS, ML_HD, ML_HD), ML_HD ** -0.5)
    f_bias = jnp.linspace(3.0, 6.0, ML_HEADS, dtype=f32)
    gate_base = jnp.concatenate([jnp.zeros((ML_HEADS,), f32), f_bias, jnp.zeros((ML_HEADS,), f32), f_bias])
    ml_gate_b = gate_base + nrm((DEPTH, ML_NGATE), 0.1)
    ml_norm_g = 1.0 + nrm((DEPTH, BRANCH_W), 0.02)
    s5_lam_re = -0.5 + nrm((DEPTH, 2, S5_G, S5_N), 0.01)
    s5_lam_im = math.pi * jnp.arange(S5_N, dtype=f32) + nrm((DEPTH, 2, S5_G, S5_N), 0.01)
    s5_log_dt = jax.random.uniform(next(ks), (DEPTH, 2, S5_G), f32, math.log(1e-3), math.log(1e-1))
    s5_b_re = nrm((DEPTH, 2, S5_G, S5_N, S5_P), (2 * S5_P) ** -0.5)
    s5_b_im = nrm((DEPTH, 2, S5_G, S5_N, S5_P), (2 * S5_P) ** -0.5)
    s5_c_re = nrm((DEPTH, 2, S5_G, S5_P, S5_N), S5_N ** -0.5)
    s5_c_im = nrm((DEPTH, 2, S5_G, S5_P, S5_N), S5_N ** -0.5)
    s5_d = nrm((DEPTH, BRANCH_W), 0.5)
    s5_glu_w = nrm((DEPTH, BRANCH_W, BRANCH_W), BRANCH_W ** -0.5)
    s5_glu_b = nrm((DEPTH, BRANCH_W), 0.02)
    w_br = nrm((DEPTH, N_BRANCH, BRANCH_W, D), BRANCH_W ** -0.5)
    w_out = nrm((DEPTH, D, D), D ** -0.5)
    peer_wq = nrm((DEPTH, D, PEER_HEADS * PEER_QD), D ** -0.5)
    peer_sub_k = nrm((DEPTH, 2, PEER_NKEYS, PEER_QD // 2), (PEER_QD // 2) ** -0.5)
    peer_u = nrm((DEPTH, PEER_EXPERTS, D), D ** -0.5)
    peer_v = nrm((DEPTH, PEER_EXPERTS, D), 1.0)
    final_g = 1.0 + nrm((D,), 0.02)
    return {'x': x, 'c': c, 'ctx': ctx, 'c_ctx': c_ctx, 'w_mod': w_mod, 'b_mod': b_mod,
            'norm1_g': norm1_g, 'norm2_g': norm2_g, 'w_in': w_in,
            'da_lam_q1': da_lam_q1, 'da_lam_k1': da_lam_k1, 'da_lam_q2': da_lam_q2,
            'da_lam_k2': da_lam_k2, 'da_sub_g': da_sub_g,
            'ml_conv_w': ml_conv_w, 'ml_conv_b': ml_conv_b, 'ml_wq': ml_wq, 'ml_wk': ml_wk,
            'ml_gate_b': ml_gate_b, 'ml_norm_g': ml_norm_g,
            's5_lam_re': s5_lam_re, 's5_lam_im': s5_lam_im, 's5_log_dt': s5_log_dt,
            's5_b_re': s5_b_re, 's5_b_im': s5_b_im, 's5_c_re': s5_c_re, 's5_c_im': s5_c_im,
            's5_d': s5_d, 's5_glu_w': s5_glu_w, 's5_glu_b': s5_glu_b,
            'w_br': w_br, 'w_out': w_out, 'peer_wq': peer_wq, 'peer_sub_k': peer_sub_k,
            'peer_u': peer_u, 'peer_v': peer_v, 'final_g': final_g}


def reference(x, c, ctx, c_ctx, w_mod, b_mod, norm1_g, norm2_g, w_in,
              da_lam_q1, da_lam_k1, da_lam_q2, da_lam_k2, da_sub_g,
              ml_conv_w, ml_conv_b, ml_wq, ml_wk, ml_gate_b, ml_norm_g,
              s5_lam_re, s5_lam_im, s5_log_dt, s5_b_re, s5_b_im, s5_c_re, s5_c_im,
              s5_d, s5_glu_w, s5_glu_b, w_br, w_out, peer_wq, peer_sub_k, peer_u, peer_v,
              final_g):
    bsz, n, d_model = x.shape
    n_c = ctx.shape[1]
    rope_cos, rope_sin = axial_rope_tables(n)
    xc = ctx
    for l in range(DEPTH):
        need_ctx = l < DEPTH - 1
        lam_init = 0.8 - 0.6 * math.exp(-0.3 * l)
        m_lat = jnp.split(jax.nn.silu(c) @ w_mod[l] + b_mod[l], N_MOD, axis=-1)
        m_ctx = jnp.split(jax.nn.silu(c_ctx) @ w_mod[l] + b_mod[l], N_MOD, axis=-1)
        sh1, sc1, g1, sh2, sc2, g2 = [t[:, None, :] for t in m_lat]
        csh1, csc1, cg1, csh2, csc2, cg2 = m_ctx
        p = dict(w_in=w_in[l], da_lam_q1=da_lam_q1[l], da_lam_k1=da_lam_k1[l],
                 da_lam_q2=da_lam_q2[l], da_lam_k2=da_lam_k2[l], da_sub_g=da_sub_g[l],
                 ml_conv_w=ml_conv_w[l], ml_conv_b=ml_conv_b[l], ml_wq=ml_wq[l], ml_wk=ml_wk[l],
                 ml_gate_b=ml_gate_b[l], ml_norm_g=ml_norm_g[l],
                 s5_lam_re=s5_lam_re[l], s5_lam_im=s5_lam_im[l], s5_log_dt=s5_log_dt[l],
                 s5_b_re=s5_b_re[l], s5_b_im=s5_b_im[l], s5_c_re=s5_c_re[l], s5_c_im=s5_c_im[l],
                 s5_d=s5_d[l], s5_glu_w=s5_glu_w[l], s5_glu_b=s5_glu_b[l],
                 w_br=w_br[l], w_out=w_out[l])
        h = rms_norm(x, norm1_g[l]) * (1.0 + sc1) + sh1
        hc = rms_norm(xc, norm1_g[l]) * (1.0 + csc1) + csh1
        y, y_c = token_mixer(h, hc, p, rope_cos, rope_sin, lam_init, need_ctx)
        x = x + g1 * y
        h2 = rms_norm(x, norm2_g[l]) * (1.0 + sc2) + sh2
        tokens = h2.reshape(-1, d_model)
        if need_ctx:
            xc = xc + cg1 * y_c
            hc2 = rms_norm(xc, norm2_g[l]) * (1.0 + csc2) + csh2
            tokens = jnp.concatenate([tokens, hc2.reshape(-1, d_model)], axis=0)
        f = peer_ffn(tokens, peer_wq[l], peer_sub_k[l], peer_u[l], peer_v[l])
        x = x + g2 * f[:bsz * n].reshape(bsz, n, d_model)
        if need_ctx:
            xc = xc + cg2 * f[bsz * n:].reshape(bsz, n_c, d_model)
    return rms_norm(x, final_g)
```

```cpp
#include <hip/hip_runtime.h>
#include <hip/hip_cooperative_groups.h>
#include <cstdio>
#include <cstdint>
namespace cg = cooperative_groups;

#define NLAT 4096
#define NCTX 256
#define NTOK 4352
#define DM 1024
#define INW 6672
#define NB 8
#define EPSF 1e-6f

enum { I_X = 0, I_C, I_CTX, I_CCTX, I_WMOD, I_BMOD, I_N1G, I_N2G, I_WIN, I_LQ1, I_LK1, I_LQ2, I_LK2, I_SUBG,
       I_CONVW, I_CONVB, I_MLWQ, I_MLWK, I_GATEB, I_MLNG, I_S5LRE, I_S5LIM, I_S5DT, I_S5BRE, I_S5BIM,
       I_S5CRE, I_S5CIM, I_S5D, I_GLUW, I_GLUB, I_WBR, I_WOUT, I_PWQ, I_PSUBK, I_PU, I_PV, I_FG, N_IN };

struct Params {
  const float* in[N_IN];
  float* out;
  float* ws;
};

#define WS_XA   ((size_t)0)
#define WS_MOD  (WS_XA + (size_t)NB * NTOK * DM)
#define WS_SKT  (WS_MOD + (size_t)2 * 9 * 6144)
#define WS_H    (WS_SKT + (size_t)2 * 2 * 128 * 128)
#define WS_Z    (WS_H + (size_t)NTOK * DM)
#define WS_XC   (WS_Z + (size_t)NTOK * INW)
#define WS_QM   (WS_XC + (size_t)NTOK * 512)
#define WS_KM   (WS_QM + (size_t)NTOK * 512)
#define WS_HF   (WS_KM + (size_t)NTOK * 512)
#define WS_HB   (WS_HF + (size_t)NTOK * 512)
#define WS_OA   (WS_HB + (size_t)NTOK * 512)
#define WS_YA   (WS_OA + (size_t)2 * NTOK * 512)
#define WS_YB   (WS_YA + (size_t)NTOK * 512)
#define WS_YS   (WS_YB + (size_t)NTOK * 512)
#define WS_YSF  (WS_YS + (size_t)NTOK * 512)
#define WS_YSB  (WS_YSF + (size_t)NTOK * 512)
#define WS_GG   (WS_YSB + (size_t)NTOK * 512)
#define WS_GT   (WS_GG + (size_t)NTOK * 512)
#define WS_MG   (WS_GT + (size_t)NTOK * 512)
#define WS_END  (WS_MG + (size_t)NTOK * DM)
#define WS_PQ   (WS_Z)
#define WS_SC   (WS_PQ + (size_t)NTOK * 2048)
#define WS_EI   (WS_SC + (size_t)NTOK * 2048)
#define WS_EG   (WS_EI + (size_t)NTOK * 128)

#define SMEM_FLOATS (24 * 1024)

__device__ __forceinline__ float sigmoidf_(float x) { return 1.0f / (1.0f + expf(-x)); }
__device__ __forceinline__ float siluf_(float x) { return x / (1.0f + expf(-x)); }
__device__ __forceinline__ float geluf_(float x) { return 0.5f * x * (1.0f + erff(x * 0.70710678118654752f)); }
__device__ __forceinline__ float wave_sum(float v) {
  for (int o = 32; o > 0; o >>= 1) v += __shfl_xor(v, o);
  return v;
}

struct GemmArgs {
  const float* A; const float* B; float* C; const float* E; const float* E2;
  int lda, ldb, ldc, lde, M, N, K, epi;
  float alpha;
};
__device__ __forceinline__ void gemm_f32(const GemmArgs& g, float* smem) {
  float (*As)[68] = (float (*)[68])smem;
  float (*Bs)[68] = (float (*)[68])(smem + 16 * 68);
  const int tid = threadIdx.x;
  const int tx = tid & 15, ty = tid >> 4;
  const int tm = (g.M + 63) >> 6, tn = (g.N + 63) >> 6;
  const int ntiles = tm * tn;
  for (int t = blockIdx.x; t < ntiles; t += gridDim.x) {
    const int m0 = (t / tn) * 64, n0 = (t % tn) * 64;
    float acc[4][4];
#pragma unroll
    for (int i = 0; i < 4; ++i)
#pragma unroll
      for (int j = 0; j < 4; ++j) acc[i][j] = 0.f;
    const int ar = m0 + (tid >> 2), ac = (tid & 3) * 4;
    const int br = tid >> 4, bc = n0 + (tid & 15) * 4;
    for (int k0 = 0; k0 < g.K; k0 += 16) {
      float4 a4 = make_float4(0.f, 0.f, 0.f, 0.f), b4 = make_float4(0.f, 0.f, 0.f, 0.f);
      if (ar < g.M) a4 = *(const float4*)(g.A + (size_t)ar * g.lda + k0 + ac);
      if (bc < g.N) b4 = *(const float4*)(g.B + (size_t)(k0 + br) * g.ldb + bc);
      __syncthreads();
      As[ac + 0][tid >> 2] = a4.x; As[ac + 1][tid >> 2] = a4.y; As[ac + 2][tid >> 2] = a4.z; As[ac + 3][tid >> 2] = a4.w;
      *(float4*)&Bs[br][(tid & 15) * 4] = b4;
      __syncthreads();
#pragma unroll
      for (int kk = 0; kk < 16; ++kk) {
        float4 av = *(const float4*)&As[kk][ty * 4];
        float4 bv = *(const float4*)&Bs[kk][tx * 4];
        float a[4] = {av.x, av.y, av.z, av.w}, b[4] = {bv.x, bv.y, bv.z, bv.w};
#pragma unroll
        for (int i = 0; i < 4; ++i)
#pragma unroll
          for (int j = 0; j < 4; ++j) acc[i][j] = fmaf(a[i], b[j], acc[i][j]);
      }
    }
    const int n = n0 + tx * 4;
    if (n < g.N) {
#pragma unroll
      for (int i = 0; i < 4; ++i) {
        const int m = m0 + ty * 4 + i;
        if (m < g.M) {
          float4* cp = (float4*)(g.C + (size_t)m * g.ldc + n);
          float4 r;
          if (g.epi == 0) {
            r = make_float4(g.alpha * acc[i][0], g.alpha * acc[i][1], g.alpha * acc[i][2], g.alpha * acc[i][3]);
          } else if (g.epi == 1 || g.epi == 2) {
            float4 e = *(const float4*)(g.E + (size_t)m * g.lde + n);
            r = make_float4(sigmoidf_(e.x) * acc[i][0], sigmoidf_(e.y) * acc[i][1], sigmoidf_(e.z) * acc[i][2], sigmoidf_(e.w) * acc[i][3]);
            if (g.epi == 2) { float4 c = *cp; r.x += c.x; r.y += c.y; r.z += c.z; r.w += c.w; }
          } else {
            float4 e = *(const float4*)((m < NLAT ? g.E : g.E2) + n);
            float4 c = *cp;
            r = make_float4(c.x + e.x * acc[i][0], c.y + e.y * acc[i][1], c.z + e.z * acc[i][2], c.w + e.w * acc[i][3]);
          }
          *cp = r;
        }
      }
    }
  }
  __syncthreads();
}

__device__ __forceinline__ void stage_init(const Params& p, float* smem) {
  const int tid = threadIdx.x;
  float* XA = p.ws + WS_XA;
  {
    const size_t n4 = (size_t)NB * NTOK * 256;
    for (size_t i = (size_t)blockIdx.x * 256 + tid; i < n4; i += (size_t)gridDim.x * 256) {
      size_t row = i >> 8; int c4 = (int)(i & 255);
      int b = (int)(row / NTOK), r = (int)(row % NTOK);
      const float* src = (r < NLAT) ? p.in[I_X] + ((size_t)b * NLAT + r) * DM : p.in[I_CTX] + ((size_t)b * NCTX + (r - NLAT)) * DM;
      ((float4*)XA)[i] = ((const float4*)src)[c4];
    }
  }
  {
    float* skt = p.ws + WS_SKT;
    const float* sk = p.in[I_PSUBK];
    for (int i = blockIdx.x * 256 + tid; i < 2 * 2 * 128 * 128; i += gridDim.x * 256) {
      int lh = i >> 14, c = (i >> 7) & 127, k = i & 127;
      skt[i] = sk[(size_t)lh * 16384 + k * 128 + c];
    }
  }
  {
    float* sc = smem;
    for (int i = tid; i < 9 * 1024; i += 256) {
      int r = i >> 10, k = i & 1023;
      float v = (r < 8) ? p.in[I_C][r * 1024 + k] : p.in[I_CCTX][k];
      sc[i] = siluf_(v);
    }
    __syncthreads();
    float* mod = p.ws + WS_MOD;
    for (int col = blockIdx.x * 256 + tid; col < 2 * 6144; col += gridDim.x * 256) {
      int l = col / 6144, j = col % 6144;
      const float* w = p.in[I_WMOD] + (size_t)l * 1024 * 6144 + j;
      float acc[9];
#pragma unroll
      for (int r = 0; r < 9; ++r) acc[r] = 0.f;
      for (int k = 0; k < 1024; ++k) {
        float wv = w[(size_t)k * 6144];
#pragma unroll
        for (int r = 0; r < 9; ++r) acc[r] = fmaf(sc[r * 1024 + k], wv, acc[r]);
      }
      float bv = p.in[I_BMOD][l * 6144 + j];
#pragma unroll
      for (int r = 0; r < 9; ++r) mod[((size_t)l * 9 + r) * 6144 + j] = acc[r] + bv;
    }
    __syncthreads();
  }
}

__device__ __forceinline__ void stage_normmod(const float* X, float* H, const float* ng, const float* mod_lat, const float* mod_ctx,
                              int off_sh, int off_sc, int nrows, float* smem) {
  const int tid = threadIdx.x;
  for (int r = blockIdx.x; r < nrows; r += gridDim.x) {
    float4 v = ((const float4*)(X + (size_t)r * DM))[tid];
    float s = wave_sum(v.x * v.x + v.y * v.y + v.z * v.z + v.w * v.w);
    __syncthreads();
    if ((tid & 63) == 0) smem[tid >> 6] = s;
    __syncthreads();
    float tot = smem[0] + smem[1] + smem[2] + smem[3];
    float rs = rsqrtf(tot * (1.0f / DM) + EPSF);
    const float* mod = (r < NLAT) ? mod_lat : mod_ctx;
    float4 g = ((const float4*)ng)[tid];
    float4 sc = ((const float4*)(mod + off_sc))[tid];
    float4 sh = ((const float4*)(mod + off_sh))[tid];
    float4 o;
    o.x = v.x * rs * g.x * (1.f + sc.x) + sh.x;
    o.y = v.y * rs * g.y * (1.f + sc.y) + sh.y;
    o.z = v.z * rs * g.z * (1.f + sc.z) + sh.z;
    o.w = v.w * rs * g.w * (1.f + sc.w) + sh.w;
    ((float4*)(H + (size_t)r * DM))[tid] = o;
  }
  __syncthreads();
}

__device__ __forceinline__ void stage_rope_conv(const Params& p, int l, float* Z, float* XC) {
  const int tid = threadIdx.x;
  for (int r = blockIdx.x; r < NTOK; r += gridDim.x) {
    float* z = Z + (size_t)r * INW;
    if (r < NLAT) {
      const float prow = (float)(r >> 6), pcol = (float)(r & 63);
      for (int i = tid; i < 512; i += 256) {
        int which = i >> 8;
        int hm = (i >> 5) & 7;
        int j = i & 31;
        float inv = powf(10000.0f, -(float)(j & 15) / 16.0f);
        float ang = ((j < 16) ? prow : pcol) * inv;
        float cs = cosf(ang), sn = sinf(ang);
        float* base = z + which * 512 + hm * 64;
        float x1 = base[j], x2 = base[32 + j];
        base[j] = x1 * cs - x2 * sn;
        base[32 + j] = x1 * sn + x2 * cs;
      }
    }
    const bool has_prev = (r < NLAT) ? (r > 0) : (r > NLAT);
    const bool has_next = (r < NLAT) ? (r < NLAT - 1) : (r < NTOK - 1);
    const float* cw = p.in[I_CONVW] + (size_t)l * 3 * 512;
    const float* cb = p.in[I_CONVB] + (size_t)l * 512;
    for (int c = tid; c < 512; c += 256) {
      float a = cb[c] + cw[512 + c] * z[1536 + c];
      if (has_prev) a += cw[c] * (z - INW)[1536 + c];
      if (has_next) a += cw[1024 + c] * (z + INW)[1536 + c];
      XC[(size_t)r * 512 + c] = siluf_(a);
    }
  }
}

__device__ __forceinline__ void attn_item(const float* Z, float* OA, int h, int qrow0, int key0, int nkeys, float* smem) {
  const int tid = threadIdx.x;
  const int m = tid >> 7;
  const int row = qrow0 + (tid & 127);
  float (*Ks)[128] = (float (*)[128])smem;
  float (*Vs)[128] = (float (*)[128])(smem + 32 * 128);
  float q[64];
  {
    const float4* qp = (const float4*)(Z + (size_t)row * INW + h * 128 + m * 64);
#pragma unroll
    for (int i = 0; i < 16; ++i) { float4 t = qp[i]; q[4 * i] = t.x * 0.125f; q[4 * i + 1] = t.y * 0.125f; q[4 * i + 2] = t.z * 0.125f; q[4 * i + 3] = t.w * 0.125f; }
  }
  float o[128];
#pragma unroll
  for (int i = 0; i < 128; ++i) o[i] = 0.f;
  float mrun = -1e30f, lrun = 0.f;
  for (int kt = 0; kt < nkeys; kt += 32) {
    __syncthreads();
#pragma unroll
    for (int i = 0; i < 4; ++i) {
      int idx = tid + i * 256;
      int key = idx >> 5, c4 = idx & 31;
      const float* zr = Z + (size_t)(key0 + kt + key) * INW;
      ((float4*)&Ks[key][0])[c4] = ((const float4*)(zr + 512 + h * 128))[c4];
      ((float4*)&Vs[key][0])[c4] = ((const float4*)(zr + 1024 + h * 128))[c4];
    }
    __syncthreads();
#pragma unroll 1
    for (int sub = 0; sub < 32; sub += 16) {
      float s[16];
      float smax = -1e30f;
#pragma unroll
      for (int jj = 0; jj < 16; ++jj) {
        const float4* kp = (const float4*)&Ks[sub + jj][m * 64];
        float a = 0.f;
#pragma unroll
        for (int d4 = 0; d4 < 16; ++d4) {
          float4 kv = kp[d4];
          a = fmaf(q[4 * d4], kv.x, a); a = fmaf(q[4 * d4 + 1], kv.y, a); a = fmaf(q[4 * d4 + 2], kv.z, a); a = fmaf(q[4 * d4 + 3], kv.w, a);
        }
        s[jj] = a;
        smax = fmaxf(smax, a);
      }
      float mnew = fmaxf(mrun, smax);
      float scale = expf(mrun - mnew);
      mrun = mnew;
      lrun *= scale;
#pragma unroll
      for (int i = 0; i < 128; ++i) o[i] *= scale;
#pragma unroll
      for (int jj = 0; jj < 16; ++jj) {
        float pj = expf(s[jj] - mnew);
        lrun += pj;
        const float4* vp = (const float4*)&Vs[sub + jj][0];
#pragma unroll
        for (int e4 = 0; e4 < 32; ++e4) {
          float4 vv = vp[e4];
          o[4 * e4] = fmaf(pj, vv.x, o[4 * e4]); o[4 * e4 + 1] = fmaf(pj, vv.y, o[4 * e4 + 1]);
          o[4 * e4 + 2] = fmaf(pj, vv.z, o[4 * e4 + 2]); o[4 * e4 + 3] = fmaf(pj, vv.w, o[4 * e4 + 3]);
        }
      }
    }
  }
  const float il = 1.0f / lrun;
  float4* op = (float4*)(OA + ((size_t)m * NTOK + row) * 512 + h * 128);
#pragma unroll
  for (int e4 = 0; e4 < 32; ++e4) op[e4] = make_float4(o[4 * e4] * il, o[4 * e4 + 1] * il, o[4 * e4 + 2] * il, o[4 * e4 + 3] * il);
  __syncthreads();
}

__device__ __forceinline__ void mlstm_item(const Params& p, int l, const float* Z, const float* QM, const float* KM, float* HX,
                           int h, int dir, float* smem) {
  const int tid = threadIdx.x;
  const int e = tid >> 1, hf = tid & 1;
  float* qs = smem;
  float* ks = smem + 16 * 128;
  float* vs = smem + 2 * 16 * 128;
  float* gi = smem + 3 * 16 * 128;
  float* gf = gi + 16;
  int* rows = (int*)(gf + 16);
  const float bi = p.in[I_GATEB][l * 16 + dir * 8 + h];
  const float bf = p.in[I_GATEB][l * 16 + dir * 8 + 4 + h];
  float C[64], nn[64];
#pragma unroll
  for (int j = 0; j < 64; ++j) { C[j] = 0.f; nn[j] = 0.f; }
  for (int s0 = 0; s0 < NTOK; s0 += 16) {
    __syncthreads();
#pragma unroll
    for (int i = 0; i < 2; ++i) {
      int idx = tid + i * 256;
      int st = idx >> 5, c4 = idx & 31;
      int step = s0 + st;
      int row = (dir == 0) ? ((step < NCTX) ? NLAT + step : step - NCTX)
                           : ((step < NCTX) ? NLAT + (NCTX - 1 - step) : (NLAT - 1) - (step - NCTX));
      ((float4*)(qs + st * 128))[c4] = ((const float4*)(QM + (size_t)row * 512 + h * 128))[c4];
      ((float4*)(ks + st * 128))[c4] = ((const float4*)(KM + (size_t)row * 512 + h * 128))[c4];
      ((float4*)(vs + st * 128))[c4] = ((const float4*)(Z + (size_t)row * INW + 2048 + h * 128))[c4];
      if (c4 == 0) {
        float a = Z[(size_t)row * INW + 3072 + dir * 8 + h] + bi;
        float f = Z[(size_t)row * INW + 3072 + dir * 8 + 4 + h] + bf;
        gi[st] = expf(a);
        gf[st] = sigmoidf_(f);
        rows[st] = row;
      }
    }
    __syncthreads();
#pragma unroll 1
    for (int st = 0; st < 16; ++st) {
      const float ig = gi[st], fg = gf[st];
      const float iv = ig * vs[st * 128 + e];
      const float4* kp = (const float4*)(ks + st * 128 + hf * 64);
      const float4* qp = (const float4*)(qs + st * 128 + hf * 64);
      float hp = 0.f, dp = 0.f;
#pragma unroll
      for (int j4 = 0; j4 < 16; ++j4) {
        float4 kv = kp[j4], qv = qp[j4];
        float kk[4] = {kv.x, kv.y, kv.z, kv.w}, qq[4] = {qv.x, qv.y, qv.z, qv.w};
#pragma unroll
        for (int u = 0; u < 4; ++u) {
          int j = j4 * 4 + u;
          C[j] = fmaf(fg, C[j], iv * kk[u]);
          nn[j] = fmaf(fg, nn[j], ig * kk[u]);
          hp = fmaf(C[j], qq[u], hp);
          dp = fmaf(nn[j], qq[u], dp);
        }
      }
      hp += __shfl_xor(hp, 1);
      dp += __shfl_xor(dp, 1);
      if (hf == 0) HX[(size_t)rows[st] * 512 + h * 128 + e] = hp / fmaxf(fabsf(dp), 1.0f);
    }
  }
  __syncthreads();
}

__device__ __forceinline__ void s5_item(const Params& p, int l, const float* Z, float* YSF, float* YSB, int g, float* smem) {
  const int tid = threadIdx.x;
  const int w = tid >> 6, lane = tid & 63;
  const bool active = w < 2;
  const int dir = w & 1;
  float* base = smem + (w & 1) * 11392;
  float* us = base;
  float* xre = base + 1024;
  float* xim = xre + 64 * 65;
  float* cre = xim + 64 * 65;
  float* cim = cre + 1024;
  const int pg = ((l * 2 + dir) * 32 + g);
  const int n = lane;
  const float lre = p.in[I_S5LRE][pg * 64 + n], lim = p.in[I_S5LIM][pg * 64 + n];
  const float dt = expf(p.in[I_S5DT][pg]);
  const float mag = expf(lre * dt);
  const float abr = mag * cosf(lim * dt), abi = mag * sinf(lim * dt);
  const float den = lre * lre + lim * lim;
  const float zr = ((abr - 1.0f) * lre + abi * lim) / den;
  const float zi = (abi * lre - (abr - 1.0f) * lim) / den;
  float bbr[16], bbi[16];
  {
    const float* br = p.in[I_S5BRE] + ((size_t)pg * 64 + n) * 16;
    const float* bi = p.in[I_S5BIM] + ((size_t)pg * 64 + n) * 16;
#pragma unroll
    for (int q = 0; q < 16; ++q) { float a = br[q], b = bi[q]; bbr[q] = zr * a - zi * b; bbi[q] = zr * b + zi * a; }
  }
  __syncthreads();
  if (active) {
    const float* cr = p.in[I_S5CRE] + (size_t)pg * 16 * 64;
    const float* ci = p.in[I_S5CIM] + (size_t)pg * 16 * 64;
#pragma unroll
    for (int q = 0; q < 16; ++q) { cre[n * 16 + q] = cr[q * 64 + n]; cim[n * 16 + q] = ci[q * 64 + n]; }
  }
  float xr = 0.f, xi = 0.f;
  float* Y = dir ? YSB : YSF;
  for (int s0 = 0; s0 < NTOK; s0 += 64) {
    const int step = s0 + lane;
    const int row = (dir == 0) ? ((step < NCTX) ? NLAT + step : step - NCTX)
                               : ((step < NCTX) ? NLAT + (NCTX - 1 - step) : (NLAT - 1) - (step - NCTX));
    if (active) {
      const float4* up = (const float4*)(Z + (size_t)row * INW + 3088 + g * 16);
#pragma unroll
      for (int q = 0; q < 4; ++q) ((float4*)(us + lane * 16))[q] = up[q];
    }
    __syncthreads();
    if (active) {
#pragma unroll 4
      for (int t = 0; t < 64; ++t) {
        const float4* up = (const float4*)(us + t * 16);
        float br_ = 0.f, bi_ = 0.f;
#pragma unroll
        for (int q4 = 0; q4 < 4; ++q4) {
          float4 uv = up[q4];
          br_ = fmaf(uv.x, bbr[4 * q4], br_); br_ = fmaf(uv.y, bbr[4 * q4 + 1], br_); br_ = fmaf(uv.z, bbr[4 * q4 + 2], br_); br_ = fmaf(uv.w, bbr[4 * q4 + 3], br_);
          bi_ = fmaf(uv.x, bbi[4 * q4], bi_); bi_ = fmaf(uv.y, bbi[4 * q4 + 1], bi_); bi_ = fmaf(uv.z, bbi[4 * q4 + 2], bi_); bi_ = fmaf(uv.w, bbi[4 * q4 + 3], bi_);
        }
        float nr = abr * xr - abi * xi + br_;
        float ni = abr * xi + abi * xr + bi_;
        xr = nr; xi = ni;
        xre[t * 65 + n] = xr;
        xim[t * 65 + n] = xi;
      }
    }
    __syncthreads();
    if (active) {
      float y[16];
#pragma unroll
      for (int q = 0; q < 16; ++q) y[q] = 0.f;
      for (int nn_ = 0; nn_ < 64; ++nn_) {
        const float a = xre[lane * 65 + nn_], b = xim[lane * 65 + nn_];
        const float4* cr4 = (const float4*)(cre + nn_ * 16);
        const float4* ci4 = (const float4*)(cim + nn_ * 16);
#pragma unroll
        for (int q4 = 0; q4 < 4; ++q4) {
          float4 c1 = cr4[q4], c2 = ci4[q4];
          y[4 * q4] += a * c1.x - b * c2.x; y[4 * q4 + 1] += a * c1.y - b * c2.y;
          y[4 * q4 + 2] += a * c1.z - b * c2.z; y[4 * q4 + 3] += a * c1.w - b * c2.w;
        }
      }
      float4* yp = (float4*)(Y + (size_t)row * 512 + g * 16);
#pragma unroll
      for (int q4 = 0; q4 < 4; ++q4) yp[q4] = make_float4(y[4 * q4], y[4 * q4 + 1], y[4 * q4 + 2], y[4 * q4 + 3]);
    }
    __syncthreads();
  }
}

__device__ __forceinline__ void stage_post(const Params& p, int l, const float* Z, const float* OA, const float* HF, const float* HB,
                           const float* YSF, const float* YSB, float* YA, float* YB, float* GG, int nrows, float* smem) {
  const int tid = threadIdx.x;
  const float lam_init = 0.8f - 0.6f * expf(-0.3f * (float)l);
  float lam;
  {
    float s1 = 0.f, s2 = 0.f;
    for (int i = 0; i < 64; ++i) {
      s1 += p.in[I_LQ1][l * 64 + i] * p.in[I_LK1][l * 64 + i];
      s2 += p.in[I_LQ2][l * 64 + i] * p.in[I_LK2][l * 64 + i];
    }
    lam = expf(s1) - expf(s2) + lam_init;
  }
  const int c0 = tid * 2;
  for (int r = blockIdx.x; r < nrows; r += gridDim.x) {
    {
      float2 a0 = *(const float2*)(OA + (size_t)r * 512 + c0);
      float2 a1 = *(const float2*)(OA + ((size_t)NTOK + r) * 512 + c0);
      float o0 = a0.x - lam * a1.x, o1 = a0.y - lam * a1.y;
      float ss = wave_sum(o0 * o0 + o1 * o1);
      float rs = rsqrtf(ss * (1.0f / 128.0f) + EPSF) * (1.0f - lam_init);
      float2 g = *(const float2*)(p.in[I_SUBG] + l * 512 + c0);
      *(float2*)(YA + (size_t)r * 512 + c0) = make_float2(o0 * rs * g.x, o1 * rs * g.y);
    }
    {
      float2 a0 = *(const float2*)(HF + (size_t)r * 512 + c0);
      float2 a1 = *(const float2*)(HB + (size_t)r * 512 + c0);
      float h0 = a0.x + a1.x, h1 = a0.y + a1.y;
      float ss = wave_sum(h0 * h0 + h1 * h1);
      float rs = rsqrtf(ss * (1.0f / 128.0f) + EPSF);
      float2 g = *(const float2*)(p.in[I_MLNG] + l * 512 + c0);
      float2 og = *(const float2*)(Z + (size_t)r * INW + 2560 + c0);
      *(float2*)(YB + (size_t)r * 512 + c0) = make_float2(h0 * rs * g.x * sigmoidf_(og.x), h1 * rs * g.y * sigmoidf_(og.y));
    }
    {
      float2 u = *(const float2*)(Z + (size_t)r * INW + 3088 + c0);
      float2 d = *(const float2*)(p.in[I_S5D] + l * 512 + c0);
      float2 f = *(const float2*)(YSF + (size_t)r * 512 + c0);
      float2 b = *(const float2*)(YSB + (size_t)r * 512 + c0);
      *(float2*)(GG + (size_t)r * 512 + c0) = make_float2(geluf_(d.x * u.x + f.x + b.x), geluf_(d.y * u.y + f.y + b.y));
    }
  }
}

__device__ __forceinline__ void stage_glu(const Params& p, int l, const float* GG, const float* GT, float* YS, int nrows) {
  const int tid = threadIdx.x;
  const size_t n = (size_t)nrows * 512;
  for (size_t i = (size_t)blockIdx.x * 256 + tid; i < n; i += (size_t)gridDim.x * 256) {
    int c = (int)(i & 511);
    YS[i] = GG[i] * sigmoidf_(GT[i] + p.in[I_GLUB][l * 512 + c]);
  }
}

__device__ __forceinline__ void wave_argmax(float& v, int& idx) {
#pragma unroll
  for (int o = 32; o > 0; o >>= 1) {
    float ov = __shfl_xor(v, o);
    int oi = __shfl_xor(idx, o);
    if (ov > v || (ov == v && oi < idx)) { v = ov; idx = oi; }
  }
}
__device__ __forceinline__ void stage_topk(const float* SC, int* EI, float* EG, int nrows) {
  const int tid = threadIdx.x, w = tid >> 6, lane = tid & 63;
  const int nth = nrows * 8;
  for (int th = blockIdx.x * 4 + w; th < nth; th += gridDim.x * 4) {
    const float* s = SC + (size_t)th * 256;
    float myv[2] = {0.f, 0.f};
    int myi[2] = {0, 0};
#pragma unroll
    for (int half = 0; half < 2; ++half) {
      float a0 = s[half * 128 + lane], a1 = s[half * 128 + 64 + lane];
      for (int r = 0; r < 16; ++r) {
        float v; int idx;
        if (a0 >= a1) { v = a0; idx = lane; } else { v = a1; idx = lane + 64; }
        wave_argmax(v, idx);
        if (idx == lane) a0 = -INFINITY;
        if (idx == lane + 64) a1 = -INFINITY;
        if (lane == r) { myv[half] = v; myi[half] = idx; }
      }
    }
    float cv[4];
    const float v1 = __shfl(myv[0], lane >> 2);
#pragma unroll
    for (int q = 0; q < 4; ++q) cv[q] = v1 + __shfl(myv[1], (lane & 3) * 4 + q);
    float tv = 0.f; int tc = 0;
    for (int r = 0; r < 16; ++r) {
      float v = cv[0]; int idx = lane * 4;
#pragma unroll
      for (int q = 1; q < 4; ++q) if (cv[q] > v) { v = cv[q]; idx = lane * 4 + q; }
      wave_argmax(v, idx);
#pragma unroll
      for (int q = 0; q < 4; ++q) if (idx == lane * 4 + q) cv[q] = -INFINITY;
      if (lane == r) { tv = v; tc = idx; }
    }
    const int e1 = __shfl(myi[0], tc >> 4);
    const int e2 = __shfl(myi[1], tc & 15);
    const float vmax = __shfl(tv, 0);
    float ex = (lane < 16) ? expf(tv - vmax) : 0.f;
    float sum = wave_sum(ex);
    if (lane < 16) {
      EI[(size_t)th * 16 + lane] = e1 * 128 + e2;
      EG[(size_t)th * 16 + lane] = ex / sum;
    }
  }
}

__device__ __forceinline__ void stage_expert(const Params& p, int l, const float* H2, const int* EI, const float* EG, float* XAb,
                             const float* mod_lat, const float* mod_ctx, int nrows, float* smem) {
  const int tid = threadIdx.x, w = tid >> 6, lane = tid & 63;
  float* coef = smem;
  int* eid = (int*)(smem + 128);
  const float* U = p.in[I_PU] + (size_t)l * 16384 * 1024;
  const float* V = p.in[I_PV] + (size_t)l * 16384 * 1024;
  for (int t = blockIdx.x; t < nrows; t += gridDim.x) {
    __syncthreads();
    float4 hv[4];
#pragma unroll
    for (int i = 0; i < 4; ++i) hv[i] = ((const float4*)(H2 + (size_t)t * DM))[i * 64 + lane];
    for (int k = w * 32; k < w * 32 + 32; ++k) {
      const int e = EI[(size_t)t * 128 + k];
      const float4* up = (const float4*)(U + (size_t)e * 1024);
      float a = 0.f;
#pragma unroll
      for (int i = 0; i < 4; ++i) {
        float4 uv = up[i * 64 + lane];
        a = fmaf(hv[i].x, uv.x, a); a = fmaf(hv[i].y, uv.y, a); a = fmaf(hv[i].z, uv.z, a); a = fmaf(hv[i].w, uv.w, a);
      }
      a = wave_sum(a);
      if (lane == 0) { coef[k] = EG[(size_t)t * 128 + k] * geluf_(a); eid[k] = e; }
    }
    __syncthreads();
    float4 acc = make_float4(0.f, 0.f, 0.f, 0.f);
#pragma unroll 8
    for (int k = 0; k < 128; ++k) {
      const float cf = coef[k];
      float4 vv = ((const float4*)(V + (size_t)eid[k] * 1024))[tid];
      acc.x = fmaf(cf, vv.x, acc.x); acc.y = fmaf(cf, vv.y, acc.y); acc.z = fmaf(cf, vv.z, acc.z); acc.w = fmaf(cf, vv.w, acc.w);
    }
    const float4 g2 = ((const float4*)((t < NLAT ? mod_lat : mod_ctx) + 5 * 1024))[tid];
    float4* xp = (float4*)(XAb + (size_t)t * DM) + tid;
    float4 xv = *xp;
    xv.x += g2.x * acc.x; xv.y += g2.y * acc.y; xv.z += g2.z * acc.z; xv.w += g2.w * acc.w;
    *xp = xv;
  }
  __syncthreads();
}

__device__ __forceinline__ void stage_final(const Params& p, float* smem) {
  const int tid = threadIdx.x;
  const float* XA = p.ws + WS_XA;
  for (int r = blockIdx.x; r < NB * NLAT; r += gridDim.x) {
    const int b = r / NLAT, rr = r % NLAT;
    float4 v = ((const float4*)(XA + ((size_t)b * NTOK + rr) * DM))[tid];
    float s = wave_sum(v.x * v.x + v.y * v.y + v.z * v.z + v.w * v.w);
    __syncthreads();
    if ((tid & 63) == 0) smem[tid >> 6] = s;
    __syncthreads();
    float rs = rsqrtf((smem[0] + smem[1] + smem[2] + smem[3]) * (1.0f / DM) + EPSF);
    float4 g = ((const float4*)p.in[I_FG])[tid];
    ((float4*)(p.out + (size_t)r * DM))[tid] = make_float4(v.x * rs * g.x, v.y * rs * g.y, v.z * rs * g.z, v.w * rs * g.w);
  }
}

__global__ void __launch_bounds__(256) mega(Params p) {
  cg::grid_group grid = cg::this_grid();
  __shared__ __attribute__((aligned(16))) float smem[SMEM_FLOATS];
  float* ws = p.ws;
  float* H = ws + WS_H; float* Z = ws + WS_Z; float* XC = ws + WS_XC; float* QM = ws + WS_QM; float* KM = ws + WS_KM;
  float* HF = ws + WS_HF; float* HB = ws + WS_HB; float* OA = ws + WS_OA; float* YA = ws + WS_YA; float* YB = ws + WS_YB;
  float* YS = ws + WS_YS; float* YSF = ws + WS_YSF; float* YSB = ws + WS_YSB; float* GG = ws + WS_GG; float* GT = ws + WS_GT;
  float* MG = ws + WS_MG; float* PQ = ws + WS_PQ; float* SC = ws + WS_SC; int* EI = (int*)(ws + WS_EI); float* EG = ws + WS_EG;

  stage_init(p, smem);
  grid.sync();

  for (int l = 0; l < 2; ++l) {
    const bool need_ctx = (l == 0);
    const int nrows = need_ctx ? NTOK : NLAT;
    for (int b = 0; b < NB; ++b) {
      float* XAb = ws + WS_XA + (size_t)b * NTOK * DM;
      const float* mod_lat = ws + WS_MOD + ((size_t)l * 9 + b) * 6144;
      const float* mod_ctx = ws + WS_MOD + ((size_t)l * 9 + 8) * 6144;
      stage_normmod(XAb, H, p.in[I_N1G] + l * DM, mod_lat, mod_ctx, 0, 1024, NTOK, smem);
      grid.sync();
      {
        GemmArgs g{}; g.A = H; g.lda = DM; g.B = p.in[I_WIN] + (size_t)l * DM * INW; g.ldb = INW; g.C = Z; g.ldc = INW;
        g.M = NTOK; g.N = INW; g.K = DM; g.epi = 0; g.alpha = 1.f;
        gemm_f32(g, smem);
      }
      grid.sync();
      stage_rope_conv(p, l, Z, XC);
      grid.sync();
      for (int i = 0; i < 8; ++i) {
        const int hh = i & 3, which = i >> 2;
        GemmArgs g{}; g.A = XC + hh * 128; g.lda = 512;
        g.B = p.in[which ? I_MLWK : I_MLWQ] + ((size_t)l * 4 + hh) * 128 * 128; g.ldb = 128;
        g.C = (which ? KM : QM) + hh * 128; g.ldc = 512; g.M = NTOK; g.N = 128; g.K = 128; g.epi = 0;
        g.alpha = which ? 1.0f : 0.08838834764831845f;
        gemm_f32(g, smem);
      }
      grid.sync();
      {
        const int n_attn_lat = 4 * 32, n_attn_ctx = need_ctx ? 4 * 2 : 0;
        const int n_items = 8 + 32 + n_attn_lat + n_attn_ctx;
        for (int it = blockIdx.x; it < n_items; it += gridDim.x) {
          if (it < 8) {
            mlstm_item(p, l, Z, QM, KM, (it >> 2) ? HB : HF, it & 3, it >> 2, smem);
          } else if (it < 40) {
            s5_item(p, l, Z, YSF, YSB, it - 8, smem);
          } else if (it < 40 + n_attn_lat) {
            const int a = it - 40;
            attn_item(Z, OA, a & 3, (a >> 2) * 128, 0, NTOK, smem);
          } else {
            const int a = it - 40 - n_attn_lat;
            attn_item(Z, OA, a & 3, NLAT + (a >> 2) * 128, NLAT, NCTX, smem);
          }
        }
      }
      grid.sync();
      stage_post(p, l, Z, OA, HF, HB, YSF, YSB, YA, YB, GG, nrows, smem);
      grid.sync();
      {
        GemmArgs g{}; g.A = GG; g.lda = 512; g.B = p.in[I_GLUW] + (size_t)l * 512 * 512; g.ldb = 512; g.C = GT; g.ldc = 512;
        g.M = nrows; g.N = 512; g.K = 512; g.epi = 0; g.alpha = 1.f;
        gemm_f32(g, smem);
      }
      grid.sync();
      stage_glu(p, l, GG, GT, YS, nrows);
      grid.sync();
      for (int r = 0; r < 3; ++r) {
        GemmArgs g{}; g.A = (r == 0) ? YA : (r == 1 ? YB : YS); g.lda = 512;
        g.B = p.in[I_WBR] + ((size_t)l * 3 + r) * 512 * DM; g.ldb = DM; g.C = MG; g.ldc = DM;
        g.E = Z + 3600 + r * 1024; g.lde = INW; g.M = nrows; g.N = DM; g.K = 512; g.epi = (r == 0) ? 1 : 2; g.alpha = 1.f;
        gemm_f32(g, smem);
      }
      grid.sync();
      {
        GemmArgs g{}; g.A = MG; g.lda = DM; g.B = p.in[I_WOUT] + (size_t)l * DM * DM; g.ldb = DM; g.C = XAb; g.ldc = DM;
        g.E = mod_lat + 2 * 1024; g.E2 = mod_ctx + 2 * 1024; g.M = nrows; g.N = DM; g.K = DM; g.epi = 3; g.alpha = 1.f;
        gemm_f32(g, smem);
      }
      grid.sync();
      stage_normmod(XAb, H, p.in[I_N2G] + l * DM, mod_lat, mod_ctx, 3 * 1024, 4 * 1024, nrows, smem);
      grid.sync();
      {
        GemmArgs g{}; g.A = H; g.lda = DM; g.B = p.in[I_PWQ] + (size_t)l * DM * 2048; g.ldb = 2048; g.C = PQ; g.ldc = 2048;
        g.M = nrows; g.N = 2048; g.K = DM; g.epi = 0; g.alpha = 1.f;
        gemm_f32(g, smem);
      }
      grid.sync();
      for (int half = 0; half < 2; ++half) {
        GemmArgs g{}; g.A = PQ + half * 128; g.lda = 256; g.B = ws + WS_SKT + ((size_t)l * 2 + half) * 16384; g.ldb = 128;
        g.C = SC + half * 128; g.ldc = 256; g.M = nrows * 8; g.N = 128; g.K = 128; g.epi = 0; g.alpha = 1.f;
        gemm_f32(g, smem);
      }
      grid.sync();
      stage_topk(SC, EI, EG, nrows);
      grid.sync();
      stage_expert(p, l, H, EI, EG, XAb, mod_lat, mod_ctx, nrows, smem);
      grid.sync();
    }
  }
  stage_final(p, smem);
}

extern "C" void kernel_launch(void* const* d_in, const int* in_sizes, int n_in, void* d_out,
                              int out_size, void* d_ws, size_t ws_size, hipStream_t stream) {
  static int grid_blocks = 0;
  if (!grid_blocks) {
    int dev = 0, cus = 0, per_cu = 0;
    (void)hipGetDevice(&dev);
    (void)hipDeviceGetAttribute(&cus, hipDeviceAttributeMultiprocessorCount, dev);
    (void)hipOccupancyMaxActiveBlocksPerMultiprocessor(&per_cu, mega, 256, 0);
    if (per_cu > 1) per_cu = 1;
    grid_blocks = cus * per_cu;
  }
  if (ws_size < WS_END * sizeof(float)) {
    fprintf(stderr, "workspace too small: %zu < %zu\n", ws_size, (size_t)(WS_END * sizeof(float)));
    return;
  }
  Params p{};
  for (int i = 0; i < N_IN; ++i) p.in[i] = (const float*)d_in[i];
  p.out = (float*)d_out;
  p.ws = (float*)d_ws;
  void* args[] = {&p};
  hipError_t e = hipLaunchCooperativeKernel((void*)mega, dim3(grid_blocks), dim3(256), args, 0, stream);
  if (e != hipSuccess) fprintf(stderr, "cooperative launch failed: %s (grid %d)\n", hipGetErrorString(e), grid_blocks);
}
```

```cpp
#include <hip/hip_runtime.h>
#include <hip/hip_cooperative_groups.h>
#include <cstdio>
#include <cstdint>
namespace cg = cooperative_groups;

#define NLAT 4096
#define NCTX 256
#define NTOK 4352
#define DM 1024
#define INW 6672
#define NB 8
#define EPSF 1e-6f

enum { I_X = 0, I_C, I_CTX, I_CCTX, I_WMOD, I_BMOD, I_N1G, I_N2G, I_WIN, I_LQ1, I_LK1, I_LQ2, I_LK2, I_SUBG,
       I_CONVW, I_CONVB, I_MLWQ, I_MLWK, I_GATEB, I_MLNG, I_S5LRE, I_S5LIM, I_S5DT, I_S5BRE, I_S5BIM,
       I_S5CRE, I_S5CIM, I_S5D, I_GLUW, I_GLUB, I_WBR, I_WOUT, I_PWQ, I_PSUBK, I_PU, I_PV, I_FG, N_IN };

struct Params {
  const float* in[N_IN];
  float* out;
  float* ws;
};

#define WS_XA   ((size_t)0)
#define WS_MOD  (WS_XA + (size_t)NB * NTOK * DM)
#define WS_SKT  (WS_MOD + (size_t)2 * 9 * 6144)
#define WS_H    (WS_SKT + (size_t)2 * 2 * 128 * 128)
#define WS_Z    (WS_H + (size_t)NTOK * DM)
#define WS_XC   (WS_Z + (size_t)NTOK * INW)
#define WS_QM   (WS_XC + (size_t)NTOK * 512)
#define WS_KM   (WS_QM + (size_t)NTOK * 512)
#define WS_HF   (WS_KM + (size_t)NTOK * 512)
#define WS_HB   (WS_HF + (size_t)NTOK * 512)
#define WS_OA   (WS_HB + (size_t)NTOK * 512)
#define WS_YA   (WS_OA + (size_t)2 * NTOK * 512)
#define WS_YB   (WS_YA + (size_t)NTOK * 512)
#define WS_YS   (WS_YB + (size_t)NTOK * 512)
#define WS_YSF  (WS_YS + (size_t)NTOK * 512)
#define WS_YSB  (WS_YSF + (size_t)NTOK * 512)
#define WS_GG   (WS_YSB + (size_t)NTOK * 512)
#define WS_GT   (WS_GG + (size_t)NTOK * 512)
#define WS_MG   (WS_GT + (size_t)NTOK * 512)
#define WS_WT   (WS_MG + (size_t)NTOK * DM)
#define WT_WIN   ((size_t)0)
#define WT_WQK   (WT_WIN + (size_t)6784 * 1024)
#define WT_GLU   (WT_WQK + (size_t)4 * 256 * 128)
#define WT_WBR   (WT_GLU + (size_t)512 * 512)
#define WT_WOUT  (WT_WBR + (size_t)3 * 1024 * 512)
#define WT_WQ    (WT_WOUT + (size_t)1024 * 1024)
#define WT_SUBK  (WT_WQ + (size_t)2048 * 1024)
#define WT_LAYER (WT_SUBK + (size_t)2 * 128 * 128)
#define WS_END  (WS_WT + (WT_LAYER * 2 + 1) / 2)
#define WS_PQ   (WS_Z)
#define WS_SC   (WS_PQ + (size_t)NTOK * 2048)
#define WS_EI   (WS_SC + (size_t)NTOK * 2048)
#define WS_EG   (WS_EI + (size_t)NTOK * 128)

#define SMEM_FLOATS (24 * 1024)

__device__ __forceinline__ float sigmoidf_(float x) { return 1.0f / (1.0f + expf(-x)); }
__device__ __forceinline__ float siluf_(float x) { return x / (1.0f + expf(-x)); }
__device__ __forceinline__ float geluf_(float x) { return 0.5f * x * (1.0f + erff(x * 0.70710678118654752f)); }
__device__ __forceinline__ int otid() { int t = threadIdx.x; asm volatile("" : "+v"(t)); return t; }
__device__ __forceinline__ float wave_sum(float v) {
  for (int o = 32; o > 0; o >>= 1) v += __shfl_xor(v, o);
  return v;
}


typedef unsigned short bf16_t;
typedef short bf16x8 __attribute__((ext_vector_type(8)));
typedef float f32x16 __attribute__((ext_vector_type(16)));
typedef unsigned u32x4 __attribute__((ext_vector_type(4)));
__device__ __forceinline__ bf16_t f2bf(float x) { unsigned u = __float_as_uint(x); u += 0x7fffu + ((u >> 16) & 1u); return (bf16_t)(u >> 16); }
__device__ __forceinline__ float bf2f(bf16_t h) { return __uint_as_float(((unsigned)h) << 16); }
__device__ __forceinline__ unsigned pack2(float a, float b) { return (unsigned)f2bf(a) | ((unsigned)f2bf(b) << 16); }

__device__ __forceinline__ void gemm_tile(const bf16_t* __restrict__ Ag, int lda, const bf16_t* __restrict__ Bg, int ldb, int K,
                                          char* smem, f32x16 (&acc)[2][2]) {
  const int tid = otid(), lane = tid & 63, w = tid >> 6, wm = w >> 1, wn = w & 1;
#pragma unroll
  for (int a = 0; a < 2; ++a)
#pragma unroll
    for (int b = 0; b < 2; ++b)
#pragma unroll
      for (int i = 0; i < 16; ++i) acc[a][b][i] = 0.f;
  const int srow = tid >> 3, sch = tid & 7;
  const bf16_t* ap = Ag + (size_t)srow * lda + sch * 8;
  const bf16_t* bp = Bg + (size_t)srow * ldb + sch * 8;
  const int wofs = srow * 128 + ((sch ^ ((srow >> 1) & 7)) << 4);
  const int fr = lane & 31, fh = lane >> 5, fsw = (fr >> 1) & 7;
  const int aofs = (wm * 64 + fr) * 128, bofs = 16384 + (wn * 64 + fr) * 128;
  u32x4 ra[4], rb[4];
  const int nk = K >> 6;
#pragma unroll
  for (int i = 0; i < 4; ++i) {
    ra[i] = *(const u32x4*)(ap + (size_t)i * 32 * lda);
    rb[i] = *(const u32x4*)(bp + (size_t)i * 32 * ldb);
  }
  __syncthreads();
#pragma unroll
  for (int i = 0; i < 4; ++i) {
    *(u32x4*)(smem + wofs + i * 4096) = ra[i];
    *(u32x4*)(smem + 16384 + wofs + i * 4096) = rb[i];
  }
  __syncthreads();
  for (int kt = 0; kt < nk; ++kt) {
    const bool more = (kt + 1 < nk);
    if (more) {
#pragma unroll
      for (int i = 0; i < 4; ++i) {
        ra[i] = *(const u32x4*)(ap + (size_t)i * 32 * lda + (kt + 1) * 64);
        rb[i] = *(const u32x4*)(bp + (size_t)i * 32 * ldb + (kt + 1) * 64);
      }
    }
    const char* base = smem + (kt & 1) * 32768;
#pragma unroll
    for (int ks = 0; ks < 4; ++ks) {
      const int coff = ((ks * 2 + fh) ^ fsw) << 4;
      bf16x8 af[2], bfr[2];
#pragma unroll
      for (int mi = 0; mi < 2; ++mi) af[mi] = *(const bf16x8*)(base + aofs + mi * 4096 + coff);
#pragma unroll
      for (int ni = 0; ni < 2; ++ni) bfr[ni] = *(const bf16x8*)(base + bofs + ni * 4096 + coff);
#pragma unroll
      for (int mi = 0; mi < 2; ++mi)
#pragma unroll
        for (int ni = 0; ni < 2; ++ni)
          acc[mi][ni] = __builtin_amdgcn_mfma_f32_32x32x16_bf16(bfr[ni], af[mi], acc[mi][ni], 0, 0, 0);
    }
    if (more) {
      char* nb = smem + ((kt + 1) & 1) * 32768;
#pragma unroll
      for (int i = 0; i < 4; ++i) {
        *(u32x4*)(nb + wofs + i * 4096) = ra[i];
        *(u32x4*)(nb + 16384 + wofs + i * 4096) = rb[i];
      }
    }
    __syncthreads();
  }
}

template <class F>
__device__ __forceinline__ void transpose_cvt(const float* __restrict__ src, int ld, F srccol, int K, int Ndst, bf16_t* __restrict__ dst, float* smem) {
  float (*T)[65] = (float (*)[65])smem;
  const int tid = otid();
  const int tk = K >> 6, tn = Ndst >> 6;
  for (int t = blockIdx.x; t < tn * tk; t += gridDim.x) {
    const int n0 = (t / tk) * 64, k0 = (t % tk) * 64;
    __syncthreads();
    const int sc = srccol(n0 + (tid & 63));
#pragma unroll
    for (int i = 0; i < 16; ++i) {
      const int ky = (tid >> 6) + 4 * i;
      T[ky][tid & 63] = (sc >= 0) ? src[(size_t)(k0 + ky) * ld + sc] : 0.f;
    }
    __syncthreads();
#pragma unroll
    for (int i = 0; i < 16; ++i) {
      const int ny = (tid >> 6) + 4 * i;
      dst[(size_t)(n0 + ny) * K + k0 + (tid & 63)] = f2bf(T[tid & 63][ny]);
    }
  }
  __syncthreads();
}
__device__ __forceinline__ int win_srccol(int n) {
  if (n < 3072) return n;
  if (n < 6656) return n + 16;
  if (n < 6672) return n - 3584;
  return -1;
}
__device__ __forceinline__ void stage_prep_weights(const Params& p, float* smem) {
  bf16_t* WT = (bf16_t*)(p.ws + WS_WT);
  for (int l = 0; l < 2; ++l) {
    bf16_t* W = WT + (size_t)l * WT_LAYER;
    transpose_cvt(p.in[I_WIN] + (size_t)l * DM * INW, INW, [](int n) { return win_srccol(n); }, DM, 6784, W + WT_WIN, smem);
    for (int h = 0; h < 4; ++h) {
      transpose_cvt(p.in[I_MLWQ] + ((size_t)l * 4 + h) * 16384, 128, [](int n) { return n; }, 128, 128, W + WT_WQK + (size_t)h * 256 * 128, smem);
      transpose_cvt(p.in[I_MLWK] + ((size_t)l * 4 + h) * 16384, 128, [](int n) { return n; }, 128, 128, W + WT_WQK + (size_t)h * 256 * 128 + 128 * 128, smem);
    }
    transpose_cvt(p.in[I_GLUW] + (size_t)l * 512 * 512, 512, [](int n) { return n; }, 512, 512, W + WT_GLU, smem);
    for (int r = 0; r < 3; ++r)
      transpose_cvt(p.in[I_WBR] + ((size_t)l * 3 + r) * 512 * DM, DM, [](int n) { return n; }, 512, DM, W + WT_WBR + (size_t)r * 1024 * 512, smem);
    transpose_cvt(p.in[I_WOUT] + (size_t)l * DM * DM, DM, [](int n) { return n; }, DM, DM, W + WT_WOUT, smem);
    transpose_cvt(p.in[I_PWQ] + (size_t)l * DM * 2048, 2048, [](int n) { return n; }, DM, 2048, W + WT_WQ, smem);
    const float* sk = p.in[I_PSUBK] + (size_t)l * 2 * 128 * 128;
    for (int i = blockIdx.x * 256 + threadIdx.x; i < 2 * 128 * 128; i += gridDim.x * 256) W[WT_SUBK + i] = f2bf(sk[i]);
  }
}

struct GemmArgs {
  const float* A; const float* B; float* C; const float* E; const float* E2;
  int lda, ldb, ldc, lde, M, N, K, epi;
  float alpha;
};
__device__ __forceinline__ void gemm_f32(const GemmArgs& g, float* smem) {
  float (*As)[68] = (float (*)[68])smem;
  float (*Bs)[68] = (float (*)[68])(smem + 16 * 68);
  const int tid = otid();
  const int tx = tid & 15, ty = tid >> 4;
  const int tm = (g.M + 63) >> 6, tn = (g.N + 63) >> 6;
  const int ntiles = tm * tn;
  for (int t = blockIdx.x; t < ntiles; t += gridDim.x) {
    const int m0 = (t / tn) * 64, n0 = (t % tn) * 64;
    float acc[4][4];
#pragma unroll
    for (int i = 0; i < 4; ++i)
#pragma unroll
      for (int j = 0; j < 4; ++j) acc[i][j] = 0.f;
    const int ar = m0 + (tid >> 2), ac = (tid & 3) * 4;
    const int br = tid >> 4, bc = n0 + (tid & 15) * 4;
    for (int k0 = 0; k0 < g.K; k0 += 16) {
      float4 a4 = make_float4(0.f, 0.f, 0.f, 0.f), b4 = make_float4(0.f, 0.f, 0.f, 0.f);
      if (ar < g.M) a4 = *(const float4*)(g.A + (size_t)ar * g.lda + k0 + ac);
      if (bc < g.N) b4 = *(const float4*)(g.B + (size_t)(k0 + br) * g.ldb + bc);
      __syncthreads();
      As[ac + 0][tid >> 2] = a4.x; As[ac + 1][tid >> 2] = a4.y; As[ac + 2][tid >> 2] = a4.z; As[ac + 3][tid >> 2] = a4.w;
      *(float4*)&Bs[br][(tid & 15) * 4] = b4;
      __syncthreads();
#pragma unroll
      for (int kk = 0; kk < 16; ++kk) {
        float4 av = *(const float4*)&As[kk][ty * 4];
        float4 bv = *(const float4*)&Bs[kk][tx * 4];
        float a[4] = {av.x, av.y, av.z, av.w}, b[4] = {bv.x, bv.y, bv.z, bv.w};
#pragma unroll
        for (int i = 0; i < 4; ++i)
#pragma unroll
          for (int j = 0; j < 4; ++j) acc[i][j] = fmaf(a[i], b[j], acc[i][j]);
      }
    }
    const int n = n0 + tx * 4;
    if (n < g.N) {
#pragma unroll
      for (int i = 0; i < 4; ++i) {
        const int m = m0 + ty * 4 + i;
        if (m < g.M) {
          float4* cp = (float4*)(g.C + (size_t)m * g.ldc + n);
          float4 r;
          if (g.epi == 0) {
            r = make_float4(g.alpha * acc[i][0], g.alpha * acc[i][1], g.alpha * acc[i][2], g.alpha * acc[i][3]);
          } else if (g.epi == 1 || g.epi == 2) {
            float4 e = *(const float4*)(g.E + (size_t)m * g.lde + n);
            r = make_float4(sigmoidf_(e.x) * acc[i][0], sigmoidf_(e.y) * acc[i][1], sigmoidf_(e.z) * acc[i][2], sigmoidf_(e.w) * acc[i][3]);
            if (g.epi == 2) { float4 c = *cp; r.x += c.x; r.y += c.y; r.z += c.z; r.w += c.w; }
          } else {
            float4 e = *(const float4*)((m < NLAT ? g.E : g.E2) + n);
            float4 c = *cp;
            r = make_float4(c.x + e.x * acc[i][0], c.y + e.y * acc[i][1], c.z + e.z * acc[i][2], c.w + e.w * acc[i][3]);
          }
          *cp = r;
        }
      }
    }
  }
  __syncthreads();
}

__device__ __forceinline__ void stage_init(const Params& p, float* smem) {
  const int tid = otid();
  float* XA = p.ws + WS_XA;
  {
    const size_t n4 = (size_t)NB * NTOK * 256;
    for (size_t i = (size_t)blockIdx.x * 256 + tid; i < n4; i += (size_t)gridDim.x * 256) {
      size_t row = i >> 8; int c4 = (int)(i & 255);
      int b = (int)(row / NTOK), r = (int)(row % NTOK);
      const float* src = (r < NLAT) ? p.in[I_X] + ((size_t)b * NLAT + r) * DM : p.in[I_CTX] + ((size_t)b * NCTX + (r - NLAT)) * DM;
      ((float4*)XA)[i] = ((const float4*)src)[c4];
    }
  }
  {
    float* skt = p.ws + WS_SKT;
    const float* sk = p.in[I_PSUBK];
    for (int i = blockIdx.x * 256 + tid; i < 2 * 2 * 128 * 128; i += gridDim.x * 256) {
      int lh = i >> 14, c = (i >> 7) & 127, k = i & 127;
      skt[i] = sk[(size_t)lh * 16384 + k * 128 + c];
    }
  }
  {
    float* sc = smem;
    for (int i = tid; i < 9 * 1024; i += 256) {
      int r = i >> 10, k = i & 1023;
      float v = (r < 8) ? p.in[I_C][r * 1024 + k] : p.in[I_CCTX][k];
      sc[i] = siluf_(v);
    }
    __syncthreads();
    float* mod = p.ws + WS_MOD;
    for (int col = blockIdx.x * 256 + tid; col < 2 * 6144; col += gridDim.x * 256) {
      int l = col / 6144, j = col % 6144;
      const float* w = p.in[I_WMOD] + (size_t)l * 1024 * 6144 + j;
      float acc[9];
#pragma unroll
      for (int r = 0; r < 9; ++r) acc[r] = 0.f;
      for (int k = 0; k < 1024; ++k) {
        float wv = w[(size_t)k * 6144];
#pragma unroll
        for (int r = 0; r < 9; ++r) acc[r] = fmaf(sc[r * 1024 + k], wv, acc[r]);
      }
      float bv = p.in[I_BMOD][l * 6144 + j];
#pragma unroll
      for (int r = 0; r < 9; ++r) mod[((size_t)l * 9 + r) * 6144 + j] = acc[r] + bv;
    }
    __syncthreads();
  }
}

__device__ __forceinline__ void stage_normmod(const float* X, bf16_t* H, const float* ng, const float* mod_lat, const float* mod_ctx,
                              int off_sh, int off_sc, int nrows, float* smem) {
  const int tid = otid();
  for (int r = blockIdx.x; r < nrows; r += gridDim.x) {
    float4 v = ((const float4*)(X + (size_t)r * DM))[tid];
    float s = wave_sum(v.x * v.x + v.y * v.y + v.z * v.z + v.w * v.w);
    __syncthreads();
    if ((tid & 63) == 0) smem[tid >> 6] = s;
    __syncthreads();
    float tot = smem[0] + smem[1] + smem[2] + smem[3];
    float rs = rsqrtf(tot * (1.0f / DM) + EPSF);
    const float* mod = (r < NLAT) ? mod_lat : mod_ctx;
    float4 g = ((const float4*)ng)[tid];
    float4 sc = ((const float4*)(mod + off_sc))[tid];
    float4 sh = ((const float4*)(mod + off_sh))[tid];
    float4 o;
    o.x = v.x * rs * g.x * (1.f + sc.x) + sh.x;
    o.y = v.y * rs * g.y * (1.f + sc.y) + sh.y;
    o.z = v.z * rs * g.z * (1.f + sc.z) + sh.z;
    o.w = v.w * rs * g.w * (1.f + sc.w) + sh.w;
    ((uint2*)(H + (size_t)r * DM))[tid] = make_uint2(pack2(o.x, o.y), pack2(o.z, o.w));
  }
  __syncthreads();
}

__device__ __forceinline__ void stage_rope_conv(const Params& p, int l, float* Z, bf16_t* XC) {
  const int tid = otid();
  for (int r = blockIdx.x; r < NTOK; r += gridDim.x) {
    float* z = Z + (size_t)r * INW;
    if (r < NLAT) {
      const float prow = (float)(r >> 6), pcol = (float)(r & 63);
      for (int i = tid; i < 512; i += 256) {
        int which = i >> 8;
        int hm = (i >> 5) & 7;
        int j = i & 31;
        float inv = powf(10000.0f, -(float)(j & 15) / 16.0f);
        float ang = ((j < 16) ? prow : pcol) * inv;
        float cs = cosf(ang), sn = sinf(ang);
        float* base = z + which * 512 + hm * 64;
        float x1 = base[j], x2 = base[32 + j];
        base[j] = x1 * cs - x2 * sn;
        base[32 + j] = x1 * sn + x2 * cs;
      }
    }
    const bool has_prev = (r < NLAT) ? (r > 0) : (r > NLAT);
    const bool has_next = (r < NLAT) ? (r < NLAT - 1) : (r < NTOK - 1);
    const float* cw = p.in[I_CONVW] + (size_t)l * 3 * 512;
    const float* cb = p.in[I_CONVB] + (size_t)l * 512;
    for (int c = tid; c < 512; c += 256) {
      float a = cb[c] + cw[512 + c] * z[1536 + c];
      if (has_prev) a += cw[c] * (z - INW)[1536 + c];
      if (has_next) a += cw[1024 + c] * (z + INW)[1536 + c];
      XC[(size_t)r * 512 + c] = f2bf(siluf_(a));
    }
  }
}

__device__ __forceinline__ void attn_item(const float* Z, float* OA, int h, int qrow0, int key0, int nkeys, float* smem) {
  const int tid = otid();
  const int m = (tid >> 6) & 1, eh = tid >> 7;
  const int row = qrow0 + (tid & 63);
  float (*Ks)[128] = (float (*)[128])smem;
  float (*Vs)[128] = (float (*)[128])(smem + 32 * 128);
  float q[64];
  {
    const float4* qp = (const float4*)(Z + (size_t)row * INW + h * 128 + m * 64);
#pragma unroll
    for (int i = 0; i < 16; ++i) { float4 t = qp[i]; q[4 * i] = t.x * 0.125f; q[4 * i + 1] = t.y * 0.125f; q[4 * i + 2] = t.z * 0.125f; q[4 * i + 3] = t.w * 0.125f; }
  }
  float o[64];
#pragma unroll
  for (int i = 0; i < 64; ++i) o[i] = 0.f;
  float mrun = -1e30f, lrun = 0.f;
  for (int kt = 0; kt < nkeys; kt += 32) {
    __syncthreads();
#pragma unroll
    for (int i = 0; i < 4; ++i) {
      int idx = tid + i * 256;
      int key = idx >> 5, c4 = idx & 31;
      const float* zr = Z + (size_t)(key0 + kt + key) * INW;
      ((float4*)&Ks[key][0])[c4] = ((const float4*)(zr + 512 + h * 128))[c4];
      ((float4*)&Vs[key][0])[c4] = ((const float4*)(zr + 1024 + h * 128))[c4];
    }
    __syncthreads();
#pragma unroll 1
    for (int sub = 0; sub < 32; sub += 16) {
      float s[16];
      float smax = -1e30f;
#pragma unroll
      for (int jj = 0; jj < 16; ++jj) {
        const float4* kp = (const float4*)&Ks[sub + jj][m * 64];
        float a = 0.f;
#pragma unroll
        for (int d4 = 0; d4 < 16; ++d4) {
          float4 kv = kp[d4];
          a = fmaf(q[4 * d4], kv.x, a); a = fmaf(q[4 * d4 + 1], kv.y, a); a = fmaf(q[4 * d4 + 2], kv.z, a); a = fmaf(q[4 * d4 + 3], kv.w, a);
        }
        s[jj] = a;
        smax = fmaxf(smax, a);
      }
      float mnew = fmaxf(mrun, smax);
      float scale = expf(mrun - mnew);
      mrun = mnew;
      lrun *= scale;
#pragma unroll
      for (int i = 0; i < 64; ++i) o[i] *= scale;
#pragma unroll
      for (int jj = 0; jj < 16; ++jj) {
        float pj = expf(s[jj] - mnew);
        lrun += pj;
        const float4* vp = (const float4*)&Vs[sub + jj][eh * 64];
#pragma unroll
        for (int e4 = 0; e4 < 16; ++e4) {
          float4 vv = vp[e4];
          o[4 * e4] = fmaf(pj, vv.x, o[4 * e4]); o[4 * e4 + 1] = fmaf(pj, vv.y, o[4 * e4 + 1]);
          o[4 * e4 + 2] = fmaf(pj, vv.z, o[4 * e4 + 2]); o[4 * e4 + 3] = fmaf(pj, vv.w, o[4 * e4 + 3]);
        }
      }
    }
  }
  const float il = 1.0f / lrun;
  float4* op = (float4*)(OA + ((size_t)m * NTOK + row) * 512 + h * 128 + eh * 64);
#pragma unroll
  for (int e4 = 0; e4 < 16; ++e4) op[e4] = make_float4(o[4 * e4] * il, o[4 * e4 + 1] * il, o[4 * e4 + 2] * il, o[4 * e4 + 3] * il);
  __syncthreads();
}

__device__ __forceinline__ void mlstm_item(const Params& p, int l, const float* Z, const float* QM, const float* KM, float* HX,
                           int h, int dir, float* smem) {
  const int tid = otid();
  const int e = tid >> 1, hf = tid & 1;
  float* qs = smem;
  float* ks = smem + 16 * 128;
  float* vs = smem + 2 * 16 * 128;
  float* gi = smem + 3 * 16 * 128;
  float* gf = gi + 16;
  int* rows = (int*)(gf + 16);
  const float bi = p.in[I_GATEB][l * 16 + dir * 8 + h];
  const float bf = p.in[I_GATEB][l * 16 + dir * 8 + 4 + h];
  float C[64], nn[64];
#pragma unroll
  for (int j = 0; j < 64; ++j) { C[j] = 0.f; nn[j] = 0.f; }
  for (int s0 = 0; s0 < NTOK; s0 += 16) {
    __syncthreads();
#pragma unroll
    for (int i = 0; i < 2; ++i) {
      int idx = tid + i * 256;
      int st = idx >> 5, c4 = idx & 31;
      int step = s0 + st;
      int row = (dir == 0) ? ((step < NCTX) ? NLAT + step : step - NCTX)
                           : ((step < NCTX) ? NLAT + (NCTX - 1 - step) : (NLAT - 1) - (step - NCTX));
      ((float4*)(qs + st * 128))[c4] = ((const float4*)(QM + (size_t)row * 512 + h * 128))[c4];
      ((float4*)(ks + st * 128))[c4] = ((const float4*)(KM + (size_t)row * 512 + h * 128))[c4];
      ((float4*)(vs + st * 128))[c4] = ((const float4*)(Z + (size_t)row * INW + 2048 + h * 128))[c4];
      if (c4 == 0) {
        float a = Z[(size_t)row * INW + 3072 + dir * 8 + h] + bi;
        float f = Z[(size_t)row * INW + 3072 + dir * 8 + 4 + h] + bf;
        gi[st] = expf(a);
        gf[st] = sigmoidf_(f);
        rows[st] = row;
      }
    }
    __syncthreads();
#pragma unroll 1
    for (int st = 0; st < 16; ++st) {
      const float ig = gi[st], fg = gf[st];
      const float iv = ig * vs[st * 128 + e];
      const float4* kp = (const float4*)(ks + st * 128 + hf * 64);
      const float4* qp = (const float4*)(qs + st * 128 + hf * 64);
      float hp = 0.f, dp = 0.f;
#pragma unroll
      for (int j4 = 0; j4 < 16; ++j4) {
        float4 kv = kp[j4], qv = qp[j4];
        float kk[4] = {kv.x, kv.y, kv.z, kv.w}, qq[4] = {qv.x, qv.y, qv.z, qv.w};
#pragma unroll
        for (int u = 0; u < 4; ++u) {
          int j = j4 * 4 + u;
          C[j] = fmaf(fg, C[j], iv * kk[u]);
          nn[j] = fmaf(fg, nn[j], ig * kk[u]);
          hp = fmaf(C[j], qq[u], hp);
          dp = fmaf(nn[j], qq[u], dp);
        }
      }
      hp += __shfl_xor(hp, 1);
      dp += __shfl_xor(dp, 1);
      if (hf == 0) HX[(size_t)rows[st] * 512 + h * 128 + e] = hp / fmaxf(fabsf(dp), 1.0f);
    }
  }
  __syncthreads();
}

__device__ __forceinline__ void s5_item(const Params& p, int l, const float* Z, float* YSF, float* YSB, int g, float* smem) {
  const int tid = otid();
  const int w = tid >> 6, lane = tid & 63;
  const bool active = w < 2;
  const int dir = w & 1;
  float* base = smem + (w & 1) * 11392;
  float* us = base;
  float* xre = base + 1024;
  float* xim = xre + 64 * 65;
  float* cre = xim + 64 * 65;
  float* cim = cre + 1024;
  const int pg = ((l * 2 + dir) * 32 + g);
  const int n = lane;
  const float lre = p.in[I_S5LRE][pg * 64 + n], lim = p.in[I_S5LIM][pg * 64 + n];
  const float dt = expf(p.in[I_S5DT][pg]);
  const float mag = expf(lre * dt);
  const float abr = mag * cosf(lim * dt), abi = mag * sinf(lim * dt);
  const float den = lre * lre + lim * lim;
  const float zr = ((abr - 1.0f) * lre + abi * lim) / den;
  const float zi = (abi * lre - (abr - 1.0f) * lim) / den;
  float bbr[16], bbi[16];
  {
    const float* br = p.in[I_S5BRE] + ((size_t)pg * 64 + n) * 16;
    const float* bi = p.in[I_S5BIM] + ((size_t)pg * 64 + n) * 16;
#pragma unroll
    for (int q = 0; q < 16; ++q) { float a = br[q], b = bi[q]; bbr[q] = zr * a - zi * b; bbi[q] = zr * b + zi * a; }
  }
  __syncthreads();
  if (active) {
    const float* cr = p.in[I_S5CRE] + (size_t)pg * 16 * 64;
    const float* ci = p.in[I_S5CIM] + (size_t)pg * 16 * 64;
#pragma unroll
    for (int q = 0; q < 16; ++q) { cre[n * 16 + q] = cr[q * 64 + n]; cim[n * 16 + q] = ci[q * 64 + n]; }
  }
  float xr = 0.f, xi = 0.f;
  float* Y = dir ? YSB : YSF;
  for (int s0 = 0; s0 < NTOK; s0 += 64) {
    const int step = s0 + lane;
    const int row = (dir == 0) ? ((step < NCTX) ? NLAT + step : step - NCTX)
                               : ((step < NCTX) ? NLAT + (NCTX - 1 - step) : (NLAT - 1) - (step - NCTX));
    if (active) {
      const float4* up = (const float4*)(Z + (size_t)row * INW + 3088 + g * 16);
#pragma unroll
      for (int q = 0; q < 4; ++q) ((float4*)(us + lane * 16))[q] = up[q];
    }
    __syncthreads();
    if (active) {
#pragma unroll 4
      for (int t = 0; t < 64; ++t) {
        const float4* up = (const float4*)(us + t * 16);
        float br_ = 0.f, bi_ = 0.f;
#pragma unroll
        for (int q4 = 0; q4 < 4; ++q4) {
          float4 uv = up[q4];
          br_ = fmaf(uv.x, bbr[4 * q4], br_); br_ = fmaf(uv.y, bbr[4 * q4 + 1], br_); br_ = fmaf(uv.z, bbr[4 * q4 + 2], br_); br_ = fmaf(uv.w, bbr[4 * q4 + 3], br_);
          bi_ = fmaf(uv.x, bbi[4 * q4], bi_); bi_ = fmaf(uv.y, bbi[4 * q4 + 1], bi_); bi_ = fmaf(uv.z, bbi[4 * q4 + 2], bi_); bi_ = fmaf(uv.w, bbi[4 * q4 + 3], bi_);
        }
        float nr = abr * xr - abi * xi + br_;
        float ni = abr * xi + abi * xr + bi_;
        xr = nr; xi = ni;
        xre[t * 65 + n] = xr;
        xim[t * 65 + n] = xi;
      }
    }
    __syncthreads();
    if (active) {
      float y[16];
#pragma unroll
      for (int q = 0; q < 16; ++q) y[q] = 0.f;
      for (int nn_ = 0; nn_ < 64; ++nn_) {
        const float a = xre[lane * 65 + nn_], b = xim[lane * 65 + nn_];
        const float4* cr4 = (const float4*)(cre + nn_ * 16);
        const float4* ci4 = (const float4*)(cim + nn_ * 16);
#pragma unroll
        for (int q4 = 0; q4 < 4; ++q4) {
          float4 c1 = cr4[q4], c2 = ci4[q4];
          y[4 * q4] += a * c1.x - b * c2.x; y[4 * q4 + 1] += a * c1.y - b * c2.y;
          y[4 * q4 + 2] += a * c1.z - b * c2.z; y[4 * q4 + 3] += a * c1.w - b * c2.w;
        }
      }
      float4* yp = (float4*)(Y + (size_t)row * 512 + g * 16);
#pragma unroll
      for (int q4 = 0; q4 < 4; ++q4) yp[q4] = make_float4(y[4 * q4], y[4 * q4 + 1], y[4 * q4 + 2], y[4 * q4 + 3]);
    }
    __syncthreads();
  }
}

__device__ __forceinline__ void stage_post(const Params& p, int l, const float* Z, const float* OA, const float* HF, const float* HB,
                           const float* YSF, const float* YSB, bf16_t* YA, bf16_t* YB, bf16_t* GG, int nrows, float* smem) {
  const int tid = otid();
  const float lam_init = 0.8f - 0.6f * expf(-0.3f * (float)l);
  float lam;
  {
    float s1 = 0.f, s2 = 0.f;
    for (int i = 0; i < 64; ++i) {
      s1 += p.in[I_LQ1][l * 64 + i] * p.in[I_LK1][l * 64 + i];
      s2 += p.in[I_LQ2][l * 64 + i] * p.in[I_LK2][l * 64 + i];
    }
    lam = expf(s1) - expf(s2) + lam_init;
  }
  const int c0 = tid * 2;
  for (int r = blockIdx.x; r < nrows; r += gridDim.x) {
    {
      float2 a0 = *(const float2*)(OA + (size_t)r * 512 + c0);
      float2 a1 = *(const float2*)(OA + ((size_t)NTOK + r) * 512 + c0);
      float o0 = a0.x - lam * a1.x, o1 = a0.y - lam * a1.y;
      float ss = wave_sum(o0 * o0 + o1 * o1);
      float rs = rsqrtf(ss * (1.0f / 128.0f) + EPSF) * (1.0f - lam_init);
      float2 g = *(const float2*)(p.in[I_SUBG] + l * 512 + c0);
      *(unsigned*)(YA + (size_t)r * 512 + c0) = pack2(o0 * rs * g.x, o1 * rs * g.y);
    }
    {
      float2 a0 = *(const float2*)(HF + (size_t)r * 512 + c0);
      float2 a1 = *(const float2*)(HB + (size_t)r * 512 + c0);
      float h0 = a0.x + a1.x, h1 = a0.y + a1.y;
      float ss = wave_sum(h0 * h0 + h1 * h1);
      float rs = rsqrtf(ss * (1.0f / 128.0f) + EPSF);
      float2 g = *(const float2*)(p.in[I_MLNG] + l * 512 + c0);
      float2 og = *(const float2*)(Z + (size_t)r * INW + 2560 + c0);
      *(unsigned*)(YB + (size_t)r * 512 + c0) = pack2(h0 * rs * g.x * sigmoidf_(og.x), h1 * rs * g.y * sigmoidf_(og.y));
    }
    {
      float2 u = *(const float2*)(Z + (size_t)r * INW + 3088 + c0);
      float2 d = *(const float2*)(p.in[I_S5D] + l * 512 + c0);
      float2 f = *(const float2*)(YSF + (size_t)r * 512 + c0);
      float2 b = *(const float2*)(YSB + (size_t)r * 512 + c0);
      *(unsigned*)(GG + (size_t)r * 512 + c0) = pack2(geluf_(d.x * u.x + f.x + b.x), geluf_(d.y * u.y + f.y + b.y));
    }
  }
}

__device__ __forceinline__ void wave_argmax(float& v, int& idx) {
#pragma unroll
  for (int o = 32; o > 0; o >>= 1) {
    float ov = __shfl_xor(v, o);
    int oi = __shfl_xor(idx, o);
    if (ov > v || (ov == v && oi < idx)) { v = ov; idx = oi; }
  }
}
__device__ __forceinline__ void stage_topk(const float* SC, int* EI, float* EG, int nrows) {
  const int tid = otid(), w = tid >> 6, lane = tid & 63;
  const int nth = nrows * 8;
  for (int th = blockIdx.x * 4 + w; th < nth; th += gridDim.x * 4) {
    const float* s = SC + (size_t)th * 256;
    float myv[2] = {0.f, 0.f};
    int myi[2] = {0, 0};
#pragma unroll
    for (int half = 0; half < 2; ++half) {
      float a0 = s[half * 128 + lane], a1 = s[half * 128 + 64 + lane];
      for (int r = 0; r < 16; ++r) {
        float v; int idx;
        if (a0 >= a1) { v = a0; idx = lane; } else { v = a1; idx = lane + 64; }
        wave_argmax(v, idx);
        if (idx == lane) a0 = -INFINITY;
        if (idx == lane + 64) a1 = -INFINITY;
        if (lane == r) { myv[half] = v; myi[half] = idx; }
      }
    }
    float cv[4];
    const float v1 = __shfl(myv[0], lane >> 2);
#pragma unroll
    for (int q = 0; q < 4; ++q) cv[q] = v1 + __shfl(myv[1], (lane & 3) * 4 + q);
    float tv = 0.f; int tc = 0;
    for (int r = 0; r < 16; ++r) {
      float v = cv[0]; int idx = lane * 4;
#pragma unroll
      for (int q = 1; q < 4; ++q) if (cv[q] > v) { v = cv[q]; idx = lane * 4 + q; }
      wave_argmax(v, idx);
#pragma unroll
      for (int q = 0; q < 4; ++q) if (idx == lane * 4 + q) cv[q] = -INFINITY;
      if (lane == r) { tv = v; tc = idx; }
    }
    const int e1 = __shfl(myi[0], tc >> 4);
    const int e2 = __shfl(myi[1], tc & 15);
    const float vmax = __shfl(tv, 0);
    float ex = (lane < 16) ? expf(tv - vmax) : 0.f;
    float sum = wave_sum(ex);
    if (lane < 16) {
      EI[(size_t)th * 16 + lane] = e1 * 128 + e2;
      EG[(size_t)th * 16 + lane] = ex / sum;
    }
  }
}

__device__ __forceinline__ void stage_expert(const Params& p, int l, const bf16_t* H2, const int* EI, const float* EG, float* XAb,
                             const float* mod_lat, const float* mod_ctx, int nrows, float* smem) {
  const int tid = otid(), w = tid >> 6, lane = tid & 63;
  float* coef = smem;
  int* eid = (int*)(smem + 128);
  const float* U = p.in[I_PU] + (size_t)l * 16384 * 1024;
  const float* V = p.in[I_PV] + (size_t)l * 16384 * 1024;
  for (int t = blockIdx.x; t < nrows; t += gridDim.x) {
    __syncthreads();
    float4 hv[4];
#pragma unroll
    for (int i = 0; i < 4; ++i) { uint2 u2 = ((const uint2*)(H2 + (size_t)t * DM))[i * 64 + lane];
      hv[i] = make_float4(__uint_as_float(u2.x << 16), __uint_as_float(u2.x & 0xffff0000u), __uint_as_float(u2.y << 16), __uint_as_float(u2.y & 0xffff0000u)); }
    for (int k = w * 32; k < w * 32 + 32; ++k) {
      const int e = EI[(size_t)t * 128 + k];
      const float4* up = (const float4*)(U + (size_t)e * 1024);
      float a = 0.f;
#pragma unroll
      for (int i = 0; i < 4; ++i) {
        float4 uv = up[i * 64 + lane];
        a = fmaf(hv[i].x, uv.x, a); a = fmaf(hv[i].y, uv.y, a); a = fmaf(hv[i].z, uv.z, a); a = fmaf(hv[i].w, uv.w, a);
      }
      a = wave_sum(a);
      if (lane == 0) { coef[k] = EG[(size_t)t * 128 + k] * geluf_(a); eid[k] = e; }
    }
    __syncthreads();
    float4 acc = make_float4(0.f, 0.f, 0.f, 0.f);
#pragma unroll 8
    for (int k = 0; k < 128; ++k) {
      const float cf = coef[k];
      float4 vv = ((const float4*)(V + (size_t)eid[k] * 1024))[tid];
      acc.x = fmaf(cf, vv.x, acc.x); acc.y = fmaf(cf, vv.y, acc.y); acc.z = fmaf(cf, vv.z, acc.z); acc.w = fmaf(cf, vv.w, acc.w);
    }
    const float4 g2 = ((const float4*)((t < NLAT ? mod_lat : mod_ctx) + 5 * 1024))[tid];
    float4* xp = (float4*)(XAb + (size_t)t * DM) + tid;
    float4 xv = *xp;
    xv.x += g2.x * acc.x; xv.y += g2.y * acc.y; xv.z += g2.z * acc.z; xv.w += g2.w * acc.w;
    *xp = xv;
  }
  __syncthreads();
}

__device__ __forceinline__ void stage_final(const Params& p, float* smem) {
  const int tid = otid();
  const float* XA = p.ws + WS_XA;
  for (int r = blockIdx.x; r < NB * NLAT; r += gridDim.x) {
    const int b = r / NLAT, rr = r % NLAT;
    float4 v = ((const float4*)(XA + ((size_t)b * NTOK + rr) * DM))[tid];
    float s = wave_sum(v.x * v.x + v.y * v.y + v.z * v.z + v.w * v.w);
    __syncthreads();
    if ((tid & 63) == 0) smem[tid >> 6] = s;
    __syncthreads();
    float rs = rsqrtf((smem[0] + smem[1] + smem[2] + smem[3]) * (1.0f / DM) + EPSF);
    float4 g = ((const float4*)p.in[I_FG])[tid];
    ((float4*)(p.out + (size_t)r * DM))[tid] = make_float4(v.x * rs * g.x, v.y * rs * g.y, v.z * rs * g.z, v.w * rs * g.w);
  }
}


#define EPI_DECL const int tid_ = otid(); const int lane = tid_ & 63, w_ = tid_ >> 6, wm = w_ >> 1, wn = w_ & 1, fr = lane & 31, fh = lane >> 5; (void)fr; (void)fh; (void)wm; (void)wn;
#define EPI_ROW(mi) (wm * 64 + (mi) * 32 + fr)
#define EPI_COL(ni, q) (wn * 64 + (ni) * 32 + 8 * (q) + 4 * fh)

__device__ __forceinline__ void stage_inproj(const bf16_t* H, const bf16_t* WinT, float* Z, int nrows, char* smem) {
  EPI_DECL
  const int tm = nrows >> 7, tn = 53;
  for (int t = blockIdx.x; t < tm * tn; t += gridDim.x) {
    const int m0 = (t / tn) * 128, j = t % tn, n0 = j * 128;
    f32x16 acc[2][2];
    gemm_tile(H + (size_t)m0 * DM, DM, WinT + (size_t)n0 * DM, DM, DM, smem, acc);
    const int obase = (j < 24) ? n0 : (j < 52 ? n0 + 16 : 3072);
#pragma unroll
    for (int mi = 0; mi < 2; ++mi)
#pragma unroll
      for (int ni = 0; ni < 2; ++ni)
#pragma unroll
        for (int q = 0; q < 4; ++q) {
          const int row = m0 + EPI_ROW(mi), c = EPI_COL(ni, q);
          if (j == 52 && c >= 16) continue;
          *(float4*)(Z + (size_t)row * INW + obase + c) = make_float4(acc[mi][ni][4 * q], acc[mi][ni][4 * q + 1], acc[mi][ni][4 * q + 2], acc[mi][ni][4 * q + 3]);
        }
  }
}

__device__ __forceinline__ void stage_mlqk(const bf16_t* XC, const bf16_t* WQK, float* QM, float* KM, int nrows, char* smem) {
  EPI_DECL
  const int tm = nrows >> 7;
  for (int t = blockIdx.x; t < tm * 8; t += gridDim.x) {
    const int m0 = (t >> 3) * 128, h = (t >> 1) & 3, nt = t & 1;
    f32x16 acc[2][2];
    gemm_tile(XC + (size_t)m0 * 512 + h * 128, 512, WQK + (size_t)h * 256 * 128 + (size_t)nt * 128 * 128, 128, 128, smem, acc);
    float* O = nt ? KM : QM;
    const float alpha = nt ? 1.0f : 0.08838834764831845f;
#pragma unroll
    for (int mi = 0; mi < 2; ++mi)
#pragma unroll
      for (int ni = 0; ni < 2; ++ni)
#pragma unroll
        for (int q = 0; q < 4; ++q) {
          const int row = m0 + EPI_ROW(mi), c = EPI_COL(ni, q);
          *(float4*)(O + (size_t)row * 512 + h * 128 + c) = make_float4(alpha * acc[mi][ni][4 * q], alpha * acc[mi][ni][4 * q + 1], alpha * acc[mi][ni][4 * q + 2], alpha * acc[mi][ni][4 * q + 3]);
        }
  }
}

__device__ __forceinline__ void stage_glu_mfma(const Params& p, int l, const bf16_t* GG, const bf16_t* GLUT, bf16_t* YS, int nrows, char* smem) {
  EPI_DECL
  const int tm = nrows >> 7;
  for (int t = blockIdx.x; t < tm * 4; t += gridDim.x) {
    const int m0 = (t >> 2) * 128, n0 = (t & 3) * 128;
    f32x16 acc[2][2];
    gemm_tile(GG + (size_t)m0 * 512, 512, GLUT + (size_t)n0 * 512, 512, 512, smem, acc);
#pragma unroll
    for (int mi = 0; mi < 2; ++mi)
#pragma unroll
      for (int ni = 0; ni < 2; ++ni)
#pragma unroll
        for (int q = 0; q < 4; ++q) {
          const int row = m0 + EPI_ROW(mi), c = n0 + EPI_COL(ni, q);
          const float4 b = *(const float4*)(p.in[I_GLUB] + l * 512 + c);
          const uint2 g2 = *(const uint2*)(GG + (size_t)row * 512 + c);
          const float g0 = __uint_as_float(g2.x << 16), g1 = __uint_as_float(g2.x & 0xffff0000u), g2f = __uint_as_float(g2.y << 16), g3 = __uint_as_float(g2.y & 0xffff0000u);
          const float o0 = g0 * sigmoidf_(acc[mi][ni][4 * q] + b.x), o1 = g1 * sigmoidf_(acc[mi][ni][4 * q + 1] + b.y);
          const float o2 = g2f * sigmoidf_(acc[mi][ni][4 * q + 2] + b.z), o3 = g3 * sigmoidf_(acc[mi][ni][4 * q + 3] + b.w);
          *(uint2*)(YS + (size_t)row * 512 + c) = make_uint2(pack2(o0, o1), pack2(o2, o3));
        }
  }
}

__device__ __forceinline__ void stage_merge_mfma(const bf16_t* YA, const bf16_t* YB, const bf16_t* YS, const bf16_t* WBR, const float* Z, bf16_t* MG, int nrows, char* smem) {
  EPI_DECL
  const int tm = nrows >> 7;
  for (int t = blockIdx.x; t < tm * 8; t += gridDim.x) {
    const int m0 = (t >> 3) * 128, n0 = (t & 7) * 128;
    f32x16 macc[2][2];
#pragma unroll
    for (int a = 0; a < 2; ++a)
#pragma unroll
      for (int b = 0; b < 2; ++b)
#pragma unroll
        for (int i = 0; i < 16; ++i) macc[a][b][i] = 0.f;
#pragma unroll 1
    for (int r = 0; r < 3; ++r) {
      const bf16_t* Y = (r == 0) ? YA : (r == 1 ? YB : YS);
      f32x16 acc[2][2];
      gemm_tile(Y + (size_t)m0 * 512, 512, WBR + (size_t)r * 1024 * 512 + (size_t)n0 * 512, 512, 512, smem, acc);
#pragma unroll
      for (int mi = 0; mi < 2; ++mi)
#pragma unroll
        for (int ni = 0; ni < 2; ++ni)
#pragma unroll
          for (int q = 0; q < 4; ++q) {
            const int row = m0 + EPI_ROW(mi), c = n0 + EPI_COL(ni, q);
            const float4 e = *(const float4*)(Z + (size_t)row * INW + 3600 + r * 1024 + c);
            macc[mi][ni][4 * q] += sigmoidf_(e.x) * acc[mi][ni][4 * q];
            macc[mi][ni][4 * q + 1] += sigmoidf_(e.y) * acc[mi][ni][4 * q + 1];
            macc[mi][ni][4 * q + 2] += sigmoidf_(e.z) * acc[mi][ni][4 * q + 2];
            macc[mi][ni][4 * q + 3] += sigmoidf_(e.w) * acc[mi][ni][4 * q + 3];
          }
    }
#pragma unroll
    for (int mi = 0; mi < 2; ++mi)
#pragma unroll
      for (int ni = 0; ni < 2; ++ni)
#pragma unroll
        for (int q = 0; q < 4; ++q) {
          const int row = m0 + EPI_ROW(mi), c = n0 + EPI_COL(ni, q);
          *(uint2*)(MG + (size_t)row * DM + c) = make_uint2(pack2(macc[mi][ni][4 * q], macc[mi][ni][4 * q + 1]), pack2(macc[mi][ni][4 * q + 2], macc[mi][ni][4 * q + 3]));
        }
  }
}

__device__ __forceinline__ void stage_outproj_mfma(const bf16_t* MG, const bf16_t* WOUT, float* XAb, const float* mod_lat, const float* mod_ctx, int nrows, char* smem) {
  EPI_DECL
  const int tm = nrows >> 7;
  for (int t = blockIdx.x; t < tm * 8; t += gridDim.x) {
    const int m0 = (t >> 3) * 128, n0 = (t & 7) * 128;
    f32x16 acc[2][2];
    gemm_tile(MG + (size_t)m0 * DM, DM, WOUT + (size_t)n0 * DM, DM, DM, smem, acc);
#pragma unroll
    for (int mi = 0; mi < 2; ++mi)
#pragma unroll
      for (int ni = 0; ni < 2; ++ni)
#pragma unroll
        for (int q = 0; q < 4; ++q) {
          const int row = m0 + EPI_ROW(mi), c = n0 + EPI_COL(ni, q);
          const float4 g = *(const float4*)((row < NLAT ? mod_lat : mod_ctx) + 2 * 1024 + c);
          float4* xp = (float4*)(XAb + (size_t)row * DM + c);
          float4 x = *xp;
          x.x += g.x * acc[mi][ni][4 * q]; x.y += g.y * acc[mi][ni][4 * q + 1]; x.z += g.z * acc[mi][ni][4 * q + 2]; x.w += g.w * acc[mi][ni][4 * q + 3];
          *xp = x;
        }
  }
}

__device__ __forceinline__ void stage_peerq_mfma(const bf16_t* H2, const bf16_t* WQ, bf16_t* PQ, int nrows, char* smem) {
  EPI_DECL
  const int tm = nrows >> 7;
  for (int t = blockIdx.x; t < tm * 16; t += gridDim.x) {
    const int m0 = (t >> 4) * 128, n0 = (t & 15) * 128;
    f32x16 acc[2][2];
    gemm_tile(H2 + (size_t)m0 * DM, DM, WQ + (size_t)n0 * DM, DM, DM, smem, acc);
#pragma unroll
    for (int mi = 0; mi < 2; ++mi)
#pragma unroll
      for (int ni = 0; ni < 2; ++ni)
#pragma unroll
        for (int q = 0; q < 4; ++q) {
          const int row = m0 + EPI_ROW(mi), c = n0 + EPI_COL(ni, q);
          *(uint2*)(PQ + (size_t)row * 2048 + c) = make_uint2(pack2(acc[mi][ni][4 * q], acc[mi][ni][4 * q + 1]), pack2(acc[mi][ni][4 * q + 2], acc[mi][ni][4 * q + 3]));
        }
  }
}

__device__ __forceinline__ void stage_scores_mfma(const bf16_t* PQ, const bf16_t* SUBK, float* SC, int nrows, char* smem) {
  EPI_DECL
  const int tm = (nrows * 8) >> 7;
  for (int t = blockIdx.x; t < tm * 2; t += gridDim.x) {
    const int m0 = (t >> 1) * 128, half = t & 1;
    f32x16 acc[2][2];
    gemm_tile(PQ + (size_t)m0 * 256 + half * 128, 256, SUBK + (size_t)half * 16384, 128, 128, smem, acc);
#pragma unroll
    for (int mi = 0; mi < 2; ++mi)
#pragma unroll
      for (int ni = 0; ni < 2; ++ni)
#pragma unroll
        for (int q = 0; q < 4; ++q) {
          const int row = m0 + EPI_ROW(mi), c = EPI_COL(ni, q);
          *(float4*)(SC + (size_t)row * 256 + half * 128 + c) = make_float4(acc[mi][ni][4 * q], acc[mi][ni][4 * q + 1], acc[mi][ni][4 * q + 2], acc[mi][ni][4 * q + 3]);
        }
  }
}

__global__ void __launch_bounds__(256) mega(Params p) {
  cg::grid_group grid = cg::this_grid();
  __shared__ __attribute__((aligned(16))) float smem[SMEM_FLOATS];
  char* smc = (char*)smem;
  float* ws = p.ws;
  bf16_t* H = (bf16_t*)(ws + WS_H); float* Z = ws + WS_Z; bf16_t* XC = (bf16_t*)(ws + WS_XC); float* QM = ws + WS_QM; float* KM = ws + WS_KM;
  float* HF = ws + WS_HF; float* HB = ws + WS_HB; float* OA = ws + WS_OA; bf16_t* YA = (bf16_t*)(ws + WS_YA); bf16_t* YB = (bf16_t*)(ws + WS_YB);
  bf16_t* YS = (bf16_t*)(ws + WS_YS); float* YSF = ws + WS_YSF; float* YSB = ws + WS_YSB; bf16_t* GG = (bf16_t*)(ws + WS_GG);
  bf16_t* MG = (bf16_t*)(ws + WS_MG); bf16_t* PQ = (bf16_t*)(ws + WS_PQ); float* SC = ws + WS_SC; int* EI = (int*)(ws + WS_EI); float* EG = ws + WS_EG;
  const bf16_t* WT = (const bf16_t*)(ws + WS_WT);

  stage_init(p, smem);
  stage_prep_weights(p, smem);
  grid.sync();

  for (int l = 0; l < 2; ++l) {
    const bool need_ctx = (l == 0);
    const int nrows = need_ctx ? NTOK : NLAT;
    const bf16_t* W = WT + (size_t)l * WT_LAYER;
    for (int b = 0; b < NB; ++b) {
      float* XAb = ws + WS_XA + (size_t)b * NTOK * DM;
      const float* mod_lat = ws + WS_MOD + ((size_t)l * 9 + b) * 6144;
      const float* mod_ctx = ws + WS_MOD + ((size_t)l * 9 + 8) * 6144;
      stage_normmod(XAb, H, p.in[I_N1G] + l * DM, mod_lat, mod_ctx, 0, 1024, NTOK, smem);
      grid.sync();
      stage_inproj(H, W + WT_WIN, Z, NTOK, smc);
      grid.sync();
      stage_rope_conv(p, l, Z, XC);
      grid.sync();
      stage_mlqk(XC, W + WT_WQK, QM, KM, NTOK, smc);
      grid.sync();
      {
        const int n_attn_lat = 4 * 64, n_attn_ctx = need_ctx ? 4 * 4 : 0;
        const int n_items = 8 + 32 + n_attn_lat + n_attn_ctx;
        for (int it = blockIdx.x; it < n_items; it += gridDim.x) {
          if (it < 8) {
            mlstm_item(p, l, Z, QM, KM, (it >> 2) ? HB : HF, it & 3, it >> 2, smem);
          } else if (it < 40) {
            s5_item(p, l, Z, YSF, YSB, it - 8, smem);
          } else if (it < 40 + n_attn_lat) {
            const int a = it - 40;
            attn_item(Z, OA, a & 3, (a >> 2) * 64, 0, NTOK, smem);
          } else {
            const int a = it - 40 - n_attn_lat;
            attn_item(Z, OA, a & 3, NLAT + (a >> 2) * 64, NLAT, NCTX, smem);
          }
        }
      }
      grid.sync();
      stage_post(p, l, Z, OA, HF, HB, YSF, YSB, YA, YB, GG, nrows, smem);
      grid.sync();
      stage_glu_mfma(p, l, GG, W + WT_GLU, YS, nrows, smc);
      grid.sync();
      stage_merge_mfma(YA, YB, YS, W + WT_WBR, Z, MG, nrows, smc);
      grid.sync();
      stage_outproj_mfma(MG, W + WT_WOUT, XAb, mod_lat, mod_ctx, nrows, smc);
      grid.sync();
      stage_normmod(XAb, H, p.in[I_N2G] + l * DM, mod_lat, mod_ctx, 3 * 1024, 4 * 1024, nrows, smem);
      grid.sync();
      stage_peerq_mfma(H, W + WT_WQ, PQ, nrows, smc);
      grid.sync();
      stage_scores_mfma(PQ, W + WT_SUBK, SC, nrows, smc);
      grid.sync();
      stage_topk(SC, EI, EG, nrows);
      grid.sync();
      stage_expert(p, l, H, EI, EG, XAb, mod_lat, mod_ctx, nrows, smem);
      grid.sync();
    }
  }
  stage_final(p, smem);
}

extern "C" void kernel_launch(void* const* d_in, const int* in_sizes, int n_in, void* d_out,
                              int out_size, void* d_ws, size_t ws_size, hipStream_t stream) {
  static int grid_blocks = 0;
  if (!grid_blocks) {
    int dev = 0, cus = 0, per_cu = 0;
    (void)hipGetDevice(&dev);
    (void)hipDeviceGetAttribute(&cus, hipDeviceAttributeMultiprocessorCount, dev);
    (void)hipOccupancyMaxActiveBlocksPerMultiprocessor(&per_cu, mega, 256, 0);
    if (per_cu > 1) per_cu = 1;
    grid_blocks = cus * per_cu;
  }
  if (ws_size < WS_END * sizeof(float)) {
    fprintf(stderr, "workspace too small: %zu < %zu\n", ws_size, (size_t)(WS_END * sizeof(float)));
    return;
  }
  Params p{};
  for (int i = 0; i < N_IN; ++i) p.in[i] = (const float*)d_in[i];
  p.out = (float*)d_out;
  p.ws = (float*)d_ws;
  void* args[] = {&p};
  hipError_t e = hipLaunchCooperativeKernel((void*)mega, dim3(grid_blocks), dim3(256), args, 0, stream);
  if (e != hipSuccess) fprintf(stderr, "cooperative launch failed: %s (grid %d)\n", hipGetErrorString(e), grid_blocks);
}
```

```cpp
#include <hip/hip_runtime.h>
#include <hip/hip_cooperative_groups.h>
#include <cstdio>
#include <cstdint>
namespace cg = cooperative_groups;

#define NLAT 4096
#define NCTX 256
#define NTOK 4352
#define DM 1024
#define INW 6672
#define NB 8
#define GB 2
#define NG (NB / GB)
#define RPG (GB * NTOK)
#define ZW 6656
#define EPSF 1e-6f

enum { I_X = 0, I_C, I_CTX, I_CCTX, I_WMOD, I_BMOD, I_N1G, I_N2G, I_WIN, I_LQ1, I_LK1, I_LQ2, I_LK2, I_SUBG,
       I_CONVW, I_CONVB, I_MLWQ, I_MLWK, I_GATEB, I_MLNG, I_S5LRE, I_S5LIM, I_S5DT, I_S5BRE, I_S5BIM,
       I_S5CRE, I_S5CIM, I_S5D, I_GLUW, I_GLUB, I_WBR, I_WOUT, I_PWQ, I_PSUBK, I_PU, I_PV, I_FG, N_IN };

struct Params {
  const float* in[N_IN];
  float* out;
  char* ws;
};

typedef unsigned short bf16_t;
typedef short bf16x8 __attribute__((ext_vector_type(8)));
typedef float f32x16 __attribute__((ext_vector_type(16)));
typedef unsigned u32x4 __attribute__((ext_vector_type(4)));
typedef unsigned u32x2 __attribute__((ext_vector_type(2)));

#define AL(x) (((x) + 255) & ~(size_t)255)
#define WB_XCX   ((size_t)0)
#define WB_MOD   AL(WB_XCX + (size_t)NB * NCTX * DM * 4)
#define WB_ROPE  AL(WB_MOD + (size_t)2 * 9 * 6144 * 4)
#define WB_WT    AL(WB_ROPE + (size_t)NLAT * 32 * 2 * 4)
#define WT_WIN   ((size_t)0)
#define WT_WQK   (WT_WIN + (size_t)6784 * 1024)
#define WT_GLU   (WT_WQK + (size_t)4 * 256 * 128)
#define WT_WBR   (WT_GLU + (size_t)512 * 512)
#define WT_WOUT  (WT_WBR + (size_t)3 * 1024 * 512)
#define WT_WQ    (WT_WOUT + (size_t)1024 * 1024)
#define WT_SUBK  (WT_WQ + (size_t)2048 * 1024)
#define WT_LAYER (WT_SUBK + (size_t)2 * 128 * 128)
#define WB_H     AL(WB_WT + WT_LAYER * 2 * 2)
#define WB_Z     AL(WB_H + (size_t)RPG * DM * 2)
#define WB_MGT   AL(WB_Z + (size_t)RPG * ZW * 2)
#define WB_XC    AL(WB_MGT + (size_t)RPG * 16 * 4)
#define WB_QM    AL(WB_XC + (size_t)RPG * 512 * 2)
#define WB_KM    AL(WB_QM + (size_t)RPG * 512 * 4)
#define WB_HF    AL(WB_KM + (size_t)RPG * 512 * 4)
#define WB_HB    AL(WB_HF + (size_t)RPG * 512 * 4)
#define WB_OA    AL(WB_HB + (size_t)RPG * 512 * 4)
#define WB_YSF   AL(WB_OA + (size_t)2 * RPG * 512 * 4)
#define WB_YSB   AL(WB_YSF + (size_t)RPG * 512 * 4)
#define WB_YA    AL(WB_YSB + (size_t)RPG * 512 * 4)
#define WB_YB    AL(WB_YA + (size_t)RPG * 512 * 2)
#define WB_YS    AL(WB_YB + (size_t)RPG * 512 * 2)
#define WB_GG    AL(WB_YS + (size_t)RPG * 512 * 2)
#define WB_MG    AL(WB_GG + (size_t)RPG * 512 * 2)
#define WB_EI    AL(WB_MG + (size_t)RPG * DM * 2)
#define WB_EG    AL(WB_EI + (size_t)RPG * 128 * 4)
#define WB_END   AL(WB_EG + (size_t)RPG * 128 * 4)
#define WB_PQ    (WB_Z)
#define WB_SC    AL(WB_PQ + (size_t)RPG * 2048 * 2)

#define SMEM_FLOATS (24 * 1024)

__device__ __forceinline__ float sigmoidf_(float x) { return 1.0f / (1.0f + expf(-x)); }
__device__ __forceinline__ float siluf_(float x) { return x / (1.0f + expf(-x)); }
__device__ __forceinline__ float geluf_(float x) { return 0.5f * x * (1.0f + erff(x * 0.70710678118654752f)); }
__device__ __forceinline__ int otid() { int t = threadIdx.x; asm volatile("" : "+v"(t)); return t; }
__device__ __forceinline__ float wave_sum(float v) {
  for (int o = 32; o > 0; o >>= 1) v += __shfl_xor(v, o);
  return v;
}
__device__ __forceinline__ bf16_t f2bf(float x) { unsigned u = __float_as_uint(x); u += 0x7fffu + ((u >> 16) & 1u); return (bf16_t)(u >> 16); }
__device__ __forceinline__ float bf2f(bf16_t h) { return __uint_as_float(((unsigned)h) << 16); }
__device__ __forceinline__ unsigned pack2(float a, float b) { return (unsigned)f2bf(a) | ((unsigned)f2bf(b) << 16); }
__device__ __forceinline__ float lo16(unsigned u) { return __uint_as_float(u << 16); }
__device__ __forceinline__ float hi16(unsigned u) { return __uint_as_float(u & 0xffff0000u); }

__device__ __forceinline__ float* xrow(const Params& p, int b, int rr) {
  return (rr < NLAT) ? p.out + ((size_t)b * NLAT + rr) * DM : (float*)(p.ws + WB_XCX) + ((size_t)b * NCTX + (rr - NLAT)) * DM;
}

__device__ __forceinline__ void gemm_tile(const bf16_t* __restrict__ Ag, int lda, const bf16_t* __restrict__ Bg, int ldb, int K,
                                          char* smem, f32x16 (&acc)[2][2]) {
  const int tid = otid(), lane = tid & 63, w = tid >> 6, wm = w >> 1, wn = w & 1;
#pragma unroll
  for (int a = 0; a < 2; ++a)
#pragma unroll
    for (int b = 0; b < 2; ++b)
#pragma unroll
      for (int i = 0; i < 16; ++i) acc[a][b][i] = 0.f;
  const int srow = tid >> 3, sch = tid & 7;
  const bf16_t* ap = Ag + (size_t)srow * lda + sch * 8;
  const bf16_t* bp = Bg + (size_t)srow * ldb + sch * 8;
  const int wofs = srow * 128 + ((sch ^ ((srow >> 1) & 7)) << 4);
  const int fr = lane & 31, fh = lane >> 5, fsw = (fr >> 1) & 7;
  const int aofs = (wm * 64 + fr) * 128, bofs = 16384 + (wn * 64 + fr) * 128;
  u32x4 ra[4], rb[4];
  const int nk = K >> 6;
#pragma unroll
  for (int i = 0; i < 4; ++i) {
    ra[i] = *(const u32x4*)(ap + (size_t)i * 32 * lda);
    rb[i] = *(const u32x4*)(bp + (size_t)i * 32 * ldb);
  }
  __syncthreads();
#pragma unroll
  for (int i = 0; i < 4; ++i) {
    *(u32x4*)(smem + wofs + i * 4096) = ra[i];
    *(u32x4*)(smem + 16384 + wofs + i * 4096) = rb[i];
  }
  __syncthreads();
  for (int kt = 0; kt < nk; ++kt) {
    const bool more = (kt + 1 < nk);
    if (more) {
#pragma unroll
      for (int i = 0; i < 4; ++i) {
        ra[i] = *(const u32x4*)(ap + (size_t)i * 32 * lda + (kt + 1) * 64);
        rb[i] = *(const u32x4*)(bp + (size_t)i * 32 * ldb + (kt + 1) * 64);
      }
    }
    const char* base = smem + (kt & 1) * 32768;
#pragma unroll
    for (int ks = 0; ks < 4; ++ks) {
      const int coff = ((ks * 2 + fh) ^ fsw) << 4;
      bf16x8 af[2], bfr[2];
#pragma unroll
      for (int mi = 0; mi < 2; ++mi) af[mi] = *(const bf16x8*)(base + aofs + mi * 4096 + coff);
#pragma unroll
      for (int ni = 0; ni < 2; ++ni) bfr[ni] = *(const bf16x8*)(base + bofs + ni * 4096 + coff);
#pragma unroll
      for (int mi = 0; mi < 2; ++mi)
#pragma unroll
        for (int ni = 0; ni < 2; ++ni)
          acc[mi][ni] = __builtin_amdgcn_mfma_f32_32x32x16_bf16(bfr[ni], af[mi], acc[mi][ni], 0, 0, 0);
    }
    if (more) {
      char* nb = smem + ((kt + 1) & 1) * 32768;
#pragma unroll
      for (int i = 0; i < 4; ++i) {
        *(u32x4*)(nb + wofs + i * 4096) = ra[i];
        *(u32x4*)(nb + 16384 + wofs + i * 4096) = rb[i];
      }
    }
    __syncthreads();
  }
}
#define EPI_DECL const int tid_ = otid(); const int lane = tid_ & 63, w_ = tid_ >> 6, wm = w_ >> 1, wn = w_ & 1, fr = lane & 31, fh = lane >> 5; (void)fr; (void)fh; (void)wm; (void)wn;
#define EPI_ROW(mi) (wm * 64 + (mi) * 32 + fr)
#define EPI_COL(ni, q) (wn * 64 + (ni) * 32 + 8 * (q) + 4 * fh)
#define MT_LR0(mt, tpb) (((mt) / (tpb)) * NTOK + ((mt) % (tpb)) * 128)

template <class F>
__device__ __forceinline__ void transpose_cvt(const float* __restrict__ src, int ld, F srccol, int K, int Ndst, bf16_t* __restrict__ dst, float* smem) {
  float (*T)[65] = (float (*)[65])smem;
  const int tid = otid();
  const int tk = K >> 6, tn = Ndst >> 6;
  for (int t = blockIdx.x; t < tn * tk; t += gridDim.x) {
    const int n0 = (t / tk) * 64, k0 = (t % tk) * 64;
    __syncthreads();
    const int sc = srccol(n0 + (tid & 63));
#pragma unroll
    for (int i = 0; i < 16; ++i) {
      const int ky = (tid >> 6) + 4 * i;
      T[ky][tid & 63] = (sc >= 0) ? src[(size_t)(k0 + ky) * ld + sc] : 0.f;
    }
    __syncthreads();
#pragma unroll
    for (int i = 0; i < 16; ++i) {
      const int ny = (tid >> 6) + 4 * i;
      dst[(size_t)(n0 + ny) * K + k0 + (tid & 63)] = f2bf(T[tid & 63][ny]);
    }
  }
  __syncthreads();
}
__device__ __forceinline__ int win_srccol(int n) {
  if (n < 3072) return n;
  if (n < 6656) return n + 16;
  if (n < 6672) return n - 3584;
  return -1;
}

__device__ __forceinline__ void stage_init(const Params& p, float* smem) {
  const int tid = otid();
  {
    const size_t n4 = (size_t)NB * NLAT * 256;
    const float4* s = (const float4*)p.in[I_X];
    float4* d = (float4*)p.out;
    for (size_t i = (size_t)blockIdx.x * 256 + tid; i < n4; i += (size_t)gridDim.x * 256) d[i] = s[i];
    const size_t m4 = (size_t)NB * NCTX * 256;
    const float4* s2 = (const float4*)p.in[I_CTX];
    float4* d2 = (float4*)(p.ws + WB_XCX);
    for (size_t i = (size_t)blockIdx.x * 256 + tid; i < m4; i += (size_t)gridDim.x * 256) d2[i] = s2[i];
  }
  {
    float2* rt = (float2*)(p.ws + WB_ROPE);
    for (int i = blockIdx.x * 256 + tid; i < NLAT * 32; i += gridDim.x * 256) {
      const int pos = i >> 5, j = i & 31;
      const float inv = powf(10000.0f, -(float)(j & 15) / 16.0f);
      const float ang = (float)((j < 16) ? (pos >> 6) : (pos & 63)) * inv;
      rt[i] = make_float2(cosf(ang), sinf(ang));
    }
  }
  {
    float* sc = smem;
    for (int i = tid; i < 9 * 1024; i += 256) {
      int r = i >> 10, k = i & 1023;
      float v = (r < 8) ? p.in[I_C][r * 1024 + k] : p.in[I_CCTX][k];
      sc[i] = siluf_(v);
    }
    __syncthreads();
    float* mod = (float*)(p.ws + WB_MOD);
    for (int col = blockIdx.x * 256 + tid; col < 2 * 6144; col += gridDim.x * 256) {
      int l = col / 6144, j = col % 6144;
      const float* w = p.in[I_WMOD] + (size_t)l * 1024 * 6144 + j;
      float acc[9];
#pragma unroll
      for (int r = 0; r < 9; ++r) acc[r] = 0.f;
      for (int k = 0; k < 1024; ++k) {
        float wv = w[(size_t)k * 6144];
#pragma unroll
        for (int r = 0; r < 9; ++r) acc[r] = fmaf(sc[r * 1024 + k], wv, acc[r]);
      }
      float bv = p.in[I_BMOD][l * 6144 + j];
#pragma unroll
      for (int r = 0; r < 9; ++r) mod[((size_t)l * 9 + r) * 6144 + j] = acc[r] + bv;
    }
    __syncthreads();
  }
  bf16_t* WT = (bf16_t*)(p.ws + WB_WT);
  for (int l = 0; l < 2; ++l) {
    bf16_t* W = WT + (size_t)l * WT_LAYER;
    transpose_cvt(p.in[I_WIN] + (size_t)l * DM * INW, INW, [](int n) { return win_srccol(n); }, DM, 6784, W + WT_WIN, smem);
    for (int h = 0; h < 4; ++h) {
      transpose_cvt(p.in[I_MLWQ] + ((size_t)l * 4 + h) * 16384, 128, [](int n) { return n; }, 128, 128, W + WT_WQK + (size_t)h * 256 * 128, smem);
      transpose_cvt(p.in[I_MLWK] + ((size_t)l * 4 + h) * 16384, 128, [](int n) { return n; }, 128, 128, W + WT_WQK + (size_t)h * 256 * 128 + 128 * 128, smem);
    }
    transpose_cvt(p.in[I_GLUW] + (size_t)l * 512 * 512, 512, [](int n) { return n; }, 512, 512, W + WT_GLU, smem);
    for (int r = 0; r < 3; ++r)
      transpose_cvt(p.in[I_WBR] + ((size_t)l * 3 + r) * 512 * DM, DM, [](int n) { return n; }, 512, DM, W + WT_WBR + (size_t)r * 1024 * 512, smem);
    transpose_cvt(p.in[I_WOUT] + (size_t)l * DM * DM, DM, [](int n) { return n; }, DM, DM, W + WT_WOUT, smem);
    transpose_cvt(p.in[I_PWQ] + (size_t)l * DM * 2048, 2048, [](int n) { return n; }, DM, 2048, W + WT_WQ, smem);
    const float* sk = p.in[I_PSUBK] + (size_t)l * 2 * 128 * 128;
    for (int i = blockIdx.x * 256 + tid; i < 2 * 128 * 128; i += gridDim.x * 256) W[WT_SUBK + i] = f2bf(sk[i]);
  }
}

__device__ __forceinline__ void stage_normmod(const Params& p, int l, int g, int which, int rr_lim, bf16_t* H, float* smem) {
  const int tid = otid();
  const float* ng = p.in[which ? I_N2G : I_N1G] + l * DM;
  const float* mod = (const float*)(p.ws + WB_MOD) + (size_t)l * 9 * 6144;
  const int off_sh = which ? 3072 : 0, off_sc = which ? 4096 : 1024;
  const int per = rr_lim;
  for (int i = blockIdx.x; i < GB * per; i += gridDim.x) {
    const int bl = i / per, rr = i % per, b = g * GB + bl;
    const float* X = xrow(p, b, rr);
    float4 v = ((const float4*)X)[tid];
    float s = wave_sum(v.x * v.x + v.y * v.y + v.z * v.z + v.w * v.w);
    __syncthreads();
    if ((tid & 63) == 0) smem[tid >> 6] = s;
    __syncthreads();
    float tot = smem[0] + smem[1] + smem[2] + smem[3];
    float rs = rsqrtf(tot * (1.0f / DM) + EPSF);
    const float* m = mod + (size_t)((rr < NLAT) ? b : 8) * 6144;
    float4 gg = ((const float4*)ng)[tid];
    float4 sc = ((const float4*)(m + off_sc))[tid];
    float4 sh = ((const float4*)(m + off_sh))[tid];
    float4 o;
    o.x = v.x * rs * gg.x * (1.f + sc.x) + sh.x;
    o.y = v.y * rs * gg.y * (1.f + sc.y) + sh.y;
    o.z = v.z * rs * gg.z * (1.f + sc.z) + sh.z;
    o.w = v.w * rs * gg.w * (1.f + sc.w) + sh.w;
    ((u32x2*)(H + ((size_t)bl * NTOK + rr) * DM))[tid] = (u32x2){pack2(o.x, o.y), pack2(o.z, o.w)};
  }
  __syncthreads();
}

__device__ __forceinline__ void stage_inproj(const Params& p, const bf16_t* H, const bf16_t* WinT, bf16_t* Z, float* MGT, char* smem) {
  EPI_DECL
  const int tm = GB * 34, tn = 53;
  const float2* rt = (const float2*)(p.ws + WB_ROPE);
  for (int t = blockIdx.x; t < tm * tn; t += gridDim.x) {
    const int mt = t / tn, j = t % tn, n0 = j * 128;
    const int lr0 = MT_LR0(mt, 34), rr0 = (mt % 34) * 128;
    f32x16 acc[2][2];
    gemm_tile(H + (size_t)lr0 * DM, DM, WinT + (size_t)n0 * DM, DM, DM, smem, acc);
    if (j < 8 && rr0 < NLAT) {
#pragma unroll
      for (int mi = 0; mi < 2; ++mi) {
        const int pos = rr0 + EPI_ROW(mi);
#pragma unroll
        for (int i = 0; i < 16; ++i) {
          const int jj = 8 * (i >> 2) + 4 * fh + (i & 3);
          const float2 cs = rt[pos * 32 + jj];
          const float x1 = acc[mi][0][i], x2 = acc[mi][1][i];
          acc[mi][0][i] = x1 * cs.x - x2 * cs.y;
          acc[mi][1][i] = x1 * cs.y + x2 * cs.x;
        }
      }
    }
    if (j < 52) {
      const bool sg = (j >= 28);
#pragma unroll
      for (int mi = 0; mi < 2; ++mi)
#pragma unroll
        for (int ni = 0; ni < 2; ++ni)
#pragma unroll
          for (int q = 0; q < 4; ++q) {
            const int row = lr0 + EPI_ROW(mi), c = n0 + EPI_COL(ni, q);
            float v0 = acc[mi][ni][4 * q], v1 = acc[mi][ni][4 * q + 1], v2 = acc[mi][ni][4 * q + 2], v3 = acc[mi][ni][4 * q + 3];
            if (sg) { v0 = sigmoidf_(v0); v1 = sigmoidf_(v1); v2 = sigmoidf_(v2); v3 = sigmoidf_(v3); }
            *(u32x2*)(Z + (size_t)row * ZW + c) = (u32x2){pack2(v0, v1), pack2(v2, v3)};
          }
    } else {
#pragma unroll
      for (int mi = 0; mi < 2; ++mi)
#pragma unroll
        for (int q = 0; q < 2; ++q) {
          const int row = lr0 + EPI_ROW(mi), c = EPI_COL(0, q);
          if (wn == 0) *(float4*)(MGT + (size_t)row * 16 + c) = make_float4(acc[mi][0][4 * q], acc[mi][0][4 * q + 1], acc[mi][0][4 * q + 2], acc[mi][0][4 * q + 3]);
        }
    }
  }
}

__device__ __forceinline__ void stage_conv(const Params& p, int l, const bf16_t* Z, bf16_t* XC) {
  const int tid = otid();
  const float* cw = p.in[I_CONVW] + (size_t)l * 3 * 512;
  const float* cb = p.in[I_CONVB] + (size_t)l * 512;
  const int c = tid * 2;
  const float2 w0 = *(const float2*)(cw + c), w1 = *(const float2*)(cw + 512 + c), w2 = *(const float2*)(cw + 1024 + c), bb = *(const float2*)(cb + c);
  for (int lr = blockIdx.x; lr < RPG; lr += gridDim.x) {
    const int rr = lr % NTOK;
    const bool has_prev = (rr < NLAT) ? (rr > 0) : (rr > NLAT);
    const bool has_next = (rr < NLAT) ? (rr < NLAT - 1) : (rr < NTOK - 1);
    const bf16_t* z = Z + (size_t)lr * ZW + 1536 + c;
    const unsigned xc = *(const unsigned*)z;
    float a0 = bb.x + w1.x * lo16(xc), a1 = bb.y + w1.y * hi16(xc);
    if (has_prev) { const unsigned xp = *(const unsigned*)(z - ZW); a0 += w0.x * lo16(xp); a1 += w0.y * hi16(xp); }
    if (has_next) { const unsigned xn = *(const unsigned*)(z + ZW); a0 += w2.x * lo16(xn); a1 += w2.y * hi16(xn); }
    *(unsigned*)(XC + (size_t)lr * 512 + c) = pack2(siluf_(a0), siluf_(a1));
  }
}

__device__ __forceinline__ void stage_mlqk(const bf16_t* XC, const bf16_t* WQK, float* QM, float* KM, char* smem) {
  EPI_DECL
  const int tm = RPG >> 7;
  for (int t = blockIdx.x; t < tm * 8; t += gridDim.x) {
    const int m0 = (t >> 3) * 128, h = (t >> 1) & 3, nt = t & 1;
    f32x16 acc[2][2];
    gemm_tile(XC + (size_t)m0 * 512 + h * 128, 512, WQK + (size_t)h * 256 * 128 + (size_t)nt * 128 * 128, 128, 128, smem, acc);
    float* O = nt ? KM : QM;
    const float alpha = nt ? 1.0f : 0.08838834764831845f;
#pragma unroll
    for (int mi = 0; mi < 2; ++mi)
#pragma unroll
      for (int ni = 0; ni < 2; ++ni)
#pragma unroll
        for (int q = 0; q < 4; ++q) {
          const int row = m0 + EPI_ROW(mi), c = EPI_COL(ni, q);
          *(float4*)(O + (size_t)row * 512 + h * 128 + c) = make_float4(alpha * acc[mi][ni][4 * q], alpha * acc[mi][ni][4 * q + 1], alpha * acc[mi][ni][4 * q + 2], alpha * acc[mi][ni][4 * q + 3]);
        }
  }
}

__device__ __forceinline__ void attn_item(const bf16_t* Zb, float* OAb, int h, int qrow0, int key0, int nkeys, float* smem) {
  const int tid = otid();
  const int m = (tid >> 6) & 1, eh = tid >> 7;
  const int row = qrow0 + (tid & 63);
  float (*Ks)[128] = (float (*)[128])smem;
  float (*Vs)[128] = (float (*)[128])(smem + 32 * 128);
  float q[64];
  {
    const u32x4* qp = (const u32x4*)(Zb + (size_t)row * ZW + h * 128 + m * 64);
#pragma unroll
    for (int i = 0; i < 8; ++i) {
      u32x4 t = qp[i];
#pragma unroll
      for (int k = 0; k < 4; ++k) { q[8 * i + 2 * k] = lo16(t[k]) * 0.125f; q[8 * i + 2 * k + 1] = hi16(t[k]) * 0.125f; }
    }
  }
  float o[64];
#pragma unroll
  for (int i = 0; i < 64; ++i) o[i] = 0.f;
  float mrun = -1e30f, lrun = 0.f;
  for (int kt = 0; kt < nkeys; kt += 32) {
    __syncthreads();
#pragma unroll
    for (int i = 0; i < 2; ++i) {
      int idx = tid + i * 256;
      int key = idx >> 4, c8 = idx & 15;
      const bf16_t* zr = Zb + (size_t)(key0 + kt + key) * ZW;
      u32x4 kv = ((const u32x4*)(zr + 512 + h * 128))[c8];
      u32x4 vv = ((const u32x4*)(zr + 1024 + h * 128))[c8];
#pragma unroll
      for (int k = 0; k < 4; ++k) {
        Ks[key][c8 * 8 + 2 * k] = lo16(kv[k]); Ks[key][c8 * 8 + 2 * k + 1] = hi16(kv[k]);
        Vs[key][c8 * 8 + 2 * k] = lo16(vv[k]); Vs[key][c8 * 8 + 2 * k + 1] = hi16(vv[k]);
      }
    }
    __syncthreads();
#pragma unroll 1
    for (int sub = 0; sub < 32; sub += 16) {
      float s[16];
      float smax = -1e30f;
#pragma unroll
      for (int jj = 0; jj < 16; ++jj) {
        const float4* kp = (const float4*)&Ks[sub + jj][m * 64];
        float a = 0.f;
#pragma unroll
        for (int d4 = 0; d4 < 16; ++d4) {
          float4 kv = kp[d4];
          a = fmaf(q[4 * d4], kv.x, a); a = fmaf(q[4 * d4 + 1], kv.y, a); a = fmaf(q[4 * d4 + 2], kv.z, a); a = fmaf(q[4 * d4 + 3], kv.w, a);
        }
        s[jj] = a;
        smax = fmaxf(smax, a);
      }
      float mnew = fmaxf(mrun, smax);
      float scale = expf(mrun - mnew);
      mrun = mnew;
      lrun *= scale;
#pragma unroll
      for (int i = 0; i < 64; ++i) o[i] *= scale;
#pragma unroll
      for (int jj = 0; jj < 16; ++jj) {
        float pj = expf(s[jj] - mnew);
        lrun += pj;
        const float4* vp = (const float4*)&Vs[sub + jj][eh * 64];
#pragma unroll
        for (int e4 = 0; e4 < 16; ++e4) {
          float4 vv = vp[e4];
          o[4 * e4] = fmaf(pj, vv.x, o[4 * e4]); o[4 * e4 + 1] = fmaf(pj, vv.y, o[4 * e4 + 1]);
          o[4 * e4 + 2] = fmaf(pj, vv.z, o[4 * e4 + 2]); o[4 * e4 + 3] = fmaf(pj, vv.w, o[4 * e4 + 3]);
        }
      }
    }
  }
  const float il = 1.0f / lrun;
  float4* op = (float4*)(OAb + ((size_t)m * RPG + row) * 512 + h * 128 + eh * 64);
#pragma unroll
  for (int e4 = 0; e4 < 16; ++e4) op[e4] = make_float4(o[4 * e4] * il, o[4 * e4 + 1] * il, o[4 * e4 + 2] * il, o[4 * e4 + 3] * il);
  __syncthreads();
}

__device__ __forceinline__ void mlstm_item(const Params& p, int l, const bf16_t* Zb, const float* MGTb, const float* QMb, const float* KMb, float* HXb,
                                           int h, int dir, float* smem) {
  const int tid = otid();
  const int e = tid >> 1, hf = tid & 1;
  float* qs = smem;
  float* ks = smem + 16 * 128;
  float* vs = smem + 2 * 16 * 128;
  float* gi = smem + 3 * 16 * 128;
  float* gf = gi + 16;
  int* rows = (int*)(gf + 16);
  const float bi = p.in[I_GATEB][l * 16 + dir * 8 + h];
  const float bf = p.in[I_GATEB][l * 16 + dir * 8 + 4 + h];
  float C[64], nn[64];
#pragma unroll
  for (int j = 0; j < 64; ++j) { C[j] = 0.f; nn[j] = 0.f; }
  for (int s0 = 0; s0 < NTOK; s0 += 16) {
    __syncthreads();
#pragma unroll
    for (int i = 0; i < 2; ++i) {
      int idx = tid + i * 256;
      int st = idx >> 5, c4 = idx & 31;
      int step = s0 + st;
      int row = (dir == 0) ? ((step < NCTX) ? NLAT + step : step - NCTX)
                           : ((step < NCTX) ? NLAT + (NCTX - 1 - step) : (NLAT - 1) - (step - NCTX));
      ((float4*)(qs + st * 128))[c4] = ((const float4*)(QMb + (size_t)row * 512 + h * 128))[c4];
      ((float4*)(ks + st * 128))[c4] = ((const float4*)(KMb + (size_t)row * 512 + h * 128))[c4];
      const u32x2 vv = ((const u32x2*)(Zb + (size_t)row * ZW + 2048 + h * 128))[c4];
      ((float4*)(vs + st * 128))[c4] = make_float4(lo16(vv[0]), hi16(vv[0]), lo16(vv[1]), hi16(vv[1]));
      if (c4 == 0) {
        float a = MGTb[(size_t)row * 16 + dir * 8 + h] + bi;
        float f = MGTb[(size_t)row * 16 + dir * 8 + 4 + h] + bf;
        gi[st] = expf(a);
        gf[st] = sigmoidf_(f);
        rows[st] = row;
      }
    }
    __syncthreads();
#pragma unroll 1
    for (int st = 0; st < 16; ++st) {
      const float ig = gi[st], fg = gf[st];
      const float iv = ig * vs[st * 128 + e];
      const float4* kp = (const float4*)(ks + st * 128 + hf * 64);
      const float4* qp = (const float4*)(qs + st * 128 + hf * 64);
      float hp = 0.f, dp = 0.f;
#pragma unroll
      for (int j4 = 0; j4 < 16; ++j4) {
        float4 kv = kp[j4], qv = qp[j4];
        float kk[4] = {kv.x, kv.y, kv.z, kv.w}, qq[4] = {qv.x, qv.y, qv.z, qv.w};
#pragma unroll
        for (int u = 0; u < 4; ++u) {
          int j = j4 * 4 + u;
          C[j] = fmaf(fg, C[j], iv * kk[u]);
          nn[j] = fmaf(fg, nn[j], ig * kk[u]);
          hp = fmaf(C[j], qq[u], hp);
          dp = fmaf(nn[j], qq[u], dp);
        }
      }
      hp += __shfl_xor(hp, 1);
      dp += __shfl_xor(dp, 1);
      if (hf == 0) HXb[(size_t)rows[st] * 512 + h * 128 + e] = hp / fmaxf(fabsf(dp), 1.0f);
    }
  }
  __syncthreads();
}

__device__ __forceinline__ void s5_item(const Params& p, int l, const bf16_t* Zb, float* YSFb, float* YSBb, int g, float* smem) {
  const int tid = otid();
  const int w = tid >> 6, lane = tid & 63;
  const bool active = w < 2;
  const int dir = w & 1;
  float* base = smem + (w & 1) * 11392;
  float* us = base;
  float* xre = base + 1024;
  float* xim = xre + 64 * 65;
  float* cre = xim + 64 * 65;
  float* cim = cre + 1024;
  const int pg = ((l * 2 + dir) * 32 + g);
  const int n = lane;
  const float lre = p.in[I_S5LRE][pg * 64 + n], lim = p.in[I_S5LIM][pg * 64 + n];
  const float dt = expf(p.in[I_S5DT][pg]);
  const float mag = expf(lre * dt);
  const float abr = mag * cosf(lim * dt), abi = mag * sinf(lim * dt);
  const float den = lre * lre + lim * lim;
  const float zr = ((abr - 1.0f) * lre + abi * lim) / den;
  const float zi = (abi * lre - (abr - 1.0f) * lim) / den;
  float bbr[16], bbi[16];
  {
    const float* br = p.in[I_S5BRE] + ((size_t)pg * 64 + n) * 16;
    const float* bi = p.in[I_S5BIM] + ((size_t)pg * 64 + n) * 16;
#pragma unroll
    for (int q = 0; q < 16; ++q) { float a = br[q], b = bi[q]; bbr[q] = zr * a - zi * b; bbi[q] = zr * b + zi * a; }
  }
  __syncthreads();
  if (active) {
    const float* cr = p.in[I_S5CRE] + (size_t)pg * 16 * 64;
    const float* ci = p.in[I_S5CIM] + (size_t)pg * 16 * 64;
#pragma unroll
    for (int q = 0; q < 16; ++q) { cre[n * 16 + q] = cr[q * 64 + n]; cim[n * 16 + q] = ci[q * 64 + n]; }
  }
  float xr = 0.f, xi = 0.f;
  float* Y = dir ? YSBb : YSFb;
  for (int s0 = 0; s0 < NTOK; s0 += 64) {
    const int step = s0 + lane;
    const int row = (dir == 0) ? ((step < NCTX) ? NLAT + step : step - NCTX)
                               : ((step < NCTX) ? NLAT + (NCTX - 1 - step) : (NLAT - 1) - (step - NCTX));
    if (active) {
      const u32x4* up = (const u32x4*)(Zb + (size_t)row * ZW + 3072 + g * 16);
#pragma unroll
      for (int q = 0; q < 2; ++q) {
        u32x4 t = up[q];
#pragma unroll
        for (int k = 0; k < 4; ++k) { us[lane * 16 + q * 8 + 2 * k] = lo16(t[k]); us[lane * 16 + q * 8 + 2 * k + 1] = hi16(t[k]); }
      }
    }
    __syncthreads();
    if (active) {
#pragma unroll 4
      for (int t = 0; t < 64; ++t) {
        const float4* up = (const float4*)(us + t * 16);
        float br_ = 0.f, bi_ = 0.f;
#pragma unroll
        for (int q4 = 0; q4 < 4; ++q4) {
          float4 uv = up[q4];
          br_ = fmaf(uv.x, bbr[4 * q4], br_); br_ = fmaf(uv.y, bbr[4 * q4 + 1], br_); br_ = fmaf(uv.z, bbr[4 * q4 + 2], br_); br_ = fmaf(uv.w, bbr[4 * q4 + 3], br_);
          bi_ = fmaf(uv.x, bbi[4 * q4], bi_); bi_ = fmaf(uv.y, bbi[4 * q4 + 1], bi_); bi_ = fmaf(uv.z, bbi[4 * q4 + 2], bi_); bi_ = fmaf(uv.w, bbi[4 * q4 + 3], bi_);
        }
        float nr = abr * xr - abi * xi + br_;
        float ni = abr * xi + abi * xr + bi_;
        xr = nr; xi = ni;
        xre[t * 65 + n] = xr;
        xim[t * 65 + n] = xi;
      }
    }
    __syncthreads();
    if (active) {
      float y[16];
#pragma unroll
      for (int q = 0; q < 16; ++q) y[q] = 0.f;
      for (int nn_ = 0; nn_ < 64; ++nn_) {
        const float a = xre[lane * 65 + nn_], b = xim[lane * 65 + nn_];
        const float4* cr4 = (const float4*)(cre + nn_ * 16);
        const float4* ci4 = (const float4*)(cim + nn_ * 16);
#pragma unroll
        for (int q4 = 0; q4 < 4; ++q4) {
          float4 c1 = cr4[q4], c2 = ci4[q4];
          y[4 * q4] += a * c1.x - b * c2.x; y[4 * q4 + 1] += a * c1.y - b * c2.y;
          y[4 * q4 + 2] += a * c1.z - b * c2.z; y[4 * q4 + 3] += a * c1.w - b * c2.w;
        }
      }
      float4* yp = (float4*)(Y + (size_t)row * 512 + g * 16);
#pragma unroll
      for (int q4 = 0; q4 < 4; ++q4) yp[q4] = make_float4(y[4 * q4], y[4 * q4 + 1], y[4 * q4 + 2], y[4 * q4 + 3]);
    }
    __syncthreads();
  }
}

__device__ __forceinline__ void stage_post(const Params& p, int l, int rr_lim, const bf16_t* Z, const float* OA, const float* HF, const float* HB,
                                           const float* YSF, const float* YSB, bf16_t* YA, bf16_t* YB, bf16_t* GG) {
  const int tid = otid();
  const float lam_init = 0.8f - 0.6f * expf(-0.3f * (float)l);
  float lam;
  {
    float s1 = 0.f, s2 = 0.f;
    for (int i = 0; i < 64; ++i) {
      s1 += p.in[I_LQ1][l * 64 + i] * p.in[I_LK1][l * 64 + i];
      s2 += p.in[I_LQ2][l * 64 + i] * p.in[I_LK2][l * 64 + i];
    }
    lam = expf(s1) - expf(s2) + lam_init;
  }
  const int c0 = tid * 2;
  for (int i = blockIdx.x; i < GB * rr_lim; i += gridDim.x) {
    const size_t r = (size_t)(i / rr_lim) * NTOK + (i % rr_lim);
    {
      float2 a0 = *(const float2*)(OA + r * 512 + c0);
      float2 a1 = *(const float2*)(OA + ((size_t)RPG + r) * 512 + c0);
      float o0 = a0.x - lam * a1.x, o1 = a0.y - lam * a1.y;
      float ss = wave_sum(o0 * o0 + o1 * o1);
      float rs = rsqrtf(ss * (1.0f / 128.0f) + EPSF) * (1.0f - lam_init);
      float2 g = *(const float2*)(p.in[I_SUBG] + l * 512 + c0);
      *(unsigned*)(YA + r * 512 + c0) = pack2(o0 * rs * g.x, o1 * rs * g.y);
    }
    {
      float2 a0 = *(const float2*)(HF + r * 512 + c0);
      float2 a1 = *(const float2*)(HB + r * 512 + c0);
      float h0 = a0.x + a1.x, h1 = a0.y + a1.y;
      float ss = wave_sum(h0 * h0 + h1 * h1);
      float rs = rsqrtf(ss * (1.0f / 128.0f) + EPSF);
      float2 g = *(const float2*)(p.in[I_MLNG] + l * 512 + c0);
      const unsigned og = *(const unsigned*)(Z + r * ZW + 2560 + c0);
      *(unsigned*)(YB + r * 512 + c0) = pack2(h0 * rs * g.x * sigmoidf_(lo16(og)), h1 * rs * g.y * sigmoidf_(hi16(og)));
    }
    {
      const unsigned u = *(const unsigned*)(Z + r * ZW + 3072 + c0);
      float2 d = *(const float2*)(p.in[I_S5D] + l * 512 + c0);
      float2 f = *(const float2*)(YSF + r * 512 + c0);
      float2 b = *(const float2*)(YSB + r * 512 + c0);
      *(unsigned*)(GG + r * 512 + c0) = pack2(geluf_(d.x * lo16(u) + f.x + b.x), geluf_(d.y * hi16(u) + f.y + b.y));
    }
  }
}

__device__ __forceinline__ void stage_glu_mfma(const Params& p, int l, int tpb, const bf16_t* GG, const bf16_t* GLUT, bf16_t* YS, char* smem) {
  EPI_DECL
  const int tm = GB * tpb;
  for (int t = blockIdx.x; t < tm * 4; t += gridDim.x) {
    const int m0 = MT_LR0(t >> 2, tpb), n0 = (t & 3) * 128;
    f32x16 acc[2][2];
    gemm_tile(GG + (size_t)m0 * 512, 512, GLUT + (size_t)n0 * 512, 512, 512, smem, acc);
#pragma unroll
    for (int mi = 0; mi < 2; ++mi)
#pragma unroll
      for (int ni = 0; ni < 2; ++ni)
#pragma unroll
        for (int q = 0; q < 4; ++q) {
          const int row = m0 + EPI_ROW(mi), c = n0 + EPI_COL(ni, q);
          const float4 b = *(const float4*)(p.in[I_GLUB] + l * 512 + c);
          const u32x2 g2 = *(const u32x2*)(GG + (size_t)row * 512 + c);
          const float o0 = lo16(g2[0]) * sigmoidf_(acc[mi][ni][4 * q] + b.x), o1 = hi16(g2[0]) * sigmoidf_(acc[mi][ni][4 * q + 1] + b.y);
          const float o2 = lo16(g2[1]) * sigmoidf_(acc[mi][ni][4 * q + 2] + b.z), o3 = hi16(g2[1]) * sigmoidf_(acc[mi][ni][4 * q + 3] + b.w);
          *(u32x2*)(YS + (size_t)row * 512 + c) = (u32x2){pack2(o0, o1), pack2(o2, o3)};
        }
  }
}

__device__ __forceinline__ void stage_merge_mfma(int tpb, const bf16_t* YA, const bf16_t* YB, const bf16_t* YS, const bf16_t* WBR, const bf16_t* Z, bf16_t* MG, char* smem) {
  EPI_DECL
  const int tm = GB * tpb;
  for (int t = blockIdx.x; t < tm * 8; t += gridDim.x) {
    const int m0 = MT_LR0(t >> 3, tpb), n0 = (t & 7) * 128;
    f32x16 macc[2][2];
#pragma unroll
    for (int a = 0; a < 2; ++a)
#pragma unroll
      for (int b = 0; b < 2; ++b)
#pragma unroll
        for (int i = 0; i < 16; ++i) macc[a][b][i] = 0.f;
#pragma unroll 1
    for (int r = 0; r < 3; ++r) {
      const bf16_t* Y = (r == 0) ? YA : (r == 1 ? YB : YS);
      f32x16 acc[2][2];
      gemm_tile(Y + (size_t)m0 * 512, 512, WBR + (size_t)r * 1024 * 512 + (size_t)n0 * 512, 512, 512, smem, acc);
#pragma unroll
      for (int mi = 0; mi < 2; ++mi)
#pragma unroll
        for (int ni = 0; ni < 2; ++ni)
#pragma unroll
          for (int q = 0; q < 4; ++q) {
            const int row = m0 + EPI_ROW(mi), c = n0 + EPI_COL(ni, q);
            const u32x2 e = *(const u32x2*)(Z + (size_t)row * ZW + 3584 + r * 1024 + c);
            macc[mi][ni][4 * q] += lo16(e[0]) * acc[mi][ni][4 * q];
            macc[mi][ni][4 * q + 1] += hi16(e[0]) * acc[mi][ni][4 * q + 1];
            macc[mi][ni][4 * q + 2] += lo16(e[1]) * acc[mi][ni][4 * q + 2];
            macc[mi][ni][4 * q + 3] += hi16(e[1]) * acc[mi][ni][4 * q + 3];
          }
    }
#pragma unroll
    for (int mi = 0; mi < 2; ++mi)
#pragma unroll
      for (int ni = 0; ni < 2; ++ni)
#pragma unroll
        for (int q = 0; q < 4; ++q) {
          const int row = m0 + EPI_ROW(mi), c = n0 + EPI_COL(ni, q);
          *(u32x2*)(MG + (size_t)row * DM + c) = (u32x2){pack2(macc[mi][ni][4 * q], macc[mi][ni][4 * q + 1]), pack2(macc[mi][ni][4 * q + 2], macc[mi][ni][4 * q + 3])};
        }
  }
}

__device__ __forceinline__ void stage_outproj_mfma(const Params& p, int l, int g, int tpb, const bf16_t* MG, const bf16_t* WOUT, char* smem) {
  EPI_DECL
  const int tm = GB * tpb;
  const float* mod = (const float*)(p.ws + WB_MOD) + (size_t)l * 9 * 6144;
  for (int t = blockIdx.x; t < tm * 8; t += gridDim.x) {
    const int mt = t >> 3, n0 = (t & 7) * 128;
    const int m0 = MT_LR0(mt, tpb), bl = mt / tpb, rr0 = (mt % tpb) * 128, b = g * GB + bl;
    f32x16 acc[2][2];
    gemm_tile(MG + (size_t)m0 * DM, DM, WOUT + (size_t)n0 * DM, DM, DM, smem, acc);
    const float* gv = mod + (size_t)((rr0 < NLAT) ? b : 8) * 6144 + 2 * 1024;
#pragma unroll
    for (int mi = 0; mi < 2; ++mi)
#pragma unroll
      for (int ni = 0; ni < 2; ++ni)
#pragma unroll
        for (int q = 0; q < 4; ++q) {
          const int rr = rr0 + EPI_ROW(mi), c = n0 + EPI_COL(ni, q);
          const float4 gg = *(const float4*)(gv + c);
          float4* xp = (float4*)(xrow(p, b, rr) + c);
          float4 x = *xp;
          x.x += gg.x * acc[mi][ni][4 * q]; x.y += gg.y * acc[mi][ni][4 * q + 1]; x.z += gg.z * acc[mi][ni][4 * q + 2]; x.w += gg.w * acc[mi][ni][4 * q + 3];
          *xp = x;
        }
  }
}

__device__ __forceinline__ void stage_peerq_mfma(int tpb, const bf16_t* H2, const bf16_t* WQ, bf16_t* PQ, char* smem) {
  EPI_DECL
  const int tm = GB * tpb;
  for (int t = blockIdx.x; t < tm * 16; t += gridDim.x) {
    const int m0 = MT_LR0(t >> 4, tpb), n0 = (t & 15) * 128;
    f32x16 acc[2][2];
    gemm_tile(H2 + (size_t)m0 * DM, DM, WQ + (size_t)n0 * DM, DM, DM, smem, acc);
#pragma unroll
    for (int mi = 0; mi < 2; ++mi)
#pragma unroll
      for (int ni = 0; ni < 2; ++ni)
#pragma unroll
        for (int q = 0; q < 4; ++q) {
          const int row = m0 + EPI_ROW(mi), c = n0 + EPI_COL(ni, q);
          *(u32x2*)(PQ + (size_t)row * 2048 + c) = (u32x2){pack2(acc[mi][ni][4 * q], acc[mi][ni][4 * q + 1]), pack2(acc[mi][ni][4 * q + 2], acc[mi][ni][4 * q + 3])};
        }
  }
}

__device__ __forceinline__ void stage_scores_mfma(int tpb, const bf16_t* PQ, const bf16_t* SUBK, float* SC, char* smem) {
  EPI_DECL
  const int tm = GB * tpb * 8;
  for (int t = blockIdx.x; t < tm * 2; t += gridDim.x) {
    const int mt = t >> 1, half = t & 1;
    const size_t m0 = (size_t)MT_LR0(mt >> 3, tpb) * 8 + (size_t)(mt & 7) * 128;
    f32x16 acc[2][2];
    gemm_tile(PQ + m0 * 256 + half * 128, 256, SUBK + (size_t)half * 16384, 128, 128, smem, acc);
#pragma unroll
    for (int mi = 0; mi < 2; ++mi)
#pragma unroll
      for (int ni = 0; ni < 2; ++ni)
#pragma unroll
        for (int q = 0; q < 4; ++q) {
          const size_t row = m0 + EPI_ROW(mi);
          const int c = EPI_COL(ni, q);
          *(float4*)(SC + row * 256 + half * 128 + c) = make_float4(acc[mi][ni][4 * q], acc[mi][ni][4 * q + 1], acc[mi][ni][4 * q + 2], acc[mi][ni][4 * q + 3]);
        }
  }
}

__device__ __forceinline__ void wave_argmax(float& v, int& idx) {
#pragma unroll
  for (int o = 32; o > 0; o >>= 1) {
    float ov = __shfl_xor(v, o);
    int oi = __shfl_xor(idx, o);
    if (ov > v || (ov == v && oi < idx)) { v = ov; idx = oi; }
  }
}
__device__ __forceinline__ void stage_topk(int rr_lim, const float* SC, int* EI, float* EG) {
  const int tid = otid(), w = tid >> 6, lane = tid & 63;
  const int nth = GB * rr_lim * 8;
  for (int i = blockIdx.x * 4 + w; i < nth; i += gridDim.x * 4) {
    const int tok = i >> 3, hh = i & 7;
    const size_t th = ((size_t)(tok / rr_lim) * NTOK + (tok % rr_lim)) * 8 + hh;
    const float* s = SC + th * 256;
    float myv[2] = {0.f, 0.f};
    int myi[2] = {0, 0};
#pragma unroll
    for (int half = 0; half < 2; ++half) {
      float a0 = s[half * 128 + lane], a1 = s[half * 128 + 64 + lane];
      for (int r = 0; r < 16; ++r) {
        float v; int idx;
        if (a0 >= a1) { v = a0; idx = lane; } else { v = a1; idx = lane + 64; }
        wave_argmax(v, idx);
        if (idx == lane) a0 = -INFINITY;
        if (idx == lane + 64) a1 = -INFINITY;
        if (lane == r) { myv[half] = v; myi[half] = idx; }
      }
    }
    float cv[4];
    const float v1 = __shfl(myv[0], lane >> 2);
#pragma unroll
    for (int q = 0; q < 4; ++q) cv[q] = v1 + __shfl(myv[1], (lane & 3) * 4 + q);
    float tv = 0.f; int tc = 0;
    for (int r = 0; r < 16; ++r) {
      float v = cv[0]; int idx = lane * 4;
#pragma unroll
      for (int q = 1; q < 4; ++q) if (cv[q] > v) { v = cv[q]; idx = lane * 4 + q; }
      wave_argmax(v, idx);
#pragma unroll
      for (int q = 0; q < 4; ++q) if (idx == lane * 4 + q) cv[q] = -INFINITY;
      if (lane == r) { tv = v; tc = idx; }
    }
    const int e1 = __shfl(myi[0], tc >> 4);
    const int e2 = __shfl(myi[1], tc & 15);
    const float vmax = __shfl(tv, 0);
    float ex = (lane < 16) ? expf(tv - vmax) : 0.f;
    float sum = wave_sum(ex);
    if (lane < 16) {
      EI[th * 16 + lane] = e1 * 128 + e2;
      EG[th * 16 + lane] = ex / sum;
    }
  }
}

__device__ __forceinline__ void stage_expert(const Params& p, int l, int g, int rr_lim, const bf16_t* H2, const int* EI, const float* EG, float* smem) {
  const int tid = otid(), w = tid >> 6, lane = tid & 63;
  float* coef = smem;
  int* eid = (int*)(smem + 128);
  const float* U = p.in[I_PU] + (size_t)l * 16384 * 1024;
  const float* V = p.in[I_PV] + (size_t)l * 16384 * 1024;
  const float* mod = (const float*)(p.ws + WB_MOD) + (size_t)l * 9 * 6144;
  for (int i = blockIdx.x; i < GB * rr_lim; i += gridDim.x) {
    const int bl = i / rr_lim, rr = i % rr_lim, b = g * GB + bl;
    const size_t t = (size_t)bl * NTOK + rr;
    __syncthreads();
    float4 hv[4];
#pragma unroll
    for (int q = 0; q < 4; ++q) { const u32x2 u2 = ((const u32x2*)(H2 + t * DM))[q * 64 + lane]; hv[q] = make_float4(lo16(u2[0]), hi16(u2[0]), lo16(u2[1]), hi16(u2[1])); }
#pragma unroll 4
    for (int k = w * 32; k < w * 32 + 32; ++k) {
      const int e = EI[t * 128 + k];
      const float4* up = (const float4*)(U + (size_t)e * 1024);
      float a = 0.f;
#pragma unroll
      for (int q = 0; q < 4; ++q) {
        float4 uv = up[q * 64 + lane];
        a = fmaf(hv[q].x, uv.x, a); a = fmaf(hv[q].y, uv.y, a); a = fmaf(hv[q].z, uv.z, a); a = fmaf(hv[q].w, uv.w, a);
      }
      a = wave_sum(a);
      if (lane == 0) { coef[k] = EG[t * 128 + k] * geluf_(a); eid[k] = e; }
    }
    __syncthreads();
    float4 acc = make_float4(0.f, 0.f, 0.f, 0.f);
#pragma unroll 8
    for (int k = 0; k < 128; ++k) {
      const float cf = coef[k];
      float4 vv = ((const float4*)(V + (size_t)eid[k] * 1024))[tid];
      acc.x = fmaf(cf, vv.x, acc.x); acc.y = fmaf(cf, vv.y, acc.y); acc.z = fmaf(cf, vv.z, acc.z); acc.w = fmaf(cf, vv.w, acc.w);
    }
    const float4 g2 = ((const float4*)(mod + (size_t)((rr < NLAT) ? b : 8) * 6144 + 5 * 1024))[tid];
    float4* xp = (float4*)xrow(p, b, rr) + tid;
    float4 xv = *xp;
    xv.x += g2.x * acc.x; xv.y += g2.y * acc.y; xv.z += g2.z * acc.z; xv.w += g2.w * acc.w;
    *xp = xv;
  }
  __syncthreads();
}

__device__ __forceinline__ void stage_final(const Params& p, float* smem) {
  const int tid = otid();
  for (int r = blockIdx.x; r < NB * NLAT; r += gridDim.x) {
    float4* xp = (float4*)(p.out + (size_t)r * DM) + tid;
    float4 v = *xp;
    float s = wave_sum(v.x * v.x + v.y * v.y + v.z * v.z + v.w * v.w);
    __syncthreads();
    if ((tid & 63) == 0) smem[tid >> 6] = s;
    __syncthreads();
    float rs = rsqrtf((smem[0] + smem[1] + smem[2] + smem[3]) * (1.0f / DM) + EPSF);
    float4 g = ((const float4*)p.in[I_FG])[tid];
    *xp = make_float4(v.x * rs * g.x, v.y * rs * g.y, v.z * rs * g.z, v.w * rs * g.w);
  }
}

__global__ void __launch_bounds__(256) mega(Params p) {
  cg::grid_group grid = cg::this_grid();
  __shared__ __attribute__((aligned(16))) float smem[SMEM_FLOATS];
  char* smc = (char*)smem;
  char* ws = p.ws;
  bf16_t* H = (bf16_t*)(ws + WB_H); bf16_t* Z = (bf16_t*)(ws + WB_Z); float* MGT = (float*)(ws + WB_MGT); bf16_t* XC = (bf16_t*)(ws + WB_XC);
  float* QM = (float*)(ws + WB_QM); float* KM = (float*)(ws + WB_KM); float* HF = (float*)(ws + WB_HF); float* HB = (float*)(ws + WB_HB);
  float* OA = (float*)(ws + WB_OA); float* YSF = (float*)(ws + WB_YSF); float* YSB = (float*)(ws + WB_YSB);
  bf16_t* YA = (bf16_t*)(ws + WB_YA); bf16_t* YB = (bf16_t*)(ws + WB_YB); bf16_t* YS = (bf16_t*)(ws + WB_YS); bf16_t* GG = (bf16_t*)(ws + WB_GG);
  bf16_t* MG = (bf16_t*)(ws + WB_MG); bf16_t* PQ = (bf16_t*)(ws + WB_PQ); float* SC = (float*)(ws + WB_SC);
  int* EI = (int*)(ws + WB_EI); float* EG = (float*)(ws + WB_EG);
  const bf16_t* WT = (const bf16_t*)(ws + WB_WT);

  stage_init(p, smem);
  grid.sync();

  for (int l = 0; l < 2; ++l) {
    const bool need_ctx = (l == 0);
    const int rr_lim = need_ctx ? NTOK : NLAT;
    const int tpb = need_ctx ? 34 : 32;
    const bf16_t* W = WT + (size_t)l * WT_LAYER;
    for (int g = 0; g < NG; ++g) {
      stage_normmod(p, l, g, 0, NTOK, H, smem);
      grid.sync();
      stage_inproj(p, H, W + WT_WIN, Z, MGT, smc);
      grid.sync();
      stage_conv(p, l, Z, XC);
      grid.sync();
      stage_mlqk(XC, W + WT_WQK, QM, KM, smc);
      grid.sync();
      {
        const int n_attn = 4 * 64 + (need_ctx ? 4 * 4 : 0);
        const int n_items = GB * (40 + n_attn);
        for (int it = blockIdx.x; it < n_items; it += gridDim.x) {
          int bl, k;
          if (it < GB * 8) { bl = it / 8; k = it % 8; }
          else if (it < GB * 40) { bl = (it - GB * 8) / 32; k = 8 + (it - GB * 8) % 32; }
          else { bl = (it - GB * 40) / n_attn; k = 40 + (it - GB * 40) % n_attn; }
          const bf16_t* Zb = Z + (size_t)bl * NTOK * ZW;
          const size_t ro = (size_t)bl * NTOK;
          if (k < 8) {
            mlstm_item(p, l, Zb, MGT + ro * 16, QM + ro * 512, KM + ro * 512, ((k >> 2) ? HB : HF) + ro * 512, k & 3, k >> 2, smem);
          } else if (k < 40) {
            s5_item(p, l, Zb, YSF + ro * 512, YSB + ro * 512, k - 8, smem);
          } else if (k < 40 + 256) {
            const int a = k - 40;
            attn_item(Zb, OA + ro * 512, a & 3, (a >> 2) * 64, 0, NTOK, smem);
          } else {
            const int a = k - 40 - 256;
            attn_item(Zb, OA + ro * 512, a & 3, NLAT + (a >> 2) * 64, NLAT, NCTX, smem);
          }
        }
      }
      grid.sync();
      stage_post(p, l, rr_lim, Z, OA, HF, HB, YSF, YSB, YA, YB, GG);
      grid.sync();
      stage_glu_mfma(p, l, tpb, GG, W + WT_GLU, YS, smc);
      grid.sync();
      stage_merge_mfma(tpb, YA, YB, YS, W + WT_WBR, Z, MG, smc);
      grid.sync();
      stage_outproj_mfma(p, l, g, tpb, MG, W + WT_WOUT, smc);
      grid.sync();
      stage_normmod(p, l, g, 1, rr_lim, H, smem);
      grid.sync();
      stage_peerq_mfma(tpb, H, W + WT_WQ, PQ, smc);
      grid.sync();
      stage_scores_mfma(tpb, PQ, W + WT_SUBK, SC, smc);
      grid.sync();
      stage_topk(rr_lim, SC, EI, EG);
      grid.sync();
      stage_expert(p, l, g, rr_lim, H, EI, EG, smem);
      grid.sync();
    }
  }
  stage_final(p, smem);
}

extern "C" void kernel_launch(void* const* d_in, const int* in_sizes, int n_in, void* d_out,
                              int out_size, void* d_ws, size_t ws_size, hipStream_t stream) {
  static int grid_blocks = 0;
  if (!grid_blocks) {
    int dev = 0, cus = 0, per_cu = 0;
    (void)hipGetDevice(&dev);
    (void)hipDeviceGetAttribute(&cus, hipDeviceAttributeMultiprocessorCount, dev);
    (void)hipOccupancyMaxActiveBlocksPerMultiprocessor(&per_cu, mega, 256, 0);
    if (per_cu > 1) per_cu = 1;
    grid_blocks = cus * per_cu;
  }
  if (ws_size < WB_END) {
    fprintf(stderr, "workspace too small: %zu < %zu\n", ws_size, (size_t)WB_END);
    return;
  }
  Params p{};
  for (int i = 0; i < N_IN; ++i) p.in[i] = (const float*)d_in[i];
  p.out = (float*)d_out;
  p.ws = (char*)d_ws;
  void* args[] = {&p};
  hipError_t e = hipLaunchCooperativeKernel((void*)mega, dim3(grid_blocks), dim3(256), args, 0, stream);
  if (e != hipSuccess) fprintf(stderr, "cooperative launch failed: %s (grid %d)\n", hipGetErrorString(e), grid_blocks);
}
```

```cpp
#include <hip/hip_runtime.h>
#include <hip/hip_cooperative_groups.h>
#include <cstdio>
#include <cstdint>
namespace cg = cooperative_groups;

#define NLAT 4096
#define NCTX 256
#define NTOK 4352
#define DM 1024
#define INW 6672
#define NB 8
#define GB 2
#define NG (NB / GB)
#define RPG (GB * NTOK)
#define ZW 6656
#define EPSF 1e-6f

enum { I_X = 0, I_C, I_CTX, I_CCTX, I_WMOD, I_BMOD, I_N1G, I_N2G, I_WIN, I_LQ1, I_LK1, I_LQ2, I_LK2, I_SUBG,
       I_CONVW, I_CONVB, I_MLWQ, I_MLWK, I_GATEB, I_MLNG, I_S5LRE, I_S5LIM, I_S5DT, I_S5BRE, I_S5BIM,
       I_S5CRE, I_S5CIM, I_S5D, I_GLUW, I_GLUB, I_WBR, I_WOUT, I_PWQ, I_PSUBK, I_PU, I_PV, I_FG, N_IN };

struct Params {
  const float* in[N_IN];
  float* out;
  char* ws;
};

typedef unsigned short bf16_t;
typedef short bf16x8 __attribute__((ext_vector_type(8)));
typedef float f32x16 __attribute__((ext_vector_type(16)));
typedef unsigned u32x4 __attribute__((ext_vector_type(4)));
typedef unsigned u32x2 __attribute__((ext_vector_type(2)));

#define AL(x) (((x) + 255) & ~(size_t)255)
#define WB_XCX   ((size_t)0)
#define WB_MOD   AL(WB_XCX + (size_t)NB * NCTX * DM * 4)
#define WB_ROPE  AL(WB_MOD + (size_t)2 * 9 * 6144 * 4)
#define WB_WT    AL(WB_ROPE + (size_t)NLAT * 32 * 2 * 4)
#define WT_WIN   ((size_t)0)
#define WT_WQK   (WT_WIN + (size_t)6784 * 1024)
#define WT_GLU   (WT_WQK + (size_t)4 * 256 * 128)
#define WT_WBR   (WT_GLU + (size_t)512 * 512)
#define WT_WOUT  (WT_WBR + (size_t)3 * 1024 * 512)
#define WT_WQ    (WT_WOUT + (size_t)1024 * 1024)
#define WT_SUBK  (WT_WQ + (size_t)2048 * 1024)
#define WT_LAYER (WT_SUBK + (size_t)2 * 128 * 128)
#define WB_H     AL(WB_WT + WT_LAYER * 2 * 2)
#define WB_Z     AL(WB_H + (size_t)RPG * DM * 2)
#define WB_MGT   AL(WB_Z + (size_t)RPG * ZW * 2)
#define WB_XC    AL(WB_MGT + (size_t)RPG * 16 * 4)
#define WB_QM    AL(WB_XC + (size_t)RPG * 512 * 2)
#define WB_KM    AL(WB_QM + (size_t)RPG * 512 * 4)
#define WB_HF    AL(WB_KM + (size_t)RPG * 512 * 4)
#define WB_HB    AL(WB_HF + (size_t)RPG * 512 * 4)
#define WB_OA    AL(WB_HB + (size_t)RPG * 512 * 4)
#define WB_YSF   AL(WB_OA + (size_t)2 * RPG * 512 * 4)
#define WB_YSB   AL(WB_YSF + (size_t)RPG * 512 * 4)
#define WB_YA    AL(WB_YSB + (size_t)RPG * 512 * 4)
#define WB_YB    AL(WB_YA + (size_t)RPG * 512 * 2)
#define WB_YS    AL(WB_YB + (size_t)RPG * 512 * 2)
#define WB_GG    AL(WB_YS + (size_t)RPG * 512 * 2)
#define WB_MG    AL(WB_GG + (size_t)RPG * 512 * 2)
#define WB_EI    AL(WB_MG + (size_t)RPG * DM * 2)
#define WB_EG    AL(WB_EI + (size_t)RPG * 128 * 4)
#define WB_U16   AL(WB_EG + (size_t)RPG * 128 * 4)
#define WB_V16   AL(WB_U16 + (size_t)2 * 16384 * 1024 * 2)
#define WB_VT    AL(WB_V16 + (size_t)2 * 16384 * 1024 * 2)
#define WB_CNT   AL(WB_VT + (size_t)GB * 4 * 128 * NTOK * 2)
#define WB_END   AL(WB_CNT + 256)
#define WB_PQ    (WB_Z)
#define WB_SC    AL(WB_PQ + (size_t)RPG * 2048 * 2)

#define SMEM_FLOATS (24 * 1024)

__device__ __forceinline__ float sigmoidf_(float x) { return 1.0f / (1.0f + expf(-x)); }
__device__ __forceinline__ float siluf_(float x) { return x / (1.0f + expf(-x)); }
__device__ __forceinline__ float geluf_(float x) { return 0.5f * x * (1.0f + erff(x * 0.70710678118654752f)); }
__device__ __forceinline__ int otid() { int t = threadIdx.x; asm volatile("" : "+v"(t)); return t; }
__device__ __forceinline__ float wave_sum(float v) {
  for (int o = 32; o > 0; o >>= 1) v += __shfl_xor(v, o);
  return v;
}
__device__ __forceinline__ bf16_t f2bf(float x) { unsigned u = __float_as_uint(x); u += 0x7fffu + ((u >> 16) & 1u); return (bf16_t)(u >> 16); }
__device__ __forceinline__ float bf2f(bf16_t h) { return __uint_as_float(((unsigned)h) << 16); }
typedef float f32x2 __attribute__((ext_vector_type(2)));
typedef __bf16 bf16x2_t __attribute__((ext_vector_type(2)));
__device__ __forceinline__ unsigned pack2(float a, float b) { f32x2 v = {a, b}; return __builtin_bit_cast(unsigned, __builtin_convertvector(v, bf16x2_t)); }
__device__ __forceinline__ float lo16(unsigned u) { return __uint_as_float(u << 16); }
__device__ __forceinline__ float hi16(unsigned u) { return __uint_as_float(u & 0xffff0000u); }

__device__ __forceinline__ float* xrow(const Params& p, int b, int rr) {
  return (rr < NLAT) ? p.out + ((size_t)b * NLAT + rr) * DM : (float*)(p.ws + WB_XCX) + ((size_t)b * NCTX + (rr - NLAT)) * DM;
}

__device__ __forceinline__ void gemm_tile(const bf16_t* __restrict__ Ag, int lda, const bf16_t* __restrict__ Bg, int ldb, int K,
                                          char* smem, f32x16 (&acc)[2][2]) {
  const int tid = otid(), lane = tid & 63, w = tid >> 6, wm = w >> 1, wn = w & 1;
#pragma unroll
  for (int a = 0; a < 2; ++a)
#pragma unroll
    for (int b = 0; b < 2; ++b)
#pragma unroll
      for (int i = 0; i < 16; ++i) acc[a][b][i] = 0.f;
  const int srow = tid >> 3, sch = tid & 7;
  const bf16_t* ap = Ag + (size_t)srow * lda + sch * 8;
  const bf16_t* bp = Bg + (size_t)srow * ldb + sch * 8;
  const int wofs = srow * 128 + ((sch ^ ((srow >> 1) & 7)) << 4);
  const int fr = lane & 31, fh = lane >> 5, fsw = (fr >> 1) & 7;
  const int aofs = (wm * 64 + fr) * 128, bofs = 16384 + (wn * 64 + fr) * 128;
  u32x4 ra[4], rb[4];
  const int nk = K >> 6;
#pragma unroll
  for (int i = 0; i < 4; ++i) {
    ra[i] = *(const u32x4*)(ap + (size_t)i * 32 * lda);
    rb[i] = *(const u32x4*)(bp + (size_t)i * 32 * ldb);
  }
  __syncthreads();
#pragma unroll
  for (int i = 0; i < 4; ++i) {
    *(u32x4*)(smem + wofs + i * 4096) = ra[i];
    *(u32x4*)(smem + 16384 + wofs + i * 4096) = rb[i];
  }
  __syncthreads();
  for (int kt = 0; kt < nk; ++kt) {
    const bool more = (kt + 1 < nk);
    if (more) {
#pragma unroll
      for (int i = 0; i < 4; ++i) {
        ra[i] = *(const u32x4*)(ap + (size_t)i * 32 * lda + (kt + 1) * 64);
        rb[i] = *(const u32x4*)(bp + (size_t)i * 32 * ldb + (kt + 1) * 64);
      }
    }
    const char* base = smem + (kt & 1) * 32768;
#pragma unroll
    for (int ks = 0; ks < 4; ++ks) {
      const int coff = ((ks * 2 + fh) ^ fsw) << 4;
      bf16x8 af[2], bfr[2];
#pragma unroll
      for (int mi = 0; mi < 2; ++mi) af[mi] = *(const bf16x8*)(base + aofs + mi * 4096 + coff);
#pragma unroll
      for (int ni = 0; ni < 2; ++ni) bfr[ni] = *(const bf16x8*)(base + bofs + ni * 4096 + coff);
#pragma unroll
      for (int mi = 0; mi < 2; ++mi)
#pragma unroll
        for (int ni = 0; ni < 2; ++ni)
          acc[mi][ni] = __builtin_amdgcn_mfma_f32_32x32x16_bf16(bfr[ni], af[mi], acc[mi][ni], 0, 0, 0);
    }
    if (more) {
      char* nb = smem + ((kt + 1) & 1) * 32768;
#pragma unroll
      for (int i = 0; i < 4; ++i) {
        *(u32x4*)(nb + wofs + i * 4096) = ra[i];
        *(u32x4*)(nb + 16384 + wofs + i * 4096) = rb[i];
      }
    }
    __syncthreads();
  }
}
#define EPI_DECL const int tid_ = otid(); const int lane = tid_ & 63, w_ = tid_ >> 6, wm = w_ >> 1, wn = w_ & 1, fr = lane & 31, fh = lane >> 5; (void)fr; (void)fh; (void)wm; (void)wn;
#define EPI_ROW(mi) (wm * 64 + (mi) * 32 + fr)
#define EPI_COL(ni, q) (wn * 64 + (ni) * 32 + 8 * (q) + 4 * fh)
#define MT_LR0(mt, tpb) (((mt) / (tpb)) * NTOK + ((mt) % (tpb)) * 128)

template <class F>
__device__ __forceinline__ void transpose_cvt(const float* __restrict__ src, int ld, F srccol, int K, int Ndst, bf16_t* __restrict__ dst, float* smem) {
  float (*T)[65] = (float (*)[65])smem;
  const int tid = otid();
  const int tk = K >> 6, tn = Ndst >> 6;
  for (int t = blockIdx.x; t < tn * tk; t += gridDim.x) {
    const int n0 = (t / tk) * 64, k0 = (t % tk) * 64;
    __syncthreads();
    const int sc = srccol(n0 + (tid & 63));
#pragma unroll
    for (int i = 0; i < 16; ++i) {
      const int ky = (tid >> 6) + 4 * i;
      T[ky][tid & 63] = (sc >= 0) ? src[(size_t)(k0 + ky) * ld + sc] : 0.f;
    }
    __syncthreads();
#pragma unroll
    for (int i = 0; i < 16; ++i) {
      const int ny = (tid >> 6) + 4 * i;
      dst[(size_t)(n0 + ny) * K + k0 + (tid & 63)] = f2bf(T[tid & 63][ny]);
    }
  }
  __syncthreads();
}
__device__ __forceinline__ int win_srccol(int n) {
  if (n < 3072) return n;
  if (n < 6656) return n + 16;
  if (n < 6672) return n - 3584;
  return -1;
}

__device__ __forceinline__ void stage_init(const Params& p, float* smem) {
  const int tid = otid();
  {
    const size_t n4 = (size_t)NB * NLAT * 256;
    const float4* s = (const float4*)p.in[I_X];
    float4* d = (float4*)p.out;
    for (size_t i = (size_t)blockIdx.x * 256 + tid; i < n4; i += (size_t)gridDim.x * 256) d[i] = s[i];
    const size_t m4 = (size_t)NB * NCTX * 256;
    const float4* s2 = (const float4*)p.in[I_CTX];
    float4* d2 = (float4*)(p.ws + WB_XCX);
    for (size_t i = (size_t)blockIdx.x * 256 + tid; i < m4; i += (size_t)gridDim.x * 256) d2[i] = s2[i];
  }
  if (blockIdx.x == 0 && tid < 64) ((int*)(p.ws + WB_CNT))[tid] = 0;
  {
    const size_t n8 = (size_t)2 * 16384 * 1024 / 8;
    const float4* su = (const float4*)p.in[I_PU];
    const float4* sv = (const float4*)p.in[I_PV];
    u32x4* du = (u32x4*)(p.ws + WB_U16);
    u32x4* dv = (u32x4*)(p.ws + WB_V16);
    for (size_t i = (size_t)blockIdx.x * 256 + tid; i < n8; i += (size_t)gridDim.x * 256) {
      const float4 a = su[2 * i], b = su[2 * i + 1];
      du[i] = (u32x4){pack2(a.x, a.y), pack2(a.z, a.w), pack2(b.x, b.y), pack2(b.z, b.w)};
      const float4 c = sv[2 * i], d = sv[2 * i + 1];
      dv[i] = (u32x4){pack2(c.x, c.y), pack2(c.z, c.w), pack2(d.x, d.y), pack2(d.z, d.w)};
    }
  }
  {
    float2* rt = (float2*)(p.ws + WB_ROPE);
    for (int i = blockIdx.x * 256 + tid; i < NLAT * 32; i += gridDim.x * 256) {
      const int pos = i >> 5, j = i & 31;
      const float inv = powf(10000.0f, -(float)(j & 15) / 16.0f);
      const float ang = (float)((j < 16) ? (pos >> 6) : (pos & 63)) * inv;
      rt[i] = make_float2(cosf(ang), sinf(ang));
    }
  }
  {
    float* sc = smem;
    for (int i = tid; i < 9 * 1024; i += 256) {
      int r = i >> 10, k = i & 1023;
      float v = (r < 8) ? p.in[I_C][r * 1024 + k] : p.in[I_CCTX][k];
      sc[i] = siluf_(v);
    }
    __syncthreads();
    float* mod = (float*)(p.ws + WB_MOD);
    for (int col = blockIdx.x * 256 + tid; col < 2 * 6144; col += gridDim.x * 256) {
      int l = col / 6144, j = col % 6144;
      const float* w = p.in[I_WMOD] + (size_t)l * 1024 * 6144 + j;
      float acc[9];
#pragma unroll
      for (int r = 0; r < 9; ++r) acc[r] = 0.f;
      for (int k = 0; k < 1024; ++k) {
        float wv = w[(size_t)k * 6144];
#pragma unroll
        for (int r = 0; r < 9; ++r) acc[r] = fmaf(sc[r * 1024 + k], wv, acc[r]);
      }
      float bv = p.in[I_BMOD][l * 6144 + j];
#pragma unroll
      for (int r = 0; r < 9; ++r) mod[((size_t)l * 9 + r) * 6144 + j] = acc[r] + bv;
    }
    __syncthreads();
  }
  bf16_t* WT = (bf16_t*)(p.ws + WB_WT);
  for (int l = 0; l < 2; ++l) {
    bf16_t* W = WT + (size_t)l * WT_LAYER;
    transpose_cvt(p.in[I_WIN] + (size_t)l * DM * INW, INW, [](int n) { return win_srccol(n); }, DM, 6784, W + WT_WIN, smem);
    for (int h = 0; h < 4; ++h) {
      transpose_cvt(p.in[I_MLWQ] + ((size_t)l * 4 + h) * 16384, 128, [](int n) { return n; }, 128, 128, W + WT_WQK + (size_t)h * 256 * 128, smem);
      transpose_cvt(p.in[I_MLWK] + ((size_t)l * 4 + h) * 16384, 128, [](int n) { return n; }, 128, 128, W + WT_WQK + (size_t)h * 256 * 128 + 128 * 128, smem);
    }
    transpose_cvt(p.in[I_GLUW] + (size_t)l * 512 * 512, 512, [](int n) { return n; }, 512, 512, W + WT_GLU, smem);
    for (int r = 0; r < 3; ++r)
      transpose_cvt(p.in[I_WBR] + ((size_t)l * 3 + r) * 512 * DM, DM, [](int n) { return n; }, 512, DM, W + WT_WBR + (size_t)r * 1024 * 512, smem);
    transpose_cvt(p.in[I_WOUT] + (size_t)l * DM * DM, DM, [](int n) { return n; }, DM, DM, W + WT_WOUT, smem);
    transpose_cvt(p.in[I_PWQ] + (size_t)l * DM * 2048, 2048, [](int n) { return n; }, DM, 2048, W + WT_WQ, smem);
    const float* sk = p.in[I_PSUBK] + (size_t)l * 2 * 128 * 128;
    for (int i = blockIdx.x * 256 + tid; i < 2 * 128 * 128; i += gridDim.x * 256) W[WT_SUBK + i] = f2bf(sk[i]);
  }
}

__device__ __forceinline__ void stage_normmod(const Params& p, int l, int g, int which, int rr_lim, bf16_t* H, float* smem) {
  const int tid = otid();
  const float* ng = p.in[which ? I_N2G : I_N1G] + l * DM;
  const float* mod = (const float*)(p.ws + WB_MOD) + (size_t)l * 9 * 6144;
  const int off_sh = which ? 3072 : 0, off_sc = which ? 4096 : 1024;
  const int per = rr_lim;
  for (int i = blockIdx.x; i < GB * per; i += gridDim.x) {
    const int bl = i / per, rr = i % per, b = g * GB + bl;
    const float* X = xrow(p, b, rr);
    float4 v = ((const float4*)X)[tid];
    float s = wave_sum(v.x * v.x + v.y * v.y + v.z * v.z + v.w * v.w);
    __syncthreads();
    if ((tid & 63) == 0) smem[tid >> 6] = s;
    __syncthreads();
    float tot = smem[0] + smem[1] + smem[2] + smem[3];
    float rs = rsqrtf(tot * (1.0f / DM) + EPSF);
    const float* m = mod + (size_t)((rr < NLAT) ? b : 8) * 6144;
    float4 gg = ((const float4*)ng)[tid];
    float4 sc = ((const float4*)(m + off_sc))[tid];
    float4 sh = ((const float4*)(m + off_sh))[tid];
    float4 o;
    o.x = v.x * rs * gg.x * (1.f + sc.x) + sh.x;
    o.y = v.y * rs * gg.y * (1.f + sc.y) + sh.y;
    o.z = v.z * rs * gg.z * (1.f + sc.z) + sh.z;
    o.w = v.w * rs * gg.w * (1.f + sc.w) + sh.w;
    ((u32x2*)(H + ((size_t)bl * NTOK + rr) * DM))[tid] = (u32x2){pack2(o.x, o.y), pack2(o.z, o.w)};
  }
  __syncthreads();
}

__device__ __forceinline__ void stage_inproj(const Params& p, const bf16_t* H, const bf16_t* WinT, bf16_t* Z, float* MGT, bf16_t* VT, char* smem) {
  EPI_DECL
  const int tm = GB * 34, tn = 53;
  const float2* rt = (const float2*)(p.ws + WB_ROPE);
  for (int t = blockIdx.x; t < tm * tn; t += gridDim.x) {
    const int mt = t / tn, j = t % tn, n0 = j * 128;
    const int lr0 = MT_LR0(mt, 34), rr0 = (mt % 34) * 128;
    f32x16 acc[2][2];
    if (j >= 8 && j < 12) {
      gemm_tile(WinT + (size_t)n0 * DM, DM, H + (size_t)lr0 * DM, DM, DM, smem, acc);
      bf16_t* vt = VT + ((size_t)(mt / 34) * 4 + (j - 8)) * 128 * NTOK;
#pragma unroll
      for (int mi = 0; mi < 2; ++mi)
#pragma unroll
        for (int ni = 0; ni < 2; ++ni)
#pragma unroll
          for (int q = 0; q < 4; ++q) {
            const int e = EPI_ROW(mi), tok = rr0 + EPI_COL(ni, q);
            *(u32x2*)(vt + (size_t)e * NTOK + tok) = (u32x2){pack2(acc[mi][ni][4 * q], acc[mi][ni][4 * q + 1]), pack2(acc[mi][ni][4 * q + 2], acc[mi][ni][4 * q + 3])};
          }
      continue;
    }
    gemm_tile(H + (size_t)lr0 * DM, DM, WinT + (size_t)n0 * DM, DM, DM, smem, acc);
    if (j < 8 && rr0 < NLAT) {
#pragma unroll
      for (int mi = 0; mi < 2; ++mi) {
        const int pos = rr0 + EPI_ROW(mi);
#pragma unroll
        for (int i = 0; i < 16; ++i) {
          const int jj = 8 * (i >> 2) + 4 * fh + (i & 3);
          const float2 cs = rt[pos * 32 + jj];
          const float x1 = acc[mi][0][i], x2 = acc[mi][1][i];
          acc[mi][0][i] = x1 * cs.x - x2 * cs.y;
          acc[mi][1][i] = x1 * cs.y + x2 * cs.x;
        }
      }
    }
    if (j < 52) {
      const bool sg = (j >= 28);
#pragma unroll
      for (int mi = 0; mi < 2; ++mi)
#pragma unroll
        for (int ni = 0; ni < 2; ++ni)
#pragma unroll
          for (int q = 0; q < 4; ++q) {
            const int row = lr0 + EPI_ROW(mi), c = n0 + EPI_COL(ni, q);
            float v0 = acc[mi][ni][4 * q], v1 = acc[mi][ni][4 * q + 1], v2 = acc[mi][ni][4 * q + 2], v3 = acc[mi][ni][4 * q + 3];
            if (sg) { v0 = sigmoidf_(v0); v1 = sigmoidf_(v1); v2 = sigmoidf_(v2); v3 = sigmoidf_(v3); }
            *(u32x2*)(Z + (size_t)row * ZW + c) = (u32x2){pack2(v0, v1), pack2(v2, v3)};
          }
    } else {
#pragma unroll
      for (int mi = 0; mi < 2; ++mi)
#pragma unroll
        for (int q = 0; q < 2; ++q) {
          const int row = lr0 + EPI_ROW(mi), c = EPI_COL(0, q);
          if (wn == 0) *(float4*)(MGT + (size_t)row * 16 + c) = make_float4(acc[mi][0][4 * q], acc[mi][0][4 * q + 1], acc[mi][0][4 * q + 2], acc[mi][0][4 * q + 3]);
        }
    }
  }
}

__device__ __forceinline__ void stage_conv(const Params& p, int l, const bf16_t* Z, bf16_t* XC) {
  const int tid = otid();
  const float* cw = p.in[I_CONVW] + (size_t)l * 3 * 512;
  const float* cb = p.in[I_CONVB] + (size_t)l * 512;
  const int c = tid * 2;
  const float2 w0 = *(const float2*)(cw + c), w1 = *(const float2*)(cw + 512 + c), w2 = *(const float2*)(cw + 1024 + c), bb = *(const float2*)(cb + c);
  for (int lr = blockIdx.x; lr < RPG; lr += gridDim.x) {
    const int rr = lr % NTOK;
    const bool has_prev = (rr < NLAT) ? (rr > 0) : (rr > NLAT);
    const bool has_next = (rr < NLAT) ? (rr < NLAT - 1) : (rr < NTOK - 1);
    const bf16_t* z = Z + (size_t)lr * ZW + 1536 + c;
    const unsigned xc = *(const unsigned*)z;
    float a0 = bb.x + w1.x * lo16(xc), a1 = bb.y + w1.y * hi16(xc);
    if (has_prev) { const unsigned xp = *(const unsigned*)(z - ZW); a0 += w0.x * lo16(xp); a1 += w0.y * hi16(xp); }
    if (has_next) { const unsigned xn = *(const unsigned*)(z + ZW); a0 += w2.x * lo16(xn); a1 += w2.y * hi16(xn); }
    *(unsigned*)(XC + (size_t)lr * 512 + c) = pack2(siluf_(a0), siluf_(a1));
  }
}

__device__ __forceinline__ void stage_mlqk(const bf16_t* XC, const bf16_t* WQK, float* QM, float* KM, char* smem) {
  EPI_DECL
  const int tm = RPG >> 7;
  for (int t = blockIdx.x; t < tm * 8; t += gridDim.x) {
    const int m0 = (t >> 3) * 128, h = (t >> 1) & 3, nt = t & 1;
    f32x16 acc[2][2];
    gemm_tile(XC + (size_t)m0 * 512 + h * 128, 512, WQK + (size_t)h * 256 * 128 + (size_t)nt * 128 * 128, 128, 128, smem, acc);
    float* O = nt ? KM : QM;
    const float alpha = nt ? 1.0f : 0.08838834764831845f;
#pragma unroll
    for (int mi = 0; mi < 2; ++mi)
#pragma unroll
      for (int ni = 0; ni < 2; ++ni)
#pragma unroll
        for (int q = 0; q < 4; ++q) {
          const int row = m0 + EPI_ROW(mi), c = EPI_COL(ni, q);
          *(float4*)(O + (size_t)row * 512 + h * 128 + c) = make_float4(alpha * acc[mi][ni][4 * q], alpha * acc[mi][ni][4 * q + 1], alpha * acc[mi][ni][4 * q + 2], alpha * acc[mi][ni][4 * q + 3]);
        }
  }
}

__device__ __forceinline__ void attn_mfma_item(const Params& p, int l, const bf16_t* Zb, const bf16_t* VTb, bf16_t* YAb, int h, int qrow0, int key0, int nkeys,
                                               float lam, float lam_init, char* smem) {
  const int tid = otid(), lane = tid & 63, w = tid >> 6, fr = lane & 31, fh = lane >> 5;
  const int ntiles = nkeys >> 6;
  const int myrow = qrow0 + w * 32 + fr;
  bf16x8 qf[2][4];
  {
    const bf16_t* qp = Zb + (size_t)myrow * ZW + h * 128 + fh * 8;
#pragma unroll
    for (int m = 0; m < 2; ++m)
#pragma unroll
      for (int ks = 0; ks < 4; ++ks) qf[m][ks] = *(const bf16x8*)(qp + m * 64 + ks * 16);
  }
  f32x16 O[2][4];
#pragma unroll
  for (int m = 0; m < 2; ++m)
#pragma unroll
    for (int eb = 0; eb < 4; ++eb)
#pragma unroll
      for (int i = 0; i < 16; ++i) O[m][eb][i] = 0.f;
  float mrun[2] = {-1e30f, -1e30f}, lrun[2] = {0.f, 0.f};
  const float cs = 0.125f * 1.4426950408889634f;
  const int skey = tid >> 4, sch = tid & 15;
  const bf16_t* ksrc = Zb + (size_t)(key0 + skey) * ZW + 512 + h * 128 + sch * 8;
  const int kdst = skey * 256 + ((sch ^ (skey & 15)) << 4);
  const int se = tid >> 3, svc = tid & 7;
  const bf16_t* vsrc = VTb + ((size_t)h * 128 + se) * NTOK + key0 + svc * 8;
  const int vsw = (se >> 1) & 15;
  const int vdst0 = se * 128 + (((2 * svc) ^ vsw) << 3), vdst1 = se * 128 + (((2 * svc + 1) ^ vsw) << 3);
  const int kfo = fr * 256, kfs = fr & 15;
  const int vfo = fr * 128, vfs = (fr >> 1) & 15;
  u32x4 rk[4], rv[4];
#pragma unroll
  for (int i = 0; i < 4; ++i) rk[i] = *(const u32x4*)(ksrc + (size_t)i * 16 * ZW);
  __syncthreads();
#pragma unroll
  for (int i = 0; i < 4; ++i) *(u32x4*)(smem + kdst + i * 4096) = rk[i];
  __syncthreads();
  bf16x8 pf[2][4];
#pragma unroll
  for (int m = 0; m < 2; ++m)
#pragma unroll
    for (int s = 0; s < 4; ++s)
#pragma unroll
      for (int i = 0; i < 8; ++i) pf[m][s][i] = 0;
#pragma unroll 1
  for (int t = 0; t <= ntiles; ++t) {
    const bool cur = t < ntiles, nxt = t + 1 < ntiles, prv = t >= 1;
    if (nxt) {
#pragma unroll
      for (int i = 0; i < 4; ++i) rk[i] = *(const u32x4*)(ksrc + (size_t)((t + 1) * 64 + i * 16) * ZW);
    }
    if (cur) {
#pragma unroll
      for (int i = 0; i < 4; ++i) rv[i] = *(const u32x4*)(vsrc + (size_t)i * 32 * NTOK + t * 64);
    }
    const char* kb_ = smem + (t & 1) * 16384;
    f32x16 S[2];
    if (cur) {
#pragma unroll
      for (int kb = 0; kb < 2; ++kb) {
#pragma unroll
        for (int i = 0; i < 16; ++i) S[kb][i] = 0.f;
#pragma unroll
        for (int ks = 0; ks < 4; ++ks) {
          const bf16x8 kf = *(const bf16x8*)(kb_ + kb * 8192 + kfo + (((ks * 2 + fh) ^ kfs) << 4));
          S[kb] = __builtin_amdgcn_mfma_f32_32x32x16_bf16(kf, qf[0][ks], S[kb], 0, 0, 0);
        }
      }
    }
    if (prv) {
      const char* vb_ = smem + 32768 + ((t - 1) & 1) * 16384;
#pragma unroll
      for (int eb = 0; eb < 4; ++eb)
#pragma unroll
        for (int s = 0; s < 4; ++s) {
          const u32x2 v0 = *(const u32x2*)(vb_ + eb * 4096 + vfo + (((4 * s + fh) ^ vfs) << 3));
          const u32x2 v1 = *(const u32x2*)(vb_ + eb * 4096 + vfo + (((4 * s + fh + 2) ^ vfs) << 3));
          const bf16x8 vf = __builtin_bit_cast(bf16x8, (u32x4){v0[0], v0[1], v1[0], v1[1]});
          O[0][eb] = __builtin_amdgcn_mfma_f32_32x32x16_bf16(vf, pf[0][s], O[0][eb], 0, 0, 0);
          O[1][eb] = __builtin_amdgcn_mfma_f32_32x32x16_bf16(vf, pf[1][s], O[1][eb], 0, 0, 0);
        }
    }
    if (cur) {
#pragma unroll
      for (int m = 0; m < 2; ++m) {
        if (m == 1) {
#pragma unroll
          for (int kb = 0; kb < 2; ++kb) {
#pragma unroll
            for (int i = 0; i < 16; ++i) S[kb][i] = 0.f;
#pragma unroll
            for (int ks = 0; ks < 4; ++ks) {
              const bf16x8 kf = *(const bf16x8*)(kb_ + kb * 8192 + kfo + (((8 + ks * 2 + fh) ^ kfs) << 4));
              S[kb] = __builtin_amdgcn_mfma_f32_32x32x16_bf16(kf, qf[1][ks], S[kb], 0, 0, 0);
            }
          }
        }
        float tm = S[0][0];
#pragma unroll
        for (int i = 1; i < 16; ++i) tm = fmaxf(tm, S[0][i]);
#pragma unroll
        for (int i = 0; i < 16; ++i) tm = fmaxf(tm, S[1][i]);
        tm = fmaxf(tm, __shfl_xor(tm, 32)) * cs;
        float alpha = 1.f;
        if (tm > mrun[m] + 8.0f) { alpha = exp2f(mrun[m] - tm); mrun[m] = tm; }
        if (__any(alpha != 1.f)) {
#pragma unroll
          for (int eb = 0; eb < 4; ++eb)
#pragma unroll
            for (int i = 0; i < 16; ++i) O[m][eb][i] *= alpha;
          lrun[m] *= alpha;
        }
        const float mc = mrun[m];
        float rs = 0.f;
#pragma unroll
        for (int kb = 0; kb < 2; ++kb) {
          float pv[16];
#pragma unroll
          for (int i = 0; i < 16; ++i) { pv[i] = exp2f(fmaf(S[kb][i], cs, -mc)); rs += pv[i]; }
#pragma unroll
          for (int hh = 0; hh < 2; ++hh)
            pf[m][kb * 2 + hh] = __builtin_bit_cast(bf16x8, (u32x4){pack2(pv[8 * hh], pv[8 * hh + 1]), pack2(pv[8 * hh + 2], pv[8 * hh + 3]),
                                                                     pack2(pv[8 * hh + 4], pv[8 * hh + 5]), pack2(pv[8 * hh + 6], pv[8 * hh + 7])});
        }
        lrun[m] += rs;
      }
    }
    if (nxt) {
      char* kd = smem + ((t + 1) & 1) * 16384;
#pragma unroll
      for (int i = 0; i < 4; ++i) *(u32x4*)(kd + kdst + i * 4096) = rk[i];
    }
    if (cur) {
      char* vd = smem + 32768 + (t & 1) * 16384;
#pragma unroll
      for (int i = 0; i < 4; ++i) {
        *(u32x2*)(vd + vdst0 + i * 4096) = (u32x2){rv[i][0], rv[i][1]};
        *(u32x2*)(vd + vdst1 + i * 4096) = (u32x2){rv[i][2], rv[i][3]};
      }
    }
    __syncthreads();
  }
  const float l0 = lrun[0] + __shfl_xor(lrun[0], 32), l1 = lrun[1] + __shfl_xor(lrun[1], 32);
  const float i0 = 1.0f / l0, i1 = lam / l1;
  float ss = 0.f;
#pragma unroll
  for (int eb = 0; eb < 4; ++eb)
#pragma unroll
    for (int i = 0; i < 16; ++i) { const float o = O[0][eb][i] * i0 - O[1][eb][i] * i1; O[0][eb][i] = o; ss = fmaf(o, o, ss); }
  ss += __shfl_xor(ss, 32);
  const float rn = rsqrtf(ss * (1.0f / 128.0f) + EPSF) * (1.0f - lam_init);
  const float* sg = p.in[I_SUBG] + l * 512 + h * 128;
  bf16_t* yp = YAb + (size_t)myrow * 512 + h * 128;
#pragma unroll
  for (int eb = 0; eb < 4; ++eb)
#pragma unroll
    for (int q = 0; q < 4; ++q) {
      const int e = eb * 32 + 8 * q + 4 * fh;
      const float4 g = *(const float4*)(sg + e);
      *(u32x2*)(yp + e) = (u32x2){pack2(O[0][eb][4 * q] * rn * g.x, O[0][eb][4 * q + 1] * rn * g.y), pack2(O[0][eb][4 * q + 2] * rn * g.z, O[0][eb][4 * q + 3] * rn * g.w)};
    }
  __syncthreads();
}

__device__ __forceinline__ void mlstm_item(const Params& p, int l, const bf16_t* Zb, const float* MGTb, const float* QMb, const float* KMb, float* HXb,
                                           int h, int dir, float* smem) {
  const int tid = otid();
  const int e = tid >> 1, hf = tid & 1;
  float* qs = smem;
  float* ks = smem + 16 * 128;
  float* vs = smem + 2 * 16 * 128;
  float* gi = smem + 3 * 16 * 128;
  float* gf = gi + 16;
  int* rows = (int*)(gf + 16);
  const float bi = p.in[I_GATEB][l * 16 + dir * 8 + h];
  const float bf = p.in[I_GATEB][l * 16 + dir * 8 + 4 + h];
  float C[64], nn[64];
#pragma unroll
  for (int j = 0; j < 64; ++j) { C[j] = 0.f; nn[j] = 0.f; }
  for (int s0 = 0; s0 < NTOK; s0 += 16) {
    __syncthreads();
#pragma unroll
    for (int i = 0; i < 2; ++i) {
      int idx = tid + i * 256;
      int st = idx >> 5, c4 = idx & 31;
      int step = s0 + st;
      int row = (dir == 0) ? ((step < NCTX) ? NLAT + step : step - NCTX)
                           : ((step < NCTX) ? NLAT + (NCTX - 1 - step) : (NLAT - 1) - (step - NCTX));
      ((float4*)(qs + st * 128))[c4] = ((const float4*)(QMb + (size_t)row * 512 + h * 128))[c4];
      ((float4*)(ks + st * 128))[c4] = ((const float4*)(KMb + (size_t)row * 512 + h * 128))[c4];
      const u32x2 vv = ((const u32x2*)(Zb + (size_t)row * ZW + 2048 + h * 128))[c4];
      ((float4*)(vs + st * 128))[c4] = make_float4(lo16(vv[0]), hi16(vv[0]), lo16(vv[1]), hi16(vv[1]));
      if (c4 == 0) {
        float a = MGTb[(size_t)row * 16 + dir * 8 + h] + bi;
        float f = MGTb[(size_t)row * 16 + dir * 8 + 4 + h] + bf;
        gi[st] = expf(a);
        gf[st] = sigmoidf_(f);
        rows[st] = row;
      }
    }
    __syncthreads();
#pragma unroll 1
    for (int st = 0; st < 16; ++st) {
      const float ig = gi[st], fg = gf[st];
      const float iv = ig * vs[st * 128 + e];
      const float4* kp = (const float4*)(ks + st * 128 + hf * 64);
      const float4* qp = (const float4*)(qs + st * 128 + hf * 64);
      float hp = 0.f, dp = 0.f;
#pragma unroll
      for (int j4 = 0; j4 < 16; ++j4) {
        float4 kv = kp[j4], qv = qp[j4];
        float kk[4] = {kv.x, kv.y, kv.z, kv.w}, qq[4] = {qv.x, qv.y, qv.z, qv.w};
#pragma unroll
        for (int u = 0; u < 4; ++u) {
          int j = j4 * 4 + u;
          C[j] = fmaf(fg, C[j], iv * kk[u]);
          nn[j] = fmaf(fg, nn[j], ig * kk[u]);
          hp = fmaf(C[j], qq[u], hp);
          dp = fmaf(nn[j], qq[u], dp);
        }
      }
      hp += __shfl_xor(hp, 1);
      dp += __shfl_xor(dp, 1);
      if (hf == 0) HXb[(size_t)rows[st] * 512 + h * 128 + e] = hp / fmaxf(fabsf(dp), 1.0f);
    }
  }
  __syncthreads();
}

__device__ __forceinline__ void s5_item(const Params& p, int l, const bf16_t* Zb, float* YSFb, float* YSBb, int g, float* smem) {
  const int tid = otid();
  const int w = tid >> 6, lane = tid & 63;
  const bool active = w < 2;
  const int dir = w & 1;
  float* base = smem + (w & 1) * 11392;
  float* us = base;
  float* xre = base + 1024;
  float* xim = xre + 64 * 65;
  float* cre = xim + 64 * 65;
  float* cim = cre + 1024;
  const int pg = ((l * 2 + dir) * 32 + g);
  const int n = lane;
  const float lre = p.in[I_S5LRE][pg * 64 + n], lim = p.in[I_S5LIM][pg * 64 + n];
  const float dt = expf(p.in[I_S5DT][pg]);
  const float mag = expf(lre * dt);
  const float abr = mag * cosf(lim * dt), abi = mag * sinf(lim * dt);
  const float den = lre * lre + lim * lim;
  const float zr = ((abr - 1.0f) * lre + abi * lim) / den;
  const float zi = (abi * lre - (abr - 1.0f) * lim) / den;
  float bbr[16], bbi[16];
  {
    const float* br = p.in[I_S5BRE] + ((size_t)pg * 64 + n) * 16;
    const float* bi = p.in[I_S5BIM] + ((size_t)pg * 64 + n) * 16;
#pragma unroll
    for (int q = 0; q < 16; ++q) { float a = br[q], b = bi[q]; bbr[q] = zr * a - zi * b; bbi[q] = zr * b + zi * a; }
  }
  __syncthreads();
  if (active) {
    const float* cr = p.in[I_S5CRE] + (size_t)pg * 16 * 64;
    const float* ci = p.in[I_S5CIM] + (size_t)pg * 16 * 64;
#pragma unroll
    for (int q = 0; q < 16; ++q) { cre[n * 16 + q] = cr[q * 64 + n]; cim[n * 16 + q] = ci[q * 64 + n]; }
  }
  float xr = 0.f, xi = 0.f;
  float* Y = dir ? YSBb : YSFb;
  for (int s0 = 0; s0 < NTOK; s0 += 64) {
    const int step = s0 + lane;
    const int row = (dir == 0) ? ((step < NCTX) ? NLAT + step : step - NCTX)
                               : ((step < NCTX) ? NLAT + (NCTX - 1 - step) : (NLAT - 1) - (step - NCTX));
    if (active) {
      const u32x4* up = (const u32x4*)(Zb + (size_t)row * ZW + 3072 + g * 16);
#pragma unroll
      for (int q = 0; q < 2; ++q) {
        u32x4 t = up[q];
#pragma unroll
        for (int k = 0; k < 4; ++k) { us[lane * 16 + q * 8 + 2 * k] = lo16(t[k]); us[lane * 16 + q * 8 + 2 * k + 1] = hi16(t[k]); }
      }
    }
    __syncthreads();
    if (active) {
#pragma unroll 4
      for (int t = 0; t < 64; ++t) {
        const float4* up = (const float4*)(us + t * 16);
        float br_ = 0.f, bi_ = 0.f;
#pragma unroll
        for (int q4 = 0; q4 < 4; ++q4) {
          float4 uv = up[q4];
          br_ = fmaf(uv.x, bbr[4 * q4], br_); br_ = fmaf(uv.y, bbr[4 * q4 + 1], br_); br_ = fmaf(uv.z, bbr[4 * q4 + 2], br_); br_ = fmaf(uv.w, bbr[4 * q4 + 3], br_);
          bi_ = fmaf(uv.x, bbi[4 * q4], bi_); bi_ = fmaf(uv.y, bbi[4 * q4 + 1], bi_); bi_ = fmaf(uv.z, bbi[4 * q4 + 2], bi_); bi_ = fmaf(uv.w, bbi[4 * q4 + 3], bi_);
        }
        float nr = abr * xr - abi * xi + br_;
        float ni = abr * xi + abi * xr + bi_;
        xr = nr; xi = ni;
        xre[t * 65 + n] = xr;
        xim[t * 65 + n] = xi;
      }
    }
    __syncthreads();
    if (active) {
      float y[16];
#pragma unroll
      for (int q = 0; q < 16; ++q) y[q] = 0.f;
      for (int nn_ = 0; nn_ < 64; ++nn_) {
        const float a = xre[lane * 65 + nn_], b = xim[lane * 65 + nn_];
        const float4* cr4 = (const float4*)(cre + nn_ * 16);
        const float4* ci4 = (const float4*)(cim + nn_ * 16);
#pragma unroll
        for (int q4 = 0; q4 < 4; ++q4) {
          float4 c1 = cr4[q4], c2 = ci4[q4];
          y[4 * q4] += a * c1.x - b * c2.x; y[4 * q4 + 1] += a * c1.y - b * c2.y;
          y[4 * q4 + 2] += a * c1.z - b * c2.z; y[4 * q4 + 3] += a * c1.w - b * c2.w;
        }
      }
      float4* yp = (float4*)(Y + (size_t)row * 512 + g * 16);
#pragma unroll
      for (int q4 = 0; q4 < 4; ++q4) yp[q4] = make_float4(y[4 * q4], y[4 * q4 + 1], y[4 * q4 + 2], y[4 * q4 + 3]);
    }
    __syncthreads();
  }
}

__device__ __forceinline__ void stage_post(const Params& p, int l, int rr_lim, const bf16_t* Z, const float* HF, const float* HB,
                                           const float* YSF, const float* YSB, bf16_t* YB, bf16_t* GG) {
  const int tid = otid();
  const int c0 = tid * 2;
  for (int i = blockIdx.x; i < GB * rr_lim; i += gridDim.x) {
    const size_t r = (size_t)(i / rr_lim) * NTOK + (i % rr_lim);
    {
      float2 a0 = *(const float2*)(HF + r * 512 + c0);
      float2 a1 = *(const float2*)(HB + r * 512 + c0);
      float h0 = a0.x + a1.x, h1 = a0.y + a1.y;
      float ss = wave_sum(h0 * h0 + h1 * h1);
      float rs = rsqrtf(ss * (1.0f / 128.0f) + EPSF);
      float2 g = *(const float2*)(p.in[I_MLNG] + l * 512 + c0);
      const unsigned og = *(const unsigned*)(Z + r * ZW + 2560 + c0);
      *(unsigned*)(YB + r * 512 + c0) = pack2(h0 * rs * g.x * sigmoidf_(lo16(og)), h1 * rs * g.y * sigmoidf_(hi16(og)));
    }
    {
      const unsigned u = *(const unsigned*)(Z + r * ZW + 3072 + c0);
      float2 d = *(const float2*)(p.in[I_S5D] + l * 512 + c0);
      float2 f = *(const float2*)(YSF + r * 512 + c0);
      float2 b = *(const float2*)(YSB + r * 512 + c0);
      *(unsigned*)(GG + r * 512 + c0) = pack2(geluf_(d.x * lo16(u) + f.x + b.x), geluf_(d.y * hi16(u) + f.y + b.y));
    }
  }
}

__device__ __forceinline__ void stage_glu_mfma(const Params& p, int l, int tpb, const bf16_t* GG, const bf16_t* GLUT, bf16_t* YS, char* smem) {
  EPI_DECL
  const int tm = GB * tpb;
  for (int t = blockIdx.x; t < tm * 4; t += gridDim.x) {
    const int m0 = MT_LR0(t >> 2, tpb), n0 = (t & 3) * 128;
    f32x16 acc[2][2];
    gemm_tile(GG + (size_t)m0 * 512, 512, GLUT + (size_t)n0 * 512, 512, 512, smem, acc);
#pragma unroll
    for (int mi = 0; mi < 2; ++mi)
#pragma unroll
      for (int ni = 0; ni < 2; ++ni)
#pragma unroll
        for (int q = 0; q < 4; ++q) {
          const int row = m0 + EPI_ROW(mi), c = n0 + EPI_COL(ni, q);
          const float4 b = *(const float4*)(p.in[I_GLUB] + l * 512 + c);
          const u32x2 g2 = *(const u32x2*)(GG + (size_t)row * 512 + c);
          const float o0 = lo16(g2[0]) * sigmoidf_(acc[mi][ni][4 * q] + b.x), o1 = hi16(g2[0]) * sigmoidf_(acc[mi][ni][4 * q + 1] + b.y);
          const float o2 = lo16(g2[1]) * sigmoidf_(acc[mi][ni][4 * q + 2] + b.z), o3 = hi16(g2[1]) * sigmoidf_(acc[mi][ni][4 * q + 3] + b.w);
          *(u32x2*)(YS + (size_t)row * 512 + c) = (u32x2){pack2(o0, o1), pack2(o2, o3)};
        }
  }
}

__device__ __forceinline__ void stage_merge_mfma(int tpb, const bf16_t* YA, const bf16_t* YB, const bf16_t* YS, const bf16_t* WBR, const bf16_t* Z, bf16_t* MG, char* smem) {
  EPI_DECL
  const int tm = GB * tpb;
  for (int t = blockIdx.x; t < tm * 8; t += gridDim.x) {
    const int m0 = MT_LR0(t >> 3, tpb), n0 = (t & 7) * 128;
    f32x16 macc[2][2];
#pragma unroll
    for (int a = 0; a < 2; ++a)
#pragma unroll
      for (int b = 0; b < 2; ++b)
#pragma unroll
        for (int i = 0; i < 16; ++i) macc[a][b][i] = 0.f;
#pragma unroll 1
    for (int r = 0; r < 3; ++r) {
      const bf16_t* Y = (r == 0) ? YA : (r == 1 ? YB : YS);
      f32x16 acc[2][2];
      gemm_tile(Y + (size_t)m0 * 512, 512, WBR + (size_t)r * 1024 * 512 + (size_t)n0 * 512, 512, 512, smem, acc);
#pragma unroll
      for (int mi = 0; mi < 2; ++mi)
#pragma unroll
        for (int ni = 0; ni < 2; ++ni)
#pragma unroll
          for (int q = 0; q < 4; ++q) {
            const int row = m0 + EPI_ROW(mi), c = n0 + EPI_COL(ni, q);
            const u32x2 e = *(const u32x2*)(Z + (size_t)row * ZW + 3584 + r * 1024 + c);
            macc[mi][ni][4 * q] += lo16(e[0]) * acc[mi][ni][4 * q];
            macc[mi][ni][4 * q + 1] += hi16(e[0]) * acc[mi][ni][4 * q + 1];
            macc[mi][ni][4 * q + 2] += lo16(e[1]) * acc[mi][ni][4 * q + 2];
            macc[mi][ni][4 * q + 3] += hi16(e[1]) * acc[mi][ni][4 * q + 3];
          }
    }
#pragma unroll
    for (int mi = 0; mi < 2; ++mi)
#pragma unroll
      for (int ni = 0; ni < 2; ++ni)
#pragma unroll
        for (int q = 0; q < 4; ++q) {
          const int row = m0 + EPI_ROW(mi), c = n0 + EPI_COL(ni, q);
          *(u32x2*)(MG + (size_t)row * DM + c) = (u32x2){pack2(macc[mi][ni][4 * q], macc[mi][ni][4 * q + 1]), pack2(macc[mi][ni][4 * q + 2], macc[mi][ni][4 * q + 3])};
        }
  }
}

__device__ __forceinline__ void stage_outproj_mfma(const Params& p, int l, int g, int tpb, const bf16_t* MG, const bf16_t* WOUT, char* smem) {
  EPI_DECL
  const int tm = GB * tpb;
  const float* mod = (const float*)(p.ws + WB_MOD) + (size_t)l * 9 * 6144;
  for (int t = blockIdx.x; t < tm * 8; t += gridDim.x) {
    const int mt = t >> 3, n0 = (t & 7) * 128;
    const int m0 = MT_LR0(mt, tpb), bl = mt / tpb, rr0 = (mt % tpb) * 128, b = g * GB + bl;
    f32x16 acc[2][2];
    gemm_tile(MG + (size_t)m0 * DM, DM, WOUT + (size_t)n0 * DM, DM, DM, smem, acc);
    const float* gv = mod + (size_t)((rr0 < NLAT) ? b : 8) * 6144 + 2 * 1024;
#pragma unroll
    for (int mi = 0; mi < 2; ++mi)
#pragma unroll
      for (int ni = 0; ni < 2; ++ni)
#pragma unroll
        for (int q = 0; q < 4; ++q) {
          const int rr = rr0 + EPI_ROW(mi), c = n0 + EPI_COL(ni, q);
          const float4 gg = *(const float4*)(gv + c);
          float4* xp = (float4*)(xrow(p, b, rr) + c);
          float4 x = *xp;
          x.x += gg.x * acc[mi][ni][4 * q]; x.y += gg.y * acc[mi][ni][4 * q + 1]; x.z += gg.z * acc[mi][ni][4 * q + 2]; x.w += gg.w * acc[mi][ni][4 * q + 3];
          *xp = x;
        }
  }
}

__device__ __forceinline__ void stage_peerq_mfma(int tpb, const bf16_t* H2, const bf16_t* WQ, bf16_t* PQ, char* smem) {
  EPI_DECL
  const int tm = GB * tpb;
  for (int t = blockIdx.x; t < tm * 16; t += gridDim.x) {
    const int m0 = MT_LR0(t >> 4, tpb), n0 = (t & 15) * 128;
    f32x16 acc[2][2];
    gemm_tile(H2 + (size_t)m0 * DM, DM, WQ + (size_t)n0 * DM, DM, DM, smem, acc);
#pragma unroll
    for (int mi = 0; mi < 2; ++mi)
#pragma unroll
      for (int ni = 0; ni < 2; ++ni)
#pragma unroll
        for (int q = 0; q < 4; ++q) {
          const int row = m0 + EPI_ROW(mi), c = n0 + EPI_COL(ni, q);
          *(u32x2*)(PQ + (size_t)row * 2048 + c) = (u32x2){pack2(acc[mi][ni][4 * q], acc[mi][ni][4 * q + 1]), pack2(acc[mi][ni][4 * q + 2], acc[mi][ni][4 * q + 3])};
        }
  }
}

__device__ __forceinline__ void stage_scores_mfma(int tpb, const bf16_t* PQ, const bf16_t* SUBK, float* SC, char* smem) {
  EPI_DECL
  const int tm = GB * tpb * 8;
  for (int t = blockIdx.x; t < tm * 2; t += gridDim.x) {
    const int mt = t >> 1, half = t & 1;
    const size_t m0 = (size_t)MT_LR0(mt >> 3, tpb) * 8 + (size_t)(mt & 7) * 128;
    f32x16 acc[2][2];
    gemm_tile(PQ + m0 * 256 + half * 128, 256, SUBK + (size_t)half * 16384, 128, 128, smem, acc);
#pragma unroll
    for (int mi = 0; mi < 2; ++mi)
#pragma unroll
      for (int ni = 0; ni < 2; ++ni)
#pragma unroll
        for (int q = 0; q < 4; ++q) {
          const size_t row = m0 + EPI_ROW(mi);
          const int c = EPI_COL(ni, q);
          *(float4*)(SC + row * 256 + half * 128 + c) = make_float4(acc[mi][ni][4 * q], acc[mi][ni][4 * q + 1], acc[mi][ni][4 * q + 2], acc[mi][ni][4 * q + 3]);
        }
  }
}

__device__ __forceinline__ void wave_argmax(float& v, int& idx) {
#pragma unroll
  for (int o = 32; o > 0; o >>= 1) {
    float ov = __shfl_xor(v, o);
    int oi = __shfl_xor(idx, o);
    if (ov > v || (ov == v && oi < idx)) { v = ov; idx = oi; }
  }
}
__device__ __forceinline__ void stage_topk(int rr_lim, const float* SC, int* EI, float* EG) {
  const int tid = otid(), w = tid >> 6, lane = tid & 63;
  const int nth = GB * rr_lim * 8;
  for (int i = blockIdx.x * 4 + w; i < nth; i += gridDim.x * 4) {
    const int tok = i >> 3, hh = i & 7;
    const size_t th = ((size_t)(tok / rr_lim) * NTOK + (tok % rr_lim)) * 8 + hh;
    const float* s = SC + th * 256;
    float myv[2] = {0.f, 0.f};
    int myi[2] = {0, 0};
#pragma unroll
    for (int half = 0; half < 2; ++half) {
      float a0 = s[half * 128 + lane], a1 = s[half * 128 + 64 + lane];
      for (int r = 0; r < 16; ++r) {
        float v; int idx;
        if (a0 >= a1) { v = a0; idx = lane; } else { v = a1; idx = lane + 64; }
        wave_argmax(v, idx);
        if (idx == lane) a0 = -INFINITY;
        if (idx == lane + 64) a1 = -INFINITY;
        if (lane == r) { myv[half] = v; myi[half] = idx; }
      }
    }
    float cv[4];
    const float v1 = __shfl(myv[0], lane >> 2);
#pragma unroll
    for (int q = 0; q < 4; ++q) cv[q] = v1 + __shfl(myv[1], (lane & 3) * 4 + q);
    float tv = 0.f; int tc = 0;
    for (int r = 0; r < 16; ++r) {
      float v = cv[0]; int idx = lane * 4;
#pragma unroll
      for (int q = 1; q < 4; ++q) if (cv[q] > v) { v = cv[q]; idx = lane * 4 + q; }
      wave_argmax(v, idx);
#pragma unroll
      for (int q = 0; q < 4; ++q) if (idx == lane * 4 + q) cv[q] = -INFINITY;
      if (lane == r) { tv = v; tc = idx; }
    }
    const int e1 = __shfl(myi[0], tc >> 4);
    const int e2 = __shfl(myi[1], tc & 15);
    const float vmax = __shfl(tv, 0);
    float ex = (lane < 16) ? expf(tv - vmax) : 0.f;
    float sum = wave_sum(ex);
    if (lane < 16) {
      EI[th * 16 + lane] = e1 * 128 + e2;
      EG[th * 16 + lane] = ex / sum;
    }
  }
}

__device__ __forceinline__ void unpack8(const u32x4 v, float* f) {
#pragma unroll
  for (int k = 0; k < 4; ++k) { f[2 * k] = lo16(v[k]); f[2 * k + 1] = hi16(v[k]); }
}
__device__ __forceinline__ void stage_expert(const Params& p, int l, int g, int rr_lim, const bf16_t* H2, const int* EI, const float* EG, float* smem) {
  const int tid = otid(), w = tid >> 6, lane = tid & 63;
  float* part = smem;
  const bf16_t* U = (const bf16_t*)(p.ws + WB_U16) + (size_t)l * 16384 * 1024;
  const bf16_t* V = (const bf16_t*)(p.ws + WB_V16) + (size_t)l * 16384 * 1024;
  const float* mod = (const float*)(p.ws + WB_MOD) + (size_t)l * 9 * 6144;
  for (int i = blockIdx.x; i < GB * rr_lim; i += gridDim.x) {
    const int bl = i / rr_lim, rr = i % rr_lim, b = g * GB + bl;
    const size_t t = (size_t)bl * NTOK + rr;
    float hf[16];
    unpack8(((const u32x4*)(H2 + t * DM))[lane], hf);
    unpack8(((const u32x4*)(H2 + t * DM + 512))[lane], hf + 8);
    const int my_e = EI[t * 128 + w * 32 + (lane & 31)];
    const float my_g = EG[t * 128 + w * 32 + (lane & 31)];
    float my_dot = 0.f;
#pragma unroll 1
    for (int k0 = 0; k0 < 32; k0 += 8) {
      u32x4 ra[8], rb[8];
#pragma unroll
      for (int j = 0; j < 8; ++j) {
        const int e = __builtin_amdgcn_readlane(my_e, k0 + j);
        const u32x4* up = (const u32x4*)(U + (size_t)e * 1024);
        ra[j] = up[lane]; rb[j] = up[64 + lane];
      }
#pragma unroll
      for (int j = 0; j < 8; ++j) {
        float f[16];
        unpack8(ra[j], f); unpack8(rb[j], f + 8);
        float a = 0.f;
#pragma unroll
        for (int q = 0; q < 16; ++q) a = fmaf(hf[q], f[q], a);
        a = wave_sum(a);
        if ((lane & 31) == k0 + j) my_dot = a;
      }
    }
    const float my_c = my_g * geluf_(my_dot);
    float acc[16];
#pragma unroll
    for (int q = 0; q < 16; ++q) acc[q] = 0.f;
#pragma unroll 1
    for (int k0 = 0; k0 < 32; k0 += 8) {
      u32x4 ra[8], rb[8];
#pragma unroll
      for (int j = 0; j < 8; ++j) {
        const int e = __builtin_amdgcn_readlane(my_e, k0 + j);
        const u32x4* vp = (const u32x4*)(V + (size_t)e * 1024);
        ra[j] = vp[lane]; rb[j] = vp[64 + lane];
      }
#pragma unroll
      for (int j = 0; j < 8; ++j) {
        const float c = __uint_as_float(__builtin_amdgcn_readlane(__float_as_uint(my_c), k0 + j));
        float f[16];
        unpack8(ra[j], f); unpack8(rb[j], f + 8);
#pragma unroll
        for (int q = 0; q < 16; ++q) acc[q] = fmaf(c, f[q], acc[q]);
      }
    }
    __syncthreads();
    {
      float4* pw = (float4*)(part + w * 1024 + lane * 8);
      pw[0] = make_float4(acc[0], acc[1], acc[2], acc[3]); pw[1] = make_float4(acc[4], acc[5], acc[6], acc[7]);
      float4* pw2 = (float4*)(part + w * 1024 + 512 + lane * 8);
      pw2[0] = make_float4(acc[8], acc[9], acc[10], acc[11]); pw2[1] = make_float4(acc[12], acc[13], acc[14], acc[15]);
    }
    __syncthreads();
    const float4 s0 = ((const float4*)part)[tid], s1 = ((const float4*)(part + 1024))[tid], s2 = ((const float4*)(part + 2048))[tid], s3 = ((const float4*)(part + 3072))[tid];
    const float4 g2 = ((const float4*)(mod + (size_t)((rr < NLAT) ? b : 8) * 6144 + 5 * 1024))[tid];
    float4* xp = (float4*)xrow(p, b, rr) + tid;
    float4 xv = *xp;
    xv.x += g2.x * (s0.x + s1.x + s2.x + s3.x); xv.y += g2.y * (s0.y + s1.y + s2.y + s3.y);
    xv.z += g2.z * (s0.z + s1.z + s2.z + s3.z); xv.w += g2.w * (s0.w + s1.w + s2.w + s3.w);
    *xp = xv;
  }
  __syncthreads();
}

__device__ __forceinline__ void stage_final(const Params& p, float* smem) {
  const int tid = otid();
  for (int r = blockIdx.x; r < NB * NLAT; r += gridDim.x) {
    float4* xp = (float4*)(p.out + (size_t)r * DM) + tid;
    float4 v = *xp;
    float s = wave_sum(v.x * v.x + v.y * v.y + v.z * v.z + v.w * v.w);
    __syncthreads();
    if ((tid & 63) == 0) smem[tid >> 6] = s;
    __syncthreads();
    float rs = rsqrtf((smem[0] + smem[1] + smem[2] + smem[3]) * (1.0f / DM) + EPSF);
    float4 g = ((const float4*)p.in[I_FG])[tid];
    *xp = make_float4(v.x * rs * g.x, v.y * rs * g.y, v.z * rs * g.z, v.w * rs * g.w);
  }
}

__global__ void __launch_bounds__(256) mega(Params p) {
  cg::grid_group grid = cg::this_grid();
  __shared__ __attribute__((aligned(16))) float smem[SMEM_FLOATS];
  char* smc = (char*)smem;
  char* ws = p.ws;
  bf16_t* H = (bf16_t*)(ws + WB_H); bf16_t* Z = (bf16_t*)(ws + WB_Z); float* MGT = (float*)(ws + WB_MGT); bf16_t* XC = (bf16_t*)(ws + WB_XC);
  float* QM = (float*)(ws + WB_QM); float* KM = (float*)(ws + WB_KM); float* HF = (float*)(ws + WB_HF); float* HB = (float*)(ws + WB_HB);
  bf16_t* VT = (bf16_t*)(ws + WB_VT); float* YSF = (float*)(ws + WB_YSF); float* YSB = (float*)(ws + WB_YSB);
  bf16_t* YA = (bf16_t*)(ws + WB_YA); bf16_t* YB = (bf16_t*)(ws + WB_YB); bf16_t* YS = (bf16_t*)(ws + WB_YS); bf16_t* GG = (bf16_t*)(ws + WB_GG);
  bf16_t* MG = (bf16_t*)(ws + WB_MG); bf16_t* PQ = (bf16_t*)(ws + WB_PQ); float* SC = (float*)(ws + WB_SC);
  int* EI = (int*)(ws + WB_EI); float* EG = (float*)(ws + WB_EG);
  const bf16_t* WT = (const bf16_t*)(ws + WB_WT);

  stage_init(p, smem);
  grid.sync();

  for (int l = 0; l < 2; ++l) {
    const bool need_ctx = (l == 0);
    const int rr_lim = need_ctx ? NTOK : NLAT;
    const int tpb = need_ctx ? 34 : 32;
    const bf16_t* W = WT + (size_t)l * WT_LAYER;
    const float lam_init = 0.8f - 0.6f * expf(-0.3f * (float)l);
    float lam;
    {
      float s1 = 0.f, s2 = 0.f;
      for (int i = 0; i < 64; ++i) {
        s1 += p.in[I_LQ1][l * 64 + i] * p.in[I_LK1][l * 64 + i];
        s2 += p.in[I_LQ2][l * 64 + i] * p.in[I_LK2][l * 64 + i];
      }
      lam = expf(s1) - expf(s2) + lam_init;
    }
    for (int g = 0; g < NG; ++g) {
      stage_normmod(p, l, g, 0, NTOK, H, smem);
      grid.sync();
      stage_inproj(p, H, W + WT_WIN, Z, MGT, VT, smc);
      grid.sync();
      stage_conv(p, l, Z, XC);
      grid.sync();
      stage_mlqk(XC, W + WT_WQK, QM, KM, smc);
      grid.sync();
      {
        const int n_attn = 4 * 32 + (need_ctx ? 4 * 2 : 0);
        const int n_items = GB * (40 + n_attn);
        int* cnt = (int*)(ws + WB_CNT) + (l * NG + g);
        int* s_item = (int*)(smem + SMEM_FLOATS - 4);
        for (;;) {
          __syncthreads();
          if (otid() == 0) *s_item = atomicAdd(cnt, 1);
          __syncthreads();
          const int it = *s_item;
          if (it >= n_items) break;
          int bl, k;
          if (it < GB * 8) { bl = it / 8; k = it % 8; }
          else if (it < GB * 40) { bl = (it - GB * 8) / 32; k = 8 + (it - GB * 8) % 32; }
          else { bl = (it - GB * 40) / n_attn; k = 40 + (it - GB * 40) % n_attn; }
          const bf16_t* Zb = Z + (size_t)bl * NTOK * ZW;
          const size_t ro = (size_t)bl * NTOK;
          if (k < 8) {
            mlstm_item(p, l, Zb, MGT + ro * 16, QM + ro * 512, KM + ro * 512, ((k >> 2) ? HB : HF) + ro * 512, k & 3, k >> 2, smem);
          } else if (k < 40) {
            s5_item(p, l, Zb, YSF + ro * 512, YSB + ro * 512, k - 8, smem);
          } else {
            const int a = k - 40;
            const bf16_t* VTb = VT + (size_t)bl * 4 * 128 * NTOK;
            if (a < 128) attn_mfma_item(p, l, Zb, VTb, YA + ro * 512, a & 3, (a >> 2) * 128, 0, NTOK, lam, lam_init, smc);
            else attn_mfma_item(p, l, Zb, VTb, YA + ro * 512, (a - 128) & 3, NLAT + ((a - 128) >> 2) * 128, NLAT, NCTX, lam, lam_init, smc);
          }
        }
      }
      grid.sync();
      stage_post(p, l, rr_lim, Z, HF, HB, YSF, YSB, YB, GG);
      grid.sync();
      stage_glu_mfma(p, l, tpb, GG, W + WT_GLU, YS, smc);
      grid.sync();
      stage_merge_mfma(tpb, YA, YB, YS, W + WT_WBR, Z, MG, smc);
      grid.sync();
      stage_outproj_mfma(p, l, g, tpb, MG, W + WT_WOUT, smc);
      grid.sync();
      stage_normmod(p, l, g, 1, rr_lim, H, smem);
      grid.sync();
      stage_peerq_mfma(tpb, H, W + WT_WQ, PQ, smc);
      grid.sync();
      stage_scores_mfma(tpb, PQ, W + WT_SUBK, SC, smc);
      grid.sync();
      stage_topk(rr_lim, SC, EI, EG);
      grid.sync();
      stage_expert(p, l, g, rr_lim, H, EI, EG, smem);
      grid.sync();
    }
  }
  stage_final(p, smem);
}

extern "C" void kernel_launch(void* const* d_in, const int* in_sizes, int n_in, void* d_out,
                              int out_size, void* d_ws, size_t ws_size, hipStream_t stream) {
  static int grid_blocks = 0;
  if (!grid_blocks) {
    int dev = 0, cus = 0, per_cu = 0;
    (void)hipGetDevice(&dev);
    (void)hipDeviceGetAttribute(&cus, hipDeviceAttributeMultiprocessorCount, dev);
    (void)hipOccupancyMaxActiveBlocksPerMultiprocessor(&per_cu, mega, 256, 0);
    if (per_cu > 1) per_cu = 1;
    grid_blocks = cus * per_cu;
  }
  if (ws_size < WB_END) {
    fprintf(stderr, "workspace too small: %zu < %zu\n", ws_size, (size_t)WB_END);
    return;
  }
  Params p{};
  for (int i = 0; i < N_IN; ++i) p.in[i] = (const float*)d_in[i];
  p.out = (float*)d_out;
  p.ws = (char*)d_ws;
  void* args[] = {&p};
  hipError_t e = hipLaunchCooperativeKernel((void*)mega, dim3(grid_blocks), dim3(256), args, 0, stream);
  if (e != hipSuccess) fprintf(stderr, "cooperative launch failed: %s (grid %d)\n", hipGetErrorString(e), grid_blocks);
}
```

```cpp
#include <hip/hip_runtime.h>
#include <hip/hip_cooperative_groups.h>
#include <cstdio>
#include <cstdint>
namespace cg = cooperative_groups;

#define NLAT 4096
#define NCTX 256
#define NTOK 4352
#define DM 1024
#define INW 6672
#define NB 8
#define GB 2
#define NG (NB / GB)
#define RPG (GB * NTOK)
#define ZW 6656
#define EPSF 1e-6f

enum { I_X = 0, I_C, I_CTX, I_CCTX, I_WMOD, I_BMOD, I_N1G, I_N2G, I_WIN, I_LQ1, I_LK1, I_LQ2, I_LK2, I_SUBG,
       I_CONVW, I_CONVB, I_MLWQ, I_MLWK, I_GATEB, I_MLNG, I_S5LRE, I_S5LIM, I_S5DT, I_S5BRE, I_S5BIM,
       I_S5CRE, I_S5CIM, I_S5D, I_GLUW, I_GLUB, I_WBR, I_WOUT, I_PWQ, I_PSUBK, I_PU, I_PV, I_FG, N_IN };

struct Params {
  const float* in[N_IN];
  float* out;
  char* ws;
};

typedef unsigned short bf16_t;
typedef short bf16x8 __attribute__((ext_vector_type(8)));
typedef float f32x16 __attribute__((ext_vector_type(16)));
typedef unsigned u32x4 __attribute__((ext_vector_type(4)));
typedef unsigned u32x2 __attribute__((ext_vector_type(2)));

#define AL(x) (((x) + 255) & ~(size_t)255)
#define WB_XCX   ((size_t)0)
#define WB_MOD   AL(WB_XCX + (size_t)NB * NCTX * DM * 4)
#define WB_ROPE  AL(WB_MOD + (size_t)2 * 9 * 6144 * 4)
#define WB_WT    AL(WB_ROPE + (size_t)NLAT * 32 * 2 * 4)
#define WT_WIN   ((size_t)0)
#define WT_WQK   (WT_WIN + (size_t)6784 * 1024)
#define WT_GLU   (WT_WQK + (size_t)4 * 256 * 128)
#define WT_WBR   (WT_GLU + (size_t)512 * 512)
#define WT_WOUT  (WT_WBR + (size_t)3 * 1024 * 512)
#define WT_WQ    (WT_WOUT + (size_t)1024 * 1024)
#define WT_SUBK  (WT_WQ + (size_t)2048 * 1024)
#define WT_LAYER (WT_SUBK + (size_t)2 * 128 * 128)
#define WB_H     AL(WB_WT + WT_LAYER * 2 * 2)
#define WB_Z     AL(WB_H + (size_t)RPG * DM * 2)
#define WB_MGT   AL(WB_Z + (size_t)RPG * ZW * 2)
#define WB_XC    AL(WB_MGT + (size_t)RPG * 16 * 4)
#define WB_QM    AL(WB_XC + (size_t)RPG * 512 * 2)
#define WB_KM    AL(WB_QM + (size_t)RPG * 512 * 2)
#define WB_KMT   AL(WB_KM + (size_t)RPG * 512 * 2)
#define WB_MVT   AL(WB_KMT + (size_t)RPG * 512 * 2)
#define WB_HF    AL(WB_MVT + (size_t)RPG * 512 * 2)
#define WB_HB    AL(WB_HF + (size_t)RPG * 512 * 2)
#define WB_YSF   AL(WB_HB + (size_t)RPG * 512 * 2)
#define WB_YSB   AL(WB_YSF + (size_t)RPG * 512 * 4)
#define WB_YA    AL(WB_YSB + (size_t)RPG * 512 * 4)
#define WB_YB    AL(WB_YA + (size_t)RPG * 512 * 2)
#define WB_YS    AL(WB_YB + (size_t)RPG * 512 * 2)
#define WB_GG    AL(WB_YS + (size_t)RPG * 512 * 2)
#define WB_MG    AL(WB_GG + (size_t)RPG * 512 * 2)
#define WB_EI    AL(WB_MG + (size_t)RPG * DM * 2)
#define WB_EG    AL(WB_EI + (size_t)RPG * 128 * 4)
#define WB_U16   AL(WB_EG + (size_t)RPG * 128 * 4)
#define WB_V16   AL(WB_U16 + (size_t)2 * 16384 * 1024 * 2)
#define WB_VT    AL(WB_V16 + (size_t)2 * 16384 * 1024 * 2)
#define WB_CNT   AL(WB_VT + (size_t)GB * 4 * 128 * NTOK * 2)
#define WB_END   AL(WB_CNT + 256)
#define WB_PQ    (WB_Z)
#define WB_SC    AL(WB_PQ + (size_t)RPG * 2048 * 2)

#define SMEM_FLOATS (25 * 1024)

__device__ __forceinline__ float sigmoidf_(float x) { return 1.0f / (1.0f + expf(-x)); }
__device__ __forceinline__ float siluf_(float x) { return x / (1.0f + expf(-x)); }
__device__ __forceinline__ float geluf_(float x) { return 0.5f * x * (1.0f + erff(x * 0.70710678118654752f)); }
__device__ __forceinline__ int otid() { int t = threadIdx.x; asm volatile("" : "+v"(t)); return t; }
__device__ __forceinline__ float wave_sum(float v) {
  for (int o = 32; o > 0; o >>= 1) v += __shfl_xor(v, o);
  return v;
}
__device__ __forceinline__ bf16_t f2bf(float x) { unsigned u = __float_as_uint(x); u += 0x7fffu + ((u >> 16) & 1u); return (bf16_t)(u >> 16); }
__device__ __forceinline__ float bf2f(bf16_t h) { return __uint_as_float(((unsigned)h) << 16); }
typedef float f32x2 __attribute__((ext_vector_type(2)));
typedef __bf16 bf16x2_t __attribute__((ext_vector_type(2)));
__device__ __forceinline__ unsigned pack2(float a, float b) { f32x2 v = {a, b}; return __builtin_bit_cast(unsigned, __builtin_convertvector(v, bf16x2_t)); }
__device__ __forceinline__ float lo16(unsigned u) { return __uint_as_float(u << 16); }
__device__ __forceinline__ float hi16(unsigned u) { return __uint_as_float(u & 0xffff0000u); }

__device__ __forceinline__ float* xrow(const Params& p, int b, int rr) {
  return (rr < NLAT) ? p.out + ((size_t)b * NLAT + rr) * DM : (float*)(p.ws + WB_XCX) + ((size_t)b * NCTX + (rr - NLAT)) * DM;
}

__device__ __forceinline__ void gemm_tile(const bf16_t* __restrict__ Ag, int lda, const bf16_t* __restrict__ Bg, int ldb, int K,
                                          char* smem, f32x16 (&acc)[2][2]) {
  const int tid = otid(), lane = tid & 63, w = tid >> 6, wm = w >> 1, wn = w & 1;
#pragma unroll
  for (int a = 0; a < 2; ++a)
#pragma unroll
    for (int b = 0; b < 2; ++b)
#pragma unroll
      for (int i = 0; i < 16; ++i) acc[a][b][i] = 0.f;
  const int srow = tid >> 3, sch = tid & 7;
  const bf16_t* ap = Ag + (size_t)srow * lda + sch * 8;
  const bf16_t* bp = Bg + (size_t)srow * ldb + sch * 8;
  const int wofs = srow * 128 + ((sch ^ ((srow >> 1) & 7)) << 4);
  const int fr = lane & 31, fh = lane >> 5, fsw = (fr >> 1) & 7;
  const int aofs = (wm * 64 + fr) * 128, bofs = 16384 + (wn * 64 + fr) * 128;
  u32x4 ra[4], rb[4];
  const int nk = K >> 6;
#pragma unroll
  for (int i = 0; i < 4; ++i) {
    ra[i] = *(const u32x4*)(ap + (size_t)i * 32 * lda);
    rb[i] = *(const u32x4*)(bp + (size_t)i * 32 * ldb);
  }
  __syncthreads();
#pragma unroll
  for (int i = 0; i < 4; ++i) {
    *(u32x4*)(smem + wofs + i * 4096) = ra[i];
    *(u32x4*)(smem + 16384 + wofs + i * 4096) = rb[i];
  }
  __syncthreads();
  for (int kt = 0; kt < nk; ++kt) {
    const bool more = (kt + 1 < nk);
    if (more) {
#pragma unroll
      for (int i = 0; i < 4; ++i) {
        ra[i] = *(const u32x4*)(ap + (size_t)i * 32 * lda + (kt + 1) * 64);
        rb[i] = *(const u32x4*)(bp + (size_t)i * 32 * ldb + (kt + 1) * 64);
      }
    }
    const char* base = smem + (kt & 1) * 32768;
#pragma unroll
    for (int ks = 0; ks < 4; ++ks) {
      const int coff = ((ks * 2 + fh) ^ fsw) << 4;
      bf16x8 af[2], bfr[2];
#pragma unroll
      for (int mi = 0; mi < 2; ++mi) af[mi] = *(const bf16x8*)(base + aofs + mi * 4096 + coff);
#pragma unroll
      for (int ni = 0; ni < 2; ++ni) bfr[ni] = *(const bf16x8*)(base + bofs + ni * 4096 + coff);
#pragma unroll
      for (int mi = 0; mi < 2; ++mi)
#pragma unroll
        for (int ni = 0; ni < 2; ++ni)
          acc[mi][ni] = __builtin_amdgcn_mfma_f32_32x32x16_bf16(bfr[ni], af[mi], acc[mi][ni], 0, 0, 0);
    }
    if (more) {
      char* nb = smem + ((kt + 1) & 1) * 32768;
#pragma unroll
      for (int i = 0; i < 4; ++i) {
        *(u32x4*)(nb + wofs + i * 4096) = ra[i];
        *(u32x4*)(nb + 16384 + wofs + i * 4096) = rb[i];
      }
    }
    __syncthreads();
  }
}
#define EPI_DECL const int tid_ = otid(); const int lane = tid_ & 63, w_ = tid_ >> 6, wm = w_ >> 1, wn = w_ & 1, fr = lane & 31, fh = lane >> 5; (void)fr; (void)fh; (void)wm; (void)wn;
#define EPI_ROW(mi) (wm * 64 + (mi) * 32 + fr)
#define EPI_COL(ni, q) (wn * 64 + (ni) * 32 + 8 * (q) + 4 * fh)
#define MT_LR0(mt, tpb) (((mt) / (tpb)) * NTOK + ((mt) % (tpb)) * 128)

template <class F>
__device__ __forceinline__ void transpose_cvt(const float* __restrict__ src, int ld, F srccol, int K, int Ndst, bf16_t* __restrict__ dst, float* smem) {
  float (*T)[65] = (float (*)[65])smem;
  const int tid = otid();
  const int tk = K >> 6, tn = Ndst >> 6;
  for (int t = blockIdx.x; t < tn * tk; t += gridDim.x) {
    const int n0 = (t / tk) * 64, k0 = (t % tk) * 64;
    __syncthreads();
    const int sc = srccol(n0 + (tid & 63));
#pragma unroll
    for (int i = 0; i < 16; ++i) {
      const int ky = (tid >> 6) + 4 * i;
      T[ky][tid & 63] = (sc >= 0) ? src[(size_t)(k0 + ky) * ld + sc] : 0.f;
    }
    __syncthreads();
#pragma unroll
    for (int i = 0; i < 16; ++i) {
      const int ny = (tid >> 6) + 4 * i;
      dst[(size_t)(n0 + ny) * K + k0 + (tid & 63)] = f2bf(T[tid & 63][ny]);
    }
  }
  __syncthreads();
}
__device__ __forceinline__ int win_srccol(int n) {
  if (n < 3072) return n;
  if (n < 6656) return n + 16;
  if (n < 6672) return n - 3584;
  return -1;
}

__device__ __forceinline__ void stage_init(const Params& p, float* smem) {
  const int tid = otid();
  {
    const size_t n4 = (size_t)NB * NLAT * 256;
    const float4* s = (const float4*)p.in[I_X];
    float4* d = (float4*)p.out;
    for (size_t i = (size_t)blockIdx.x * 256 + tid; i < n4; i += (size_t)gridDim.x * 256) d[i] = s[i];
    const size_t m4 = (size_t)NB * NCTX * 256;
    const float4* s2 = (const float4*)p.in[I_CTX];
    float4* d2 = (float4*)(p.ws + WB_XCX);
    for (size_t i = (size_t)blockIdx.x * 256 + tid; i < m4; i += (size_t)gridDim.x * 256) d2[i] = s2[i];
  }
  if (blockIdx.x == 0 && tid < 64) ((int*)(p.ws + WB_CNT))[tid] = 0;
  {
    const size_t n8 = (size_t)2 * 16384 * 1024 / 8;
    const float4* su = (const float4*)p.in[I_PU];
    const float4* sv = (const float4*)p.in[I_PV];
    u32x4* du = (u32x4*)(p.ws + WB_U16);
    u32x4* dv = (u32x4*)(p.ws + WB_V16);
    for (size_t i = (size_t)blockIdx.x * 256 + tid; i < n8; i += (size_t)gridDim.x * 256) {
      const float4 a = su[2 * i], b = su[2 * i + 1];
      du[i] = (u32x4){pack2(a.x, a.y), pack2(a.z, a.w), pack2(b.x, b.y), pack2(b.z, b.w)};
      const float4 c = sv[2 * i], d = sv[2 * i + 1];
      dv[i] = (u32x4){pack2(c.x, c.y), pack2(c.z, c.w), pack2(d.x, d.y), pack2(d.z, d.w)};
    }
  }
  {
    float2* rt = (float2*)(p.ws + WB_ROPE);
    for (int i = blockIdx.x * 256 + tid; i < NLAT * 32; i += gridDim.x * 256) {
      const int pos = i >> 5, j = i & 31;
      const float inv = powf(10000.0f, -(float)(j & 15) / 16.0f);
      const float ang = (float)((j < 16) ? (pos >> 6) : (pos & 63)) * inv;
      rt[i] = make_float2(cosf(ang), sinf(ang));
    }
  }
  {
    float* sc = smem;
    for (int i = tid; i < 9 * 1024; i += 256) {
      int r = i >> 10, k = i & 1023;
      float v = (r < 8) ? p.in[I_C][r * 1024 + k] : p.in[I_CCTX][k];
      sc[i] = siluf_(v);
    }
    __syncthreads();
    float* mod = (float*)(p.ws + WB_MOD);
    for (int col = blockIdx.x * 256 + tid; col < 2 * 6144; col += gridDim.x * 256) {
      int l = col / 6144, j = col % 6144;
      const float* w = p.in[I_WMOD] + (size_t)l * 1024 * 6144 + j;
      float acc[9];
#pragma unroll
      for (int r = 0; r < 9; ++r) acc[r] = 0.f;
      for (int k = 0; k < 1024; ++k) {
        float wv = w[(size_t)k * 6144];
#pragma unroll
        for (int r = 0; r < 9; ++r) acc[r] = fmaf(sc[r * 1024 + k], wv, acc[r]);
      }
      float bv = p.in[I_BMOD][l * 6144 + j];
#pragma unroll
      for (int r = 0; r < 9; ++r) mod[((size_t)l * 9 + r) * 6144 + j] = acc[r] + bv;
    }
    __syncthreads();
  }
  bf16_t* WT = (bf16_t*)(p.ws + WB_WT);
  for (int l = 0; l < 2; ++l) {
    bf16_t* W = WT + (size_t)l * WT_LAYER;
    transpose_cvt(p.in[I_WIN] + (size_t)l * DM * INW, INW, [](int n) { return win_srccol(n); }, DM, 6784, W + WT_WIN, smem);
    for (int h = 0; h < 4; ++h) {
      transpose_cvt(p.in[I_MLWQ] + ((size_t)l * 4 + h) * 16384, 128, [](int n) { return n; }, 128, 128, W + WT_WQK + (size_t)h * 256 * 128, smem);
      transpose_cvt(p.in[I_MLWK] + ((size_t)l * 4 + h) * 16384, 128, [](int n) { return n; }, 128, 128, W + WT_WQK + (size_t)h * 256 * 128 + 128 * 128, smem);
    }
    transpose_cvt(p.in[I_GLUW] + (size_t)l * 512 * 512, 512, [](int n) { return n; }, 512, 512, W + WT_GLU, smem);
    for (int r = 0; r < 3; ++r)
      transpose_cvt(p.in[I_WBR] + ((size_t)l * 3 + r) * 512 * DM, DM, [](int n) { return n; }, 512, DM, W + WT_WBR + (size_t)r * 1024 * 512, smem);
    transpose_cvt(p.in[I_WOUT] + (size_t)l * DM * DM, DM, [](int n) { return n; }, DM, DM, W + WT_WOUT, smem);
    transpose_cvt(p.in[I_PWQ] + (size_t)l * DM * 2048, 2048, [](int n) { return n; }, DM, 2048, W + WT_WQ, smem);
    const float* sk = p.in[I_PSUBK] + (size_t)l * 2 * 128 * 128;
    for (int i = blockIdx.x * 256 + tid; i < 2 * 128 * 128; i += gridDim.x * 256) W[WT_SUBK + i] = f2bf(sk[i]);
  }
}

__device__ __forceinline__ void stage_normmod(const Params& p, int l, int g, int which, int rr_lim, bf16_t* H, float* smem) {
  const int tid = otid();
  const float* ng = p.in[which ? I_N2G : I_N1G] + l * DM;
  const float* mod = (const float*)(p.ws + WB_MOD) + (size_t)l * 9 * 6144;
  const int off_sh = which ? 3072 : 0, off_sc = which ? 4096 : 1024;
  const int per = rr_lim;
  for (int i = blockIdx.x; i < GB * per; i += gridDim.x) {
    const int bl = i / per, rr = i % per, b = g * GB + bl;
    const float* X = xrow(p, b, rr);
    float4 v = ((const float4*)X)[tid];
    float s = wave_sum(v.x * v.x + v.y * v.y + v.z * v.z + v.w * v.w);
    __syncthreads();
    if ((tid & 63) == 0) smem[tid >> 6] = s;
    __syncthreads();
    float tot = smem[0] + smem[1] + smem[2] + smem[3];
    float rs = rsqrtf(tot * (1.0f / DM) + EPSF);
    const float* m = mod + (size_t)((rr < NLAT) ? b : 8) * 6144;
    float4 gg = ((const float4*)ng)[tid];
    float4 sc = ((const float4*)(m + off_sc))[tid];
    float4 sh = ((const float4*)(m + off_sh))[tid];
    float4 o;
    o.x = v.x * rs * gg.x * (1.f + sc.x) + sh.x;
    o.y = v.y * rs * gg.y * (1.f + sc.y) + sh.y;
    o.z = v.z * rs * gg.z * (1.f + sc.z) + sh.z;
    o.w = v.w * rs * gg.w * (1.f + sc.w) + sh.w;
    ((u32x2*)(H + ((size_t)bl * NTOK + rr) * DM))[tid] = (u32x2){pack2(o.x, o.y), pack2(o.z, o.w)};
  }
  __syncthreads();
}

__device__ __forceinline__ void stage_inproj(const Params& p, const bf16_t* H, const bf16_t* WinT, bf16_t* Z, float* MGT, bf16_t* VT, bf16_t* MVT, char* smem) {
  EPI_DECL
  const int tm = GB * 34, tn = 53;
  const float2* rt = (const float2*)(p.ws + WB_ROPE);
  for (int t = blockIdx.x; t < tm * tn; t += gridDim.x) {
    const int mt = t / tn, j = t % tn, n0 = j * 128;
    const int lr0 = MT_LR0(mt, 34), rr0 = (mt % 34) * 128;
    f32x16 acc[2][2];
    if ((j >= 8 && j < 12) || (j >= 16 && j < 20)) {
      gemm_tile(WinT + (size_t)n0 * DM, DM, H + (size_t)lr0 * DM, DM, DM, smem, acc);
      bf16_t* vt = ((j < 12) ? VT : MVT) + ((size_t)(mt / 34) * 4 + (j & 3)) * 128 * NTOK;
#pragma unroll
      for (int mi = 0; mi < 2; ++mi)
#pragma unroll
        for (int ni = 0; ni < 2; ++ni)
#pragma unroll
          for (int q = 0; q < 4; ++q) {
            const int e = EPI_ROW(mi), tok = rr0 + EPI_COL(ni, q);
            *(u32x2*)(vt + (size_t)e * NTOK + tok) = (u32x2){pack2(acc[mi][ni][4 * q], acc[mi][ni][4 * q + 1]), pack2(acc[mi][ni][4 * q + 2], acc[mi][ni][4 * q + 3])};
          }
      continue;
    }
    gemm_tile(H + (size_t)lr0 * DM, DM, WinT + (size_t)n0 * DM, DM, DM, smem, acc);
    if (j < 8 && rr0 < NLAT) {
#pragma unroll
      for (int mi = 0; mi < 2; ++mi) {
        const int pos = rr0 + EPI_ROW(mi);
#pragma unroll
        for (int i = 0; i < 16; ++i) {
          const int jj = 8 * (i >> 2) + 4 * fh + (i & 3);
          const float2 cs = rt[pos * 32 + jj];
          const float x1 = acc[mi][0][i], x2 = acc[mi][1][i];
          acc[mi][0][i] = x1 * cs.x - x2 * cs.y;
          acc[mi][1][i] = x1 * cs.y + x2 * cs.x;
        }
      }
    }
    if (j < 52) {
      const bool sg = (j >= 28);
#pragma unroll
      for (int mi = 0; mi < 2; ++mi)
#pragma unroll
        for (int ni = 0; ni < 2; ++ni)
#pragma unroll
          for (int q = 0; q < 4; ++q) {
            const int row = lr0 + EPI_ROW(mi), c = n0 + EPI_COL(ni, q);
            float v0 = acc[mi][ni][4 * q], v1 = acc[mi][ni][4 * q + 1], v2 = acc[mi][ni][4 * q + 2], v3 = acc[mi][ni][4 * q + 3];
            if (sg) { v0 = sigmoidf_(v0); v1 = sigmoidf_(v1); v2 = sigmoidf_(v2); v3 = sigmoidf_(v3); }
            *(u32x2*)(Z + (size_t)row * ZW + c) = (u32x2){pack2(v0, v1), pack2(v2, v3)};
          }
    } else {
#pragma unroll
      for (int mi = 0; mi < 2; ++mi)
#pragma unroll
        for (int q = 0; q < 2; ++q) {
          const int row = lr0 + EPI_ROW(mi), c = EPI_COL(0, q);
          if (wn == 0) *(float4*)(MGT + (size_t)row * 16 + c) = make_float4(acc[mi][0][4 * q], acc[mi][0][4 * q + 1], acc[mi][0][4 * q + 2], acc[mi][0][4 * q + 3]);
        }
    }
  }
}

__device__ __forceinline__ void stage_conv(const Params& p, int l, const bf16_t* Z, bf16_t* XC) {
  const int tid = otid();
  const float* cw = p.in[I_CONVW] + (size_t)l * 3 * 512;
  const float* cb = p.in[I_CONVB] + (size_t)l * 512;
  const int c = tid * 2;
  const float2 w0 = *(const float2*)(cw + c), w1 = *(const float2*)(cw + 512 + c), w2 = *(const float2*)(cw + 1024 + c), bb = *(const float2*)(cb + c);
  for (int lr = blockIdx.x; lr < RPG; lr += gridDim.x) {
    const int rr = lr % NTOK;
    const bool has_prev = (rr < NLAT) ? (rr > 0) : (rr > NLAT);
    const bool has_next = (rr < NLAT) ? (rr < NLAT - 1) : (rr < NTOK - 1);
    const bf16_t* z = Z + (size_t)lr * ZW + 1536 + c;
    const unsigned xc = *(const unsigned*)z;
    float a0 = bb.x + w1.x * lo16(xc), a1 = bb.y + w1.y * hi16(xc);
    if (has_prev) { const unsigned xp = *(const unsigned*)(z - ZW); a0 += w0.x * lo16(xp); a1 += w0.y * hi16(xp); }
    if (has_next) { const unsigned xn = *(const unsigned*)(z + ZW); a0 += w2.x * lo16(xn); a1 += w2.y * hi16(xn); }
    *(unsigned*)(XC + (size_t)lr * 512 + c) = pack2(siluf_(a0), siluf_(a1));
  }
}

__device__ __forceinline__ void stage_mlqk(const bf16_t* XC, const bf16_t* WQK, bf16_t* QM, bf16_t* KM, bf16_t* KMT, char* smem) {
  EPI_DECL
  const int tm = RPG >> 7;
  for (int t = blockIdx.x; t < tm * 12; t += gridDim.x) {
    const int mt = t / 12, r12 = t % 12, h = r12 & 3, kind = r12 >> 2;
    const int m0 = mt * 128;
    f32x16 acc[2][2];
    const bf16_t* Wt = WQK + (size_t)h * 256 * 128 + (size_t)(kind ? 1 : 0) * 128 * 128;
    const bf16_t* Xt = XC + (size_t)m0 * 512 + h * 128;
    if (kind < 2) {
      gemm_tile(Xt, 512, Wt, 128, 128, smem, acc);
      bf16_t* O = kind ? KM : QM;
      const float alpha = kind ? 1.0f : 0.08838834764831845f;
#pragma unroll
      for (int mi = 0; mi < 2; ++mi)
#pragma unroll
        for (int ni = 0; ni < 2; ++ni)
#pragma unroll
          for (int q = 0; q < 4; ++q) {
            const int row = m0 + EPI_ROW(mi), c = EPI_COL(ni, q);
            *(u32x2*)(O + (size_t)row * 512 + h * 128 + c) = (u32x2){pack2(alpha * acc[mi][ni][4 * q], alpha * acc[mi][ni][4 * q + 1]), pack2(alpha * acc[mi][ni][4 * q + 2], alpha * acc[mi][ni][4 * q + 3])};
          }
    } else {
      gemm_tile(Wt, 128, Xt, 512, 128, smem, acc);
      bf16_t* kt = KMT + ((size_t)(mt / 34) * 4 + h) * 128 * NTOK + (mt % 34) * 128;
#pragma unroll
      for (int mi = 0; mi < 2; ++mi)
#pragma unroll
        for (int ni = 0; ni < 2; ++ni)
#pragma unroll
          for (int q = 0; q < 4; ++q) {
            const int d = EPI_ROW(mi), tok = EPI_COL(ni, q);
            *(u32x2*)(kt + (size_t)d * NTOK + tok) = (u32x2){pack2(acc[mi][ni][4 * q], acc[mi][ni][4 * q + 1]), pack2(acc[mi][ni][4 * q + 2], acc[mi][ni][4 * q + 3])};
          }
    }
  }
}

__device__ __forceinline__ void attn_mfma_item(const Params& p, int l, const bf16_t* Zb, const bf16_t* VTb, bf16_t* YAb, int h, int qrow0, int key0, int nkeys,
                                               float lam, float lam_init, char* smem) {
  const int tid = otid(), lane = tid & 63, w = tid >> 6, fr = lane & 31, fh = lane >> 5;
  const int ntiles = nkeys >> 6;
  const int myrow = qrow0 + w * 32 + fr;
  bf16x8 qf[2][4];
  {
    const bf16_t* qp = Zb + (size_t)myrow * ZW + h * 128 + fh * 8;
#pragma unroll
    for (int m = 0; m < 2; ++m)
#pragma unroll
      for (int ks = 0; ks < 4; ++ks) qf[m][ks] = *(const bf16x8*)(qp + m * 64 + ks * 16);
  }
  f32x16 O[2][4];
#pragma unroll
  for (int m = 0; m < 2; ++m)
#pragma unroll
    for (int eb = 0; eb < 4; ++eb)
#pragma unroll
      for (int i = 0; i < 16; ++i) O[m][eb][i] = 0.f;
  float mrun[2] = {-1e30f, -1e30f}, lrun[2] = {0.f, 0.f};
  const float cs = 0.125f * 1.4426950408889634f;
  const int skey = tid >> 4, sch = tid & 15;
  const bf16_t* ksrc = Zb + (size_t)(key0 + skey) * ZW + 512 + h * 128 + sch * 8;
  const int kdst = skey * 256 + ((sch ^ (skey & 15)) << 4);
  const int se = tid >> 3, svc = tid & 7;
  const bf16_t* vsrc = VTb + ((size_t)h * 128 + se) * NTOK + key0 + svc * 8;
  const int vsw = (se >> 1) & 15;
  const int vdst0 = se * 128 + (((2 * svc) ^ vsw) << 3), vdst1 = se * 128 + (((2 * svc + 1) ^ vsw) << 3);
  const int kfo = fr * 256, kfs = fr & 15;
  const int vfo = fr * 128, vfs = (fr >> 1) & 15;
  u32x4 rk[4], rv[4];
#pragma unroll
  for (int i = 0; i < 4; ++i) rk[i] = *(const u32x4*)(ksrc + (size_t)i * 16 * ZW);
  __syncthreads();
#pragma unroll
  for (int i = 0; i < 4; ++i) *(u32x4*)(smem + kdst + i * 4096) = rk[i];
  __syncthreads();
  bf16x8 pf[2][4];
#pragma unroll
  for (int m = 0; m < 2; ++m)
#pragma unroll
    for (int s = 0; s < 4; ++s)
#pragma unroll
      for (int i = 0; i < 8; ++i) pf[m][s][i] = 0;
#pragma unroll 1
  for (int t = 0; t <= ntiles; ++t) {
    const bool cur = t < ntiles, nxt = t + 1 < ntiles, prv = t >= 1;
    if (nxt) {
#pragma unroll
      for (int i = 0; i < 4; ++i) rk[i] = *(const u32x4*)(ksrc + (size_t)((t + 1) * 64 + i * 16) * ZW);
    }
    if (cur) {
#pragma unroll
      for (int i = 0; i < 4; ++i) rv[i] = *(const u32x4*)(vsrc + (size_t)i * 32 * NTOK + t * 64);
    }
    const char* kb_ = smem + (t & 1) * 16384;
    f32x16 S[2];
    if (cur) {
#pragma unroll
      for (int kb = 0; kb < 2; ++kb) {
#pragma unroll
        for (int i = 0; i < 16; ++i) S[kb][i] = 0.f;
#pragma unroll
        for (int ks = 0; ks < 4; ++ks) {
          const bf16x8 kf = *(const bf16x8*)(kb_ + kb * 8192 + kfo + (((ks * 2 + fh) ^ kfs) << 4));
          S[kb] = __builtin_amdgcn_mfma_f32_32x32x16_bf16(kf, qf[0][ks], S[kb], 0, 0, 0);
        }
      }
    }
    if (prv) {
      const char* vb_ = smem + 32768 + ((t - 1) & 1) * 16384;
#pragma unroll
      for (int eb = 0; eb < 4; ++eb)
#pragma unroll
        for (int s = 0; s < 4; ++s) {
          const u32x2 v0 = *(const u32x2*)(vb_ + eb * 4096 + vfo + (((4 * s + fh) ^ vfs) << 3));
          const u32x2 v1 = *(const u32x2*)(vb_ + eb * 4096 + vfo + (((4 * s + fh + 2) ^ vfs) << 3));
          const bf16x8 vf = __builtin_bit_cast(bf16x8, (u32x4){v0[0], v0[1], v1[0], v1[1]});
          O[0][eb] = __builtin_amdgcn_mfma_f32_32x32x16_bf16(vf, pf[0][s], O[0][eb], 0, 0, 0);
          O[1][eb] = __builtin_amdgcn_mfma_f32_32x32x16_bf16(vf, pf[1][s], O[1][eb], 0, 0, 0);
        }
    }
    if (cur) {
#pragma unroll
      for (int m = 0; m < 2; ++m) {
        if (m == 1) {
#pragma unroll
          for (int kb = 0; kb < 2; ++kb) {
#pragma unroll
            for (int i = 0; i < 16; ++i) S[kb][i] = 0.f;
#pragma unroll
            for (int ks = 0; ks < 4; ++ks) {
              const bf16x8 kf = *(const bf16x8*)(kb_ + kb * 8192 + kfo + (((8 + ks * 2 + fh) ^ kfs) << 4));
              S[kb] = __builtin_amdgcn_mfma_f32_32x32x16_bf16(kf, qf[1][ks], S[kb], 0, 0, 0);
            }
          }
        }
        float tm = S[0][0];
#pragma unroll
        for (int i = 1; i < 16; ++i) tm = fmaxf(tm, S[0][i]);
#pragma unroll
        for (int i = 0; i < 16; ++i) tm = fmaxf(tm, S[1][i]);
        tm = fmaxf(tm, __shfl_xor(tm, 32)) * cs;
        float alpha = 1.f;
        if (tm > mrun[m] + 8.0f) { alpha = exp2f(mrun[m] - tm); mrun[m] = tm; }
        if (__any(alpha != 1.f)) {
#pragma unroll
          for (int eb = 0; eb < 4; ++eb)
#pragma unroll
            for (int i = 0; i < 16; ++i) O[m][eb][i] *= alpha;
          lrun[m] *= alpha;
        }
        const float mc = mrun[m];
        float rs = 0.f;
#pragma unroll
        for (int kb = 0; kb < 2; ++kb) {
          float pv[16];
#pragma unroll
          for (int i = 0; i < 16; ++i) { pv[i] = exp2f(fmaf(S[kb][i], cs, -mc)); rs += pv[i]; }
#pragma unroll
          for (int hh = 0; hh < 2; ++hh)
            pf[m][kb * 2 + hh] = __builtin_bit_cast(bf16x8, (u32x4){pack2(pv[8 * hh], pv[8 * hh + 1]), pack2(pv[8 * hh + 2], pv[8 * hh + 3]),
                                                                     pack2(pv[8 * hh + 4], pv[8 * hh + 5]), pack2(pv[8 * hh + 6], pv[8 * hh + 7])});
        }
        lrun[m] += rs;
      }
    }
    if (nxt) {
      char* kd = smem + ((t + 1) & 1) * 16384;
#pragma unroll
      for (int i = 0; i < 4; ++i) *(u32x4*)(kd + kdst + i * 4096) = rk[i];
    }
    if (cur) {
      char* vd = smem + 32768 + (t & 1) * 16384;
#pragma unroll
      for (int i = 0; i < 4; ++i) {
        *(u32x2*)(vd + vdst0 + i * 4096) = (u32x2){rv[i][0], rv[i][1]};
        *(u32x2*)(vd + vdst1 + i * 4096) = (u32x2){rv[i][2], rv[i][3]};
      }
    }
    __syncthreads();
  }
  const float l0 = lrun[0] + __shfl_xor(lrun[0], 32), l1 = lrun[1] + __shfl_xor(lrun[1], 32);
  const float i0 = 1.0f / l0, i1 = lam / l1;
  float ss = 0.f;
#pragma unroll
  for (int eb = 0; eb < 4; ++eb)
#pragma unroll
    for (int i = 0; i < 16; ++i) { const float o = O[0][eb][i] * i0 - O[1][eb][i] * i1; O[0][eb][i] = o; ss = fmaf(o, o, ss); }
  ss += __shfl_xor(ss, 32);
  const float rn = rsqrtf(ss * (1.0f / 128.0f) + EPSF) * (1.0f - lam_init);
  const float* sg = p.in[I_SUBG] + l * 512 + h * 128;
  bf16_t* yp = YAb + (size_t)myrow * 512 + h * 128;
#pragma unroll
  for (int eb = 0; eb < 4; ++eb)
#pragma unroll
    for (int q = 0; q < 4; ++q) {
      const int e = eb * 32 + 8 * q + 4 * fh;
      const float4 g = *(const float4*)(sg + e);
      *(u32x2*)(yp + e) = (u32x2){pack2(O[0][eb][4 * q] * rn * g.x, O[0][eb][4 * q + 1] * rn * g.y), pack2(O[0][eb][4 * q + 2] * rn * g.z, O[0][eb][4 * q + 3] * rn * g.w)};
    }
  __syncthreads();
}

__device__ __forceinline__ void mlstm_chain_item(const Params& p, int l, const bf16_t* QMb, const bf16_t* KMb, const bf16_t* KMTb, const bf16_t* MVTb,
                                                 const float* MGTb, bf16_t* HXb, int h, int dir, char* smem) {
  const int tid = otid(), lane = tid & 63, w = tid >> 6, fr = lane & 31, fh = lane >> 5;
  const int tb = w & 1, eh = w >> 1;
  float* fl = (float*)(smem + 98304);
  float* bs = fl; float* as_ = fl + 64; float* wgs = fl + 128; float* ebs = fl + 192; float* nprev = fl + 256; float* npart = fl + 384; float* dec_s = fl + 640;
  const float bi = p.in[I_GATEB][l * 16 + dir * 8 + h];
  const float bf_ = p.in[I_GATEB][l * 16 + dir * 8 + 4 + h];
  f32x16 CT[4];
#pragma unroll
  for (int eb = 0; eb < 4; ++eb)
#pragma unroll
    for (int i = 0; i < 16; ++i) CT[eb][i] = 0.f;
  __syncthreads();
  for (int i = tid; i < 2048; i += 256) ((u32x4*)(smem + 65536))[i] = (u32x4){0u, 0u, 0u, 0u};
  if (tid < 128) nprev[tid] = 0.f;
  const int qr = tid >> 4, qc = tid & 15;
  const int qdst = qr * 256 + ((qc ^ (qr & 15)) << 4);
  const int tr = tid >> 3, tc = tid & 7;
  const int tdst = tr * 128 + ((tc ^ ((tr >> 1) & 7)) << 4);
  const int sw16 = fr & 15, sw8 = (fr >> 1) & 7;
#pragma unroll 1
  for (int c = 0; c < 68; ++c) {
    const int row0 = (dir == 0) ? ((c < 4) ? NLAT + 64 * c : 64 * (c - 4)) : ((c < 4) ? NLAT + 64 * (3 - c) : 64 * (67 - c));
    __syncthreads();
    {
      const bf16_t* qs = QMb + (size_t)(row0 + qr) * 512 + h * 128 + qc * 8;
      const bf16_t* ks = KMb + (size_t)(row0 + qr) * 512 + h * 128 + qc * 8;
      const bf16_t* kts = KMTb + ((size_t)h * 128 + tr) * NTOK + row0 + tc * 8;
      const bf16_t* vts = MVTb + ((size_t)h * 128 + tr) * NTOK + row0 + tc * 8;
      u32x4 a[4], b[4], cc[4], d[4];
#pragma unroll
      for (int i = 0; i < 4; ++i) {
        a[i] = *(const u32x4*)(qs + (size_t)i * 16 * 512);
        b[i] = *(const u32x4*)(ks + (size_t)i * 16 * 512);
        cc[i] = *(const u32x4*)(kts + (size_t)i * 32 * NTOK);
        d[i] = *(const u32x4*)(vts + (size_t)i * 32 * NTOK);
      }
#pragma unroll
      for (int i = 0; i < 4; ++i) {
        *(u32x4*)(smem + qdst + i * 4096) = a[i];
        *(u32x4*)(smem + 16384 + qdst + i * 4096) = b[i];
        *(u32x4*)(smem + 32768 + tdst + i * 4096) = cc[i];
        *(u32x4*)(smem + 49152 + tdst + i * 4096) = d[i];
      }
    }
    if (w == 0) {
      const int row = row0 + lane;
      const float li = MGTb[(size_t)row * 16 + dir * 8 + h] + bi;
      const float x = MGTb[(size_t)row * 16 + dir * 8 + 4 + h] + bf_;
      const float lf = fminf(x, 0.f) - log1pf(expf(-fabsf(x)));
      float b = lf;
#pragma unroll
      for (int o = 1; o < 64; o <<= 1) {
        const float v = (dir == 0) ? __shfl_up(b, o) : __shfl_down(b, o);
        const bool ok = (dir == 0) ? (lane >= o) : (lane + o < 64);
        if (ok) b += v;
      }
      const float tot = (dir == 0) ? __shfl(b, 63) : __shfl(b, 0);
      bs[lane] = b; as_[lane] = li - b; wgs[lane] = expf(tot + li - b); ebs[lane] = expf(b);
      if (lane == 0) *dec_s = expf(tot);
    }
    __syncthreads();
    const int t = tb * 32 + fr;
    bf16x8 qf[8];
#pragma unroll
    for (int ks = 0; ks < 8; ++ks) qf[ks] = *(const bf16x8*)(smem + t * 256 + (((ks * 2 + fh) ^ sw16) << 4));
    const float bt = bs[t], ebt = ebs[t];
    f32x16 S[2];
    float dsum = 0.f;
#pragma unroll
    for (int sb = 0; sb < 2; ++sb) {
#pragma unroll
      for (int i = 0; i < 16; ++i) S[sb][i] = 0.f;
      const bool valid = (dir == 0) ? (sb <= tb) : (sb >= tb);
      if (valid) {
#pragma unroll
        for (int ks = 0; ks < 8; ++ks) {
          const bf16x8 kf = *(const bf16x8*)(smem + 16384 + (sb * 32 + fr) * 256 + (((ks * 2 + fh) ^ sw16) << 4));
          S[sb] = __builtin_amdgcn_mfma_f32_32x32x16_bf16(kf, qf[ks], S[sb], 0, 0, 0);
        }
#pragma unroll
        for (int q = 0; q < 4; ++q) {
          const float4 a4 = *(const float4*)(as_ + sb * 32 + 8 * q + 4 * fh);
          const float av[4] = {a4.x, a4.y, a4.z, a4.w};
#pragma unroll
          for (int j = 0; j < 4; ++j) {
            const int s = sb * 32 + 8 * q + 4 * fh + j;
            const bool ok = (dir == 0) ? (s <= t) : (s >= t);
            const float v = ok ? S[sb][4 * q + j] * expf(bt + av[j]) : 0.f;
            S[sb][4 * q + j] = v;
            dsum += v;
          }
        }
      }
    }
    bf16x8 pf[4];
#pragma unroll
    for (int sb = 0; sb < 2; ++sb)
#pragma unroll
      for (int hh = 0; hh < 2; ++hh)
        pf[sb * 2 + hh] = __builtin_bit_cast(bf16x8, (u32x4){pack2(S[sb][8 * hh], S[sb][8 * hh + 1]), pack2(S[sb][8 * hh + 2], S[sb][8 * hh + 3]),
                                                                 pack2(S[sb][8 * hh + 4], S[sb][8 * hh + 5]), pack2(S[sb][8 * hh + 6], S[sb][8 * hh + 7])});
    float nq = 0.f;
#pragma unroll
    for (int c8 = 0; c8 < 8; ++c8) {
      const u32x4 qv = *(const u32x4*)(smem + t * 256 + (((fh * 8 + c8) ^ sw16) << 4));
      const float4 n0 = *(const float4*)(nprev + fh * 64 + c8 * 8), n1 = *(const float4*)(nprev + fh * 64 + c8 * 8 + 4);
      nq = fmaf(lo16(qv[0]), n0.x, nq); nq = fmaf(hi16(qv[0]), n0.y, nq); nq = fmaf(lo16(qv[1]), n0.z, nq); nq = fmaf(hi16(qv[1]), n0.w, nq);
      nq = fmaf(lo16(qv[2]), n1.x, nq); nq = fmaf(hi16(qv[2]), n1.y, nq); nq = fmaf(lo16(qv[3]), n1.z, nq); nq = fmaf(hi16(qv[3]), n1.w, nq);
    }
    dsum += __shfl_xor(dsum, 32);
    nq += __shfl_xor(nq, 32);
    const float den = dsum + ebt * nq;
    const float inv = 1.0f / fmaxf(fabsf(den), 1.0f);
#pragma unroll
    for (int x = 0; x < 2; ++x) {
      const int eb = 2 * eh + x;
      f32x16 N;
#pragma unroll
      for (int i = 0; i < 16; ++i) N[i] = 0.f;
#pragma unroll
      for (int ks = 0; ks < 8; ++ks) {
        const bf16x8 cf = *(const bf16x8*)(smem + 65536 + (eb * 32 + fr) * 256 + (((ks * 2 + fh) ^ sw16) << 4));
        N = __builtin_amdgcn_mfma_f32_32x32x16_bf16(cf, qf[ks], N, 0, 0, 0);
      }
#pragma unroll
      for (int i = 0; i < 16; ++i) N[i] *= ebt;
#pragma unroll
      for (int s4 = 0; s4 < 4; ++s4) {
        const bool valid = (dir == 0) ? ((s4 >> 1) <= tb) : ((s4 >> 1) >= tb);
        if (valid) {
          const int u0 = 4 * s4 + fh, u1 = u0 + 2;
          const char* vrow = smem + 49152 + (eb * 32 + fr) * 128;
          const u32x2 v0 = *(const u32x2*)(vrow + (((u0 >> 1) ^ sw8) << 4) + (u0 & 1) * 8);
          const u32x2 v1 = *(const u32x2*)(vrow + (((u1 >> 1) ^ sw8) << 4) + (u1 & 1) * 8);
          const bf16x8 vf = __builtin_bit_cast(bf16x8, (u32x4){v0[0], v0[1], v1[0], v1[1]});
          N = __builtin_amdgcn_mfma_f32_32x32x16_bf16(vf, pf[s4], N, 0, 0, 0);
        }
      }
      bf16_t* hp = HXb + (size_t)(row0 + t) * 512 + h * 128 + eb * 32 + 4 * fh;
#pragma unroll
      for (int q = 0; q < 4; ++q)
        *(u32x2*)(hp + 8 * q) = (u32x2){pack2(N[4 * q] * inv, N[4 * q + 1] * inv), pack2(N[4 * q + 2] * inv, N[4 * q + 3] * inv)};
    }
    const float decay = *dec_s;
#pragma unroll
    for (int eb = 0; eb < 4; ++eb)
#pragma unroll
      for (int i = 0; i < 16; ++i) CT[eb][i] *= decay;
#pragma unroll
    for (int ks = 0; ks < 4; ++ks) {
      const u32x4 kraw = *(const u32x4*)(smem + 32768 + (w * 32 + fr) * 128 + (((ks * 2 + fh) ^ sw8) << 4));
      const float4 g0 = *(const float4*)(wgs + ks * 16 + 8 * fh), g1 = *(const float4*)(wgs + ks * 16 + 8 * fh + 4);
      const bf16x8 kts = __builtin_bit_cast(bf16x8, (u32x4){pack2(lo16(kraw[0]) * g0.x, hi16(kraw[0]) * g0.y), pack2(lo16(kraw[1]) * g0.z, hi16(kraw[1]) * g0.w),
                                                             pack2(lo16(kraw[2]) * g1.x, hi16(kraw[2]) * g1.y), pack2(lo16(kraw[3]) * g1.z, hi16(kraw[3]) * g1.w)});
#pragma unroll
      for (int eb = 0; eb < 4; ++eb) {
        const bf16x8 vt = *(const bf16x8*)(smem + 49152 + (eb * 32 + fr) * 128 + (((ks * 2 + fh) ^ sw8) << 4));
        CT[eb] = __builtin_amdgcn_mfma_f32_32x32x16_bf16(kts, vt, CT[eb], 0, 0, 0);
      }
    }
    {
      const int d = tid & 127, sh = tid >> 7;
      float a = 0.f;
#pragma unroll 8
      for (int s = sh * 32; s < sh * 32 + 32; ++s) {
        const bf16_t kv = *(const bf16_t*)(smem + 16384 + s * 256 + ((((d >> 3)) ^ (s & 15)) << 4) + (d & 7) * 2);
        a = fmaf(wgs[s], bf2f(kv), a);
      }
      npart[sh * 128 + d] = a;
    }
    __syncthreads();
#pragma unroll
    for (int eb = 0; eb < 4; ++eb)
#pragma unroll
      for (int q = 0; q < 4; ++q)
        *(u32x2*)(smem + 65536 + (eb * 32 + fr) * 256 + ((((w * 4 + q)) ^ sw16) << 4) + 8 * fh) =
            (u32x2){pack2(CT[eb][4 * q], CT[eb][4 * q + 1]), pack2(CT[eb][4 * q + 2], CT[eb][4 * q + 3])};
    if (tid < 128) nprev[tid] = decay * nprev[tid] + npart[tid] + npart[128 + tid];
  }
  __syncthreads();
}

__device__ __forceinline__ void s5_item(const Params& p, int l, const bf16_t* Zb, float* YSFb, float* YSBb, int g, float* smem) {
  const int tid = otid();
  const int w = tid >> 6, lane = tid & 63;
  const bool active = w < 2;
  const int dir = w & 1;
  float* base = smem + (w & 1) * 11392;
  float* us = base;
  float* xre = base + 1024;
  float* xim = xre + 64 * 65;
  float* cre = xim + 64 * 65;
  float* cim = cre + 1024;
  const int pg = ((l * 2 + dir) * 32 + g);
  const int n = lane;
  const float lre = p.in[I_S5LRE][pg * 64 + n], lim = p.in[I_S5LIM][pg * 64 + n];
  const float dt = expf(p.in[I_S5DT][pg]);
  const float mag = expf(lre * dt);
  const float abr = mag * cosf(lim * dt), abi = mag * sinf(lim * dt);
  const float den = lre * lre + lim * lim;
  const float zr = ((abr - 1.0f) * lre + abi * lim) / den;
  const float zi = (abi * lre - (abr - 1.0f) * lim) / den;
  float bbr[16], bbi[16];
  {
    const float* br = p.in[I_S5BRE] + ((size_t)pg * 64 + n) * 16;
    const float* bi = p.in[I_S5BIM] + ((size_t)pg * 64 + n) * 16;
#pragma unroll
    for (int q = 0; q < 16; ++q) { float a = br[q], b = bi[q]; bbr[q] = zr * a - zi * b; bbi[q] = zr * b + zi * a; }
  }
  __syncthreads();
  if (active) {
    const float* cr = p.in[I_S5CRE] + (size_t)pg * 16 * 64;
    const float* ci = p.in[I_S5CIM] + (size_t)pg * 16 * 64;
#pragma unroll
    for (int q = 0; q < 16; ++q) { cre[n * 16 + q] = cr[q * 64 + n]; cim[n * 16 + q] = ci[q * 64 + n]; }
  }
  float xr = 0.f, xi = 0.f;
  float* Y = dir ? YSBb : YSFb;
  for (int s0 = 0; s0 < NTOK; s0 += 64) {
    const int step = s0 + lane;
    const int row = (dir == 0) ? ((step < NCTX) ? NLAT + step : step - NCTX)
                               : ((step < NCTX) ? NLAT + (NCTX - 1 - step) : (NLAT - 1) - (step - NCTX));
    if (active) {
      const u32x4* up = (const u32x4*)(Zb + (size_t)row * ZW + 3072 + g * 16);
#pragma unroll
      for (int q = 0; q < 2; ++q) {
        u32x4 t = up[q];
#pragma unroll
        for (int k = 0; k < 4; ++k) { us[lane * 16 + q * 8 + 2 * k] = lo16(t[k]); us[lane * 16 + q * 8 + 2 * k + 1] = hi16(t[k]); }
      }
    }
    __syncthreads();
    if (active) {
#pragma unroll 4
      for (int t = 0; t < 64; ++t) {
        const float4* up = (const float4*)(us + t * 16);
        float br_ = 0.f, bi_ = 0.f;
#pragma unroll
        for (int q4 = 0; q4 < 4; ++q4) {
          float4 uv = up[q4];
          br_ = fmaf(uv.x, bbr[4 * q4], br_); br_ = fmaf(uv.y, bbr[4 * q4 + 1], br_); br_ = fmaf(uv.z, bbr[4 * q4 + 2], br_); br_ = fmaf(uv.w, bbr[4 * q4 + 3], br_);
          bi_ = fmaf(uv.x, bbi[4 * q4], bi_); bi_ = fmaf(uv.y, bbi[4 * q4 + 1], bi_); bi_ = fmaf(uv.z, bbi[4 * q4 + 2], bi_); bi_ = fmaf(uv.w, bbi[4 * q4 + 3], bi_);
        }
        float nr = abr * xr - abi * xi + br_;
        float ni = abr * xi + abi * xr + bi_;
        xr = nr; xi = ni;
        xre[t * 65 + n] = xr;
        xim[t * 65 + n] = xi;
      }
    }
    __syncthreads();
    if (active) {
      float y[16];
#pragma unroll
      for (int q = 0; q < 16; ++q) y[q] = 0.f;
      for (int nn_ = 0; nn_ < 64; ++nn_) {
        const float a = xre[lane * 65 + nn_], b = xim[lane * 65 + nn_];
        const float4* cr4 = (const float4*)(cre + nn_ * 16);
        const float4* ci4 = (const float4*)(cim + nn_ * 16);
#pragma unroll
        for (int q4 = 0; q4 < 4; ++q4) {
          float4 c1 = cr4[q4], c2 = ci4[q4];
          y[4 * q4] += a * c1.x - b * c2.x; y[4 * q4 + 1] += a * c1.y - b * c2.y;
          y[4 * q4 + 2] += a * c1.z - b * c2.z; y[4 * q4 + 3] += a * c1.w - b * c2.w;
        }
      }
      float4* yp = (float4*)(Y + (size_t)row * 512 + g * 16);
#pragma unroll
      for (int q4 = 0; q4 < 4; ++q4) yp[q4] = make_float4(y[4 * q4], y[4 * q4 + 1], y[4 * q4 + 2], y[4 * q4 + 3]);
    }
    __syncthreads();
  }
}

__device__ __forceinline__ void stage_post(const Params& p, int l, int rr_lim, const bf16_t* Z, const bf16_t* HF, const bf16_t* HB,
                                           const float* YSF, const float* YSB, bf16_t* YB, bf16_t* GG) {
  const int tid = otid();
  const int c0 = tid * 2;
  for (int i = blockIdx.x; i < GB * rr_lim; i += gridDim.x) {
    const size_t r = (size_t)(i / rr_lim) * NTOK + (i % rr_lim);
    {
      const unsigned a0 = *(const unsigned*)(HF + r * 512 + c0), a1 = *(const unsigned*)(HB + r * 512 + c0);
      float h0 = lo16(a0) + lo16(a1), h1 = hi16(a0) + hi16(a1);
      float ss = wave_sum(h0 * h0 + h1 * h1);
      float rs = rsqrtf(ss * (1.0f / 128.0f) + EPSF);
      float2 g = *(const float2*)(p.in[I_MLNG] + l * 512 + c0);
      const unsigned og = *(const unsigned*)(Z + r * ZW + 2560 + c0);
      *(unsigned*)(YB + r * 512 + c0) = pack2(h0 * rs * g.x * sigmoidf_(lo16(og)), h1 * rs * g.y * sigmoidf_(hi16(og)));
    }
    {
      const unsigned u = *(const unsigned*)(Z + r * ZW + 3072 + c0);
      float2 d = *(const float2*)(p.in[I_S5D] + l * 512 + c0);
      float2 f = *(const float2*)(YSF + r * 512 + c0);
      float2 b = *(const float2*)(YSB + r * 512 + c0);
      *(unsigned*)(GG + r * 512 + c0) = pack2(geluf_(d.x * lo16(u) + f.x + b.x), geluf_(d.y * hi16(u) + f.y + b.y));
    }
  }
}

__device__ __forceinline__ void stage_glu_mfma(const Params& p, int l, int tpb, const bf16_t* GG, const bf16_t* GLUT, bf16_t* YS, char* smem) {
  EPI_DECL
  const int tm = GB * tpb;
  for (int t = blockIdx.x; t < tm * 4; t += gridDim.x) {
    const int m0 = MT_LR0(t >> 2, tpb), n0 = (t & 3) * 128;
    f32x16 acc[2][2];
    gemm_tile(GG + (size_t)m0 * 512, 512, GLUT + (size_t)n0 * 512, 512, 512, smem, acc);
#pragma unroll
    for (int mi = 0; mi < 2; ++mi)
#pragma unroll
      for (int ni = 0; ni < 2; ++ni)
#pragma unroll
        for (int q = 0; q < 4; ++q) {
          const int row = m0 + EPI_ROW(mi), c = n0 + EPI_COL(ni, q);
          const float4 b = *(const float4*)(p.in[I_GLUB] + l * 512 + c);
          const u32x2 g2 = *(const u32x2*)(GG + (size_t)row * 512 + c);
          const float o0 = lo16(g2[0]) * sigmoidf_(acc[mi][ni][4 * q] + b.x), o1 = hi16(g2[0]) * sigmoidf_(acc[mi][ni][4 * q + 1] + b.y);
          const float o2 = lo16(g2[1]) * sigmoidf_(acc[mi][ni][4 * q + 2] + b.z), o3 = hi16(g2[1]) * sigmoidf_(acc[mi][ni][4 * q + 3] + b.w);
          *(u32x2*)(YS + (size_t)row * 512 + c) = (u32x2){pack2(o0, o1), pack2(o2, o3)};
        }
  }
}

__device__ __forceinline__ void stage_merge_mfma(int tpb, const bf16_t* YA, const bf16_t* YB, const bf16_t* YS, const bf16_t* WBR, const bf16_t* Z, bf16_t* MG, char* smem) {
  EPI_DECL
  const int tm = GB * tpb;
  for (int t = blockIdx.x; t < tm * 8; t += gridDim.x) {
    const int m0 = MT_LR0(t >> 3, tpb), n0 = (t & 7) * 128;
    f32x16 macc[2][2];
#pragma unroll
    for (int a = 0; a < 2; ++a)
#pragma unroll
      for (int b = 0; b < 2; ++b)
#pragma unroll
        for (int i = 0; i < 16; ++i) macc[a][b][i] = 0.f;
#pragma unroll 1
    for (int r = 0; r < 3; ++r) {
      const bf16_t* Y = (r == 0) ? YA : (r == 1 ? YB : YS);
      f32x16 acc[2][2];
      gemm_tile(Y + (size_t)m0 * 512, 512, WBR + (size_t)r * 1024 * 512 + (size_t)n0 * 512, 512, 512, smem, acc);
#pragma unroll
      for (int mi = 0; mi < 2; ++mi)
#pragma unroll
        for (int ni = 0; ni < 2; ++ni)
#pragma unroll
          for (int q = 0; q < 4; ++q) {
            const int row = m0 + EPI_ROW(mi), c = n0 + EPI_COL(ni, q);
            const u32x2 e = *(const u32x2*)(Z + (size_t)row * ZW + 3584 + r * 1024 + c);
            macc[mi][ni][4 * q] += lo16(e[0]) * acc[mi][ni][4 * q];
            macc[mi][ni][4 * q + 1] += hi16(e[0]) * acc[mi][ni][4 * q + 1];
            macc[mi][ni][4 * q + 2] += lo16(e[1]) * acc[mi][ni][4 * q + 2];
            macc[mi][ni][4 * q + 3] += hi16(e[1]) * acc[mi][ni][4 * q + 3];
          }
    }
#pragma unroll
    for (int mi = 0; mi < 2; ++mi)
#pragma unroll
      for (int ni = 0; ni < 2; ++ni)
#pragma unroll
        for (int q = 0; q < 4; ++q) {
          const int row = m0 + EPI_ROW(mi), c = n0 + EPI_COL(ni, q);
          *(u32x2*)(MG + (size_t)row * DM + c) = (u32x2){pack2(macc[mi][ni][4 * q], macc[mi][ni][4 * q + 1]), pack2(macc[mi][ni][4 * q + 2], macc[mi][ni][4 * q + 3])};
        }
  }
}

__device__ __forceinline__ void stage_outproj_mfma(const Params& p, int l, int g, int tpb, const bf16_t* MG, const bf16_t* WOUT, char* smem) {
  EPI_DECL
  const int tm = GB * tpb;
  const float* mod = (const float*)(p.ws + WB_MOD) + (size_t)l * 9 * 6144;
  for (int t = blockIdx.x; t < tm * 8; t += gridDim.x) {
    const int mt = t >> 3, n0 = (t & 7) * 128;
    const int m0 = MT_LR0(mt, tpb), bl = mt / tpb, rr0 = (mt % tpb) * 128, b = g * GB + bl;
    f32x16 acc[2][2];
    gemm_tile(MG + (size_t)m0 * DM, DM, WOUT + (size_t)n0 * DM, DM, DM, smem, acc);
    const float* gv = mod + (size_t)((rr0 < NLAT) ? b : 8) * 6144 + 2 * 1024;
#pragma unroll
    for (int mi = 0; mi < 2; ++mi)
#pragma unroll
      for (int ni = 0; ni < 2; ++ni)
#pragma unroll
        for (int q = 0; q < 4; ++q) {
          const int rr = rr0 + EPI_ROW(mi), c = n0 + EPI_COL(ni, q);
          const float4 gg = *(const float4*)(gv + c);
          float4* xp = (float4*)(xrow(p, b, rr) + c);
          float4 x = *xp;
          x.x += gg.x * acc[mi][ni][4 * q]; x.y += gg.y * acc[mi][ni][4 * q + 1]; x.z += gg.z * acc[mi][ni][4 * q + 2]; x.w += gg.w * acc[mi][ni][4 * q + 3];
          *xp = x;
        }
  }
}

__device__ __forceinline__ void stage_peerq_mfma(int tpb, const bf16_t* H2, const bf16_t* WQ, bf16_t* PQ, char* smem) {
  EPI_DECL
  const int tm = GB * tpb;
  for (int t = blockIdx.x; t < tm * 16; t += gridDim.x) {
    const int m0 = MT_LR0(t >> 4, tpb), n0 = (t & 15) * 128;
    f32x16 acc[2][2];
    gemm_tile(H2 + (size_t)m0 * DM, DM, WQ + (size_t)n0 * DM, DM, DM, smem, acc);
#pragma unroll
    for (int mi = 0; mi < 2; ++mi)
#pragma unroll
      for (int ni = 0; ni < 2; ++ni)
#pragma unroll
        for (int q = 0; q < 4; ++q) {
          const int row = m0 + EPI_ROW(mi), c = n0 + EPI_COL(ni, q);
          *(u32x2*)(PQ + (size_t)row * 2048 + c) = (u32x2){pack2(acc[mi][ni][4 * q], acc[mi][ni][4 * q + 1]), pack2(acc[mi][ni][4 * q + 2], acc[mi][ni][4 * q + 3])};
        }
  }
}

__device__ __forceinline__ void stage_scores_mfma(int tpb, const bf16_t* PQ, const bf16_t* SUBK, float* SC, char* smem) {
  EPI_DECL
  const int tm = GB * tpb * 8;
  for (int t = blockIdx.x; t < tm * 2; t += gridDim.x) {
    const int mt = t >> 1, half = t & 1;
    const size_t m0 = (size_t)MT_LR0(mt >> 3, tpb) * 8 + (size_t)(mt & 7) * 128;
    f32x16 acc[2][2];
    gemm_tile(PQ + m0 * 256 + half * 128, 256, SUBK + (size_t)half * 16384, 128, 128, smem, acc);
#pragma unroll
    for (int mi = 0; mi < 2; ++mi)
#pragma unroll
      for (int ni = 0; ni < 2; ++ni)
#pragma unroll
        for (int q = 0; q < 4; ++q) {
          const size_t row = m0 + EPI_ROW(mi);
          const int c = EPI_COL(ni, q);
          *(float4*)(SC + row * 256 + half * 128 + c) = make_float4(acc[mi][ni][4 * q], acc[mi][ni][4 * q + 1], acc[mi][ni][4 * q + 2], acc[mi][ni][4 * q + 3]);
        }
  }
}

__device__ __forceinline__ void wave_argmax(float& v, int& idx) {
#pragma unroll
  for (int o = 32; o > 0; o >>= 1) {
    float ov = __shfl_xor(v, o);
    int oi = __shfl_xor(idx, o);
    if (ov > v || (ov == v && oi < idx)) { v = ov; idx = oi; }
  }
}
__device__ __forceinline__ void stage_topk(int rr_lim, const float* SC, int* EI, float* EG) {
  const int tid = otid(), w = tid >> 6, lane = tid & 63;
  const int nth = GB * rr_lim * 8;
  for (int i = blockIdx.x * 4 + w; i < nth; i += gridDim.x * 4) {
    const int tok = i >> 3, hh = i & 7;
    const size_t th = ((size_t)(tok / rr_lim) * NTOK + (tok % rr_lim)) * 8 + hh;
    const float* s = SC + th * 256;
    float myv[2] = {0.f, 0.f};
    int myi[2] = {0, 0};
#pragma unroll
    for (int half = 0; half < 2; ++half) {
      float a0 = s[half * 128 + lane], a1 = s[half * 128 + 64 + lane];
      for (int r = 0; r < 16; ++r) {
        float v; int idx;
        if (a0 >= a1) { v = a0; idx = lane; } else { v = a1; idx = lane + 64; }
        wave_argmax(v, idx);
        if (idx == lane) a0 = -INFINITY;
        if (idx == lane + 64) a1 = -INFINITY;
        if (lane == r) { myv[half] = v; myi[half] = idx; }
      }
    }
    float cv[4];
    const float v1 = __shfl(myv[0], lane >> 2);
#pragma unroll
    for (int q = 0; q < 4; ++q) cv[q] = v1 + __shfl(myv[1], (lane & 3) * 4 + q);
    float tv = 0.f; int tc = 0;
    for (int r = 0; r < 16; ++r) {
      float v = cv[0]; int idx = lane * 4;
#pragma unroll
      for (int q = 1; q < 4; ++q) if (cv[q] > v) { v = cv[q]; idx = lane * 4 + q; }
      wave_argmax(v, idx);
#pragma unroll
      for (int q = 0; q < 4; ++q) if (idx == lane * 4 + q) cv[q] = -INFINITY;
      if (lane == r) { tv = v; tc = idx; }
    }
    const int e1 = __shfl(myi[0], tc >> 4);
    const int e2 = __shfl(myi[1], tc & 15);
    const float vmax = __shfl(tv, 0);
    float ex = (lane < 16) ? expf(tv - vmax) : 0.f;
    float sum = wave_sum(ex);
    if (lane < 16) {
      EI[th * 16 + lane] = e1 * 128 + e2;
      EG[th * 16 + lane] = ex / sum;
    }
  }
}

__device__ __forceinline__ void unpack8(const u32x4 v, float* f) {
#pragma unroll
  for (int k = 0; k < 4; ++k) { f[2 * k] = lo16(v[k]); f[2 * k + 1] = hi16(v[k]); }
}
__device__ __forceinline__ void stage_expert(const Params& p, int l, int g, int rr_lim, const bf16_t* H2, const int* EI, const float* EG, float* smem) {
  const int tid = otid(), w = tid >> 6, lane = tid & 63;
  float* part = smem;
  const bf16_t* U = (const bf16_t*)(p.ws + WB_U16) + (size_t)l * 16384 * 1024;
  const bf16_t* V = (const bf16_t*)(p.ws + WB_V16) + (size_t)l * 16384 * 1024;
  const float* mod = (const float*)(p.ws + WB_MOD) + (size_t)l * 9 * 6144;
  for (int i = blockIdx.x; i < GB * rr_lim; i += gridDim.x) {
    const int bl = i / rr_lim, rr = i % rr_lim, b = g * GB + bl;
    const size_t t = (size_t)bl * NTOK + rr;
    float hf[16];
    unpack8(((const u32x4*)(H2 + t * DM))[lane], hf);
    unpack8(((const u32x4*)(H2 + t * DM + 512))[lane], hf + 8);
    const int my_e = EI[t * 128 + w * 32 + (lane & 31)];
    const float my_g = EG[t * 128 + w * 32 + (lane & 31)];
    float my_dot = 0.f;
#pragma unroll 1
    for (int k0 = 0; k0 < 32; k0 += 8) {
      u32x4 ra[8], rb[8];
#pragma unroll
      for (int j = 0; j < 8; ++j) {
        const int e = __builtin_amdgcn_readlane(my_e, k0 + j);
        const u32x4* up = (const u32x4*)(U + (size_t)e * 1024);
        ra[j] = up[lane]; rb[j] = up[64 + lane];
      }
#pragma unroll
      for (int j = 0; j < 8; ++j) {
        float f[16];
        unpack8(ra[j], f); unpack8(rb[j], f + 8);
        float a = 0.f;
#pragma unroll
        for (int q = 0; q < 16; ++q) a = fmaf(hf[q], f[q], a);
        a = wave_sum(a);
        if ((lane & 31) == k0 + j) my_dot = a;
      }
    }
    const float my_c = my_g * geluf_(my_dot);
    float acc[16];
#pragma unroll
    for (int q = 0; q < 16; ++q) acc[q] = 0.f;
#pragma unroll 1
    for (int k0 = 0; k0 < 32; k0 += 8) {
      u32x4 ra[8], rb[8];
#pragma unroll
      for (int j = 0; j < 8; ++j) {
        const int e = __builtin_amdgcn_readlane(my_e, k0 + j);
        const u32x4* vp = (const u32x4*)(V + (size_t)e * 1024);
        ra[j] = vp[lane]; rb[j] = vp[64 + lane];
      }
#pragma unroll
      for (int j = 0; j < 8; ++j) {
        const float c = __uint_as_float(__builtin_amdgcn_readlane(__float_as_uint(my_c), k0 + j));
        float f[16];
        unpack8(ra[j], f); unpack8(rb[j], f + 8);
#pragma unroll
        for (int q = 0; q < 16; ++q) acc[q] = fmaf(c, f[q], acc[q]);
      }
    }
    __syncthreads();
    {
      float4* pw = (float4*)(part + w * 1024 + lane * 8);
      pw[0] = make_float4(acc[0], acc[1], acc[2], acc[3]); pw[1] = make_float4(acc[4], acc[5], acc[6], acc[7]);
      float4* pw2 = (float4*)(part + w * 1024 + 512 + lane * 8);
      pw2[0] = make_float4(acc[8], acc[9], acc[10], acc[11]); pw2[1] = make_float4(acc[12], acc[13], acc[14], acc[15]);
    }
    __syncthreads();
    const float4 s0 = ((const float4*)part)[tid], s1 = ((const float4*)(part + 1024))[tid], s2 = ((const float4*)(part + 2048))[tid], s3 = ((const float4*)(part + 3072))[tid];
    const float4 g2 = ((const float4*)(mod + (size_t)((rr < NLAT) ? b : 8) * 6144 + 5 * 1024))[tid];
    float4* xp = (float4*)xrow(p, b, rr) + tid;
    float4 xv = *xp;
    xv.x += g2.x * (s0.x + s1.x + s2.x + s3.x); xv.y += g2.y * (s0.y + s1.y + s2.y + s3.y);
    xv.z += g2.z * (s0.z + s1.z + s2.z + s3.z); xv.w += g2.w * (s0.w + s1.w + s2.w + s3.w);
    *xp = xv;
  }
  __syncthreads();
}

__device__ __forceinline__ void stage_final(const Params& p, float* smem) {
  const int tid = otid();
  for (int r = blockIdx.x; r < NB * NLAT; r += gridDim.x) {
    float4* xp = (float4*)(p.out + (size_t)r * DM) + tid;
    float4 v = *xp;
    float s = wave_sum(v.x * v.x + v.y * v.y + v.z * v.z + v.w * v.w);
    __syncthreads();
    if ((tid & 63) == 0) smem[tid >> 6] = s;
    __syncthreads();
    float rs = rsqrtf((smem[0] + smem[1] + smem[2] + smem[3]) * (1.0f / DM) + EPSF);
    float4 g = ((const float4*)p.in[I_FG])[tid];
    *xp = make_float4(v.x * rs * g.x, v.y * rs * g.y, v.z * rs * g.z, v.w * rs * g.w);
  }
}

__global__ void __launch_bounds__(256) mega(Params p) {
  cg::grid_group grid = cg::this_grid();
  __shared__ __attribute__((aligned(16))) float smem[SMEM_FLOATS];
  char* smc = (char*)smem;
  char* ws = p.ws;
  bf16_t* H = (bf16_t*)(ws + WB_H); bf16_t* Z = (bf16_t*)(ws + WB_Z); float* MGT = (float*)(ws + WB_MGT); bf16_t* XC = (bf16_t*)(ws + WB_XC);
  bf16_t* QM = (bf16_t*)(ws + WB_QM); bf16_t* KM = (bf16_t*)(ws + WB_KM); bf16_t* KMT = (bf16_t*)(ws + WB_KMT); bf16_t* MVT = (bf16_t*)(ws + WB_MVT);
  bf16_t* HF = (bf16_t*)(ws + WB_HF); bf16_t* HB = (bf16_t*)(ws + WB_HB);
  bf16_t* VT = (bf16_t*)(ws + WB_VT); float* YSF = (float*)(ws + WB_YSF); float* YSB = (float*)(ws + WB_YSB);
  bf16_t* YA = (bf16_t*)(ws + WB_YA); bf16_t* YB = (bf16_t*)(ws + WB_YB); bf16_t* YS = (bf16_t*)(ws + WB_YS); bf16_t* GG = (bf16_t*)(ws + WB_GG);
  bf16_t* MG = (bf16_t*)(ws + WB_MG); bf16_t* PQ = (bf16_t*)(ws + WB_PQ); float* SC = (float*)(ws + WB_SC);
  int* EI = (int*)(ws + WB_EI); float* EG = (float*)(ws + WB_EG);
  const bf16_t* WT = (const bf16_t*)(ws + WB_WT);

  stage_init(p, smem);
  grid.sync();

  for (int l = 0; l < 2; ++l) {
    const bool need_ctx = (l == 0);
    const int rr_lim = need_ctx ? NTOK : NLAT;
    const int tpb = need_ctx ? 34 : 32;
    const bf16_t* W = WT + (size_t)l * WT_LAYER;
    const float lam_init = 0.8f - 0.6f * expf(-0.3f * (float)l);
    float lam;
    {
      float s1 = 0.f, s2 = 0.f;
      for (int i = 0; i < 64; ++i) {
        s1 += p.in[I_LQ1][l * 64 + i] * p.in[I_LK1][l * 64 + i];
        s2 += p.in[I_LQ2][l * 64 + i] * p.in[I_LK2][l * 64 + i];
      }
      lam = expf(s1) - expf(s2) + lam_init;
    }
    for (int g = 0; g < NG; ++g) {
      stage_normmod(p, l, g, 0, NTOK, H, smem);
      grid.sync();
      stage_inproj(p, H, W + WT_WIN, Z, MGT, VT, MVT, smc);
      grid.sync();
      stage_conv(p, l, Z, XC);
      grid.sync();
      stage_mlqk(XC, W + WT_WQK, QM, KM, KMT, smc);
      grid.sync();
      {
        const int n_attn = 4 * 32 + (need_ctx ? 4 * 2 : 0);
        const int n_items = GB * (40 + n_attn);
        int* cnt = (int*)(ws + WB_CNT) + (l * NG + g);
        int* s_item = (int*)(smem + SMEM_FLOATS - 4);
        for (;;) {
          __syncthreads();
          if (otid() == 0) *s_item = atomicAdd(cnt, 1);
          __syncthreads();
          const int it = *s_item;
          if (it >= n_items) break;
          int bl, k;
          if (it < GB * 8) { bl = it / 8; k = it % 8; }
          else if (it < GB * 40) { bl = (it - GB * 8) / 32; k = 8 + (it - GB * 8) % 32; }
          else { bl = (it - GB * 40) / n_attn; k = 40 + (it - GB * 40) % n_attn; }
          const bf16_t* Zb = Z + (size_t)bl * NTOK * ZW;
          const size_t ro = (size_t)bl * NTOK;
          if (k < 8) {
            mlstm_chain_item(p, l, QM + ro * 512, KM + ro * 512, KMT + (size_t)bl * 4 * 128 * NTOK, MVT + (size_t)bl * 4 * 128 * NTOK, MGT + ro * 16,
                             ((k >> 2) ? HB : HF) + ro * 512, k & 3, k >> 2, smc);
          } else if (k < 40) {
            s5_item(p, l, Zb, YSF + ro * 512, YSB + ro * 512, k - 8, smem);
          } else {
            const int a = k - 40;
            const bf16_t* VTb = VT + (size_t)bl * 4 * 128 * NTOK;
            if (a < 128) attn_mfma_item(p, l, Zb, VTb, YA + ro * 512, a & 3, (a >> 2) * 128, 0, NTOK, lam, lam_init, smc);
            else attn_mfma_item(p, l, Zb, VTb, YA + ro * 512, (a - 128) & 3, NLAT + ((a - 128) >> 2) * 128, NLAT, NCTX, lam, lam_init, smc);
          }
        }
      }
      grid.sync();
      stage_post(p, l, rr_lim, Z, HF, HB, YSF, YSB, YB, GG);
      grid.sync();
      stage_glu_mfma(p, l, tpb, GG, W + WT_GLU, YS, smc);
      grid.sync();
      stage_merge_mfma(tpb, YA, YB, YS, W + WT_WBR, Z, MG, smc);
      grid.sync();
      stage_outproj_mfma(p, l, g, tpb, MG, W + WT_WOUT, smc);
      grid.sync();
      stage_normmod(p, l, g, 1, rr_lim, H, smem);
      grid.sync();
      stage_peerq_mfma(tpb, H, W + WT_WQ, PQ, smc);
      grid.sync();
      stage_scores_mfma(tpb, PQ, W + WT_SUBK, SC, smc);
      grid.sync();
      stage_topk(rr_lim, SC, EI, EG);
      grid.sync();
      stage_expert(p, l, g, rr_lim, H, EI, EG, smem);
      grid.sync();
    }
  }
  stage_final(p, smem);
}

extern "C" void kernel_launch(void* const* d_in, const int* in_sizes, int n_in, void* d_out,
                              int out_size, void* d_ws, size_t ws_size, hipStream_t stream) {
  static int grid_blocks = 0;
  if (!grid_blocks) {
    int dev = 0, cus = 0, per_cu = 0;
    (void)hipGetDevice(&dev);
    (void)hipDeviceGetAttribute(&cus, hipDeviceAttributeMultiprocessorCount, dev);
    (void)hipOccupancyMaxActiveBlocksPerMultiprocessor(&per_cu, mega, 256, 0);
    if (per_cu > 1) per_cu = 1;
    grid_blocks = cus * per_cu;
  }
  if (ws_size < WB_END) {
    fprintf(stderr, "workspace too small: %zu < %zu\n", ws_size, (size_t)WB_END);
    return;
  }
  Params p{};
  for (int i = 0; i < N_IN; ++i) p.in[i] = (const float*)d_in[i];
  p.out = (float*)d_out;
  p.ws = (char*)d_ws;
  void* args[] = {&p};
  hipError_t e = hipLaunchCooperativeKernel((void*)mega, dim3(grid_blocks), dim3(256), args, 0, stream);
  if (e != hipSuccess) fprintf(stderr, "cooperative launch failed: %s (grid %d)\n", hipGetErrorString(e), grid_blocks);
}
```

```cpp
#include <hip/hip_runtime.h>
#include <hip/hip_cooperative_groups.h>
#include <cstdio>
#include <cstdint>
namespace cg = cooperative_groups;

#define NLAT 4096
#define NCTX 256
#define NTOK 4352
#define DM 1024
#define INW 6672
#define NB 8
#define GB 2
#define NG (NB / GB)
#define RPG (GB * NTOK)
#define ZW 6656
#define EPSF 1e-6f

enum { I_X = 0, I_C, I_CTX, I_CCTX, I_WMOD, I_BMOD, I_N1G, I_N2G, I_WIN, I_LQ1, I_LK1, I_LQ2, I_LK2, I_SUBG,
       I_CONVW, I_CONVB, I_MLWQ, I_MLWK, I_GATEB, I_MLNG, I_S5LRE, I_S5LIM, I_S5DT, I_S5BRE, I_S5BIM,
       I_S5CRE, I_S5CIM, I_S5D, I_GLUW, I_GLUB, I_WBR, I_WOUT, I_PWQ, I_PSUBK, I_PU, I_PV, I_FG, N_IN };

struct Params {
  const float* in[N_IN];
  float* out;
  char* ws;
};

typedef unsigned short bf16_t;
typedef short bf16x8 __attribute__((ext_vector_type(8)));
typedef float f32x16 __attribute__((ext_vector_type(16)));
typedef unsigned u32x4 __attribute__((ext_vector_type(4)));
typedef unsigned u32x2 __attribute__((ext_vector_type(2)));

#define AL(x) (((x) + 255) & ~(size_t)255)
#define WB_XCX   ((size_t)0)
#define WB_MOD   AL(WB_XCX + (size_t)NB * NCTX * DM * 4)
#define WB_ROPE  AL(WB_MOD + (size_t)2 * 9 * 6144 * 4)
#define WB_WT    AL(WB_ROPE + (size_t)NLAT * 32 * 2 * 4)
#define WT_WIN   ((size_t)0)
#define WT_WQK   (WT_WIN + (size_t)6784 * 1024)
#define WT_GLU   (WT_WQK + (size_t)4 * 256 * 128)
#define WT_WBR   (WT_GLU + (size_t)512 * 512)
#define WT_WOUT  (WT_WBR + (size_t)3 * 1024 * 512)
#define WT_WQ    (WT_WOUT + (size_t)1024 * 1024)
#define WT_SUBK  (WT_WQ + (size_t)2048 * 1024)
#define WT_LAYER (WT_SUBK + (size_t)2 * 128 * 128)
#define WB_H     AL(WB_WT + WT_LAYER * 2 * 2)
#define WB_Z     AL(WB_H + (size_t)RPG * DM * 2)
#define WB_MGT   AL(WB_Z + (size_t)RPG * ZW * 2)
#define WB_XC    AL(WB_MGT + (size_t)RPG * 16 * 4)
#define WB_QM    AL(WB_XC + (size_t)RPG * 512 * 2)
#define WB_KM    AL(WB_QM + (size_t)RPG * 512 * 2)
#define WB_KMT   AL(WB_KM + (size_t)RPG * 512 * 2)
#define WB_MVT   AL(WB_KMT + (size_t)RPG * 512 * 2)
#define WB_HF    AL(WB_MVT + (size_t)RPG * 512 * 2)
#define WB_HB    AL(WB_HF + (size_t)RPG * 512 * 2)
#define WB_YSF   AL(WB_HB + (size_t)RPG * 512 * 2)
#define WB_YSB   AL(WB_YSF + (size_t)RPG * 512 * 4)
#define WB_YA    AL(WB_YSB + (size_t)RPG * 512 * 4)
#define WB_YB    AL(WB_YA + (size_t)RPG * 512 * 2)
#define WB_YS    AL(WB_YB + (size_t)RPG * 512 * 2)
#define WB_GG    AL(WB_YS + (size_t)RPG * 512 * 2)
#define WB_MG    AL(WB_GG + (size_t)RPG * 512 * 2)
#define WB_EI    AL(WB_MG + (size_t)RPG * DM * 2)
#define WB_EG    AL(WB_EI + (size_t)RPG * 128 * 4)
#define WB_U16   AL(WB_EG + (size_t)RPG * 128 * 4)
#define WB_V16   AL(WB_U16 + (size_t)2 * 16384 * 1024 * 2)
#define WB_VT    AL(WB_V16 + (size_t)2 * 16384 * 1024 * 2)
#define WB_CNT   AL(WB_VT + (size_t)GB * 4 * 128 * NTOK * 2)
#define WB_XE    AL(WB_CNT + 256)
#define WB_END   AL(WB_XE + (size_t)GB * 32 * 2 * 33 * 128 * 4)
#define WB_PQ    (WB_Z)
#define WB_SC    AL(WB_PQ + (size_t)RPG * 2048 * 2)

#define SMEM_FLOATS (25 * 1024)

__device__ __forceinline__ float sigmoidf_(float x) { return 1.0f / (1.0f + expf(-x)); }
__device__ __forceinline__ float siluf_(float x) { return x / (1.0f + expf(-x)); }
__device__ __forceinline__ float geluf_(float x) { return 0.5f * x * (1.0f + erff(x * 0.70710678118654752f)); }
__device__ __forceinline__ int otid() { int t = threadIdx.x; asm volatile("" : "+v"(t)); return t; }
__device__ __forceinline__ float wave_sum(float v) {
  for (int o = 32; o > 0; o >>= 1) v += __shfl_xor(v, o);
  return v;
}
__device__ __forceinline__ bf16_t f2bf(float x) { unsigned u = __float_as_uint(x); u += 0x7fffu + ((u >> 16) & 1u); return (bf16_t)(u >> 16); }
__device__ __forceinline__ float bf2f(bf16_t h) { return __uint_as_float(((unsigned)h) << 16); }
typedef float f32x2 __attribute__((ext_vector_type(2)));
typedef __bf16 bf16x2_t __attribute__((ext_vector_type(2)));
__device__ __forceinline__ unsigned pack2(float a, float b) { f32x2 v = {a, b}; return __builtin_bit_cast(unsigned, __builtin_convertvector(v, bf16x2_t)); }
__device__ __forceinline__ float lo16(unsigned u) { return __uint_as_float(u << 16); }
__device__ __forceinline__ float hi16(unsigned u) { return __uint_as_float(u & 0xffff0000u); }

__device__ __forceinline__ float* xrow(const Params& p, int b, int rr) {
  return (rr < NLAT) ? p.out + ((size_t)b * NLAT + rr) * DM : (float*)(p.ws + WB_XCX) + ((size_t)b * NCTX + (rr - NLAT)) * DM;
}

__device__ __forceinline__ void gemm_tile(const bf16_t* __restrict__ Ag, int lda, const bf16_t* __restrict__ Bg, int ldb, int K,
                                          char* smem, f32x16 (&acc)[2][2]) {
  const int tid = otid(), lane = tid & 63, w = tid >> 6, wm = w >> 1, wn = w & 1;
#pragma unroll
  for (int a = 0; a < 2; ++a)
#pragma unroll
    for (int b = 0; b < 2; ++b)
#pragma unroll
      for (int i = 0; i < 16; ++i) acc[a][b][i] = 0.f;
  const int srow = tid >> 3, sch = tid & 7;
  const bf16_t* ap = Ag + (size_t)srow * lda + sch * 8;
  const bf16_t* bp = Bg + (size_t)srow * ldb + sch * 8;
  const int wofs = srow * 128 + ((sch ^ ((srow >> 1) & 7)) << 4);
  const int fr = lane & 31, fh = lane >> 5, fsw = (fr >> 1) & 7;
  const int aofs = (wm * 64 + fr) * 128, bofs = 16384 + (wn * 64 + fr) * 128;
  u32x4 ra[4], rb[4];
  const int nk = K >> 6;
#pragma unroll
  for (int i = 0; i < 4; ++i) {
    ra[i] = *(const u32x4*)(ap + (size_t)i * 32 * lda);
    rb[i] = *(const u32x4*)(bp + (size_t)i * 32 * ldb);
  }
  __syncthreads();
#pragma unroll
  for (int i = 0; i < 4; ++i) {
    *(u32x4*)(smem + wofs + i * 4096) = ra[i];
    *(u32x4*)(smem + 16384 + wofs + i * 4096) = rb[i];
  }
  __syncthreads();
  for (int kt = 0; kt < nk; ++kt) {
    const bool more = (kt + 1 < nk);
    if (more) {
#pragma unroll
      for (int i = 0; i < 4; ++i) {
        ra[i] = *(const u32x4*)(ap + (size_t)i * 32 * lda + (kt + 1) * 64);
        rb[i] = *(const u32x4*)(bp + (size_t)i * 32 * ldb + (kt + 1) * 64);
      }
    }
    const char* base = smem + (kt & 1) * 32768;
#pragma unroll
    for (int ks = 0; ks < 4; ++ks) {
      const int coff = ((ks * 2 + fh) ^ fsw) << 4;
      bf16x8 af[2], bfr[2];
#pragma unroll
      for (int mi = 0; mi < 2; ++mi) af[mi] = *(const bf16x8*)(base + aofs + mi * 4096 + coff);
#pragma unroll
      for (int ni = 0; ni < 2; ++ni) bfr[ni] = *(const bf16x8*)(base + bofs + ni * 4096 + coff);
#pragma unroll
      for (int mi = 0; mi < 2; ++mi)
#pragma unroll
        for (int ni = 0; ni < 2; ++ni)
          acc[mi][ni] = __builtin_amdgcn_mfma_f32_32x32x16_bf16(bfr[ni], af[mi], acc[mi][ni], 0, 0, 0);
    }
    if (more) {
      char* nb = smem + ((kt + 1) & 1) * 32768;
#pragma unroll
      for (int i = 0; i < 4; ++i) {
        *(u32x4*)(nb + wofs + i * 4096) = ra[i];
        *(u32x4*)(nb + 16384 + wofs + i * 4096) = rb[i];
      }
    }
    __syncthreads();
  }
}
#define EPI_DECL const int tid_ = otid(); const int lane = tid_ & 63, w_ = tid_ >> 6, wm = w_ >> 1, wn = w_ & 1, fr = lane & 31, fh = lane >> 5; (void)fr; (void)fh; (void)wm; (void)wn;
#define EPI_ROW(mi) (wm * 64 + (mi) * 32 + fr)
#define EPI_COL(ni, q) (wn * 64 + (ni) * 32 + 8 * (q) + 4 * fh)
#define MT_LR0(mt, tpb) (((mt) / (tpb)) * NTOK + ((mt) % (tpb)) * 128)

template <class F>
__device__ __forceinline__ void transpose_cvt(const float* __restrict__ src, int ld, F srccol, int K, int Ndst, bf16_t* __restrict__ dst, float* smem) {
  float (*T)[65] = (float (*)[65])smem;
  const int tid = otid();
  const int tk = K >> 6, tn = Ndst >> 6;
  for (int t = blockIdx.x; t < tn * tk; t += gridDim.x) {
    const int n0 = (t / tk) * 64, k0 = (t % tk) * 64;
    __syncthreads();
    const int sc = srccol(n0 + (tid & 63));
#pragma unroll
    for (int i = 0; i < 16; ++i) {
      const int ky = (tid >> 6) + 4 * i;
      T[ky][tid & 63] = (sc >= 0) ? src[(size_t)(k0 + ky) * ld + sc] : 0.f;
    }
    __syncthreads();
#pragma unroll
    for (int i = 0; i < 16; ++i) {
      const int ny = (tid >> 6) + 4 * i;
      dst[(size_t)(n0 + ny) * K + k0 + (tid & 63)] = f2bf(T[tid & 63][ny]);
    }
  }
  __syncthreads();
}
__device__ __forceinline__ int win_srccol(int n) {
  if (n < 3072) return n;
  if (n < 6656) return n + 16;
  if (n < 6672) return n - 3584;
  return -1;
}

__device__ __forceinline__ void stage_init(const Params& p, float* smem) {
  const int tid = otid();
  {
    const size_t n4 = (size_t)NB * NLAT * 256;
    const float4* s = (const float4*)p.in[I_X];
    float4* d = (float4*)p.out;
    for (size_t i = (size_t)blockIdx.x * 256 + tid; i < n4; i += (size_t)gridDim.x * 256) d[i] = s[i];
    const size_t m4 = (size_t)NB * NCTX * 256;
    const float4* s2 = (const float4*)p.in[I_CTX];
    float4* d2 = (float4*)(p.ws + WB_XCX);
    for (size_t i = (size_t)blockIdx.x * 256 + tid; i < m4; i += (size_t)gridDim.x * 256) d2[i] = s2[i];
  }
  if (blockIdx.x == 0 && tid < 64) ((int*)(p.ws + WB_CNT))[tid] = 0;
  {
    const size_t n8 = (size_t)2 * 16384 * 1024 / 8;
    const float4* su = (const float4*)p.in[I_PU];
    const float4* sv = (const float4*)p.in[I_PV];
    u32x4* du = (u32x4*)(p.ws + WB_U16);
    u32x4* dv = (u32x4*)(p.ws + WB_V16);
    for (size_t i = (size_t)blockIdx.x * 256 + tid; i < n8; i += (size_t)gridDim.x * 256) {
      const float4 a = su[2 * i], b = su[2 * i + 1];
      du[i] = (u32x4){pack2(a.x, a.y), pack2(a.z, a.w), pack2(b.x, b.y), pack2(b.z, b.w)};
      const float4 c = sv[2 * i], d = sv[2 * i + 1];
      dv[i] = (u32x4){pack2(c.x, c.y), pack2(c.z, c.w), pack2(d.x, d.y), pack2(d.z, d.w)};
    }
  }
  {
    float2* rt = (float2*)(p.ws + WB_ROPE);
    for (int i = blockIdx.x * 256 + tid; i < NLAT * 32; i += gridDim.x * 256) {
      const int pos = i >> 5, j = i & 31;
      const float inv = powf(10000.0f, -(float)(j & 15) / 16.0f);
      const float ang = (float)((j < 16) ? (pos >> 6) : (pos & 63)) * inv;
      rt[i] = make_float2(cosf(ang), sinf(ang));
    }
  }
  {
    float* sc = smem;
    for (int i = tid; i < 9 * 1024; i += 256) {
      int r = i >> 10, k = i & 1023;
      float v = (r < 8) ? p.in[I_C][r * 1024 + k] : p.in[I_CCTX][k];
      sc[i] = siluf_(v);
    }
    __syncthreads();
    float* mod = (float*)(p.ws + WB_MOD);
    for (int col = blockIdx.x * 256 + tid; col < 2 * 6144; col += gridDim.x * 256) {
      int l = col / 6144, j = col % 6144;
      const float* w = p.in[I_WMOD] + (size_t)l * 1024 * 6144 + j;
      float acc[9];
#pragma unroll
      for (int r = 0; r < 9; ++r) acc[r] = 0.f;
      for (int k = 0; k < 1024; ++k) {
        float wv = w[(size_t)k * 6144];
#pragma unroll
        for (int r = 0; r < 9; ++r) acc[r] = fmaf(sc[r * 1024 + k], wv, acc[r]);
      }
      float bv = p.in[I_BMOD][l * 6144 + j];
#pragma unroll
      for (int r = 0; r < 9; ++r) mod[((size_t)l * 9 + r) * 6144 + j] = acc[r] + bv;
    }
    __syncthreads();
  }
  bf16_t* WT = (bf16_t*)(p.ws + WB_WT);
  for (int l = 0; l < 2; ++l) {
    bf16_t* W = WT + (size_t)l * WT_LAYER;
    transpose_cvt(p.in[I_WIN] + (size_t)l * DM * INW, INW, [](int n) { return win_srccol(n); }, DM, 6784, W + WT_WIN, smem);
    for (int h = 0; h < 4; ++h) {
      transpose_cvt(p.in[I_MLWQ] + ((size_t)l * 4 + h) * 16384, 128, [](int n) { return n; }, 128, 128, W + WT_WQK + (size_t)h * 256 * 128, smem);
      transpose_cvt(p.in[I_MLWK] + ((size_t)l * 4 + h) * 16384, 128, [](int n) { return n; }, 128, 128, W + WT_WQK + (size_t)h * 256 * 128 + 128 * 128, smem);
    }
    transpose_cvt(p.in[I_GLUW] + (size_t)l * 512 * 512, 512, [](int n) { return n; }, 512, 512, W + WT_GLU, smem);
    for (int r = 0; r < 3; ++r)
      transpose_cvt(p.in[I_WBR] + ((size_t)l * 3 + r) * 512 * DM, DM, [](int n) { return n; }, 512, DM, W + WT_WBR + (size_t)r * 1024 * 512, smem);
    transpose_cvt(p.in[I_WOUT] + (size_t)l * DM * DM, DM, [](int n) { return n; }, DM, DM, W + WT_WOUT, smem);
    transpose_cvt(p.in[I_PWQ] + (size_t)l * DM * 2048, 2048, [](int n) { return n; }, DM, 2048, W + WT_WQ, smem);
    const float* sk = p.in[I_PSUBK] + (size_t)l * 2 * 128 * 128;
    for (int i = blockIdx.x * 256 + tid; i < 2 * 128 * 128; i += gridDim.x * 256) W[WT_SUBK + i] = f2bf(sk[i]);
  }
}

__device__ __forceinline__ void stage_normmod(const Params& p, int l, int g, int which, int rr_lim, bf16_t* H, float* smem) {
  const int tid = otid();
  const float* ng = p.in[which ? I_N2G : I_N1G] + l * DM;
  const float* mod = (const float*)(p.ws + WB_MOD) + (size_t)l * 9 * 6144;
  const int off_sh = which ? 3072 : 0, off_sc = which ? 4096 : 1024;
  const int per = rr_lim;
  for (int i = blockIdx.x; i < GB * per; i += gridDim.x) {
    const int bl = i / per, rr = i % per, b = g * GB + bl;
    const float* X = xrow(p, b, rr);
    float4 v = ((const float4*)X)[tid];
    float s = wave_sum(v.x * v.x + v.y * v.y + v.z * v.z + v.w * v.w);
    __syncthreads();
    if ((tid & 63) == 0) smem[tid >> 6] = s;
    __syncthreads();
    float tot = smem[0] + smem[1] + smem[2] + smem[3];
    float rs = rsqrtf(tot * (1.0f / DM) + EPSF);
    const float* m = mod + (size_t)((rr < NLAT) ? b : 8) * 6144;
    float4 gg = ((const float4*)ng)[tid];
    float4 sc = ((const float4*)(m + off_sc))[tid];
    float4 sh = ((const float4*)(m + off_sh))[tid];
    float4 o;
    o.x = v.x * rs * gg.x * (1.f + sc.x) + sh.x;
    o.y = v.y * rs * gg.y * (1.f + sc.y) + sh.y;
    o.z = v.z * rs * gg.z * (1.f + sc.z) + sh.z;
    o.w = v.w * rs * gg.w * (1.f + sc.w) + sh.w;
    ((u32x2*)(H + ((size_t)bl * NTOK + rr) * DM))[tid] = (u32x2){pack2(o.x, o.y), pack2(o.z, o.w)};
  }
  __syncthreads();
}

__device__ __forceinline__ void stage_inproj(const Params& p, const bf16_t* H, const bf16_t* WinT, bf16_t* Z, float* MGT, bf16_t* VT, bf16_t* MVT, char* smem) {
  EPI_DECL
  const int tm = GB * 34, tn = 53;
  const float2* rt = (const float2*)(p.ws + WB_ROPE);
  for (int t = blockIdx.x; t < tm * tn; t += gridDim.x) {
    const int mt = t / tn, j = t % tn, n0 = j * 128;
    const int lr0 = MT_LR0(mt, 34), rr0 = (mt % 34) * 128;
    f32x16 acc[2][2];
    if ((j >= 8 && j < 12) || (j >= 16 && j < 20)) {
      gemm_tile(WinT + (size_t)n0 * DM, DM, H + (size_t)lr0 * DM, DM, DM, smem, acc);
      bf16_t* vt = ((j < 12) ? VT : MVT) + ((size_t)(mt / 34) * 4 + (j & 3)) * 128 * NTOK;
#pragma unroll
      for (int mi = 0; mi < 2; ++mi)
#pragma unroll
        for (int ni = 0; ni < 2; ++ni)
#pragma unroll
          for (int q = 0; q < 4; ++q) {
            const int e = EPI_ROW(mi), tok = rr0 + EPI_COL(ni, q);
            *(u32x2*)(vt + (size_t)e * NTOK + tok) = (u32x2){pack2(acc[mi][ni][4 * q], acc[mi][ni][4 * q + 1]), pack2(acc[mi][ni][4 * q + 2], acc[mi][ni][4 * q + 3])};
          }
      continue;
    }
    gemm_tile(H + (size_t)lr0 * DM, DM, WinT + (size_t)n0 * DM, DM, DM, smem, acc);
    if (j < 8 && rr0 < NLAT) {
#pragma unroll
      for (int mi = 0; mi < 2; ++mi) {
        const int pos = rr0 + EPI_ROW(mi);
#pragma unroll
        for (int i = 0; i < 16; ++i) {
          const int jj = 8 * (i >> 2) + 4 * fh + (i & 3);
          const float2 cs = rt[pos * 32 + jj];
          const float x1 = acc[mi][0][i], x2 = acc[mi][1][i];
          acc[mi][0][i] = x1 * cs.x - x2 * cs.y;
          acc[mi][1][i] = x1 * cs.y + x2 * cs.x;
        }
      }
    }
    if (j < 52) {
      const bool sg = (j >= 28);
#pragma unroll
      for (int mi = 0; mi < 2; ++mi)
#pragma unroll
        for (int ni = 0; ni < 2; ++ni)
#pragma unroll
          for (int q = 0; q < 4; ++q) {
            const int row = lr0 + EPI_ROW(mi), c = n0 + EPI_COL(ni, q);
            float v0 = acc[mi][ni][4 * q], v1 = acc[mi][ni][4 * q + 1], v2 = acc[mi][ni][4 * q + 2], v3 = acc[mi][ni][4 * q + 3];
            if (sg) { v0 = sigmoidf_(v0); v1 = sigmoidf_(v1); v2 = sigmoidf_(v2); v3 = sigmoidf_(v3); }
            *(u32x2*)(Z + (size_t)row * ZW + c) = (u32x2){pack2(v0, v1), pack2(v2, v3)};
          }
    } else {
#pragma unroll
      for (int mi = 0; mi < 2; ++mi)
#pragma unroll
        for (int q = 0; q < 2; ++q) {
          const int row = lr0 + EPI_ROW(mi), c = EPI_COL(0, q);
          if (wn == 0) *(float4*)(MGT + (size_t)row * 16 + c) = make_float4(acc[mi][0][4 * q], acc[mi][0][4 * q + 1], acc[mi][0][4 * q + 2], acc[mi][0][4 * q + 3]);
        }
    }
  }
}

__device__ __forceinline__ void stage_conv(const Params& p, int l, const bf16_t* Z, bf16_t* XC) {
  const int tid = otid();
  const float* cw = p.in[I_CONVW] + (size_t)l * 3 * 512;
  const float* cb = p.in[I_CONVB] + (size_t)l * 512;
  const int c = tid * 2;
  const float2 w0 = *(const float2*)(cw + c), w1 = *(const float2*)(cw + 512 + c), w2 = *(const float2*)(cw + 1024 + c), bb = *(const float2*)(cb + c);
  for (int lr = blockIdx.x; lr < RPG; lr += gridDim.x) {
    const int rr = lr % NTOK;
    const bool has_prev = (rr < NLAT) ? (rr > 0) : (rr > NLAT);
    const bool has_next = (rr < NLAT) ? (rr < NLAT - 1) : (rr < NTOK - 1);
    const bf16_t* z = Z + (size_t)lr * ZW + 1536 + c;
    const unsigned xc = *(const unsigned*)z;
    float a0 = bb.x + w1.x * lo16(xc), a1 = bb.y + w1.y * hi16(xc);
    if (has_prev) { const unsigned xp = *(const unsigned*)(z - ZW); a0 += w0.x * lo16(xp); a1 += w0.y * hi16(xp); }
    if (has_next) { const unsigned xn = *(const unsigned*)(z + ZW); a0 += w2.x * lo16(xn); a1 += w2.y * hi16(xn); }
    *(unsigned*)(XC + (size_t)lr * 512 + c) = pack2(siluf_(a0), siluf_(a1));
  }
}

__device__ __forceinline__ void stage_mlqk(const bf16_t* XC, const bf16_t* WQK, bf16_t* QM, bf16_t* KM, bf16_t* KMT, char* smem) {
  EPI_DECL
  const int tm = RPG >> 7;
  for (int t = blockIdx.x; t < tm * 12; t += gridDim.x) {
    const int mt = t / 12, r12 = t % 12, h = r12 & 3, kind = r12 >> 2;
    const int m0 = mt * 128;
    f32x16 acc[2][2];
    const bf16_t* Wt = WQK + (size_t)h * 256 * 128 + (size_t)(kind ? 1 : 0) * 128 * 128;
    const bf16_t* Xt = XC + (size_t)m0 * 512 + h * 128;
    if (kind < 2) {
      gemm_tile(Xt, 512, Wt, 128, 128, smem, acc);
      bf16_t* O = kind ? KM : QM;
      const float alpha = kind ? 1.0f : 0.08838834764831845f;
#pragma unroll
      for (int mi = 0; mi < 2; ++mi)
#pragma unroll
        for (int ni = 0; ni < 2; ++ni)
#pragma unroll
          for (int q = 0; q < 4; ++q) {
            const int row = m0 + EPI_ROW(mi), c = EPI_COL(ni, q);
            *(u32x2*)(O + (size_t)row * 512 + h * 128 + c) = (u32x2){pack2(alpha * acc[mi][ni][4 * q], alpha * acc[mi][ni][4 * q + 1]), pack2(alpha * acc[mi][ni][4 * q + 2], alpha * acc[mi][ni][4 * q + 3])};
          }
    } else {
      gemm_tile(Wt, 128, Xt, 512, 128, smem, acc);
      bf16_t* kt = KMT + ((size_t)(mt / 34) * 4 + h) * 128 * NTOK + (mt % 34) * 128;
#pragma unroll
      for (int mi = 0; mi < 2; ++mi)
#pragma unroll
        for (int ni = 0; ni < 2; ++ni)
#pragma unroll
          for (int q = 0; q < 4; ++q) {
            const int d = EPI_ROW(mi), tok = EPI_COL(ni, q);
            *(u32x2*)(kt + (size_t)d * NTOK + tok) = (u32x2){pack2(acc[mi][ni][4 * q], acc[mi][ni][4 * q + 1]), pack2(acc[mi][ni][4 * q + 2], acc[mi][ni][4 * q + 3])};
          }
    }
  }
}

__device__ __forceinline__ void attn_mfma_item(const Params& p, int l, const bf16_t* Zb, const bf16_t* VTb, bf16_t* YAb, int h, int qrow0, int key0, int nkeys,
                                               float lam, float lam_init, char* smem) {
  const int tid = otid(), lane = tid & 63, w = tid >> 6, fr = lane & 31, fh = lane >> 5;
  const int ntiles = nkeys >> 6;
  const int myrow = qrow0 + w * 32 + fr;
  bf16x8 qf[2][4];
  {
    const bf16_t* qp = Zb + (size_t)myrow * ZW + h * 128 + fh * 8;
#pragma unroll
    for (int m = 0; m < 2; ++m)
#pragma unroll
      for (int ks = 0; ks < 4; ++ks) qf[m][ks] = *(const bf16x8*)(qp + m * 64 + ks * 16);
  }
  f32x16 O[2][4];
#pragma unroll
  for (int m = 0; m < 2; ++m)
#pragma unroll
    for (int eb = 0; eb < 4; ++eb)
#pragma unroll
      for (int i = 0; i < 16; ++i) O[m][eb][i] = 0.f;
  float mrun[2] = {-1e30f, -1e30f}, lrun[2] = {0.f, 0.f};
  const float cs = 0.125f * 1.4426950408889634f;
  const int skey = tid >> 4, sch = tid & 15;
  const bf16_t* ksrc = Zb + (size_t)(key0 + skey) * ZW + 512 + h * 128 + sch * 8;
  const int kdst = skey * 256 + ((sch ^ (skey & 15)) << 4);
  const int se = tid >> 3, svc = tid & 7;
  const bf16_t* vsrc = VTb + ((size_t)h * 128 + se) * NTOK + key0 + svc * 8;
  const int vsw = (se >> 1) & 15;
  const int vdst0 = se * 128 + (((2 * svc) ^ vsw) << 3), vdst1 = se * 128 + (((2 * svc + 1) ^ vsw) << 3);
  const int kfo = fr * 256, kfs = fr & 15;
  const int vfo = fr * 128, vfs = (fr >> 1) & 15;
  u32x4 rk[4], rv[4];
#pragma unroll
  for (int i = 0; i < 4; ++i) rk[i] = *(const u32x4*)(ksrc + (size_t)i * 16 * ZW);
  __syncthreads();
#pragma unroll
  for (int i = 0; i < 4; ++i) *(u32x4*)(smem + kdst + i * 4096) = rk[i];
  __syncthreads();
  bf16x8 pf[2][4];
#pragma unroll
  for (int m = 0; m < 2; ++m)
#pragma unroll
    for (int s = 0; s < 4; ++s)
#pragma unroll
      for (int i = 0; i < 8; ++i) pf[m][s][i] = 0;
#pragma unroll 1
  for (int t = 0; t <= ntiles; ++t) {
    const bool cur = t < ntiles, nxt = t + 1 < ntiles, prv = t >= 1;
    if (nxt) {
#pragma unroll
      for (int i = 0; i < 4; ++i) rk[i] = *(const u32x4*)(ksrc + (size_t)((t + 1) * 64 + i * 16) * ZW);
    }
    if (cur) {
#pragma unroll
      for (int i = 0; i < 4; ++i) rv[i] = *(const u32x4*)(vsrc + (size_t)i * 32 * NTOK + t * 64);
    }
    const char* kb_ = smem + (t & 1) * 16384;
    f32x16 S[2];
    if (cur) {
#pragma unroll
      for (int kb = 0; kb < 2; ++kb) {
#pragma unroll
        for (int i = 0; i < 16; ++i) S[kb][i] = 0.f;
#pragma unroll
        for (int ks = 0; ks < 4; ++ks) {
          const bf16x8 kf = *(const bf16x8*)(kb_ + kb * 8192 + kfo + (((ks * 2 + fh) ^ kfs) << 4));
          S[kb] = __builtin_amdgcn_mfma_f32_32x32x16_bf16(kf, qf[0][ks], S[kb], 0, 0, 0);
        }
      }
    }
    if (prv) {
      const char* vb_ = smem + 32768 + ((t - 1) & 1) * 16384;
#pragma unroll
      for (int eb = 0; eb < 4; ++eb)
#pragma unroll
        for (int s = 0; s < 4; ++s) {
          const u32x2 v0 = *(const u32x2*)(vb_ + eb * 4096 + vfo + (((4 * s + fh) ^ vfs) << 3));
          const u32x2 v1 = *(const u32x2*)(vb_ + eb * 4096 + vfo + (((4 * s + fh + 2) ^ vfs) << 3));
          const bf16x8 vf = __builtin_bit_cast(bf16x8, (u32x4){v0[0], v0[1], v1[0], v1[1]});
          O[0][eb] = __builtin_amdgcn_mfma_f32_32x32x16_bf16(vf, pf[0][s], O[0][eb], 0, 0, 0);
          O[1][eb] = __builtin_amdgcn_mfma_f32_32x32x16_bf16(vf, pf[1][s], O[1][eb], 0, 0, 0);
        }
    }
    if (cur) {
#pragma unroll
      for (int m = 0; m < 2; ++m) {
        if (m == 1) {
#pragma unroll
          for (int kb = 0; kb < 2; ++kb) {
#pragma unroll
            for (int i = 0; i < 16; ++i) S[kb][i] = 0.f;
#pragma unroll
            for (int ks = 0; ks < 4; ++ks) {
              const bf16x8 kf = *(const bf16x8*)(kb_ + kb * 8192 + kfo + (((8 + ks * 2 + fh) ^ kfs) << 4));
              S[kb] = __builtin_amdgcn_mfma_f32_32x32x16_bf16(kf, qf[1][ks], S[kb], 0, 0, 0);
            }
          }
        }
        float tm = S[0][0];
#pragma unroll
        for (int i = 1; i < 16; ++i) tm = fmaxf(tm, S[0][i]);
#pragma unroll
        for (int i = 0; i < 16; ++i) tm = fmaxf(tm, S[1][i]);
        tm = fmaxf(tm, __shfl_xor(tm, 32)) * cs;
        float alpha = 1.f;
        if (tm > mrun[m] + 8.0f) { alpha = exp2f(mrun[m] - tm); mrun[m] = tm; }
        if (__any(alpha != 1.f)) {
#pragma unroll
          for (int eb = 0; eb < 4; ++eb)
#pragma unroll
            for (int i = 0; i < 16; ++i) O[m][eb][i] *= alpha;
          lrun[m] *= alpha;
        }
        const float mc = mrun[m];
        float rs = 0.f;
#pragma unroll
        for (int kb = 0; kb < 2; ++kb) {
          float pv[16];
#pragma unroll
          for (int i = 0; i < 16; ++i) { pv[i] = exp2f(fmaf(S[kb][i], cs, -mc)); rs += pv[i]; }
#pragma unroll
          for (int hh = 0; hh < 2; ++hh)
            pf[m][kb * 2 + hh] = __builtin_bit_cast(bf16x8, (u32x4){pack2(pv[8 * hh], pv[8 * hh + 1]), pack2(pv[8 * hh + 2], pv[8 * hh + 3]),
                                                                     pack2(pv[8 * hh + 4], pv[8 * hh + 5]), pack2(pv[8 * hh + 6], pv[8 * hh + 7])});
        }
        lrun[m] += rs;
      }
    }
    if (nxt) {
      char* kd = smem + ((t + 1) & 1) * 16384;
#pragma unroll
      for (int i = 0; i < 4; ++i) *(u32x4*)(kd + kdst + i * 4096) = rk[i];
    }
    if (cur) {
      char* vd = smem + 32768 + (t & 1) * 16384;
#pragma unroll
      for (int i = 0; i < 4; ++i) {
        *(u32x2*)(vd + vdst0 + i * 4096) = (u32x2){rv[i][0], rv[i][1]};
        *(u32x2*)(vd + vdst1 + i * 4096) = (u32x2){rv[i][2], rv[i][3]};
      }
    }
    __syncthreads();
  }
  const float l0 = lrun[0] + __shfl_xor(lrun[0], 32), l1 = lrun[1] + __shfl_xor(lrun[1], 32);
  const float i0 = 1.0f / l0, i1 = lam / l1;
  float ss = 0.f;
#pragma unroll
  for (int eb = 0; eb < 4; ++eb)
#pragma unroll
    for (int i = 0; i < 16; ++i) { const float o = O[0][eb][i] * i0 - O[1][eb][i] * i1; O[0][eb][i] = o; ss = fmaf(o, o, ss); }
  ss += __shfl_xor(ss, 32);
  const float rn = rsqrtf(ss * (1.0f / 128.0f) + EPSF) * (1.0f - lam_init);
  const float* sg = p.in[I_SUBG] + l * 512 + h * 128;
  bf16_t* yp = YAb + (size_t)myrow * 512 + h * 128;
#pragma unroll
  for (int eb = 0; eb < 4; ++eb)
#pragma unroll
    for (int q = 0; q < 4; ++q) {
      const int e = eb * 32 + 8 * q + 4 * fh;
      const float4 g = *(const float4*)(sg + e);
      *(u32x2*)(yp + e) = (u32x2){pack2(O[0][eb][4 * q] * rn * g.x, O[0][eb][4 * q + 1] * rn * g.y), pack2(O[0][eb][4 * q + 2] * rn * g.z, O[0][eb][4 * q + 3] * rn * g.w)};
    }
  __syncthreads();
}

__device__ __forceinline__ void mlstm_chain_item(const Params& p, int l, const bf16_t* QMb, const bf16_t* KMb, const bf16_t* KMTb, const bf16_t* MVTb,
                                                 const float* MGTb, bf16_t* HXb, int h, int dir, char* smem) {
  const int tid = otid(), lane = tid & 63, w = tid >> 6, fr = lane & 31, fh = lane >> 5;
  const int tb = w & 1, eh = w >> 1;
  float* fl = (float*)(smem + 98304);
  float* bs = fl; float* as_ = fl + 64; float* wgs = fl + 128; float* ebs = fl + 192; float* nprev = fl + 256; float* npart = fl + 384; float* dec_s = fl + 640;
  const float bi = p.in[I_GATEB][l * 16 + dir * 8 + h];
  const float bf_ = p.in[I_GATEB][l * 16 + dir * 8 + 4 + h];
  f32x16 CT[4];
#pragma unroll
  for (int eb = 0; eb < 4; ++eb)
#pragma unroll
    for (int i = 0; i < 16; ++i) CT[eb][i] = 0.f;
  __syncthreads();
  for (int i = tid; i < 2048; i += 256) ((u32x4*)(smem + 65536))[i] = (u32x4){0u, 0u, 0u, 0u};
  if (tid < 128) nprev[tid] = 0.f;
  const int qr = tid >> 4, qc = tid & 15;
  const int qdst = qr * 256 + ((qc ^ (qr & 15)) << 4);
  const int tr = tid >> 3, tc = tid & 7;
  const int tdst = tr * 128 + ((tc ^ ((tr >> 1) & 7)) << 4);
  const int sw16 = fr & 15, sw8 = (fr >> 1) & 7;
#pragma unroll 1
  for (int c = 0; c < 68; ++c) {
    const int row0 = (dir == 0) ? ((c < 4) ? NLAT + 64 * c : 64 * (c - 4)) : ((c < 4) ? NLAT + 64 * (3 - c) : 64 * (67 - c));
    __syncthreads();
    {
      const bf16_t* qs = QMb + (size_t)(row0 + qr) * 512 + h * 128 + qc * 8;
      const bf16_t* ks = KMb + (size_t)(row0 + qr) * 512 + h * 128 + qc * 8;
      const bf16_t* kts = KMTb + ((size_t)h * 128 + tr) * NTOK + row0 + tc * 8;
      const bf16_t* vts = MVTb + ((size_t)h * 128 + tr) * NTOK + row0 + tc * 8;
      u32x4 a[4], b[4], cc[4], d[4];
#pragma unroll
      for (int i = 0; i < 4; ++i) {
        a[i] = *(const u32x4*)(qs + (size_t)i * 16 * 512);
        b[i] = *(const u32x4*)(ks + (size_t)i * 16 * 512);
        cc[i] = *(const u32x4*)(kts + (size_t)i * 32 * NTOK);
        d[i] = *(const u32x4*)(vts + (size_t)i * 32 * NTOK);
      }
#pragma unroll
      for (int i = 0; i < 4; ++i) {
        *(u32x4*)(smem + qdst + i * 4096) = a[i];
        *(u32x4*)(smem + 16384 + qdst + i * 4096) = b[i];
        *(u32x4*)(smem + 32768 + tdst + i * 4096) = cc[i];
        *(u32x4*)(smem + 49152 + tdst + i * 4096) = d[i];
      }
    }
    if (w == 0) {
      const int row = row0 + lane;
      const float li = MGTb[(size_t)row * 16 + dir * 8 + h] + bi;
      const float x = MGTb[(size_t)row * 16 + dir * 8 + 4 + h] + bf_;
      const float lf = fminf(x, 0.f) - log1pf(expf(-fabsf(x)));
      float b = lf;
#pragma unroll
      for (int o = 1; o < 64; o <<= 1) {
        const float v = (dir == 0) ? __shfl_up(b, o) : __shfl_down(b, o);
        const bool ok = (dir == 0) ? (lane >= o) : (lane + o < 64);
        if (ok) b += v;
      }
      const float tot = (dir == 0) ? __shfl(b, 63) : __shfl(b, 0);
      bs[lane] = b; as_[lane] = li - b; wgs[lane] = expf(tot + li - b); ebs[lane] = expf(b);
      if (lane == 0) *dec_s = expf(tot);
    }
    __syncthreads();
    const int t = tb * 32 + fr;
    bf16x8 qf[8];
#pragma unroll
    for (int ks = 0; ks < 8; ++ks) qf[ks] = *(const bf16x8*)(smem + t * 256 + (((ks * 2 + fh) ^ sw16) << 4));
    const float bt = bs[t], ebt = ebs[t];
    f32x16 S[2];
    float dsum = 0.f;
#pragma unroll
    for (int sb = 0; sb < 2; ++sb) {
#pragma unroll
      for (int i = 0; i < 16; ++i) S[sb][i] = 0.f;
      const bool valid = (dir == 0) ? (sb <= tb) : (sb >= tb);
      if (valid) {
#pragma unroll
        for (int ks = 0; ks < 8; ++ks) {
          const bf16x8 kf = *(const bf16x8*)(smem + 16384 + (sb * 32 + fr) * 256 + (((ks * 2 + fh) ^ sw16) << 4));
          S[sb] = __builtin_amdgcn_mfma_f32_32x32x16_bf16(kf, qf[ks], S[sb], 0, 0, 0);
        }
#pragma unroll
        for (int q = 0; q < 4; ++q) {
          const float4 a4 = *(const float4*)(as_ + sb * 32 + 8 * q + 4 * fh);
          const float av[4] = {a4.x, a4.y, a4.z, a4.w};
#pragma unroll
          for (int j = 0; j < 4; ++j) {
            const int s = sb * 32 + 8 * q + 4 * fh + j;
            const bool ok = (dir == 0) ? (s <= t) : (s >= t);
            const float v = ok ? S[sb][4 * q + j] * expf(bt + av[j]) : 0.f;
            S[sb][4 * q + j] = v;
            dsum += v;
          }
        }
      }
    }
    bf16x8 pf[4];
#pragma unroll
    for (int sb = 0; sb < 2; ++sb)
#pragma unroll
      for (int hh = 0; hh < 2; ++hh)
        pf[sb * 2 + hh] = __builtin_bit_cast(bf16x8, (u32x4){pack2(S[sb][8 * hh], S[sb][8 * hh + 1]), pack2(S[sb][8 * hh + 2], S[sb][8 * hh + 3]),
                                                                 pack2(S[sb][8 * hh + 4], S[sb][8 * hh + 5]), pack2(S[sb][8 * hh + 6], S[sb][8 * hh + 7])});
    float nq = 0.f;
#pragma unroll
    for (int c8 = 0; c8 < 8; ++c8) {
      const u32x4 qv = *(const u32x4*)(smem + t * 256 + (((fh * 8 + c8) ^ sw16) << 4));
      const float4 n0 = *(const float4*)(nprev + fh * 64 + c8 * 8), n1 = *(const float4*)(nprev + fh * 64 + c8 * 8 + 4);
      nq = fmaf(lo16(qv[0]), n0.x, nq); nq = fmaf(hi16(qv[0]), n0.y, nq); nq = fmaf(lo16(qv[1]), n0.z, nq); nq = fmaf(hi16(qv[1]), n0.w, nq);
      nq = fmaf(lo16(qv[2]), n1.x, nq); nq = fmaf(hi16(qv[2]), n1.y, nq); nq = fmaf(lo16(qv[3]), n1.z, nq); nq = fmaf(hi16(qv[3]), n1.w, nq);
    }
    dsum += __shfl_xor(dsum, 32);
    nq += __shfl_xor(nq, 32);
    const float den = dsum + ebt * nq;
    const float inv = 1.0f / fmaxf(fabsf(den), 1.0f);
#pragma unroll
    for (int x = 0; x < 2; ++x) {
      const int eb = 2 * eh + x;
      f32x16 N;
#pragma unroll
      for (int i = 0; i < 16; ++i) N[i] = 0.f;
#pragma unroll
      for (int ks = 0; ks < 8; ++ks) {
        const bf16x8 cf = *(const bf16x8*)(smem + 65536 + (eb * 32 + fr) * 256 + (((ks * 2 + fh) ^ sw16) << 4));
        N = __builtin_amdgcn_mfma_f32_32x32x16_bf16(cf, qf[ks], N, 0, 0, 0);
      }
#pragma unroll
      for (int i = 0; i < 16; ++i) N[i] *= ebt;
#pragma unroll
      for (int s4 = 0; s4 < 4; ++s4) {
        const bool valid = (dir == 0) ? ((s4 >> 1) <= tb) : ((s4 >> 1) >= tb);
        if (valid) {
          const int u0 = 4 * s4 + fh, u1 = u0 + 2;
          const char* vrow = smem + 49152 + (eb * 32 + fr) * 128;
          const u32x2 v0 = *(const u32x2*)(vrow + (((u0 >> 1) ^ sw8) << 4) + (u0 & 1) * 8);
          const u32x2 v1 = *(const u32x2*)(vrow + (((u1 >> 1) ^ sw8) << 4) + (u1 & 1) * 8);
          const bf16x8 vf = __builtin_bit_cast(bf16x8, (u32x4){v0[0], v0[1], v1[0], v1[1]});
          N = __builtin_amdgcn_mfma_f32_32x32x16_bf16(vf, pf[s4], N, 0, 0, 0);
        }
      }
      bf16_t* hp = HXb + (size_t)(row0 + t) * 512 + h * 128 + eb * 32 + 4 * fh;
#pragma unroll
      for (int q = 0; q < 4; ++q)
        *(u32x2*)(hp + 8 * q) = (u32x2){pack2(N[4 * q] * inv, N[4 * q + 1] * inv), pack2(N[4 * q + 2] * inv, N[4 * q + 3] * inv)};
    }
    const float decay = *dec_s;
#pragma unroll
    for (int eb = 0; eb < 4; ++eb)
#pragma unroll
      for (int i = 0; i < 16; ++i) CT[eb][i] *= decay;
#pragma unroll
    for (int ks = 0; ks < 4; ++ks) {
      const u32x4 kraw = *(const u32x4*)(smem + 32768 + (w * 32 + fr) * 128 + (((ks * 2 + fh) ^ sw8) << 4));
      const float4 g0 = *(const float4*)(wgs + ks * 16 + 8 * fh), g1 = *(const float4*)(wgs + ks * 16 + 8 * fh + 4);
      const bf16x8 kts = __builtin_bit_cast(bf16x8, (u32x4){pack2(lo16(kraw[0]) * g0.x, hi16(kraw[0]) * g0.y), pack2(lo16(kraw[1]) * g0.z, hi16(kraw[1]) * g0.w),
                                                             pack2(lo16(kraw[2]) * g1.x, hi16(kraw[2]) * g1.y), pack2(lo16(kraw[3]) * g1.z, hi16(kraw[3]) * g1.w)});
#pragma unroll
      for (int eb = 0; eb < 4; ++eb) {
        const bf16x8 vt = *(const bf16x8*)(smem + 49152 + (eb * 32 + fr) * 128 + (((ks * 2 + fh) ^ sw8) << 4));
        CT[eb] = __builtin_amdgcn_mfma_f32_32x32x16_bf16(kts, vt, CT[eb], 0, 0, 0);
      }
    }
    {
      const int d = tid & 127, sh = tid >> 7;
      float a = 0.f;
#pragma unroll 8
      for (int s = sh * 32; s < sh * 32 + 32; ++s) {
        const bf16_t kv = *(const bf16_t*)(smem + 16384 + s * 256 + ((((d >> 3)) ^ (s & 15)) << 4) + (d & 7) * 2);
        a = fmaf(wgs[s], bf2f(kv), a);
      }
      npart[sh * 128 + d] = a;
    }
    __syncthreads();
#pragma unroll
    for (int eb = 0; eb < 4; ++eb)
#pragma unroll
      for (int q = 0; q < 4; ++q)
        *(u32x2*)(smem + 65536 + (eb * 32 + fr) * 256 + ((((w * 4 + q)) ^ sw16) << 4) + 8 * fh) =
            (u32x2){pack2(CT[eb][4 * q], CT[eb][4 * q + 1]), pack2(CT[eb][4 * q + 2], CT[eb][4 * q + 3])};
    if (tid < 128) nprev[tid] = decay * nprev[tid] + npart[tid] + npart[128 + tid];
  }
  __syncthreads();
}

#define S5SEG 128
#define S5NSEG 34
__device__ __forceinline__ int s5_row(int dir, int step) {
  return (dir == 0) ? ((step < NCTX) ? NLAT + step : step - NCTX)
                    : ((step < NCTX) ? NLAT + (NCTX - 1 - step) : (NLAT - 1) - (step - NCTX));
}
struct S5Disc { float abr, abi, lre_dt, lim_dt; float bbr[16], bbi[16]; };
__device__ __forceinline__ void s5_discretise(const Params& p, int pg, int n, S5Disc& d) {
  const float lre = p.in[I_S5LRE][pg * 64 + n], lim = p.in[I_S5LIM][pg * 64 + n];
  const float dt = expf(p.in[I_S5DT][pg]);
  d.lre_dt = lre * dt; d.lim_dt = lim * dt;
  const float mag = expf(lre * dt);
  d.abr = mag * cosf(lim * dt); d.abi = mag * sinf(lim * dt);
  const float den = lre * lre + lim * lim;
  const float zr = ((d.abr - 1.0f) * lre + d.abi * lim) / den;
  const float zi = (d.abi * lre - (d.abr - 1.0f) * lim) / den;
  const float* br = p.in[I_S5BRE] + ((size_t)pg * 64 + n) * 16;
  const float* bi = p.in[I_S5BIM] + ((size_t)pg * 64 + n) * 16;
#pragma unroll
  for (int q = 0; q < 16; ++q) { float a = br[q], b = bi[q]; d.bbr[q] = zr * a - zi * b; d.bbi[q] = zr * b + zi * a; }
}
__device__ __forceinline__ void s5_step(const S5Disc& d, const float* urow, float& xr, float& xi) {
  const float4* up = (const float4*)urow;
  float br_ = 0.f, bi_ = 0.f;
#pragma unroll
  for (int q4 = 0; q4 < 4; ++q4) {
    const float4 uv = up[q4];
    br_ = fmaf(uv.x, d.bbr[4 * q4], br_); br_ = fmaf(uv.y, d.bbr[4 * q4 + 1], br_); br_ = fmaf(uv.z, d.bbr[4 * q4 + 2], br_); br_ = fmaf(uv.w, d.bbr[4 * q4 + 3], br_);
    bi_ = fmaf(uv.x, d.bbi[4 * q4], bi_); bi_ = fmaf(uv.y, d.bbi[4 * q4 + 1], bi_); bi_ = fmaf(uv.z, d.bbi[4 * q4 + 2], bi_); bi_ = fmaf(uv.w, d.bbi[4 * q4 + 3], bi_);
  }
  const float nr = d.abr * xr - d.abi * xi + br_;
  const float ni = d.abr * xi + d.abi * xr + bi_;
  xr = nr; xi = ni;
}
__device__ __forceinline__ void stage_s5_pass1(const Params& p, int l, const bf16_t* Z, float* XE, float* smem) {
  const int tid = otid(), w = tid >> 6, lane = tid & 63;
  float* us = smem + w * 1024;
  const int nitems = GB * 32 * 2 * (S5NSEG - 1);
  for (int it = blockIdx.x; it * 4 < nitems; it += gridDim.x) {
    const int idx = it * 4 + w;
    const bool active = idx < nitems;
    const int seg = idx % (S5NSEG - 1), r1 = idx / (S5NSEG - 1), dir = r1 & 1, g = (r1 >> 1) & 31, bl = r1 >> 6;
    S5Disc d;
    if (active) s5_discretise(p, (l * 2 + dir) * 32 + g, lane, d);
    float xr = 0.f, xi = 0.f;
    for (int sub = 0; sub < S5SEG / 64; ++sub) {
      __syncthreads();
      if (active) {
        const int row = s5_row(dir, seg * S5SEG + sub * 64 + lane);
        const u32x4* up = (const u32x4*)(Z + ((size_t)bl * NTOK + row) * ZW + 3072 + g * 16);
#pragma unroll
        for (int q = 0; q < 2; ++q) {
          const u32x4 t = up[q];
#pragma unroll
          for (int k = 0; k < 4; ++k) { us[lane * 16 + q * 8 + 2 * k] = lo16(t[k]); us[lane * 16 + q * 8 + 2 * k + 1] = hi16(t[k]); }
        }
      }
      __syncthreads();
      if (active) {
#pragma unroll 4
        for (int t = 0; t < 64; ++t) s5_step(d, us + t * 16, xr, xi);
      }
    }
    if (active) {
      float* xe = XE + ((((size_t)bl * 32 + g) * 2 + dir) * (S5NSEG - 1) + seg) * 128;
      xe[lane] = xr; xe[64 + lane] = xi;
    }
  }
  __syncthreads();
}
__device__ __forceinline__ void s5_item(const Params& p, int l, const bf16_t* Zb, const float* XEc, float* Yb, int g, int dir, int sq, float* smem) {
  const int tid = otid(), w = tid >> 6, lane = tid & 63;
  const int seg = sq * 4 + w;
  const bool active = seg < S5NSEG;
  float* cre = smem;
  float* cim = smem + 1024;
  float* wb = smem + 2048 + w * 4800;
  float* us = wb;
  float* xre = wb + 512;
  float* xim = xre + 32 * 65;
  const int pg = (l * 2 + dir) * 32 + g;
  S5Disc d;
  s5_discretise(p, pg, lane, d);
  __syncthreads();
  {
    const float* cr = p.in[I_S5CRE] + (size_t)pg * 16 * 64;
    const float* ci = p.in[I_S5CIM] + (size_t)pg * 16 * 64;
    for (int i = tid; i < 1024; i += 256) { const int q = i >> 6, n = i & 63; cre[n * 16 + q] = cr[i]; cim[n * 16 + q] = ci[i]; }
  }
  float xr = 0.f, xi = 0.f;
  if (active) {
    const float mg = expf(d.lre_dt * (float)S5SEG);
    const float ar = mg * cosf(d.lim_dt * (float)S5SEG), ai = mg * sinf(d.lim_dt * (float)S5SEG);
    for (int j = 0; j < seg; ++j) {
      const float er = XEc[j * 128 + lane], ei = XEc[j * 128 + 64 + lane];
      const float nr = ar * xr - ai * xi + er, ni = ar * xi + ai * xr + ei;
      xr = nr; xi = ni;
    }
  }
  const int tl = lane & 31, ph = lane >> 5;
  for (int sub = 0; sub < S5SEG / 32; ++sub) {
    const int row = s5_row(dir, (active ? seg : 0) * S5SEG + sub * 32 + tl);
    __syncthreads();
    if (active) {
      const u32x4 t = *(const u32x4*)(Zb + (size_t)row * ZW + 3072 + g * 16 + ph * 8);
#pragma unroll
      for (int k = 0; k < 4; ++k) { us[tl * 16 + ph * 8 + 2 * k] = lo16(t[k]); us[tl * 16 + ph * 8 + 2 * k + 1] = hi16(t[k]); }
    }
    __syncthreads();
    if (active) {
#pragma unroll 4
      for (int t = 0; t < 32; ++t) {
        s5_step(d, us + t * 16, xr, xi);
        xre[t * 65 + lane] = xr;
        xim[t * 65 + lane] = xi;
      }
    }
    __syncthreads();
    if (active) {
      float y[8];
#pragma unroll
      for (int q = 0; q < 8; ++q) y[q] = 0.f;
      for (int n = 0; n < 64; ++n) {
        const float a = xre[tl * 65 + n], b = xim[tl * 65 + n];
        const float4 c0 = *(const float4*)(cre + n * 16 + ph * 8), c1 = *(const float4*)(cre + n * 16 + ph * 8 + 4);
        const float4 e0 = *(const float4*)(cim + n * 16 + ph * 8), e1 = *(const float4*)(cim + n * 16 + ph * 8 + 4);
        y[0] += a * c0.x - b * e0.x; y[1] += a * c0.y - b * e0.y; y[2] += a * c0.z - b * e0.z; y[3] += a * c0.w - b * e0.w;
        y[4] += a * c1.x - b * e1.x; y[5] += a * c1.y - b * e1.y; y[6] += a * c1.z - b * e1.z; y[7] += a * c1.w - b * e1.w;
      }
      float4* yp = (float4*)(Yb + (size_t)row * 512 + g * 16 + ph * 8);
      yp[0] = make_float4(y[0], y[1], y[2], y[3]);
      yp[1] = make_float4(y[4], y[5], y[6], y[7]);
    }
  }
  __syncthreads();
}

__device__ __forceinline__ void stage_post(const Params& p, int l, int rr_lim, const bf16_t* Z, const bf16_t* HF, const bf16_t* HB,
                                           const float* YSF, const float* YSB, bf16_t* YB, bf16_t* GG) {
  const int tid = otid();
  const int c0 = tid * 2;
  for (int i = blockIdx.x; i < GB * rr_lim; i += gridDim.x) {
    const size_t r = (size_t)(i / rr_lim) * NTOK + (i % rr_lim);
    {
      const unsigned a0 = *(const unsigned*)(HF + r * 512 + c0), a1 = *(const unsigned*)(HB + r * 512 + c0);
      float h0 = lo16(a0) + lo16(a1), h1 = hi16(a0) + hi16(a1);
      float ss = wave_sum(h0 * h0 + h1 * h1);
      float rs = rsqrtf(ss * (1.0f / 128.0f) + EPSF);
      float2 g = *(const float2*)(p.in[I_MLNG] + l * 512 + c0);
      const unsigned og = *(const unsigned*)(Z + r * ZW + 2560 + c0);
      *(unsigned*)(YB + r * 512 + c0) = pack2(h0 * rs * g.x * sigmoidf_(lo16(og)), h1 * rs * g.y * sigmoidf_(hi16(og)));
    }
    {
      const unsigned u = *(const unsigned*)(Z + r * ZW + 3072 + c0);
      float2 d = *(const float2*)(p.in[I_S5D] + l * 512 + c0);
      float2 f = *(const float2*)(YSF + r * 512 + c0);
      float2 b = *(const float2*)(YSB + r * 512 + c0);
      *(unsigned*)(GG + r * 512 + c0) = pack2(geluf_(d.x * lo16(u) + f.x + b.x), geluf_(d.y * hi16(u) + f.y + b.y));
    }
  }
}

__device__ __forceinline__ void stage_glu_mfma(const Params& p, int l, int tpb, const bf16_t* GG, const bf16_t* GLUT, bf16_t* YS, char* smem) {
  EPI_DECL
  const int tm = GB * tpb;
  for (int t = blockIdx.x; t < tm * 4; t += gridDim.x) {
    const int m0 = MT_LR0(t >> 2, tpb), n0 = (t & 3) * 128;
    f32x16 acc[2][2];
    gemm_tile(GG + (size_t)m0 * 512, 512, GLUT + (size_t)n0 * 512, 512, 512, smem, acc);
#pragma unroll
    for (int mi = 0; mi < 2; ++mi)
#pragma unroll
      for (int ni = 0; ni < 2; ++ni)
#pragma unroll
        for (int q = 0; q < 4; ++q) {
          const int row = m0 + EPI_ROW(mi), c = n0 + EPI_COL(ni, q);
          const float4 b = *(const float4*)(p.in[I_GLUB] + l * 512 + c);
          const u32x2 g2 = *(const u32x2*)(GG + (size_t)row * 512 + c);
          const float o0 = lo16(g2[0]) * sigmoidf_(acc[mi][ni][4 * q] + b.x), o1 = hi16(g2[0]) * sigmoidf_(acc[mi][ni][4 * q + 1] + b.y);
          const float o2 = lo16(g2[1]) * sigmoidf_(acc[mi][ni][4 * q + 2] + b.z), o3 = hi16(g2[1]) * sigmoidf_(acc[mi][ni][4 * q + 3] + b.w);
          *(u32x2*)(YS + (size_t)row * 512 + c) = (u32x2){pack2(o0, o1), pack2(o2, o3)};
        }
  }
}

__device__ __forceinline__ void stage_merge_mfma(int tpb, const bf16_t* YA, const bf16_t* YB, const bf16_t* YS, const bf16_t* WBR, const bf16_t* Z, bf16_t* MG, char* smem) {
  EPI_DECL
  const int tm = GB * tpb;
  for (int t = blockIdx.x; t < tm * 8; t += gridDim.x) {
    const int m0 = MT_LR0(t >> 3, tpb), n0 = (t & 7) * 128;
    f32x16 macc[2][2];
#pragma unroll
    for (int a = 0; a < 2; ++a)
#pragma unroll
      for (int b = 0; b < 2; ++b)
#pragma unroll
        for (int i = 0; i < 16; ++i) macc[a][b][i] = 0.f;
#pragma unroll 1
    for (int r = 0; r < 3; ++r) {
      const bf16_t* Y = (r == 0) ? YA : (r == 1 ? YB : YS);
      f32x16 acc[2][2];
      gemm_tile(Y + (size_t)m0 * 512, 512, WBR + (size_t)r * 1024 * 512 + (size_t)n0 * 512, 512, 512, smem, acc);
#pragma unroll
      for (int mi = 0; mi < 2; ++mi)
#pragma unroll
        for (int ni = 0; ni < 2; ++ni)
#pragma unroll
          for (int q = 0; q < 4; ++q) {
            const int row = m0 + EPI_ROW(mi), c = n0 + EPI_COL(ni, q);
            const u32x2 e = *(const u32x2*)(Z + (size_t)row * ZW + 3584 + r * 1024 + c);
            macc[mi][ni][4 * q] += lo16(e[0]) * acc[mi][ni][4 * q];
            macc[mi][ni][4 * q + 1] += hi16(e[0]) * acc[mi][ni][4 * q + 1];
            macc[mi][ni][4 * q + 2] += lo16(e[1]) * acc[mi][ni][4 * q + 2];
            macc[mi][ni][4 * q + 3] += hi16(e[1]) * acc[mi][ni][4 * q + 3];
          }
    }
#pragma unroll
    for (int mi = 0; mi < 2; ++mi)
#pragma unroll
      for (int ni = 0; ni < 2; ++ni)
#pragma unroll
        for (int q = 0; q < 4; ++q) {
          const int row = m0 + EPI_ROW(mi), c = n0 + EPI_COL(ni, q);
          *(u32x2*)(MG + (size_t)row * DM + c) = (u32x2){pack2(macc[mi][ni][4 * q], macc[mi][ni][4 * q + 1]), pack2(macc[mi][ni][4 * q + 2], macc[mi][ni][4 * q + 3])};
        }
  }
}

__device__ __forceinline__ void stage_outproj_mfma(const Params& p, int l, int g, int tpb, const bf16_t* MG, const bf16_t* WOUT, char* smem) {
  EPI_DECL
  const int tm = GB * tpb;
  const float* mod = (const float*)(p.ws + WB_MOD) + (size_t)l * 9 * 6144;
  for (int t = blockIdx.x; t < tm * 8; t += gridDim.x) {
    const int mt = t >> 3, n0 = (t & 7) * 128;
    const int m0 = MT_LR0(mt, tpb), bl = mt / tpb, rr0 = (mt % tpb) * 128, b = g * GB + bl;
    f32x16 acc[2][2];
    gemm_tile(MG + (size_t)m0 * DM, DM, WOUT + (size_t)n0 * DM, DM, DM, smem, acc);
    const float* gv = mod + (size_t)((rr0 < NLAT) ? b : 8) * 6144 + 2 * 1024;
#pragma unroll
    for (int mi = 0; mi < 2; ++mi)
#pragma unroll
      for (int ni = 0; ni < 2; ++ni)
#pragma unroll
        for (int q = 0; q < 4; ++q) {
          const int rr = rr0 + EPI_ROW(mi), c = n0 + EPI_COL(ni, q);
          const float4 gg = *(const float4*)(gv + c);
          float4* xp = (float4*)(xrow(p, b, rr) + c);
          float4 x = *xp;
          x.x += gg.x * acc[mi][ni][4 * q]; x.y += gg.y * acc[mi][ni][4 * q + 1]; x.z += gg.z * acc[mi][ni][4 * q + 2]; x.w += gg.w * acc[mi][ni][4 * q + 3];
          *xp = x;
        }
  }
}

__device__ __forceinline__ void stage_peerq_mfma(int tpb, const bf16_t* H2, const bf16_t* WQ, bf16_t* PQ, char* smem) {
  EPI_DECL
  const int tm = GB * tpb;
  for (int t = blockIdx.x; t < tm * 16; t += gridDim.x) {
    const int m0 = MT_LR0(t >> 4, tpb), n0 = (t & 15) * 128;
    f32x16 acc[2][2];
    gemm_tile(H2 + (size_t)m0 * DM, DM, WQ + (size_t)n0 * DM, DM, DM, smem, acc);
#pragma unroll
    for (int mi = 0; mi < 2; ++mi)
#pragma unroll
      for (int ni = 0; ni < 2; ++ni)
#pragma unroll
        for (int q = 0; q < 4; ++q) {
          const int row = m0 + EPI_ROW(mi), c = n0 + EPI_COL(ni, q);
          *(u32x2*)(PQ + (size_t)row * 2048 + c) = (u32x2){pack2(acc[mi][ni][4 * q], acc[mi][ni][4 * q + 1]), pack2(acc[mi][ni][4 * q + 2], acc[mi][ni][4 * q + 3])};
        }
  }
}

__device__ __forceinline__ void stage_scores_mfma(int tpb, const bf16_t* PQ, const bf16_t* SUBK, float* SCT, char* smem) {
  EPI_DECL
  const int tm = GB * tpb * 8;
  for (int t = blockIdx.x; t < tm * 2; t += gridDim.x) {
    const int mt = t >> 1, half = t & 1;
    const size_t m0 = (size_t)MT_LR0(mt >> 3, tpb) * 8 + (size_t)(mt & 7) * 128;
    f32x16 acc[2][2];
    gemm_tile(SUBK + (size_t)half * 16384, 128, PQ + m0 * 256 + half * 128, 256, 128, smem, acc);
    float* o = SCT + ((size_t)mt * 2 + half) * 16384;
#pragma unroll
    for (int mi = 0; mi < 2; ++mi)
#pragma unroll
      for (int ni = 0; ni < 2; ++ni)
#pragma unroll
        for (int q = 0; q < 4; ++q) {
          const int key = EPI_ROW(mi), item = EPI_COL(ni, q);
          *(float4*)(o + key * 128 + item) = make_float4(acc[mi][ni][4 * q], acc[mi][ni][4 * q + 1], acc[mi][ni][4 * q + 2], acc[mi][ni][4 * q + 3]);
        }
  }
}

__device__ __forceinline__ unsigned f2sortable(float x) { const unsigned u = __float_as_uint(x); return (u & 0x80000000u) ? ~u : (u | 0x80000000u); }
__device__ __forceinline__ float sortable2f(unsigned k) { return __uint_as_float((k & 0x80000000u) ? (k & 0x7fffffffu) : ~k); }
#define TOPK_INSERT(v, key) { unsigned t_ = (key); _Pragma("unroll") for (int s_ = 0; s_ < 16; ++s_) { const unsigned hi_ = max(v[s_], t_); t_ = min(v[s_], t_); v[s_] = hi_; } }
__device__ __forceinline__ void stage_topk(int tpb, const float* SCT, int* EI, float* EG, float* smem) {
  const int tid = otid();
  const int item = tid & 127, half = tid >> 7;
  unsigned* xk = (unsigned*)smem;
  const int tm = GB * tpb * 8;
  for (int mt = blockIdx.x; mt < tm; mt += gridDim.x) {
    const size_t m0 = (size_t)MT_LR0(mt >> 3, tpb) * 8 + (size_t)(mt & 7) * 128;
    const float* sc = SCT + ((size_t)mt * 2 + half) * 16384 + item;
    unsigned v[16];
#pragma unroll
    for (int s = 0; s < 16; ++s) v[s] = 0u;
#pragma unroll 4
    for (int k = 0; k < 128; ++k) {
      const unsigned key = (f2sortable(sc[k * 128]) & ~127u) | (unsigned)(127 - k);
      TOPK_INSERT(v, key)
    }
    __syncthreads();
    if (half == 1) {
#pragma unroll
      for (int s = 0; s < 16; ++s) xk[item * 17 + s] = v[s];
    }
    __syncthreads();
    if (half == 0) {
      float v1[16], v2[16];
      unsigned k2[16];
#pragma unroll
      for (int s = 0; s < 16; ++s) { k2[s] = xk[item * 17 + s]; v1[s] = sortable2f((v[s] & ~127u) | 64u); v2[s] = sortable2f((k2[s] & ~127u) | 64u); }
      unsigned c[16];
#pragma unroll
      for (int s = 0; s < 16; ++s) c[s] = 0u;
      {
        int o = 0;
#pragma unroll
        for (int i = 0; i < 16; ++i)
#pragma unroll
          for (int j = 0; j < 16 / (i + 1); ++j) {
            const unsigned key = (f2sortable(v1[i] + v2[j]) & ~63u) | (unsigned)(63 - o);
            TOPK_INSERT(c, key)
            ++o;
          }
      }
      const float vmax = sortable2f((c[0] & ~63u) | 32u);
      float sum = 0.f;
#pragma unroll
      for (int s = 0; s < 16; ++s) sum += expf(sortable2f((c[s] & ~63u) | 32u) - vmax);
      const float isum = 1.0f / sum;
      const unsigned thr = c[15];
      int* ei = EI + (m0 + item) * 16;
      float* eg = EG + (m0 + item) * 16;
      int cntw = 0;
      {
        int o = 0;
#pragma unroll
        for (int i = 0; i < 16; ++i)
#pragma unroll
          for (int j = 0; j < 16 / (i + 1); ++j) {
            const unsigned key = (f2sortable(v1[i] + v2[j]) & ~63u) | (unsigned)(63 - o);
            if (key >= thr) {
              ei[cntw] = (int)((127u - (v[i] & 127u)) * 128u + (127u - (k2[j] & 127u)));
              eg[cntw] = expf(sortable2f((key & ~63u) | 32u) - vmax) * isum;
              ++cntw;
            }
            ++o;
          }
      }
    }
  }
  __syncthreads();
}

__device__ __forceinline__ void unpack8(const u32x4 v, float* f) {
#pragma unroll
  for (int k = 0; k < 4; ++k) { f[2 * k] = lo16(v[k]); f[2 * k + 1] = hi16(v[k]); }
}
__device__ __forceinline__ void stage_expert(const Params& p, int l, int g, int rr_lim, const bf16_t* H2, const int* EI, const float* EG, float* smem) {
  const int tid = otid(), w = tid >> 6, lane = tid & 63;
  float* part = smem;
  const bf16_t* U = (const bf16_t*)(p.ws + WB_U16) + (size_t)l * 16384 * 1024;
  const bf16_t* V = (const bf16_t*)(p.ws + WB_V16) + (size_t)l * 16384 * 1024;
  const float* mod = (const float*)(p.ws + WB_MOD) + (size_t)l * 9 * 6144;
  for (int i = blockIdx.x; i < GB * rr_lim; i += gridDim.x) {
    const int bl = i / rr_lim, rr = i % rr_lim, b = g * GB + bl;
    const size_t t = (size_t)bl * NTOK + rr;
    float hf[16];
    unpack8(((const u32x4*)(H2 + t * DM))[lane], hf);
    unpack8(((const u32x4*)(H2 + t * DM + 512))[lane], hf + 8);
    const int my_e = EI[t * 128 + w * 32 + (lane & 31)];
    const float my_g = EG[t * 128 + w * 32 + (lane & 31)];
    float my_dot = 0.f;
#pragma unroll 1
    for (int k0 = 0; k0 < 32; k0 += 8) {
      u32x4 ra[8], rb[8];
#pragma unroll
      for (int j = 0; j < 8; ++j) {
        const int e = __builtin_amdgcn_readlane(my_e, k0 + j);
        const u32x4* up = (const u32x4*)(U + (size_t)e * 1024);
        ra[j] = up[lane]; rb[j] = up[64 + lane];
      }
#pragma unroll
      for (int j = 0; j < 8; ++j) {
        float f[16];
        unpack8(ra[j], f); unpack8(rb[j], f + 8);
        float a = 0.f;
#pragma unroll
        for (int q = 0; q < 16; ++q) a = fmaf(hf[q], f[q], a);
        a = wave_sum(a);
        if ((lane & 31) == k0 + j) my_dot = a;
      }
    }
    const float my_c = my_g * geluf_(my_dot);
    float acc[16];
#pragma unroll
    for (int q = 0; q < 16; ++q) acc[q] = 0.f;
#pragma unroll 1
    for (int k0 = 0; k0 < 32; k0 += 8) {
      u32x4 ra[8], rb[8];
#pragma unroll
      for (int j = 0; j < 8; ++j) {
        const int e = __builtin_amdgcn_readlane(my_e, k0 + j);
        const u32x4* vp = (const u32x4*)(V + (size_t)e * 1024);
        ra[j] = vp[lane]; rb[j] = vp[64 + lane];
      }
#pragma unroll
      for (int j = 0; j < 8; ++j) {
        const float c = __uint_as_float(__builtin_amdgcn_readlane(__float_as_uint(my_c), k0 + j));
        float f[16];
        unpack8(ra[j], f); unpack8(rb[j], f + 8);
#pragma unroll
        for (int q = 0; q < 16; ++q) acc[q] = fmaf(c, f[q], acc[q]);
      }
    }
    __syncthreads();
    {
      float4* pw = (float4*)(part + w * 1024 + lane * 8);
      pw[0] = make_float4(acc[0], acc[1], acc[2], acc[3]); pw[1] = make_float4(acc[4], acc[5], acc[6], acc[7]);
      float4* pw2 = (float4*)(part + w * 1024 + 512 + lane * 8);
      pw2[0] = make_float4(acc[8], acc[9], acc[10], acc[11]); pw2[1] = make_float4(acc[12], acc[13], acc[14], acc[15]);
    }
    __syncthreads();
    const float4 s0 = ((const float4*)part)[tid], s1 = ((const float4*)(part + 1024))[tid], s2 = ((const float4*)(part + 2048))[tid], s3 = ((const float4*)(part + 3072))[tid];
    const float4 g2 = ((const float4*)(mod + (size_t)((rr < NLAT) ? b : 8) * 6144 + 5 * 1024))[tid];
    float4* xp = (float4*)xrow(p, b, rr) + tid;
    float4 xv = *xp;
    xv.x += g2.x * (s0.x + s1.x + s2.x + s3.x); xv.y += g2.y * (s0.y + s1.y + s2.y + s3.y);
    xv.z += g2.z * (s0.z + s1.z + s2.z + s3.z); xv.w += g2.w * (s0.w + s1.w + s2.w + s3.w);
    *xp = xv;
  }
  __syncthreads();
}

__device__ __forceinline__ void stage_final(const Params& p, float* smem) {
  const int tid = otid();
  for (int r = blockIdx.x; r < NB * NLAT; r += gridDim.x) {
    float4* xp = (float4*)(p.out + (size_t)r * DM) + tid;
    float4 v = *xp;
    float s = wave_sum(v.x * v.x + v.y * v.y + v.z * v.z + v.w * v.w);
    __syncthreads();
    if ((tid & 63) == 0) smem[tid >> 6] = s;
    __syncthreads();
    float rs = rsqrtf((smem[0] + smem[1] + smem[2] + smem[3]) * (1.0f / DM) + EPSF);
    float4 g = ((const float4*)p.in[I_FG])[tid];
    *xp = make_float4(v.x * rs * g.x, v.y * rs * g.y, v.z * rs * g.z, v.w * rs * g.w);
  }
}

__global__ void __launch_bounds__(256) mega(Params p) {
  cg::grid_group grid = cg::this_grid();
  __shared__ __attribute__((aligned(16))) float smem[SMEM_FLOATS];
  char* smc = (char*)smem;
  char* ws = p.ws;
  bf16_t* H = (bf16_t*)(ws + WB_H); bf16_t* Z = (bf16_t*)(ws + WB_Z); float* MGT = (float*)(ws + WB_MGT); bf16_t* XC = (bf16_t*)(ws + WB_XC);
  bf16_t* QM = (bf16_t*)(ws + WB_QM); bf16_t* KM = (bf16_t*)(ws + WB_KM); bf16_t* KMT = (bf16_t*)(ws + WB_KMT); bf16_t* MVT = (bf16_t*)(ws + WB_MVT);
  bf16_t* HF = (bf16_t*)(ws + WB_HF); bf16_t* HB = (bf16_t*)(ws + WB_HB);
  bf16_t* VT = (bf16_t*)(ws + WB_VT); float* YSF = (float*)(ws + WB_YSF); float* YSB = (float*)(ws + WB_YSB);
  bf16_t* YA = (bf16_t*)(ws + WB_YA); bf16_t* YB = (bf16_t*)(ws + WB_YB); bf16_t* YS = (bf16_t*)(ws + WB_YS); bf16_t* GG = (bf16_t*)(ws + WB_GG);
  bf16_t* MG = (bf16_t*)(ws + WB_MG); bf16_t* PQ = (bf16_t*)(ws + WB_PQ); float* SC = (float*)(ws + WB_SC);
  int* EI = (int*)(ws + WB_EI); float* EG = (float*)(ws + WB_EG); float* XE = (float*)(ws + WB_XE);
  const bf16_t* WT = (const bf16_t*)(ws + WB_WT);

  stage_init(p, smem);
  grid.sync();

  for (int l = 0; l < 2; ++l) {
    const bool need_ctx = (l == 0);
    const int rr_lim = need_ctx ? NTOK : NLAT;
    const int tpb = need_ctx ? 34 : 32;
    const bf16_t* W = WT + (size_t)l * WT_LAYER;
    const float lam_init = 0.8f - 0.6f * expf(-0.3f * (float)l);
    float lam;
    {
      float s1 = 0.f, s2 = 0.f;
      for (int i = 0; i < 64; ++i) {
        s1 += p.in[I_LQ1][l * 64 + i] * p.in[I_LK1][l * 64 + i];
        s2 += p.in[I_LQ2][l * 64 + i] * p.in[I_LK2][l * 64 + i];
      }
      lam = expf(s1) - expf(s2) + lam_init;
    }
    for (int g = 0; g < NG; ++g) {
      stage_normmod(p, l, g, 0, NTOK, H, smem);
      grid.sync();
      stage_inproj(p, H, W + WT_WIN, Z, MGT, VT, MVT, smc);
      grid.sync();
      stage_conv(p, l, Z, XC);
      stage_s5_pass1(p, l, Z, XE, smem);
      grid.sync();
      stage_mlqk(XC, W + WT_WQK, QM, KM, KMT, smc);
      grid.sync();
      {
        const int n_attn = 4 * 32 + (need_ctx ? 4 * 2 : 0);
        const int n_s5 = 32 * 2 * 9;
        const int n_items = GB * (8 + n_attn + n_s5);
        int* cnt = (int*)(ws + WB_CNT) + (l * NG + g);
        int* s_item = (int*)(smem + SMEM_FLOATS - 4);
        for (;;) {
          __syncthreads();
          if (otid() == 0) *s_item = atomicAdd(cnt, 1);
          __syncthreads();
          const int it = *s_item;
          if (it >= n_items) break;
          int bl, k;
          if (it < GB * 8) { bl = it / 8; k = it % 8; }
          else if (it < GB * (8 + n_attn)) { bl = (it - GB * 8) / n_attn; k = 8 + (it - GB * 8) % n_attn; }
          else { bl = (it - GB * (8 + n_attn)) / n_s5; k = 8 + n_attn + (it - GB * (8 + n_attn)) % n_s5; }
          const bf16_t* Zb = Z + (size_t)bl * NTOK * ZW;
          const size_t ro = (size_t)bl * NTOK;
          if (k < 8) {
            mlstm_chain_item(p, l, QM + ro * 512, KM + ro * 512, KMT + (size_t)bl * 4 * 128 * NTOK, MVT + (size_t)bl * 4 * 128 * NTOK, MGT + ro * 16,
                             ((k >> 2) ? HB : HF) + ro * 512, k & 3, k >> 2, smc);
          } else if (k < 8 + n_attn) {
            const int a = k - 8;
            const bf16_t* VTb = VT + (size_t)bl * 4 * 128 * NTOK;
            if (a < 128) attn_mfma_item(p, l, Zb, VTb, YA + ro * 512, a & 3, (a >> 2) * 128, 0, NTOK, lam, lam_init, smc);
            else attn_mfma_item(p, l, Zb, VTb, YA + ro * 512, (a - 128) & 3, NLAT + ((a - 128) >> 2) * 128, NLAT, NCTX, lam, lam_init, smc);
          } else {
            const int a = k - 8 - n_attn;
            const int sq = a % 9, dir = (a / 9) & 1, gg = a / 18;
            s5_item(p, l, Zb, XE + (((size_t)bl * 32 + gg) * 2 + dir) * (S5NSEG - 1) * 128, (dir ? YSB : YSF) + ro * 512, gg, dir, sq, smem);
          }
        }
      }
      grid.sync();
      stage_post(p, l, rr_lim, Z, HF, HB, YSF, YSB, YB, GG);
      grid.sync();
      stage_glu_mfma(p, l, tpb, GG, W + WT_GLU, YS, smc);
      grid.sync();
      stage_merge_mfma(tpb, YA, YB, YS, W + WT_WBR, Z, MG, smc);
      grid.sync();
      stage_outproj_mfma(p, l, g, tpb, MG, W + WT_WOUT, smc);
      grid.sync();
      stage_normmod(p, l, g, 1, rr_lim, H, smem);
      grid.sync();
      stage_peerq_mfma(tpb, H, W + WT_WQ, PQ, smc);
      grid.sync();
      stage_scores_mfma(tpb, PQ, W + WT_SUBK, SC, smc);
      grid.sync();
      stage_topk(tpb, SC, EI, EG, smem);
      grid.sync();
      stage_expert(p, l, g, rr_lim, H, EI, EG, smem);
      grid.sync();
    }
  }
  stage_final(p, smem);
}

extern "C" void kernel_launch(void* const* d_in, const int* in_sizes, int n_in, void* d_out,
                              int out_size, void* d_ws, size_t ws_size, hipStream_t stream) {
  static int grid_blocks = 0;
  if (!grid_blocks) {
    int dev = 0, cus = 0, per_cu = 0;
    (void)hipGetDevice(&dev);
    (void)hipDeviceGetAttribute(&cus, hipDeviceAttributeMultiprocessorCount, dev);
    (void)hipOccupancyMaxActiveBlocksPerMultiprocessor(&per_cu, mega, 256, 0);
    if (per_cu > 1) per_cu = 1;
    grid_blocks = cus * per_cu;
  }
  if (ws_size < WB_END) {
    fprintf(stderr, "workspace too small: %zu < %zu\n", ws_size, (size_t)WB_END);
    return;
  }
  Params p{};
  for (int i = 0; i < N_IN; ++i) p.in[i] = (const float*)d_in[i];
  p.out = (float*)d_out;
  p.ws = (char*)d_ws;
  void* args[] = {&p};
  hipError_t e = hipLaunchCooperativeKernel((void*)mega, dim3(grid_blocks), dim3(256), args, 0, stream);
  if (e != hipSuccess) fprintf(stderr, "cooperative launch failed: %s (grid %d)\n", hipGetErrorString(e), grid_blocks);
}
```

```cpp
#include <hip/hip_runtime.h>
#include <hip/hip_cooperative_groups.h>
#include <cstdio>
#include <cstdint>
namespace cg = cooperative_groups;

#define NLAT 4096
#define NCTX 256
#define NTOK 4352
#define DM 1024
#define INW 6672
#define NB 8
#define GB 2
#define NG (NB / GB)
#define RPG (GB * NTOK)
#define ZW 6656
#define EPSF 1e-6f

enum { I_X = 0, I_C, I_CTX, I_CCTX, I_WMOD, I_BMOD, I_N1G, I_N2G, I_WIN, I_LQ1, I_LK1, I_LQ2, I_LK2, I_SUBG,
       I_CONVW, I_CONVB, I_MLWQ, I_MLWK, I_GATEB, I_MLNG, I_S5LRE, I_S5LIM, I_S5DT, I_S5BRE, I_S5BIM,
       I_S5CRE, I_S5CIM, I_S5D, I_GLUW, I_GLUB, I_WBR, I_WOUT, I_PWQ, I_PSUBK, I_PU, I_PV, I_FG, N_IN };

struct Params {
  const float* in[N_IN];
  float* out;
  char* ws;
};

typedef unsigned short bf16_t;
typedef short bf16x8 __attribute__((ext_vector_type(8)));
typedef float f32x16 __attribute__((ext_vector_type(16)));
typedef unsigned u32x4 __attribute__((ext_vector_type(4)));
typedef unsigned u32x2 __attribute__((ext_vector_type(2)));

#define AL(x) (((x) + 255) & ~(size_t)255)
#define WB_XCX   ((size_t)0)
#define WB_MOD   AL(WB_XCX + (size_t)NB * NCTX * DM * 4)
#define WB_ROPE  AL(WB_MOD + (size_t)2 * 9 * 6144 * 4)
#define WB_WT    AL(WB_ROPE + (size_t)NLAT * 32 * 2 * 4)
#define WT_WIN   ((size_t)0)
#define WT_WQK   (WT_WIN + (size_t)6784 * 1024)
#define WT_GLU   (WT_WQK + (size_t)4 * 256 * 128)
#define WT_WBR   (WT_GLU + (size_t)512 * 512)
#define WT_WOUT  (WT_WBR + (size_t)3 * 1024 * 512)
#define WT_WQ    (WT_WOUT + (size_t)1024 * 1024)
#define WT_SUBK  (WT_WQ + (size_t)2048 * 1024)
#define WT_LAYER (WT_SUBK + (size_t)2 * 128 * 128)
#define WB_H     AL(WB_WT + WT_LAYER * 2 * 2)
#define WB_Z     AL(WB_H + (size_t)RPG * DM * 2)
#define WB_MGT   AL(WB_Z + (size_t)RPG * ZW * 2)
#define WB_XC    AL(WB_MGT + (size_t)RPG * 16 * 4)
#define WB_QM    AL(WB_XC + (size_t)RPG * 512 * 2)
#define WB_KM    AL(WB_QM + (size_t)RPG * 512 * 2)
#define WB_KMT   AL(WB_KM + (size_t)RPG * 512 * 2)
#define WB_MVT   AL(WB_KMT + (size_t)RPG * 512 * 2)
#define WB_HF    AL(WB_MVT + (size_t)RPG * 512 * 2)
#define WB_HB    AL(WB_HF + (size_t)RPG * 512 * 2)
#define WB_YSF   AL(WB_HB + (size_t)RPG * 512 * 2)
#define WB_YSB   AL(WB_YSF + (size_t)RPG * 512 * 4)
#define WB_YA    AL(WB_YSB + (size_t)RPG * 512 * 4)
#define WB_YB    AL(WB_YA + (size_t)RPG * 512 * 2)
#define WB_YS    AL(WB_YB + (size_t)RPG * 512 * 2)
#define WB_GG    AL(WB_YS + (size_t)RPG * 512 * 2)
#define WB_MG    AL(WB_GG + (size_t)RPG * 512 * 2)
#define WB_EI    AL(WB_MG + (size_t)RPG * DM * 2)
#define WB_EG    AL(WB_EI + (size_t)RPG * 128 * 4)
#define WB_U16   AL(WB_EG + (size_t)RPG * 128 * 4)
#define WB_V16   AL(WB_U16 + (size_t)2 * 16384 * 1024 * 2)
#define WB_VT    AL(WB_V16 + (size_t)2 * 16384 * 1024 * 2)
#define WB_CNT   AL(WB_VT + (size_t)GB * 4 * 128 * NTOK * 2)
#define WB_XE    AL(WB_CNT + 256)
#define WB_BAR   AL(WB_XE + (size_t)GB * 32 * 2 * 33 * 128 * 4)
#define WB_END   AL(WB_BAR + 256)
#define WB_PQ    (WB_Z)
#define WB_SC    AL(WB_PQ + (size_t)RPG * 2048 * 2)

#define SMEM_FLOATS (25 * 1024)

__device__ __forceinline__ float sigmoidf_(float x) { return 1.0f / (1.0f + expf(-x)); }
__device__ __forceinline__ float siluf_(float x) { return x / (1.0f + expf(-x)); }
__device__ __forceinline__ float geluf_(float x) { return 0.5f * x * (1.0f + erff(x * 0.70710678118654752f)); }
__device__ __forceinline__ int otid() { int t = threadIdx.x; asm volatile("" : "+v"(t)); return t; }
__device__ __forceinline__ float wave_sum(float v) {
  for (int o = 32; o > 0; o >>= 1) v += __shfl_xor(v, o);
  return v;
}
__device__ __forceinline__ bf16_t f2bf(float x) { unsigned u = __float_as_uint(x); u += 0x7fffu + ((u >> 16) & 1u); return (bf16_t)(u >> 16); }
__device__ __forceinline__ float bf2f(bf16_t h) { return __uint_as_float(((unsigned)h) << 16); }
typedef float f32x2 __attribute__((ext_vector_type(2)));
typedef __bf16 bf16x2_t __attribute__((ext_vector_type(2)));
__device__ __forceinline__ unsigned pack2(float a, float b) { f32x2 v = {a, b}; return __builtin_bit_cast(unsigned, __builtin_convertvector(v, bf16x2_t)); }
__device__ __forceinline__ float lo16(unsigned u) { return __uint_as_float(u << 16); }
__device__ __forceinline__ float hi16(unsigned u) { return __uint_as_float(u & 0xffff0000u); }

__device__ __forceinline__ float* xrow(const Params& p, int b, int rr) {
  return (rr < NLAT) ? p.out + ((size_t)b * NLAT + rr) * DM : (float*)(p.ws + WB_XCX) + ((size_t)b * NCTX + (rr - NLAT)) * DM;
}

__device__ __forceinline__ void gemm_tile(const bf16_t* __restrict__ Ag, int lda, const bf16_t* __restrict__ Bg, int ldb, int K,
                                          char* smem, f32x16 (&acc)[2][2]) {
  const int tid = otid(), lane = tid & 63, w = tid >> 6, wm = w >> 1, wn = w & 1;
#pragma unroll
  for (int a = 0; a < 2; ++a)
#pragma unroll
    for (int b = 0; b < 2; ++b)
#pragma unroll
      for (int i = 0; i < 16; ++i) acc[a][b][i] = 0.f;
  const int srow = tid >> 3, sch = tid & 7;
  const bf16_t* ap = Ag + (size_t)srow * lda + sch * 8;
  const bf16_t* bp = Bg + (size_t)srow * ldb + sch * 8;
  const int wofs = srow * 128 + ((sch ^ ((srow >> 1) & 7)) << 4);
  const int fr = lane & 31, fh = lane >> 5, fsw = (fr >> 1) & 7;
  const int aofs = (wm * 64 + fr) * 128, bofs = 16384 + (wn * 64 + fr) * 128;
  u32x4 ra[4], rb[4];
  const int nk = K >> 6;
#pragma unroll
  for (int i = 0; i < 4; ++i) {
    ra[i] = *(const u32x4*)(ap + (size_t)i * 32 * lda);
    rb[i] = *(const u32x4*)(bp + (size_t)i * 32 * ldb);
  }
  __syncthreads();
#pragma unroll
  for (int i = 0; i < 4; ++i) {
    *(u32x4*)(smem + wofs + i * 4096) = ra[i];
    *(u32x4*)(smem + 16384 + wofs + i * 4096) = rb[i];
  }
  __syncthreads();
  for (int kt = 0; kt < nk; ++kt) {
    const bool more = (kt + 1 < nk);
    if (more) {
#pragma unroll
      for (int i = 0; i < 4; ++i) {
        ra[i] = *(const u32x4*)(ap + (size_t)i * 32 * lda + (kt + 1) * 64);
        rb[i] = *(const u32x4*)(bp + (size_t)i * 32 * ldb + (kt + 1) * 64);
      }
    }
    const char* base = smem + (kt & 1) * 32768;
#pragma unroll
    for (int ks = 0; ks < 4; ++ks) {
      const int coff = ((ks * 2 + fh) ^ fsw) << 4;
      bf16x8 af[2], bfr[2];
#pragma unroll
      for (int mi = 0; mi < 2; ++mi) af[mi] = *(const bf16x8*)(base + aofs + mi * 4096 + coff);
#pragma unroll
      for (int ni = 0; ni < 2; ++ni) bfr[ni] = *(const bf16x8*)(base + bofs + ni * 4096 + coff);
#pragma unroll
      for (int mi = 0; mi < 2; ++mi)
#pragma unroll
        for (int ni = 0; ni < 2; ++ni)
          acc[mi][ni] = __builtin_amdgcn_mfma_f32_32x32x16_bf16(bfr[ni], af[mi], acc[mi][ni], 0, 0, 0);
    }
    if (more) {
      char* nb = smem + ((kt + 1) & 1) * 32768;
#pragma unroll
      for (int i = 0; i < 4; ++i) {
        *(u32x4*)(nb + wofs + i * 4096) = ra[i];
        *(u32x4*)(nb + 16384 + wofs + i * 4096) = rb[i];
      }
    }
    __syncthreads();
  }
}
#define EPI_DECL const int tid_ = otid(); const int lane = tid_ & 63, w_ = tid_ >> 6, wm = w_ >> 1, wn = w_ & 1, fr = lane & 31, fh = lane >> 5; (void)fr; (void)fh; (void)wm; (void)wn;
#define EPI_ROW(mi) (wm * 64 + (mi) * 32 + fr)
#define EPI_COL(ni, q) (wn * 64 + (ni) * 32 + 8 * (q) + 4 * fh)
#define MT_LR0(mt, tpb) (((mt) / (tpb)) * NTOK + ((mt) % (tpb)) * 128)

template <class F>
__device__ __forceinline__ void transpose_cvt(const float* __restrict__ src, int ld, F srccol, int K, int Ndst, bf16_t* __restrict__ dst, float* smem) {
  float (*T)[65] = (float (*)[65])smem;
  const int tid = otid();
  const int tk = K >> 6, tn = Ndst >> 6;
  for (int t = blockIdx.x; t < tn * tk; t += gridDim.x) {
    const int n0 = (t / tk) * 64, k0 = (t % tk) * 64;
    __syncthreads();
    const int sc = srccol(n0 + (tid & 63));
#pragma unroll
    for (int i = 0; i < 16; ++i) {
      const int ky = (tid >> 6) + 4 * i;
      T[ky][tid & 63] = (sc >= 0) ? src[(size_t)(k0 + ky) * ld + sc] : 0.f;
    }
    __syncthreads();
#pragma unroll
    for (int i = 0; i < 16; ++i) {
      const int ny = (tid >> 6) + 4 * i;
      dst[(size_t)(n0 + ny) * K + k0 + (tid & 63)] = f2bf(T[tid & 63][ny]);
    }
  }
  __syncthreads();
}
__device__ __forceinline__ int win_srccol(int n) {
  if (n < 3072) return n;
  if (n < 6656) return n + 16;
  if (n < 6672) return n - 3584;
  return -1;
}

__device__ __forceinline__ void stage_init(const Params& p, float* smem) {
  const int tid = otid();
  {
    const size_t n4 = (size_t)NB * NLAT * 256;
    const float4* s = (const float4*)p.in[I_X];
    float4* d = (float4*)p.out;
    for (size_t i = (size_t)blockIdx.x * 256 + tid; i < n4; i += (size_t)gridDim.x * 256) d[i] = s[i];
    const size_t m4 = (size_t)NB * NCTX * 256;
    const float4* s2 = (const float4*)p.in[I_CTX];
    float4* d2 = (float4*)(p.ws + WB_XCX);
    for (size_t i = (size_t)blockIdx.x * 256 + tid; i < m4; i += (size_t)gridDim.x * 256) d2[i] = s2[i];
  }
  if (blockIdx.x == 0 && tid < 64) ((int*)(p.ws + WB_CNT))[tid] = 0;
  {
    const size_t n8 = (size_t)2 * 16384 * 1024 / 8;
    const float4* su = (const float4*)p.in[I_PU];
    const float4* sv = (const float4*)p.in[I_PV];
    u32x4* du = (u32x4*)(p.ws + WB_U16);
    u32x4* dv = (u32x4*)(p.ws + WB_V16);
    for (size_t i = (size_t)blockIdx.x * 256 + tid; i < n8; i += (size_t)gridDim.x * 256) {
      const float4 a = su[2 * i], b = su[2 * i + 1];
      du[i] = (u32x4){pack2(a.x, a.y), pack2(a.z, a.w), pack2(b.x, b.y), pack2(b.z, b.w)};
      const float4 c = sv[2 * i], d = sv[2 * i + 1];
      dv[i] = (u32x4){pack2(c.x, c.y), pack2(c.z, c.w), pack2(d.x, d.y), pack2(d.z, d.w)};
    }
  }
  {
    float2* rt = (float2*)(p.ws + WB_ROPE);
    for (int i = blockIdx.x * 256 + tid; i < NLAT * 32; i += gridDim.x * 256) {
      const int pos = i >> 5, j = i & 31;
      const float inv = powf(10000.0f, -(float)(j & 15) / 16.0f);
      const float ang = (float)((j < 16) ? (pos >> 6) : (pos & 63)) * inv;
      rt[i] = make_float2(cosf(ang), sinf(ang));
    }
  }
  {
    float* sc = smem;
    for (int i = tid; i < 9 * 1024; i += 256) {
      int r = i >> 10, k = i & 1023;
      float v = (r < 8) ? p.in[I_C][r * 1024 + k] : p.in[I_CCTX][k];
      sc[i] = siluf_(v);
    }
    __syncthreads();
    float* mod = (float*)(p.ws + WB_MOD);
    for (int col = blockIdx.x * 256 + tid; col < 2 * 6144; col += gridDim.x * 256) {
      int l = col / 6144, j = col % 6144;
      const float* w = p.in[I_WMOD] + (size_t)l * 1024 * 6144 + j;
      float acc[9];
#pragma unroll
      for (int r = 0; r < 9; ++r) acc[r] = 0.f;
      for (int k = 0; k < 1024; ++k) {
        float wv = w[(size_t)k * 6144];
#pragma unroll
        for (int r = 0; r < 9; ++r) acc[r] = fmaf(sc[r * 1024 + k], wv, acc[r]);
      }
      float bv = p.in[I_BMOD][l * 6144 + j];
#pragma unroll
      for (int r = 0; r < 9; ++r) mod[((size_t)l * 9 + r) * 6144 + j] = acc[r] + bv;
    }
    __syncthreads();
  }
  bf16_t* WT = (bf16_t*)(p.ws + WB_WT);
  for (int l = 0; l < 2; ++l) {
    bf16_t* W = WT + (size_t)l * WT_LAYER;
    transpose_cvt(p.in[I_WIN] + (size_t)l * DM * INW, INW, [](int n) { return win_srccol(n); }, DM, 6784, W + WT_WIN, smem);
    for (int h = 0; h < 4; ++h) {
      transpose_cvt(p.in[I_MLWQ] + ((size_t)l * 4 + h) * 16384, 128, [](int n) { return n; }, 128, 128, W + WT_WQK + (size_t)h * 256 * 128, smem);
      transpose_cvt(p.in[I_MLWK] + ((size_t)l * 4 + h) * 16384, 128, [](int n) { return n; }, 128, 128, W + WT_WQK + (size_t)h * 256 * 128 + 128 * 128, smem);
    }
    transpose_cvt(p.in[I_GLUW] + (size_t)l * 512 * 512, 512, [](int n) { return n; }, 512, 512, W + WT_GLU, smem);
    for (int r = 0; r < 3; ++r)
      transpose_cvt(p.in[I_WBR] + ((size_t)l * 3 + r) * 512 * DM, DM, [](int n) { return n; }, 512, DM, W + WT_WBR + (size_t)r * 1024 * 512, smem);
    transpose_cvt(p.in[I_WOUT] + (size_t)l * DM * DM, DM, [](int n) { return n; }, DM, DM, W + WT_WOUT, smem);
    transpose_cvt(p.in[I_PWQ] + (size_t)l * DM * 2048, 2048, [](int n) { return n; }, DM, 2048, W + WT_WQ, smem);
    const float* sk = p.in[I_PSUBK] + (size_t)l * 2 * 128 * 128;
    for (int i = blockIdx.x * 256 + tid; i < 2 * 128 * 128; i += gridDim.x * 256) W[WT_SUBK + i] = f2bf(sk[i]);
  }
}

__device__ __forceinline__ void stage_normmod(const Params& p, int l, int g, int which, int rr_lim, bf16_t* H, float* smem) {
  const int tid = otid();
  const float* ng = p.in[which ? I_N2G : I_N1G] + l * DM;
  const float* mod = (const float*)(p.ws + WB_MOD) + (size_t)l * 9 * 6144;
  const int off_sh = which ? 3072 : 0, off_sc = which ? 4096 : 1024;
  const int per = rr_lim;
  for (int i = blockIdx.x; i < GB * per; i += gridDim.x) {
    const int bl = i / per, rr = i % per, b = g * GB + bl;
    const float* X = xrow(p, b, rr);
    float4 v = ((const float4*)X)[tid];
    float s = wave_sum(v.x * v.x + v.y * v.y + v.z * v.z + v.w * v.w);
    __syncthreads();
    if ((tid & 63) == 0) smem[tid >> 6] = s;
    __syncthreads();
    float tot = smem[0] + smem[1] + smem[2] + smem[3];
    float rs = rsqrtf(tot * (1.0f / DM) + EPSF);
    const float* m = mod + (size_t)((rr < NLAT) ? b : 8) * 6144;
    float4 gg = ((const float4*)ng)[tid];
    float4 sc = ((const float4*)(m + off_sc))[tid];
    float4 sh = ((const float4*)(m + off_sh))[tid];
    float4 o;
    o.x = v.x * rs * gg.x * (1.f + sc.x) + sh.x;
    o.y = v.y * rs * gg.y * (1.f + sc.y) + sh.y;
    o.z = v.z * rs * gg.z * (1.f + sc.z) + sh.z;
    o.w = v.w * rs * gg.w * (1.f + sc.w) + sh.w;
    ((u32x2*)(H + ((size_t)bl * NTOK + rr) * DM))[tid] = (u32x2){pack2(o.x, o.y), pack2(o.z, o.w)};
  }
  __syncthreads();
}

__device__ __forceinline__ void stage_inproj(const Params& p, const bf16_t* H, const bf16_t* WinT, bf16_t* Z, float* MGT, bf16_t* VT, bf16_t* MVT, char* smem) {
  EPI_DECL
  const int tm = GB * 34, tn = 53;
  const float2* rt = (const float2*)(p.ws + WB_ROPE);
  for (int t = blockIdx.x; t < tm * tn; t += gridDim.x) {
    const int mt = t / tn, j = t % tn, n0 = j * 128;
    const int lr0 = MT_LR0(mt, 34), rr0 = (mt % 34) * 128;
    f32x16 acc[2][2];
    if ((j >= 8 && j < 12) || (j >= 16 && j < 20)) {
      gemm_tile(WinT + (size_t)n0 * DM, DM, H + (size_t)lr0 * DM, DM, DM, smem, acc);
      bf16_t* vt = ((j < 12) ? VT : MVT) + ((size_t)(mt / 34) * 4 + (j & 3)) * 128 * NTOK;
#pragma unroll
      for (int mi = 0; mi < 2; ++mi)
#pragma unroll
        for (int ni = 0; ni < 2; ++ni)
#pragma unroll
          for (int q = 0; q < 4; ++q) {
            const int e = EPI_ROW(mi), tok = rr0 + EPI_COL(ni, q);
            *(u32x2*)(vt + (size_t)e * NTOK + tok) = (u32x2){pack2(acc[mi][ni][4 * q], acc[mi][ni][4 * q + 1]), pack2(acc[mi][ni][4 * q + 2], acc[mi][ni][4 * q + 3])};
          }
      continue;
    }
    gemm_tile(H + (size_t)lr0 * DM, DM, WinT + (size_t)n0 * DM, DM, DM, smem, acc);
    if (j < 8 && rr0 < NLAT) {
#pragma unroll
      for (int mi = 0; mi < 2; ++mi) {
        const int pos = rr0 + EPI_ROW(mi);
#pragma unroll
        for (int i = 0; i < 16; ++i) {
          const int jj = 8 * (i >> 2) + 4 * fh + (i & 3);
          const float2 cs = rt[pos * 32 + jj];
          const float x1 = acc[mi][0][i], x2 = acc[mi][1][i];
          acc[mi][0][i] = x1 * cs.x - x2 * cs.y;
          acc[mi][1][i] = x1 * cs.y + x2 * cs.x;
        }
      }
    }
    if (j < 52) {
      const bool sg = (j >= 28);
#pragma unroll
      for (int mi = 0; mi < 2; ++mi)
#pragma unroll
        for (int ni = 0; ni < 2; ++ni)
#pragma unroll
          for (int q = 0; q < 4; ++q) {
            const int row = lr0 + EPI_ROW(mi), c = n0 + EPI_COL(ni, q);
            float v0 = acc[mi][ni][4 * q], v1 = acc[mi][ni][4 * q + 1], v2 = acc[mi][ni][4 * q + 2], v3 = acc[mi][ni][4 * q + 3];
            if (sg) { v0 = sigmoidf_(v0); v1 = sigmoidf_(v1); v2 = sigmoidf_(v2); v3 = sigmoidf_(v3); }
            *(u32x2*)(Z + (size_t)row * ZW + c) = (u32x2){pack2(v0, v1), pack2(v2, v3)};
          }
    } else {
#pragma unroll
      for (int mi = 0; mi < 2; ++mi)
#pragma unroll
        for (int q = 0; q < 2; ++q) {
          const int row = lr0 + EPI_ROW(mi), c = EPI_COL(0, q);
          if (wn == 0) *(float4*)(MGT + (size_t)row * 16 + c) = make_float4(acc[mi][0][4 * q], acc[mi][0][4 * q + 1], acc[mi][0][4 * q + 2], acc[mi][0][4 * q + 3]);
        }
    }
  }
}

__device__ __forceinline__ void stage_conv(const Params& p, int l, const bf16_t* Z, bf16_t* XC) {
  const int tid = otid();
  const float* cw = p.in[I_CONVW] + (size_t)l * 3 * 512;
  const float* cb = p.in[I_CONVB] + (size_t)l * 512;
  const int c = tid * 2;
  const float2 w0 = *(const float2*)(cw + c), w1 = *(const float2*)(cw + 512 + c), w2 = *(const float2*)(cw + 1024 + c), bb = *(const float2*)(cb + c);
  for (int lr = blockIdx.x; lr < RPG; lr += gridDim.x) {
    const int rr = lr % NTOK;
    const bool has_prev = (rr < NLAT) ? (rr > 0) : (rr > NLAT);
    const bool has_next = (rr < NLAT) ? (rr < NLAT - 1) : (rr < NTOK - 1);
    const bf16_t* z = Z + (size_t)lr * ZW + 1536 + c;
    const unsigned xc = *(const unsigned*)z;
    float a0 = bb.x + w1.x * lo16(xc), a1 = bb.y + w1.y * hi16(xc);
    if (has_prev) { const unsigned xp = *(const unsigned*)(z - ZW); a0 += w0.x * lo16(xp); a1 += w0.y * hi16(xp); }
    if (has_next) { const unsigned xn = *(const unsigned*)(z + ZW); a0 += w2.x * lo16(xn); a1 += w2.y * hi16(xn); }
    *(unsigned*)(XC + (size_t)lr * 512 + c) = pack2(siluf_(a0), siluf_(a1));
  }
}

__device__ __forceinline__ void stage_mlqk(const bf16_t* XC, const bf16_t* WQK, bf16_t* QM, bf16_t* KM, bf16_t* KMT, char* smem) {
  EPI_DECL
  const int tm = RPG >> 7;
  for (int t = blockIdx.x; t < tm * 12; t += gridDim.x) {
    const int mt = t / 12, r12 = t % 12, h = r12 & 3, kind = r12 >> 2;
    const int m0 = mt * 128;
    f32x16 acc[2][2];
    const bf16_t* Wt = WQK + (size_t)h * 256 * 128 + (size_t)(kind ? 1 : 0) * 128 * 128;
    const bf16_t* Xt = XC + (size_t)m0 * 512 + h * 128;
    if (kind < 2) {
      gemm_tile(Xt, 512, Wt, 128, 128, smem, acc);
      bf16_t* O = kind ? KM : QM;
      const float alpha = kind ? 1.0f : 0.08838834764831845f;
#pragma unroll
      for (int mi = 0; mi < 2; ++mi)
#pragma unroll
        for (int ni = 0; ni < 2; ++ni)
#pragma unroll
          for (int q = 0; q < 4; ++q) {
            const int row = m0 + EPI_ROW(mi), c = EPI_COL(ni, q);
            *(u32x2*)(O + (size_t)row * 512 + h * 128 + c) = (u32x2){pack2(alpha * acc[mi][ni][4 * q], alpha * acc[mi][ni][4 * q + 1]), pack2(alpha * acc[mi][ni][4 * q + 2], alpha * acc[mi][ni][4 * q + 3])};
          }
    } else {
      gemm_tile(Wt, 128, Xt, 512, 128, smem, acc);
      bf16_t* kt = KMT + ((size_t)(mt / 34) * 4 + h) * 128 * NTOK + (mt % 34) * 128;
#pragma unroll
      for (int mi = 0; mi < 2; ++mi)
#pragma unroll
        for (int ni = 0; ni < 2; ++ni)
#pragma unroll
          for (int q = 0; q < 4; ++q) {
            const int d = EPI_ROW(mi), tok = EPI_COL(ni, q);
            *(u32x2*)(kt + (size_t)d * NTOK + tok) = (u32x2){pack2(acc[mi][ni][4 * q], acc[mi][ni][4 * q + 1]), pack2(acc[mi][ni][4 * q + 2], acc[mi][ni][4 * q + 3])};
          }
    }
  }
}

__device__ __forceinline__ void attn_mfma_item(const Params& p, int l, const bf16_t* Zb, const bf16_t* VTb, bf16_t* YAb, int h, int qrow0, int key0, int nkeys,
                                               float lam, float lam_init, char* smem) {
  const int tid = otid(), lane = tid & 63, w = tid >> 6, fr = lane & 31, fh = lane >> 5;
  const int ntiles = nkeys >> 6;
  const int myrow = qrow0 + w * 32 + fr;
  bf16x8 qf[2][4];
  {
    const bf16_t* qp = Zb + (size_t)myrow * ZW + h * 128 + fh * 8;
#pragma unroll
    for (int m = 0; m < 2; ++m)
#pragma unroll
      for (int ks = 0; ks < 4; ++ks) qf[m][ks] = *(const bf16x8*)(qp + m * 64 + ks * 16);
  }
  f32x16 O[2][4];
#pragma unroll
  for (int m = 0; m < 2; ++m)
#pragma unroll
    for (int eb = 0; eb < 4; ++eb)
#pragma unroll
      for (int i = 0; i < 16; ++i) O[m][eb][i] = 0.f;
  float mrun[2] = {-1e30f, -1e30f}, lrun[2] = {0.f, 0.f};
  const float cs = 0.125f * 1.4426950408889634f;
  const int skey = tid >> 4, sch = tid & 15;
  const bf16_t* ksrc = Zb + (size_t)(key0 + skey) * ZW + 512 + h * 128 + sch * 8;
  const int kdst = skey * 256 + ((sch ^ (skey & 15)) << 4);
  const int se = tid >> 3, svc = tid & 7;
  const bf16_t* vsrc = VTb + ((size_t)h * 128 + se) * NTOK + key0 + svc * 8;
  const int vsw = (se >> 1) & 15;
  const int vdst0 = se * 128 + (((2 * svc) ^ vsw) << 3), vdst1 = se * 128 + (((2 * svc + 1) ^ vsw) << 3);
  const int kfo = fr * 256, kfs = fr & 15;
  const int vfo = fr * 128, vfs = (fr >> 1) & 15;
  u32x4 rk[4], rv[4];
#pragma unroll
  for (int i = 0; i < 4; ++i) rk[i] = *(const u32x4*)(ksrc + (size_t)i * 16 * ZW);
  __syncthreads();
#pragma unroll
  for (int i = 0; i < 4; ++i) *(u32x4*)(smem + kdst + i * 4096) = rk[i];
  __syncthreads();
  bf16x8 pf[2][4];
#pragma unroll
  for (int m = 0; m < 2; ++m)
#pragma unroll
    for (int s = 0; s < 4; ++s)
#pragma unroll
      for (int i = 0; i < 8; ++i) pf[m][s][i] = 0;
#pragma unroll 1
  for (int t = 0; t <= ntiles; ++t) {
    const bool cur = t < ntiles, nxt = t + 1 < ntiles, prv = t >= 1;
    if (nxt) {
#pragma unroll
      for (int i = 0; i < 4; ++i) rk[i] = *(const u32x4*)(ksrc + (size_t)((t + 1) * 64 + i * 16) * ZW);
    }
    if (cur) {
#pragma unroll
      for (int i = 0; i < 4; ++i) rv[i] = *(const u32x4*)(vsrc + (size_t)i * 32 * NTOK + t * 64);
    }
    const char* kb_ = smem + (t & 1) * 16384;
    f32x16 S[2];
    if (cur) {
#pragma unroll
      for (int kb = 0; kb < 2; ++kb) {
#pragma unroll
        for (int i = 0; i < 16; ++i) S[kb][i] = 0.f;
#pragma unroll
        for (int ks = 0; ks < 4; ++ks) {
          const bf16x8 kf = *(const bf16x8*)(kb_ + kb * 8192 + kfo + (((ks * 2 + fh) ^ kfs) << 4));
          S[kb] = __builtin_amdgcn_mfma_f32_32x32x16_bf16(kf, qf[0][ks], S[kb], 0, 0, 0);
        }
      }
    }
    if (prv) {
      const char* vb_ = smem + 32768 + ((t - 1) & 1) * 16384;
#pragma unroll
      for (int eb = 0; eb < 4; ++eb)
#pragma unroll
        for (int s = 0; s < 4; ++s) {
          const u32x2 v0 = *(const u32x2*)(vb_ + eb * 4096 + vfo + (((4 * s + fh) ^ vfs) << 3));
          const u32x2 v1 = *(const u32x2*)(vb_ + eb * 4096 + vfo + (((4 * s + fh + 2) ^ vfs) << 3));
          const bf16x8 vf = __builtin_bit_cast(bf16x8, (u32x4){v0[0], v0[1], v1[0], v1[1]});
          O[0][eb] = __builtin_amdgcn_mfma_f32_32x32x16_bf16(vf, pf[0][s], O[0][eb], 0, 0, 0);
          O[1][eb] = __builtin_amdgcn_mfma_f32_32x32x16_bf16(vf, pf[1][s], O[1][eb], 0, 0, 0);
        }
    }
    if (cur) {
#pragma unroll
      for (int m = 0; m < 2; ++m) {
        if (m == 1) {
#pragma unroll
          for (int kb = 0; kb < 2; ++kb) {
#pragma unroll
            for (int i = 0; i < 16; ++i) S[kb][i] = 0.f;
#pragma unroll
            for (int ks = 0; ks < 4; ++ks) {
              const bf16x8 kf = *(const bf16x8*)(kb_ + kb * 8192 + kfo + (((8 + ks * 2 + fh) ^ kfs) << 4));
              S[kb] = __builtin_amdgcn_mfma_f32_32x32x16_bf16(kf, qf[1][ks], S[kb], 0, 0, 0);
            }
          }
        }
        float tm = S[0][0];
#pragma unroll
        for (int i = 1; i < 16; ++i) tm = fmaxf(tm, S[0][i]);
#pragma unroll
        for (int i = 0; i < 16; ++i) tm = fmaxf(tm, S[1][i]);
        tm = fmaxf(tm, __shfl_xor(tm, 32)) * cs;
        float alpha = 1.f;
        if (tm > mrun[m] + 8.0f) { alpha = exp2f(mrun[m] - tm); mrun[m] = tm; }
        if (__any(alpha != 1.f)) {
#pragma unroll
          for (int eb = 0; eb < 4; ++eb)
#pragma unroll
            for (int i = 0; i < 16; ++i) O[m][eb][i] *= alpha;
          lrun[m] *= alpha;
        }
        const float mc = mrun[m];
        float rs = 0.f;
#pragma unroll
        for (int kb = 0; kb < 2; ++kb) {
          float pv[16];
#pragma unroll
          for (int i = 0; i < 16; ++i) { pv[i] = exp2f(fmaf(S[kb][i], cs, -mc)); rs += pv[i]; }
#pragma unroll
          for (int hh = 0; hh < 2; ++hh)
            pf[m][kb * 2 + hh] = __builtin_bit_cast(bf16x8, (u32x4){pack2(pv[8 * hh], pv[8 * hh + 1]), pack2(pv[8 * hh + 2], pv[8 * hh + 3]),
                                                                     pack2(pv[8 * hh + 4], pv[8 * hh + 5]), pack2(pv[8 * hh + 6], pv[8 * hh + 7])});
        }
        lrun[m] += rs;
      }
    }
    if (nxt) {
      char* kd = smem + ((t + 1) & 1) * 16384;
#pragma unroll
      for (int i = 0; i < 4; ++i) *(u32x4*)(kd + kdst + i * 4096) = rk[i];
    }
    if (cur) {
      char* vd = smem + 32768 + (t & 1) * 16384;
#pragma unroll
      for (int i = 0; i < 4; ++i) {
        *(u32x2*)(vd + vdst0 + i * 4096) = (u32x2){rv[i][0], rv[i][1]};
        *(u32x2*)(vd + vdst1 + i * 4096) = (u32x2){rv[i][2], rv[i][3]};
      }
    }
    __syncthreads();
  }
  const float l0 = lrun[0] + __shfl_xor(lrun[0], 32), l1 = lrun[1] + __shfl_xor(lrun[1], 32);
  const float i0 = 1.0f / l0, i1 = lam / l1;
  float ss = 0.f;
#pragma unroll
  for (int eb = 0; eb < 4; ++eb)
#pragma unroll
    for (int i = 0; i < 16; ++i) { const float o = O[0][eb][i] * i0 - O[1][eb][i] * i1; O[0][eb][i] = o; ss = fmaf(o, o, ss); }
  ss += __shfl_xor(ss, 32);
  const float rn = rsqrtf(ss * (1.0f / 128.0f) + EPSF) * (1.0f - lam_init);
  const float* sg = p.in[I_SUBG] + l * 512 + h * 128;
  bf16_t* yp = YAb + (size_t)myrow * 512 + h * 128;
#pragma unroll
  for (int eb = 0; eb < 4; ++eb)
#pragma unroll
    for (int q = 0; q < 4; ++q) {
      const int e = eb * 32 + 8 * q + 4 * fh;
      const float4 g = *(const float4*)(sg + e);
      *(u32x2*)(yp + e) = (u32x2){pack2(O[0][eb][4 * q] * rn * g.x, O[0][eb][4 * q + 1] * rn * g.y), pack2(O[0][eb][4 * q + 2] * rn * g.z, O[0][eb][4 * q + 3] * rn * g.w)};
    }
  __syncthreads();
}

__device__ __forceinline__ void mlstm_chain_item(const Params& p, int l, const bf16_t* QMb, const bf16_t* KMb, const bf16_t* KMTb, const bf16_t* MVTb,
                                                 const float* MGTb, bf16_t* HXb, int h, int dir, char* smem) {
  const int tid = otid(), lane = tid & 63, w = tid >> 6, fr = lane & 31, fh = lane >> 5;
  const int tb = w & 1, eh = w >> 1;
  float* fl = (float*)(smem + 98304);
  float* bs = fl; float* as_ = fl + 64; float* wgs = fl + 128; float* ebs = fl + 192; float* nprev = fl + 256; float* npart = fl + 384; float* dec_s = fl + 640;
  const float bi = p.in[I_GATEB][l * 16 + dir * 8 + h];
  const float bf_ = p.in[I_GATEB][l * 16 + dir * 8 + 4 + h];
  f32x16 CT[4];
#pragma unroll
  for (int eb = 0; eb < 4; ++eb)
#pragma unroll
    for (int i = 0; i < 16; ++i) CT[eb][i] = 0.f;
  __syncthreads();
  for (int i = tid; i < 2048; i += 256) ((u32x4*)(smem + 65536))[i] = (u32x4){0u, 0u, 0u, 0u};
  if (tid < 128) nprev[tid] = 0.f;
  const int qr = tid >> 4, qc = tid & 15;
  const int qdst = qr * 256 + ((qc ^ (qr & 15)) << 4);
  const int tr = tid >> 3, tc = tid & 7;
  const int tdst = tr * 128 + ((tc ^ ((tr >> 1) & 7)) << 4);
  const int sw16 = fr & 15, sw8 = (fr >> 1) & 7;
#pragma unroll 1
  for (int c = 0; c < 68; ++c) {
    const int row0 = (dir == 0) ? ((c < 4) ? NLAT + 64 * c : 64 * (c - 4)) : ((c < 4) ? NLAT + 64 * (3 - c) : 64 * (67 - c));
    __syncthreads();
    {
      const bf16_t* qs = QMb + (size_t)(row0 + qr) * 512 + h * 128 + qc * 8;
      const bf16_t* ks = KMb + (size_t)(row0 + qr) * 512 + h * 128 + qc * 8;
      const bf16_t* kts = KMTb + ((size_t)h * 128 + tr) * NTOK + row0 + tc * 8;
      const bf16_t* vts = MVTb + ((size_t)h * 128 + tr) * NTOK + row0 + tc * 8;
      u32x4 a[4], b[4], cc[4], d[4];
#pragma unroll
      for (int i = 0; i < 4; ++i) {
        a[i] = *(const u32x4*)(qs + (size_t)i * 16 * 512);
        b[i] = *(const u32x4*)(ks + (size_t)i * 16 * 512);
        cc[i] = *(const u32x4*)(kts + (size_t)i * 32 * NTOK);
        d[i] = *(const u32x4*)(vts + (size_t)i * 32 * NTOK);
      }
#pragma unroll
      for (int i = 0; i < 4; ++i) {
        *(u32x4*)(smem + qdst + i * 4096) = a[i];
        *(u32x4*)(smem + 16384 + qdst + i * 4096) = b[i];
        *(u32x4*)(smem + 32768 + tdst + i * 4096) = cc[i];
        *(u32x4*)(smem + 49152 + tdst + i * 4096) = d[i];
      }
    }
    if (w == 0) {
      const int row = row0 + lane;
      const float li = MGTb[(size_t)row * 16 + dir * 8 + h] + bi;
      const float x = MGTb[(size_t)row * 16 + dir * 8 + 4 + h] + bf_;
      const float lf = fminf(x, 0.f) - log1pf(expf(-fabsf(x)));
      float b = lf;
#pragma unroll
      for (int o = 1; o < 64; o <<= 1) {
        const float v = (dir == 0) ? __shfl_up(b, o) : __shfl_down(b, o);
        const bool ok = (dir == 0) ? (lane >= o) : (lane + o < 64);
        if (ok) b += v;
      }
      const float tot = (dir == 0) ? __shfl(b, 63) : __shfl(b, 0);
      bs[lane] = b; as_[lane] = li - b; wgs[lane] = expf(tot + li - b); ebs[lane] = expf(b);
      if (lane == 0) *dec_s = expf(tot);
    }
    __syncthreads();
    const int t = tb * 32 + fr;
    bf16x8 qf[8];
#pragma unroll
    for (int ks = 0; ks < 8; ++ks) qf[ks] = *(const bf16x8*)(smem + t * 256 + (((ks * 2 + fh) ^ sw16) << 4));
    const float bt = bs[t], ebt = ebs[t];
    f32x16 S[2];
    float dsum = 0.f;
#pragma unroll
    for (int sb = 0; sb < 2; ++sb) {
#pragma unroll
      for (int i = 0; i < 16; ++i) S[sb][i] = 0.f;
      const bool valid = (dir == 0) ? (sb <= tb) : (sb >= tb);
      if (valid) {
#pragma unroll
        for (int ks = 0; ks < 8; ++ks) {
          const bf16x8 kf = *(const bf16x8*)(smem + 16384 + (sb * 32 + fr) * 256 + (((ks * 2 + fh) ^ sw16) << 4));
          S[sb] = __builtin_amdgcn_mfma_f32_32x32x16_bf16(kf, qf[ks], S[sb], 0, 0, 0);
        }
#pragma unroll
        for (int q = 0; q < 4; ++q) {
          const float4 a4 = *(const float4*)(as_ + sb * 32 + 8 * q + 4 * fh);
          const float av[4] = {a4.x, a4.y, a4.z, a4.w};
#pragma unroll
          for (int j = 0; j < 4; ++j) {
            const int s = sb * 32 + 8 * q + 4 * fh + j;
            const bool ok = (dir == 0) ? (s <= t) : (s >= t);
            const float v = ok ? S[sb][4 * q + j] * expf(bt + av[j]) : 0.f;
            S[sb][4 * q + j] = v;
            dsum += v;
          }
        }
      }
    }
    bf16x8 pf[4];
#pragma unroll
    for (int sb = 0; sb < 2; ++sb)
#pragma unroll
      for (int hh = 0; hh < 2; ++hh)
        pf[sb * 2 + hh] = __builtin_bit_cast(bf16x8, (u32x4){pack2(S[sb][8 * hh], S[sb][8 * hh + 1]), pack2(S[sb][8 * hh + 2], S[sb][8 * hh + 3]),
                                                                 pack2(S[sb][8 * hh + 4], S[sb][8 * hh + 5]), pack2(S[sb][8 * hh + 6], S[sb][8 * hh + 7])});
    float nq = 0.f;
#pragma unroll
    for (int c8 = 0; c8 < 8; ++c8) {
      const u32x4 qv = *(const u32x4*)(smem + t * 256 + (((fh * 8 + c8) ^ sw16) << 4));
      const float4 n0 = *(const float4*)(nprev + fh * 64 + c8 * 8), n1 = *(const float4*)(nprev + fh * 64 + c8 * 8 + 4);
      nq = fmaf(lo16(qv[0]), n0.x, nq); nq = fmaf(hi16(qv[0]), n0.y, nq); nq = fmaf(lo16(qv[1]), n0.z, nq); nq = fmaf(hi16(qv[1]), n0.w, nq);
      nq = fmaf(lo16(qv[2]), n1.x, nq); nq = fmaf(hi16(qv[2]), n1.y, nq); nq = fmaf(lo16(qv[3]), n1.z, nq); nq = fmaf(hi16(qv[3]), n1.w, nq);
    }
    dsum += __shfl_xor(dsum, 32);
    nq += __shfl_xor(nq, 32);
    const float den = dsum + ebt * nq;
    const float inv = 1.0f / fmaxf(fabsf(den), 1.0f);
#pragma unroll
    for (int x = 0; x < 2; ++x) {
      const int eb = 2 * eh + x;
      f32x16 N;
#pragma unroll
      for (int i = 0; i < 16; ++i) N[i] = 0.f;
#pragma unroll
      for (int ks = 0; ks < 8; ++ks) {
        const bf16x8 cf = *(const bf16x8*)(smem + 65536 + (eb * 32 + fr) * 256 + (((ks * 2 + fh) ^ sw16) << 4));
        N = __builtin_amdgcn_mfma_f32_32x32x16_bf16(cf, qf[ks], N, 0, 0, 0);
      }
#pragma unroll
      for (int i = 0; i < 16; ++i) N[i] *= ebt;
#pragma unroll
      for (int s4 = 0; s4 < 4; ++s4) {
        const bool valid = (dir == 0) ? ((s4 >> 1) <= tb) : ((s4 >> 1) >= tb);
        if (valid) {
          const int u0 = 4 * s4 + fh, u1 = u0 + 2;
          const char* vrow = smem + 49152 + (eb * 32 + fr) * 128;
          const u32x2 v0 = *(const u32x2*)(vrow + (((u0 >> 1) ^ sw8) << 4) + (u0 & 1) * 8);
          const u32x2 v1 = *(const u32x2*)(vrow + (((u1 >> 1) ^ sw8) << 4) + (u1 & 1) * 8);
          const bf16x8 vf = __builtin_bit_cast(bf16x8, (u32x4){v0[0], v0[1], v1[0], v1[1]});
          N = __builtin_amdgcn_mfma_f32_32x32x16_bf16(vf, pf[s4], N, 0, 0, 0);
        }
      }
      bf16_t* hp = HXb + (size_t)(row0 + t) * 512 + h * 128 + eb * 32 + 4 * fh;
#pragma unroll
      for (int q = 0; q < 4; ++q)
        *(u32x2*)(hp + 8 * q) = (u32x2){pack2(N[4 * q] * inv, N[4 * q + 1] * inv), pack2(N[4 * q + 2] * inv, N[4 * q + 3] * inv)};
    }
    const float decay = *dec_s;
#pragma unroll
    for (int eb = 0; eb < 4; ++eb)
#pragma unroll
      for (int i = 0; i < 16; ++i) CT[eb][i] *= decay;
#pragma unroll
    for (int ks = 0; ks < 4; ++ks) {
      const u32x4 kraw = *(const u32x4*)(smem + 32768 + (w * 32 + fr) * 128 + (((ks * 2 + fh) ^ sw8) << 4));
      const float4 g0 = *(const float4*)(wgs + ks * 16 + 8 * fh), g1 = *(const float4*)(wgs + ks * 16 + 8 * fh + 4);
      const bf16x8 kts = __builtin_bit_cast(bf16x8, (u32x4){pack2(lo16(kraw[0]) * g0.x, hi16(kraw[0]) * g0.y), pack2(lo16(kraw[1]) * g0.z, hi16(kraw[1]) * g0.w),
                                                             pack2(lo16(kraw[2]) * g1.x, hi16(kraw[2]) * g1.y), pack2(lo16(kraw[3]) * g1.z, hi16(kraw[3]) * g1.w)});
#pragma unroll
      for (int eb = 0; eb < 4; ++eb) {
        const bf16x8 vt = *(const bf16x8*)(smem + 49152 + (eb * 32 + fr) * 128 + (((ks * 2 + fh) ^ sw8) << 4));
        CT[eb] = __builtin_amdgcn_mfma_f32_32x32x16_bf16(kts, vt, CT[eb], 0, 0, 0);
      }
    }
    {
      const int d = tid & 127, sh = tid >> 7;
      float a = 0.f;
#pragma unroll 8
      for (int s = sh * 32; s < sh * 32 + 32; ++s) {
        const bf16_t kv = *(const bf16_t*)(smem + 16384 + s * 256 + ((((d >> 3)) ^ (s & 15)) << 4) + (d & 7) * 2);
        a = fmaf(wgs[s], bf2f(kv), a);
      }
      npart[sh * 128 + d] = a;
    }
    __syncthreads();
#pragma unroll
    for (int eb = 0; eb < 4; ++eb)
#pragma unroll
      for (int q = 0; q < 4; ++q)
        *(u32x2*)(smem + 65536 + (eb * 32 + fr) * 256 + ((((w * 4 + q)) ^ sw16) << 4) + 8 * fh) =
            (u32x2){pack2(CT[eb][4 * q], CT[eb][4 * q + 1]), pack2(CT[eb][4 * q + 2], CT[eb][4 * q + 3])};
    if (tid < 128) nprev[tid] = decay * nprev[tid] + npart[tid] + npart[128 + tid];
  }
  __syncthreads();
}

#define S5SEG 128
#define S5NSEG 34
__device__ __forceinline__ int s5_row(int dir, int step) {
  return (dir == 0) ? ((step < NCTX) ? NLAT + step : step - NCTX)
                    : ((step < NCTX) ? NLAT + (NCTX - 1 - step) : (NLAT - 1) - (step - NCTX));
}
struct S5Disc { float abr, abi, lre_dt, lim_dt; float bbr[16], bbi[16]; };
__device__ __forceinline__ void s5_discretise(const Params& p, int pg, int n, S5Disc& d) {
  const float lre = p.in[I_S5LRE][pg * 64 + n], lim = p.in[I_S5LIM][pg * 64 + n];
  const float dt = expf(p.in[I_S5DT][pg]);
  d.lre_dt = lre * dt; d.lim_dt = lim * dt;
  const float mag = expf(lre * dt);
  d.abr = mag * cosf(lim * dt); d.abi = mag * sinf(lim * dt);
  const float den = lre * lre + lim * lim;
  const float zr = ((d.abr - 1.0f) * lre + d.abi * lim) / den;
  const float zi = (d.abi * lre - (d.abr - 1.0f) * lim) / den;
  const float* br = p.in[I_S5BRE] + ((size_t)pg * 64 + n) * 16;
  const float* bi = p.in[I_S5BIM] + ((size_t)pg * 64 + n) * 16;
#pragma unroll
  for (int q = 0; q < 16; ++q) { float a = br[q], b = bi[q]; d.bbr[q] = zr * a - zi * b; d.bbi[q] = zr * b + zi * a; }
}
__device__ __forceinline__ void s5_step(const S5Disc& d, const float* urow, float& xr, float& xi) {
  const float4* up = (const float4*)urow;
  float br_ = 0.f, bi_ = 0.f;
#pragma unroll
  for (int q4 = 0; q4 < 4; ++q4) {
    const float4 uv = up[q4];
    br_ = fmaf(uv.x, d.bbr[4 * q4], br_); br_ = fmaf(uv.y, d.bbr[4 * q4 + 1], br_); br_ = fmaf(uv.z, d.bbr[4 * q4 + 2], br_); br_ = fmaf(uv.w, d.bbr[4 * q4 + 3], br_);
    bi_ = fmaf(uv.x, d.bbi[4 * q4], bi_); bi_ = fmaf(uv.y, d.bbi[4 * q4 + 1], bi_); bi_ = fmaf(uv.z, d.bbi[4 * q4 + 2], bi_); bi_ = fmaf(uv.w, d.bbi[4 * q4 + 3], bi_);
  }
  const float nr = d.abr * xr - d.abi * xi + br_;
  const float ni = d.abr * xi + d.abi * xr + bi_;
  xr = nr; xi = ni;
}
__device__ __forceinline__ void stage_s5_pass1(const Params& p, int l, const bf16_t* Z, float* XE, float* smem) {
  const int tid = otid(), w = tid >> 6, lane = tid & 63;
  float* us = smem + w * 1024;
  const int nitems = GB * 32 * 2 * (S5NSEG - 1);
  for (int it = blockIdx.x; it * 4 < nitems; it += gridDim.x) {
    const int idx = it * 4 + w;
    const bool active = idx < nitems;
    const int seg = idx % (S5NSEG - 1), r1 = idx / (S5NSEG - 1), dir = r1 & 1, g = (r1 >> 1) & 31, bl = r1 >> 6;
    S5Disc d;
    if (active) s5_discretise(p, (l * 2 + dir) * 32 + g, lane, d);
    float xr = 0.f, xi = 0.f;
    for (int sub = 0; sub < S5SEG / 64; ++sub) {
      __syncthreads();
      if (active) {
        const int row = s5_row(dir, seg * S5SEG + sub * 64 + lane);
        const u32x4* up = (const u32x4*)(Z + ((size_t)bl * NTOK + row) * ZW + 3072 + g * 16);
#pragma unroll
        for (int q = 0; q < 2; ++q) {
          const u32x4 t = up[q];
#pragma unroll
          for (int k = 0; k < 4; ++k) { us[lane * 16 + q * 8 + 2 * k] = lo16(t[k]); us[lane * 16 + q * 8 + 2 * k + 1] = hi16(t[k]); }
        }
      }
      __syncthreads();
      if (active) {
#pragma unroll 4
        for (int t = 0; t < 64; ++t) s5_step(d, us + t * 16, xr, xi);
      }
    }
    if (active) {
      float* xe = XE + ((((size_t)bl * 32 + g) * 2 + dir) * (S5NSEG - 1) + seg) * 128;
      xe[lane] = xr; xe[64 + lane] = xi;
    }
  }
  __syncthreads();
}
__device__ __forceinline__ void s5_item(const Params& p, int l, const bf16_t* Zb, const float* XEc, float* Yb, int g, int dir, int sq, float* smem) {
  const int tid = otid(), w = tid >> 6, lane = tid & 63;
  const int seg = sq * 4 + w;
  const bool active = seg < S5NSEG;
  float* cre = smem;
  float* cim = smem + 1024;
  float* wb = smem + 2048 + w * 4800;
  float* us = wb;
  float* xre = wb + 512;
  float* xim = xre + 32 * 65;
  const int pg = (l * 2 + dir) * 32 + g;
  S5Disc d;
  s5_discretise(p, pg, lane, d);
  __syncthreads();
  {
    const float* cr = p.in[I_S5CRE] + (size_t)pg * 16 * 64;
    const float* ci = p.in[I_S5CIM] + (size_t)pg * 16 * 64;
    for (int i = tid; i < 1024; i += 256) { const int q = i >> 6, n = i & 63; cre[n * 16 + q] = cr[i]; cim[n * 16 + q] = ci[i]; }
  }
  float xr = 0.f, xi = 0.f;
  if (active) {
    const float mg = expf(d.lre_dt * (float)S5SEG);
    const float ar = mg * cosf(d.lim_dt * (float)S5SEG), ai = mg * sinf(d.lim_dt * (float)S5SEG);
    for (int j = 0; j < seg; ++j) {
      const float er = XEc[j * 128 + lane], ei = XEc[j * 128 + 64 + lane];
      const float nr = ar * xr - ai * xi + er, ni = ar * xi + ai * xr + ei;
      xr = nr; xi = ni;
    }
  }
  const int tl = lane & 31, ph = lane >> 5;
  for (int sub = 0; sub < S5SEG / 32; ++sub) {
    const int row = s5_row(dir, (active ? seg : 0) * S5SEG + sub * 32 + tl);
    __syncthreads();
    if (active) {
      const u32x4 t = *(const u32x4*)(Zb + (size_t)row * ZW + 3072 + g * 16 + ph * 8);
#pragma unroll
      for (int k = 0; k < 4; ++k) { us[tl * 16 + ph * 8 + 2 * k] = lo16(t[k]); us[tl * 16 + ph * 8 + 2 * k + 1] = hi16(t[k]); }
    }
    __syncthreads();
    if (active) {
#pragma unroll 4
      for (int t = 0; t < 32; ++t) {
        s5_step(d, us + t * 16, xr, xi);
        xre[t * 65 + lane] = xr;
        xim[t * 65 + lane] = xi;
      }
    }
    __syncthreads();
    if (active) {
      float y[8];
#pragma unroll
      for (int q = 0; q < 8; ++q) y[q] = 0.f;
      for (int n = 0; n < 64; ++n) {
        const float a = xre[tl * 65 + n], b = xim[tl * 65 + n];
        const float4 c0 = *(const float4*)(cre + n * 16 + ph * 8), c1 = *(const float4*)(cre + n * 16 + ph * 8 + 4);
        const float4 e0 = *(const float4*)(cim + n * 16 + ph * 8), e1 = *(const float4*)(cim + n * 16 + ph * 8 + 4);
        y[0] += a * c0.x - b * e0.x; y[1] += a * c0.y - b * e0.y; y[2] += a * c0.z - b * e0.z; y[3] += a * c0.w - b * e0.w;
        y[4] += a * c1.x - b * e1.x; y[5] += a * c1.y - b * e1.y; y[6] += a * c1.z - b * e1.z; y[7] += a * c1.w - b * e1.w;
      }
      float4* yp = (float4*)(Yb + (size_t)row * 512 + g * 16 + ph * 8);
      yp[0] = make_float4(y[0], y[1], y[2], y[3]);
      yp[1] = make_float4(y[4], y[5], y[6], y[7]);
    }
  }
  __syncthreads();
}

__device__ __forceinline__ void stage_post(const Params& p, int l, int rr_lim, const bf16_t* Z, const bf16_t* HF, const bf16_t* HB,
                                           const float* YSF, const float* YSB, bf16_t* YB, bf16_t* GG) {
  const int tid = otid();
  const int c0 = tid * 2;
  for (int i = blockIdx.x; i < GB * rr_lim; i += gridDim.x) {
    const size_t r = (size_t)(i / rr_lim) * NTOK + (i % rr_lim);
    {
      const unsigned a0 = *(const unsigned*)(HF + r * 512 + c0), a1 = *(const unsigned*)(HB + r * 512 + c0);
      float h0 = lo16(a0) + lo16(a1), h1 = hi16(a0) + hi16(a1);
      float ss = wave_sum(h0 * h0 + h1 * h1);
      float rs = rsqrtf(ss * (1.0f / 128.0f) + EPSF);
      float2 g = *(const float2*)(p.in[I_MLNG] + l * 512 + c0);
      const unsigned og = *(const unsigned*)(Z + r * ZW + 2560 + c0);
      *(unsigned*)(YB + r * 512 + c0) = pack2(h0 * rs * g.x * sigmoidf_(lo16(og)), h1 * rs * g.y * sigmoidf_(hi16(og)));
    }
    {
      const unsigned u = *(const unsigned*)(Z + r * ZW + 3072 + c0);
      float2 d = *(const float2*)(p.in[I_S5D] + l * 512 + c0);
      float2 f = *(const float2*)(YSF + r * 512 + c0);
      float2 b = *(const float2*)(YSB + r * 512 + c0);
      *(unsigned*)(GG + r * 512 + c0) = pack2(geluf_(d.x * lo16(u) + f.x + b.x), geluf_(d.y * hi16(u) + f.y + b.y));
    }
  }
}

__device__ __forceinline__ void stage_glu_mfma(const Params& p, int l, int tpb, const bf16_t* GG, const bf16_t* GLUT, bf16_t* YS, char* smem) {
  EPI_DECL
  const int tm = GB * tpb;
  for (int t = blockIdx.x; t < tm * 4; t += gridDim.x) {
    const int m0 = MT_LR0(t >> 2, tpb), n0 = (t & 3) * 128;
    f32x16 acc[2][2];
    gemm_tile(GG + (size_t)m0 * 512, 512, GLUT + (size_t)n0 * 512, 512, 512, smem, acc);
#pragma unroll
    for (int mi = 0; mi < 2; ++mi)
#pragma unroll
      for (int ni = 0; ni < 2; ++ni)
#pragma unroll
        for (int q = 0; q < 4; ++q) {
          const int row = m0 + EPI_ROW(mi), c = n0 + EPI_COL(ni, q);
          const float4 b = *(const float4*)(p.in[I_GLUB] + l * 512 + c);
          const u32x2 g2 = *(const u32x2*)(GG + (size_t)row * 512 + c);
          const float o0 = lo16(g2[0]) * sigmoidf_(acc[mi][ni][4 * q] + b.x), o1 = hi16(g2[0]) * sigmoidf_(acc[mi][ni][4 * q + 1] + b.y);
          const float o2 = lo16(g2[1]) * sigmoidf_(acc[mi][ni][4 * q + 2] + b.z), o3 = hi16(g2[1]) * sigmoidf_(acc[mi][ni][4 * q + 3] + b.w);
          *(u32x2*)(YS + (size_t)row * 512 + c) = (u32x2){pack2(o0, o1), pack2(o2, o3)};
        }
  }
}

__device__ __forceinline__ void stage_merge_mfma(int tpb, const bf16_t* YA, const bf16_t* YB, const bf16_t* YS, const bf16_t* WBR, const bf16_t* Z, bf16_t* MG, char* smem) {
  EPI_DECL
  const int tm = GB * tpb;
  for (int t = blockIdx.x; t < tm * 8; t += gridDim.x) {
    const int m0 = MT_LR0(t >> 3, tpb), n0 = (t & 7) * 128;
    f32x16 macc[2][2];
#pragma unroll
    for (int a = 0; a < 2; ++a)
#pragma unroll
      for (int b = 0; b < 2; ++b)
#pragma unroll
        for (int i = 0; i < 16; ++i) macc[a][b][i] = 0.f;
#pragma unroll 1
    for (int r = 0; r < 3; ++r) {
      const bf16_t* Y = (r == 0) ? YA : (r == 1 ? YB : YS);
      f32x16 acc[2][2];
      gemm_tile(Y + (size_t)m0 * 512, 512, WBR + (size_t)r * 1024 * 512 + (size_t)n0 * 512, 512, 512, smem, acc);
#pragma unroll
      for (int mi = 0; mi < 2; ++mi)
#pragma unroll
        for (int ni = 0; ni < 2; ++ni)
#pragma unroll
          for (int q = 0; q < 4; ++q) {
            const int row = m0 + EPI_ROW(mi), c = n0 + EPI_COL(ni, q);
            const u32x2 e = *(const u32x2*)(Z + (size_t)row * ZW + 3584 + r * 1024 + c);
            macc[mi][ni][4 * q] += lo16(e[0]) * acc[mi][ni][4 * q];
            macc[mi][ni][4 * q + 1] += hi16(e[0]) * acc[mi][ni][4 * q + 1];
            macc[mi][ni][4 * q + 2] += lo16(e[1]) * acc[mi][ni][4 * q + 2];
            macc[mi][ni][4 * q + 3] += hi16(e[1]) * acc[mi][ni][4 * q + 3];
          }
    }
#pragma unroll
    for (int mi = 0; mi < 2; ++mi)
#pragma unroll
      for (int ni = 0; ni < 2; ++ni)
#pragma unroll
        for (int q = 0; q < 4; ++q) {
          const int row = m0 + EPI_ROW(mi), c = n0 + EPI_COL(ni, q);
          *(u32x2*)(MG + (size_t)row * DM + c) = (u32x2){pack2(macc[mi][ni][4 * q], macc[mi][ni][4 * q + 1]), pack2(macc[mi][ni][4 * q + 2], macc[mi][ni][4 * q + 3])};
        }
  }
}

__device__ __forceinline__ void stage_outproj_mfma(const Params& p, int l, int g, int tpb, const bf16_t* MG, const bf16_t* WOUT, char* smem) {
  EPI_DECL
  const int tm = GB * tpb;
  const float* mod = (const float*)(p.ws + WB_MOD) + (size_t)l * 9 * 6144;
  for (int t = blockIdx.x; t < tm * 8; t += gridDim.x) {
    const int mt = t >> 3, n0 = (t & 7) * 128;
    const int m0 = MT_LR0(mt, tpb), bl = mt / tpb, rr0 = (mt % tpb) * 128, b = g * GB + bl;
    f32x16 acc[2][2];
    gemm_tile(MG + (size_t)m0 * DM, DM, WOUT + (size_t)n0 * DM, DM, DM, smem, acc);
    const float* gv = mod + (size_t)((rr0 < NLAT) ? b : 8) * 6144 + 2 * 1024;
#pragma unroll
    for (int mi = 0; mi < 2; ++mi)
#pragma unroll
      for (int ni = 0; ni < 2; ++ni)
#pragma unroll
        for (int q = 0; q < 4; ++q) {
          const int rr = rr0 + EPI_ROW(mi), c = n0 + EPI_COL(ni, q);
          const float4 gg = *(const float4*)(gv + c);
          float4* xp = (float4*)(xrow(p, b, rr) + c);
          float4 x = *xp;
          x.x += gg.x * acc[mi][ni][4 * q]; x.y += gg.y * acc[mi][ni][4 * q + 1]; x.z += gg.z * acc[mi][ni][4 * q + 2]; x.w += gg.w * acc[mi][ni][4 * q + 3];
          *xp = x;
        }
  }
}

__device__ __forceinline__ void stage_peerq_mfma(int tpb, const bf16_t* H2, const bf16_t* WQ, bf16_t* PQ, char* smem) {
  EPI_DECL
  const int tm = GB * tpb;
  for (int t = blockIdx.x; t < tm * 16; t += gridDim.x) {
    const int m0 = MT_LR0(t >> 4, tpb), n0 = (t & 15) * 128;
    f32x16 acc[2][2];
    gemm_tile(H2 + (size_t)m0 * DM, DM, WQ + (size_t)n0 * DM, DM, DM, smem, acc);
#pragma unroll
    for (int mi = 0; mi < 2; ++mi)
#pragma unroll
      for (int ni = 0; ni < 2; ++ni)
#pragma unroll
        for (int q = 0; q < 4; ++q) {
          const int row = m0 + EPI_ROW(mi), c = n0 + EPI_COL(ni, q);
          *(u32x2*)(PQ + (size_t)row * 2048 + c) = (u32x2){pack2(acc[mi][ni][4 * q], acc[mi][ni][4 * q + 1]), pack2(acc[mi][ni][4 * q + 2], acc[mi][ni][4 * q + 3])};
        }
  }
}

__device__ __forceinline__ void stage_scores_mfma(int tpb, const bf16_t* PQ, const bf16_t* SUBK, float* SCT, char* smem) {
  EPI_DECL
  const int tm = GB * tpb * 8;
  for (int t = blockIdx.x; t < tm * 2; t += gridDim.x) {
    const int mt = t >> 1, half = t & 1;
    const size_t m0 = (size_t)MT_LR0(mt >> 3, tpb) * 8 + (size_t)(mt & 7) * 128;
    f32x16 acc[2][2];
    gemm_tile(SUBK + (size_t)half * 16384, 128, PQ + m0 * 256 + half * 128, 256, 128, smem, acc);
    float* o = SCT + ((size_t)mt * 2 + half) * 16384;
#pragma unroll
    for (int mi = 0; mi < 2; ++mi)
#pragma unroll
      for (int ni = 0; ni < 2; ++ni)
#pragma unroll
        for (int q = 0; q < 4; ++q) {
          const int key = EPI_ROW(mi), item = EPI_COL(ni, q);
          *(float4*)(o + key * 128 + item) = make_float4(acc[mi][ni][4 * q], acc[mi][ni][4 * q + 1], acc[mi][ni][4 * q + 2], acc[mi][ni][4 * q + 3]);
        }
  }
}

__device__ __forceinline__ unsigned f2sortable(float x) { const unsigned u = __float_as_uint(x); return (u & 0x80000000u) ? ~u : (u | 0x80000000u); }
__device__ __forceinline__ float sortable2f(unsigned k) { return __uint_as_float((k & 0x80000000u) ? (k & 0x7fffffffu) : ~k); }
#define TOPK_INSERT(v, key) { unsigned t_ = (key); _Pragma("unroll") for (int s_ = 0; s_ < 16; ++s_) { const unsigned hi_ = max(v[s_], t_); t_ = min(v[s_], t_); v[s_] = hi_; } }
__device__ __forceinline__ void stage_topk(int tpb, const float* SCT, int* EI, float* EG, float* smem) {
  const int tid = otid();
  const int item = tid & 127, half = tid >> 7;
  unsigned* xk = (unsigned*)smem;
  const int tm = GB * tpb * 8;
  for (int mt = blockIdx.x; mt < tm; mt += gridDim.x) {
    const size_t m0 = (size_t)MT_LR0(mt >> 3, tpb) * 8 + (size_t)(mt & 7) * 128;
    const float* sc = SCT + ((size_t)mt * 2 + half) * 16384 + item;
    unsigned v[16];
#pragma unroll
    for (int s = 0; s < 16; ++s) v[s] = 0u;
#pragma unroll 4
    for (int k = 0; k < 128; ++k) {
      const unsigned key = (f2sortable(sc[k * 128]) & ~127u) | (unsigned)(127 - k);
      TOPK_INSERT(v, key)
    }
    __syncthreads();
    if (half == 1) {
#pragma unroll
      for (int s = 0; s < 16; ++s) xk[item * 17 + s] = v[s];
    }
    __syncthreads();
    if (half == 0) {
      float v1[16], v2[16];
      unsigned k2[16];
#pragma unroll
      for (int s = 0; s < 16; ++s) { k2[s] = xk[item * 17 + s]; v1[s] = sortable2f((v[s] & ~127u) | 64u); v2[s] = sortable2f((k2[s] & ~127u) | 64u); }
      unsigned c[16];
#pragma unroll
      for (int s = 0; s < 16; ++s) c[s] = 0u;
      {
        int o = 0;
#pragma unroll
        for (int i = 0; i < 16; ++i)
#pragma unroll
          for (int j = 0; j < 16 / (i + 1); ++j) {
            const unsigned key = (f2sortable(v1[i] + v2[j]) & ~63u) | (unsigned)(63 - o);
            TOPK_INSERT(c, key)
            ++o;
          }
      }
      const float vmax = sortable2f((c[0] & ~63u) | 32u);
      float sum = 0.f;
#pragma unroll
      for (int s = 0; s < 16; ++s) sum += expf(sortable2f((c[s] & ~63u) | 32u) - vmax);
      const float isum = 1.0f / sum;
      const unsigned thr = c[15];
      int* ei = EI + (m0 + item) * 16;
      float* eg = EG + (m0 + item) * 16;
      int cntw = 0;
      {
        int o = 0;
#pragma unroll
        for (int i = 0; i < 16; ++i)
#pragma unroll
          for (int j = 0; j < 16 / (i + 1); ++j) {
            const unsigned key = (f2sortable(v1[i] + v2[j]) & ~63u) | (unsigned)(63 - o);
            if (key >= thr) {
              ei[cntw] = (int)((127u - (v[i] & 127u)) * 128u + (127u - (k2[j] & 127u)));
              eg[cntw] = expf(sortable2f((key & ~63u) | 32u) - vmax) * isum;
              ++cntw;
            }
            ++o;
          }
      }
    }
  }
  __syncthreads();
}

__device__ __forceinline__ void unpack8(const u32x4 v, float* f) {
#pragma unroll
  for (int k = 0; k < 4; ++k) { f[2 * k] = lo16(v[k]); f[2 * k + 1] = hi16(v[k]); }
}
__device__ __forceinline__ void stage_expert(const Params& p, int l, int g, int rr_lim, const bf16_t* H2, const int* EI, const float* EG, float* smem) {
  const int tid = otid(), w = tid >> 6, lane = tid & 63;
  float* part = smem;
  const bf16_t* U = (const bf16_t*)(p.ws + WB_U16) + (size_t)l * 16384 * 1024;
  const bf16_t* V = (const bf16_t*)(p.ws + WB_V16) + (size_t)l * 16384 * 1024;
  const float* mod = (const float*)(p.ws + WB_MOD) + (size_t)l * 9 * 6144;
  for (int i = blockIdx.x; i < GB * rr_lim; i += gridDim.x) {
    const int bl = i / rr_lim, rr = i % rr_lim, b = g * GB + bl;
    const size_t t = (size_t)bl * NTOK + rr;
    float hf[16];
    unpack8(((const u32x4*)(H2 + t * DM))[lane], hf);
    unpack8(((const u32x4*)(H2 + t * DM + 512))[lane], hf + 8);
    const int my_e = EI[t * 128 + w * 32 + (lane & 31)];
    const float my_g = EG[t * 128 + w * 32 + (lane & 31)];
    float my_dot = 0.f;
#pragma unroll 1
    for (int k0 = 0; k0 < 32; k0 += 8) {
      u32x4 ra[8], rb[8];
#pragma unroll
      for (int j = 0; j < 8; ++j) {
        const int e = __builtin_amdgcn_readlane(my_e, k0 + j);
        const u32x4* up = (const u32x4*)(U + (size_t)e * 1024);
        ra[j] = up[lane]; rb[j] = up[64 + lane];
      }
#pragma unroll
      for (int j = 0; j < 8; ++j) {
        float f[16];
        unpack8(ra[j], f); unpack8(rb[j], f + 8);
        float a = 0.f;
#pragma unroll
        for (int q = 0; q < 16; ++q) a = fmaf(hf[q], f[q], a);
        a = wave_sum(a);
        if ((lane & 31) == k0 + j) my_dot = a;
      }
    }
    const float my_c = my_g * geluf_(my_dot);
    float acc[16];
#pragma unroll
    for (int q = 0; q < 16; ++q) acc[q] = 0.f;
#pragma unroll 1
    for (int k0 = 0; k0 < 32; k0 += 8) {
      u32x4 ra[8], rb[8];
#pragma unroll
      for (int j = 0; j < 8; ++j) {
        const int e = __builtin_amdgcn_readlane(my_e, k0 + j);
        const u32x4* vp = (const u32x4*)(V + (size_t)e * 1024);
        ra[j] = vp[lane]; rb[j] = vp[64 + lane];
      }
#pragma unroll
      for (int j = 0; j < 8; ++j) {
        const float c = __uint_as_float(__builtin_amdgcn_readlane(__float_as_uint(my_c), k0 + j));
        float f[16];
        unpack8(ra[j], f); unpack8(rb[j], f + 8);
#pragma unroll
        for (int q = 0; q < 16; ++q) acc[q] = fmaf(c, f[q], acc[q]);
      }
    }
    __syncthreads();
    {
      float4* pw = (float4*)(part + w * 1024 + lane * 8);
      pw[0] = make_float4(acc[0], acc[1], acc[2], acc[3]); pw[1] = make_float4(acc[4], acc[5], acc[6], acc[7]);
      float4* pw2 = (float4*)(part + w * 1024 + 512 + lane * 8);
      pw2[0] = make_float4(acc[8], acc[9], acc[10], acc[11]); pw2[1] = make_float4(acc[12], acc[13], acc[14], acc[15]);
    }
    __syncthreads();
    const float4 s0 = ((const float4*)part)[tid], s1 = ((const float4*)(part + 1024))[tid], s2 = ((const float4*)(part + 2048))[tid], s3 = ((const float4*)(part + 3072))[tid];
    const float4 g2 = ((const float4*)(mod + (size_t)((rr < NLAT) ? b : 8) * 6144 + 5 * 1024))[tid];
    float4* xp = (float4*)xrow(p, b, rr) + tid;
    float4 xv = *xp;
    xv.x += g2.x * (s0.x + s1.x + s2.x + s3.x); xv.y += g2.y * (s0.y + s1.y + s2.y + s3.y);
    xv.z += g2.z * (s0.z + s1.z + s2.z + s3.z); xv.w += g2.w * (s0.w + s1.w + s2.w + s3.w);
    *xp = xv;
  }
  __syncthreads();
}

__device__ __forceinline__ void stage_final(const Params& p, float* smem) {
  const int tid = otid();
  for (int r = blockIdx.x; r < NB * NLAT; r += gridDim.x) {
    float4* xp = (float4*)(p.out + (size_t)r * DM) + tid;
    float4 v = *xp;
    float s = wave_sum(v.x * v.x + v.y * v.y + v.z * v.z + v.w * v.w);
    __syncthreads();
    if ((tid & 63) == 0) smem[tid >> 6] = s;
    __syncthreads();
    float rs = rsqrtf((smem[0] + smem[1] + smem[2] + smem[3]) * (1.0f / DM) + EPSF);
    float4 g = ((const float4*)p.in[I_FG])[tid];
    *xp = make_float4(v.x * rs * g.x, v.y * rs * g.y, v.z * rs * g.z, v.w * rs * g.w);
  }
}


__device__ __forceinline__ void gbar(unsigned* ctr, unsigned& epoch) {
  asm volatile("s_waitcnt vmcnt(0)" ::: "memory");
  __syncthreads();
  epoch += gridDim.x;
  if (threadIdx.x == 0) {
    __builtin_amdgcn_fence(__ATOMIC_RELEASE, "agent");
    asm volatile("s_waitcnt vmcnt(0)" ::: "memory");
    __hip_atomic_fetch_add(ctr, 1u, __ATOMIC_RELAXED, __HIP_MEMORY_SCOPE_AGENT);
    while (__hip_atomic_load(ctr, __ATOMIC_RELAXED, __HIP_MEMORY_SCOPE_AGENT) < epoch) __builtin_amdgcn_s_sleep(2);
    __builtin_amdgcn_fence(__ATOMIC_ACQUIRE, "agent");
    asm volatile("s_waitcnt vmcnt(0)" ::: "memory");
  }
  __syncthreads();
}

__global__ void __launch_bounds__(256) mega(Params p) {
  cg::grid_group grid = cg::this_grid();
  __shared__ __attribute__((aligned(16))) float smem[SMEM_FLOATS];
  char* smc = (char*)smem;
  char* ws = p.ws;
  bf16_t* H = (bf16_t*)(ws + WB_H); bf16_t* Z = (bf16_t*)(ws + WB_Z); float* MGT = (float*)(ws + WB_MGT); bf16_t* XC = (bf16_t*)(ws + WB_XC);
  bf16_t* QM = (bf16_t*)(ws + WB_QM); bf16_t* KM = (bf16_t*)(ws + WB_KM); bf16_t* KMT = (bf16_t*)(ws + WB_KMT); bf16_t* MVT = (bf16_t*)(ws + WB_MVT);
  bf16_t* HF = (bf16_t*)(ws + WB_HF); bf16_t* HB = (bf16_t*)(ws + WB_HB);
  bf16_t* VT = (bf16_t*)(ws + WB_VT); float* YSF = (float*)(ws + WB_YSF); float* YSB = (float*)(ws + WB_YSB);
  bf16_t* YA = (bf16_t*)(ws + WB_YA); bf16_t* YB = (bf16_t*)(ws + WB_YB); bf16_t* YS = (bf16_t*)(ws + WB_YS); bf16_t* GG = (bf16_t*)(ws + WB_GG);
  bf16_t* MG = (bf16_t*)(ws + WB_MG); bf16_t* PQ = (bf16_t*)(ws + WB_PQ); float* SC = (float*)(ws + WB_SC);
  int* EI = (int*)(ws + WB_EI); float* EG = (float*)(ws + WB_EG); float* XE = (float*)(ws + WB_XE);
  const bf16_t* WT = (const bf16_t*)(ws + WB_WT);

  unsigned* bar = (unsigned*)(ws + WB_BAR);
  unsigned epoch = 0;
  stage_init(p, smem);
  grid.sync();

  for (int l = 0; l < 2; ++l) {
    const bool need_ctx = (l == 0);
    const int rr_lim = need_ctx ? NTOK : NLAT;
    const int tpb = need_ctx ? 34 : 32;
    const bf16_t* W = WT + (size_t)l * WT_LAYER;
    const float lam_init = 0.8f - 0.6f * expf(-0.3f * (float)l);
    float lam;
    {
      float s1 = 0.f, s2 = 0.f;
      for (int i = 0; i < 64; ++i) {
        s1 += p.in[I_LQ1][l * 64 + i] * p.in[I_LK1][l * 64 + i];
        s2 += p.in[I_LQ2][l * 64 + i] * p.in[I_LK2][l * 64 + i];
      }
      lam = expf(s1) - expf(s2) + lam_init;
    }
    for (int g = 0; g < NG; ++g) {
      stage_normmod(p, l, g, 0, NTOK, H, smem);
      gbar(bar, epoch);
      stage_inproj(p, H, W + WT_WIN, Z, MGT, VT, MVT, smc);
      gbar(bar, epoch);
      stage_conv(p, l, Z, XC);
      stage_s5_pass1(p, l, Z, XE, smem);
      gbar(bar, epoch);
      stage_mlqk(XC, W + WT_WQK, QM, KM, KMT, smc);
      gbar(bar, epoch);
      {
        const int n_attn = 4 * 32 + (need_ctx ? 4 * 2 : 0);
        const int n_s5 = 32 * 2 * 9;
        const int n_items = GB * (8 + n_attn + n_s5);
        int* cnt = (int*)(ws + WB_CNT) + (l * NG + g);
        int* s_item = (int*)(smem + SMEM_FLOATS - 4);
        for (;;) {
          __syncthreads();
          if (otid() == 0) *s_item = atomicAdd(cnt, 1);
          __syncthreads();
          const int it = *s_item;
          if (it >= n_items) break;
          int bl, k;
          if (it < GB * 8) { bl = it / 8; k = it % 8; }
          else if (it < GB * (8 + n_attn)) { bl = (it - GB * 8) / n_attn; k = 8 + (it - GB * 8) % n_attn; }
          else { bl = (it - GB * (8 + n_attn)) / n_s5; k = 8 + n_attn + (it - GB * (8 + n_attn)) % n_s5; }
          const bf16_t* Zb = Z + (size_t)bl * NTOK * ZW;
          const size_t ro = (size_t)bl * NTOK;
          if (k < 8) {
            mlstm_chain_item(p, l, QM + ro * 512, KM + ro * 512, KMT + (size_t)bl * 4 * 128 * NTOK, MVT + (size_t)bl * 4 * 128 * NTOK, MGT + ro * 16,
                             ((k >> 2) ? HB : HF) + ro * 512, k & 3, k >> 2, smc);
          } else if (k < 8 + n_attn) {
            const int a = k - 8;
            const bf16_t* VTb = VT + (size_t)bl * 4 * 128 * NTOK;
            if (a < 128) attn_mfma_item(p, l, Zb, VTb, YA + ro * 512, a & 3, (a >> 2) * 128, 0, NTOK, lam, lam_init, smc);
            else attn_mfma_item(p, l, Zb, VTb, YA + ro * 512, (a - 128) & 3, NLAT + ((a - 128) >> 2) * 128, NLAT, NCTX, lam, lam_init, smc);
          } else {
            const int a = k - 8 - n_attn;
            const int sq = a % 9, dir = (a / 9) & 1, gg = a / 18;
            s5_item(p, l, Zb, XE + (((size_t)bl * 32 + gg) * 2 + dir) * (S5NSEG - 1) * 128, (dir ? YSB : YSF) + ro * 512, gg, dir, sq, smem);
          }
        }
      }
      gbar(bar, epoch);
      stage_post(p, l, rr_lim, Z, HF, HB, YSF, YSB, YB, GG);
      gbar(bar, epoch);
      stage_glu_mfma(p, l, tpb, GG, W + WT_GLU, YS, smc);
      gbar(bar, epoch);
      stage_merge_mfma(tpb, YA, YB, YS, W + WT_WBR, Z, MG, smc);
      gbar(bar, epoch);
      stage_outproj_mfma(p, l, g, tpb, MG, W + WT_WOUT, smc);
      gbar(bar, epoch);
      stage_normmod(p, l, g, 1, rr_lim, H, smem);
      gbar(bar, epoch);
      stage_peerq_mfma(tpb, H, W + WT_WQ, PQ, smc);
      gbar(bar, epoch);
      stage_scores_mfma(tpb, PQ, W + WT_SUBK, SC, smc);
      gbar(bar, epoch);
      stage_topk(tpb, SC, EI, EG, smem);
      gbar(bar, epoch);
      stage_expert(p, l, g, rr_lim, H, EI, EG, smem);
      gbar(bar, epoch);
    }
  }
  stage_final(p, smem);
}

extern "C" void kernel_launch(void* const* d_in, const int* in_sizes, int n_in, void* d_out,
                              int out_size, void* d_ws, size_t ws_size, hipStream_t stream) {
  static int grid_blocks = 0;
  if (!grid_blocks) {
    int dev = 0, cus = 0, per_cu = 0;
    (void)hipGetDevice(&dev);
    (void)hipDeviceGetAttribute(&cus, hipDeviceAttributeMultiprocessorCount, dev);
    (void)hipOccupancyMaxActiveBlocksPerMultiprocessor(&per_cu, mega, 256, 0);
    if (per_cu > 1) per_cu = 1;
    grid_blocks = cus * per_cu;
  }
  if (ws_size < WB_END) {
    fprintf(stderr, "workspace too small: %zu < %zu\n", ws_size, (size_t)WB_END);
    return;
  }
  Params p{};
  for (int i = 0; i < N_IN; ++i) p.in[i] = (const float*)d_in[i];
  p.out = (float*)d_out;
  p.ws = (char*)d_ws;
  (void)hipMemsetAsync((char*)d_ws + WB_BAR, 0, 256, stream);
  void* args[] = {&p};
  hipError_t e = hipLaunchCooperativeKernel((void*)mega, dim3(grid_blocks), dim3(256), args, 0, stream);
  if (e != hipSuccess) fprintf(stderr, "cooperative launch failed: %s (grid %d)\n", hipGetErrorString(e), grid_blocks);
}
```

```cpp
#include <hip/hip_runtime.h>
#include <hip/hip_cooperative_groups.h>
#include <cstdio>
#include <cstdint>
namespace cg = cooperative_groups;

#define NLAT 4096
#define NCTX 256
#define NTOK 4352
#define DM 1024
#define INW 6672
#define NB 8
#define GB 2
#define NG (NB / GB)
#define RPG (GB * NTOK)
#define ZW 6656
#define EPSF 1e-6f

enum { I_X = 0, I_C, I_CTX, I_CCTX, I_WMOD, I_BMOD, I_N1G, I_N2G, I_WIN, I_LQ1, I_LK1, I_LQ2, I_LK2, I_SUBG,
       I_CONVW, I_CONVB, I_MLWQ, I_MLWK, I_GATEB, I_MLNG, I_S5LRE, I_S5LIM, I_S5DT, I_S5BRE, I_S5BIM,
       I_S5CRE, I_S5CIM, I_S5D, I_GLUW, I_GLUB, I_WBR, I_WOUT, I_PWQ, I_PSUBK, I_PU, I_PV, I_FG, N_IN };

struct Params {
  const float* in[N_IN];
  float* out;
  char* ws;
};

typedef unsigned short bf16_t;
typedef short bf16x8 __attribute__((ext_vector_type(8)));
typedef float f32x16 __attribute__((ext_vector_type(16)));
typedef unsigned u32x4 __attribute__((ext_vector_type(4)));
typedef unsigned u32x2 __attribute__((ext_vector_type(2)));

#define AL(x) (((x) + 255) & ~(size_t)255)
#define WB_XCX   ((size_t)0)
#define WB_MOD   AL(WB_XCX + (size_t)NB * NCTX * DM * 4)
#define WB_ROPE  AL(WB_MOD + (size_t)2 * 9 * 6144 * 4)
#define WB_WT    AL(WB_ROPE + (size_t)NLAT * 32 * 2 * 4)
#define WT_WIN   ((size_t)0)
#define WT_WQK   (WT_WIN + (size_t)6784 * 1024)
#define WT_GLU   (WT_WQK + (size_t)4 * 256 * 128)
#define WT_WBR   (WT_GLU + (size_t)512 * 512)
#define WT_WOUT  (WT_WBR + (size_t)3 * 1024 * 512)
#define WT_WQ    (WT_WOUT + (size_t)1024 * 1024)
#define WT_SUBK  (WT_WQ + (size_t)2048 * 1024)
#define WT_LAYER (WT_SUBK + (size_t)2 * 128 * 128)
#define WB_H     AL(WB_WT + WT_LAYER * 2 * 2)
#define WB_Z     AL(WB_H + (size_t)RPG * DM * 2)
#define WB_MGT   AL(WB_Z + (size_t)RPG * ZW * 2)
#define WB_XC    AL(WB_MGT + (size_t)RPG * 16 * 4)
#define WB_QM    AL(WB_XC + (size_t)RPG * 512 * 2)
#define WB_KM    AL(WB_QM + (size_t)RPG * 512 * 2)
#define WB_KMT   AL(WB_KM + (size_t)RPG * 512 * 2)
#define WB_MVT   AL(WB_KMT + (size_t)RPG * 512 * 2)
#define WB_HF    AL(WB_MVT + (size_t)RPG * 512 * 2)
#define WB_HB    AL(WB_HF + (size_t)RPG * 512 * 2)
#define WB_YSF   AL(WB_HB + (size_t)RPG * 512 * 2)
#define WB_YSB   AL(WB_YSF + (size_t)RPG * 512 * 4)
#define WB_YA    AL(WB_YSB + (size_t)RPG * 512 * 4)
#define WB_YB    AL(WB_YA + (size_t)RPG * 512 * 2)
#define WB_YS    AL(WB_YB + (size_t)RPG * 512 * 2)
#define WB_GG    AL(WB_YS + (size_t)RPG * 512 * 2)
#define WB_MG    AL(WB_GG + (size_t)RPG * 512 * 2)
#define WB_EI    AL(WB_MG + (size_t)RPG * DM * 2)
#define WB_EG    AL(WB_EI + (size_t)RPG * 128 * 4)
#define WB_U16   AL(WB_EG + (size_t)RPG * 128 * 4)
#define WB_V16   AL(WB_U16 + (size_t)2 * 16384 * 1024)
#define WB_VT    AL(WB_V16 + (size_t)2 * 16384 * 1024)
#define WB_CNT   AL(WB_VT + (size_t)GB * 4 * 128 * NTOK * 2)
#define WB_XE    AL(WB_CNT + 256)
#define WB_BAR   AL(WB_XE + (size_t)GB * 32 * 2 * 33 * 128 * 4)
#define WB_GA    AL(WB_BAR + 256)
#define WB_END   AL(WB_GA + (size_t)GB * 4 * 2 * 68 * 272 * 4)
#define WB_PQ    (WB_Z)
#define WB_SC    AL(WB_PQ + (size_t)RPG * 2048 * 2)

#define SMEM_FLOATS (25 * 1024)

__device__ __forceinline__ float sigmoidf_(float x) { return __builtin_amdgcn_rcpf(1.0f + __builtin_amdgcn_exp2f(-1.4426950408889634f * x)); }
__device__ __forceinline__ float siluf_(float x) { return x * __builtin_amdgcn_rcpf(1.0f + __builtin_amdgcn_exp2f(-1.4426950408889634f * x)); }
__device__ __forceinline__ float geluf_(float x) { return 0.5f * x * (1.0f + erff(x * 0.70710678118654752f)); }
__device__ __forceinline__ int otid() { int t = threadIdx.x; asm volatile("" : "+v"(t)); return t; }
__device__ __forceinline__ float wave_sum(float v) {
  for (int o = 32; o > 0; o >>= 1) v += __shfl_xor(v, o);
  return v;
}
__device__ __forceinline__ bf16_t f2bf(float x) { unsigned u = __float_as_uint(x); u += 0x7fffu + ((u >> 16) & 1u); return (bf16_t)(u >> 16); }
__device__ __forceinline__ float bf2f(bf16_t h) { return __uint_as_float(((unsigned)h) << 16); }
typedef float f32x2 __attribute__((ext_vector_type(2)));
typedef __bf16 bf16x2_t __attribute__((ext_vector_type(2)));
__device__ __forceinline__ unsigned pack2(float a, float b) { f32x2 v = {a, b}; return __builtin_bit_cast(unsigned, __builtin_convertvector(v, bf16x2_t)); }
__device__ __forceinline__ float lo16(unsigned u) { return __uint_as_float(u << 16); }
__device__ __forceinline__ float hi16(unsigned u) { return __uint_as_float(u & 0xffff0000u); }

__device__ __forceinline__ float* xrow(const Params& p, int b, int rr) {
  return (rr < NLAT) ? p.out + ((size_t)b * NLAT + rr) * DM : (float*)(p.ws + WB_XCX) + ((size_t)b * NCTX + (rr - NLAT)) * DM;
}

__device__ __forceinline__ void gemm_tile(const bf16_t* __restrict__ Ag, int lda, const bf16_t* __restrict__ Bg, int ldb, int K,
                                          char* smem, f32x16 (&acc)[2][2]) {
  const int tid = otid(), lane = tid & 63, w = tid >> 6, wm = w >> 1, wn = w & 1;
#pragma unroll
  for (int a = 0; a < 2; ++a)
#pragma unroll
    for (int b = 0; b < 2; ++b)
#pragma unroll
      for (int i = 0; i < 16; ++i) acc[a][b][i] = 0.f;
  const int srow = tid >> 3, sch = tid & 7;
  const bf16_t* ap = Ag + (size_t)srow * lda + sch * 8;
  const bf16_t* bp = Bg + (size_t)srow * ldb + sch * 8;
  const int wofs = srow * 128 + ((sch ^ ((srow >> 1) & 7)) << 4);
  const int fr = lane & 31, fh = lane >> 5, fsw = (fr >> 1) & 7;
  const int aofs = (wm * 64 + fr) * 128, bofs = 16384 + (wn * 64 + fr) * 128;
  u32x4 ra0[4], rb0[4], ra1[4], rb1[4];
  const int nk = K >> 6;
#define G_LOAD(RA, RB, KT) { _Pragma("unroll") for (int i = 0; i < 4; ++i) { RA[i] = *(const u32x4*)(ap + (size_t)i * 32 * lda + (KT) * 64); RB[i] = *(const u32x4*)(bp + (size_t)i * 32 * ldb + (KT) * 64); } }
#define G_STORE(RA, RB, BUF) { char* nb_ = smem + (BUF) * 32768; _Pragma("unroll") for (int i = 0; i < 4; ++i) { *(u32x4*)(nb_ + wofs + i * 4096) = RA[i]; *(u32x4*)(nb_ + 16384 + wofs + i * 4096) = RB[i]; } }
#define G_COMPUTE(BUF) { const char* base = smem + (BUF) * 32768; _Pragma("unroll") for (int ks = 0; ks < 4; ++ks) { \
      const int coff = ((ks * 2 + fh) ^ fsw) << 4; bf16x8 af[2], bfr[2]; \
      _Pragma("unroll") for (int mi = 0; mi < 2; ++mi) af[mi] = *(const bf16x8*)(base + aofs + mi * 4096 + coff); \
      _Pragma("unroll") for (int ni = 0; ni < 2; ++ni) bfr[ni] = *(const bf16x8*)(base + bofs + ni * 4096 + coff); \
      _Pragma("unroll") for (int mi = 0; mi < 2; ++mi) _Pragma("unroll") for (int ni = 0; ni < 2; ++ni) \
          acc[mi][ni] = __builtin_amdgcn_mfma_f32_32x32x16_bf16(bfr[ni], af[mi], acc[mi][ni], 0, 0, 0); } }
  G_LOAD(ra0, rb0, 0)
  G_LOAD(ra1, rb1, 1)
  __syncthreads();
  G_STORE(ra0, rb0, 0)
  __syncthreads();
  for (int kt = 0; kt < nk; kt += 2) {
    if (kt + 2 < nk) G_LOAD(ra0, rb0, kt + 2)
    G_COMPUTE(0)
    G_STORE(ra1, rb1, 1)
    __syncthreads();
    if (kt + 3 < nk) G_LOAD(ra1, rb1, kt + 3)
    G_COMPUTE(1)
    if (kt + 2 < nk) G_STORE(ra0, rb0, 0)
    __syncthreads();
  }
#undef G_LOAD
#undef G_STORE
#undef G_COMPUTE
}
#define EPI_DECL const int tid_ = otid(); const int lane = tid_ & 63, w_ = tid_ >> 6, wm = w_ >> 1, wn = w_ & 1, fr = lane & 31, fh = lane >> 5; (void)fr; (void)fh; (void)wm; (void)wn;
#define EPI_ROW(mi) (wm * 64 + (mi) * 32 + fr)
#define EPI_COL(ni, q) (wn * 64 + (ni) * 32 + 8 * (q) + 4 * fh)
#define MT_LR0(mt, tpb) (((mt) / (tpb)) * NTOK + ((mt) % (tpb)) * 128)


struct TileIter {
  int tm, tn, pw, ph, PN, NP, x, i, it;
  __device__ __forceinline__ TileIter(int tm_, int tn_) : tm(tm_), tn(tn_) {
    pw = tn < 8 ? tn : 8; ph = 32 / pw; PN = (tn + pw - 1) / pw; NP = ((tm + ph - 1) / ph) * PN;
    x = blockIdx.x & 7; i = blockIdx.x >> 3; it = 0;
  }
  __device__ __forceinline__ bool next(int& mt, int& nt, bool& valid) {
    if (gridDim.x != 256) {
      const int t = blockIdx.x + it * gridDim.x; ++it;
      if (t >= tm * tn) return false;
      mt = t / tn; nt = t % tn; valid = true; return true;
    }
    const int P = it * 8 + x; ++it;
    if (P >= NP) return false;
    mt = (P / PN) * ph + i / pw; nt = (P % PN) * pw + i % pw;
    valid = (mt < tm) && (nt < tn);
    return true;
  }
};

template <class F>
__device__ __forceinline__ void transpose_cvt(const float* __restrict__ src, int ld, F srccol, int K, int Ndst, bf16_t* __restrict__ dst, float* smem) {
  float (*T)[65] = (float (*)[65])smem;
  const int tid = otid();
  const int tk = K >> 6, tn = Ndst >> 6;
  for (int t = blockIdx.x; t < tn * tk; t += gridDim.x) {
    const int n0 = (t / tk) * 64, k0 = (t % tk) * 64;
    __syncthreads();
    const int sc = srccol(n0 + (tid & 63));
#pragma unroll
    for (int i = 0; i < 16; ++i) {
      const int ky = (tid >> 6) + 4 * i;
      T[ky][tid & 63] = (sc >= 0) ? src[(size_t)(k0 + ky) * ld + sc] : 0.f;
    }
    __syncthreads();
#pragma unroll
    for (int i = 0; i < 16; ++i) {
      const int ny = (tid >> 6) + 4 * i;
      dst[(size_t)(n0 + ny) * K + k0 + (tid & 63)] = f2bf(T[tid & 63][ny]);
    }
  }
  __syncthreads();
}
__device__ __forceinline__ int win_srccol(int n) {
  if (n < 3072) return n;
  if (n < 6656) return n + 16;
  if (n < 6672) return n - 3584;
  return -1;
}

__device__ __forceinline__ void stage_init(const Params& p, float* smem) {
  const int tid = otid();
  {
    const size_t n4 = (size_t)NB * NLAT * 256;
    const float4* s = (const float4*)p.in[I_X];
    float4* d = (float4*)p.out;
    for (size_t i = (size_t)blockIdx.x * 256 + tid; i < n4; i += (size_t)gridDim.x * 256) d[i] = s[i];
    const size_t m4 = (size_t)NB * NCTX * 256;
    const float4* s2 = (const float4*)p.in[I_CTX];
    float4* d2 = (float4*)(p.ws + WB_XCX);
    for (size_t i = (size_t)blockIdx.x * 256 + tid; i < m4; i += (size_t)gridDim.x * 256) d2[i] = s2[i];
  }
  if (blockIdx.x == 0 && tid < 64) ((int*)(p.ws + WB_CNT))[tid] = 0;
  {
    const size_t n16 = (size_t)2 * 16384 * 1024 / 16;
    const float4* su = (const float4*)p.in[I_PU];
    const float4* sv = (const float4*)p.in[I_PV];
    u32x4* du = (u32x4*)(p.ws + WB_U16);
    u32x4* dv = (u32x4*)(p.ws + WB_V16);
    for (size_t i = (size_t)blockIdx.x * 256 + tid; i < n16; i += (size_t)gridDim.x * 256) {
      u32x4 ou, ov;
#pragma unroll
      for (int q = 0; q < 4; ++q) {
        const float4 a = su[4 * i + q];
        int w = 0;
        w = __builtin_amdgcn_cvt_pk_fp8_f32(a.x * 32.f, a.y * 32.f, w, false);
        w = __builtin_amdgcn_cvt_pk_fp8_f32(a.z * 32.f, a.w * 32.f, w, true);
        ou[q] = (unsigned)w;
        const float4 b = sv[4 * i + q];
        int w2 = 0;
        w2 = __builtin_amdgcn_cvt_pk_fp8_f32(b.x, b.y, w2, false);
        w2 = __builtin_amdgcn_cvt_pk_fp8_f32(b.z, b.w, w2, true);
        ov[q] = (unsigned)w2;
      }
      du[i] = ou; dv[i] = ov;
    }
  }
  {
    float2* rt = (float2*)(p.ws + WB_ROPE);
    for (int i = blockIdx.x * 256 + tid; i < NLAT * 32; i += gridDim.x * 256) {
      const int pos = i >> 5, j = i & 31;
      const float inv = powf(10000.0f, -(float)(j & 15) / 16.0f);
      const float ang = (float)((j < 16) ? (pos >> 6) : (pos & 63)) * inv;
      rt[i] = make_float2(cosf(ang), sinf(ang));
    }
  }
  {
    float* sc = smem;
    for (int i = tid; i < 9 * 1024; i += 256) {
      int r = i >> 10, k = i & 1023;
      float v = (r < 8) ? p.in[I_C][r * 1024 + k] : p.in[I_CCTX][k];
      sc[i] = siluf_(v);
    }
    __syncthreads();
    float* mod = (float*)(p.ws + WB_MOD);
    for (int col = blockIdx.x * 256 + tid; col < 2 * 6144; col += gridDim.x * 256) {
      int l = col / 6144, j = col % 6144;
      const float* w = p.in[I_WMOD] + (size_t)l * 1024 * 6144 + j;
      float acc[9];
#pragma unroll
      for (int r = 0; r < 9; ++r) acc[r] = 0.f;
      for (int k = 0; k < 1024; ++k) {
        float wv = w[(size_t)k * 6144];
#pragma unroll
        for (int r = 0; r < 9; ++r) acc[r] = fmaf(sc[r * 1024 + k], wv, acc[r]);
      }
      float bv = p.in[I_BMOD][l * 6144 + j];
#pragma unroll
      for (int r = 0; r < 9; ++r) mod[((size_t)l * 9 + r) * 6144 + j] = acc[r] + bv;
    }
    __syncthreads();
  }
  bf16_t* WT = (bf16_t*)(p.ws + WB_WT);
  for (int l = 0; l < 2; ++l) {
    bf16_t* W = WT + (size_t)l * WT_LAYER;
    transpose_cvt(p.in[I_WIN] + (size_t)l * DM * INW, INW, [](int n) { return win_srccol(n); }, DM, 6784, W + WT_WIN, smem);
    for (int h = 0; h < 4; ++h) {
      transpose_cvt(p.in[I_MLWQ] + ((size_t)l * 4 + h) * 16384, 128, [](int n) { return n; }, 128, 128, W + WT_WQK + (size_t)h * 256 * 128, smem);
      transpose_cvt(p.in[I_MLWK] + ((size_t)l * 4 + h) * 16384, 128, [](int n) { return n; }, 128, 128, W + WT_WQK + (size_t)h * 256 * 128 + 128 * 128, smem);
    }
    transpose_cvt(p.in[I_GLUW] + (size_t)l * 512 * 512, 512, [](int n) { return n; }, 512, 512, W + WT_GLU, smem);
    for (int r = 0; r < 3; ++r)
      transpose_cvt(p.in[I_WBR] + ((size_t)l * 3 + r) * 512 * DM, DM, [](int n) { return n; }, 512, DM, W + WT_WBR + (size_t)r * 1024 * 512, smem);
    transpose_cvt(p.in[I_WOUT] + (size_t)l * DM * DM, DM, [](int n) { return n; }, DM, DM, W + WT_WOUT, smem);
    transpose_cvt(p.in[I_PWQ] + (size_t)l * DM * 2048, 2048, [](int n) { return n; }, DM, 2048, W + WT_WQ, smem);
    const float* sk = p.in[I_PSUBK] + (size_t)l * 2 * 128 * 128;
    for (int i = blockIdx.x * 256 + tid; i < 2 * 128 * 128; i += gridDim.x * 256) W[WT_SUBK + i] = f2bf(sk[i]);
  }
}

__device__ __forceinline__ void stage_normmod(const Params& p, int l, int g, int which, int rr_lim, bf16_t* H, float* smem) {
  const int tid = otid();
  const float* ng = p.in[which ? I_N2G : I_N1G] + l * DM;
  const float* mod = (const float*)(p.ws + WB_MOD) + (size_t)l * 9 * 6144;
  const int off_sh = which ? 3072 : 0, off_sc = which ? 4096 : 1024;
  const int per = rr_lim;
  for (int i = blockIdx.x; i < GB * per; i += gridDim.x) {
    const int bl = i / per, rr = i % per, b = g * GB + bl;
    const float* X = xrow(p, b, rr);
    float4 v = ((const float4*)X)[tid];
    float s = wave_sum(v.x * v.x + v.y * v.y + v.z * v.z + v.w * v.w);
    __syncthreads();
    if ((tid & 63) == 0) smem[tid >> 6] = s;
    __syncthreads();
    float tot = smem[0] + smem[1] + smem[2] + smem[3];
    float rs = rsqrtf(tot * (1.0f / DM) + EPSF);
    const float* m = mod + (size_t)((rr < NLAT) ? b : 8) * 6144;
    float4 gg = ((const float4*)ng)[tid];
    float4 sc = ((const float4*)(m + off_sc))[tid];
    float4 sh = ((const float4*)(m + off_sh))[tid];
    float4 o;
    o.x = v.x * rs * gg.x * (1.f + sc.x) + sh.x;
    o.y = v.y * rs * gg.y * (1.f + sc.y) + sh.y;
    o.z = v.z * rs * gg.z * (1.f + sc.z) + sh.z;
    o.w = v.w * rs * gg.w * (1.f + sc.w) + sh.w;
    ((u32x2*)(H + ((size_t)bl * NTOK + rr) * DM))[tid] = (u32x2){pack2(o.x, o.y), pack2(o.z, o.w)};
  }
  __syncthreads();
}

__device__ __forceinline__ void stage_inproj(const Params& p, const bf16_t* H, const bf16_t* WinT, bf16_t* Z, float* MGT, bf16_t* VT, bf16_t* MVT, char* smem) {
  EPI_DECL
  const int tm = GB * 34, tn = 53;
  const float2* rt = (const float2*)(p.ws + WB_ROPE);
  TileIter ti(tm, tn);
  int mt, j; bool valid;
  while (ti.next(mt, j, valid)) {
    if (!valid) continue;
    const int n0 = j * 128;
    const int lr0 = MT_LR0(mt, 34), rr0 = (mt % 34) * 128;
    f32x16 acc[2][2];
    if ((j >= 8 && j < 12) || (j >= 16 && j < 20)) {
      gemm_tile(WinT + (size_t)n0 * DM, DM, H + (size_t)lr0 * DM, DM, DM, smem, acc);
      bf16_t* vt = ((j < 12) ? VT : MVT) + ((size_t)(mt / 34) * 4 + (j & 3)) * 128 * NTOK;
#pragma unroll
      for (int mi = 0; mi < 2; ++mi)
#pragma unroll
        for (int ni = 0; ni < 2; ++ni)
#pragma unroll
          for (int q = 0; q < 4; ++q) {
            const int e = EPI_ROW(mi), tok = rr0 + EPI_COL(ni, q);
            *(u32x2*)(vt + (size_t)e * NTOK + tok) = (u32x2){pack2(acc[mi][ni][4 * q], acc[mi][ni][4 * q + 1]), pack2(acc[mi][ni][4 * q + 2], acc[mi][ni][4 * q + 3])};
          }
      continue;
    }
    gemm_tile(H + (size_t)lr0 * DM, DM, WinT + (size_t)n0 * DM, DM, DM, smem, acc);
    if (j < 8 && rr0 < NLAT) {
#pragma unroll
      for (int mi = 0; mi < 2; ++mi) {
        const int pos = rr0 + EPI_ROW(mi);
#pragma unroll
        for (int i = 0; i < 16; ++i) {
          const int jj = 8 * (i >> 2) + 4 * fh + (i & 3);
          const float2 cs = rt[pos * 32 + jj];
          const float x1 = acc[mi][0][i], x2 = acc[mi][1][i];
          acc[mi][0][i] = x1 * cs.x - x2 * cs.y;
          acc[mi][1][i] = x1 * cs.y + x2 * cs.x;
        }
      }
    }
    if (j < 52) {
      const bool sg = (j >= 28);
#pragma unroll
      for (int mi = 0; mi < 2; ++mi)
#pragma unroll
        for (int ni = 0; ni < 2; ++ni)
#pragma unroll
          for (int q = 0; q < 4; ++q) {
            const int row = lr0 + EPI_ROW(mi), c = n0 + EPI_COL(ni, q);
            float v0 = acc[mi][ni][4 * q], v1 = acc[mi][ni][4 * q + 1], v2 = acc[mi][ni][4 * q + 2], v3 = acc[mi][ni][4 * q + 3];
            if (sg) { v0 = sigmoidf_(v0); v1 = sigmoidf_(v1); v2 = sigmoidf_(v2); v3 = sigmoidf_(v3); }
            *(u32x2*)(Z + (size_t)row * ZW + c) = (u32x2){pack2(v0, v1), pack2(v2, v3)};
          }
    } else {
#pragma unroll
      for (int mi = 0; mi < 2; ++mi)
#pragma unroll
        for (int q = 0; q < 2; ++q) {
          const int row = lr0 + EPI_ROW(mi), c = EPI_COL(0, q);
          if (wn == 0) *(float4*)(MGT + (size_t)row * 16 + c) = make_float4(acc[mi][0][4 * q], acc[mi][0][4 * q + 1], acc[mi][0][4 * q + 2], acc[mi][0][4 * q + 3]);
        }
    }
  }
}

__device__ __forceinline__ void stage_conv(const Params& p, int l, const bf16_t* Z, bf16_t* XC) {
  const int tid = otid();
  const float* cw = p.in[I_CONVW] + (size_t)l * 3 * 512;
  const float* cb = p.in[I_CONVB] + (size_t)l * 512;
  const int c = tid * 2;
  const float2 w0 = *(const float2*)(cw + c), w1 = *(const float2*)(cw + 512 + c), w2 = *(const float2*)(cw + 1024 + c), bb = *(const float2*)(cb + c);
  for (int lr = blockIdx.x; lr < RPG; lr += gridDim.x) {
    const int rr = lr % NTOK;
    const bool has_prev = (rr < NLAT) ? (rr > 0) : (rr > NLAT);
    const bool has_next = (rr < NLAT) ? (rr < NLAT - 1) : (rr < NTOK - 1);
    const bf16_t* z = Z + (size_t)lr * ZW + 1536 + c;
    const unsigned xc = *(const unsigned*)z;
    float a0 = bb.x + w1.x * lo16(xc), a1 = bb.y + w1.y * hi16(xc);
    if (has_prev) { const unsigned xp = *(const unsigned*)(z - ZW); a0 += w0.x * lo16(xp); a1 += w0.y * hi16(xp); }
    if (has_next) { const unsigned xn = *(const unsigned*)(z + ZW); a0 += w2.x * lo16(xn); a1 += w2.y * hi16(xn); }
    *(unsigned*)(XC + (size_t)lr * 512 + c) = pack2(siluf_(a0), siluf_(a1));
  }
}

__device__ __forceinline__ void stage_mlqk(const bf16_t* XC, const bf16_t* WQK, bf16_t* QM, bf16_t* KM, bf16_t* KMT, char* smem) {
  EPI_DECL
  const int tm = RPG >> 7;
  TileIter ti(tm, 12);
  int mt, r12; bool valid;
  while (ti.next(mt, r12, valid)) {
    if (!valid) continue;
    const int h = r12 & 3, kind = r12 >> 2;
    const int m0 = mt * 128;
    f32x16 acc[2][2];
    const bf16_t* Wt = WQK + (size_t)h * 256 * 128 + (size_t)(kind ? 1 : 0) * 128 * 128;
    const bf16_t* Xt = XC + (size_t)m0 * 512 + h * 128;
    if (kind < 2) {
      gemm_tile(Xt, 512, Wt, 128, 128, smem, acc);
      bf16_t* O = kind ? KM : QM;
      const float alpha = kind ? 1.0f : 0.08838834764831845f;
#pragma unroll
      for (int mi = 0; mi < 2; ++mi)
#pragma unroll
        for (int ni = 0; ni < 2; ++ni)
#pragma unroll
          for (int q = 0; q < 4; ++q) {
            const int row = m0 + EPI_ROW(mi), c = EPI_COL(ni, q);
            *(u32x2*)(O + (size_t)row * 512 + h * 128 + c) = (u32x2){pack2(alpha * acc[mi][ni][4 * q], alpha * acc[mi][ni][4 * q + 1]), pack2(alpha * acc[mi][ni][4 * q + 2], alpha * acc[mi][ni][4 * q + 3])};
          }
    } else {
      gemm_tile(Wt, 128, Xt, 512, 128, smem, acc);
      bf16_t* kt = KMT + ((size_t)(mt / 34) * 4 + h) * 128 * NTOK + (mt % 34) * 128;
#pragma unroll
      for (int mi = 0; mi < 2; ++mi)
#pragma unroll
        for (int ni = 0; ni < 2; ++ni)
#pragma unroll
          for (int q = 0; q < 4; ++q) {
            const int d = EPI_ROW(mi), tok = EPI_COL(ni, q);
            *(u32x2*)(kt + (size_t)d * NTOK + tok) = (u32x2){pack2(acc[mi][ni][4 * q], acc[mi][ni][4 * q + 1]), pack2(acc[mi][ni][4 * q + 2], acc[mi][ni][4 * q + 3])};
          }
    }
  }
}

__device__ __forceinline__ void attn_mfma_item(const Params& p, int l, const bf16_t* Zb, const bf16_t* VTb, bf16_t* YAb, int h, int qrow0, int key0, int nkeys,
                                               float lam, float lam_init, char* smem) {
  const int tid = otid(), lane = tid & 63, w = tid >> 6, fr = lane & 31, fh = lane >> 5;
  const int rb = w & 1, m = w >> 1;
  const int ntiles = nkeys >> 6;
  const int myrow = qrow0 + rb * 32 + fr;
  bf16x8 qf[4];
  {
    const bf16_t* qp = Zb + (size_t)myrow * ZW + h * 128 + m * 64 + fh * 8;
#pragma unroll
    for (int ks = 0; ks < 4; ++ks) qf[ks] = *(const bf16x8*)(qp + ks * 16);
  }
  f32x16 O[4];
#pragma unroll
  for (int eb = 0; eb < 4; ++eb)
#pragma unroll
    for (int i = 0; i < 16; ++i) O[eb][i] = 0.f;
  float mrun = -1e30f, lrun = 0.f;
  const float cs = 0.125f * 1.4426950408889634f;
  const int skey = tid >> 4, sch = tid & 15;
  const bf16_t* ksrc = Zb + (size_t)(key0 + skey) * ZW + 512 + h * 128 + sch * 8;
  const int kdst = skey * 256 + ((sch ^ (skey & 15)) << 4);
  const int se = tid >> 3, svc = tid & 7;
  const bf16_t* vsrc = VTb + ((size_t)h * 128 + se) * NTOK + key0 + svc * 8;
  const int vsw = (se >> 1) & 15;
  const int vdst0 = se * 128 + (((2 * svc) ^ vsw) << 3), vdst1 = se * 128 + (((2 * svc + 1) ^ vsw) << 3);
  const int kfo = fr * 256, kfs = fr & 15;
  const int vfo = fr * 128, vfs = (fr >> 1) & 15;
  u32x4 rk[4], rv[4];
#pragma unroll
  for (int i = 0; i < 4; ++i) rk[i] = *(const u32x4*)(ksrc + (size_t)i * 16 * ZW);
  __syncthreads();
#pragma unroll
  for (int i = 0; i < 4; ++i) *(u32x4*)(smem + kdst + i * 4096) = rk[i];
  __syncthreads();
  bf16x8 pf[4];
#pragma unroll
  for (int s = 0; s < 4; ++s)
#pragma unroll
    for (int i = 0; i < 8; ++i) pf[s][i] = 0;
#pragma unroll 1
  for (int t = 0; t <= ntiles; ++t) {
    const bool cur = t < ntiles, nxt = t + 1 < ntiles, prv = t >= 1;
    if (nxt) {
#pragma unroll
      for (int i = 0; i < 4; ++i) rk[i] = *(const u32x4*)(ksrc + (size_t)((t + 1) * 64 + i * 16) * ZW);
    }
    if (cur) {
#pragma unroll
      for (int i = 0; i < 4; ++i) rv[i] = *(const u32x4*)(vsrc + (size_t)i * 32 * NTOK + t * 64);
    }
    const char* kb_ = smem + (t & 1) * 16384;
    f32x16 S[2];
    if (cur) {
#pragma unroll
      for (int kb = 0; kb < 2; ++kb) {
#pragma unroll
        for (int i = 0; i < 16; ++i) S[kb][i] = 0.f;
#pragma unroll
        for (int ks = 0; ks < 4; ++ks) {
          const bf16x8 kf = *(const bf16x8*)(kb_ + kb * 8192 + kfo + (((m * 8 + ks * 2 + fh) ^ kfs) << 4));
          S[kb] = __builtin_amdgcn_mfma_f32_32x32x16_bf16(kf, qf[ks], S[kb], 0, 0, 0);
        }
      }
    }
    if (prv) {
      const char* vb_ = smem + 32768 + ((t - 1) & 1) * 16384;
#pragma unroll
      for (int eb = 0; eb < 4; ++eb)
#pragma unroll
        for (int s = 0; s < 4; ++s) {
          const u32x2 v0 = *(const u32x2*)(vb_ + eb * 4096 + vfo + (((4 * s + fh) ^ vfs) << 3));
          const u32x2 v1 = *(const u32x2*)(vb_ + eb * 4096 + vfo + (((4 * s + fh + 2) ^ vfs) << 3));
          const bf16x8 vf = __builtin_bit_cast(bf16x8, (u32x4){v0[0], v0[1], v1[0], v1[1]});
          O[eb] = __builtin_amdgcn_mfma_f32_32x32x16_bf16(vf, pf[s], O[eb], 0, 0, 0);
        }
    }
    if (cur) {
      float tm = S[0][0];
#pragma unroll
      for (int i = 1; i < 16; ++i) tm = fmaxf(tm, S[0][i]);
#pragma unroll
      for (int i = 0; i < 16; ++i) tm = fmaxf(tm, S[1][i]);
      tm = fmaxf(tm, __shfl_xor(tm, 32)) * cs;
      float alpha = 1.f;
      if (tm > mrun + 8.0f) { alpha = __builtin_amdgcn_exp2f(mrun - tm); mrun = tm; }
      if (__any(alpha != 1.f)) {
#pragma unroll
        for (int eb = 0; eb < 4; ++eb)
#pragma unroll
          for (int i = 0; i < 16; ++i) O[eb][i] *= alpha;
        lrun *= alpha;
      }
      const float mc = mrun;
      float rs = 0.f;
#pragma unroll
      for (int kb = 0; kb < 2; ++kb) {
        float pv[16];
#pragma unroll
        for (int i = 0; i < 16; ++i) { pv[i] = __builtin_amdgcn_exp2f(fmaf(S[kb][i], cs, -mc)); rs += pv[i]; }
#pragma unroll
        for (int hh = 0; hh < 2; ++hh)
          pf[kb * 2 + hh] = __builtin_bit_cast(bf16x8, (u32x4){pack2(pv[8 * hh], pv[8 * hh + 1]), pack2(pv[8 * hh + 2], pv[8 * hh + 3]),
                                                                pack2(pv[8 * hh + 4], pv[8 * hh + 5]), pack2(pv[8 * hh + 6], pv[8 * hh + 7])});
      }
      lrun += rs;
    }
    if (nxt) {
      char* kd = smem + ((t + 1) & 1) * 16384;
#pragma unroll
      for (int i = 0; i < 4; ++i) *(u32x4*)(kd + kdst + i * 4096) = rk[i];
    }
    if (cur) {
      char* vd = smem + 32768 + (t & 1) * 16384;
#pragma unroll
      for (int i = 0; i < 4; ++i) {
        *(u32x2*)(vd + vdst0 + i * 4096) = (u32x2){rv[i][0], rv[i][1]};
        *(u32x2*)(vd + vdst1 + i * 4096) = (u32x2){rv[i][2], rv[i][3]};
      }
    }
    __syncthreads();
  }
  const float lt = lrun + __shfl_xor(lrun, 32);
  const float sc = (m ? lam : 1.0f) / lt;
  float* xo = (float*)smem + rb * 4096;
  if (m == 1) {
#pragma unroll
    for (int eb = 0; eb < 4; ++eb)
#pragma unroll
      for (int i = 0; i < 16; ++i) xo[(eb * 32 + (i & 3) + 8 * (i >> 2) + 4 * fh) * 32 + fr] = O[eb][i] * sc;
  }
  __syncthreads();
  if (m == 0) {
    float ss = 0.f;
#pragma unroll
    for (int eb = 0; eb < 4; ++eb)
#pragma unroll
      for (int i = 0; i < 16; ++i) {
        const float o = O[eb][i] * sc - xo[(eb * 32 + (i & 3) + 8 * (i >> 2) + 4 * fh) * 32 + fr];
        O[eb][i] = o; ss = fmaf(o, o, ss);
      }
    ss += __shfl_xor(ss, 32);
    const float rn = rsqrtf(ss * (1.0f / 128.0f) + EPSF) * (1.0f - lam_init);
    const float* sg = p.in[I_SUBG] + l * 512 + h * 128;
    bf16_t* yp = YAb + (size_t)myrow * 512 + h * 128;
#pragma unroll
    for (int eb = 0; eb < 4; ++eb)
#pragma unroll
      for (int q = 0; q < 4; ++q) {
        const int e = eb * 32 + 8 * q + 4 * fh;
        const float4 g = *(const float4*)(sg + e);
        *(u32x2*)(yp + e) = (u32x2){pack2(O[eb][4 * q] * rn * g.x, O[eb][4 * q + 1] * rn * g.y), pack2(O[eb][4 * q + 2] * rn * g.z, O[eb][4 * q + 3] * rn * g.w)};
      }
  }
  __syncthreads();
}

__device__ __forceinline__ int mlstm_row0(int dir, int c) {
  return (dir == 0) ? ((c < 4) ? NLAT + 64 * c : 64 * (c - 4)) : ((c < 4) ? NLAT + 64 * (3 - c) : 64 * (67 - c));
}
__device__ __forceinline__ void stage_mlgates(const Params& p, int l, const float* MGT, float* GA) {
  const int tid = otid(), w = tid >> 6, lane = tid & 63;
  const int nitems = GB * 4 * 2 * 68;
  for (int idx = blockIdx.x * 4 + w; idx < nitems; idx += gridDim.x * 4) {
    const int c = idx % 68, r1 = idx / 68, dir = r1 & 1, h = (r1 >> 1) & 3, bl = r1 >> 3;
    const int row = mlstm_row0(dir, c) + lane;
    const float* mg = MGT + ((size_t)bl * NTOK + row) * 16;
    const float li = mg[dir * 8 + h] + p.in[I_GATEB][l * 16 + dir * 8 + h];
    const float x = mg[dir * 8 + 4 + h] + p.in[I_GATEB][l * 16 + dir * 8 + 4 + h];
    const float lf = fminf(x, 0.f) - log1pf(expf(-fabsf(x)));
    float b = lf;
#pragma unroll
    for (int o = 1; o < 64; o <<= 1) {
      const float v = (dir == 0) ? __shfl_up(b, o) : __shfl_down(b, o);
      const bool ok = (dir == 0) ? (lane >= o) : (lane + o < 64);
      if (ok) b += v;
    }
    const float tot = (dir == 0) ? __shfl(b, 63) : __shfl(b, 0);
    float* ga = GA + (size_t)idx * 272;
    ga[lane] = b * 1.4426950408889634f; ga[64 + lane] = (li - b) * 1.4426950408889634f; ga[128 + lane] = expf(tot + li - b); ga[192 + lane] = expf(b);
    if (lane < 4) ga[256 + lane] = expf(tot);
  }
}

__device__ __forceinline__ void mlstm_chain_item(const Params& p, int l, const bf16_t* QMb, const bf16_t* KMb, const bf16_t* KMTb, const bf16_t* MVTb,
                                                 const float* GAc, bf16_t* HXb, int h, int dir, char* smem) {
  const int tid = otid(), lane = tid & 63, w = tid >> 6, fr = lane & 31, fh = lane >> 5;
  const int tb = w & 1, eh = w >> 1;
  float* fl = (float*)(smem + 98304);
  float* bs = fl; float* as_ = fl + 64; float* wgs = fl + 128; float* ebs = fl + 192; float* dec_s = fl + 256; float* nprev = fl + 272; float* npart = fl + 400;
  f32x16 CT[4];
#pragma unroll
  for (int eb = 0; eb < 4; ++eb)
#pragma unroll
    for (int i = 0; i < 16; ++i) CT[eb][i] = 0.f;
  __syncthreads();
  for (int i = tid; i < 2048; i += 256) ((u32x4*)(smem + 65536))[i] = (u32x4){0u, 0u, 0u, 0u};
  if (tid < 128) nprev[tid] = 0.f;
  const int qr = tid >> 4, qc = tid & 15;
  const int qdst = qr * 256 + ((qc ^ (qr & 15)) << 4);
  const int tr = tid >> 3, tc = tid & 7;
  const int tdst = tr * 128 + ((tc ^ ((tr >> 1) & 7)) << 4);
  const int sw16 = fr & 15, sw8 = (fr >> 1) & 7;
  u32x4 ra[4], rb[4], rc[4], rd[4];
  float4 rg = make_float4(0.f, 0.f, 0.f, 0.f);
  {
    const int row0 = mlstm_row0(dir, 0);
    const bf16_t* qs = QMb + (size_t)(row0 + qr) * 512 + h * 128 + qc * 8;
    const bf16_t* ks = KMb + (size_t)(row0 + qr) * 512 + h * 128 + qc * 8;
    const bf16_t* kts = KMTb + ((size_t)h * 128 + tr) * NTOK + row0 + tc * 8;
    const bf16_t* vts = MVTb + ((size_t)h * 128 + tr) * NTOK + row0 + tc * 8;
#pragma unroll
    for (int i = 0; i < 4; ++i) {
      ra[i] = *(const u32x4*)(qs + (size_t)i * 16 * 512);
      rb[i] = *(const u32x4*)(ks + (size_t)i * 16 * 512);
      rc[i] = *(const u32x4*)(kts + (size_t)i * 32 * NTOK);
      rd[i] = *(const u32x4*)(vts + (size_t)i * 32 * NTOK);
    }
    if (tid < 68) rg = ((const float4*)GAc)[tid];
  }
#pragma unroll 1
  for (int c = 0; c < 68; ++c) {
    const int row0 = mlstm_row0(dir, c);
    __syncthreads();
#pragma unroll
    for (int i = 0; i < 4; ++i) {
      *(u32x4*)(smem + qdst + i * 4096) = ra[i];
      *(u32x4*)(smem + 16384 + qdst + i * 4096) = rb[i];
      *(u32x4*)(smem + 32768 + tdst + i * 4096) = rc[i];
      *(u32x4*)(smem + 49152 + tdst + i * 4096) = rd[i];
    }
    if (tid < 68) ((float4*)fl)[tid] = rg;
    if (c + 1 < 68) {
      const int rown = mlstm_row0(dir, c + 1);
      const bf16_t* qs = QMb + (size_t)(rown + qr) * 512 + h * 128 + qc * 8;
      const bf16_t* ks = KMb + (size_t)(rown + qr) * 512 + h * 128 + qc * 8;
      const bf16_t* kts = KMTb + ((size_t)h * 128 + tr) * NTOK + rown + tc * 8;
      const bf16_t* vts = MVTb + ((size_t)h * 128 + tr) * NTOK + rown + tc * 8;
#pragma unroll
      for (int i = 0; i < 4; ++i) {
        ra[i] = *(const u32x4*)(qs + (size_t)i * 16 * 512);
        rb[i] = *(const u32x4*)(ks + (size_t)i * 16 * 512);
        rc[i] = *(const u32x4*)(kts + (size_t)i * 32 * NTOK);
        rd[i] = *(const u32x4*)(vts + (size_t)i * 32 * NTOK);
      }
      if (tid < 68) rg = ((const float4*)(GAc + (size_t)(c + 1) * 272))[tid];
    }
    __syncthreads();
    const int t = tb * 32 + fr;
    bf16x8 qf[8];
#pragma unroll
    for (int ks = 0; ks < 8; ++ks) qf[ks] = *(const bf16x8*)(smem + t * 256 + (((ks * 2 + fh) ^ sw16) << 4));
    const float bt = bs[t], ebt = ebs[t];
    f32x16 S[2];
    float dsum = 0.f;
#pragma unroll
    for (int sb = 0; sb < 2; ++sb) {
#pragma unroll
      for (int i = 0; i < 16; ++i) S[sb][i] = 0.f;
      const bool valid = (dir == 0) ? (sb <= tb) : (sb >= tb);
      if (valid) {
#pragma unroll
        for (int ks = 0; ks < 8; ++ks) {
          const bf16x8 kf = *(const bf16x8*)(smem + 16384 + (sb * 32 + fr) * 256 + (((ks * 2 + fh) ^ sw16) << 4));
          S[sb] = __builtin_amdgcn_mfma_f32_32x32x16_bf16(kf, qf[ks], S[sb], 0, 0, 0);
        }
#pragma unroll
        for (int q = 0; q < 4; ++q) {
          const float4 a4 = *(const float4*)(as_ + sb * 32 + 8 * q + 4 * fh);
          const float av[4] = {a4.x, a4.y, a4.z, a4.w};
#pragma unroll
          for (int j = 0; j < 4; ++j) {
            const int s = sb * 32 + 8 * q + 4 * fh + j;
            const bool ok = (dir == 0) ? (s <= t) : (s >= t);
            const float v = ok ? S[sb][4 * q + j] * __builtin_amdgcn_exp2f(bt + av[j]) : 0.f;
            S[sb][4 * q + j] = v;
            dsum += v;
          }
        }
      }
    }
    bf16x8 pf[4];
#pragma unroll
    for (int sb = 0; sb < 2; ++sb)
#pragma unroll
      for (int hh = 0; hh < 2; ++hh)
        pf[sb * 2 + hh] = __builtin_bit_cast(bf16x8, (u32x4){pack2(S[sb][8 * hh], S[sb][8 * hh + 1]), pack2(S[sb][8 * hh + 2], S[sb][8 * hh + 3]),
                                                                 pack2(S[sb][8 * hh + 4], S[sb][8 * hh + 5]), pack2(S[sb][8 * hh + 6], S[sb][8 * hh + 7])});
    float nq = 0.f;
#pragma unroll
    for (int c8 = 0; c8 < 8; ++c8) {
      const u32x4 qv = *(const u32x4*)(smem + t * 256 + (((fh * 8 + c8) ^ sw16) << 4));
      const float4 n0 = *(const float4*)(nprev + fh * 64 + c8 * 8), n1 = *(const float4*)(nprev + fh * 64 + c8 * 8 + 4);
      nq = fmaf(lo16(qv[0]), n0.x, nq); nq = fmaf(hi16(qv[0]), n0.y, nq); nq = fmaf(lo16(qv[1]), n0.z, nq); nq = fmaf(hi16(qv[1]), n0.w, nq);
      nq = fmaf(lo16(qv[2]), n1.x, nq); nq = fmaf(hi16(qv[2]), n1.y, nq); nq = fmaf(lo16(qv[3]), n1.z, nq); nq = fmaf(hi16(qv[3]), n1.w, nq);
    }
    dsum += __shfl_xor(dsum, 32);
    nq += __shfl_xor(nq, 32);
    const float den = dsum + ebt * nq;
    const float inv = 1.0f / fmaxf(fabsf(den), 1.0f);
#pragma unroll
    for (int x = 0; x < 2; ++x) {
      const int eb = 2 * eh + x;
      f32x16 N;
#pragma unroll
      for (int i = 0; i < 16; ++i) N[i] = 0.f;
#pragma unroll
      for (int ks = 0; ks < 8; ++ks) {
        const bf16x8 cf = *(const bf16x8*)(smem + 65536 + (eb * 32 + fr) * 256 + (((ks * 2 + fh) ^ sw16) << 4));
        N = __builtin_amdgcn_mfma_f32_32x32x16_bf16(cf, qf[ks], N, 0, 0, 0);
      }
#pragma unroll
      for (int i = 0; i < 16; ++i) N[i] *= ebt;
#pragma unroll
      for (int s4 = 0; s4 < 4; ++s4) {
        const bool valid = (dir == 0) ? ((s4 >> 1) <= tb) : ((s4 >> 1) >= tb);
        if (valid) {
          const int u0 = 4 * s4 + fh, u1 = u0 + 2;
          const char* vrow = smem + 49152 + (eb * 32 + fr) * 128;
          const u32x2 v0 = *(const u32x2*)(vrow + (((u0 >> 1) ^ sw8) << 4) + (u0 & 1) * 8);
          const u32x2 v1 = *(const u32x2*)(vrow + (((u1 >> 1) ^ sw8) << 4) + (u1 & 1) * 8);
          const bf16x8 vf = __builtin_bit_cast(bf16x8, (u32x4){v0[0], v0[1], v1[0], v1[1]});
          N = __builtin_amdgcn_mfma_f32_32x32x16_bf16(vf, pf[s4], N, 0, 0, 0);
        }
      }
      bf16_t* hp = HXb + (size_t)(row0 + t) * 512 + h * 128 + eb * 32 + 4 * fh;
#pragma unroll
      for (int q = 0; q < 4; ++q)
        *(u32x2*)(hp + 8 * q) = (u32x2){pack2(N[4 * q] * inv, N[4 * q + 1] * inv), pack2(N[4 * q + 2] * inv, N[4 * q + 3] * inv)};
    }
    const float decay = *dec_s;
#pragma unroll
    for (int eb = 0; eb < 4; ++eb)
#pragma unroll
      for (int i = 0; i < 16; ++i) CT[eb][i] *= decay;
#pragma unroll
    for (int ks = 0; ks < 4; ++ks) {
      const u32x4 kraw = *(const u32x4*)(smem + 32768 + (w * 32 + fr) * 128 + (((ks * 2 + fh) ^ sw8) << 4));
      const float4 g0 = *(const float4*)(wgs + ks * 16 + 8 * fh), g1 = *(const float4*)(wgs + ks * 16 + 8 * fh + 4);
      const bf16x8 kts = __builtin_bit_cast(bf16x8, (u32x4){pack2(lo16(kraw[0]) * g0.x, hi16(kraw[0]) * g0.y), pack2(lo16(kraw[1]) * g0.z, hi16(kraw[1]) * g0.w),
                                                             pack2(lo16(kraw[2]) * g1.x, hi16(kraw[2]) * g1.y), pack2(lo16(kraw[3]) * g1.z, hi16(kraw[3]) * g1.w)});
#pragma unroll
      for (int eb = 0; eb < 4; ++eb) {
        const bf16x8 vt = *(const bf16x8*)(smem + 49152 + (eb * 32 + fr) * 128 + (((ks * 2 + fh) ^ sw8) << 4));
        CT[eb] = __builtin_amdgcn_mfma_f32_32x32x16_bf16(kts, vt, CT[eb], 0, 0, 0);
      }
    }
    {
      const int d = tid & 127, sh = tid >> 7;
      float a = 0.f;
#pragma unroll 8
      for (int s = sh * 32; s < sh * 32 + 32; ++s) {
        const bf16_t kv = *(const bf16_t*)(smem + 16384 + s * 256 + ((((d >> 3)) ^ (s & 15)) << 4) + (d & 7) * 2);
        a = fmaf(wgs[s], bf2f(kv), a);
      }
      npart[sh * 128 + d] = a;
    }
    __syncthreads();
#pragma unroll
    for (int eb = 0; eb < 4; ++eb)
#pragma unroll
      for (int q = 0; q < 4; ++q)
        *(u32x2*)(smem + 65536 + (eb * 32 + fr) * 256 + ((((w * 4 + q)) ^ sw16) << 4) + 8 * fh) =
            (u32x2){pack2(CT[eb][4 * q], CT[eb][4 * q + 1]), pack2(CT[eb][4 * q + 2], CT[eb][4 * q + 3])};
    if (tid < 128) nprev[tid] = decay * nprev[tid] + npart[tid] + npart[128 + tid];
  }
  __syncthreads();
}

#define S5SEG 128
#define S5NSEG 34
__device__ __forceinline__ int s5_row(int dir, int step) {
  return (dir == 0) ? ((step < NCTX) ? NLAT + step : step - NCTX)
                    : ((step < NCTX) ? NLAT + (NCTX - 1 - step) : (NLAT - 1) - (step - NCTX));
}
__device__ __forceinline__ bf16x8 pack8(const float* f) {
  return __builtin_bit_cast(bf16x8, (u32x4){pack2(f[0], f[1]), pack2(f[2], f[3]), pack2(f[4], f[5]), pack2(f[6], f[7])});
}
struct S5M { float abr, abi, a128r, a128i; bf16x8 bbf[4]; };
__device__ __forceinline__ void s5m_setup(const Params& p, int pg, int lane, S5M& m) {
  const int fr = lane & 31, fh = lane >> 5;
  const float dt = expf(p.in[I_S5DT][pg]);
  m.abr = 0.f; m.abi = 0.f; m.a128r = 0.f; m.a128i = 0.f;
#pragma unroll
  for (int c = 0; c < 2; ++c) {
    const int n = fr + 32 * c;
    const float lre = p.in[I_S5LRE][pg * 64 + n], lim = p.in[I_S5LIM][pg * 64 + n];
    const float mag = expf(lre * dt);
    const float abr = mag * cosf(lim * dt), abi = mag * sinf(lim * dt);
    const float den = lre * lre + lim * lim;
    const float zr = ((abr - 1.0f) * lre + abi * lim) / den;
    const float zi = (abi * lre - (abr - 1.0f) * lim) / den;
    const float4* br4 = (const float4*)(p.in[I_S5BRE] + ((size_t)pg * 64 + n) * 16 + 8 * fh);
    const float4* bi4 = (const float4*)(p.in[I_S5BIM] + ((size_t)pg * 64 + n) * 16 + 8 * fh);
    const float4 b0 = br4[0], b1 = br4[1], c0 = bi4[0], c1 = bi4[1];
    const float br[8] = {b0.x, b0.y, b0.z, b0.w, b1.x, b1.y, b1.z, b1.w}, bi[8] = {c0.x, c0.y, c0.z, c0.w, c1.x, c1.y, c1.z, c1.w};
    float rr[8], ii[8];
#pragma unroll
    for (int j = 0; j < 8; ++j) { rr[j] = zr * br[j] - zi * bi[j]; ii[j] = zr * bi[j] + zi * br[j]; }
    m.bbf[c] = pack8(rr); m.bbf[2 + c] = pack8(ii);
    if (fh == c) {
      m.abr = abr; m.abi = abi;
      const float mg = expf(lre * dt * (float)S5SEG);
      m.a128r = mg * cosf(lim * dt * (float)S5SEG); m.a128i = mg * sinf(lim * dt * (float)S5SEG);
    }
  }
}
template <bool STORE>
__device__ __forceinline__ void s5m_block(const S5M& m, const bf16x8 uf, float& xr, float& xi, char* xs, int lane) {
  f32x16 T[4];
#pragma unroll
  for (int k = 0; k < 4; ++k) {
#pragma unroll
    for (int i = 0; i < 16; ++i) T[k][i] = 0.f;
    T[k] = __builtin_amdgcn_mfma_f32_32x32x16_bf16(uf, m.bbf[k], T[k], 0, 0, 0);
  }
#pragma unroll
  for (int r = 0; r < 16; ++r) {
    auto a = __builtin_amdgcn_permlane32_swap(__float_as_uint(T[0][r]), __float_as_uint(T[1][r]), false, false);
    T[0][r] = __uint_as_float(a[0]); T[1][r] = __uint_as_float(a[1]);
    auto b = __builtin_amdgcn_permlane32_swap(__float_as_uint(T[2][r]), __float_as_uint(T[3][r]), false, false);
    T[2][r] = __uint_as_float(b[0]); T[3][r] = __uint_as_float(b[1]);
  }
#pragma unroll
  for (int q = 0; q < 4; ++q)
#pragma unroll
    for (int hh = 0; hh < 2; ++hh)
#pragma unroll
      for (int j = 0; j < 4; ++j) {
        const int t = 8 * q + 4 * hh + j, r = 4 * q + j;
        const float bre = hh ? T[1][r] : T[0][r], bim = hh ? T[3][r] : T[2][r];
        const float nr = fmaf(m.abr, xr, fmaf(-m.abi, xi, bre));
        const float ni = fmaf(m.abr, xi, fmaf(m.abi, xr, bim));
        xr = nr; xi = ni;
        if (STORE) *(unsigned*)(xs + t * 256 + (((lane >> 2) ^ (t & 15)) << 4) + (lane & 3) * 4) = pack2(xr, xi);
      }
}
__device__ __forceinline__ void stage_s5_pass1(const Params& p, int l, const bf16_t* Z, float* XE) {
  const int tid = otid(), w = tid >> 6, lane = tid & 63, fr = lane & 31, fh = lane >> 5;
  const int nitems = GB * 32 * 2 * (S5NSEG - 1);
  for (int idx = blockIdx.x * 4 + w; idx < nitems; idx += gridDim.x * 4) {
    const int seg = idx % (S5NSEG - 1), r1 = idx / (S5NSEG - 1), dir = r1 & 1, g = (r1 >> 1) & 31, bl = r1 >> 6;
    S5M m;
    s5m_setup(p, (l * 2 + dir) * 32 + g, lane, m);
    float xr = 0.f, xi = 0.f;
#pragma unroll 1
    for (int sub = 0; sub < S5SEG / 32; ++sub) {
      const int row = s5_row(dir, seg * S5SEG + sub * 32 + fr);
      const bf16x8 uf = *(const bf16x8*)(Z + ((size_t)bl * NTOK + row) * ZW + 3072 + g * 16 + 8 * fh);
      s5m_block<false>(m, uf, xr, xi, nullptr, lane);
    }
    float* xe = XE + ((((size_t)bl * 32 + g) * 2 + dir) * (S5NSEG - 1) + seg) * 128;
    xe[lane] = xr; xe[64 + lane] = xi;
  }
}
__device__ __forceinline__ void s5_item(const Params& p, int l, const bf16_t* Zb, const float* XEc, float* Yb, int g, int dir, int sq, char* smem) {
  const int tid = otid(), w = tid >> 6, lane = tid & 63, fr = lane & 31, fh = lane >> 5;
  const int seg = sq * 4 + w;
  char* xs = smem + w * 8192;
  const int pg = (l * 2 + dir) * 32 + g;
  __syncthreads();
  if (seg < S5NSEG) {
    S5M m;
    s5m_setup(p, pg, lane, m);
    bf16x8 ccf[8];
#pragma unroll
    for (int ks = 0; ks < 8; ++ks) {
      float f[8] = {0.f, 0.f, 0.f, 0.f, 0.f, 0.f, 0.f, 0.f};
      if (fr < 16) {
        const float4 cr = *(const float4*)(p.in[I_S5CRE] + ((size_t)pg * 16 + fr) * 64 + ks * 8 + 4 * fh);
        const float4 ci = *(const float4*)(p.in[I_S5CIM] + ((size_t)pg * 16 + fr) * 64 + ks * 8 + 4 * fh);
        f[0] = cr.x; f[1] = -ci.x; f[2] = cr.y; f[3] = -ci.y; f[4] = cr.z; f[5] = -ci.z; f[6] = cr.w; f[7] = -ci.w;
      }
      ccf[ks] = pack8(f);
    }
    float xr = 0.f, xi = 0.f;
    for (int j = 0; j < seg; ++j) {
      const float er = XEc[j * 128 + lane], ei = XEc[j * 128 + 64 + lane];
      const float nr = m.a128r * xr - m.a128i * xi + er, ni = m.a128r * xi + m.a128i * xr + ei;
      xr = nr; xi = ni;
    }
#pragma unroll 1
    for (int sub = 0; sub < S5SEG / 32; ++sub) {
      const int row = s5_row(dir, seg * S5SEG + sub * 32 + fr);
      const bf16x8 uf = *(const bf16x8*)(Zb + (size_t)row * ZW + 3072 + g * 16 + 8 * fh);
      s5m_block<true>(m, uf, xr, xi, xs, lane);
      f32x16 Y;
#pragma unroll
      for (int i = 0; i < 16; ++i) Y[i] = 0.f;
#pragma unroll
      for (int ks = 0; ks < 8; ++ks) {
        const bf16x8 xf = *(const bf16x8*)(xs + fr * 256 + (((ks * 2 + fh) ^ (fr & 15)) << 4));
        Y = __builtin_amdgcn_mfma_f32_32x32x16_bf16(ccf[ks], xf, Y, 0, 0, 0);
      }
      float* yp = Yb + (size_t)row * 512 + g * 16 + 4 * fh;
      *(float4*)yp = make_float4(Y[0], Y[1], Y[2], Y[3]);
      *(float4*)(yp + 8) = make_float4(Y[4], Y[5], Y[6], Y[7]);
    }
  }
}

__device__ __forceinline__ void stage_post(const Params& p, int l, int rr_lim, const bf16_t* Z, const bf16_t* HF, const bf16_t* HB,
                                           const float* YSF, const float* YSB, bf16_t* YB, bf16_t* GG) {
  const int tid = otid();
  const int c0 = tid * 2;
  for (int i = blockIdx.x; i < GB * rr_lim; i += gridDim.x) {
    const size_t r = (size_t)(i / rr_lim) * NTOK + (i % rr_lim);
    {
      const unsigned a0 = *(const unsigned*)(HF + r * 512 + c0), a1 = *(const unsigned*)(HB + r * 512 + c0);
      float h0 = lo16(a0) + lo16(a1), h1 = hi16(a0) + hi16(a1);
      float ss = wave_sum(h0 * h0 + h1 * h1);
      float rs = rsqrtf(ss * (1.0f / 128.0f) + EPSF);
      float2 g = *(const float2*)(p.in[I_MLNG] + l * 512 + c0);
      const unsigned og = *(const unsigned*)(Z + r * ZW + 2560 + c0);
      *(unsigned*)(YB + r * 512 + c0) = pack2(h0 * rs * g.x * sigmoidf_(lo16(og)), h1 * rs * g.y * sigmoidf_(hi16(og)));
    }
    {
      const unsigned u = *(const unsigned*)(Z + r * ZW + 3072 + c0);
      float2 d = *(const float2*)(p.in[I_S5D] + l * 512 + c0);
      float2 f = *(const float2*)(YSF + r * 512 + c0);
      float2 b = *(const float2*)(YSB + r * 512 + c0);
      *(unsigned*)(GG + r * 512 + c0) = pack2(geluf_(d.x * lo16(u) + f.x + b.x), geluf_(d.y * hi16(u) + f.y + b.y));
    }
  }
}

__device__ __forceinline__ void stage_glu_mfma(const Params& p, int l, int tpb, const bf16_t* GG, const bf16_t* GLUT, bf16_t* YS, char* smem) {
  EPI_DECL
  const int tm = GB * tpb;
  TileIter ti(tm, 4);
  int mt_, nt_; bool valid;
  while (ti.next(mt_, nt_, valid)) {
    if (!valid) continue;
    const int m0 = MT_LR0(mt_, tpb), n0 = nt_ * 128;
    f32x16 acc[2][2];
    gemm_tile(GG + (size_t)m0 * 512, 512, GLUT + (size_t)n0 * 512, 512, 512, smem, acc);
#pragma unroll
    for (int mi = 0; mi < 2; ++mi)
#pragma unroll
      for (int ni = 0; ni < 2; ++ni)
#pragma unroll
        for (int q = 0; q < 4; ++q) {
          const int row = m0 + EPI_ROW(mi), c = n0 + EPI_COL(ni, q);
          const float4 b = *(const float4*)(p.in[I_GLUB] + l * 512 + c);
          const u32x2 g2 = *(const u32x2*)(GG + (size_t)row * 512 + c);
          const float o0 = lo16(g2[0]) * sigmoidf_(acc[mi][ni][4 * q] + b.x), o1 = hi16(g2[0]) * sigmoidf_(acc[mi][ni][4 * q + 1] + b.y);
          const float o2 = lo16(g2[1]) * sigmoidf_(acc[mi][ni][4 * q + 2] + b.z), o3 = hi16(g2[1]) * sigmoidf_(acc[mi][ni][4 * q + 3] + b.w);
          *(u32x2*)(YS + (size_t)row * 512 + c) = (u32x2){pack2(o0, o1), pack2(o2, o3)};
        }
  }
}

__device__ __forceinline__ void stage_merge_mfma(int tpb, const bf16_t* YA, const bf16_t* YB, const bf16_t* YS, const bf16_t* WBR, const bf16_t* Z, bf16_t* MG, char* smem) {
  EPI_DECL
  const int tm = GB * tpb;
  TileIter ti(tm, 8);
  int mt_, nt_; bool valid;
  while (ti.next(mt_, nt_, valid)) {
    if (!valid) continue;
    const int m0 = MT_LR0(mt_, tpb), n0 = nt_ * 128;
    f32x16 macc[2][2];
#pragma unroll
    for (int a = 0; a < 2; ++a)
#pragma unroll
      for (int b = 0; b < 2; ++b)
#pragma unroll
        for (int i = 0; i < 16; ++i) macc[a][b][i] = 0.f;
#pragma unroll 1
    for (int r = 0; r < 3; ++r) {
      const bf16_t* Y = (r == 0) ? YA : (r == 1 ? YB : YS);
      f32x16 acc[2][2];
      gemm_tile(Y + (size_t)m0 * 512, 512, WBR + (size_t)r * 1024 * 512 + (size_t)n0 * 512, 512, 512, smem, acc);
#pragma unroll
      for (int mi = 0; mi < 2; ++mi)
#pragma unroll
        for (int ni = 0; ni < 2; ++ni)
#pragma unroll
          for (int q = 0; q < 4; ++q) {
            const int row = m0 + EPI_ROW(mi), c = n0 + EPI_COL(ni, q);
            const u32x2 e = *(const u32x2*)(Z + (size_t)row * ZW + 3584 + r * 1024 + c);
            macc[mi][ni][4 * q] += lo16(e[0]) * acc[mi][ni][4 * q];
            macc[mi][ni][4 * q + 1] += hi16(e[0]) * acc[mi][ni][4 * q + 1];
            macc[mi][ni][4 * q + 2] += lo16(e[1]) * acc[mi][ni][4 * q + 2];
            macc[mi][ni][4 * q + 3] += hi16(e[1]) * acc[mi][ni][4 * q + 3];
          }
    }
#pragma unroll
    for (int mi = 0; mi < 2; ++mi)
#pragma unroll
      for (int ni = 0; ni < 2; ++ni)
#pragma unroll
        for (int q = 0; q < 4; ++q) {
          const int row = m0 + EPI_ROW(mi), c = n0 + EPI_COL(ni, q);
          *(u32x2*)(MG + (size_t)row * DM + c) = (u32x2){pack2(macc[mi][ni][4 * q], macc[mi][ni][4 * q + 1]), pack2(macc[mi][ni][4 * q + 2], macc[mi][ni][4 * q + 3])};
        }
  }
}

__device__ __forceinline__ void stage_outproj_mfma(const Params& p, int l, int g, int tpb, const bf16_t* MG, const bf16_t* WOUT, char* smem) {
  EPI_DECL
  const int tm = GB * tpb;
  const float* mod = (const float*)(p.ws + WB_MOD) + (size_t)l * 9 * 6144;
  TileIter ti(tm, 8);
  int mt, nt_; bool valid;
  while (ti.next(mt, nt_, valid)) {
    if (!valid) continue;
    const int n0 = nt_ * 128;
    const int m0 = MT_LR0(mt, tpb), bl = mt / tpb, rr0 = (mt % tpb) * 128, b = g * GB + bl;
    f32x16 acc[2][2];
    gemm_tile(MG + (size_t)m0 * DM, DM, WOUT + (size_t)n0 * DM, DM, DM, smem, acc);
    const float* gv = mod + (size_t)((rr0 < NLAT) ? b : 8) * 6144 + 2 * 1024;
#pragma unroll
    for (int mi = 0; mi < 2; ++mi)
#pragma unroll
      for (int ni = 0; ni < 2; ++ni)
#pragma unroll
        for (int q = 0; q < 4; ++q) {
          const int rr = rr0 + EPI_ROW(mi), c = n0 + EPI_COL(ni, q);
          const float4 gg = *(const float4*)(gv + c);
          float4* xp = (float4*)(xrow(p, b, rr) + c);
          float4 x = *xp;
          x.x += gg.x * acc[mi][ni][4 * q]; x.y += gg.y * acc[mi][ni][4 * q + 1]; x.z += gg.z * acc[mi][ni][4 * q + 2]; x.w += gg.w * acc[mi][ni][4 * q + 3];
          *xp = x;
        }
  }
}

__device__ __forceinline__ void stage_peerq_mfma(int tpb, const bf16_t* H2, const bf16_t* WQ, bf16_t* PQ, char* smem) {
  EPI_DECL
  const int tm = GB * tpb;
  TileIter ti(tm, 16);
  int mt_, nt_; bool valid;
  while (ti.next(mt_, nt_, valid)) {
    if (!valid) continue;
    const int m0 = MT_LR0(mt_, tpb), n0 = nt_ * 128;
    f32x16 acc[2][2];
    gemm_tile(H2 + (size_t)m0 * DM, DM, WQ + (size_t)n0 * DM, DM, DM, smem, acc);
#pragma unroll
    for (int mi = 0; mi < 2; ++mi)
#pragma unroll
      for (int ni = 0; ni < 2; ++ni)
#pragma unroll
        for (int q = 0; q < 4; ++q) {
          const int row = m0 + EPI_ROW(mi), c = n0 + EPI_COL(ni, q);
          *(u32x2*)(PQ + (size_t)row * 2048 + c) = (u32x2){pack2(acc[mi][ni][4 * q], acc[mi][ni][4 * q + 1]), pack2(acc[mi][ni][4 * q + 2], acc[mi][ni][4 * q + 3])};
        }
  }
}

__device__ __forceinline__ void stage_scores_mfma(int tpb, const bf16_t* PQ, const bf16_t* SUBK, float* SCT, char* smem) {
  EPI_DECL
  const int tm = GB * tpb * 8;
  for (int t = blockIdx.x; t < tm * 2; t += gridDim.x) {
    const int mt = t >> 1, half = t & 1;
    const size_t m0 = (size_t)MT_LR0(mt >> 3, tpb) * 8 + (size_t)(mt & 7) * 128;
    f32x16 acc[2][2];
    gemm_tile(SUBK + (size_t)half * 16384, 128, PQ + m0 * 256 + half * 128, 256, 128, smem, acc);
    float* o = SCT + ((size_t)mt * 2 + half) * 16384;
#pragma unroll
    for (int mi = 0; mi < 2; ++mi)
#pragma unroll
      for (int ni = 0; ni < 2; ++ni)
#pragma unroll
        for (int q = 0; q < 4; ++q) {
          const int key = EPI_ROW(mi), item = EPI_COL(ni, q);
          *(float4*)(o + key * 128 + item) = make_float4(acc[mi][ni][4 * q], acc[mi][ni][4 * q + 1], acc[mi][ni][4 * q + 2], acc[mi][ni][4 * q + 3]);
        }
  }
}

__device__ __forceinline__ unsigned f2sortable(float x) { const unsigned u = __float_as_uint(x); return (u & 0x80000000u) ? ~u : (u | 0x80000000u); }
__device__ __forceinline__ float sortable2f(unsigned k) { return __uint_as_float((k & 0x80000000u) ? (k & 0x7fffffffu) : ~k); }
#define TOPK_INSERT(v, key) { unsigned t_ = (key); _Pragma("unroll") for (int s_ = 0; s_ < 16; ++s_) { const unsigned hi_ = max(v[s_], t_); t_ = min(v[s_], t_); v[s_] = hi_; } }
__device__ __forceinline__ void stage_topk(int tpb, const float* SCT, int* EI, float* EG, float* smem) {
  const int tid = otid();
  const int item = tid & 127, half = tid >> 7;
  unsigned* xk = (unsigned*)smem;
  const int tm = GB * tpb * 8;
  for (int mt = blockIdx.x; mt < tm; mt += gridDim.x) {
    const size_t m0 = (size_t)MT_LR0(mt >> 3, tpb) * 8 + (size_t)(mt & 7) * 128;
    const float* sc = SCT + ((size_t)mt * 2 + half) * 16384 + item;
    unsigned v[16];
#pragma unroll
    for (int s = 0; s < 16; ++s) v[s] = 0u;
#pragma unroll 4
    for (int k = 0; k < 128; ++k) {
      const unsigned key = (f2sortable(sc[k * 128]) & ~127u) | (unsigned)(127 - k);
      TOPK_INSERT(v, key)
    }
    __syncthreads();
    if (half == 1) {
#pragma unroll
      for (int s = 0; s < 16; ++s) xk[item * 17 + s] = v[s];
    }
    __syncthreads();
    if (half == 0) {
      float v1[16], v2[16];
      unsigned k2[16];
#pragma unroll
      for (int s = 0; s < 16; ++s) { k2[s] = xk[item * 17 + s]; v1[s] = sortable2f((v[s] & ~127u) | 64u); v2[s] = sortable2f((k2[s] & ~127u) | 64u); }
      unsigned c[16];
#pragma unroll
      for (int s = 0; s < 16; ++s) c[s] = 0u;
      {
        int o = 0;
#pragma unroll
        for (int i = 0; i < 16; ++i)
#pragma unroll
          for (int j = 0; j < 16 / (i + 1); ++j) {
            const unsigned key = (f2sortable(v1[i] + v2[j]) & ~63u) | (unsigned)(63 - o);
            TOPK_INSERT(c, key)
            ++o;
          }
      }
      const float vmax = sortable2f((c[0] & ~63u) | 32u);
      float sum = 0.f;
#pragma unroll
      for (int s = 0; s < 16; ++s) sum += expf(sortable2f((c[s] & ~63u) | 32u) - vmax);
      const float isum = 1.0f / sum;
      const unsigned thr = c[15];
      int* ei = EI + (m0 + item) * 16;
      float* eg = EG + (m0 + item) * 16;
      int cntw = 0;
      {
        int o = 0;
#pragma unroll
        for (int i = 0; i < 16; ++i)
#pragma unroll
          for (int j = 0; j < 16 / (i + 1); ++j) {
            const unsigned key = (f2sortable(v1[i] + v2[j]) & ~63u) | (unsigned)(63 - o);
            if (key >= thr) {
              ei[cntw] = (int)((127u - (v[i] & 127u)) * 128u + (127u - (k2[j] & 127u)));
              eg[cntw] = expf(sortable2f((key & ~63u) | 32u) - vmax) * isum;
              ++cntw;
            }
            ++o;
          }
      }
    }
  }
  __syncthreads();
}

__device__ __forceinline__ void unpack8(const u32x4 v, float* f) {
#pragma unroll
  for (int k = 0; k < 4; ++k) { f[2 * k] = lo16(v[k]); f[2 * k + 1] = hi16(v[k]); }
}
__device__ __forceinline__ void unpack16_fp8(const u32x4 v, float* f) {
#pragma unroll
  for (int k = 0; k < 4; ++k) {
    const f32x2 a = __builtin_amdgcn_cvt_pk_f32_fp8((int)v[k], false), b = __builtin_amdgcn_cvt_pk_f32_fp8((int)v[k], true);
    f[4 * k] = a[0]; f[4 * k + 1] = a[1]; f[4 * k + 2] = b[0]; f[4 * k + 3] = b[1];
  }
}
__device__ __forceinline__ void stage_expert(const Params& p, int l, int g, int rr_lim, const bf16_t* H2, const int* EI, const float* EG, float* smem) {
  const int tid = otid(), w = tid >> 6, lane = tid & 63;
  float* part = smem;
  const unsigned char* U = (const unsigned char*)(p.ws + WB_U16) + (size_t)l * 16384 * 1024;
  const unsigned char* V = (const unsigned char*)(p.ws + WB_V16) + (size_t)l * 16384 * 1024;
  const float* mod = (const float*)(p.ws + WB_MOD) + (size_t)l * 9 * 6144;
  const int ntok = GB * rr_lim;
  int nx_e = 0; float nx_g = 0.f; u32x4 nx_h0 = {0u, 0u, 0u, 0u}, nx_h1 = {0u, 0u, 0u, 0u};
  if ((int)blockIdx.x < ntok) {
    const size_t t0 = (size_t)((int)blockIdx.x / rr_lim) * NTOK + ((int)blockIdx.x % rr_lim);
    nx_e = EI[t0 * 128 + w * 32 + (lane & 31)]; nx_g = EG[t0 * 128 + w * 32 + (lane & 31)];
    nx_h0 = ((const u32x4*)(H2 + t0 * DM))[2 * lane]; nx_h1 = ((const u32x4*)(H2 + t0 * DM))[2 * lane + 1];
  }
  for (int i = blockIdx.x; i < ntok; i += gridDim.x) {
    const int bl = i / rr_lim, rr = i % rr_lim, b = g * GB + bl;
    const int my_e = nx_e; const float my_g = nx_g;
    float hf[16];
    unpack8(nx_h0, hf); unpack8(nx_h1, hf + 8);
    {
      const int i2 = i + gridDim.x;
      if (i2 < ntok) {
        const size_t t2 = (size_t)(i2 / rr_lim) * NTOK + (i2 % rr_lim);
        nx_e = EI[t2 * 128 + w * 32 + (lane & 31)]; nx_g = EG[t2 * 128 + w * 32 + (lane & 31)];
        nx_h0 = ((const u32x4*)(H2 + t2 * DM))[2 * lane]; nx_h1 = ((const u32x4*)(H2 + t2 * DM))[2 * lane + 1];
      }
    }
    float my_dot = 0.f;
    {
      u32x4 ra[32];
#pragma unroll
      for (int j = 0; j < 32; ++j) {
        const int e = __builtin_amdgcn_readlane(my_e, j);
        ra[j] = ((const u32x4*)(U + (size_t)e * 1024))[lane];
      }
#pragma unroll
      for (int j = 0; j < 32; ++j) {
        float f[16];
        unpack16_fp8(ra[j], f);
        float a = 0.f;
#pragma unroll
        for (int q = 0; q < 16; ++q) a = fmaf(hf[q], f[q], a);
        a = wave_sum(a);
        if ((lane & 31) == j) my_dot = a;
      }
    }
    const float my_c = my_g * geluf_(my_dot * (1.0f / 32.0f));
    float acc[16];
#pragma unroll
    for (int q = 0; q < 16; ++q) acc[q] = 0.f;
    {
      u32x4 ra[32];
#pragma unroll
      for (int j = 0; j < 32; ++j) {
        const int e = __builtin_amdgcn_readlane(my_e, j);
        ra[j] = ((const u32x4*)(V + (size_t)e * 1024))[lane];
      }
#pragma unroll
      for (int j = 0; j < 32; ++j) {
        const float c = __uint_as_float(__builtin_amdgcn_readlane(__float_as_uint(my_c), j));
        float f[16];
        unpack16_fp8(ra[j], f);
#pragma unroll
        for (int q = 0; q < 16; ++q) acc[q] = fmaf(c, f[q], acc[q]);
      }
    }
    __syncthreads();
    {
      float4* pw = (float4*)(part + w * 1024 + lane * 16);
      pw[0] = make_float4(acc[0], acc[1], acc[2], acc[3]); pw[1] = make_float4(acc[4], acc[5], acc[6], acc[7]);
      pw[2] = make_float4(acc[8], acc[9], acc[10], acc[11]); pw[3] = make_float4(acc[12], acc[13], acc[14], acc[15]);
    }
    __syncthreads();
    const float4 s0 = ((const float4*)part)[tid], s1 = ((const float4*)(part + 1024))[tid], s2 = ((const float4*)(part + 2048))[tid], s3 = ((const float4*)(part + 3072))[tid];
    const float4 g2 = ((const float4*)(mod + (size_t)((rr < NLAT) ? b : 8) * 6144 + 5 * 1024))[tid];
    float4* xp = (float4*)xrow(p, b, rr) + tid;
    float4 xv = *xp;
    xv.x += g2.x * (s0.x + s1.x + s2.x + s3.x); xv.y += g2.y * (s0.y + s1.y + s2.y + s3.y);
    xv.z += g2.z * (s0.z + s1.z + s2.z + s3.z); xv.w += g2.w * (s0.w + s1.w + s2.w + s3.w);
    *xp = xv;
  }
  __syncthreads();
}

__device__ __forceinline__ void stage_final(const Params& p, float* smem) {
  const int tid = otid();
  for (int r = blockIdx.x; r < NB * NLAT; r += gridDim.x) {
    float4* xp = (float4*)(p.out + (size_t)r * DM) + tid;
    float4 v = *xp;
    float s = wave_sum(v.x * v.x + v.y * v.y + v.z * v.z + v.w * v.w);
    __syncthreads();
    if ((tid & 63) == 0) smem[tid >> 6] = s;
    __syncthreads();
    float rs = rsqrtf((smem[0] + smem[1] + smem[2] + smem[3]) * (1.0f / DM) + EPSF);
    float4 g = ((const float4*)p.in[I_FG])[tid];
    *xp = make_float4(v.x * rs * g.x, v.y * rs * g.y, v.z * rs * g.z, v.w * rs * g.w);
  }
}


__device__ __forceinline__ void gbar(unsigned* ctr, unsigned& epoch) {
  asm volatile("s_waitcnt vmcnt(0)" ::: "memory");
  __syncthreads();
  epoch += gridDim.x;
  if (threadIdx.x == 0) {
    __builtin_amdgcn_fence(__ATOMIC_RELEASE, "agent");
    asm volatile("s_waitcnt vmcnt(0)" ::: "memory");
    __hip_atomic_fetch_add(ctr, 1u, __ATOMIC_RELAXED, __HIP_MEMORY_SCOPE_AGENT);
    while (__hip_atomic_load(ctr, __ATOMIC_RELAXED, __HIP_MEMORY_SCOPE_AGENT) < epoch) __builtin_amdgcn_s_sleep(2);
    __builtin_amdgcn_fence(__ATOMIC_ACQUIRE, "agent");
    asm volatile("s_waitcnt vmcnt(0)" ::: "memory");
  }
  __syncthreads();
}

__global__ void __launch_bounds__(256) mega(Params p) {
  cg::grid_group grid = cg::this_grid();
  __shared__ __attribute__((aligned(16))) float smem[SMEM_FLOATS];
  char* smc = (char*)smem;
  char* ws = p.ws;
  bf16_t* H = (bf16_t*)(ws + WB_H); bf16_t* Z = (bf16_t*)(ws + WB_Z); float* MGT = (float*)(ws + WB_MGT); bf16_t* XC = (bf16_t*)(ws + WB_XC);
  bf16_t* QM = (bf16_t*)(ws + WB_QM); bf16_t* KM = (bf16_t*)(ws + WB_KM); bf16_t* KMT = (bf16_t*)(ws + WB_KMT); bf16_t* MVT = (bf16_t*)(ws + WB_MVT);
  bf16_t* HF = (bf16_t*)(ws + WB_HF); bf16_t* HB = (bf16_t*)(ws + WB_HB);
  bf16_t* VT = (bf16_t*)(ws + WB_VT); float* YSF = (float*)(ws + WB_YSF); float* YSB = (float*)(ws + WB_YSB);
  bf16_t* YA = (bf16_t*)(ws + WB_YA); bf16_t* YB = (bf16_t*)(ws + WB_YB); bf16_t* YS = (bf16_t*)(ws + WB_YS); bf16_t* GG = (bf16_t*)(ws + WB_GG);
  bf16_t* MG = (bf16_t*)(ws + WB_MG); bf16_t* PQ = (bf16_t*)(ws + WB_PQ); float* SC = (float*)(ws + WB_SC);
  int* EI = (int*)(ws + WB_EI); float* EG = (float*)(ws + WB_EG); float* XE = (float*)(ws + WB_XE); float* GA = (float*)(ws + WB_GA);
  const bf16_t* WT = (const bf16_t*)(ws + WB_WT);

  unsigned* bar = (unsigned*)(ws + WB_BAR);
  unsigned epoch = 0;
  stage_init(p, smem);
  grid.sync();

  for (int l = 0; l < 2; ++l) {
    const bool need_ctx = (l == 0);
    const int rr_lim = need_ctx ? NTOK : NLAT;
    const int tpb = need_ctx ? 34 : 32;
    const bf16_t* W = WT + (size_t)l * WT_LAYER;
    const float lam_init = 0.8f - 0.6f * expf(-0.3f * (float)l);
    float lam;
    {
      float s1 = 0.f, s2 = 0.f;
      for (int i = 0; i < 64; ++i) {
        s1 += p.in[I_LQ1][l * 64 + i] * p.in[I_LK1][l * 64 + i];
        s2 += p.in[I_LQ2][l * 64 + i] * p.in[I_LK2][l * 64 + i];
      }
      lam = expf(s1) - expf(s2) + lam_init;
    }
    for (int g = 0; g < NG; ++g) {
      stage_normmod(p, l, g, 0, NTOK, H, smem);
      gbar(bar, epoch);
      stage_inproj(p, H, W + WT_WIN, Z, MGT, VT, MVT, smc);
      gbar(bar, epoch);
      stage_conv(p, l, Z, XC);
      stage_s5_pass1(p, l, Z, XE);
      gbar(bar, epoch);
      stage_mlqk(XC, W + WT_WQK, QM, KM, KMT, smc);
      stage_mlgates(p, l, MGT, GA);
      gbar(bar, epoch);
      {
        const int n_attn = 4 * 64 + (need_ctx ? 4 * 4 : 0);
        const int n_s5 = 32 * 2 * 9;
        const int n_items = GB * (8 + n_attn + n_s5);
        int* cnt = (int*)(ws + WB_CNT) + (l * NG + g);
        int* s_item = (int*)(smem + SMEM_FLOATS - 4);
        for (;;) {
          __syncthreads();
          if (otid() == 0) *s_item = atomicAdd(cnt, 1);
          __syncthreads();
          const int it = *s_item;
          if (it >= n_items) break;
          int bl, k;
          if (it < GB * 8) { bl = it / 8; k = it % 8; }
          else if (it < GB * (8 + n_attn)) { bl = (it - GB * 8) / n_attn; k = 8 + (it - GB * 8) % n_attn; }
          else { bl = (it - GB * (8 + n_attn)) / n_s5; k = 8 + n_attn + (it - GB * (8 + n_attn)) % n_s5; }
          const bf16_t* Zb = Z + (size_t)bl * NTOK * ZW;
          const size_t ro = (size_t)bl * NTOK;
          if (k < 8) {
            mlstm_chain_item(p, l, QM + ro * 512, KM + ro * 512, KMT + (size_t)bl * 4 * 128 * NTOK, MVT + (size_t)bl * 4 * 128 * NTOK, GA + (size_t)(((bl * 4 + (k & 3)) * 2 + (k >> 2)) * 68) * 272,
                             ((k >> 2) ? HB : HF) + ro * 512, k & 3, k >> 2, smc);
          } else if (k < 8 + n_attn) {
            const int a = k - 8;
            const bf16_t* VTb = VT + (size_t)bl * 4 * 128 * NTOK;
            if (a < 256) attn_mfma_item(p, l, Zb, VTb, YA + ro * 512, a & 3, (a >> 2) * 64, 0, NTOK, lam, lam_init, smc);
            else attn_mfma_item(p, l, Zb, VTb, YA + ro * 512, (a - 256) & 3, NLAT + ((a - 256) >> 2) * 64, NLAT, NCTX, lam, lam_init, smc);
          } else {
            const int a = k - 8 - n_attn;
            const int sq = a % 9, dir = (a / 9) & 1, gg = a / 18;
            s5_item(p, l, Zb, XE + (((size_t)bl * 32 + gg) * 2 + dir) * (S5NSEG - 1) * 128, (dir ? YSB : YSF) + ro * 512, gg, dir, sq, smc);
          }
        }
      }
      gbar(bar, epoch);
      stage_post(p, l, rr_lim, Z, HF, HB, YSF, YSB, YB, GG);
      gbar(bar, epoch);
      stage_glu_mfma(p, l, tpb, GG, W + WT_GLU, YS, smc);
      gbar(bar, epoch);
      stage_merge_mfma(tpb, YA, YB, YS, W + WT_WBR, Z, MG, smc);
      gbar(bar, epoch);
      stage_outproj_mfma(p, l, g, tpb, MG, W + WT_WOUT, smc);
      gbar(bar, epoch);
      stage_normmod(p, l, g, 1, rr_lim, H, smem);
      gbar(bar, epoch);
      stage_peerq_mfma(tpb, H, W + WT_WQ, PQ, smc);
      gbar(bar, epoch);
      stage_scores_mfma(tpb, PQ, W + WT_SUBK, SC, smc);
      gbar(bar, epoch);
      stage_topk(tpb, SC, EI, EG, smem);
      gbar(bar, epoch);
      stage_expert(p, l, g, rr_lim, H, EI, EG, smem);
      gbar(bar, epoch);
    }
  }
  stage_final(p, smem);
}

extern "C" void kernel_launch(void* const* d_in, const int* in_sizes, int n_in, void* d_out,
                              int out_size, void* d_ws, size_t ws_size, hipStream_t stream) {
  static int grid_blocks = 0;
  if (!grid_blocks) {
    int dev = 0, cus = 0, per_cu = 0;
    (void)hipGetDevice(&dev);
    (void)hipDeviceGetAttribute(&cus, hipDeviceAttributeMultiprocessorCount, dev);
    (void)hipOccupancyMaxActiveBlocksPerMultiprocessor(&per_cu, mega, 256, 0);
    if (per_cu > 1) per_cu = 1;
    grid_blocks = cus * per_cu;
  }
  if (ws_size < WB_END) {
    fprintf(stderr, "workspace too small: %zu < %zu\n", ws_size, (size_t)WB_END);
    return;
  }
  Params p{};
  for (int i = 0; i < N_IN; ++i) p.in[i] = (const float*)d_in[i];
  p.out = (float*)d_out;
  p.ws = (char*)d_ws;
  (void)hipMemsetAsync((char*)d_ws + WB_BAR, 0, 256, stream);
  void* args[] = {&p};
  hipError_t e = hipLaunchCooperativeKernel((void*)mega, dim3(grid_blocks), dim3(256), args, 0, stream);
  if (e != hipSuccess) fprintf(stderr, "cooperative launch failed: %s (grid %d)\n", hipGetErrorString(e), grid_blocks);
}
```

```cpp
#include <hip/hip_runtime.h>
#include <hip/hip_cooperative_groups.h>
#include <cstdio>
#include <cstdint>
namespace cg = cooperative_groups;

#define NLAT 4096
#define NCTX 256
#define NTOK 4352
#define DM 1024
#define INW 6672
#define NB 8
#define GB 2
#define NG (NB / GB)
#define RPG (GB * NTOK)
#define ZW 6656
#define EPSF 1e-6f

enum { I_X = 0, I_C, I_CTX, I_CCTX, I_WMOD, I_BMOD, I_N1G, I_N2G, I_WIN, I_LQ1, I_LK1, I_LQ2, I_LK2, I_SUBG,
       I_CONVW, I_CONVB, I_MLWQ, I_MLWK, I_GATEB, I_MLNG, I_S5LRE, I_S5LIM, I_S5DT, I_S5BRE, I_S5BIM,
       I_S5CRE, I_S5CIM, I_S5D, I_GLUW, I_GLUB, I_WBR, I_WOUT, I_PWQ, I_PSUBK, I_PU, I_PV, I_FG, N_IN };

struct Params {
  const float* in[N_IN];
  float* out;
  char* ws;
};

typedef unsigned short bf16_t;
typedef short bf16x8 __attribute__((ext_vector_type(8)));
typedef float f32x16 __attribute__((ext_vector_type(16)));
typedef unsigned u32x4 __attribute__((ext_vector_type(4)));
typedef unsigned u32x2 __attribute__((ext_vector_type(2)));

#define AL(x) (((x) + 255) & ~(size_t)255)
#define WB_XCX   ((size_t)0)
#define WB_MOD   AL(WB_XCX + (size_t)NB * NCTX * DM * 4)
#define WB_ROPE  AL(WB_MOD + (size_t)2 * 9 * 6144 * 4)
#define WB_WT    AL(WB_ROPE + (size_t)NLAT * 32 * 2 * 4)
#define WT_WIN   ((size_t)0)
#define WT_WQK   (WT_WIN + (size_t)6784 * 1024)
#define WT_GLU   (WT_WQK + (size_t)4 * 256 * 128)
#define WT_WBR   (WT_GLU + (size_t)512 * 512)
#define WT_WOUT  (WT_WBR + (size_t)3 * 1024 * 512)
#define WT_WQ    (WT_WOUT + (size_t)1024 * 1024)
#define WT_SUBK  (WT_WQ + (size_t)2048 * 1024)
#define WT_LAYER (WT_SUBK + (size_t)2 * 128 * 128)
#define WB_H     AL(WB_WT + WT_LAYER * 2 * 2)
#define WB_Z     AL(WB_H + (size_t)RPG * DM * 2)
#define WB_MGT   AL(WB_Z + (size_t)RPG * ZW * 2)
#define WB_XC    AL(WB_MGT + (size_t)RPG * 16 * 4)
#define WB_QM    AL(WB_XC + (size_t)RPG * 512 * 2)
#define WB_KM    AL(WB_QM + (size_t)RPG * 512 * 2)
#define WB_KMT   AL(WB_KM + (size_t)RPG * 512 * 2)
#define WB_MVT   AL(WB_KMT + (size_t)RPG * 512 * 2)
#define WB_HF    AL(WB_MVT + (size_t)RPG * 512 * 2)
#define WB_HB    AL(WB_HF + (size_t)RPG * 512 * 2)
#define WB_YSF   AL(WB_HB + (size_t)RPG * 512 * 2)
#define WB_YSB   AL(WB_YSF + (size_t)RPG * 512 * 4)
#define WB_YA    AL(WB_YSB + (size_t)RPG * 512 * 4)
#define WB_YB    AL(WB_YA + (size_t)RPG * 512 * 2)
#define WB_YS    AL(WB_YB + (size_t)RPG * 512 * 2)
#define WB_GG    AL(WB_YS + (size_t)RPG * 512 * 2)
#define WB_MG    AL(WB_GG + (size_t)RPG * 512 * 2)
#define WB_EI    AL(WB_MG + (size_t)RPG * DM * 2)
#define WB_EG    AL(WB_EI + (size_t)RPG * 128 * 4)
#define WB_U16   AL(WB_EG + (size_t)RPG * 128 * 4)
#define WB_V16   AL(WB_U16 + (size_t)2 * 16384 * 1024)
#define WB_VT    AL(WB_V16 + (size_t)2 * 16384 * 1024)
#define WB_CNT   AL(WB_VT + (size_t)GB * 4 * 128 * NTOK * 2)
#define WB_XE    AL(WB_CNT + 256)
#define WB_BAR   AL(WB_XE + (size_t)GB * 32 * 2 * 33 * 128 * 4)
#define WB_GA    AL(WB_BAR + 256)
#define WB_END   AL(WB_GA + (size_t)GB * 4 * 2 * 68 * 272 * 4)
#define WB_PQ    (WB_Z)
#define WB_SC    AL(WB_PQ + (size_t)RPG * 2048 * 2)

#define SMEM_FLOATS (25 * 1024)

__device__ __forceinline__ float sigmoidf_(float x) { return __builtin_amdgcn_rcpf(1.0f + __builtin_amdgcn_exp2f(-1.4426950408889634f * x)); }
__device__ __forceinline__ float siluf_(float x) { return x * __builtin_amdgcn_rcpf(1.0f + __builtin_amdgcn_exp2f(-1.4426950408889634f * x)); }
__device__ __forceinline__ float geluf_(float x) { return 0.5f * x * (1.0f + erff(x * 0.70710678118654752f)); }
__device__ __forceinline__ int otid() { int t = threadIdx.x; asm volatile("" : "+v"(t)); return t; }
__device__ __forceinline__ float wave_sum(float v) {
  for (int o = 32; o > 0; o >>= 1) v += __shfl_xor(v, o);
  return v;
}
__device__ __forceinline__ bf16_t f2bf(float x) { unsigned u = __float_as_uint(x); u += 0x7fffu + ((u >> 16) & 1u); return (bf16_t)(u >> 16); }
__device__ __forceinline__ float bf2f(bf16_t h) { return __uint_as_float(((unsigned)h) << 16); }
typedef float f32x2 __attribute__((ext_vector_type(2)));
typedef __bf16 bf16x2_t __attribute__((ext_vector_type(2)));
__device__ __forceinline__ unsigned pack2(float a, float b) { f32x2 v = {a, b}; return __builtin_bit_cast(unsigned, __builtin_convertvector(v, bf16x2_t)); }
__device__ __forceinline__ float lo16(unsigned u) { return __uint_as_float(u << 16); }
__device__ __forceinline__ float hi16(unsigned u) { return __uint_as_float(u & 0xffff0000u); }

__device__ __forceinline__ float* xrow(const Params& p, int b, int rr) {
  return (rr < NLAT) ? p.out + ((size_t)b * NLAT + rr) * DM : (float*)(p.ws + WB_XCX) + ((size_t)b * NCTX + (rr - NLAT)) * DM;
}

__device__ __forceinline__ const float* xrow_in(const Params& p, int b, int rr) {
  return (rr < NLAT) ? p.in[I_X] + ((size_t)b * NLAT + rr) * DM : p.in[I_CTX] + ((size_t)b * NCTX + (rr - NLAT)) * DM;
}

__device__ __forceinline__ void gemm_tile(const bf16_t* __restrict__ Ag, int lda, const bf16_t* __restrict__ Bg, int ldb, int K,
                                          char* smem, f32x16 (&acc)[2][2]) {
  const int tid = otid(), lane = tid & 63, w = tid >> 6, wm = w >> 1, wn = w & 1;
#pragma unroll
  for (int a = 0; a < 2; ++a)
#pragma unroll
    for (int b = 0; b < 2; ++b)
#pragma unroll
      for (int i = 0; i < 16; ++i) acc[a][b][i] = 0.f;
  const int srow = tid >> 3, sch = tid & 7;
  const bf16_t* ap = Ag + (size_t)srow * lda + sch * 8;
  const bf16_t* bp = Bg + (size_t)srow * ldb + sch * 8;
  const int wofs = srow * 128 + ((sch ^ ((srow >> 1) & 7)) << 4);
  const int fr = lane & 31, fh = lane >> 5, fsw = (fr >> 1) & 7;
  const int aofs = (wm * 64 + fr) * 128, bofs = 16384 + (wn * 64 + fr) * 128;
  u32x4 ra0[4], rb0[4], ra1[4], rb1[4];
  const int nk = K >> 6;
#define G_LOAD(RA, RB, KT) { _Pragma("unroll") for (int i = 0; i < 4; ++i) { RA[i] = *(const u32x4*)(ap + (size_t)i * 32 * lda + (KT) * 64); RB[i] = *(const u32x4*)(bp + (size_t)i * 32 * ldb + (KT) * 64); } }
#define G_STORE(RA, RB, BUF) { char* nb_ = smem + (BUF) * 32768; _Pragma("unroll") for (int i = 0; i < 4; ++i) { *(u32x4*)(nb_ + wofs + i * 4096) = RA[i]; *(u32x4*)(nb_ + 16384 + wofs + i * 4096) = RB[i]; } }
#define G_COMPUTE(BUF) { const char* base = smem + (BUF) * 32768; _Pragma("unroll") for (int ks = 0; ks < 4; ++ks) { \
      const int coff = ((ks * 2 + fh) ^ fsw) << 4; bf16x8 af[2], bfr[2]; \
      _Pragma("unroll") for (int mi = 0; mi < 2; ++mi) af[mi] = *(const bf16x8*)(base + aofs + mi * 4096 + coff); \
      _Pragma("unroll") for (int ni = 0; ni < 2; ++ni) bfr[ni] = *(const bf16x8*)(base + bofs + ni * 4096 + coff); \
      _Pragma("unroll") for (int mi = 0; mi < 2; ++mi) _Pragma("unroll") for (int ni = 0; ni < 2; ++ni) \
          acc[mi][ni] = __builtin_amdgcn_mfma_f32_32x32x16_bf16(bfr[ni], af[mi], acc[mi][ni], 0, 0, 0); } }
  G_LOAD(ra0, rb0, 0)
  G_LOAD(ra1, rb1, 1)
  __syncthreads();
  G_STORE(ra0, rb0, 0)
  __syncthreads();
  for (int kt = 0; kt < nk; kt += 2) {
    if (kt + 2 < nk) G_LOAD(ra0, rb0, kt + 2)
    G_COMPUTE(0)
    G_STORE(ra1, rb1, 1)
    __syncthreads();
    if (kt + 3 < nk) G_LOAD(ra1, rb1, kt + 3)
    G_COMPUTE(1)
    if (kt + 2 < nk) G_STORE(ra0, rb0, 0)
    __syncthreads();
  }
#undef G_LOAD
#undef G_STORE
#undef G_COMPUTE
}
#define EPI_DECL const int tid_ = otid(); const int lane = tid_ & 63, w_ = tid_ >> 6, wm = w_ >> 1, wn = w_ & 1, fr = lane & 31, fh = lane >> 5; (void)fr; (void)fh; (void)wm; (void)wn;
#define EPI_ROW(mi) (wm * 64 + (mi) * 32 + fr)
#define EPI_COL(ni, q) (wn * 64 + (ni) * 32 + 8 * (q) + 4 * fh)
#define MT_LR0(mt, tpb) (((mt) / (tpb)) * NTOK + ((mt) % (tpb)) * 128)


struct TileIter {
  int tm, tn, pw, ph, PN, NP, x, i, it;
  __device__ __forceinline__ TileIter(int tm_, int tn_) : tm(tm_), tn(tn_) {
    pw = tn < 8 ? tn : 8; ph = 32 / pw; PN = (tn + pw - 1) / pw; NP = ((tm + ph - 1) / ph) * PN;
    x = blockIdx.x & 7; i = blockIdx.x >> 3; it = 0;
  }
  __device__ __forceinline__ bool next(int& mt, int& nt, bool& valid) {
    if (gridDim.x != 256) {
      const int t = blockIdx.x + it * gridDim.x; ++it;
      if (t >= tm * tn) return false;
      mt = t / tn; nt = t % tn; valid = true; return true;
    }
    const int P = it * 8 + x; ++it;
    if (P >= NP) return false;
    mt = (P / PN) * ph + i / pw; nt = (P % PN) * pw + i % pw;
    valid = (mt < tm) && (nt < tn);
    return true;
  }
};

template <class F>
__device__ __forceinline__ void transpose_cvt(const float* __restrict__ src, int ld, F srccol, int K, int Ndst, bf16_t* __restrict__ dst, float* smem) {
  float (*T)[65] = (float (*)[65])smem;
  const int tid = otid();
  const int tk = K >> 6, tn = Ndst >> 6;
  for (int t = blockIdx.x; t < tn * tk; t += gridDim.x) {
    const int n0 = (t / tk) * 64, k0 = (t % tk) * 64;
    __syncthreads();
    const int sc = srccol(n0 + (tid & 63));
#pragma unroll
    for (int i = 0; i < 16; ++i) {
      const int ky = (tid >> 6) + 4 * i;
      T[ky][tid & 63] = (sc >= 0) ? src[(size_t)(k0 + ky) * ld + sc] : 0.f;
    }
    __syncthreads();
#pragma unroll
    for (int i = 0; i < 16; ++i) {
      const int ny = (tid >> 6) + 4 * i;
      dst[(size_t)(n0 + ny) * K + k0 + (tid & 63)] = f2bf(T[tid & 63][ny]);
    }
  }
  __syncthreads();
}
__device__ __forceinline__ int win_srccol(int n) {
  if (n < 3072) return n;
  if (n < 6656) return n + 16;
  if (n < 6672) return n - 3584;
  return -1;
}

__device__ __forceinline__ void stage_init(const Params& p, float* smem) {
  const int tid = otid();
  if (blockIdx.x == 0 && tid < 64) ((int*)(p.ws + WB_CNT))[tid] = 0;
  {
    const size_t n16 = (size_t)2 * 16384 * 1024 / 16;
    const float4* su = (const float4*)p.in[I_PU];
    const float4* sv = (const float4*)p.in[I_PV];
    u32x4* du = (u32x4*)(p.ws + WB_U16);
    u32x4* dv = (u32x4*)(p.ws + WB_V16);
    for (size_t i = (size_t)blockIdx.x * 256 + tid; i < n16; i += (size_t)gridDim.x * 256) {
      u32x4 ou, ov;
#pragma unroll
      for (int q = 0; q < 4; ++q) {
        const float4 a = su[4 * i + q];
        int w = 0;
        w = __builtin_amdgcn_cvt_pk_fp8_f32(a.x * 32.f, a.y * 32.f, w, false);
        w = __builtin_amdgcn_cvt_pk_fp8_f32(a.z * 32.f, a.w * 32.f, w, true);
        ou[q] = (unsigned)w;
        const float4 b = sv[4 * i + q];
        int w2 = 0;
        w2 = __builtin_amdgcn_cvt_pk_fp8_f32(b.x, b.y, w2, false);
        w2 = __builtin_amdgcn_cvt_pk_fp8_f32(b.z, b.w, w2, true);
        ov[q] = (unsigned)w2;
      }
      du[i] = ou; dv[i] = ov;
    }
  }
  {
    float2* rt = (float2*)(p.ws + WB_ROPE);
    for (int i = blockIdx.x * 256 + tid; i < NLAT * 32; i += gridDim.x * 256) {
      const int pos = i >> 5, j = i & 31;
      const float inv = powf(10000.0f, -(float)(j & 15) / 16.0f);
      const float ang = (float)((j < 16) ? (pos >> 6) : (pos & 63)) * inv;
      rt[i] = make_float2(cosf(ang), sinf(ang));
    }
  }
  {
    float* sc = smem;
    float* red = smem + 9 * 1024;
    for (int i = tid; i < 9 * 1024; i += 256) {
      int r = i >> 10, k = i & 1023;
      float v = (r < 8) ? p.in[I_C][r * 1024 + k] : p.in[I_CCTX][k];
      sc[i] = siluf_(v);
    }
    __syncthreads();
    float* mod = (float*)(p.ws + WB_MOD);
    const int jc = tid & 63, ksl = tid >> 6;
    for (int cb = blockIdx.x; cb < 2 * 6144 / 64; cb += gridDim.x) {
      const int col = cb * 64 + jc;
      const int l = col / 6144, j = col % 6144;
      const float* w = p.in[I_WMOD] + (size_t)l * 1024 * 6144 + j;
      float acc[9];
#pragma unroll
      for (int r = 0; r < 9; ++r) acc[r] = 0.f;
#pragma unroll 8
      for (int k = ksl * 256; k < ksl * 256 + 256; ++k) {
        const float wv = w[(size_t)k * 6144];
#pragma unroll
        for (int r = 0; r < 9; ++r) acc[r] = fmaf(sc[r * 1024 + k], wv, acc[r]);
      }
      __syncthreads();
#pragma unroll
      for (int r = 0; r < 9; ++r) red[(ksl * 64 + jc) * 9 + r] = acc[r];
      __syncthreads();
      if (ksl == 0) {
        const float bv = p.in[I_BMOD][l * 6144 + j];
#pragma unroll
        for (int r = 0; r < 9; ++r)
          mod[((size_t)l * 9 + r) * 6144 + j] = red[jc * 9 + r] + red[(64 + jc) * 9 + r] + red[(128 + jc) * 9 + r] + red[(192 + jc) * 9 + r] + bv;
      }
    }
    __syncthreads();
  }
  bf16_t* WT = (bf16_t*)(p.ws + WB_WT);
  for (int l = 0; l < 2; ++l) {
    bf16_t* W = WT + (size_t)l * WT_LAYER;
    transpose_cvt(p.in[I_WIN] + (size_t)l * DM * INW, INW, [](int n) { return win_srccol(n); }, DM, 6784, W + WT_WIN, smem);
    for (int h = 0; h < 4; ++h) {
      transpose_cvt(p.in[I_MLWQ] + ((size_t)l * 4 + h) * 16384, 128, [](int n) { return n; }, 128, 128, W + WT_WQK + (size_t)h * 256 * 128, smem);
      transpose_cvt(p.in[I_MLWK] + ((size_t)l * 4 + h) * 16384, 128, [](int n) { return n; }, 128, 128, W + WT_WQK + (size_t)h * 256 * 128 + 128 * 128, smem);
    }
    transpose_cvt(p.in[I_GLUW] + (size_t)l * 512 * 512, 512, [](int n) { return n; }, 512, 512, W + WT_GLU, smem);
    for (int r = 0; r < 3; ++r)
      transpose_cvt(p.in[I_WBR] + ((size_t)l * 3 + r) * 512 * DM, DM, [](int n) { return n; }, 512, DM, W + WT_WBR + (size_t)r * 1024 * 512, smem);
    transpose_cvt(p.in[I_WOUT] + (size_t)l * DM * DM, DM, [](int n) { return n; }, DM, DM, W + WT_WOUT, smem);
    transpose_cvt(p.in[I_PWQ] + (size_t)l * DM * 2048, 2048, [](int n) { return n; }, DM, 2048, W + WT_WQ, smem);
    const float* sk = p.in[I_PSUBK] + (size_t)l * 2 * 128 * 128;
    for (int i = blockIdx.x * 256 + tid; i < 2 * 128 * 128; i += gridDim.x * 256) W[WT_SUBK + i] = f2bf(sk[i]);
  }
}

__device__ __forceinline__ void stage_normmod(const Params& p, int l, int g, int which, int rr_lim, bf16_t* H, float* smem) {
  const int tid = otid(), w = tid >> 6, lane = tid & 63;
  const float* ng = p.in[which ? I_N2G : I_N1G] + l * DM;
  const float* mod = (const float*)(p.ws + WB_MOD) + (size_t)l * 9 * 6144;
  const int off_sh = which ? 3072 : 0, off_sc = which ? 4096 : 1024;
  const int n = GB * rr_lim;
  for (int i0 = (blockIdx.x * 4 + w) * 2; i0 < n; i0 += gridDim.x * 8) {
    float4 v[2][4];
    int bl[2], rr[2];
#pragma unroll
    for (int u = 0; u < 2; ++u) {
      const int i = (i0 + u < n) ? i0 + u : i0;
      bl[u] = i / rr_lim; rr[u] = i % rr_lim;
      const float4* X = (const float4*)((l == 0 && which == 0) ? xrow_in(p, g * GB + bl[u], rr[u]) : xrow(p, g * GB + bl[u], rr[u]));
#pragma unroll
      for (int q = 0; q < 4; ++q) v[u][q] = X[q * 64 + lane];
    }
#pragma unroll
    for (int u = 0; u < 2; ++u) {
      if (i0 + u >= n) break;
      float s = 0.f;
#pragma unroll
      for (int q = 0; q < 4; ++q) s += v[u][q].x * v[u][q].x + v[u][q].y * v[u][q].y + v[u][q].z * v[u][q].z + v[u][q].w * v[u][q].w;
      s = wave_sum(s);
      const float rs = rsqrtf(s * (1.0f / DM) + EPSF);
      const float* m = mod + (size_t)((rr[u] < NLAT) ? (g * GB + bl[u]) : 8) * 6144;
      u32x2* hp = (u32x2*)(H + ((size_t)bl[u] * NTOK + rr[u]) * DM);
#pragma unroll
      for (int q = 0; q < 4; ++q) {
        const float4 gg = ((const float4*)ng)[q * 64 + lane];
        const float4 sc = ((const float4*)(m + off_sc))[q * 64 + lane];
        const float4 sh = ((const float4*)(m + off_sh))[q * 64 + lane];
        const float4 x = v[u][q];
        hp[q * 64 + lane] = (u32x2){pack2(x.x * rs * gg.x * (1.f + sc.x) + sh.x, x.y * rs * gg.y * (1.f + sc.y) + sh.y),
                                    pack2(x.z * rs * gg.z * (1.f + sc.z) + sh.z, x.w * rs * gg.w * (1.f + sc.w) + sh.w)};
      }
    }
  }
}

__device__ __forceinline__ void stage_inproj(const Params& p, const bf16_t* H, const bf16_t* WinT, bf16_t* Z, float* MGT, bf16_t* VT, bf16_t* MVT, char* smem) {
  EPI_DECL
  const int tm = GB * 34, tn = 53;
  const float2* rt = (const float2*)(p.ws + WB_ROPE);
  TileIter ti(tm, tn);
  int mt, j; bool valid;
  while (ti.next(mt, j, valid)) {
    if (!valid) continue;
    const int n0 = j * 128;
    const int lr0 = MT_LR0(mt, 34), rr0 = (mt % 34) * 128;
    f32x16 acc[2][2];
    if ((j >= 8 && j < 12) || (j >= 16 && j < 20)) {
      gemm_tile(WinT + (size_t)n0 * DM, DM, H + (size_t)lr0 * DM, DM, DM, smem, acc);
      bf16_t* vt = ((j < 12) ? VT : MVT) + ((size_t)(mt / 34) * 4 + (j & 3)) * 128 * NTOK;
#pragma unroll
      for (int mi = 0; mi < 2; ++mi)
#pragma unroll
        for (int ni = 0; ni < 2; ++ni)
#pragma unroll
          for (int q = 0; q < 4; ++q) {
            const int e = EPI_ROW(mi), tok = rr0 + EPI_COL(ni, q);
            *(u32x2*)(vt + (size_t)e * NTOK + tok) = (u32x2){pack2(acc[mi][ni][4 * q], acc[mi][ni][4 * q + 1]), pack2(acc[mi][ni][4 * q + 2], acc[mi][ni][4 * q + 3])};
          }
      continue;
    }
    gemm_tile(H + (size_t)lr0 * DM, DM, WinT + (size_t)n0 * DM, DM, DM, smem, acc);
    if (j < 8 && rr0 < NLAT) {
#pragma unroll
      for (int mi = 0; mi < 2; ++mi) {
        const int pos = rr0 + EPI_ROW(mi);
#pragma unroll
        for (int i = 0; i < 16; ++i) {
          const int jj = 8 * (i >> 2) + 4 * fh + (i & 3);
          const float2 cs = rt[pos * 32 + jj];
          const float x1 = acc[mi][0][i], x2 = acc[mi][1][i];
          acc[mi][0][i] = x1 * cs.x - x2 * cs.y;
          acc[mi][1][i] = x1 * cs.y + x2 * cs.x;
        }
      }
    }
    if (j < 52) {
      const bool sg = (j >= 28);
#pragma unroll
      for (int mi = 0; mi < 2; ++mi)
#pragma unroll
        for (int ni = 0; ni < 2; ++ni)
#pragma unroll
          for (int q = 0; q < 4; ++q) {
            const int row = lr0 + EPI_ROW(mi), c = n0 + EPI_COL(ni, q);
            float v0 = acc[mi][ni][4 * q], v1 = acc[mi][ni][4 * q + 1], v2 = acc[mi][ni][4 * q + 2], v3 = acc[mi][ni][4 * q + 3];
            if (sg) { v0 = sigmoidf_(v0); v1 = sigmoidf_(v1); v2 = sigmoidf_(v2); v3 = sigmoidf_(v3); }
            *(u32x2*)(Z + (size_t)row * ZW + c) = (u32x2){pack2(v0, v1), pack2(v2, v3)};
          }
    } else {
#pragma unroll
      for (int mi = 0; mi < 2; ++mi)
#pragma unroll
        for (int q = 0; q < 2; ++q) {
          const int row = lr0 + EPI_ROW(mi), c = EPI_COL(0, q);
          if (wn == 0) *(float4*)(MGT + (size_t)row * 16 + c) = make_float4(acc[mi][0][4 * q], acc[mi][0][4 * q + 1], acc[mi][0][4 * q + 2], acc[mi][0][4 * q + 3]);
        }
    }
  }
}

__device__ __forceinline__ void stage_conv(const Params& p, int l, const bf16_t* Z, bf16_t* XC) {
  const int tid = otid();
  const float* cw = p.in[I_CONVW] + (size_t)l * 3 * 512;
  const float* cb = p.in[I_CONVB] + (size_t)l * 512;
  const int c = tid * 2;
  const float2 w0 = *(const float2*)(cw + c), w1 = *(const float2*)(cw + 512 + c), w2 = *(const float2*)(cw + 1024 + c), bb = *(const float2*)(cb + c);
  for (int lr0 = blockIdx.x * 4; lr0 < RPG; lr0 += gridDim.x * 4) {
    unsigned xc[4], xp[4], xn[4];
#pragma unroll
    for (int u = 0; u < 4; ++u) {
      const int lr = lr0 + u, rr = lr % NTOK;
      const bool has_prev = (rr < NLAT) ? (rr > 0) : (rr > NLAT);
      const bool has_next = (rr < NLAT) ? (rr < NLAT - 1) : (rr < NTOK - 1);
      const bf16_t* z = Z + (size_t)lr * ZW + 1536 + c;
      xc[u] = *(const unsigned*)z;
      xp[u] = has_prev ? *(const unsigned*)(z - ZW) : 0u;
      xn[u] = has_next ? *(const unsigned*)(z + ZW) : 0u;
    }
#pragma unroll
    for (int u = 0; u < 4; ++u) {
      const float a0 = bb.x + w1.x * lo16(xc[u]) + w0.x * lo16(xp[u]) + w2.x * lo16(xn[u]);
      const float a1 = bb.y + w1.y * hi16(xc[u]) + w0.y * hi16(xp[u]) + w2.y * hi16(xn[u]);
      *(unsigned*)(XC + (size_t)(lr0 + u) * 512 + c) = pack2(siluf_(a0), siluf_(a1));
    }
  }
}

__device__ __forceinline__ void stage_mlqk(const bf16_t* XC, const bf16_t* WQK, bf16_t* QM, bf16_t* KM, bf16_t* KMT, char* smem) {
  EPI_DECL
  const int tm = RPG >> 7;
  TileIter ti(tm, 12);
  int mt, r12; bool valid;
  while (ti.next(mt, r12, valid)) {
    if (!valid) continue;
    const int h = r12 & 3, kind = r12 >> 2;
    const int m0 = mt * 128;
    f32x16 acc[2][2];
    const bf16_t* Wt = WQK + (size_t)h * 256 * 128 + (size_t)(kind ? 1 : 0) * 128 * 128;
    const bf16_t* Xt = XC + (size_t)m0 * 512 + h * 128;
    if (kind < 2) {
      gemm_tile(Xt, 512, Wt, 128, 128, smem, acc);
      bf16_t* O = kind ? KM : QM;
      const float alpha = kind ? 1.0f : 0.08838834764831845f;
#pragma unroll
      for (int mi = 0; mi < 2; ++mi)
#pragma unroll
        for (int ni = 0; ni < 2; ++ni)
#pragma unroll
          for (int q = 0; q < 4; ++q) {
            const int row = m0 + EPI_ROW(mi), c = EPI_COL(ni, q);
            *(u32x2*)(O + (size_t)row * 512 + h * 128 + c) = (u32x2){pack2(alpha * acc[mi][ni][4 * q], alpha * acc[mi][ni][4 * q + 1]), pack2(alpha * acc[mi][ni][4 * q + 2], alpha * acc[mi][ni][4 * q + 3])};
          }
    } else {
      gemm_tile(Wt, 128, Xt, 512, 128, smem, acc);
      bf16_t* kt = KMT + ((size_t)(mt / 34) * 4 + h) * 128 * NTOK + (mt % 34) * 128;
#pragma unroll
      for (int mi = 0; mi < 2; ++mi)
#pragma unroll
        for (int ni = 0; ni < 2; ++ni)
#pragma unroll
          for (int q = 0; q < 4; ++q) {
            const int d = EPI_ROW(mi), tok = EPI_COL(ni, q);
            *(u32x2*)(kt + (size_t)d * NTOK + tok) = (u32x2){pack2(acc[mi][ni][4 * q], acc[mi][ni][4 * q + 1]), pack2(acc[mi][ni][4 * q + 2], acc[mi][ni][4 * q + 3])};
          }
    }
  }
}

__device__ __forceinline__ void attn_mfma_item(const Params& p, int l, const bf16_t* Zb, const bf16_t* VTb, bf16_t* YAb, int h, int qrow0, int key0, int nkeys,
                                               float lam, float lam_init, char* smem) {
  const int tid = otid(), lane = tid & 63, w = tid >> 6, fr = lane & 31, fh = lane >> 5;
  const int rb = w & 1, m = w >> 1;
  const int ntiles = nkeys >> 6;
  const int myrow = qrow0 + rb * 32 + fr;
  bf16x8 qf[4];
  {
    const bf16_t* qp = Zb + (size_t)myrow * ZW + h * 128 + m * 64 + fh * 8;
#pragma unroll
    for (int ks = 0; ks < 4; ++ks) qf[ks] = *(const bf16x8*)(qp + ks * 16);
  }
  f32x16 O[4];
#pragma unroll
  for (int eb = 0; eb < 4; ++eb)
#pragma unroll
    for (int i = 0; i < 16; ++i) O[eb][i] = 0.f;
  float mrun = -1e30f, lrun = 0.f;
  const float cs = 0.125f * 1.4426950408889634f;
  const int skey = tid >> 4, sch = tid & 15;
  const bf16_t* ksrc = Zb + (size_t)(key0 + skey) * ZW + 512 + h * 128 + sch * 8;
  const int kdst = skey * 256 + ((sch ^ (skey & 15)) << 4);
  const int se = tid >> 3, svc = tid & 7;
  const bf16_t* vsrc = VTb + ((size_t)h * 128 + se) * NTOK + key0 + svc * 8;
  const int vsw = (se >> 1) & 15;
  const int vdst0 = se * 128 + (((2 * svc) ^ vsw) << 3), vdst1 = se * 128 + (((2 * svc + 1) ^ vsw) << 3);
  const int kfo = fr * 256, kfs = fr & 15;
  const int vfo = fr * 128, vfs = (fr >> 1) & 15;
  u32x4 rk[4], rv[4];
#pragma unroll
  for (int i = 0; i < 4; ++i) rk[i] = *(const u32x4*)(ksrc + (size_t)i * 16 * ZW);
  __syncthreads();
#pragma unroll
  for (int i = 0; i < 4; ++i) *(u32x4*)(smem + kdst + i * 4096) = rk[i];
  __syncthreads();
  bf16x8 pf[4];
#pragma unroll
  for (int s = 0; s < 4; ++s)
#pragma unroll
    for (int i = 0; i < 8; ++i) pf[s][i] = 0;
#pragma unroll 1
  for (int t = 0; t <= ntiles; ++t) {
    const bool cur = t < ntiles, nxt = t + 1 < ntiles, prv = t >= 1;
    if (nxt) {
#pragma unroll
      for (int i = 0; i < 4; ++i) rk[i] = *(const u32x4*)(ksrc + (size_t)((t + 1) * 64 + i * 16) * ZW);
    }
    if (cur) {
#pragma unroll
      for (int i = 0; i < 4; ++i) rv[i] = *(const u32x4*)(vsrc + (size_t)i * 32 * NTOK + t * 64);
    }
    const char* kb_ = smem + (t & 1) * 16384;
    f32x16 S[2];
    if (cur) {
#pragma unroll
      for (int kb = 0; kb < 2; ++kb) {
#pragma unroll
        for (int i = 0; i < 16; ++i) S[kb][i] = 0.f;
#pragma unroll
        for (int ks = 0; ks < 4; ++ks) {
          const bf16x8 kf = *(const bf16x8*)(kb_ + kb * 8192 + kfo + (((m * 8 + ks * 2 + fh) ^ kfs) << 4));
          S[kb] = __builtin_amdgcn_mfma_f32_32x32x16_bf16(kf, qf[ks], S[kb], 0, 0, 0);
        }
      }
    }
    if (prv) {
      const char* vb_ = smem + 32768 + ((t - 1) & 1) * 16384;
#pragma unroll
      for (int eb = 0; eb < 4; ++eb)
#pragma unroll
        for (int s = 0; s < 4; ++s) {
          const u32x2 v0 = *(const u32x2*)(vb_ + eb * 4096 + vfo + (((4 * s + fh) ^ vfs) << 3));
          const u32x2 v1 = *(const u32x2*)(vb_ + eb * 4096 + vfo + (((4 * s + fh + 2) ^ vfs) << 3));
          const bf16x8 vf = __builtin_bit_cast(bf16x8, (u32x4){v0[0], v0[1], v1[0], v1[1]});
          O[eb] = __builtin_amdgcn_mfma_f32_32x32x16_bf16(vf, pf[s], O[eb], 0, 0, 0);
        }
    }
    if (cur) {
      float tm = S[0][0];
#pragma unroll
      for (int i = 1; i < 16; ++i) tm = fmaxf(tm, S[0][i]);
#pragma unroll
      for (int i = 0; i < 16; ++i) tm = fmaxf(tm, S[1][i]);
      tm = fmaxf(tm, __shfl_xor(tm, 32)) * cs;
      float alpha = 1.f;
      if (tm > mrun + 8.0f) { alpha = __builtin_amdgcn_exp2f(mrun - tm); mrun = tm; }
      if (__any(alpha != 1.f)) {
#pragma unroll
        for (int eb = 0; eb < 4; ++eb)
#pragma unroll
          for (int i = 0; i < 16; ++i) O[eb][i] *= alpha;
        lrun *= alpha;
      }
      const float mc = mrun;
      float rs = 0.f;
#pragma unroll
      for (int kb = 0; kb < 2; ++kb) {
        float pv[16];
#pragma unroll
        for (int i = 0; i < 16; ++i) { pv[i] = __builtin_amdgcn_exp2f(fmaf(S[kb][i], cs, -mc)); rs += pv[i]; }
#pragma unroll
        for (int hh = 0; hh < 2; ++hh)
          pf[kb * 2 + hh] = __builtin_bit_cast(bf16x8, (u32x4){pack2(pv[8 * hh], pv[8 * hh + 1]), pack2(pv[8 * hh + 2], pv[8 * hh + 3]),
                                                                pack2(pv[8 * hh + 4], pv[8 * hh + 5]), pack2(pv[8 * hh + 6], pv[8 * hh + 7])});
      }
      lrun += rs;
    }
    if (nxt) {
      char* kd = smem + ((t + 1) & 1) * 16384;
#pragma unroll
      for (int i = 0; i < 4; ++i) *(u32x4*)(kd + kdst + i * 4096) = rk[i];
    }
    if (cur) {
      char* vd = smem + 32768 + (t & 1) * 16384;
#pragma unroll
      for (int i = 0; i < 4; ++i) {
        *(u32x2*)(vd + vdst0 + i * 4096) = (u32x2){rv[i][0], rv[i][1]};
        *(u32x2*)(vd + vdst1 + i * 4096) = (u32x2){rv[i][2], rv[i][3]};
      }
    }
    __syncthreads();
  }
  const float lt = lrun + __shfl_xor(lrun, 32);
  const float sc = (m ? lam : 1.0f) / lt;
  float* xo = (float*)smem + rb * 4096;
  if (m == 1) {
#pragma unroll
    for (int eb = 0; eb < 4; ++eb)
#pragma unroll
      for (int i = 0; i < 16; ++i) xo[(eb * 32 + (i & 3) + 8 * (i >> 2) + 4 * fh) * 32 + fr] = O[eb][i] * sc;
  }
  __syncthreads();
  if (m == 0) {
    float ss = 0.f;
#pragma unroll
    for (int eb = 0; eb < 4; ++eb)
#pragma unroll
      for (int i = 0; i < 16; ++i) {
        const float o = O[eb][i] * sc - xo[(eb * 32 + (i & 3) + 8 * (i >> 2) + 4 * fh) * 32 + fr];
        O[eb][i] = o; ss = fmaf(o, o, ss);
      }
    ss += __shfl_xor(ss, 32);
    const float rn = rsqrtf(ss * (1.0f / 128.0f) + EPSF) * (1.0f - lam_init);
    const float* sg = p.in[I_SUBG] + l * 512 + h * 128;
    bf16_t* yp = YAb + (size_t)myrow * 512 + h * 128;
#pragma unroll
    for (int eb = 0; eb < 4; ++eb)
#pragma unroll
      for (int q = 0; q < 4; ++q) {
        const int e = eb * 32 + 8 * q + 4 * fh;
        const float4 g = *(const float4*)(sg + e);
        *(u32x2*)(yp + e) = (u32x2){pack2(O[eb][4 * q] * rn * g.x, O[eb][4 * q + 1] * rn * g.y), pack2(O[eb][4 * q + 2] * rn * g.z, O[eb][4 * q + 3] * rn * g.w)};
      }
  }
  __syncthreads();
}

__device__ __forceinline__ int mlstm_row0(int dir, int c) {
  return (dir == 0) ? ((c < 4) ? NLAT + 64 * c : 64 * (c - 4)) : ((c < 4) ? NLAT + 64 * (3 - c) : 64 * (67 - c));
}
__device__ __forceinline__ void stage_mlgates(const Params& p, int l, const float* MGT, float* GA) {
  const int tid = otid(), w = tid >> 6, lane = tid & 63;
  const int nitems = GB * 4 * 2 * 68;
  for (int idx = blockIdx.x * 4 + w; idx < nitems; idx += gridDim.x * 4) {
    const int c = idx % 68, r1 = idx / 68, dir = r1 & 1, h = (r1 >> 1) & 3, bl = r1 >> 3;
    const int row = mlstm_row0(dir, c) + lane;
    const float* mg = MGT + ((size_t)bl * NTOK + row) * 16;
    const float li = mg[dir * 8 + h] + p.in[I_GATEB][l * 16 + dir * 8 + h];
    const float x = mg[dir * 8 + 4 + h] + p.in[I_GATEB][l * 16 + dir * 8 + 4 + h];
    const float lf = fminf(x, 0.f) - log1pf(expf(-fabsf(x)));
    float b = lf;
#pragma unroll
    for (int o = 1; o < 64; o <<= 1) {
      const float v = (dir == 0) ? __shfl_up(b, o) : __shfl_down(b, o);
      const bool ok = (dir == 0) ? (lane >= o) : (lane + o < 64);
      if (ok) b += v;
    }
    const float tot = (dir == 0) ? __shfl(b, 63) : __shfl(b, 0);
    float* ga = GA + (size_t)idx * 272;
    ga[lane] = b * 1.4426950408889634f; ga[64 + lane] = (li - b) * 1.4426950408889634f; ga[128 + lane] = expf(tot + li - b); ga[192 + lane] = expf(b);
    if (lane < 4) ga[256 + lane] = expf(tot);
  }
}

__device__ __forceinline__ void mlstm_chain_item(const Params& p, int l, const bf16_t* QMb, const bf16_t* KMb, const bf16_t* KMTb, const bf16_t* MVTb,
                                                 const float* GAc, bf16_t* HXb, int h, int dir, char* smem) {
  const int tid = otid(), lane = tid & 63, w = tid >> 6, fr = lane & 31, fh = lane >> 5;
  const int tb = w & 1, eh = w >> 1;
  float* fl = (float*)(smem + 98304);
  float* bs = fl; float* as_ = fl + 64; float* wgs = fl + 128; float* ebs = fl + 192; float* dec_s = fl + 256; float* nprev = fl + 272; float* npart = fl + 400;
  f32x16 CT[4];
#pragma unroll
  for (int eb = 0; eb < 4; ++eb)
#pragma unroll
    for (int i = 0; i < 16; ++i) CT[eb][i] = 0.f;
  __syncthreads();
  for (int i = tid; i < 2048; i += 256) ((u32x4*)(smem + 65536))[i] = (u32x4){0u, 0u, 0u, 0u};
  if (tid < 128) nprev[tid] = 0.f;
  const int qr = tid >> 4, qc = tid & 15;
  const int qdst = qr * 256 + ((qc ^ (qr & 15)) << 4);
  const int tr = tid >> 3, tc = tid & 7;
  const int tdst = tr * 128 + ((tc ^ ((tr >> 1) & 7)) << 4);
  const int sw16 = fr & 15, sw8 = (fr >> 1) & 7;
  u32x4 ra[4], rb[4], rc[4], rd[4];
  float4 rg = make_float4(0.f, 0.f, 0.f, 0.f);
  {
    const int row0 = mlstm_row0(dir, 0);
    const bf16_t* qs = QMb + (size_t)(row0 + qr) * 512 + h * 128 + qc * 8;
    const bf16_t* ks = KMb + (size_t)(row0 + qr) * 512 + h * 128 + qc * 8;
    const bf16_t* kts = KMTb + ((size_t)h * 128 + tr) * NTOK + row0 + tc * 8;
    const bf16_t* vts = MVTb + ((size_t)h * 128 + tr) * NTOK + row0 + tc * 8;
#pragma unroll
    for (int i = 0; i < 4; ++i) {
      ra[i] = *(const u32x4*)(qs + (size_t)i * 16 * 512);
      rb[i] = *(const u32x4*)(ks + (size_t)i * 16 * 512);
      rc[i] = *(const u32x4*)(kts + (size_t)i * 32 * NTOK);
      rd[i] = *(const u32x4*)(vts + (size_t)i * 32 * NTOK);
    }
    if (tid < 68) rg = ((const float4*)GAc)[tid];
  }
#pragma unroll 1
  for (int c = 0; c < 68; ++c) {
    const int row0 = mlstm_row0(dir, c);
    __syncthreads();
#pragma unroll
    for (int i = 0; i < 4; ++i) {
      *(u32x4*)(smem + qdst + i * 4096) = ra[i];
      *(u32x4*)(smem + 16384 + qdst + i * 4096) = rb[i];
      *(u32x4*)(smem + 32768 + tdst + i * 4096) = rc[i];
      *(u32x4*)(smem + 49152 + tdst + i * 4096) = rd[i];
    }
    if (tid < 68) ((float4*)fl)[tid] = rg;
    if (c + 1 < 68) {
      const int rown = mlstm_row0(dir, c + 1);
      const bf16_t* qs = QMb + (size_t)(rown + qr) * 512 + h * 128 + qc * 8;
      const bf16_t* ks = KMb + (size_t)(rown + qr) * 512 + h * 128 + qc * 8;
      const bf16_t* kts = KMTb + ((size_t)h * 128 + tr) * NTOK + rown + tc * 8;
      const bf16_t* vts = MVTb + ((size_t)h * 128 + tr) * NTOK + rown + tc * 8;
#pragma unroll
      for (int i = 0; i < 4; ++i) {
        ra[i] = *(const u32x4*)(qs + (size_t)i * 16 * 512);
        rb[i] = *(const u32x4*)(ks + (size_t)i * 16 * 512);
        rc[i] = *(const u32x4*)(kts + (size_t)i * 32 * NTOK);
        rd[i] = *(const u32x4*)(vts + (size_t)i * 32 * NTOK);
      }
      if (tid < 68) rg = ((const float4*)(GAc + (size_t)(c + 1) * 272))[tid];
    }
    __syncthreads();
    const int t = tb * 32 + fr;
    bf16x8 qf[8];
#pragma unroll
    for (int ks = 0; ks < 8; ++ks) qf[ks] = *(const bf16x8*)(smem + t * 256 + (((ks * 2 + fh) ^ sw16) << 4));
    const float bt = bs[t], ebt = ebs[t];
    f32x16 S[2];
    float dsum = 0.f;
#pragma unroll
    for (int sb = 0; sb < 2; ++sb) {
#pragma unroll
      for (int i = 0; i < 16; ++i) S[sb][i] = 0.f;
      const bool valid = (dir == 0) ? (sb <= tb) : (sb >= tb);
      if (valid) {
#pragma unroll
        for (int ks = 0; ks < 8; ++ks) {
          const bf16x8 kf = *(const bf16x8*)(smem + 16384 + (sb * 32 + fr) * 256 + (((ks * 2 + fh) ^ sw16) << 4));
          S[sb] = __builtin_amdgcn_mfma_f32_32x32x16_bf16(kf, qf[ks], S[sb], 0, 0, 0);
        }
#pragma unroll
        for (int q = 0; q < 4; ++q) {
          const float4 a4 = *(const float4*)(as_ + sb * 32 + 8 * q + 4 * fh);
          const float av[4] = {a4.x, a4.y, a4.z, a4.w};
#pragma unroll
          for (int j = 0; j < 4; ++j) {
            const int s = sb * 32 + 8 * q + 4 * fh + j;
            const bool ok = (dir == 0) ? (s <= t) : (s >= t);
            const float v = ok ? S[sb][4 * q + j] * __builtin_amdgcn_exp2f(bt + av[j]) : 0.f;
            S[sb][4 * q + j] = v;
            dsum += v;
          }
        }
      }
    }
    bf16x8 pf[4];
#pragma unroll
    for (int sb = 0; sb < 2; ++sb)
#pragma unroll
      for (int hh = 0; hh < 2; ++hh)
        pf[sb * 2 + hh] = __builtin_bit_cast(bf16x8, (u32x4){pack2(S[sb][8 * hh], S[sb][8 * hh + 1]), pack2(S[sb][8 * hh + 2], S[sb][8 * hh + 3]),
                                                                 pack2(S[sb][8 * hh + 4], S[sb][8 * hh + 5]), pack2(S[sb][8 * hh + 6], S[sb][8 * hh + 7])});
    float nq = 0.f;
#pragma unroll
    for (int c8 = 0; c8 < 8; ++c8) {
      const u32x4 qv = *(const u32x4*)(smem + t * 256 + (((fh * 8 + c8) ^ sw16) << 4));
      const float4 n0 = *(const float4*)(nprev + fh * 64 + c8 * 8), n1 = *(const float4*)(nprev + fh * 64 + c8 * 8 + 4);
      nq = fmaf(lo16(qv[0]), n0.x, nq); nq = fmaf(hi16(qv[0]), n0.y, nq); nq = fmaf(lo16(qv[1]), n0.z, nq); nq = fmaf(hi16(qv[1]), n0.w, nq);
      nq = fmaf(lo16(qv[2]), n1.x, nq); nq = fmaf(hi16(qv[2]), n1.y, nq); nq = fmaf(lo16(qv[3]), n1.z, nq); nq = fmaf(hi16(qv[3]), n1.w, nq);
    }
    dsum += __shfl_xor(dsum, 32);
    nq += __shfl_xor(nq, 32);
    const float den = dsum + ebt * nq;
    const float inv = 1.0f / fmaxf(fabsf(den), 1.0f);
#pragma unroll
    for (int x = 0; x < 2; ++x) {
      const int eb = 2 * eh + x;
      f32x16 N;
#pragma unroll
      for (int i = 0; i < 16; ++i) N[i] = 0.f;
#pragma unroll
      for (int ks = 0; ks < 8; ++ks) {
        const bf16x8 cf = *(const bf16x8*)(smem + 65536 + (eb * 32 + fr) * 256 + (((ks * 2 + fh) ^ sw16) << 4));
        N = __builtin_amdgcn_mfma_f32_32x32x16_bf16(cf, qf[ks], N, 0, 0, 0);
      }
#pragma unroll
      for (int i = 0; i < 16; ++i) N[i] *= ebt;
#pragma unroll
      for (int s4 = 0; s4 < 4; ++s4) {
        const bool valid = (dir == 0) ? ((s4 >> 1) <= tb) : ((s4 >> 1) >= tb);
        if (valid) {
          const int u0 = 4 * s4 + fh, u1 = u0 + 2;
          const char* vrow = smem + 49152 + (eb * 32 + fr) * 128;
          const u32x2 v0 = *(const u32x2*)(vrow + (((u0 >> 1) ^ sw8) << 4) + (u0 & 1) * 8);
          const u32x2 v1 = *(const u32x2*)(vrow + (((u1 >> 1) ^ sw8) << 4) + (u1 & 1) * 8);
          const bf16x8 vf = __builtin_bit_cast(bf16x8, (u32x4){v0[0], v0[1], v1[0], v1[1]});
          N = __builtin_amdgcn_mfma_f32_32x32x16_bf16(vf, pf[s4], N, 0, 0, 0);
        }
      }
      bf16_t* hp = HXb + (size_t)(row0 + t) * 512 + h * 128 + eb * 32 + 4 * fh;
#pragma unroll
      for (int q = 0; q < 4; ++q)
        *(u32x2*)(hp + 8 * q) = (u32x2){pack2(N[4 * q] * inv, N[4 * q + 1] * inv), pack2(N[4 * q + 2] * inv, N[4 * q + 3] * inv)};
    }
    const float decay = *dec_s;
#pragma unroll
    for (int eb = 0; eb < 4; ++eb)
#pragma unroll
      for (int i = 0; i < 16; ++i) CT[eb][i] *= decay;
#pragma unroll
    for (int ks = 0; ks < 4; ++ks) {
      const u32x4 kraw = *(const u32x4*)(smem + 32768 + (w * 32 + fr) * 128 + (((ks * 2 + fh) ^ sw8) << 4));
      const float4 g0 = *(const float4*)(wgs + ks * 16 + 8 * fh), g1 = *(const float4*)(wgs + ks * 16 + 8 * fh + 4);
      const bf16x8 kts = __builtin_bit_cast(bf16x8, (u32x4){pack2(lo16(kraw[0]) * g0.x, hi16(kraw[0]) * g0.y), pack2(lo16(kraw[1]) * g0.z, hi16(kraw[1]) * g0.w),
                                                             pack2(lo16(kraw[2]) * g1.x, hi16(kraw[2]) * g1.y), pack2(lo16(kraw[3]) * g1.z, hi16(kraw[3]) * g1.w)});
#pragma unroll
      for (int eb = 0; eb < 4; ++eb) {
        const bf16x8 vt = *(const bf16x8*)(smem + 49152 + (eb * 32 + fr) * 128 + (((ks * 2 + fh) ^ sw8) << 4));
        CT[eb] = __builtin_amdgcn_mfma_f32_32x32x16_bf16(kts, vt, CT[eb], 0, 0, 0);
      }
    }
    {
      const int d = tid & 127, sh = tid >> 7;
      float a = 0.f;
#pragma unroll 8
      for (int s = sh * 32; s < sh * 32 + 32; ++s) {
        const bf16_t kv = *(const bf16_t*)(smem + 16384 + s * 256 + ((((d >> 3)) ^ (s & 15)) << 4) + (d & 7) * 2);
        a = fmaf(wgs[s], bf2f(kv), a);
      }
      npart[sh * 128 + d] = a;
    }
    __syncthreads();
#pragma unroll
    for (int eb = 0; eb < 4; ++eb)
#pragma unroll
      for (int q = 0; q < 4; ++q)
        *(u32x2*)(smem + 65536 + (eb * 32 + fr) * 256 + ((((w * 4 + q)) ^ sw16) << 4) + 8 * fh) =
            (u32x2){pack2(CT[eb][4 * q], CT[eb][4 * q + 1]), pack2(CT[eb][4 * q + 2], CT[eb][4 * q + 3])};
    if (tid < 128) nprev[tid] = decay * nprev[tid] + npart[tid] + npart[128 + tid];
  }
  __syncthreads();
}

#define S5SEG 128
#define S5NSEG 34
__device__ __forceinline__ int s5_row(int dir, int step) {
  return (dir == 0) ? ((step < NCTX) ? NLAT + step : step - NCTX)
                    : ((step < NCTX) ? NLAT + (NCTX - 1 - step) : (NLAT - 1) - (step - NCTX));
}
__device__ __forceinline__ bf16x8 pack8(const float* f) {
  return __builtin_bit_cast(bf16x8, (u32x4){pack2(f[0], f[1]), pack2(f[2], f[3]), pack2(f[4], f[5]), pack2(f[6], f[7])});
}
struct S5M { float abr, abi, a128r, a128i; bf16x8 bbf[4]; };
__device__ __forceinline__ void s5m_setup(const Params& p, int pg, int lane, S5M& m) {
  const int fr = lane & 31, fh = lane >> 5;
  const float dt = expf(p.in[I_S5DT][pg]);
  m.abr = 0.f; m.abi = 0.f; m.a128r = 0.f; m.a128i = 0.f;
#pragma unroll
  for (int c = 0; c < 2; ++c) {
    const int n = fr + 32 * c;
    const float lre = p.in[I_S5LRE][pg * 64 + n], lim = p.in[I_S5LIM][pg * 64 + n];
    const float mag = expf(lre * dt);
    const float abr = mag * cosf(lim * dt), abi = mag * sinf(lim * dt);
    const float den = lre * lre + lim * lim;
    const float zr = ((abr - 1.0f) * lre + abi * lim) / den;
    const float zi = (abi * lre - (abr - 1.0f) * lim) / den;
    const float4* br4 = (const float4*)(p.in[I_S5BRE] + ((size_t)pg * 64 + n) * 16 + 8 * fh);
    const float4* bi4 = (const float4*)(p.in[I_S5BIM] + ((size_t)pg * 64 + n) * 16 + 8 * fh);
    const float4 b0 = br4[0], b1 = br4[1], c0 = bi4[0], c1 = bi4[1];
    const float br[8] = {b0.x, b0.y, b0.z, b0.w, b1.x, b1.y, b1.z, b1.w}, bi[8] = {c0.x, c0.y, c0.z, c0.w, c1.x, c1.y, c1.z, c1.w};
    float rr[8], ii[8];
#pragma unroll
    for (int j = 0; j < 8; ++j) { rr[j] = zr * br[j] - zi * bi[j]; ii[j] = zr * bi[j] + zi * br[j]; }
    m.bbf[c] = pack8(rr); m.bbf[2 + c] = pack8(ii);
    if (fh == c) {
      m.abr = abr; m.abi = abi;
      const float mg = expf(lre * dt * (float)S5SEG);
      m.a128r = mg * cosf(lim * dt * (float)S5SEG); m.a128i = mg * sinf(lim * dt * (float)S5SEG);
    }
  }
}
template <bool STORE>
__device__ __forceinline__ void s5m_block(const S5M& m, const bf16x8 uf, float& xr, float& xi, char* xs, int lane) {
  f32x16 T[4];
#pragma unroll
  for (int k = 0; k < 4; ++k) {
#pragma unroll
    for (int i = 0; i < 16; ++i) T[k][i] = 0.f;
    T[k] = __builtin_amdgcn_mfma_f32_32x32x16_bf16(uf, m.bbf[k], T[k], 0, 0, 0);
  }
#pragma unroll
  for (int r = 0; r < 16; ++r) {
    auto a = __builtin_amdgcn_permlane32_swap(__float_as_uint(T[0][r]), __float_as_uint(T[1][r]), false, false);
    T[0][r] = __uint_as_float(a[0]); T[1][r] = __uint_as_float(a[1]);
    auto b = __builtin_amdgcn_permlane32_swap(__float_as_uint(T[2][r]), __float_as_uint(T[3][r]), false, false);
    T[2][r] = __uint_as_float(b[0]); T[3][r] = __uint_as_float(b[1]);
  }
#pragma unroll
  for (int q = 0; q < 4; ++q)
#pragma unroll
    for (int hh = 0; hh < 2; ++hh)
#pragma unroll
      for (int j = 0; j < 4; ++j) {
        const int t = 8 * q + 4 * hh + j, r = 4 * q + j;
        const float bre = hh ? T[1][r] : T[0][r], bim = hh ? T[3][r] : T[2][r];
        const float nr = fmaf(m.abr, xr, fmaf(-m.abi, xi, bre));
        const float ni = fmaf(m.abr, xi, fmaf(m.abi, xr, bim));
        xr = nr; xi = ni;
        if (STORE) *(unsigned*)(xs + t * 256 + (((lane >> 2) ^ (t & 15)) << 4) + (lane & 3) * 4) = pack2(xr, xi);
      }
}
__device__ __forceinline__ void stage_s5_pass1(const Params& p, int l, const bf16_t* Z, float* XE) {
  const int tid = otid(), w = tid >> 6, lane = tid & 63, fr = lane & 31, fh = lane >> 5;
  const int nitems = GB * 32 * 2 * (S5NSEG - 1);
  for (int idx = blockIdx.x * 4 + w; idx < nitems; idx += gridDim.x * 4) {
    const int seg = idx % (S5NSEG - 1), r1 = idx / (S5NSEG - 1), dir = r1 & 1, g = (r1 >> 1) & 31, bl = r1 >> 6;
    S5M m;
    s5m_setup(p, (l * 2 + dir) * 32 + g, lane, m);
    float xr = 0.f, xi = 0.f;
#pragma unroll 1
    for (int sub = 0; sub < S5SEG / 32; ++sub) {
      const int row = s5_row(dir, seg * S5SEG + sub * 32 + fr);
      const bf16x8 uf = *(const bf16x8*)(Z + ((size_t)bl * NTOK + row) * ZW + 3072 + g * 16 + 8 * fh);
      s5m_block<false>(m, uf, xr, xi, nullptr, lane);
    }
    float* xe = XE + ((((size_t)bl * 32 + g) * 2 + dir) * (S5NSEG - 1) + seg) * 128;
    xe[lane] = xr; xe[64 + lane] = xi;
  }
}
__device__ __forceinline__ void s5_item(const Params& p, int l, const bf16_t* Zb, const float* XEc, float* Yb, int g, int dir, int sq, char* smem) {
  const int tid = otid(), w = tid >> 6, lane = tid & 63, fr = lane & 31, fh = lane >> 5;
  const int seg = sq * 4 + w;
  char* xs = smem + w * 8192;
  const int pg = (l * 2 + dir) * 32 + g;
  __syncthreads();
  if (seg < S5NSEG) {
    S5M m;
    s5m_setup(p, pg, lane, m);
    bf16x8 ccf[8];
#pragma unroll
    for (int ks = 0; ks < 8; ++ks) {
      float f[8] = {0.f, 0.f, 0.f, 0.f, 0.f, 0.f, 0.f, 0.f};
      if (fr < 16) {
        const float4 cr = *(const float4*)(p.in[I_S5CRE] + ((size_t)pg * 16 + fr) * 64 + ks * 8 + 4 * fh);
        const float4 ci = *(const float4*)(p.in[I_S5CIM] + ((size_t)pg * 16 + fr) * 64 + ks * 8 + 4 * fh);
        f[0] = cr.x; f[1] = -ci.x; f[2] = cr.y; f[3] = -ci.y; f[4] = cr.z; f[5] = -ci.z; f[6] = cr.w; f[7] = -ci.w;
      }
      ccf[ks] = pack8(f);
    }
    float xr = 0.f, xi = 0.f;
    for (int j = 0; j < seg; ++j) {
      const float er = XEc[j * 128 + lane], ei = XEc[j * 128 + 64 + lane];
      const float nr = m.a128r * xr - m.a128i * xi + er, ni = m.a128r * xi + m.a128i * xr + ei;
      xr = nr; xi = ni;
    }
#pragma unroll 1
    for (int sub = 0; sub < S5SEG / 32; ++sub) {
      const int row = s5_row(dir, seg * S5SEG + sub * 32 + fr);
      const bf16x8 uf = *(const bf16x8*)(Zb + (size_t)row * ZW + 3072 + g * 16 + 8 * fh);
      s5m_block<true>(m, uf, xr, xi, xs, lane);
      f32x16 Y;
#pragma unroll
      for (int i = 0; i < 16; ++i) Y[i] = 0.f;
#pragma unroll
      for (int ks = 0; ks < 8; ++ks) {
        const bf16x8 xf = *(const bf16x8*)(xs + fr * 256 + (((ks * 2 + fh) ^ (fr & 15)) << 4));
        Y = __builtin_amdgcn_mfma_f32_32x32x16_bf16(ccf[ks], xf, Y, 0, 0, 0);
      }
      float* yp = Yb + (size_t)row * 512 + g * 16 + 4 * fh;
      *(float4*)yp = make_float4(Y[0], Y[1], Y[2], Y[3]);
      *(float4*)(yp + 8) = make_float4(Y[4], Y[5], Y[6], Y[7]);
    }
  }
}

__device__ __forceinline__ void stage_post(const Params& p, int l, int rr_lim, const bf16_t* Z, const bf16_t* HF, const bf16_t* HB,
                                           const float* YSF, const float* YSB, bf16_t* YB, bf16_t* GG) {
  const int tid = otid();
  const int c0 = tid * 2;
  const float2 gml = *(const float2*)(p.in[I_MLNG] + l * 512 + c0);
  const float2 dsk = *(const float2*)(p.in[I_S5D] + l * 512 + c0);
  const int n = GB * rr_lim;
  for (int i0 = blockIdx.x * 4; i0 < n; i0 += gridDim.x * 4) {
    unsigned a0[4], a1[4], og[4], uu[4];
    float2 f[4], b[4];
    size_t r[4];
#pragma unroll
    for (int u = 0; u < 4; ++u) {
      const int i = i0 + u;
      r[u] = (size_t)(i / rr_lim) * NTOK + (i % rr_lim);
      a0[u] = *(const unsigned*)(HF + r[u] * 512 + c0); a1[u] = *(const unsigned*)(HB + r[u] * 512 + c0);
      og[u] = *(const unsigned*)(Z + r[u] * ZW + 2560 + c0); uu[u] = *(const unsigned*)(Z + r[u] * ZW + 3072 + c0);
      f[u] = *(const float2*)(YSF + r[u] * 512 + c0); b[u] = *(const float2*)(YSB + r[u] * 512 + c0);
    }
#pragma unroll
    for (int u = 0; u < 4; ++u) {
      const float h0 = lo16(a0[u]) + lo16(a1[u]), h1 = hi16(a0[u]) + hi16(a1[u]);
      const float ss = wave_sum(h0 * h0 + h1 * h1);
      const float rs = rsqrtf(ss * (1.0f / 128.0f) + EPSF);
      *(unsigned*)(YB + r[u] * 512 + c0) = pack2(h0 * rs * gml.x * sigmoidf_(lo16(og[u])), h1 * rs * gml.y * sigmoidf_(hi16(og[u])));
      *(unsigned*)(GG + r[u] * 512 + c0) = pack2(geluf_(dsk.x * lo16(uu[u]) + f[u].x + b[u].x), geluf_(dsk.y * hi16(uu[u]) + f[u].y + b[u].y));
    }
  }
}

__device__ __forceinline__ void stage_glu_mfma(const Params& p, int l, int tpb, const bf16_t* GG, const bf16_t* GLUT, bf16_t* YS, char* smem) {
  EPI_DECL
  const int tm = GB * tpb;
  TileIter ti(tm, 4);
  int mt_, nt_; bool valid;
  while (ti.next(mt_, nt_, valid)) {
    if (!valid) continue;
    const int m0 = MT_LR0(mt_, tpb), n0 = nt_ * 128;
    f32x16 acc[2][2];
    gemm_tile(GG + (size_t)m0 * 512, 512, GLUT + (size_t)n0 * 512, 512, 512, smem, acc);
#pragma unroll
    for (int mi = 0; mi < 2; ++mi)
#pragma unroll
      for (int ni = 0; ni < 2; ++ni)
#pragma unroll
        for (int q = 0; q < 4; ++q) {
          const int row = m0 + EPI_ROW(mi), c = n0 + EPI_COL(ni, q);
          const float4 b = *(const float4*)(p.in[I_GLUB] + l * 512 + c);
          const u32x2 g2 = *(const u32x2*)(GG + (size_t)row * 512 + c);
          const float o0 = lo16(g2[0]) * sigmoidf_(acc[mi][ni][4 * q] + b.x), o1 = hi16(g2[0]) * sigmoidf_(acc[mi][ni][4 * q + 1] + b.y);
          const float o2 = lo16(g2[1]) * sigmoidf_(acc[mi][ni][4 * q + 2] + b.z), o3 = hi16(g2[1]) * sigmoidf_(acc[mi][ni][4 * q + 3] + b.w);
          *(u32x2*)(YS + (size_t)row * 512 + c) = (u32x2){pack2(o0, o1), pack2(o2, o3)};
        }
  }
}

__device__ __forceinline__ void stage_merge_mfma(int tpb, const bf16_t* YA, const bf16_t* YB, const bf16_t* YS, const bf16_t* WBR, const bf16_t* Z, bf16_t* MG, char* smem) {
  EPI_DECL
  const int tm = GB * tpb;
  TileIter ti(tm, 8);
  int mt_, nt_; bool valid;
  while (ti.next(mt_, nt_, valid)) {
    if (!valid) continue;
    const int m0 = MT_LR0(mt_, tpb), n0 = nt_ * 128;
    f32x16 macc[2][2];
#pragma unroll
    for (int a = 0; a < 2; ++a)
#pragma unroll
      for (int b = 0; b < 2; ++b)
#pragma unroll
        for (int i = 0; i < 16; ++i) macc[a][b][i] = 0.f;
#pragma unroll 1
    for (int r = 0; r < 3; ++r) {
      const bf16_t* Y = (r == 0) ? YA : (r == 1 ? YB : YS);
      f32x16 acc[2][2];
      gemm_tile(Y + (size_t)m0 * 512, 512, WBR + (size_t)r * 1024 * 512 + (size_t)n0 * 512, 512, 512, smem, acc);
#pragma unroll
      for (int mi = 0; mi < 2; ++mi)
#pragma unroll
        for (int ni = 0; ni < 2; ++ni)
#pragma unroll
          for (int q = 0; q < 4; ++q) {
            const int row = m0 + EPI_ROW(mi), c = n0 + EPI_COL(ni, q);
            const u32x2 e = *(const u32x2*)(Z + (size_t)row * ZW + 3584 + r * 1024 + c);
            macc[mi][ni][4 * q] += lo16(e[0]) * acc[mi][ni][4 * q];
            macc[mi][ni][4 * q + 1] += hi16(e[0]) * acc[mi][ni][4 * q + 1];
            macc[mi][ni][4 * q + 2] += lo16(e[1]) * acc[mi][ni][4 * q + 2];
            macc[mi][ni][4 * q + 3] += hi16(e[1]) * acc[mi][ni][4 * q + 3];
          }
    }
#pragma unroll
    for (int mi = 0; mi < 2; ++mi)
#pragma unroll
      for (int ni = 0; ni < 2; ++ni)
#pragma unroll
        for (int q = 0; q < 4; ++q) {
          const int row = m0 + EPI_ROW(mi), c = n0 + EPI_COL(ni, q);
          *(u32x2*)(MG + (size_t)row * DM + c) = (u32x2){pack2(macc[mi][ni][4 * q], macc[mi][ni][4 * q + 1]), pack2(macc[mi][ni][4 * q + 2], macc[mi][ni][4 * q + 3])};
        }
  }
}

__device__ __forceinline__ void stage_outproj_mfma(const Params& p, int l, int g, int tpb, const bf16_t* MG, const bf16_t* WOUT, char* smem) {
  EPI_DECL
  const int tm = GB * tpb;
  const float* mod = (const float*)(p.ws + WB_MOD) + (size_t)l * 9 * 6144;
  TileIter ti(tm, 8);
  int mt, nt_; bool valid;
  while (ti.next(mt, nt_, valid)) {
    if (!valid) continue;
    const int n0 = nt_ * 128;
    const int m0 = MT_LR0(mt, tpb), bl = mt / tpb, rr0 = (mt % tpb) * 128, b = g * GB + bl;
    f32x16 acc[2][2];
    gemm_tile(MG + (size_t)m0 * DM, DM, WOUT + (size_t)n0 * DM, DM, DM, smem, acc);
    const float* gv = mod + (size_t)((rr0 < NLAT) ? b : 8) * 6144 + 2 * 1024;
#pragma unroll
    for (int mi = 0; mi < 2; ++mi)
#pragma unroll
      for (int ni = 0; ni < 2; ++ni)
#pragma unroll
        for (int q = 0; q < 4; ++q) {
          const int rr = rr0 + EPI_ROW(mi), c = n0 + EPI_COL(ni, q);
          const float4 gg = *(const float4*)(gv + c);
          float4* xp = (float4*)(xrow(p, b, rr) + c);
          float4 x = (l == 0) ? *(const float4*)(xrow_in(p, b, rr) + c) : *xp;
          x.x += gg.x * acc[mi][ni][4 * q]; x.y += gg.y * acc[mi][ni][4 * q + 1]; x.z += gg.z * acc[mi][ni][4 * q + 2]; x.w += gg.w * acc[mi][ni][4 * q + 3];
          *xp = x;
        }
  }
}

__device__ __forceinline__ void stage_peerq_mfma(int tpb, const bf16_t* H2, const bf16_t* WQ, bf16_t* PQ, char* smem) {
  EPI_DECL
  const int tm = GB * tpb;
  TileIter ti(tm, 16);
  int mt_, nt_; bool valid;
  while (ti.next(mt_, nt_, valid)) {
    if (!valid) continue;
    const int m0 = MT_LR0(mt_, tpb), n0 = nt_ * 128;
    f32x16 acc[2][2];
    gemm_tile(H2 + (size_t)m0 * DM, DM, WQ + (size_t)n0 * DM, DM, DM, smem, acc);
#pragma unroll
    for (int mi = 0; mi < 2; ++mi)
#pragma unroll
      for (int ni = 0; ni < 2; ++ni)
#pragma unroll
        for (int q = 0; q < 4; ++q) {
          const int row = m0 + EPI_ROW(mi), c = n0 + EPI_COL(ni, q);
          *(u32x2*)(PQ + (size_t)row * 2048 + c) = (u32x2){pack2(acc[mi][ni][4 * q], acc[mi][ni][4 * q + 1]), pack2(acc[mi][ni][4 * q + 2], acc[mi][ni][4 * q + 3])};
        }
  }
}

__device__ __forceinline__ void stage_scores_mfma(int tpb, const bf16_t* PQ, const bf16_t* SUBK, float* SCT, char* smem) {
  EPI_DECL
  const int tm = GB * tpb * 8;
  for (int t = blockIdx.x; t < tm * 2; t += gridDim.x) {
    const int mt = t >> 1, half = t & 1;
    const size_t m0 = (size_t)MT_LR0(mt >> 3, tpb) * 8 + (size_t)(mt & 7) * 128;
    f32x16 acc[2][2];
    gemm_tile(SUBK + (size_t)half * 16384, 128, PQ + m0 * 256 + half * 128, 256, 128, smem, acc);
    float* o = SCT + ((size_t)mt * 2 + half) * 16384;
#pragma unroll
    for (int mi = 0; mi < 2; ++mi)
#pragma unroll
      for (int ni = 0; ni < 2; ++ni)
#pragma unroll
        for (int q = 0; q < 4; ++q) {
          const int key = EPI_ROW(mi), item = EPI_COL(ni, q);
          *(float4*)(o + key * 128 + item) = make_float4(acc[mi][ni][4 * q], acc[mi][ni][4 * q + 1], acc[mi][ni][4 * q + 2], acc[mi][ni][4 * q + 3]);
        }
  }
}

__device__ __forceinline__ unsigned f2sortable(float x) { const unsigned u = __float_as_uint(x); return (u & 0x80000000u) ? ~u : (u | 0x80000000u); }
__device__ __forceinline__ float sortable2f(unsigned k) { return __uint_as_float((k & 0x80000000u) ? (k & 0x7fffffffu) : ~k); }
#define TOPK_INSERT(v, key) { unsigned t_ = (key); _Pragma("unroll") for (int s_ = 0; s_ < 16; ++s_) { const unsigned hi_ = max(v[s_], t_); t_ = min(v[s_], t_); v[s_] = hi_; } }
__device__ __forceinline__ void stage_topk(int tpb, const float* SCT, int* EI, float* EG, float* smem) {
  const int tid = otid();
  const int item = tid & 127, half = tid >> 7;
  unsigned* xk = (unsigned*)smem;
  const int tm = GB * tpb * 8;
  for (int mt = blockIdx.x; mt < tm; mt += gridDim.x) {
    const size_t m0 = (size_t)MT_LR0(mt >> 3, tpb) * 8 + (size_t)(mt & 7) * 128;
    const float* sc = SCT + ((size_t)mt * 2 + half) * 16384 + item;
    unsigned v[16];
#pragma unroll
    for (int s = 0; s < 16; ++s) v[s] = 0u;
#pragma unroll 1
    for (int k0 = 0; k0 < 128; k0 += 32) {
      float sv[32];
#pragma unroll
      for (int k = 0; k < 32; ++k) sv[k] = sc[(k0 + k) * 128];
#pragma unroll
      for (int k = 0; k < 32; ++k) {
        const unsigned key = (f2sortable(sv[k]) & ~127u) | (unsigned)(127 - (k0 + k));
        TOPK_INSERT(v, key)
      }
    }
    __syncthreads();
    if (half == 1) {
#pragma unroll
      for (int s = 0; s < 16; ++s) xk[item * 17 + s] = v[s];
    }
    __syncthreads();
    if (half == 0) {
      float v1[16], v2[16];
      unsigned k2[16];
#pragma unroll
      for (int s = 0; s < 16; ++s) { k2[s] = xk[item * 17 + s]; v1[s] = sortable2f((v[s] & ~127u) | 64u); v2[s] = sortable2f((k2[s] & ~127u) | 64u); }
      unsigned c[16];
#pragma unroll
      for (int s = 0; s < 16; ++s) c[s] = 0u;
      {
        int o = 0;
#pragma unroll
        for (int i = 0; i < 16; ++i)
#pragma unroll
          for (int j = 0; j < 16 / (i + 1); ++j) {
            const unsigned key = (f2sortable(v1[i] + v2[j]) & ~63u) | (unsigned)(63 - o);
            TOPK_INSERT(c, key)
            ++o;
          }
      }
      const float vmax = sortable2f((c[0] & ~63u) | 32u);
      float sum = 0.f;
#pragma unroll
      for (int s = 0; s < 16; ++s) sum += expf(sortable2f((c[s] & ~63u) | 32u) - vmax);
      const float isum = 1.0f / sum;
      const unsigned thr = c[15];
      int* ei = EI + (m0 + item) * 16;
      float* eg = EG + (m0 + item) * 16;
      int cntw = 0;
      {
        int o = 0;
#pragma unroll
        for (int i = 0; i < 16; ++i)
#pragma unroll
          for (int j = 0; j < 16 / (i + 1); ++j) {
            const unsigned key = (f2sortable(v1[i] + v2[j]) & ~63u) | (unsigned)(63 - o);
            if (key >= thr) {
              ei[cntw] = (int)((127u - (v[i] & 127u)) * 128u + (127u - (k2[j] & 127u)));
              eg[cntw] = expf(sortable2f((key & ~63u) | 32u) - vmax) * isum;
              ++cntw;
            }
            ++o;
          }
      }
    }
  }
  __syncthreads();
}

__device__ __forceinline__ void unpack8(const u32x4 v, float* f) {
#pragma unroll
  for (int k = 0; k < 4; ++k) { f[2 * k] = lo16(v[k]); f[2 * k + 1] = hi16(v[k]); }
}
__device__ __forceinline__ void unpack16_fp8(const u32x4 v, float* f) {
#pragma unroll
  for (int k = 0; k < 4; ++k) {
    const f32x2 a = __builtin_amdgcn_cvt_pk_f32_fp8((int)v[k], false), b = __builtin_amdgcn_cvt_pk_f32_fp8((int)v[k], true);
    f[4 * k] = a[0]; f[4 * k + 1] = a[1]; f[4 * k + 2] = b[0]; f[4 * k + 3] = b[1];
  }
}
__device__ __forceinline__ void stage_expert(const Params& p, int l, int g, int rr_lim, const bf16_t* H2, const int* EI, const float* EG, float* smem) {
  const int tid = otid(), w = tid >> 6, lane = tid & 63;
  float* part = smem;
  const unsigned char* U = (const unsigned char*)(p.ws + WB_U16) + (size_t)l * 16384 * 1024;
  const unsigned char* V = (const unsigned char*)(p.ws + WB_V16) + (size_t)l * 16384 * 1024;
  const float* mod = (const float*)(p.ws + WB_MOD) + (size_t)l * 9 * 6144;
  const int ntok = GB * rr_lim;
  int nx_e = 0; float nx_g = 0.f; u32x4 nx_h0 = {0u, 0u, 0u, 0u}, nx_h1 = {0u, 0u, 0u, 0u};
  if ((int)blockIdx.x < ntok) {
    const size_t t0 = (size_t)((int)blockIdx.x / rr_lim) * NTOK + ((int)blockIdx.x % rr_lim);
    nx_e = EI[t0 * 128 + w * 32 + (lane & 31)]; nx_g = EG[t0 * 128 + w * 32 + (lane & 31)];
    nx_h0 = ((const u32x4*)(H2 + t0 * DM))[2 * lane]; nx_h1 = ((const u32x4*)(H2 + t0 * DM))[2 * lane + 1];
  }
  for (int i = blockIdx.x; i < ntok; i += gridDim.x) {
    const int bl = i / rr_lim, rr = i % rr_lim, b = g * GB + bl;
    const int my_e = nx_e; const float my_g = nx_g;
    float hf[16];
    unpack8(nx_h0, hf); unpack8(nx_h1, hf + 8);
    {
      const int i2 = i + gridDim.x;
      if (i2 < ntok) {
        const size_t t2 = (size_t)(i2 / rr_lim) * NTOK + (i2 % rr_lim);
        nx_e = EI[t2 * 128 + w * 32 + (lane & 31)]; nx_g = EG[t2 * 128 + w * 32 + (lane & 31)];
        nx_h0 = ((const u32x4*)(H2 + t2 * DM))[2 * lane]; nx_h1 = ((const u32x4*)(H2 + t2 * DM))[2 * lane + 1];
      }
    }
    float my_dot = 0.f;
    {
      u32x4 ra[32];
#pragma unroll
      for (int j = 0; j < 32; ++j) {
        const int e = __builtin_amdgcn_readlane(my_e, j);
        ra[j] = ((const u32x4*)(U + (size_t)e * 1024))[lane];
      }
#pragma unroll
      for (int j = 0; j < 32; ++j) {
        float f[16];
        unpack16_fp8(ra[j], f);
        float a = 0.f;
#pragma unroll
        for (int q = 0; q < 16; ++q) a = fmaf(hf[q], f[q], a);
        a = wave_sum(a);
        if ((lane & 31) == j) my_dot = a;
      }
    }
    const float my_c = my_g * geluf_(my_dot * (1.0f / 32.0f));
    float acc[16];
#pragma unroll
    for (int q = 0; q < 16; ++q) acc[q] = 0.f;
    {
      u32x4 ra[32];
#pragma unroll
      for (int j = 0; j < 32; ++j) {
        const int e = __builtin_amdgcn_readlane(my_e, j);
        ra[j] = ((const u32x4*)(V + (size_t)e * 1024))[lane];
      }
#pragma unroll
      for (int j = 0; j < 32; ++j) {
        const float c = __uint_as_float(__builtin_amdgcn_readlane(__float_as_uint(my_c), j));
        float f[16];
        unpack16_fp8(ra[j], f);
#pragma unroll
        for (int q = 0; q < 16; ++q) acc[q] = fmaf(c, f[q], acc[q]);
      }
    }
    __syncthreads();
    {
      float4* pw = (float4*)(part + w * 1024 + lane * 16);
      pw[0] = make_float4(acc[0], acc[1], acc[2], acc[3]); pw[1] = make_float4(acc[4], acc[5], acc[6], acc[7]);
      pw[2] = make_float4(acc[8], acc[9], acc[10], acc[11]); pw[3] = make_float4(acc[12], acc[13], acc[14], acc[15]);
    }
    __syncthreads();
    const float4 s0 = ((const float4*)part)[tid], s1 = ((const float4*)(part + 1024))[tid], s2 = ((const float4*)(part + 2048))[tid], s3 = ((const float4*)(part + 3072))[tid];
    const float4 g2 = ((const float4*)(mod + (size_t)((rr < NLAT) ? b : 8) * 6144 + 5 * 1024))[tid];
    float4* xp = (float4*)xrow(p, b, rr) + tid;
    float4 xv = *xp;
    xv.x += g2.x * (s0.x + s1.x + s2.x + s3.x); xv.y += g2.y * (s0.y + s1.y + s2.y + s3.y);
    xv.z += g2.z * (s0.z + s1.z + s2.z + s3.z); xv.w += g2.w * (s0.w + s1.w + s2.w + s3.w);
    *xp = xv;
  }
  __syncthreads();
}

__device__ __forceinline__ void stage_final(const Params& p, float* smem) {
  const int tid = otid(), w = tid >> 6, lane = tid & 63;
  const int n = NB * NLAT;
  for (int r0 = (blockIdx.x * 4 + w) * 2; r0 < n; r0 += gridDim.x * 8) {
    float4 v[2][4];
#pragma unroll
    for (int u = 0; u < 2; ++u)
#pragma unroll
      for (int q = 0; q < 4; ++q) v[u][q] = ((const float4*)(p.out + (size_t)(r0 + u) * DM))[q * 64 + lane];
#pragma unroll
    for (int u = 0; u < 2; ++u) {
      float s = 0.f;
#pragma unroll
      for (int q = 0; q < 4; ++q) s += v[u][q].x * v[u][q].x + v[u][q].y * v[u][q].y + v[u][q].z * v[u][q].z + v[u][q].w * v[u][q].w;
      s = wave_sum(s);
      const float rs = rsqrtf(s * (1.0f / DM) + EPSF);
#pragma unroll
      for (int q = 0; q < 4; ++q) {
        const float4 g = ((const float4*)p.in[I_FG])[q * 64 + lane];
        const float4 x = v[u][q];
        ((float4*)(p.out + (size_t)(r0 + u) * DM))[q * 64 + lane] = make_float4(x.x * rs * g.x, x.y * rs * g.y, x.z * rs * g.z, x.w * rs * g.w);
      }
    }
  }
}

__device__ __forceinline__ void gbar(unsigned* ctr, unsigned& epoch) {
  asm volatile("s_waitcnt vmcnt(0)" ::: "memory");
  __syncthreads();
  epoch += gridDim.x;
  if (threadIdx.x == 0) {
    __builtin_amdgcn_fence(__ATOMIC_RELEASE, "agent");
    asm volatile("s_waitcnt vmcnt(0)" ::: "memory");
    __hip_atomic_fetch_add(ctr, 1u, __ATOMIC_RELAXED, __HIP_MEMORY_SCOPE_AGENT);
    while (__hip_atomic_load(ctr, __ATOMIC_RELAXED, __HIP_MEMORY_SCOPE_AGENT) < epoch) __builtin_amdgcn_s_sleep(2);
    __builtin_amdgcn_fence(__ATOMIC_ACQUIRE, "agent");
    asm volatile("s_waitcnt vmcnt(0)" ::: "memory");
  }
  __syncthreads();
}

__global__ void __launch_bounds__(256) mega(Params p) {
  cg::grid_group grid = cg::this_grid();
  __shared__ __attribute__((aligned(16))) float smem[SMEM_FLOATS];
  char* smc = (char*)smem;
  char* ws = p.ws;
  bf16_t* H = (bf16_t*)(ws + WB_H); bf16_t* Z = (bf16_t*)(ws + WB_Z); float* MGT = (float*)(ws + WB_MGT); bf16_t* XC = (bf16_t*)(ws + WB_XC);
  bf16_t* QM = (bf16_t*)(ws + WB_QM); bf16_t* KM = (bf16_t*)(ws + WB_KM); bf16_t* KMT = (bf16_t*)(ws + WB_KMT); bf16_t* MVT = (bf16_t*)(ws + WB_MVT);
  bf16_t* HF = (bf16_t*)(ws + WB_HF); bf16_t* HB = (bf16_t*)(ws + WB_HB);
  bf16_t* VT = (bf16_t*)(ws + WB_VT); float* YSF = (float*)(ws + WB_YSF); float* YSB = (float*)(ws + WB_YSB);
  bf16_t* YA = (bf16_t*)(ws + WB_YA); bf16_t* YB = (bf16_t*)(ws + WB_YB); bf16_t* YS = (bf16_t*)(ws + WB_YS); bf16_t* GG = (bf16_t*)(ws + WB_GG);
  bf16_t* MG = (bf16_t*)(ws + WB_MG); bf16_t* PQ = (bf16_t*)(ws + WB_PQ); float* SC = (float*)(ws + WB_SC);
  int* EI = (int*)(ws + WB_EI); float* EG = (float*)(ws + WB_EG); float* XE = (float*)(ws + WB_XE); float* GA = (float*)(ws + WB_GA);
  const bf16_t* WT = (const bf16_t*)(ws + WB_WT);

  unsigned* bar = (unsigned*)(ws + WB_BAR);
  unsigned epoch = 0;
  stage_init(p, smem);
  grid.sync();

  for (int l = 0; l < 2; ++l) {
    const bool need_ctx = (l == 0);
    const int rr_lim = need_ctx ? NTOK : NLAT;
    const int tpb = need_ctx ? 34 : 32;
    const bf16_t* W = WT + (size_t)l * WT_LAYER;
    const float lam_init = 0.8f - 0.6f * expf(-0.3f * (float)l);
    float lam;
    {
      float s1 = 0.f, s2 = 0.f;
      for (int i = 0; i < 64; ++i) {
        s1 += p.in[I_LQ1][l * 64 + i] * p.in[I_LK1][l * 64 + i];
        s2 += p.in[I_LQ2][l * 64 + i] * p.in[I_LK2][l * 64 + i];
      }
      lam = expf(s1) - expf(s2) + lam_init;
    }
    for (int g = 0; g < NG; ++g) {
      stage_normmod(p, l, g, 0, NTOK, H, smem);
      gbar(bar, epoch);
      stage_inproj(p, H, W + WT_WIN, Z, MGT, VT, MVT, smc);
      gbar(bar, epoch);
      stage_conv(p, l, Z, XC);
      stage_s5_pass1(p, l, Z, XE);
      gbar(bar, epoch);
      stage_mlqk(XC, W + WT_WQK, QM, KM, KMT, smc);
      stage_mlgates(p, l, MGT, GA);
      gbar(bar, epoch);
      {
        const int n_attn = 4 * 64 + (need_ctx ? 4 * 4 : 0);
        const int n_s5 = 32 * 2 * 9;
        const int n_items = GB * (8 + n_attn + n_s5);
        int* cnt = (int*)(ws + WB_CNT) + (l * NG + g);
        int* s_item = (int*)(smem + SMEM_FLOATS - 4);
        for (;;) {
          __syncthreads();
          if (otid() == 0) *s_item = atomicAdd(cnt, 1);
          __syncthreads();
          const int it = *s_item;
          if (it >= n_items) break;
          int bl, k;
          if (it < GB * 8) { bl = it / 8; k = it % 8; }
          else if (it < GB * (8 + n_attn)) { bl = (it - GB * 8) / n_attn; k = 8 + (it - GB * 8) % n_attn; }
          else { bl = (it - GB * (8 + n_attn)) / n_s5; k = 8 + n_attn + (it - GB * (8 + n_attn)) % n_s5; }
          const bf16_t* Zb = Z + (size_t)bl * NTOK * ZW;
          const size_t ro = (size_t)bl * NTOK;
          if (k < 8) {
            mlstm_chain_item(p, l, QM + ro * 512, KM + ro * 512, KMT + (size_t)bl * 4 * 128 * NTOK, MVT + (size_t)bl * 4 * 128 * NTOK, GA + (size_t)(((bl * 4 + (k & 3)) * 2 + (k >> 2)) * 68) * 272,
                             ((k >> 2) ? HB : HF) + ro * 512, k & 3, k >> 2, smc);
          } else if (k < 8 + n_attn) {
            const int a = k - 8;
            const bf16_t* VTb = VT + (size_t)bl * 4 * 128 * NTOK;
            if (a < 256) attn_mfma_item(p, l, Zb, VTb, YA + ro * 512, a & 3, (a >> 2) * 64, 0, NTOK, lam, lam_init, smc);
            else attn_mfma_item(p, l, Zb, VTb, YA + ro * 512, (a - 256) & 3, NLAT + ((a - 256) >> 2) * 64, NLAT, NCTX, lam, lam_init, smc);
          } else {
            const int a = k - 8 - n_attn;
            const int sq = a % 9, dir = (a / 9) & 1, gg = a / 18;
            s5_item(p, l, Zb, XE + (((size_t)bl * 32 + gg) * 2 + dir) * (S5NSEG - 1) * 128, (dir ? YSB : YSF) + ro * 512, gg, dir, sq, smc);
          }
        }
      }
      gbar(bar, epoch);
      stage_post(p, l, rr_lim, Z, HF, HB, YSF, YSB, YB, GG);
      gbar(bar, epoch);
      stage_glu_mfma(p, l, tpb, GG, W + WT_GLU, YS, smc);
      gbar(bar, epoch);
      stage_merge_mfma(tpb, YA, YB, YS, W + WT_WBR, Z, MG, smc);
      gbar(bar, epoch);
      stage_outproj_mfma(p, l, g, tpb, MG, W + WT_WOUT, smc);
      gbar(bar, epoch);
      stage_normmod(p, l, g, 1, rr_lim, H, smem);
      gbar(bar, epoch);
      stage_peerq_mfma(tpb, H, W + WT_WQ, PQ, smc);
      gbar(bar, epoch);
      stage_scores_mfma(tpb, PQ, W + WT_SUBK, SC, smc);
      gbar(bar, epoch);
      stage_topk(tpb, SC, EI, EG, smem);
      gbar(bar, epoch);
      stage_expert(p, l, g, rr_lim, H, EI, EG, smem);
      gbar(bar, epoch);
    }
  }
  stage_final(p, smem);
}

extern "C" void kernel_launch(void* const* d_in, const int* in_sizes, int n_in, void* d_out,
                              int out_size, void* d_ws, size_t ws_size, hipStream_t stream) {
  static int grid_blocks = 0;
  if (!grid_blocks) {
    int dev = 0, cus = 0, per_cu = 0;
    (void)hipGetDevice(&dev);
    (void)hipDeviceGetAttribute(&cus, hipDeviceAttributeMultiprocessorCount, dev);
    (void)hipOccupancyMaxActiveBlocksPerMultiprocessor(&per_cu, mega, 256, 0);
    if (per_cu > 1) per_cu = 1;
    grid_blocks = cus * per_cu;
  }
  if (ws_size < WB_END) {
    fprintf(stderr, "workspace too small: %zu < %zu\n", ws_size, (size_t)WB_END);
    return;
  }
  Params p{};
  for (int i = 0; i < N_IN; ++i) p.in[i] = (const float*)d_in[i];
  p.out = (float*)d_out;
  p.ws = (char*)d_ws;
  (void)hipMemsetAsync((char*)d_ws + WB_BAR, 0, 256, stream);
  void* args[] = {&p};
  hipError_t e = hipLaunchCooperativeKernel((void*)mega, dim3(grid_blocks), dim3(256), args, 0, stream);
  if (e != hipSuccess) fprintf(stderr, "cooperative launch failed: %s (grid %d)\n", hipGetErrorString(e), grid_blocks);
}
```

```cpp
#include <hip/hip_runtime.h>
#include <hip/hip_cooperative_groups.h>
#include <cstdio>
#include <cstdint>
namespace cg = cooperative_groups;

#define NLAT 4096
#define NCTX 256
#define NTOK 4352
#define DM 1024
#define INW 6672
#define NB 8
#define GB 2
#define NG (NB / GB)
#define RPG (GB * NTOK)
#define ZW 6656
#define EPSF 1e-6f

enum { I_X = 0, I_C, I_CTX, I_CCTX, I_WMOD, I_BMOD, I_N1G, I_N2G, I_WIN, I_LQ1, I_LK1, I_LQ2, I_LK2, I_SUBG,
       I_CONVW, I_CONVB, I_MLWQ, I_MLWK, I_GATEB, I_MLNG, I_S5LRE, I_S5LIM, I_S5DT, I_S5BRE, I_S5BIM,
       I_S5CRE, I_S5CIM, I_S5D, I_GLUW, I_GLUB, I_WBR, I_WOUT, I_PWQ, I_PSUBK, I_PU, I_PV, I_FG, N_IN };

struct Params {
  const float* in[N_IN];
  float* out;
  char* ws;
};

typedef unsigned short bf16_t;
typedef short bf16x8 __attribute__((ext_vector_type(8)));
typedef float f32x16 __attribute__((ext_vector_type(16)));
typedef unsigned u32x4 __attribute__((ext_vector_type(4)));
typedef unsigned u32x2 __attribute__((ext_vector_type(2)));

#define AL(x) (((x) + 255) & ~(size_t)255)
#define WB_XCX   ((size_t)0)
#define WB_MOD   AL(WB_XCX + (size_t)NB * NCTX * DM * 4)
#define WB_ROPE  AL(WB_MOD + (size_t)2 * 9 * 6144 * 4)
#define WB_WT    AL(WB_ROPE + (size_t)NLAT * 32 * 2 * 4)
#define WT_WIN   ((size_t)0)
#define WT_WQK   (WT_WIN + (size_t)6784 * 1024)
#define WT_GLU   (WT_WQK + (size_t)4 * 256 * 128)
#define WT_WBR   (WT_GLU + (size_t)512 * 512)
#define WT_WOUT  (WT_WBR + (size_t)3 * 1024 * 512)
#define WT_WQ    (WT_WOUT + (size_t)1024 * 1024)
#define WT_SUBK  (WT_WQ + (size_t)2048 * 1024)
#define WT_LAYER (WT_SUBK + (size_t)2 * 128 * 128)
#define WB_H     AL(WB_WT + WT_LAYER * 2 * 2)
#define WB_Z     AL(WB_H + (size_t)RPG * DM * 2)
#define WB_MGT   AL(WB_Z + (size_t)RPG * ZW * 2)
#define WB_XC    AL(WB_MGT + (size_t)RPG * 16 * 4)
#define WB_QM    AL(WB_XC + (size_t)RPG * 512 * 2)
#define WB_KM    AL(WB_QM + (size_t)RPG * 512 * 2)
#define WB_KMT   AL(WB_KM + (size_t)RPG * 512 * 2)
#define WB_MVT   AL(WB_KMT + (size_t)RPG * 512 * 2)
#define WB_HF    AL(WB_MVT + (size_t)RPG * 512 * 2)
#define WB_HB    AL(WB_HF + (size_t)RPG * 512 * 2)
#define WB_YSF   AL(WB_HB + (size_t)RPG * 512 * 2)
#define WB_YSB   AL(WB_YSF + (size_t)RPG * 512 * 4)
#define WB_YA    AL(WB_YSB + (size_t)RPG * 512 * 4)
#define WB_YB    AL(WB_YA + (size_t)RPG * 512 * 2)
#define WB_YS    AL(WB_YB + (size_t)RPG * 512 * 2)
#define WB_GG    AL(WB_YS + (size_t)RPG * 512 * 2)
#define WB_MG    AL(WB_GG + (size_t)RPG * 512 * 2)
#define WB_EI    AL(WB_MG + (size_t)RPG * DM * 2)
#define WB_EG    AL(WB_EI + (size_t)2 * RPG * 128 * 4)
#define WB_H2    AL(WB_EG + (size_t)2 * RPG * 128 * 4)
#define WB_U16   AL(WB_H2 + (size_t)2 * RPG * DM * 2)
#define WB_V16   AL(WB_U16 + (size_t)2 * 16384 * 1024)
#define WB_VT    AL(WB_V16 + (size_t)2 * 16384 * 1024)
#define WB_CNT   AL(WB_VT + (size_t)GB * 4 * 128 * NTOK * 2)
#define WB_XE    AL(WB_CNT + 256)
#define WB_BAR   AL(WB_XE + (size_t)GB * 32 * 2 * 33 * 128 * 4)
#define WB_GA    AL(WB_BAR + 256)
#define WB_POOL  AL(WB_GA + (size_t)GB * 4 * 2 * 68 * 272 * 4)
#define WB_END   AL(WB_POOL + 256)
#define WB_PQ    (WB_Z)
#define WB_SC    AL(WB_PQ + (size_t)RPG * 2048 * 2)

#define SMEM_FLOATS (25 * 1024)

__device__ __forceinline__ float sigmoidf_(float x) { return __builtin_amdgcn_rcpf(1.0f + __builtin_amdgcn_exp2f(-1.4426950408889634f * x)); }
__device__ __forceinline__ float siluf_(float x) { return x * __builtin_amdgcn_rcpf(1.0f + __builtin_amdgcn_exp2f(-1.4426950408889634f * x)); }
__device__ __forceinline__ float geluf_(float x) { return 0.5f * x * (1.0f + erff(x * 0.70710678118654752f)); }
__device__ __forceinline__ int otid() { int t = threadIdx.x; asm volatile("" : "+v"(t)); return t; }
__device__ __forceinline__ float wave_sum(float v) {
  for (int o = 32; o > 0; o >>= 1) v += __shfl_xor(v, o);
  return v;
}
__device__ __forceinline__ bf16_t f2bf(float x) { unsigned u = __float_as_uint(x); u += 0x7fffu + ((u >> 16) & 1u); return (bf16_t)(u >> 16); }
__device__ __forceinline__ float bf2f(bf16_t h) { return __uint_as_float(((unsigned)h) << 16); }
typedef float f32x2 __attribute__((ext_vector_type(2)));
typedef __bf16 bf16x2_t __attribute__((ext_vector_type(2)));
__device__ __forceinline__ unsigned pack2(float a, float b) { f32x2 v = {a, b}; return __builtin_bit_cast(unsigned, __builtin_convertvector(v, bf16x2_t)); }
__device__ __forceinline__ float lo16(unsigned u) { return __uint_as_float(u << 16); }
__device__ __forceinline__ float hi16(unsigned u) { return __uint_as_float(u & 0xffff0000u); }

__device__ __forceinline__ float* xrow(const Params& p, int b, int rr) {
  return (rr < NLAT) ? p.out + ((size_t)b * NLAT + rr) * DM : (float*)(p.ws + WB_XCX) + ((size_t)b * NCTX + (rr - NLAT)) * DM;
}

__device__ __forceinline__ const float* xrow_in(const Params& p, int b, int rr) {
  return (rr < NLAT) ? p.in[I_X] + ((size_t)b * NLAT + rr) * DM : p.in[I_CTX] + ((size_t)b * NCTX + (rr - NLAT)) * DM;
}

__device__ __forceinline__ void gemm_tile(const bf16_t* __restrict__ Ag, int lda, const bf16_t* __restrict__ Bg, int ldb, int K,
                                          char* smem, f32x16 (&acc)[2][2]) {
  const int tid = otid(), lane = tid & 63, w = tid >> 6, wm = w >> 1, wn = w & 1;
#pragma unroll
  for (int a = 0; a < 2; ++a)
#pragma unroll
    for (int b = 0; b < 2; ++b)
#pragma unroll
      for (int i = 0; i < 16; ++i) acc[a][b][i] = 0.f;
  const int srow = tid >> 3, sch = tid & 7;
  const bf16_t* ap = Ag + (size_t)srow * lda + sch * 8;
  const bf16_t* bp = Bg + (size_t)srow * ldb + sch * 8;
  const int wofs = srow * 128 + ((sch ^ ((srow >> 1) & 7)) << 4);
  const int fr = lane & 31, fh = lane >> 5, fsw = (fr >> 1) & 7;
  const int aofs = (wm * 64 + fr) * 128, bofs = 16384 + (wn * 64 + fr) * 128;
  u32x4 ra0[4], rb0[4], ra1[4], rb1[4];
  const int nk = K >> 6;
#define G_LOAD(RA, RB, KT) { _Pragma("unroll") for (int i = 0; i < 4; ++i) { RA[i] = *(const u32x4*)(ap + (size_t)i * 32 * lda + (KT) * 64); RB[i] = *(const u32x4*)(bp + (size_t)i * 32 * ldb + (KT) * 64); } }
#define G_STORE(RA, RB, BUF) { char* nb_ = smem + (BUF) * 32768; _Pragma("unroll") for (int i = 0; i < 4; ++i) { *(u32x4*)(nb_ + wofs + i * 4096) = RA[i]; *(u32x4*)(nb_ + 16384 + wofs + i * 4096) = RB[i]; } }
#define G_COMPUTE(BUF) { const char* base = smem + (BUF) * 32768; _Pragma("unroll") for (int ks = 0; ks < 4; ++ks) { \
      const int coff = ((ks * 2 + fh) ^ fsw) << 4; bf16x8 af[2], bfr[2]; \
      _Pragma("unroll") for (int mi = 0; mi < 2; ++mi) af[mi] = *(const bf16x8*)(base + aofs + mi * 4096 + coff); \
      _Pragma("unroll") for (int ni = 0; ni < 2; ++ni) bfr[ni] = *(const bf16x8*)(base + bofs + ni * 4096 + coff); \
      _Pragma("unroll") for (int mi = 0; mi < 2; ++mi) _Pragma("unroll") for (int ni = 0; ni < 2; ++ni) \
          acc[mi][ni] = __builtin_amdgcn_mfma_f32_32x32x16_bf16(bfr[ni], af[mi], acc[mi][ni], 0, 0, 0); } }
  G_LOAD(ra0, rb0, 0)
  G_LOAD(ra1, rb1, 1)
  __syncthreads();
  G_STORE(ra0, rb0, 0)
  __syncthreads();
  for (int kt = 0; kt < nk; kt += 2) {
    if (kt + 2 < nk) G_LOAD(ra0, rb0, kt + 2)
    G_COMPUTE(0)
    G_STORE(ra1, rb1, 1)
    __syncthreads();
    if (kt + 3 < nk) G_LOAD(ra1, rb1, kt + 3)
    G_COMPUTE(1)
    if (kt + 2 < nk) G_STORE(ra0, rb0, 0)
    __syncthreads();
  }
#undef G_LOAD
#undef G_STORE
#undef G_COMPUTE
}
#define EPI_DECL const int tid_ = otid(); const int lane = tid_ & 63, w_ = tid_ >> 6, wm = w_ >> 1, wn = w_ & 1, fr = lane & 31, fh = lane >> 5; (void)fr; (void)fh; (void)wm; (void)wn;
#define EPI_ROW(mi) (wm * 64 + (mi) * 32 + fr)
#define EPI_COL(ni, q) (wn * 64 + (ni) * 32 + 8 * (q) + 4 * fh)
#define MT_LR0(mt, tpb) (((mt) / (tpb)) * NTOK + ((mt) % (tpb)) * 128)


struct TileIter {
  int tm, tn, pw, ph, PN, NP, x, i, it;
  __device__ __forceinline__ TileIter(int tm_, int tn_) : tm(tm_), tn(tn_) {
    pw = tn < 8 ? tn : 8; ph = 32 / pw; PN = (tn + pw - 1) / pw; NP = ((tm + ph - 1) / ph) * PN;
    x = blockIdx.x & 7; i = blockIdx.x >> 3; it = 0;
  }
  __device__ __forceinline__ bool next(int& mt, int& nt, bool& valid) {
    if (gridDim.x != 256) {
      const int t = blockIdx.x + it * gridDim.x; ++it;
      if (t >= tm * tn) return false;
      mt = t / tn; nt = t % tn; valid = true; return true;
    }
    const int P = it * 8 + x; ++it;
    if (P >= NP) return false;
    mt = (P / PN) * ph + i / pw; nt = (P % PN) * pw + i % pw;
    valid = (mt < tm) && (nt < tn);
    return true;
  }
};

template <class F>
__device__ __forceinline__ void transpose_cvt(const float* __restrict__ src, int ld, F srccol, int K, int Ndst, bf16_t* __restrict__ dst, float* smem) {
  float (*T)[65] = (float (*)[65])smem;
  const int tid = otid();
  const int tk = K >> 6, tn = Ndst >> 6;
  for (int t = blockIdx.x; t < tn * tk; t += gridDim.x) {
    const int n0 = (t / tk) * 64, k0 = (t % tk) * 64;
    __syncthreads();
    const int sc = srccol(n0 + (tid & 63));
#pragma unroll
    for (int i = 0; i < 16; ++i) {
      const int ky = (tid >> 6) + 4 * i;
      T[ky][tid & 63] = (sc >= 0) ? src[(size_t)(k0 + ky) * ld + sc] : 0.f;
    }
    __syncthreads();
#pragma unroll
    for (int i = 0; i < 16; ++i) {
      const int ny = (tid >> 6) + 4 * i;
      dst[(size_t)(n0 + ny) * K + k0 + (tid & 63)] = f2bf(T[tid & 63][ny]);
    }
  }
  __syncthreads();
}
__device__ __forceinline__ int win_srccol(int n) {
  if (n < 3072) return n;
  if (n < 6656) return n + 16;
  if (n < 6672) return n - 3584;
  return -1;
}

__device__ __forceinline__ void stage_init(const Params& p, float* smem) {
  const int tid = otid();
  if (blockIdx.x == 0 && tid < 64) { ((int*)(p.ws + WB_CNT))[tid] = 0; if (tid < 16) ((int*)(p.ws + WB_POOL))[tid] = 0; }
  {
    const size_t n16 = (size_t)2 * 16384 * 1024 / 16;
    const float4* su = (const float4*)p.in[I_PU];
    const float4* sv = (const float4*)p.in[I_PV];
    u32x4* du = (u32x4*)(p.ws + WB_U16);
    u32x4* dv = (u32x4*)(p.ws + WB_V16);
    for (size_t i = (size_t)blockIdx.x * 256 + tid; i < n16; i += (size_t)gridDim.x * 256) {
      u32x4 ou, ov;
#pragma unroll
      for (int q = 0; q < 4; ++q) {
        const float4 a = su[4 * i + q];
        int w = 0;
        w = __builtin_amdgcn_cvt_pk_fp8_f32(a.x * 32.f, a.y * 32.f, w, false);
        w = __builtin_amdgcn_cvt_pk_fp8_f32(a.z * 32.f, a.w * 32.f, w, true);
        ou[q] = (unsigned)w;
        const float4 b = sv[4 * i + q];
        int w2 = 0;
        w2 = __builtin_amdgcn_cvt_pk_fp8_f32(b.x, b.y, w2, false);
        w2 = __builtin_amdgcn_cvt_pk_fp8_f32(b.z, b.w, w2, true);
        ov[q] = (unsigned)w2;
      }
      du[i] = ou; dv[i] = ov;
    }
  }
  {
    float2* rt = (float2*)(p.ws + WB_ROPE);
    for (int i = blockIdx.x * 256 + tid; i < NLAT * 32; i += gridDim.x * 256) {
      const int pos = i >> 5, j = i & 31;
      const float inv = powf(10000.0f, -(float)(j & 15) / 16.0f);
      const float ang = (float)((j < 16) ? (pos >> 6) : (pos & 63)) * inv;
      rt[i] = make_float2(cosf(ang), sinf(ang));
    }
  }
  {
    float* sc = smem;
    float* red = smem + 9 * 1024;
    for (int i = tid; i < 9 * 1024; i += 256) {
      int r = i >> 10, k = i & 1023;
      float v = (r < 8) ? p.in[I_C][r * 1024 + k] : p.in[I_CCTX][k];
      sc[i] = siluf_(v);
    }
    __syncthreads();
    float* mod = (float*)(p.ws + WB_MOD);
    const int jc = tid & 63, ksl = tid >> 6;
    for (int cb = blockIdx.x; cb < 2 * 6144 / 64; cb += gridDim.x) {
      const int col = cb * 64 + jc;
      const int l = col / 6144, j = col % 6144;
      const float* w = p.in[I_WMOD] + (size_t)l * 1024 * 6144 + j;
      float acc[9];
#pragma unroll
      for (int r = 0; r < 9; ++r) acc[r] = 0.f;
#pragma unroll 8
      for (int k = ksl * 256; k < ksl * 256 + 256; ++k) {
        const float wv = w[(size_t)k * 6144];
#pragma unroll
        for (int r = 0; r < 9; ++r) acc[r] = fmaf(sc[r * 1024 + k], wv, acc[r]);
      }
      __syncthreads();
#pragma unroll
      for (int r = 0; r < 9; ++r) red[(ksl * 64 + jc) * 9 + r] = acc[r];
      __syncthreads();
      if (ksl == 0) {
        const float bv = p.in[I_BMOD][l * 6144 + j];
#pragma unroll
        for (int r = 0; r < 9; ++r)
          mod[((size_t)l * 9 + r) * 6144 + j] = red[jc * 9 + r] + red[(64 + jc) * 9 + r] + red[(128 + jc) * 9 + r] + red[(192 + jc) * 9 + r] + bv;
      }
    }
    __syncthreads();
  }
  bf16_t* WT = (bf16_t*)(p.ws + WB_WT);
  for (int l = 0; l < 2; ++l) {
    bf16_t* W = WT + (size_t)l * WT_LAYER;
    transpose_cvt(p.in[I_WIN] + (size_t)l * DM * INW, INW, [](int n) { return win_srccol(n); }, DM, 6784, W + WT_WIN, smem);
    for (int h = 0; h < 4; ++h) {
      transpose_cvt(p.in[I_MLWQ] + ((size_t)l * 4 + h) * 16384, 128, [](int n) { return n; }, 128, 128, W + WT_WQK + (size_t)h * 256 * 128, smem);
      transpose_cvt(p.in[I_MLWK] + ((size_t)l * 4 + h) * 16384, 128, [](int n) { return n; }, 128, 128, W + WT_WQK + (size_t)h * 256 * 128 + 128 * 128, smem);
    }
    transpose_cvt(p.in[I_GLUW] + (size_t)l * 512 * 512, 512, [](int n) { return n; }, 512, 512, W + WT_GLU, smem);
    for (int r = 0; r < 3; ++r)
      transpose_cvt(p.in[I_WBR] + ((size_t)l * 3 + r) * 512 * DM, DM, [](int n) { return n; }, 512, DM, W + WT_WBR + (size_t)r * 1024 * 512, smem);
    transpose_cvt(p.in[I_WOUT] + (size_t)l * DM * DM, DM, [](int n) { return n; }, DM, DM, W + WT_WOUT, smem);
    transpose_cvt(p.in[I_PWQ] + (size_t)l * DM * 2048, 2048, [](int n) { return n; }, DM, 2048, W + WT_WQ, smem);
    const float* sk = p.in[I_PSUBK] + (size_t)l * 2 * 128 * 128;
    for (int i = blockIdx.x * 256 + tid; i < 2 * 128 * 128; i += gridDim.x * 256) W[WT_SUBK + i] = f2bf(sk[i]);
  }
}

__device__ __forceinline__ void stage_normmod(const Params& p, int l, int g, int which, int rr_lim, bf16_t* H, float* smem) {
  const int tid = otid(), w = tid >> 6, lane = tid & 63;
  const float* ng = p.in[which ? I_N2G : I_N1G] + l * DM;
  const float* mod = (const float*)(p.ws + WB_MOD) + (size_t)l * 9 * 6144;
  const int off_sh = which ? 3072 : 0, off_sc = which ? 4096 : 1024;
  const int n = GB * rr_lim;
  for (int i0 = (blockIdx.x * 4 + w) * 2; i0 < n; i0 += gridDim.x * 8) {
    float4 v[2][4];
    int bl[2], rr[2];
#pragma unroll
    for (int u = 0; u < 2; ++u) {
      const int i = (i0 + u < n) ? i0 + u : i0;
      bl[u] = i / rr_lim; rr[u] = i % rr_lim;
      const float4* X = (const float4*)((l == 0 && which == 0) ? xrow_in(p, g * GB + bl[u], rr[u]) : xrow(p, g * GB + bl[u], rr[u]));
#pragma unroll
      for (int q = 0; q < 4; ++q) v[u][q] = X[q * 64 + lane];
    }
#pragma unroll
    for (int u = 0; u < 2; ++u) {
      if (i0 + u >= n) break;
      float s = 0.f;
#pragma unroll
      for (int q = 0; q < 4; ++q) s += v[u][q].x * v[u][q].x + v[u][q].y * v[u][q].y + v[u][q].z * v[u][q].z + v[u][q].w * v[u][q].w;
      s = wave_sum(s);
      const float rs = rsqrtf(s * (1.0f / DM) + EPSF);
      const float* m = mod + (size_t)((rr[u] < NLAT) ? (g * GB + bl[u]) : 8) * 6144;
      u32x2* hp = (u32x2*)(H + ((size_t)bl[u] * NTOK + rr[u]) * DM);
#pragma unroll
      for (int q = 0; q < 4; ++q) {
        const float4 gg = ((const float4*)ng)[q * 64 + lane];
        const float4 sc = ((const float4*)(m + off_sc))[q * 64 + lane];
        const float4 sh = ((const float4*)(m + off_sh))[q * 64 + lane];
        const float4 x = v[u][q];
        hp[q * 64 + lane] = (u32x2){pack2(x.x * rs * gg.x * (1.f + sc.x) + sh.x, x.y * rs * gg.y * (1.f + sc.y) + sh.y),
                                    pack2(x.z * rs * gg.z * (1.f + sc.z) + sh.z, x.w * rs * gg.w * (1.f + sc.w) + sh.w)};
      }
    }
  }
}

__device__ __forceinline__ void stage_inproj(const Params& p, const bf16_t* H, const bf16_t* WinT, bf16_t* Z, float* MGT, bf16_t* VT, bf16_t* MVT, char* smem) {
  EPI_DECL
  const int tm = GB * 34, tn = 53;
  const float2* rt = (const float2*)(p.ws + WB_ROPE);
  TileIter ti(tm, tn);
  int mt, j; bool valid;
  while (ti.next(mt, j, valid)) {
    if (!valid) continue;
    const int n0 = j * 128;
    const int lr0 = MT_LR0(mt, 34), rr0 = (mt % 34) * 128;
    f32x16 acc[2][2];
    if ((j >= 8 && j < 12) || (j >= 16 && j < 20)) {
      gemm_tile(WinT + (size_t)n0 * DM, DM, H + (size_t)lr0 * DM, DM, DM, smem, acc);
      bf16_t* vt = ((j < 12) ? VT : MVT) + ((size_t)(mt / 34) * 4 + (j & 3)) * 128 * NTOK;
#pragma unroll
      for (int mi = 0; mi < 2; ++mi)
#pragma unroll
        for (int ni = 0; ni < 2; ++ni)
#pragma unroll
          for (int q = 0; q < 4; ++q) {
            const int e = EPI_ROW(mi), tok = rr0 + EPI_COL(ni, q);
            *(u32x2*)(vt + (size_t)e * NTOK + tok) = (u32x2){pack2(acc[mi][ni][4 * q], acc[mi][ni][4 * q + 1]), pack2(acc[mi][ni][4 * q + 2], acc[mi][ni][4 * q + 3])};
          }
      continue;
    }
    gemm_tile(H + (size_t)lr0 * DM, DM, WinT + (size_t)n0 * DM, DM, DM, smem, acc);
    if (j < 8 && rr0 < NLAT) {
#pragma unroll
      for (int mi = 0; mi < 2; ++mi) {
        const int pos = rr0 + EPI_ROW(mi);
#pragma unroll
        for (int i = 0; i < 16; ++i) {
          const int jj = 8 * (i >> 2) + 4 * fh + (i & 3);
          const float2 cs = rt[pos * 32 + jj];
          const float x1 = acc[mi][0][i], x2 = acc[mi][1][i];
          acc[mi][0][i] = x1 * cs.x - x2 * cs.y;
          acc[mi][1][i] = x1 * cs.y + x2 * cs.x;
        }
      }
    }
    if (j < 52) {
      const bool sg = (j >= 28);
#pragma unroll
      for (int mi = 0; mi < 2; ++mi)
#pragma unroll
        for (int ni = 0; ni < 2; ++ni)
#pragma unroll
          for (int q = 0; q < 4; ++q) {
            const int row = lr0 + EPI_ROW(mi), c = n0 + EPI_COL(ni, q);
            float v0 = acc[mi][ni][4 * q], v1 = acc[mi][ni][4 * q + 1], v2 = acc[mi][ni][4 * q + 2], v3 = acc[mi][ni][4 * q + 3];
            if (sg) { v0 = sigmoidf_(v0); v1 = sigmoidf_(v1); v2 = sigmoidf_(v2); v3 = sigmoidf_(v3); }
            *(u32x2*)(Z + (size_t)row * ZW + c) = (u32x2){pack2(v0, v1), pack2(v2, v3)};
          }
    } else {
#pragma unroll
      for (int mi = 0; mi < 2; ++mi)
#pragma unroll
        for (int q = 0; q < 2; ++q) {
          const int row = lr0 + EPI_ROW(mi), c = EPI_COL(0, q);
          if (wn == 0) *(float4*)(MGT + (size_t)row * 16 + c) = make_float4(acc[mi][0][4 * q], acc[mi][0][4 * q + 1], acc[mi][0][4 * q + 2], acc[mi][0][4 * q + 3]);
        }
    }
  }
}

__device__ __forceinline__ void stage_conv(const Params& p, int l, const bf16_t* Z, bf16_t* XC) {
  const int tid = otid();
  const float* cw = p.in[I_CONVW] + (size_t)l * 3 * 512;
  const float* cb = p.in[I_CONVB] + (size_t)l * 512;
  const int c = tid * 2;
  const float2 w0 = *(const float2*)(cw + c), w1 = *(const float2*)(cw + 512 + c), w2 = *(const float2*)(cw + 1024 + c), bb = *(const float2*)(cb + c);
  for (int lr0 = blockIdx.x * 4; lr0 < RPG; lr0 += gridDim.x * 4) {
    unsigned xc[4], xp[4], xn[4];
#pragma unroll
    for (int u = 0; u < 4; ++u) {
      const int lr = lr0 + u, rr = lr % NTOK;
      const bool has_prev = (rr < NLAT) ? (rr > 0) : (rr > NLAT);
      const bool has_next = (rr < NLAT) ? (rr < NLAT - 1) : (rr < NTOK - 1);
      const bf16_t* z = Z + (size_t)lr * ZW + 1536 + c;
      xc[u] = *(const unsigned*)z;
      xp[u] = has_prev ? *(const unsigned*)(z - ZW) : 0u;
      xn[u] = has_next ? *(const unsigned*)(z + ZW) : 0u;
    }
#pragma unroll
    for (int u = 0; u < 4; ++u) {
      const float a0 = bb.x + w1.x * lo16(xc[u]) + w0.x * lo16(xp[u]) + w2.x * lo16(xn[u]);
      const float a1 = bb.y + w1.y * hi16(xc[u]) + w0.y * hi16(xp[u]) + w2.y * hi16(xn[u]);
      *(unsigned*)(XC + (size_t)(lr0 + u) * 512 + c) = pack2(siluf_(a0), siluf_(a1));
    }
  }
}

__device__ __forceinline__ void stage_mlqk(const bf16_t* XC, const bf16_t* WQK, bf16_t* QM, bf16_t* KM, bf16_t* KMT, char* smem) {
  EPI_DECL
  const int tm = RPG >> 7;
  TileIter ti(tm, 12);
  int mt, r12; bool valid;
  while (ti.next(mt, r12, valid)) {
    if (!valid) continue;
    const int h = r12 & 3, kind = r12 >> 2;
    const int m0 = mt * 128;
    f32x16 acc[2][2];
    const bf16_t* Wt = WQK + (size_t)h * 256 * 128 + (size_t)(kind ? 1 : 0) * 128 * 128;
    const bf16_t* Xt = XC + (size_t)m0 * 512 + h * 128;
    if (kind < 2) {
      gemm_tile(Xt, 512, Wt, 128, 128, smem, acc);
      bf16_t* O = kind ? KM : QM;
      const float alpha = kind ? 1.0f : 0.08838834764831845f;
#pragma unroll
      for (int mi = 0; mi < 2; ++mi)
#pragma unroll
        for (int ni = 0; ni < 2; ++ni)
#pragma unroll
          for (int q = 0; q < 4; ++q) {
            const int row = m0 + EPI_ROW(mi), c = EPI_COL(ni, q);
            *(u32x2*)(O + (size_t)row * 512 + h * 128 + c) = (u32x2){pack2(alpha * acc[mi][ni][4 * q], alpha * acc[mi][ni][4 * q + 1]), pack2(alpha * acc[mi][ni][4 * q + 2], alpha * acc[mi][ni][4 * q + 3])};
          }
    } else {
      gemm_tile(Wt, 128, Xt, 512, 128, smem, acc);
      bf16_t* kt = KMT + ((size_t)(mt / 34) * 4 + h) * 128 * NTOK + (mt % 34) * 128;
#pragma unroll
      for (int mi = 0; mi < 2; ++mi)
#pragma unroll
        for (int ni = 0; ni < 2; ++ni)
#pragma unroll
          for (int q = 0; q < 4; ++q) {
            const int d = EPI_ROW(mi), tok = EPI_COL(ni, q);
            *(u32x2*)(kt + (size_t)d * NTOK + tok) = (u32x2){pack2(acc[mi][ni][4 * q], acc[mi][ni][4 * q + 1]), pack2(acc[mi][ni][4 * q + 2], acc[mi][ni][4 * q + 3])};
          }
    }
  }
}

__device__ __forceinline__ void attn_mfma_item(const Params& p, int l, const bf16_t* Zb, const bf16_t* VTb, bf16_t* YAb, int h, int qrow0, int key0, int nkeys,
                                               float lam, float lam_init, char* smem) {
  const int tid = otid(), lane = tid & 63, w = tid >> 6, fr = lane & 31, fh = lane >> 5;
  const int rb = w & 1, m = w >> 1;
  const int ntiles = nkeys >> 6;
  const int myrow = qrow0 + rb * 32 + fr;
  bf16x8 qf[4];
  {
    const bf16_t* qp = Zb + (size_t)myrow * ZW + h * 128 + m * 64 + fh * 8;
#pragma unroll
    for (int ks = 0; ks < 4; ++ks) qf[ks] = *(const bf16x8*)(qp + ks * 16);
  }
  f32x16 O[4];
#pragma unroll
  for (int eb = 0; eb < 4; ++eb)
#pragma unroll
    for (int i = 0; i < 16; ++i) O[eb][i] = 0.f;
  float mrun = -1e30f, lrun = 0.f;
  const float cs = 0.125f * 1.4426950408889634f;
  const int skey = tid >> 4, sch = tid & 15;
  const bf16_t* ksrc = Zb + (size_t)(key0 + skey) * ZW + 512 + h * 128 + sch * 8;
  const int kdst = skey * 256 + ((sch ^ (skey & 15)) << 4);
  const int se = tid >> 3, svc = tid & 7;
  const bf16_t* vsrc = VTb + ((size_t)h * 128 + se) * NTOK + key0 + svc * 8;
  const int vsw = (se >> 1) & 15;
  const int vdst0 = se * 128 + (((2 * svc) ^ vsw) << 3), vdst1 = se * 128 + (((2 * svc + 1) ^ vsw) << 3);
  const int kfo = fr * 256, kfs = fr & 15;
  const int vfo = fr * 128, vfs = (fr >> 1) & 15;
  u32x4 rk[4], rv[4];
#pragma unroll
  for (int i = 0; i < 4; ++i) rk[i] = *(const u32x4*)(ksrc + (size_t)i * 16 * ZW);
  __syncthreads();
#pragma unroll
  for (int i = 0; i < 4; ++i) *(u32x4*)(smem + kdst + i * 4096) = rk[i];
  __syncthreads();
  bf16x8 pf[4];
#define ATT_S(T) { const char* kb_ = smem + ((T) & 1) * 16384; _Pragma("unroll") for (int kb = 0; kb < 2; ++kb) { \
      _Pragma("unroll") for (int i = 0; i < 16; ++i) S[kb][i] = 0.f; \
      _Pragma("unroll") for (int ks = 0; ks < 4; ++ks) { \
        const bf16x8 kf = *(const bf16x8*)(kb_ + kb * 8192 + kfo + (((m * 8 + ks * 2 + fh) ^ kfs) << 4)); \
        S[kb] = __builtin_amdgcn_mfma_f32_32x32x16_bf16(kf, qf[ks], S[kb], 0, 0, 0); } } }
#define ATT_MAX() { float tm = S[0][0]; \
      _Pragma("unroll") for (int i = 1; i < 16; ++i) tm = fmaxf(tm, S[0][i]); \
      _Pragma("unroll") for (int i = 0; i < 16; ++i) tm = fmaxf(tm, S[1][i]); \
      tm = fmaxf(tm, __shfl_xor(tm, 32)) * cs; alpha = 1.f; \
      if (tm > mrun + 8.0f) { alpha = __builtin_amdgcn_exp2f(mrun - tm); mrun = tm; } }
#define ATT_EXP(PF) { const float mc = mrun; float rs = 0.f; \
      _Pragma("unroll") for (int kb = 0; kb < 2; ++kb) { float pv[16]; \
        _Pragma("unroll") for (int i = 0; i < 16; ++i) { pv[i] = __builtin_amdgcn_exp2f(fmaf(S[kb][i], cs, -mc)); rs += pv[i]; } \
        _Pragma("unroll") for (int hh = 0; hh < 2; ++hh) \
          PF[kb * 2 + hh] = __builtin_bit_cast(bf16x8, (u32x4){pack2(pv[8 * hh], pv[8 * hh + 1]), pack2(pv[8 * hh + 2], pv[8 * hh + 3]), \
                                                               pack2(pv[8 * hh + 4], pv[8 * hh + 5]), pack2(pv[8 * hh + 6], pv[8 * hh + 7])}); } \
      lrun += rs; }
#define ATT_PV(T) { const char* vb_ = smem + 32768 + ((T) & 1) * 16384; _Pragma("unroll") for (int eb = 0; eb < 4; ++eb) _Pragma("unroll") for (int s = 0; s < 4; ++s) { \
        const u32x2 v0 = *(const u32x2*)(vb_ + eb * 4096 + vfo + (((4 * s + fh) ^ vfs) << 3)); \
        const u32x2 v1 = *(const u32x2*)(vb_ + eb * 4096 + vfo + (((4 * s + fh + 2) ^ vfs) << 3)); \
        const bf16x8 vf = __builtin_bit_cast(bf16x8, (u32x4){v0[0], v0[1], v1[0], v1[1]}); \
        O[eb] = __builtin_amdgcn_mfma_f32_32x32x16_bf16(vf, pf[s], O[eb], 0, 0, 0); } }
  f32x16 S[2];
  float alpha;
  {
#pragma unroll
    for (int i = 0; i < 4; ++i) rk[i] = *(const u32x4*)(ksrc + (size_t)(64 + i * 16) * ZW);
#pragma unroll
    for (int i = 0; i < 4; ++i) rv[i] = *(const u32x4*)(vsrc + (size_t)i * 32 * NTOK);
    ATT_S(0)
    ATT_MAX()
    ATT_EXP(pf)
#pragma unroll
    for (int i = 0; i < 4; ++i) *(u32x4*)(smem + 16384 + kdst + i * 4096) = rk[i];
#pragma unroll
    for (int i = 0; i < 4; ++i) {
      *(u32x2*)(smem + 32768 + vdst0 + i * 4096) = (u32x2){rv[i][0], rv[i][1]};
      *(u32x2*)(smem + 32768 + vdst1 + i * 4096) = (u32x2){rv[i][2], rv[i][3]};
    }
    __syncthreads();
  }
#pragma unroll 1
  for (int t = 1; t < ntiles; ++t) {
    const int tn = (t + 1 < ntiles) ? t + 1 : t;
#pragma unroll
    for (int i = 0; i < 4; ++i) rk[i] = *(const u32x4*)(ksrc + (size_t)(tn * 64 + i * 16) * ZW);
#pragma unroll
    for (int i = 0; i < 4; ++i) rv[i] = *(const u32x4*)(vsrc + (size_t)i * 32 * NTOK + t * 64);
    ATT_S(t)
    ATT_MAX()
    if (__any(alpha != 1.f)) {
#pragma unroll
      for (int eb = 0; eb < 4; ++eb)
#pragma unroll
        for (int i = 0; i < 16; ++i) O[eb][i] *= alpha;
      lrun *= alpha;
#pragma unroll
      for (int s = 0; s < 4; ++s) {
        const u32x4 r_ = __builtin_bit_cast(u32x4, pf[s]);
        pf[s] = __builtin_bit_cast(bf16x8, (u32x4){pack2(lo16(r_[0]) * alpha, hi16(r_[0]) * alpha), pack2(lo16(r_[1]) * alpha, hi16(r_[1]) * alpha),
                                                   pack2(lo16(r_[2]) * alpha, hi16(r_[2]) * alpha), pack2(lo16(r_[3]) * alpha, hi16(r_[3]) * alpha)});
      }
    }
    bf16x8 pn[4];
    {
      ATT_PV(t - 1)
      ATT_EXP(pn)
#pragma unroll
      for (int i = 0; i < 16; ++i) {
        __builtin_amdgcn_sched_group_barrier(0x100, 1, 0);
        __builtin_amdgcn_sched_group_barrier(0x008, 1, 0);
        __builtin_amdgcn_sched_group_barrier(0x002, 9, 0);
      }
    }
#pragma unroll
    for (int s = 0; s < 4; ++s) pf[s] = pn[s];
    if (t + 1 < ntiles) {
      char* kd = smem + ((t + 1) & 1) * 16384;
#pragma unroll
      for (int i = 0; i < 4; ++i) *(u32x4*)(kd + kdst + i * 4096) = rk[i];
    }
    {
      char* vd = smem + 32768 + (t & 1) * 16384;
#pragma unroll
      for (int i = 0; i < 4; ++i) {
        *(u32x2*)(vd + vdst0 + i * 4096) = (u32x2){rv[i][0], rv[i][1]};
        *(u32x2*)(vd + vdst1 + i * 4096) = (u32x2){rv[i][2], rv[i][3]};
      }
    }
    __syncthreads();
  }
  ATT_PV(ntiles - 1)
  __syncthreads();
#undef ATT_S
#undef ATT_MAX
#undef ATT_EXP
#undef ATT_PV
  const float lt = lrun + __shfl_xor(lrun, 32);
  const float sc = (m ? lam : 1.0f) / lt;
  float* xo = (float*)smem + rb * 4096;
  if (m == 1) {
#pragma unroll
    for (int eb = 0; eb < 4; ++eb)
#pragma unroll
      for (int i = 0; i < 16; ++i) xo[(eb * 32 + (i & 3) + 8 * (i >> 2) + 4 * fh) * 32 + fr] = O[eb][i] * sc;
  }
  __syncthreads();
  if (m == 0) {
    float ss = 0.f;
#pragma unroll
    for (int eb = 0; eb < 4; ++eb)
#pragma unroll
      for (int i = 0; i < 16; ++i) {
        const float o = O[eb][i] * sc - xo[(eb * 32 + (i & 3) + 8 * (i >> 2) + 4 * fh) * 32 + fr];
        O[eb][i] = o; ss = fmaf(o, o, ss);
      }
    ss += __shfl_xor(ss, 32);
    const float rn = rsqrtf(ss * (1.0f / 128.0f) + EPSF) * (1.0f - lam_init);
    const float* sg = p.in[I_SUBG] + l * 512 + h * 128;
    bf16_t* yp = YAb + (size_t)myrow * 512 + h * 128;
#pragma unroll
    for (int eb = 0; eb < 4; ++eb)
#pragma unroll
      for (int q = 0; q < 4; ++q) {
        const int e = eb * 32 + 8 * q + 4 * fh;
        const float4 g = *(const float4*)(sg + e);
        *(u32x2*)(yp + e) = (u32x2){pack2(O[eb][4 * q] * rn * g.x, O[eb][4 * q + 1] * rn * g.y), pack2(O[eb][4 * q + 2] * rn * g.z, O[eb][4 * q + 3] * rn * g.w)};
      }
  }
  __syncthreads();
}

__device__ __forceinline__ int mlstm_row0(int dir, int c) {
  return (dir == 0) ? ((c < 4) ? NLAT + 64 * c : 64 * (c - 4)) : ((c < 4) ? NLAT + 64 * (3 - c) : 64 * (67 - c));
}
__device__ __forceinline__ void stage_mlgates(const Params& p, int l, const float* MGT, float* GA) {
  const int tid = otid(), w = tid >> 6, lane = tid & 63;
  const int nitems = GB * 4 * 2 * 68;
  for (int idx = blockIdx.x * 4 + w; idx < nitems; idx += gridDim.x * 4) {
    const int c = idx % 68, r1 = idx / 68, dir = r1 & 1, h = (r1 >> 1) & 3, bl = r1 >> 3;
    const int row = mlstm_row0(dir, c) + lane;
    const float* mg = MGT + ((size_t)bl * NTOK + row) * 16;
    const float li = mg[dir * 8 + h] + p.in[I_GATEB][l * 16 + dir * 8 + h];
    const float x = mg[dir * 8 + 4 + h] + p.in[I_GATEB][l * 16 + dir * 8 + 4 + h];
    const float lf = fminf(x, 0.f) - log1pf(expf(-fabsf(x)));
    float b = lf;
#pragma unroll
    for (int o = 1; o < 64; o <<= 1) {
      const float v = (dir == 0) ? __shfl_up(b, o) : __shfl_down(b, o);
      const bool ok = (dir == 0) ? (lane >= o) : (lane + o < 64);
      if (ok) b += v;
    }
    const float tot = (dir == 0) ? __shfl(b, 63) : __shfl(b, 0);
    float* ga = GA + (size_t)idx * 272;
    ga[lane] = b * 1.4426950408889634f; ga[64 + lane] = (li - b) * 1.4426950408889634f; ga[128 + lane] = expf(tot + li - b); ga[192 + lane] = expf(b);
    if (lane < 4) ga[256 + lane] = expf(tot);
  }
}

__device__ __forceinline__ void mlstm_chain_item(const Params& p, int l, const bf16_t* QMb, const bf16_t* KMb, const bf16_t* KMTb, const bf16_t* MVTb,
                                                 const float* GAc, bf16_t* HXb, int h, int dir, char* smem) {
  const int tid = otid(), lane = tid & 63, w = tid >> 6, fr = lane & 31, fh = lane >> 5;
  const int tb = w & 1, eh = w >> 1;
  float* fl = (float*)(smem + 98304);
  float* bs = fl; float* as_ = fl + 64; float* wgs = fl + 128; float* ebs = fl + 192; float* dec_s = fl + 256; float* nprev = fl + 272; float* npart = fl + 400;
  f32x16 CT[4];
#pragma unroll
  for (int eb = 0; eb < 4; ++eb)
#pragma unroll
    for (int i = 0; i < 16; ++i) CT[eb][i] = 0.f;
  __syncthreads();
  for (int i = tid; i < 2048; i += 256) ((u32x4*)(smem + 65536))[i] = (u32x4){0u, 0u, 0u, 0u};
  if (tid < 128) nprev[tid] = 0.f;
  const int qr = tid >> 4, qc = tid & 15;
  const int qdst = qr * 256 + ((qc ^ (qr & 15)) << 4);
  const int tr = tid >> 3, tc = tid & 7;
  const int tdst = tr * 128 + ((tc ^ ((tr >> 1) & 7)) << 4);
  const int sw16 = fr & 15, sw8 = (fr >> 1) & 7;
  u32x4 ra[4], rb[4], rc[4], rd[4];
  float4 rg = make_float4(0.f, 0.f, 0.f, 0.f);
  {
    const int row0 = mlstm_row0(dir, 0);
    const bf16_t* qs = QMb + (size_t)(row0 + qr) * 512 + h * 128 + qc * 8;
    const bf16_t* ks = KMb + (size_t)(row0 + qr) * 512 + h * 128 + qc * 8;
    const bf16_t* kts = KMTb + ((size_t)h * 128 + tr) * NTOK + row0 + tc * 8;
    const bf16_t* vts = MVTb + ((size_t)h * 128 + tr) * NTOK + row0 + tc * 8;
#pragma unroll
    for (int i = 0; i < 4; ++i) {
      ra[i] = *(const u32x4*)(qs + (size_t)i * 16 * 512);
      rb[i] = *(const u32x4*)(ks + (size_t)i * 16 * 512);
      rc[i] = *(const u32x4*)(kts + (size_t)i * 32 * NTOK);
      rd[i] = *(const u32x4*)(vts + (size_t)i * 32 * NTOK);
    }
    if (tid < 68) rg = ((const float4*)GAc)[tid];
  }
#pragma unroll 1
  for (int c = 0; c < 68; ++c) {
    const int row0 = mlstm_row0(dir, c);
    __syncthreads();
#pragma unroll
    for (int i = 0; i < 4; ++i) {
      *(u32x4*)(smem + qdst + i * 4096) = ra[i];
      *(u32x4*)(smem + 16384 + qdst + i * 4096) = rb[i];
      *(u32x4*)(smem + 32768 + tdst + i * 4096) = rc[i];
      *(u32x4*)(smem + 49152 + tdst + i * 4096) = rd[i];
    }
    if (tid < 68) ((float4*)fl)[tid] = rg;
    if (c + 1 < 68) {
      const int rown = mlstm_row0(dir, c + 1);
      const bf16_t* qs = QMb + (size_t)(rown + qr) * 512 + h * 128 + qc * 8;
      const bf16_t* ks = KMb + (size_t)(rown + qr) * 512 + h * 128 + qc * 8;
      const bf16_t* kts = KMTb + ((size_t)h * 128 + tr) * NTOK + rown + tc * 8;
      const bf16_t* vts = MVTb + ((size_t)h * 128 + tr) * NTOK + rown + tc * 8;
#pragma unroll
      for (int i = 0; i < 4; ++i) {
        ra[i] = *(const u32x4*)(qs + (size_t)i * 16 * 512);
        rb[i] = *(const u32x4*)(ks + (size_t)i * 16 * 512);
        rc[i] = *(const u32x4*)(kts + (size_t)i * 32 * NTOK);
        rd[i] = *(const u32x4*)(vts + (size_t)i * 32 * NTOK);
      }
      if (tid < 68) rg = ((const float4*)(GAc + (size_t)(c + 1) * 272))[tid];
    }
    __syncthreads();
    const int t = tb * 32 + fr;
    bf16x8 qf[8];
#pragma unroll
    for (int ks = 0; ks < 8; ++ks) qf[ks] = *(const bf16x8*)(smem + t * 256 + (((ks * 2 + fh) ^ sw16) << 4));
    const float bt = bs[t], ebt = ebs[t];
    f32x16 S[2];
    float dsum = 0.f;
#pragma unroll
    for (int sb = 0; sb < 2; ++sb) {
#pragma unroll
      for (int i = 0; i < 16; ++i) S[sb][i] = 0.f;
      const bool valid = (dir == 0) ? (sb <= tb) : (sb >= tb);
      if (valid) {
#pragma unroll
        for (int ks = 0; ks < 8; ++ks) {
          const bf16x8 kf = *(const bf16x8*)(smem + 16384 + (sb * 32 + fr) * 256 + (((ks * 2 + fh) ^ sw16) << 4));
          S[sb] = __builtin_amdgcn_mfma_f32_32x32x16_bf16(kf, qf[ks], S[sb], 0, 0, 0);
        }
#pragma unroll
        for (int q = 0; q < 4; ++q) {
          const float4 a4 = *(const float4*)(as_ + sb * 32 + 8 * q + 4 * fh);
          const float av[4] = {a4.x, a4.y, a4.z, a4.w};
#pragma unroll
          for (int j = 0; j < 4; ++j) {
            const int s = sb * 32 + 8 * q + 4 * fh + j;
            const bool ok = (dir == 0) ? (s <= t) : (s >= t);
            const float v = ok ? S[sb][4 * q + j] * __builtin_amdgcn_exp2f(bt + av[j]) : 0.f;
            S[sb][4 * q + j] = v;
            dsum += v;
          }
        }
      }
    }
    bf16x8 pf[4];
#pragma unroll
    for (int sb = 0; sb < 2; ++sb)
#pragma unroll
      for (int hh = 0; hh < 2; ++hh)
        pf[sb * 2 + hh] = __builtin_bit_cast(bf16x8, (u32x4){pack2(S[sb][8 * hh], S[sb][8 * hh + 1]), pack2(S[sb][8 * hh + 2], S[sb][8 * hh + 3]),
                                                                 pack2(S[sb][8 * hh + 4], S[sb][8 * hh + 5]), pack2(S[sb][8 * hh + 6], S[sb][8 * hh + 7])});
    float nq = 0.f;
#pragma unroll
    for (int c8 = 0; c8 < 8; ++c8) {
      const u32x4 qv = *(const u32x4*)(smem + t * 256 + (((fh * 8 + c8) ^ sw16) << 4));
      const float4 n0 = *(const float4*)(nprev + fh * 64 + c8 * 8), n1 = *(const float4*)(nprev + fh * 64 + c8 * 8 + 4);
      nq = fmaf(lo16(qv[0]), n0.x, nq); nq = fmaf(hi16(qv[0]), n0.y, nq); nq = fmaf(lo16(qv[1]), n0.z, nq); nq = fmaf(hi16(qv[1]), n0.w, nq);
      nq = fmaf(lo16(qv[2]), n1.x, nq); nq = fmaf(hi16(qv[2]), n1.y, nq); nq = fmaf(lo16(qv[3]), n1.z, nq); nq = fmaf(hi16(qv[3]), n1.w, nq);
    }
    dsum += __shfl_xor(dsum, 32);
    nq += __shfl_xor(nq, 32);
    const float den = dsum + ebt * nq;
    const float inv = 1.0f / fmaxf(fabsf(den), 1.0f);
#pragma unroll
    for (int x = 0; x < 2; ++x) {
      const int eb = 2 * eh + x;
      f32x16 N;
#pragma unroll
      for (int i = 0; i < 16; ++i) N[i] = 0.f;
#pragma unroll
      for (int ks = 0; ks < 8; ++ks) {
        const bf16x8 cf = *(const bf16x8*)(smem + 65536 + (eb * 32 + fr) * 256 + (((ks * 2 + fh) ^ sw16) << 4));
        N = __builtin_amdgcn_mfma_f32_32x32x16_bf16(cf, qf[ks], N, 0, 0, 0);
      }
#pragma unroll
      for (int i = 0; i < 16; ++i) N[i] *= ebt;
#pragma unroll
      for (int s4 = 0; s4 < 4; ++s4) {
        const bool valid = (dir == 0) ? ((s4 >> 1) <= tb) : ((s4 >> 1) >= tb);
        if (valid) {
          const int u0 = 4 * s4 + fh, u1 = u0 + 2;
          const char* vrow = smem + 49152 + (eb * 32 + fr) * 128;
          const u32x2 v0 = *(const u32x2*)(vrow + (((u0 >> 1) ^ sw8) << 4) + (u0 & 1) * 8);
          const u32x2 v1 = *(const u32x2*)(vrow + (((u1 >> 1) ^ sw8) << 4) + (u1 & 1) * 8);
          const bf16x8 vf = __builtin_bit_cast(bf16x8, (u32x4){v0[0], v0[1], v1[0], v1[1]});
          N = __builtin_amdgcn_mfma_f32_32x32x16_bf16(vf, pf[s4], N, 0, 0, 0);
        }
      }
      bf16_t* hp = HXb + (size_t)(row0 + t) * 512 + h * 128 + eb * 32 + 4 * fh;
#pragma unroll
      for (int q = 0; q < 4; ++q)
        *(u32x2*)(hp + 8 * q) = (u32x2){pack2(N[4 * q] * inv, N[4 * q + 1] * inv), pack2(N[4 * q + 2] * inv, N[4 * q + 3] * inv)};
    }
    const float decay = *dec_s;
#pragma unroll
    for (int eb = 0; eb < 4; ++eb)
#pragma unroll
      for (int i = 0; i < 16; ++i) CT[eb][i] *= decay;
#pragma unroll
    for (int ks = 0; ks < 4; ++ks) {
      const u32x4 kraw = *(const u32x4*)(smem + 32768 + (w * 32 + fr) * 128 + (((ks * 2 + fh) ^ sw8) << 4));
      const float4 g0 = *(const float4*)(wgs + ks * 16 + 8 * fh), g1 = *(const float4*)(wgs + ks * 16 + 8 * fh + 4);
      const bf16x8 kts = __builtin_bit_cast(bf16x8, (u32x4){pack2(lo16(kraw[0]) * g0.x, hi16(kraw[0]) * g0.y), pack2(lo16(kraw[1]) * g0.z, hi16(kraw[1]) * g0.w),
                                                             pack2(lo16(kraw[2]) * g1.x, hi16(kraw[2]) * g1.y), pack2(lo16(kraw[3]) * g1.z, hi16(kraw[3]) * g1.w)});
#pragma unroll
      for (int eb = 0; eb < 4; ++eb) {
        const bf16x8 vt = *(const bf16x8*)(smem + 49152 + (eb * 32 + fr) * 128 + (((ks * 2 + fh) ^ sw8) << 4));
        CT[eb] = __builtin_amdgcn_mfma_f32_32x32x16_bf16(kts, vt, CT[eb], 0, 0, 0);
      }
    }
    {
      const int d = tid & 127, sh = tid >> 7;
      float a = 0.f;
#pragma unroll 8
      for (int s = sh * 32; s < sh * 32 + 32; ++s) {
        const bf16_t kv = *(const bf16_t*)(smem + 16384 + s * 256 + ((((d >> 3)) ^ (s & 15)) << 4) + (d & 7) * 2);
        a = fmaf(wgs[s], bf2f(kv), a);
      }
      npart[sh * 128 + d] = a;
    }
    __syncthreads();
#pragma unroll
    for (int eb = 0; eb < 4; ++eb)
#pragma unroll
      for (int q = 0; q < 4; ++q)
        *(u32x2*)(smem + 65536 + (eb * 32 + fr) * 256 + ((((w * 4 + q)) ^ sw16) << 4) + 8 * fh) =
            (u32x2){pack2(CT[eb][4 * q], CT[eb][4 * q + 1]), pack2(CT[eb][4 * q + 2], CT[eb][4 * q + 3])};
    if (tid < 128) nprev[tid] = decay * nprev[tid] + npart[tid] + npart[128 + tid];
  }
  __syncthreads();
}

#define S5SEG 128
#define S5NSEG 34
__device__ __forceinline__ int s5_row(int dir, int step) {
  return (dir == 0) ? ((step < NCTX) ? NLAT + step : step - NCTX)
                    : ((step < NCTX) ? NLAT + (NCTX - 1 - step) : (NLAT - 1) - (step - NCTX));
}
__device__ __forceinline__ bf16x8 pack8(const float* f) {
  return __builtin_bit_cast(bf16x8, (u32x4){pack2(f[0], f[1]), pack2(f[2], f[3]), pack2(f[4], f[5]), pack2(f[6], f[7])});
}
struct S5M { float abr, abi, a128r, a128i; bf16x8 bbf[4]; };
__device__ __forceinline__ void s5m_setup(const Params& p, int pg, int lane, S5M& m) {
  const int fr = lane & 31, fh = lane >> 5;
  const float dt = expf(p.in[I_S5DT][pg]);
  m.abr = 0.f; m.abi = 0.f; m.a128r = 0.f; m.a128i = 0.f;
#pragma unroll
  for (int c = 0; c < 2; ++c) {
    const int n = fr + 32 * c;
    const float lre = p.in[I_S5LRE][pg * 64 + n], lim = p.in[I_S5LIM][pg * 64 + n];
    const float mag = expf(lre * dt);
    const float abr = mag * cosf(lim * dt), abi = mag * sinf(lim * dt);
    const float den = lre * lre + lim * lim;
    const float zr = ((abr - 1.0f) * lre + abi * lim) / den;
    const float zi = (abi * lre - (abr - 1.0f) * lim) / den;
    const float4* br4 = (const float4*)(p.in[I_S5BRE] + ((size_t)pg * 64 + n) * 16 + 8 * fh);
    const float4* bi4 = (const float4*)(p.in[I_S5BIM] + ((size_t)pg * 64 + n) * 16 + 8 * fh);
    const float4 b0 = br4[0], b1 = br4[1], c0 = bi4[0], c1 = bi4[1];
    const float br[8] = {b0.x, b0.y, b0.z, b0.w, b1.x, b1.y, b1.z, b1.w}, bi[8] = {c0.x, c0.y, c0.z, c0.w, c1.x, c1.y, c1.z, c1.w};
    float rr[8], ii[8];
#pragma unroll
    for (int j = 0; j < 8; ++j) { rr[j] = zr * br[j] - zi * bi[j]; ii[j] = zr * bi[j] + zi * br[j]; }
    m.bbf[c] = pack8(rr); m.bbf[2 + c] = pack8(ii);
    if (fh == c) {
      m.abr = abr; m.abi = abi;
      const float mg = expf(lre * dt * (float)S5SEG);
      m.a128r = mg * cosf(lim * dt * (float)S5SEG); m.a128i = mg * sinf(lim * dt * (float)S5SEG);
    }
  }
}
template <bool STORE>
__device__ __forceinline__ void s5m_block(const S5M& m, const bf16x8 uf, float& xr, float& xi, char* xs, int lane) {
  f32x16 T[4];
#pragma unroll
  for (int k = 0; k < 4; ++k) {
#pragma unroll
    for (int i = 0; i < 16; ++i) T[k][i] = 0.f;
    T[k] = __builtin_amdgcn_mfma_f32_32x32x16_bf16(uf, m.bbf[k], T[k], 0, 0, 0);
  }
#pragma unroll
  for (int r = 0; r < 16; ++r) {
    auto a = __builtin_amdgcn_permlane32_swap(__float_as_uint(T[0][r]), __float_as_uint(T[1][r]), false, false);
    T[0][r] = __uint_as_float(a[0]); T[1][r] = __uint_as_float(a[1]);
    auto b = __builtin_amdgcn_permlane32_swap(__float_as_uint(T[2][r]), __float_as_uint(T[3][r]), false, false);
    T[2][r] = __uint_as_float(b[0]); T[3][r] = __uint_as_float(b[1]);
  }
#pragma unroll
  for (int q = 0; q < 4; ++q)
#pragma unroll
    for (int hh = 0; hh < 2; ++hh)
#pragma unroll
      for (int j = 0; j < 4; ++j) {
        const int t = 8 * q + 4 * hh + j, r = 4 * q + j;
        const float bre = hh ? T[1][r] : T[0][r], bim = hh ? T[3][r] : T[2][r];
        const float nr = fmaf(m.abr, xr, fmaf(-m.abi, xi, bre));
        const float ni = fmaf(m.abr, xi, fmaf(m.abi, xr, bim));
        xr = nr; xi = ni;
        if (STORE) *(unsigned*)(xs + t * 256 + (((lane >> 2) ^ (t & 15)) << 4) + (lane & 3) * 4) = pack2(xr, xi);
      }
}
__device__ __forceinline__ void stage_s5_pass1(const Params& p, int l, const bf16_t* Z, float* XE) {
  const int tid = otid(), w = tid >> 6, lane = tid & 63, fr = lane & 31, fh = lane >> 5;
  const int nitems = GB * 32 * 2 * (S5NSEG - 1);
  for (int idx = blockIdx.x * 4 + w; idx < nitems; idx += gridDim.x * 4) {
    const int seg = idx % (S5NSEG - 1), r1 = idx / (S5NSEG - 1), dir = r1 & 1, g = (r1 >> 1) & 31, bl = r1 >> 6;
    S5M m;
    s5m_setup(p, (l * 2 + dir) * 32 + g, lane, m);
    float xr = 0.f, xi = 0.f;
#pragma unroll 1
    for (int sub = 0; sub < S5SEG / 32; ++sub) {
      const int row = s5_row(dir, seg * S5SEG + sub * 32 + fr);
      const bf16x8 uf = *(const bf16x8*)(Z + ((size_t)bl * NTOK + row) * ZW + 3072 + g * 16 + 8 * fh);
      s5m_block<false>(m, uf, xr, xi, nullptr, lane);
    }
    float* xe = XE + ((((size_t)bl * 32 + g) * 2 + dir) * (S5NSEG - 1) + seg) * 128;
    xe[lane] = xr; xe[64 + lane] = xi;
  }
}
__device__ __forceinline__ void s5_item(const Params& p, int l, const bf16_t* Zb, const float* XEc, float* Yb, int g, int dir, int sq, char* smem) {
  const int tid = otid(), w = tid >> 6, lane = tid & 63, fr = lane & 31, fh = lane >> 5;
  const int seg = sq * 4 + w;
  char* xs = smem + w * 8192;
  const int pg = (l * 2 + dir) * 32 + g;
  __syncthreads();
  if (seg < S5NSEG) {
    S5M m;
    s5m_setup(p, pg, lane, m);
    bf16x8 ccf[8];
#pragma unroll
    for (int ks = 0; ks < 8; ++ks) {
      float f[8] = {0.f, 0.f, 0.f, 0.f, 0.f, 0.f, 0.f, 0.f};
      if (fr < 16) {
        const float4 cr = *(const float4*)(p.in[I_S5CRE] + ((size_t)pg * 16 + fr) * 64 + ks * 8 + 4 * fh);
        const float4 ci = *(const float4*)(p.in[I_S5CIM] + ((size_t)pg * 16 + fr) * 64 + ks * 8 + 4 * fh);
        f[0] = cr.x; f[1] = -ci.x; f[2] = cr.y; f[3] = -ci.y; f[4] = cr.z; f[5] = -ci.z; f[6] = cr.w; f[7] = -ci.w;
      }
      ccf[ks] = pack8(f);
    }
    float xr = 0.f, xi = 0.f;
    for (int j = 0; j < seg; ++j) {
      const float er = XEc[j * 128 + lane], ei = XEc[j * 128 + 64 + lane];
      const float nr = m.a128r * xr - m.a128i * xi + er, ni = m.a128r * xi + m.a128i * xr + ei;
      xr = nr; xi = ni;
    }
#pragma unroll 1
    for (int sub = 0; sub < S5SEG / 32; ++sub) {
      const int row = s5_row(dir, seg * S5SEG + sub * 32 + fr);
      const bf16x8 uf = *(const bf16x8*)(Zb + (size_t)row * ZW + 3072 + g * 16 + 8 * fh);
      s5m_block<true>(m, uf, xr, xi, xs, lane);
      f32x16 Y;
#pragma unroll
      for (int i = 0; i < 16; ++i) Y[i] = 0.f;
#pragma unroll
      for (int ks = 0; ks < 8; ++ks) {
        const bf16x8 xf = *(const bf16x8*)(xs + fr * 256 + (((ks * 2 + fh) ^ (fr & 15)) << 4));
        Y = __builtin_amdgcn_mfma_f32_32x32x16_bf16(ccf[ks], xf, Y, 0, 0, 0);
      }
      float* yp = Yb + (size_t)row * 512 + g * 16 + 4 * fh;
      *(float4*)yp = make_float4(Y[0], Y[1], Y[2], Y[3]);
      *(float4*)(yp + 8) = make_float4(Y[4], Y[5], Y[6], Y[7]);
    }
  }
}

__device__ __forceinline__ void stage_post(const Params& p, int l, int rr_lim, const bf16_t* Z, const bf16_t* HF, const bf16_t* HB,
                                           const float* YSF, const float* YSB, bf16_t* YB, bf16_t* GG) {
  const int tid = otid();
  const int c0 = tid * 2;
  const float2 gml = *(const float2*)(p.in[I_MLNG] + l * 512 + c0);
  const float2 dsk = *(const float2*)(p.in[I_S5D] + l * 512 + c0);
  const int n = GB * rr_lim;
  for (int i0 = blockIdx.x * 4; i0 < n; i0 += gridDim.x * 4) {
    unsigned a0[4], a1[4], og[4], uu[4];
    float2 f[4], b[4];
    size_t r[4];
#pragma unroll
    for (int u = 0; u < 4; ++u) {
      const int i = i0 + u;
      r[u] = (size_t)(i / rr_lim) * NTOK + (i % rr_lim);
      a0[u] = *(const unsigned*)(HF + r[u] * 512 + c0); a1[u] = *(const unsigned*)(HB + r[u] * 512 + c0);
      og[u] = *(const unsigned*)(Z + r[u] * ZW + 2560 + c0); uu[u] = *(const unsigned*)(Z + r[u] * ZW + 3072 + c0);
      f[u] = *(const float2*)(YSF + r[u] * 512 + c0); b[u] = *(const float2*)(YSB + r[u] * 512 + c0);
    }
#pragma unroll
    for (int u = 0; u < 4; ++u) {
      const float h0 = lo16(a0[u]) + lo16(a1[u]), h1 = hi16(a0[u]) + hi16(a1[u]);
      const float ss = wave_sum(h0 * h0 + h1 * h1);
      const float rs = rsqrtf(ss * (1.0f / 128.0f) + EPSF);
      *(unsigned*)(YB + r[u] * 512 + c0) = pack2(h0 * rs * gml.x * sigmoidf_(lo16(og[u])), h1 * rs * gml.y * sigmoidf_(hi16(og[u])));
      *(unsigned*)(GG + r[u] * 512 + c0) = pack2(geluf_(dsk.x * lo16(uu[u]) + f[u].x + b[u].x), geluf_(dsk.y * hi16(uu[u]) + f[u].y + b[u].y));
    }
  }
}

__device__ __forceinline__ void stage_glu_mfma(const Params& p, int l, int tpb, const bf16_t* GG, const bf16_t* GLUT, bf16_t* YS, char* smem) {
  EPI_DECL
  const int tm = GB * tpb;
  TileIter ti(tm, 4);
  int mt_, nt_; bool valid;
  while (ti.next(mt_, nt_, valid)) {
    if (!valid) continue;
    const int m0 = MT_LR0(mt_, tpb), n0 = nt_ * 128;
    f32x16 acc[2][2];
    gemm_tile(GG + (size_t)m0 * 512, 512, GLUT + (size_t)n0 * 512, 512, 512, smem, acc);
#pragma unroll
    for (int mi = 0; mi < 2; ++mi)
#pragma unroll
      for (int ni = 0; ni < 2; ++ni)
#pragma unroll
        for (int q = 0; q < 4; ++q) {
          const int row = m0 + EPI_ROW(mi), c = n0 + EPI_COL(ni, q);
          const float4 b = *(const float4*)(p.in[I_GLUB] + l * 512 + c);
          const u32x2 g2 = *(const u32x2*)(GG + (size_t)row * 512 + c);
          const float o0 = lo16(g2[0]) * sigmoidf_(acc[mi][ni][4 * q] + b.x), o1 = hi16(g2[0]) * sigmoidf_(acc[mi][ni][4 * q + 1] + b.y);
          const float o2 = lo16(g2[1]) * sigmoidf_(acc[mi][ni][4 * q + 2] + b.z), o3 = hi16(g2[1]) * sigmoidf_(acc[mi][ni][4 * q + 3] + b.w);
          *(u32x2*)(YS + (size_t)row * 512 + c) = (u32x2){pack2(o0, o1), pack2(o2, o3)};
        }
  }
}

__device__ __forceinline__ void stage_merge_mfma(int tpb, const bf16_t* YA, const bf16_t* YB, const bf16_t* YS, const bf16_t* WBR, const bf16_t* Z, bf16_t* MG, char* smem) {
  EPI_DECL
  const int tm = GB * tpb;
  TileIter ti(tm, 8);
  int mt_, nt_; bool valid;
  while (ti.next(mt_, nt_, valid)) {
    if (!valid) continue;
    const int m0 = MT_LR0(mt_, tpb), n0 = nt_ * 128;
    f32x16 macc[2][2];
#pragma unroll
    for (int a = 0; a < 2; ++a)
#pragma unroll
      for (int b = 0; b < 2; ++b)
#pragma unroll
        for (int i = 0; i < 16; ++i) macc[a][b][i] = 0.f;
#pragma unroll 1
    for (int r = 0; r < 3; ++r) {
      const bf16_t* Y = (r == 0) ? YA : (r == 1 ? YB : YS);
      f32x16 acc[2][2];
      gemm_tile(Y + (size_t)m0 * 512, 512, WBR + (size_t)r * 1024 * 512 + (size_t)n0 * 512, 512, 512, smem, acc);
#pragma unroll
      for (int mi = 0; mi < 2; ++mi)
#pragma unroll
        for (int ni = 0; ni < 2; ++ni)
#pragma unroll
          for (int q = 0; q < 4; ++q) {
            const int row = m0 + EPI_ROW(mi), c = n0 + EPI_COL(ni, q);
            const u32x2 e = *(const u32x2*)(Z + (size_t)row * ZW + 3584 + r * 1024 + c);
            macc[mi][ni][4 * q] += lo16(e[0]) * acc[mi][ni][4 * q];
            macc[mi][ni][4 * q + 1] += hi16(e[0]) * acc[mi][ni][4 * q + 1];
            macc[mi][ni][4 * q + 2] += lo16(e[1]) * acc[mi][ni][4 * q + 2];
            macc[mi][ni][4 * q + 3] += hi16(e[1]) * acc[mi][ni][4 * q + 3];
          }
    }
#pragma unroll
    for (int mi = 0; mi < 2; ++mi)
#pragma unroll
      for (int ni = 0; ni < 2; ++ni)
#pragma unroll
        for (int q = 0; q < 4; ++q) {
          const int row = m0 + EPI_ROW(mi), c = n0 + EPI_COL(ni, q);
          *(u32x2*)(MG + (size_t)row * DM + c) = (u32x2){pack2(macc[mi][ni][4 * q], macc[mi][ni][4 * q + 1]), pack2(macc[mi][ni][4 * q + 2], macc[mi][ni][4 * q + 3])};
        }
  }
}

__device__ __forceinline__ void stage_outproj_mfma(const Params& p, int l, int g, int tpb, const bf16_t* MG, const bf16_t* WOUT, char* smem) {
  EPI_DECL
  const int tm = GB * tpb;
  const float* mod = (const float*)(p.ws + WB_MOD) + (size_t)l * 9 * 6144;
  TileIter ti(tm, 8);
  int mt, nt_; bool valid;
  while (ti.next(mt, nt_, valid)) {
    if (!valid) continue;
    const int n0 = nt_ * 128;
    const int m0 = MT_LR0(mt, tpb), bl = mt / tpb, rr0 = (mt % tpb) * 128, b = g * GB + bl;
    f32x16 acc[2][2];
    gemm_tile(MG + (size_t)m0 * DM, DM, WOUT + (size_t)n0 * DM, DM, DM, smem, acc);
    const float* gv = mod + (size_t)((rr0 < NLAT) ? b : 8) * 6144 + 2 * 1024;
#pragma unroll
    for (int mi = 0; mi < 2; ++mi)
#pragma unroll
      for (int ni = 0; ni < 2; ++ni)
#pragma unroll
        for (int q = 0; q < 4; ++q) {
          const int rr = rr0 + EPI_ROW(mi), c = n0 + EPI_COL(ni, q);
          const float4 gg = *(const float4*)(gv + c);
          float4* xp = (float4*)(xrow(p, b, rr) + c);
          float4 x = (l == 0) ? *(const float4*)(xrow_in(p, b, rr) + c) : *xp;
          x.x += gg.x * acc[mi][ni][4 * q]; x.y += gg.y * acc[mi][ni][4 * q + 1]; x.z += gg.z * acc[mi][ni][4 * q + 2]; x.w += gg.w * acc[mi][ni][4 * q + 3];
          *xp = x;
        }
  }
}

__device__ __forceinline__ void stage_peerq_mfma(int tpb, const bf16_t* H2, const bf16_t* WQ, bf16_t* PQ, char* smem) {
  EPI_DECL
  const int tm = GB * tpb;
  TileIter ti(tm, 16);
  int mt_, nt_; bool valid;
  while (ti.next(mt_, nt_, valid)) {
    if (!valid) continue;
    const int m0 = MT_LR0(mt_, tpb), n0 = nt_ * 128;
    f32x16 acc[2][2];
    gemm_tile(H2 + (size_t)m0 * DM, DM, WQ + (size_t)n0 * DM, DM, DM, smem, acc);
#pragma unroll
    for (int mi = 0; mi < 2; ++mi)
#pragma unroll
      for (int ni = 0; ni < 2; ++ni)
#pragma unroll
        for (int q = 0; q < 4; ++q) {
          const int row = m0 + EPI_ROW(mi), c = n0 + EPI_COL(ni, q);
          *(u32x2*)(PQ + (size_t)row * 2048 + c) = (u32x2){pack2(acc[mi][ni][4 * q], acc[mi][ni][4 * q + 1]), pack2(acc[mi][ni][4 * q + 2], acc[mi][ni][4 * q + 3])};
        }
  }
}

__device__ __forceinline__ void stage_scores_mfma(int tpb, const bf16_t* PQ, const bf16_t* SUBK, float* SCT, char* smem) {
  EPI_DECL
  const int tm = GB * tpb * 8;
  for (int t = blockIdx.x; t < tm * 2; t += gridDim.x) {
    const int mt = t >> 1, half = t & 1;
    const size_t m0 = (size_t)MT_LR0(mt >> 3, tpb) * 8 + (size_t)(mt & 7) * 128;
    f32x16 acc[2][2];
    gemm_tile(SUBK + (size_t)half * 16384, 128, PQ + m0 * 256 + half * 128, 256, 128, smem, acc);
    float* o = SCT + ((size_t)mt * 2 + half) * 16384;
#pragma unroll
    for (int mi = 0; mi < 2; ++mi)
#pragma unroll
      for (int ni = 0; ni < 2; ++ni)
#pragma unroll
        for (int q = 0; q < 4; ++q) {
          const int key = EPI_ROW(mi), item = EPI_COL(ni, q);
          *(float4*)(o + key * 128 + item) = make_float4(acc[mi][ni][4 * q], acc[mi][ni][4 * q + 1], acc[mi][ni][4 * q + 2], acc[mi][ni][4 * q + 3]);
        }
  }
}

__device__ __forceinline__ unsigned f2sortable(float x) { const unsigned u = __float_as_uint(x); return (u & 0x80000000u) ? ~u : (u | 0x80000000u); }
__device__ __forceinline__ float sortable2f(unsigned k) { return __uint_as_float((k & 0x80000000u) ? (k & 0x7fffffffu) : ~k); }
#define TOPK_INSERT(v, key) { unsigned t_ = (key); _Pragma("unroll") for (int s_ = 0; s_ < 16; ++s_) { const unsigned hi_ = max(v[s_], t_); t_ = min(v[s_], t_); v[s_] = hi_; } }
__device__ __forceinline__ void stage_topk(int tpb, const float* SCT, int* EI, float* EG, float* smem) {
  const int tid = otid();
  const int item = tid & 127, half = tid >> 7;
  unsigned* xk = (unsigned*)smem;
  const int tm = GB * tpb * 8;
  for (int mt = blockIdx.x; mt < tm; mt += gridDim.x) {
    const size_t m0 = (size_t)MT_LR0(mt >> 3, tpb) * 8 + (size_t)(mt & 7) * 128;
    const float* sc = SCT + ((size_t)mt * 2 + half) * 16384 + item;
    unsigned v[16];
#pragma unroll
    for (int s = 0; s < 16; ++s) v[s] = 0u;
#pragma unroll 1
    for (int k0 = 0; k0 < 128; k0 += 32) {
      float sv[32];
#pragma unroll
      for (int k = 0; k < 32; ++k) sv[k] = sc[(k0 + k) * 128];
#pragma unroll
      for (int k = 0; k < 32; ++k) {
        const unsigned key = (f2sortable(sv[k]) & ~127u) | (unsigned)(127 - (k0 + k));
        TOPK_INSERT(v, key)
      }
    }
    __syncthreads();
    if (half == 1) {
#pragma unroll
      for (int s = 0; s < 16; ++s) xk[item * 17 + s] = v[s];
    }
    __syncthreads();
    if (half == 0) {
      float v1[16], v2[16];
      unsigned k2[16];
#pragma unroll
      for (int s = 0; s < 16; ++s) { k2[s] = xk[item * 17 + s]; v1[s] = sortable2f((v[s] & ~127u) | 64u); v2[s] = sortable2f((k2[s] & ~127u) | 64u); }
      unsigned c[16];
#pragma unroll
      for (int s = 0; s < 16; ++s) c[s] = 0u;
      {
        int o = 0;
#pragma unroll
        for (int i = 0; i < 16; ++i)
#pragma unroll
          for (int j = 0; j < 16 / (i + 1); ++j) {
            const unsigned key = (f2sortable(v1[i] + v2[j]) & ~63u) | (unsigned)(63 - o);
            TOPK_INSERT(c, key)
            ++o;
          }
      }
      const float vmax = sortable2f((c[0] & ~63u) | 32u);
      float sum = 0.f;
#pragma unroll
      for (int s = 0; s < 16; ++s) sum += expf(sortable2f((c[s] & ~63u) | 32u) - vmax);
      const float isum = 1.0f / sum;
      const unsigned thr = c[15];
      int* ei = EI + (m0 + item) * 16;
      float* eg = EG + (m0 + item) * 16;
      int cntw = 0;
      {
        int o = 0;
#pragma unroll
        for (int i = 0; i < 16; ++i)
#pragma unroll
          for (int j = 0; j < 16 / (i + 1); ++j) {
            const unsigned key = (f2sortable(v1[i] + v2[j]) & ~63u) | (unsigned)(63 - o);
            if (key >= thr) {
              ei[cntw] = (int)((127u - (v[i] & 127u)) * 128u + (127u - (k2[j] & 127u)));
              eg[cntw] = expf(sortable2f((key & ~63u) | 32u) - vmax) * isum;
              ++cntw;
            }
            ++o;
          }
      }
    }
  }
  __syncthreads();
}

__device__ __forceinline__ void unpack8(const u32x4 v, float* f) {
#pragma unroll
  for (int k = 0; k < 4; ++k) { f[2 * k] = lo16(v[k]); f[2 * k + 1] = hi16(v[k]); }
}
__device__ __forceinline__ void unpack16_fp8(const u32x4 v, float* f) {
#pragma unroll
  for (int k = 0; k < 4; ++k) {
    const f32x2 a = __builtin_amdgcn_cvt_pk_f32_fp8((int)v[k], false), b = __builtin_amdgcn_cvt_pk_f32_fp8((int)v[k], true);
    f[4 * k] = a[0]; f[4 * k + 1] = a[1]; f[4 * k + 2] = b[0]; f[4 * k + 3] = b[1];
  }
}
__device__ __forceinline__ void expert_token(const Params& p, int q, int i, float* smem) {
  const int tid = otid(), w = tid >> 6, lane = tid & 63;
  const int l = q / NG, g = q % NG, rr_lim = (l == 0) ? NTOK : NLAT;
  float* part = smem;
  const unsigned char* U = (const unsigned char*)(p.ws + WB_U16) + (size_t)l * 16384 * 1024;
  const unsigned char* V = (const unsigned char*)(p.ws + WB_V16) + (size_t)l * 16384 * 1024;
  const float* mod = (const float*)(p.ws + WB_MOD) + (size_t)l * 9 * 6144;
  const bf16_t* H2 = (const bf16_t*)(p.ws + WB_H2) + (size_t)(q & 1) * RPG * DM;
  const int* EI = (const int*)(p.ws + WB_EI) + (size_t)(q & 1) * RPG * 128;
  const float* EG = (const float*)(p.ws + WB_EG) + (size_t)(q & 1) * RPG * 128;
  const int bl = i / rr_lim, rr = i % rr_lim, b = g * GB + bl;
  const size_t t = (size_t)bl * NTOK + rr;
  const int my_e = EI[t * 128 + w * 32 + (lane & 31)];
  const float my_g = EG[t * 128 + w * 32 + (lane & 31)];
  float hf[16];
  unpack8(((const u32x4*)(H2 + t * DM))[2 * lane], hf);
  unpack8(((const u32x4*)(H2 + t * DM))[2 * lane + 1], hf + 8);
  float my_dot = 0.f;
  {
    u32x4 ra[32];
#pragma unroll
    for (int j = 0; j < 32; ++j) {
      const int e = __builtin_amdgcn_readlane(my_e, j);
      ra[j] = ((const u32x4*)(U + (size_t)e * 1024))[lane];
    }
#pragma unroll
    for (int j = 0; j < 32; ++j) {
      float f[16];
      unpack16_fp8(ra[j], f);
      float a = 0.f;
#pragma unroll
      for (int qq = 0; qq < 16; ++qq) a = fmaf(hf[qq], f[qq], a);
      a = wave_sum(a);
      if ((lane & 31) == j) my_dot = a;
    }
  }
  const float my_c = my_g * geluf_(my_dot * (1.0f / 32.0f));
  float acc[16];
#pragma unroll
  for (int qq = 0; qq < 16; ++qq) acc[qq] = 0.f;
  {
    u32x4 ra[32];
#pragma unroll
    for (int j = 0; j < 32; ++j) {
      const int e = __builtin_amdgcn_readlane(my_e, j);
      ra[j] = ((const u32x4*)(V + (size_t)e * 1024))[lane];
    }
#pragma unroll
    for (int j = 0; j < 32; ++j) {
      const float c = __uint_as_float(__builtin_amdgcn_readlane(__float_as_uint(my_c), j));
      float f[16];
      unpack16_fp8(ra[j], f);
#pragma unroll
      for (int qq = 0; qq < 16; ++qq) acc[qq] = fmaf(c, f[qq], acc[qq]);
    }
  }
  __syncthreads();
  {
    float4* pw = (float4*)(part + w * 1024 + lane * 16);
    pw[0] = make_float4(acc[0], acc[1], acc[2], acc[3]); pw[1] = make_float4(acc[4], acc[5], acc[6], acc[7]);
    pw[2] = make_float4(acc[8], acc[9], acc[10], acc[11]); pw[3] = make_float4(acc[12], acc[13], acc[14], acc[15]);
  }
  __syncthreads();
  const float4 s0 = ((const float4*)part)[tid], s1 = ((const float4*)(part + 1024))[tid], s2 = ((const float4*)(part + 2048))[tid], s3 = ((const float4*)(part + 3072))[tid];
  const float4 g2 = ((const float4*)(mod + (size_t)((rr < NLAT) ? b : 8) * 6144 + 5 * 1024))[tid];
  float4* xp = (float4*)xrow(p, b, rr) + tid;
  float4 xv = *xp;
  xv.x += g2.x * (s0.x + s1.x + s2.x + s3.x); xv.y += g2.y * (s0.y + s1.y + s2.y + s3.y);
  xv.z += g2.z * (s0.z + s1.z + s2.z + s3.z); xv.w += g2.w * (s0.w + s1.w + s2.w + s3.w);
  *xp = xv;
}
__device__ __forceinline__ bool expert_steal(const Params& p, int lo, int hi, float* smem) {
  int* s_tok = (int*)(smem + SMEM_FLOATS - 8);
  __syncthreads();
  if (otid() == 0) {
    int r = -1;
    int* pool = (int*)(p.ws + WB_POOL);
    for (int q = lo; q <= hi && r < 0; ++q) {
      if (q < 0) continue;
      const int n = GB * ((q < NG) ? NTOK : NLAT);
      if (__hip_atomic_load(pool + q, __ATOMIC_RELAXED, __HIP_MEMORY_SCOPE_AGENT) < n) {
        const int i = atomicAdd(pool + q, 1);
        if (i < n) r = q * 65536 + i;
      }
    }
    *s_tok = r;
  }
  __syncthreads();
  const int r = *s_tok;
  if (r < 0) return false;
  expert_token(p, r >> 16, r & 65535, smem);
  return true;
}
__device__ __forceinline__ void expert_drain(const Params& p, int lo, int hi, float* smem) {
  while (expert_steal(p, lo, hi, smem)) {}
}

__device__ __forceinline__ void stage_final(const Params& p, float* smem) {
  const int tid = otid(), w = tid >> 6, lane = tid & 63;
  const int n = NB * NLAT;
  for (int r0 = (blockIdx.x * 4 + w) * 2; r0 < n; r0 += gridDim.x * 8) {
    float4 v[2][4];
#pragma unroll
    for (int u = 0; u < 2; ++u)
#pragma unroll
      for (int q = 0; q < 4; ++q) v[u][q] = ((const float4*)(p.out + (size_t)(r0 + u) * DM))[q * 64 + lane];
#pragma unroll
    for (int u = 0; u < 2; ++u) {
      float s = 0.f;
#pragma unroll
      for (int q = 0; q < 4; ++q) s += v[u][q].x * v[u][q].x + v[u][q].y * v[u][q].y + v[u][q].z * v[u][q].z + v[u][q].w * v[u][q].w;
      s = wave_sum(s);
      const float rs = rsqrtf(s * (1.0f / DM) + EPSF);
#pragma unroll
      for (int q = 0; q < 4; ++q) {
        const float4 g = ((const float4*)p.in[I_FG])[q * 64 + lane];
        const float4 x = v[u][q];
        ((float4*)(p.out + (size_t)(r0 + u) * DM))[q * 64 + lane] = make_float4(x.x * rs * g.x, x.y * rs * g.y, x.z * rs * g.z, x.w * rs * g.w);
      }
    }
  }
}

__device__ __forceinline__ void gbar(const Params& p, unsigned* ctr, unsigned& epoch, int lo, int hi, float* smem) {
  asm volatile("s_waitcnt vmcnt(0)" ::: "memory");
  __syncthreads();
  epoch += gridDim.x;
  int* s_flag = (int*)(smem + SMEM_FLOATS - 12);
  if (threadIdx.x == 0) {
    __builtin_amdgcn_fence(__ATOMIC_RELEASE, "agent");
    asm volatile("s_waitcnt vmcnt(0)" ::: "memory");
    __hip_atomic_fetch_add(ctr, 1u, __ATOMIC_RELAXED, __HIP_MEMORY_SCOPE_AGENT);
  }
  if (hi >= lo && hi >= 0) {
    for (;;) {
      if (threadIdx.x == 0) {
        const unsigned c = __hip_atomic_load(ctr, __ATOMIC_RELAXED, __HIP_MEMORY_SCOPE_AGENT);
        *s_flag = (c >= epoch) ? 2 : ((c + 1u < epoch) ? 1 : 0);
      }
      __syncthreads();
      const int f = *s_flag;
      if (f != 1) break;
      if (!expert_steal(p, lo, hi, smem)) break;
    }
  }
  if (threadIdx.x == 0) {
    while (__hip_atomic_load(ctr, __ATOMIC_RELAXED, __HIP_MEMORY_SCOPE_AGENT) < epoch) __builtin_amdgcn_s_sleep(2);
    __builtin_amdgcn_fence(__ATOMIC_ACQUIRE, "agent");
    asm volatile("s_waitcnt vmcnt(0)" ::: "memory");
  }
  __syncthreads();
}

__global__ void __launch_bounds__(256) mega(Params p) {
  cg::grid_group grid = cg::this_grid();
  __shared__ __attribute__((aligned(16))) float smem[SMEM_FLOATS];
  char* smc = (char*)smem;
  char* ws = p.ws;
  bf16_t* H = (bf16_t*)(ws + WB_H); bf16_t* Z = (bf16_t*)(ws + WB_Z); float* MGT = (float*)(ws + WB_MGT); bf16_t* XC = (bf16_t*)(ws + WB_XC);
  bf16_t* QM = (bf16_t*)(ws + WB_QM); bf16_t* KM = (bf16_t*)(ws + WB_KM); bf16_t* KMT = (bf16_t*)(ws + WB_KMT); bf16_t* MVT = (bf16_t*)(ws + WB_MVT);
  bf16_t* HF = (bf16_t*)(ws + WB_HF); bf16_t* HB = (bf16_t*)(ws + WB_HB);
  bf16_t* VT = (bf16_t*)(ws + WB_VT); float* YSF = (float*)(ws + WB_YSF); float* YSB = (float*)(ws + WB_YSB);
  bf16_t* YA = (bf16_t*)(ws + WB_YA); bf16_t* YB = (bf16_t*)(ws + WB_YB); bf16_t* YS = (bf16_t*)(ws + WB_YS); bf16_t* GG = (bf16_t*)(ws + WB_GG);
  bf16_t* MG = (bf16_t*)(ws + WB_MG); bf16_t* PQ = (bf16_t*)(ws + WB_PQ); float* SC = (float*)(ws + WB_SC);
  float* XE = (float*)(ws + WB_XE); float* GA = (float*)(ws + WB_GA);
  const bf16_t* WT = (const bf16_t*)(ws + WB_WT);

  unsigned* bar = (unsigned*)(ws + WB_BAR);
  unsigned epoch = 0;
  stage_init(p, smem);
  grid.sync();

  for (int l = 0; l < 2; ++l) {
    const bool need_ctx = (l == 0);
    const int rr_lim = need_ctx ? NTOK : NLAT;
    const int tpb = need_ctx ? 34 : 32;
    const bf16_t* W = WT + (size_t)l * WT_LAYER;
    const float lam_init = 0.8f - 0.6f * expf(-0.3f * (float)l);
    float lam;
    {
      float s1 = 0.f, s2 = 0.f;
      for (int i = 0; i < 64; ++i) {
        s1 += p.in[I_LQ1][l * 64 + i] * p.in[I_LK1][l * 64 + i];
        s2 += p.in[I_LQ2][l * 64 + i] * p.in[I_LK2][l * 64 + i];
      }
      lam = expf(s1) - expf(s2) + lam_init;
    }
    for (int g = 0; g < NG; ++g) {
      const int q = l * NG + g;
      int plo = q - 2, phi = q - 1;
      int* EI = (int*)(ws + WB_EI) + (size_t)(q & 1) * RPG * 128; float* EG = (float*)(ws + WB_EG) + (size_t)(q & 1) * RPG * 128;
      bf16_t* H2 = (bf16_t*)(ws + WB_H2) + (size_t)(q & 1) * RPG * DM;
      stage_normmod(p, l, g, 0, NTOK, H, smem);
      gbar(p, bar, epoch, plo, phi, smem);
      stage_inproj(p, H, W + WT_WIN, Z, MGT, VT, MVT, smc);
      gbar(p, bar, epoch, plo, phi, smem);
      stage_conv(p, l, Z, XC);
      stage_s5_pass1(p, l, Z, XE);
      gbar(p, bar, epoch, plo, phi, smem);
      stage_mlqk(XC, W + WT_WQK, QM, KM, KMT, smc);
      stage_mlgates(p, l, MGT, GA);
      gbar(p, bar, epoch, plo, phi, smem);
      {
        const int n_attn = 4 * 64 + (need_ctx ? 4 * 4 : 0);
        const int n_s5 = 32 * 2 * 9;
        const int n_items = GB * (8 + n_attn + n_s5);
        int* cnt = (int*)(ws + WB_CNT) + (l * NG + g);
        int* s_item = (int*)(smem + SMEM_FLOATS - 4);
        for (;;) {
          __syncthreads();
          if (otid() == 0) *s_item = atomicAdd(cnt, 1);
          __syncthreads();
          const int it = *s_item;
          if (it >= n_items) break;
          int bl, k;
          if (it < GB * 8) { bl = it / 8; k = it % 8; }
          else if (it < GB * (8 + n_attn)) { bl = (it - GB * 8) / n_attn; k = 8 + (it - GB * 8) % n_attn; }
          else { bl = (it - GB * (8 + n_attn)) / n_s5; k = 8 + n_attn + (it - GB * (8 + n_attn)) % n_s5; }
          const bf16_t* Zb = Z + (size_t)bl * NTOK * ZW;
          const size_t ro = (size_t)bl * NTOK;
          if (k < 8) {
            mlstm_chain_item(p, l, QM + ro * 512, KM + ro * 512, KMT + (size_t)bl * 4 * 128 * NTOK, MVT + (size_t)bl * 4 * 128 * NTOK, GA + (size_t)(((bl * 4 + (k & 3)) * 2 + (k >> 2)) * 68) * 272,
                             ((k >> 2) ? HB : HF) + ro * 512, k & 3, k >> 2, smc);
          } else if (k < 8 + n_attn) {
            const int a = k - 8;
            const bf16_t* VTb = VT + (size_t)bl * 4 * 128 * NTOK;
            if (a < 256) attn_mfma_item(p, l, Zb, VTb, YA + ro * 512, a & 3, (a >> 2) * 64, 0, NTOK, lam, lam_init, smc);
            else attn_mfma_item(p, l, Zb, VTb, YA + ro * 512, (a - 256) & 3, NLAT + ((a - 256) >> 2) * 64, NLAT, NCTX, lam, lam_init, smc);
          } else {
            const int a = k - 8 - n_attn;
            const int sq = a % 9, dir = (a / 9) & 1, gg = a / 18;
            s5_item(p, l, Zb, XE + (((size_t)bl * 32 + gg) * 2 + dir) * (S5NSEG - 1) * 128, (dir ? YSB : YSF) + ro * 512, gg, dir, sq, smc);
          }
        }
      }
      gbar(p, bar, epoch, plo, phi, smem);
      stage_post(p, l, rr_lim, Z, HF, HB, YSF, YSB, YB, GG);
      gbar(p, bar, epoch, plo, phi, smem);
      stage_glu_mfma(p, l, tpb, GG, W + WT_GLU, YS, smc);
      gbar(p, bar, epoch, plo, phi, smem);
      stage_merge_mfma(tpb, YA, YB, YS, W + WT_WBR, Z, MG, smc);
      gbar(p, bar, epoch, plo, phi, smem);
      stage_outproj_mfma(p, l, g, tpb, MG, W + WT_WOUT, smc);
      gbar(p, bar, epoch, plo, phi, smem);
      expert_drain(p, plo, plo, smem);
      plo = q - 1;
      gbar(p, bar, epoch, plo, phi, smem);
      stage_normmod(p, l, g, 1, rr_lim, H2, smem);
      gbar(p, bar, epoch, plo, phi, smem);
      stage_peerq_mfma(tpb, H2, W + WT_WQ, PQ, smc);
      gbar(p, bar, epoch, plo, phi, smem);
      stage_scores_mfma(tpb, PQ, W + WT_SUBK, SC, smc);
      gbar(p, bar, epoch, plo, phi, smem);
      stage_topk(tpb, SC, EI, EG, smem);
      gbar(p, bar, epoch, plo, phi, smem);
    }
  }
  expert_drain(p, 2 * NG - 2, 2 * NG - 1, smem);
  gbar(p, bar, epoch, 0, -1, smem);
  stage_final(p, smem);
}

extern "C" void kernel_launch(void* const* d_in, const int* in_sizes, int n_in, void* d_out,
                              int out_size, void* d_ws, size_t ws_size, hipStream_t stream) {
  static int grid_blocks = 0;
  if (!grid_blocks) {
    int dev = 0, cus = 0, per_cu = 0;
    (void)hipGetDevice(&dev);
    (void)hipDeviceGetAttribute(&cus, hipDeviceAttributeMultiprocessorCount, dev);
    (void)hipOccupancyMaxActiveBlocksPerMultiprocessor(&per_cu, mega, 256, 0);
    if (per_cu > 1) per_cu = 1;
    grid_blocks = cus * per_cu;
  }
  if (ws_size < WB_END) {
    fprintf(stderr, "workspace too small: %zu < %zu\n", ws_size, (size_t)WB_END);
    return;
  }
  Params p{};
  for (int i = 0; i < N_IN; ++i) p.in[i] = (const float*)d_in[i];
  p.out = (float*)d_out;
  p.ws = (char*)d_ws;
  (void)hipMemsetAsync((char*)d_ws + WB_BAR, 0, 256, stream);
  void* args[] = {&p};
  hipError_t e = hipLaunchCooperativeKernel((void*)mega, dim3(grid_blocks), dim3(256), args, 0, stream);
  if (e != hipSuccess) fprintf(stderr, "cooperative launch failed: %s (grid %d)\n", hipGetErrorString(e), grid_blocks);
}
```

```cpp
#include <hip/hip_runtime.h>
#include <hip/hip_cooperative_groups.h>
#include <cstdio>
#include <cstdint>
namespace cg = cooperative_groups;

#define NLAT 4096
#define NCTX 256
#define NTOK 4352
#define DM 1024
#define INW 6672
#define NB 8
#define GB 2
#define NG (NB / GB)
#define RPG (GB * NTOK)
#define ZW 6656
#define EPSF 1e-6f

enum { I_X = 0, I_C, I_CTX, I_CCTX, I_WMOD, I_BMOD, I_N1G, I_N2G, I_WIN, I_LQ1, I_LK1, I_LQ2, I_LK2, I_SUBG,
       I_CONVW, I_CONVB, I_MLWQ, I_MLWK, I_GATEB, I_MLNG, I_S5LRE, I_S5LIM, I_S5DT, I_S5BRE, I_S5BIM,
       I_S5CRE, I_S5CIM, I_S5D, I_GLUW, I_GLUB, I_WBR, I_WOUT, I_PWQ, I_PSUBK, I_PU, I_PV, I_FG, N_IN };

struct Params {
  const float* in[N_IN];
  float* out;
  char* ws;
};

typedef unsigned short bf16_t;
typedef short bf16x8 __attribute__((ext_vector_type(8)));
typedef float f32x16 __attribute__((ext_vector_type(16)));
typedef unsigned u32x4 __attribute__((ext_vector_type(4)));
typedef unsigned u32x2 __attribute__((ext_vector_type(2)));

#define AL(x) (((x) + 255) & ~(size_t)255)
#define WB_XCX   ((size_t)0)
#define WB_MOD   AL(WB_XCX + (size_t)NB * NCTX * DM * 4)
#define WB_ROPE  AL(WB_MOD + (size_t)2 * 9 * 6144 * 4)
#define WB_WT    AL(WB_ROPE + (size_t)NLAT * 32 * 2 * 4)
#define WT_WIN   ((size_t)0)
#define WT_WQK   (WT_WIN + (size_t)6784 * 1024)
#define WT_GLU   (WT_WQK + (size_t)4 * 256 * 128)
#define WT_WBR   (WT_GLU + (size_t)512 * 512)
#define WT_WOUT  (WT_WBR + (size_t)3 * 1024 * 512)
#define WT_WQ    (WT_WOUT + (size_t)1024 * 1024)
#define WT_SUBK  (WT_WQ + (size_t)2048 * 1024)
#define WT_LAYER (WT_SUBK + (size_t)2 * 128 * 128)
#define WB_H     AL(WB_WT + WT_LAYER * 2 * 2)
#define WB_Z     AL(WB_H + (size_t)RPG * DM * 2)
#define WB_MGT   AL(WB_Z + (size_t)RPG * ZW * 2)
#define WB_XC    AL(WB_MGT + (size_t)RPG * 16 * 4)
#define WB_QM    AL(WB_XC + (size_t)RPG * 512 * 2)
#define WB_KM    AL(WB_QM + (size_t)RPG * 512 * 2)
#define WB_KMT   AL(WB_KM + (size_t)RPG * 512 * 2)
#define WB_MVT   AL(WB_KMT + (size_t)RPG * 512 * 2)
#define WB_HF    AL(WB_MVT + (size_t)RPG * 512 * 2)
#define WB_HB    AL(WB_HF + (size_t)RPG * 512 * 2)
#define WB_YSF   AL(WB_HB + (size_t)RPG * 512 * 2)
#define WB_YSB   AL(WB_YSF + (size_t)RPG * 512 * 4)
#define WB_YA    AL(WB_YSB + (size_t)RPG * 512 * 4)
#define WB_YB    AL(WB_YA + (size_t)RPG * 512 * 2)
#define WB_YS    AL(WB_YB + (size_t)RPG * 512 * 2)
#define WB_GG    AL(WB_YS + (size_t)RPG * 512 * 2)
#define WB_MG    AL(WB_GG + (size_t)RPG * 512 * 2)
#define WB_EI    AL(WB_MG + (size_t)RPG * DM * 2)
#define WB_EG    AL(WB_EI + (size_t)2 * RPG * 128 * 4)
#define WB_H2    AL(WB_EG + (size_t)2 * RPG * 128 * 4)
#define WB_U16   AL(WB_H2 + (size_t)2 * RPG * DM * 2)
#define WB_V16   AL(WB_U16 + (size_t)2 * 16384 * 1024)
#define WB_VT    AL(WB_V16 + (size_t)2 * 16384 * 1024)
#define WB_CNT   AL(WB_VT + (size_t)GB * 4 * 128 * NTOK * 2)
#define WB_XE    AL(WB_CNT + 256)
#define WB_BAR   AL(WB_XE + (size_t)GB * 32 * 2 * 33 * 128 * 4)
#define WB_GA    AL(WB_BAR + 256)
#define WB_POOL  AL(WB_GA + (size_t)GB * 4 * 2 * 68 * 272 * 4)
#define WB_END   AL(WB_POOL + 256)
#define WB_PQ    (WB_Z)
#define WB_SC    AL(WB_PQ + (size_t)RPG * 2048 * 2)

#define SMEM_FLOATS (25 * 1024)

__device__ __forceinline__ float sigmoidf_(float x) { return __builtin_amdgcn_rcpf(1.0f + __builtin_amdgcn_exp2f(-1.4426950408889634f * x)); }
__device__ __forceinline__ float siluf_(float x) { return x * __builtin_amdgcn_rcpf(1.0f + __builtin_amdgcn_exp2f(-1.4426950408889634f * x)); }
__device__ __forceinline__ float geluf_(float x) { return 0.5f * x * (1.0f + erff(x * 0.70710678118654752f)); }
__device__ __forceinline__ int otid() { int t = threadIdx.x; asm volatile("" : "+v"(t)); return t; }
__device__ __forceinline__ float wave_sum(float v) {
  for (int o = 32; o > 0; o >>= 1) v += __shfl_xor(v, o);
  return v;
}
__device__ __forceinline__ bf16_t f2bf(float x) { unsigned u = __float_as_uint(x); u += 0x7fffu + ((u >> 16) & 1u); return (bf16_t)(u >> 16); }
__device__ __forceinline__ float bf2f(bf16_t h) { return __uint_as_float(((unsigned)h) << 16); }
typedef float f32x2 __attribute__((ext_vector_type(2)));
typedef __bf16 bf16x2_t __attribute__((ext_vector_type(2)));
__device__ __forceinline__ unsigned pack2(float a, float b) { f32x2 v = {a, b}; return __builtin_bit_cast(unsigned, __builtin_convertvector(v, bf16x2_t)); }
__device__ __forceinline__ float lo16(unsigned u) { return __uint_as_float(u << 16); }
__device__ __forceinline__ float hi16(unsigned u) { return __uint_as_float(u & 0xffff0000u); }

__device__ __forceinline__ float* xrow(const Params& p, int b, int rr) {
  return (rr < NLAT) ? p.out + ((size_t)b * NLAT + rr) * DM : (float*)(p.ws + WB_XCX) + ((size_t)b * NCTX + (rr - NLAT)) * DM;
}

__device__ __forceinline__ const float* xrow_in(const Params& p, int b, int rr) {
  return (rr < NLAT) ? p.in[I_X] + ((size_t)b * NLAT + rr) * DM : p.in[I_CTX] + ((size_t)b * NCTX + (rr - NLAT)) * DM;
}

__device__ __forceinline__ void gemm_tile(const bf16_t* __restrict__ Ag, int lda, const bf16_t* __restrict__ Bg, int ldb, int K,
                                          char* smem, f32x16 (&acc)[2][2]) {
  const int tid = otid(), lane = tid & 63, w = tid >> 6, wm = w >> 1, wn = w & 1;
#pragma unroll
  for (int a = 0; a < 2; ++a)
#pragma unroll
    for (int b = 0; b < 2; ++b)
#pragma unroll
      for (int i = 0; i < 16; ++i) acc[a][b][i] = 0.f;
  const int srow = tid >> 3, sch = tid & 7;
  const bf16_t* ap = Ag + (size_t)srow * lda + sch * 8;
  const bf16_t* bp = Bg + (size_t)srow * ldb + sch * 8;
  const int wofs = srow * 128 + ((sch ^ ((srow >> 1) & 7)) << 4);
  const int fr = lane & 31, fh = lane >> 5, fsw = (fr >> 1) & 7;
  const int aofs = (wm * 64 + fr) * 128, bofs = 16384 + (wn * 64 + fr) * 128;
  u32x4 ra0[4], rb0[4], ra1[4], rb1[4];
  const int nk = K >> 6;
#define G_LOAD(RA, RB, KT) { _Pragma("unroll") for (int i = 0; i < 4; ++i) { RA[i] = *(const u32x4*)(ap + (size_t)i * 32 * lda + (KT) * 64); RB[i] = *(const u32x4*)(bp + (size_t)i * 32 * ldb + (KT) * 64); } }
#define G_STORE(RA, RB, BUF) { char* nb_ = smem + (BUF) * 32768; _Pragma("unroll") for (int i = 0; i < 4; ++i) { *(u32x4*)(nb_ + wofs + i * 4096) = RA[i]; *(u32x4*)(nb_ + 16384 + wofs + i * 4096) = RB[i]; } }
#define G_COMPUTE(BUF) { const char* base = smem + (BUF) * 32768; _Pragma("unroll") for (int ks = 0; ks < 4; ++ks) { \
      const int coff = ((ks * 2 + fh) ^ fsw) << 4; bf16x8 af[2], bfr[2]; \
      _Pragma("unroll") for (int mi = 0; mi < 2; ++mi) af[mi] = *(const bf16x8*)(base + aofs + mi * 4096 + coff); \
      _Pragma("unroll") for (int ni = 0; ni < 2; ++ni) bfr[ni] = *(const bf16x8*)(base + bofs + ni * 4096 + coff); \
      _Pragma("unroll") for (int mi = 0; mi < 2; ++mi) _Pragma("unroll") for (int ni = 0; ni < 2; ++ni) \
          acc[mi][ni] = __builtin_amdgcn_mfma_f32_32x32x16_bf16(bfr[ni], af[mi], acc[mi][ni], 0, 0, 0); } }
  G_LOAD(ra0, rb0, 0)
  G_LOAD(ra1, rb1, 1)
  __syncthreads();
  G_STORE(ra0, rb0, 0)
  __syncthreads();
  for (int kt = 0; kt < nk; kt += 2) {
    if (kt + 2 < nk) G_LOAD(ra0, rb0, kt + 2)
    G_COMPUTE(0)
    G_STORE(ra1, rb1, 1)
    __syncthreads();
    if (kt + 3 < nk) G_LOAD(ra1, rb1, kt + 3)
    G_COMPUTE(1)
    if (kt + 2 < nk) G_STORE(ra0, rb0, 0)
    __syncthreads();
  }
#undef G_LOAD
#undef G_STORE
#undef G_COMPUTE
}
#define EPI_DECL const int tid_ = otid(); const int lane = tid_ & 63, w_ = tid_ >> 6, wm = w_ >> 1, wn = w_ & 1, fr = lane & 31, fh = lane >> 5; (void)fr; (void)fh; (void)wm; (void)wn;
#define EPI_ROW(mi) (wm * 64 + (mi) * 32 + fr)
#define EPI_COL(ni, q) (wn * 64 + (ni) * 32 + 8 * (q) + 4 * fh)
#define MT_LR0(mt, tpb) (((mt) / (tpb)) * NTOK + ((mt) % (tpb)) * 128)


struct TileIter {
  int tm, tn, pw, ph, PN, NP, x, i, it;
  __device__ __forceinline__ TileIter(int tm_, int tn_) : tm(tm_), tn(tn_) {
    pw = tn < 8 ? tn : 8; ph = 32 / pw; PN = (tn + pw - 1) / pw; NP = ((tm + ph - 1) / ph) * PN;
    x = blockIdx.x & 7; i = blockIdx.x >> 3; it = 0;
  }
  __device__ __forceinline__ bool next(int& mt, int& nt, bool& valid) {
    if (gridDim.x != 256) {
      const int t = blockIdx.x + it * gridDim.x; ++it;
      if (t >= tm * tn) return false;
      mt = t / tn; nt = t % tn; valid = true; return true;
    }
    const int P = it * 8 + x; ++it;
    if (P >= NP) return false;
    mt = (P / PN) * ph + i / pw; nt = (P % PN) * pw + i % pw;
    valid = (mt < tm) && (nt < tn);
    return true;
  }
};

template <class F>
__device__ __forceinline__ void transpose_cvt(const float* __restrict__ src, int ld, F srccol, int K, int Ndst, bf16_t* __restrict__ dst, float* smem) {
  float (*T)[65] = (float (*)[65])smem;
  const int tid = otid();
  const int tk = K >> 6, tn = Ndst >> 6;
  for (int t = blockIdx.x; t < tn * tk; t += gridDim.x) {
    const int n0 = (t / tk) * 64, k0 = (t % tk) * 64;
    __syncthreads();
    const int sc = srccol(n0 + (tid & 63));
#pragma unroll
    for (int i = 0; i < 16; ++i) {
      const int ky = (tid >> 6) + 4 * i;
      T[ky][tid & 63] = (sc >= 0) ? src[(size_t)(k0 + ky) * ld + sc] : 0.f;
    }
    __syncthreads();
#pragma unroll
    for (int i = 0; i < 16; ++i) {
      const int ny = (tid >> 6) + 4 * i;
      dst[(size_t)(n0 + ny) * K + k0 + (tid & 63)] = f2bf(T[tid & 63][ny]);
    }
  }
  __syncthreads();
}
__device__ __forceinline__ int win_srccol(int n) {
  if (n < 3072) return n;
  if (n < 6656) return n + 16;
  if (n < 6672) return n - 3584;
  return -1;
}

__device__ __forceinline__ void stage_init(const Params& p, float* smem) {
  const int tid = otid();
  if (blockIdx.x == 0 && tid < 64) { ((int*)(p.ws + WB_CNT))[tid] = 0; if (tid < 16) ((int*)(p.ws + WB_POOL))[tid] = 0; }
  {
    const size_t n16 = (size_t)2 * 16384 * 1024 / 16;
    const float4* su = (const float4*)p.in[I_PU];
    const float4* sv = (const float4*)p.in[I_PV];
    u32x4* du = (u32x4*)(p.ws + WB_U16);
    u32x4* dv = (u32x4*)(p.ws + WB_V16);
    for (size_t i = (size_t)blockIdx.x * 256 + tid; i < n16; i += (size_t)gridDim.x * 256) {
      u32x4 ou, ov;
#pragma unroll
      for (int q = 0; q < 4; ++q) {
        const float4 a = su[4 * i + q];
        int w = 0;
        w = __builtin_amdgcn_cvt_pk_fp8_f32(a.x * 32.f, a.y * 32.f, w, false);
        w = __builtin_amdgcn_cvt_pk_fp8_f32(a.z * 32.f, a.w * 32.f, w, true);
        ou[q] = (unsigned)w;
        const float4 b = sv[4 * i + q];
        int w2 = 0;
        w2 = __builtin_amdgcn_cvt_pk_fp8_f32(b.x, b.y, w2, false);
        w2 = __builtin_amdgcn_cvt_pk_fp8_f32(b.z, b.w, w2, true);
        ov[q] = (unsigned)w2;
      }
      du[i] = ou; dv[i] = ov;
    }
  }
  {
    float2* rt = (float2*)(p.ws + WB_ROPE);
    for (int i = blockIdx.x * 256 + tid; i < NLAT * 32; i += gridDim.x * 256) {
      const int pos = i >> 5, j = i & 31;
      const float inv = powf(10000.0f, -(float)(j & 15) / 16.0f);
      const float ang = (float)((j < 16) ? (pos >> 6) : (pos & 63)) * inv;
      rt[i] = make_float2(cosf(ang), sinf(ang));
    }
  }
  {
    float* sc = smem;
    float* red = smem + 9 * 1024;
    for (int i = tid; i < 9 * 1024; i += 256) {
      int r = i >> 10, k = i & 1023;
      float v = (r < 8) ? p.in[I_C][r * 1024 + k] : p.in[I_CCTX][k];
      sc[i] = siluf_(v);
    }
    __syncthreads();
    float* mod = (float*)(p.ws + WB_MOD);
    const int jc = tid & 63, ksl = tid >> 6;
    for (int cb = blockIdx.x; cb < 2 * 6144 / 64; cb += gridDim.x) {
      const int col = cb * 64 + jc;
      const int l = col / 6144, j = col % 6144;
      const float* w = p.in[I_WMOD] + (size_t)l * 1024 * 6144 + j;
      float acc[9];
#pragma unroll
      for (int r = 0; r < 9; ++r) acc[r] = 0.f;
#pragma unroll 8
      for (int k = ksl * 256; k < ksl * 256 + 256; ++k) {
        const float wv = w[(size_t)k * 6144];
#pragma unroll
        for (int r = 0; r < 9; ++r) acc[r] = fmaf(sc[r * 1024 + k], wv, acc[r]);
      }
      __syncthreads();
#pragma unroll
      for (int r = 0; r < 9; ++r) red[(ksl * 64 + jc) * 9 + r] = acc[r];
      __syncthreads();
      if (ksl == 0) {
        const float bv = p.in[I_BMOD][l * 6144 + j];
#pragma unroll
        for (int r = 0; r < 9; ++r)
          mod[((size_t)l * 9 + r) * 6144 + j] = red[jc * 9 + r] + red[(64 + jc) * 9 + r] + red[(128 + jc) * 9 + r] + red[(192 + jc) * 9 + r] + bv;
      }
    }
    __syncthreads();
  }
  bf16_t* WT = (bf16_t*)(p.ws + WB_WT);
  for (int l = 0; l < 2; ++l) {
    bf16_t* W = WT + (size_t)l * WT_LAYER;
    transpose_cvt(p.in[I_WIN] + (size_t)l * DM * INW, INW, [](int n) { return win_srccol(n); }, DM, 6784, W + WT_WIN, smem);
    for (int h = 0; h < 4; ++h) {
      transpose_cvt(p.in[I_MLWQ] + ((size_t)l * 4 + h) * 16384, 128, [](int n) { return n; }, 128, 128, W + WT_WQK + (size_t)h * 256 * 128, smem);
      transpose_cvt(p.in[I_MLWK] + ((size_t)l * 4 + h) * 16384, 128, [](int n) { return n; }, 128, 128, W + WT_WQK + (size_t)h * 256 * 128 + 128 * 128, smem);
    }
    transpose_cvt(p.in[I_GLUW] + (size_t)l * 512 * 512, 512, [](int n) { return n; }, 512, 512, W + WT_GLU, smem);
    for (int r = 0; r < 3; ++r)
      transpose_cvt(p.in[I_WBR] + ((size_t)l * 3 + r) * 512 * DM, DM, [](int n) { return n; }, 512, DM, W + WT_WBR + (size_t)r * 1024 * 512, smem);
    transpose_cvt(p.in[I_WOUT] + (size_t)l * DM * DM, DM, [](int n) { return n; }, DM, DM, W + WT_WOUT, smem);
    transpose_cvt(p.in[I_PWQ] + (size_t)l * DM * 2048, 2048, [](int n) { return n; }, DM, 2048, W + WT_WQ, smem);
    const float* sk = p.in[I_PSUBK] + (size_t)l * 2 * 128 * 128;
    for (int i = blockIdx.x * 256 + tid; i < 2 * 128 * 128; i += gridDim.x * 256) W[WT_SUBK + i] = f2bf(sk[i]);
  }
}

__device__ __forceinline__ void stage_normmod(const Params& p, int l, int g, int which, int rr_lim, bf16_t* H, float* smem) {
  const int tid = otid(), w = tid >> 6, lane = tid & 63;
  const float* ng = p.in[which ? I_N2G : I_N1G] + l * DM;
  const float* mod = (const float*)(p.ws + WB_MOD) + (size_t)l * 9 * 6144;
  const int off_sh = which ? 3072 : 0, off_sc = which ? 4096 : 1024;
  const int n = GB * rr_lim;
  for (int i0 = (blockIdx.x * 4 + w) * 2; i0 < n; i0 += gridDim.x * 8) {
    float4 v[2][4];
    int bl[2], rr[2];
#pragma unroll
    for (int u = 0; u < 2; ++u) {
      const int i = (i0 + u < n) ? i0 + u : i0;
      bl[u] = i / rr_lim; rr[u] = i % rr_lim;
      const float4* X = (const float4*)((l == 0 && which == 0) ? xrow_in(p, g * GB + bl[u], rr[u]) : xrow(p, g * GB + bl[u], rr[u]));
#pragma unroll
      for (int q = 0; q < 4; ++q) v[u][q] = X[q * 64 + lane];
    }
#pragma unroll
    for (int u = 0; u < 2; ++u) {
      if (i0 + u >= n) break;
      float s = 0.f;
#pragma unroll
      for (int q = 0; q < 4; ++q) s += v[u][q].x * v[u][q].x + v[u][q].y * v[u][q].y + v[u][q].z * v[u][q].z + v[u][q].w * v[u][q].w;
      s = wave_sum(s);
      const float rs = rsqrtf(s * (1.0f / DM) + EPSF);
      const float* m = mod + (size_t)((rr[u] < NLAT) ? (g * GB + bl[u]) : 8) * 6144;
      u32x2* hp = (u32x2*)(H + ((size_t)bl[u] * NTOK + rr[u]) * DM);
#pragma unroll
      for (int q = 0; q < 4; ++q) {
        const float4 gg = ((const float4*)ng)[q * 64 + lane];
        const float4 sc = ((const float4*)(m + off_sc))[q * 64 + lane];
        const float4 sh = ((const float4*)(m + off_sh))[q * 64 + lane];
        const float4 x = v[u][q];
        hp[q * 64 + lane] = (u32x2){pack2(x.x * rs * gg.x * (1.f + sc.x) + sh.x, x.y * rs * gg.y * (1.f + sc.y) + sh.y),
                                    pack2(x.z * rs * gg.z * (1.f + sc.z) + sh.z, x.w * rs * gg.w * (1.f + sc.w) + sh.w)};
      }
    }
  }
}

__device__ __forceinline__ void stage_inproj(const Params& p, const bf16_t* H, const bf16_t* WinT, bf16_t* Z, float* MGT, bf16_t* VT, bf16_t* MVT, char* smem) {
  EPI_DECL
  const int tm = GB * 34, tn = 53;
  const float2* rt = (const float2*)(p.ws + WB_ROPE);
  TileIter ti(tm, tn);
  int mt, j; bool valid;
  while (ti.next(mt, j, valid)) {
    if (!valid) continue;
    const int n0 = j * 128;
    const int lr0 = MT_LR0(mt, 34), rr0 = (mt % 34) * 128;
    f32x16 acc[2][2];
    if ((j >= 8 && j < 12) || (j >= 16 && j < 20)) {
      gemm_tile(WinT + (size_t)n0 * DM, DM, H + (size_t)lr0 * DM, DM, DM, smem, acc);
      bf16_t* vt = ((j < 12) ? VT : MVT) + ((size_t)(mt / 34) * 4 + (j & 3)) * 128 * NTOK;
#pragma unroll
      for (int mi = 0; mi < 2; ++mi)
#pragma unroll
        for (int ni = 0; ni < 2; ++ni)
#pragma unroll
          for (int q = 0; q < 4; ++q) {
            const int e = EPI_ROW(mi), tok = rr0 + EPI_COL(ni, q);
            *(u32x2*)(vt + (size_t)e * NTOK + tok) = (u32x2){pack2(acc[mi][ni][4 * q], acc[mi][ni][4 * q + 1]), pack2(acc[mi][ni][4 * q + 2], acc[mi][ni][4 * q + 3])};
          }
      continue;
    }
    gemm_tile(H + (size_t)lr0 * DM, DM, WinT + (size_t)n0 * DM, DM, DM, smem, acc);
    if (j < 8 && rr0 < NLAT) {
#pragma unroll
      for (int mi = 0; mi < 2; ++mi) {
        const int pos = rr0 + EPI_ROW(mi);
#pragma unroll
        for (int i = 0; i < 16; ++i) {
          const int jj = 8 * (i >> 2) + 4 * fh + (i & 3);
          const float2 cs = rt[pos * 32 + jj];
          const float x1 = acc[mi][0][i], x2 = acc[mi][1][i];
          acc[mi][0][i] = x1 * cs.x - x2 * cs.y;
          acc[mi][1][i] = x1 * cs.y + x2 * cs.x;
        }
      }
    }
    if (j < 52) {
      const bool sg = (j >= 28);
#pragma unroll
      for (int mi = 0; mi < 2; ++mi)
#pragma unroll
        for (int ni = 0; ni < 2; ++ni)
#pragma unroll
          for (int q = 0; q < 4; ++q) {
            const int row = lr0 + EPI_ROW(mi), c = n0 + EPI_COL(ni, q);
            float v0 = acc[mi][ni][4 * q], v1 = acc[mi][ni][4 * q + 1], v2 = acc[mi][ni][4 * q + 2], v3 = acc[mi][ni][4 * q + 3];
            if (sg) { v0 = sigmoidf_(v0); v1 = sigmoidf_(v1); v2 = sigmoidf_(v2); v3 = sigmoidf_(v3); }
            *(u32x2*)(Z + (size_t)row * ZW + c) = (u32x2){pack2(v0, v1), pack2(v2, v3)};
          }
    } else {
#pragma unroll
      for (int mi = 0; mi < 2; ++mi)
#pragma unroll
        for (int q = 0; q < 2; ++q) {
          const int row = lr0 + EPI_ROW(mi), c = EPI_COL(0, q);
          if (wn == 0) *(float4*)(MGT + (size_t)row * 16 + c) = make_float4(acc[mi][0][4 * q], acc[mi][0][4 * q + 1], acc[mi][0][4 * q + 2], acc[mi][0][4 * q + 3]);
        }
    }
  }
}

__device__ __forceinline__ void stage_conv(const Params& p, int l, const bf16_t* Z, bf16_t* XC) {
  const int tid = otid();
  const float* cw = p.in[I_CONVW] + (size_t)l * 3 * 512;
  const float* cb = p.in[I_CONVB] + (size_t)l * 512;
  const int c = tid * 2;
  const float2 w0 = *(const float2*)(cw + c), w1 = *(const float2*)(cw + 512 + c), w2 = *(const float2*)(cw + 1024 + c), bb = *(const float2*)(cb + c);
  for (int lr0 = blockIdx.x * 4; lr0 < RPG; lr0 += gridDim.x * 4) {
    unsigned xc[4], xp[4], xn[4];
#pragma unroll
    for (int u = 0; u < 4; ++u) {
      const int lr = lr0 + u, rr = lr % NTOK;
      const bool has_prev = (rr < NLAT) ? (rr > 0) : (rr > NLAT);
      const bool has_next = (rr < NLAT) ? (rr < NLAT - 1) : (rr < NTOK - 1);
      const bf16_t* z = Z + (size_t)lr * ZW + 1536 + c;
      xc[u] = *(const unsigned*)z;
      xp[u] = has_prev ? *(const unsigned*)(z - ZW) : 0u;
      xn[u] = has_next ? *(const unsigned*)(z + ZW) : 0u;
    }
#pragma unroll
    for (int u = 0; u < 4; ++u) {
      const float a0 = bb.x + w1.x * lo16(xc[u]) + w0.x * lo16(xp[u]) + w2.x * lo16(xn[u]);
      const float a1 = bb.y + w1.y * hi16(xc[u]) + w0.y * hi16(xp[u]) + w2.y * hi16(xn[u]);
      *(unsigned*)(XC + (size_t)(lr0 + u) * 512 + c) = pack2(siluf_(a0), siluf_(a1));
    }
  }
}

__device__ __forceinline__ void stage_mlqk(const bf16_t* XC, const bf16_t* WQK, bf16_t* QM, bf16_t* KM, bf16_t* KMT, char* smem) {
  EPI_DECL
  const int tm = RPG >> 7;
  TileIter ti(tm, 12);
  int mt, r12; bool valid;
  while (ti.next(mt, r12, valid)) {
    if (!valid) continue;
    const int h = r12 & 3, kind = r12 >> 2;
    const int m0 = mt * 128;
    f32x16 acc[2][2];
    const bf16_t* Wt = WQK + (size_t)h * 256 * 128 + (size_t)(kind ? 1 : 0) * 128 * 128;
    const bf16_t* Xt = XC + (size_t)m0 * 512 + h * 128;
    if (kind < 2) {
      gemm_tile(Xt, 512, Wt, 128, 128, smem, acc);
      bf16_t* O = kind ? KM : QM;
      const float alpha = kind ? 1.0f : 0.08838834764831845f;
#pragma unroll
      for (int mi = 0; mi < 2; ++mi)
#pragma unroll
        for (int ni = 0; ni < 2; ++ni)
#pragma unroll
          for (int q = 0; q < 4; ++q) {
            const int row = m0 + EPI_ROW(mi), c = EPI_COL(ni, q);
            *(u32x2*)(O + (size_t)row * 512 + h * 128 + c) = (u32x2){pack2(alpha * acc[mi][ni][4 * q], alpha * acc[mi][ni][4 * q + 1]), pack2(alpha * acc[mi][ni][4 * q + 2], alpha * acc[mi][ni][4 * q + 3])};
          }
    } else {
      gemm_tile(Wt, 128, Xt, 512, 128, smem, acc);
      bf16_t* kt = KMT + ((size_t)(mt / 34) * 4 + h) * 128 * NTOK + (mt % 34) * 128;
#pragma unroll
      for (int mi = 0; mi < 2; ++mi)
#pragma unroll
        for (int ni = 0; ni < 2; ++ni)
#pragma unroll
          for (int q = 0; q < 4; ++q) {
            const int d = EPI_ROW(mi), tok = EPI_COL(ni, q);
            *(u32x2*)(kt + (size_t)d * NTOK + tok) = (u32x2){pack2(acc[mi][ni][4 * q], acc[mi][ni][4 * q + 1]), pack2(acc[mi][ni][4 * q + 2], acc[mi][ni][4 * q + 3])};
          }
    }
  }
}

__device__ __forceinline__ void attn_mfma_item(const Params& p, int l, const bf16_t* Zb, const bf16_t* VTb, bf16_t* YAb, int h, int qrow0, int key0, int nkeys,
                                               float lam, float lam_init, char* smem) {
  const int tid = otid(), lane = tid & 63, w = tid >> 6, fr = lane & 31, fh = lane >> 5;
  const int rb = w & 1, m = w >> 1;
  const int ntiles = nkeys >> 6;
  const int myrow = qrow0 + rb * 32 + fr;
  bf16x8 qf[4];
  {
    const bf16_t* qp = Zb + (size_t)myrow * ZW + h * 128 + m * 64 + fh * 8;
#pragma unroll
    for (int ks = 0; ks < 4; ++ks) qf[ks] = *(const bf16x8*)(qp + ks * 16);
  }
  f32x16 O[4];
#pragma unroll
  for (int eb = 0; eb < 4; ++eb)
#pragma unroll
    for (int i = 0; i < 16; ++i) O[eb][i] = 0.f;
  float mrun = -1e30f, lrun = 0.f;
  const float cs = 0.125f * 1.4426950408889634f;
  const int skey = tid >> 4, sch = tid & 15;
  const bf16_t* ksrc = Zb + (size_t)(key0 + skey) * ZW + 512 + h * 128 + sch * 8;
  const int kdst = skey * 256 + ((sch ^ (skey & 15)) << 4);
  const int se = tid >> 3, svc = tid & 7;
  const bf16_t* vsrc = VTb + ((size_t)h * 128 + se) * NTOK + key0 + svc * 8;
  const int vsw = (se >> 1) & 15;
  const int vdst0 = se * 128 + (((2 * svc) ^ vsw) << 3), vdst1 = se * 128 + (((2 * svc + 1) ^ vsw) << 3);
  const int kfo = fr * 256, kfs = fr & 15;
  const int vfo = fr * 128, vfs = (fr >> 1) & 15;
  u32x4 rk[4], rv[4];
#pragma unroll
  for (int i = 0; i < 4; ++i) rk[i] = *(const u32x4*)(ksrc + (size_t)i * 16 * ZW);
  __syncthreads();
#pragma unroll
  for (int i = 0; i < 4; ++i) *(u32x4*)(smem + kdst + i * 4096) = rk[i];
  __syncthreads();
  bf16x8 pf[4];
#define ATT_S(T) { const char* kb_ = smem + ((T) & 1) * 16384; _Pragma("unroll") for (int kb = 0; kb < 2; ++kb) { \
      _Pragma("unroll") for (int i = 0; i < 16; ++i) S[kb][i] = 0.f; \
      _Pragma("unroll") for (int ks = 0; ks < 4; ++ks) { \
        const bf16x8 kf = *(const bf16x8*)(kb_ + kb * 8192 + kfo + (((m * 8 + ks * 2 + fh) ^ kfs) << 4)); \
        S[kb] = __builtin_amdgcn_mfma_f32_32x32x16_bf16(kf, qf[ks], S[kb], 0, 0, 0); } } }
#define ATT_MAX() { float tm = S[0][0]; \
      _Pragma("unroll") for (int i = 1; i < 16; ++i) tm = fmaxf(tm, S[0][i]); \
      _Pragma("unroll") for (int i = 0; i < 16; ++i) tm = fmaxf(tm, S[1][i]); \
      tm = fmaxf(tm, __shfl_xor(tm, 32)) * cs; alpha = 1.f; \
      if (tm > mrun + 8.0f) { alpha = __builtin_amdgcn_exp2f(mrun - tm); mrun = tm; } }
#define ATT_EXP(PF) { const float mc = mrun; float rs = 0.f; \
      _Pragma("unroll") for (int kb = 0; kb < 2; ++kb) { float pv[16]; \
        _Pragma("unroll") for (int i = 0; i < 16; ++i) { pv[i] = __builtin_amdgcn_exp2f(fmaf(S[kb][i], cs, -mc)); rs += pv[i]; } \
        _Pragma("unroll") for (int hh = 0; hh < 2; ++hh) \
          PF[kb * 2 + hh] = __builtin_bit_cast(bf16x8, (u32x4){pack2(pv[8 * hh], pv[8 * hh + 1]), pack2(pv[8 * hh + 2], pv[8 * hh + 3]), \
                                                               pack2(pv[8 * hh + 4], pv[8 * hh + 5]), pack2(pv[8 * hh + 6], pv[8 * hh + 7])}); } \
      lrun += rs; }
#define ATT_PV(T) { const char* vb_ = smem + 32768 + ((T) & 1) * 16384; _Pragma("unroll") for (int eb = 0; eb < 4; ++eb) _Pragma("unroll") for (int s = 0; s < 4; ++s) { \
        const u32x2 v0 = *(const u32x2*)(vb_ + eb * 4096 + vfo + (((4 * s + fh) ^ vfs) << 3)); \
        const u32x2 v1 = *(const u32x2*)(vb_ + eb * 4096 + vfo + (((4 * s + fh + 2) ^ vfs) << 3)); \
        const bf16x8 vf = __builtin_bit_cast(bf16x8, (u32x4){v0[0], v0[1], v1[0], v1[1]}); \
        O[eb] = __builtin_amdgcn_mfma_f32_32x32x16_bf16(vf, pf[s], O[eb], 0, 0, 0); } }
  f32x16 S[2];
  float alpha;
  {
#pragma unroll
    for (int i = 0; i < 4; ++i) rk[i] = *(const u32x4*)(ksrc + (size_t)(64 + i * 16) * ZW);
#pragma unroll
    for (int i = 0; i < 4; ++i) rv[i] = *(const u32x4*)(vsrc + (size_t)i * 32 * NTOK);
    ATT_S(0)
    ATT_MAX()
    ATT_EXP(pf)
#pragma unroll
    for (int i = 0; i < 4; ++i) *(u32x4*)(smem + 16384 + kdst + i * 4096) = rk[i];
#pragma unroll
    for (int i = 0; i < 4; ++i) {
      *(u32x2*)(smem + 32768 + vdst0 + i * 4096) = (u32x2){rv[i][0], rv[i][1]};
      *(u32x2*)(smem + 32768 + vdst1 + i * 4096) = (u32x2){rv[i][2], rv[i][3]};
    }
    __syncthreads();
  }
#pragma unroll 1
  for (int t = 1; t < ntiles; ++t) {
    const int tn = (t + 1 < ntiles) ? t + 1 : t;
#pragma unroll
    for (int i = 0; i < 4; ++i) rk[i] = *(const u32x4*)(ksrc + (size_t)(tn * 64 + i * 16) * ZW);
#pragma unroll
    for (int i = 0; i < 4; ++i) rv[i] = *(const u32x4*)(vsrc + (size_t)i * 32 * NTOK + t * 64);
    ATT_S(t)
    ATT_MAX()
    if (__any(alpha != 1.f)) {
#pragma unroll
      for (int eb = 0; eb < 4; ++eb)
#pragma unroll
        for (int i = 0; i < 16; ++i) O[eb][i] *= alpha;
      lrun *= alpha;
#pragma unroll
      for (int s = 0; s < 4; ++s) {
        const u32x4 r_ = __builtin_bit_cast(u32x4, pf[s]);
        pf[s] = __builtin_bit_cast(bf16x8, (u32x4){pack2(lo16(r_[0]) * alpha, hi16(r_[0]) * alpha), pack2(lo16(r_[1]) * alpha, hi16(r_[1]) * alpha),
                                                   pack2(lo16(r_[2]) * alpha, hi16(r_[2]) * alpha), pack2(lo16(r_[3]) * alpha, hi16(r_[3]) * alpha)});
      }
    }
    bf16x8 pn[4];
    {
      ATT_PV(t - 1)
      ATT_EXP(pn)
#pragma unroll
      for (int i = 0; i < 16; ++i) {
        __builtin_amdgcn_sched_group_barrier(0x100, 1, 0);
        __builtin_amdgcn_sched_group_barrier(0x008, 1, 0);
        __builtin_amdgcn_sched_group_barrier(0x002, 9, 0);
      }
    }
#pragma unroll
    for (int s = 0; s < 4; ++s) pf[s] = pn[s];
    if (t + 1 < ntiles) {
      char* kd = smem + ((t + 1) & 1) * 16384;
#pragma unroll
      for (int i = 0; i < 4; ++i) *(u32x4*)(kd + kdst + i * 4096) = rk[i];
    }
    {
      char* vd = smem + 32768 + (t & 1) * 16384;
#pragma unroll
      for (int i = 0; i < 4; ++i) {
        *(u32x2*)(vd + vdst0 + i * 4096) = (u32x2){rv[i][0], rv[i][1]};
        *(u32x2*)(vd + vdst1 + i * 4096) = (u32x2){rv[i][2], rv[i][3]};
      }
    }
    __syncthreads();
  }
  ATT_PV(ntiles - 1)
  __syncthreads();
#undef ATT_S
#undef ATT_MAX
#undef ATT_EXP
#undef ATT_PV
  const float lt = lrun + __shfl_xor(lrun, 32);
  const float sc = (m ? lam : 1.0f) / lt;
  float* xo = (float*)smem + rb * 4096;
  if (m == 1) {
#pragma unroll
    for (int eb = 0; eb < 4; ++eb)
#pragma unroll
      for (int i = 0; i < 16; ++i) xo[(eb * 32 + (i & 3) + 8 * (i >> 2) + 4 * fh) * 32 + fr] = O[eb][i] * sc;
  }
  __syncthreads();
  if (m == 0) {
    float ss = 0.f;
#pragma unroll
    for (int eb = 0; eb < 4; ++eb)
#pragma unroll
      for (int i = 0; i < 16; ++i) {
        const float o = O[eb][i] * sc - xo[(eb * 32 + (i & 3) + 8 * (i >> 2) + 4 * fh) * 32 + fr];
        O[eb][i] = o; ss = fmaf(o, o, ss);
      }
    ss += __shfl_xor(ss, 32);
    const float rn = rsqrtf(ss * (1.0f / 128.0f) + EPSF) * (1.0f - lam_init);
    const float* sg = p.in[I_SUBG] + l * 512 + h * 128;
    bf16_t* yp = YAb + (size_t)myrow * 512 + h * 128;
#pragma unroll
    for (int eb = 0; eb < 4; ++eb)
#pragma unroll
      for (int q = 0; q < 4; ++q) {
        const int e = eb * 32 + 8 * q + 4 * fh;
        const float4 g = *(const float4*)(sg + e);
        *(u32x2*)(yp + e) = (u32x2){pack2(O[eb][4 * q] * rn * g.x, O[eb][4 * q + 1] * rn * g.y), pack2(O[eb][4 * q + 2] * rn * g.z, O[eb][4 * q + 3] * rn * g.w)};
      }
  }
  __syncthreads();
}

__device__ __forceinline__ int mlstm_row0(int dir, int c) {
  return (dir == 0) ? ((c < 4) ? NLAT + 64 * c : 64 * (c - 4)) : ((c < 4) ? NLAT + 64 * (3 - c) : 64 * (67 - c));
}
__device__ __forceinline__ void stage_mlgates(const Params& p, int l, const float* MGT, float* GA) {
  const int tid = otid(), w = tid >> 6, lane = tid & 63;
  const int nitems = GB * 4 * 2 * 68;
  for (int idx = blockIdx.x * 4 + w; idx < nitems; idx += gridDim.x * 4) {
    const int c = idx % 68, r1 = idx / 68, dir = r1 & 1, h = (r1 >> 1) & 3, bl = r1 >> 3;
    const int row = mlstm_row0(dir, c) + lane;
    const float* mg = MGT + ((size_t)bl * NTOK + row) * 16;
    const float li = mg[dir * 8 + h] + p.in[I_GATEB][l * 16 + dir * 8 + h];
    const float x = mg[dir * 8 + 4 + h] + p.in[I_GATEB][l * 16 + dir * 8 + 4 + h];
    const float lf = fminf(x, 0.f) - log1pf(expf(-fabsf(x)));
    float b = lf;
#pragma unroll
    for (int o = 1; o < 64; o <<= 1) {
      const float v = (dir == 0) ? __shfl_up(b, o) : __shfl_down(b, o);
      const bool ok = (dir == 0) ? (lane >= o) : (lane + o < 64);
      if (ok) b += v;
    }
    const float tot = (dir == 0) ? __shfl(b, 63) : __shfl(b, 0);
    float* ga = GA + (size_t)idx * 272;
    ga[lane] = b * 1.4426950408889634f; ga[64 + lane] = (li - b) * 1.4426950408889634f; ga[128 + lane] = expf(tot + li - b); ga[192 + lane] = expf(b);
    if (lane < 4) ga[256 + lane] = expf(tot);
  }
}

__device__ __forceinline__ void mlstm_chain_item(const Params& p, int l, const bf16_t* QMb, const bf16_t* KMb, const bf16_t* KMTb, const bf16_t* MVTb,
                                                 const float* GAc, bf16_t* HXb, int h, int dir, char* smem) {
  const int tid = otid(), lane = tid & 63, w = tid >> 6, fr = lane & 31, fh = lane >> 5;
  const int tb = w & 1, eh = w >> 1;
  float* fl = (float*)(smem + 98304);
  float* bs = fl; float* as_ = fl + 64; float* wgs = fl + 128; float* ebs = fl + 192; float* dec_s = fl + 256; float* nprev = fl + 272; float* npart = fl + 400;
  f32x16 CT[4];
#pragma unroll
  for (int eb = 0; eb < 4; ++eb)
#pragma unroll
    for (int i = 0; i < 16; ++i) CT[eb][i] = 0.f;
  __syncthreads();
  for (int i = tid; i < 2048; i += 256) ((u32x4*)(smem + 65536))[i] = (u32x4){0u, 0u, 0u, 0u};
  if (tid < 128) nprev[tid] = 0.f;
  const int qr = tid >> 4, qc = tid & 15;
  const int qdst = qr * 256 + ((qc ^ (qr & 15)) << 4);
  const int tr = tid >> 3, tc = tid & 7;
  const int tdst = tr * 128 + ((tc ^ ((tr >> 1) & 7)) << 4);
  const int sw16 = fr & 15, sw8 = (fr >> 1) & 7;
  u32x4 ra[4], rb[4], rc[4], rd[4];
  float4 rg = make_float4(0.f, 0.f, 0.f, 0.f);
  {
    const int row0 = mlstm_row0(dir, 0);
    const bf16_t* qs = QMb + (size_t)(row0 + qr) * 512 + h * 128 + qc * 8;
    const bf16_t* ks = KMb + (size_t)(row0 + qr) * 512 + h * 128 + qc * 8;
    const bf16_t* kts = KMTb + ((size_t)h * 128 + tr) * NTOK + row0 + tc * 8;
    const bf16_t* vts = MVTb + ((size_t)h * 128 + tr) * NTOK + row0 + tc * 8;
#pragma unroll
    for (int i = 0; i < 4; ++i) {
      ra[i] = *(const u32x4*)(qs + (size_t)i * 16 * 512);
      rb[i] = *(const u32x4*)(ks + (size_t)i * 16 * 512);
      rc[i] = *(const u32x4*)(kts + (size_t)i * 32 * NTOK);
      rd[i] = *(const u32x4*)(vts + (size_t)i * 32 * NTOK);
    }
    if (tid < 68) rg = ((const float4*)GAc)[tid];
  }
#pragma unroll 1
  for (int c = 0; c < 68; ++c) {
    const int row0 = mlstm_row0(dir, c);
    __syncthreads();
#pragma unroll
    for (int i = 0; i < 4; ++i) {
      *(u32x4*)(smem + qdst + i * 4096) = ra[i];
      *(u32x4*)(smem + 16384 + qdst + i * 4096) = rb[i];
      *(u32x4*)(smem + 32768 + tdst + i * 4096) = rc[i];
      *(u32x4*)(smem + 49152 + tdst + i * 4096) = rd[i];
    }
    if (tid < 68) ((float4*)fl)[tid] = rg;
    if (c + 1 < 68) {
      const int rown = mlstm_row0(dir, c + 1);
      const bf16_t* qs = QMb + (size_t)(rown + qr) * 512 + h * 128 + qc * 8;
      const bf16_t* ks = KMb + (size_t)(rown + qr) * 512 + h * 128 + qc * 8;
      const bf16_t* kts = KMTb + ((size_t)h * 128 + tr) * NTOK + rown + tc * 8;
      const bf16_t* vts = MVTb + ((size_t)h * 128 + tr) * NTOK + rown + tc * 8;
#pragma unroll
      for (int i = 0; i < 4; ++i) {
        ra[i] = *(const u32x4*)(qs + (size_t)i * 16 * 512);
        rb[i] = *(const u32x4*)(ks + (size_t)i * 16 * 512);
        rc[i] = *(const u32x4*)(kts + (size_t)i * 32 * NTOK);
        rd[i] = *(const u32x4*)(vts + (size_t)i * 32 * NTOK);
      }
      if (tid < 68) rg = ((const float4*)(GAc + (size_t)(c + 1) * 272))[tid];
    }
    __syncthreads();
    const int t = tb * 32 + fr;
    bf16x8 qf[8];
#pragma unroll
    for (int ks = 0; ks < 8; ++ks) qf[ks] = *(const bf16x8*)(smem + t * 256 + (((ks * 2 + fh) ^ sw16) << 4));
    const float bt = bs[t], ebt = ebs[t];
    f32x16 S[2];
    float dsum = 0.f;
#pragma unroll
    for (int sb = 0; sb < 2; ++sb) {
#pragma unroll
      for (int i = 0; i < 16; ++i) S[sb][i] = 0.f;
      const bool valid = (dir == 0) ? (sb <= tb) : (sb >= tb);
      if (valid) {
#pragma unroll
        for (int ks = 0; ks < 8; ++ks) {
          const bf16x8 kf = *(const bf16x8*)(smem + 16384 + (sb * 32 + fr) * 256 + (((ks * 2 + fh) ^ sw16) << 4));
          S[sb] = __builtin_amdgcn_mfma_f32_32x32x16_bf16(kf, qf[ks], S[sb], 0, 0, 0);
        }
#pragma unroll
        for (int q = 0; q < 4; ++q) {
          const float4 a4 = *(const float4*)(as_ + sb * 32 + 8 * q + 4 * fh);
          const float av[4] = {a4.x, a4.y, a4.z, a4.w};
#pragma unroll
          for (int j = 0; j < 4; ++j) {
            const int s = sb * 32 + 8 * q + 4 * fh + j;
            const bool ok = (dir == 0) ? (s <= t) : (s >= t);
            const float v = ok ? S[sb][4 * q + j] * __builtin_amdgcn_exp2f(bt + av[j]) : 0.f;
            S[sb][4 * q + j] = v;
            dsum += v;
          }
        }
      }
    }
    bf16x8 pf[4];
#pragma unroll
    for (int sb = 0; sb < 2; ++sb)
#pragma unroll
      for (int hh = 0; hh < 2; ++hh)
        pf[sb * 2 + hh] = __builtin_bit_cast(bf16x8, (u32x4){pack2(S[sb][8 * hh], S[sb][8 * hh + 1]), pack2(S[sb][8 * hh + 2], S[sb][8 * hh + 3]),
                                                                 pack2(S[sb][8 * hh + 4], S[sb][8 * hh + 5]), pack2(S[sb][8 * hh + 6], S[sb][8 * hh + 7])});
    float nq = 0.f;
#pragma unroll
    for (int c8 = 0; c8 < 8; ++c8) {
      const u32x4 qv = *(const u32x4*)(smem + t * 256 + (((fh * 8 + c8) ^ sw16) << 4));
      const float4 n0 = *(const float4*)(nprev + fh * 64 + c8 * 8), n1 = *(const float4*)(nprev + fh * 64 + c8 * 8 + 4);
      nq = fmaf(lo16(qv[0]), n0.x, nq); nq = fmaf(hi16(qv[0]), n0.y, nq); nq = fmaf(lo16(qv[1]), n0.z, nq); nq = fmaf(hi16(qv[1]), n0.w, nq);
      nq = fmaf(lo16(qv[2]), n1.x, nq); nq = fmaf(hi16(qv[2]), n1.y, nq); nq = fmaf(lo16(qv[3]), n1.z, nq); nq = fmaf(hi16(qv[3]), n1.w, nq);
    }
    dsum += __shfl_xor(dsum, 32);
    nq += __shfl_xor(nq, 32);
    const float den = dsum + ebt * nq;
    const float inv = 1.0f / fmaxf(fabsf(den), 1.0f);
#pragma unroll
    for (int x = 0; x < 2; ++x) {
      const int eb = 2 * eh + x;
      f32x16 N;
#pragma unroll
      for (int i = 0; i < 16; ++i) N[i] = 0.f;
#pragma unroll
      for (int ks = 0; ks < 8; ++ks) {
        const bf16x8 cf = *(const bf16x8*)(smem + 65536 + (eb * 32 + fr) * 256 + (((ks * 2 + fh) ^ sw16) << 4));
        N = __builtin_amdgcn_mfma_f32_32x32x16_bf16(cf, qf[ks], N, 0, 0, 0);
      }
#pragma unroll
      for (int i = 0; i < 16; ++i) N[i] *= ebt;
#pragma unroll
      for (int s4 = 0; s4 < 4; ++s4) {
        const bool valid = (dir == 0) ? ((s4 >> 1) <= tb) : ((s4 >> 1) >= tb);
        if (valid) {
          const int u0 = 4 * s4 + fh, u1 = u0 + 2;
          const char* vrow = smem + 49152 + (eb * 32 + fr) * 128;
          const u32x2 v0 = *(const u32x2*)(vrow + (((u0 >> 1) ^ sw8) << 4) + (u0 & 1) * 8);
          const u32x2 v1 = *(const u32x2*)(vrow + (((u1 >> 1) ^ sw8) << 4) + (u1 & 1) * 8);
          const bf16x8 vf = __builtin_bit_cast(bf16x8, (u32x4){v0[0], v0[1], v1[0], v1[1]});
          N = __builtin_amdgcn_mfma_f32_32x32x16_bf16(vf, pf[s4], N, 0, 0, 0);
        }
      }
      bf16_t* hp = HXb + (size_t)(row0 + t) * 512 + h * 128 + eb * 32 + 4 * fh;
#pragma unroll
      for (int q = 0; q < 4; ++q)
        *(u32x2*)(hp + 8 * q) = (u32x2){pack2(N[4 * q] * inv, N[4 * q + 1] * inv), pack2(N[4 * q + 2] * inv, N[4 * q + 3] * inv)};
    }
    const float decay = *dec_s;
#pragma unroll
    for (int eb = 0; eb < 4; ++eb)
#pragma unroll
      for (int i = 0; i < 16; ++i) CT[eb][i] *= decay;
#pragma unroll
    for (int ks = 0; ks < 4; ++ks) {
      const u32x4 kraw = *(const u32x4*)(smem + 32768 + (w * 32 + fr) * 128 + (((ks * 2 + fh) ^ sw8) << 4));
      const float4 g0 = *(const float4*)(wgs + ks * 16 + 8 * fh), g1 = *(const float4*)(wgs + ks * 16 + 8 * fh + 4);
      const bf16x8 kts = __builtin_bit_cast(bf16x8, (u32x4){pack2(lo16(kraw[0]) * g0.x, hi16(kraw[0]) * g0.y), pack2(lo16(kraw[1]) * g0.z, hi16(kraw[1]) * g0.w),
                                                             pack2(lo16(kraw[2]) * g1.x, hi16(kraw[2]) * g1.y), pack2(lo16(kraw[3]) * g1.z, hi16(kraw[3]) * g1.w)});
#pragma unroll
      for (int eb = 0; eb < 4; ++eb) {
        const bf16x8 vt = *(const bf16x8*)(smem + 49152 + (eb * 32 + fr) * 128 + (((ks * 2 + fh) ^ sw8) << 4));
        CT[eb] = __builtin_amdgcn_mfma_f32_32x32x16_bf16(kts, vt, CT[eb], 0, 0, 0);
      }
    }
    {
      const int d = tid & 127, sh = tid >> 7;
      float a = 0.f;
#pragma unroll 8
      for (int s = sh * 32; s < sh * 32 + 32; ++s) {
        const bf16_t kv = *(const bf16_t*)(smem + 16384 + s * 256 + ((((d >> 3)) ^ (s & 15)) << 4) + (d & 7) * 2);
        a = fmaf(wgs[s], bf2f(kv), a);
      }
      npart[sh * 128 + d] = a;
    }
    __syncthreads();
#pragma unroll
    for (int eb = 0; eb < 4; ++eb)
#pragma unroll
      for (int q = 0; q < 4; ++q)
        *(u32x2*)(smem + 65536 + (eb * 32 + fr) * 256 + ((((w * 4 + q)) ^ sw16) << 4) + 8 * fh) =
            (u32x2){pack2(CT[eb][4 * q], CT[eb][4 * q + 1]), pack2(CT[eb][4 * q + 2], CT[eb][4 * q + 3])};
    if (tid < 128) nprev[tid] = decay * nprev[tid] + npart[tid] + npart[128 + tid];
  }
  __syncthreads();
}

#define S5SEG 128
#define S5NSEG 34
__device__ __forceinline__ int s5_row(int dir, int step) {
  return (dir == 0) ? ((step < NCTX) ? NLAT + step : step - NCTX)
                    : ((step < NCTX) ? NLAT + (NCTX - 1 - step) : (NLAT - 1) - (step - NCTX));
}
__device__ __forceinline__ bf16x8 pack8(const float* f) {
  return __builtin_bit_cast(bf16x8, (u32x4){pack2(f[0], f[1]), pack2(f[2], f[3]), pack2(f[4], f[5]), pack2(f[6], f[7])});
}
struct S5M { float abr, abi, a128r, a128i; bf16x8 bbf[4]; };
__device__ __forceinline__ void s5m_setup(const Params& p, int pg, int lane, S5M& m) {
  const int fr = lane & 31, fh = lane >> 5;
  const float dt = expf(p.in[I_S5DT][pg]);
  m.abr = 0.f; m.abi = 0.f; m.a128r = 0.f; m.a128i = 0.f;
#pragma unroll
  for (int c = 0; c < 2; ++c) {
    const int n = fr + 32 * c;
    const float lre = p.in[I_S5LRE][pg * 64 + n], lim = p.in[I_S5LIM][pg * 64 + n];
    const float mag = expf(lre * dt);
    const float abr = mag * cosf(lim * dt), abi = mag * sinf(lim * dt);
    const float den = lre * lre + lim * lim;
    const float zr = ((abr - 1.0f) * lre + abi * lim) / den;
    const float zi = (abi * lre - (abr - 1.0f) * lim) / den;
    const float4* br4 = (const float4*)(p.in[I_S5BRE] + ((size_t)pg * 64 + n) * 16 + 8 * fh);
    const float4* bi4 = (const float4*)(p.in[I_S5BIM] + ((size_t)pg * 64 + n) * 16 + 8 * fh);
    const float4 b0 = br4[0], b1 = br4[1], c0 = bi4[0], c1 = bi4[1];
    const float br[8] = {b0.x, b0.y, b0.z, b0.w, b1.x, b1.y, b1.z, b1.w}, bi[8] = {c0.x, c0.y, c0.z, c0.w, c1.x, c1.y, c1.z, c1.w};
    float rr[8], ii[8];
#pragma unroll
    for (int j = 0; j < 8; ++j) { rr[j] = zr * br[j] - zi * bi[j]; ii[j] = zr * bi[j] + zi * br[j]; }
    m.bbf[c] = pack8(rr); m.bbf[2 + c] = pack8(ii);
    if (fh == c) {
      m.abr = abr; m.abi = abi;
      const float mg = expf(lre * dt * (float)S5SEG);
      m.a128r = mg * cosf(lim * dt * (float)S5SEG); m.a128i = mg * sinf(lim * dt * (float)S5SEG);
    }
  }
}
template <bool STORE>
__device__ __forceinline__ void s5m_block(const S5M& m, const bf16x8 uf, float& xr, float& xi, char* xs, int lane) {
  f32x16 T[4];
#pragma unroll
  for (int k = 0; k < 4; ++k) {
#pragma unroll
    for (int i = 0; i < 16; ++i) T[k][i] = 0.f;
    T[k] = __builtin_amdgcn_mfma_f32_32x32x16_bf16(uf, m.bbf[k], T[k], 0, 0, 0);
  }
#pragma unroll
  for (int r = 0; r < 16; ++r) {
    auto a = __builtin_amdgcn_permlane32_swap(__float_as_uint(T[0][r]), __float_as_uint(T[1][r]), false, false);
    T[0][r] = __uint_as_float(a[0]); T[1][r] = __uint_as_float(a[1]);
    auto b = __builtin_amdgcn_permlane32_swap(__float_as_uint(T[2][r]), __float_as_uint(T[3][r]), false, false);
    T[2][r] = __uint_as_float(b[0]); T[3][r] = __uint_as_float(b[1]);
  }
#pragma unroll
  for (int q = 0; q < 4; ++q)
#pragma unroll
    for (int hh = 0; hh < 2; ++hh)
#pragma unroll
      for (int j = 0; j < 4; ++j) {
        const int t = 8 * q + 4 * hh + j, r = 4 * q + j;
        const float bre = hh ? T[1][r] : T[0][r], bim = hh ? T[3][r] : T[2][r];
        const float nr = fmaf(m.abr, xr, fmaf(-m.abi, xi, bre));
        const float ni = fmaf(m.abr, xi, fmaf(m.abi, xr, bim));
        xr = nr; xi = ni;
        if (STORE) *(unsigned*)(xs + t * 256 + (((lane >> 2) ^ (t & 15)) << 4) + (lane & 3) * 4) = pack2(xr, xi);
      }
}
__device__ __forceinline__ void stage_s5_pass1(const Params& p, int l, const bf16_t* Z, float* XE) {
  const int tid = otid(), w = tid >> 6, lane = tid & 63, fr = lane & 31, fh = lane >> 5;
  const int nitems = GB * 32 * 2 * (S5NSEG - 1);
  for (int idx = blockIdx.x * 4 + w; idx < nitems; idx += gridDim.x * 4) {
    const int seg = idx % (S5NSEG - 1), r1 = idx / (S5NSEG - 1), dir = r1 & 1, g = (r1 >> 1) & 31, bl = r1 >> 6;
    S5M m;
    s5m_setup(p, (l * 2 + dir) * 32 + g, lane, m);
    float xr = 0.f, xi = 0.f;
#pragma unroll 1
    for (int sub = 0; sub < S5SEG / 32; ++sub) {
      const int row = s5_row(dir, seg * S5SEG + sub * 32 + fr);
      const bf16x8 uf = *(const bf16x8*)(Z + ((size_t)bl * NTOK + row) * ZW + 3072 + g * 16 + 8 * fh);
      s5m_block<false>(m, uf, xr, xi, nullptr, lane);
    }
    float* xe = XE + ((((size_t)bl * 32 + g) * 2 + dir) * (S5NSEG - 1) + seg) * 128;
    xe[lane] = xr; xe[64 + lane] = xi;
  }
}
__device__ __forceinline__ void s5_item(const Params& p, int l, const bf16_t* Zb, const float* XEc, float* Yb, int g, int dir, int sq, char* smem) {
  const int tid = otid(), w = tid >> 6, lane = tid & 63, fr = lane & 31, fh = lane >> 5;
  const int seg = sq * 4 + w;
  char* xs = smem + w * 8192;
  const int pg = (l * 2 + dir) * 32 + g;
  __syncthreads();
  if (seg < S5NSEG) {
    S5M m;
    s5m_setup(p, pg, lane, m);
    bf16x8 ccf[8];
#pragma unroll
    for (int ks = 0; ks < 8; ++ks) {
      float f[8] = {0.f, 0.f, 0.f, 0.f, 0.f, 0.f, 0.f, 0.f};
      if (fr < 16) {
        const float4 cr = *(const float4*)(p.in[I_S5CRE] + ((size_t)pg * 16 + fr) * 64 + ks * 8 + 4 * fh);
        const float4 ci = *(const float4*)(p.in[I_S5CIM] + ((size_t)pg * 16 + fr) * 64 + ks * 8 + 4 * fh);
        f[0] = cr.x; f[1] = -ci.x; f[2] = cr.y; f[3] = -ci.y; f[4] = cr.z; f[5] = -ci.z; f[6] = cr.w; f[7] = -ci.w;
      }
      ccf[ks] = pack8(f);
    }
    float xr = 0.f, xi = 0.f;
    for (int j = 0; j < seg; ++j) {
      const float er = XEc[j * 128 + lane], ei = XEc[j * 128 + 64 + lane];
      const float nr = m.a128r * xr - m.a128i * xi + er, ni = m.a128r * xi + m.a128i * xr + ei;
      xr = nr; xi = ni;
    }
#pragma unroll 1
    for (int sub = 0; sub < S5SEG / 32; ++sub) {
      const int row = s5_row(dir, seg * S5SEG + sub * 32 + fr);
      const bf16x8 uf = *(const bf16x8*)(Zb + (size_t)row * ZW + 3072 + g * 16 + 8 * fh);
      s5m_block<true>(m, uf, xr, xi, xs, lane);
      f32x16 Y;
#pragma unroll
      for (int i = 0; i < 16; ++i) Y[i] = 0.f;
#pragma unroll
      for (int ks = 0; ks < 8; ++ks) {
        const bf16x8 xf = *(const bf16x8*)(xs + fr * 256 + (((ks * 2 + fh) ^ (fr & 15)) << 4));
        Y = __builtin_amdgcn_mfma_f32_32x32x16_bf16(ccf[ks], xf, Y, 0, 0, 0);
      }
      float* yp = Yb + (size_t)row * 512 + g * 16 + 4 * fh;
      *(float4*)yp = make_float4(Y[0], Y[1], Y[2], Y[3]);
      *(float4*)(yp + 8) = make_float4(Y[4], Y[5], Y[6], Y[7]);
    }
  }
}

__device__ __forceinline__ void stage_post(const Params& p, int l, int rr_lim, const bf16_t* Z, const bf16_t* HF, const bf16_t* HB,
                                           const float* YSF, const float* YSB, bf16_t* YB, bf16_t* GG) {
  const int tid = otid();
  const int c0 = tid * 2;
  const float2 gml = *(const float2*)(p.in[I_MLNG] + l * 512 + c0);
  const float2 dsk = *(const float2*)(p.in[I_S5D] + l * 512 + c0);
  const int n = GB * rr_lim;
  for (int i0 = blockIdx.x * 4; i0 < n; i0 += gridDim.x * 4) {
    unsigned a0[4], a1[4], og[4], uu[4];
    float2 f[4], b[4];
    size_t r[4];
#pragma unroll
    for (int u = 0; u < 4; ++u) {
      const int i = i0 + u;
      r[u] = (size_t)(i / rr_lim) * NTOK + (i % rr_lim);
      a0[u] = *(const unsigned*)(HF + r[u] * 512 + c0); a1[u] = *(const unsigned*)(HB + r[u] * 512 + c0);
      og[u] = *(const unsigned*)(Z + r[u] * ZW + 2560 + c0); uu[u] = *(const unsigned*)(Z + r[u] * ZW + 3072 + c0);
      f[u] = *(const float2*)(YSF + r[u] * 512 + c0); b[u] = *(const float2*)(YSB + r[u] * 512 + c0);
    }
#pragma unroll
    for (int u = 0; u < 4; ++u) {
      const float h0 = lo16(a0[u]) + lo16(a1[u]), h1 = hi16(a0[u]) + hi16(a1[u]);
      const float ss = wave_sum(h0 * h0 + h1 * h1);
      const float rs = rsqrtf(ss * (1.0f / 128.0f) + EPSF);
      *(unsigned*)(YB + r[u] * 512 + c0) = pack2(h0 * rs * gml.x * sigmoidf_(lo16(og[u])), h1 * rs * gml.y * sigmoidf_(hi16(og[u])));
      *(unsigned*)(GG + r[u] * 512 + c0) = pack2(geluf_(dsk.x * lo16(uu[u]) + f[u].x + b[u].x), geluf_(dsk.y * hi16(uu[u]) + f[u].y + b[u].y));
    }
  }
}

__device__ __forceinline__ void stage_glu_mfma(const Params& p, int l, int tpb, const bf16_t* GG, const bf16_t* GLUT, bf16_t* YS, char* smem) {
  EPI_DECL
  const int tm = GB * tpb;
  TileIter ti(tm, 4);
  int mt_, nt_; bool valid;
  while (ti.next(mt_, nt_, valid)) {
    if (!valid) continue;
    const int m0 = MT_LR0(mt_, tpb), n0 = nt_ * 128;
    f32x16 acc[2][2];
    gemm_tile(GG + (size_t)m0 * 512, 512, GLUT + (size_t)n0 * 512, 512, 512, smem, acc);
#pragma unroll
    for (int mi = 0; mi < 2; ++mi)
#pragma unroll
      for (int ni = 0; ni < 2; ++ni)
#pragma unroll
        for (int q = 0; q < 4; ++q) {
          const int row = m0 + EPI_ROW(mi), c = n0 + EPI_COL(ni, q);
          const float4 b = *(const float4*)(p.in[I_GLUB] + l * 512 + c);
          const u32x2 g2 = *(const u32x2*)(GG + (size_t)row * 512 + c);
          const float o0 = lo16(g2[0]) * sigmoidf_(acc[mi][ni][4 * q] + b.x), o1 = hi16(g2[0]) * sigmoidf_(acc[mi][ni][4 * q + 1] + b.y);
          const float o2 = lo16(g2[1]) * sigmoidf_(acc[mi][ni][4 * q + 2] + b.z), o3 = hi16(g2[1]) * sigmoidf_(acc[mi][ni][4 * q + 3] + b.w);
          *(u32x2*)(YS + (size_t)row * 512 + c) = (u32x2){pack2(o0, o1), pack2(o2, o3)};
        }
  }
}

__device__ __forceinline__ void stage_merge_mfma(int tpb, const bf16_t* YA, const bf16_t* YB, const bf16_t* YS, const bf16_t* WBR, const bf16_t* Z, bf16_t* MG, char* smem) {
  EPI_DECL
  const int tm = GB * tpb;
  TileIter ti(tm, 8);
  int mt_, nt_; bool valid;
  while (ti.next(mt_, nt_, valid)) {
    if (!valid) continue;
    const int m0 = MT_LR0(mt_, tpb), n0 = nt_ * 128;
    f32x16 macc[2][2];
#pragma unroll
    for (int a = 0; a < 2; ++a)
#pragma unroll
      for (int b = 0; b < 2; ++b)
#pragma unroll
        for (int i = 0; i < 16; ++i) macc[a][b][i] = 0.f;
#pragma unroll 1
    for (int r = 0; r < 3; ++r) {
      const bf16_t* Y = (r == 0) ? YA : (r == 1 ? YB : YS);
      f32x16 acc[2][2];
      gemm_tile(Y + (size_t)m0 * 512, 512, WBR + (size_t)r * 1024 * 512 + (size_t)n0 * 512, 512, 512, smem, acc);
#pragma unroll
      for (int mi = 0; mi < 2; ++mi)
#pragma unroll
        for (int ni = 0; ni < 2; ++ni)
#pragma unroll
          for (int q = 0; q < 4; ++q) {
            const int row = m0 + EPI_ROW(mi), c = n0 + EPI_COL(ni, q);
            const u32x2 e = *(const u32x2*)(Z + (size_t)row * ZW + 3584 + r * 1024 + c);
            macc[mi][ni][4 * q] += lo16(e[0]) * acc[mi][ni][4 * q];
            macc[mi][ni][4 * q + 1] += hi16(e[0]) * acc[mi][ni][4 * q + 1];
            macc[mi][ni][4 * q + 2] += lo16(e[1]) * acc[mi][ni][4 * q + 2];
            macc[mi][ni][4 * q + 3] += hi16(e[1]) * acc[mi][ni][4 * q + 3];
          }
    }
#pragma unroll
    for (int mi = 0; mi < 2; ++mi)
#pragma unroll
      for (int ni = 0; ni < 2; ++ni)
#pragma unroll
        for (int q = 0; q < 4; ++q) {
          const int row = m0 + EPI_ROW(mi), c = n0 + EPI_COL(ni, q);
          *(u32x2*)(MG + (size_t)row * DM + c) = (u32x2){pack2(macc[mi][ni][4 * q], macc[mi][ni][4 * q + 1]), pack2(macc[mi][ni][4 * q + 2], macc[mi][ni][4 * q + 3])};
        }
  }
}

__device__ __forceinline__ void stage_outproj_mfma(const Params& p, int l, int g, int tpb, const bf16_t* MG, const bf16_t* WOUT, char* smem) {
  EPI_DECL
  const int tm = GB * tpb;
  const float* mod = (const float*)(p.ws + WB_MOD) + (size_t)l * 9 * 6144;
  TileIter ti(tm, 8);
  int mt, nt_; bool valid;
  while (ti.next(mt, nt_, valid)) {
    if (!valid) continue;
    const int n0 = nt_ * 128;
    const int m0 = MT_LR0(mt, tpb), bl = mt / tpb, rr0 = (mt % tpb) * 128, b = g * GB + bl;
    f32x16 acc[2][2];
    gemm_tile(MG + (size_t)m0 * DM, DM, WOUT + (size_t)n0 * DM, DM, DM, smem, acc);
    const float* gv = mod + (size_t)((rr0 < NLAT) ? b : 8) * 6144 + 2 * 1024;
#pragma unroll
    for (int mi = 0; mi < 2; ++mi)
#pragma unroll
      for (int ni = 0; ni < 2; ++ni)
#pragma unroll
        for (int q = 0; q < 4; ++q) {
          const int rr = rr0 + EPI_ROW(mi), c = n0 + EPI_COL(ni, q);
          const float4 gg = *(const float4*)(gv + c);
          float4* xp = (float4*)(xrow(p, b, rr) + c);
          float4 x = (l == 0) ? *(const float4*)(xrow_in(p, b, rr) + c) : *xp;
          x.x += gg.x * acc[mi][ni][4 * q]; x.y += gg.y * acc[mi][ni][4 * q + 1]; x.z += gg.z * acc[mi][ni][4 * q + 2]; x.w += gg.w * acc[mi][ni][4 * q + 3];
          *xp = x;
        }
  }
}

__device__ __forceinline__ void stage_peerq_mfma(int tpb, const bf16_t* H2, const bf16_t* WQ, bf16_t* PQ, char* smem) {
  EPI_DECL
  const int tm = GB * tpb;
  TileIter ti(tm, 16);
  int mt_, nt_; bool valid;
  while (ti.next(mt_, nt_, valid)) {
    if (!valid) continue;
    const int m0 = MT_LR0(mt_, tpb), n0 = nt_ * 128;
    f32x16 acc[2][2];
    gemm_tile(H2 + (size_t)m0 * DM, DM, WQ + (size_t)n0 * DM, DM, DM, smem, acc);
#pragma unroll
    for (int mi = 0; mi < 2; ++mi)
#pragma unroll
      for (int ni = 0; ni < 2; ++ni)
#pragma unroll
        for (int q = 0; q < 4; ++q) {
          const int row = m0 + EPI_ROW(mi), c = n0 + EPI_COL(ni, q);
          *(u32x2*)(PQ + (size_t)row * 2048 + c) = (u32x2){pack2(acc[mi][ni][4 * q], acc[mi][ni][4 * q + 1]), pack2(acc[mi][ni][4 * q + 2], acc[mi][ni][4 * q + 3])};
        }
  }
}

__device__ __forceinline__ unsigned f2sortable(float x) { const unsigned u = __float_as_uint(x); return (u & 0x80000000u) ? ~u : (u | 0x80000000u); }
__device__ __forceinline__ float sortable2f(unsigned k) { return __uint_as_float((k & 0x80000000u) ? (k & 0x7fffffffu) : ~k); }
#define TOPK_INSERT(v, key) { unsigned t_ = (key); _Pragma("unroll") for (int s_ = 0; s_ < 16; ++s_) { const unsigned hi_ = max(v[s_], t_); t_ = min(v[s_], t_); v[s_] = hi_; } }
__device__ __forceinline__ void stage_scores_topk(int tpb, const bf16_t* PQ, const bf16_t* SUBK, int* EI, float* EG, char* smem) {
  EPI_DECL
  const int tid = tid_;
  const int item = tid & 127, kpart = tid >> 7;
  float* S = (float*)smem;
  unsigned* xk = (unsigned*)(smem + 128 * 129 * 4);
  const int tm = GB * tpb * 8;
  for (int mt = blockIdx.x; mt < tm; mt += gridDim.x) {
    const size_t m0 = (size_t)MT_LR0(mt >> 3, tpb) * 8 + (size_t)(mt & 7) * 128;
    unsigned vh[2][16];
#pragma unroll
    for (int half = 0; half < 2; ++half) {
      f32x16 acc[2][2];
      gemm_tile(PQ + m0 * 256 + half * 128, 256, SUBK + (size_t)half * 16384, 128, 128, smem, acc);
#pragma unroll
      for (int mi = 0; mi < 2; ++mi)
#pragma unroll
        for (int ni = 0; ni < 2; ++ni)
#pragma unroll
          for (int i = 0; i < 16; ++i)
            S[EPI_ROW(mi) * 129 + wn * 64 + ni * 32 + 8 * (i >> 2) + 4 * fh + (i & 3)] = acc[mi][ni][i];
      __syncthreads();
      unsigned v[16];
#pragma unroll
      for (int s = 0; s < 16; ++s) v[s] = 0u;
      const float* sr = S + item * 129 + kpart * 64;
#pragma unroll 8
      for (int k = 0; k < 64; ++k) {
        const unsigned key = (f2sortable(sr[k]) & ~127u) | (unsigned)(127 - (kpart * 64 + k));
        TOPK_INSERT(v, key)
      }
      if (kpart == 1) {
#pragma unroll
        for (int s = 0; s < 16; ++s) xk[item * 17 + s] = v[s];
      }
      __syncthreads();
      if (kpart == 0) {
#pragma unroll
        for (int s = 0; s < 16; ++s) { const unsigned key = xk[item * 17 + s]; TOPK_INSERT(v, key) }
      }
#pragma unroll
      for (int s = 0; s < 16; ++s) vh[half][s] = v[s];
      __syncthreads();
    }
    if (kpart == 0) {
      float v1[16], v2[16];
#pragma unroll
      for (int s = 0; s < 16; ++s) { v1[s] = sortable2f((vh[0][s] & ~127u) | 64u); v2[s] = sortable2f((vh[1][s] & ~127u) | 64u); }
      unsigned c[16];
#pragma unroll
      for (int s = 0; s < 16; ++s) c[s] = 0u;
      {
        int o = 0;
#pragma unroll
        for (int i = 0; i < 16; ++i)
#pragma unroll
          for (int j = 0; j < 16 / (i + 1); ++j) {
            const unsigned key = (f2sortable(v1[i] + v2[j]) & ~63u) | (unsigned)(63 - o);
            TOPK_INSERT(c, key)
            ++o;
          }
      }
      const float vmax = sortable2f((c[0] & ~63u) | 32u);
      float sum = 0.f;
#pragma unroll
      for (int s = 0; s < 16; ++s) sum += expf(sortable2f((c[s] & ~63u) | 32u) - vmax);
      const float isum = 1.0f / sum;
      const unsigned thr = c[15];
      int* ei = EI + (m0 + item) * 16;
      float* eg = EG + (m0 + item) * 16;
      int cntw = 0;
      {
        int o = 0;
#pragma unroll
        for (int i = 0; i < 16; ++i)
#pragma unroll
          for (int j = 0; j < 16 / (i + 1); ++j) {
            const unsigned key = (f2sortable(v1[i] + v2[j]) & ~63u) | (unsigned)(63 - o);
            if (key >= thr) {
              ei[cntw] = (int)((127u - (vh[0][i] & 127u)) * 128u + (127u - (vh[1][j] & 127u)));
              eg[cntw] = expf(sortable2f((key & ~63u) | 32u) - vmax) * isum;
              ++cntw;
            }
            ++o;
          }
      }
    }
  }
  __syncthreads();
}

__device__ __forceinline__ void unpack8(const u32x4 v, float* f) {
#pragma unroll
  for (int k = 0; k < 4; ++k) { f[2 * k] = lo16(v[k]); f[2 * k + 1] = hi16(v[k]); }
}
__device__ __forceinline__ void unpack16_fp8(const u32x4 v, float* f) {
#pragma unroll
  for (int k = 0; k < 4; ++k) {
    const f32x2 a = __builtin_amdgcn_cvt_pk_f32_fp8((int)v[k], false), b = __builtin_amdgcn_cvt_pk_f32_fp8((int)v[k], true);
    f[4 * k] = a[0]; f[4 * k + 1] = a[1]; f[4 * k + 2] = b[0]; f[4 * k + 3] = b[1];
  }
}
__device__ __forceinline__ void expert_token(const Params& p, int q, int i, float* smem) {
  const int tid = otid(), w = tid >> 6, lane = tid & 63;
  const int l = q / NG, g = q % NG, rr_lim = (l == 0) ? NTOK : NLAT;
  float* part = smem;
  const unsigned char* U = (const unsigned char*)(p.ws + WB_U16) + (size_t)l * 16384 * 1024;
  const unsigned char* V = (const unsigned char*)(p.ws + WB_V16) + (size_t)l * 16384 * 1024;
  const float* mod = (const float*)(p.ws + WB_MOD) + (size_t)l * 9 * 6144;
  const bf16_t* H2 = (const bf16_t*)(p.ws + WB_H2) + (size_t)(q & 1) * RPG * DM;
  const int* EI = (const int*)(p.ws + WB_EI) + (size_t)(q & 1) * RPG * 128;
  const float* EG = (const float*)(p.ws + WB_EG) + (size_t)(q & 1) * RPG * 128;
  const int bl = i / rr_lim, rr = i % rr_lim, b = g * GB + bl;
  const size_t t = (size_t)bl * NTOK + rr;
  const int my_e = EI[t * 128 + w * 32 + (lane & 31)];
  const float my_g = EG[t * 128 + w * 32 + (lane & 31)];
  float hf[16];
  unpack8(((const u32x4*)(H2 + t * DM))[2 * lane], hf);
  unpack8(((const u32x4*)(H2 + t * DM))[2 * lane + 1], hf + 8);
  float my_dot = 0.f;
  {
    u32x4 ra[32];
#pragma unroll
    for (int j = 0; j < 32; ++j) {
      const int e = __builtin_amdgcn_readlane(my_e, j);
      ra[j] = ((const u32x4*)(U + (size_t)e * 1024))[lane];
    }
#pragma unroll
    for (int j = 0; j < 32; ++j) {
      float f[16];
      unpack16_fp8(ra[j], f);
      float a = 0.f;
#pragma unroll
      for (int qq = 0; qq < 16; ++qq) a = fmaf(hf[qq], f[qq], a);
      a = wave_sum(a);
      if ((lane & 31) == j) my_dot = a;
    }
  }
  const float my_c = my_g * geluf_(my_dot * (1.0f / 32.0f));
  float acc[16];
#pragma unroll
  for (int qq = 0; qq < 16; ++qq) acc[qq] = 0.f;
  {
    u32x4 ra[32];
#pragma unroll
    for (int j = 0; j < 32; ++j) {
      const int e = __builtin_amdgcn_readlane(my_e, j);
      ra[j] = ((const u32x4*)(V + (size_t)e * 1024))[lane];
    }
#pragma unroll
    for (int j = 0; j < 32; ++j) {
      const float c = __uint_as_float(__builtin_amdgcn_readlane(__float_as_uint(my_c), j));
      float f[16];
      unpack16_fp8(ra[j], f);
#pragma unroll
      for (int qq = 0; qq < 16; ++qq) acc[qq] = fmaf(c, f[qq], acc[qq]);
    }
  }
  __syncthreads();
  {
    float4* pw = (float4*)(part + w * 1024 + lane * 16);
    pw[0] = make_float4(acc[0], acc[1], acc[2], acc[3]); pw[1] = make_float4(acc[4], acc[5], acc[6], acc[7]);
    pw[2] = make_float4(acc[8], acc[9], acc[10], acc[11]); pw[3] = make_float4(acc[12], acc[13], acc[14], acc[15]);
  }
  __syncthreads();
  const float4 s0 = ((const float4*)part)[tid], s1 = ((const float4*)(part + 1024))[tid], s2 = ((const float4*)(part + 2048))[tid], s3 = ((const float4*)(part + 3072))[tid];
  const float4 g2 = ((const float4*)(mod + (size_t)((rr < NLAT) ? b : 8) * 6144 + 5 * 1024))[tid];
  float4* xp = (float4*)xrow(p, b, rr) + tid;
  float4 xv = *xp;
  xv.x += g2.x * (s0.x + s1.x + s2.x + s3.x); xv.y += g2.y * (s0.y + s1.y + s2.y + s3.y);
  xv.z += g2.z * (s0.z + s1.z + s2.z + s3.z); xv.w += g2.w * (s0.w + s1.w + s2.w + s3.w);
  *xp = xv;
}
__device__ __forceinline__ bool expert_steal(const Params& p, int lo, int hi, float* smem) {
  int* s_tok = (int*)(smem + SMEM_FLOATS - 8);
  __syncthreads();
  if (otid() == 0) {
    int r = -1;
    int* pool = (int*)(p.ws + WB_POOL);
    for (int q = lo; q <= hi && r < 0; ++q) {
      if (q < 0) continue;
      const int n = GB * ((q < NG) ? NTOK : NLAT);
      if (__hip_atomic_load(pool + q, __ATOMIC_RELAXED, __HIP_MEMORY_SCOPE_AGENT) < n) {
        const int i = atomicAdd(pool + q, 1);
        if (i < n) r = q * 65536 + i;
      }
    }
    *s_tok = r;
  }
  __syncthreads();
  const int r = *s_tok;
  if (r < 0) return false;
  expert_token(p, r >> 16, r & 65535, smem);
  return true;
}
__device__ __forceinline__ void expert_drain(const Params& p, int lo, int hi, float* smem) {
  while (expert_steal(p, lo, hi, smem)) {}
}

__device__ __forceinline__ void stage_final(const Params& p, float* smem) {
  const int tid = otid(), w = tid >> 6, lane = tid & 63;
  const int n = NB * NLAT;
  for (int r0 = (blockIdx.x * 4 + w) * 2; r0 < n; r0 += gridDim.x * 8) {
    float4 v[2][4];
#pragma unroll
    for (int u = 0; u < 2; ++u)
#pragma unroll
      for (int q = 0; q < 4; ++q) v[u][q] = ((const float4*)(p.out + (size_t)(r0 + u) * DM))[q * 64 + lane];
#pragma unroll
    for (int u = 0; u < 2; ++u) {
      float s = 0.f;
#pragma unroll
      for (int q = 0; q < 4; ++q) s += v[u][q].x * v[u][q].x + v[u][q].y * v[u][q].y + v[u][q].z * v[u][q].z + v[u][q].w * v[u][q].w;
      s = wave_sum(s);
      const float rs = rsqrtf(s * (1.0f / DM) + EPSF);
#pragma unroll
      for (int q = 0; q < 4; ++q) {
        const float4 g = ((const float4*)p.in[I_FG])[q * 64 + lane];
        const float4 x = v[u][q];
        ((float4*)(p.out + (size_t)(r0 + u) * DM))[q * 64 + lane] = make_float4(x.x * rs * g.x, x.y * rs * g.y, x.z * rs * g.z, x.w * rs * g.w);
      }
    }
  }
}

__device__ __forceinline__ void gbar(const Params& p, unsigned* ctr, unsigned& epoch, int lo, int hi, float* smem) {
  asm volatile("s_waitcnt vmcnt(0)" ::: "memory");
  __syncthreads();
  epoch += gridDim.x;
  int* s_flag = (int*)(smem + SMEM_FLOATS - 12);
  if (threadIdx.x == 0) {
    __builtin_amdgcn_fence(__ATOMIC_RELEASE, "agent");
    asm volatile("s_waitcnt vmcnt(0)" ::: "memory");
    __hip_atomic_fetch_add(ctr, 1u, __ATOMIC_RELAXED, __HIP_MEMORY_SCOPE_AGENT);
  }
  if (hi >= lo && hi >= 0) {
    for (;;) {
      if (threadIdx.x == 0) {
        const unsigned c = __hip_atomic_load(ctr, __ATOMIC_RELAXED, __HIP_MEMORY_SCOPE_AGENT);
        *s_flag = (c >= epoch) ? 2 : ((c + 1u < epoch) ? 1 : 0);
      }
      __syncthreads();
      const int f = *s_flag;
      if (f != 1) break;
      if (!expert_steal(p, lo, hi, smem)) break;
    }
  }
  if (threadIdx.x == 0) {
    while (__hip_atomic_load(ctr, __ATOMIC_RELAXED, __HIP_MEMORY_SCOPE_AGENT) < epoch) __builtin_amdgcn_s_sleep(2);
    __builtin_amdgcn_fence(__ATOMIC_ACQUIRE, "agent");
    asm volatile("s_waitcnt vmcnt(0)" ::: "memory");
  }
  __syncthreads();
}

__global__ void __launch_bounds__(256) mega(Params p) {
  cg::grid_group grid = cg::this_grid();
  __shared__ __attribute__((aligned(16))) float smem[SMEM_FLOATS];
  char* smc = (char*)smem;
  char* ws = p.ws;
  bf16_t* H = (bf16_t*)(ws + WB_H); bf16_t* Z = (bf16_t*)(ws + WB_Z); float* MGT = (float*)(ws + WB_MGT); bf16_t* XC = (bf16_t*)(ws + WB_XC);
  bf16_t* QM = (bf16_t*)(ws + WB_QM); bf16_t* KM = (bf16_t*)(ws + WB_KM); bf16_t* KMT = (bf16_t*)(ws + WB_KMT); bf16_t* MVT = (bf16_t*)(ws + WB_MVT);
  bf16_t* HF = (bf16_t*)(ws + WB_HF); bf16_t* HB = (bf16_t*)(ws + WB_HB);
  bf16_t* VT = (bf16_t*)(ws + WB_VT); float* YSF = (float*)(ws + WB_YSF); float* YSB = (float*)(ws + WB_YSB);
  bf16_t* YA = (bf16_t*)(ws + WB_YA); bf16_t* YB = (bf16_t*)(ws + WB_YB); bf16_t* YS = (bf16_t*)(ws + WB_YS); bf16_t* GG = (bf16_t*)(ws + WB_GG);
  bf16_t* MG = (bf16_t*)(ws + WB_MG); bf16_t* PQ = (bf16_t*)(ws + WB_PQ); float* SC = (float*)(ws + WB_SC);
  float* XE = (float*)(ws + WB_XE); float* GA = (float*)(ws + WB_GA);
  const bf16_t* WT = (const bf16_t*)(ws + WB_WT);

  unsigned* bar = (unsigned*)(ws + WB_BAR);
  unsigned epoch = 0;
  stage_init(p, smem);
  grid.sync();

  for (int l = 0; l < 2; ++l) {
    const bool need_ctx = (l == 0);
    const int rr_lim = need_ctx ? NTOK : NLAT;
    const int tpb = need_ctx ? 34 : 32;
    const bf16_t* W = WT + (size_t)l * WT_LAYER;
    const float lam_init = 0.8f - 0.6f * expf(-0.3f * (float)l);
    float lam;
    {
      float s1 = 0.f, s2 = 0.f;
      for (int i = 0; i < 64; ++i) {
        s1 += p.in[I_LQ1][l * 64 + i] * p.in[I_LK1][l * 64 + i];
        s2 += p.in[I_LQ2][l * 64 + i] * p.in[I_LK2][l * 64 + i];
      }
      lam = expf(s1) - expf(s2) + lam_init;
    }
    for (int g = 0; g < NG; ++g) {
      const int q = l * NG + g;
      int plo = q - 2, phi = q - 1;
      int* EI = (int*)(ws + WB_EI) + (size_t)(q & 1) * RPG * 128; float* EG = (float*)(ws + WB_EG) + (size_t)(q & 1) * RPG * 128;
      bf16_t* H2 = (bf16_t*)(ws + WB_H2) + (size_t)(q & 1) * RPG * DM;
      stage_normmod(p, l, g, 0, NTOK, H, smem);
      gbar(p, bar, epoch, plo, phi, smem);
      stage_inproj(p, H, W + WT_WIN, Z, MGT, VT, MVT, smc);
      gbar(p, bar, epoch, plo, phi, smem);
      stage_conv(p, l, Z, XC);
      stage_s5_pass1(p, l, Z, XE);
      gbar(p, bar, epoch, plo, phi, smem);
      stage_mlqk(XC, W + WT_WQK, QM, KM, KMT, smc);
      stage_mlgates(p, l, MGT, GA);
      gbar(p, bar, epoch, plo, phi, smem);
      {
        const int n_attn = 4 * 64 + (need_ctx ? 4 * 4 : 0);
        const int n_s5 = 32 * 2 * 9;
        const int n_items = GB * (8 + n_attn + n_s5);
        int* cnt = (int*)(ws + WB_CNT) + (l * NG + g);
        int* s_item = (int*)(smem + SMEM_FLOATS - 4);
        for (;;) {
          __syncthreads();
          if (otid() == 0) *s_item = atomicAdd(cnt, 1);
          __syncthreads();
          const int it = *s_item;
          if (it >= n_items) break;
          int bl, k;
          if (it < GB * 8) { bl = it / 8; k = it % 8; }
          else if (it < GB * (8 + n_attn)) { bl = (it - GB * 8) / n_attn; k = 8 + (it - GB * 8) % n_attn; }
          else { bl = (it - GB * (8 + n_attn)) / n_s5; k = 8 + n_attn + (it - GB * (8 + n_attn)) % n_s5; }
          const bf16_t* Zb = Z + (size_t)bl * NTOK * ZW;
          const size_t ro = (size_t)bl * NTOK;
          if (k < 8) {
            mlstm_chain_item(p, l, QM + ro * 512, KM + ro * 512, KMT + (size_t)bl * 4 * 128 * NTOK, MVT + (size_t)bl * 4 * 128 * NTOK, GA + (size_t)(((bl * 4 + (k & 3)) * 2 + (k >> 2)) * 68) * 272,
                             ((k >> 2) ? HB : HF) + ro * 512, k & 3, k >> 2, smc);
          } else if (k < 8 + n_attn) {
            const int a = k - 8;
            const bf16_t* VTb = VT + (size_t)bl * 4 * 128 * NTOK;
            if (a < 256) attn_mfma_item(p, l, Zb, VTb, YA + ro * 512, a & 3, (a >> 2) * 64, 0, NTOK, lam, lam_init, smc);
            else attn_mfma_item(p, l, Zb, VTb, YA + ro * 512, (a - 256) & 3, NLAT + ((a - 256) >> 2) * 64, NLAT, NCTX, lam, lam_init, smc);
          } else {
            const int a = k - 8 - n_attn;
            const int sq = a % 9, dir = (a / 9) & 1, gg = a / 18;
            s5_item(p, l, Zb, XE + (((size_t)bl * 32 + gg) * 2 + dir) * (S5NSEG - 1) * 128, (dir ? YSB : YSF) + ro * 512, gg, dir, sq, smc);
          }
        }
      }
      gbar(p, bar, epoch, plo, phi, smem);
      stage_post(p, l, rr_lim, Z, HF, HB, YSF, YSB, YB, GG);
      gbar(p, bar, epoch, plo, phi, smem);
      stage_glu_mfma(p, l, tpb, GG, W + WT_GLU, YS, smc);
      gbar(p, bar, epoch, plo, phi, smem);
      stage_merge_mfma(tpb, YA, YB, YS, W + WT_WBR, Z, MG, smc);
      gbar(p, bar, epoch, plo, phi, smem);
      stage_outproj_mfma(p, l, g, tpb, MG, W + WT_WOUT, smc);
      gbar(p, bar, epoch, plo, phi, smem);
      expert_drain(p, plo, plo, smem);
      plo = q - 1;
      gbar(p, bar, epoch, plo, phi, smem);
      stage_normmod(p, l, g, 1, rr_lim, H2, smem);
      gbar(p, bar, epoch, plo, phi, smem);
      stage_peerq_mfma(tpb, H2, W + WT_WQ, PQ, smc);
      gbar(p, bar, epoch, plo, phi, smem);
      stage_scores_topk(tpb, PQ, W + WT_SUBK, EI, EG, smc);
      gbar(p, bar, epoch, plo, phi, smem);
    }
  }
  expert_drain(p, 2 * NG - 2, 2 * NG - 1, smem);
  gbar(p, bar, epoch, 0, -1, smem);
  stage_final(p, smem);
}

extern "C" void kernel_launch(void* const* d_in, const int* in_sizes, int n_in, void* d_out,
                              int out_size, void* d_ws, size_t ws_size, hipStream_t stream) {
  static int grid_blocks = 0;
  if (!grid_blocks) {
    int dev = 0, cus = 0, per_cu = 0;
    (void)hipGetDevice(&dev);
    (void)hipDeviceGetAttribute(&cus, hipDeviceAttributeMultiprocessorCount, dev);
    (void)hipOccupancyMaxActiveBlocksPerMultiprocessor(&per_cu, mega, 256, 0);
    if (per_cu > 1) per_cu = 1;
    grid_blocks = cus * per_cu;
  }
  if (ws_size < WB_END) {
    fprintf(stderr, "workspace too small: %zu < %zu\n", ws_size, (size_t)WB_END);
    return;
  }
  Params p{};
  for (int i = 0; i < N_IN; ++i) p.in[i] = (const float*)d_in[i];
  p.out = (float*)d_out;
  p.ws = (char*)d_ws;
  (void)hipMemsetAsync((char*)d_ws + WB_BAR, 0, 256, stream);
  void* args[] = {&p};
  hipError_t e = hipLaunchCooperativeKernel((void*)mega, dim3(grid_blocks), dim3(256), args, 0, stream);
  if (e != hipSuccess) fprintf(stderr, "cooperative launch failed: %s (grid %d)\n", hipGetErrorString(e), grid_blocks);
}
```

```cpp
#include <hip/hip_runtime.h>
#include <hip/hip_cooperative_groups.h>
#include <cstdio>
#include <cstdint>
namespace cg = cooperative_groups;

#define NLAT 4096
#define NCTX 256
#define NTOK 4352
#define DM 1024
#define INW 6672
#define NB 8
#define GB 2
#define NG (NB / GB)
#define RPG (GB * NTOK)
#define ZW 6656
#define EPSF 1e-6f

enum { I_X = 0, I_C, I_CTX, I_CCTX, I_WMOD, I_BMOD, I_N1G, I_N2G, I_WIN, I_LQ1, I_LK1, I_LQ2, I_LK2, I_SUBG,
       I_CONVW, I_CONVB, I_MLWQ, I_MLWK, I_GATEB, I_MLNG, I_S5LRE, I_S5LIM, I_S5DT, I_S5BRE, I_S5BIM,
       I_S5CRE, I_S5CIM, I_S5D, I_GLUW, I_GLUB, I_WBR, I_WOUT, I_PWQ, I_PSUBK, I_PU, I_PV, I_FG, N_IN };

struct Params {
  const float* in[N_IN];
  float* out;
  char* ws;
};

typedef unsigned short bf16_t;
typedef short bf16x8 __attribute__((ext_vector_type(8)));
typedef float f32x16 __attribute__((ext_vector_type(16)));
typedef unsigned u32x4 __attribute__((ext_vector_type(4)));
typedef unsigned u32x2 __attribute__((ext_vector_type(2)));
typedef unsigned u32x4_u __attribute__((ext_vector_type(4), aligned(8)));
typedef float v16f __attribute__((ext_vector_type(16)));
typedef float v32f __attribute__((ext_vector_type(32)));
typedef unsigned v6u __attribute__((ext_vector_type(6)));

#define AL(x) (((x) + 255) & ~(size_t)255)
#define WB_XCX   ((size_t)0)
#define WB_MOD   AL(WB_XCX + (size_t)NB * NCTX * DM * 4)
#define WB_ROPE  AL(WB_MOD + (size_t)2 * 9 * 6144 * 4)
#define WB_WT    AL(WB_ROPE + (size_t)NLAT * 32 * 2 * 4)
#define WT_WIN   ((size_t)0)
#define WT_WQK   (WT_WIN + (size_t)6784 * 1024)
#define WT_GLU   (WT_WQK + (size_t)4 * 256 * 128)
#define WT_WBR   (WT_GLU + (size_t)512 * 512)
#define WT_WOUT  (WT_WBR + (size_t)3 * 1024 * 512)
#define WT_WQ    (WT_WOUT + (size_t)1024 * 1024)
#define WT_SUBK  (WT_WQ + (size_t)2048 * 1024)
#define WT_LAYER (WT_SUBK + (size_t)2 * 128 * 128)
#define WB_H     AL(WB_WT + WT_LAYER * 2 * 2)
#define WB_Z     AL(WB_H + (size_t)RPG * DM * 2)
#define WB_MGT   AL(WB_Z + (size_t)RPG * ZW * 2)
#define WB_XC    AL(WB_MGT + (size_t)RPG * 16 * 4)
#define WB_QM    AL(WB_XC + (size_t)RPG * 512 * 2)
#define WB_KM    AL(WB_QM + (size_t)RPG * 512 * 2)
#define WB_KMT   AL(WB_KM + (size_t)RPG * 512 * 2)
#define WB_MVT   AL(WB_KMT + (size_t)RPG * 512 * 2)
#define WB_HF    AL(WB_MVT + (size_t)RPG * 512 * 2)
#define WB_HB    AL(WB_HF + (size_t)RPG * 512 * 2)
#define WB_YSF   AL(WB_HB + (size_t)RPG * 512 * 2)
#define WB_YSB   AL(WB_YSF + (size_t)RPG * 512 * 4)
#define WB_YA    AL(WB_YSB + (size_t)RPG * 512 * 4)
#define WB_YB    AL(WB_YA + (size_t)RPG * 512 * 2)
#define WB_YS    AL(WB_YB + (size_t)RPG * 512 * 2)
#define WB_GG    AL(WB_YS + (size_t)RPG * 512 * 2)
#define WB_MG    AL(WB_GG + (size_t)RPG * 512 * 2)
#define WB_EI    AL(WB_MG + (size_t)RPG * DM * 2)
#define WB_EG    AL(WB_EI + (size_t)2 * RPG * 128 * 4)
#define WB_H2    AL(WB_EG + (size_t)2 * RPG * 128 * 4)
#define WB_U16   AL(WB_H2 + (size_t)2 * RPG * DM * 2)
#define WB_V16   AL(WB_U16 + (size_t)2 * 16384 * 768)
#define WB_VT    AL(WB_V16 + (size_t)2 * 16384 * 768)
#define WB_CNT   AL(WB_VT + (size_t)GB * 4 * 128 * NTOK * 2)
#define WB_XE    AL(WB_CNT + 256)
#define WB_BAR   AL(WB_XE + (size_t)GB * 32 * 2 * 33 * 128 * 4)
#define WB_GA    AL(WB_BAR + 256)
#define WB_POOL  AL(WB_GA + (size_t)GB * 4 * 2 * 68 * 272 * 4)
#define WB_END   AL(WB_POOL + 256)
#define WB_PQ    (WB_Z)
#define WB_SC    AL(WB_PQ + (size_t)RPG * 2048 * 2)

#define SMEM_FLOATS (25 * 1024)

__device__ __forceinline__ float sigmoidf_(float x) { return __builtin_amdgcn_rcpf(1.0f + __builtin_amdgcn_exp2f(-1.4426950408889634f * x)); }
__device__ __forceinline__ float siluf_(float x) { return x * __builtin_amdgcn_rcpf(1.0f + __builtin_amdgcn_exp2f(-1.4426950408889634f * x)); }
__device__ __forceinline__ float geluf_(float x) { return 0.5f * x * (1.0f + erff(x * 0.70710678118654752f)); }
__device__ __forceinline__ int otid() { int t = threadIdx.x; asm volatile("" : "+v"(t)); return t; }
__device__ __forceinline__ float wave_sum(float v) {
  for (int o = 32; o > 0; o >>= 1) v += __shfl_xor(v, o);
  return v;
}
__device__ __forceinline__ bf16_t f2bf(float x) { unsigned u = __float_as_uint(x); u += 0x7fffu + ((u >> 16) & 1u); return (bf16_t)(u >> 16); }
__device__ __forceinline__ float bf2f(bf16_t h) { return __uint_as_float(((unsigned)h) << 16); }
typedef float f32x2 __attribute__((ext_vector_type(2)));
typedef __bf16 bf16x2_t __attribute__((ext_vector_type(2)));
__device__ __forceinline__ unsigned pack2(float a, float b) { f32x2 v = {a, b}; return __builtin_bit_cast(unsigned, __builtin_convertvector(v, bf16x2_t)); }
__device__ __forceinline__ float lo16(unsigned u) { return __uint_as_float(u << 16); }
__device__ __forceinline__ float hi16(unsigned u) { return __uint_as_float(u & 0xffff0000u); }

__device__ __forceinline__ float* xrow(const Params& p, int b, int rr) {
  return (rr < NLAT) ? p.out + ((size_t)b * NLAT + rr) * DM : (float*)(p.ws + WB_XCX) + ((size_t)b * NCTX + (rr - NLAT)) * DM;
}

__device__ __forceinline__ const float* xrow_in(const Params& p, int b, int rr) {
  return (rr < NLAT) ? p.in[I_X] + ((size_t)b * NLAT + rr) * DM : p.in[I_CTX] + ((size_t)b * NCTX + (rr - NLAT)) * DM;
}

__device__ __forceinline__ void gemm_tile(const bf16_t* __restrict__ Ag, int lda, const bf16_t* __restrict__ Bg, int ldb, int K,
                                          char* smem, f32x16 (&acc)[2][2]) {
  const int tid = otid(), lane = tid & 63, w = tid >> 6, wm = w >> 1, wn = w & 1;
#pragma unroll
  for (int a = 0; a < 2; ++a)
#pragma unroll
    for (int b = 0; b < 2; ++b)
#pragma unroll
      for (int i = 0; i < 16; ++i) acc[a][b][i] = 0.f;
  const int srow = tid >> 3, sch = tid & 7;
  const bf16_t* ap = Ag + (size_t)srow * lda + sch * 8;
  const bf16_t* bp = Bg + (size_t)srow * ldb + sch * 8;
  const int wofs = srow * 128 + ((sch ^ ((srow >> 1) & 7)) << 4);
  const int fr = lane & 31, fh = lane >> 5, fsw = (fr >> 1) & 7;
  const int aofs = (wm * 64 + fr) * 128, bofs = 16384 + (wn * 64 + fr) * 128;
  u32x4 ra0[4], rb0[4], ra1[4], rb1[4];
  const int nk = K >> 6;
#define G_LOAD(RA, RB, KT) { _Pragma("unroll") for (int i = 0; i < 4; ++i) { RA[i] = *(const u32x4*)(ap + (size_t)i * 32 * lda + (KT) * 64); RB[i] = *(const u32x4*)(bp + (size_t)i * 32 * ldb + (KT) * 64); } }
#define G_STORE(RA, RB, BUF) { char* nb_ = smem + (BUF) * 32768; _Pragma("unroll") for (int i = 0; i < 4; ++i) { *(u32x4*)(nb_ + wofs + i * 4096) = RA[i]; *(u32x4*)(nb_ + 16384 + wofs + i * 4096) = RB[i]; } }
#define G_COMPUTE(BUF) { const char* base = smem + (BUF) * 32768; _Pragma("unroll") for (int ks = 0; ks < 4; ++ks) { \
      const int coff = ((ks * 2 + fh) ^ fsw) << 4; bf16x8 af[2], bfr[2]; \
      _Pragma("unroll") for (int mi = 0; mi < 2; ++mi) af[mi] = *(const bf16x8*)(base + aofs + mi * 4096 + coff); \
      _Pragma("unroll") for (int ni = 0; ni < 2; ++ni) bfr[ni] = *(const bf16x8*)(base + bofs + ni * 4096 + coff); \
      _Pragma("unroll") for (int mi = 0; mi < 2; ++mi) _Pragma("unroll") for (int ni = 0; ni < 2; ++ni) \
          acc[mi][ni] = __builtin_amdgcn_mfma_f32_32x32x16_bf16(bfr[ni], af[mi], acc[mi][ni], 0, 0, 0); } }
  G_LOAD(ra0, rb0, 0)
  G_LOAD(ra1, rb1, 1)
  __syncthreads();
  G_STORE(ra0, rb0, 0)
  __syncthreads();
  for (int kt = 0; kt < nk; kt += 2) {
    if (kt + 2 < nk) G_LOAD(ra0, rb0, kt + 2)
    G_COMPUTE(0)
    G_STORE(ra1, rb1, 1)
    __syncthreads();
    if (kt + 3 < nk) G_LOAD(ra1, rb1, kt + 3)
    G_COMPUTE(1)
    if (kt + 2 < nk) G_STORE(ra0, rb0, 0)
    __syncthreads();
  }
#undef G_LOAD
#undef G_STORE
#undef G_COMPUTE
}
#define EPI_DECL const int tid_ = otid(); const int lane = tid_ & 63, w_ = tid_ >> 6, wm = w_ >> 1, wn = w_ & 1, fr = lane & 31, fh = lane >> 5; (void)fr; (void)fh; (void)wm; (void)wn;
#define EPI_ROW(mi) (wm * 64 + (mi) * 32 + fr)
#define EPI_COL(ni, q) (wn * 64 + (ni) * 32 + 8 * (q) + 4 * fh)
#define MT_LR0(mt, tpb) (((mt) / (tpb)) * NTOK + ((mt) % (tpb)) * 128)


struct TileIter {
  int tm, tn, pw, ph, PN, NP, x, i, it;
  __device__ __forceinline__ TileIter(int tm_, int tn_) : tm(tm_), tn(tn_) {
    pw = tn < 8 ? tn : 8; ph = 32 / pw; PN = (tn + pw - 1) / pw; NP = ((tm + ph - 1) / ph) * PN;
    x = blockIdx.x & 7; i = blockIdx.x >> 3; it = 0;
  }
  __device__ __forceinline__ bool next(int& mt, int& nt, bool& valid) {
    if (gridDim.x != 256) {
      const int t = blockIdx.x + it * gridDim.x; ++it;
      if (t >= tm * tn) return false;
      mt = t / tn; nt = t % tn; valid = true; return true;
    }
    const int P = it * 8 + x; ++it;
    if (P >= NP) return false;
    mt = (P / PN) * ph + i / pw; nt = (P % PN) * pw + i % pw;
    valid = (mt < tm) && (nt < tn);
    return true;
  }
};

template <class F>
__device__ __forceinline__ void transpose_cvt(const float* __restrict__ src, int ld, F srccol, int K, int Ndst, bf16_t* __restrict__ dst, float* smem) {
  float (*T)[65] = (float (*)[65])smem;
  const int tid = otid();
  const int tk = K >> 6, tn = Ndst >> 6;
  for (int t = blockIdx.x; t < tn * tk; t += gridDim.x) {
    const int n0 = (t / tk) * 64, k0 = (t % tk) * 64;
    __syncthreads();
    const int sc = srccol(n0 + (tid & 63));
#pragma unroll
    for (int i = 0; i < 16; ++i) {
      const int ky = (tid >> 6) + 4 * i;
      T[ky][tid & 63] = (sc >= 0) ? src[(size_t)(k0 + ky) * ld + sc] : 0.f;
    }
    __syncthreads();
#pragma unroll
    for (int i = 0; i < 16; ++i) {
      const int ny = (tid >> 6) + 4 * i;
      dst[(size_t)(n0 + ny) * K + k0 + (tid & 63)] = f2bf(T[tid & 63][ny]);
    }
  }
  __syncthreads();
}
__device__ __forceinline__ int win_srccol(int n) {
  if (n < 3072) return n;
  if (n < 6656) return n + 16;
  if (n < 6672) return n - 3584;
  return -1;
}

__device__ __forceinline__ void stage_init(const Params& p, float* smem) {
  const int tid = otid();
  if (blockIdx.x == 0 && tid < 64) { ((int*)(p.ws + WB_CNT))[tid] = 0; if (tid < 16) ((int*)(p.ws + WB_POOL))[tid] = 0; }
  {
    float* lx = smem + tid * 33;
    int perm[32];
    {
      v16f a, b;
#pragma unroll
      for (int j = 0; j < 16; ++j) { a[j] = (float)(j & 7); b[j] = (float)((j + 16) & 7); }
      const v32f u1 = __builtin_amdgcn_cvt_scalef32_pk32_f32_fp6(__builtin_amdgcn_cvt_scalef32_2xpk16_fp6_f32(a, b, 1.0f), 1.0f);
#pragma unroll
      for (int j = 0; j < 16; ++j) { a[j] = (float)(j >> 3); b[j] = (float)((j + 16) >> 3); }
      const v32f u2 = __builtin_amdgcn_cvt_scalef32_pk32_f32_fp6(__builtin_amdgcn_cvt_scalef32_2xpk16_fp6_f32(a, b, 1.0f), 1.0f);
#pragma unroll
      for (int k = 0; k < 32; ++k) perm[k] = ((int)(u1[k] + 0.5f) + 8 * (int)(u2[k] + 0.5f)) & 31;
    }
    const size_t ngrp = (size_t)2 * 16384 * 32;
    for (size_t i = (size_t)blockIdx.x * 256 + tid; i < 2 * ngrp; i += (size_t)gridDim.x * 256) {
      const bool isv = i >= ngrp;
      const size_t gi = isv ? i - ngrp : i;
      const float4* s4 = (const float4*)((isv ? p.in[I_PV] : p.in[I_PU]) + gi * 32);
      const float sc = isv ? 2.0f : 64.0f;
      float o[32];
#pragma unroll
      for (int q = 0; q < 8; ++q) { const float4 t = s4[q]; o[4 * q] = t.x * sc; o[4 * q + 1] = t.y * sc; o[4 * q + 2] = t.z * sc; o[4 * q + 3] = t.w * sc; }
#pragma unroll
      for (int k = 0; k < 32; ++k) lx[perm[k]] = o[k];
      v16f a, b;
#pragma unroll
      for (int j = 0; j < 16; ++j) { a[j] = lx[j]; b[j] = lx[16 + j]; }
      const v6u pk = __builtin_amdgcn_cvt_scalef32_2xpk16_fp6_f32(a, b, 1.0f);
      u32x2* d = (u32x2*)(p.ws + (isv ? WB_V16 : WB_U16) + gi * 24);
      d[0] = (u32x2){pk[0], pk[1]}; d[1] = (u32x2){pk[2], pk[3]}; d[2] = (u32x2){pk[4], pk[5]};
    }
    __syncthreads();
  }
  {
    float2* rt = (float2*)(p.ws + WB_ROPE);
    for (int i = blockIdx.x * 256 + tid; i < NLAT * 32; i += gridDim.x * 256) {
      const int pos = i >> 5, j = i & 31;
      const float inv = powf(10000.0f, -(float)(j & 15) / 16.0f);
      const float ang = (float)((j < 16) ? (pos >> 6) : (pos & 63)) * inv;
      rt[i] = make_float2(cosf(ang), sinf(ang));
    }
  }
  {
    float* sc = smem;
    float* red = smem + 9 * 1024;
    for (int i = tid; i < 9 * 1024; i += 256) {
      int r = i >> 10, k = i & 1023;
      float v = (r < 8) ? p.in[I_C][r * 1024 + k] : p.in[I_CCTX][k];
      sc[i] = siluf_(v);
    }
    __syncthreads();
    float* mod = (float*)(p.ws + WB_MOD);
    const int jc = tid & 63, ksl = tid >> 6;
    for (int cb = blockIdx.x; cb < 2 * 6144 / 64; cb += gridDim.x) {
      const int col = cb * 64 + jc;
      const int l = col / 6144, j = col % 6144;
      const float* w = p.in[I_WMOD] + (size_t)l * 1024 * 6144 + j;
      float acc[9];
#pragma unroll
      for (int r = 0; r < 9; ++r) acc[r] = 0.f;
#pragma unroll 8
      for (int k = ksl * 256; k < ksl * 256 + 256; ++k) {
        const float wv = w[(size_t)k * 6144];
#pragma unroll
        for (int r = 0; r < 9; ++r) acc[r] = fmaf(sc[r * 1024 + k], wv, acc[r]);
      }
      __syncthreads();
#pragma unroll
      for (int r = 0; r < 9; ++r) red[(ksl * 64 + jc) * 9 + r] = acc[r];
      __syncthreads();
      if (ksl == 0) {
        const float bv = p.in[I_BMOD][l * 6144 + j];
#pragma unroll
        for (int r = 0; r < 9; ++r)
          mod[((size_t)l * 9 + r) * 6144 + j] = red[jc * 9 + r] + red[(64 + jc) * 9 + r] + red[(128 + jc) * 9 + r] + red[(192 + jc) * 9 + r] + bv;
      }
    }
    __syncthreads();
  }
  bf16_t* WT = (bf16_t*)(p.ws + WB_WT);
  for (int l = 0; l < 2; ++l) {
    bf16_t* W = WT + (size_t)l * WT_LAYER;
    transpose_cvt(p.in[I_WIN] + (size_t)l * DM * INW, INW, [](int n) { return win_srccol(n); }, DM, 6784, W + WT_WIN, smem);
    for (int h = 0; h < 4; ++h) {
      transpose_cvt(p.in[I_MLWQ] + ((size_t)l * 4 + h) * 16384, 128, [](int n) { return n; }, 128, 128, W + WT_WQK + (size_t)h * 256 * 128, smem);
      transpose_cvt(p.in[I_MLWK] + ((size_t)l * 4 + h) * 16384, 128, [](int n) { return n; }, 128, 128, W + WT_WQK + (size_t)h * 256 * 128 + 128 * 128, smem);
    }
    transpose_cvt(p.in[I_GLUW] + (size_t)l * 512 * 512, 512, [](int n) { return n; }, 512, 512, W + WT_GLU, smem);
    for (int r = 0; r < 3; ++r)
      transpose_cvt(p.in[I_WBR] + ((size_t)l * 3 + r) * 512 * DM, DM, [](int n) { return n; }, 512, DM, W + WT_WBR + (size_t)r * 1024 * 512, smem);
    transpose_cvt(p.in[I_WOUT] + (size_t)l * DM * DM, DM, [](int n) { return n; }, DM, DM, W + WT_WOUT, smem);
    transpose_cvt(p.in[I_PWQ] + (size_t)l * DM * 2048, 2048, [](int n) { return n; }, DM, 2048, W + WT_WQ, smem);
    const float* sk = p.in[I_PSUBK] + (size_t)l * 2 * 128 * 128;
    for (int i = blockIdx.x * 256 + tid; i < 2 * 128 * 128; i += gridDim.x * 256) W[WT_SUBK + i] = f2bf(sk[i]);
  }
}

__device__ __forceinline__ void stage_normmod(const Params& p, int l, int g, int which, int rr_lim, bf16_t* H, float* smem) {
  const int tid = otid(), w = tid >> 6, lane = tid & 63;
  const float* ng = p.in[which ? I_N2G : I_N1G] + l * DM;
  const float* mod = (const float*)(p.ws + WB_MOD) + (size_t)l * 9 * 6144;
  const int off_sh = which ? 3072 : 0, off_sc = which ? 4096 : 1024;
  const int n = GB * rr_lim;
  for (int i0 = (blockIdx.x * 4 + w) * 2; i0 < n; i0 += gridDim.x * 8) {
    float4 v[2][4];
    int bl[2], rr[2];
#pragma unroll
    for (int u = 0; u < 2; ++u) {
      const int i = (i0 + u < n) ? i0 + u : i0;
      bl[u] = i / rr_lim; rr[u] = i % rr_lim;
      const float4* X = (const float4*)((l == 0 && which == 0) ? xrow_in(p, g * GB + bl[u], rr[u]) : xrow(p, g * GB + bl[u], rr[u]));
#pragma unroll
      for (int q = 0; q < 4; ++q) v[u][q] = X[q * 64 + lane];
    }
#pragma unroll
    for (int u = 0; u < 2; ++u) {
      if (i0 + u >= n) break;
      float s = 0.f;
#pragma unroll
      for (int q = 0; q < 4; ++q) s += v[u][q].x * v[u][q].x + v[u][q].y * v[u][q].y + v[u][q].z * v[u][q].z + v[u][q].w * v[u][q].w;
      s = wave_sum(s);
      const float rs = rsqrtf(s * (1.0f / DM) + EPSF);
      const float* m = mod + (size_t)((rr[u] < NLAT) ? (g * GB + bl[u]) : 8) * 6144;
      u32x2* hp = (u32x2*)(H + ((size_t)bl[u] * NTOK + rr[u]) * DM);
#pragma unroll
      for (int q = 0; q < 4; ++q) {
        const float4 gg = ((const float4*)ng)[q * 64 + lane];
        const float4 sc = ((const float4*)(m + off_sc))[q * 64 + lane];
        const float4 sh = ((const float4*)(m + off_sh))[q * 64 + lane];
        const float4 x = v[u][q];
        hp[q * 64 + lane] = (u32x2){pack2(x.x * rs * gg.x * (1.f + sc.x) + sh.x, x.y * rs * gg.y * (1.f + sc.y) + sh.y),
                                    pack2(x.z * rs * gg.z * (1.f + sc.z) + sh.z, x.w * rs * gg.w * (1.f + sc.w) + sh.w)};
      }
    }
  }
}

__device__ __forceinline__ void stage_inproj(const Params& p, const bf16_t* H, const bf16_t* WinT, bf16_t* Z, float* MGT, bf16_t* VT, bf16_t* MVT, char* smem) {
  EPI_DECL
  const int tm = GB * 34, tn = 53;
  const float2* rt = (const float2*)(p.ws + WB_ROPE);
  TileIter ti(tm, tn);
  int mt, j; bool valid;
  while (ti.next(mt, j, valid)) {
    if (!valid) continue;
    const int n0 = j * 128;
    const int lr0 = MT_LR0(mt, 34), rr0 = (mt % 34) * 128;
    f32x16 acc[2][2];
    if ((j >= 8 && j < 12) || (j >= 16 && j < 20)) {
      gemm_tile(WinT + (size_t)n0 * DM, DM, H + (size_t)lr0 * DM, DM, DM, smem, acc);
      bf16_t* vt = ((j < 12) ? VT : MVT) + ((size_t)(mt / 34) * 4 + (j & 3)) * 128 * NTOK;
#pragma unroll
      for (int mi = 0; mi < 2; ++mi)
#pragma unroll
        for (int ni = 0; ni < 2; ++ni)
#pragma unroll
          for (int q = 0; q < 4; ++q) {
            const int e = EPI_ROW(mi), tok = rr0 + EPI_COL(ni, q);
            *(u32x2*)(vt + (size_t)e * NTOK + tok) = (u32x2){pack2(acc[mi][ni][4 * q], acc[mi][ni][4 * q + 1]), pack2(acc[mi][ni][4 * q + 2], acc[mi][ni][4 * q + 3])};
          }
      continue;
    }
    gemm_tile(H + (size_t)lr0 * DM, DM, WinT + (size_t)n0 * DM, DM, DM, smem, acc);
    if (j < 8 && rr0 < NLAT) {
#pragma unroll
      for (int mi = 0; mi < 2; ++mi) {
        const int pos = rr0 + EPI_ROW(mi);
#pragma unroll
        for (int i = 0; i < 16; ++i) {
          const int jj = 8 * (i >> 2) + 4 * fh + (i & 3);
          const float2 cs = rt[pos * 32 + jj];
          const float x1 = acc[mi][0][i], x2 = acc[mi][1][i];
          acc[mi][0][i] = x1 * cs.x - x2 * cs.y;
          acc[mi][1][i] = x1 * cs.y + x2 * cs.x;
        }
      }
    }
    if (j < 52) {
      const bool sg = (j >= 28);
#pragma unroll
      for (int mi = 0; mi < 2; ++mi)
#pragma unroll
        for (int ni = 0; ni < 2; ++ni)
#pragma unroll
          for (int q = 0; q < 4; ++q) {
            const int row = lr0 + EPI_ROW(mi), c = n0 + EPI_COL(ni, q);
            float v0 = acc[mi][ni][4 * q], v1 = acc[mi][ni][4 * q + 1], v2 = acc[mi][ni][4 * q + 2], v3 = acc[mi][ni][4 * q + 3];
            if (sg) { v0 = sigmoidf_(v0); v1 = sigmoidf_(v1); v2 = sigmoidf_(v2); v3 = sigmoidf_(v3); }
            *(u32x2*)(Z + (size_t)row * ZW + c) = (u32x2){pack2(v0, v1), pack2(v2, v3)};
          }
    } else {
#pragma unroll
      for (int mi = 0; mi < 2; ++mi)
#pragma unroll
        for (int q = 0; q < 2; ++q) {
          const int row = lr0 + EPI_ROW(mi), c = EPI_COL(0, q);
          if (wn == 0) *(float4*)(MGT + (size_t)row * 16 + c) = make_float4(acc[mi][0][4 * q], acc[mi][0][4 * q + 1], acc[mi][0][4 * q + 2], acc[mi][0][4 * q + 3]);
        }
    }
  }
}

__device__ __forceinline__ void stage_conv(const Params& p, int l, const bf16_t* Z, bf16_t* XC) {
  const int tid = otid();
  const float* cw = p.in[I_CONVW] + (size_t)l * 3 * 512;
  const float* cb = p.in[I_CONVB] + (size_t)l * 512;
  const int c = tid * 2;
  const float2 w0 = *(const float2*)(cw + c), w1 = *(const float2*)(cw + 512 + c), w2 = *(const float2*)(cw + 1024 + c), bb = *(const float2*)(cb + c);
  for (int lr0 = blockIdx.x * 4; lr0 < RPG; lr0 += gridDim.x * 4) {
    unsigned xc[4], xp[4], xn[4];
#pragma unroll
    for (int u = 0; u < 4; ++u) {
      const int lr = lr0 + u, rr = lr % NTOK;
      const bool has_prev = (rr < NLAT) ? (rr > 0) : (rr > NLAT);
      const bool has_next = (rr < NLAT) ? (rr < NLAT - 1) : (rr < NTOK - 1);
      const bf16_t* z = Z + (size_t)lr * ZW + 1536 + c;
      xc[u] = *(const unsigned*)z;
      xp[u] = has_prev ? *(const unsigned*)(z - ZW) : 0u;
      xn[u] = has_next ? *(const unsigned*)(z + ZW) : 0u;
    }
#pragma unroll
    for (int u = 0; u < 4; ++u) {
      const float a0 = bb.x + w1.x * lo16(xc[u]) + w0.x * lo16(xp[u]) + w2.x * lo16(xn[u]);
      const float a1 = bb.y + w1.y * hi16(xc[u]) + w0.y * hi16(xp[u]) + w2.y * hi16(xn[u]);
      *(unsigned*)(XC + (size_t)(lr0 + u) * 512 + c) = pack2(siluf_(a0), siluf_(a1));
    }
  }
}

__device__ __forceinline__ void stage_mlqk(const bf16_t* XC, const bf16_t* WQK, bf16_t* QM, bf16_t* KM, bf16_t* KMT, char* smem) {
  EPI_DECL
  const int tm = RPG >> 7;
  TileIter ti(tm, 12);
  int mt, r12; bool valid;
  while (ti.next(mt, r12, valid)) {
    if (!valid) continue;
    const int h = r12 & 3, kind = r12 >> 2;
    const int m0 = mt * 128;
    f32x16 acc[2][2];
    const bf16_t* Wt = WQK + (size_t)h * 256 * 128 + (size_t)(kind ? 1 : 0) * 128 * 128;
    const bf16_t* Xt = XC + (size_t)m0 * 512 + h * 128;
    if (kind < 2) {
      gemm_tile(Xt, 512, Wt, 128, 128, smem, acc);
      bf16_t* O = kind ? KM : QM;
      const float alpha = kind ? 1.0f : 0.08838834764831845f;
#pragma unroll
      for (int mi = 0; mi < 2; ++mi)
#pragma unroll
        for (int ni = 0; ni < 2; ++ni)
#pragma unroll
          for (int q = 0; q < 4; ++q) {
            const int row = m0 + EPI_ROW(mi), c = EPI_COL(ni, q);
            *(u32x2*)(O + (size_t)row * 512 + h * 128 + c) = (u32x2){pack2(alpha * acc[mi][ni][4 * q], alpha * acc[mi][ni][4 * q + 1]), pack2(alpha * acc[mi][ni][4 * q + 2], alpha * acc[mi][ni][4 * q + 3])};
          }
    } else {
      gemm_tile(Wt, 128, Xt, 512, 128, smem, acc);
      bf16_t* kt = KMT + ((size_t)(mt / 34) * 4 + h) * 128 * NTOK + (mt % 34) * 128;
#pragma unroll
      for (int mi = 0; mi < 2; ++mi)
#pragma unroll
        for (int ni = 0; ni < 2; ++ni)
#pragma unroll
          for (int q = 0; q < 4; ++q) {
            const int d = EPI_ROW(mi), tok = EPI_COL(ni, q);
            *(u32x2*)(kt + (size_t)d * NTOK + tok) = (u32x2){pack2(acc[mi][ni][4 * q], acc[mi][ni][4 * q + 1]), pack2(acc[mi][ni][4 * q + 2], acc[mi][ni][4 * q + 3])};
          }
    }
  }
}

__device__ __forceinline__ void attn_mfma_item(const Params& p, int l, const bf16_t* Zb, const bf16_t* VTb, bf16_t* YAb, int h, int qrow0, int key0, int nkeys,
                                               float lam, float lam_init, char* smem) {
  const int tid = otid(), lane = tid & 63, w = tid >> 6, fr = lane & 31, fh = lane >> 5;
  const int rb = w & 1, m = w >> 1;
  const int ntiles = nkeys >> 6;
  const int myrow = qrow0 + rb * 32 + fr;
  bf16x8 qf[4];
  {
    const bf16_t* qp = Zb + (size_t)myrow * ZW + h * 128 + m * 64 + fh * 8;
#pragma unroll
    for (int ks = 0; ks < 4; ++ks) qf[ks] = *(const bf16x8*)(qp + ks * 16);
  }
  f32x16 O[4];
#pragma unroll
  for (int eb = 0; eb < 4; ++eb)
#pragma unroll
    for (int i = 0; i < 16; ++i) O[eb][i] = 0.f;
  float mrun = -1e30f, lrun = 0.f;
  const float cs = 0.125f * 1.4426950408889634f;
  const int skey = tid >> 4, sch = tid & 15;
  const bf16_t* ksrc = Zb + (size_t)(key0 + skey) * ZW + 512 + h * 128 + sch * 8;
  const int kdst = skey * 256 + ((sch ^ (skey & 15)) << 4);
  const int se = tid >> 3, svc = tid & 7;
  const bf16_t* vsrc = VTb + ((size_t)h * 128 + se) * NTOK + key0 + svc * 8;
  const int vsw = (se >> 1) & 15;
  const int vdst0 = se * 128 + (((2 * svc) ^ vsw) << 3), vdst1 = se * 128 + (((2 * svc + 1) ^ vsw) << 3);
  const int kfo = fr * 256, kfs = fr & 15;
  const int vfo = fr * 128, vfs = (fr >> 1) & 15;
  u32x4 rk[4], rv[4];
#pragma unroll
  for (int i = 0; i < 4; ++i) rk[i] = *(const u32x4*)(ksrc + (size_t)i * 16 * ZW);
  __syncthreads();
#pragma unroll
  for (int i = 0; i < 4; ++i) *(u32x4*)(smem + kdst + i * 4096) = rk[i];
  __syncthreads();
  bf16x8 pf[4];
#define ATT_S(T) { const char* kb_ = smem + ((T) & 1) * 16384; _Pragma("unroll") for (int kb = 0; kb < 2; ++kb) { \
      _Pragma("unroll") for (int i = 0; i < 16; ++i) S[kb][i] = 0.f; \
      _Pragma("unroll") for (int ks = 0; ks < 4; ++ks) { \
        const bf16x8 kf = *(const bf16x8*)(kb_ + kb * 8192 + kfo + (((m * 8 + ks * 2 + fh) ^ kfs) << 4)); \
        S[kb] = __builtin_amdgcn_mfma_f32_32x32x16_bf16(kf, qf[ks], S[kb], 0, 0, 0); } } }
#define ATT_MAX() { float tm = S[0][0]; \
      _Pragma("unroll") for (int i = 1; i < 16; ++i) tm = fmaxf(tm, S[0][i]); \
      _Pragma("unroll") for (int i = 0; i < 16; ++i) tm = fmaxf(tm, S[1][i]); \
      tm = fmaxf(tm, __shfl_xor(tm, 32)) * cs; alpha = 1.f; \
      if (tm > mrun + 8.0f) { alpha = __builtin_amdgcn_exp2f(mrun - tm); mrun = tm; } }
#define ATT_EXP(PF) { const float mc = mrun; float rs = 0.f; \
      _Pragma("unroll") for (int kb = 0; kb < 2; ++kb) { float pv[16]; \
        _Pragma("unroll") for (int i = 0; i < 16; ++i) { pv[i] = __builtin_amdgcn_exp2f(fmaf(S[kb][i], cs, -mc)); rs += pv[i]; } \
        _Pragma("unroll") for (int hh = 0; hh < 2; ++hh) \
          PF[kb * 2 + hh] = __builtin_bit_cast(bf16x8, (u32x4){pack2(pv[8 * hh], pv[8 * hh + 1]), pack2(pv[8 * hh + 2], pv[8 * hh + 3]), \
                                                               pack2(pv[8 * hh + 4], pv[8 * hh + 5]), pack2(pv[8 * hh + 6], pv[8 * hh + 7])}); } \
      lrun += rs; }
#define ATT_PV(T) { const char* vb_ = smem + 32768 + ((T) & 1) * 16384; _Pragma("unroll") for (int eb = 0; eb < 4; ++eb) _Pragma("unroll") for (int s = 0; s < 4; ++s) { \
        const u32x2 v0 = *(const u32x2*)(vb_ + eb * 4096 + vfo + (((4 * s + fh) ^ vfs) << 3)); \
        const u32x2 v1 = *(const u32x2*)(vb_ + eb * 4096 + vfo + (((4 * s + fh + 2) ^ vfs) << 3)); \
        const bf16x8 vf = __builtin_bit_cast(bf16x8, (u32x4){v0[0], v0[1], v1[0], v1[1]}); \
        O[eb] = __builtin_amdgcn_mfma_f32_32x32x16_bf16(vf, pf[s], O[eb], 0, 0, 0); } }
  f32x16 S[2];
  float alpha;
  {
#pragma unroll
    for (int i = 0; i < 4; ++i) rk[i] = *(const u32x4*)(ksrc + (size_t)(64 + i * 16) * ZW);
#pragma unroll
    for (int i = 0; i < 4; ++i) rv[i] = *(const u32x4*)(vsrc + (size_t)i * 32 * NTOK);
    ATT_S(0)
    ATT_MAX()
    ATT_EXP(pf)
#pragma unroll
    for (int i = 0; i < 4; ++i) *(u32x4*)(smem + 16384 + kdst + i * 4096) = rk[i];
#pragma unroll
    for (int i = 0; i < 4; ++i) {
      *(u32x2*)(smem + 32768 + vdst0 + i * 4096) = (u32x2){rv[i][0], rv[i][1]};
      *(u32x2*)(smem + 32768 + vdst1 + i * 4096) = (u32x2){rv[i][2], rv[i][3]};
    }
    __syncthreads();
  }
#pragma unroll 1
  for (int t = 1; t < ntiles; ++t) {
    const int tn = (t + 1 < ntiles) ? t + 1 : t;
#pragma unroll
    for (int i = 0; i < 4; ++i) rk[i] = *(const u32x4*)(ksrc + (size_t)(tn * 64 + i * 16) * ZW);
#pragma unroll
    for (int i = 0; i < 4; ++i) rv[i] = *(const u32x4*)(vsrc + (size_t)i * 32 * NTOK + t * 64);
    ATT_S(t)
    ATT_MAX()
    if (__any(alpha != 1.f)) {
#pragma unroll
      for (int eb = 0; eb < 4; ++eb)
#pragma unroll
        for (int i = 0; i < 16; ++i) O[eb][i] *= alpha;
      lrun *= alpha;
#pragma unroll
      for (int s = 0; s < 4; ++s) {
        const u32x4 r_ = __builtin_bit_cast(u32x4, pf[s]);
        pf[s] = __builtin_bit_cast(bf16x8, (u32x4){pack2(lo16(r_[0]) * alpha, hi16(r_[0]) * alpha), pack2(lo16(r_[1]) * alpha, hi16(r_[1]) * alpha),
                                                   pack2(lo16(r_[2]) * alpha, hi16(r_[2]) * alpha), pack2(lo16(r_[3]) * alpha, hi16(r_[3]) * alpha)});
      }
    }
    bf16x8 pn[4];
    {
      ATT_PV(t - 1)
      ATT_EXP(pn)
#pragma unroll
      for (int i = 0; i < 16; ++i) {
        __builtin_amdgcn_sched_group_barrier(0x100, 1, 0);
        __builtin_amdgcn_sched_group_barrier(0x008, 1, 0);
        __builtin_amdgcn_sched_group_barrier(0x002, 9, 0);
      }
    }
#pragma unroll
    for (int s = 0; s < 4; ++s) pf[s] = pn[s];
    if (t + 1 < ntiles) {
      char* kd = smem + ((t + 1) & 1) * 16384;
#pragma unroll
      for (int i = 0; i < 4; ++i) *(u32x4*)(kd + kdst + i * 4096) = rk[i];
    }
    {
      char* vd = smem + 32768 + (t & 1) * 16384;
#pragma unroll
      for (int i = 0; i < 4; ++i) {
        *(u32x2*)(vd + vdst0 + i * 4096) = (u32x2){rv[i][0], rv[i][1]};
        *(u32x2*)(vd + vdst1 + i * 4096) = (u32x2){rv[i][2], rv[i][3]};
      }
    }
    __syncthreads();
  }
  ATT_PV(ntiles - 1)
  __syncthreads();
#undef ATT_S
#undef ATT_MAX
#undef ATT_EXP
#undef ATT_PV
  const float lt = lrun + __shfl_xor(lrun, 32);
  const float sc = (m ? lam : 1.0f) / lt;
  float* xo = (float*)smem + rb * 4096;
  if (m == 1) {
#pragma unroll
    for (int eb = 0; eb < 4; ++eb)
#pragma unroll
      for (int i = 0; i < 16; ++i) xo[(eb * 32 + (i & 3) + 8 * (i >> 2) + 4 * fh) * 32 + fr] = O[eb][i] * sc;
  }
  __syncthreads();
  if (m == 0) {
    float ss = 0.f;
#pragma unroll
    for (int eb = 0; eb < 4; ++eb)
#pragma unroll
      for (int i = 0; i < 16; ++i) {
        const float o = O[eb][i] * sc - xo[(eb * 32 + (i & 3) + 8 * (i >> 2) + 4 * fh) * 32 + fr];
        O[eb][i] = o; ss = fmaf(o, o, ss);
      }
    ss += __shfl_xor(ss, 32);
    const float rn = rsqrtf(ss * (1.0f / 128.0f) + EPSF) * (1.0f - lam_init);
    const float* sg = p.in[I_SUBG] + l * 512 + h * 128;
    bf16_t* yp = YAb + (size_t)myrow * 512 + h * 128;
#pragma unroll
    for (int eb = 0; eb < 4; ++eb)
#pragma unroll
      for (int q = 0; q < 4; ++q) {
        const int e = eb * 32 + 8 * q + 4 * fh;
        const float4 g = *(const float4*)(sg + e);
        *(u32x2*)(yp + e) = (u32x2){pack2(O[eb][4 * q] * rn * g.x, O[eb][4 * q + 1] * rn * g.y), pack2(O[eb][4 * q + 2] * rn * g.z, O[eb][4 * q + 3] * rn * g.w)};
      }
  }
  __syncthreads();
}

__device__ __forceinline__ int mlstm_row0(int dir, int c) {
  return (dir == 0) ? ((c < 4) ? NLAT + 64 * c : 64 * (c - 4)) : ((c < 4) ? NLAT + 64 * (3 - c) : 64 * (67 - c));
}
__device__ __forceinline__ void stage_mlgates(const Params& p, int l, const float* MGT, float* GA) {
  const int tid = otid(), w = tid >> 6, lane = tid & 63;
  const int nitems = GB * 4 * 2 * 68;
  for (int idx = blockIdx.x * 4 + w; idx < nitems; idx += gridDim.x * 4) {
    const int c = idx % 68, r1 = idx / 68, dir = r1 & 1, h = (r1 >> 1) & 3, bl = r1 >> 3;
    const int row = mlstm_row0(dir, c) + lane;
    const float* mg = MGT + ((size_t)bl * NTOK + row) * 16;
    const float li = mg[dir * 8 + h] + p.in[I_GATEB][l * 16 + dir * 8 + h];
    const float x = mg[dir * 8 + 4 + h] + p.in[I_GATEB][l * 16 + dir * 8 + 4 + h];
    const float lf = fminf(x, 0.f) - log1pf(expf(-fabsf(x)));
    float b = lf;
#pragma unroll
    for (int o = 1; o < 64; o <<= 1) {
      const float v = (dir == 0) ? __shfl_up(b, o) : __shfl_down(b, o);
      const bool ok = (dir == 0) ? (lane >= o) : (lane + o < 64);
      if (ok) b += v;
    }
    const float tot = (dir == 0) ? __shfl(b, 63) : __shfl(b, 0);
    float* ga = GA + (size_t)idx * 272;
    ga[lane] = b * 1.4426950408889634f; ga[64 + lane] = (li - b) * 1.4426950408889634f; ga[128 + lane] = expf(tot + li - b); ga[192 + lane] = expf(b);
    if (lane < 4) ga[256 + lane] = expf(tot);
  }
}

__device__ __forceinline__ void mlstm_chain_item(const Params& p, int l, const bf16_t* QMb, const bf16_t* KMb, const bf16_t* KMTb, const bf16_t* MVTb,
                                                 const float* GAc, bf16_t* HXb, int h, int dir, int ehalf, char* smem) {
  const int tid = otid(), lane = tid & 63, w = tid >> 6, fr = lane & 31, fh = lane >> 5;
  const int tb = w & 1, xb = w >> 1;
  float* fl = (float*)(smem + 73728);
  float* bs = fl; float* as_ = fl + 64; float* wgs = fl + 128; float* ebs = fl + 192; float* dec_s = fl + 256; float* nprev = fl + 272; float* npart = fl + 400;
  f32x16 CT[2];
#pragma unroll
  for (int eb = 0; eb < 2; ++eb)
#pragma unroll
    for (int i = 0; i < 16; ++i) CT[eb][i] = 0.f;
  __syncthreads();
  for (int i = tid; i < 1024; i += 256) ((u32x4*)(smem + 57344))[i] = (u32x4){0u, 0u, 0u, 0u};
  if (tid < 128) nprev[tid] = 0.f;
  const int qr = tid >> 4, qc = tid & 15;
  const int qdst = qr * 256 + ((qc ^ (qr & 15)) << 4);
  const int tr = tid >> 3, tc = tid & 7;
  const int tdst = tr * 128 + ((tc ^ ((tr >> 1) & 7)) << 4);
  const int sw16 = fr & 15, sw8 = (fr >> 1) & 7;
  u32x4 ra[4], rb[4], rc[4], rd[2];
  float4 rg = make_float4(0.f, 0.f, 0.f, 0.f);
#define ML_LOAD(C_) { const int r0_ = mlstm_row0(dir, (C_)); \
    const bf16_t* qs = QMb + (size_t)(r0_ + qr) * 512 + h * 128 + qc * 8; \
    const bf16_t* ks = KMb + (size_t)(r0_ + qr) * 512 + h * 128 + qc * 8; \
    const bf16_t* kts = KMTb + ((size_t)h * 128 + tr) * NTOK + r0_ + tc * 8; \
    const bf16_t* vts = MVTb + ((size_t)h * 128 + ehalf * 64 + tr) * NTOK + r0_ + tc * 8; \
    _Pragma("unroll") for (int i = 0; i < 4; ++i) { ra[i] = *(const u32x4*)(qs + (size_t)i * 16 * 512); rb[i] = *(const u32x4*)(ks + (size_t)i * 16 * 512); \
                                                    rc[i] = *(const u32x4*)(kts + (size_t)i * 32 * NTOK); } \
    _Pragma("unroll") for (int i = 0; i < 2; ++i) rd[i] = *(const u32x4*)(vts + (size_t)i * 32 * NTOK); \
    if (tid < 68) rg = ((const float4*)(GAc + (size_t)(C_) * 272))[tid]; }
  ML_LOAD(0)
#pragma unroll 1
  for (int c = 0; c < 68; ++c) {
    const int row0 = mlstm_row0(dir, c);
    __syncthreads();
#pragma unroll
    for (int i = 0; i < 4; ++i) {
      *(u32x4*)(smem + qdst + i * 4096) = ra[i];
      *(u32x4*)(smem + 16384 + qdst + i * 4096) = rb[i];
      *(u32x4*)(smem + 32768 + tdst + i * 4096) = rc[i];
    }
#pragma unroll
    for (int i = 0; i < 2; ++i) *(u32x4*)(smem + 49152 + tdst + i * 4096) = rd[i];
    if (tid < 68) ((float4*)fl)[tid] = rg;
    if (c + 1 < 68) ML_LOAD(c + 1)
    __syncthreads();
    const int t = tb * 32 + fr;
    bf16x8 qf[8];
#pragma unroll
    for (int ks = 0; ks < 8; ++ks) qf[ks] = *(const bf16x8*)(smem + t * 256 + (((ks * 2 + fh) ^ sw16) << 4));
    const float bt = bs[t], ebt = ebs[t];
    f32x16 S[2];
    float dsum = 0.f;
#pragma unroll
    for (int sb = 0; sb < 2; ++sb) {
#pragma unroll
      for (int i = 0; i < 16; ++i) S[sb][i] = 0.f;
      const bool valid = (dir == 0) ? (sb <= tb) : (sb >= tb);
      if (valid) {
#pragma unroll
        for (int ks = 0; ks < 8; ++ks) {
          const bf16x8 kf = *(const bf16x8*)(smem + 16384 + (sb * 32 + fr) * 256 + (((ks * 2 + fh) ^ sw16) << 4));
          S[sb] = __builtin_amdgcn_mfma_f32_32x32x16_bf16(kf, qf[ks], S[sb], 0, 0, 0);
        }
#pragma unroll
        for (int q = 0; q < 4; ++q) {
          const float4 a4 = *(const float4*)(as_ + sb * 32 + 8 * q + 4 * fh);
          const float av[4] = {a4.x, a4.y, a4.z, a4.w};
#pragma unroll
          for (int j = 0; j < 4; ++j) {
            const int s = sb * 32 + 8 * q + 4 * fh + j;
            const bool ok = (dir == 0) ? (s <= t) : (s >= t);
            const float v = ok ? S[sb][4 * q + j] * __builtin_amdgcn_exp2f(bt + av[j]) : 0.f;
            S[sb][4 * q + j] = v;
            dsum += v;
          }
        }
      }
    }
    bf16x8 pf[4];
#pragma unroll
    for (int sb = 0; sb < 2; ++sb)
#pragma unroll
      for (int hh = 0; hh < 2; ++hh)
        pf[sb * 2 + hh] = __builtin_bit_cast(bf16x8, (u32x4){pack2(S[sb][8 * hh], S[sb][8 * hh + 1]), pack2(S[sb][8 * hh + 2], S[sb][8 * hh + 3]),
                                                                 pack2(S[sb][8 * hh + 4], S[sb][8 * hh + 5]), pack2(S[sb][8 * hh + 6], S[sb][8 * hh + 7])});
    float nq = 0.f;
#pragma unroll
    for (int c8 = 0; c8 < 8; ++c8) {
      const u32x4 qv = *(const u32x4*)(smem + t * 256 + (((fh * 8 + c8) ^ sw16) << 4));
      const float4 n0 = *(const float4*)(nprev + fh * 64 + c8 * 8), n1 = *(const float4*)(nprev + fh * 64 + c8 * 8 + 4);
      nq = fmaf(lo16(qv[0]), n0.x, nq); nq = fmaf(hi16(qv[0]), n0.y, nq); nq = fmaf(lo16(qv[1]), n0.z, nq); nq = fmaf(hi16(qv[1]), n0.w, nq);
      nq = fmaf(lo16(qv[2]), n1.x, nq); nq = fmaf(hi16(qv[2]), n1.y, nq); nq = fmaf(lo16(qv[3]), n1.z, nq); nq = fmaf(hi16(qv[3]), n1.w, nq);
    }
    dsum += __shfl_xor(dsum, 32);
    nq += __shfl_xor(nq, 32);
    const float den = dsum + ebt * nq;
    const float inv = 1.0f / fmaxf(fabsf(den), 1.0f);
    {
      f32x16 N;
#pragma unroll
      for (int i = 0; i < 16; ++i) N[i] = 0.f;
#pragma unroll
      for (int ks = 0; ks < 8; ++ks) {
        const bf16x8 cf = *(const bf16x8*)(smem + 57344 + (xb * 32 + fr) * 256 + (((ks * 2 + fh) ^ sw16) << 4));
        N = __builtin_amdgcn_mfma_f32_32x32x16_bf16(cf, qf[ks], N, 0, 0, 0);
      }
#pragma unroll
      for (int i = 0; i < 16; ++i) N[i] *= ebt;
#pragma unroll
      for (int s4 = 0; s4 < 4; ++s4) {
        const bool valid = (dir == 0) ? ((s4 >> 1) <= tb) : ((s4 >> 1) >= tb);
        if (valid) {
          const int u0 = 4 * s4 + fh, u1 = u0 + 2;
          const char* vrow = smem + 49152 + (xb * 32 + fr) * 128;
          const u32x2 v0 = *(const u32x2*)(vrow + (((u0 >> 1) ^ sw8) << 4) + (u0 & 1) * 8);
          const u32x2 v1 = *(const u32x2*)(vrow + (((u1 >> 1) ^ sw8) << 4) + (u1 & 1) * 8);
          const bf16x8 vf = __builtin_bit_cast(bf16x8, (u32x4){v0[0], v0[1], v1[0], v1[1]});
          N = __builtin_amdgcn_mfma_f32_32x32x16_bf16(vf, pf[s4], N, 0, 0, 0);
        }
      }
      bf16_t* hp = HXb + (size_t)(row0 + t) * 512 + h * 128 + (2 * ehalf + xb) * 32 + 4 * fh;
#pragma unroll
      for (int q = 0; q < 4; ++q)
        *(u32x2*)(hp + 8 * q) = (u32x2){pack2(N[4 * q] * inv, N[4 * q + 1] * inv), pack2(N[4 * q + 2] * inv, N[4 * q + 3] * inv)};
    }
    const float decay = *dec_s;
#pragma unroll
    for (int eb = 0; eb < 2; ++eb)
#pragma unroll
      for (int i = 0; i < 16; ++i) CT[eb][i] *= decay;
#pragma unroll
    for (int ks = 0; ks < 4; ++ks) {
      const u32x4 kraw = *(const u32x4*)(smem + 32768 + (w * 32 + fr) * 128 + (((ks * 2 + fh) ^ sw8) << 4));
      const float4 g0 = *(const float4*)(wgs + ks * 16 + 8 * fh), g1 = *(const float4*)(wgs + ks * 16 + 8 * fh + 4);
      const bf16x8 kts = __builtin_bit_cast(bf16x8, (u32x4){pack2(lo16(kraw[0]) * g0.x, hi16(kraw[0]) * g0.y), pack2(lo16(kraw[1]) * g0.z, hi16(kraw[1]) * g0.w),
                                                             pack2(lo16(kraw[2]) * g1.x, hi16(kraw[2]) * g1.y), pack2(lo16(kraw[3]) * g1.z, hi16(kraw[3]) * g1.w)});
#pragma unroll
      for (int eb = 0; eb < 2; ++eb) {
        const bf16x8 vt = *(const bf16x8*)(smem + 49152 + (eb * 32 + fr) * 128 + (((ks * 2 + fh) ^ sw8) << 4));
        CT[eb] = __builtin_amdgcn_mfma_f32_32x32x16_bf16(kts, vt, CT[eb], 0, 0, 0);
      }
    }
    {
      const int d = tid & 127, sh = tid >> 7;
      float a = 0.f;
#pragma unroll 8
      for (int s = sh * 32; s < sh * 32 + 32; ++s) {
        const bf16_t kv = *(const bf16_t*)(smem + 16384 + s * 256 + ((((d >> 3)) ^ (s & 15)) << 4) + (d & 7) * 2);
        a = fmaf(wgs[s], bf2f(kv), a);
      }
      npart[sh * 128 + d] = a;
    }
    __syncthreads();
#pragma unroll
    for (int eb = 0; eb < 2; ++eb)
#pragma unroll
      for (int q = 0; q < 4; ++q)
        *(u32x2*)(smem + 57344 + (eb * 32 + fr) * 256 + ((((w * 4 + q)) ^ sw16) << 4) + 8 * fh) =
            (u32x2){pack2(CT[eb][4 * q], CT[eb][4 * q + 1]), pack2(CT[eb][4 * q + 2], CT[eb][4 * q + 3])};
    if (tid < 128) nprev[tid] = decay * nprev[tid] + npart[tid] + npart[128 + tid];
  }
#undef ML_LOAD
  __syncthreads();
}

#define S5SEG 128
#define S5NSEG 34
__device__ __forceinline__ int s5_row(int dir, int step) {
  return (dir == 0) ? ((step < NCTX) ? NLAT + step : step - NCTX)
                    : ((step < NCTX) ? NLAT + (NCTX - 1 - step) : (NLAT - 1) - (step - NCTX));
}
__device__ __forceinline__ bf16x8 pack8(const float* f) {
  return __builtin_bit_cast(bf16x8, (u32x4){pack2(f[0], f[1]), pack2(f[2], f[3]), pack2(f[4], f[5]), pack2(f[6], f[7])});
}
struct S5M { float abr, abi, a128r, a128i; bf16x8 bbf[4]; };
__device__ __forceinline__ void s5m_setup(const Params& p, int pg, int lane, S5M& m) {
  const int fr = lane & 31, fh = lane >> 5;
  const float dt = expf(p.in[I_S5DT][pg]);
  m.abr = 0.f; m.abi = 0.f; m.a128r = 0.f; m.a128i = 0.f;
#pragma unroll
  for (int c = 0; c < 2; ++c) {
    const int n = fr + 32 * c;
    const float lre = p.in[I_S5LRE][pg * 64 + n], lim = p.in[I_S5LIM][pg * 64 + n];
    const float mag = expf(lre * dt);
    const float abr = mag * cosf(lim * dt), abi = mag * sinf(lim * dt);
    const float den = lre * lre + lim * lim;
    const float zr = ((abr - 1.0f) * lre + abi * lim) / den;
    const float zi = (abi * lre - (abr - 1.0f) * lim) / den;
    const float4* br4 = (const float4*)(p.in[I_S5BRE] + ((size_t)pg * 64 + n) * 16 + 8 * fh);
    const float4* bi4 = (const float4*)(p.in[I_S5BIM] + ((size_t)pg * 64 + n) * 16 + 8 * fh);
    const float4 b0 = br4[0], b1 = br4[1], c0 = bi4[0], c1 = bi4[1];
    const float br[8] = {b0.x, b0.y, b0.z, b0.w, b1.x, b1.y, b1.z, b1.w}, bi[8] = {c0.x, c0.y, c0.z, c0.w, c1.x, c1.y, c1.z, c1.w};
    float rr[8], ii[8];
#pragma unroll
    for (int j = 0; j < 8; ++j) { rr[j] = zr * br[j] - zi * bi[j]; ii[j] = zr * bi[j] + zi * br[j]; }
    m.bbf[c] = pack8(rr); m.bbf[2 + c] = pack8(ii);
    if (fh == c) {
      m.abr = abr; m.abi = abi;
      const float mg = expf(lre * dt * (float)S5SEG);
      m.a128r = mg * cosf(lim * dt * (float)S5SEG); m.a128i = mg * sinf(lim * dt * (float)S5SEG);
    }
  }
}
template <bool STORE>
__device__ __forceinline__ void s5m_block(const S5M& m, const bf16x8 uf, float& xr, float& xi, char* xs, int lane) {
  f32x16 T[4];
#pragma unroll
  for (int k = 0; k < 4; ++k) {
#pragma unroll
    for (int i = 0; i < 16; ++i) T[k][i] = 0.f;
    T[k] = __builtin_amdgcn_mfma_f32_32x32x16_bf16(uf, m.bbf[k], T[k], 0, 0, 0);
  }
#pragma unroll
  for (int r = 0; r < 16; ++r) {
    auto a = __builtin_amdgcn_permlane32_swap(__float_as_uint(T[0][r]), __float_as_uint(T[1][r]), false, false);
    T[0][r] = __uint_as_float(a[0]); T[1][r] = __uint_as_float(a[1]);
    auto b = __builtin_amdgcn_permlane32_swap(__float_as_uint(T[2][r]), __float_as_uint(T[3][r]), false, false);
    T[2][r] = __uint_as_float(b[0]); T[3][r] = __uint_as_float(b[1]);
  }
#pragma unroll
  for (int q = 0; q < 4; ++q)
#pragma unroll
    for (int hh = 0; hh < 2; ++hh)
#pragma unroll
      for (int j = 0; j < 4; ++j) {
        const int t = 8 * q + 4 * hh + j, r = 4 * q + j;
        const float bre = hh ? T[1][r] : T[0][r], bim = hh ? T[3][r] : T[2][r];
        const float nr = fmaf(m.abr, xr, fmaf(-m.abi, xi, bre));
        const float ni = fmaf(m.abr, xi, fmaf(m.abi, xr, bim));
        xr = nr; xi = ni;
        if (STORE) *(unsigned*)(xs + t * 256 + (((lane >> 2) ^ (t & 15)) << 4) + (lane & 3) * 4) = pack2(xr, xi);
      }
}
__device__ __forceinline__ void stage_s5_pass1(const Params& p, int l, const bf16_t* Z, float* XE) {
  const int tid = otid(), w = tid >> 6, lane = tid & 63, fr = lane & 31, fh = lane >> 5;
  const int nitems = GB * 32 * 2 * (S5NSEG - 1);
  for (int idx = blockIdx.x * 4 + w; idx < nitems; idx += gridDim.x * 4) {
    const int seg = idx % (S5NSEG - 1), r1 = idx / (S5NSEG - 1), dir = r1 & 1, g = (r1 >> 1) & 31, bl = r1 >> 6;
    S5M m;
    s5m_setup(p, (l * 2 + dir) * 32 + g, lane, m);
    float xr = 0.f, xi = 0.f;
    bf16x8 ufs[S5SEG / 32];
#pragma unroll
    for (int sub = 0; sub < S5SEG / 32; ++sub) {
      const int row = s5_row(dir, seg * S5SEG + sub * 32 + fr);
      ufs[sub] = *(const bf16x8*)(Z + ((size_t)bl * NTOK + row) * ZW + 3072 + g * 16 + 8 * fh);
    }
#pragma unroll
    for (int sub = 0; sub < S5SEG / 32; ++sub) s5m_block<false>(m, ufs[sub], xr, xi, nullptr, lane);
    float* xe = XE + ((((size_t)bl * 32 + g) * 2 + dir) * (S5NSEG - 1) + seg) * 128;
    xe[lane] = xr; xe[64 + lane] = xi;
  }
}
__device__ __forceinline__ void s5_item(const Params& p, int l, const bf16_t* Zb, const float* XEc, float* Yb, int g, int dir, int sq, char* smem) {
  const int tid = otid(), w = tid >> 6, lane = tid & 63, fr = lane & 31, fh = lane >> 5;
  const int seg = sq * 4 + w;
  char* xs = smem + w * 8192;
  const int pg = (l * 2 + dir) * 32 + g;
  __syncthreads();
  if (seg < S5NSEG) {
    S5M m;
    s5m_setup(p, pg, lane, m);
    bf16x8 ccf[8];
#pragma unroll
    for (int ks = 0; ks < 8; ++ks) {
      float f[8] = {0.f, 0.f, 0.f, 0.f, 0.f, 0.f, 0.f, 0.f};
      if (fr < 16) {
        const float4 cr = *(const float4*)(p.in[I_S5CRE] + ((size_t)pg * 16 + fr) * 64 + ks * 8 + 4 * fh);
        const float4 ci = *(const float4*)(p.in[I_S5CIM] + ((size_t)pg * 16 + fr) * 64 + ks * 8 + 4 * fh);
        f[0] = cr.x; f[1] = -ci.x; f[2] = cr.y; f[3] = -ci.y; f[4] = cr.z; f[5] = -ci.z; f[6] = cr.w; f[7] = -ci.w;
      }
      ccf[ks] = pack8(f);
    }
    float xr = 0.f, xi = 0.f;
    for (int j = 0; j < seg; ++j) {
      const float er = XEc[j * 128 + lane], ei = XEc[j * 128 + 64 + lane];
      const float nr = m.a128r * xr - m.a128i * xi + er, ni = m.a128r * xi + m.a128i * xr + ei;
      xr = nr; xi = ni;
    }
    bf16x8 ufs[S5SEG / 32];
#pragma unroll
    for (int sub = 0; sub < S5SEG / 32; ++sub) {
      const int row = s5_row(dir, seg * S5SEG + sub * 32 + fr);
      ufs[sub] = *(const bf16x8*)(Zb + (size_t)row * ZW + 3072 + g * 16 + 8 * fh);
    }
#pragma unroll
    for (int sub = 0; sub < S5SEG / 32; ++sub) {
      const int row = s5_row(dir, seg * S5SEG + sub * 32 + fr);
      const bf16x8 uf = ufs[sub];
      s5m_block<true>(m, uf, xr, xi, xs, lane);
      f32x16 Y;
#pragma unroll
      for (int i = 0; i < 16; ++i) Y[i] = 0.f;
#pragma unroll
      for (int ks = 0; ks < 8; ++ks) {
        const bf16x8 xf = *(const bf16x8*)(xs + fr * 256 + (((ks * 2 + fh) ^ (fr & 15)) << 4));
        Y = __builtin_amdgcn_mfma_f32_32x32x16_bf16(ccf[ks], xf, Y, 0, 0, 0);
      }
      float* yp = Yb + (size_t)row * 512 + g * 16 + 4 * fh;
      *(float4*)yp = make_float4(Y[0], Y[1], Y[2], Y[3]);
      *(float4*)(yp + 8) = make_float4(Y[4], Y[5], Y[6], Y[7]);
    }
  }
}

__device__ __forceinline__ void stage_post(const Params& p, int l, int rr_lim, const bf16_t* Z, const bf16_t* HF, const bf16_t* HB,
                                           const float* YSF, const float* YSB, bf16_t* YB, bf16_t* GG) {
  const int tid = otid();
  const int c0 = tid * 2;
  const float2 gml = *(const float2*)(p.in[I_MLNG] + l * 512 + c0);
  const float2 dsk = *(const float2*)(p.in[I_S5D] + l * 512 + c0);
  const int n = GB * rr_lim;
  for (int i0 = blockIdx.x * 4; i0 < n; i0 += gridDim.x * 4) {
    unsigned a0[4], a1[4], og[4], uu[4];
    float2 f[4], b[4];
    size_t r[4];
#pragma unroll
    for (int u = 0; u < 4; ++u) {
      const int i = i0 + u;
      r[u] = (size_t)(i / rr_lim) * NTOK + (i % rr_lim);
      a0[u] = *(const unsigned*)(HF + r[u] * 512 + c0); a1[u] = *(const unsigned*)(HB + r[u] * 512 + c0);
      og[u] = *(const unsigned*)(Z + r[u] * ZW + 2560 + c0); uu[u] = *(const unsigned*)(Z + r[u] * ZW + 3072 + c0);
      f[u] = *(const float2*)(YSF + r[u] * 512 + c0); b[u] = *(const float2*)(YSB + r[u] * 512 + c0);
    }
#pragma unroll
    for (int u = 0; u < 4; ++u) {
      const float h0 = lo16(a0[u]) + lo16(a1[u]), h1 = hi16(a0[u]) + hi16(a1[u]);
      const float ss = wave_sum(h0 * h0 + h1 * h1);
      const float rs = rsqrtf(ss * (1.0f / 128.0f) + EPSF);
      *(unsigned*)(YB + r[u] * 512 + c0) = pack2(h0 * rs * gml.x * sigmoidf_(lo16(og[u])), h1 * rs * gml.y * sigmoidf_(hi16(og[u])));
      *(unsigned*)(GG + r[u] * 512 + c0) = pack2(geluf_(dsk.x * lo16(uu[u]) + f[u].x + b[u].x), geluf_(dsk.y * hi16(uu[u]) + f[u].y + b[u].y));
    }
  }
}

__device__ __forceinline__ void stage_glu_mfma(const Params& p, int l, int tpb, const bf16_t* GG, const bf16_t* GLUT, bf16_t* YS, char* smem) {
  EPI_DECL
  const int tm = GB * tpb;
  TileIter ti(tm, 4);
  int mt_, nt_; bool valid;
  while (ti.next(mt_, nt_, valid)) {
    if (!valid) continue;
    const int m0 = MT_LR0(mt_, tpb), n0 = nt_ * 128;
    f32x16 acc[2][2];
    gemm_tile(GG + (size_t)m0 * 512, 512, GLUT + (size_t)n0 * 512, 512, 512, smem, acc);
#pragma unroll
    for (int mi = 0; mi < 2; ++mi)
#pragma unroll
      for (int ni = 0; ni < 2; ++ni)
#pragma unroll
        for (int q = 0; q < 4; ++q) {
          const int row = m0 + EPI_ROW(mi), c = n0 + EPI_COL(ni, q);
          const float4 b = *(const float4*)(p.in[I_GLUB] + l * 512 + c);
          const u32x2 g2 = *(const u32x2*)(GG + (size_t)row * 512 + c);
          const float o0 = lo16(g2[0]) * sigmoidf_(acc[mi][ni][4 * q] + b.x), o1 = hi16(g2[0]) * sigmoidf_(acc[mi][ni][4 * q + 1] + b.y);
          const float o2 = lo16(g2[1]) * sigmoidf_(acc[mi][ni][4 * q + 2] + b.z), o3 = hi16(g2[1]) * sigmoidf_(acc[mi][ni][4 * q + 3] + b.w);
          *(u32x2*)(YS + (size_t)row * 512 + c) = (u32x2){pack2(o0, o1), pack2(o2, o3)};
        }
  }
}

__device__ __forceinline__ void stage_merge_mfma(int tpb, const bf16_t* YA, const bf16_t* YB, const bf16_t* YS, const bf16_t* WBR, const bf16_t* Z, bf16_t* MG, char* smem) {
  EPI_DECL
  const int tm = GB * tpb;
  TileIter ti(tm, 8);
  int mt_, nt_; bool valid;
  while (ti.next(mt_, nt_, valid)) {
    if (!valid) continue;
    const int m0 = MT_LR0(mt_, tpb), n0 = nt_ * 128;
    f32x16 macc[2][2];
#pragma unroll
    for (int a = 0; a < 2; ++a)
#pragma unroll
      for (int b = 0; b < 2; ++b)
#pragma unroll
        for (int i = 0; i < 16; ++i) macc[a][b][i] = 0.f;
#pragma unroll 1
    for (int r = 0; r < 3; ++r) {
      const bf16_t* Y = (r == 0) ? YA : (r == 1 ? YB : YS);
      f32x16 acc[2][2];
      gemm_tile(Y + (size_t)m0 * 512, 512, WBR + (size_t)r * 1024 * 512 + (size_t)n0 * 512, 512, 512, smem, acc);
#pragma unroll
      for (int mi = 0; mi < 2; ++mi)
#pragma unroll
        for (int ni = 0; ni < 2; ++ni)
#pragma unroll
          for (int q = 0; q < 4; ++q) {
            const int row = m0 + EPI_ROW(mi), c = n0 + EPI_COL(ni, q);
            const u32x2 e = *(const u32x2*)(Z + (size_t)row * ZW + 3584 + r * 1024 + c);
            macc[mi][ni][4 * q] += lo16(e[0]) * acc[mi][ni][4 * q];
            macc[mi][ni][4 * q + 1] += hi16(e[0]) * acc[mi][ni][4 * q + 1];
            macc[mi][ni][4 * q + 2] += lo16(e[1]) * acc[mi][ni][4 * q + 2];
            macc[mi][ni][4 * q + 3] += hi16(e[1]) * acc[mi][ni][4 * q + 3];
          }
    }
#pragma unroll
    for (int mi = 0; mi < 2; ++mi)
#pragma unroll
      for (int ni = 0; ni < 2; ++ni)
#pragma unroll
        for (int q = 0; q < 4; ++q) {
          const int row = m0 + EPI_ROW(mi), c = n0 + EPI_COL(ni, q);
          *(u32x2*)(MG + (size_t)row * DM + c) = (u32x2){pack2(macc[mi][ni][4 * q], macc[mi][ni][4 * q + 1]), pack2(macc[mi][ni][4 * q + 2], macc[mi][ni][4 * q + 3])};
        }
  }
}

__device__ __forceinline__ void stage_outproj_mfma(const Params& p, int l, int g, int tpb, const bf16_t* MG, const bf16_t* WOUT, char* smem) {
  EPI_DECL
  const int tm = GB * tpb;
  const float* mod = (const float*)(p.ws + WB_MOD) + (size_t)l * 9 * 6144;
  TileIter ti(tm, 8);
  int mt, nt_; bool valid;
  while (ti.next(mt, nt_, valid)) {
    if (!valid) continue;
    const int n0 = nt_ * 128;
    const int m0 = MT_LR0(mt, tpb), bl = mt / tpb, rr0 = (mt % tpb) * 128, b = g * GB + bl;
    f32x16 acc[2][2];
    gemm_tile(MG + (size_t)m0 * DM, DM, WOUT + (size_t)n0 * DM, DM, DM, smem, acc);
    const float* gv = mod + (size_t)((rr0 < NLAT) ? b : 8) * 6144 + 2 * 1024;
#pragma unroll
    for (int mi = 0; mi < 2; ++mi)
#pragma unroll
      for (int ni = 0; ni < 2; ++ni)
#pragma unroll
        for (int q = 0; q < 4; ++q) {
          const int rr = rr0 + EPI_ROW(mi), c = n0 + EPI_COL(ni, q);
          const float4 gg = *(const float4*)(gv + c);
          float4* xp = (float4*)(xrow(p, b, rr) + c);
          float4 x = (l == 0) ? *(const float4*)(xrow_in(p, b, rr) + c) : *xp;
          x.x += gg.x * acc[mi][ni][4 * q]; x.y += gg.y * acc[mi][ni][4 * q + 1]; x.z += gg.z * acc[mi][ni][4 * q + 2]; x.w += gg.w * acc[mi][ni][4 * q + 3];
          *xp = x;
        }
  }
}

__device__ __forceinline__ void stage_peerq_mfma(int tpb, const bf16_t* H2, const bf16_t* WQ, bf16_t* PQ, char* smem) {
  EPI_DECL
  const int tm = GB * tpb;
  TileIter ti(tm, 16);
  int mt_, nt_; bool valid;
  while (ti.next(mt_, nt_, valid)) {
    if (!valid) continue;
    const int m0 = MT_LR0(mt_, tpb), n0 = nt_ * 128;
    f32x16 acc[2][2];
    gemm_tile(H2 + (size_t)m0 * DM, DM, WQ + (size_t)n0 * DM, DM, DM, smem, acc);
#pragma unroll
    for (int mi = 0; mi < 2; ++mi)
#pragma unroll
      for (int ni = 0; ni < 2; ++ni)
#pragma unroll
        for (int q = 0; q < 4; ++q) {
          const int row = m0 + EPI_ROW(mi), c = n0 + EPI_COL(ni, q);
          *(u32x2*)(PQ + (size_t)row * 2048 + c) = (u32x2){pack2(acc[mi][ni][4 * q], acc[mi][ni][4 * q + 1]), pack2(acc[mi][ni][4 * q + 2], acc[mi][ni][4 * q + 3])};
        }
  }
}

__device__ __forceinline__ unsigned f2sortable(float x) { const unsigned u = __float_as_uint(x); return (u & 0x80000000u) ? ~u : (u | 0x80000000u); }
__device__ __forceinline__ float sortable2f(unsigned k) { return __uint_as_float((k & 0x80000000u) ? (k & 0x7fffffffu) : ~k); }
#define TOPK_INSERT(v, key) { unsigned t_ = (key); _Pragma("unroll") for (int s_ = 0; s_ < 16; ++s_) { const unsigned hi_ = max(v[s_], t_); t_ = min(v[s_], t_); v[s_] = hi_; } }
__device__ __forceinline__ void stage_scores_topk(int tpb, const bf16_t* PQ, const bf16_t* SUBK, int* EI, float* EG, char* smem) {
  EPI_DECL
  const int tid = tid_;
  const int item = tid & 127, kpart = tid >> 7;
  float* S = (float*)smem;
  unsigned* xk = (unsigned*)(smem + 128 * 129 * 4);
  const int tm = GB * tpb * 8;
  for (int mt = blockIdx.x; mt < tm; mt += gridDim.x) {
    const size_t m0 = (size_t)MT_LR0(mt >> 3, tpb) * 8 + (size_t)(mt & 7) * 128;
    unsigned vh[2][16];
#pragma unroll
    for (int half = 0; half < 2; ++half) {
      f32x16 acc[2][2];
      gemm_tile(PQ + m0 * 256 + half * 128, 256, SUBK + (size_t)half * 16384, 128, 128, smem, acc);
#pragma unroll
      for (int mi = 0; mi < 2; ++mi)
#pragma unroll
        for (int ni = 0; ni < 2; ++ni)
#pragma unroll
          for (int i = 0; i < 16; ++i)
            S[EPI_ROW(mi) * 129 + wn * 64 + ni * 32 + 8 * (i >> 2) + 4 * fh + (i & 3)] = acc[mi][ni][i];
      __syncthreads();
      unsigned v[16];
#pragma unroll
      for (int s = 0; s < 16; ++s) v[s] = 0u;
      const float* sr = S + item * 129 + kpart * 64;
#pragma unroll 8
      for (int k = 0; k < 64; ++k) {
        const unsigned key = (f2sortable(sr[k]) & ~127u) | (unsigned)(127 - (kpart * 64 + k));
        TOPK_INSERT(v, key)
      }
      if (kpart == 1) {
#pragma unroll
        for (int s = 0; s < 16; ++s) xk[item * 17 + s] = v[s];
      }
      __syncthreads();
      if (kpart == 0) {
#pragma unroll
        for (int s = 0; s < 16; ++s) { const unsigned key = xk[item * 17 + s]; TOPK_INSERT(v, key) }
      }
#pragma unroll
      for (int s = 0; s < 16; ++s) vh[half][s] = v[s];
      __syncthreads();
    }
    if (kpart == 0) {
      float v1[16], v2[16];
#pragma unroll
      for (int s = 0; s < 16; ++s) { v1[s] = sortable2f((vh[0][s] & ~127u) | 64u); v2[s] = sortable2f((vh[1][s] & ~127u) | 64u); }
      unsigned c[16];
#pragma unroll
      for (int s = 0; s < 16; ++s) c[s] = 0u;
      {
        int o = 0;
#pragma unroll
        for (int i = 0; i < 16; ++i)
#pragma unroll
          for (int j = 0; j < 16 / (i + 1); ++j) {
            const unsigned key = (f2sortable(v1[i] + v2[j]) & ~63u) | (unsigned)(63 - o);
            TOPK_INSERT(c, key)
            ++o;
          }
      }
      const float vmax = sortable2f((c[0] & ~63u) | 32u);
      float sum = 0.f;
#pragma unroll
      for (int s = 0; s < 16; ++s) sum += expf(sortable2f((c[s] & ~63u) | 32u) - vmax);
      const float isum = 1.0f / sum;
      const unsigned thr = c[15];
      int* ei = EI + (m0 + item) * 16;
      float* eg = EG + (m0 + item) * 16;
      int cntw = 0;
      {
        int o = 0;
#pragma unroll
        for (int i = 0; i < 16; ++i)
#pragma unroll
          for (int j = 0; j < 16 / (i + 1); ++j) {
            const unsigned key = (f2sortable(v1[i] + v2[j]) & ~63u) | (unsigned)(63 - o);
            if (key >= thr) {
              ei[cntw] = (int)((127u - (vh[0][i] & 127u)) * 128u + (127u - (vh[1][j] & 127u)));
              eg[cntw] = expf(sortable2f((key & ~63u) | 32u) - vmax) * isum;
              ++cntw;
            }
            ++o;
          }
      }
    }
  }
  __syncthreads();
}

__device__ __forceinline__ void unpack8(const u32x4 v, float* f) {
#pragma unroll
  for (int k = 0; k < 4; ++k) { f[2 * k] = lo16(v[k]); f[2 * k + 1] = hi16(v[k]); }
}
__device__ __forceinline__ void unpack16_fp8(const u32x4 v, float* f) {
#pragma unroll
  for (int k = 0; k < 4; ++k) {
    const f32x2 a = __builtin_amdgcn_cvt_pk_f32_fp8((int)v[k], false), b = __builtin_amdgcn_cvt_pk_f32_fp8((int)v[k], true);
    f[4 * k] = a[0]; f[4 * k + 1] = a[1]; f[4 * k + 2] = b[0]; f[4 * k + 3] = b[1];
  }
}
__device__ __forceinline__ void expert_token(const Params& p, int q, int i, float* smem) {
  const int tid = otid(), w = tid >> 6, lane = tid & 63, hl = lane & 31, hw = lane >> 5;
  const int l = q / NG, g = q % NG, rr_lim = (l == 0) ? NTOK : NLAT;
  float* part = smem;
  const char* U = p.ws + WB_U16 + (size_t)l * 16384 * 768;
  const char* V = p.ws + WB_V16 + (size_t)l * 16384 * 768;
  const float* mod = (const float*)(p.ws + WB_MOD) + (size_t)l * 9 * 6144;
  const bf16_t* H2 = (const bf16_t*)(p.ws + WB_H2) + (size_t)(q & 1) * RPG * DM;
  const int* EI = (const int*)(p.ws + WB_EI) + (size_t)(q & 1) * RPG * 128;
  const float* EG = (const float*)(p.ws + WB_EG) + (size_t)(q & 1) * RPG * 128;
  const int bl = i / rr_lim, rr = i % rr_lim, b = g * GB + bl;
  const size_t t = (size_t)bl * NTOK + rr;
  const int my_e = EI[t * 128 + w * 32 + hl];
  const float my_g = EG[t * 128 + w * 32 + hl];
  float hq[32];
#pragma unroll
  for (int c = 0; c < 4; ++c) unpack8(((const u32x4*)(H2 + t * DM + hl * 32))[c], hq + 8 * c);
  float my_dot = 0.f;
  {
    v6u ra[16];
#pragma unroll
    for (int pr = 0; pr < 16; ++pr) {
      const int e0 = __builtin_amdgcn_readlane(my_e, 2 * pr), e1 = __builtin_amdgcn_readlane(my_e, 2 * pr + 1);
      const char* rp = U + (size_t)(hw ? e1 : e0) * 768 + hl * 24;
      const u32x4_u x = *(const u32x4_u*)rp; const u32x2 y = *(const u32x2*)(rp + 16);
      ra[pr] = (v6u){x[0], x[1], x[2], x[3], y[0], y[1]};
    }
#pragma unroll
    for (int pr = 0; pr < 16; ++pr) {
      const v32f f = __builtin_amdgcn_cvt_scalef32_pk32_f32_fp6(ra[pr], 1.0f);
      float a = 0.f;
#pragma unroll
      for (int k = 0; k < 32; ++k) a = fmaf(hq[k], f[k], a);
#pragma unroll
      for (int o = 16; o > 0; o >>= 1) a += __shfl_xor(a, o);
      const float d0 = __uint_as_float(__builtin_amdgcn_readlane(__float_as_uint(a), 0)), d1 = __uint_as_float(__builtin_amdgcn_readlane(__float_as_uint(a), 32));
      if (hl == 2 * pr) my_dot = d0;
      if (hl == 2 * pr + 1) my_dot = d1;
    }
  }
  const float my_c = my_g * geluf_(my_dot * (1.0f / 64.0f));
  float acc[32];
#pragma unroll
  for (int k = 0; k < 32; ++k) acc[k] = 0.f;
  {
    v6u ra[16];
#pragma unroll
    for (int pr = 0; pr < 16; ++pr) {
      const int e0 = __builtin_amdgcn_readlane(my_e, 2 * pr), e1 = __builtin_amdgcn_readlane(my_e, 2 * pr + 1);
      const char* rp = V + (size_t)(hw ? e1 : e0) * 768 + hl * 24;
      const u32x4_u x = *(const u32x4_u*)rp; const u32x2 y = *(const u32x2*)(rp + 16);
      ra[pr] = (v6u){x[0], x[1], x[2], x[3], y[0], y[1]};
    }
#pragma unroll
    for (int pr = 0; pr < 16; ++pr) {
      const float c0 = __uint_as_float(__builtin_amdgcn_readlane(__float_as_uint(my_c), 2 * pr)), c1 = __uint_as_float(__builtin_amdgcn_readlane(__float_as_uint(my_c), 2 * pr + 1));
      const float c = hw ? c1 : c0;
      const v32f f = __builtin_amdgcn_cvt_scalef32_pk32_f32_fp6(ra[pr], 1.0f);
#pragma unroll
      for (int k = 0; k < 32; ++k) acc[k] = fmaf(c, f[k], acc[k]);
    }
  }
  __syncthreads();
  {
    float4* pw = (float4*)(part + (w * 2 + hw) * 1024 + hl * 32);
#pragma unroll
    for (int c = 0; c < 8; ++c) pw[c] = make_float4(acc[4 * c], acc[4 * c + 1], acc[4 * c + 2], acc[4 * c + 3]);
  }
  __syncthreads();
  float4 s = ((const float4*)part)[tid];
#pragma unroll
  for (int c = 1; c < 8; ++c) { const float4 x = ((const float4*)(part + c * 1024))[tid]; s.x += x.x; s.y += x.y; s.z += x.z; s.w += x.w; }
  float4 g2 = ((const float4*)(mod + (size_t)((rr < NLAT) ? b : 8) * 6144 + 5 * 1024))[tid];
  g2.x *= 0.5f; g2.y *= 0.5f; g2.z *= 0.5f; g2.w *= 0.5f;
  float4* xp = (float4*)xrow(p, b, rr) + tid;
  float4 xv = *xp;
  xv.x += g2.x * s.x; xv.y += g2.y * s.y; xv.z += g2.z * s.z; xv.w += g2.w * s.w;
  *xp = xv;
}
__device__ __forceinline__ bool expert_steal(const Params& p, int lo, int hi, float* smem) {
  int* s_tok = (int*)(smem + SMEM_FLOATS - 8);
  __syncthreads();
  if (otid() == 0) {
    int r = -1;
    int* pool = (int*)(p.ws + WB_POOL);
    for (int q = lo; q <= hi && r < 0; ++q) {
      if (q < 0) continue;
      const int n = GB * ((q < NG) ? NTOK : NLAT);
      if (__hip_atomic_load(pool + q, __ATOMIC_RELAXED, __HIP_MEMORY_SCOPE_AGENT) < n) {
        const int i = atomicAdd(pool + q, 1);
        if (i < n) r = q * 65536 + i;
      }
    }
    *s_tok = r;
  }
  __syncthreads();
  const int r = *s_tok;
  if (r < 0) return false;
  expert_token(p, r >> 16, r & 65535, smem);
  return true;
}
__device__ __forceinline__ void expert_drain(const Params& p, int lo, int hi, float* smem) {
  while (expert_steal(p, lo, hi, smem)) {}
}

__device__ __forceinline__ void stage_final(const Params& p, float* smem) {
  const int tid = otid(), w = tid >> 6, lane = tid & 63;
  const int n = NB * NLAT;
  for (int r0 = (blockIdx.x * 4 + w) * 2; r0 < n; r0 += gridDim.x * 8) {
    float4 v[2][4];
#pragma unroll
    for (int u = 0; u < 2; ++u)
#pragma unroll
      for (int q = 0; q < 4; ++q) v[u][q] = ((const float4*)(p.out + (size_t)(r0 + u) * DM))[q * 64 + lane];
#pragma unroll
    for (int u = 0; u < 2; ++u) {
      float s = 0.f;
#pragma unroll
      for (int q = 0; q < 4; ++q) s += v[u][q].x * v[u][q].x + v[u][q].y * v[u][q].y + v[u][q].z * v[u][q].z + v[u][q].w * v[u][q].w;
      s = wave_sum(s);
      const float rs = rsqrtf(s * (1.0f / DM) + EPSF);
#pragma unroll
      for (int q = 0; q < 4; ++q) {
        const float4 g = ((const float4*)p.in[I_FG])[q * 64 + lane];
        const float4 x = v[u][q];
        ((float4*)(p.out + (size_t)(r0 + u) * DM))[q * 64 + lane] = make_float4(x.x * rs * g.x, x.y * rs * g.y, x.z * rs * g.z, x.w * rs * g.w);
      }
    }
  }
}

__device__ __forceinline__ void gbar(const Params& p, unsigned* ctr, unsigned& epoch, int lo, int hi, float* smem) {
  asm volatile("s_waitcnt vmcnt(0)" ::: "memory");
  __syncthreads();
  epoch += gridDim.x;
  int* s_flag = (int*)(smem + SMEM_FLOATS - 12);
  if (threadIdx.x == 0) {
    __builtin_amdgcn_fence(__ATOMIC_RELEASE, "agent");
    asm volatile("s_waitcnt vmcnt(0)" ::: "memory");
    __hip_atomic_fetch_add(ctr, 1u, __ATOMIC_RELAXED, __HIP_MEMORY_SCOPE_AGENT);
  }
  if (hi >= lo && hi >= 0) {
    for (;;) {
      if (threadIdx.x == 0) {
        const unsigned c = __hip_atomic_load(ctr, __ATOMIC_RELAXED, __HIP_MEMORY_SCOPE_AGENT);
        *s_flag = (c >= epoch) ? 2 : ((c + 1u < epoch) ? 1 : 0);
      }
      __syncthreads();
      const int f = *s_flag;
      if (f != 1) break;
      if (!expert_steal(p, lo, hi, smem)) break;
    }
  }
  if (threadIdx.x == 0) {
    while (__hip_atomic_load(ctr, __ATOMIC_RELAXED, __HIP_MEMORY_SCOPE_AGENT) < epoch) __builtin_amdgcn_s_sleep(2);
    __builtin_amdgcn_fence(__ATOMIC_ACQUIRE, "agent");
    asm volatile("s_waitcnt vmcnt(0)" ::: "memory");
  }
  __syncthreads();
}

__global__ void __launch_bounds__(256) mega(Params p) {
  cg::grid_group grid = cg::this_grid();
  __shared__ __attribute__((aligned(16))) float smem[SMEM_FLOATS];
  char* smc = (char*)smem;
  char* ws = p.ws;
  bf16_t* H = (bf16_t*)(ws + WB_H); bf16_t* Z = (bf16_t*)(ws + WB_Z); float* MGT = (float*)(ws + WB_MGT); bf16_t* XC = (bf16_t*)(ws + WB_XC);
  bf16_t* QM = (bf16_t*)(ws + WB_QM); bf16_t* KM = (bf16_t*)(ws + WB_KM); bf16_t* KMT = (bf16_t*)(ws + WB_KMT); bf16_t* MVT = (bf16_t*)(ws + WB_MVT);
  bf16_t* HF = (bf16_t*)(ws + WB_HF); bf16_t* HB = (bf16_t*)(ws + WB_HB);
  bf16_t* VT = (bf16_t*)(ws + WB_VT); float* YSF = (float*)(ws + WB_YSF); float* YSB = (float*)(ws + WB_YSB);
  bf16_t* YA = (bf16_t*)(ws + WB_YA); bf16_t* YB = (bf16_t*)(ws + WB_YB); bf16_t* YS = (bf16_t*)(ws + WB_YS); bf16_t* GG = (bf16_t*)(ws + WB_GG);
  bf16_t* MG = (bf16_t*)(ws + WB_MG); bf16_t* PQ = (bf16_t*)(ws + WB_PQ); float* SC = (float*)(ws + WB_SC);
  float* XE = (float*)(ws + WB_XE); float* GA = (float*)(ws + WB_GA);
  const bf16_t* WT = (const bf16_t*)(ws + WB_WT);

  unsigned* bar = (unsigned*)(ws + WB_BAR);
  unsigned epoch = 0;
  stage_init(p, smem);
  grid.sync();

  for (int l = 0; l < 2; ++l) {
    const bool need_ctx = (l == 0);
    const int rr_lim = need_ctx ? NTOK : NLAT;
    const int tpb = need_ctx ? 34 : 32;
    const bf16_t* W = WT + (size_t)l * WT_LAYER;
    const float lam_init = 0.8f - 0.6f * expf(-0.3f * (float)l);
    float lam;
    {
      float s1 = 0.f, s2 = 0.f;
      for (int i = 0; i < 64; ++i) {
        s1 += p.in[I_LQ1][l * 64 + i] * p.in[I_LK1][l * 64 + i];
        s2 += p.in[I_LQ2][l * 64 + i] * p.in[I_LK2][l * 64 + i];
      }
      lam = expf(s1) - expf(s2) + lam_init;
    }
    for (int g = 0; g < NG; ++g) {
      const int q = l * NG + g;
      int plo = q - 2, phi = q - 1;
      int* EI = (int*)(ws + WB_EI) + (size_t)(q & 1) * RPG * 128; float* EG = (float*)(ws + WB_EG) + (size_t)(q & 1) * RPG * 128;
      bf16_t* H2 = (bf16_t*)(ws + WB_H2) + (size_t)(q & 1) * RPG * DM;
      stage_normmod(p, l, g, 0, NTOK, H, smem);
      gbar(p, bar, epoch, plo, phi, smem);
      stage_inproj(p, H, W + WT_WIN, Z, MGT, VT, MVT, smc);
      gbar(p, bar, epoch, plo, phi, smem);
      stage_conv(p, l, Z, XC);
      stage_s5_pass1(p, l, Z, XE);
      gbar(p, bar, epoch, plo, phi, smem);
      stage_mlqk(XC, W + WT_WQK, QM, KM, KMT, smc);
      stage_mlgates(p, l, MGT, GA);
      gbar(p, bar, epoch, plo, phi, smem);
      {
        const int n_attn = 4 * 64 + (need_ctx ? 4 * 4 : 0);
        const int n_s5 = 32 * 2 * 9;
        const int n_items = GB * (16 + n_attn + n_s5);
        int* cnt = (int*)(ws + WB_CNT) + (l * NG + g);
        int* s_item = (int*)(smem + SMEM_FLOATS - 4);
        for (;;) {
          __syncthreads();
          if (otid() == 0) *s_item = atomicAdd(cnt, 1);
          __syncthreads();
          const int it = *s_item;
          if (it >= n_items) break;
          int bl, k;
          if (it < GB * 16) { bl = it / 16; k = it % 16; }
          else if (it < GB * (16 + n_attn)) { bl = (it - GB * 16) / n_attn; k = 16 + (it - GB * 16) % n_attn; }
          else { bl = (it - GB * (16 + n_attn)) / n_s5; k = 16 + n_attn + (it - GB * (16 + n_attn)) % n_s5; }
          const bf16_t* Zb = Z + (size_t)bl * NTOK * ZW;
          const size_t ro = (size_t)bl * NTOK;
          if (k < 16) {
            const int hh = k & 3, dd = (k >> 2) & 1, eh = k >> 3;
            mlstm_chain_item(p, l, QM + ro * 512, KM + ro * 512, KMT + (size_t)bl * 4 * 128 * NTOK, MVT + (size_t)bl * 4 * 128 * NTOK, GA + (size_t)(((bl * 4 + hh) * 2 + dd) * 68) * 272,
                             (dd ? HB : HF) + ro * 512, hh, dd, eh, smc);
          } else if (k < 16 + n_attn) {
            const int a = k - 16;
            const bf16_t* VTb = VT + (size_t)bl * 4 * 128 * NTOK;
            if (a < 256) attn_mfma_item(p, l, Zb, VTb, YA + ro * 512, a & 3, (a >> 2) * 64, 0, NTOK, lam, lam_init, smc);
            else attn_mfma_item(p, l, Zb, VTb, YA + ro * 512, (a - 256) & 3, NLAT + ((a - 256) >> 2) * 64, NLAT, NCTX, lam, lam_init, smc);
          } else {
            const int a = k - 16 - n_attn;
            const int sq = a % 9, dir = (a / 9) & 1, gg = a / 18;
            s5_item(p, l, Zb, XE + (((size_t)bl * 32 + gg) * 2 + dir) * (S5NSEG - 1) * 128, (dir ? YSB : YSF) + ro * 512, gg, dir, sq, smc);
          }
        }
      }
      gbar(p, bar, epoch, plo, phi, smem);
      stage_post(p, l, rr_lim, Z, HF, HB, YSF, YSB, YB, GG);
      gbar(p, bar, epoch, plo, phi, smem);
      stage_glu_mfma(p, l, tpb, GG, W + WT_GLU, YS, smc);
      gbar(p, bar, epoch, plo, phi, smem);
      stage_merge_mfma(tpb, YA, YB, YS, W + WT_WBR, Z, MG, smc);
      gbar(p, bar, epoch, plo, phi, smem);
      stage_outproj_mfma(p, l, g, tpb, MG, W + WT_WOUT, smc);
      gbar(p, bar, epoch, plo, phi, smem);
      expert_drain(p, plo, plo, smem);
      plo = q - 1;
      gbar(p, bar, epoch, plo, phi, smem);
      stage_normmod(p, l, g, 1, rr_lim, H2, smem);
      gbar(p, bar, epoch, plo, phi, smem);
      stage_peerq_mfma(tpb, H2, W + WT_WQ, PQ, smc);
      gbar(p, bar, epoch, plo, phi, smem);
      stage_scores_topk(tpb, PQ, W + WT_SUBK, EI, EG, smc);
      gbar(p, bar, epoch, plo, phi, smem);
    }
  }
  expert_drain(p, 2 * NG - 2, 2 * NG - 1, smem);
  gbar(p, bar, epoch, 0, -1, smem);
  stage_final(p, smem);
}

extern "C" void kernel_launch(void* const* d_in, const int* in_sizes, int n_in, void* d_out,
                              int out_size, void* d_ws, size_t ws_size, hipStream_t stream) {
  static int grid_blocks = 0;
  if (!grid_blocks) {
    int dev = 0, cus = 0, per_cu = 0;
    (void)hipGetDevice(&dev);
    (void)hipDeviceGetAttribute(&cus, hipDeviceAttributeMultiprocessorCount, dev);
    (void)hipOccupancyMaxActiveBlocksPerMultiprocessor(&per_cu, mega, 256, 0);
    if (per_cu > 1) per_cu = 1;
    grid_blocks = cus * per_cu;
  }
  if (ws_size < WB_END) {
    fprintf(stderr, "workspace too small: %zu < %zu\n", ws_size, (size_t)WB_END);
    return;
  }
  Params p{};
  for (int i = 0; i < N_IN; ++i) p.in[i] = (const float*)d_in[i];
  p.out = (float*)d_out;
  p.ws = (char*)d_ws;
  (void)hipMemsetAsync((char*)d_ws + WB_BAR, 0, 256, stream);
  void* args[] = {&p};
  hipError_t e = hipLaunchCooperativeKernel((void*)mega, dim3(grid_blocks), dim3(256), args, 0, stream);
  if (e != hipSuccess) fprintf(stderr, "cooperative launch failed: %s (grid %d)\n", hipGetErrorString(e), grid_blocks);
}
```

```cpp
#include <hip/hip_runtime.h>
#include <hip/hip_cooperative_groups.h>
#include <cstdio>
#include <cstdint>
namespace cg = cooperative_groups;

#define NLAT 4096
#define NCTX 256
#define NTOK 4352
#define DM 1024
#define INW 6672
#define NB 8
#define GB 2
#define NG (NB / GB)
#define RPG (GB * NTOK)
#define ZW 6656
#define EPSF 1e-6f

enum { I_X = 0, I_C, I_CTX, I_CCTX, I_WMOD, I_BMOD, I_N1G, I_N2G, I_WIN, I_LQ1, I_LK1, I_LQ2, I_LK2, I_SUBG,
       I_CONVW, I_CONVB, I_MLWQ, I_MLWK, I_GATEB, I_MLNG, I_S5LRE, I_S5LIM, I_S5DT, I_S5BRE, I_S5BIM,
       I_S5CRE, I_S5CIM, I_S5D, I_GLUW, I_GLUB, I_WBR, I_WOUT, I_PWQ, I_PSUBK, I_PU, I_PV, I_FG, N_IN };

struct Params {
  const float* in[N_IN];
  float* out;
  char* ws;
};

typedef unsigned short bf16_t;
typedef short bf16x8 __attribute__((ext_vector_type(8)));
typedef float f32x16 __attribute__((ext_vector_type(16)));
typedef unsigned u32x4 __attribute__((ext_vector_type(4)));
typedef unsigned u32x2 __attribute__((ext_vector_type(2)));
typedef unsigned u32x4_u __attribute__((ext_vector_type(4), aligned(8)));
typedef float v16f __attribute__((ext_vector_type(16)));
typedef float v32f __attribute__((ext_vector_type(32)));
typedef unsigned v6u __attribute__((ext_vector_type(6)));

#define AL(x) (((x) + 255) & ~(size_t)255)
#define WB_XCX   ((size_t)0)
#define WB_MOD   AL(WB_XCX + (size_t)NB * NCTX * DM * 4)
#define WB_ROPE  AL(WB_MOD + (size_t)2 * 9 * 6144 * 4)
#define WB_WT    AL(WB_ROPE + (size_t)NLAT * 32 * 2 * 4)
#define WT_WIN   ((size_t)0)
#define WT_WQK   (WT_WIN + (size_t)6784 * 1024)
#define WT_GLU   (WT_WQK + (size_t)4 * 256 * 128)
#define WT_WBR   (WT_GLU + (size_t)512 * 512)
#define WT_WOUT  (WT_WBR + (size_t)3 * 1024 * 512)
#define WT_WQ    (WT_WOUT + (size_t)1024 * 1024)
#define WT_SUBK  (WT_WQ + (size_t)2048 * 1024)
#define WT_LAYER (WT_SUBK + (size_t)2 * 128 * 128)
#define WB_H     AL(WB_WT + WT_LAYER * 2 * 2)
#define WB_Z     AL(WB_H + (size_t)RPG * DM * 2)
#define WB_MGT   AL(WB_Z + (size_t)RPG * ZW * 2)
#define WB_XC    AL(WB_MGT + (size_t)RPG * 16 * 4)
#define WB_QM    AL(WB_XC + (size_t)RPG * 512 * 2)
#define WB_KM    AL(WB_QM + (size_t)RPG * 512 * 2)
#define WB_KMT   AL(WB_KM + (size_t)RPG * 512 * 2)
#define WB_MVT   AL(WB_KMT + (size_t)RPG * 512 * 2)
#define WB_HF    AL(WB_MVT + (size_t)RPG * 512 * 2)
#define WB_HB    AL(WB_HF + (size_t)RPG * 512 * 2)
#define WB_YSF   AL(WB_HB + (size_t)RPG * 512 * 2)
#define WB_YSB   AL(WB_YSF + (size_t)RPG * 512 * 4)
#define WB_YA    AL(WB_YSB + (size_t)RPG * 512 * 4)
#define WB_YB    AL(WB_YA + (size_t)RPG * 512 * 2)
#define WB_YS    AL(WB_YB + (size_t)RPG * 512 * 2)
#define WB_GG    AL(WB_YS + (size_t)RPG * 512 * 2)
#define WB_MG    AL(WB_GG + (size_t)RPG * 512 * 2)
#define WB_EI    AL(WB_MG + (size_t)RPG * DM * 2)
#define WB_EG    AL(WB_EI + (size_t)2 * RPG * 128 * 4)
#define WB_H2    AL(WB_EG + (size_t)2 * RPG * 128 * 4)
#define WB_U16   AL(WB_H2 + (size_t)2 * RPG * DM * 2)
#define WB_V16   AL(WB_U16 + (size_t)2 * 16384 * 768)
#define WB_VT    AL(WB_V16 + (size_t)2 * 16384 * 768)
#define WB_CNT   AL(WB_VT + (size_t)GB * 4 * 128 * NTOK * 2)
#define WB_XE    AL(WB_CNT + 256)
#define WB_BAR   AL(WB_XE + (size_t)GB * 32 * 2 * 33 * 128 * 4)
#define WB_GA    AL(WB_BAR + 256)
#define WB_POOL  AL(WB_GA + (size_t)GB * 4 * 2 * 68 * 272 * 4)
#define WB_END   AL(WB_POOL + 256)
#define WB_PQ    (WB_Z)
#define WB_SC    AL(WB_PQ + (size_t)RPG * 2048 * 2)

#define SMEM_FLOATS (25 * 1024)

__device__ __forceinline__ float sigmoidf_(float x) { return __builtin_amdgcn_rcpf(1.0f + __builtin_amdgcn_exp2f(-1.4426950408889634f * x)); }
__device__ __forceinline__ float siluf_(float x) { return x * __builtin_amdgcn_rcpf(1.0f + __builtin_amdgcn_exp2f(-1.4426950408889634f * x)); }
__device__ __forceinline__ float geluf_(float x) { return 0.5f * x * (1.0f + erff(x * 0.70710678118654752f)); }
__device__ __forceinline__ int otid() { int t = threadIdx.x; asm volatile("" : "+v"(t)); return t; }
__device__ __forceinline__ float wave_sum(float v) {
  for (int o = 32; o > 0; o >>= 1) v += __shfl_xor(v, o);
  return v;
}
__device__ __forceinline__ bf16_t f2bf(float x) { unsigned u = __float_as_uint(x); u += 0x7fffu + ((u >> 16) & 1u); return (bf16_t)(u >> 16); }
__device__ __forceinline__ float bf2f(bf16_t h) { return __uint_as_float(((unsigned)h) << 16); }
typedef float f32x2 __attribute__((ext_vector_type(2)));
typedef __bf16 bf16x2_t __attribute__((ext_vector_type(2)));
__device__ __forceinline__ unsigned pack2(float a, float b) { f32x2 v = {a, b}; return __builtin_bit_cast(unsigned, __builtin_convertvector(v, bf16x2_t)); }
__device__ __forceinline__ float lo16(unsigned u) { return __uint_as_float(u << 16); }
__device__ __forceinline__ float hi16(unsigned u) { return __uint_as_float(u & 0xffff0000u); }

__device__ __forceinline__ float* xrow(const Params& p, int b, int rr) {
  return (rr < NLAT) ? p.out + ((size_t)b * NLAT + rr) * DM : (float*)(p.ws + WB_XCX) + ((size_t)b * NCTX + (rr - NLAT)) * DM;
}

__device__ __forceinline__ const float* xrow_in(const Params& p, int b, int rr) {
  return (rr < NLAT) ? p.in[I_X] + ((size_t)b * NLAT + rr) * DM : p.in[I_CTX] + ((size_t)b * NCTX + (rr - NLAT)) * DM;
}

__device__ __forceinline__ void gemm_tile(const bf16_t* __restrict__ Ag, int lda, const bf16_t* __restrict__ Bg, int ldb, int K,
                                          char* smem, f32x16 (&acc)[2][2]) {
  const int tid = otid(), lane = tid & 63, w = tid >> 6, wm = w >> 1, wn = w & 1;
#pragma unroll
  for (int a = 0; a < 2; ++a)
#pragma unroll
    for (int b = 0; b < 2; ++b)
#pragma unroll
      for (int i = 0; i < 16; ++i) acc[a][b][i] = 0.f;
  const int srow = tid >> 3, sch = tid & 7;
  const bf16_t* ap = Ag + (size_t)srow * lda + sch * 8;
  const bf16_t* bp = Bg + (size_t)srow * ldb + sch * 8;
  const int wofs = srow * 128 + ((sch ^ ((srow >> 1) & 7)) << 4);
  const int fr = lane & 31, fh = lane >> 5, fsw = (fr >> 1) & 7;
  const int aofs = (wm * 64 + fr) * 128, bofs = 16384 + (wn * 64 + fr) * 128;
  u32x4 ra0[4], rb0[4], ra1[4], rb1[4];
  const int nk = K >> 6;
#define G_LOAD(RA, RB, KT) { _Pragma("unroll") for (int i = 0; i < 4; ++i) { RA[i] = *(const u32x4*)(ap + (size_t)i * 32 * lda + (KT) * 64); RB[i] = *(const u32x4*)(bp + (size_t)i * 32 * ldb + (KT) * 64); } }
#define G_STORE(RA, RB, BUF) { char* nb_ = smem + (BUF) * 32768; _Pragma("unroll") for (int i = 0; i < 4; ++i) { *(u32x4*)(nb_ + wofs + i * 4096) = RA[i]; *(u32x4*)(nb_ + 16384 + wofs + i * 4096) = RB[i]; } }
#define G_COMPUTE(BUF) { const char* base = smem + (BUF) * 32768; _Pragma("unroll") for (int ks = 0; ks < 4; ++ks) { \
      const int coff = ((ks * 2 + fh) ^ fsw) << 4; bf16x8 af[2], bfr[2]; \
      _Pragma("unroll") for (int mi = 0; mi < 2; ++mi) af[mi] = *(const bf16x8*)(base + aofs + mi * 4096 + coff); \
      _Pragma("unroll") for (int ni = 0; ni < 2; ++ni) bfr[ni] = *(const bf16x8*)(base + bofs + ni * 4096 + coff); \
      _Pragma("unroll") for (int mi = 0; mi < 2; ++mi) _Pragma("unroll") for (int ni = 0; ni < 2; ++ni) \
          acc[mi][ni] = __builtin_amdgcn_mfma_f32_32x32x16_bf16(bfr[ni], af[mi], acc[mi][ni], 0, 0, 0); } }
  G_LOAD(ra0, rb0, 0)
  G_LOAD(ra1, rb1, 1)
  __syncthreads();
  G_STORE(ra0, rb0, 0)
  __syncthreads();
  for (int kt = 0; kt < nk; kt += 2) {
    if (kt + 2 < nk) G_LOAD(ra0, rb0, kt + 2)
    G_COMPUTE(0)
    G_STORE(ra1, rb1, 1)
    __syncthreads();
    if (kt + 3 < nk) G_LOAD(ra1, rb1, kt + 3)
    G_COMPUTE(1)
    if (kt + 2 < nk) G_STORE(ra0, rb0, 0)
    __syncthreads();
  }
#undef G_LOAD
#undef G_STORE
#undef G_COMPUTE
}
#define EPI_DECL const int tid_ = otid(); const int lane = tid_ & 63, w_ = tid_ >> 6, wm = w_ >> 1, wn = w_ & 1, fr = lane & 31, fh = lane >> 5; (void)fr; (void)fh; (void)wm; (void)wn;
#define EPI_ROW(mi) (wm * 64 + (mi) * 32 + fr)
#define EPI_COL(ni, q) (wn * 64 + (ni) * 32 + 8 * (q) + 4 * fh)
#define MT_LR0(mt, tpb) (((mt) / (tpb)) * NTOK + ((mt) % (tpb)) * 128)


struct TileIter {
  int tm, tn, pw, ph, PN, NP, x, i, it;
  __device__ __forceinline__ TileIter(int tm_, int tn_) : tm(tm_), tn(tn_) {
    pw = tn < 8 ? tn : 8; ph = 32 / pw; PN = (tn + pw - 1) / pw; NP = ((tm + ph - 1) / ph) * PN;
    x = blockIdx.x & 7; i = blockIdx.x >> 3; it = 0;
  }
  __device__ __forceinline__ bool next(int& mt, int& nt, bool& valid) {
    if (gridDim.x != 256) {
      const int t = blockIdx.x + it * gridDim.x; ++it;
      if (t >= tm * tn) return false;
      mt = t / tn; nt = t % tn; valid = true; return true;
    }
    const int P = it * 8 + x; ++it;
    if (P >= NP) return false;
    mt = (P / PN) * ph + i / pw; nt = (P % PN) * pw + i % pw;
    valid = (mt < tm) && (nt < tn);
    return true;
  }
};

template <class F>
__device__ __forceinline__ void transpose_cvt(const float* __restrict__ src, int ld, F srccol, int K, int Ndst, bf16_t* __restrict__ dst, float* smem) {
  float (*T)[65] = (float (*)[65])smem;
  const int tid = otid();
  const int tk = K >> 6, tn = Ndst >> 6;
  for (int t = blockIdx.x; t < tn * tk; t += gridDim.x) {
    const int n0 = (t / tk) * 64, k0 = (t % tk) * 64;
    __syncthreads();
    const int sc = srccol(n0 + (tid & 63));
#pragma unroll
    for (int i = 0; i < 16; ++i) {
      const int ky = (tid >> 6) + 4 * i;
      T[ky][tid & 63] = (sc >= 0) ? src[(size_t)(k0 + ky) * ld + sc] : 0.f;
    }
    __syncthreads();
#pragma unroll
    for (int i = 0; i < 16; ++i) {
      const int ny = (tid >> 6) + 4 * i;
      dst[(size_t)(n0 + ny) * K + k0 + (tid & 63)] = f2bf(T[tid & 63][ny]);
    }
  }
  __syncthreads();
}
__device__ __forceinline__ int win_srccol(int n) {
  if (n < 3072) return n;
  if (n < 6656) return n + 16;
  if (n < 6672) return n - 3584;
  return -1;
}

__device__ __forceinline__ void stage_init(const Params& p, float* smem) {
  const int tid = otid();
  if (blockIdx.x == 0 && tid < 64) { ((int*)(p.ws + WB_CNT))[tid] = 0; if (tid < 16) ((int*)(p.ws + WB_POOL))[tid] = 0; }
  {
    float* lx = smem + tid * 33;
    int perm[32];
    {
      v16f a, b;
#pragma unroll
      for (int j = 0; j < 16; ++j) { a[j] = (float)(j & 7); b[j] = (float)((j + 16) & 7); }
      const v32f u1 = __builtin_amdgcn_cvt_scalef32_pk32_f32_fp6(__builtin_amdgcn_cvt_scalef32_2xpk16_fp6_f32(a, b, 1.0f), 1.0f);
#pragma unroll
      for (int j = 0; j < 16; ++j) { a[j] = (float)(j >> 3); b[j] = (float)((j + 16) >> 3); }
      const v32f u2 = __builtin_amdgcn_cvt_scalef32_pk32_f32_fp6(__builtin_amdgcn_cvt_scalef32_2xpk16_fp6_f32(a, b, 1.0f), 1.0f);
#pragma unroll
      for (int k = 0; k < 32; ++k) perm[k] = ((int)(u1[k] + 0.5f) + 8 * (int)(u2[k] + 0.5f)) & 31;
    }
    const size_t ngrp = (size_t)2 * 16384 * 32;
    for (size_t i = (size_t)blockIdx.x * 256 + tid; i < 2 * ngrp; i += (size_t)gridDim.x * 256) {
      const bool isv = i >= ngrp;
      const size_t gi = isv ? i - ngrp : i;
      const float4* s4 = (const float4*)((isv ? p.in[I_PV] : p.in[I_PU]) + gi * 32);
      const float sc = isv ? 2.0f : 64.0f;
      float o[32];
#pragma unroll
      for (int q = 0; q < 8; ++q) { const float4 t = s4[q]; o[4 * q] = t.x * sc; o[4 * q + 1] = t.y * sc; o[4 * q + 2] = t.z * sc; o[4 * q + 3] = t.w * sc; }
#pragma unroll
      for (int k = 0; k < 32; ++k) lx[perm[k]] = o[k];
      v16f a, b;
#pragma unroll
      for (int j = 0; j < 16; ++j) { a[j] = lx[j]; b[j] = lx[16 + j]; }
      const v6u pk = __builtin_amdgcn_cvt_scalef32_2xpk16_fp6_f32(a, b, 1.0f);
      u32x2* d = (u32x2*)(p.ws + (isv ? WB_V16 : WB_U16) + gi * 24);
      d[0] = (u32x2){pk[0], pk[1]}; d[1] = (u32x2){pk[2], pk[3]}; d[2] = (u32x2){pk[4], pk[5]};
    }
    __syncthreads();
  }
  {
    float2* rt = (float2*)(p.ws + WB_ROPE);
    for (int i = blockIdx.x * 256 + tid; i < NLAT * 32; i += gridDim.x * 256) {
      const int pos = i >> 5, j = i & 31;
      const float inv = powf(10000.0f, -(float)(j & 15) / 16.0f);
      const float ang = (float)((j < 16) ? (pos >> 6) : (pos & 63)) * inv;
      rt[i] = make_float2(cosf(ang), sinf(ang));
    }
  }
  {
    float* sc = smem;
    float* red = smem + 9 * 1024;
    for (int i = tid; i < 9 * 1024; i += 256) {
      int r = i >> 10, k = i & 1023;
      float v = (r < 8) ? p.in[I_C][r * 1024 + k] : p.in[I_CCTX][k];
      sc[i] = siluf_(v);
    }
    __syncthreads();
    float* mod = (float*)(p.ws + WB_MOD);
    const int jc = tid & 63, ksl = tid >> 6;
    for (int cb = blockIdx.x; cb < 2 * 6144 / 64; cb += gridDim.x) {
      const int col = cb * 64 + jc;
      const int l = col / 6144, j = col % 6144;
      const float* w = p.in[I_WMOD] + (size_t)l * 1024 * 6144 + j;
      float acc[9];
#pragma unroll
      for (int r = 0; r < 9; ++r) acc[r] = 0.f;
#pragma unroll 8
      for (int k = ksl * 256; k < ksl * 256 + 256; ++k) {
        const float wv = w[(size_t)k * 6144];
#pragma unroll
        for (int r = 0; r < 9; ++r) acc[r] = fmaf(sc[r * 1024 + k], wv, acc[r]);
      }
      __syncthreads();
#pragma unroll
      for (int r = 0; r < 9; ++r) red[(ksl * 64 + jc) * 9 + r] = acc[r];
      __syncthreads();
      if (ksl == 0) {
        const float bv = p.in[I_BMOD][l * 6144 + j];
#pragma unroll
        for (int r = 0; r < 9; ++r)
          mod[((size_t)l * 9 + r) * 6144 + j] = red[jc * 9 + r] + red[(64 + jc) * 9 + r] + red[(128 + jc) * 9 + r] + red[(192 + jc) * 9 + r] + bv;
      }
    }
    __syncthreads();
  }
  bf16_t* WT = (bf16_t*)(p.ws + WB_WT);
  for (int l = 0; l < 2; ++l) {
    bf16_t* W = WT + (size_t)l * WT_LAYER;
    transpose_cvt(p.in[I_WIN] + (size_t)l * DM * INW, INW, [](int n) { return win_srccol(n); }, DM, 6784, W + WT_WIN, smem);
    for (int h = 0; h < 4; ++h) {
      transpose_cvt(p.in[I_MLWQ] + ((size_t)l * 4 + h) * 16384, 128, [](int n) { return n; }, 128, 128, W + WT_WQK + (size_t)h * 256 * 128, smem);
      transpose_cvt(p.in[I_MLWK] + ((size_t)l * 4 + h) * 16384, 128, [](int n) { return n; }, 128, 128, W + WT_WQK + (size_t)h * 256 * 128 + 128 * 128, smem);
    }
    transpose_cvt(p.in[I_GLUW] + (size_t)l * 512 * 512, 512, [](int n) { return n; }, 512, 512, W + WT_GLU, smem);
    for (int r = 0; r < 3; ++r)
      transpose_cvt(p.in[I_WBR] + ((size_t)l * 3 + r) * 512 * DM, DM, [](int n) { return n; }, 512, DM, W + WT_WBR + (size_t)r * 1024 * 512, smem);
    transpose_cvt(p.in[I_WOUT] + (size_t)l * DM * DM, DM, [](int n) { return n; }, DM, DM, W + WT_WOUT, smem);
    transpose_cvt(p.in[I_PWQ] + (size_t)l * DM * 2048, 2048, [](int n) { return n; }, DM, 2048, W + WT_WQ, smem);
    const float* sk = p.in[I_PSUBK] + (size_t)l * 2 * 128 * 128;
    for (int i = blockIdx.x * 256 + tid; i < 2 * 128 * 128; i += gridDim.x * 256) W[WT_SUBK + i] = f2bf(sk[i]);
  }
}

__device__ __forceinline__ void stage_normmod(const Params& p, int l, int g, int which, int rr_lim, bf16_t* H, float* smem) {
  const int tid = otid(), w = tid >> 6, lane = tid & 63;
  const float* ng = p.in[which ? I_N2G : I_N1G] + l * DM;
  const float* mod = (const float*)(p.ws + WB_MOD) + (size_t)l * 9 * 6144;
  const int off_sh = which ? 3072 : 0, off_sc = which ? 4096 : 1024;
  const int n = GB * rr_lim;
  for (int i0 = (blockIdx.x * 4 + w) * 2; i0 < n; i0 += gridDim.x * 8) {
    float4 v[2][4];
    int bl[2], rr[2];
#pragma unroll
    for (int u = 0; u < 2; ++u) {
      const int i = (i0 + u < n) ? i0 + u : i0;
      bl[u] = i / rr_lim; rr[u] = i % rr_lim;
      const float4* X = (const float4*)((l == 0 && which == 0) ? xrow_in(p, g * GB + bl[u], rr[u]) : xrow(p, g * GB + bl[u], rr[u]));
#pragma unroll
      for (int q = 0; q < 4; ++q) v[u][q] = X[q * 64 + lane];
    }
#pragma unroll
    for (int u = 0; u < 2; ++u) {
      if (i0 + u >= n) break;
      float s = 0.f;
#pragma unroll
      for (int q = 0; q < 4; ++q) s += v[u][q].x * v[u][q].x + v[u][q].y * v[u][q].y + v[u][q].z * v[u][q].z + v[u][q].w * v[u][q].w;
      s = wave_sum(s);
      const float rs = rsqrtf(s * (1.0f / DM) + EPSF);
      const float* m = mod + (size_t)((rr[u] < NLAT) ? (g * GB + bl[u]) : 8) * 6144;
      u32x2* hp = (u32x2*)(H + ((size_t)bl[u] * NTOK + rr[u]) * DM);
#pragma unroll
      for (int q = 0; q < 4; ++q) {
        const float4 gg = ((const float4*)ng)[q * 64 + lane];
        const float4 sc = ((const float4*)(m + off_sc))[q * 64 + lane];
        const float4 sh = ((const float4*)(m + off_sh))[q * 64 + lane];
        const float4 x = v[u][q];
        hp[q * 64 + lane] = (u32x2){pack2(x.x * rs * gg.x * (1.f + sc.x) + sh.x, x.y * rs * gg.y * (1.f + sc.y) + sh.y),
                                    pack2(x.z * rs * gg.z * (1.f + sc.z) + sh.z, x.w * rs * gg.w * (1.f + sc.w) + sh.w)};
      }
    }
  }
}

__device__ __forceinline__ void stage_inproj(const Params& p, const bf16_t* H, const bf16_t* WinT, bf16_t* Z, float* MGT, bf16_t* VT, bf16_t* MVT, char* smem) {
  EPI_DECL
  const int tm = GB * 34, tn = 53;
  const float2* rt = (const float2*)(p.ws + WB_ROPE);
  TileIter ti(tm, tn);
  int mt, j; bool valid;
  while (ti.next(mt, j, valid)) {
    if (!valid) continue;
    const int n0 = j * 128;
    const int lr0 = MT_LR0(mt, 34), rr0 = (mt % 34) * 128;
    f32x16 acc[2][2];
    if ((j >= 8 && j < 12) || (j >= 16 && j < 20)) {
      gemm_tile(WinT + (size_t)n0 * DM, DM, H + (size_t)lr0 * DM, DM, DM, smem, acc);
      bf16_t* vt = ((j < 12) ? VT : MVT) + ((size_t)(mt / 34) * 4 + (j & 3)) * 128 * NTOK;
#pragma unroll
      for (int mi = 0; mi < 2; ++mi)
#pragma unroll
        for (int ni = 0; ni < 2; ++ni)
#pragma unroll
          for (int q = 0; q < 4; ++q) {
            const int e = EPI_ROW(mi), tok = rr0 + EPI_COL(ni, q);
            *(u32x2*)(vt + (size_t)e * NTOK + tok) = (u32x2){pack2(acc[mi][ni][4 * q], acc[mi][ni][4 * q + 1]), pack2(acc[mi][ni][4 * q + 2], acc[mi][ni][4 * q + 3])};
          }
      continue;
    }
    gemm_tile(H + (size_t)lr0 * DM, DM, WinT + (size_t)n0 * DM, DM, DM, smem, acc);
    if (j < 8 && rr0 < NLAT) {
#pragma unroll
      for (int mi = 0; mi < 2; ++mi) {
        const int pos = rr0 + EPI_ROW(mi);
#pragma unroll
        for (int i = 0; i < 16; ++i) {
          const int jj = 8 * (i >> 2) + 4 * fh + (i & 3);
          const float2 cs = rt[pos * 32 + jj];
          const float x1 = acc[mi][0][i], x2 = acc[mi][1][i];
          acc[mi][0][i] = x1 * cs.x - x2 * cs.y;
          acc[mi][1][i] = x1 * cs.y + x2 * cs.x;
        }
      }
    }
    if (j < 52) {
      const bool sg = (j >= 28);
#pragma unroll
      for (int mi = 0; mi < 2; ++mi)
#pragma unroll
        for (int ni = 0; ni < 2; ++ni)
#pragma unroll
          for (int q = 0; q < 4; ++q) {
            const int row = lr0 + EPI_ROW(mi), c = n0 + EPI_COL(ni, q);
            float v0 = acc[mi][ni][4 * q], v1 = acc[mi][ni][4 * q + 1], v2 = acc[mi][ni][4 * q + 2], v3 = acc[mi][ni][4 * q + 3];
            if (sg) { v0 = sigmoidf_(v0); v1 = sigmoidf_(v1); v2 = sigmoidf_(v2); v3 = sigmoidf_(v3); }
            *(u32x2*)(Z + (size_t)row * ZW + c) = (u32x2){pack2(v0, v1), pack2(v2, v3)};
          }
    } else {
#pragma unroll
      for (int mi = 0; mi < 2; ++mi)
#pragma unroll
        for (int q = 0; q < 2; ++q) {
          const int row = lr0 + EPI_ROW(mi), c = EPI_COL(0, q);
          if (wn == 0) *(float4*)(MGT + (size_t)row * 16 + c) = make_float4(acc[mi][0][4 * q], acc[mi][0][4 * q + 1], acc[mi][0][4 * q + 2], acc[mi][0][4 * q + 3]);
        }
    }
  }
}

__device__ __forceinline__ void stage_conv(const Params& p, int l, const bf16_t* Z, bf16_t* XC) {
  const int tid = otid();
  const float* cw = p.in[I_CONVW] + (size_t)l * 3 * 512;
  const float* cb = p.in[I_CONVB] + (size_t)l * 512;
  const int c = tid * 2;
  const float2 w0 = *(const float2*)(cw + c), w1 = *(const float2*)(cw + 512 + c), w2 = *(const float2*)(cw + 1024 + c), bb = *(const float2*)(cb + c);
  for (int lr0 = blockIdx.x * 4; lr0 < RPG; lr0 += gridDim.x * 4) {
    unsigned xc[4], xp[4], xn[4];
#pragma unroll
    for (int u = 0; u < 4; ++u) {
      const int lr = lr0 + u, rr = lr % NTOK;
      const bool has_prev = (rr < NLAT) ? (rr > 0) : (rr > NLAT);
      const bool has_next = (rr < NLAT) ? (rr < NLAT - 1) : (rr < NTOK - 1);
      const bf16_t* z = Z + (size_t)lr * ZW + 1536 + c;
      xc[u] = *(const unsigned*)z;
      xp[u] = has_prev ? *(const unsigned*)(z - ZW) : 0u;
      xn[u] = has_next ? *(const unsigned*)(z + ZW) : 0u;
    }
#pragma unroll
    for (int u = 0; u < 4; ++u) {
      const float a0 = bb.x + w1.x * lo16(xc[u]) + w0.x * lo16(xp[u]) + w2.x * lo16(xn[u]);
      const float a1 = bb.y + w1.y * hi16(xc[u]) + w0.y * hi16(xp[u]) + w2.y * hi16(xn[u]);
      *(unsigned*)(XC + (size_t)(lr0 + u) * 512 + c) = pack2(siluf_(a0), siluf_(a1));
    }
  }
}

__device__ __forceinline__ void stage_mlqk(const bf16_t* XC, const bf16_t* WQK, bf16_t* QM, bf16_t* KM, bf16_t* KMT, char* smem) {
  EPI_DECL
  const int tm = RPG >> 7;
  TileIter ti(tm, 12);
  int mt, r12; bool valid;
  while (ti.next(mt, r12, valid)) {
    if (!valid) continue;
    const int h = r12 & 3, kind = r12 >> 2;
    const int m0 = mt * 128;
    f32x16 acc[2][2];
    const bf16_t* Wt = WQK + (size_t)h * 256 * 128 + (size_t)(kind ? 1 : 0) * 128 * 128;
    const bf16_t* Xt = XC + (size_t)m0 * 512 + h * 128;
    if (kind < 2) {
      gemm_tile(Xt, 512, Wt, 128, 128, smem, acc);
      bf16_t* O = kind ? KM : QM;
      const float alpha = kind ? 1.0f : 0.08838834764831845f;
#pragma unroll
      for (int mi = 0; mi < 2; ++mi)
#pragma unroll
        for (int ni = 0; ni < 2; ++ni)
#pragma unroll
          for (int q = 0; q < 4; ++q) {
            const int row = m0 + EPI_ROW(mi), c = EPI_COL(ni, q);
            *(u32x2*)(O + (size_t)row * 512 + h * 128 + c) = (u32x2){pack2(alpha * acc[mi][ni][4 * q], alpha * acc[mi][ni][4 * q + 1]), pack2(alpha * acc[mi][ni][4 * q + 2], alpha * acc[mi][ni][4 * q + 3])};
          }
    } else {
      gemm_tile(Wt, 128, Xt, 512, 128, smem, acc);
      bf16_t* kt = KMT + ((size_t)(mt / 34) * 4 + h) * 128 * NTOK + (mt % 34) * 128;
#pragma unroll
      for (int mi = 0; mi < 2; ++mi)
#pragma unroll
        for (int ni = 0; ni < 2; ++ni)
#pragma unroll
          for (int q = 0; q < 4; ++q) {
            const int d = EPI_ROW(mi), tok = EPI_COL(ni, q);
            *(u32x2*)(kt + (size_t)d * NTOK + tok) = (u32x2){pack2(acc[mi][ni][4 * q], acc[mi][ni][4 * q + 1]), pack2(acc[mi][ni][4 * q + 2], acc[mi][ni][4 * q + 3])};
          }
    }
  }
}

__device__ __forceinline__ void attn_mfma_item(const Params& p, int l, const bf16_t* Zb, const bf16_t* VTb, bf16_t* YAb, int h, int qrow0, int key0, int nkeys,
                                               float lam, float lam_init, char* smem) {
  const int tid = otid(), lane = tid & 63, w = tid >> 6, fr = lane & 31, fh = lane >> 5;
  const int rb = w & 1, m = w >> 1;
  const int ntiles = nkeys >> 6;
  const int myrow = qrow0 + rb * 32 + fr;
  bf16x8 qf[4];
  {
    const bf16_t* qp = Zb + (size_t)myrow * ZW + h * 128 + m * 64 + fh * 8;
#pragma unroll
    for (int ks = 0; ks < 4; ++ks) qf[ks] = *(const bf16x8*)(qp + ks * 16);
  }
  f32x16 O[4];
#pragma unroll
  for (int eb = 0; eb < 4; ++eb)
#pragma unroll
    for (int i = 0; i < 16; ++i) O[eb][i] = 0.f;
  float mrun = -1e30f, lrun = 0.f;
  const float cs = 0.125f * 1.4426950408889634f;
  const int skey = tid >> 4, sch = tid & 15;
  const bf16_t* ksrc = Zb + (size_t)(key0 + skey) * ZW + 512 + h * 128 + sch * 8;
  const int kdst = skey * 256 + ((sch ^ (skey & 15)) << 4);
  const int se = tid >> 3, svc = tid & 7;
  const bf16_t* vsrc = VTb + ((size_t)h * 128 + se) * NTOK + key0 + svc * 8;
  const int vsw = (se >> 1) & 15;
  const int vdst0 = se * 128 + (((2 * svc) ^ vsw) << 3), vdst1 = se * 128 + (((2 * svc + 1) ^ vsw) << 3);
  const int kfo = fr * 256, kfs = fr & 15;
  const int vfo = fr * 128, vfs = (fr >> 1) & 15;
  u32x4 rk[4], rv[4];
#pragma unroll
  for (int i = 0; i < 4; ++i) rk[i] = *(const u32x4*)(ksrc + (size_t)i * 16 * ZW);
  __syncthreads();
#pragma unroll
  for (int i = 0; i < 4; ++i) *(u32x4*)(smem + kdst + i * 4096) = rk[i];
  __syncthreads();
  bf16x8 pf[4];
#define ATT_S(T) { const char* kb_ = smem + ((T) & 1) * 16384; _Pragma("unroll") for (int kb = 0; kb < 2; ++kb) { \
      _Pragma("unroll") for (int i = 0; i < 16; ++i) S[kb][i] = 0.f; \
      _Pragma("unroll") for (int ks = 0; ks < 4; ++ks) { \
        const bf16x8 kf = *(const bf16x8*)(kb_ + kb * 8192 + kfo + (((m * 8 + ks * 2 + fh) ^ kfs) << 4)); \
        S[kb] = __builtin_amdgcn_mfma_f32_32x32x16_bf16(kf, qf[ks], S[kb], 0, 0, 0); } } }
#define ATT_MAX() { float tm = S[0][0]; \
      _Pragma("unroll") for (int i = 1; i < 16; ++i) tm = fmaxf(tm, S[0][i]); \
      _Pragma("unroll") for (int i = 0; i < 16; ++i) tm = fmaxf(tm, S[1][i]); \
      tm = fmaxf(tm, __shfl_xor(tm, 32)) * cs; alpha = 1.f; \
      if (tm > mrun + 8.0f) { alpha = __builtin_amdgcn_exp2f(mrun - tm); mrun = tm; } }
#define ATT_EXP(PF) { const float mc = mrun; float rs = 0.f; \
      _Pragma("unroll") for (int kb = 0; kb < 2; ++kb) { float pv[16]; \
        _Pragma("unroll") for (int i = 0; i < 16; ++i) { pv[i] = __builtin_amdgcn_exp2f(fmaf(S[kb][i], cs, -mc)); rs += pv[i]; } \
        _Pragma("unroll") for (int hh = 0; hh < 2; ++hh) \
          PF[kb * 2 + hh] = __builtin_bit_cast(bf16x8, (u32x4){pack2(pv[8 * hh], pv[8 * hh + 1]), pack2(pv[8 * hh + 2], pv[8 * hh + 3]), \
                                                               pack2(pv[8 * hh + 4], pv[8 * hh + 5]), pack2(pv[8 * hh + 6], pv[8 * hh + 7])}); } \
      lrun += rs; }
#define ATT_PV(T) { const char* vb_ = smem + 32768 + ((T) & 1) * 16384; _Pragma("unroll") for (int eb = 0; eb < 4; ++eb) _Pragma("unroll") for (int s = 0; s < 4; ++s) { \
        const u32x2 v0 = *(const u32x2*)(vb_ + eb * 4096 + vfo + (((4 * s + fh) ^ vfs) << 3)); \
        const u32x2 v1 = *(const u32x2*)(vb_ + eb * 4096 + vfo + (((4 * s + fh + 2) ^ vfs) << 3)); \
        const bf16x8 vf = __builtin_bit_cast(bf16x8, (u32x4){v0[0], v0[1], v1[0], v1[1]}); \
        O[eb] = __builtin_amdgcn_mfma_f32_32x32x16_bf16(vf, pf[s], O[eb], 0, 0, 0); } }
  f32x16 S[2];
  float alpha;
  {
#pragma unroll
    for (int i = 0; i < 4; ++i) rk[i] = *(const u32x4*)(ksrc + (size_t)(64 + i * 16) * ZW);
#pragma unroll
    for (int i = 0; i < 4; ++i) rv[i] = *(const u32x4*)(vsrc + (size_t)i * 32 * NTOK);
    ATT_S(0)
    ATT_MAX()
    ATT_EXP(pf)
#pragma unroll
    for (int i = 0; i < 4; ++i) *(u32x4*)(smem + 16384 + kdst + i * 4096) = rk[i];
#pragma unroll
    for (int i = 0; i < 4; ++i) {
      *(u32x2*)(smem + 32768 + vdst0 + i * 4096) = (u32x2){rv[i][0], rv[i][1]};
      *(u32x2*)(smem + 32768 + vdst1 + i * 4096) = (u32x2){rv[i][2], rv[i][3]};
    }
    __syncthreads();
  }
#pragma unroll 1
  for (int t = 1; t < ntiles; ++t) {
    const int tn = (t + 1 < ntiles) ? t + 1 : t;
#pragma unroll
    for (int i = 0; i < 4; ++i) rk[i] = *(const u32x4*)(ksrc + (size_t)(tn * 64 + i * 16) * ZW);
#pragma unroll
    for (int i = 0; i < 4; ++i) rv[i] = *(const u32x4*)(vsrc + (size_t)i * 32 * NTOK + t * 64);
    ATT_S(t)
    ATT_MAX()
    if (__any(alpha != 1.f)) {
#pragma unroll
      for (int eb = 0; eb < 4; ++eb)
#pragma unroll
        for (int i = 0; i < 16; ++i) O[eb][i] *= alpha;
      lrun *= alpha;
#pragma unroll
      for (int s = 0; s < 4; ++s) {
        const u32x4 r_ = __builtin_bit_cast(u32x4, pf[s]);
        pf[s] = __builtin_bit_cast(bf16x8, (u32x4){pack2(lo16(r_[0]) * alpha, hi16(r_[0]) * alpha), pack2(lo16(r_[1]) * alpha, hi16(r_[1]) * alpha),
                                                   pack2(lo16(r_[2]) * alpha, hi16(r_[2]) * alpha), pack2(lo16(r_[3]) * alpha, hi16(r_[3]) * alpha)});
      }
    }
    bf16x8 pn[4];
    {
      ATT_PV(t - 1)
      ATT_EXP(pn)
#pragma unroll
      for (int i = 0; i < 16; ++i) {
        __builtin_amdgcn_sched_group_barrier(0x100, 1, 0);
        __builtin_amdgcn_sched_group_barrier(0x008, 1, 0);
        __builtin_amdgcn_sched_group_barrier(0x002, 9, 0);
      }
    }
#pragma unroll
    for (int s = 0; s < 4; ++s) pf[s] = pn[s];
    if (t + 1 < ntiles) {
      char* kd = smem + ((t + 1) & 1) * 16384;
#pragma unroll
      for (int i = 0; i < 4; ++i) *(u32x4*)(kd + kdst + i * 4096) = rk[i];
    }
    {
      char* vd = smem + 32768 + (t & 1) * 16384;
#pragma unroll
      for (int i = 0; i < 4; ++i) {
        *(u32x2*)(vd + vdst0 + i * 4096) = (u32x2){rv[i][0], rv[i][1]};
        *(u32x2*)(vd + vdst1 + i * 4096) = (u32x2){rv[i][2], rv[i][3]};
      }
    }
    __syncthreads();
  }
  ATT_PV(ntiles - 1)
  __syncthreads();
#undef ATT_S
#undef ATT_MAX
#undef ATT_EXP
#undef ATT_PV
  const float lt = lrun + __shfl_xor(lrun, 32);
  const float sc = (m ? lam : 1.0f) / lt;
  float* xo = (float*)smem + rb * 4096;
  if (m == 1) {
#pragma unroll
    for (int eb = 0; eb < 4; ++eb)
#pragma unroll
      for (int i = 0; i < 16; ++i) xo[(eb * 32 + (i & 3) + 8 * (i >> 2) + 4 * fh) * 32 + fr] = O[eb][i] * sc;
  }
  __syncthreads();
  if (m == 0) {
    float ss = 0.f;
#pragma unroll
    for (int eb = 0; eb < 4; ++eb)
#pragma unroll
      for (int i = 0; i < 16; ++i) {
        const float o = O[eb][i] * sc - xo[(eb * 32 + (i & 3) + 8 * (i >> 2) + 4 * fh) * 32 + fr];
        O[eb][i] = o; ss = fmaf(o, o, ss);
      }
    ss += __shfl_xor(ss, 32);
    const float rn = rsqrtf(ss * (1.0f / 128.0f) + EPSF) * (1.0f - lam_init);
    const float* sg = p.in[I_SUBG] + l * 512 + h * 128;
    bf16_t* yp = YAb + (size_t)myrow * 512 + h * 128;
#pragma unroll
    for (int eb = 0; eb < 4; ++eb)
#pragma unroll
      for (int q = 0; q < 4; ++q) {
        const int e = eb * 32 + 8 * q + 4 * fh;
        const float4 g = *(const float4*)(sg + e);
        *(u32x2*)(yp + e) = (u32x2){pack2(O[eb][4 * q] * rn * g.x, O[eb][4 * q + 1] * rn * g.y), pack2(O[eb][4 * q + 2] * rn * g.z, O[eb][4 * q + 3] * rn * g.w)};
      }
  }
  __syncthreads();
}

__device__ __forceinline__ int mlstm_row0(int dir, int c) {
  return (dir == 0) ? ((c < 4) ? NLAT + 64 * c : 64 * (c - 4)) : ((c < 4) ? NLAT + 64 * (3 - c) : 64 * (67 - c));
}
__device__ __forceinline__ void stage_mlgates(const Params& p, int l, const float* MGT, float* GA) {
  const int tid = otid(), w = tid >> 6, lane = tid & 63;
  const int nitems = GB * 4 * 2 * 68;
  for (int idx = blockIdx.x * 4 + w; idx < nitems; idx += gridDim.x * 4) {
    const int c = idx % 68, r1 = idx / 68, dir = r1 & 1, h = (r1 >> 1) & 3, bl = r1 >> 3;
    const int row = mlstm_row0(dir, c) + lane;
    const float* mg = MGT + ((size_t)bl * NTOK + row) * 16;
    const float li = mg[dir * 8 + h] + p.in[I_GATEB][l * 16 + dir * 8 + h];
    const float x = mg[dir * 8 + 4 + h] + p.in[I_GATEB][l * 16 + dir * 8 + 4 + h];
    const float lf = fminf(x, 0.f) - log1pf(expf(-fabsf(x)));
    float b = lf;
#pragma unroll
    for (int o = 1; o < 64; o <<= 1) {
      const float v = (dir == 0) ? __shfl_up(b, o) : __shfl_down(b, o);
      const bool ok = (dir == 0) ? (lane >= o) : (lane + o < 64);
      if (ok) b += v;
    }
    const float tot = (dir == 0) ? __shfl(b, 63) : __shfl(b, 0);
    float* ga = GA + (size_t)idx * 272;
    ga[lane] = b * 1.4426950408889634f; ga[64 + lane] = (li - b) * 1.4426950408889634f; ga[128 + lane] = expf(tot + li - b); ga[192 + lane] = expf(b);
    if (lane < 4) ga[256 + lane] = expf(tot);
  }
}

__device__ __forceinline__ void mlstm_chain_item(const Params& p, int l, const bf16_t* QMb, const bf16_t* KMb, const bf16_t* KMTb, const bf16_t* MVTb,
                                                 const float* GAc, bf16_t* HXb, int h, int dir, int ehalf, char* smem) {
  const int tid = otid(), lane = tid & 63, w = tid >> 6, fr = lane & 31, fh = lane >> 5;
  const int tb = w & 1, xb = w >> 1;
  float* fl = (float*)(smem + 73728);
  float* bs = fl; float* as_ = fl + 64; float* wgs = fl + 128; float* ebs = fl + 192; float* dec_s = fl + 256; float* nprev = fl + 272; float* npart = fl + 400;
  f32x16 CT[2];
#pragma unroll
  for (int eb = 0; eb < 2; ++eb)
#pragma unroll
    for (int i = 0; i < 16; ++i) CT[eb][i] = 0.f;
  __syncthreads();
  for (int i = tid; i < 1024; i += 256) ((u32x4*)(smem + 57344))[i] = (u32x4){0u, 0u, 0u, 0u};
  if (tid < 128) nprev[tid] = 0.f;
  const int qr = tid >> 4, qc = tid & 15;
  const int qdst = qr * 256 + ((qc ^ (qr & 15)) << 4);
  const int tr = tid >> 3, tc = tid & 7;
  const int tdst = tr * 128 + ((tc ^ ((tr >> 1) & 7)) << 4);
  const int sw16 = fr & 15, sw8 = (fr >> 1) & 7;
  u32x4 ra[4], rb[4], rc[4], rd[2];
  float4 rg = make_float4(0.f, 0.f, 0.f, 0.f);
#define ML_LOAD(C_) { const int r0_ = mlstm_row0(dir, (C_)); \
    const bf16_t* qs = QMb + (size_t)(r0_ + qr) * 512 + h * 128 + qc * 8; \
    const bf16_t* ks = KMb + (size_t)(r0_ + qr) * 512 + h * 128 + qc * 8; \
    const bf16_t* kts = KMTb + ((size_t)h * 128 + tr) * NTOK + r0_ + tc * 8; \
    const bf16_t* vts = MVTb + ((size_t)h * 128 + ehalf * 64 + tr) * NTOK + r0_ + tc * 8; \
    _Pragma("unroll") for (int i = 0; i < 4; ++i) { ra[i] = *(const u32x4*)(qs + (size_t)i * 16 * 512); rb[i] = *(const u32x4*)(ks + (size_t)i * 16 * 512); \
                                                    rc[i] = *(const u32x4*)(kts + (size_t)i * 32 * NTOK); } \
    _Pragma("unroll") for (int i = 0; i < 2; ++i) rd[i] = *(const u32x4*)(vts + (size_t)i * 32 * NTOK); \
    if (tid < 68) rg = ((const float4*)(GAc + (size_t)(C_) * 272))[tid]; }
  ML_LOAD(0)
#pragma unroll 1
  for (int c = 0; c < 68; ++c) {
    const int row0 = mlstm_row0(dir, c);
    __syncthreads();
#pragma unroll
    for (int i = 0; i < 4; ++i) {
      *(u32x4*)(smem + qdst + i * 4096) = ra[i];
      *(u32x4*)(smem + 16384 + qdst + i * 4096) = rb[i];
      *(u32x4*)(smem + 32768 + tdst + i * 4096) = rc[i];
    }
#pragma unroll
    for (int i = 0; i < 2; ++i) *(u32x4*)(smem + 49152 + tdst + i * 4096) = rd[i];
    if (tid < 68) ((float4*)fl)[tid] = rg;
    if (c + 1 < 68) ML_LOAD(c + 1)
    __syncthreads();
    const int t = tb * 32 + fr;
    bf16x8 qf[8];
#pragma unroll
    for (int ks = 0; ks < 8; ++ks) qf[ks] = *(const bf16x8*)(smem + t * 256 + (((ks * 2 + fh) ^ sw16) << 4));
    const float bt = bs[t], ebt = ebs[t];
    f32x16 S[2];
    float dsum = 0.f;
#pragma unroll
    for (int sb = 0; sb < 2; ++sb) {
#pragma unroll
      for (int i = 0; i < 16; ++i) S[sb][i] = 0.f;
      const bool valid = (dir == 0) ? (sb <= tb) : (sb >= tb);
      if (valid) {
#pragma unroll
        for (int ks = 0; ks < 8; ++ks) {
          const bf16x8 kf = *(const bf16x8*)(smem + 16384 + (sb * 32 + fr) * 256 + (((ks * 2 + fh) ^ sw16) << 4));
          S[sb] = __builtin_amdgcn_mfma_f32_32x32x16_bf16(kf, qf[ks], S[sb], 0, 0, 0);
        }
#pragma unroll
        for (int q = 0; q < 4; ++q) {
          const float4 a4 = *(const float4*)(as_ + sb * 32 + 8 * q + 4 * fh);
          const float av[4] = {a4.x, a4.y, a4.z, a4.w};
#pragma unroll
          for (int j = 0; j < 4; ++j) {
            const int s = sb * 32 + 8 * q + 4 * fh + j;
            const bool ok = (dir == 0) ? (s <= t) : (s >= t);
            const float v = ok ? S[sb][4 * q + j] * __builtin_amdgcn_exp2f(bt + av[j]) : 0.f;
            S[sb][4 * q + j] = v;
            dsum += v;
          }
        }
      }
    }
    bf16x8 pf[4];
#pragma unroll
    for (int sb = 0; sb < 2; ++sb)
#pragma unroll
      for (int hh = 0; hh < 2; ++hh)
        pf[sb * 2 + hh] = __builtin_bit_cast(bf16x8, (u32x4){pack2(S[sb][8 * hh], S[sb][8 * hh + 1]), pack2(S[sb][8 * hh + 2], S[sb][8 * hh + 3]),
                                                                 pack2(S[sb][8 * hh + 4], S[sb][8 * hh + 5]), pack2(S[sb][8 * hh + 6], S[sb][8 * hh + 7])});
    float nq = 0.f;
#pragma unroll
    for (int c8 = 0; c8 < 8; ++c8) {
      const u32x4 qv = *(const u32x4*)(smem + t * 256 + (((fh * 8 + c8) ^ sw16) << 4));
      const float4 n0 = *(const float4*)(nprev + fh * 64 + c8 * 8), n1 = *(const float4*)(nprev + fh * 64 + c8 * 8 + 4);
      nq = fmaf(lo16(qv[0]), n0.x, nq); nq = fmaf(hi16(qv[0]), n0.y, nq); nq = fmaf(lo16(qv[1]), n0.z, nq); nq = fmaf(hi16(qv[1]), n0.w, nq);
      nq = fmaf(lo16(qv[2]), n1.x, nq); nq = fmaf(hi16(qv[2]), n1.y, nq); nq = fmaf(lo16(qv[3]), n1.z, nq); nq = fmaf(hi16(qv[3]), n1.w, nq);
    }
    dsum += __shfl_xor(dsum, 32);
    nq += __shfl_xor(nq, 32);
    const float den = dsum + ebt * nq;
    const float inv = 1.0f / fmaxf(fabsf(den), 1.0f);
    {
      f32x16 N;
#pragma unroll
      for (int i = 0; i < 16; ++i) N[i] = 0.f;
#pragma unroll
      for (int ks = 0; ks < 8; ++ks) {
        const bf16x8 cf = *(const bf16x8*)(smem + 57344 + (xb * 32 + fr) * 256 + (((ks * 2 + fh) ^ sw16) << 4));
        N = __builtin_amdgcn_mfma_f32_32x32x16_bf16(cf, qf[ks], N, 0, 0, 0);
      }
#pragma unroll
      for (int i = 0; i < 16; ++i) N[i] *= ebt;
#pragma unroll
      for (int s4 = 0; s4 < 4; ++s4) {
        const bool valid = (dir == 0) ? ((s4 >> 1) <= tb) : ((s4 >> 1) >= tb);
        if (valid) {
          const int u0 = 4 * s4 + fh, u1 = u0 + 2;
          const char* vrow = smem + 49152 + (xb * 32 + fr) * 128;
          const u32x2 v0 = *(const u32x2*)(vrow + (((u0 >> 1) ^ sw8) << 4) + (u0 & 1) * 8);
          const u32x2 v1 = *(const u32x2*)(vrow + (((u1 >> 1) ^ sw8) << 4) + (u1 & 1) * 8);
          const bf16x8 vf = __builtin_bit_cast(bf16x8, (u32x4){v0[0], v0[1], v1[0], v1[1]});
          N = __builtin_amdgcn_mfma_f32_32x32x16_bf16(vf, pf[s4], N, 0, 0, 0);
        }
      }
      bf16_t* hp = HXb + (size_t)(row0 + t) * 512 + h * 128 + (2 * ehalf + xb) * 32 + 4 * fh;
#pragma unroll
      for (int q = 0; q < 4; ++q)
        *(u32x2*)(hp + 8 * q) = (u32x2){pack2(N[4 * q] * inv, N[4 * q + 1] * inv), pack2(N[4 * q + 2] * inv, N[4 * q + 3] * inv)};
    }
    const float decay = *dec_s;
#pragma unroll
    for (int eb = 0; eb < 2; ++eb)
#pragma unroll
      for (int i = 0; i < 16; ++i) CT[eb][i] *= decay;
#pragma unroll
    for (int ks = 0; ks < 4; ++ks) {
      const u32x4 kraw = *(const u32x4*)(smem + 32768 + (w * 32 + fr) * 128 + (((ks * 2 + fh) ^ sw8) << 4));
      const float4 g0 = *(const float4*)(wgs + ks * 16 + 8 * fh), g1 = *(const float4*)(wgs + ks * 16 + 8 * fh + 4);
      const bf16x8 kts = __builtin_bit_cast(bf16x8, (u32x4){pack2(lo16(kraw[0]) * g0.x, hi16(kraw[0]) * g0.y), pack2(lo16(kraw[1]) * g0.z, hi16(kraw[1]) * g0.w),
                                                             pack2(lo16(kraw[2]) * g1.x, hi16(kraw[2]) * g1.y), pack2(lo16(kraw[3]) * g1.z, hi16(kraw[3]) * g1.w)});
#pragma unroll
      for (int eb = 0; eb < 2; ++eb) {
        const bf16x8 vt = *(const bf16x8*)(smem + 49152 + (eb * 32 + fr) * 128 + (((ks * 2 + fh) ^ sw8) << 4));
        CT[eb] = __builtin_amdgcn_mfma_f32_32x32x16_bf16(kts, vt, CT[eb], 0, 0, 0);
      }
    }
    {
      const int d = tid & 127, sh = tid >> 7;
      float a = 0.f;
#pragma unroll 8
      for (int s = sh * 32; s < sh * 32 + 32; ++s) {
        const bf16_t kv = *(const bf16_t*)(smem + 16384 + s * 256 + ((((d >> 3)) ^ (s & 15)) << 4) + (d & 7) * 2);
        a = fmaf(wgs[s], bf2f(kv), a);
      }
      npart[sh * 128 + d] = a;
    }
    __syncthreads();
#pragma unroll
    for (int eb = 0; eb < 2; ++eb)
#pragma unroll
      for (int q = 0; q < 4; ++q)
        *(u32x2*)(smem + 57344 + (eb * 32 + fr) * 256 + ((((w * 4 + q)) ^ sw16) << 4) + 8 * fh) =
            (u32x2){pack2(CT[eb][4 * q], CT[eb][4 * q + 1]), pack2(CT[eb][4 * q + 2], CT[eb][4 * q + 3])};
    if (tid < 128) nprev[tid] = decay * nprev[tid] + npart[tid] + npart[128 + tid];
  }
#undef ML_LOAD
  __syncthreads();
}

#define S5SEG 128
#define S5NSEG 34
__device__ __forceinline__ int s5_row(int dir, int step) {
  return (dir == 0) ? ((step < NCTX) ? NLAT + step : step - NCTX)
                    : ((step < NCTX) ? NLAT + (NCTX - 1 - step) : (NLAT - 1) - (step - NCTX));
}
__device__ __forceinline__ bf16x8 pack8(const float* f) {
  return __builtin_bit_cast(bf16x8, (u32x4){pack2(f[0], f[1]), pack2(f[2], f[3]), pack2(f[4], f[5]), pack2(f[6], f[7])});
}
struct S5M { float abr, abi, a128r, a128i; bf16x8 bbf[4]; };
__device__ __forceinline__ void s5m_setup(const Params& p, int pg, int lane, S5M& m) {
  const int fr = lane & 31, fh = lane >> 5;
  const float dt = expf(p.in[I_S5DT][pg]);
  m.abr = 0.f; m.abi = 0.f; m.a128r = 0.f; m.a128i = 0.f;
#pragma unroll
  for (int c = 0; c < 2; ++c) {
    const int n = fr + 32 * c;
    const float lre = p.in[I_S5LRE][pg * 64 + n], lim = p.in[I_S5LIM][pg * 64 + n];
    const float mag = expf(lre * dt);
    const float abr = mag * cosf(lim * dt), abi = mag * sinf(lim * dt);
    const float den = lre * lre + lim * lim;
    const float zr = ((abr - 1.0f) * lre + abi * lim) / den;
    const float zi = (abi * lre - (abr - 1.0f) * lim) / den;
    const float4* br4 = (const float4*)(p.in[I_S5BRE] + ((size_t)pg * 64 + n) * 16 + 8 * fh);
    const float4* bi4 = (const float4*)(p.in[I_S5BIM] + ((size_t)pg * 64 + n) * 16 + 8 * fh);
    const float4 b0 = br4[0], b1 = br4[1], c0 = bi4[0], c1 = bi4[1];
    const float br[8] = {b0.x, b0.y, b0.z, b0.w, b1.x, b1.y, b1.z, b1.w}, bi[8] = {c0.x, c0.y, c0.z, c0.w, c1.x, c1.y, c1.z, c1.w};
    float rr[8], ii[8];
#pragma unroll
    for (int j = 0; j < 8; ++j) { rr[j] = zr * br[j] - zi * bi[j]; ii[j] = zr * bi[j] + zi * br[j]; }
    m.bbf[c] = pack8(rr); m.bbf[2 + c] = pack8(ii);
    if (fh == c) {
      m.abr = abr; m.abi = abi;
      const float mg = expf(lre * dt * (float)S5SEG);
      m.a128r = mg * cosf(lim * dt * (float)S5SEG); m.a128i = mg * sinf(lim * dt * (float)S5SEG);
    }
  }
}
template <bool STORE>
__device__ __forceinline__ void s5m_block(const S5M& m, const bf16x8 uf, float& xr, float& xi, char* xs, int lane) {
  f32x16 T[4];
#pragma unroll
  for (int k = 0; k < 4; ++k) {
#pragma unroll
    for (int i = 0; i < 16; ++i) T[k][i] = 0.f;
    T[k] = __builtin_amdgcn_mfma_f32_32x32x16_bf16(uf, m.bbf[k], T[k], 0, 0, 0);
  }
#pragma unroll
  for (int r = 0; r < 16; ++r) {
    auto a = __builtin_amdgcn_permlane32_swap(__float_as_uint(T[0][r]), __float_as_uint(T[1][r]), false, false);
    T[0][r] = __uint_as_float(a[0]); T[1][r] = __uint_as_float(a[1]);
    auto b = __builtin_amdgcn_permlane32_swap(__float_as_uint(T[2][r]), __float_as_uint(T[3][r]), false, false);
    T[2][r] = __uint_as_float(b[0]); T[3][r] = __uint_as_float(b[1]);
  }
#pragma unroll
  for (int q = 0; q < 4; ++q)
#pragma unroll
    for (int hh = 0; hh < 2; ++hh)
#pragma unroll
      for (int j = 0; j < 4; ++j) {
        const int t = 8 * q + 4 * hh + j, r = 4 * q + j;
        const float bre = hh ? T[1][r] : T[0][r], bim = hh ? T[3][r] : T[2][r];
        const float nr = fmaf(m.abr, xr, fmaf(-m.abi, xi, bre));
        const float ni = fmaf(m.abr, xi, fmaf(m.abi, xr, bim));
        xr = nr; xi = ni;
        if (STORE) *(unsigned*)(xs + t * 256 + (((lane >> 2) ^ (t & 15)) << 4) + (lane & 3) * 4) = pack2(xr, xi);
      }
}
__device__ __forceinline__ void stage_s5_pass1(const Params& p, int l, const bf16_t* Z, float* XE) {
  const int tid = otid(), w = tid >> 6, lane = tid & 63, fr = lane & 31, fh = lane >> 5;
  const int nitems = GB * 32 * 2 * (S5NSEG - 1);
  for (int idx = blockIdx.x * 4 + w; idx < nitems; idx += gridDim.x * 4) {
    const int seg = idx % (S5NSEG - 1), r1 = idx / (S5NSEG - 1), dir = r1 & 1, g = (r1 >> 1) & 31, bl = r1 >> 6;
    S5M m;
    s5m_setup(p, (l * 2 + dir) * 32 + g, lane, m);
    float xr = 0.f, xi = 0.f;
    bf16x8 ufs[S5SEG / 32];
#pragma unroll
    for (int sub = 0; sub < S5SEG / 32; ++sub) {
      const int row = s5_row(dir, seg * S5SEG + sub * 32 + fr);
      ufs[sub] = *(const bf16x8*)(Z + ((size_t)bl * NTOK + row) * ZW + 3072 + g * 16 + 8 * fh);
    }
#pragma unroll
    for (int sub = 0; sub < S5SEG / 32; ++sub) s5m_block<false>(m, ufs[sub], xr, xi, nullptr, lane);
    float* xe = XE + ((((size_t)bl * 32 + g) * 2 + dir) * (S5NSEG - 1) + seg) * 128;
    xe[lane] = xr; xe[64 + lane] = xi;
  }
}
__device__ __forceinline__ void s5_item(const Params& p, int l, const bf16_t* Zb, const float* XEc, float* Yb, int g, int dir, int sq, char* smem) {
  const int tid = otid(), w = tid >> 6, lane = tid & 63, fr = lane & 31, fh = lane >> 5;
  const int seg = sq * 4 + w;
  char* xs = smem + w * 8192;
  const int pg = (l * 2 + dir) * 32 + g;
  __syncthreads();
  if (seg < S5NSEG) {
    S5M m;
    s5m_setup(p, pg, lane, m);
    bf16x8 ccf[8];
#pragma unroll
    for (int ks = 0; ks < 8; ++ks) {
      float f[8] = {0.f, 0.f, 0.f, 0.f, 0.f, 0.f, 0.f, 0.f};
      if (fr < 16) {
        const float4 cr = *(const float4*)(p.in[I_S5CRE] + ((size_t)pg * 16 + fr) * 64 + ks * 8 + 4 * fh);
        const float4 ci = *(const float4*)(p.in[I_S5CIM] + ((size_t)pg * 16 + fr) * 64 + ks * 8 + 4 * fh);
        f[0] = cr.x; f[1] = -ci.x; f[2] = cr.y; f[3] = -ci.y; f[4] = cr.z; f[5] = -ci.z; f[6] = cr.w; f[7] = -ci.w;
      }
      ccf[ks] = pack8(f);
    }
    float xr = 0.f, xi = 0.f;
    for (int j = 0; j < seg; ++j) {
      const float er = XEc[j * 128 + lane], ei = XEc[j * 128 + 64 + lane];
      const float nr = m.a128r * xr - m.a128i * xi + er, ni = m.a128r * xi + m.a128i * xr + ei;
      xr = nr; xi = ni;
    }
    bf16x8 ufs[S5SEG / 32];
#pragma unroll
    for (int sub = 0; sub < S5SEG / 32; ++sub) {
      const int row = s5_row(dir, seg * S5SEG + sub * 32 + fr);
      ufs[sub] = *(const bf16x8*)(Zb + (size_t)row * ZW + 3072 + g * 16 + 8 * fh);
    }
#pragma unroll
    for (int sub = 0; sub < S5SEG / 32; ++sub) {
      const int row = s5_row(dir, seg * S5SEG + sub * 32 + fr);
      const bf16x8 uf = ufs[sub];
      s5m_block<true>(m, uf, xr, xi, xs, lane);
      f32x16 Y;
#pragma unroll
      for (int i = 0; i < 16; ++i) Y[i] = 0.f;
#pragma unroll
      for (int ks = 0; ks < 8; ++ks) {
        const bf16x8 xf = *(const bf16x8*)(xs + fr * 256 + (((ks * 2 + fh) ^ (fr & 15)) << 4));
        Y = __builtin_amdgcn_mfma_f32_32x32x16_bf16(ccf[ks], xf, Y, 0, 0, 0);
      }
      float* yp = Yb + (size_t)row * 512 + g * 16 + 4 * fh;
      *(float4*)yp = make_float4(Y[0], Y[1], Y[2], Y[3]);
      *(float4*)(yp + 8) = make_float4(Y[4], Y[5], Y[6], Y[7]);
    }
  }
}

__device__ __forceinline__ void stage_post(const Params& p, int l, int rr_lim, const bf16_t* Z, const bf16_t* HF, const bf16_t* HB,
                                           const float* YSF, const float* YSB, bf16_t* YB, bf16_t* GG) {
  const int tid = otid();
  const int c0 = tid * 2;
  const float2 gml = *(const float2*)(p.in[I_MLNG] + l * 512 + c0);
  const float2 dsk = *(const float2*)(p.in[I_S5D] + l * 512 + c0);
  const int n = GB * rr_lim;
  for (int i0 = blockIdx.x * 4; i0 < n; i0 += gridDim.x * 4) {
    unsigned a0[4], a1[4], og[4], uu[4];
    float2 f[4], b[4];
    size_t r[4];
#pragma unroll
    for (int u = 0; u < 4; ++u) {
      const int i = i0 + u;
      r[u] = (size_t)(i / rr_lim) * NTOK + (i % rr_lim);
      a0[u] = *(const unsigned*)(HF + r[u] * 512 + c0); a1[u] = *(const unsigned*)(HB + r[u] * 512 + c0);
      og[u] = *(const unsigned*)(Z + r[u] * ZW + 2560 + c0); uu[u] = *(const unsigned*)(Z + r[u] * ZW + 3072 + c0);
      f[u] = *(const float2*)(YSF + r[u] * 512 + c0); b[u] = *(const float2*)(YSB + r[u] * 512 + c0);
    }
#pragma unroll
    for (int u = 0; u < 4; ++u) {
      const float h0 = lo16(a0[u]) + lo16(a1[u]), h1 = hi16(a0[u]) + hi16(a1[u]);
      const float ss = wave_sum(h0 * h0 + h1 * h1);
      const float rs = rsqrtf(ss * (1.0f / 128.0f) + EPSF);
      *(unsigned*)(YB + r[u] * 512 + c0) = pack2(h0 * rs * gml.x * sigmoidf_(lo16(og[u])), h1 * rs * gml.y * sigmoidf_(hi16(og[u])));
      *(unsigned*)(GG + r[u] * 512 + c0) = pack2(geluf_(dsk.x * lo16(uu[u]) + f[u].x + b[u].x), geluf_(dsk.y * hi16(uu[u]) + f[u].y + b[u].y));
    }
  }
}

__device__ __forceinline__ void stage_glu_mfma(const Params& p, int l, int tpb, const bf16_t* GG, const bf16_t* GLUT, bf16_t* YS, char* smem) {
  EPI_DECL
  const int tm = GB * tpb;
  TileIter ti(tm, 4);
  int mt_, nt_; bool valid;
  while (ti.next(mt_, nt_, valid)) {
    if (!valid) continue;
    const int m0 = MT_LR0(mt_, tpb), n0 = nt_ * 128;
    f32x16 acc[2][2];
    gemm_tile(GG + (size_t)m0 * 512, 512, GLUT + (size_t)n0 * 512, 512, 512, smem, acc);
#pragma unroll
    for (int mi = 0; mi < 2; ++mi)
#pragma unroll
      for (int ni = 0; ni < 2; ++ni)
#pragma unroll
        for (int q = 0; q < 4; ++q) {
          const int row = m0 + EPI_ROW(mi), c = n0 + EPI_COL(ni, q);
          const float4 b = *(const float4*)(p.in[I_GLUB] + l * 512 + c);
          const u32x2 g2 = *(const u32x2*)(GG + (size_t)row * 512 + c);
          const float o0 = lo16(g2[0]) * sigmoidf_(acc[mi][ni][4 * q] + b.x), o1 = hi16(g2[0]) * sigmoidf_(acc[mi][ni][4 * q + 1] + b.y);
          const float o2 = lo16(g2[1]) * sigmoidf_(acc[mi][ni][4 * q + 2] + b.z), o3 = hi16(g2[1]) * sigmoidf_(acc[mi][ni][4 * q + 3] + b.w);
          *(u32x2*)(YS + (size_t)row * 512 + c) = (u32x2){pack2(o0, o1), pack2(o2, o3)};
        }
  }
}

__device__ __forceinline__ void stage_merge_mfma(int tpb, const bf16_t* YA, const bf16_t* YB, const bf16_t* YS, const bf16_t* WBR, const bf16_t* Z, bf16_t* MG, char* smem) {
  EPI_DECL
  const int tm = GB * tpb;
  TileIter ti(tm, 8);
  int mt_, nt_; bool valid;
  while (ti.next(mt_, nt_, valid)) {
    if (!valid) continue;
    const int m0 = MT_LR0(mt_, tpb), n0 = nt_ * 128;
    f32x16 macc[2][2];
#pragma unroll
    for (int a = 0; a < 2; ++a)
#pragma unroll
      for (int b = 0; b < 2; ++b)
#pragma unroll
        for (int i = 0; i < 16; ++i) macc[a][b][i] = 0.f;
#pragma unroll 1
    for (int r = 0; r < 3; ++r) {
      const bf16_t* Y = (r == 0) ? YA : (r == 1 ? YB : YS);
      f32x16 acc[2][2];
      gemm_tile(Y + (size_t)m0 * 512, 512, WBR + (size_t)r * 1024 * 512 + (size_t)n0 * 512, 512, 512, smem, acc);
#pragma unroll
      for (int mi = 0; mi < 2; ++mi)
#pragma unroll
        for (int ni = 0; ni < 2; ++ni)
#pragma unroll
          for (int q = 0; q < 4; ++q) {
            const int row = m0 + EPI_ROW(mi), c = n0 + EPI_COL(ni, q);
            const u32x2 e = *(const u32x2*)(Z + (size_t)row * ZW + 3584 + r * 1024 + c);
            macc[mi][ni][4 * q] += lo16(e[0]) * acc[mi][ni][4 * q];
            macc[mi][ni][4 * q + 1] += hi16(e[0]) * acc[mi][ni][4 * q + 1];
            macc[mi][ni][4 * q + 2] += lo16(e[1]) * acc[mi][ni][4 * q + 2];
            macc[mi][ni][4 * q + 3] += hi16(e[1]) * acc[mi][ni][4 * q + 3];
          }
    }
#pragma unroll
    for (int mi = 0; mi < 2; ++mi)
#pragma unroll
      for (int ni = 0; ni < 2; ++ni)
#pragma unroll
        for (int q = 0; q < 4; ++q) {
          const int row = m0 + EPI_ROW(mi), c = n0 + EPI_COL(ni, q);
          *(u32x2*)(MG + (size_t)row * DM + c) = (u32x2){pack2(macc[mi][ni][4 * q], macc[mi][ni][4 * q + 1]), pack2(macc[mi][ni][4 * q + 2], macc[mi][ni][4 * q + 3])};
        }
  }
}

__device__ __forceinline__ void stage_outproj_mfma(const Params& p, int l, int g, int tpb, const bf16_t* MG, const bf16_t* WOUT, char* smem) {
  EPI_DECL
  const int tm = GB * tpb;
  const float* mod = (const float*)(p.ws + WB_MOD) + (size_t)l * 9 * 6144;
  TileIter ti(tm, 8);
  int mt, nt_; bool valid;
  while (ti.next(mt, nt_, valid)) {
    if (!valid) continue;
    const int n0 = nt_ * 128;
    const int m0 = MT_LR0(mt, tpb), bl = mt / tpb, rr0 = (mt % tpb) * 128, b = g * GB + bl;
    f32x16 acc[2][2];
    gemm_tile(MG + (size_t)m0 * DM, DM, WOUT + (size_t)n0 * DM, DM, DM, smem, acc);
    const float* gv = mod + (size_t)((rr0 < NLAT) ? b : 8) * 6144 + 2 * 1024;
#pragma unroll
    for (int mi = 0; mi < 2; ++mi)
#pragma unroll
      for (int ni = 0; ni < 2; ++ni)
#pragma unroll
        for (int q = 0; q < 4; ++q) {
          const int rr = rr0 + EPI_ROW(mi), c = n0 + EPI_COL(ni, q);
          const float4 gg = *(const float4*)(gv + c);
          float4* xp = (float4*)(xrow(p, b, rr) + c);
          float4 x = (l == 0) ? *(const float4*)(xrow_in(p, b, rr) + c) : *xp;
          x.x += gg.x * acc[mi][ni][4 * q]; x.y += gg.y * acc[mi][ni][4 * q + 1]; x.z += gg.z * acc[mi][ni][4 * q + 2]; x.w += gg.w * acc[mi][ni][4 * q + 3];
          *xp = x;
        }
  }
}

__device__ __forceinline__ void stage_peerq_mfma(int tpb, const bf16_t* H2, const bf16_t* WQ, bf16_t* PQ, char* smem) {
  EPI_DECL
  const int tm = GB * tpb;
  TileIter ti(tm, 16);
  int mt_, nt_; bool valid;
  while (ti.next(mt_, nt_, valid)) {
    if (!valid) continue;
    const int m0 = MT_LR0(mt_, tpb), n0 = nt_ * 128;
    f32x16 acc[2][2];
    gemm_tile(H2 + (size_t)m0 * DM, DM, WQ + (size_t)n0 * DM, DM, DM, smem, acc);
#pragma unroll
    for (int mi = 0; mi < 2; ++mi)
#pragma unroll
      for (int ni = 0; ni < 2; ++ni)
#pragma unroll
        for (int q = 0; q < 4; ++q) {
          const int row = m0 + EPI_ROW(mi), c = n0 + EPI_COL(ni, q);
          *(u32x2*)(PQ + (size_t)row * 2048 + c) = (u32x2){pack2(acc[mi][ni][4 * q], acc[mi][ni][4 * q + 1]), pack2(acc[mi][ni][4 * q + 2], acc[mi][ni][4 * q + 3])};
        }
  }
}

__device__ __forceinline__ unsigned f2sortable(float x) { const unsigned u = __float_as_uint(x); return (u & 0x80000000u) ? ~u : (u | 0x80000000u); }
__device__ __forceinline__ float sortable2f(unsigned k) { return __uint_as_float((k & 0x80000000u) ? (k & 0x7fffffffu) : ~k); }
#define TOPK_INSERT(v, key) { unsigned t_ = (key); _Pragma("unroll") for (int s_ = 0; s_ < 16; ++s_) { const unsigned hi_ = max(v[s_], t_); t_ = min(v[s_], t_); v[s_] = hi_; } }
__device__ __forceinline__ void stage_scores_topk(int tpb, const bf16_t* PQ, const bf16_t* SUBK, int* EI, float* EG, char* smem) {
  EPI_DECL
  const int tid = tid_;
  const int item = tid & 127, kpart = tid >> 7;
  float* S = (float*)smem;
  unsigned* xk = (unsigned*)(smem + 128 * 129 * 4);
  const int tm = GB * tpb * 8;
  for (int mt = blockIdx.x; mt < tm; mt += gridDim.x) {
    const size_t m0 = (size_t)MT_LR0(mt >> 3, tpb) * 8 + (size_t)(mt & 7) * 128;
    unsigned vh[2][16];
#pragma unroll
    for (int half = 0; half < 2; ++half) {
      f32x16 acc[2][2];
      gemm_tile(PQ + m0 * 256 + half * 128, 256, SUBK + (size_t)half * 16384, 128, 128, smem, acc);
#pragma unroll
      for (int mi = 0; mi < 2; ++mi)
#pragma unroll
        for (int ni = 0; ni < 2; ++ni)
#pragma unroll
          for (int i = 0; i < 16; ++i)
            S[EPI_ROW(mi) * 129 + wn * 64 + ni * 32 + 8 * (i >> 2) + 4 * fh + (i & 3)] = acc[mi][ni][i];
      __syncthreads();
      unsigned v[16];
#pragma unroll
      for (int s = 0; s < 16; ++s) v[s] = 0u;
      const float* sr = S + item * 129 + kpart * 64;
#pragma unroll 8
      for (int k = 0; k < 64; ++k) {
        const unsigned key = (f2sortable(sr[k]) & ~127u) | (unsigned)(127 - (kpart * 64 + k));
        TOPK_INSERT(v, key)
      }
      if (kpart == 1) {
#pragma unroll
        for (int s = 0; s < 16; ++s) xk[item * 17 + s] = v[s];
      }
      __syncthreads();
      if (kpart == 0) {
#pragma unroll
        for (int s = 0; s < 16; ++s) { const unsigned key = xk[item * 17 + s]; TOPK_INSERT(v, key) }
      }
#pragma unroll
      for (int s = 0; s < 16; ++s) vh[half][s] = v[s];
      __syncthreads();
    }
    if (kpart == 0) {
      float v1[16], v2[16];
#pragma unroll
      for (int s = 0; s < 16; ++s) { v1[s] = sortable2f((vh[0][s] & ~127u) | 64u); v2[s] = sortable2f((vh[1][s] & ~127u) | 64u); }
      unsigned c[16];
#pragma unroll
      for (int s = 0; s < 16; ++s) c[s] = 0u;
      {
        int o = 0;
#pragma unroll
        for (int i = 0; i < 16; ++i)
#pragma unroll
          for (int j = 0; j < 16 / (i + 1); ++j) {
            const unsigned key = (f2sortable(v1[i] + v2[j]) & ~63u) | (unsigned)(63 - o);
            TOPK_INSERT(c, key)
            ++o;
          }
      }
      const float vmax = sortable2f((c[0] & ~63u) | 32u);
      float sum = 0.f;
#pragma unroll
      for (int s = 0; s < 16; ++s) sum += expf(sortable2f((c[s] & ~63u) | 32u) - vmax);
      const float isum = 1.0f / sum;
      const unsigned thr = c[15];
      int* ei = EI + (m0 + item) * 16;
      float* eg = EG + (m0 + item) * 16;
      int cntw = 0;
      {
        int o = 0;
#pragma unroll
        for (int i = 0; i < 16; ++i)
#pragma unroll
          for (int j = 0; j < 16 / (i + 1); ++j) {
            const unsigned key = (f2sortable(v1[i] + v2[j]) & ~63u) | (unsigned)(63 - o);
            if (key >= thr) {
              ei[cntw] = (int)((127u - (vh[0][i] & 127u)) * 128u + (127u - (vh[1][j] & 127u)));
              eg[cntw] = expf(sortable2f((key & ~63u) | 32u) - vmax) * isum;
              ++cntw;
            }
            ++o;
          }
      }
    }
  }
  __syncthreads();
}

#define DPPF(x, ctrl) __uint_as_float((unsigned)__builtin_amdgcn_update_dpp(0, (int)__float_as_uint(x), (ctrl), 0xf, 0xf, true))
#define XP_HALVE(n, bit, ctrl) { _Pragma("unroll") for (int j_ = 0; j_ < (n); ++j_) { const float keep_ = (bit) ? a[j_ + (n)] : a[j_]; const float send_ = (bit) ? a[j_] : a[j_ + (n)]; a[j_] = keep_ + DPPF(send_, ctrl); } }
#define XP_ROW(TAB, E, PR) { const int e0_ = __builtin_amdgcn_readlane((E), 2 * (PR)), e1_ = __builtin_amdgcn_readlane((E), 2 * (PR) + 1); \
    const char* rp_ = (TAB) + (size_t)(hw ? e1_ : e0_) * 768 + hl * 24; \
    const u32x4_u x_ = *(const u32x4_u*)rp_; const u32x2 y_ = *(const u32x2*)(rp_ + 16); \
    ra[PR] = (v6u){x_[0], x_[1], x_[2], x_[3], y_[0], y_[1]}; }
#define XP_META(PAR, T, E, G, HP) { const size_t mo_ = ((size_t)(PAR) * RPG + (T)) * 128 + w * 32 + hl; \
    E = ((const int*)(p.ws + WB_EI))[mo_]; G = ((const float*)(p.ws + WB_EG))[mo_]; \
    const u32x4* hr_ = (const u32x4*)((const bf16_t*)(p.ws + WB_H2) + ((size_t)(PAR) * RPG + (T)) * DM + hl * 32); \
    _Pragma("unroll") for (int c_ = 0; c_ < 4; ++c_) HP[c_] = hr_[c_]; }
__device__ __forceinline__ void unpack8(const u32x4 v, float* f) {
#pragma unroll
  for (int k = 0; k < 4; ++k) { f[2 * k] = lo16(v[k]); f[2 * k + 1] = hi16(v[k]); }
}
__device__ __forceinline__ int xp_pool_n(int q) { return GB * ((q < NG) ? NTOK : NLAT); }
__device__ __forceinline__ int xp_claim(int* pool, int& qa, int hi) {
  while (qa <= hi) {
    const int n = xp_pool_n(qa);
    if (__hip_atomic_load(pool + qa, __ATOMIC_RELAXED, __HIP_MEMORY_SCOPE_AGENT) < n) {
      const int i = atomicAdd(pool + qa, 1);
      if (i < n) return qa * 65536 + i;
    }
    ++qa;
  }
  return -1;
}
__device__ __forceinline__ void xp_decode(int tok, int& l, int& par, int& b, int& rr, int& t) {
  const int q = tok >> 16, i = tok & 65535;
  l = q / NG;
  const int g = q % NG, rr_lim = (l == 0) ? NTOK : NLAT, bl = i / rr_lim;
  rr = i % rr_lim; b = g * GB + bl; t = bl * NTOK + rr; par = q & 1;
}
__device__ __forceinline__ void expert_run(const Params& p, int lo, int hi, unsigned* ctr, unsigned epoch, const bool steal, int& pend, float* smem) {
  if (lo < 0) lo = 0;
  if (hi < lo) return;
  const int tid = otid(), w = tid >> 6, lane = tid & 63, hl = lane & 31, hw = lane >> 5;
  int* s_tok = (int*)(smem + SMEM_FLOATS - 8);
  int* pool = (int*)(p.ws + WB_POOL);
  float* part = smem;
  int qa = lo, ci = 0;
  bool cpend = false;
  unsigned cb = 0;
  int cur = pend; pend = -1;
  if (cur < 0) {
    __syncthreads();
    if (tid == 0) s_tok[2] = xp_claim(pool, qa, hi);
    __syncthreads();
    cur = __builtin_amdgcn_readfirstlane(s_tok[2]);
  }
  if (cur < 0) return;
  if (tid == 0 && qa <= hi) { ci = atomicAdd(pool + qa, 1); cpend = true; }
  int l, par, b, rr, t;
  xp_decode(cur, l, par, b, rr, t);
  int e_c; float g_c; u32x4 hp[4];
  XP_META(par, t, e_c, g_c, hp)
  v6u ra[16];
  {
    const char* U = p.ws + WB_U16 + (size_t)l * 16384 * 768;
#pragma unroll
    for (int pr = 0; pr < 16; ++pr) XP_ROW(U, e_c, pr)
  }
  for (;;) {
    const float* mod = (const float*)(p.ws + WB_MOD) + (size_t)l * 9 * 6144;
    const float4 g2 = ((const float4*)(mod + (size_t)((rr < NLAT) ? b : 8) * 6144 + 5 * 1024))[tid];
    float4* xp = (float4*)xrow(p, b, rr) + tid;
    float4 xv = *xp;
    if (tid == 0) {
      int r = -1;
      if (cpend) {
        if (ci < xp_pool_n(qa)) r = qa * 65536 + ci;
        else { ++qa; r = xp_claim(pool, qa, hi); }
      }
      const int st = (steal && cb + 1u >= epoch) ? 1 : 0;
      s_tok[0] = r; s_tok[1] = st;
      cpend = false;
      if (!st && r >= 0 && qa <= hi) { ci = atomicAdd(pool + qa, 1); cpend = true; }
      if (steal) cb = __hip_atomic_load(ctr, __ATOMIC_RELAXED, __HIP_MEMORY_SCOPE_AGENT);
    }
    __syncthreads();
    const int nxt = __builtin_amdgcn_readfirstlane(s_tok[0]);
    const bool pf = nxt >= 0 && __builtin_amdgcn_readfirstlane(s_tok[1]) == 0;
    int ln = l, parn = 0, bn = 0, rrn = 0, tn = 0, e_n = 0;
    float g_n = 0.f;
    u32x4 hn[4];
#pragma unroll
    for (int c = 0; c < 4; ++c) hn[c] = (u32x4){0u, 0u, 0u, 0u};
    if (pf) {
      xp_decode(nxt, ln, parn, bn, rrn, tn);
      XP_META(parn, tn, e_n, g_n, hn)
    }
    const char* V = p.ws + WB_V16 + (size_t)l * 16384 * 768;
    f32x2 hq2[16];
#pragma unroll
    for (int c = 0; c < 4; ++c)
#pragma unroll
      for (int k = 0; k < 4; ++k) hq2[4 * c + k] = (f32x2){lo16(hp[c][k]), hi16(hp[c][k])};
    float a[16];
#pragma unroll
    for (int pr = 0; pr < 16; ++pr) {
      const v32f f = __builtin_amdgcn_cvt_scalef32_pk32_f32_fp6(ra[pr], 1.0f);
      f32x2 sa = {0.f, 0.f}, sb = {0.f, 0.f};
#pragma unroll
      for (int k = 0; k < 16; k += 2) {
        sa = __builtin_elementwise_fma(hq2[k], (f32x2){f[2 * k], f[2 * k + 1]}, sa);
        sb = __builtin_elementwise_fma(hq2[k + 1], (f32x2){f[2 * k + 2], f[2 * k + 3]}, sb);
      }
      a[pr] = (sa[0] + sb[0]) + (sa[1] + sb[1]);
      XP_ROW(V, e_c, pr)
    }
    {
      const bool b3 = (lane & 8) != 0, b2 = (lane & 4) != 0, b1 = (lane & 2) != 0, b0 = (lane & 1) != 0;
      XP_HALVE(8, b3, 0x128)
      XP_HALVE(4, b2, 0x141)
      XP_HALVE(2, b1, 0x4E)
      XP_HALVE(1, b0, 0xB1)
    }
    float dsum = a[0];
    dsum += __shfl_xor(dsum, 16);
    const float my_dot = __shfl(dsum, 32 * (hl & 1) + (hl >> 1));
    const float my_c = g_c * geluf_(my_dot * (1.0f / 64.0f));
    f32x2 acc2[16];
#pragma unroll
    for (int k = 0; k < 16; ++k) acc2[k] = (f32x2){0.f, 0.f};
    {
      const char* Un = p.ws + WB_U16 + (size_t)ln * 16384 * 768;
#pragma unroll
      for (int pr = 0; pr < 16; ++pr) {
        const float c0 = __uint_as_float(__builtin_amdgcn_readlane(__float_as_uint(my_c), 2 * pr)), c1 = __uint_as_float(__builtin_amdgcn_readlane(__float_as_uint(my_c), 2 * pr + 1));
        const float c = hw ? c1 : c0;
        const f32x2 cc = {c, c};
        const v32f f = __builtin_amdgcn_cvt_scalef32_pk32_f32_fp6(ra[pr], 1.0f);
#pragma unroll
        for (int k = 0; k < 16; ++k) acc2[k] = __builtin_elementwise_fma(cc, (f32x2){f[2 * k], f[2 * k + 1]}, acc2[k]);
        XP_ROW(Un, e_n, pr)
      }
    }
    __syncthreads();
    {
      float4* pw = (float4*)(part + (w * 2 + hw) * 1024 + hl * 32);
#pragma unroll
      for (int c = 0; c < 8; ++c) pw[c] = make_float4(acc2[2 * c][0], acc2[2 * c][1], acc2[2 * c + 1][0], acc2[2 * c + 1][1]);
    }
    __syncthreads();
    float4 s = ((const float4*)part)[tid];
#pragma unroll
    for (int c = 1; c < 8; ++c) { const float4 x = ((const float4*)(part + c * 1024))[tid]; s.x += x.x; s.y += x.y; s.z += x.z; s.w += x.w; }
    xv.x += 0.5f * g2.x * s.x; xv.y += 0.5f * g2.y * s.y; xv.z += 0.5f * g2.z * s.z; xv.w += 0.5f * g2.w * s.w;
    *xp = xv;
    if (!pf) { pend = nxt; break; }
    l = ln; par = parn; b = bn; rr = rrn; t = tn; e_c = e_n; g_c = g_n;
#pragma unroll
    for (int c = 0; c < 4; ++c) hp[c] = hn[c];
  }
}
__device__ __forceinline__ void expert_drain(const Params& p, int lo, int hi, int& pend, float* smem) {
  expert_run(p, lo, hi, nullptr, 0u, false, pend, smem);
}

__device__ __forceinline__ void stage_final(const Params& p, float* smem) {
  const int tid = otid(), w = tid >> 6, lane = tid & 63;
  const int n = NB * NLAT;
  for (int r0 = (blockIdx.x * 4 + w) * 2; r0 < n; r0 += gridDim.x * 8) {
    float4 v[2][4];
#pragma unroll
    for (int u = 0; u < 2; ++u)
#pragma unroll
      for (int q = 0; q < 4; ++q) v[u][q] = ((const float4*)(p.out + (size_t)(r0 + u) * DM))[q * 64 + lane];
#pragma unroll
    for (int u = 0; u < 2; ++u) {
      float s = 0.f;
#pragma unroll
      for (int q = 0; q < 4; ++q) s += v[u][q].x * v[u][q].x + v[u][q].y * v[u][q].y + v[u][q].z * v[u][q].z + v[u][q].w * v[u][q].w;
      s = wave_sum(s);
      const float rs = rsqrtf(s * (1.0f / DM) + EPSF);
#pragma unroll
      for (int q = 0; q < 4; ++q) {
        const float4 g = ((const float4*)p.in[I_FG])[q * 64 + lane];
        const float4 x = v[u][q];
        ((float4*)(p.out + (size_t)(r0 + u) * DM))[q * 64 + lane] = make_float4(x.x * rs * g.x, x.y * rs * g.y, x.z * rs * g.z, x.w * rs * g.w);
      }
    }
  }
}

__device__ __forceinline__ void gbar(const Params& p, unsigned* ctr, unsigned& epoch, int lo, int hi, int& pend, float* smem) {
  asm volatile("s_waitcnt vmcnt(0)" ::: "memory");
  __syncthreads();
  epoch += gridDim.x;
  int* s_flag = (int*)(smem + SMEM_FLOATS - 12);
  if (threadIdx.x == 0) {
    __builtin_amdgcn_fence(__ATOMIC_RELEASE, "agent");
    asm volatile("s_waitcnt vmcnt(0)" ::: "memory");
    __hip_atomic_fetch_add(ctr, 1u, __ATOMIC_RELAXED, __HIP_MEMORY_SCOPE_AGENT);
  }
  if (hi >= lo && hi >= 0) {
    if (threadIdx.x == 0) {
      const unsigned c = __hip_atomic_load(ctr, __ATOMIC_RELAXED, __HIP_MEMORY_SCOPE_AGENT);
      *s_flag = (c + 1u < epoch) ? 1 : 0;
    }
    __syncthreads();
    if (*s_flag) expert_run(p, lo, hi, ctr, epoch, true, pend, smem);
  }
  if (threadIdx.x == 0) {
    while (__hip_atomic_load(ctr, __ATOMIC_RELAXED, __HIP_MEMORY_SCOPE_AGENT) < epoch) __builtin_amdgcn_s_sleep(2);
    __builtin_amdgcn_fence(__ATOMIC_ACQUIRE, "agent");
    asm volatile("s_waitcnt vmcnt(0)" ::: "memory");
  }
  __syncthreads();
}

__global__ void __launch_bounds__(256) mega(Params p) {
  cg::grid_group grid = cg::this_grid();
  __shared__ __attribute__((aligned(16))) float smem[SMEM_FLOATS];
  char* smc = (char*)smem;
  char* ws = p.ws;
  bf16_t* H = (bf16_t*)(ws + WB_H); bf16_t* Z = (bf16_t*)(ws + WB_Z); float* MGT = (float*)(ws + WB_MGT); bf16_t* XC = (bf16_t*)(ws + WB_XC);
  bf16_t* QM = (bf16_t*)(ws + WB_QM); bf16_t* KM = (bf16_t*)(ws + WB_KM); bf16_t* KMT = (bf16_t*)(ws + WB_KMT); bf16_t* MVT = (bf16_t*)(ws + WB_MVT);
  bf16_t* HF = (bf16_t*)(ws + WB_HF); bf16_t* HB = (bf16_t*)(ws + WB_HB);
  bf16_t* VT = (bf16_t*)(ws + WB_VT); float* YSF = (float*)(ws + WB_YSF); float* YSB = (float*)(ws + WB_YSB);
  bf16_t* YA = (bf16_t*)(ws + WB_YA); bf16_t* YB = (bf16_t*)(ws + WB_YB); bf16_t* YS = (bf16_t*)(ws + WB_YS); bf16_t* GG = (bf16_t*)(ws + WB_GG);
  bf16_t* MG = (bf16_t*)(ws + WB_MG); bf16_t* PQ = (bf16_t*)(ws + WB_PQ); float* SC = (float*)(ws + WB_SC);
  float* XE = (float*)(ws + WB_XE); float* GA = (float*)(ws + WB_GA);
  const bf16_t* WT = (const bf16_t*)(ws + WB_WT);

  unsigned* bar = (unsigned*)(ws + WB_BAR);
  unsigned epoch = 0;
  int pend = -1;
  stage_init(p, smem);
  grid.sync();

  for (int l = 0; l < 2; ++l) {
    const bool need_ctx = (l == 0);
    const int rr_lim = need_ctx ? NTOK : NLAT;
    const int tpb = need_ctx ? 34 : 32;
    const bf16_t* W = WT + (size_t)l * WT_LAYER;
    const float lam_init = 0.8f - 0.6f * expf(-0.3f * (float)l);
    float lam;
    {
      float s1 = 0.f, s2 = 0.f;
      for (int i = 0; i < 64; ++i) {
        s1 += p.in[I_LQ1][l * 64 + i] * p.in[I_LK1][l * 64 + i];
        s2 += p.in[I_LQ2][l * 64 + i] * p.in[I_LK2][l * 64 + i];
      }
      lam = expf(s1) - expf(s2) + lam_init;
    }
    for (int g = 0; g < NG; ++g) {
      const int q = l * NG + g;
      int plo = q - 2, phi = q - 1;
      int* EI = (int*)(ws + WB_EI) + (size_t)(q & 1) * RPG * 128; float* EG = (float*)(ws + WB_EG) + (size_t)(q & 1) * RPG * 128;
      bf16_t* H2 = (bf16_t*)(ws + WB_H2) + (size_t)(q & 1) * RPG * DM;
      stage_normmod(p, l, g, 0, NTOK, H, smem);
      gbar(p, bar, epoch, plo, phi, pend, smem);
      stage_inproj(p, H, W + WT_WIN, Z, MGT, VT, MVT, smc);
      gbar(p, bar, epoch, plo, phi, pend, smem);
      stage_conv(p, l, Z, XC);
      stage_s5_pass1(p, l, Z, XE);
      gbar(p, bar, epoch, plo, phi, pend, smem);
      stage_mlqk(XC, W + WT_WQK, QM, KM, KMT, smc);
      stage_mlgates(p, l, MGT, GA);
      gbar(p, bar, epoch, plo, phi, pend, smem);
      {
        const int n_attn = 4 * 64 + (need_ctx ? 4 * 4 : 0);
        const int n_s5 = 32 * 2 * 9;
        const int n_items = GB * (16 + n_attn + n_s5);
        int* cnt = (int*)(ws + WB_CNT) + (l * NG + g);
        int* s_item = (int*)(smem + SMEM_FLOATS - 4);
        for (;;) {
          __syncthreads();
          if (otid() == 0) *s_item = atomicAdd(cnt, 1);
          __syncthreads();
          const int it = *s_item;
          if (it >= n_items) break;
          int bl, k;
          if (it < GB * 16) { bl = it / 16; k = it % 16; }
          else if (it < GB * (16 + n_attn)) { bl = (it - GB * 16) / n_attn; k = 16 + (it - GB * 16) % n_attn; }
          else { bl = (it - GB * (16 + n_attn)) / n_s5; k = 16 + n_attn + (it - GB * (16 + n_attn)) % n_s5; }
          const bf16_t* Zb = Z + (size_t)bl * NTOK * ZW;
          const size_t ro = (size_t)bl * NTOK;
          if (k < 16) {
            const int hh = k & 3, dd = (k >> 2) & 1, eh = k >> 3;
            mlstm_chain_item(p, l, QM + ro * 512, KM + ro * 512, KMT + (size_t)bl * 4 * 128 * NTOK, MVT + (size_t)bl * 4 * 128 * NTOK, GA + (size_t)(((bl * 4 + hh) * 2 + dd) * 68) * 272,
                             (dd ? HB : HF) + ro * 512, hh, dd, eh, smc);
          } else if (k < 16 + n_attn) {
            const int a = k - 16;
            const bf16_t* VTb = VT + (size_t)bl * 4 * 128 * NTOK;
            if (a < 256) attn_mfma_item(p, l, Zb, VTb, YA + ro * 512, a & 3, (a >> 2) * 64, 0, NTOK, lam, lam_init, smc);
            else attn_mfma_item(p, l, Zb, VTb, YA + ro * 512, (a - 256) & 3, NLAT + ((a - 256) >> 2) * 64, NLAT, NCTX, lam, lam_init, smc);
          } else {
            const int a = k - 16 - n_attn;
            const int sq = a % 9, dir = (a / 9) & 1, gg = a / 18;
            s5_item(p, l, Zb, XE + (((size_t)bl * 32 + gg) * 2 + dir) * (S5NSEG - 1) * 128, (dir ? YSB : YSF) + ro * 512, gg, dir, sq, smc);
          }
        }
      }
      gbar(p, bar, epoch, plo, phi, pend, smem);
      stage_post(p, l, rr_lim, Z, HF, HB, YSF, YSB, YB, GG);
      gbar(p, bar, epoch, plo, phi, pend, smem);
      stage_glu_mfma(p, l, tpb, GG, W + WT_GLU, YS, smc);
      gbar(p, bar, epoch, plo, phi, pend, smem);
      stage_merge_mfma(tpb, YA, YB, YS, W + WT_WBR, Z, MG, smc);
      gbar(p, bar, epoch, plo, phi, pend, smem);
      stage_outproj_mfma(p, l, g, tpb, MG, W + WT_WOUT, smc);
      gbar(p, bar, epoch, plo, phi, pend, smem);
      expert_drain(p, plo, plo, pend, smem);
      plo = q - 1;
      gbar(p, bar, epoch, plo, phi, pend, smem);
      stage_normmod(p, l, g, 1, rr_lim, H2, smem);
      gbar(p, bar, epoch, plo, phi, pend, smem);
      stage_peerq_mfma(tpb, H2, W + WT_WQ, PQ, smc);
      gbar(p, bar, epoch, plo, phi, pend, smem);
      stage_scores_topk(tpb, PQ, W + WT_SUBK, EI, EG, smc);
      gbar(p, bar, epoch, plo, phi, pend, smem);
    }
  }
  expert_drain(p, 2 * NG - 2, 2 * NG - 1, pend, smem);
  gbar(p, bar, epoch, 0, -1, pend, smem);
  stage_final(p, smem);
}

extern "C" void kernel_launch(void* const* d_in, const int* in_sizes, int n_in, void* d_out,
                              int out_size, void* d_ws, size_t ws_size, hipStream_t stream) {
  static int grid_blocks = 0;
  if (!grid_blocks) {
    int dev = 0, cus = 0, per_cu = 0;
    (void)hipGetDevice(&dev);
    (void)hipDeviceGetAttribute(&cus, hipDeviceAttributeMultiprocessorCount, dev);
    (void)hipOccupancyMaxActiveBlocksPerMultiprocessor(&per_cu, mega, 256, 0);
    if (per_cu > 1) per_cu = 1;
    grid_blocks = cus * per_cu;
  }
  if (ws_size < WB_END) {
    fprintf(stderr, "workspace too small: %zu < %zu\n", ws_size, (size_t)WB_END);
    return;
  }
  Params p{};
  for (int i = 0; i < N_IN; ++i) p.in[i] = (const float*)d_in[i];
  p.out = (float*)d_out;
  p.ws = (char*)d_ws;
  (void)hipMemsetAsync((char*)d_ws + WB_BAR, 0, 256, stream);
  void* args[] = {&p};
  hipError_t e = hipLaunchCooperativeKernel((void*)mega, dim3(grid_blocks), dim3(256), args, 0, stream);
  if (e != hipSuccess) fprintf(stderr, "cooperative launch failed: %s (grid %d)\n", hipGetErrorString(e), grid_blocks);
}
```

```cpp
#include <hip/hip_runtime.h>
#include <hip/hip_cooperative_groups.h>
#include <cstdio>
#include <cstdint>
namespace cg = cooperative_groups;

#define NLAT 4096
#define NCTX 256
#define NTOK 4352
#define DM 1024
#define INW 6672
#define NB 8
#define GB 2
#define NG (NB / GB)
#define RPG (GB * NTOK)
#define ZW 6656
#define EPSF 1e-6f

enum { I_X = 0, I_C, I_CTX, I_CCTX, I_WMOD, I_BMOD, I_N1G, I_N2G, I_WIN, I_LQ1, I_LK1, I_LQ2, I_LK2, I_SUBG,
       I_CONVW, I_CONVB, I_MLWQ, I_MLWK, I_GATEB, I_MLNG, I_S5LRE, I_S5LIM, I_S5DT, I_S5BRE, I_S5BIM,
       I_S5CRE, I_S5CIM, I_S5D, I_GLUW, I_GLUB, I_WBR, I_WOUT, I_PWQ, I_PSUBK, I_PU, I_PV, I_FG, N_IN };

struct Params {
  const float* in[N_IN];
  float* out;
  char* ws;
};

typedef unsigned short bf16_t;
typedef short bf16x8 __attribute__((ext_vector_type(8)));
typedef float f32x16 __attribute__((ext_vector_type(16)));
typedef unsigned u32x4 __attribute__((ext_vector_type(4)));
typedef unsigned u32x2 __attribute__((ext_vector_type(2)));
typedef unsigned u32x4_u __attribute__((ext_vector_type(4), aligned(8)));
typedef float v16f __attribute__((ext_vector_type(16)));
typedef float v32f __attribute__((ext_vector_type(32)));
typedef unsigned v6u __attribute__((ext_vector_type(6)));

#define AL(x) (((x) + 255) & ~(size_t)255)
#define WB_XCX   ((size_t)0)
#define WB_MOD   AL(WB_XCX + (size_t)NB * NCTX * DM * 4)
#define WB_ROPE  AL(WB_MOD + (size_t)2 * 9 * 6144 * 4)
#define WB_WT    AL(WB_ROPE + (size_t)NLAT * 32 * 2 * 4)
#define WT_WIN   ((size_t)0)
#define WT_WQK   (WT_WIN + (size_t)6784 * 1024)
#define WT_GLU   (WT_WQK + (size_t)4 * 256 * 128)
#define WT_WBR   (WT_GLU + (size_t)512 * 512)
#define WT_WOUT  (WT_WBR + (size_t)3 * 1024 * 512)
#define WT_WQ    (WT_WOUT + (size_t)1024 * 1024)
#define WT_SUBK  (WT_WQ + (size_t)2048 * 1024)
#define WT_LAYER (WT_SUBK + (size_t)2 * 128 * 128)
#define WB_H     AL(WB_WT + WT_LAYER * 2 * 2)
#define WB_Z     AL(WB_H + (size_t)RPG * DM * 2)
#define WB_MGT   AL(WB_Z + (size_t)RPG * ZW * 2)
#define WB_XC    AL(WB_MGT + (size_t)RPG * 16 * 4)
#define WB_QM    AL(WB_XC + (size_t)RPG * 512 * 2)
#define WB_KM    AL(WB_QM + (size_t)RPG * 512 * 2)
#define WB_KMT   AL(WB_KM + (size_t)RPG * 512 * 2)
#define WB_MVT   AL(WB_KMT + (size_t)RPG * 512 * 2)
#define WB_HF    AL(WB_MVT + (size_t)RPG * 512 * 2)
#define WB_HB    AL(WB_HF + (size_t)RPG * 512 * 2)
#define WB_YSF   AL(WB_HB + (size_t)RPG * 512 * 2)
#define WB_YSB   AL(WB_YSF + (size_t)RPG * 512 * 4)
#define WB_YA    AL(WB_YSB + (size_t)RPG * 512 * 4)
#define WB_YB    AL(WB_YA + (size_t)RPG * 512 * 2)
#define WB_YS    AL(WB_YB + (size_t)RPG * 512 * 2)
#define WB_GG    AL(WB_YS + (size_t)RPG * 512 * 2)
#define WB_MG    AL(WB_GG + (size_t)RPG * 512 * 2)
#define WB_EI    AL(WB_MG + (size_t)RPG * DM * 2)
#define WB_EG    AL(WB_EI + (size_t)2 * RPG * 128 * 4)
#define WB_H2    AL(WB_EG + (size_t)2 * RPG * 128 * 4)
#define WB_U16   AL(WB_H2 + (size_t)2 * RPG * DM * 2)
#define WB_V16   AL(WB_U16 + (size_t)2 * 16384 * 768)
#define WB_VT    AL(WB_V16 + (size_t)2 * 16384 * 768)
#define WB_CNT   AL(WB_VT + (size_t)GB * 4 * 128 * NTOK * 2)
#define WB_XE    AL(WB_CNT + 256)
#define WB_BAR   AL(WB_XE + (size_t)GB * 32 * 2 * 33 * 128 * 4)
#define WB_GA    AL(WB_BAR + 256)
#define WB_POOL  AL(WB_GA + (size_t)GB * 4 * 2 * 68 * 272 * 4)
#define WB_END   AL(WB_POOL + 256)
#define WB_PQ    (WB_Z)
#define WB_SC    AL(WB_PQ + (size_t)RPG * 2048 * 2)

#define SMEM_FLOATS (25 * 1024)

__device__ __forceinline__ float sigmoidf_(float x) { return __builtin_amdgcn_rcpf(1.0f + __builtin_amdgcn_exp2f(-1.4426950408889634f * x)); }
__device__ __forceinline__ float siluf_(float x) { return x * __builtin_amdgcn_rcpf(1.0f + __builtin_amdgcn_exp2f(-1.4426950408889634f * x)); }
__device__ __forceinline__ float geluf_(float x) { return 0.5f * x * (1.0f + erff(x * 0.70710678118654752f)); }
__device__ __forceinline__ int otid() { int t = threadIdx.x; asm volatile("" : "+v"(t)); return t; }
__device__ __forceinline__ float wave_sum(float v) {
  for (int o = 32; o > 0; o >>= 1) v += __shfl_xor(v, o);
  return v;
}
__device__ __forceinline__ bf16_t f2bf(float x) { unsigned u = __float_as_uint(x); u += 0x7fffu + ((u >> 16) & 1u); return (bf16_t)(u >> 16); }
__device__ __forceinline__ float bf2f(bf16_t h) { return __uint_as_float(((unsigned)h) << 16); }
typedef float f32x2 __attribute__((ext_vector_type(2)));
typedef __bf16 bf16x2_t __attribute__((ext_vector_type(2)));
__device__ __forceinline__ unsigned pack2(float a, float b) { f32x2 v = {a, b}; return __builtin_bit_cast(unsigned, __builtin_convertvector(v, bf16x2_t)); }
__device__ __forceinline__ float lo16(unsigned u) { return __uint_as_float(u << 16); }
__device__ __forceinline__ float hi16(unsigned u) { return __uint_as_float(u & 0xffff0000u); }

__device__ __forceinline__ float* xrow(const Params& p, int b, int rr) {
  return (rr < NLAT) ? p.out + ((size_t)b * NLAT + rr) * DM : (float*)(p.ws + WB_XCX) + ((size_t)b * NCTX + (rr - NLAT)) * DM;
}

__device__ __forceinline__ const float* xrow_in(const Params& p, int b, int rr) {
  return (rr < NLAT) ? p.in[I_X] + ((size_t)b * NLAT + rr) * DM : p.in[I_CTX] + ((size_t)b * NCTX + (rr - NLAT)) * DM;
}

__device__ __forceinline__ void gemm_tile(const bf16_t* __restrict__ Ag, int lda, const bf16_t* __restrict__ Bg, int ldb, int K,
                                          char* smem, f32x16 (&acc)[2][2]) {
  const int tid = otid(), lane = tid & 63, w = tid >> 6, wm = w >> 1, wn = w & 1;
#pragma unroll
  for (int a = 0; a < 2; ++a)
#pragma unroll
    for (int b = 0; b < 2; ++b)
#pragma unroll
      for (int i = 0; i < 16; ++i) acc[a][b][i] = 0.f;
  const int srow = tid >> 3, sch = tid & 7;
  const bf16_t* ap = Ag + (size_t)srow * lda + sch * 8;
  const bf16_t* bp = Bg + (size_t)srow * ldb + sch * 8;
  const int wofs = srow * 128 + ((sch ^ ((srow >> 1) & 7)) << 4);
  const int fr = lane & 31, fh = lane >> 5, fsw = (fr >> 1) & 7;
  const int aofs = (wm * 64 + fr) * 128, bofs = 16384 + (wn * 64 + fr) * 128;
  u32x4 ra0[4], rb0[4], ra1[4], rb1[4];
  const int nk = K >> 6;
#define G_LOAD(RA, RB, KT) { _Pragma("unroll") for (int i = 0; i < 4; ++i) { RA[i] = *(const u32x4*)(ap + (size_t)i * 32 * lda + (KT) * 64); RB[i] = *(const u32x4*)(bp + (size_t)i * 32 * ldb + (KT) * 64); } }
#define G_STORE(RA, RB, BUF) { char* nb_ = smem + (BUF) * 32768; _Pragma("unroll") for (int i = 0; i < 4; ++i) { *(u32x4*)(nb_ + wofs + i * 4096) = RA[i]; *(u32x4*)(nb_ + 16384 + wofs + i * 4096) = RB[i]; } }
#define G_COMPUTE(BUF) { const char* base = smem + (BUF) * 32768; _Pragma("unroll") for (int ks = 0; ks < 4; ++ks) { \
      const int coff = ((ks * 2 + fh) ^ fsw) << 4; bf16x8 af[2], bfr[2]; \
      _Pragma("unroll") for (int mi = 0; mi < 2; ++mi) af[mi] = *(const bf16x8*)(base + aofs + mi * 4096 + coff); \
      _Pragma("unroll") for (int ni = 0; ni < 2; ++ni) bfr[ni] = *(const bf16x8*)(base + bofs + ni * 4096 + coff); \
      _Pragma("unroll") for (int mi = 0; mi < 2; ++mi) _Pragma("unroll") for (int ni = 0; ni < 2; ++ni) \
          acc[mi][ni] = __builtin_amdgcn_mfma_f32_32x32x16_bf16(bfr[ni], af[mi], acc[mi][ni], 0, 0, 0); } }
  G_LOAD(ra0, rb0, 0)
  G_LOAD(ra1, rb1, 1)
  __syncthreads();
  G_STORE(ra0, rb0, 0)
  __syncthreads();
  for (int kt = 0; kt < nk; kt += 2) {
    if (kt + 2 < nk) G_LOAD(ra0, rb0, kt + 2)
    G_COMPUTE(0)
    G_STORE(ra1, rb1, 1)
    __syncthreads();
    if (kt + 3 < nk) G_LOAD(ra1, rb1, kt + 3)
    G_COMPUTE(1)
    if (kt + 2 < nk) G_STORE(ra0, rb0, 0)
    __syncthreads();
  }
#undef G_LOAD
#undef G_STORE
#undef G_COMPUTE
}
#define EPI_DECL const int tid_ = otid(); const int lane = tid_ & 63, w_ = tid_ >> 6, wm = w_ >> 1, wn = w_ & 1, fr = lane & 31, fh = lane >> 5; (void)fr; (void)fh; (void)wm; (void)wn;
#define EPI_ROW(mi) (wm * 64 + (mi) * 32 + fr)
#define EPI_COL(ni, q) (wn * 64 + (ni) * 32 + 8 * (q) + 4 * fh)
#define MT_LR0(mt, tpb) (((mt) / (tpb)) * NTOK + ((mt) % (tpb)) * 128)


struct TileIter {
  int tm, tn, pw, ph, PN, NP, x, i, it;
  __device__ __forceinline__ TileIter(int tm_, int tn_) : tm(tm_), tn(tn_) {
    pw = tn < 8 ? tn : 8; ph = 32 / pw; PN = (tn + pw - 1) / pw; NP = ((tm + ph - 1) / ph) * PN;
    x = blockIdx.x & 7; i = blockIdx.x >> 3; it = 0;
  }
  __device__ __forceinline__ bool next(int& mt, int& nt, bool& valid) {
    if (gridDim.x != 256) {
      const int t = blockIdx.x + it * gridDim.x; ++it;
      if (t >= tm * tn) return false;
      mt = t / tn; nt = t % tn; valid = true; return true;
    }
    const int P = it * 8 + x; ++it;
    if (P >= NP) return false;
    mt = (P / PN) * ph + i / pw; nt = (P % PN) * pw + i % pw;
    valid = (mt < tm) && (nt < tn);
    return true;
  }
};

template <class F>
__device__ __forceinline__ void transpose_cvt(const float* __restrict__ src, int ld, F srccol, int K, int Ndst, bf16_t* __restrict__ dst, float* smem) {
  float (*T)[65] = (float (*)[65])smem;
  const int tid = otid();
  const int tk = K >> 6, tn = Ndst >> 6;
  for (int t = blockIdx.x; t < tn * tk; t += gridDim.x) {
    const int n0 = (t / tk) * 64, k0 = (t % tk) * 64;
    __syncthreads();
    const int sc = srccol(n0 + (tid & 63));
#pragma unroll
    for (int i = 0; i < 16; ++i) {
      const int ky = (tid >> 6) + 4 * i;
      T[ky][tid & 63] = (sc >= 0) ? src[(size_t)(k0 + ky) * ld + sc] : 0.f;
    }
    __syncthreads();
#pragma unroll
    for (int i = 0; i < 16; ++i) {
      const int ny = (tid >> 6) + 4 * i;
      dst[(size_t)(n0 + ny) * K + k0 + (tid & 63)] = f2bf(T[tid & 63][ny]);
    }
  }
  __syncthreads();
}
__device__ __forceinline__ void fragpack(const float* __restrict__ src, int ld, int K, int N, bf16_t* __restrict__ dst) {
  const int kc = K >> 6, total = (N >> 5) * kc * 256;
  for (int idx = blockIdx.x * 256 + otid(); idx < total; idx += gridDim.x * 256) {
    const int lane = idx & 63, ks = (idx >> 6) & 3, c = (idx >> 8) % kc, nf = (idx >> 8) / kc;
    const int n = 32 * nf + (lane & 31), k0 = 64 * c + 32 * (lane >> 5) + 8 * ks;
    float f[8];
#pragma unroll
    for (int j = 0; j < 8; ++j) f[j] = src[(size_t)(k0 + j) * ld + n];
    *(u32x4*)(dst + (size_t)idx * 8) = (u32x4){pack2(f[0], f[1]), pack2(f[2], f[3]), pack2(f[4], f[5]), pack2(f[6], f[7])};
  }
}
__device__ __forceinline__ int win_srccol(int n) {
  if (n < 3072) return n;
  if (n < 6656) return n + 16;
  if (n < 6672) return n - 3584;
  return -1;
}

__device__ __forceinline__ void stage_init(const Params& p, float* smem) {
  const int tid = otid();
  if (blockIdx.x == 0 && tid < 64) { ((int*)(p.ws + WB_CNT))[tid] = 0; if (tid < 16) ((int*)(p.ws + WB_POOL))[tid] = 0; }
  {
    float* lx = smem + tid * 33;
    int perm[32];
    {
      v16f a, b;
#pragma unroll
      for (int j = 0; j < 16; ++j) { a[j] = (float)(j & 7); b[j] = (float)((j + 16) & 7); }
      const v32f u1 = __builtin_amdgcn_cvt_scalef32_pk32_f32_fp6(__builtin_amdgcn_cvt_scalef32_2xpk16_fp6_f32(a, b, 1.0f), 1.0f);
#pragma unroll
      for (int j = 0; j < 16; ++j) { a[j] = (float)(j >> 3); b[j] = (float)((j + 16) >> 3); }
      const v32f u2 = __builtin_amdgcn_cvt_scalef32_pk32_f32_fp6(__builtin_amdgcn_cvt_scalef32_2xpk16_fp6_f32(a, b, 1.0f), 1.0f);
#pragma unroll
      for (int k = 0; k < 32; ++k) perm[k] = ((int)(u1[k] + 0.5f) + 8 * (int)(u2[k] + 0.5f)) & 31;
    }
    const size_t ngrp = (size_t)2 * 16384 * 32;
    for (size_t i = (size_t)blockIdx.x * 256 + tid; i < 2 * ngrp; i += (size_t)gridDim.x * 256) {
      const bool isv = i >= ngrp;
      const size_t gi = isv ? i - ngrp : i;
      const float4* s4 = (const float4*)((isv ? p.in[I_PV] : p.in[I_PU]) + gi * 32);
      const float sc = isv ? 2.0f : 64.0f;
      float o[32];
#pragma unroll
      for (int q = 0; q < 8; ++q) { const float4 t = s4[q]; o[4 * q] = t.x * sc; o[4 * q + 1] = t.y * sc; o[4 * q + 2] = t.z * sc; o[4 * q + 3] = t.w * sc; }
#pragma unroll
      for (int k = 0; k < 32; ++k) lx[perm[k]] = o[k];
      v16f a, b;
#pragma unroll
      for (int j = 0; j < 16; ++j) { a[j] = lx[j]; b[j] = lx[16 + j]; }
      const v6u pk = __builtin_amdgcn_cvt_scalef32_2xpk16_fp6_f32(a, b, 1.0f);
      u32x2* d = (u32x2*)(p.ws + (isv ? WB_V16 : WB_U16) + gi * 24);
      d[0] = (u32x2){pk[0], pk[1]}; d[1] = (u32x2){pk[2], pk[3]}; d[2] = (u32x2){pk[4], pk[5]};
    }
    __syncthreads();
  }
  {
    float2* rt = (float2*)(p.ws + WB_ROPE);
    for (int i = blockIdx.x * 256 + tid; i < NLAT * 32; i += gridDim.x * 256) {
      const int pos = i >> 5, j = i & 31;
      const float inv = powf(10000.0f, -(float)(j & 15) / 16.0f);
      const float ang = (float)((j < 16) ? (pos >> 6) : (pos & 63)) * inv;
      rt[i] = make_float2(cosf(ang), sinf(ang));
    }
  }
  {
    float* sc = smem;
    float* red = smem + 9 * 1024;
    for (int i = tid; i < 9 * 1024; i += 256) {
      int r = i >> 10, k = i & 1023;
      float v = (r < 8) ? p.in[I_C][r * 1024 + k] : p.in[I_CCTX][k];
      sc[i] = siluf_(v);
    }
    __syncthreads();
    float* mod = (float*)(p.ws + WB_MOD);
    const int jc = tid & 63, ksl = tid >> 6;
    for (int cb = blockIdx.x; cb < 2 * 6144 / 64; cb += gridDim.x) {
      const int col = cb * 64 + jc;
      const int l = col / 6144, j = col % 6144;
      const float* w = p.in[I_WMOD] + (size_t)l * 1024 * 6144 + j;
      float acc[9];
#pragma unroll
      for (int r = 0; r < 9; ++r) acc[r] = 0.f;
#pragma unroll 8
      for (int k = ksl * 256; k < ksl * 256 + 256; ++k) {
        const float wv = w[(size_t)k * 6144];
#pragma unroll
        for (int r = 0; r < 9; ++r) acc[r] = fmaf(sc[r * 1024 + k], wv, acc[r]);
      }
      __syncthreads();
#pragma unroll
      for (int r = 0; r < 9; ++r) red[(ksl * 64 + jc) * 9 + r] = acc[r];
      __syncthreads();
      if (ksl == 0) {
        const float bv = p.in[I_BMOD][l * 6144 + j];
#pragma unroll
        for (int r = 0; r < 9; ++r)
          mod[((size_t)l * 9 + r) * 6144 + j] = red[jc * 9 + r] + red[(64 + jc) * 9 + r] + red[(128 + jc) * 9 + r] + red[(192 + jc) * 9 + r] + bv;
      }
    }
    __syncthreads();
  }
  bf16_t* WT = (bf16_t*)(p.ws + WB_WT);
  for (int l = 0; l < 2; ++l) {
    bf16_t* W = WT + (size_t)l * WT_LAYER;
    transpose_cvt(p.in[I_WIN] + (size_t)l * DM * INW, INW, [](int n) { return win_srccol(n); }, DM, 6784, W + WT_WIN, smem);
    for (int h = 0; h < 4; ++h) {
      transpose_cvt(p.in[I_MLWQ] + ((size_t)l * 4 + h) * 16384, 128, [](int n) { return n; }, 128, 128, W + WT_WQK + (size_t)h * 256 * 128, smem);
      transpose_cvt(p.in[I_MLWK] + ((size_t)l * 4 + h) * 16384, 128, [](int n) { return n; }, 128, 128, W + WT_WQK + (size_t)h * 256 * 128 + 128 * 128, smem);
    }
    fragpack(p.in[I_GLUW] + (size_t)l * 512 * 512, 512, 512, 512, W + WT_GLU);
    for (int r = 0; r < 3; ++r) fragpack(p.in[I_WBR] + ((size_t)l * 3 + r) * 512 * DM, DM, 512, DM, W + WT_WBR + (size_t)r * 1024 * 512);
    fragpack(p.in[I_WOUT] + (size_t)l * DM * DM, DM, DM, DM, W + WT_WOUT);
    transpose_cvt(p.in[I_PWQ] + (size_t)l * DM * 2048, 2048, [](int n) { return n; }, DM, 2048, W + WT_WQ, smem);
    const float* sk = p.in[I_PSUBK] + (size_t)l * 2 * 128 * 128;
    for (int i = blockIdx.x * 256 + tid; i < 2 * 128 * 128; i += gridDim.x * 256) W[WT_SUBK + i] = f2bf(sk[i]);
  }
}

__device__ __forceinline__ void stage_normmod(const Params& p, int l, int g, int which, int rr_lim, bf16_t* H, float* smem) {
  const int tid = otid(), w = tid >> 6, lane = tid & 63;
  const float* ng = p.in[which ? I_N2G : I_N1G] + l * DM;
  const float* mod = (const float*)(p.ws + WB_MOD) + (size_t)l * 9 * 6144;
  const int off_sh = which ? 3072 : 0, off_sc = which ? 4096 : 1024;
  const int n = GB * rr_lim;
  for (int i0 = (blockIdx.x * 4 + w) * 2; i0 < n; i0 += gridDim.x * 8) {
    float4 v[2][4];
    int bl[2], rr[2];
#pragma unroll
    for (int u = 0; u < 2; ++u) {
      const int i = (i0 + u < n) ? i0 + u : i0;
      bl[u] = i / rr_lim; rr[u] = i % rr_lim;
      const float4* X = (const float4*)((l == 0 && which == 0) ? xrow_in(p, g * GB + bl[u], rr[u]) : xrow(p, g * GB + bl[u], rr[u]));
#pragma unroll
      for (int q = 0; q < 4; ++q) v[u][q] = X[q * 64 + lane];
    }
#pragma unroll
    for (int u = 0; u < 2; ++u) {
      if (i0 + u >= n) break;
      float s = 0.f;
#pragma unroll
      for (int q = 0; q < 4; ++q) s += v[u][q].x * v[u][q].x + v[u][q].y * v[u][q].y + v[u][q].z * v[u][q].z + v[u][q].w * v[u][q].w;
      s = wave_sum(s);
      const float rs = rsqrtf(s * (1.0f / DM) + EPSF);
      const float* m = mod + (size_t)((rr[u] < NLAT) ? (g * GB + bl[u]) : 8) * 6144;
      u32x2* hp = (u32x2*)(H + ((size_t)bl[u] * NTOK + rr[u]) * DM);
#pragma unroll
      for (int q = 0; q < 4; ++q) {
        const float4 gg = ((const float4*)ng)[q * 64 + lane];
        const float4 sc = ((const float4*)(m + off_sc))[q * 64 + lane];
        const float4 sh = ((const float4*)(m + off_sh))[q * 64 + lane];
        const float4 x = v[u][q];
        hp[q * 64 + lane] = (u32x2){pack2(x.x * rs * gg.x * (1.f + sc.x) + sh.x, x.y * rs * gg.y * (1.f + sc.y) + sh.y),
                                    pack2(x.z * rs * gg.z * (1.f + sc.z) + sh.z, x.w * rs * gg.w * (1.f + sc.w) + sh.w)};
      }
    }
  }
}

__device__ __forceinline__ void stage_inproj(const Params& p, const bf16_t* H, const bf16_t* WinT, bf16_t* Z, float* MGT, bf16_t* VT, bf16_t* MVT, char* smem) {
  EPI_DECL
  const int tm = GB * 34, tn = 53;
  const float2* rt = (const float2*)(p.ws + WB_ROPE);
  TileIter ti(tm, tn);
  int mt, j; bool valid;
  while (ti.next(mt, j, valid)) {
    if (!valid) continue;
    const int n0 = j * 128;
    const int lr0 = MT_LR0(mt, 34), rr0 = (mt % 34) * 128;
    f32x16 acc[2][2];
    if ((j >= 8 && j < 12) || (j >= 16 && j < 20)) {
      gemm_tile(WinT + (size_t)n0 * DM, DM, H + (size_t)lr0 * DM, DM, DM, smem, acc);
      bf16_t* vt = ((j < 12) ? VT : MVT) + ((size_t)(mt / 34) * 4 + (j & 3)) * 128 * NTOK;
#pragma unroll
      for (int mi = 0; mi < 2; ++mi)
#pragma unroll
        for (int ni = 0; ni < 2; ++ni)
#pragma unroll
          for (int q = 0; q < 4; ++q) {
            const int e = EPI_ROW(mi), tok = rr0 + EPI_COL(ni, q);
            *(u32x2*)(vt + (size_t)e * NTOK + tok) = (u32x2){pack2(acc[mi][ni][4 * q], acc[mi][ni][4 * q + 1]), pack2(acc[mi][ni][4 * q + 2], acc[mi][ni][4 * q + 3])};
          }
      continue;
    }
    gemm_tile(H + (size_t)lr0 * DM, DM, WinT + (size_t)n0 * DM, DM, DM, smem, acc);
    if (j < 8 && rr0 < NLAT) {
#pragma unroll
      for (int mi = 0; mi < 2; ++mi) {
        const int pos = rr0 + EPI_ROW(mi);
#pragma unroll
        for (int i = 0; i < 16; ++i) {
          const int jj = 8 * (i >> 2) + 4 * fh + (i & 3);
          const float2 cs = rt[pos * 32 + jj];
          const float x1 = acc[mi][0][i], x2 = acc[mi][1][i];
          acc[mi][0][i] = x1 * cs.x - x2 * cs.y;
          acc[mi][1][i] = x1 * cs.y + x2 * cs.x;
        }
      }
    }
    if (j < 52) {
      const bool sg = (j >= 28);
#pragma unroll
      for (int mi = 0; mi < 2; ++mi)
#pragma unroll
        for (int ni = 0; ni < 2; ++ni)
#pragma unroll
          for (int q = 0; q < 4; ++q) {
            const int row = lr0 + EPI_ROW(mi), c = n0 + EPI_COL(ni, q);
            float v0 = acc[mi][ni][4 * q], v1 = acc[mi][ni][4 * q + 1], v2 = acc[mi][ni][4 * q + 2], v3 = acc[mi][ni][4 * q + 3];
            if (sg) { v0 = sigmoidf_(v0); v1 = sigmoidf_(v1); v2 = sigmoidf_(v2); v3 = sigmoidf_(v3); }
            *(u32x2*)(Z + (size_t)row * ZW + c) = (u32x2){pack2(v0, v1), pack2(v2, v3)};
          }
    } else {
#pragma unroll
      for (int mi = 0; mi < 2; ++mi)
#pragma unroll
        for (int q = 0; q < 2; ++q) {
          const int row = lr0 + EPI_ROW(mi), c = EPI_COL(0, q);
          if (wn == 0) *(float4*)(MGT + (size_t)row * 16 + c) = make_float4(acc[mi][0][4 * q], acc[mi][0][4 * q + 1], acc[mi][0][4 * q + 2], acc[mi][0][4 * q + 3]);
        }
    }
  }
}

__device__ __forceinline__ void stage_conv(const Params& p, int l, const bf16_t* Z, bf16_t* XC) {
  const int tid = otid();
  const float* cw = p.in[I_CONVW] + (size_t)l * 3 * 512;
  const float* cb = p.in[I_CONVB] + (size_t)l * 512;
  const int c = tid * 2;
  const float2 w0 = *(const float2*)(cw + c), w1 = *(const float2*)(cw + 512 + c), w2 = *(const float2*)(cw + 1024 + c), bb = *(const float2*)(cb + c);
  for (int lr0 = blockIdx.x * 4; lr0 < RPG; lr0 += gridDim.x * 4) {
    unsigned xc[4], xp[4], xn[4];
#pragma unroll
    for (int u = 0; u < 4; ++u) {
      const int lr = lr0 + u, rr = lr % NTOK;
      const bool has_prev = (rr < NLAT) ? (rr > 0) : (rr > NLAT);
      const bool has_next = (rr < NLAT) ? (rr < NLAT - 1) : (rr < NTOK - 1);
      const bf16_t* z = Z + (size_t)lr * ZW + 1536 + c;
      xc[u] = *(const unsigned*)z;
      xp[u] = has_prev ? *(const unsigned*)(z - ZW) : 0u;
      xn[u] = has_next ? *(const unsigned*)(z + ZW) : 0u;
    }
#pragma unroll
    for (int u = 0; u < 4; ++u) {
      const float a0 = bb.x + w1.x * lo16(xc[u]) + w0.x * lo16(xp[u]) + w2.x * lo16(xn[u]);
      const float a1 = bb.y + w1.y * hi16(xc[u]) + w0.y * hi16(xp[u]) + w2.y * hi16(xn[u]);
      *(unsigned*)(XC + (size_t)(lr0 + u) * 512 + c) = pack2(siluf_(a0), siluf_(a1));
    }
  }
}

__device__ __forceinline__ void stage_mlqk(const bf16_t* XC, const bf16_t* WQK, bf16_t* QM, bf16_t* KM, bf16_t* KMT, char* smem) {
  EPI_DECL
  const int tm = RPG >> 7;
  TileIter ti(tm, 12);
  int mt, r12; bool valid;
  while (ti.next(mt, r12, valid)) {
    if (!valid) continue;
    const int h = r12 & 3, kind = r12 >> 2;
    const int m0 = mt * 128;
    f32x16 acc[2][2];
    const bf16_t* Wt = WQK + (size_t)h * 256 * 128 + (size_t)(kind ? 1 : 0) * 128 * 128;
    const bf16_t* Xt = XC + (size_t)m0 * 512 + h * 128;
    if (kind < 2) {
      gemm_tile(Xt, 512, Wt, 128, 128, smem, acc);
      bf16_t* O = kind ? KM : QM;
      const float alpha = kind ? 1.0f : 0.08838834764831845f;
#pragma unroll
      for (int mi = 0; mi < 2; ++mi)
#pragma unroll
        for (int ni = 0; ni < 2; ++ni)
#pragma unroll
          for (int q = 0; q < 4; ++q) {
            const int row = m0 + EPI_ROW(mi), c = EPI_COL(ni, q);
            *(u32x2*)(O + (size_t)row * 512 + h * 128 + c) = (u32x2){pack2(alpha * acc[mi][ni][4 * q], alpha * acc[mi][ni][4 * q + 1]), pack2(alpha * acc[mi][ni][4 * q + 2], alpha * acc[mi][ni][4 * q + 3])};
          }
    } else {
      gemm_tile(Wt, 128, Xt, 512, 128, smem, acc);
      bf16_t* kt = KMT + ((size_t)(mt / 34) * 4 + h) * 128 * NTOK + (mt % 34) * 128;
#pragma unroll
      for (int mi = 0; mi < 2; ++mi)
#pragma unroll
        for (int ni = 0; ni < 2; ++ni)
#pragma unroll
          for (int q = 0; q < 4; ++q) {
            const int d = EPI_ROW(mi), tok = EPI_COL(ni, q);
            *(u32x2*)(kt + (size_t)d * NTOK + tok) = (u32x2){pack2(acc[mi][ni][4 * q], acc[mi][ni][4 * q + 1]), pack2(acc[mi][ni][4 * q + 2], acc[mi][ni][4 * q + 3])};
          }
    }
  }
}

__device__ __forceinline__ void attn_mfma_item(const Params& p, int l, const bf16_t* Zb, const bf16_t* VTb, bf16_t* YAb, int h, int qrow0, int key0, int nkeys,
                                               float lam, float lam_init, char* smem) {
  const int tid = otid(), lane = tid & 63, w = tid >> 6, fr = lane & 31, fh = lane >> 5;
  const int rb = w & 1, m = w >> 1;
  const int ntiles = nkeys >> 6;
  const int myrow = qrow0 + rb * 32 + fr;
  bf16x8 qf[4];
  {
    const bf16_t* qp = Zb + (size_t)myrow * ZW + h * 128 + m * 64 + fh * 8;
#pragma unroll
    for (int ks = 0; ks < 4; ++ks) qf[ks] = *(const bf16x8*)(qp + ks * 16);
  }
  f32x16 O[4];
#pragma unroll
  for (int eb = 0; eb < 4; ++eb)
#pragma unroll
    for (int i = 0; i < 16; ++i) O[eb][i] = 0.f;
  float mrun = -1e30f, lrun = 0.f;
  const float cs = 0.125f * 1.4426950408889634f;
  const int skey = tid >> 4, sch = tid & 15;
  const bf16_t* ksrc = Zb + (size_t)(key0 + skey) * ZW + 512 + h * 128 + sch * 8;
  const int kdst = skey * 256 + ((sch ^ (skey & 15)) << 4);
  const int se = tid >> 3, svc = tid & 7;
  const bf16_t* vsrc = VTb + ((size_t)h * 128 + se) * NTOK + key0 + svc * 8;
  const int vsw = (se >> 1) & 15;
  const int vdst0 = se * 128 + (((2 * svc) ^ vsw) << 3), vdst1 = se * 128 + (((2 * svc + 1) ^ vsw) << 3);
  const int kfo = fr * 256, kfs = fr & 15;
  const int vfo = fr * 128, vfs = (fr >> 1) & 15;
  u32x4 rk[4], rv[4];
#pragma unroll
  for (int i = 0; i < 4; ++i) rk[i] = *(const u32x4*)(ksrc + (size_t)i * 16 * ZW);
  __syncthreads();
#pragma unroll
  for (int i = 0; i < 4; ++i) *(u32x4*)(smem + kdst + i * 4096) = rk[i];
  __syncthreads();
  bf16x8 pf[4];
#define ATT_S(T) { const char* kb_ = smem + ((T) & 1) * 16384; _Pragma("unroll") for (int kb = 0; kb < 2; ++kb) { \
      _Pragma("unroll") for (int i = 0; i < 16; ++i) S[kb][i] = 0.f; \
      _Pragma("unroll") for (int ks = 0; ks < 4; ++ks) { \
        const bf16x8 kf = *(const bf16x8*)(kb_ + kb * 8192 + kfo + (((m * 8 + ks * 2 + fh) ^ kfs) << 4)); \
        S[kb] = __builtin_amdgcn_mfma_f32_32x32x16_bf16(kf, qf[ks], S[kb], 0, 0, 0); } } }
#define ATT_MAX() { float tm = S[0][0]; \
      _Pragma("unroll") for (int i = 1; i < 16; ++i) tm = fmaxf(tm, S[0][i]); \
      _Pragma("unroll") for (int i = 0; i < 16; ++i) tm = fmaxf(tm, S[1][i]); \
      tm = fmaxf(tm, __shfl_xor(tm, 32)) * cs; alpha = 1.f; \
      if (tm > mrun + 8.0f) { alpha = __builtin_amdgcn_exp2f(mrun - tm); mrun = tm; } }
#define ATT_EXP(PF) { const float mc = mrun; float rs = 0.f; \
      _Pragma("unroll") for (int kb = 0; kb < 2; ++kb) { float pv[16]; \
        _Pragma("unroll") for (int i = 0; i < 16; ++i) { pv[i] = __builtin_amdgcn_exp2f(fmaf(S[kb][i], cs, -mc)); rs += pv[i]; } \
        _Pragma("unroll") for (int hh = 0; hh < 2; ++hh) \
          PF[kb * 2 + hh] = __builtin_bit_cast(bf16x8, (u32x4){pack2(pv[8 * hh], pv[8 * hh + 1]), pack2(pv[8 * hh + 2], pv[8 * hh + 3]), \
                                                               pack2(pv[8 * hh + 4], pv[8 * hh + 5]), pack2(pv[8 * hh + 6], pv[8 * hh + 7])}); } \
      lrun += rs; }
#define ATT_PV(T) { const char* vb_ = smem + 32768 + ((T) & 1) * 16384; _Pragma("unroll") for (int eb = 0; eb < 4; ++eb) _Pragma("unroll") for (int s = 0; s < 4; ++s) { \
        const u32x2 v0 = *(const u32x2*)(vb_ + eb * 4096 + vfo + (((4 * s + fh) ^ vfs) << 3)); \
        const u32x2 v1 = *(const u32x2*)(vb_ + eb * 4096 + vfo + (((4 * s + fh + 2) ^ vfs) << 3)); \
        const bf16x8 vf = __builtin_bit_cast(bf16x8, (u32x4){v0[0], v0[1], v1[0], v1[1]}); \
        O[eb] = __builtin_amdgcn_mfma_f32_32x32x16_bf16(vf, pf[s], O[eb], 0, 0, 0); } }
  f32x16 S[2];
  float alpha;
  {
#pragma unroll
    for (int i = 0; i < 4; ++i) rk[i] = *(const u32x4*)(ksrc + (size_t)(64 + i * 16) * ZW);
#pragma unroll
    for (int i = 0; i < 4; ++i) rv[i] = *(const u32x4*)(vsrc + (size_t)i * 32 * NTOK);
    ATT_S(0)
    ATT_MAX()
    ATT_EXP(pf)
#pragma unroll
    for (int i = 0; i < 4; ++i) *(u32x4*)(smem + 16384 + kdst + i * 4096) = rk[i];
#pragma unroll
    for (int i = 0; i < 4; ++i) {
      *(u32x2*)(smem + 32768 + vdst0 + i * 4096) = (u32x2){rv[i][0], rv[i][1]};
      *(u32x2*)(smem + 32768 + vdst1 + i * 4096) = (u32x2){rv[i][2], rv[i][3]};
    }
    __syncthreads();
  }
#pragma unroll 1
  for (int t = 1; t < ntiles; ++t) {
    const int tn = (t + 1 < ntiles) ? t + 1 : t;
#pragma unroll
    for (int i = 0; i < 4; ++i) rk[i] = *(const u32x4*)(ksrc + (size_t)(tn * 64 + i * 16) * ZW);
#pragma unroll
    for (int i = 0; i < 4; ++i) rv[i] = *(const u32x4*)(vsrc + (size_t)i * 32 * NTOK + t * 64);
    ATT_S(t)
    ATT_MAX()
    if (__any(alpha != 1.f)) {
#pragma unroll
      for (int eb = 0; eb < 4; ++eb)
#pragma unroll
        for (int i = 0; i < 16; ++i) O[eb][i] *= alpha;
      lrun *= alpha;
#pragma unroll
      for (int s = 0; s < 4; ++s) {
        const u32x4 r_ = __builtin_bit_cast(u32x4, pf[s]);
        pf[s] = __builtin_bit_cast(bf16x8, (u32x4){pack2(lo16(r_[0]) * alpha, hi16(r_[0]) * alpha), pack2(lo16(r_[1]) * alpha, hi16(r_[1]) * alpha),
                                                   pack2(lo16(r_[2]) * alpha, hi16(r_[2]) * alpha), pack2(lo16(r_[3]) * alpha, hi16(r_[3]) * alpha)});
      }
    }
    bf16x8 pn[4];
    {
      ATT_PV(t - 1)
      ATT_EXP(pn)
#pragma unroll
      for (int i = 0; i < 16; ++i) {
        __builtin_amdgcn_sched_group_barrier(0x100, 1, 0);
        __builtin_amdgcn_sched_group_barrier(0x008, 1, 0);
        __builtin_amdgcn_sched_group_barrier(0x002, 9, 0);
      }
    }
#pragma unroll
    for (int s = 0; s < 4; ++s) pf[s] = pn[s];
    if (t + 1 < ntiles) {
      char* kd = smem + ((t + 1) & 1) * 16384;
#pragma unroll
      for (int i = 0; i < 4; ++i) *(u32x4*)(kd + kdst + i * 4096) = rk[i];
    }
    {
      char* vd = smem + 32768 + (t & 1) * 16384;
#pragma unroll
      for (int i = 0; i < 4; ++i) {
        *(u32x2*)(vd + vdst0 + i * 4096) = (u32x2){rv[i][0], rv[i][1]};
        *(u32x2*)(vd + vdst1 + i * 4096) = (u32x2){rv[i][2], rv[i][3]};
      }
    }
    __syncthreads();
  }
  ATT_PV(ntiles - 1)
  __syncthreads();
#undef ATT_S
#undef ATT_MAX
#undef ATT_EXP
#undef ATT_PV
  const float lt = lrun + __shfl_xor(lrun, 32);
  const float sc = (m ? lam : 1.0f) / lt;
  float* xo = (float*)smem + rb * 4096;
  if (m == 1) {
#pragma unroll
    for (int eb = 0; eb < 4; ++eb)
#pragma unroll
      for (int i = 0; i < 16; ++i) xo[(eb * 32 + (i & 3) + 8 * (i >> 2) + 4 * fh) * 32 + fr] = O[eb][i] * sc;
  }
  __syncthreads();
  if (m == 0) {
    float ss = 0.f;
#pragma unroll
    for (int eb = 0; eb < 4; ++eb)
#pragma unroll
      for (int i = 0; i < 16; ++i) {
        const float o = O[eb][i] * sc - xo[(eb * 32 + (i & 3) + 8 * (i >> 2) + 4 * fh) * 32 + fr];
        O[eb][i] = o; ss = fmaf(o, o, ss);
      }
    ss += __shfl_xor(ss, 32);
    const float rn = rsqrtf(ss * (1.0f / 128.0f) + EPSF) * (1.0f - lam_init);
    const float* sg = p.in[I_SUBG] + l * 512 + h * 128;
    bf16_t* yp = YAb + (size_t)myrow * 512 + h * 128;
#pragma unroll
    for (int eb = 0; eb < 4; ++eb)
#pragma unroll
      for (int q = 0; q < 4; ++q) {
        const int e = eb * 32 + 8 * q + 4 * fh;
        const float4 g = *(const float4*)(sg + e);
        *(u32x2*)(yp + e) = (u32x2){pack2(O[eb][4 * q] * rn * g.x, O[eb][4 * q + 1] * rn * g.y), pack2(O[eb][4 * q + 2] * rn * g.z, O[eb][4 * q + 3] * rn * g.w)};
      }
  }
  __syncthreads();
}

__device__ __forceinline__ int mlstm_row0(int dir, int c) {
  return (dir == 0) ? ((c < 4) ? NLAT + 64 * c : 64 * (c - 4)) : ((c < 4) ? NLAT + 64 * (3 - c) : 64 * (67 - c));
}
__device__ __forceinline__ void stage_mlgates(const Params& p, int l, const float* MGT, float* GA) {
  const int tid = otid(), w = tid >> 6, lane = tid & 63;
  const int nitems = GB * 4 * 2 * 68;
  for (int idx = blockIdx.x * 4 + w; idx < nitems; idx += gridDim.x * 4) {
    const int c = idx % 68, r1 = idx / 68, dir = r1 & 1, h = (r1 >> 1) & 3, bl = r1 >> 3;
    const int row = mlstm_row0(dir, c) + lane;
    const float* mg = MGT + ((size_t)bl * NTOK + row) * 16;
    const float li = mg[dir * 8 + h] + p.in[I_GATEB][l * 16 + dir * 8 + h];
    const float x = mg[dir * 8 + 4 + h] + p.in[I_GATEB][l * 16 + dir * 8 + 4 + h];
    const float lf = fminf(x, 0.f) - log1pf(expf(-fabsf(x)));
    float b = lf;
#pragma unroll
    for (int o = 1; o < 64; o <<= 1) {
      const float v = (dir == 0) ? __shfl_up(b, o) : __shfl_down(b, o);
      const bool ok = (dir == 0) ? (lane >= o) : (lane + o < 64);
      if (ok) b += v;
    }
    const float tot = (dir == 0) ? __shfl(b, 63) : __shfl(b, 0);
    float* ga = GA + (size_t)idx * 272;
    ga[lane] = b * 1.4426950408889634f; ga[64 + lane] = (li - b) * 1.4426950408889634f; ga[128 + lane] = expf(tot + li - b); ga[192 + lane] = expf(b);
    if (lane < 4) ga[256 + lane] = expf(tot);
  }
}

__device__ __forceinline__ void mlstm_chain_item(const Params& p, int l, const bf16_t* QMb, const bf16_t* KMb, const bf16_t* KMTb, const bf16_t* MVTb,
                                                 const float* GAc, bf16_t* HXb, int h, int dir, int ehalf, char* smem) {
  const int tid = otid(), lane = tid & 63, w = tid >> 6, fr = lane & 31, fh = lane >> 5;
  const int tb = w & 1, xb = w >> 1;
  float* fl = (float*)(smem + 73728);
  float* bs = fl; float* as_ = fl + 64; float* wgs = fl + 128; float* ebs = fl + 192; float* dec_s = fl + 256; float* nprev = fl + 272; float* npart = fl + 400;
  f32x16 CT[2];
#pragma unroll
  for (int eb = 0; eb < 2; ++eb)
#pragma unroll
    for (int i = 0; i < 16; ++i) CT[eb][i] = 0.f;
  __syncthreads();
  for (int i = tid; i < 1024; i += 256) ((u32x4*)(smem + 57344))[i] = (u32x4){0u, 0u, 0u, 0u};
  if (tid < 128) nprev[tid] = 0.f;
  const int qr = tid >> 4, qc = tid & 15;
  const int qdst = qr * 256 + ((qc ^ (qr & 15)) << 4);
  const int tr = tid >> 3, tc = tid & 7;
  const int tdst = tr * 128 + ((tc ^ ((tr >> 1) & 7)) << 4);
  const int sw16 = fr & 15, sw8 = (fr >> 1) & 7;
  u32x4 ra[4], rb[4], rc[4], rd[2];
  float4 rg = make_float4(0.f, 0.f, 0.f, 0.f);
#define ML_LOAD(C_) { const int r0_ = mlstm_row0(dir, (C_)); \
    const bf16_t* qs = QMb + (size_t)(r0_ + qr) * 512 + h * 128 + qc * 8; \
    const bf16_t* ks = KMb + (size_t)(r0_ + qr) * 512 + h * 128 + qc * 8; \
    const bf16_t* kts = KMTb + ((size_t)h * 128 + tr) * NTOK + r0_ + tc * 8; \
    const bf16_t* vts = MVTb + ((size_t)h * 128 + ehalf * 64 + tr) * NTOK + r0_ + tc * 8; \
    _Pragma("unroll") for (int i = 0; i < 4; ++i) { ra[i] = *(const u32x4*)(qs + (size_t)i * 16 * 512); rb[i] = *(const u32x4*)(ks + (size_t)i * 16 * 512); \
                                                    rc[i] = *(const u32x4*)(kts + (size_t)i * 32 * NTOK); } \
    _Pragma("unroll") for (int i = 0; i < 2; ++i) rd[i] = *(const u32x4*)(vts + (size_t)i * 32 * NTOK); \
    if (tid < 68) rg = ((const float4*)(GAc + (size_t)(C_) * 272))[tid]; }
  ML_LOAD(0)
#pragma unroll 1
  for (int c = 0; c < 68; ++c) {
    const int row0 = mlstm_row0(dir, c);
    __syncthreads();
#pragma unroll
    for (int i = 0; i < 4; ++i) {
      *(u32x4*)(smem + qdst + i * 4096) = ra[i];
      *(u32x4*)(smem + 16384 + qdst + i * 4096) = rb[i];
      *(u32x4*)(smem + 32768 + tdst + i * 4096) = rc[i];
    }
#pragma unroll
    for (int i = 0; i < 2; ++i) *(u32x4*)(smem + 49152 + tdst + i * 4096) = rd[i];
    if (tid < 68) ((float4*)fl)[tid] = rg;
    if (c + 1 < 68) ML_LOAD(c + 1)
    __syncthreads();
    const int t = tb * 32 + fr;
    bf16x8 qf[8];
#pragma unroll
    for (int ks = 0; ks < 8; ++ks) qf[ks] = *(const bf16x8*)(smem + t * 256 + (((ks * 2 + fh) ^ sw16) << 4));
    const float bt = bs[t], ebt = ebs[t];
    f32x16 S[2];
    float dsum = 0.f;
#pragma unroll
    for (int sb = 0; sb < 2; ++sb) {
#pragma unroll
      for (int i = 0; i < 16; ++i) S[sb][i] = 0.f;
      const bool valid = (dir == 0) ? (sb <= tb) : (sb >= tb);
      if (valid) {
#pragma unroll
        for (int ks = 0; ks < 8; ++ks) {
          const bf16x8 kf = *(const bf16x8*)(smem + 16384 + (sb * 32 + fr) * 256 + (((ks * 2 + fh) ^ sw16) << 4));
          S[sb] = __builtin_amdgcn_mfma_f32_32x32x16_bf16(kf, qf[ks], S[sb], 0, 0, 0);
        }
#pragma unroll
        for (int q = 0; q < 4; ++q) {
          const float4 a4 = *(const float4*)(as_ + sb * 32 + 8 * q + 4 * fh);
          const float av[4] = {a4.x, a4.y, a4.z, a4.w};
#pragma unroll
          for (int j = 0; j < 4; ++j) {
            const int s = sb * 32 + 8 * q + 4 * fh + j;
            const bool ok = (dir == 0) ? (s <= t) : (s >= t);
            const float v = ok ? S[sb][4 * q + j] * __builtin_amdgcn_exp2f(bt + av[j]) : 0.f;
            S[sb][4 * q + j] = v;
            dsum += v;
          }
        }
      }
    }
    bf16x8 pf[4];
#pragma unroll
    for (int sb = 0; sb < 2; ++sb)
#pragma unroll
      for (int hh = 0; hh < 2; ++hh)
        pf[sb * 2 + hh] = __builtin_bit_cast(bf16x8, (u32x4){pack2(S[sb][8 * hh], S[sb][8 * hh + 1]), pack2(S[sb][8 * hh + 2], S[sb][8 * hh + 3]),
                                                                 pack2(S[sb][8 * hh + 4], S[sb][8 * hh + 5]), pack2(S[sb][8 * hh + 6], S[sb][8 * hh + 7])});
    float nq = 0.f;
#pragma unroll
    for (int c8 = 0; c8 < 8; ++c8) {
      const u32x4 qv = *(const u32x4*)(smem + t * 256 + (((fh * 8 + c8) ^ sw16) << 4));
      const float4 n0 = *(const float4*)(nprev + fh * 64 + c8 * 8), n1 = *(const float4*)(nprev + fh * 64 + c8 * 8 + 4);
      nq = fmaf(lo16(qv[0]), n0.x, nq); nq = fmaf(hi16(qv[0]), n0.y, nq); nq = fmaf(lo16(qv[1]), n0.z, nq); nq = fmaf(hi16(qv[1]), n0.w, nq);
      nq = fmaf(lo16(qv[2]), n1.x, nq); nq = fmaf(hi16(qv[2]), n1.y, nq); nq = fmaf(lo16(qv[3]), n1.z, nq); nq = fmaf(hi16(qv[3]), n1.w, nq);
    }
    dsum += __shfl_xor(dsum, 32);
    nq += __shfl_xor(nq, 32);
    const float den = dsum + ebt * nq;
    const float inv = 1.0f / fmaxf(fabsf(den), 1.0f);
    {
      f32x16 N;
#pragma unroll
      for (int i = 0; i < 16; ++i) N[i] = 0.f;
#pragma unroll
      for (int ks = 0; ks < 8; ++ks) {
        const bf16x8 cf = *(const bf16x8*)(smem + 57344 + (xb * 32 + fr) * 256 + (((ks * 2 + fh) ^ sw16) << 4));
        N = __builtin_amdgcn_mfma_f32_32x32x16_bf16(cf, qf[ks], N, 0, 0, 0);
      }
#pragma unroll
      for (int i = 0; i < 16; ++i) N[i] *= ebt;
#pragma unroll
      for (int s4 = 0; s4 < 4; ++s4) {
        const bool valid = (dir == 0) ? ((s4 >> 1) <= tb) : ((s4 >> 1) >= tb);
        if (valid) {
          const int u0 = 4 * s4 + fh, u1 = u0 + 2;
          const char* vrow = smem + 49152 + (xb * 32 + fr) * 128;
          const u32x2 v0 = *(const u32x2*)(vrow + (((u0 >> 1) ^ sw8) << 4) + (u0 & 1) * 8);
          const u32x2 v1 = *(const u32x2*)(vrow + (((u1 >> 1) ^ sw8) << 4) + (u1 & 1) * 8);
          const bf16x8 vf = __builtin_bit_cast(bf16x8, (u32x4){v0[0], v0[1], v1[0], v1[1]});
          N = __builtin_amdgcn_mfma_f32_32x32x16_bf16(vf, pf[s4], N, 0, 0, 0);
        }
      }
      bf16_t* hp = HXb + (size_t)(row0 + t) * 512 + h * 128 + (2 * ehalf + xb) * 32 + 4 * fh;
#pragma unroll
      for (int q = 0; q < 4; ++q)
        *(u32x2*)(hp + 8 * q) = (u32x2){pack2(N[4 * q] * inv, N[4 * q + 1] * inv), pack2(N[4 * q + 2] * inv, N[4 * q + 3] * inv)};
    }
    const float decay = *dec_s;
#pragma unroll
    for (int eb = 0; eb < 2; ++eb)
#pragma unroll
      for (int i = 0; i < 16; ++i) CT[eb][i] *= decay;
#pragma unroll
    for (int ks = 0; ks < 4; ++ks) {
      const u32x4 kraw = *(const u32x4*)(smem + 32768 + (w * 32 + fr) * 128 + (((ks * 2 + fh) ^ sw8) << 4));
      const float4 g0 = *(const float4*)(wgs + ks * 16 + 8 * fh), g1 = *(const float4*)(wgs + ks * 16 + 8 * fh + 4);
      const bf16x8 kts = __builtin_bit_cast(bf16x8, (u32x4){pack2(lo16(kraw[0]) * g0.x, hi16(kraw[0]) * g0.y), pack2(lo16(kraw[1]) * g0.z, hi16(kraw[1]) * g0.w),
                                                             pack2(lo16(kraw[2]) * g1.x, hi16(kraw[2]) * g1.y), pack2(lo16(kraw[3]) * g1.z, hi16(kraw[3]) * g1.w)});
#pragma unroll
      for (int eb = 0; eb < 2; ++eb) {
        const bf16x8 vt = *(const bf16x8*)(smem + 49152 + (eb * 32 + fr) * 128 + (((ks * 2 + fh) ^ sw8) << 4));
        CT[eb] = __builtin_amdgcn_mfma_f32_32x32x16_bf16(kts, vt, CT[eb], 0, 0, 0);
      }
    }
    {
      const int d = tid & 127, sh = tid >> 7;
      float a = 0.f;
#pragma unroll 8
      for (int s = sh * 32; s < sh * 32 + 32; ++s) {
        const bf16_t kv = *(const bf16_t*)(smem + 16384 + s * 256 + ((((d >> 3)) ^ (s & 15)) << 4) + (d & 7) * 2);
        a = fmaf(wgs[s], bf2f(kv), a);
      }
      npart[sh * 128 + d] = a;
    }
    __syncthreads();
#pragma unroll
    for (int eb = 0; eb < 2; ++eb)
#pragma unroll
      for (int q = 0; q < 4; ++q)
        *(u32x2*)(smem + 57344 + (eb * 32 + fr) * 256 + ((((w * 4 + q)) ^ sw16) << 4) + 8 * fh) =
            (u32x2){pack2(CT[eb][4 * q], CT[eb][4 * q + 1]), pack2(CT[eb][4 * q + 2], CT[eb][4 * q + 3])};
    if (tid < 128) nprev[tid] = decay * nprev[tid] + npart[tid] + npart[128 + tid];
  }
#undef ML_LOAD
  __syncthreads();
}

#define S5SEG 128
#define S5NSEG 34
__device__ __forceinline__ int s5_row(int dir, int step) {
  return (dir == 0) ? ((step < NCTX) ? NLAT + step : step - NCTX)
                    : ((step < NCTX) ? NLAT + (NCTX - 1 - step) : (NLAT - 1) - (step - NCTX));
}
__device__ __forceinline__ bf16x8 pack8(const float* f) {
  return __builtin_bit_cast(bf16x8, (u32x4){pack2(f[0], f[1]), pack2(f[2], f[3]), pack2(f[4], f[5]), pack2(f[6], f[7])});
}
struct S5M { float abr, abi, a128r, a128i; bf16x8 bbf[4]; };
__device__ __forceinline__ void s5m_setup(const Params& p, int pg, int lane, S5M& m) {
  const int fr = lane & 31, fh = lane >> 5;
  const float dt = expf(p.in[I_S5DT][pg]);
  m.abr = 0.f; m.abi = 0.f; m.a128r = 0.f; m.a128i = 0.f;
#pragma unroll
  for (int c = 0; c < 2; ++c) {
    const int n = fr + 32 * c;
    const float lre = p.in[I_S5LRE][pg * 64 + n], lim = p.in[I_S5LIM][pg * 64 + n];
    const float mag = expf(lre * dt);
    const float abr = mag * cosf(lim * dt), abi = mag * sinf(lim * dt);
    const float den = lre * lre + lim * lim;
    const float zr = ((abr - 1.0f) * lre + abi * lim) / den;
    const float zi = (abi * lre - (abr - 1.0f) * lim) / den;
    const float4* br4 = (const float4*)(p.in[I_S5BRE] + ((size_t)pg * 64 + n) * 16 + 8 * fh);
    const float4* bi4 = (const float4*)(p.in[I_S5BIM] + ((size_t)pg * 64 + n) * 16 + 8 * fh);
    const float4 b0 = br4[0], b1 = br4[1], c0 = bi4[0], c1 = bi4[1];
    const float br[8] = {b0.x, b0.y, b0.z, b0.w, b1.x, b1.y, b1.z, b1.w}, bi[8] = {c0.x, c0.y, c0.z, c0.w, c1.x, c1.y, c1.z, c1.w};
    float rr[8], ii[8];
#pragma unroll
    for (int j = 0; j < 8; ++j) { rr[j] = zr * br[j] - zi * bi[j]; ii[j] = zr * bi[j] + zi * br[j]; }
    m.bbf[c] = pack8(rr); m.bbf[2 + c] = pack8(ii);
    if (fh == c) {
      m.abr = abr; m.abi = abi;
      const float mg = expf(lre * dt * (float)S5SEG);
      m.a128r = mg * cosf(lim * dt * (float)S5SEG); m.a128i = mg * sinf(lim * dt * (float)S5SEG);
    }
  }
}
template <bool STORE>
__device__ __forceinline__ void s5m_block(const S5M& m, const bf16x8 uf, float& xr, float& xi, char* xs, int lane) {
  f32x16 T[4];
#pragma unroll
  for (int k = 0; k < 4; ++k) {
#pragma unroll
    for (int i = 0; i < 16; ++i) T[k][i] = 0.f;
    T[k] = __builtin_amdgcn_mfma_f32_32x32x16_bf16(uf, m.bbf[k], T[k], 0, 0, 0);
  }
#pragma unroll
  for (int r = 0; r < 16; ++r) {
    auto a = __builtin_amdgcn_permlane32_swap(__float_as_uint(T[0][r]), __float_as_uint(T[1][r]), false, false);
    T[0][r] = __uint_as_float(a[0]); T[1][r] = __uint_as_float(a[1]);
    auto b = __builtin_amdgcn_permlane32_swap(__float_as_uint(T[2][r]), __float_as_uint(T[3][r]), false, false);
    T[2][r] = __uint_as_float(b[0]); T[3][r] = __uint_as_float(b[1]);
  }
#pragma unroll
  for (int q = 0; q < 4; ++q)
#pragma unroll
    for (int hh = 0; hh < 2; ++hh)
#pragma unroll
      for (int j = 0; j < 4; ++j) {
        const int t = 8 * q + 4 * hh + j, r = 4 * q + j;
        const float bre = hh ? T[1][r] : T[0][r], bim = hh ? T[3][r] : T[2][r];
        const float nr = fmaf(m.abr, xr, fmaf(-m.abi, xi, bre));
        const float ni = fmaf(m.abr, xi, fmaf(m.abi, xr, bim));
        xr = nr; xi = ni;
        if (STORE) *(unsigned*)(xs + t * 256 + (((lane >> 2) ^ (t & 15)) << 4) + (lane & 3) * 4) = pack2(xr, xi);
      }
}
__device__ __forceinline__ void stage_s5_pass1(const Params& p, int l, const bf16_t* Z, float* XE) {
  const int tid = otid(), w = tid >> 6, lane = tid & 63, fr = lane & 31, fh = lane >> 5;
  const int nitems = GB * 32 * 2 * (S5NSEG - 1);
  for (int idx = blockIdx.x * 4 + w; idx < nitems; idx += gridDim.x * 4) {
    const int seg = idx % (S5NSEG - 1), r1 = idx / (S5NSEG - 1), dir = r1 & 1, g = (r1 >> 1) & 31, bl = r1 >> 6;
    S5M m;
    s5m_setup(p, (l * 2 + dir) * 32 + g, lane, m);
    float xr = 0.f, xi = 0.f;
    bf16x8 ufs[S5SEG / 32];
#pragma unroll
    for (int sub = 0; sub < S5SEG / 32; ++sub) {
      const int row = s5_row(dir, seg * S5SEG + sub * 32 + fr);
      ufs[sub] = *(const bf16x8*)(Z + ((size_t)bl * NTOK + row) * ZW + 3072 + g * 16 + 8 * fh);
    }
#pragma unroll
    for (int sub = 0; sub < S5SEG / 32; ++sub) s5m_block<false>(m, ufs[sub], xr, xi, nullptr, lane);
    float* xe = XE + ((((size_t)bl * 32 + g) * 2 + dir) * (S5NSEG - 1) + seg) * 128;
    xe[lane] = xr; xe[64 + lane] = xi;
  }
}
__device__ __forceinline__ void s5_item(const Params& p, int l, const bf16_t* Zb, const float* XEc, float* Yb, int g, int dir, int sq, char* smem) {
  const int tid = otid(), w = tid >> 6, lane = tid & 63, fr = lane & 31, fh = lane >> 5;
  const int seg = sq * 4 + w;
  char* xs = smem + w * 8192;
  const int pg = (l * 2 + dir) * 32 + g;
  __syncthreads();
  if (seg < S5NSEG) {
    S5M m;
    s5m_setup(p, pg, lane, m);
    bf16x8 ccf[8];
#pragma unroll
    for (int ks = 0; ks < 8; ++ks) {
      float f[8] = {0.f, 0.f, 0.f, 0.f, 0.f, 0.f, 0.f, 0.f};
      if (fr < 16) {
        const float4 cr = *(const float4*)(p.in[I_S5CRE] + ((size_t)pg * 16 + fr) * 64 + ks * 8 + 4 * fh);
        const float4 ci = *(const float4*)(p.in[I_S5CIM] + ((size_t)pg * 16 + fr) * 64 + ks * 8 + 4 * fh);
        f[0] = cr.x; f[1] = -ci.x; f[2] = cr.y; f[3] = -ci.y; f[4] = cr.z; f[5] = -ci.z; f[6] = cr.w; f[7] = -ci.w;
      }
      ccf[ks] = pack8(f);
    }
    float xr = 0.f, xi = 0.f;
    for (int j = 0; j < seg; ++j) {
      const float er = XEc[j * 128 + lane], ei = XEc[j * 128 + 64 + lane];
      const float nr = m.a128r * xr - m.a128i * xi + er, ni = m.a128r * xi + m.a128i * xr + ei;
      xr = nr; xi = ni;
    }
    bf16x8 ufs[S5SEG / 32];
#pragma unroll
    for (int sub = 0; sub < S5SEG / 32; ++sub) {
      const int row = s5_row(dir, seg * S5SEG + sub * 32 + fr);
      ufs[sub] = *(const bf16x8*)(Zb + (size_t)row * ZW + 3072 + g * 16 + 8 * fh);
    }
#pragma unroll
    for (int sub = 0; sub < S5SEG / 32; ++sub) {
      const int row = s5_row(dir, seg * S5SEG + sub * 32 + fr);
      const bf16x8 uf = ufs[sub];
      s5m_block<true>(m, uf, xr, xi, xs, lane);
      f32x16 Y;
#pragma unroll
      for (int i = 0; i < 16; ++i) Y[i] = 0.f;
#pragma unroll
      for (int ks = 0; ks < 8; ++ks) {
        const bf16x8 xf = *(const bf16x8*)(xs + fr * 256 + (((ks * 2 + fh) ^ (fr & 15)) << 4));
        Y = __builtin_amdgcn_mfma_f32_32x32x16_bf16(ccf[ks], xf, Y, 0, 0, 0);
      }
      float* yp = Yb + (size_t)row * 512 + g * 16 + 4 * fh;
      *(float4*)yp = make_float4(Y[0], Y[1], Y[2], Y[3]);
      *(float4*)(yp + 8) = make_float4(Y[4], Y[5], Y[6], Y[7]);
    }
  }
}

__device__ __forceinline__ void stage_post(const Params& p, int l, int rr_lim, const bf16_t* Z, const bf16_t* HF, const bf16_t* HB,
                                           const float* YSF, const float* YSB, bf16_t* YB, bf16_t* GG) {
  const int tid = otid();
  const int c0 = tid * 2;
  const float2 gml = *(const float2*)(p.in[I_MLNG] + l * 512 + c0);
  const float2 dsk = *(const float2*)(p.in[I_S5D] + l * 512 + c0);
  const int n = GB * rr_lim;
  for (int i0 = blockIdx.x * 4; i0 < n; i0 += gridDim.x * 4) {
    unsigned a0[4], a1[4], og[4], uu[4];
    float2 f[4], b[4];
    size_t r[4];
#pragma unroll
    for (int u = 0; u < 4; ++u) {
      const int i = i0 + u;
      r[u] = (size_t)(i / rr_lim) * NTOK + (i % rr_lim);
      a0[u] = *(const unsigned*)(HF + r[u] * 512 + c0); a1[u] = *(const unsigned*)(HB + r[u] * 512 + c0);
      og[u] = *(const unsigned*)(Z + r[u] * ZW + 2560 + c0); uu[u] = *(const unsigned*)(Z + r[u] * ZW + 3072 + c0);
      f[u] = *(const float2*)(YSF + r[u] * 512 + c0); b[u] = *(const float2*)(YSB + r[u] * 512 + c0);
    }
#pragma unroll
    for (int u = 0; u < 4; ++u) {
      const float h0 = lo16(a0[u]) + lo16(a1[u]), h1 = hi16(a0[u]) + hi16(a1[u]);
      const float ss = wave_sum(h0 * h0 + h1 * h1);
      const float rs = rsqrtf(ss * (1.0f / 128.0f) + EPSF);
      *(unsigned*)(YB + r[u] * 512 + c0) = pack2(h0 * rs * gml.x * sigmoidf_(lo16(og[u])), h1 * rs * gml.y * sigmoidf_(hi16(og[u])));
      *(unsigned*)(GG + r[u] * 512 + c0) = pack2(geluf_(dsk.x * lo16(uu[u]) + f[u].x + b[u].x), geluf_(dsk.y * hi16(uu[u]) + f[u].y + b[u].y));
    }
  }
}

__device__ __forceinline__ void stage_glu_mfma(const Params& p, int l, int tpb, const bf16_t* GG, const bf16_t* GLUT, bf16_t* YS, char* smem) {
  EPI_DECL
  const int tm = GB * tpb;
  TileIter ti(tm, 4);
  int mt_, nt_; bool valid;
  while (ti.next(mt_, nt_, valid)) {
    if (!valid) continue;
    const int m0 = MT_LR0(mt_, tpb), n0 = nt_ * 128;
    f32x16 acc[2][2];
    gemm_tile(GG + (size_t)m0 * 512, 512, GLUT + (size_t)n0 * 512, 512, 512, smem, acc);
#pragma unroll
    for (int mi = 0; mi < 2; ++mi)
#pragma unroll
      for (int ni = 0; ni < 2; ++ni)
#pragma unroll
        for (int q = 0; q < 4; ++q) {
          const int row = m0 + EPI_ROW(mi), c = n0 + EPI_COL(ni, q);
          const float4 b = *(const float4*)(p.in[I_GLUB] + l * 512 + c);
          const u32x2 g2 = *(const u32x2*)(GG + (size_t)row * 512 + c);
          const float o0 = lo16(g2[0]) * sigmoidf_(acc[mi][ni][4 * q] + b.x), o1 = hi16(g2[0]) * sigmoidf_(acc[mi][ni][4 * q + 1] + b.y);
          const float o2 = lo16(g2[1]) * sigmoidf_(acc[mi][ni][4 * q + 2] + b.z), o3 = hi16(g2[1]) * sigmoidf_(acc[mi][ni][4 * q + 3] + b.w);
          *(u32x2*)(YS + (size_t)row * 512 + c) = (u32x2){pack2(o0, o1), pack2(o2, o3)};
        }
  }
}

__device__ __forceinline__ void stage_merge_mfma(int tpb, const bf16_t* YA, const bf16_t* YB, const bf16_t* YS, const bf16_t* WBR, const bf16_t* Z, bf16_t* MG, char* smem) {
  EPI_DECL
  const int tm = GB * tpb;
  TileIter ti(tm, 8);
  int mt_, nt_; bool valid;
  while (ti.next(mt_, nt_, valid)) {
    if (!valid) continue;
    const int m0 = MT_LR0(mt_, tpb), n0 = nt_ * 128;
    f32x16 macc[2][2];
#pragma unroll
    for (int a = 0; a < 2; ++a)
#pragma unroll
      for (int b = 0; b < 2; ++b)
#pragma unroll
        for (int i = 0; i < 16; ++i) macc[a][b][i] = 0.f;
#pragma unroll 1
    for (int r = 0; r < 3; ++r) {
      const bf16_t* Y = (r == 0) ? YA : (r == 1 ? YB : YS);
      f32x16 acc[2][2];
      gemm_tile(Y + (size_t)m0 * 512, 512, WBR + (size_t)r * 1024 * 512 + (size_t)n0 * 512, 512, 512, smem, acc);
#pragma unroll
      for (int mi = 0; mi < 2; ++mi)
#pragma unroll
        for (int ni = 0; ni < 2; ++ni)
#pragma unroll
          for (int q = 0; q < 4; ++q) {
            const int row = m0 + EPI_ROW(mi), c = n0 + EPI_COL(ni, q);
            const u32x2 e = *(const u32x2*)(Z + (size_t)row * ZW + 3584 + r * 1024 + c);
            macc[mi][ni][4 * q] += lo16(e[0]) * acc[mi][ni][4 * q];
            macc[mi][ni][4 * q + 1] += hi16(e[0]) * acc[mi][ni][4 * q + 1];
            macc[mi][ni][4 * q + 2] += lo16(e[1]) * acc[mi][ni][4 * q + 2];
            macc[mi][ni][4 * q + 3] += hi16(e[1]) * acc[mi][ni][4 * q + 3];
          }
    }
#pragma unroll
    for (int mi = 0; mi < 2; ++mi)
#pragma unroll
      for (int ni = 0; ni < 2; ++ni)
#pragma unroll
        for (int q = 0; q < 4; ++q) {
          const int row = m0 + EPI_ROW(mi), c = n0 + EPI_COL(ni, q);
          *(u32x2*)(MG + (size_t)row * DM + c) = (u32x2){pack2(macc[mi][ni][4 * q], macc[mi][ni][4 * q + 1]), pack2(macc[mi][ni][4 * q + 2], macc[mi][ni][4 * q + 3])};
        }
  }
}

__device__ __forceinline__ void stage_outproj_mfma(const Params& p, int l, int g, int tpb, const bf16_t* MG, const bf16_t* WOUT, char* smem) {
  EPI_DECL
  const int tm = GB * tpb;
  const float* mod = (const float*)(p.ws + WB_MOD) + (size_t)l * 9 * 6144;
  TileIter ti(tm, 8);
  int mt, nt_; bool valid;
  while (ti.next(mt, nt_, valid)) {
    if (!valid) continue;
    const int n0 = nt_ * 128;
    const int m0 = MT_LR0(mt, tpb), bl = mt / tpb, rr0 = (mt % tpb) * 128, b = g * GB + bl;
    f32x16 acc[2][2];
    gemm_tile(MG + (size_t)m0 * DM, DM, WOUT + (size_t)n0 * DM, DM, DM, smem, acc);
    const float* gv = mod + (size_t)((rr0 < NLAT) ? b : 8) * 6144 + 2 * 1024;
#pragma unroll
    for (int mi = 0; mi < 2; ++mi)
#pragma unroll
      for (int ni = 0; ni < 2; ++ni)
#pragma unroll
        for (int q = 0; q < 4; ++q) {
          const int rr = rr0 + EPI_ROW(mi), c = n0 + EPI_COL(ni, q);
          const float4 gg = *(const float4*)(gv + c);
          float4* xp = (float4*)(xrow(p, b, rr) + c);
          float4 x = (l == 0) ? *(const float4*)(xrow_in(p, b, rr) + c) : *xp;
          x.x += gg.x * acc[mi][ni][4 * q]; x.y += gg.y * acc[mi][ni][4 * q + 1]; x.z += gg.z * acc[mi][ni][4 * q + 2]; x.w += gg.w * acc[mi][ni][4 * q + 3];
          *xp = x;
        }
  }
}

#define CH_SW(m_, chunk_) ((((chunk_) ^ ((m_) & 15))) << 4)
template <int KC, class BF, class AF, class PF, class EF>
__device__ __forceinline__ void cphase(const int nseg, const int lane, BF bbase, AF abase, PF pre, EF epi) {
  const int half = lane >> 5, sw = lane & 15;
  bf16x8 bs[4][2][4];
  const int S = nseg * KC;
#define CH_LD(ST, s_) { const int sg_ = (s_) / KC, c_ = (s_) % KC; const char* bp_ = bbase(sg_) + 4096 * c_; asm volatile("" : "+v"(bp_)); \
    const char* bq_ = bp_ + KC * 4096; asm volatile("" : "+v"(bq_));     \
    _Pragma("unroll") for (int ks_ = 0; ks_ < 4; ++ks_) { bs[ST][0][ks_] = *(const bf16x8*)(bp_ + 1024 * ks_); bs[ST][1][ks_] = *(const bf16x8*)(bq_ + 1024 * ks_); } }
  CH_LD(0, 0) CH_LD(1, 1) CH_LD(2, 2)
  f32x16 acc[2];
#pragma unroll
  for (int f = 0; f < 2; ++f)
#pragma unroll
    for (int i = 0; i < 16; ++i) acc[f][i] = 0.f;
#pragma unroll 1
  for (int s0 = 0; s0 < S; s0 += 4) {
#pragma unroll
    for (int j = 0; j < 4; ++j) {
      const int s = s0 + j;
      if (s + 3 < S) CH_LD((j + 3) & 3, s + 3)
      const int sg = s / KC, c = s % KC;
      const char* ap = abase(sg);
#pragma unroll
      for (int ks = 0; ks < 4; ++ks) {
        const bf16x8 a = *(const bf16x8*)(ap + (((8 * c + 4 * half + ks) ^ sw) << 4));
#pragma unroll
        for (int f = 0; f < 2; ++f) acc[f] = __builtin_amdgcn_mfma_f32_32x32x16_bf16(bs[j][f][ks], a, acc[f], 0, 0, 0);
      }
      if (j == 3 && c == KC - 5) pre(sg);
      if (j == 3 && c == KC - 1) {
        epi(sg, acc);
#pragma unroll
        for (int f = 0; f < 2; ++f)
#pragma unroll
          for (int i = 0; i < 16; ++i) acc[f][i] = 0.f;
      }
    }
  }
#undef CH_LD
}

__device__ __forceinline__ void stage_chain1(const Params& p, int l, int g, int rr_lim, const bf16_t* Z, const bf16_t* HF, const bf16_t* HB,
                                             const float* YSF, const float* YSB, const bf16_t* YA, bf16_t* MG, const bf16_t* W, char* smem) {
  const int tid = otid(), w = tid >> 6, lane = tid & 63, m = lane & 31, half = lane >> 5;
  const int tpb32 = rr_lim >> 5, ntile = GB * tpb32;
  const float* mod = (const float*)(p.ws + WB_MOD) + (size_t)l * 9 * 6144;
  const bf16_t* GLUT = W + WT_GLU; const bf16_t* WBR = W + WT_WBR; const bf16_t* WOUT = W + WT_WOUT;
  char* R0 = smem; char* R1 = smem + 32768; char* R2 = smem + 65536;
  const int c0 = tid * 2;
  const float2 gml = *(const float2*)(p.in[I_MLNG] + l * 512 + c0);
  const float2 dsk = *(const float2*)(p.in[I_S5D] + l * 512 + c0);
  const int rot = blockIdx.x >> 3;
  for (int t = blockIdx.x; t < ntile; t += gridDim.x) {
    const int bl = t / tpb32, rr0 = (t % tpb32) * 32, b = g * GB + bl;
    const size_t lr0 = (size_t)bl * NTOK + rr0;
    __syncthreads();
    for (int i0 = 0; i0 < 32; i0 += 4) {
      unsigned a0[4], a1[4], og[4], uu[4];
      float2 f[4], bb[4];
#pragma unroll
      for (int u = 0; u < 4; ++u) {
        const size_t r = lr0 + i0 + u;
        a0[u] = *(const unsigned*)(HF + r * 512 + c0); a1[u] = *(const unsigned*)(HB + r * 512 + c0);
        og[u] = *(const unsigned*)(Z + r * ZW + 2560 + c0); uu[u] = *(const unsigned*)(Z + r * ZW + 3072 + c0);
        f[u] = *(const float2*)(YSF + r * 512 + c0); bb[u] = *(const float2*)(YSB + r * 512 + c0);
      }
#pragma unroll
      for (int u = 0; u < 4; ++u) {
        const float h0 = lo16(a0[u]) + lo16(a1[u]), h1 = hi16(a0[u]) + hi16(a1[u]);
        const float ss = wave_sum(h0 * h0 + h1 * h1);
        const float rs = rsqrtf(ss * (1.0f / 128.0f) + EPSF);
        const int mm = i0 + u, off = mm * 1024 + CH_SW(mm, c0 >> 3) + (c0 & 7) * 2;
        *(unsigned*)(R1 + off) = pack2(h0 * rs * gml.x * sigmoidf_(lo16(og[u])), h1 * rs * gml.y * sigmoidf_(hi16(og[u])));
        *(unsigned*)(R0 + off) = pack2(geluf_(dsk.x * lo16(uu[u]) + f[u].x + bb[u].x), geluf_(dsk.y * hi16(uu[u]) + f[u].y + bb[u].y));
      }
    }
    __syncthreads();
    {
      float4 bv[2][4];
      cphase<8>(2, lane,
        [&](int sg) __attribute__((always_inline)) { const int cb = (w * 2 + sg + rot) & 7; return (const char*)(GLUT + (size_t)(cb * 2) * (8 * 2048)) + lane * 16; },
        [&](int sg) __attribute__((always_inline)) { return (const char*)(R0 + m * 1024); },
        [&](int sg) __attribute__((always_inline)) {
          const int n0 = ((w * 2 + sg + rot) & 7) * 64;
#pragma unroll
          for (int f = 0; f < 2; ++f)
#pragma unroll
            for (int q = 0; q < 4; ++q) bv[f][q] = *(const float4*)(p.in[I_GLUB] + l * 512 + n0 + f * 32 + 8 * q + 4 * half);
        },
        [&](int sg, f32x16 (&acc)[2]) __attribute__((always_inline)) {
          const int n0 = ((w * 2 + sg + rot) & 7) * 64;
#pragma unroll
          for (int f = 0; f < 2; ++f)
#pragma unroll
            for (int q = 0; q < 4; ++q) {
              const int c = n0 + f * 32 + 8 * q + 4 * half;
              const int off = m * 1024 + CH_SW(m, c >> 3) + 8 * half;
              const u32x2 g2 = *(const u32x2*)(R0 + off);
              const float o0 = lo16(g2[0]) * sigmoidf_(acc[f][4 * q] + bv[f][q].x), o1 = hi16(g2[0]) * sigmoidf_(acc[f][4 * q + 1] + bv[f][q].y);
              const float o2 = lo16(g2[1]) * sigmoidf_(acc[f][4 * q + 2] + bv[f][q].z), o3 = hi16(g2[1]) * sigmoidf_(acc[f][4 * q + 3] + bv[f][q].w);
              *(u32x2*)(R2 + off) = (u32x2){pack2(o0, o1), pack2(o2, o3)};
            }
        });
    }
    __syncthreads();
    for (int i = tid; i < 32 * 64; i += 256) {
      const int mm = i >> 6, ch = i & 63;
      *(u32x4*)(R0 + mm * 1024 + CH_SW(mm, ch)) = *(const u32x4*)(YA + (lr0 + mm) * 512 + ch * 8);
    }
    __syncthreads();
    {
      f32x16 macc[2];
#pragma unroll
      for (int f = 0; f < 2; ++f)
#pragma unroll
        for (int i = 0; i < 16; ++i) macc[f][i] = 0.f;
      u32x2 e[2][4];
      const size_t row = lr0 + m;
      cphase<8>(12, lane,
        [&](int sg) __attribute__((always_inline)) { const int pass = sg / 3, r = sg % 3, cb = (w * 4 + pass + rot) & 15; return (const char*)(WBR + (size_t)r * 1024 * 512 + (size_t)(cb * 2) * (8 * 2048)) + lane * 16; },
        [&](int sg) __attribute__((always_inline)) { const int r = sg % 3; return (const char*)(smem + r * 32768 + m * 1024); },
        [&](int sg) __attribute__((always_inline)) {
          const int pass = sg / 3, r = sg % 3, n0 = ((w * 4 + pass + rot) & 15) * 64;
#pragma unroll
          for (int f = 0; f < 2; ++f)
#pragma unroll
            for (int q = 0; q < 4; ++q) e[f][q] = *(const u32x2*)(Z + row * ZW + 3584 + r * 1024 + n0 + f * 32 + 8 * q + 4 * half);
        },
        [&](int sg, f32x16 (&acc)[2]) __attribute__((always_inline)) {
          const int pass = sg / 3, r = sg % 3, n0 = ((w * 4 + pass + rot) & 15) * 64;
#pragma unroll
          for (int f = 0; f < 2; ++f)
#pragma unroll
            for (int q = 0; q < 4; ++q) {
              macc[f][4 * q] += lo16(e[f][q][0]) * acc[f][4 * q];
              macc[f][4 * q + 1] += hi16(e[f][q][0]) * acc[f][4 * q + 1];
              macc[f][4 * q + 2] += lo16(e[f][q][1]) * acc[f][4 * q + 2];
              macc[f][4 * q + 3] += hi16(e[f][q][1]) * acc[f][4 * q + 3];
            }
          if (r == 2) {
#pragma unroll
            for (int f = 0; f < 2; ++f)
#pragma unroll
              for (int q = 0; q < 4; ++q) {
                const int c = n0 + f * 32 + 8 * q + 4 * half;
                *(u32x2*)(MG + row * DM + c) = (u32x2){pack2(macc[f][4 * q], macc[f][4 * q + 1]), pack2(macc[f][4 * q + 2], macc[f][4 * q + 3])};
              }
#pragma unroll
            for (int f = 0; f < 2; ++f)
#pragma unroll
              for (int i = 0; i < 16; ++i) macc[f][i] = 0.f;
          }
        });
    }
    __builtin_amdgcn_fence(__ATOMIC_RELEASE, "agent");
    __syncthreads();
    __builtin_amdgcn_fence(__ATOMIC_ACQUIRE, "agent");
    for (int i = tid; i < 32 * 128; i += 256) {
      const int mm = i >> 7, ch = i & 127;
      *(u32x4*)(smem + mm * 2048 + CH_SW(mm, ch)) = *(const u32x4*)(MG + (lr0 + mm) * DM + ch * 8);
    }
    __syncthreads();
    {
      const float* gv = mod + (size_t)((rr0 < NLAT) ? b : 8) * 6144 + 2 * 1024;
      const int rr = rr0 + m;
      float4 xg[2][4], xx[2][4];
      cphase<16>(4, lane,
        [&](int sg) __attribute__((always_inline)) { const int cb = (w * 4 + sg + rot) & 15; return (const char*)(WOUT + (size_t)(cb * 2) * (16 * 2048)) + lane * 16; },
        [&](int sg) __attribute__((always_inline)) { return (const char*)(smem + m * 2048); },
        [&](int sg) __attribute__((always_inline)) {
          const int n0 = ((w * 4 + sg + rot) & 15) * 64;
#pragma unroll
          for (int f = 0; f < 2; ++f)
#pragma unroll
            for (int q = 0; q < 4; ++q) {
              const int c = n0 + f * 32 + 8 * q + 4 * half;
              xg[f][q] = *(const float4*)(gv + c);
              xx[f][q] = (l == 0) ? *(const float4*)(xrow_in(p, b, rr) + c) : *(const float4*)(xrow(p, b, rr) + c);
            }
        },
        [&](int sg, f32x16 (&acc)[2]) __attribute__((always_inline)) {
          const int n0 = ((w * 4 + sg + rot) & 15) * 64;
#pragma unroll
          for (int f = 0; f < 2; ++f)
#pragma unroll
            for (int q = 0; q < 4; ++q) {
              const int c = n0 + f * 32 + 8 * q + 4 * half;
              float4 x = xx[f][q];
              const float4 gg = xg[f][q];
              x.x += gg.x * acc[f][4 * q]; x.y += gg.y * acc[f][4 * q + 1]; x.z += gg.z * acc[f][4 * q + 2]; x.w += gg.w * acc[f][4 * q + 3];
              *(float4*)(xrow(p, b, rr) + c) = x;
            }
        });
    }
  }
}

__device__ __forceinline__ void stage_peerq_mfma(int tpb, const bf16_t* H2, const bf16_t* WQ, bf16_t* PQ, char* smem) {
  EPI_DECL
  const int tm = GB * tpb;
  TileIter ti(tm, 16);
  int mt_, nt_; bool valid;
  while (ti.next(mt_, nt_, valid)) {
    if (!valid) continue;
    const int m0 = MT_LR0(mt_, tpb), n0 = nt_ * 128;
    f32x16 acc[2][2];
    gemm_tile(H2 + (size_t)m0 * DM, DM, WQ + (size_t)n0 * DM, DM, DM, smem, acc);
#pragma unroll
    for (int mi = 0; mi < 2; ++mi)
#pragma unroll
      for (int ni = 0; ni < 2; ++ni)
#pragma unroll
        for (int q = 0; q < 4; ++q) {
          const int row = m0 + EPI_ROW(mi), c = n0 + EPI_COL(ni, q);
          *(u32x2*)(PQ + (size_t)row * 2048 + c) = (u32x2){pack2(acc[mi][ni][4 * q], acc[mi][ni][4 * q + 1]), pack2(acc[mi][ni][4 * q + 2], acc[mi][ni][4 * q + 3])};
        }
  }
}

__device__ __forceinline__ unsigned f2sortable(float x) { const unsigned u = __float_as_uint(x); return (u & 0x80000000u) ? ~u : (u | 0x80000000u); }
__device__ __forceinline__ float sortable2f(unsigned k) { return __uint_as_float((k & 0x80000000u) ? (k & 0x7fffffffu) : ~k); }
#define TOPK_INSERT(v, key) { unsigned t_ = (key); _Pragma("unroll") for (int s_ = 0; s_ < 16; ++s_) { const unsigned hi_ = max(v[s_], t_); t_ = min(v[s_], t_); v[s_] = hi_; } }
__device__ __forceinline__ void stage_scores_topk(int tpb, const bf16_t* PQ, const bf16_t* SUBK, int* EI, float* EG, char* smem) {
  EPI_DECL
  const int tid = tid_;
  const int item = tid & 127, kpart = tid >> 7;
  float* S = (float*)smem;
  unsigned* xk = (unsigned*)(smem + 128 * 129 * 4);
  const int tm = GB * tpb * 8;
  for (int mt = blockIdx.x; mt < tm; mt += gridDim.x) {
    const size_t m0 = (size_t)MT_LR0(mt >> 3, tpb) * 8 + (size_t)(mt & 7) * 128;
    unsigned vh[2][16];
#pragma unroll
    for (int half = 0; half < 2; ++half) {
      f32x16 acc[2][2];
      gemm_tile(PQ + m0 * 256 + half * 128, 256, SUBK + (size_t)half * 16384, 128, 128, smem, acc);
#pragma unroll
      for (int mi = 0; mi < 2; ++mi)
#pragma unroll
        for (int ni = 0; ni < 2; ++ni)
#pragma unroll
          for (int i = 0; i < 16; ++i)
            S[EPI_ROW(mi) * 129 + wn * 64 + ni * 32 + 8 * (i >> 2) + 4 * fh + (i & 3)] = acc[mi][ni][i];
      __syncthreads();
      unsigned v[16];
#pragma unroll
      for (int s = 0; s < 16; ++s) v[s] = 0u;
      const float* sr = S + item * 129 + kpart * 64;
#pragma unroll 8
      for (int k = 0; k < 64; ++k) {
        const unsigned key = (f2sortable(sr[k]) & ~127u) | (unsigned)(127 - (kpart * 64 + k));
        TOPK_INSERT(v, key)
      }
      if (kpart == 1) {
#pragma unroll
        for (int s = 0; s < 16; ++s) xk[item * 17 + s] = v[s];
      }
      __syncthreads();
      if (kpart == 0) {
#pragma unroll
        for (int s = 0; s < 16; ++s) { const unsigned key = xk[item * 17 + s]; TOPK_INSERT(v, key) }
      }
#pragma unroll
      for (int s = 0; s < 16; ++s) vh[half][s] = v[s];
      __syncthreads();
    }
    if (kpart == 0) {
      float v1[16], v2[16];
#pragma unroll
      for (int s = 0; s < 16; ++s) { v1[s] = sortable2f((vh[0][s] & ~127u) | 64u); v2[s] = sortable2f((vh[1][s] & ~127u) | 64u); }
      unsigned c[16];
#pragma unroll
      for (int s = 0; s < 16; ++s) c[s] = 0u;
      {
        int o = 0;
#pragma unroll
        for (int i = 0; i < 16; ++i)
#pragma unroll
          for (int j = 0; j < 16 / (i + 1); ++j) {
            const unsigned key = (f2sortable(v1[i] + v2[j]) & ~63u) | (unsigned)(63 - o);
            TOPK_INSERT(c, key)
            ++o;
          }
      }
      const float vmax = sortable2f((c[0] & ~63u) | 32u);
      float sum = 0.f;
#pragma unroll
      for (int s = 0; s < 16; ++s) sum += expf(sortable2f((c[s] & ~63u) | 32u) - vmax);
      const float isum = 1.0f / sum;
      const unsigned thr = c[15];
      int* ei = EI + (m0 + item) * 16;
      float* eg = EG + (m0 + item) * 16;
      int cntw = 0;
      {
        int o = 0;
#pragma unroll
        for (int i = 0; i < 16; ++i)
#pragma unroll
          for (int j = 0; j < 16 / (i + 1); ++j) {
            const unsigned key = (f2sortable(v1[i] + v2[j]) & ~63u) | (unsigned)(63 - o);
            if (key >= thr) {
              ei[cntw] = (int)((127u - (vh[0][i] & 127u)) * 128u + (127u - (vh[1][j] & 127u)));
              eg[cntw] = expf(sortable2f((key & ~63u) | 32u) - vmax) * isum;
              ++cntw;
            }
            ++o;
          }
      }
    }
  }
  __syncthreads();
}

#define DPPF(x, ctrl) __uint_as_float((unsigned)__builtin_amdgcn_update_dpp(0, (int)__float_as_uint(x), (ctrl), 0xf, 0xf, true))
#define XP_HALVE(n, bit, ctrl) { _Pragma("unroll") for (int j_ = 0; j_ < (n); ++j_) { const float keep_ = (bit) ? a[j_ + (n)] : a[j_]; const float send_ = (bit) ? a[j_] : a[j_ + (n)]; a[j_] = keep_ + DPPF(send_, ctrl); } }
#define XP_ROW(TAB, E, PR) { const int e0_ = __builtin_amdgcn_readlane((E), 2 * (PR)), e1_ = __builtin_amdgcn_readlane((E), 2 * (PR) + 1); \
    const char* rp_ = (TAB) + (size_t)(hw ? e1_ : e0_) * 768 + hl * 24; \
    const u32x4_u x_ = *(const u32x4_u*)rp_; const u32x2 y_ = *(const u32x2*)(rp_ + 16); \
    ra[PR] = (v6u){x_[0], x_[1], x_[2], x_[3], y_[0], y_[1]}; }
#define XP_META(PAR, T, E, G, HP) { const size_t mo_ = ((size_t)(PAR) * RPG + (T)) * 128 + w * 32 + hl; \
    E = ((const int*)(p.ws + WB_EI))[mo_]; G = ((const float*)(p.ws + WB_EG))[mo_]; \
    const u32x4* hr_ = (const u32x4*)((const bf16_t*)(p.ws + WB_H2) + ((size_t)(PAR) * RPG + (T)) * DM + hl * 32); \
    _Pragma("unroll") for (int c_ = 0; c_ < 4; ++c_) HP[c_] = hr_[c_]; }
__device__ __forceinline__ void unpack8(const u32x4 v, float* f) {
#pragma unroll
  for (int k = 0; k < 4; ++k) { f[2 * k] = lo16(v[k]); f[2 * k + 1] = hi16(v[k]); }
}
__device__ __forceinline__ int xp_pool_n(int q) { return GB * ((q < NG) ? NTOK : NLAT); }
__device__ __forceinline__ int xp_claim(int* pool, int& qa, int hi) {
  while (qa <= hi) {
    const int n = xp_pool_n(qa);
    if (__hip_atomic_load(pool + qa, __ATOMIC_RELAXED, __HIP_MEMORY_SCOPE_AGENT) < n) {
      const int i = atomicAdd(pool + qa, 1);
      if (i < n) return qa * 65536 + i;
    }
    ++qa;
  }
  return -1;
}
__device__ __forceinline__ void xp_decode(int tok, int& l, int& par, int& b, int& rr, int& t) {
  const int q = tok >> 16, i = tok & 65535;
  l = q / NG;
  const int g = q % NG, rr_lim = (l == 0) ? NTOK : NLAT, bl = i / rr_lim;
  rr = i % rr_lim; b = g * GB + bl; t = bl * NTOK + rr; par = q & 1;
}
__device__ __forceinline__ void expert_run(const Params& p, int lo, int hi, unsigned* ctr, unsigned epoch, const bool steal, int& pend, float* smem) {
  if (lo < 0) lo = 0;
  if (hi < lo) return;
  const int tid = otid(), w = tid >> 6, lane = tid & 63, hl = lane & 31, hw = lane >> 5;
  int* s_tok = (int*)(smem + SMEM_FLOATS - 8);
  int* pool = (int*)(p.ws + WB_POOL);
  float* part = smem;
  int qa = lo, ci = 0;
  bool cpend = false;
  unsigned cb = 0;
  int cur = pend; pend = -1;
  if (cur < 0) {
    __syncthreads();
    if (tid == 0) s_tok[2] = xp_claim(pool, qa, hi);
    __syncthreads();
    cur = __builtin_amdgcn_readfirstlane(s_tok[2]);
  }
  if (cur < 0) return;
  if (tid == 0 && qa <= hi) { ci = atomicAdd(pool + qa, 1); cpend = true; }
  int l, par, b, rr, t;
  xp_decode(cur, l, par, b, rr, t);
  int e_c; float g_c; u32x4 hp[4];
  XP_META(par, t, e_c, g_c, hp)
  v6u ra[16];
  {
    const char* U = p.ws + WB_U16 + (size_t)l * 16384 * 768;
#pragma unroll
    for (int pr = 0; pr < 16; ++pr) XP_ROW(U, e_c, pr)
  }
  for (;;) {
    const float* mod = (const float*)(p.ws + WB_MOD) + (size_t)l * 9 * 6144;
    const float4 g2 = ((const float4*)(mod + (size_t)((rr < NLAT) ? b : 8) * 6144 + 5 * 1024))[tid];
    float4* xp = (float4*)xrow(p, b, rr) + tid;
    float4 xv = *xp;
    if (tid == 0) {
      int r = -1;
      if (cpend) {
        if (ci < xp_pool_n(qa)) r = qa * 65536 + ci;
        else { ++qa; r = xp_claim(pool, qa, hi); }
      }
      const int st = (steal && cb + 1u >= epoch) ? 1 : 0;
      s_tok[0] = r; s_tok[1] = st;
      cpend = false;
      if (!st && r >= 0 && qa <= hi) { ci = atomicAdd(pool + qa, 1); cpend = true; }
      if (steal) cb = __hip_atomic_load(ctr, __ATOMIC_RELAXED, __HIP_MEMORY_SCOPE_AGENT);
    }
    __syncthreads();
    const int nxt = __builtin_amdgcn_readfirstlane(s_tok[0]);
    const bool pf = nxt >= 0 && __builtin_amdgcn_readfirstlane(s_tok[1]) == 0;
    int ln = l, parn = 0, bn = 0, rrn = 0, tn = 0, e_n = 0;
    float g_n = 0.f;
    u32x4 hn[4];
#pragma unroll
    for (int c = 0; c < 4; ++c) hn[c] = (u32x4){0u, 0u, 0u, 0u};
    if (pf) {
      xp_decode(nxt, ln, parn, bn, rrn, tn);
      XP_META(parn, tn, e_n, g_n, hn)
    }
    const char* V = p.ws + WB_V16 + (size_t)l * 16384 * 768;
    f32x2 hq2[16];
#pragma unroll
    for (int c = 0; c < 4; ++c)
#pragma unroll
      for (int k = 0; k < 4; ++k) hq2[4 * c + k] = (f32x2){lo16(hp[c][k]), hi16(hp[c][k])};
    float a[16];
#pragma unroll
    for (int pr = 0; pr < 16; ++pr) {
      const v32f f = __builtin_amdgcn_cvt_scalef32_pk32_f32_fp6(ra[pr], 1.0f);
      f32x2 sa = {0.f, 0.f}, sb = {0.f, 0.f};
#pragma unroll
      for (int k = 0; k < 16; k += 2) {
        sa = __builtin_elementwise_fma(hq2[k], (f32x2){f[2 * k], f[2 * k + 1]}, sa);
        sb = __builtin_elementwise_fma(hq2[k + 1], (f32x2){f[2 * k + 2], f[2 * k + 3]}, sb);
      }
      a[pr] = (sa[0] + sb[0]) + (sa[1] + sb[1]);
      XP_ROW(V, e_c, pr)
    }
    {
      const bool b3 = (lane & 8) != 0, b2 = (lane & 4) != 0, b1 = (lane & 2) != 0, b0 = (lane & 1) != 0;
      XP_HALVE(8, b3, 0x128)
      XP_HALVE(4, b2, 0x141)
      XP_HALVE(2, b1, 0x4E)
      XP_HALVE(1, b0, 0xB1)
    }
    float dsum = a[0];
    dsum += __shfl_xor(dsum, 16);
    const float my_dot = __shfl(dsum, 32 * (hl & 1) + (hl >> 1));
    const float my_c = g_c * geluf_(my_dot * (1.0f / 64.0f));
    f32x2 acc2[16];
#pragma unroll
    for (int k = 0; k < 16; ++k) acc2[k] = (f32x2){0.f, 0.f};
    {
      const char* Un = p.ws + WB_U16 + (size_t)ln * 16384 * 768;
#pragma unroll
      for (int pr = 0; pr < 16; ++pr) {
        const float c0 = __uint_as_float(__builtin_amdgcn_readlane(__float_as_uint(my_c), 2 * pr)), c1 = __uint_as_float(__builtin_amdgcn_readlane(__float_as_uint(my_c), 2 * pr + 1));
        const float c = hw ? c1 : c0;
        const f32x2 cc = {c, c};
        const v32f f = __builtin_amdgcn_cvt_scalef32_pk32_f32_fp6(ra[pr], 1.0f);
#pragma unroll
        for (int k = 0; k < 16; ++k) acc2[k] = __builtin_elementwise_fma(cc, (f32x2){f[2 * k], f[2 * k + 1]}, acc2[k]);
        XP_ROW(Un, e_n, pr)
      }
    }
    __syncthreads();
    {
      float4* pw = (float4*)(part + (w * 2 + hw) * 1024 + hl * 32);
#pragma unroll
      for (int c = 0; c < 8; ++c) pw[c] = make_float4(acc2[2 * c][0], acc2[2 * c][1], acc2[2 * c + 1][0], acc2[2 * c + 1][1]);
    }
    __syncthreads();
    float4 s = ((const float4*)part)[tid];
#pragma unroll
    for (int c = 1; c < 8; ++c) { const float4 x = ((const float4*)(part + c * 1024))[tid]; s.x += x.x; s.y += x.y; s.z += x.z; s.w += x.w; }
    xv.x += 0.5f * g2.x * s.x; xv.y += 0.5f * g2.y * s.y; xv.z += 0.5f * g2.z * s.z; xv.w += 0.5f * g2.w * s.w;
    *xp = xv;
    if (!pf) { pend = nxt; break; }
    l = ln; par = parn; b = bn; rr = rrn; t = tn; e_c = e_n; g_c = g_n;
#pragma unroll
    for (int c = 0; c < 4; ++c) hp[c] = hn[c];
  }
}
__device__ __forceinline__ void expert_drain(const Params& p, int lo, int hi, int& pend, float* smem) {
  expert_run(p, lo, hi, nullptr, 0u, false, pend, smem);
}

__device__ __forceinline__ void stage_final(const Params& p, float* smem) {
  const int tid = otid(), w = tid >> 6, lane = tid & 63;
  const int n = NB * NLAT;
  for (int r0 = (blockIdx.x * 4 + w) * 2; r0 < n; r0 += gridDim.x * 8) {
    float4 v[2][4];
#pragma unroll
    for (int u = 0; u < 2; ++u)
#pragma unroll
      for (int q = 0; q < 4; ++q) v[u][q] = ((const float4*)(p.out + (size_t)(r0 + u) * DM))[q * 64 + lane];
#pragma unroll
    for (int u = 0; u < 2; ++u) {
      float s = 0.f;
#pragma unroll
      for (int q = 0; q < 4; ++q) s += v[u][q].x * v[u][q].x + v[u][q].y * v[u][q].y + v[u][q].z * v[u][q].z + v[u][q].w * v[u][q].w;
      s = wave_sum(s);
      const float rs = rsqrtf(s * (1.0f / DM) + EPSF);
#pragma unroll
      for (int q = 0; q < 4; ++q) {
        const float4 g = ((const float4*)p.in[I_FG])[q * 64 + lane];
        const float4 x = v[u][q];
        ((float4*)(p.out + (size_t)(r0 + u) * DM))[q * 64 + lane] = make_float4(x.x * rs * g.x, x.y * rs * g.y, x.z * rs * g.z, x.w * rs * g.w);
      }
    }
  }
}

__device__ __forceinline__ void gbar(const Params& p, unsigned* ctr, unsigned& epoch, int lo, int hi, int& pend, float* smem) {
  asm volatile("s_waitcnt vmcnt(0)" ::: "memory");
  __syncthreads();
  epoch += gridDim.x;
  int* s_flag = (int*)(smem + SMEM_FLOATS - 12);
  if (threadIdx.x == 0) {
    __builtin_amdgcn_fence(__ATOMIC_RELEASE, "agent");
    asm volatile("s_waitcnt vmcnt(0)" ::: "memory");
    __hip_atomic_fetch_add(ctr, 1u, __ATOMIC_RELAXED, __HIP_MEMORY_SCOPE_AGENT);
  }
  if (hi >= lo && hi >= 0) {
    if (threadIdx.x == 0) {
      const unsigned c = __hip_atomic_load(ctr, __ATOMIC_RELAXED, __HIP_MEMORY_SCOPE_AGENT);
      *s_flag = (c + 1u < epoch) ? 1 : 0;
    }
    __syncthreads();
    if (*s_flag) expert_run(p, lo, hi, ctr, epoch, true, pend, smem);
  }
  if (threadIdx.x == 0) {
    while (__hip_atomic_load(ctr, __ATOMIC_RELAXED, __HIP_MEMORY_SCOPE_AGENT) < epoch) __builtin_amdgcn_s_sleep(2);
    __builtin_amdgcn_fence(__ATOMIC_ACQUIRE, "agent");
    asm volatile("s_waitcnt vmcnt(0)" ::: "memory");
  }
  __syncthreads();
}

__global__ void __launch_bounds__(256) mega(Params p) {
  cg::grid_group grid = cg::this_grid();
  __shared__ __attribute__((aligned(16))) float smem[SMEM_FLOATS];
  char* smc = (char*)smem;
  char* ws = p.ws;
  bf16_t* H = (bf16_t*)(ws + WB_H); bf16_t* Z = (bf16_t*)(ws + WB_Z); float* MGT = (float*)(ws + WB_MGT); bf16_t* XC = (bf16_t*)(ws + WB_XC);
  bf16_t* QM = (bf16_t*)(ws + WB_QM); bf16_t* KM = (bf16_t*)(ws + WB_KM); bf16_t* KMT = (bf16_t*)(ws + WB_KMT); bf16_t* MVT = (bf16_t*)(ws + WB_MVT);
  bf16_t* HF = (bf16_t*)(ws + WB_HF); bf16_t* HB = (bf16_t*)(ws + WB_HB);
  bf16_t* VT = (bf16_t*)(ws + WB_VT); float* YSF = (float*)(ws + WB_YSF); float* YSB = (float*)(ws + WB_YSB);
  bf16_t* YA = (bf16_t*)(ws + WB_YA); bf16_t* YB = (bf16_t*)(ws + WB_YB); bf16_t* YS = (bf16_t*)(ws + WB_YS); bf16_t* GG = (bf16_t*)(ws + WB_GG);
  bf16_t* MG = (bf16_t*)(ws + WB_MG); bf16_t* PQ = (bf16_t*)(ws + WB_PQ); float* SC = (float*)(ws + WB_SC);
  float* XE = (float*)(ws + WB_XE); float* GA = (float*)(ws + WB_GA);
  const bf16_t* WT = (const bf16_t*)(ws + WB_WT);

  unsigned* bar = (unsigned*)(ws + WB_BAR);
  unsigned epoch = 0;
  int pend = -1;
  stage_init(p, smem);
  grid.sync();

  for (int l = 0; l < 2; ++l) {
    const bool need_ctx = (l == 0);
    const int rr_lim = need_ctx ? NTOK : NLAT;
    const int tpb = need_ctx ? 34 : 32;
    const bf16_t* W = WT + (size_t)l * WT_LAYER;
    const float lam_init = 0.8f - 0.6f * expf(-0.3f * (float)l);
    float lam;
    {
      float s1 = 0.f, s2 = 0.f;
      for (int i = 0; i < 64; ++i) {
        s1 += p.in[I_LQ1][l * 64 + i] * p.in[I_LK1][l * 64 + i];
        s2 += p.in[I_LQ2][l * 64 + i] * p.in[I_LK2][l * 64 + i];
      }
      lam = expf(s1) - expf(s2) + lam_init;
    }
    for (int g = 0; g < NG; ++g) {
      const int q = l * NG + g;
      int plo = q - 2, phi = q - 1;
      int* EI = (int*)(ws + WB_EI) + (size_t)(q & 1) * RPG * 128; float* EG = (float*)(ws + WB_EG) + (size_t)(q & 1) * RPG * 128;
      bf16_t* H2 = (bf16_t*)(ws + WB_H2) + (size_t)(q & 1) * RPG * DM;
      stage_normmod(p, l, g, 0, NTOK, H, smem);
      gbar(p, bar, epoch, plo, phi, pend, smem);
      stage_inproj(p, H, W + WT_WIN, Z, MGT, VT, MVT, smc);
      gbar(p, bar, epoch, plo, phi, pend, smem);
      stage_conv(p, l, Z, XC);
      stage_s5_pass1(p, l, Z, XE);
      gbar(p, bar, epoch, plo, phi, pend, smem);
      stage_mlqk(XC, W + WT_WQK, QM, KM, KMT, smc);
      stage_mlgates(p, l, MGT, GA);
      gbar(p, bar, epoch, plo, phi, pend, smem);
      {
        const int n_attn = 4 * 64 + (need_ctx ? 4 * 4 : 0);
        const int n_s5 = 32 * 2 * 9;
        const int n_items = GB * (16 + n_attn + n_s5);
        int* cnt = (int*)(ws + WB_CNT) + (l * NG + g);
        int* s_item = (int*)(smem + SMEM_FLOATS - 4);
        for (;;) {
          __syncthreads();
          if (otid() == 0) *s_item = atomicAdd(cnt, 1);
          __syncthreads();
          const int it = *s_item;
          if (it >= n_items) break;
          int bl, k;
          if (it < GB * 16) { bl = it / 16; k = it % 16; }
          else if (it < GB * (16 + n_attn)) { bl = (it - GB * 16) / n_attn; k = 16 + (it - GB * 16) % n_attn; }
          else { bl = (it - GB * (16 + n_attn)) / n_s5; k = 16 + n_attn + (it - GB * (16 + n_attn)) % n_s5; }
          const bf16_t* Zb = Z + (size_t)bl * NTOK * ZW;
          const size_t ro = (size_t)bl * NTOK;
          if (k < 16) {
            const int hh = k & 3, dd = (k >> 2) & 1, eh = k >> 3;
            mlstm_chain_item(p, l, QM + ro * 512, KM + ro * 512, KMT + (size_t)bl * 4 * 128 * NTOK, MVT + (size_t)bl * 4 * 128 * NTOK, GA + (size_t)(((bl * 4 + hh) * 2 + dd) * 68) * 272,
                             (dd ? HB : HF) + ro * 512, hh, dd, eh, smc);
          } else if (k < 16 + n_attn) {
            const int a = k - 16;
            const bf16_t* VTb = VT + (size_t)bl * 4 * 128 * NTOK;
            if (a < 256) attn_mfma_item(p, l, Zb, VTb, YA + ro * 512, a & 3, (a >> 2) * 64, 0, NTOK, lam, lam_init, smc);
            else attn_mfma_item(p, l, Zb, VTb, YA + ro * 512, (a - 256) & 3, NLAT + ((a - 256) >> 2) * 64, NLAT, NCTX, lam, lam_init, smc);
          } else {
            const int a = k - 16 - n_attn;
            const int sq = a % 9, dir = (a / 9) & 1, gg = a / 18;
            s5_item(p, l, Zb, XE + (((size_t)bl * 32 + gg) * 2 + dir) * (S5NSEG - 1) * 128, (dir ? YSB : YSF) + ro * 512, gg, dir, sq, smc);
          }
        }
      }
      gbar(p, bar, epoch, plo, phi, pend, smem);
      stage_chain1(p, l, g, rr_lim, Z, HF, HB, YSF, YSB, YA, MG, W, smc);
      gbar(p, bar, epoch, plo, phi, pend, smem);
      expert_drain(p, plo, plo, pend, smem);
      plo = q - 1;
      gbar(p, bar, epoch, plo, phi, pend, smem);
      stage_normmod(p, l, g, 1, rr_lim, H2, smem);
      gbar(p, bar, epoch, plo, phi, pend, smem);
      stage_peerq_mfma(tpb, H2, W + WT_WQ, PQ, smc);
      gbar(p, bar, epoch, plo, phi, pend, smem);
      stage_scores_topk(tpb, PQ, W + WT_SUBK, EI, EG, smc);
      gbar(p, bar, epoch, plo, phi, pend, smem);
    }
  }
  expert_drain(p, 2 * NG - 2, 2 * NG - 1, pend, smem);
  gbar(p, bar, epoch, 0, -1, pend, smem);
  stage_final(p, smem);
}

extern "C" void kernel_launch(void* const* d_in, const int* in_sizes, int n_in, void* d_out,
                              int out_size, void* d_ws, size_t ws_size, hipStream_t stream) {
  static int grid_blocks = 0;
  if (!grid_blocks) {
    int dev = 0, cus = 0, per_cu = 0;
    (void)hipGetDevice(&dev);
    (void)hipDeviceGetAttribute(&cus, hipDeviceAttributeMultiprocessorCount, dev);
    (void)hipOccupancyMaxActiveBlocksPerMultiprocessor(&per_cu, mega, 256, 0);
    if (per_cu > 1) per_cu = 1;
    grid_blocks = cus * per_cu;
  }
  if (ws_size < WB_END) {
    fprintf(stderr, "workspace too small: %zu < %zu\n", ws_size, (size_t)WB_END);
    return;
  }
  Params p{};
  for (int i = 0; i < N_IN; ++i) p.in[i] = (const float*)d_in[i];
  p.out = (float*)d_out;
  p.ws = (char*)d_ws;
  (void)hipMemsetAsync((char*)d_ws + WB_BAR, 0, 256, stream);
  void* args[] = {&p};
  hipError_t e = hipLaunchCooperativeKernel((void*)mega, dim3(grid_blocks), dim3(256), args, 0, stream);
  if (e != hipSuccess) fprintf(stderr, "cooperative launch failed: %s (grid %d)\n", hipGetErrorString(e), grid_blocks);
}
```

```cpp
#include <hip/hip_runtime.h>
#include <hip/hip_cooperative_groups.h>
#include <cstdio>
#include <cstdint>
namespace cg = cooperative_groups;

#define NLAT 4096
#define NCTX 256
#define NTOK 4352
#define DM 1024
#define INW 6672
#define NB 8
#define GB 2
#define NG (NB / GB)
#define RPG (GB * NTOK)
#define ZW 6656
#define EPSF 1e-6f

enum { I_X = 0, I_C, I_CTX, I_CCTX, I_WMOD, I_BMOD, I_N1G, I_N2G, I_WIN, I_LQ1, I_LK1, I_LQ2, I_LK2, I_SUBG,
       I_CONVW, I_CONVB, I_MLWQ, I_MLWK, I_GATEB, I_MLNG, I_S5LRE, I_S5LIM, I_S5DT, I_S5BRE, I_S5BIM,
       I_S5CRE, I_S5CIM, I_S5D, I_GLUW, I_GLUB, I_WBR, I_WOUT, I_PWQ, I_PSUBK, I_PU, I_PV, I_FG, N_IN };

struct Params {
  const float* in[N_IN];
  float* out;
  char* ws;
};

typedef unsigned short bf16_t;
typedef short bf16x8 __attribute__((ext_vector_type(8)));
typedef float f32x16 __attribute__((ext_vector_type(16)));
typedef unsigned u32x4 __attribute__((ext_vector_type(4)));
typedef unsigned u32x2 __attribute__((ext_vector_type(2)));
typedef unsigned u32x4_u __attribute__((ext_vector_type(4), aligned(8)));
typedef float v16f __attribute__((ext_vector_type(16)));
typedef float v32f __attribute__((ext_vector_type(32)));
typedef unsigned v6u __attribute__((ext_vector_type(6)));

#define AL(x) (((x) + 255) & ~(size_t)255)
#define WB_XCX   ((size_t)0)
#define WB_MOD   AL(WB_XCX + (size_t)NB * NCTX * DM * 4)
#define WB_ROPE  AL(WB_MOD + (size_t)2 * 9 * 6144 * 4)
#define WB_WT    AL(WB_ROPE + (size_t)NLAT * 32 * 2 * 4)
#define WT_WIN   ((size_t)0)
#define WT_WQK   (WT_WIN + (size_t)6784 * 1024)
#define WT_GLU   (WT_WQK + (size_t)4 * 256 * 128)
#define WT_WBR   (WT_GLU + (size_t)512 * 512)
#define WT_WOUT  (WT_WBR + (size_t)3 * 1024 * 512)
#define WT_WQ    (WT_WOUT + (size_t)1024 * 1024)
#define WT_SUBK  (WT_WQ + (size_t)2048 * 1024)
#define WT_LAYER (WT_SUBK + (size_t)2 * 128 * 128)
#define WB_H     AL(WB_WT + WT_LAYER * 2 * 2)
#define WB_Z     AL(WB_H + (size_t)RPG * DM * 2)
#define WB_MGT   AL(WB_Z + (size_t)RPG * ZW * 2)
#define WB_XC    AL(WB_MGT + (size_t)RPG * 16 * 4)
#define WB_QM    AL(WB_XC + (size_t)RPG * 512 * 2)
#define WB_KM    AL(WB_QM + (size_t)RPG * 512 * 2)
#define WB_KMT   AL(WB_KM + (size_t)RPG * 512 * 2)
#define WB_MVT   AL(WB_KMT + (size_t)RPG * 512 * 2)
#define WB_HF    AL(WB_MVT + (size_t)RPG * 512 * 2)
#define WB_HB    AL(WB_HF + (size_t)RPG * 512 * 2)
#define WB_YSF   AL(WB_HB + (size_t)RPG * 512 * 2)
#define WB_YSB   AL(WB_YSF + (size_t)RPG * 512 * 4)
#define WB_YA    AL(WB_YSB + (size_t)RPG * 512 * 4)
#define WB_YB    AL(WB_YA + (size_t)RPG * 512 * 2)
#define WB_YS    AL(WB_YB + (size_t)RPG * 512 * 2)
#define WB_GG    AL(WB_YS + (size_t)RPG * 512 * 2)
#define WB_MG    AL(WB_GG + (size_t)RPG * 512 * 2)
#define WB_EI    AL(WB_MG + (size_t)RPG * DM * 2)
#define WB_EG    AL(WB_EI + (size_t)2 * RPG * 128 * 4)
#define WB_H2    AL(WB_EG + (size_t)2 * RPG * 128 * 4)
#define WB_U16   AL(WB_H2 + (size_t)2 * RPG * DM * 2)
#define WB_V16   AL(WB_U16 + (size_t)2 * 16384 * 768)
#define WB_VT    AL(WB_V16 + (size_t)2 * 16384 * 768)
#define WB_CNT   AL(WB_VT + (size_t)GB * 4 * 128 * NTOK * 2)
#define WB_XE    AL(WB_CNT + 256)
#define WB_BAR   AL(WB_XE + (size_t)GB * 32 * 2 * 33 * 128 * 4)
#define WB_GA    AL(WB_BAR + 256)
#define WB_POOL  AL(WB_GA + (size_t)GB * 4 * 2 * 68 * 272 * 4)
#define WB_END   AL(WB_POOL + 256)
#define WB_PQ    (WB_Z)
#define WB_SC    AL(WB_PQ + (size_t)RPG * 2048 * 2)

#define SMEM_FLOATS (25 * 1024)

__device__ __forceinline__ float sigmoidf_(float x) { return __builtin_amdgcn_rcpf(1.0f + __builtin_amdgcn_exp2f(-1.4426950408889634f * x)); }
__device__ __forceinline__ float siluf_(float x) { return x * __builtin_amdgcn_rcpf(1.0f + __builtin_amdgcn_exp2f(-1.4426950408889634f * x)); }
__device__ __forceinline__ float geluf_(float x) { return 0.5f * x * (1.0f + erff(x * 0.70710678118654752f)); }
__device__ __forceinline__ int otid() { int t = threadIdx.x; asm volatile("" : "+v"(t)); return t; }
__device__ __forceinline__ float wave_sum(float v) {
  for (int o = 32; o > 0; o >>= 1) v += __shfl_xor(v, o);
  return v;
}
__device__ __forceinline__ bf16_t f2bf(float x) { unsigned u = __float_as_uint(x); u += 0x7fffu + ((u >> 16) & 1u); return (bf16_t)(u >> 16); }
__device__ __forceinline__ float bf2f(bf16_t h) { return __uint_as_float(((unsigned)h) << 16); }
typedef float f32x2 __attribute__((ext_vector_type(2)));
typedef __bf16 bf16x2_t __attribute__((ext_vector_type(2)));
__device__ __forceinline__ unsigned pack2(float a, float b) { f32x2 v = {a, b}; return __builtin_bit_cast(unsigned, __builtin_convertvector(v, bf16x2_t)); }
__device__ __forceinline__ float lo16(unsigned u) { return __uint_as_float(u << 16); }
__device__ __forceinline__ float hi16(unsigned u) { return __uint_as_float(u & 0xffff0000u); }

__device__ __forceinline__ float* xrow(const Params& p, int b, int rr) {
  return (rr < NLAT) ? p.out + ((size_t)b * NLAT + rr) * DM : (float*)(p.ws + WB_XCX) + ((size_t)b * NCTX + (rr - NLAT)) * DM;
}

__device__ __forceinline__ const float* xrow_in(const Params& p, int b, int rr) {
  return (rr < NLAT) ? p.in[I_X] + ((size_t)b * NLAT + rr) * DM : p.in[I_CTX] + ((size_t)b * NCTX + (rr - NLAT)) * DM;
}

__device__ __forceinline__ void gemm_tile(const bf16_t* __restrict__ Ag, int lda, const bf16_t* __restrict__ Bg, int ldb, int K,
                                          char* smem, f32x16 (&acc)[2][2]) {
  const int tid = otid(), lane = tid & 63, w = tid >> 6, wm = w >> 1, wn = w & 1;
#pragma unroll
  for (int a = 0; a < 2; ++a)
#pragma unroll
    for (int b = 0; b < 2; ++b)
#pragma unroll
      for (int i = 0; i < 16; ++i) acc[a][b][i] = 0.f;
  const int srow = tid >> 3, sch = tid & 7;
  const bf16_t* ap = Ag + (size_t)srow * lda + sch * 8;
  const bf16_t* bp = Bg + (size_t)srow * ldb + sch * 8;
  const int wofs = srow * 128 + ((sch ^ ((srow >> 1) & 7)) << 4);
  const int fr = lane & 31, fh = lane >> 5, fsw = (fr >> 1) & 7;
  const int aofs = (wm * 64 + fr) * 128, bofs = 16384 + (wn * 64 + fr) * 128;
  u32x4 ra0[4], rb0[4], ra1[4], rb1[4];
  const int nk = K >> 6;
#define G_LOAD(RA, RB, KT) { _Pragma("unroll") for (int i = 0; i < 4; ++i) { RA[i] = *(const u32x4*)(ap + (size_t)i * 32 * lda + (KT) * 64); RB[i] = *(const u32x4*)(bp + (size_t)i * 32 * ldb + (KT) * 64); } }
#define G_STORE(RA, RB, BUF) { char* nb_ = smem + (BUF) * 32768; _Pragma("unroll") for (int i = 0; i < 4; ++i) { *(u32x4*)(nb_ + wofs + i * 4096) = RA[i]; *(u32x4*)(nb_ + 16384 + wofs + i * 4096) = RB[i]; } }
#define G_COMPUTE(BUF) { const char* base = smem + (BUF) * 32768; _Pragma("unroll") for (int ks = 0; ks < 4; ++ks) { \
      const int coff = ((ks * 2 + fh) ^ fsw) << 4; bf16x8 af[2], bfr[2]; \
      _Pragma("unroll") for (int mi = 0; mi < 2; ++mi) af[mi] = *(const bf16x8*)(base + aofs + mi * 4096 + coff); \
      _Pragma("unroll") for (int ni = 0; ni < 2; ++ni) bfr[ni] = *(const bf16x8*)(base + bofs + ni * 4096 + coff); \
      _Pragma("unroll") for (int mi = 0; mi < 2; ++mi) _Pragma("unroll") for (int ni = 0; ni < 2; ++ni) \
          acc[mi][ni] = __builtin_amdgcn_mfma_f32_32x32x16_bf16(bfr[ni], af[mi], acc[mi][ni], 0, 0, 0); } }
  G_LOAD(ra0, rb0, 0)
  G_LOAD(ra1, rb1, 1)
  __syncthreads();
  G_STORE(ra0, rb0, 0)
  __syncthreads();
  for (int kt = 0; kt < nk; kt += 2) {
    if (kt + 2 < nk) G_LOAD(ra0, rb0, kt + 2)
    G_COMPUTE(0)
    G_STORE(ra1, rb1, 1)
    __syncthreads();
    if (kt + 3 < nk) G_LOAD(ra1, rb1, kt + 3)
    G_COMPUTE(1)
    if (kt + 2 < nk) G_STORE(ra0, rb0, 0)
    __syncthreads();
  }
#undef G_LOAD
#undef G_STORE
#undef G_COMPUTE
}
#define EPI_DECL const int tid_ = otid(); const int lane = tid_ & 63, w_ = tid_ >> 6, wm = w_ >> 1, wn = w_ & 1, fr = lane & 31, fh = lane >> 5; (void)fr; (void)fh; (void)wm; (void)wn;
#define EPI_ROW(mi) (wm * 64 + (mi) * 32 + fr)
#define EPI_COL(ni, q) (wn * 64 + (ni) * 32 + 8 * (q) + 4 * fh)
#define MT_LR0(mt, tpb) (((mt) / (tpb)) * NTOK + ((mt) % (tpb)) * 128)


struct TileIter {
  int tm, tn, pw, ph, PN, NP, x, i, it;
  __device__ __forceinline__ TileIter(int tm_, int tn_) : tm(tm_), tn(tn_) {
    pw = tn < 8 ? tn : 8; ph = 32 / pw; PN = (tn + pw - 1) / pw; NP = ((tm + ph - 1) / ph) * PN;
    x = blockIdx.x & 7; i = blockIdx.x >> 3; it = 0;
  }
  __device__ __forceinline__ bool next(int& mt, int& nt, bool& valid) {
    if (gridDim.x != 256) {
      const int t = blockIdx.x + it * gridDim.x; ++it;
      if (t >= tm * tn) return false;
      mt = t / tn; nt = t % tn; valid = true; return true;
    }
    const int P = it * 8 + x; ++it;
    if (P >= NP) return false;
    mt = (P / PN) * ph + i / pw; nt = (P % PN) * pw + i % pw;
    valid = (mt < tm) && (nt < tn);
    return true;
  }
};

template <class F>
__device__ __forceinline__ void transpose_cvt(const float* __restrict__ src, int ld, F srccol, int K, int Ndst, bf16_t* __restrict__ dst, float* smem) {
  float (*T)[65] = (float (*)[65])smem;
  const int tid = otid();
  const int tk = K >> 6, tn = Ndst >> 6;
  for (int t = blockIdx.x; t < tn * tk; t += gridDim.x) {
    const int n0 = (t / tk) * 64, k0 = (t % tk) * 64;
    __syncthreads();
    const int sc = srccol(n0 + (tid & 63));
#pragma unroll
    for (int i = 0; i < 16; ++i) {
      const int ky = (tid >> 6) + 4 * i;
      T[ky][tid & 63] = (sc >= 0) ? src[(size_t)(k0 + ky) * ld + sc] : 0.f;
    }
    __syncthreads();
#pragma unroll
    for (int i = 0; i < 16; ++i) {
      const int ny = (tid >> 6) + 4 * i;
      dst[(size_t)(n0 + ny) * K + k0 + (tid & 63)] = f2bf(T[tid & 63][ny]);
    }
  }
  __syncthreads();
}
__device__ __forceinline__ void fragpack(const float* __restrict__ src, int ld, int K, int N, bf16_t* __restrict__ dst) {
  const int kc = K >> 6, total = (N >> 5) * kc * 256;
  for (int idx = blockIdx.x * 256 + otid(); idx < total; idx += gridDim.x * 256) {
    const int lane = idx & 63, ks = (idx >> 6) & 3, c = (idx >> 8) % kc, nf = (idx >> 8) / kc;
    const int n = 32 * nf + (lane & 31), k0 = 64 * c + 32 * (lane >> 5) + 8 * ks;
    float f[8];
#pragma unroll
    for (int j = 0; j < 8; ++j) f[j] = src[(size_t)(k0 + j) * ld + n];
    *(u32x4*)(dst + (size_t)idx * 8) = (u32x4){pack2(f[0], f[1]), pack2(f[2], f[3]), pack2(f[4], f[5]), pack2(f[6], f[7])};
  }
}
__device__ __forceinline__ int win_srccol(int n) {
  if (n < 3072) return n;
  if (n < 6656) return n + 16;
  if (n < 6672) return n - 3584;
  return -1;
}

__device__ __forceinline__ void stage_init(const Params& p, float* smem) {
  const int tid = otid();
  if (blockIdx.x == 0 && tid < 64) { ((int*)(p.ws + WB_CNT))[tid] = 0; if (tid < 16) ((int*)(p.ws + WB_POOL))[tid] = 0; }
  {
    float* lx = smem + tid * 33;
    int perm[32];
    {
      v16f a, b;
#pragma unroll
      for (int j = 0; j < 16; ++j) { a[j] = (float)(j & 7); b[j] = (float)((j + 16) & 7); }
      const v32f u1 = __builtin_amdgcn_cvt_scalef32_pk32_f32_fp6(__builtin_amdgcn_cvt_scalef32_2xpk16_fp6_f32(a, b, 1.0f), 1.0f);
#pragma unroll
      for (int j = 0; j < 16; ++j) { a[j] = (float)(j >> 3); b[j] = (float)((j + 16) >> 3); }
      const v32f u2 = __builtin_amdgcn_cvt_scalef32_pk32_f32_fp6(__builtin_amdgcn_cvt_scalef32_2xpk16_fp6_f32(a, b, 1.0f), 1.0f);
#pragma unroll
      for (int k = 0; k < 32; ++k) perm[k] = ((int)(u1[k] + 0.5f) + 8 * (int)(u2[k] + 0.5f)) & 31;
    }
    const size_t ngrp = (size_t)2 * 16384 * 32;
    for (size_t i = (size_t)blockIdx.x * 256 + tid; i < 2 * ngrp; i += (size_t)gridDim.x * 256) {
      const bool isv = i >= ngrp;
      const size_t gi = isv ? i - ngrp : i;
      const float4* s4 = (const float4*)((isv ? p.in[I_PV] : p.in[I_PU]) + gi * 32);
      const float sc = isv ? 2.0f : 64.0f;
      float o[32];
#pragma unroll
      for (int q = 0; q < 8; ++q) { const float4 t = s4[q]; o[4 * q] = t.x * sc; o[4 * q + 1] = t.y * sc; o[4 * q + 2] = t.z * sc; o[4 * q + 3] = t.w * sc; }
#pragma unroll
      for (int k = 0; k < 32; ++k) lx[perm[k]] = o[k];
      v16f a, b;
#pragma unroll
      for (int j = 0; j < 16; ++j) { a[j] = lx[j]; b[j] = lx[16 + j]; }
      const v6u pk = __builtin_amdgcn_cvt_scalef32_2xpk16_fp6_f32(a, b, 1.0f);
      u32x2* d = (u32x2*)(p.ws + (isv ? WB_V16 : WB_U16) + gi * 24);
      d[0] = (u32x2){pk[0], pk[1]}; d[1] = (u32x2){pk[2], pk[3]}; d[2] = (u32x2){pk[4], pk[5]};
    }
    __syncthreads();
  }
  {
    float2* rt = (float2*)(p.ws + WB_ROPE);
    for (int i = blockIdx.x * 256 + tid; i < NLAT * 32; i += gridDim.x * 256) {
      const int pos = i >> 5, j = i & 31;
      const float inv = powf(10000.0f, -(float)(j & 15) / 16.0f);
      const float ang = (float)((j < 16) ? (pos >> 6) : (pos & 63)) * inv;
      rt[i] = make_float2(cosf(ang), sinf(ang));
    }
  }
  {
    float* sc = smem;
    float* red = smem + 9 * 1024;
    for (int i = tid; i < 9 * 1024; i += 256) {
      int r = i >> 10, k = i & 1023;
      float v = (r < 8) ? p.in[I_C][r * 1024 + k] : p.in[I_CCTX][k];
      sc[i] = siluf_(v);
    }
    __syncthreads();
    float* mod = (float*)(p.ws + WB_MOD);
    const int jc = tid & 63, ksl = tid >> 6;
    for (int cb = blockIdx.x; cb < 2 * 6144 / 64; cb += gridDim.x) {
      const int col = cb * 64 + jc;
      const int l = col / 6144, j = col % 6144;
      const float* w = p.in[I_WMOD] + (size_t)l * 1024 * 6144 + j;
      float acc[9];
#pragma unroll
      for (int r = 0; r < 9; ++r) acc[r] = 0.f;
#pragma unroll 8
      for (int k = ksl * 256; k < ksl * 256 + 256; ++k) {
        const float wv = w[(size_t)k * 6144];
#pragma unroll
        for (int r = 0; r < 9; ++r) acc[r] = fmaf(sc[r * 1024 + k], wv, acc[r]);
      }
      __syncthreads();
#pragma unroll
      for (int r = 0; r < 9; ++r) red[(ksl * 64 + jc) * 9 + r] = acc[r];
      __syncthreads();
      if (ksl == 0) {
        const float bv = p.in[I_BMOD][l * 6144 + j];
#pragma unroll
        for (int r = 0; r < 9; ++r)
          mod[((size_t)l * 9 + r) * 6144 + j] = red[jc * 9 + r] + red[(64 + jc) * 9 + r] + red[(128 + jc) * 9 + r] + red[(192 + jc) * 9 + r] + bv;
      }
    }
    __syncthreads();
  }
  bf16_t* WT = (bf16_t*)(p.ws + WB_WT);
  for (int l = 0; l < 2; ++l) {
    bf16_t* W = WT + (size_t)l * WT_LAYER;
    transpose_cvt(p.in[I_WIN] + (size_t)l * DM * INW, INW, [](int n) { return win_srccol(n); }, DM, 6784, W + WT_WIN, smem);
    for (int h = 0; h < 4; ++h) {
      transpose_cvt(p.in[I_MLWQ] + ((size_t)l * 4 + h) * 16384, 128, [](int n) { return n; }, 128, 128, W + WT_WQK + (size_t)h * 256 * 128, smem);
      transpose_cvt(p.in[I_MLWK] + ((size_t)l * 4 + h) * 16384, 128, [](int n) { return n; }, 128, 128, W + WT_WQK + (size_t)h * 256 * 128 + 128 * 128, smem);
    }
    fragpack(p.in[I_GLUW] + (size_t)l * 512 * 512, 512, 512, 512, W + WT_GLU);
    for (int r = 0; r < 3; ++r) fragpack(p.in[I_WBR] + ((size_t)l * 3 + r) * 512 * DM, DM, 512, DM, W + WT_WBR + (size_t)r * 1024 * 512);
    fragpack(p.in[I_WOUT] + (size_t)l * DM * DM, DM, DM, DM, W + WT_WOUT);
    transpose_cvt(p.in[I_PWQ] + (size_t)l * DM * 2048, 2048, [](int n) { return n; }, DM, 2048, W + WT_WQ, smem);
    const float* sk = p.in[I_PSUBK] + (size_t)l * 2 * 128 * 128;
    for (int i = blockIdx.x * 256 + tid; i < 2 * 128 * 128; i += gridDim.x * 256) W[WT_SUBK + i] = f2bf(sk[i]);
  }
}

__device__ __forceinline__ void stage_normmod(const Params& p, int l, int g, int which, int rr_lim, bf16_t* H, float* smem) {
  const int tid = otid(), w = tid >> 6, lane = tid & 63;
  const float* ng = p.in[which ? I_N2G : I_N1G] + l * DM;
  const float* mod = (const float*)(p.ws + WB_MOD) + (size_t)l * 9 * 6144;
  const int off_sh = which ? 3072 : 0, off_sc = which ? 4096 : 1024;
  const int n = GB * rr_lim;
  for (int i0 = (blockIdx.x * 4 + w) * 2; i0 < n; i0 += gridDim.x * 8) {
    float4 v[2][4];
    int bl[2], rr[2];
#pragma unroll
    for (int u = 0; u < 2; ++u) {
      const int i = (i0 + u < n) ? i0 + u : i0;
      bl[u] = i / rr_lim; rr[u] = i % rr_lim;
      const float4* X = (const float4*)((l == 0 && which == 0) ? xrow_in(p, g * GB + bl[u], rr[u]) : xrow(p, g * GB + bl[u], rr[u]));
#pragma unroll
      for (int q = 0; q < 4; ++q) v[u][q] = X[q * 64 + lane];
    }
#pragma unroll
    for (int u = 0; u < 2; ++u) {
      if (i0 + u >= n) break;
      float s = 0.f;
#pragma unroll
      for (int q = 0; q < 4; ++q) s += v[u][q].x * v[u][q].x + v[u][q].y * v[u][q].y + v[u][q].z * v[u][q].z + v[u][q].w * v[u][q].w;
      s = wave_sum(s);
      const float rs = rsqrtf(s * (1.0f / DM) + EPSF);
      const float* m = mod + (size_t)((rr[u] < NLAT) ? (g * GB + bl[u]) : 8) * 6144;
      u32x2* hp = (u32x2*)(H + ((size_t)bl[u] * NTOK + rr[u]) * DM);
#pragma unroll
      for (int q = 0; q < 4; ++q) {
        const float4 gg = ((const float4*)ng)[q * 64 + lane];
        const float4 sc = ((const float4*)(m + off_sc))[q * 64 + lane];
        const float4 sh = ((const float4*)(m + off_sh))[q * 64 + lane];
        const float4 x = v[u][q];
        hp[q * 64 + lane] = (u32x2){pack2(x.x * rs * gg.x * (1.f + sc.x) + sh.x, x.y * rs * gg.y * (1.f + sc.y) + sh.y),
                                    pack2(x.z * rs * gg.z * (1.f + sc.z) + sh.z, x.w * rs * gg.w * (1.f + sc.w) + sh.w)};
      }
    }
  }
}

__device__ __forceinline__ void stage_inproj(const Params& p, const bf16_t* H, const bf16_t* WinT, bf16_t* Z, float* MGT, bf16_t* VT, bf16_t* MVT, char* smem) {
  EPI_DECL
  const int tm = GB * 34, tn = 53;
  const float2* rt = (const float2*)(p.ws + WB_ROPE);
  TileIter ti(tm, tn);
  int mt, j; bool valid;
  while (ti.next(mt, j, valid)) {
    if (!valid) continue;
    const int n0 = j * 128;
    const int lr0 = MT_LR0(mt, 34), rr0 = (mt % 34) * 128;
    f32x16 acc[2][2];
    if ((j >= 8 && j < 12) || (j >= 16 && j < 20)) {
      gemm_tile(WinT + (size_t)n0 * DM, DM, H + (size_t)lr0 * DM, DM, DM, smem, acc);
      bf16_t* vt = ((j < 12) ? VT : MVT) + ((size_t)(mt / 34) * 4 + (j & 3)) * 128 * NTOK;
#pragma unroll
      for (int mi = 0; mi < 2; ++mi)
#pragma unroll
        for (int ni = 0; ni < 2; ++ni)
#pragma unroll
          for (int q = 0; q < 4; ++q) {
            const int e = EPI_ROW(mi), tok = rr0 + EPI_COL(ni, q);
            *(u32x2*)(vt + (size_t)e * NTOK + tok) = (u32x2){pack2(acc[mi][ni][4 * q], acc[mi][ni][4 * q + 1]), pack2(acc[mi][ni][4 * q + 2], acc[mi][ni][4 * q + 3])};
          }
      continue;
    }
    gemm_tile(H + (size_t)lr0 * DM, DM, WinT + (size_t)n0 * DM, DM, DM, smem, acc);
    if (j < 8 && rr0 < NLAT) {
#pragma unroll
      for (int mi = 0; mi < 2; ++mi) {
        const int pos = rr0 + EPI_ROW(mi);
#pragma unroll
        for (int i = 0; i < 16; ++i) {
          const int jj = 8 * (i >> 2) + 4 * fh + (i & 3);
          const float2 cs = rt[pos * 32 + jj];
          const float x1 = acc[mi][0][i], x2 = acc[mi][1][i];
          acc[mi][0][i] = x1 * cs.x - x2 * cs.y;
          acc[mi][1][i] = x1 * cs.y + x2 * cs.x;
        }
      }
    }
    if (j < 52) {
      const bool sg = (j >= 28);
#pragma unroll
      for (int mi = 0; mi < 2; ++mi)
#pragma unroll
        for (int ni = 0; ni < 2; ++ni)
#pragma unroll
          for (int q = 0; q < 4; ++q) {
            const int row = lr0 + EPI_ROW(mi), c = n0 + EPI_COL(ni, q);
            float v0 = acc[mi][ni][4 * q], v1 = acc[mi][ni][4 * q + 1], v2 = acc[mi][ni][4 * q + 2], v3 = acc[mi][ni][4 * q + 3];
            if (sg) { v0 = sigmoidf_(v0); v1 = sigmoidf_(v1); v2 = sigmoidf_(v2); v3 = sigmoidf_(v3); }
            *(u32x2*)(Z + (size_t)row * ZW + c) = (u32x2){pack2(v0, v1), pack2(v2, v3)};
          }
    } else {
#pragma unroll
      for (int mi = 0; mi < 2; ++mi)
#pragma unroll
        for (int q = 0; q < 2; ++q) {
          const int row = lr0 + EPI_ROW(mi), c = EPI_COL(0, q);
          if (wn == 0) *(float4*)(MGT + (size_t)row * 16 + c) = make_float4(acc[mi][0][4 * q], acc[mi][0][4 * q + 1], acc[mi][0][4 * q + 2], acc[mi][0][4 * q + 3]);
        }
    }
  }
}

__device__ __forceinline__ void stage_conv(const Params& p, int l, const bf16_t* Z, bf16_t* XC) {
  const int tid = otid();
  const float* cw = p.in[I_CONVW] + (size_t)l * 3 * 512;
  const float* cb = p.in[I_CONVB] + (size_t)l * 512;
  const int c = tid * 2;
  const float2 w0 = *(const float2*)(cw + c), w1 = *(const float2*)(cw + 512 + c), w2 = *(const float2*)(cw + 1024 + c), bb = *(const float2*)(cb + c);
  for (int lr0 = blockIdx.x * 4; lr0 < RPG; lr0 += gridDim.x * 4) {
    unsigned xc[4], xp[4], xn[4];
#pragma unroll
    for (int u = 0; u < 4; ++u) {
      const int lr = lr0 + u, rr = lr % NTOK;
      const bool has_prev = (rr < NLAT) ? (rr > 0) : (rr > NLAT);
      const bool has_next = (rr < NLAT) ? (rr < NLAT - 1) : (rr < NTOK - 1);
      const bf16_t* z = Z + (size_t)lr * ZW + 1536 + c;
      xc[u] = *(const unsigned*)z;
      xp[u] = has_prev ? *(const unsigned*)(z - ZW) : 0u;
      xn[u] = has_next ? *(const unsigned*)(z + ZW) : 0u;
    }
#pragma unroll
    for (int u = 0; u < 4; ++u) {
      const float a0 = bb.x + w1.x * lo16(xc[u]) + w0.x * lo16(xp[u]) + w2.x * lo16(xn[u]);
      const float a1 = bb.y + w1.y * hi16(xc[u]) + w0.y * hi16(xp[u]) + w2.y * hi16(xn[u]);
      *(unsigned*)(XC + (size_t)(lr0 + u) * 512 + c) = pack2(siluf_(a0), siluf_(a1));
    }
  }
}

__device__ __forceinline__ void stage_mlqk(const bf16_t* XC, const bf16_t* WQK, bf16_t* QM, bf16_t* KM, bf16_t* KMT, char* smem) {
  EPI_DECL
  const int tm = RPG >> 7;
  TileIter ti(tm, 12);
  int mt, r12; bool valid;
  while (ti.next(mt, r12, valid)) {
    if (!valid) continue;
    const int h = r12 & 3, kind = r12 >> 2;
    const int m0 = mt * 128;
    f32x16 acc[2][2];
    const bf16_t* Wt = WQK + (size_t)h * 256 * 128 + (size_t)(kind ? 1 : 0) * 128 * 128;
    const bf16_t* Xt = XC + (size_t)m0 * 512 + h * 128;
    if (kind < 2) {
      gemm_tile(Xt, 512, Wt, 128, 128, smem, acc);
      bf16_t* O = kind ? KM : QM;
      const float alpha = kind ? 1.0f : 0.08838834764831845f;
#pragma unroll
      for (int mi = 0; mi < 2; ++mi)
#pragma unroll
        for (int ni = 0; ni < 2; ++ni)
#pragma unroll
          for (int q = 0; q < 4; ++q) {
            const int row = m0 + EPI_ROW(mi), c = EPI_COL(ni, q);
            *(u32x2*)(O + (size_t)row * 512 + h * 128 + c) = (u32x2){pack2(alpha * acc[mi][ni][4 * q], alpha * acc[mi][ni][4 * q + 1]), pack2(alpha * acc[mi][ni][4 * q + 2], alpha * acc[mi][ni][4 * q + 3])};
          }
    } else {
      gemm_tile(Wt, 128, Xt, 512, 128, smem, acc);
      bf16_t* kt = KMT + ((size_t)(mt / 34) * 4 + h) * 128 * NTOK + (mt % 34) * 128;
#pragma unroll
      for (int mi = 0; mi < 2; ++mi)
#pragma unroll
        for (int ni = 0; ni < 2; ++ni)
#pragma unroll
          for (int q = 0; q < 4; ++q) {
            const int d = EPI_ROW(mi), tok = EPI_COL(ni, q);
            *(u32x2*)(kt + (size_t)d * NTOK + tok) = (u32x2){pack2(acc[mi][ni][4 * q], acc[mi][ni][4 * q + 1]), pack2(acc[mi][ni][4 * q + 2], acc[mi][ni][4 * q + 3])};
          }
    }
  }
}

__device__ __forceinline__ void attn_mfma_item(const Params& p, int l, const bf16_t* Zb, const bf16_t* VTb, bf16_t* YAb, int h, int qrow0, int key0, int nkeys,
                                               float lam, float lam_init, char* smem) {
  const int tid = otid(), lane = tid & 63, w = tid >> 6, fr = lane & 31, fh = lane >> 5;
  const int rb = w & 1, m = w >> 1;
  const int ntiles = nkeys >> 6;
  const int myrow = qrow0 + rb * 32 + fr;
  bf16x8 qf[4];
  {
    const bf16_t* qp = Zb + (size_t)myrow * ZW + h * 128 + m * 64 + fh * 8;
#pragma unroll
    for (int ks = 0; ks < 4; ++ks) qf[ks] = *(const bf16x8*)(qp + ks * 16);
  }
  f32x16 O[4];
#pragma unroll
  for (int eb = 0; eb < 4; ++eb)
#pragma unroll
    for (int i = 0; i < 16; ++i) O[eb][i] = 0.f;
  float mrun = -1e30f, lrun = 0.f;
  const float cs = 0.125f * 1.4426950408889634f;
  const int skey = tid >> 4, sch = tid & 15;
  const bf16_t* ksrc = Zb + (size_t)(key0 + skey) * ZW + 512 + h * 128 + sch * 8;
  const int kdst = skey * 256 + ((sch ^ (skey & 15)) << 4);
  const int se = tid >> 3, svc = tid & 7;
  const bf16_t* vsrc = VTb + ((size_t)h * 128 + se) * NTOK + key0 + svc * 8;
  const int vsw = (se >> 1) & 15;
  const int vdst0 = se * 128 + (((2 * svc) ^ vsw) << 3), vdst1 = se * 128 + (((2 * svc + 1) ^ vsw) << 3);
  const int kfo = fr * 256, kfs = fr & 15;
  const int vfo = fr * 128, vfs = (fr >> 1) & 15;
  u32x4 rk[4], rv[4];
#pragma unroll
  for (int i = 0; i < 4; ++i) rk[i] = *(const u32x4*)(ksrc + (size_t)i * 16 * ZW);
  __syncthreads();
#pragma unroll
  for (int i = 0; i < 4; ++i) *(u32x4*)(smem + kdst + i * 4096) = rk[i];
  __syncthreads();
  bf16x8 pf[4];
#define ATT_S(T) { const char* kb_ = smem + ((T) & 1) * 16384; _Pragma("unroll") for (int kb = 0; kb < 2; ++kb) { \
      _Pragma("unroll") for (int i = 0; i < 16; ++i) S[kb][i] = 0.f; \
      _Pragma("unroll") for (int ks = 0; ks < 4; ++ks) { \
        const bf16x8 kf = *(const bf16x8*)(kb_ + kb * 8192 + kfo + (((m * 8 + ks * 2 + fh) ^ kfs) << 4)); \
        S[kb] = __builtin_amdgcn_mfma_f32_32x32x16_bf16(kf, qf[ks], S[kb], 0, 0, 0); } } }
#define ATT_MAX() { float tm = S[0][0]; \
      _Pragma("unroll") for (int i = 1; i < 16; ++i) tm = fmaxf(tm, S[0][i]); \
      _Pragma("unroll") for (int i = 0; i < 16; ++i) tm = fmaxf(tm, S[1][i]); \
      tm = fmaxf(tm, __shfl_xor(tm, 32)) * cs; alpha = 1.f; \
      if (tm > mrun + 8.0f) { alpha = __builtin_amdgcn_exp2f(mrun - tm); mrun = tm; } }
#define ATT_EXP(PF) { const float mc = mrun; float rs = 0.f; \
      _Pragma("unroll") for (int kb = 0; kb < 2; ++kb) { float pv[16]; \
        _Pragma("unroll") for (int i = 0; i < 16; ++i) { pv[i] = __builtin_amdgcn_exp2f(fmaf(S[kb][i], cs, -mc)); rs += pv[i]; } \
        _Pragma("unroll") for (int hh = 0; hh < 2; ++hh) \
          PF[kb * 2 + hh] = __builtin_bit_cast(bf16x8, (u32x4){pack2(pv[8 * hh], pv[8 * hh + 1]), pack2(pv[8 * hh + 2], pv[8 * hh + 3]), \
                                                               pack2(pv[8 * hh + 4], pv[8 * hh + 5]), pack2(pv[8 * hh + 6], pv[8 * hh + 7])}); } \
      lrun += rs; }
#define ATT_PV(T) { const char* vb_ = smem + 32768 + ((T) & 1) * 16384; _Pragma("unroll") for (int eb = 0; eb < 4; ++eb) _Pragma("unroll") for (int s = 0; s < 4; ++s) { \
        const u32x2 v0 = *(const u32x2*)(vb_ + eb * 4096 + vfo + (((4 * s + fh) ^ vfs) << 3)); \
        const u32x2 v1 = *(const u32x2*)(vb_ + eb * 4096 + vfo + (((4 * s + fh + 2) ^ vfs) << 3)); \
        const bf16x8 vf = __builtin_bit_cast(bf16x8, (u32x4){v0[0], v0[1], v1[0], v1[1]}); \
        O[eb] = __builtin_amdgcn_mfma_f32_32x32x16_bf16(vf, pf[s], O[eb], 0, 0, 0); } }
  f32x16 S[2];
  float alpha;
  {
#pragma unroll
    for (int i = 0; i < 4; ++i) rk[i] = *(const u32x4*)(ksrc + (size_t)(64 + i * 16) * ZW);
#pragma unroll
    for (int i = 0; i < 4; ++i) rv[i] = *(const u32x4*)(vsrc + (size_t)i * 32 * NTOK);
    ATT_S(0)
    ATT_MAX()
    ATT_EXP(pf)
#pragma unroll
    for (int i = 0; i < 4; ++i) *(u32x4*)(smem + 16384 + kdst + i * 4096) = rk[i];
#pragma unroll
    for (int i = 0; i < 4; ++i) {
      *(u32x2*)(smem + 32768 + vdst0 + i * 4096) = (u32x2){rv[i][0], rv[i][1]};
      *(u32x2*)(smem + 32768 + vdst1 + i * 4096) = (u32x2){rv[i][2], rv[i][3]};
    }
    __syncthreads();
  }
#pragma unroll 1
  for (int t = 1; t < ntiles; ++t) {
    const int tn = (t + 1 < ntiles) ? t + 1 : t;
#pragma unroll
    for (int i = 0; i < 4; ++i) rk[i] = *(const u32x4*)(ksrc + (size_t)(tn * 64 + i * 16) * ZW);
#pragma unroll
    for (int i = 0; i < 4; ++i) rv[i] = *(const u32x4*)(vsrc + (size_t)i * 32 * NTOK + t * 64);
    ATT_S(t)
    ATT_MAX()
    if (__any(alpha != 1.f)) {
#pragma unroll
      for (int eb = 0; eb < 4; ++eb)
#pragma unroll
        for (int i = 0; i < 16; ++i) O[eb][i] *= alpha;
      lrun *= alpha;
#pragma unroll
      for (int s = 0; s < 4; ++s) {
        const u32x4 r_ = __builtin_bit_cast(u32x4, pf[s]);
        pf[s] = __builtin_bit_cast(bf16x8, (u32x4){pack2(lo16(r_[0]) * alpha, hi16(r_[0]) * alpha), pack2(lo16(r_[1]) * alpha, hi16(r_[1]) * alpha),
                                                   pack2(lo16(r_[2]) * alpha, hi16(r_[2]) * alpha), pack2(lo16(r_[3]) * alpha, hi16(r_[3]) * alpha)});
      }
    }
    bf16x8 pn[4];
    {
      ATT_PV(t - 1)
      ATT_EXP(pn)
#pragma unroll
      for (int i = 0; i < 16; ++i) {
        __builtin_amdgcn_sched_group_barrier(0x100, 1, 0);
        __builtin_amdgcn_sched_group_barrier(0x008, 1, 0);
        __builtin_amdgcn_sched_group_barrier(0x002, 9, 0);
      }
    }
#pragma unroll
    for (int s = 0; s < 4; ++s) pf[s] = pn[s];
    if (t + 1 < ntiles) {
      char* kd = smem + ((t + 1) & 1) * 16384;
#pragma unroll
      for (int i = 0; i < 4; ++i) *(u32x4*)(kd + kdst + i * 4096) = rk[i];
    }
    {
      char* vd = smem + 32768 + (t & 1) * 16384;
#pragma unroll
      for (int i = 0; i < 4; ++i) {
        *(u32x2*)(vd + vdst0 + i * 4096) = (u32x2){rv[i][0], rv[i][1]};
        *(u32x2*)(vd + vdst1 + i * 4096) = (u32x2){rv[i][2], rv[i][3]};
      }
    }
    __syncthreads();
  }
  ATT_PV(ntiles - 1)
  __syncthreads();
#undef ATT_S
#undef ATT_MAX
#undef ATT_EXP
#undef ATT_PV
  const float lt = lrun + __shfl_xor(lrun, 32);
  const float sc = (m ? lam : 1.0f) / lt;
  float* xo = (float*)smem + rb * 4096;
  if (m == 1) {
#pragma unroll
    for (int eb = 0; eb < 4; ++eb)
#pragma unroll
      for (int i = 0; i < 16; ++i) xo[(eb * 32 + (i & 3) + 8 * (i >> 2) + 4 * fh) * 32 + fr] = O[eb][i] * sc;
  }
  __syncthreads();
  if (m == 0) {
    float ss = 0.f;
#pragma unroll
    for (int eb = 0; eb < 4; ++eb)
#pragma unroll
      for (int i = 0; i < 16; ++i) {
        const float o = O[eb][i] * sc - xo[(eb * 32 + (i & 3) + 8 * (i >> 2) + 4 * fh) * 32 + fr];
        O[eb][i] = o; ss = fmaf(o, o, ss);
      }
    ss += __shfl_xor(ss, 32);
    const float rn = rsqrtf(ss * (1.0f / 128.0f) + EPSF) * (1.0f - lam_init);
    const float* sg = p.in[I_SUBG] + l * 512 + h * 128;
    bf16_t* yp = YAb + (size_t)myrow * 512 + h * 128;
#pragma unroll
    for (int eb = 0; eb < 4; ++eb)
#pragma unroll
      for (int q = 0; q < 4; ++q) {
        const int e = eb * 32 + 8 * q + 4 * fh;
        const float4 g = *(const float4*)(sg + e);
        *(u32x2*)(yp + e) = (u32x2){pack2(O[eb][4 * q] * rn * g.x, O[eb][4 * q + 1] * rn * g.y), pack2(O[eb][4 * q + 2] * rn * g.z, O[eb][4 * q + 3] * rn * g.w)};
      }
  }
  __syncthreads();
}

__device__ __forceinline__ int mlstm_row0(int dir, int c) {
  return (dir == 0) ? ((c < 4) ? NLAT + 64 * c : 64 * (c - 4)) : ((c < 4) ? NLAT + 64 * (3 - c) : 64 * (67 - c));
}
__device__ __forceinline__ void stage_mlgates(const Params& p, int l, const float* MGT, float* GA) {
  const int tid = otid(), w = tid >> 6, lane = tid & 63;
  const int nitems = GB * 4 * 2 * 68;
  for (int idx = blockIdx.x * 4 + w; idx < nitems; idx += gridDim.x * 4) {
    const int c = idx % 68, r1 = idx / 68, dir = r1 & 1, h = (r1 >> 1) & 3, bl = r1 >> 3;
    const int row = mlstm_row0(dir, c) + lane;
    const float* mg = MGT + ((size_t)bl * NTOK + row) * 16;
    const float li = mg[dir * 8 + h] + p.in[I_GATEB][l * 16 + dir * 8 + h];
    const float x = mg[dir * 8 + 4 + h] + p.in[I_GATEB][l * 16 + dir * 8 + 4 + h];
    const float lf = fminf(x, 0.f) - log1pf(expf(-fabsf(x)));
    float b = lf;
#pragma unroll
    for (int o = 1; o < 64; o <<= 1) {
      const float v = (dir == 0) ? __shfl_up(b, o) : __shfl_down(b, o);
      const bool ok = (dir == 0) ? (lane >= o) : (lane + o < 64);
      if (ok) b += v;
    }
    const float tot = (dir == 0) ? __shfl(b, 63) : __shfl(b, 0);
    float* ga = GA + (size_t)idx * 272;
    ga[lane] = b * 1.4426950408889634f; ga[64 + lane] = (li - b) * 1.4426950408889634f; ga[128 + lane] = expf(tot + li - b); ga[192 + lane] = expf(b);
    if (lane < 4) ga[256 + lane] = expf(tot);
  }
}

__device__ __forceinline__ void mlstm_chain_item(const Params& p, int l, const bf16_t* QMb, const bf16_t* KMb, const bf16_t* KMTb, const bf16_t* MVTb,
                                                 const float* GAc, bf16_t* HXb, int h, int dir, int ehalf, char* smem) {
  const int tid = otid(), lane = tid & 63, w = tid >> 6, fr = lane & 31, fh = lane >> 5;
  const int tb = w & 1, xb = w >> 1;
  float* fl = (float*)(smem + 73728);
  float* bs = fl; float* as_ = fl + 64; float* wgs = fl + 128; float* ebs = fl + 192; float* dec_s = fl + 256; float* nprev = fl + 272; float* npart = fl + 400;
  f32x16 CT[2];
#pragma unroll
  for (int eb = 0; eb < 2; ++eb)
#pragma unroll
    for (int i = 0; i < 16; ++i) CT[eb][i] = 0.f;
  __syncthreads();
  for (int i = tid; i < 1024; i += 256) ((u32x4*)(smem + 57344))[i] = (u32x4){0u, 0u, 0u, 0u};
  if (tid < 128) nprev[tid] = 0.f;
  const int qr = tid >> 4, qc = tid & 15;
  const int qdst = qr * 256 + ((qc ^ (qr & 15)) << 4);
  const int tr = tid >> 3, tc = tid & 7;
  const int tdst = tr * 128 + ((tc ^ ((tr >> 1) & 7)) << 4);
  const int sw16 = fr & 15, sw8 = (fr >> 1) & 7;
  u32x4 ra[4], rb[4], rc[4], rd[2];
  float4 rg = make_float4(0.f, 0.f, 0.f, 0.f);
#define ML_LOAD(C_) { const int r0_ = mlstm_row0(dir, (C_)); \
    const bf16_t* qs = QMb + (size_t)(r0_ + qr) * 512 + h * 128 + qc * 8; \
    const bf16_t* ks = KMb + (size_t)(r0_ + qr) * 512 + h * 128 + qc * 8; \
    const bf16_t* kts = KMTb + ((size_t)h * 128 + tr) * NTOK + r0_ + tc * 8; \
    const bf16_t* vts = MVTb + ((size_t)h * 128 + ehalf * 64 + tr) * NTOK + r0_ + tc * 8; \
    _Pragma("unroll") for (int i = 0; i < 4; ++i) { ra[i] = *(const u32x4*)(qs + (size_t)i * 16 * 512); rb[i] = *(const u32x4*)(ks + (size_t)i * 16 * 512); \
                                                    rc[i] = *(const u32x4*)(kts + (size_t)i * 32 * NTOK); } \
    _Pragma("unroll") for (int i = 0; i < 2; ++i) rd[i] = *(const u32x4*)(vts + (size_t)i * 32 * NTOK); \
    if (tid < 68) rg = ((const float4*)(GAc + (size_t)(C_) * 272))[tid]; }
  ML_LOAD(0)
#pragma unroll 1
  for (int c = 0; c < 68; ++c) {
    const int row0 = mlstm_row0(dir, c);
    __syncthreads();
#pragma unroll
    for (int i = 0; i < 4; ++i) {
      *(u32x4*)(smem + qdst + i * 4096) = ra[i];
      *(u32x4*)(smem + 16384 + qdst + i * 4096) = rb[i];
      *(u32x4*)(smem + 32768 + tdst + i * 4096) = rc[i];
    }
#pragma unroll
    for (int i = 0; i < 2; ++i) *(u32x4*)(smem + 49152 + tdst + i * 4096) = rd[i];
    if (tid < 68) ((float4*)fl)[tid] = rg;
    if (c + 1 < 68) ML_LOAD(c + 1)
    __syncthreads();
    const int t = tb * 32 + fr;
    bf16x8 qf[8];
#pragma unroll
    for (int ks = 0; ks < 8; ++ks) qf[ks] = *(const bf16x8*)(smem + t * 256 + (((ks * 2 + fh) ^ sw16) << 4));
    const float bt = bs[t], ebt = ebs[t];
    f32x16 S[2];
    float dsum = 0.f;
#pragma unroll
    for (int sb = 0; sb < 2; ++sb) {
#pragma unroll
      for (int i = 0; i < 16; ++i) S[sb][i] = 0.f;
      const bool valid = (dir == 0) ? (sb <= tb) : (sb >= tb);
      if (valid) {
#pragma unroll
        for (int ks = 0; ks < 8; ++ks) {
          const bf16x8 kf = *(const bf16x8*)(smem + 16384 + (sb * 32 + fr) * 256 + (((ks * 2 + fh) ^ sw16) << 4));
          S[sb] = __builtin_amdgcn_mfma_f32_32x32x16_bf16(kf, qf[ks], S[sb], 0, 0, 0);
        }
#pragma unroll
        for (int q = 0; q < 4; ++q) {
          const float4 a4 = *(const float4*)(as_ + sb * 32 + 8 * q + 4 * fh);
          const float av[4] = {a4.x, a4.y, a4.z, a4.w};
#pragma unroll
          for (int j = 0; j < 4; ++j) {
            const int s = sb * 32 + 8 * q + 4 * fh + j;
            const bool ok = (dir == 0) ? (s <= t) : (s >= t);
            const float v = ok ? S[sb][4 * q + j] * __builtin_amdgcn_exp2f(bt + av[j]) : 0.f;
            S[sb][4 * q + j] = v;
            dsum += v;
          }
        }
      }
    }
    bf16x8 pf[4];
#pragma unroll
    for (int sb = 0; sb < 2; ++sb)
#pragma unroll
      for (int hh = 0; hh < 2; ++hh)
        pf[sb * 2 + hh] = __builtin_bit_cast(bf16x8, (u32x4){pack2(S[sb][8 * hh], S[sb][8 * hh + 1]), pack2(S[sb][8 * hh + 2], S[sb][8 * hh + 3]),
                                                                 pack2(S[sb][8 * hh + 4], S[sb][8 * hh + 5]), pack2(S[sb][8 * hh + 6], S[sb][8 * hh + 7])});
    float nq = 0.f;
#pragma unroll
    for (int c8 = 0; c8 < 8; ++c8) {
      const u32x4 qv = *(const u32x4*)(smem + t * 256 + (((fh * 8 + c8) ^ sw16) << 4));
      const float4 n0 = *(const float4*)(nprev + fh * 64 + c8 * 8), n1 = *(const float4*)(nprev + fh * 64 + c8 * 8 + 4);
      nq = fmaf(lo16(qv[0]), n0.x, nq); nq = fmaf(hi16(qv[0]), n0.y, nq); nq = fmaf(lo16(qv[1]), n0.z, nq); nq = fmaf(hi16(qv[1]), n0.w, nq);
      nq = fmaf(lo16(qv[2]), n1.x, nq); nq = fmaf(hi16(qv[2]), n1.y, nq); nq = fmaf(lo16(qv[3]), n1.z, nq); nq = fmaf(hi16(qv[3]), n1.w, nq);
    }
    dsum += __shfl_xor(dsum, 32);
    nq += __shfl_xor(nq, 32);
    const float den = dsum + ebt * nq;
    const float inv = 1.0f / fmaxf(fabsf(den), 1.0f);
    {
      f32x16 N;
#pragma unroll
      for (int i = 0; i < 16; ++i) N[i] = 0.f;
#pragma unroll
      for (int ks = 0; ks < 8; ++ks) {
        const bf16x8 cf = *(const bf16x8*)(smem + 57344 + (xb * 32 + fr) * 256 + (((ks * 2 + fh) ^ sw16) << 4));
        N = __builtin_amdgcn_mfma_f32_32x32x16_bf16(cf, qf[ks], N, 0, 0, 0);
      }
#pragma unroll
      for (int i = 0; i < 16; ++i) N[i] *= ebt;
#pragma unroll
      for (int s4 = 0; s4 < 4; ++s4) {
        const bool valid = (dir == 0) ? ((s4 >> 1) <= tb) : ((s4 >> 1) >= tb);
        if (valid) {
          const int u0 = 4 * s4 + fh, u1 = u0 + 2;
          const char* vrow = smem + 49152 + (xb * 32 + fr) * 128;
          const u32x2 v0 = *(const u32x2*)(vrow + (((u0 >> 1) ^ sw8) << 4) + (u0 & 1) * 8);
          const u32x2 v1 = *(const u32x2*)(vrow + (((u1 >> 1) ^ sw8) << 4) + (u1 & 1) * 8);
          const bf16x8 vf = __builtin_bit_cast(bf16x8, (u32x4){v0[0], v0[1], v1[0], v1[1]});
          N = __builtin_amdgcn_mfma_f32_32x32x16_bf16(vf, pf[s4], N, 0, 0, 0);
        }
      }
      bf16_t* hp = HXb + (size_t)(row0 + t) * 512 + h * 128 + (2 * ehalf + xb) * 32 + 4 * fh;
#pragma unroll
      for (int q = 0; q < 4; ++q)
        *(u32x2*)(hp + 8 * q) = (u32x2){pack2(N[4 * q] * inv, N[4 * q + 1] * inv), pack2(N[4 * q + 2] * inv, N[4 * q + 3] * inv)};
    }
    const float decay = *dec_s;
#pragma unroll
    for (int eb = 0; eb < 2; ++eb)
#pragma unroll
      for (int i = 0; i < 16; ++i) CT[eb][i] *= decay;
#pragma unroll
    for (int ks = 0; ks < 4; ++ks) {
      const u32x4 kraw = *(const u32x4*)(smem + 32768 + (w * 32 + fr) * 128 + (((ks * 2 + fh) ^ sw8) << 4));
      const float4 g0 = *(const float4*)(wgs + ks * 16 + 8 * fh), g1 = *(const float4*)(wgs + ks * 16 + 8 * fh + 4);
      const bf16x8 kts = __builtin_bit_cast(bf16x8, (u32x4){pack2(lo16(kraw[0]) * g0.x, hi16(kraw[0]) * g0.y), pack2(lo16(kraw[1]) * g0.z, hi16(kraw[1]) * g0.w),
                                                             pack2(lo16(kraw[2]) * g1.x, hi16(kraw[2]) * g1.y), pack2(lo16(kraw[3]) * g1.z, hi16(kraw[3]) * g1.w)});
#pragma unroll
      for (int eb = 0; eb < 2; ++eb) {
        const bf16x8 vt = *(const bf16x8*)(smem + 49152 + (eb * 32 + fr) * 128 + (((ks * 2 + fh) ^ sw8) << 4));
        CT[eb] = __builtin_amdgcn_mfma_f32_32x32x16_bf16(kts, vt, CT[eb], 0, 0, 0);
      }
    }
    {
      const int d = tid & 127, sh = tid >> 7;
      float a = 0.f;
#pragma unroll 8
      for (int s = sh * 32; s < sh * 32 + 32; ++s) {
        const bf16_t kv = *(const bf16_t*)(smem + 16384 + s * 256 + ((((d >> 3)) ^ (s & 15)) << 4) + (d & 7) * 2);
        a = fmaf(wgs[s], bf2f(kv), a);
      }
      npart[sh * 128 + d] = a;
    }
    __syncthreads();
#pragma unroll
    for (int eb = 0; eb < 2; ++eb)
#pragma unroll
      for (int q = 0; q < 4; ++q)
        *(u32x2*)(smem + 57344 + (eb * 32 + fr) * 256 + ((((w * 4 + q)) ^ sw16) << 4) + 8 * fh) =
            (u32x2){pack2(CT[eb][4 * q], CT[eb][4 * q + 1]), pack2(CT[eb][4 * q + 2], CT[eb][4 * q + 3])};
    if (tid < 128) nprev[tid] = decay * nprev[tid] + npart[tid] + npart[128 + tid];
  }
#undef ML_LOAD
  __syncthreads();
}

#define S5SEG 128
#define S5NSEG 34
__device__ __forceinline__ int s5_row(int dir, int step) {
  return (dir == 0) ? ((step < NCTX) ? NLAT + step : step - NCTX)
                    : ((step < NCTX) ? NLAT + (NCTX - 1 - step) : (NLAT - 1) - (step - NCTX));
}
__device__ __forceinline__ bf16x8 pack8(const float* f) {
  return __builtin_bit_cast(bf16x8, (u32x4){pack2(f[0], f[1]), pack2(f[2], f[3]), pack2(f[4], f[5]), pack2(f[6], f[7])});
}
struct S5M { float abr, abi, a128r, a128i; bf16x8 bbf[4]; };
__device__ __forceinline__ void s5m_setup(const Params& p, int pg, int lane, S5M& m) {
  const int fr = lane & 31, fh = lane >> 5;
  const float dt = expf(p.in[I_S5DT][pg]);
  m.abr = 0.f; m.abi = 0.f; m.a128r = 0.f; m.a128i = 0.f;
#pragma unroll
  for (int c = 0; c < 2; ++c) {
    const int n = fr + 32 * c;
    const float lre = p.in[I_S5LRE][pg * 64 + n], lim = p.in[I_S5LIM][pg * 64 + n];
    const float mag = expf(lre * dt);
    const float abr = mag * cosf(lim * dt), abi = mag * sinf(lim * dt);
    const float den = lre * lre + lim * lim;
    const float zr = ((abr - 1.0f) * lre + abi * lim) / den;
    const float zi = (abi * lre - (abr - 1.0f) * lim) / den;
    const float4* br4 = (const float4*)(p.in[I_S5BRE] + ((size_t)pg * 64 + n) * 16 + 8 * fh);
    const float4* bi4 = (const float4*)(p.in[I_S5BIM] + ((size_t)pg * 64 + n) * 16 + 8 * fh);
    const float4 b0 = br4[0], b1 = br4[1], c0 = bi4[0], c1 = bi4[1];
    const float br[8] = {b0.x, b0.y, b0.z, b0.w, b1.x, b1.y, b1.z, b1.w}, bi[8] = {c0.x, c0.y, c0.z, c0.w, c1.x, c1.y, c1.z, c1.w};
    float rr[8], ii[8];
#pragma unroll
    for (int j = 0; j < 8; ++j) { rr[j] = zr * br[j] - zi * bi[j]; ii[j] = zr * bi[j] + zi * br[j]; }
    m.bbf[c] = pack8(rr); m.bbf[2 + c] = pack8(ii);
    if (fh == c) {
      m.abr = abr; m.abi = abi;
      const float mg = expf(lre * dt * (float)S5SEG);
      m.a128r = mg * cosf(lim * dt * (float)S5SEG); m.a128i = mg * sinf(lim * dt * (float)S5SEG);
    }
  }
}
template <bool STORE>
__device__ __forceinline__ void s5m_block(const S5M& m, const bf16x8 uf, float& xr, float& xi, char* xs, int lane) {
  f32x16 T[4];
#pragma unroll
  for (int k = 0; k < 4; ++k) {
#pragma unroll
    for (int i = 0; i < 16; ++i) T[k][i] = 0.f;
    T[k] = __builtin_amdgcn_mfma_f32_32x32x16_bf16(uf, m.bbf[k], T[k], 0, 0, 0);
  }
#pragma unroll
  for (int r = 0; r < 16; ++r) {
    auto a = __builtin_amdgcn_permlane32_swap(__float_as_uint(T[0][r]), __float_as_uint(T[1][r]), false, false);
    T[0][r] = __uint_as_float(a[0]); T[1][r] = __uint_as_float(a[1]);
    auto b = __builtin_amdgcn_permlane32_swap(__float_as_uint(T[2][r]), __float_as_uint(T[3][r]), false, false);
    T[2][r] = __uint_as_float(b[0]); T[3][r] = __uint_as_float(b[1]);
  }
#pragma unroll
  for (int q = 0; q < 4; ++q)
#pragma unroll
    for (int hh = 0; hh < 2; ++hh)
#pragma unroll
      for (int j = 0; j < 4; ++j) {
        const int t = 8 * q + 4 * hh + j, r = 4 * q + j;
        const float bre = hh ? T[1][r] : T[0][r], bim = hh ? T[3][r] : T[2][r];
        const float nr = fmaf(m.abr, xr, fmaf(-m.abi, xi, bre));
        const float ni = fmaf(m.abr, xi, fmaf(m.abi, xr, bim));
        xr = nr; xi = ni;
        if (STORE) *(unsigned*)(xs + t * 256 + (((lane >> 2) ^ (t & 15)) << 4) + (lane & 3) * 4) = pack2(xr, xi);
      }
}
__device__ __forceinline__ void stage_s5_pass1(const Params& p, int l, const bf16_t* Z, float* XE) {
  const int tid = otid(), w = tid >> 6, lane = tid & 63, fr = lane & 31, fh = lane >> 5;
  const int nitems = GB * 32 * 2 * (S5NSEG - 1);
  for (int idx = blockIdx.x * 4 + w; idx < nitems; idx += gridDim.x * 4) {
    const int seg = idx % (S5NSEG - 1), r1 = idx / (S5NSEG - 1), dir = r1 & 1, g = (r1 >> 1) & 31, bl = r1 >> 6;
    S5M m;
    s5m_setup(p, (l * 2 + dir) * 32 + g, lane, m);
    float xr = 0.f, xi = 0.f;
    bf16x8 ufs[S5SEG / 32];
#pragma unroll
    for (int sub = 0; sub < S5SEG / 32; ++sub) {
      const int row = s5_row(dir, seg * S5SEG + sub * 32 + fr);
      ufs[sub] = *(const bf16x8*)(Z + ((size_t)bl * NTOK + row) * ZW + 3072 + g * 16 + 8 * fh);
    }
#pragma unroll
    for (int sub = 0; sub < S5SEG / 32; ++sub) s5m_block<false>(m, ufs[sub], xr, xi, nullptr, lane);
    float* xe = XE + ((((size_t)bl * 32 + g) * 2 + dir) * (S5NSEG - 1) + seg) * 128;
    xe[lane] = xr; xe[64 + lane] = xi;
  }
}
__device__ __forceinline__ void s5_item(const Params& p, int l, const bf16_t* Zb, const float* XEc, float* Yb, int g, int dir, int sq, char* smem) {
  const int tid = otid(), w = tid >> 6, lane = tid & 63, fr = lane & 31, fh = lane >> 5;
  const int seg = sq * 4 + w;
  char* xs = smem + w * 8192;
  const int pg = (l * 2 + dir) * 32 + g;
  __syncthreads();
  if (seg < S5NSEG) {
    S5M m;
    s5m_setup(p, pg, lane, m);
    bf16x8 ccf[8];
#pragma unroll
    for (int ks = 0; ks < 8; ++ks) {
      float f[8] = {0.f, 0.f, 0.f, 0.f, 0.f, 0.f, 0.f, 0.f};
      if (fr < 16) {
        const float4 cr = *(const float4*)(p.in[I_S5CRE] + ((size_t)pg * 16 + fr) * 64 + ks * 8 + 4 * fh);
        const float4 ci = *(const float4*)(p.in[I_S5CIM] + ((size_t)pg * 16 + fr) * 64 + ks * 8 + 4 * fh);
        f[0] = cr.x; f[1] = -ci.x; f[2] = cr.y; f[3] = -ci.y; f[4] = cr.z; f[5] = -ci.z; f[6] = cr.w; f[7] = -ci.w;
      }
      ccf[ks] = pack8(f);
    }
    float xr = 0.f, xi = 0.f;
    for (int j = 0; j < seg; ++j) {
      const float er = XEc[j * 128 + lane], ei = XEc[j * 128 + 64 + lane];
      const float nr = m.a128r * xr - m.a128i * xi + er, ni = m.a128r * xi + m.a128i * xr + ei;
      xr = nr; xi = ni;
    }
    bf16x8 ufs[S5SEG / 32];
#pragma unroll
    for (int sub = 0; sub < S5SEG / 32; ++sub) {
      const int row = s5_row(dir, seg * S5SEG + sub * 32 + fr);
      ufs[sub] = *(const bf16x8*)(Zb + (size_t)row * ZW + 3072 + g * 16 + 8 * fh);
    }
#pragma unroll
    for (int sub = 0; sub < S5SEG / 32; ++sub) {
      const int row = s5_row(dir, seg * S5SEG + sub * 32 + fr);
      const bf16x8 uf = ufs[sub];
      s5m_block<true>(m, uf, xr, xi, xs, lane);
      f32x16 Y;
#pragma unroll
      for (int i = 0; i < 16; ++i) Y[i] = 0.f;
#pragma unroll
      for (int ks = 0; ks < 8; ++ks) {
        const bf16x8 xf = *(const bf16x8*)(xs + fr * 256 + (((ks * 2 + fh) ^ (fr & 15)) << 4));
        Y = __builtin_amdgcn_mfma_f32_32x32x16_bf16(ccf[ks], xf, Y, 0, 0, 0);
      }
      float* yp = Yb + (size_t)row * 512 + g * 16 + 4 * fh;
      *(float4*)yp = make_float4(Y[0], Y[1], Y[2], Y[3]);
      *(float4*)(yp + 8) = make_float4(Y[4], Y[5], Y[6], Y[7]);
    }
  }
}

__device__ __forceinline__ void stage_post(const Params& p, int l, int rr_lim, const bf16_t* Z, const bf16_t* HF, const bf16_t* HB,
                                           const float* YSF, const float* YSB, bf16_t* YB, bf16_t* GG) {
  const int tid = otid();
  const int c0 = tid * 2;
  const float2 gml = *(const float2*)(p.in[I_MLNG] + l * 512 + c0);
  const float2 dsk = *(const float2*)(p.in[I_S5D] + l * 512 + c0);
  const int n = GB * rr_lim;
  for (int i0 = blockIdx.x * 4; i0 < n; i0 += gridDim.x * 4) {
    unsigned a0[4], a1[4], og[4], uu[4];
    float2 f[4], b[4];
    size_t r[4];
#pragma unroll
    for (int u = 0; u < 4; ++u) {
      const int i = i0 + u;
      r[u] = (size_t)(i / rr_lim) * NTOK + (i % rr_lim);
      a0[u] = *(const unsigned*)(HF + r[u] * 512 + c0); a1[u] = *(const unsigned*)(HB + r[u] * 512 + c0);
      og[u] = *(const unsigned*)(Z + r[u] * ZW + 2560 + c0); uu[u] = *(const unsigned*)(Z + r[u] * ZW + 3072 + c0);
      f[u] = *(const float2*)(YSF + r[u] * 512 + c0); b[u] = *(const float2*)(YSB + r[u] * 512 + c0);
    }
#pragma unroll
    for (int u = 0; u < 4; ++u) {
      const float h0 = lo16(a0[u]) + lo16(a1[u]), h1 = hi16(a0[u]) + hi16(a1[u]);
      const float ss = wave_sum(h0 * h0 + h1 * h1);
      const float rs = rsqrtf(ss * (1.0f / 128.0f) + EPSF);
      *(unsigned*)(YB + r[u] * 512 + c0) = pack2(h0 * rs * gml.x * sigmoidf_(lo16(og[u])), h1 * rs * gml.y * sigmoidf_(hi16(og[u])));
      *(unsigned*)(GG + r[u] * 512 + c0) = pack2(geluf_(dsk.x * lo16(uu[u]) + f[u].x + b[u].x), geluf_(dsk.y * hi16(uu[u]) + f[u].y + b[u].y));
    }
  }
}

__device__ __forceinline__ void stage_glu_mfma(const Params& p, int l, int tpb, const bf16_t* GG, const bf16_t* GLUT, bf16_t* YS, char* smem) {
  EPI_DECL
  const int tm = GB * tpb;
  TileIter ti(tm, 4);
  int mt_, nt_; bool valid;
  while (ti.next(mt_, nt_, valid)) {
    if (!valid) continue;
    const int m0 = MT_LR0(mt_, tpb), n0 = nt_ * 128;
    f32x16 acc[2][2];
    gemm_tile(GG + (size_t)m0 * 512, 512, GLUT + (size_t)n0 * 512, 512, 512, smem, acc);
#pragma unroll
    for (int mi = 0; mi < 2; ++mi)
#pragma unroll
      for (int ni = 0; ni < 2; ++ni)
#pragma unroll
        for (int q = 0; q < 4; ++q) {
          const int row = m0 + EPI_ROW(mi), c = n0 + EPI_COL(ni, q);
          const float4 b = *(const float4*)(p.in[I_GLUB] + l * 512 + c);
          const u32x2 g2 = *(const u32x2*)(GG + (size_t)row * 512 + c);
          const float o0 = lo16(g2[0]) * sigmoidf_(acc[mi][ni][4 * q] + b.x), o1 = hi16(g2[0]) * sigmoidf_(acc[mi][ni][4 * q + 1] + b.y);
          const float o2 = lo16(g2[1]) * sigmoidf_(acc[mi][ni][4 * q + 2] + b.z), o3 = hi16(g2[1]) * sigmoidf_(acc[mi][ni][4 * q + 3] + b.w);
          *(u32x2*)(YS + (size_t)row * 512 + c) = (u32x2){pack2(o0, o1), pack2(o2, o3)};
        }
  }
}

__device__ __forceinline__ void stage_merge_mfma(int tpb, const bf16_t* YA, const bf16_t* YB, const bf16_t* YS, const bf16_t* WBR, const bf16_t* Z, bf16_t* MG, char* smem) {
  EPI_DECL
  const int tm = GB * tpb;
  TileIter ti(tm, 8);
  int mt_, nt_; bool valid;
  while (ti.next(mt_, nt_, valid)) {
    if (!valid) continue;
    const int m0 = MT_LR0(mt_, tpb), n0 = nt_ * 128;
    f32x16 macc[2][2];
#pragma unroll
    for (int a = 0; a < 2; ++a)
#pragma unroll
      for (int b = 0; b < 2; ++b)
#pragma unroll
        for (int i = 0; i < 16; ++i) macc[a][b][i] = 0.f;
#pragma unroll 1
    for (int r = 0; r < 3; ++r) {
      const bf16_t* Y = (r == 0) ? YA : (r == 1 ? YB : YS);
      f32x16 acc[2][2];
      gemm_tile(Y + (size_t)m0 * 512, 512, WBR + (size_t)r * 1024 * 512 + (size_t)n0 * 512, 512, 512, smem, acc);
#pragma unroll
      for (int mi = 0; mi < 2; ++mi)
#pragma unroll
        for (int ni = 0; ni < 2; ++ni)
#pragma unroll
          for (int q = 0; q < 4; ++q) {
            const int row = m0 + EPI_ROW(mi), c = n0 + EPI_COL(ni, q);
            const u32x2 e = *(const u32x2*)(Z + (size_t)row * ZW + 3584 + r * 1024 + c);
            macc[mi][ni][4 * q] += lo16(e[0]) * acc[mi][ni][4 * q];
            macc[mi][ni][4 * q + 1] += hi16(e[0]) * acc[mi][ni][4 * q + 1];
            macc[mi][ni][4 * q + 2] += lo16(e[1]) * acc[mi][ni][4 * q + 2];
            macc[mi][ni][4 * q + 3] += hi16(e[1]) * acc[mi][ni][4 * q + 3];
          }
    }
#pragma unroll
    for (int mi = 0; mi < 2; ++mi)
#pragma unroll
      for (int ni = 0; ni < 2; ++ni)
#pragma unroll
        for (int q = 0; q < 4; ++q) {
          const int row = m0 + EPI_ROW(mi), c = n0 + EPI_COL(ni, q);
          *(u32x2*)(MG + (size_t)row * DM + c) = (u32x2){pack2(macc[mi][ni][4 * q], macc[mi][ni][4 * q + 1]), pack2(macc[mi][ni][4 * q + 2], macc[mi][ni][4 * q + 3])};
        }
  }
}

__device__ __forceinline__ void stage_outproj_mfma(const Params& p, int l, int g, int tpb, const bf16_t* MG, const bf16_t* WOUT, char* smem) {
  EPI_DECL
  const int tm = GB * tpb;
  const float* mod = (const float*)(p.ws + WB_MOD) + (size_t)l * 9 * 6144;
  TileIter ti(tm, 8);
  int mt, nt_; bool valid;
  while (ti.next(mt, nt_, valid)) {
    if (!valid) continue;
    const int n0 = nt_ * 128;
    const int m0 = MT_LR0(mt, tpb), bl = mt / tpb, rr0 = (mt % tpb) * 128, b = g * GB + bl;
    f32x16 acc[2][2];
    gemm_tile(MG + (size_t)m0 * DM, DM, WOUT + (size_t)n0 * DM, DM, DM, smem, acc);
    const float* gv = mod + (size_t)((rr0 < NLAT) ? b : 8) * 6144 + 2 * 1024;
#pragma unroll
    for (int mi = 0; mi < 2; ++mi)
#pragma unroll
      for (int ni = 0; ni < 2; ++ni)
#pragma unroll
        for (int q = 0; q < 4; ++q) {
          const int rr = rr0 + EPI_ROW(mi), c = n0 + EPI_COL(ni, q);
          const float4 gg = *(const float4*)(gv + c);
          float4* xp = (float4*)(xrow(p, b, rr) + c);
          float4 x = (l == 0) ? *(const float4*)(xrow_in(p, b, rr) + c) : *xp;
          x.x += gg.x * acc[mi][ni][4 * q]; x.y += gg.y * acc[mi][ni][4 * q + 1]; x.z += gg.z * acc[mi][ni][4 * q + 2]; x.w += gg.w * acc[mi][ni][4 * q + 3];
          *xp = x;
        }
  }
}

#define CH_SW(m_, chunk_) ((((chunk_) ^ ((m_) & 15))) << 4)
template <int KC, class BF, class AF, class PF, class EF>
__device__ __forceinline__ void cphase(const int nseg, const int lane, const bf16_t* __restrict__ Wb, BF bofs, AF abase, PF pre, EF epi) {
  const int half = lane >> 5, sw = lane & 15;
  bf16x8 bs[4][2][4];
  const int S = nseg * KC;
  const int crot = ((blockIdx.x >> 3) * 3 + (lane >> 6) + (otid() >> 6) * 5) & (KC - 1);
#define CH_LD(ST, s_) { const int sg_ = (s_) / KC, c_ = ((s_) + crot) % KC; unsigned o0_ = bofs(sg_) + 4096u * c_ + lane * 16; asm volatile("" : "+v"(o0_)); \
    unsigned o1_ = o0_ + KC * 4096u; asm volatile("" : "+v"(o1_)); \
    _Pragma("unroll") for (int ks_ = 0; ks_ < 4; ++ks_) { bs[ST][0][ks_] = *(const bf16x8*)((const char*)Wb + o0_ + 1024 * ks_); bs[ST][1][ks_] = *(const bf16x8*)((const char*)Wb + o1_ + 1024 * ks_); } }
#define CH_LA(DST, s_) { const int sg_ = (s_) / KC, c_ = ((s_) + crot) % KC; const char* ap_ = abase(sg_); \
    _Pragma("unroll") for (int ks_ = 0; ks_ < 4; ++ks_) DST[ks_] = *(const bf16x8*)(ap_ + (((8 * c_ + 4 * half + ks_) ^ sw) << 4)); }
  CH_LD(0, 0) CH_LD(1, 1) CH_LD(2, 2)
  bf16x8 ac[4];
  CH_LA(ac, 0)
  f32x16 acc[2];
#pragma unroll
  for (int f = 0; f < 2; ++f)
#pragma unroll
    for (int i = 0; i < 16; ++i) acc[f][i] = 0.f;
#pragma unroll 1
  for (int s0 = 0; s0 < S; s0 += 4) {
#pragma unroll
    for (int j = 0; j < 4; ++j) {
      const int s = s0 + j;
      if (s + 3 < S) CH_LD((j + 3) & 3, s + 3)
      bf16x8 an[4];
      { const int sn = (s + 1 < S) ? s + 1 : s; CH_LA(an, sn) }
      const int sg = s / KC, c = s % KC;
#pragma unroll
      for (int ks = 0; ks < 4; ++ks)
#pragma unroll
        for (int f = 0; f < 2; ++f) acc[f] = __builtin_amdgcn_mfma_f32_32x32x16_bf16(bs[j][f][ks], ac[ks], acc[f], 0, 0, 0);
      if (j == 3 && c == KC - 5) pre(sg);
      if (j == 3 && c == KC - 1) {
        epi(sg, acc);
#pragma unroll
        for (int f = 0; f < 2; ++f)
#pragma unroll
          for (int i = 0; i < 16; ++i) acc[f][i] = 0.f;
      }
#pragma unroll
      for (int ks = 0; ks < 4; ++ks) ac[ks] = an[ks];
    }
  }
#undef CH_LD
#undef CH_LA
}

__device__ __forceinline__ void stage_chain1(const Params& p, int l, int g, int rr_lim, const bf16_t* Z, const bf16_t* HF, const bf16_t* HB,
                                             const float* YSF, const float* YSB, const bf16_t* YA, bf16_t* MG, const bf16_t* W, char* smem) {
  const int tid = otid(), w = tid >> 6, lane = tid & 63, m = lane & 31, half = lane >> 5;
  const int tpb32 = rr_lim >> 5, ntile = GB * tpb32;
  const float* mod = (const float*)(p.ws + WB_MOD) + (size_t)l * 9 * 6144;
  const bf16_t* GLUT = W + WT_GLU; const bf16_t* WBR = W + WT_WBR; const bf16_t* WOUT = W + WT_WOUT;
  char* R0 = smem; char* R1 = smem + 32768; char* R2 = smem + 65536;
  const int c0 = tid * 2;
  const float2 gml = *(const float2*)(p.in[I_MLNG] + l * 512 + c0);
  const float2 dsk = *(const float2*)(p.in[I_S5D] + l * 512 + c0);
  const int rot = blockIdx.x >> 3;
  for (int t = blockIdx.x; t < ntile; t += gridDim.x) {
    const int bl = t / tpb32, rr0 = (t % tpb32) * 32, b = g * GB + bl;
    const size_t lr0 = (size_t)bl * NTOK + rr0;
    __syncthreads();
    for (int i0 = 0; i0 < 32; i0 += 8) {
      unsigned a0[8], a1[8], og[8], uu[8];
      float2 f[8], bb[8];
#pragma unroll
      for (int u = 0; u < 8; ++u) {
        const size_t r = lr0 + i0 + u;
        a0[u] = *(const unsigned*)(HF + r * 512 + c0); a1[u] = *(const unsigned*)(HB + r * 512 + c0);
        og[u] = *(const unsigned*)(Z + r * ZW + 2560 + c0); uu[u] = *(const unsigned*)(Z + r * ZW + 3072 + c0);
        f[u] = *(const float2*)(YSF + r * 512 + c0); bb[u] = *(const float2*)(YSB + r * 512 + c0);
      }
#pragma unroll
      for (int u = 0; u < 8; ++u) {
        const float h0 = lo16(a0[u]) + lo16(a1[u]), h1 = hi16(a0[u]) + hi16(a1[u]);
        const float ss = wave_sum(h0 * h0 + h1 * h1);
        const float rs = rsqrtf(ss * (1.0f / 128.0f) + EPSF);
        const int mm = i0 + u, off = mm * 1024 + CH_SW(mm, c0 >> 3) + (c0 & 7) * 2;
        *(unsigned*)(R1 + off) = pack2(h0 * rs * gml.x * sigmoidf_(lo16(og[u])), h1 * rs * gml.y * sigmoidf_(hi16(og[u])));
        *(unsigned*)(R0 + off) = pack2(geluf_(dsk.x * lo16(uu[u]) + f[u].x + bb[u].x), geluf_(dsk.y * hi16(uu[u]) + f[u].y + bb[u].y));
      }
    }
    __syncthreads();
    {
      float4 bv[2][4];
      cphase<8>(2, lane, GLUT,
        [&](int sg) __attribute__((always_inline)) { const int cb = (w * 2 + sg + rot) & 7; return (unsigned)(cb * 2) * (8u * 4096u); },
        [&](int sg) __attribute__((always_inline)) { return (const char*)(R0 + m * 1024); },
        [&](int sg) __attribute__((always_inline)) {
          const int n0 = ((w * 2 + sg + rot) & 7) * 64;
#pragma unroll
          for (int f = 0; f < 2; ++f)
#pragma unroll
            for (int q = 0; q < 4; ++q) bv[f][q] = *(const float4*)(p.in[I_GLUB] + l * 512 + n0 + f * 32 + 8 * q + 4 * half);
        },
        [&](int sg, f32x16 (&acc)[2]) __attribute__((always_inline)) {
          const int n0 = ((w * 2 + sg + rot) & 7) * 64;
#pragma unroll
          for (int f = 0; f < 2; ++f)
#pragma unroll
            for (int q = 0; q < 4; ++q) {
              const int c = n0 + f * 32 + 8 * q + 4 * half;
              const int off = m * 1024 + CH_SW(m, c >> 3) + 8 * half;
              const u32x2 g2 = *(const u32x2*)(R0 + off);
              const float o0 = lo16(g2[0]) * sigmoidf_(acc[f][4 * q] + bv[f][q].x), o1 = hi16(g2[0]) * sigmoidf_(acc[f][4 * q + 1] + bv[f][q].y);
              const float o2 = lo16(g2[1]) * sigmoidf_(acc[f][4 * q + 2] + bv[f][q].z), o3 = hi16(g2[1]) * sigmoidf_(acc[f][4 * q + 3] + bv[f][q].w);
              *(u32x2*)(R2 + off) = (u32x2){pack2(o0, o1), pack2(o2, o3)};
            }
        });
    }
    __syncthreads();
    for (int i = tid; i < 32 * 64; i += 256) {
      const int mm = i >> 6, ch = i & 63;
      *(u32x4*)(R0 + mm * 1024 + CH_SW(mm, ch)) = *(const u32x4*)(YA + (lr0 + mm) * 512 + ch * 8);
    }
    __syncthreads();
    {
      f32x16 macc[2];
#pragma unroll
      for (int f = 0; f < 2; ++f)
#pragma unroll
        for (int i = 0; i < 16; ++i) macc[f][i] = 0.f;
      u32x2 e[2][4];
      const size_t row = lr0 + m;
      cphase<8>(12, lane, WBR,
        [&](int sg) __attribute__((always_inline)) { const int pass = sg / 3, r = sg % 3, cb = (w * 4 + pass + rot) & 15; return (unsigned)r * (1024u * 512u * 2u) + (unsigned)(cb * 2) * (8u * 4096u); },
        [&](int sg) __attribute__((always_inline)) { const int r = sg % 3; return (const char*)(smem + r * 32768 + m * 1024); },
        [&](int sg) __attribute__((always_inline)) {
          const int pass = sg / 3, r = sg % 3, n0 = ((w * 4 + pass + rot) & 15) * 64;
#pragma unroll
          for (int f = 0; f < 2; ++f)
#pragma unroll
            for (int q = 0; q < 4; ++q) e[f][q] = *(const u32x2*)(Z + row * ZW + 3584 + r * 1024 + n0 + f * 32 + 8 * q + 4 * half);
        },
        [&](int sg, f32x16 (&acc)[2]) __attribute__((always_inline)) {
          const int pass = sg / 3, r = sg % 3, n0 = ((w * 4 + pass + rot) & 15) * 64;
#pragma unroll
          for (int f = 0; f < 2; ++f)
#pragma unroll
            for (int q = 0; q < 4; ++q) {
              macc[f][4 * q] += lo16(e[f][q][0]) * acc[f][4 * q];
              macc[f][4 * q + 1] += hi16(e[f][q][0]) * acc[f][4 * q + 1];
              macc[f][4 * q + 2] += lo16(e[f][q][1]) * acc[f][4 * q + 2];
              macc[f][4 * q + 3] += hi16(e[f][q][1]) * acc[f][4 * q + 3];
            }
          if (r == 2) {
#pragma unroll
            for (int f = 0; f < 2; ++f)
#pragma unroll
              for (int q = 0; q < 4; ++q) {
                const int c = n0 + f * 32 + 8 * q + 4 * half;
                *(u32x2*)(MG + row * DM + c) = (u32x2){pack2(macc[f][4 * q], macc[f][4 * q + 1]), pack2(macc[f][4 * q + 2], macc[f][4 * q + 3])};
              }
#pragma unroll
            for (int f = 0; f < 2; ++f)
#pragma unroll
              for (int i = 0; i < 16; ++i) macc[f][i] = 0.f;
          }
        });
    }
    __builtin_amdgcn_fence(__ATOMIC_RELEASE, "agent");
    __syncthreads();
    __builtin_amdgcn_fence(__ATOMIC_ACQUIRE, "agent");
    for (int i = tid; i < 32 * 128; i += 256) {
      const int mm = i >> 7, ch = i & 127;
      *(u32x4*)(smem + mm * 2048 + CH_SW(mm, ch)) = *(const u32x4*)(MG + (lr0 + mm) * DM + ch * 8);
    }
    __syncthreads();
    {
      const float* gv = mod + (size_t)((rr0 < NLAT) ? b : 8) * 6144 + 2 * 1024;
      const int rr = rr0 + m;
      float4 xg[2][4], xx[2][4];
      cphase<16>(4, lane, WOUT,
        [&](int sg) __attribute__((always_inline)) { const int cb = (w * 4 + sg + rot) & 15; return (unsigned)(cb * 2) * (16u * 4096u); },
        [&](int sg) __attribute__((always_inline)) { return (const char*)(smem + m * 2048); },
        [&](int sg) __attribute__((always_inline)) {
          const int n0 = ((w * 4 + sg + rot) & 15) * 64;
#pragma unroll
          for (int f = 0; f < 2; ++f)
#pragma unroll
            for (int q = 0; q < 4; ++q) {
              const int c = n0 + f * 32 + 8 * q + 4 * half;
              xg[f][q] = *(const float4*)(gv + c);
              xx[f][q] = (l == 0) ? *(const float4*)(xrow_in(p, b, rr) + c) : *(const float4*)(xrow(p, b, rr) + c);
            }
        },
        [&](int sg, f32x16 (&acc)[2]) __attribute__((always_inline)) {
          const int n0 = ((w * 4 + sg + rot) & 15) * 64;
#pragma unroll
          for (int f = 0; f < 2; ++f)
#pragma unroll
            for (int q = 0; q < 4; ++q) {
              const int c = n0 + f * 32 + 8 * q + 4 * half;
              float4 x = xx[f][q];
              const float4 gg = xg[f][q];
              x.x += gg.x * acc[f][4 * q]; x.y += gg.y * acc[f][4 * q + 1]; x.z += gg.z * acc[f][4 * q + 2]; x.w += gg.w * acc[f][4 * q + 3];
              *(float4*)(xrow(p, b, rr) + c) = x;
            }
        });
    }
  }
}

__device__ __forceinline__ void stage_peerq_mfma(int tpb, const bf16_t* H2, const bf16_t* WQ, bf16_t* PQ, char* smem) {
  EPI_DECL
  const int tm = GB * tpb;
  TileIter ti(tm, 16);
  int mt_, nt_; bool valid;
  while (ti.next(mt_, nt_, valid)) {
    if (!valid) continue;
    const int m0 = MT_LR0(mt_, tpb), n0 = nt_ * 128;
    f32x16 acc[2][2];
    gemm_tile(H2 + (size_t)m0 * DM, DM, WQ + (size_t)n0 * DM, DM, DM, smem, acc);
#pragma unroll
    for (int mi = 0; mi < 2; ++mi)
#pragma unroll
      for (int ni = 0; ni < 2; ++ni)
#pragma unroll
        for (int q = 0; q < 4; ++q) {
          const int row = m0 + EPI_ROW(mi), c = n0 + EPI_COL(ni, q);
          *(u32x2*)(PQ + (size_t)row * 2048 + c) = (u32x2){pack2(acc[mi][ni][4 * q], acc[mi][ni][4 * q + 1]), pack2(acc[mi][ni][4 * q + 2], acc[mi][ni][4 * q + 3])};
        }
  }
}

__device__ __forceinline__ unsigned f2sortable(float x) { const unsigned u = __float_as_uint(x); return (u & 0x80000000u) ? ~u : (u | 0x80000000u); }
__device__ __forceinline__ float sortable2f(unsigned k) { return __uint_as_float((k & 0x80000000u) ? (k & 0x7fffffffu) : ~k); }
#define TOPK_INSERT(v, key) { unsigned t_ = (key); _Pragma("unroll") for (int s_ = 0; s_ < 16; ++s_) { const unsigned hi_ = max(v[s_], t_); t_ = min(v[s_], t_); v[s_] = hi_; } }
__device__ __forceinline__ void stage_scores_topk(int tpb, const bf16_t* PQ, const bf16_t* SUBK, int* EI, float* EG, char* smem) {
  EPI_DECL
  const int tid = tid_;
  const int item = tid & 127, kpart = tid >> 7;
  float* S = (float*)smem;
  unsigned* xk = (unsigned*)(smem + 128 * 129 * 4);
  const int tm = GB * tpb * 8;
  for (int mt = blockIdx.x; mt < tm; mt += gridDim.x) {
    const size_t m0 = (size_t)MT_LR0(mt >> 3, tpb) * 8 + (size_t)(mt & 7) * 128;
    unsigned vh[2][16];
#pragma unroll
    for (int half = 0; half < 2; ++half) {
      f32x16 acc[2][2];
      gemm_tile(PQ + m0 * 256 + half * 128, 256, SUBK + (size_t)half * 16384, 128, 128, smem, acc);
#pragma unroll
      for (int mi = 0; mi < 2; ++mi)
#pragma unroll
        for (int ni = 0; ni < 2; ++ni)
#pragma unroll
          for (int i = 0; i < 16; ++i)
            S[EPI_ROW(mi) * 129 + wn * 64 + ni * 32 + 8 * (i >> 2) + 4 * fh + (i & 3)] = acc[mi][ni][i];
      __syncthreads();
      unsigned v[16];
#pragma unroll
      for (int s = 0; s < 16; ++s) v[s] = 0u;
      const float* sr = S + item * 129 + kpart * 64;
#pragma unroll 8
      for (int k = 0; k < 64; ++k) {
        const unsigned key = (f2sortable(sr[k]) & ~127u) | (unsigned)(127 - (kpart * 64 + k));
        TOPK_INSERT(v, key)
      }
      if (kpart == 1) {
#pragma unroll
        for (int s = 0; s < 16; ++s) xk[item * 17 + s] = v[s];
      }
      __syncthreads();
      if (kpart == 0) {
#pragma unroll
        for (int s = 0; s < 16; ++s) { const unsigned key = xk[item * 17 + s]; TOPK_INSERT(v, key) }
      }
#pragma unroll
      for (int s = 0; s < 16; ++s) vh[half][s] = v[s];
      __syncthreads();
    }
    if (kpart == 0) {
      float v1[16], v2[16];
#pragma unroll
      for (int s = 0; s < 16; ++s) { v1[s] = sortable2f((vh[0][s] & ~127u) | 64u); v2[s] = sortable2f((vh[1][s] & ~127u) | 64u); }
      unsigned c[16];
#pragma unroll
      for (int s = 0; s < 16; ++s) c[s] = 0u;
      {
        int o = 0;
#pragma unroll
        for (int i = 0; i < 16; ++i)
#pragma unroll
          for (int j = 0; j < 16 / (i + 1); ++j) {
            const unsigned key = (f2sortable(v1[i] + v2[j]) & ~63u) | (unsigned)(63 - o);
            TOPK_INSERT(c, key)
            ++o;
          }
      }
      const float vmax = sortable2f((c[0] & ~63u) | 32u);
      float sum = 0.f;
#pragma unroll
      for (int s = 0; s < 16; ++s) sum += expf(sortable2f((c[s] & ~63u) | 32u) - vmax);
      const float isum = 1.0f / sum;
      const unsigned thr = c[15];
      int* ei = EI + (m0 + item) * 16;
      float* eg = EG + (m0 + item) * 16;
      int cntw = 0;
      {
        int o = 0;
#pragma unroll
        for (int i = 0; i < 16; ++i)
#pragma unroll
          for (int j = 0; j < 16 / (i + 1); ++j) {
            const unsigned key = (f2sortable(v1[i] + v2[j]) & ~63u) | (unsigned)(63 - o);
            if (key >= thr) {
              ei[cntw] = (int)((127u - (vh[0][i] & 127u)) * 128u + (127u - (vh[1][j] & 127u)));
              eg[cntw] = expf(sortable2f((key & ~63u) | 32u) - vmax) * isum;
              ++cntw;
            }
            ++o;
          }
      }
    }
  }
  __syncthreads();
}

#define DPPF(x, ctrl) __uint_as_float((unsigned)__builtin_amdgcn_update_dpp(0, (int)__float_as_uint(x), (ctrl), 0xf, 0xf, true))
#define XP_HALVE(n, bit, ctrl) { _Pragma("unroll") for (int j_ = 0; j_ < (n); ++j_) { const float keep_ = (bit) ? a[j_ + (n)] : a[j_]; const float send_ = (bit) ? a[j_] : a[j_ + (n)]; a[j_] = keep_ + DPPF(send_, ctrl); } }
#define XP_ROW(TAB, E, PR) { const int e0_ = __builtin_amdgcn_readlane((E), 2 * (PR)), e1_ = __builtin_amdgcn_readlane((E), 2 * (PR) + 1); \
    const char* rp_ = (TAB) + (size_t)(hw ? e1_ : e0_) * 768 + hl * 24; \
    const u32x4_u x_ = *(const u32x4_u*)rp_; const u32x2 y_ = *(const u32x2*)(rp_ + 16); \
    ra[PR] = (v6u){x_[0], x_[1], x_[2], x_[3], y_[0], y_[1]}; }
#define XP_META(PAR, T, E, G, HP) { const size_t mo_ = ((size_t)(PAR) * RPG + (T)) * 128 + w * 32 + hl; \
    E = ((const int*)(p.ws + WB_EI))[mo_]; G = ((const float*)(p.ws + WB_EG))[mo_]; \
    const u32x4* hr_ = (const u32x4*)((const bf16_t*)(p.ws + WB_H2) + ((size_t)(PAR) * RPG + (T)) * DM + hl * 32); \
    _Pragma("unroll") for (int c_ = 0; c_ < 4; ++c_) HP[c_] = hr_[c_]; }
__device__ __forceinline__ void unpack8(const u32x4 v, float* f) {
#pragma unroll
  for (int k = 0; k < 4; ++k) { f[2 * k] = lo16(v[k]); f[2 * k + 1] = hi16(v[k]); }
}
__device__ __forceinline__ int xp_pool_n(int q) { return GB * ((q < NG) ? NTOK : NLAT); }
__device__ __forceinline__ int xp_claim(int* pool, int& qa, int hi) {
  while (qa <= hi) {
    const int n = xp_pool_n(qa);
    if (__hip_atomic_load(pool + qa, __ATOMIC_RELAXED, __HIP_MEMORY_SCOPE_AGENT) < n) {
      const int i = atomicAdd(pool + qa, 1);
      if (i < n) return qa * 65536 + i;
    }
    ++qa;
  }
  return -1;
}
__device__ __forceinline__ void xp_decode(int tok, int& l, int& par, int& b, int& rr, int& t) {
  const int q = tok >> 16, i = tok & 65535;
  l = q / NG;
  const int g = q % NG, rr_lim = (l == 0) ? NTOK : NLAT, bl = i / rr_lim;
  rr = i % rr_lim; b = g * GB + bl; t = bl * NTOK + rr; par = q & 1;
}
__device__ __forceinline__ void expert_run(const Params& p, int lo, int hi, unsigned* ctr, unsigned epoch, const bool steal, int& pend, float* smem) {
  if (lo < 0) lo = 0;
  if (hi < lo) return;
  const int tid = otid(), w = tid >> 6, lane = tid & 63, hl = lane & 31, hw = lane >> 5;
  int* s_tok = (int*)(smem + SMEM_FLOATS - 8);
  int* pool = (int*)(p.ws + WB_POOL);
  float* part = smem;
  int qa = lo, ci = 0;
  bool cpend = false;
  unsigned cb = 0;
  int cur = pend; pend = -1;
  if (cur < 0) {
    __syncthreads();
    if (tid == 0) s_tok[2] = xp_claim(pool, qa, hi);
    __syncthreads();
    cur = __builtin_amdgcn_readfirstlane(s_tok[2]);
  }
  if (cur < 0) return;
  if (tid == 0 && qa <= hi) { ci = atomicAdd(pool + qa, 1); cpend = true; }
  int l, par, b, rr, t;
  xp_decode(cur, l, par, b, rr, t);
  int e_c; float g_c; u32x4 hp[4];
  XP_META(par, t, e_c, g_c, hp)
  v6u ra[16];
  {
    const char* U = p.ws + WB_U16 + (size_t)l * 16384 * 768;
#pragma unroll
    for (int pr = 0; pr < 16; ++pr) XP_ROW(U, e_c, pr)
  }
  for (;;) {
    const float* mod = (const float*)(p.ws + WB_MOD) + (size_t)l * 9 * 6144;
    const float4 g2 = ((const float4*)(mod + (size_t)((rr < NLAT) ? b : 8) * 6144 + 5 * 1024))[tid];
    float4* xp = (float4*)xrow(p, b, rr) + tid;
    float4 xv = *xp;
    if (tid == 0) {
      int r = -1;
      if (cpend) {
        if (ci < xp_pool_n(qa)) r = qa * 65536 + ci;
        else { ++qa; r = xp_claim(pool, qa, hi); }
      }
      const int st = (steal && cb + 1u >= epoch) ? 1 : 0;
      s_tok[0] = r; s_tok[1] = st;
      cpend = false;
      if (!st && r >= 0 && qa <= hi) { ci = atomicAdd(pool + qa, 1); cpend = true; }
      if (steal) cb = __hip_atomic_load(ctr, __ATOMIC_RELAXED, __HIP_MEMORY_SCOPE_AGENT);
    }
    __syncthreads();
    const int nxt = __builtin_amdgcn_readfirstlane(s_tok[0]);
    const bool pf = nxt >= 0 && __builtin_amdgcn_readfirstlane(s_tok[1]) == 0;
    int ln = l, parn = 0, bn = 0, rrn = 0, tn = 0, e_n = 0;
    float g_n = 0.f;
    u32x4 hn[4];
#pragma unroll
    for (int c = 0; c < 4; ++c) hn[c] = (u32x4){0u, 0u, 0u, 0u};
    if (pf) {
      xp_decode(nxt, ln, parn, bn, rrn, tn);
      XP_META(parn, tn, e_n, g_n, hn)
    }
    const char* V = p.ws + WB_V16 + (size_t)l * 16384 * 768;
    f32x2 hq2[16];
#pragma unroll
    for (int c = 0; c < 4; ++c)
#pragma unroll
      for (int k = 0; k < 4; ++k) hq2[4 * c + k] = (f32x2){lo16(hp[c][k]), hi16(hp[c][k])};
    float a[16];
#pragma unroll
    for (int pr = 0; pr < 16; ++pr) {
      const v32f f = __builtin_amdgcn_cvt_scalef32_pk32_f32_fp6(ra[pr], 1.0f);
      f32x2 sa = {0.f, 0.f}, sb = {0.f, 0.f};
#pragma unroll
      for (int k = 0; k < 16; k += 2) {
        sa = __builtin_elementwise_fma(hq2[k], (f32x2){f[2 * k], f[2 * k + 1]}, sa);
        sb = __builtin_elementwise_fma(hq2[k + 1], (f32x2){f[2 * k + 2], f[2 * k + 3]}, sb);
      }
      a[pr] = (sa[0] + sb[0]) + (sa[1] + sb[1]);
      XP_ROW(V, e_c, pr)
    }
    {
      const bool b3 = (lane & 8) != 0, b2 = (lane & 4) != 0, b1 = (lane & 2) != 0, b0 = (lane & 1) != 0;
      XP_HALVE(8, b3, 0x128)
      XP_HALVE(4, b2, 0x141)
      XP_HALVE(2, b1, 0x4E)
      XP_HALVE(1, b0, 0xB1)
    }
    float dsum = a[0];
    dsum += __shfl_xor(dsum, 16);
    const float my_dot = __shfl(dsum, 32 * (hl & 1) + (hl >> 1));
    const float my_c = g_c * geluf_(my_dot * (1.0f / 64.0f));
    f32x2 acc2[16];
#pragma unroll
    for (int k = 0; k < 16; ++k) acc2[k] = (f32x2){0.f, 0.f};
    {
      const char* Un = p.ws + WB_U16 + (size_t)ln * 16384 * 768;
#pragma unroll
      for (int pr = 0; pr < 16; ++pr) {
        const float c0 = __uint_as_float(__builtin_amdgcn_readlane(__float_as_uint(my_c), 2 * pr)), c1 = __uint_as_float(__builtin_amdgcn_readlane(__float_as_uint(my_c), 2 * pr + 1));
        const float c = hw ? c1 : c0;
        const f32x2 cc = {c, c};
        const v32f f = __builtin_amdgcn_cvt_scalef32_pk32_f32_fp6(ra[pr], 1.0f);
#pragma unroll
        for (int k = 0; k < 16; ++k) acc2[k] = __builtin_elementwise_fma(cc, (f32x2){f[2 * k], f[2 * k + 1]}, acc2[k]);
        XP_ROW(Un, e_n, pr)
      }
    }
    __syncthreads();
    {
      float4* pw = (float4*)(part + (w * 2 + hw) * 1024 + hl * 32);
#pragma unroll
      for (int c = 0; c < 8; ++c) pw[c] = make_float4(acc2[2 * c][0], acc2[2 * c][1], acc2[2 * c + 1][0], acc2[2 * c + 1][1]);
    }
    __syncthreads();
    float4 s = ((const float4*)part)[tid];
#pragma unroll
    for (int c = 1; c < 8; ++c) { const float4 x = ((const float4*)(part + c * 1024))[tid]; s.x += x.x; s.y += x.y; s.z += x.z; s.w += x.w; }
    xv.x += 0.5f * g2.x * s.x; xv.y += 0.5f * g2.y * s.y; xv.z += 0.5f * g2.z * s.z; xv.w += 0.5f * g2.w * s.w;
    *xp = xv;
    if (!pf) { pend = nxt; break; }
    l = ln; par = parn; b = bn; rr = rrn; t = tn; e_c = e_n; g_c = g_n;
#pragma unroll
    for (int c = 0; c < 4; ++c) hp[c] = hn[c];
  }
}
__device__ __forceinline__ void expert_drain(const Params& p, int lo, int hi, int& pend, float* smem) {
  expert_run(p, lo, hi, nullptr, 0u, false, pend, smem);
}

__device__ __forceinline__ void stage_final(const Params& p, float* smem) {
  const int tid = otid(), w = tid >> 6, lane = tid & 63;
  const int n = NB * NLAT;
  for (int r0 = (blockIdx.x * 4 + w) * 2; r0 < n; r0 += gridDim.x * 8) {
    float4 v[2][4];
#pragma unroll
    for (int u = 0; u < 2; ++u)
#pragma unroll
      for (int q = 0; q < 4; ++q) v[u][q] = ((const float4*)(p.out + (size_t)(r0 + u) * DM))[q * 64 + lane];
#pragma unroll
    for (int u = 0; u < 2; ++u) {
      float s = 0.f;
#pragma unroll
      for (int q = 0; q < 4; ++q) s += v[u][q].x * v[u][q].x + v[u][q].y * v[u][q].y + v[u][q].z * v[u][q].z + v[u][q].w * v[u][q].w;
      s = wave_sum(s);
      const float rs = rsqrtf(s * (1.0f / DM) + EPSF);
#pragma unroll
      for (int q = 0; q < 4; ++q) {
        const float4 g = ((const float4*)p.in[I_FG])[q * 64 + lane];
        const float4 x = v[u][q];
        ((float4*)(p.out + (size_t)(r0 + u) * DM))[q * 64 + lane] = make_float4(x.x * rs * g.x, x.y * rs * g.y, x.z * rs * g.z, x.w * rs * g.w);
      }
    }
  }
}

__device__ __forceinline__ void gbar(const Params& p, unsigned* ctr, unsigned& epoch, int lo, int hi, int& pend, float* smem) {
  asm volatile("s_waitcnt vmcnt(0)" ::: "memory");
  __syncthreads();
  epoch += gridDim.x;
  int* s_flag = (int*)(smem + SMEM_FLOATS - 12);
  if (threadIdx.x == 0) {
    __builtin_amdgcn_fence(__ATOMIC_RELEASE, "agent");
    asm volatile("s_waitcnt vmcnt(0)" ::: "memory");
    __hip_atomic_fetch_add(ctr, 1u, __ATOMIC_RELAXED, __HIP_MEMORY_SCOPE_AGENT);
  }
  if (hi >= lo && hi >= 0) {
    if (threadIdx.x == 0) {
      const unsigned c = __hip_atomic_load(ctr, __ATOMIC_RELAXED, __HIP_MEMORY_SCOPE_AGENT);
      *s_flag = (c + 1u < epoch) ? 1 : 0;
    }
    __syncthreads();
    if (*s_flag) expert_run(p, lo, hi, ctr, epoch, true, pend, smem);
  }
  if (threadIdx.x == 0) {
    while (__hip_atomic_load(ctr, __ATOMIC_RELAXED, __HIP_MEMORY_SCOPE_AGENT) < epoch) __builtin_amdgcn_s_sleep(2);
    __builtin_amdgcn_fence(__ATOMIC_ACQUIRE, "agent");
    asm volatile("s_waitcnt vmcnt(0)" ::: "memory");
  }
  __syncthreads();
}

__global__ void __launch_bounds__(256) mega(Params p) {
  cg::grid_group grid = cg::this_grid();
  __shared__ __attribute__((aligned(16))) float smem[SMEM_FLOATS];
  char* smc = (char*)smem;
  char* ws = p.ws;
  bf16_t* H = (bf16_t*)(ws + WB_H); bf16_t* Z = (bf16_t*)(ws + WB_Z); float* MGT = (float*)(ws + WB_MGT); bf16_t* XC = (bf16_t*)(ws + WB_XC);
  bf16_t* QM = (bf16_t*)(ws + WB_QM); bf16_t* KM = (bf16_t*)(ws + WB_KM); bf16_t* KMT = (bf16_t*)(ws + WB_KMT); bf16_t* MVT = (bf16_t*)(ws + WB_MVT);
  bf16_t* HF = (bf16_t*)(ws + WB_HF); bf16_t* HB = (bf16_t*)(ws + WB_HB);
  bf16_t* VT = (bf16_t*)(ws + WB_VT); float* YSF = (float*)(ws + WB_YSF); float* YSB = (float*)(ws + WB_YSB);
  bf16_t* YA = (bf16_t*)(ws + WB_YA); bf16_t* YB = (bf16_t*)(ws + WB_YB); bf16_t* YS = (bf16_t*)(ws + WB_YS); bf16_t* GG = (bf16_t*)(ws + WB_GG);
  bf16_t* MG = (bf16_t*)(ws + WB_MG); bf16_t* PQ = (bf16_t*)(ws + WB_PQ); float* SC = (float*)(ws + WB_SC);
  float* XE = (float*)(ws + WB_XE); float* GA = (float*)(ws + WB_GA);
  const bf16_t* WT = (const bf16_t*)(ws + WB_WT);

  unsigned* bar = (unsigned*)(ws + WB_BAR);
  unsigned epoch = 0;
  int pend = -1;
  stage_init(p, smem);
  grid.sync();

  for (int l = 0; l < 2; ++l) {
    const bool need_ctx = (l == 0);
    const int rr_lim = need_ctx ? NTOK : NLAT;
    const int tpb = need_ctx ? 34 : 32;
    const bf16_t* W = WT + (size_t)l * WT_LAYER;
    const float lam_init = 0.8f - 0.6f * expf(-0.3f * (float)l);
    float lam;
    {
      float s1 = 0.f, s2 = 0.f;
      for (int i = 0; i < 64; ++i) {
        s1 += p.in[I_LQ1][l * 64 + i] * p.in[I_LK1][l * 64 + i];
        s2 += p.in[I_LQ2][l * 64 + i] * p.in[I_LK2][l * 64 + i];
      }
      lam = expf(s1) - expf(s2) + lam_init;
    }
    for (int g = 0; g < NG; ++g) {
      const int q = l * NG + g;
      int plo = q - 2, phi = q - 1;
      int* EI = (int*)(ws + WB_EI) + (size_t)(q & 1) * RPG * 128; float* EG = (float*)(ws + WB_EG) + (size_t)(q & 1) * RPG * 128;
      bf16_t* H2 = (bf16_t*)(ws + WB_H2) + (size_t)(q & 1) * RPG * DM;
      stage_normmod(p, l, g, 0, NTOK, H, smem);
      gbar(p, bar, epoch, plo, phi, pend, smem);
      stage_inproj(p, H, W + WT_WIN, Z, MGT, VT, MVT, smc);
      gbar(p, bar, epoch, plo, phi, pend, smem);
      stage_conv(p, l, Z, XC);
      stage_s5_pass1(p, l, Z, XE);
      gbar(p, bar, epoch, plo, phi, pend, smem);
      stage_mlqk(XC, W + WT_WQK, QM, KM, KMT, smc);
      stage_mlgates(p, l, MGT, GA);
      gbar(p, bar, epoch, plo, phi, pend, smem);
      {
        const int n_attn = 4 * 64 + (need_ctx ? 4 * 4 : 0);
        const int n_s5 = 32 * 2 * 9;
        const int n_items = GB * (16 + n_attn + n_s5);
        int* cnt = (int*)(ws + WB_CNT) + (l * NG + g);
        int* s_item = (int*)(smem + SMEM_FLOATS - 4);
        for (;;) {
          __syncthreads();
          if (otid() == 0) *s_item = atomicAdd(cnt, 1);
          __syncthreads();
          const int it = *s_item;
          if (it >= n_items) break;
          int bl, k;
          if (it < GB * 16) { bl = it / 16; k = it % 16; }
          else if (it < GB * (16 + n_attn)) { bl = (it - GB * 16) / n_attn; k = 16 + (it - GB * 16) % n_attn; }
          else { bl = (it - GB * (16 + n_attn)) / n_s5; k = 16 + n_attn + (it - GB * (16 + n_attn)) % n_s5; }
          const bf16_t* Zb = Z + (size_t)bl * NTOK * ZW;
          const size_t ro = (size_t)bl * NTOK;
          if (k < 16) {
            const int hh = k & 3, dd = (k >> 2) & 1, eh = k >> 3;
            mlstm_chain_item(p, l, QM + ro * 512, KM + ro * 512, KMT + (size_t)bl * 4 * 128 * NTOK, MVT + (size_t)bl * 4 * 128 * NTOK, GA + (size_t)(((bl * 4 + hh) * 2 + dd) * 68) * 272,
                             (dd ? HB : HF) + ro * 512, hh, dd, eh, smc);
          } else if (k < 16 + n_attn) {
            const int a = k - 16;
            const bf16_t* VTb = VT + (size_t)bl * 4 * 128 * NTOK;
            if (a < 256) attn_mfma_item(p, l, Zb, VTb, YA + ro * 512, a & 3, (a >> 2) * 64, 0, NTOK, lam, lam_init, smc);
            else attn_mfma_item(p, l, Zb, VTb, YA + ro * 512, (a - 256) & 3, NLAT + ((a - 256) >> 2) * 64, NLAT, NCTX, lam, lam_init, smc);
          } else {
            const int a = k - 16 - n_attn;
            const int sq = a % 9, dir = (a / 9) & 1, gg = a / 18;
            s5_item(p, l, Zb, XE + (((size_t)bl * 32 + gg) * 2 + dir) * (S5NSEG - 1) * 128, (dir ? YSB : YSF) + ro * 512, gg, dir, sq, smc);
          }
        }
      }
      gbar(p, bar, epoch, plo, phi, pend, smem);
      stage_chain1(p, l, g, rr_lim, Z, HF, HB, YSF, YSB, YA, MG, W, smc);
      gbar(p, bar, epoch, plo, phi, pend, smem);
      expert_drain(p, plo, plo, pend, smem);
      plo = q - 1;
      gbar(p, bar, epoch, plo, phi, pend, smem);
      stage_normmod(p, l, g, 1, rr_lim, H2, smem);
      gbar(p, bar, epoch, plo, phi, pend, smem);
      stage_peerq_mfma(tpb, H2, W + WT_WQ, PQ, smc);
      gbar(p, bar, epoch, plo, phi, pend, smem);
      stage_scores_topk(tpb, PQ, W + WT_SUBK, EI, EG, smc);
      gbar(p, bar, epoch, plo, phi, pend, smem);
    }
  }
  expert_drain(p, 2 * NG - 2, 2 * NG - 1, pend, smem);
  gbar(p, bar, epoch, 0, -1, pend, smem);
  stage_final(p, smem);
}

extern "C" void kernel_launch(void* const* d_in, const int* in_sizes, int n_in, void* d_out,
                              int out_size, void* d_ws, size_t ws_size, hipStream_t stream) {
  static int grid_blocks = 0;
  if (!grid_blocks) {
    int dev = 0, cus = 0, per_cu = 0;
    (void)hipGetDevice(&dev);
    (void)hipDeviceGetAttribute(&cus, hipDeviceAttributeMultiprocessorCount, dev);
    (void)hipOccupancyMaxActiveBlocksPerMultiprocessor(&per_cu, mega, 256, 0);
    if (per_cu > 1) per_cu = 1;
    grid_blocks = cus * per_cu;
  }
  if (ws_size < WB_END) {
    fprintf(stderr, "workspace too small: %zu < %zu\n", ws_size, (size_t)WB_END);
    return;
  }
  Params p{};
  for (int i = 0; i < N_IN; ++i) p.in[i] = (const float*)d_in[i];
  p.out = (float*)d_out;
  p.ws = (char*)d_ws;
  (void)hipMemsetAsync((char*)d_ws + WB_BAR, 0, 256, stream);
  void* args[] = {&p};
  hipError_t e = hipLaunchCooperativeKernel((void*)mega, dim3(grid_blocks), dim3(256), args, 0, stream);
  if (e != hipSuccess) fprintf(stderr, "cooperative launch failed: %s (grid %d)\n", hipGetErrorString(e), grid_blocks);
}
```

```cpp
#include <hip/hip_runtime.h>
#include <hip/hip_cooperative_groups.h>
#include <cstdio>
#include <cstdint>
namespace cg = cooperative_groups;

#define NLAT 4096
#define NCTX 256
#define NTOK 4352
#define DM 1024
#define INW 6672
#define NB 8
#define GB 2
#define NG (NB / GB)
#define RPG (GB * NTOK)
#define ZW 6656
#define EPSF 1e-6f

enum { I_X = 0, I_C, I_CTX, I_CCTX, I_WMOD, I_BMOD, I_N1G, I_N2G, I_WIN, I_LQ1, I_LK1, I_LQ2, I_LK2, I_SUBG,
       I_CONVW, I_CONVB, I_MLWQ, I_MLWK, I_GATEB, I_MLNG, I_S5LRE, I_S5LIM, I_S5DT, I_S5BRE, I_S5BIM,
       I_S5CRE, I_S5CIM, I_S5D, I_GLUW, I_GLUB, I_WBR, I_WOUT, I_PWQ, I_PSUBK, I_PU, I_PV, I_FG, N_IN };

struct Params {
  const float* in[N_IN];
  float* out;
  char* ws;
};

typedef unsigned short bf16_t;
typedef short bf16x8 __attribute__((ext_vector_type(8)));
typedef float f32x16 __attribute__((ext_vector_type(16)));
typedef unsigned u32x4 __attribute__((ext_vector_type(4)));
typedef unsigned u32x2 __attribute__((ext_vector_type(2)));
typedef unsigned u32x4_u __attribute__((ext_vector_type(4), aligned(8)));
typedef float v16f __attribute__((ext_vector_type(16)));
typedef float v32f __attribute__((ext_vector_type(32)));
typedef unsigned v6u __attribute__((ext_vector_type(6)));

#define AL(x) (((x) + 255) & ~(size_t)255)
#define WB_XCX   ((size_t)0)
#define WB_MOD   AL(WB_XCX + (size_t)NB * NCTX * DM * 4)
#define WB_ROPE  AL(WB_MOD + (size_t)2 * 9 * 6144 * 4)
#define WB_WT    AL(WB_ROPE + (size_t)NLAT * 32 * 2 * 4)
#define WT_WIN   ((size_t)0)
#define WT_WQK   (WT_WIN + (size_t)6784 * 1024)
#define WT_GLU   (WT_WQK + (size_t)4 * 256 * 128)
#define WT_WBR   (WT_GLU + (size_t)512 * 512)
#define WT_WOUT  (WT_WBR + (size_t)3 * 1024 * 512)
#define WT_WQ    (WT_WOUT + (size_t)1024 * 1024)
#define WT_SUBK  (WT_WQ + (size_t)2048 * 1024)
#define WT_LAYER (WT_SUBK + (size_t)2 * 128 * 128)
#define WB_H     AL(WB_WT + WT_LAYER * 2 * 2)
#define WB_Z     AL(WB_H + (size_t)RPG * DM * 2)
#define WB_MGT   AL(WB_Z + (size_t)RPG * ZW * 2)
#define WB_XC    AL(WB_MGT + (size_t)RPG * 16 * 4)
#define WB_QM    AL(WB_XC + (size_t)RPG * 512 * 2)
#define WB_KM    AL(WB_QM + (size_t)RPG * 512 * 2)
#define WB_KMT   AL(WB_KM + (size_t)RPG * 512 * 2)
#define WB_MVT   AL(WB_KMT + (size_t)RPG * 512 * 2)
#define WB_HF    AL(WB_MVT + (size_t)RPG * 512 * 2)
#define WB_HB    AL(WB_HF + (size_t)RPG * 512 * 2)
#define WB_YSF   AL(WB_HB + (size_t)RPG * 512 * 2)
#define WB_YSB   AL(WB_YSF + (size_t)RPG * 512 * 4)
#define WB_YA    AL(WB_YSB + (size_t)RPG * 512 * 4)
#define WB_YB    AL(WB_YA + (size_t)RPG * 512 * 2)
#define WB_YS    AL(WB_YB + (size_t)RPG * 512 * 2)
#define WB_GG    AL(WB_YS + (size_t)RPG * 512 * 2)
#define WB_MG    AL(WB_GG + (size_t)RPG * 512 * 2)
#define WB_EI    AL(WB_MG + (size_t)RPG * DM * 2)
#define WB_EG    AL(WB_EI + (size_t)3 * RPG * 128 * 4)
#define WB_H2    AL(WB_EG + (size_t)3 * RPG * 128 * 4)
#define WB_U16   AL(WB_H2 + (size_t)3 * RPG * DM * 2)
#define WB_V16   AL(WB_U16 + (size_t)2 * 16384 * 768)
#define WB_VT    AL(WB_V16 + (size_t)2 * 16384 * 768)
#define WB_CNT   AL(WB_VT + (size_t)GB * 4 * 128 * NTOK * 2)
#define WB_XE    AL(WB_CNT + 256)
#define WB_BAR   AL(WB_XE + (size_t)GB * 32 * 2 * 33 * 128 * 4)
#define WB_GA    AL(WB_BAR + 256)
#define WB_POOL  AL(WB_GA + (size_t)GB * 4 * 2 * 68 * 272 * 4)
#define WB_END   AL(WB_POOL + 256)
#define WB_PQ    (WB_Z)
#define WB_SC    AL(WB_PQ + (size_t)RPG * 2048 * 2)

#define SMEM_FLOATS (25 * 1024)

__device__ __forceinline__ float sigmoidf_(float x) { return __builtin_amdgcn_rcpf(1.0f + __builtin_amdgcn_exp2f(-1.4426950408889634f * x)); }
__device__ __forceinline__ float siluf_(float x) { return x * __builtin_amdgcn_rcpf(1.0f + __builtin_amdgcn_exp2f(-1.4426950408889634f * x)); }
__device__ __forceinline__ float geluf_(float x) { return 0.5f * x * (1.0f + erff(x * 0.70710678118654752f)); }
__device__ __forceinline__ int otid() { int t = threadIdx.x; asm volatile("" : "+v"(t)); return t; }
__device__ __forceinline__ float wave_sum(float v) {
  for (int o = 32; o > 0; o >>= 1) v += __shfl_xor(v, o);
  return v;
}
__device__ __forceinline__ bf16_t f2bf(float x) { unsigned u = __float_as_uint(x); u += 0x7fffu + ((u >> 16) & 1u); return (bf16_t)(u >> 16); }
__device__ __forceinline__ float bf2f(bf16_t h) { return __uint_as_float(((unsigned)h) << 16); }
typedef float f32x2 __attribute__((ext_vector_type(2)));
typedef __bf16 bf16x2_t __attribute__((ext_vector_type(2)));
__device__ __forceinline__ unsigned pack2(float a, float b) { f32x2 v = {a, b}; return __builtin_bit_cast(unsigned, __builtin_convertvector(v, bf16x2_t)); }
__device__ __forceinline__ float lo16(unsigned u) { return __uint_as_float(u << 16); }
__device__ __forceinline__ float hi16(unsigned u) { return __uint_as_float(u & 0xffff0000u); }

__device__ __forceinline__ float* xrow(const Params& p, int b, int rr) {
  return (rr < NLAT) ? p.out + ((size_t)b * NLAT + rr) * DM : (float*)(p.ws + WB_XCX) + ((size_t)b * NCTX + (rr - NLAT)) * DM;
}

__device__ __forceinline__ const float* xrow_in(const Params& p, int b, int rr) {
  return (rr < NLAT) ? p.in[I_X] + ((size_t)b * NLAT + rr) * DM : p.in[I_CTX] + ((size_t)b * NCTX + (rr - NLAT)) * DM;
}

__device__ __forceinline__ void gemm_tile(const bf16_t* __restrict__ Ag, int lda, const bf16_t* __restrict__ Bg, int ldb, int K,
                                          char* smem, f32x16 (&acc)[2][2]) {
  const int tid = otid(), lane = tid & 63, w = tid >> 6, wm = w >> 1, wn = w & 1;
#pragma unroll
  for (int a = 0; a < 2; ++a)
#pragma unroll
    for (int b = 0; b < 2; ++b)
#pragma unroll
      for (int i = 0; i < 16; ++i) acc[a][b][i] = 0.f;
  const int srow = tid >> 3, sch = tid & 7;
  const bf16_t* ap = Ag + (size_t)srow * lda + sch * 8;
  const bf16_t* bp = Bg + (size_t)srow * ldb + sch * 8;
  const int wofs = srow * 128 + ((sch ^ ((srow >> 1) & 7)) << 4);
  const int fr = lane & 31, fh = lane >> 5, fsw = (fr >> 1) & 7;
  const int aofs = (wm * 64 + fr) * 128, bofs = 16384 + (wn * 64 + fr) * 128;
  u32x4 ra0[4], rb0[4], ra1[4], rb1[4];
  const int nk = K >> 6;
#define G_LOAD(RA, RB, KT) { _Pragma("unroll") for (int i = 0; i < 4; ++i) { RA[i] = *(const u32x4*)(ap + (size_t)i * 32 * lda + (KT) * 64); RB[i] = *(const u32x4*)(bp + (size_t)i * 32 * ldb + (KT) * 64); } }
#define G_STORE(RA, RB, BUF) { char* nb_ = smem + (BUF) * 32768; _Pragma("unroll") for (int i = 0; i < 4; ++i) { *(u32x4*)(nb_ + wofs + i * 4096) = RA[i]; *(u32x4*)(nb_ + 16384 + wofs + i * 4096) = RB[i]; } }
#define G_COMPUTE(BUF) { const char* base = smem + (BUF) * 32768; _Pragma("unroll") for (int ks = 0; ks < 4; ++ks) { \
      const int coff = ((ks * 2 + fh) ^ fsw) << 4; bf16x8 af[2], bfr[2]; \
      _Pragma("unroll") for (int mi = 0; mi < 2; ++mi) af[mi] = *(const bf16x8*)(base + aofs + mi * 4096 + coff); \
      _Pragma("unroll") for (int ni = 0; ni < 2; ++ni) bfr[ni] = *(const bf16x8*)(base + bofs + ni * 4096 + coff); \
      _Pragma("unroll") for (int mi = 0; mi < 2; ++mi) _Pragma("unroll") for (int ni = 0; ni < 2; ++ni) \
          acc[mi][ni] = __builtin_amdgcn_mfma_f32_32x32x16_bf16(bfr[ni], af[mi], acc[mi][ni], 0, 0, 0); } }
  G_LOAD(ra0, rb0, 0)
  G_LOAD(ra1, rb1, 1)
  __syncthreads();
  G_STORE(ra0, rb0, 0)
  __syncthreads();
  for (int kt = 0; kt < nk; kt += 2) {
    if (kt + 2 < nk) G_LOAD(ra0, rb0, kt + 2)
    G_COMPUTE(0)
    G_STORE(ra1, rb1, 1)
    __syncthreads();
    if (kt + 3 < nk) G_LOAD(ra1, rb1, kt + 3)
    G_COMPUTE(1)
    if (kt + 2 < nk) G_STORE(ra0, rb0, 0)
    __syncthreads();
  }
#undef G_LOAD
#undef G_STORE
#undef G_COMPUTE
}
#define EPI_DECL const int tid_ = otid(); const int lane = tid_ & 63, w_ = tid_ >> 6, wm = w_ >> 1, wn = w_ & 1, fr = lane & 31, fh = lane >> 5; (void)fr; (void)fh; (void)wm; (void)wn;
#define EPI_ROW(mi) (wm * 64 + (mi) * 32 + fr)
#define EPI_COL(ni, q) (wn * 64 + (ni) * 32 + 8 * (q) + 4 * fh)
#define MT_LR0(mt, tpb) (((mt) / (tpb)) * NTOK + ((mt) % (tpb)) * 128)


struct TileIter {
  int tm, tn, pw, ph, PN, NP, x, i, it;
  __device__ __forceinline__ TileIter(int tm_, int tn_) : tm(tm_), tn(tn_) {
    pw = tn < 8 ? tn : 8; ph = 32 / pw; PN = (tn + pw - 1) / pw; NP = ((tm + ph - 1) / ph) * PN;
    x = blockIdx.x & 7; i = blockIdx.x >> 3; it = 0;
  }
  __device__ __forceinline__ bool next(int& mt, int& nt, bool& valid) {
    if (gridDim.x != 256) {
      const int t = blockIdx.x + it * gridDim.x; ++it;
      if (t >= tm * tn) return false;
      mt = t / tn; nt = t % tn; valid = true; return true;
    }
    const int P = it * 8 + x; ++it;
    if (P >= NP) return false;
    mt = (P / PN) * ph + i / pw; nt = (P % PN) * pw + i % pw;
    valid = (mt < tm) && (nt < tn);
    return true;
  }
};

template <class F>
__device__ __forceinline__ void transpose_cvt(const float* __restrict__ src, int ld, F srccol, int K, int Ndst, bf16_t* __restrict__ dst, float* smem) {
  float (*T)[65] = (float (*)[65])smem;
  const int tid = otid();
  const int tk = K >> 6, tn = Ndst >> 6;
  for (int t = blockIdx.x; t < tn * tk; t += gridDim.x) {
    const int n0 = (t / tk) * 64, k0 = (t % tk) * 64;
    __syncthreads();
    const int sc = srccol(n0 + (tid & 63));
#pragma unroll
    for (int i = 0; i < 16; ++i) {
      const int ky = (tid >> 6) + 4 * i;
      T[ky][tid & 63] = (sc >= 0) ? src[(size_t)(k0 + ky) * ld + sc] : 0.f;
    }
    __syncthreads();
#pragma unroll
    for (int i = 0; i < 16; ++i) {
      const int ny = (tid >> 6) + 4 * i;
      dst[(size_t)(n0 + ny) * K + k0 + (tid & 63)] = f2bf(T[tid & 63][ny]);
    }
  }
  __syncthreads();
}
__device__ __forceinline__ void fragpack(const float* __restrict__ src, int ld, int K, int N, bf16_t* __restrict__ dst) {
  const int kc = K >> 6, total = (N >> 5) * kc * 256;
  for (int idx = blockIdx.x * 256 + otid(); idx < total; idx += gridDim.x * 256) {
    const int lane = idx & 63, ks = (idx >> 6) & 3, c = (idx >> 8) % kc, nf = (idx >> 8) / kc;
    const int n = 32 * nf + (lane & 31), k0 = 64 * c + 32 * (lane >> 5) + 8 * ks;
    float f[8];
#pragma unroll
    for (int j = 0; j < 8; ++j) f[j] = src[(size_t)(k0 + j) * ld + n];
    *(u32x4*)(dst + (size_t)idx * 8) = (u32x4){pack2(f[0], f[1]), pack2(f[2], f[3]), pack2(f[4], f[5]), pack2(f[6], f[7])};
  }
}
__device__ __forceinline__ int win_srccol(int n) {
  if (n < 3072) return n;
  if (n < 6656) return n + 16;
  if (n < 6672) return n - 3584;
  return -1;
}

__device__ __forceinline__ void stage_init(const Params& p, float* smem) {
  const int tid = otid();
  if (blockIdx.x == 0 && tid < 64) { ((int*)(p.ws + WB_CNT))[tid] = 0; if (tid < 16) ((int*)(p.ws + WB_POOL))[tid] = 0; }
  {
    float* lx = smem + tid * 33;
    int perm[32];
    {
      v16f a, b;
#pragma unroll
      for (int j = 0; j < 16; ++j) { a[j] = (float)(j & 7); b[j] = (float)((j + 16) & 7); }
      const v32f u1 = __builtin_amdgcn_cvt_scalef32_pk32_f32_fp6(__builtin_amdgcn_cvt_scalef32_2xpk16_fp6_f32(a, b, 1.0f), 1.0f);
#pragma unroll
      for (int j = 0; j < 16; ++j) { a[j] = (float)(j >> 3); b[j] = (float)((j + 16) >> 3); }
      const v32f u2 = __builtin_amdgcn_cvt_scalef32_pk32_f32_fp6(__builtin_amdgcn_cvt_scalef32_2xpk16_fp6_f32(a, b, 1.0f), 1.0f);
#pragma unroll
      for (int k = 0; k < 32; ++k) perm[k] = ((int)(u1[k] + 0.5f) + 8 * (int)(u2[k] + 0.5f)) & 31;
    }
    const size_t ngrp = (size_t)2 * 16384 * 32;
    for (size_t i = (size_t)blockIdx.x * 256 + tid; i < 2 * ngrp; i += (size_t)gridDim.x * 256) {
      const bool isv = i >= ngrp;
      const size_t gi = isv ? i - ngrp : i;
      const float4* s4 = (const float4*)((isv ? p.in[I_PV] : p.in[I_PU]) + gi * 32);
      const float sc = isv ? 2.0f : 64.0f;
      float o[32];
#pragma unroll
      for (int q = 0; q < 8; ++q) { const float4 t = s4[q]; o[4 * q] = t.x * sc; o[4 * q + 1] = t.y * sc; o[4 * q + 2] = t.z * sc; o[4 * q + 3] = t.w * sc; }
#pragma unroll
      for (int k = 0; k < 32; ++k) lx[perm[k]] = o[k];
      v16f a, b;
#pragma unroll
      for (int j = 0; j < 16; ++j) { a[j] = lx[j]; b[j] = lx[16 + j]; }
      const v6u pk = __builtin_amdgcn_cvt_scalef32_2xpk16_fp6_f32(a, b, 1.0f);
      u32x2* d = (u32x2*)(p.ws + (isv ? WB_V16 : WB_U16) + gi * 24);
      d[0] = (u32x2){pk[0], pk[1]}; d[1] = (u32x2){pk[2], pk[3]}; d[2] = (u32x2){pk[4], pk[5]};
    }
    __syncthreads();
  }
  {
    float2* rt = (float2*)(p.ws + WB_ROPE);
    for (int i = blockIdx.x * 256 + tid; i < NLAT * 32; i += gridDim.x * 256) {
      const int pos = i >> 5, j = i & 31;
      const float inv = powf(10000.0f, -(float)(j & 15) / 16.0f);
      const float ang = (float)((j < 16) ? (pos >> 6) : (pos & 63)) * inv;
      rt[i] = make_float2(cosf(ang), sinf(ang));
    }
  }
  {
    float* sc = smem;
    float* red = smem + 9 * 1024;
    for (int i = tid; i < 9 * 1024; i += 256) {
      int r = i >> 10, k = i & 1023;
      float v = (r < 8) ? p.in[I_C][r * 1024 + k] : p.in[I_CCTX][k];
      sc[i] = siluf_(v);
    }
    __syncthreads();
    float* mod = (float*)(p.ws + WB_MOD);
    const int jc = tid & 63, ksl = tid >> 6;
    for (int cb = blockIdx.x; cb < 2 * 6144 / 64; cb += gridDim.x) {
      const int col = cb * 64 + jc;
      const int l = col / 6144, j = col % 6144;
      const float* w = p.in[I_WMOD] + (size_t)l * 1024 * 6144 + j;
      float acc[9];
#pragma unroll
      for (int r = 0; r < 9; ++r) acc[r] = 0.f;
#pragma unroll 8
      for (int k = ksl * 256; k < ksl * 256 + 256; ++k) {
        const float wv = w[(size_t)k * 6144];
#pragma unroll
        for (int r = 0; r < 9; ++r) acc[r] = fmaf(sc[r * 1024 + k], wv, acc[r]);
      }
      __syncthreads();
#pragma unroll
      for (int r = 0; r < 9; ++r) red[(ksl * 64 + jc) * 9 + r] = acc[r];
      __syncthreads();
      if (ksl == 0) {
        const float bv = p.in[I_BMOD][l * 6144 + j];
#pragma unroll
        for (int r = 0; r < 9; ++r)
          mod[((size_t)l * 9 + r) * 6144 + j] = red[jc * 9 + r] + red[(64 + jc) * 9 + r] + red[(128 + jc) * 9 + r] + red[(192 + jc) * 9 + r] + bv;
      }
    }
    __syncthreads();
  }
  bf16_t* WT = (bf16_t*)(p.ws + WB_WT);
  for (int l = 0; l < 2; ++l) {
    bf16_t* W = WT + (size_t)l * WT_LAYER;
    transpose_cvt(p.in[I_WIN] + (size_t)l * DM * INW, INW, [](int n) { return win_srccol(n); }, DM, 6784, W + WT_WIN, smem);
    for (int h = 0; h < 4; ++h) {
      transpose_cvt(p.in[I_MLWQ] + ((size_t)l * 4 + h) * 16384, 128, [](int n) { return n; }, 128, 128, W + WT_WQK + (size_t)h * 256 * 128, smem);
      transpose_cvt(p.in[I_MLWK] + ((size_t)l * 4 + h) * 16384, 128, [](int n) { return n; }, 128, 128, W + WT_WQK + (size_t)h * 256 * 128 + 128 * 128, smem);
    }
    fragpack(p.in[I_GLUW] + (size_t)l * 512 * 512, 512, 512, 512, W + WT_GLU);
    for (int r = 0; r < 3; ++r) fragpack(p.in[I_WBR] + ((size_t)l * 3 + r) * 512 * DM, DM, 512, DM, W + WT_WBR + (size_t)r * 1024 * 512);
    fragpack(p.in[I_WOUT] + (size_t)l * DM * DM, DM, DM, DM, W + WT_WOUT);
    transpose_cvt(p.in[I_PWQ] + (size_t)l * DM * 2048, 2048, [](int n) { return n; }, DM, 2048, W + WT_WQ, smem);
    const float* sk = p.in[I_PSUBK] + (size_t)l * 2 * 128 * 128;
    for (int i = blockIdx.x * 256 + tid; i < 2 * 128 * 128; i += gridDim.x * 256) W[WT_SUBK + i] = f2bf(sk[i]);
  }
}

__device__ __forceinline__ void stage_normmod(const Params& p, int l, int g, int which, int rr_lim, bf16_t* H, float* smem) {
  const int tid = otid(), w = tid >> 6, lane = tid & 63;
  const float* ng = p.in[which ? I_N2G : I_N1G] + l * DM;
  const float* mod = (const float*)(p.ws + WB_MOD) + (size_t)l * 9 * 6144;
  const int off_sh = which ? 3072 : 0, off_sc = which ? 4096 : 1024;
  const int n = GB * rr_lim;
  for (int i0 = (blockIdx.x * 4 + w) * 2; i0 < n; i0 += gridDim.x * 8) {
    float4 v[2][4];
    int bl[2], rr[2];
#pragma unroll
    for (int u = 0; u < 2; ++u) {
      const int i = (i0 + u < n) ? i0 + u : i0;
      bl[u] = i / rr_lim; rr[u] = i % rr_lim;
      const float4* X = (const float4*)((l == 0 && which == 0) ? xrow_in(p, g * GB + bl[u], rr[u]) : xrow(p, g * GB + bl[u], rr[u]));
#pragma unroll
      for (int q = 0; q < 4; ++q) v[u][q] = X[q * 64 + lane];
    }
#pragma unroll
    for (int u = 0; u < 2; ++u) {
      if (i0 + u >= n) break;
      float s = 0.f;
#pragma unroll
      for (int q = 0; q < 4; ++q) s += v[u][q].x * v[u][q].x + v[u][q].y * v[u][q].y + v[u][q].z * v[u][q].z + v[u][q].w * v[u][q].w;
      s = wave_sum(s);
      const float rs = rsqrtf(s * (1.0f / DM) + EPSF);
      const float* m = mod + (size_t)((rr[u] < NLAT) ? (g * GB + bl[u]) : 8) * 6144;
      u32x2* hp = (u32x2*)(H + ((size_t)bl[u] * NTOK + rr[u]) * DM);
#pragma unroll
      for (int q = 0; q < 4; ++q) {
        const float4 gg = ((const float4*)ng)[q * 64 + lane];
        const float4 sc = ((const float4*)(m + off_sc))[q * 64 + lane];
        const float4 sh = ((const float4*)(m + off_sh))[q * 64 + lane];
        const float4 x = v[u][q];
        hp[q * 64 + lane] = (u32x2){pack2(x.x * rs * gg.x * (1.f + sc.x) + sh.x, x.y * rs * gg.y * (1.f + sc.y) + sh.y),
                                    pack2(x.z * rs * gg.z * (1.f + sc.z) + sh.z, x.w * rs * gg.w * (1.f + sc.w) + sh.w)};
      }
    }
  }
}

__device__ __forceinline__ void stage_inproj(const Params& p, const bf16_t* H, const bf16_t* WinT, bf16_t* Z, float* MGT, bf16_t* VT, bf16_t* MVT, char* smem) {
  EPI_DECL
  const int tm = GB * 34, tn = 53;
  const float2* rt = (const float2*)(p.ws + WB_ROPE);
  TileIter ti(tm, tn);
  int mt, j; bool valid;
  while (ti.next(mt, j, valid)) {
    if (!valid) continue;
    const int n0 = j * 128;
    const int lr0 = MT_LR0(mt, 34), rr0 = (mt % 34) * 128;
    f32x16 acc[2][2];
    if ((j >= 8 && j < 12) || (j >= 16 && j < 20)) {
      gemm_tile(WinT + (size_t)n0 * DM, DM, H + (size_t)lr0 * DM, DM, DM, smem, acc);
      bf16_t* vt = ((j < 12) ? VT : MVT) + ((size_t)(mt / 34) * 4 + (j & 3)) * 128 * NTOK;
#pragma unroll
      for (int mi = 0; mi < 2; ++mi)
#pragma unroll
        for (int ni = 0; ni < 2; ++ni)
#pragma unroll
          for (int q = 0; q < 4; ++q) {
            const int e = EPI_ROW(mi), tok = rr0 + EPI_COL(ni, q);
            *(u32x2*)(vt + (size_t)e * NTOK + tok) = (u32x2){pack2(acc[mi][ni][4 * q], acc[mi][ni][4 * q + 1]), pack2(acc[mi][ni][4 * q + 2], acc[mi][ni][4 * q + 3])};
          }
      continue;
    }
    gemm_tile(H + (size_t)lr0 * DM, DM, WinT + (size_t)n0 * DM, DM, DM, smem, acc);
    if (j < 8 && rr0 < NLAT) {
#pragma unroll
      for (int mi = 0; mi < 2; ++mi) {
        const int pos = rr0 + EPI_ROW(mi);
#pragma unroll
        for (int i = 0; i < 16; ++i) {
          const int jj = 8 * (i >> 2) + 4 * fh + (i & 3);
          const float2 cs = rt[pos * 32 + jj];
          const float x1 = acc[mi][0][i], x2 = acc[mi][1][i];
          acc[mi][0][i] = x1 * cs.x - x2 * cs.y;
          acc[mi][1][i] = x1 * cs.y + x2 * cs.x;
        }
      }
    }
    if (j < 52) {
      const bool sg = (j >= 28);
#pragma unroll
      for (int mi = 0; mi < 2; ++mi)
#pragma unroll
        for (int ni = 0; ni < 2; ++ni)
#pragma unroll
          for (int q = 0; q < 4; ++q) {
            const int row = lr0 + EPI_ROW(mi), c = n0 + EPI_COL(ni, q);
            float v0 = acc[mi][ni][4 * q], v1 = acc[mi][ni][4 * q + 1], v2 = acc[mi][ni][4 * q + 2], v3 = acc[mi][ni][4 * q + 3];
            if (sg) { v0 = sigmoidf_(v0); v1 = sigmoidf_(v1); v2 = sigmoidf_(v2); v3 = sigmoidf_(v3); }
            *(u32x2*)(Z + (size_t)row * ZW + c) = (u32x2){pack2(v0, v1), pack2(v2, v3)};
          }
    } else {
#pragma unroll
      for (int mi = 0; mi < 2; ++mi)
#pragma unroll
        for (int q = 0; q < 2; ++q) {
          const int row = lr0 + EPI_ROW(mi), c = EPI_COL(0, q);
          if (wn == 0) *(float4*)(MGT + (size_t)row * 16 + c) = make_float4(acc[mi][0][4 * q], acc[mi][0][4 * q + 1], acc[mi][0][4 * q + 2], acc[mi][0][4 * q + 3]);
        }
    }
  }
}

__device__ __forceinline__ void stage_conv(const Params& p, int l, const bf16_t* Z, bf16_t* XC) {
  const int tid = otid();
  const float* cw = p.in[I_CONVW] + (size_t)l * 3 * 512;
  const float* cb = p.in[I_CONVB] + (size_t)l * 512;
  const int c = tid * 2;
  const float2 w0 = *(const float2*)(cw + c), w1 = *(const float2*)(cw + 512 + c), w2 = *(const float2*)(cw + 1024 + c), bb = *(const float2*)(cb + c);
  for (int lr0 = blockIdx.x * 4; lr0 < RPG; lr0 += gridDim.x * 4) {
    unsigned xc[4], xp[4], xn[4];
#pragma unroll
    for (int u = 0; u < 4; ++u) {
      const int lr = lr0 + u, rr = lr % NTOK;
      const bool has_prev = (rr < NLAT) ? (rr > 0) : (rr > NLAT);
      const bool has_next = (rr < NLAT) ? (rr < NLAT - 1) : (rr < NTOK - 1);
      const bf16_t* z = Z + (size_t)lr * ZW + 1536 + c;
      xc[u] = *(const unsigned*)z;
      xp[u] = has_prev ? *(const unsigned*)(z - ZW) : 0u;
      xn[u] = has_next ? *(const unsigned*)(z + ZW) : 0u;
    }
#pragma unroll
    for (int u = 0; u < 4; ++u) {
      const float a0 = bb.x + w1.x * lo16(xc[u]) + w0.x * lo16(xp[u]) + w2.x * lo16(xn[u]);
      const float a1 = bb.y + w1.y * hi16(xc[u]) + w0.y * hi16(xp[u]) + w2.y * hi16(xn[u]);
      *(unsigned*)(XC + (size_t)(lr0 + u) * 512 + c) = pack2(siluf_(a0), siluf_(a1));
    }
  }
}

__device__ __forceinline__ void stage_mlqk(const bf16_t* XC, const bf16_t* WQK, bf16_t* QM, bf16_t* KM, bf16_t* KMT, char* smem) {
  EPI_DECL
  const int tm = RPG >> 7;
  TileIter ti(tm, 12);
  int mt, r12; bool valid;
  while (ti.next(mt, r12, valid)) {
    if (!valid) continue;
    const int h = r12 & 3, kind = r12 >> 2;
    const int m0 = mt * 128;
    f32x16 acc[2][2];
    const bf16_t* Wt = WQK + (size_t)h * 256 * 128 + (size_t)(kind ? 1 : 0) * 128 * 128;
    const bf16_t* Xt = XC + (size_t)m0 * 512 + h * 128;
    if (kind < 2) {
      gemm_tile(Xt, 512, Wt, 128, 128, smem, acc);
      bf16_t* O = kind ? KM : QM;
      const float alpha = kind ? 1.0f : 0.08838834764831845f;
#pragma unroll
      for (int mi = 0; mi < 2; ++mi)
#pragma unroll
        for (int ni = 0; ni < 2; ++ni)
#pragma unroll
          for (int q = 0; q < 4; ++q) {
            const int row = m0 + EPI_ROW(mi), c = EPI_COL(ni, q);
            *(u32x2*)(O + (size_t)row * 512 + h * 128 + c) = (u32x2){pack2(alpha * acc[mi][ni][4 * q], alpha * acc[mi][ni][4 * q + 1]), pack2(alpha * acc[mi][ni][4 * q + 2], alpha * acc[mi][ni][4 * q + 3])};
          }
    } else {
      gemm_tile(Wt, 128, Xt, 512, 128, smem, acc);
      bf16_t* kt = KMT + ((size_t)(mt / 34) * 4 + h) * 128 * NTOK + (mt % 34) * 128;
#pragma unroll
      for (int mi = 0; mi < 2; ++mi)
#pragma unroll
        for (int ni = 0; ni < 2; ++ni)
#pragma unroll
          for (int q = 0; q < 4; ++q) {
            const int d = EPI_ROW(mi), tok = EPI_COL(ni, q);
            *(u32x2*)(kt + (size_t)d * NTOK + tok) = (u32x2){pack2(acc[mi][ni][4 * q], acc[mi][ni][4 * q + 1]), pack2(acc[mi][ni][4 * q + 2], acc[mi][ni][4 * q + 3])};
          }
    }
  }
}

__device__ __forceinline__ void attn_mfma_item(const Params& p, int l, const bf16_t* Zb, const bf16_t* VTb, bf16_t* YAb, int h, int qrow0, int key0, int nkeys,
                                               float lam, float lam_init, char* smem) {
  const int tid = otid(), lane = tid & 63, w = tid >> 6, fr = lane & 31, fh = lane >> 5;
  const int rb = w & 1, m = w >> 1;
  const int ntiles = nkeys >> 6;
  const int myrow = qrow0 + rb * 32 + fr;
  bf16x8 qf[4];
  {
    const bf16_t* qp = Zb + (size_t)myrow * ZW + h * 128 + m * 64 + fh * 8;
#pragma unroll
    for (int ks = 0; ks < 4; ++ks) qf[ks] = *(const bf16x8*)(qp + ks * 16);
  }
  f32x16 O[4];
#pragma unroll
  for (int eb = 0; eb < 4; ++eb)
#pragma unroll
    for (int i = 0; i < 16; ++i) O[eb][i] = 0.f;
  float mrun = -1e30f, lrun = 0.f;
  const float cs = 0.125f * 1.4426950408889634f;
  const int skey = tid >> 4, sch = tid & 15;
  const bf16_t* ksrc = Zb + (size_t)(key0 + skey) * ZW + 512 + h * 128 + sch * 8;
  const int kdst = skey * 256 + ((sch ^ (skey & 15)) << 4);
  const int se = tid >> 3, svc = tid & 7;
  const bf16_t* vsrc = VTb + ((size_t)h * 128 + se) * NTOK + key0 + svc * 8;
  const int vsw = (se >> 1) & 15;
  const int vdst0 = se * 128 + (((2 * svc) ^ vsw) << 3), vdst1 = se * 128 + (((2 * svc + 1) ^ vsw) << 3);
  const int kfo = fr * 256, kfs = fr & 15;
  const int vfo = fr * 128, vfs = (fr >> 1) & 15;
  u32x4 rk[4], rv[4];
#pragma unroll
  for (int i = 0; i < 4; ++i) rk[i] = *(const u32x4*)(ksrc + (size_t)i * 16 * ZW);
  __syncthreads();
#pragma unroll
  for (int i = 0; i < 4; ++i) *(u32x4*)(smem + kdst + i * 4096) = rk[i];
  __syncthreads();
  bf16x8 pf[4];
#define ATT_S(T) { const char* kb_ = smem + ((T) & 1) * 16384; _Pragma("unroll") for (int kb = 0; kb < 2; ++kb) { \
      _Pragma("unroll") for (int i = 0; i < 16; ++i) S[kb][i] = 0.f; \
      _Pragma("unroll") for (int ks = 0; ks < 4; ++ks) { \
        const bf16x8 kf = *(const bf16x8*)(kb_ + kb * 8192 + kfo + (((m * 8 + ks * 2 + fh) ^ kfs) << 4)); \
        S[kb] = __builtin_amdgcn_mfma_f32_32x32x16_bf16(kf, qf[ks], S[kb], 0, 0, 0); } } }
#define ATT_MAX() { float tm = S[0][0]; \
      _Pragma("unroll") for (int i = 1; i < 16; ++i) tm = fmaxf(tm, S[0][i]); \
      _Pragma("unroll") for (int i = 0; i < 16; ++i) tm = fmaxf(tm, S[1][i]); \
      tm = fmaxf(tm, __shfl_xor(tm, 32)) * cs; alpha = 1.f; \
      if (tm > mrun + 8.0f) { alpha = __builtin_amdgcn_exp2f(mrun - tm); mrun = tm; } }
#define ATT_EXP(PF) { const float mc = mrun; float rs = 0.f; \
      _Pragma("unroll") for (int kb = 0; kb < 2; ++kb) { float pv[16]; \
        _Pragma("unroll") for (int i = 0; i < 16; ++i) { pv[i] = __builtin_amdgcn_exp2f(fmaf(S[kb][i], cs, -mc)); rs += pv[i]; } \
        _Pragma("unroll") for (int hh = 0; hh < 2; ++hh) \
          PF[kb * 2 + hh] = __builtin_bit_cast(bf16x8, (u32x4){pack2(pv[8 * hh], pv[8 * hh + 1]), pack2(pv[8 * hh + 2], pv[8 * hh + 3]), \
                                                               pack2(pv[8 * hh + 4], pv[8 * hh + 5]), pack2(pv[8 * hh + 6], pv[8 * hh + 7])}); } \
      lrun += rs; }
#define ATT_PV(T) { const char* vb_ = smem + 32768 + ((T) & 1) * 16384; _Pragma("unroll") for (int eb = 0; eb < 4; ++eb) _Pragma("unroll") for (int s = 0; s < 4; ++s) { \
        const u32x2 v0 = *(const u32x2*)(vb_ + eb * 4096 + vfo + (((4 * s + fh) ^ vfs) << 3)); \
        const u32x2 v1 = *(const u32x2*)(vb_ + eb * 4096 + vfo + (((4 * s + fh + 2) ^ vfs) << 3)); \
        const bf16x8 vf = __builtin_bit_cast(bf16x8, (u32x4){v0[0], v0[1], v1[0], v1[1]}); \
        O[eb] = __builtin_amdgcn_mfma_f32_32x32x16_bf16(vf, pf[s], O[eb], 0, 0, 0); } }
  f32x16 S[2];
  float alpha;
  {
#pragma unroll
    for (int i = 0; i < 4; ++i) rk[i] = *(const u32x4*)(ksrc + (size_t)(64 + i * 16) * ZW);
#pragma unroll
    for (int i = 0; i < 4; ++i) rv[i] = *(const u32x4*)(vsrc + (size_t)i * 32 * NTOK);
    ATT_S(0)
    ATT_MAX()
    ATT_EXP(pf)
#pragma unroll
    for (int i = 0; i < 4; ++i) *(u32x4*)(smem + 16384 + kdst + i * 4096) = rk[i];
#pragma unroll
    for (int i = 0; i < 4; ++i) {
      *(u32x2*)(smem + 32768 + vdst0 + i * 4096) = (u32x2){rv[i][0], rv[i][1]};
      *(u32x2*)(smem + 32768 + vdst1 + i * 4096) = (u32x2){rv[i][2], rv[i][3]};
    }
    __syncthreads();
  }
#pragma unroll 1
  for (int t = 1; t < ntiles; ++t) {
    const int tn = (t + 1 < ntiles) ? t + 1 : t;
#pragma unroll
    for (int i = 0; i < 4; ++i) rk[i] = *(const u32x4*)(ksrc + (size_t)(tn * 64 + i * 16) * ZW);
#pragma unroll
    for (int i = 0; i < 4; ++i) rv[i] = *(const u32x4*)(vsrc + (size_t)i * 32 * NTOK + t * 64);
    ATT_S(t)
    ATT_MAX()
    if (__any(alpha != 1.f)) {
#pragma unroll
      for (int eb = 0; eb < 4; ++eb)
#pragma unroll
        for (int i = 0; i < 16; ++i) O[eb][i] *= alpha;
      lrun *= alpha;
#pragma unroll
      for (int s = 0; s < 4; ++s) {
        const u32x4 r_ = __builtin_bit_cast(u32x4, pf[s]);
        pf[s] = __builtin_bit_cast(bf16x8, (u32x4){pack2(lo16(r_[0]) * alpha, hi16(r_[0]) * alpha), pack2(lo16(r_[1]) * alpha, hi16(r_[1]) * alpha),
                                                   pack2(lo16(r_[2]) * alpha, hi16(r_[2]) * alpha), pack2(lo16(r_[3]) * alpha, hi16(r_[3]) * alpha)});
      }
    }
    bf16x8 pn[4];
    {
      ATT_PV(t - 1)
      ATT_EXP(pn)
#pragma unroll
      for (int i = 0; i < 16; ++i) {
        __builtin_amdgcn_sched_group_barrier(0x100, 1, 0);
        __builtin_amdgcn_sched_group_barrier(0x008, 1, 0);
        __builtin_amdgcn_sched_group_barrier(0x002, 9, 0);
      }
    }
#pragma unroll
    for (int s = 0; s < 4; ++s) pf[s] = pn[s];
    if (t + 1 < ntiles) {
      char* kd = smem + ((t + 1) & 1) * 16384;
#pragma unroll
      for (int i = 0; i < 4; ++i) *(u32x4*)(kd + kdst + i * 4096) = rk[i];
    }
    {
      char* vd = smem + 32768 + (t & 1) * 16384;
#pragma unroll
      for (int i = 0; i < 4; ++i) {
        *(u32x2*)(vd + vdst0 + i * 4096) = (u32x2){rv[i][0], rv[i][1]};
        *(u32x2*)(vd + vdst1 + i * 4096) = (u32x2){rv[i][2], rv[i][3]};
      }
    }
    __syncthreads();
  }
  ATT_PV(ntiles - 1)
  __syncthreads();
#undef ATT_S
#undef ATT_MAX
#undef ATT_EXP
#undef ATT_PV
  const float lt = lrun + __shfl_xor(lrun, 32);
  const float sc = (m ? lam : 1.0f) / lt;
  float* xo = (float*)smem + rb * 4096;
  if (m == 1) {
#pragma unroll
    for (int eb = 0; eb < 4; ++eb)
#pragma unroll
      for (int i = 0; i < 16; ++i) xo[(eb * 32 + (i & 3) + 8 * (i >> 2) + 4 * fh) * 32 + fr] = O[eb][i] * sc;
  }
  __syncthreads();
  if (m == 0) {
    float ss = 0.f;
#pragma unroll
    for (int eb = 0; eb < 4; ++eb)
#pragma unroll
      for (int i = 0; i < 16; ++i) {
        const float o = O[eb][i] * sc - xo[(eb * 32 + (i & 3) + 8 * (i >> 2) + 4 * fh) * 32 + fr];
        O[eb][i] = o; ss = fmaf(o, o, ss);
      }
    ss += __shfl_xor(ss, 32);
    const float rn = rsqrtf(ss * (1.0f / 128.0f) + EPSF) * (1.0f - lam_init);
    const float* sg = p.in[I_SUBG] + l * 512 + h * 128;
    bf16_t* yp = YAb + (size_t)myrow * 512 + h * 128;
#pragma unroll
    for (int eb = 0; eb < 4; ++eb)
#pragma unroll
      for (int q = 0; q < 4; ++q) {
        const int e = eb * 32 + 8 * q + 4 * fh;
        const float4 g = *(const float4*)(sg + e);
        *(u32x2*)(yp + e) = (u32x2){pack2(O[eb][4 * q] * rn * g.x, O[eb][4 * q + 1] * rn * g.y), pack2(O[eb][4 * q + 2] * rn * g.z, O[eb][4 * q + 3] * rn * g.w)};
      }
  }
  __syncthreads();
}

__device__ __forceinline__ int mlstm_row0(int dir, int c) {
  return (dir == 0) ? ((c < 4) ? NLAT + 64 * c : 64 * (c - 4)) : ((c < 4) ? NLAT + 64 * (3 - c) : 64 * (67 - c));
}
__device__ __forceinline__ void stage_mlgates(const Params& p, int l, const float* MGT, float* GA) {
  const int tid = otid(), w = tid >> 6, lane = tid & 63;
  const int nitems = GB * 4 * 2 * 68;
  for (int idx = blockIdx.x * 4 + w; idx < nitems; idx += gridDim.x * 4) {
    const int c = idx % 68, r1 = idx / 68, dir = r1 & 1, h = (r1 >> 1) & 3, bl = r1 >> 3;
    const int row = mlstm_row0(dir, c) + lane;
    const float* mg = MGT + ((size_t)bl * NTOK + row) * 16;
    const float li = mg[dir * 8 + h] + p.in[I_GATEB][l * 16 + dir * 8 + h];
    const float x = mg[dir * 8 + 4 + h] + p.in[I_GATEB][l * 16 + dir * 8 + 4 + h];
    const float lf = fminf(x, 0.f) - log1pf(expf(-fabsf(x)));
    float b = lf;
#pragma unroll
    for (int o = 1; o < 64; o <<= 1) {
      const float v = (dir == 0) ? __shfl_up(b, o) : __shfl_down(b, o);
      const bool ok = (dir == 0) ? (lane >= o) : (lane + o < 64);
      if (ok) b += v;
    }
    const float tot = (dir == 0) ? __shfl(b, 63) : __shfl(b, 0);
    float* ga = GA + (size_t)idx * 272;
    ga[lane] = b * 1.4426950408889634f; ga[64 + lane] = (li - b) * 1.4426950408889634f; ga[128 + lane] = expf(tot + li - b); ga[192 + lane] = expf(b);
    if (lane < 4) ga[256 + lane] = expf(tot);
  }
}

__device__ __forceinline__ void mlstm_chain_item(const Params& p, int l, const bf16_t* QMb, const bf16_t* KMb, const bf16_t* KMTb, const bf16_t* MVTb,
                                                 const float* GAc, bf16_t* HXb, int h, int dir, int ehalf, char* smem) {
  const int tid = otid(), lane = tid & 63, w = tid >> 6, fr = lane & 31, fh = lane >> 5;
  const int tb = w & 1, xb = w >> 1;
  float* fl = (float*)(smem + 73728);
  float* bs = fl; float* as_ = fl + 64; float* wgs = fl + 128; float* ebs = fl + 192; float* dec_s = fl + 256; float* nprev = fl + 272; float* npart = fl + 400;
  f32x16 CT[2];
#pragma unroll
  for (int eb = 0; eb < 2; ++eb)
#pragma unroll
    for (int i = 0; i < 16; ++i) CT[eb][i] = 0.f;
  __syncthreads();
  for (int i = tid; i < 1024; i += 256) ((u32x4*)(smem + 57344))[i] = (u32x4){0u, 0u, 0u, 0u};
  if (tid < 128) nprev[tid] = 0.f;
  const int qr = tid >> 4, qc = tid & 15;
  const int qdst = qr * 256 + ((qc ^ (qr & 15)) << 4);
  const int tr = tid >> 3, tc = tid & 7;
  const int tdst = tr * 128 + ((tc ^ ((tr >> 1) & 7)) << 4);
  const int sw16 = fr & 15, sw8 = (fr >> 1) & 7;
  u32x4 ra[4], rb[4], rc[4], rd[2];
  float4 rg = make_float4(0.f, 0.f, 0.f, 0.f);
#define ML_LOAD(C_) { const int r0_ = mlstm_row0(dir, (C_)); \
    const bf16_t* qs = QMb + (size_t)(r0_ + qr) * 512 + h * 128 + qc * 8; \
    const bf16_t* ks = KMb + (size_t)(r0_ + qr) * 512 + h * 128 + qc * 8; \
    const bf16_t* kts = KMTb + ((size_t)h * 128 + tr) * NTOK + r0_ + tc * 8; \
    const bf16_t* vts = MVTb + ((size_t)h * 128 + ehalf * 64 + tr) * NTOK + r0_ + tc * 8; \
    _Pragma("unroll") for (int i = 0; i < 4; ++i) { ra[i] = *(const u32x4*)(qs + (size_t)i * 16 * 512); rb[i] = *(const u32x4*)(ks + (size_t)i * 16 * 512); \
                                                    rc[i] = *(const u32x4*)(kts + (size_t)i * 32 * NTOK); } \
    _Pragma("unroll") for (int i = 0; i < 2; ++i) rd[i] = *(const u32x4*)(vts + (size_t)i * 32 * NTOK); \
    if (tid < 68) rg = ((const float4*)(GAc + (size_t)(C_) * 272))[tid]; }
  ML_LOAD(0)
#pragma unroll 1
  for (int c = 0; c < 68; ++c) {
    const int row0 = mlstm_row0(dir, c);
    __syncthreads();
#pragma unroll
    for (int i = 0; i < 4; ++i) {
      *(u32x4*)(smem + qdst + i * 4096) = ra[i];
      *(u32x4*)(smem + 16384 + qdst + i * 4096) = rb[i];
      *(u32x4*)(smem + 32768 + tdst + i * 4096) = rc[i];
    }
#pragma unroll
    for (int i = 0; i < 2; ++i) *(u32x4*)(smem + 49152 + tdst + i * 4096) = rd[i];
    if (tid < 68) ((float4*)fl)[tid] = rg;
    if (c + 1 < 68) ML_LOAD(c + 1)
    __syncthreads();
    const int t = tb * 32 + fr;
    bf16x8 qf[8];
#pragma unroll
    for (int ks = 0; ks < 8; ++ks) qf[ks] = *(const bf16x8*)(smem + t * 256 + (((ks * 2 + fh) ^ sw16) << 4));
    const float bt = bs[t], ebt = ebs[t];
    f32x16 S[2];
    float dsum = 0.f;
#pragma unroll
    for (int sb = 0; sb < 2; ++sb) {
#pragma unroll
      for (int i = 0; i < 16; ++i) S[sb][i] = 0.f;
      const bool valid = (dir == 0) ? (sb <= tb) : (sb >= tb);
      if (valid) {
#pragma unroll
        for (int ks = 0; ks < 8; ++ks) {
          const bf16x8 kf = *(const bf16x8*)(smem + 16384 + (sb * 32 + fr) * 256 + (((ks * 2 + fh) ^ sw16) << 4));
          S[sb] = __builtin_amdgcn_mfma_f32_32x32x16_bf16(kf, qf[ks], S[sb], 0, 0, 0);
        }
#pragma unroll
        for (int q = 0; q < 4; ++q) {
          const float4 a4 = *(const float4*)(as_ + sb * 32 + 8 * q + 4 * fh);
          const float av[4] = {a4.x, a4.y, a4.z, a4.w};
#pragma unroll
          for (int j = 0; j < 4; ++j) {
            const int s = sb * 32 + 8 * q + 4 * fh + j;
            const bool ok = (dir == 0) ? (s <= t) : (s >= t);
            const float v = ok ? S[sb][4 * q + j] * __builtin_amdgcn_exp2f(bt + av[j]) : 0.f;
            S[sb][4 * q + j] = v;
            dsum += v;
          }
        }
      }
    }
    bf16x8 pf[4];
#pragma unroll
    for (int sb = 0; sb < 2; ++sb)
#pragma unroll
      for (int hh = 0; hh < 2; ++hh)
        pf[sb * 2 + hh] = __builtin_bit_cast(bf16x8, (u32x4){pack2(S[sb][8 * hh], S[sb][8 * hh + 1]), pack2(S[sb][8 * hh + 2], S[sb][8 * hh + 3]),
                                                                 pack2(S[sb][8 * hh + 4], S[sb][8 * hh + 5]), pack2(S[sb][8 * hh + 6], S[sb][8 * hh + 7])});
    float nq = 0.f;
#pragma unroll
    for (int c8 = 0; c8 < 8; ++c8) {
      const u32x4 qv = *(const u32x4*)(smem + t * 256 + (((fh * 8 + c8) ^ sw16) << 4));
      const float4 n0 = *(const float4*)(nprev + fh * 64 + c8 * 8), n1 = *(const float4*)(nprev + fh * 64 + c8 * 8 + 4);
      nq = fmaf(lo16(qv[0]), n0.x, nq); nq = fmaf(hi16(qv[0]), n0.y, nq); nq = fmaf(lo16(qv[1]), n0.z, nq); nq = fmaf(hi16(qv[1]), n0.w, nq);
      nq = fmaf(lo16(qv[2]), n1.x, nq); nq = fmaf(hi16(qv[2]), n1.y, nq); nq = fmaf(lo16(qv[3]), n1.z, nq); nq = fmaf(hi16(qv[3]), n1.w, nq);
    }
    dsum += __shfl_xor(dsum, 32);
    nq += __shfl_xor(nq, 32);
    const float den = dsum + ebt * nq;
    const float inv = 1.0f / fmaxf(fabsf(den), 1.0f);
    {
      f32x16 N;
#pragma unroll
      for (int i = 0; i < 16; ++i) N[i] = 0.f;
#pragma unroll
      for (int ks = 0; ks < 8; ++ks) {
        const bf16x8 cf = *(const bf16x8*)(smem + 57344 + (xb * 32 + fr) * 256 + (((ks * 2 + fh) ^ sw16) << 4));
        N = __builtin_amdgcn_mfma_f32_32x32x16_bf16(cf, qf[ks], N, 0, 0, 0);
      }
#pragma unroll
      for (int i = 0; i < 16; ++i) N[i] *= ebt;
#pragma unroll
      for (int s4 = 0; s4 < 4; ++s4) {
        const bool valid = (dir == 0) ? ((s4 >> 1) <= tb) : ((s4 >> 1) >= tb);
        if (valid) {
          const int u0 = 4 * s4 + fh, u1 = u0 + 2;
          const char* vrow = smem + 49152 + (xb * 32 + fr) * 128;
          const u32x2 v0 = *(const u32x2*)(vrow + (((u0 >> 1) ^ sw8) << 4) + (u0 & 1) * 8);
          const u32x2 v1 = *(const u32x2*)(vrow + (((u1 >> 1) ^ sw8) << 4) + (u1 & 1) * 8);
          const bf16x8 vf = __builtin_bit_cast(bf16x8, (u32x4){v0[0], v0[1], v1[0], v1[1]});
          N = __builtin_amdgcn_mfma_f32_32x32x16_bf16(vf, pf[s4], N, 0, 0, 0);
        }
      }
      bf16_t* hp = HXb + (size_t)(row0 + t) * 512 + h * 128 + (2 * ehalf + xb) * 32 + 4 * fh;
#pragma unroll
      for (int q = 0; q < 4; ++q)
        *(u32x2*)(hp + 8 * q) = (u32x2){pack2(N[4 * q] * inv, N[4 * q + 1] * inv), pack2(N[4 * q + 2] * inv, N[4 * q + 3] * inv)};
    }
    const float decay = *dec_s;
#pragma unroll
    for (int eb = 0; eb < 2; ++eb)
#pragma unroll
      for (int i = 0; i < 16; ++i) CT[eb][i] *= decay;
#pragma unroll
    for (int ks = 0; ks < 4; ++ks) {
      const u32x4 kraw = *(const u32x4*)(smem + 32768 + (w * 32 + fr) * 128 + (((ks * 2 + fh) ^ sw8) << 4));
      const float4 g0 = *(const float4*)(wgs + ks * 16 + 8 * fh), g1 = *(const float4*)(wgs + ks * 16 + 8 * fh + 4);
      const bf16x8 kts = __builtin_bit_cast(bf16x8, (u32x4){pack2(lo16(kraw[0]) * g0.x, hi16(kraw[0]) * g0.y), pack2(lo16(kraw[1]) * g0.z, hi16(kraw[1]) * g0.w),
                                                             pack2(lo16(kraw[2]) * g1.x, hi16(kraw[2]) * g1.y), pack2(lo16(kraw[3]) * g1.z, hi16(kraw[3]) * g1.w)});
#pragma unroll
      for (int eb = 0; eb < 2; ++eb) {
        const bf16x8 vt = *(const bf16x8*)(smem + 49152 + (eb * 32 + fr) * 128 + (((ks * 2 + fh) ^ sw8) << 4));
        CT[eb] = __builtin_amdgcn_mfma_f32_32x32x16_bf16(kts, vt, CT[eb], 0, 0, 0);
      }
    }
    {
      const int d = tid & 127, sh = tid >> 7;
      float a = 0.f;
#pragma unroll 8
      for (int s = sh * 32; s < sh * 32 + 32; ++s) {
        const bf16_t kv = *(const bf16_t*)(smem + 16384 + s * 256 + ((((d >> 3)) ^ (s & 15)) << 4) + (d & 7) * 2);
        a = fmaf(wgs[s], bf2f(kv), a);
      }
      npart[sh * 128 + d] = a;
    }
    __syncthreads();
#pragma unroll
    for (int eb = 0; eb < 2; ++eb)
#pragma unroll
      for (int q = 0; q < 4; ++q)
        *(u32x2*)(smem + 57344 + (eb * 32 + fr) * 256 + ((((w * 4 + q)) ^ sw16) << 4) + 8 * fh) =
            (u32x2){pack2(CT[eb][4 * q], CT[eb][4 * q + 1]), pack2(CT[eb][4 * q + 2], CT[eb][4 * q + 3])};
    if (tid < 128) nprev[tid] = decay * nprev[tid] + npart[tid] + npart[128 + tid];
  }
#undef ML_LOAD
  __syncthreads();
}

#define S5SEG 128
#define S5NSEG 34
__device__ __forceinline__ int s5_row(int dir, int step) {
  return (dir == 0) ? ((step < NCTX) ? NLAT + step : step - NCTX)
                    : ((step < NCTX) ? NLAT + (NCTX - 1 - step) : (NLAT - 1) - (step - NCTX));
}
__device__ __forceinline__ bf16x8 pack8(const float* f) {
  return __builtin_bit_cast(bf16x8, (u32x4){pack2(f[0], f[1]), pack2(f[2], f[3]), pack2(f[4], f[5]), pack2(f[6], f[7])});
}
struct S5M { float abr, abi, a128r, a128i; bf16x8 bbf[4]; };
__device__ __forceinline__ void s5m_setup(const Params& p, int pg, int lane, S5M& m) {
  const int fr = lane & 31, fh = lane >> 5;
  const float dt = expf(p.in[I_S5DT][pg]);
  m.abr = 0.f; m.abi = 0.f; m.a128r = 0.f; m.a128i = 0.f;
#pragma unroll
  for (int c = 0; c < 2; ++c) {
    const int n = fr + 32 * c;
    const float lre = p.in[I_S5LRE][pg * 64 + n], lim = p.in[I_S5LIM][pg * 64 + n];
    const float mag = expf(lre * dt);
    const float abr = mag * cosf(lim * dt), abi = mag * sinf(lim * dt);
    const float den = lre * lre + lim * lim;
    const float zr = ((abr - 1.0f) * lre + abi * lim) / den;
    const float zi = (abi * lre - (abr - 1.0f) * lim) / den;
    const float4* br4 = (const float4*)(p.in[I_S5BRE] + ((size_t)pg * 64 + n) * 16 + 8 * fh);
    const float4* bi4 = (const float4*)(p.in[I_S5BIM] + ((size_t)pg * 64 + n) * 16 + 8 * fh);
    const float4 b0 = br4[0], b1 = br4[1], c0 = bi4[0], c1 = bi4[1];
    const float br[8] = {b0.x, b0.y, b0.z, b0.w, b1.x, b1.y, b1.z, b1.w}, bi[8] = {c0.x, c0.y, c0.z, c0.w, c1.x, c1.y, c1.z, c1.w};
    float rr[8], ii[8];
#pragma unroll
    for (int j = 0; j < 8; ++j) { rr[j] = zr * br[j] - zi * bi[j]; ii[j] = zr * bi[j] + zi * br[j]; }
    m.bbf[c] = pack8(rr); m.bbf[2 + c] = pack8(ii);
    if (fh == c) {
      m.abr = abr; m.abi = abi;
      const float mg = expf(lre * dt * (float)S5SEG);
      m.a128r = mg * cosf(lim * dt * (float)S5SEG); m.a128i = mg * sinf(lim * dt * (float)S5SEG);
    }
  }
}
template <bool STORE>
__device__ __forceinline__ void s5m_block(const S5M& m, const bf16x8 uf, float& xr, float& xi, char* xs, int lane) {
  f32x16 T[4];
#pragma unroll
  for (int k = 0; k < 4; ++k) {
#pragma unroll
    for (int i = 0; i < 16; ++i) T[k][i] = 0.f;
    T[k] = __builtin_amdgcn_mfma_f32_32x32x16_bf16(uf, m.bbf[k], T[k], 0, 0, 0);
  }
#pragma unroll
  for (int r = 0; r < 16; ++r) {
    auto a = __builtin_amdgcn_permlane32_swap(__float_as_uint(T[0][r]), __float_as_uint(T[1][r]), false, false);
    T[0][r] = __uint_as_float(a[0]); T[1][r] = __uint_as_float(a[1]);
    auto b = __builtin_amdgcn_permlane32_swap(__float_as_uint(T[2][r]), __float_as_uint(T[3][r]), false, false);
    T[2][r] = __uint_as_float(b[0]); T[3][r] = __uint_as_float(b[1]);
  }
#pragma unroll
  for (int q = 0; q < 4; ++q)
#pragma unroll
    for (int hh = 0; hh < 2; ++hh)
#pragma unroll
      for (int j = 0; j < 4; ++j) {
        const int t = 8 * q + 4 * hh + j, r = 4 * q + j;
        const float bre = hh ? T[1][r] : T[0][r], bim = hh ? T[3][r] : T[2][r];
        const float nr = fmaf(m.abr, xr, fmaf(-m.abi, xi, bre));
        const float ni = fmaf(m.abr, xi, fmaf(m.abi, xr, bim));
        xr = nr; xi = ni;
        if (STORE) *(unsigned*)(xs + t * 256 + (((lane >> 2) ^ (t & 15)) << 4) + (lane & 3) * 4) = pack2(xr, xi);
      }
}
__device__ __forceinline__ void stage_s5_pass1(const Params& p, int l, const bf16_t* Z, float* XE) {
  const int tid = otid(), w = tid >> 6, lane = tid & 63, fr = lane & 31, fh = lane >> 5;
  const int nitems = GB * 32 * 2 * (S5NSEG - 1);
  for (int idx = blockIdx.x * 4 + w; idx < nitems; idx += gridDim.x * 4) {
    const int seg = idx % (S5NSEG - 1), r1 = idx / (S5NSEG - 1), dir = r1 & 1, g = (r1 >> 1) & 31, bl = r1 >> 6;
    S5M m;
    s5m_setup(p, (l * 2 + dir) * 32 + g, lane, m);
    float xr = 0.f, xi = 0.f;
    bf16x8 ufs[S5SEG / 32];
#pragma unroll
    for (int sub = 0; sub < S5SEG / 32; ++sub) {
      const int row = s5_row(dir, seg * S5SEG + sub * 32 + fr);
      ufs[sub] = *(const bf16x8*)(Z + ((size_t)bl * NTOK + row) * ZW + 3072 + g * 16 + 8 * fh);
    }
#pragma unroll
    for (int sub = 0; sub < S5SEG / 32; ++sub) s5m_block<false>(m, ufs[sub], xr, xi, nullptr, lane);
    float* xe = XE + ((((size_t)bl * 32 + g) * 2 + dir) * (S5NSEG - 1) + seg) * 128;
    xe[lane] = xr; xe[64 + lane] = xi;
  }
}
__device__ __forceinline__ void s5_item(const Params& p, int l, const bf16_t* Zb, const float* XEc, float* Yb, int g, int dir, int sq, char* smem) {
  const int tid = otid(), w = tid >> 6, lane = tid & 63, fr = lane & 31, fh = lane >> 5;
  const int seg = sq * 4 + w;
  char* xs = smem + w * 8192;
  const int pg = (l * 2 + dir) * 32 + g;
  __syncthreads();
  if (seg < S5NSEG) {
    S5M m;
    s5m_setup(p, pg, lane, m);
    bf16x8 ccf[8];
#pragma unroll
    for (int ks = 0; ks < 8; ++ks) {
      float f[8] = {0.f, 0.f, 0.f, 0.f, 0.f, 0.f, 0.f, 0.f};
      if (fr < 16) {
        const float4 cr = *(const float4*)(p.in[I_S5CRE] + ((size_t)pg * 16 + fr) * 64 + ks * 8 + 4 * fh);
        const float4 ci = *(const float4*)(p.in[I_S5CIM] + ((size_t)pg * 16 + fr) * 64 + ks * 8 + 4 * fh);
        f[0] = cr.x; f[1] = -ci.x; f[2] = cr.y; f[3] = -ci.y; f[4] = cr.z; f[5] = -ci.z; f[6] = cr.w; f[7] = -ci.w;
      }
      ccf[ks] = pack8(f);
    }
    float xr = 0.f, xi = 0.f;
    for (int j = 0; j < seg; ++j) {
      const float er = XEc[j * 128 + lane], ei = XEc[j * 128 + 64 + lane];
      const float nr = m.a128r * xr - m.a128i * xi + er, ni = m.a128r * xi + m.a128i * xr + ei;
      xr = nr; xi = ni;
    }
    bf16x8 ufs[S5SEG / 32];
#pragma unroll
    for (int sub = 0; sub < S5SEG / 32; ++sub) {
      const int row = s5_row(dir, seg * S5SEG + sub * 32 + fr);
      ufs[sub] = *(const bf16x8*)(Zb + (size_t)row * ZW + 3072 + g * 16 + 8 * fh);
    }
#pragma unroll
    for (int sub = 0; sub < S5SEG / 32; ++sub) {
      const int row = s5_row(dir, seg * S5SEG + sub * 32 + fr);
      const bf16x8 uf = ufs[sub];
      s5m_block<true>(m, uf, xr, xi, xs, lane);
      f32x16 Y;
#pragma unroll
      for (int i = 0; i < 16; ++i) Y[i] = 0.f;
#pragma unroll
      for (int ks = 0; ks < 8; ++ks) {
        const bf16x8 xf = *(const bf16x8*)(xs + fr * 256 + (((ks * 2 + fh) ^ (fr & 15)) << 4));
        Y = __builtin_amdgcn_mfma_f32_32x32x16_bf16(ccf[ks], xf, Y, 0, 0, 0);
      }
      float* yp = Yb + (size_t)row * 512 + g * 16 + 4 * fh;
      *(float4*)yp = make_float4(Y[0], Y[1], Y[2], Y[3]);
      *(float4*)(yp + 8) = make_float4(Y[4], Y[5], Y[6], Y[7]);
    }
  }
}

__device__ __forceinline__ void stage_post(const Params& p, int l, int rr_lim, const bf16_t* Z, const bf16_t* HF, const bf16_t* HB,
                                           const float* YSF, const float* YSB, bf16_t* YB, bf16_t* GG) {
  const int tid = otid();
  const int c0 = tid * 2;
  const float2 gml = *(const float2*)(p.in[I_MLNG] + l * 512 + c0);
  const float2 dsk = *(const float2*)(p.in[I_S5D] + l * 512 + c0);
  const int n = GB * rr_lim;
  for (int i0 = blockIdx.x * 4; i0 < n; i0 += gridDim.x * 4) {
    unsigned a0[4], a1[4], og[4], uu[4];
    float2 f[4], b[4];
    size_t r[4];
#pragma unroll
    for (int u = 0; u < 4; ++u) {
      const int i = i0 + u;
      r[u] = (size_t)(i / rr_lim) * NTOK + (i % rr_lim);
      a0[u] = *(const unsigned*)(HF + r[u] * 512 + c0); a1[u] = *(const unsigned*)(HB + r[u] * 512 + c0);
      og[u] = *(const unsigned*)(Z + r[u] * ZW + 2560 + c0); uu[u] = *(const unsigned*)(Z + r[u] * ZW + 3072 + c0);
      f[u] = *(const float2*)(YSF + r[u] * 512 + c0); b[u] = *(const float2*)(YSB + r[u] * 512 + c0);
    }
#pragma unroll
    for (int u = 0; u < 4; ++u) {
      const float h0 = lo16(a0[u]) + lo16(a1[u]), h1 = hi16(a0[u]) + hi16(a1[u]);
      const float ss = wave_sum(h0 * h0 + h1 * h1);
      const float rs = rsqrtf(ss * (1.0f / 128.0f) + EPSF);
      *(unsigned*)(YB + r[u] * 512 + c0) = pack2(h0 * rs * gml.x * sigmoidf_(lo16(og[u])), h1 * rs * gml.y * sigmoidf_(hi16(og[u])));
      *(unsigned*)(GG + r[u] * 512 + c0) = pack2(geluf_(dsk.x * lo16(uu[u]) + f[u].x + b[u].x), geluf_(dsk.y * hi16(uu[u]) + f[u].y + b[u].y));
    }
  }
}

__device__ __forceinline__ void stage_glu_mfma(const Params& p, int l, int tpb, const bf16_t* GG, const bf16_t* GLUT, bf16_t* YS, char* smem) {
  EPI_DECL
  const int tm = GB * tpb;
  TileIter ti(tm, 4);
  int mt_, nt_; bool valid;
  while (ti.next(mt_, nt_, valid)) {
    if (!valid) continue;
    const int m0 = MT_LR0(mt_, tpb), n0 = nt_ * 128;
    f32x16 acc[2][2];
    gemm_tile(GG + (size_t)m0 * 512, 512, GLUT + (size_t)n0 * 512, 512, 512, smem, acc);
#pragma unroll
    for (int mi = 0; mi < 2; ++mi)
#pragma unroll
      for (int ni = 0; ni < 2; ++ni)
#pragma unroll
        for (int q = 0; q < 4; ++q) {
          const int row = m0 + EPI_ROW(mi), c = n0 + EPI_COL(ni, q);
          const float4 b = *(const float4*)(p.in[I_GLUB] + l * 512 + c);
          const u32x2 g2 = *(const u32x2*)(GG + (size_t)row * 512 + c);
          const float o0 = lo16(g2[0]) * sigmoidf_(acc[mi][ni][4 * q] + b.x), o1 = hi16(g2[0]) * sigmoidf_(acc[mi][ni][4 * q + 1] + b.y);
          const float o2 = lo16(g2[1]) * sigmoidf_(acc[mi][ni][4 * q + 2] + b.z), o3 = hi16(g2[1]) * sigmoidf_(acc[mi][ni][4 * q + 3] + b.w);
          *(u32x2*)(YS + (size_t)row * 512 + c) = (u32x2){pack2(o0, o1), pack2(o2, o3)};
        }
  }
}

__device__ __forceinline__ void stage_merge_mfma(int tpb, const bf16_t* YA, const bf16_t* YB, const bf16_t* YS, const bf16_t* WBR, const bf16_t* Z, bf16_t* MG, char* smem) {
  EPI_DECL
  const int tm = GB * tpb;
  TileIter ti(tm, 8);
  int mt_, nt_; bool valid;
  while (ti.next(mt_, nt_, valid)) {
    if (!valid) continue;
    const int m0 = MT_LR0(mt_, tpb), n0 = nt_ * 128;
    f32x16 macc[2][2];
#pragma unroll
    for (int a = 0; a < 2; ++a)
#pragma unroll
      for (int b = 0; b < 2; ++b)
#pragma unroll
        for (int i = 0; i < 16; ++i) macc[a][b][i] = 0.f;
#pragma unroll 1
    for (int r = 0; r < 3; ++r) {
      const bf16_t* Y = (r == 0) ? YA : (r == 1 ? YB : YS);
      f32x16 acc[2][2];
      gemm_tile(Y + (size_t)m0 * 512, 512, WBR + (size_t)r * 1024 * 512 + (size_t)n0 * 512, 512, 512, smem, acc);
#pragma unroll
      for (int mi = 0; mi < 2; ++mi)
#pragma unroll
        for (int ni = 0; ni < 2; ++ni)
#pragma unroll
          for (int q = 0; q < 4; ++q) {
            const int row = m0 + EPI_ROW(mi), c = n0 + EPI_COL(ni, q);
            const u32x2 e = *(const u32x2*)(Z + (size_t)row * ZW + 3584 + r * 1024 + c);
            macc[mi][ni][4 * q] += lo16(e[0]) * acc[mi][ni][4 * q];
            macc[mi][ni][4 * q + 1] += hi16(e[0]) * acc[mi][ni][4 * q + 1];
            macc[mi][ni][4 * q + 2] += lo16(e[1]) * acc[mi][ni][4 * q + 2];
            macc[mi][ni][4 * q + 3] += hi16(e[1]) * acc[mi][ni][4 * q + 3];
          }
    }
#pragma unroll
    for (int mi = 0; mi < 2; ++mi)
#pragma unroll
      for (int ni = 0; ni < 2; ++ni)
#pragma unroll
        for (int q = 0; q < 4; ++q) {
          const int row = m0 + EPI_ROW(mi), c = n0 + EPI_COL(ni, q);
          *(u32x2*)(MG + (size_t)row * DM + c) = (u32x2){pack2(macc[mi][ni][4 * q], macc[mi][ni][4 * q + 1]), pack2(macc[mi][ni][4 * q + 2], macc[mi][ni][4 * q + 3])};
        }
  }
}

__device__ __forceinline__ void stage_outproj_mfma(const Params& p, int l, int g, int tpb, const bf16_t* MG, const bf16_t* WOUT, char* smem) {
  EPI_DECL
  const int tm = GB * tpb;
  const float* mod = (const float*)(p.ws + WB_MOD) + (size_t)l * 9 * 6144;
  TileIter ti(tm, 8);
  int mt, nt_; bool valid;
  while (ti.next(mt, nt_, valid)) {
    if (!valid) continue;
    const int n0 = nt_ * 128;
    const int m0 = MT_LR0(mt, tpb), bl = mt / tpb, rr0 = (mt % tpb) * 128, b = g * GB + bl;
    f32x16 acc[2][2];
    gemm_tile(MG + (size_t)m0 * DM, DM, WOUT + (size_t)n0 * DM, DM, DM, smem, acc);
    const float* gv = mod + (size_t)((rr0 < NLAT) ? b : 8) * 6144 + 2 * 1024;
#pragma unroll
    for (int mi = 0; mi < 2; ++mi)
#pragma unroll
      for (int ni = 0; ni < 2; ++ni)
#pragma unroll
        for (int q = 0; q < 4; ++q) {
          const int rr = rr0 + EPI_ROW(mi), c = n0 + EPI_COL(ni, q);
          const float4 gg = *(const float4*)(gv + c);
          float4* xp = (float4*)(xrow(p, b, rr) + c);
          float4 x = (l == 0) ? *(const float4*)(xrow_in(p, b, rr) + c) : *xp;
          x.x += gg.x * acc[mi][ni][4 * q]; x.y += gg.y * acc[mi][ni][4 * q + 1]; x.z += gg.z * acc[mi][ni][4 * q + 2]; x.w += gg.w * acc[mi][ni][4 * q + 3];
          *xp = x;
        }
  }
}

#define CH_SW(m_, chunk_) ((((chunk_) ^ ((m_) & 15))) << 4)
template <int KC, class BF, class AF, class PF, class EF>
__device__ __forceinline__ void cphase(const int nseg, const int lane, const bf16_t* __restrict__ Wb, BF bofs, AF abase, PF pre, EF epi) {
  const int half = lane >> 5, sw = lane & 15;
  bf16x8 bs[4][2][4];
  const int S = nseg * KC;
  const int crot = ((blockIdx.x >> 3) * 3 + (lane >> 6) + (otid() >> 6) * 5) & (KC - 1);
#define CH_LD(ST, s_) { const int sg_ = (s_) / KC, c_ = ((s_) + crot) % KC; unsigned o0_ = bofs(sg_) + 4096u * c_ + lane * 16; asm volatile("" : "+v"(o0_)); \
    unsigned o1_ = o0_ + KC * 4096u; asm volatile("" : "+v"(o1_)); \
    _Pragma("unroll") for (int ks_ = 0; ks_ < 4; ++ks_) { bs[ST][0][ks_] = *(const bf16x8*)((const char*)Wb + o0_ + 1024 * ks_); bs[ST][1][ks_] = *(const bf16x8*)((const char*)Wb + o1_ + 1024 * ks_); } }
#define CH_LA(DST, s_) { const int sg_ = (s_) / KC, c_ = ((s_) + crot) % KC; const char* ap_ = abase(sg_); \
    _Pragma("unroll") for (int ks_ = 0; ks_ < 4; ++ks_) DST[ks_] = *(const bf16x8*)(ap_ + (((8 * c_ + 4 * half + ks_) ^ sw) << 4)); }
  CH_LD(0, 0) CH_LD(1, 1) CH_LD(2, 2)
  bf16x8 ac[4];
  CH_LA(ac, 0)
  f32x16 acc[2];
#pragma unroll
  for (int f = 0; f < 2; ++f)
#pragma unroll
    for (int i = 0; i < 16; ++i) acc[f][i] = 0.f;
#pragma unroll 1
  for (int s0 = 0; s0 < S; s0 += 4) {
#pragma unroll
    for (int j = 0; j < 4; ++j) {
      const int s = s0 + j;
      if (s + 3 < S) CH_LD((j + 3) & 3, s + 3)
      bf16x8 an[4];
      { const int sn = (s + 1 < S) ? s + 1 : s; CH_LA(an, sn) }
      const int sg = s / KC, c = s % KC;
#pragma unroll
      for (int ks = 0; ks < 4; ++ks)
#pragma unroll
        for (int f = 0; f < 2; ++f) acc[f] = __builtin_amdgcn_mfma_f32_32x32x16_bf16(bs[j][f][ks], ac[ks], acc[f], 0, 0, 0);
      if (j == 3 && c == KC - 5) pre(sg);
      if (j == 3 && c == KC - 1) {
        epi(sg, acc);
#pragma unroll
        for (int f = 0; f < 2; ++f)
#pragma unroll
          for (int i = 0; i < 16; ++i) acc[f][i] = 0.f;
      }
#pragma unroll
      for (int ks = 0; ks < 4; ++ks) ac[ks] = an[ks];
    }
  }
#undef CH_LD
#undef CH_LA
}

__device__ __forceinline__ void stage_chain1(const Params& p, int l, int g, int rr_lim, const bf16_t* Z, const bf16_t* HF, const bf16_t* HB,
                                             const float* YSF, const float* YSB, const bf16_t* YA, bf16_t* MG, bf16_t* H2, const bf16_t* W, char* smem) {
  const int tid = otid(), w = tid >> 6, lane = tid & 63, m = lane & 31, half = lane >> 5;
  const int tpb32 = rr_lim >> 5, ntile = GB * tpb32;
  const float* mod = (const float*)(p.ws + WB_MOD) + (size_t)l * 9 * 6144;
  const bf16_t* GLUT = W + WT_GLU; const bf16_t* WBR = W + WT_WBR; const bf16_t* WOUT = W + WT_WOUT;
  char* R0 = smem; char* R1 = smem + 32768; char* R2 = smem + 65536;
  const int c0 = tid * 2;
  const float2 gml = *(const float2*)(p.in[I_MLNG] + l * 512 + c0);
  const float2 dsk = *(const float2*)(p.in[I_S5D] + l * 512 + c0);
  const int rot = blockIdx.x >> 3;
  for (int t = blockIdx.x; t < ntile; t += gridDim.x) {
    const int bl = t / tpb32, rr0 = (t % tpb32) * 32, b = g * GB + bl;
    const size_t lr0 = (size_t)bl * NTOK + rr0;
    __syncthreads();
    for (int i0 = 0; i0 < 32; i0 += 8) {
      unsigned a0[8], a1[8], og[8], uu[8];
      float2 f[8], bb[8];
#pragma unroll
      for (int u = 0; u < 8; ++u) {
        const size_t r = lr0 + i0 + u;
        a0[u] = *(const unsigned*)(HF + r * 512 + c0); a1[u] = *(const unsigned*)(HB + r * 512 + c0);
        og[u] = *(const unsigned*)(Z + r * ZW + 2560 + c0); uu[u] = *(const unsigned*)(Z + r * ZW + 3072 + c0);
        f[u] = *(const float2*)(YSF + r * 512 + c0); bb[u] = *(const float2*)(YSB + r * 512 + c0);
      }
#pragma unroll
      for (int u = 0; u < 8; ++u) {
        const float h0 = lo16(a0[u]) + lo16(a1[u]), h1 = hi16(a0[u]) + hi16(a1[u]);
        const float ss = wave_sum(h0 * h0 + h1 * h1);
        const float rs = rsqrtf(ss * (1.0f / 128.0f) + EPSF);
        const int mm = i0 + u, off = mm * 1024 + CH_SW(mm, c0 >> 3) + (c0 & 7) * 2;
        *(unsigned*)(R1 + off) = pack2(h0 * rs * gml.x * sigmoidf_(lo16(og[u])), h1 * rs * gml.y * sigmoidf_(hi16(og[u])));
        *(unsigned*)(R0 + off) = pack2(geluf_(dsk.x * lo16(uu[u]) + f[u].x + bb[u].x), geluf_(dsk.y * hi16(uu[u]) + f[u].y + bb[u].y));
      }
    }
    __syncthreads();
    {
      float4 bv[2][4];
      cphase<8>(2, lane, GLUT,
        [&](int sg) __attribute__((always_inline)) { const int cb = (w * 2 + sg + rot) & 7; return (unsigned)(cb * 2) * (8u * 4096u); },
        [&](int sg) __attribute__((always_inline)) { return (const char*)(R0 + m * 1024); },
        [&](int sg) __attribute__((always_inline)) {
          const int n0 = ((w * 2 + sg + rot) & 7) * 64;
#pragma unroll
          for (int f = 0; f < 2; ++f)
#pragma unroll
            for (int q = 0; q < 4; ++q) bv[f][q] = *(const float4*)(p.in[I_GLUB] + l * 512 + n0 + f * 32 + 8 * q + 4 * half);
        },
        [&](int sg, f32x16 (&acc)[2]) __attribute__((always_inline)) {
          const int n0 = ((w * 2 + sg + rot) & 7) * 64;
#pragma unroll
          for (int f = 0; f < 2; ++f)
#pragma unroll
            for (int q = 0; q < 4; ++q) {
              const int c = n0 + f * 32 + 8 * q + 4 * half;
              const int off = m * 1024 + CH_SW(m, c >> 3) + 8 * half;
              const u32x2 g2 = *(const u32x2*)(R0 + off);
              const float o0 = lo16(g2[0]) * sigmoidf_(acc[f][4 * q] + bv[f][q].x), o1 = hi16(g2[0]) * sigmoidf_(acc[f][4 * q + 1] + bv[f][q].y);
              const float o2 = lo16(g2[1]) * sigmoidf_(acc[f][4 * q + 2] + bv[f][q].z), o3 = hi16(g2[1]) * sigmoidf_(acc[f][4 * q + 3] + bv[f][q].w);
              *(u32x2*)(R2 + off) = (u32x2){pack2(o0, o1), pack2(o2, o3)};
            }
        });
    }
    __syncthreads();
    for (int i = tid; i < 32 * 64; i += 256) {
      const int mm = i >> 6, ch = i & 63;
      *(u32x4*)(R0 + mm * 1024 + CH_SW(mm, ch)) = *(const u32x4*)(YA + (lr0 + mm) * 512 + ch * 8);
    }
    __syncthreads();
    {
      f32x16 macc[2];
#pragma unroll
      for (int f = 0; f < 2; ++f)
#pragma unroll
        for (int i = 0; i < 16; ++i) macc[f][i] = 0.f;
      u32x2 e[2][4];
      const size_t row = lr0 + m;
      cphase<8>(12, lane, WBR,
        [&](int sg) __attribute__((always_inline)) { const int pass = sg / 3, r = sg % 3, cb = (w * 4 + pass + rot) & 15; return (unsigned)r * (1024u * 512u * 2u) + (unsigned)(cb * 2) * (8u * 4096u); },
        [&](int sg) __attribute__((always_inline)) { const int r = sg % 3; return (const char*)(smem + r * 32768 + m * 1024); },
        [&](int sg) __attribute__((always_inline)) {
          const int pass = sg / 3, r = sg % 3, n0 = ((w * 4 + pass + rot) & 15) * 64;
#pragma unroll
          for (int f = 0; f < 2; ++f)
#pragma unroll
            for (int q = 0; q < 4; ++q) e[f][q] = *(const u32x2*)(Z + row * ZW + 3584 + r * 1024 + n0 + f * 32 + 8 * q + 4 * half);
        },
        [&](int sg, f32x16 (&acc)[2]) __attribute__((always_inline)) {
          const int pass = sg / 3, r = sg % 3, n0 = ((w * 4 + pass + rot) & 15) * 64;
#pragma unroll
          for (int f = 0; f < 2; ++f)
#pragma unroll
            for (int q = 0; q < 4; ++q) {
              macc[f][4 * q] += lo16(e[f][q][0]) * acc[f][4 * q];
              macc[f][4 * q + 1] += hi16(e[f][q][0]) * acc[f][4 * q + 1];
              macc[f][4 * q + 2] += lo16(e[f][q][1]) * acc[f][4 * q + 2];
              macc[f][4 * q + 3] += hi16(e[f][q][1]) * acc[f][4 * q + 3];
            }
          if (r == 2) {
#pragma unroll
            for (int f = 0; f < 2; ++f)
#pragma unroll
              for (int q = 0; q < 4; ++q) {
                const int c = n0 + f * 32 + 8 * q + 4 * half;
                *(u32x2*)(MG + row * DM + c) = (u32x2){pack2(macc[f][4 * q], macc[f][4 * q + 1]), pack2(macc[f][4 * q + 2], macc[f][4 * q + 3])};
              }
#pragma unroll
            for (int f = 0; f < 2; ++f)
#pragma unroll
              for (int i = 0; i < 16; ++i) macc[f][i] = 0.f;
          }
        });
    }
    __syncthreads();
    for (int i = tid; i < 32 * 128; i += 256) {
      const int mm = i >> 7, ch = i & 127;
      *(u32x4*)(smem + mm * 2048 + CH_SW(mm, ch)) = *(const u32x4*)(MG + (lr0 + mm) * DM + ch * 8);
    }
    __syncthreads();
    {
      const float* gv = mod + (size_t)((rr0 < NLAT) ? b : 8) * 6144 + 2 * 1024;
      const int rr = rr0 + m;
      float4 xg[2][4], xx[2][4];
      cphase<16>(4, lane, WOUT,
        [&](int sg) __attribute__((always_inline)) { const int cb = (w * 4 + sg + rot) & 15; return (unsigned)(cb * 2) * (16u * 4096u); },
        [&](int sg) __attribute__((always_inline)) { return (const char*)(smem + m * 2048); },
        [&](int sg) __attribute__((always_inline)) {
          const int n0 = ((w * 4 + sg + rot) & 15) * 64;
#pragma unroll
          for (int f = 0; f < 2; ++f)
#pragma unroll
            for (int q = 0; q < 4; ++q) {
              const int c = n0 + f * 32 + 8 * q + 4 * half;
              xg[f][q] = *(const float4*)(gv + c);
              xx[f][q] = (l == 0) ? *(const float4*)(xrow_in(p, b, rr) + c) : *(const float4*)(xrow(p, b, rr) + c);
            }
        },
        [&](int sg, f32x16 (&acc)[2]) __attribute__((always_inline)) {
          const int n0 = ((w * 4 + sg + rot) & 15) * 64;
#pragma unroll
          for (int f = 0; f < 2; ++f)
#pragma unroll
            for (int q = 0; q < 4; ++q) {
              const int c = n0 + f * 32 + 8 * q + 4 * half;
              float4 x = xx[f][q];
              const float4 gg = xg[f][q];
              x.x += gg.x * acc[f][4 * q]; x.y += gg.y * acc[f][4 * q + 1]; x.z += gg.z * acc[f][4 * q + 2]; x.w += gg.w * acc[f][4 * q + 3];
              *(float4*)(xrow(p, b, rr) + c) = x;
            }
        });
    }
    __syncthreads();
    {
      const float* ng = p.in[I_N2G] + l * DM;
      const float* mm_ = mod + (size_t)((rr0 < NLAT) ? b : 8) * 6144;
#pragma unroll 1
      for (int i0 = w * 8; i0 < w * 8 + 8; i0 += 2) {
        float4 v[2][4];
#pragma unroll
        for (int u = 0; u < 2; ++u) {
          const float4* X = (const float4*)xrow(p, b, rr0 + i0 + u);
#pragma unroll
          for (int q = 0; q < 4; ++q) v[u][q] = X[q * 64 + lane];
        }
#pragma unroll
        for (int u = 0; u < 2; ++u) {
          float s = 0.f;
#pragma unroll
          for (int q = 0; q < 4; ++q) s += v[u][q].x * v[u][q].x + v[u][q].y * v[u][q].y + v[u][q].z * v[u][q].z + v[u][q].w * v[u][q].w;
          s = wave_sum(s);
          const float rs = rsqrtf(s * (1.0f / DM) + EPSF);
          u32x2* hp = (u32x2*)(H2 + (lr0 + i0 + u) * DM);
#pragma unroll
          for (int q = 0; q < 4; ++q) {
            const float4 gg = ((const float4*)ng)[q * 64 + lane];
            const float4 sc = ((const float4*)(mm_ + 4096))[q * 64 + lane];
            const float4 sh = ((const float4*)(mm_ + 3072))[q * 64 + lane];
            const float4 x = v[u][q];
            hp[q * 64 + lane] = (u32x2){pack2(x.x * rs * gg.x * (1.f + sc.x) + sh.x, x.y * rs * gg.y * (1.f + sc.y) + sh.y),
                                        pack2(x.z * rs * gg.z * (1.f + sc.z) + sh.z, x.w * rs * gg.w * (1.f + sc.w) + sh.w)};
          }
        }
      }
    }
  }
}

__device__ __forceinline__ void stage_peerq_mfma(int tpb, const bf16_t* H2, const bf16_t* WQ, bf16_t* PQ, char* smem) {
  EPI_DECL
  const int tm = GB * tpb;
  TileIter ti(tm, 16);
  int mt_, nt_; bool valid;
  while (ti.next(mt_, nt_, valid)) {
    if (!valid) continue;
    const int m0 = MT_LR0(mt_, tpb), n0 = nt_ * 128;
    f32x16 acc[2][2];
    gemm_tile(H2 + (size_t)m0 * DM, DM, WQ + (size_t)n0 * DM, DM, DM, smem, acc);
#pragma unroll
    for (int mi = 0; mi < 2; ++mi)
#pragma unroll
      for (int ni = 0; ni < 2; ++ni)
#pragma unroll
        for (int q = 0; q < 4; ++q) {
          const int row = m0 + EPI_ROW(mi), c = n0 + EPI_COL(ni, q);
          *(u32x2*)(PQ + (size_t)row * 2048 + c) = (u32x2){pack2(acc[mi][ni][4 * q], acc[mi][ni][4 * q + 1]), pack2(acc[mi][ni][4 * q + 2], acc[mi][ni][4 * q + 3])};
        }
  }
}

__device__ __forceinline__ unsigned f2sortable(float x) { const unsigned u = __float_as_uint(x); return (u & 0x80000000u) ? ~u : (u | 0x80000000u); }
__device__ __forceinline__ float sortable2f(unsigned k) { return __uint_as_float((k & 0x80000000u) ? (k & 0x7fffffffu) : ~k); }
#define TOPK_INSERT(v, key) { unsigned t_ = (key); _Pragma("unroll") for (int s_ = 0; s_ < 16; ++s_) { const unsigned hi_ = max(v[s_], t_); t_ = min(v[s_], t_); v[s_] = hi_; } }
__device__ __forceinline__ void stage_scores_topk(int tpb, const bf16_t* PQ, const bf16_t* SUBK, int* EI, float* EG, char* smem) {
  EPI_DECL
  const int tid = tid_;
  const int item = tid & 127, kpart = tid >> 7;
  float* S = (float*)smem;
  unsigned* xk = (unsigned*)(smem + 128 * 129 * 4);
  const int tm = GB * tpb * 8;
  for (int mt = blockIdx.x; mt < tm; mt += gridDim.x) {
    const size_t m0 = (size_t)MT_LR0(mt >> 3, tpb) * 8 + (size_t)(mt & 7) * 128;
    unsigned vh[2][16];
#pragma unroll
    for (int half = 0; half < 2; ++half) {
      f32x16 acc[2][2];
      gemm_tile(PQ + m0 * 256 + half * 128, 256, SUBK + (size_t)half * 16384, 128, 128, smem, acc);
#pragma unroll
      for (int mi = 0; mi < 2; ++mi)
#pragma unroll
        for (int ni = 0; ni < 2; ++ni)
#pragma unroll
          for (int i = 0; i < 16; ++i)
            S[EPI_ROW(mi) * 129 + wn * 64 + ni * 32 + 8 * (i >> 2) + 4 * fh + (i & 3)] = acc[mi][ni][i];
      __syncthreads();
      unsigned v[16];
#pragma unroll
      for (int s = 0; s < 16; ++s) v[s] = 0u;
      const float* sr = S + item * 129 + kpart * 64;
#pragma unroll 8
      for (int k = 0; k < 64; ++k) {
        const unsigned key = (f2sortable(sr[k]) & ~127u) | (unsigned)(127 - (kpart * 64 + k));
        TOPK_INSERT(v, key)
      }
      if (kpart == 1) {
#pragma unroll
        for (int s = 0; s < 16; ++s) xk[item * 17 + s] = v[s];
      }
      __syncthreads();
      if (kpart == 0) {
#pragma unroll
        for (int s = 0; s < 16; ++s) { const unsigned key = xk[item * 17 + s]; TOPK_INSERT(v, key) }
      }
#pragma unroll
      for (int s = 0; s < 16; ++s) vh[half][s] = v[s];
      __syncthreads();
    }
    if (kpart == 0) {
      float v1[16], v2[16];
#pragma unroll
      for (int s = 0; s < 16; ++s) { v1[s] = sortable2f((vh[0][s] & ~127u) | 64u); v2[s] = sortable2f((vh[1][s] & ~127u) | 64u); }
      unsigned c[16];
#pragma unroll
      for (int s = 0; s < 16; ++s) c[s] = 0u;
      {
        int o = 0;
#pragma unroll
        for (int i = 0; i < 16; ++i)
#pragma unroll
          for (int j = 0; j < 16 / (i + 1); ++j) {
            const unsigned key = (f2sortable(v1[i] + v2[j]) & ~63u) | (unsigned)(63 - o);
            TOPK_INSERT(c, key)
            ++o;
          }
      }
      const float vmax = sortable2f((c[0] & ~63u) | 32u);
      float sum = 0.f;
#pragma unroll
      for (int s = 0; s < 16; ++s) sum += expf(sortable2f((c[s] & ~63u) | 32u) - vmax);
      const float isum = 1.0f / sum;
      const unsigned thr = c[15];
      int* ei = EI + (m0 + item) * 16;
      float* eg = EG + (m0 + item) * 16;
      int cntw = 0;
      {
        int o = 0;
#pragma unroll
        for (int i = 0; i < 16; ++i)
#pragma unroll
          for (int j = 0; j < 16 / (i + 1); ++j) {
            const unsigned key = (f2sortable(v1[i] + v2[j]) & ~63u) | (unsigned)(63 - o);
            if (key >= thr) {
              ei[cntw] = (int)((127u - (vh[0][i] & 127u)) * 128u + (127u - (vh[1][j] & 127u)));
              eg[cntw] = expf(sortable2f((key & ~63u) | 32u) - vmax) * isum;
              ++cntw;
            }
            ++o;
          }
      }
    }
  }
  __syncthreads();
}

#define DPPF(x, ctrl) __uint_as_float((unsigned)__builtin_amdgcn_update_dpp(0, (int)__float_as_uint(x), (ctrl), 0xf, 0xf, true))
#define XP_HALVE(n, bit, ctrl) { _Pragma("unroll") for (int j_ = 0; j_ < (n); ++j_) { const float keep_ = (bit) ? a[j_ + (n)] : a[j_]; const float send_ = (bit) ? a[j_] : a[j_ + (n)]; a[j_] = keep_ + DPPF(send_, ctrl); } }
#define XP_ROW(TAB, E, PR) { const int e0_ = __builtin_amdgcn_readlane((E), 2 * (PR)), e1_ = __builtin_amdgcn_readlane((E), 2 * (PR) + 1); \
    const char* rp_ = (TAB) + (size_t)(hw ? e1_ : e0_) * 768 + hl * 24; \
    const u32x4_u x_ = *(const u32x4_u*)rp_; const u32x2 y_ = *(const u32x2*)(rp_ + 16); \
    ra[PR] = (v6u){x_[0], x_[1], x_[2], x_[3], y_[0], y_[1]}; }
#define XP_META(PAR, T, E, G, HP) { const size_t mo_ = ((size_t)(PAR) * RPG + (T)) * 128 + w * 32 + hl; \
    E = ((const int*)(p.ws + WB_EI))[mo_]; G = ((const float*)(p.ws + WB_EG))[mo_]; \
    const u32x4* hr_ = (const u32x4*)((const bf16_t*)(p.ws + WB_H2) + ((size_t)(PAR) * RPG + (T)) * DM + hl * 32); \
    _Pragma("unroll") for (int c_ = 0; c_ < 4; ++c_) HP[c_] = hr_[c_]; }
__device__ __forceinline__ void unpack8(const u32x4 v, float* f) {
#pragma unroll
  for (int k = 0; k < 4; ++k) { f[2 * k] = lo16(v[k]); f[2 * k + 1] = hi16(v[k]); }
}
__device__ __forceinline__ int xp_pool_n(int q) { return GB * ((q < NG) ? NTOK : NLAT); }
__device__ __forceinline__ int xp_claim(int* pool, int& qa, int hi) {
  while (qa <= hi) {
    const int n = xp_pool_n(qa);
    if (__hip_atomic_load(pool + qa, __ATOMIC_RELAXED, __HIP_MEMORY_SCOPE_AGENT) < n) {
      const int i = atomicAdd(pool + qa, 1);
      if (i < n) return qa * 65536 + i;
    }
    ++qa;
  }
  return -1;
}
__device__ __forceinline__ void xp_decode(int tok, int& l, int& par, int& b, int& rr, int& t) {
  const int q = tok >> 16, i = tok & 65535;
  l = q / NG;
  const int g = q % NG, rr_lim = (l == 0) ? NTOK : NLAT, bl = i / rr_lim;
  rr = i % rr_lim; b = g * GB + bl; t = bl * NTOK + rr; par = q % 3;
}
__device__ __forceinline__ void expert_run(const Params& p, int lo, int hi, unsigned* ctr, unsigned epoch, const bool steal, int& pend, float* smem) {
  if (lo < 0) lo = 0;
  if (hi < lo) return;
  const int tid = otid(), w = tid >> 6, lane = tid & 63, hl = lane & 31, hw = lane >> 5;
  int* s_tok = (int*)(smem + SMEM_FLOATS - 8);
  int* pool = (int*)(p.ws + WB_POOL);
  float* part = smem;
  int qa = lo, ci = 0;
  bool cpend = false;
  unsigned cb = 0;
  int cur = pend; pend = -1;
  if (cur < 0) {
    __syncthreads();
    if (tid == 0) s_tok[2] = xp_claim(pool, qa, hi);
    __syncthreads();
    cur = __builtin_amdgcn_readfirstlane(s_tok[2]);
  }
  if (cur < 0) return;
  if (tid == 0 && qa <= hi) { ci = atomicAdd(pool + qa, 1); cpend = true; }
  int l, par, b, rr, t;
  xp_decode(cur, l, par, b, rr, t);
  int e_c; float g_c; u32x4 hp[4];
  XP_META(par, t, e_c, g_c, hp)
  v6u ra[16];
  {
    const char* U = p.ws + WB_U16 + (size_t)l * 16384 * 768;
#pragma unroll
    for (int pr = 0; pr < 16; ++pr) XP_ROW(U, e_c, pr)
  }
  for (;;) {
    const float* mod = (const float*)(p.ws + WB_MOD) + (size_t)l * 9 * 6144;
    const float4 g2 = ((const float4*)(mod + (size_t)((rr < NLAT) ? b : 8) * 6144 + 5 * 1024))[tid];
    float4* xp = (float4*)xrow(p, b, rr) + tid;
    float4 xv = *xp;
    if (tid == 0) {
      int r = -1;
      if (cpend) {
        if (ci < xp_pool_n(qa)) r = qa * 65536 + ci;
        else { ++qa; r = xp_claim(pool, qa, hi); }
      }
      const int st = (steal && cb + 1u >= epoch) ? 1 : 0;
      s_tok[0] = r; s_tok[1] = st;
      cpend = false;
      if (!st && r >= 0 && qa <= hi) { ci = atomicAdd(pool + qa, 1); cpend = true; }
      if (steal) cb = __hip_atomic_load(ctr, __ATOMIC_RELAXED, __HIP_MEMORY_SCOPE_AGENT);
    }
    __syncthreads();
    const int nxt = __builtin_amdgcn_readfirstlane(s_tok[0]);
    const bool pf = nxt >= 0 && __builtin_amdgcn_readfirstlane(s_tok[1]) == 0;
    int ln = l, parn = 0, bn = 0, rrn = 0, tn = 0, e_n = 0;
    float g_n = 0.f;
    u32x4 hn[4];
#pragma unroll
    for (int c = 0; c < 4; ++c) hn[c] = (u32x4){0u, 0u, 0u, 0u};
    if (pf) {
      xp_decode(nxt, ln, parn, bn, rrn, tn);
      XP_META(parn, tn, e_n, g_n, hn)
    }
    const char* V = p.ws + WB_V16 + (size_t)l * 16384 * 768;
    f32x2 hq2[16];
#pragma unroll
    for (int c = 0; c < 4; ++c)
#pragma unroll
      for (int k = 0; k < 4; ++k) hq2[4 * c + k] = (f32x2){lo16(hp[c][k]), hi16(hp[c][k])};
    float a[16];
#pragma unroll
    for (int pr = 0; pr < 16; ++pr) {
      const v32f f = __builtin_amdgcn_cvt_scalef32_pk32_f32_fp6(ra[pr], 1.0f);
      f32x2 sa = {0.f, 0.f}, sb = {0.f, 0.f};
#pragma unroll
      for (int k = 0; k < 16; k += 2) {
        sa = __builtin_elementwise_fma(hq2[k], (f32x2){f[2 * k], f[2 * k + 1]}, sa);
        sb = __builtin_elementwise_fma(hq2[k + 1], (f32x2){f[2 * k + 2], f[2 * k + 3]}, sb);
      }
      a[pr] = (sa[0] + sb[0]) + (sa[1] + sb[1]);
      XP_ROW(V, e_c, pr)
    }
    {
      const bool b3 = (lane & 8) != 0, b2 = (lane & 4) != 0, b1 = (lane & 2) != 0, b0 = (lane & 1) != 0;
      XP_HALVE(8, b3, 0x128)
      XP_HALVE(4, b2, 0x141)
      XP_HALVE(2, b1, 0x4E)
      XP_HALVE(1, b0, 0xB1)
    }
    float dsum = a[0];
    dsum += __shfl_xor(dsum, 16);
    const float my_dot = __shfl(dsum, 32 * (hl & 1) + (hl >> 1));
    const float my_c = g_c * geluf_(my_dot * (1.0f / 64.0f));
    f32x2 acc2[16];
#pragma unroll
    for (int k = 0; k < 16; ++k) acc2[k] = (f32x2){0.f, 0.f};
    {
      const char* Un = p.ws + WB_U16 + (size_t)ln * 16384 * 768;
#pragma unroll
      for (int pr = 0; pr < 16; ++pr) {
        const float c0 = __uint_as_float(__builtin_amdgcn_readlane(__float_as_uint(my_c), 2 * pr)), c1 = __uint_as_float(__builtin_amdgcn_readlane(__float_as_uint(my_c), 2 * pr + 1));
        const float c = hw ? c1 : c0;
        const f32x2 cc = {c, c};
        const v32f f = __builtin_amdgcn_cvt_scalef32_pk32_f32_fp6(ra[pr], 1.0f);
#pragma unroll
        for (int k = 0; k < 16; ++k) acc2[k] = __builtin_elementwise_fma(cc, (f32x2){f[2 * k], f[2 * k + 1]}, acc2[k]);
        XP_ROW(Un, e_n, pr)
      }
    }
    __syncthreads();
    {
      float4* pw = (float4*)(part + (w * 2 + hw) * 1024 + hl * 32);
#pragma unroll
      for (int c = 0; c < 8; ++c) pw[c] = make_float4(acc2[2 * c][0], acc2[2 * c][1], acc2[2 * c + 1][0], acc2[2 * c + 1][1]);
    }
    __syncthreads();
    float4 s = ((const float4*)part)[tid];
#pragma unroll
    for (int c = 1; c < 8; ++c) { const float4 x = ((const float4*)(part + c * 1024))[tid]; s.x += x.x; s.y += x.y; s.z += x.z; s.w += x.w; }
    xv.x += 0.5f * g2.x * s.x; xv.y += 0.5f * g2.y * s.y; xv.z += 0.5f * g2.z * s.z; xv.w += 0.5f * g2.w * s.w;
    *xp = xv;
    if (!pf) { pend = nxt; break; }
    l = ln; par = parn; b = bn; rr = rrn; t = tn; e_c = e_n; g_c = g_n;
#pragma unroll
    for (int c = 0; c < 4; ++c) hp[c] = hn[c];
  }
}
__device__ __forceinline__ void expert_drain(const Params& p, int lo, int hi, int& pend, float* smem) {
  expert_run(p, lo, hi, nullptr, 0u, false, pend, smem);
}

__device__ __forceinline__ void stage_final(const Params& p, float* smem) {
  const int tid = otid(), w = tid >> 6, lane = tid & 63;
  const int n = NB * NLAT;
  for (int r0 = (blockIdx.x * 4 + w) * 2; r0 < n; r0 += gridDim.x * 8) {
    float4 v[2][4];
#pragma unroll
    for (int u = 0; u < 2; ++u)
#pragma unroll
      for (int q = 0; q < 4; ++q) v[u][q] = ((const float4*)(p.out + (size_t)(r0 + u) * DM))[q * 64 + lane];
#pragma unroll
    for (int u = 0; u < 2; ++u) {
      float s = 0.f;
#pragma unroll
      for (int q = 0; q < 4; ++q) s += v[u][q].x * v[u][q].x + v[u][q].y * v[u][q].y + v[u][q].z * v[u][q].z + v[u][q].w * v[u][q].w;
      s = wave_sum(s);
      const float rs = rsqrtf(s * (1.0f / DM) + EPSF);
#pragma unroll
      for (int q = 0; q < 4; ++q) {
        const float4 g = ((const float4*)p.in[I_FG])[q * 64 + lane];
        const float4 x = v[u][q];
        ((float4*)(p.out + (size_t)(r0 + u) * DM))[q * 64 + lane] = make_float4(x.x * rs * g.x, x.y * rs * g.y, x.z * rs * g.z, x.w * rs * g.w);
      }
    }
  }
}

__device__ __forceinline__ void gbar(const Params& p, unsigned* ctr, unsigned& epoch, int lo, int hi, int& pend, float* smem) {
  asm volatile("s_waitcnt vmcnt(0)" ::: "memory");
  __syncthreads();
  epoch += gridDim.x;
  int* s_flag = (int*)(smem + SMEM_FLOATS - 12);
  if (threadIdx.x == 0) {
    __builtin_amdgcn_fence(__ATOMIC_RELEASE, "agent");
    asm volatile("s_waitcnt vmcnt(0)" ::: "memory");
    __hip_atomic_fetch_add(ctr, 1u, __ATOMIC_RELAXED, __HIP_MEMORY_SCOPE_AGENT);
  }
  if (hi >= lo && hi >= 0) {
    if (threadIdx.x == 0) {
      const unsigned c = __hip_atomic_load(ctr, __ATOMIC_RELAXED, __HIP_MEMORY_SCOPE_AGENT);
      *s_flag = (c + 1u < epoch) ? 1 : 0;
    }
    __syncthreads();
    if (*s_flag) expert_run(p, lo, hi, ctr, epoch, true, pend, smem);
  }
  if (threadIdx.x == 0) {
    while (__hip_atomic_load(ctr, __ATOMIC_RELAXED, __HIP_MEMORY_SCOPE_AGENT) < epoch) __builtin_amdgcn_s_sleep(2);
    __builtin_amdgcn_fence(__ATOMIC_ACQUIRE, "agent");
    asm volatile("s_waitcnt vmcnt(0)" ::: "memory");
  }
  __syncthreads();
}

__global__ void __launch_bounds__(256) mega(Params p) {
  cg::grid_group grid = cg::this_grid();
  __shared__ __attribute__((aligned(16))) float smem[SMEM_FLOATS];
  char* smc = (char*)smem;
  char* ws = p.ws;
  bf16_t* H = (bf16_t*)(ws + WB_H); bf16_t* Z = (bf16_t*)(ws + WB_Z); float* MGT = (float*)(ws + WB_MGT); bf16_t* XC = (bf16_t*)(ws + WB_XC);
  bf16_t* QM = (bf16_t*)(ws + WB_QM); bf16_t* KM = (bf16_t*)(ws + WB_KM); bf16_t* KMT = (bf16_t*)(ws + WB_KMT); bf16_t* MVT = (bf16_t*)(ws + WB_MVT);
  bf16_t* HF = (bf16_t*)(ws + WB_HF); bf16_t* HB = (bf16_t*)(ws + WB_HB);
  bf16_t* VT = (bf16_t*)(ws + WB_VT); float* YSF = (float*)(ws + WB_YSF); float* YSB = (float*)(ws + WB_YSB);
  bf16_t* YA = (bf16_t*)(ws + WB_YA); bf16_t* YB = (bf16_t*)(ws + WB_YB); bf16_t* YS = (bf16_t*)(ws + WB_YS); bf16_t* GG = (bf16_t*)(ws + WB_GG);
  bf16_t* MG = (bf16_t*)(ws + WB_MG); bf16_t* PQ = (bf16_t*)(ws + WB_PQ); float* SC = (float*)(ws + WB_SC);
  float* XE = (float*)(ws + WB_XE); float* GA = (float*)(ws + WB_GA);
  const bf16_t* WT = (const bf16_t*)(ws + WB_WT);

  unsigned* bar = (unsigned*)(ws + WB_BAR);
  unsigned epoch = 0;
  int pend = -1;
  stage_init(p, smem);
  grid.sync();

  for (int l = 0; l < 2; ++l) {
    const bool need_ctx = (l == 0);
    const int rr_lim = need_ctx ? NTOK : NLAT;
    const int tpb = need_ctx ? 34 : 32;
    const bf16_t* W = WT + (size_t)l * WT_LAYER;
    const float lam_init = 0.8f - 0.6f * expf(-0.3f * (float)l);
    float lam;
    {
      float s1 = 0.f, s2 = 0.f;
      for (int i = 0; i < 64; ++i) {
        s1 += p.in[I_LQ1][l * 64 + i] * p.in[I_LK1][l * 64 + i];
        s2 += p.in[I_LQ2][l * 64 + i] * p.in[I_LK2][l * 64 + i];
      }
      lam = expf(s1) - expf(s2) + lam_init;
    }
    for (int g = 0; g < NG; ++g) {
      const int q = l * NG + g;
      int plo = q - 3, phi = q - 1;
      int* EI = (int*)(ws + WB_EI) + (size_t)(q % 3) * RPG * 128; float* EG = (float*)(ws + WB_EG) + (size_t)(q % 3) * RPG * 128;
      bf16_t* H2 = (bf16_t*)(ws + WB_H2) + (size_t)(q % 3) * RPG * DM;
      stage_normmod(p, l, g, 0, NTOK, H, smem);
      gbar(p, bar, epoch, plo, phi, pend, smem);
      stage_inproj(p, H, W + WT_WIN, Z, MGT, VT, MVT, smc);
      gbar(p, bar, epoch, plo, phi, pend, smem);
      stage_conv(p, l, Z, XC);
      stage_s5_pass1(p, l, Z, XE);
      gbar(p, bar, epoch, plo, phi, pend, smem);
      stage_mlqk(XC, W + WT_WQK, QM, KM, KMT, smc);
      stage_mlgates(p, l, MGT, GA);
      gbar(p, bar, epoch, plo, phi, pend, smem);
      {
        const int n_attn = 4 * 64 + (need_ctx ? 4 * 4 : 0);
        const int n_s5 = 32 * 2 * 9;
        const int n_items = GB * (16 + n_attn + n_s5);
        int* cnt = (int*)(ws + WB_CNT) + (l * NG + g);
        int* s_item = (int*)(smem + SMEM_FLOATS - 4);
        for (;;) {
          __syncthreads();
          if (otid() == 0) *s_item = atomicAdd(cnt, 1);
          __syncthreads();
          const int it = *s_item;
          if (it >= n_items) break;
          int bl, k;
          if (it < GB * 16) { bl = it / 16; k = it % 16; }
          else if (it < GB * (16 + n_attn)) { bl = (it - GB * 16) / n_attn; k = 16 + (it - GB * 16) % n_attn; }
          else { bl = (it - GB * (16 + n_attn)) / n_s5; k = 16 + n_attn + (it - GB * (16 + n_attn)) % n_s5; }
          const bf16_t* Zb = Z + (size_t)bl * NTOK * ZW;
          const size_t ro = (size_t)bl * NTOK;
          if (k < 16) {
            const int hh = k & 3, dd = (k >> 2) & 1, eh = k >> 3;
            mlstm_chain_item(p, l, QM + ro * 512, KM + ro * 512, KMT + (size_t)bl * 4 * 128 * NTOK, MVT + (size_t)bl * 4 * 128 * NTOK, GA + (size_t)(((bl * 4 + hh) * 2 + dd) * 68) * 272,
                             (dd ? HB : HF) + ro * 512, hh, dd, eh, smc);
          } else if (k < 16 + n_attn) {
            const int a = k - 16;
            const bf16_t* VTb = VT + (size_t)bl * 4 * 128 * NTOK;
            if (a < 256) attn_mfma_item(p, l, Zb, VTb, YA + ro * 512, a & 3, (a >> 2) * 64, 0, NTOK, lam, lam_init, smc);
            else attn_mfma_item(p, l, Zb, VTb, YA + ro * 512, (a - 256) & 3, NLAT + ((a - 256) >> 2) * 64, NLAT, NCTX, lam, lam_init, smc);
          } else {
            const int a = k - 16 - n_attn;
            const int sq = a % 9, dir = (a / 9) & 1, gg = a / 18;
            s5_item(p, l, Zb, XE + (((size_t)bl * 32 + gg) * 2 + dir) * (S5NSEG - 1) * 128, (dir ? YSB : YSF) + ro * 512, gg, dir, sq, smc);
          }
        }
      }
      expert_drain(p, plo, plo, pend, smem);
      plo = q - 2;
      gbar(p, bar, epoch, plo, phi, pend, smem);
      stage_chain1(p, l, g, rr_lim, Z, HF, HB, YSF, YSB, YA, MG, H2, W, smc);
      gbar(p, bar, epoch, plo, phi, pend, smem);
      stage_peerq_mfma(tpb, H2, W + WT_WQ, PQ, smc);
      gbar(p, bar, epoch, plo, phi, pend, smem);
      stage_scores_topk(tpb, PQ, W + WT_SUBK, EI, EG, smc);
      gbar(p, bar, epoch, plo, phi, pend, smem);
    }
  }
  expert_drain(p, 2 * NG - 3, 2 * NG - 1, pend, smem);
  gbar(p, bar, epoch, 0, -1, pend, smem);
  stage_final(p, smem);
}

extern "C" void kernel_launch(void* const* d_in, const int* in_sizes, int n_in, void* d_out,
                              int out_size, void* d_ws, size_t ws_size, hipStream_t stream) {
  static int grid_blocks = 0;
  if (!grid_blocks) {
    int dev = 0, cus = 0, per_cu = 0;
    (void)hipGetDevice(&dev);
    (void)hipDeviceGetAttribute(&cus, hipDeviceAttributeMultiprocessorCount, dev);
    (void)hipOccupancyMaxActiveBlocksPerMultiprocessor(&per_cu, mega, 256, 0);
    if (per_cu > 1) per_cu = 1;
    grid_blocks = cus * per_cu;
  }
  if (ws_size < WB_END) {
    fprintf(stderr, "workspace too small: %zu < %zu\n", ws_size, (size_t)WB_END);
    return;
  }
  Params p{};
  for (int i = 0; i < N_IN; ++i) p.in[i] = (const float*)d_in[i];
  p.out = (float*)d_out;
  p.ws = (char*)d_ws;
  (void)hipMemsetAsync((char*)d_ws + WB_BAR, 0, 256, stream);
  void* args[] = {&p};
  hipError_t e = hipLaunchCooperativeKernel((void*)mega, dim3(grid_blocks), dim3(256), args, 0, stream);
  if (e != hipSuccess) fprintf(stderr, "cooperative launch failed: %s (grid %d)\n", hipGetErrorString(e), grid_blocks);
}
```

```cpp
#include <hip/hip_runtime.h>
#include <hip/hip_cooperative_groups.h>
#include <cstdio>
#include <cstdint>
namespace cg = cooperative_groups;

#define NLAT 4096
#define NCTX 256
#define NTOK 4352
#define DM 1024
#define INW 6672
#define NB 8
#define GB 2
#define NG (NB / GB)
#define RPG (GB * NTOK)
#define ZW 6656
#define EPSF 1e-6f

enum { I_X = 0, I_C, I_CTX, I_CCTX, I_WMOD, I_BMOD, I_N1G, I_N2G, I_WIN, I_LQ1, I_LK1, I_LQ2, I_LK2, I_SUBG,
       I_CONVW, I_CONVB, I_MLWQ, I_MLWK, I_GATEB, I_MLNG, I_S5LRE, I_S5LIM, I_S5DT, I_S5BRE, I_S5BIM,
       I_S5CRE, I_S5CIM, I_S5D, I_GLUW, I_GLUB, I_WBR, I_WOUT, I_PWQ, I_PSUBK, I_PU, I_PV, I_FG, N_IN };

struct Params {
  const float* in[N_IN];
  float* out;
  char* ws;
};

typedef unsigned short bf16_t;
typedef short bf16x8 __attribute__((ext_vector_type(8)));
typedef float f32x16 __attribute__((ext_vector_type(16)));
typedef unsigned u32x4 __attribute__((ext_vector_type(4)));
typedef unsigned u32x2 __attribute__((ext_vector_type(2)));
typedef unsigned u32x4_u __attribute__((ext_vector_type(4), aligned(8)));
typedef float v16f __attribute__((ext_vector_type(16)));
typedef float v32f __attribute__((ext_vector_type(32)));
typedef unsigned v6u __attribute__((ext_vector_type(6)));

#define AL(x) (((x) + 255) & ~(size_t)255)
#define WB_XCX   ((size_t)0)
#define WB_MOD   AL(WB_XCX + (size_t)NB * NCTX * DM * 4)
#define WB_ROPE  AL(WB_MOD + (size_t)2 * 9 * 6144 * 4)
#define WB_WT    AL(WB_ROPE + (size_t)NLAT * 32 * 2 * 4)
#define WT_WIN   ((size_t)0)
#define WT_WQK   (WT_WIN + (size_t)6784 * 1024)
#define WT_GLU   (WT_WQK + (size_t)4 * 256 * 128)
#define WT_WBR   (WT_GLU + (size_t)512 * 512)
#define WT_WOUT  (WT_WBR + (size_t)3 * 1024 * 512)
#define WT_WQ    (WT_WOUT + (size_t)1024 * 1024)
#define WT_SUBK  (WT_WQ + (size_t)2048 * 1024)
#define WT_LAYER (WT_SUBK + (size_t)2 * 128 * 128)
#define WB_H     AL(WB_WT + WT_LAYER * 2 * 2)
#define WB_Z     AL(WB_H + (size_t)RPG * DM * 2)
#define WB_MGT   AL(WB_Z + (size_t)RPG * ZW * 2)
#define WB_XC    AL(WB_MGT + (size_t)RPG * 16 * 4)
#define WB_QM    AL(WB_XC + (size_t)RPG * 512 * 2)
#define WB_KM    AL(WB_QM + (size_t)RPG * 512 * 2)
#define WB_KMT   AL(WB_KM + (size_t)RPG * 512 * 2)
#define WB_MVT   AL(WB_KMT + (size_t)RPG * 512 * 2)
#define WB_HF    AL(WB_MVT + (size_t)RPG * 512 * 2)
#define WB_HB    AL(WB_HF + (size_t)RPG * 512 * 2)
#define WB_YSF   AL(WB_HB + (size_t)RPG * 512 * 2)
#define WB_YSB   AL(WB_YSF + (size_t)RPG * 512 * 4)
#define WB_YA    AL(WB_YSB + (size_t)RPG * 512 * 4)
#define WB_YB    AL(WB_YA + (size_t)RPG * 512 * 2)
#define WB_YS    AL(WB_YB + (size_t)RPG * 512 * 2)
#define WB_GG    AL(WB_YS + (size_t)RPG * 512 * 2)
#define WB_MG    AL(WB_GG + (size_t)RPG * 512 * 2)
#define WB_EI    AL(WB_MG + (size_t)RPG * DM * 2)
#define WB_EG    AL(WB_EI + (size_t)3 * RPG * 128 * 4)
#define WB_H2    AL(WB_EG + (size_t)3 * RPG * 128 * 4)
#define WB_U16   AL(WB_H2 + (size_t)3 * RPG * DM * 2)
#define WB_V16   AL(WB_U16 + (size_t)2 * 16384 * 768)
#define WB_VT    AL(WB_V16 + (size_t)2 * 16384 * 768)
#define WB_CNT   AL(WB_VT + (size_t)GB * 4 * 128 * NTOK * 2)
#define WB_XE    AL(WB_CNT + 256)
#define WB_BAR   AL(WB_XE + (size_t)GB * 32 * 2 * 33 * 128 * 4)
#define WB_GA    AL(WB_BAR + 256)
#define WB_POOL  AL(WB_GA + (size_t)GB * 4 * 2 * 68 * 272 * 4)
#define WB_END   AL(WB_POOL + 256)
#define WB_PQ    (WB_Z)
#define WB_SC    AL(WB_PQ + (size_t)RPG * 2048 * 2)

#define SMEM_FLOATS (25 * 1024)

__device__ __forceinline__ float sigmoidf_(float x) { return __builtin_amdgcn_rcpf(1.0f + __builtin_amdgcn_exp2f(-1.4426950408889634f * x)); }
__device__ __forceinline__ float siluf_(float x) { return x * __builtin_amdgcn_rcpf(1.0f + __builtin_amdgcn_exp2f(-1.4426950408889634f * x)); }
__device__ __forceinline__ float geluf_(float x) { return 0.5f * x * (1.0f + erff(x * 0.70710678118654752f)); }
__device__ __forceinline__ int otid() { int t = threadIdx.x; asm volatile("" : "+v"(t)); return t; }
__device__ __forceinline__ float wave_sum(float v) {
  for (int o = 32; o > 0; o >>= 1) v += __shfl_xor(v, o);
  return v;
}
__device__ __forceinline__ bf16_t f2bf(float x) { unsigned u = __float_as_uint(x); u += 0x7fffu + ((u >> 16) & 1u); return (bf16_t)(u >> 16); }
__device__ __forceinline__ float bf2f(bf16_t h) { return __uint_as_float(((unsigned)h) << 16); }
typedef float f32x2 __attribute__((ext_vector_type(2)));
typedef __bf16 bf16x2_t __attribute__((ext_vector_type(2)));
__device__ __forceinline__ unsigned pack2(float a, float b) { f32x2 v = {a, b}; return __builtin_bit_cast(unsigned, __builtin_convertvector(v, bf16x2_t)); }
__device__ __forceinline__ float lo16(unsigned u) { return __uint_as_float(u << 16); }
__device__ __forceinline__ float hi16(unsigned u) { return __uint_as_float(u & 0xffff0000u); }

__device__ __forceinline__ float* xrow(const Params& p, int b, int rr) {
  return (rr < NLAT) ? p.out + ((size_t)b * NLAT + rr) * DM : (float*)(p.ws + WB_XCX) + ((size_t)b * NCTX + (rr - NLAT)) * DM;
}

__device__ __forceinline__ const float* xrow_in(const Params& p, int b, int rr) {
  return (rr < NLAT) ? p.in[I_X] + ((size_t)b * NLAT + rr) * DM : p.in[I_CTX] + ((size_t)b * NCTX + (rr - NLAT)) * DM;
}

__device__ __forceinline__ void gemm_tile(const bf16_t* __restrict__ Ag, int lda, const bf16_t* __restrict__ Bg, int ldb, int K,
                                          char* smem, f32x16 (&acc)[2][2]) {
  const int tid = otid(), lane = tid & 63, w = tid >> 6, wm = w >> 1, wn = w & 1;
#pragma unroll
  for (int a = 0; a < 2; ++a)
#pragma unroll
    for (int b = 0; b < 2; ++b)
#pragma unroll
      for (int i = 0; i < 16; ++i) acc[a][b][i] = 0.f;
  const int srow = tid >> 3, sch = tid & 7;
  const bf16_t* ap = Ag + (size_t)srow * lda + sch * 8;
  const bf16_t* bp = Bg + (size_t)srow * ldb + sch * 8;
  const int wofs = srow * 128 + ((sch ^ ((srow >> 1) & 7)) << 4);
  const int fr = lane & 31, fh = lane >> 5, fsw = (fr >> 1) & 7;
  const int aofs = (wm * 64 + fr) * 128, bofs = 16384 + (wn * 64 + fr) * 128;
  u32x4 ra0[4], rb0[4], ra1[4], rb1[4];
  const int nk = K >> 6;
#define G_LOAD(RA, RB, KT) { _Pragma("unroll") for (int i = 0; i < 4; ++i) { RA[i] = *(const u32x4*)(ap + (size_t)i * 32 * lda + (KT) * 64); RB[i] = *(const u32x4*)(bp + (size_t)i * 32 * ldb + (KT) * 64); } }
#define G_STORE(RA, RB, BUF) { char* nb_ = smem + (BUF) * 32768; _Pragma("unroll") for (int i = 0; i < 4; ++i) { *(u32x4*)(nb_ + wofs + i * 4096) = RA[i]; *(u32x4*)(nb_ + 16384 + wofs + i * 4096) = RB[i]; } }
#define G_COMPUTE(BUF) { const char* base = smem + (BUF) * 32768; _Pragma("unroll") for (int ks = 0; ks < 4; ++ks) { \
      const int coff = ((ks * 2 + fh) ^ fsw) << 4; bf16x8 af[2], bfr[2]; \
      _Pragma("unroll") for (int mi = 0; mi < 2; ++mi) af[mi] = *(const bf16x8*)(base + aofs + mi * 4096 + coff); \
      _Pragma("unroll") for (int ni = 0; ni < 2; ++ni) bfr[ni] = *(const bf16x8*)(base + bofs + ni * 4096 + coff); \
      _Pragma("unroll") for (int mi = 0; mi < 2; ++mi) _Pragma("unroll") for (int ni = 0; ni < 2; ++ni) \
          acc[mi][ni] = __builtin_amdgcn_mfma_f32_32x32x16_bf16(bfr[ni], af[mi], acc[mi][ni], 0, 0, 0); } }
  G_LOAD(ra0, rb0, 0)
  G_LOAD(ra1, rb1, 1)
  __syncthreads();
  G_STORE(ra0, rb0, 0)
  __syncthreads();
  for (int kt = 0; kt < nk; kt += 2) {
    if (kt + 2 < nk) G_LOAD(ra0, rb0, kt + 2)
    G_COMPUTE(0)
    G_STORE(ra1, rb1, 1)
    __syncthreads();
    if (kt + 3 < nk) G_LOAD(ra1, rb1, kt + 3)
    G_COMPUTE(1)
    if (kt + 2 < nk) G_STORE(ra0, rb0, 0)
    __syncthreads();
  }
#undef G_LOAD
#undef G_STORE
#undef G_COMPUTE
}
#define EPI_DECL const int tid_ = otid(); const int lane = tid_ & 63, w_ = tid_ >> 6, wm = w_ >> 1, wn = w_ & 1, fr = lane & 31, fh = lane >> 5; (void)fr; (void)fh; (void)wm; (void)wn;
#define EPI_ROW(mi) (wm * 64 + (mi) * 32 + fr)
#define EPI_COL(ni, q) (wn * 64 + (ni) * 32 + 8 * (q) + 4 * fh)
#define MT_LR0(mt, tpb) (((mt) / (tpb)) * NTOK + ((mt) % (tpb)) * 128)


struct TileIter {
  int tm, tn, pw, ph, PN, NP, x, i, it;
  __device__ __forceinline__ TileIter(int tm_, int tn_) : tm(tm_), tn(tn_) {
    pw = tn < 8 ? tn : 8; ph = 32 / pw; PN = (tn + pw - 1) / pw; NP = ((tm + ph - 1) / ph) * PN;
    x = blockIdx.x & 7; i = blockIdx.x >> 3; it = 0;
  }
  __device__ __forceinline__ bool next(int& mt, int& nt, bool& valid) {
    if (gridDim.x != 256) {
      const int t = blockIdx.x + it * gridDim.x; ++it;
      if (t >= tm * tn) return false;
      mt = t / tn; nt = t % tn; valid = true; return true;
    }
    const int P = it * 8 + x; ++it;
    if (P >= NP) return false;
    mt = (P / PN) * ph + i / pw; nt = (P % PN) * pw + i % pw;
    valid = (mt < tm) && (nt < tn);
    return true;
  }
};

template <class F>
__device__ __forceinline__ void transpose_cvt(const float* __restrict__ src, int ld, F srccol, int K, int Ndst, bf16_t* __restrict__ dst, float* smem) {
  float (*T)[65] = (float (*)[65])smem;
  const int tid = otid();
  const int tk = K >> 6, tn = Ndst >> 6;
  for (int t = blockIdx.x; t < tn * tk; t += gridDim.x) {
    const int n0 = (t / tk) * 64, k0 = (t % tk) * 64;
    __syncthreads();
    const int sc = srccol(n0 + (tid & 63));
#pragma unroll
    for (int i = 0; i < 16; ++i) {
      const int ky = (tid >> 6) + 4 * i;
      T[ky][tid & 63] = (sc >= 0) ? src[(size_t)(k0 + ky) * ld + sc] : 0.f;
    }
    __syncthreads();
#pragma unroll
    for (int i = 0; i < 16; ++i) {
      const int ny = (tid >> 6) + 4 * i;
      dst[(size_t)(n0 + ny) * K + k0 + (tid & 63)] = f2bf(T[tid & 63][ny]);
    }
  }
  __syncthreads();
}
__device__ __forceinline__ void fragpack(const float* __restrict__ src, int ld, int K, int N, bf16_t* __restrict__ dst) {
  const int kc = K >> 6, total = (N >> 5) * kc * 256;
  for (int idx = blockIdx.x * 256 + otid(); idx < total; idx += gridDim.x * 256) {
    const int lane = idx & 63, ks = (idx >> 6) & 3, c = (idx >> 8) % kc, nf = (idx >> 8) / kc;
    const int n = 32 * nf + (lane & 31), k0 = 64 * c + 32 * (lane >> 5) + 8 * ks;
    float f[8];
#pragma unroll
    for (int j = 0; j < 8; ++j) f[j] = src[(size_t)(k0 + j) * ld + n];
    *(u32x4*)(dst + (size_t)idx * 8) = (u32x4){pack2(f[0], f[1]), pack2(f[2], f[3]), pack2(f[4], f[5]), pack2(f[6], f[7])};
  }
}
__device__ __forceinline__ int win_srccol(int n) {
  if (n < 3072) return n;
  if (n < 6656) return n + 16;
  if (n < 6672) return n - 3584;
  return -1;
}

__device__ __forceinline__ void stage_init(const Params& p, float* smem) {
  const int tid = otid();
  if (blockIdx.x == 0 && tid < 64) { ((int*)(p.ws + WB_CNT))[tid] = 0; if (tid < 16) ((int*)(p.ws + WB_POOL))[tid] = 0; }
  {
    float* lx = smem + tid * 33;
    int perm[32];
    {
      v16f a, b;
#pragma unroll
      for (int j = 0; j < 16; ++j) { a[j] = (float)(j & 7); b[j] = (float)((j + 16) & 7); }
      const v32f u1 = __builtin_amdgcn_cvt_scalef32_pk32_f32_fp6(__builtin_amdgcn_cvt_scalef32_2xpk16_fp6_f32(a, b, 1.0f), 1.0f);
#pragma unroll
      for (int j = 0; j < 16; ++j) { a[j] = (float)(j >> 3); b[j] = (float)((j + 16) >> 3); }
      const v32f u2 = __builtin_amdgcn_cvt_scalef32_pk32_f32_fp6(__builtin_amdgcn_cvt_scalef32_2xpk16_fp6_f32(a, b, 1.0f), 1.0f);
#pragma unroll
      for (int k = 0; k < 32; ++k) perm[k] = ((int)(u1[k] + 0.5f) + 8 * (int)(u2[k] + 0.5f)) & 31;
    }
    const size_t ngrp = (size_t)2 * 16384 * 32;
    for (size_t i = (size_t)blockIdx.x * 256 + tid; i < 2 * ngrp; i += (size_t)gridDim.x * 256) {
      const bool isv = i >= ngrp;
      const size_t gi = isv ? i - ngrp : i;
      const float4* s4 = (const float4*)((isv ? p.in[I_PV] : p.in[I_PU]) + gi * 32);
      const float sc = isv ? 2.0f : 64.0f;
      float o[32];
#pragma unroll
      for (int q = 0; q < 8; ++q) { const float4 t = s4[q]; o[4 * q] = t.x * sc; o[4 * q + 1] = t.y * sc; o[4 * q + 2] = t.z * sc; o[4 * q + 3] = t.w * sc; }
#pragma unroll
      for (int k = 0; k < 32; ++k) lx[perm[k]] = o[k];
      v16f a, b;
#pragma unroll
      for (int j = 0; j < 16; ++j) { a[j] = lx[j]; b[j] = lx[16 + j]; }
      const v6u pk = __builtin_amdgcn_cvt_scalef32_2xpk16_fp6_f32(a, b, 1.0f);
      u32x2* d = (u32x2*)(p.ws + (isv ? WB_V16 : WB_U16) + gi * 24);
      d[0] = (u32x2){pk[0], pk[1]}; d[1] = (u32x2){pk[2], pk[3]}; d[2] = (u32x2){pk[4], pk[5]};
    }
    __syncthreads();
  }
  {
    float2* rt = (float2*)(p.ws + WB_ROPE);
    for (int i = blockIdx.x * 256 + tid; i < NLAT * 32; i += gridDim.x * 256) {
      const int pos = i >> 5, j = i & 31;
      const float inv = powf(10000.0f, -(float)(j & 15) / 16.0f);
      const float ang = (float)((j < 16) ? (pos >> 6) : (pos & 63)) * inv;
      rt[i] = make_float2(cosf(ang), sinf(ang));
    }
  }
  {
    float* sc = smem;
    float* red = smem + 9 * 1024;
    for (int i = tid; i < 9 * 1024; i += 256) {
      int r = i >> 10, k = i & 1023;
      float v = (r < 8) ? p.in[I_C][r * 1024 + k] : p.in[I_CCTX][k];
      sc[i] = siluf_(v);
    }
    __syncthreads();
    float* mod = (float*)(p.ws + WB_MOD);
    const int jc = tid & 63, ksl = tid >> 6;
    for (int cb = blockIdx.x; cb < 2 * 6144 / 64; cb += gridDim.x) {
      const int col = cb * 64 + jc;
      const int l = col / 6144, j = col % 6144;
      const float* w = p.in[I_WMOD] + (size_t)l * 1024 * 6144 + j;
      float acc[9];
#pragma unroll
      for (int r = 0; r < 9; ++r) acc[r] = 0.f;
#pragma unroll 8
      for (int k = ksl * 256; k < ksl * 256 + 256; ++k) {
        const float wv = w[(size_t)k * 6144];
#pragma unroll
        for (int r = 0; r < 9; ++r) acc[r] = fmaf(sc[r * 1024 + k], wv, acc[r]);
      }
      __syncthreads();
#pragma unroll
      for (int r = 0; r < 9; ++r) red[(ksl * 64 + jc) * 9 + r] = acc[r];
      __syncthreads();
      if (ksl == 0) {
        const float bv = p.in[I_BMOD][l * 6144 + j];
#pragma unroll
        for (int r = 0; r < 9; ++r)
          mod[((size_t)l * 9 + r) * 6144 + j] = red[jc * 9 + r] + red[(64 + jc) * 9 + r] + red[(128 + jc) * 9 + r] + red[(192 + jc) * 9 + r] + bv;
      }
    }
    __syncthreads();
  }
  bf16_t* WT = (bf16_t*)(p.ws + WB_WT);
  for (int l = 0; l < 2; ++l) {
    bf16_t* W = WT + (size_t)l * WT_LAYER;
    transpose_cvt(p.in[I_WIN] + (size_t)l * DM * INW, INW, [](int n) { return win_srccol(n); }, DM, 6784, W + WT_WIN, smem);
    for (int h = 0; h < 4; ++h) {
      transpose_cvt(p.in[I_MLWQ] + ((size_t)l * 4 + h) * 16384, 128, [](int n) { return n; }, 128, 128, W + WT_WQK + (size_t)h * 256 * 128, smem);
      transpose_cvt(p.in[I_MLWK] + ((size_t)l * 4 + h) * 16384, 128, [](int n) { return n; }, 128, 128, W + WT_WQK + (size_t)h * 256 * 128 + 128 * 128, smem);
    }
    fragpack(p.in[I_GLUW] + (size_t)l * 512 * 512, 512, 512, 512, W + WT_GLU);
    for (int r = 0; r < 3; ++r) fragpack(p.in[I_WBR] + ((size_t)l * 3 + r) * 512 * DM, DM, 512, DM, W + WT_WBR + (size_t)r * 1024 * 512);
    fragpack(p.in[I_WOUT] + (size_t)l * DM * DM, DM, DM, DM, W + WT_WOUT);
    transpose_cvt(p.in[I_PWQ] + (size_t)l * DM * 2048, 2048, [](int n) { return n; }, DM, 2048, W + WT_WQ, smem);
    const float* sk = p.in[I_PSUBK] + (size_t)l * 2 * 128 * 128;
    for (int i = blockIdx.x * 256 + tid; i < 2 * 128 * 128; i += gridDim.x * 256) W[WT_SUBK + i] = f2bf(sk[i]);
  }
}

__device__ __forceinline__ void stage_normmod(const Params& p, int l, int g, int which, int rr_lim, bf16_t* H, float* smem) {
  const int tid = otid(), w = tid >> 6, lane = tid & 63;
  const float* ng = p.in[which ? I_N2G : I_N1G] + l * DM;
  const float* mod = (const float*)(p.ws + WB_MOD) + (size_t)l * 9 * 6144;
  const int off_sh = which ? 3072 : 0, off_sc = which ? 4096 : 1024;
  const int n = GB * rr_lim;
  for (int i0 = (blockIdx.x * 4 + w) * 2; i0 < n; i0 += gridDim.x * 8) {
    float4 v[2][4];
    int bl[2], rr[2];
#pragma unroll
    for (int u = 0; u < 2; ++u) {
      const int i = (i0 + u < n) ? i0 + u : i0;
      bl[u] = i / rr_lim; rr[u] = i % rr_lim;
      const float4* X = (const float4*)((l == 0 && which == 0) ? xrow_in(p, g * GB + bl[u], rr[u]) : xrow(p, g * GB + bl[u], rr[u]));
#pragma unroll
      for (int q = 0; q < 4; ++q) v[u][q] = X[q * 64 + lane];
    }
#pragma unroll
    for (int u = 0; u < 2; ++u) {
      if (i0 + u >= n) break;
      float s = 0.f;
#pragma unroll
      for (int q = 0; q < 4; ++q) s += v[u][q].x * v[u][q].x + v[u][q].y * v[u][q].y + v[u][q].z * v[u][q].z + v[u][q].w * v[u][q].w;
      s = wave_sum(s);
      const float rs = rsqrtf(s * (1.0f / DM) + EPSF);
      const float* m = mod + (size_t)((rr[u] < NLAT) ? (g * GB + bl[u]) : 8) * 6144;
      u32x2* hp = (u32x2*)(H + ((size_t)bl[u] * NTOK + rr[u]) * DM);
#pragma unroll
      for (int q = 0; q < 4; ++q) {
        const float4 gg = ((const float4*)ng)[q * 64 + lane];
        const float4 sc = ((const float4*)(m + off_sc))[q * 64 + lane];
        const float4 sh = ((const float4*)(m + off_sh))[q * 64 + lane];
        const float4 x = v[u][q];
        hp[q * 64 + lane] = (u32x2){pack2(x.x * rs * gg.x * (1.f + sc.x) + sh.x, x.y * rs * gg.y * (1.f + sc.y) + sh.y),
                                    pack2(x.z * rs * gg.z * (1.f + sc.z) + sh.z, x.w * rs * gg.w * (1.f + sc.w) + sh.w)};
      }
    }
  }
}

__device__ __forceinline__ void stage_inproj(const Params& p, const bf16_t* H, const bf16_t* WinT, bf16_t* Z, float* MGT, bf16_t* VT, bf16_t* MVT, char* smem) {
  EPI_DECL
  const int tm = GB * 34, tn = 53;
  const float2* rt = (const float2*)(p.ws + WB_ROPE);
  TileIter ti(tm, tn);
  int mt, j; bool valid;
  while (ti.next(mt, j, valid)) {
    if (!valid) continue;
    const int n0 = j * 128;
    const int lr0 = MT_LR0(mt, 34), rr0 = (mt % 34) * 128;
    f32x16 acc[2][2];
    if ((j >= 8 && j < 12) || (j >= 16 && j < 20)) {
      gemm_tile(WinT + (size_t)n0 * DM, DM, H + (size_t)lr0 * DM, DM, DM, smem, acc);
      bf16_t* vt = ((j < 12) ? VT : MVT) + ((size_t)(mt / 34) * 4 + (j & 3)) * 128 * NTOK;
#pragma unroll
      for (int mi = 0; mi < 2; ++mi)
#pragma unroll
        for (int ni = 0; ni < 2; ++ni)
#pragma unroll
          for (int q = 0; q < 4; ++q) {
            const int e = EPI_ROW(mi), tok = rr0 + EPI_COL(ni, q);
            *(u32x2*)(vt + (size_t)e * NTOK + tok) = (u32x2){pack2(acc[mi][ni][4 * q], acc[mi][ni][4 * q + 1]), pack2(acc[mi][ni][4 * q + 2], acc[mi][ni][4 * q + 3])};
          }
      continue;
    }
    gemm_tile(H + (size_t)lr0 * DM, DM, WinT + (size_t)n0 * DM, DM, DM, smem, acc);
    if (j < 8 && rr0 < NLAT) {
#pragma unroll
      for (int mi = 0; mi < 2; ++mi) {
        const int pos = rr0 + EPI_ROW(mi);
#pragma unroll
        for (int i = 0; i < 16; ++i) {
          const int jj = 8 * (i >> 2) + 4 * fh + (i & 3);
          const float2 cs = rt[pos * 32 + jj];
          const float x1 = acc[mi][0][i], x2 = acc[mi][1][i];
          acc[mi][0][i] = x1 * cs.x - x2 * cs.y;
          acc[mi][1][i] = x1 * cs.y + x2 * cs.x;
        }
      }
    }
    if (j < 52) {
      const bool sg = (j >= 28);
#pragma unroll
      for (int mi = 0; mi < 2; ++mi)
#pragma unroll
        for (int ni = 0; ni < 2; ++ni)
#pragma unroll
          for (int q = 0; q < 4; ++q) {
            const int row = lr0 + EPI_ROW(mi), c = n0 + EPI_COL(ni, q);
            float v0 = acc[mi][ni][4 * q], v1 = acc[mi][ni][4 * q + 1], v2 = acc[mi][ni][4 * q + 2], v3 = acc[mi][ni][4 * q + 3];
            if (sg) { v0 = sigmoidf_(v0); v1 = sigmoidf_(v1); v2 = sigmoidf_(v2); v3 = sigmoidf_(v3); }
            *(u32x2*)(Z + (size_t)row * ZW + c) = (u32x2){pack2(v0, v1), pack2(v2, v3)};
          }
    } else {
#pragma unroll
      for (int mi = 0; mi < 2; ++mi)
#pragma unroll
        for (int q = 0; q < 2; ++q) {
          const int row = lr0 + EPI_ROW(mi), c = EPI_COL(0, q);
          if (wn == 0) *(float4*)(MGT + (size_t)row * 16 + c) = make_float4(acc[mi][0][4 * q], acc[mi][0][4 * q + 1], acc[mi][0][4 * q + 2], acc[mi][0][4 * q + 3]);
        }
    }
  }
}

__device__ __forceinline__ void stage_conv(const Params& p, int l, const bf16_t* Z, bf16_t* XC) {
  const int tid = otid();
  const float* cw = p.in[I_CONVW] + (size_t)l * 3 * 512;
  const float* cb = p.in[I_CONVB] + (size_t)l * 512;
  const int c = tid * 2;
  const float2 w0 = *(const float2*)(cw + c), w1 = *(const float2*)(cw + 512 + c), w2 = *(const float2*)(cw + 1024 + c), bb = *(const float2*)(cb + c);
  for (int lr0 = blockIdx.x * 4; lr0 < RPG; lr0 += gridDim.x * 4) {
    unsigned xc[4], xp[4], xn[4];
#pragma unroll
    for (int u = 0; u < 4; ++u) {
      const int lr = lr0 + u, rr = lr % NTOK;
      const bool has_prev = (rr < NLAT) ? (rr > 0) : (rr > NLAT);
      const bool has_next = (rr < NLAT) ? (rr < NLAT - 1) : (rr < NTOK - 1);
      const bf16_t* z = Z + (size_t)lr * ZW + 1536 + c;
      xc[u] = *(const unsigned*)z;
      xp[u] = has_prev ? *(const unsigned*)(z - ZW) : 0u;
      xn[u] = has_next ? *(const unsigned*)(z + ZW) : 0u;
    }
#pragma unroll
    for (int u = 0; u < 4; ++u) {
      const float a0 = bb.x + w1.x * lo16(xc[u]) + w0.x * lo16(xp[u]) + w2.x * lo16(xn[u]);
      const float a1 = bb.y + w1.y * hi16(xc[u]) + w0.y * hi16(xp[u]) + w2.y * hi16(xn[u]);
      *(unsigned*)(XC + (size_t)(lr0 + u) * 512 + c) = pack2(siluf_(a0), siluf_(a1));
    }
  }
}

__device__ __forceinline__ void stage_mlqk(const bf16_t* XC, const bf16_t* WQK, bf16_t* QM, bf16_t* KM, bf16_t* KMT, char* smem) {
  EPI_DECL
  const int tm = RPG >> 7;
  TileIter ti(tm, 12);
  int mt, r12; bool valid;
  while (ti.next(mt, r12, valid)) {
    if (!valid) continue;
    const int h = r12 & 3, kind = r12 >> 2;
    const int m0 = mt * 128;
    f32x16 acc[2][2];
    const bf16_t* Wt = WQK + (size_t)h * 256 * 128 + (size_t)(kind ? 1 : 0) * 128 * 128;
    const bf16_t* Xt = XC + (size_t)m0 * 512 + h * 128;
    if (kind < 2) {
      gemm_tile(Xt, 512, Wt, 128, 128, smem, acc);
      bf16_t* O = kind ? KM : QM;
      const float alpha = kind ? 1.0f : 0.08838834764831845f;
#pragma unroll
      for (int mi = 0; mi < 2; ++mi)
#pragma unroll
        for (int ni = 0; ni < 2; ++ni)
#pragma unroll
          for (int q = 0; q < 4; ++q) {
            const int row = m0 + EPI_ROW(mi), c = EPI_COL(ni, q);
            *(u32x2*)(O + (size_t)row * 512 + h * 128 + c) = (u32x2){pack2(alpha * acc[mi][ni][4 * q], alpha * acc[mi][ni][4 * q + 1]), pack2(alpha * acc[mi][ni][4 * q + 2], alpha * acc[mi][ni][4 * q + 3])};
          }
    } else {
      gemm_tile(Wt, 128, Xt, 512, 128, smem, acc);
      bf16_t* kt = KMT + ((size_t)(mt / 34) * 4 + h) * 128 * NTOK + (mt % 34) * 128;
#pragma unroll
      for (int mi = 0; mi < 2; ++mi)
#pragma unroll
        for (int ni = 0; ni < 2; ++ni)
#pragma unroll
          for (int q = 0; q < 4; ++q) {
            const int d = EPI_ROW(mi), tok = EPI_COL(ni, q);
            *(u32x2*)(kt + (size_t)d * NTOK + tok) = (u32x2){pack2(acc[mi][ni][4 * q], acc[mi][ni][4 * q + 1]), pack2(acc[mi][ni][4 * q + 2], acc[mi][ni][4 * q + 3])};
          }
    }
  }
}

__device__ __forceinline__ void attn_mfma_item(const Params& p, int l, const bf16_t* Zb, const bf16_t* VTb, bf16_t* YAb, int h, int qrow0, int key0, int nkeys,
                                               float lam, float lam_init, char* smem) {
  const int tid = otid(), lane = tid & 63, w = tid >> 6, fr = lane & 31, fh = lane >> 5;
  const int rb = w & 1, m = w >> 1;
  const int ntiles = nkeys >> 6;
  const int myrow = qrow0 + rb * 32 + fr;
  bf16x8 qf[4];
  {
    const bf16_t* qp = Zb + (size_t)myrow * ZW + h * 128 + m * 64 + fh * 8;
#pragma unroll
    for (int ks = 0; ks < 4; ++ks) qf[ks] = *(const bf16x8*)(qp + ks * 16);
  }
  f32x16 O[4];
#pragma unroll
  for (int eb = 0; eb < 4; ++eb)
#pragma unroll
    for (int i = 0; i < 16; ++i) O[eb][i] = 0.f;
  float mrun = -1e30f, lrun = 0.f;
  const float cs = 0.125f * 1.4426950408889634f;
  const int skey = tid >> 4, sch = tid & 15;
  const bf16_t* ksrc = Zb + (size_t)(key0 + skey) * ZW + 512 + h * 128 + sch * 8;
  const int kdst = skey * 256 + ((sch ^ (skey & 15)) << 4);
  const int se = tid >> 3, svc = tid & 7;
  const bf16_t* vsrc = VTb + ((size_t)h * 128 + se) * NTOK + key0 + svc * 8;
  const int vsw = (se >> 1) & 15;
  const int vdst0 = se * 128 + (((2 * svc) ^ vsw) << 3), vdst1 = se * 128 + (((2 * svc + 1) ^ vsw) << 3);
  const int kfo = fr * 256, kfs = fr & 15;
  const int vfo = fr * 128, vfs = (fr >> 1) & 15;
  u32x4 rk[4], rv[4];
#pragma unroll
  for (int i = 0; i < 4; ++i) rk[i] = *(const u32x4*)(ksrc + (size_t)i * 16 * ZW);
  __syncthreads();
#pragma unroll
  for (int i = 0; i < 4; ++i) *(u32x4*)(smem + kdst + i * 4096) = rk[i];
  __syncthreads();
  bf16x8 pf[4];
#define ATT_S(T) { const char* kb_ = smem + ((T) & 1) * 16384; _Pragma("unroll") for (int kb = 0; kb < 2; ++kb) { \
      _Pragma("unroll") for (int i = 0; i < 16; ++i) S[kb][i] = 0.f; \
      _Pragma("unroll") for (int ks = 0; ks < 4; ++ks) { \
        const bf16x8 kf = *(const bf16x8*)(kb_ + kb * 8192 + kfo + (((m * 8 + ks * 2 + fh) ^ kfs) << 4)); \
        S[kb] = __builtin_amdgcn_mfma_f32_32x32x16_bf16(kf, qf[ks], S[kb], 0, 0, 0); } } }
#define ATT_MAX() { float tm = S[0][0]; \
      _Pragma("unroll") for (int i = 1; i < 16; ++i) tm = fmaxf(tm, S[0][i]); \
      _Pragma("unroll") for (int i = 0; i < 16; ++i) tm = fmaxf(tm, S[1][i]); \
      tm = fmaxf(tm, __shfl_xor(tm, 32)) * cs; alpha = 1.f; \
      if (tm > mrun + 8.0f) { alpha = __builtin_amdgcn_exp2f(mrun - tm); mrun = tm; } }
#define ATT_EXP(PF) { const float mc = mrun; float rs = 0.f; \
      _Pragma("unroll") for (int kb = 0; kb < 2; ++kb) { float pv[16]; \
        _Pragma("unroll") for (int i = 0; i < 16; ++i) { pv[i] = __builtin_amdgcn_exp2f(fmaf(S[kb][i], cs, -mc)); rs += pv[i]; } \
        _Pragma("unroll") for (int hh = 0; hh < 2; ++hh) \
          PF[kb * 2 + hh] = __builtin_bit_cast(bf16x8, (u32x4){pack2(pv[8 * hh], pv[8 * hh + 1]), pack2(pv[8 * hh + 2], pv[8 * hh + 3]), \
                                                               pack2(pv[8 * hh + 4], pv[8 * hh + 5]), pack2(pv[8 * hh + 6], pv[8 * hh + 7])}); } \
      lrun += rs; }
#define ATT_PV(T) { const char* vb_ = smem + 32768 + ((T) & 1) * 16384; _Pragma("unroll") for (int eb = 0; eb < 4; ++eb) _Pragma("unroll") for (int s = 0; s < 4; ++s) { \
        const u32x2 v0 = *(const u32x2*)(vb_ + eb * 4096 + vfo + (((4 * s + fh) ^ vfs) << 3)); \
        const u32x2 v1 = *(const u32x2*)(vb_ + eb * 4096 + vfo + (((4 * s + fh + 2) ^ vfs) << 3)); \
        const bf16x8 vf = __builtin_bit_cast(bf16x8, (u32x4){v0[0], v0[1], v1[0], v1[1]}); \
        O[eb] = __builtin_amdgcn_mfma_f32_32x32x16_bf16(vf, pf[s], O[eb], 0, 0, 0); } }
  f32x16 S[2];
  float alpha;
  {
#pragma unroll
    for (int i = 0; i < 4; ++i) rk[i] = *(const u32x4*)(ksrc + (size_t)(64 + i * 16) * ZW);
#pragma unroll
    for (int i = 0; i < 4; ++i) rv[i] = *(const u32x4*)(vsrc + (size_t)i * 32 * NTOK);
    ATT_S(0)
    ATT_MAX()
    ATT_EXP(pf)
#pragma unroll
    for (int i = 0; i < 4; ++i) *(u32x4*)(smem + 16384 + kdst + i * 4096) = rk[i];
#pragma unroll
    for (int i = 0; i < 4; ++i) {
      *(u32x2*)(smem + 32768 + vdst0 + i * 4096) = (u32x2){rv[i][0], rv[i][1]};
      *(u32x2*)(smem + 32768 + vdst1 + i * 4096) = (u32x2){rv[i][2], rv[i][3]};
    }
    __syncthreads();
  }
#pragma unroll 1
  for (int t = 1; t < ntiles; ++t) {
    const int tn = (t + 1 < ntiles) ? t + 1 : t;
#pragma unroll
    for (int i = 0; i < 4; ++i) rk[i] = *(const u32x4*)(ksrc + (size_t)(tn * 64 + i * 16) * ZW);
#pragma unroll
    for (int i = 0; i < 4; ++i) rv[i] = *(const u32x4*)(vsrc + (size_t)i * 32 * NTOK + t * 64);
    ATT_S(t)
    ATT_MAX()
    if (__any(alpha != 1.f)) {
#pragma unroll
      for (int eb = 0; eb < 4; ++eb)
#pragma unroll
        for (int i = 0; i < 16; ++i) O[eb][i] *= alpha;
      lrun *= alpha;
#pragma unroll
      for (int s = 0; s < 4; ++s) {
        const u32x4 r_ = __builtin_bit_cast(u32x4, pf[s]);
        pf[s] = __builtin_bit_cast(bf16x8, (u32x4){pack2(lo16(r_[0]) * alpha, hi16(r_[0]) * alpha), pack2(lo16(r_[1]) * alpha, hi16(r_[1]) * alpha),
                                                   pack2(lo16(r_[2]) * alpha, hi16(r_[2]) * alpha), pack2(lo16(r_[3]) * alpha, hi16(r_[3]) * alpha)});
      }
    }
    bf16x8 pn[4];
    {
      ATT_PV(t - 1)
      ATT_EXP(pn)
#pragma unroll
      for (int i = 0; i < 16; ++i) {
        __builtin_amdgcn_sched_group_barrier(0x100, 1, 0);
        __builtin_amdgcn_sched_group_barrier(0x008, 1, 0);
        __builtin_amdgcn_sched_group_barrier(0x002, 9, 0);
      }
    }
#pragma unroll
    for (int s = 0; s < 4; ++s) pf[s] = pn[s];
    if (t + 1 < ntiles) {
      char* kd = smem + ((t + 1) & 1) * 16384;
#pragma unroll
      for (int i = 0; i < 4; ++i) *(u32x4*)(kd + kdst + i * 4096) = rk[i];
    }
    {
      char* vd = smem + 32768 + (t & 1) * 16384;
#pragma unroll
      for (int i = 0; i < 4; ++i) {
        *(u32x2*)(vd + vdst0 + i * 4096) = (u32x2){rv[i][0], rv[i][1]};
        *(u32x2*)(vd + vdst1 + i * 4096) = (u32x2){rv[i][2], rv[i][3]};
      }
    }
    __syncthreads();
  }
  ATT_PV(ntiles - 1)
  __syncthreads();
#undef ATT_S
#undef ATT_MAX
#undef ATT_EXP
#undef ATT_PV
  const float lt = lrun + __shfl_xor(lrun, 32);
  const float sc = (m ? lam : 1.0f) / lt;
  float* xo = (float*)smem + rb * 4096;
  if (m == 1) {
#pragma unroll
    for (int eb = 0; eb < 4; ++eb)
#pragma unroll
      for (int i = 0; i < 16; ++i) xo[(eb * 32 + (i & 3) + 8 * (i >> 2) + 4 * fh) * 32 + fr] = O[eb][i] * sc;
  }
  __syncthreads();
  if (m == 0) {
    float ss = 0.f;
#pragma unroll
    for (int eb = 0; eb < 4; ++eb)
#pragma unroll
      for (int i = 0; i < 16; ++i) {
        const float o = O[eb][i] * sc - xo[(eb * 32 + (i & 3) + 8 * (i >> 2) + 4 * fh) * 32 + fr];
        O[eb][i] = o; ss = fmaf(o, o, ss);
      }
    ss += __shfl_xor(ss, 32);
    const float rn = rsqrtf(ss * (1.0f / 128.0f) + EPSF) * (1.0f - lam_init);
    const float* sg = p.in[I_SUBG] + l * 512 + h * 128;
    bf16_t* yp = YAb + (size_t)myrow * 512 + h * 128;
#pragma unroll
    for (int eb = 0; eb < 4; ++eb)
#pragma unroll
      for (int q = 0; q < 4; ++q) {
        const int e = eb * 32 + 8 * q + 4 * fh;
        const float4 g = *(const float4*)(sg + e);
        *(u32x2*)(yp + e) = (u32x2){pack2(O[eb][4 * q] * rn * g.x, O[eb][4 * q + 1] * rn * g.y), pack2(O[eb][4 * q + 2] * rn * g.z, O[eb][4 * q + 3] * rn * g.w)};
      }
  }
  __syncthreads();
}

__device__ __forceinline__ int mlstm_row0(int dir, int c) {
  return (dir == 0) ? ((c < 4) ? NLAT + 64 * c : 64 * (c - 4)) : ((c < 4) ? NLAT + 64 * (3 - c) : 64 * (67 - c));
}
__device__ __forceinline__ void stage_mlgates(const Params& p, int l, const float* MGT, float* GA) {
  const int tid = otid(), w = tid >> 6, lane = tid & 63;
  const int nitems = GB * 4 * 2 * 68;
  for (int idx = blockIdx.x * 4 + w; idx < nitems; idx += gridDim.x * 4) {
    const int c = idx % 68, r1 = idx / 68, dir = r1 & 1, h = (r1 >> 1) & 3, bl = r1 >> 3;
    const int row = mlstm_row0(dir, c) + lane;
    const float* mg = MGT + ((size_t)bl * NTOK + row) * 16;
    const float li = mg[dir * 8 + h] + p.in[I_GATEB][l * 16 + dir * 8 + h];
    const float x = mg[dir * 8 + 4 + h] + p.in[I_GATEB][l * 16 + dir * 8 + 4 + h];
    const float lf = fminf(x, 0.f) - log1pf(expf(-fabsf(x)));
    float b = lf;
#pragma unroll
    for (int o = 1; o < 64; o <<= 1) {
      const float v = (dir == 0) ? __shfl_up(b, o) : __shfl_down(b, o);
      const bool ok = (dir == 0) ? (lane >= o) : (lane + o < 64);
      if (ok) b += v;
    }
    const float tot = (dir == 0) ? __shfl(b, 63) : __shfl(b, 0);
    float* ga = GA + (size_t)idx * 272;
    ga[lane] = b * 1.4426950408889634f; ga[64 + lane] = (li - b) * 1.4426950408889634f; ga[128 + lane] = expf(tot + li - b); ga[192 + lane] = expf(b);
    if (lane < 4) ga[256 + lane] = expf(tot);
  }
}

__device__ __forceinline__ void mlstm_chain_item(const Params& p, int l, const bf16_t* QMb, const bf16_t* KMb, const bf16_t* KMTb, const bf16_t* MVTb,
                                                 const float* GAc, bf16_t* HXb, int h, int dir, int ehalf, char* smem) {
  const int tid = otid(), lane = tid & 63, w = tid >> 6, fr = lane & 31, fh = lane >> 5;
  const int tb = w & 1, xb = w >> 1;
  float* fl = (float*)(smem + 73728);
  float* bs = fl; float* as_ = fl + 64; float* wgs = fl + 128; float* ebs = fl + 192; float* dec_s = fl + 256; float* nprev = fl + 272; float* npart = fl + 400;
  f32x16 CT[2];
#pragma unroll
  for (int eb = 0; eb < 2; ++eb)
#pragma unroll
    for (int i = 0; i < 16; ++i) CT[eb][i] = 0.f;
  __syncthreads();
  for (int i = tid; i < 1024; i += 256) ((u32x4*)(smem + 57344))[i] = (u32x4){0u, 0u, 0u, 0u};
  if (tid < 128) nprev[tid] = 0.f;
  const int qr = tid >> 4, qc = tid & 15;
  const int qdst = qr * 256 + ((qc ^ (qr & 15)) << 4);
  const int tr = tid >> 3, tc = tid & 7;
  const int tdst = tr * 128 + ((tc ^ ((tr >> 1) & 7)) << 4);
  const int sw16 = fr & 15, sw8 = (fr >> 1) & 7;
  u32x4 ra[4], rb[4], rc[4], rd[2];
  float4 rg = make_float4(0.f, 0.f, 0.f, 0.f);
#define ML_LOAD(C_) { const int r0_ = mlstm_row0(dir, (C_)); \
    const bf16_t* qs = QMb + (size_t)(r0_ + qr) * 512 + h * 128 + qc * 8; \
    const bf16_t* ks = KMb + (size_t)(r0_ + qr) * 512 + h * 128 + qc * 8; \
    const bf16_t* kts = KMTb + ((size_t)h * 128 + tr) * NTOK + r0_ + tc * 8; \
    const bf16_t* vts = MVTb + ((size_t)h * 128 + ehalf * 64 + tr) * NTOK + r0_ + tc * 8; \
    _Pragma("unroll") for (int i = 0; i < 4; ++i) { ra[i] = *(const u32x4*)(qs + (size_t)i * 16 * 512); rb[i] = *(const u32x4*)(ks + (size_t)i * 16 * 512); \
                                                    rc[i] = *(const u32x4*)(kts + (size_t)i * 32 * NTOK); } \
    _Pragma("unroll") for (int i = 0; i < 2; ++i) rd[i] = *(const u32x4*)(vts + (size_t)i * 32 * NTOK); \
    if (tid < 68) rg = ((const float4*)(GAc + (size_t)(C_) * 272))[tid]; }
  ML_LOAD(0)
#pragma unroll 1
  for (int c = 0; c < 68; ++c) {
    const int row0 = mlstm_row0(dir, c);
    __syncthreads();
#pragma unroll
    for (int i = 0; i < 4; ++i) {
      *(u32x4*)(smem + qdst + i * 4096) = ra[i];
      *(u32x4*)(smem + 16384 + qdst + i * 4096) = rb[i];
      *(u32x4*)(smem + 32768 + tdst + i * 4096) = rc[i];
    }
#pragma unroll
    for (int i = 0; i < 2; ++i) *(u32x4*)(smem + 49152 + tdst + i * 4096) = rd[i];
    if (tid < 68) ((float4*)fl)[tid] = rg;
    if (c + 1 < 68) ML_LOAD(c + 1)
    __syncthreads();
    const int t = tb * 32 + fr;
    bf16x8 qf[8];
#pragma unroll
    for (int ks = 0; ks < 8; ++ks) qf[ks] = *(const bf16x8*)(smem + t * 256 + (((ks * 2 + fh) ^ sw16) << 4));
    const float bt = bs[t], ebt = ebs[t];
    f32x16 S[2];
    float dsum = 0.f;
#pragma unroll
    for (int sb = 0; sb < 2; ++sb) {
#pragma unroll
      for (int i = 0; i < 16; ++i) S[sb][i] = 0.f;
      const bool valid = (dir == 0) ? (sb <= tb) : (sb >= tb);
      if (valid) {
#pragma unroll
        for (int ks = 0; ks < 8; ++ks) {
          const bf16x8 kf = *(const bf16x8*)(smem + 16384 + (sb * 32 + fr) * 256 + (((ks * 2 + fh) ^ sw16) << 4));
          S[sb] = __builtin_amdgcn_mfma_f32_32x32x16_bf16(kf, qf[ks], S[sb], 0, 0, 0);
        }
#pragma unroll
        for (int q = 0; q < 4; ++q) {
          const float4 a4 = *(const float4*)(as_ + sb * 32 + 8 * q + 4 * fh);
          const float av[4] = {a4.x, a4.y, a4.z, a4.w};
#pragma unroll
          for (int j = 0; j < 4; ++j) {
            const int s = sb * 32 + 8 * q + 4 * fh + j;
            const bool ok = (dir == 0) ? (s <= t) : (s >= t);
            const float v = ok ? S[sb][4 * q + j] * __builtin_amdgcn_exp2f(bt + av[j]) : 0.f;
            S[sb][4 * q + j] = v;
            dsum += v;
          }
        }
      }
    }
    bf16x8 pf[4];
#pragma unroll
    for (int sb = 0; sb < 2; ++sb)
#pragma unroll
      for (int hh = 0; hh < 2; ++hh)
        pf[sb * 2 + hh] = __builtin_bit_cast(bf16x8, (u32x4){pack2(S[sb][8 * hh], S[sb][8 * hh + 1]), pack2(S[sb][8 * hh + 2], S[sb][8 * hh + 3]),
                                                                 pack2(S[sb][8 * hh + 4], S[sb][8 * hh + 5]), pack2(S[sb][8 * hh + 6], S[sb][8 * hh + 7])});
    float nq = 0.f;
#pragma unroll
    for (int c8 = 0; c8 < 8; ++c8) {
      const u32x4 qv = *(const u32x4*)(smem + t * 256 + (((fh * 8 + c8) ^ sw16) << 4));
      const float4 n0 = *(const float4*)(nprev + fh * 64 + c8 * 8), n1 = *(const float4*)(nprev + fh * 64 + c8 * 8 + 4);
      nq = fmaf(lo16(qv[0]), n0.x, nq); nq = fmaf(hi16(qv[0]), n0.y, nq); nq = fmaf(lo16(qv[1]), n0.z, nq); nq = fmaf(hi16(qv[1]), n0.w, nq);
      nq = fmaf(lo16(qv[2]), n1.x, nq); nq = fmaf(hi16(qv[2]), n1.y, nq); nq = fmaf(lo16(qv[3]), n1.z, nq); nq = fmaf(hi16(qv[3]), n1.w, nq);
    }
    dsum += __shfl_xor(dsum, 32);
    nq += __shfl_xor(nq, 32);
    const float den = dsum + ebt * nq;
    const float inv = 1.0f / fmaxf(fabsf(den), 1.0f);
    {
      f32x16 N;
#pragma unroll
      for (int i = 0; i < 16; ++i) N[i] = 0.f;
#pragma unroll
      for (int ks = 0; ks < 8; ++ks) {
        const bf16x8 cf = *(const bf16x8*)(smem + 57344 + (xb * 32 + fr) * 256 + (((ks * 2 + fh) ^ sw16) << 4));
        N = __builtin_amdgcn_mfma_f32_32x32x16_bf16(cf, qf[ks], N, 0, 0, 0);
      }
#pragma unroll
      for (int i = 0; i < 16; ++i) N[i] *= ebt;
#pragma unroll
      for (int s4 = 0; s4 < 4; ++s4) {
        const bool valid = (dir == 0) ? ((s4 >> 1) <= tb) : ((s4 >> 1) >= tb);
        if (valid) {
          const int u0 = 4 * s4 + fh, u1 = u0 + 2;
          const char* vrow = smem + 49152 + (xb * 32 + fr) * 128;
          const u32x2 v0 = *(const u32x2*)(vrow + (((u0 >> 1) ^ sw8) << 4) + (u0 & 1) * 8);
          const u32x2 v1 = *(const u32x2*)(vrow + (((u1 >> 1) ^ sw8) << 4) + (u1 & 1) * 8);
          const bf16x8 vf = __builtin_bit_cast(bf16x8, (u32x4){v0[0], v0[1], v1[0], v1[1]});
          N = __builtin_amdgcn_mfma_f32_32x32x16_bf16(vf, pf[s4], N, 0, 0, 0);
        }
      }
      bf16_t* hp = HXb + (size_t)(row0 + t) * 512 + h * 128 + (2 * ehalf + xb) * 32 + 4 * fh;
#pragma unroll
      for (int q = 0; q < 4; ++q)
        *(u32x2*)(hp + 8 * q) = (u32x2){pack2(N[4 * q] * inv, N[4 * q + 1] * inv), pack2(N[4 * q + 2] * inv, N[4 * q + 3] * inv)};
    }
    const float decay = *dec_s;
#pragma unroll
    for (int eb = 0; eb < 2; ++eb)
#pragma unroll
      for (int i = 0; i < 16; ++i) CT[eb][i] *= decay;
#pragma unroll
    for (int ks = 0; ks < 4; ++ks) {
      const u32x4 kraw = *(const u32x4*)(smem + 32768 + (w * 32 + fr) * 128 + (((ks * 2 + fh) ^ sw8) << 4));
      const float4 g0 = *(const float4*)(wgs + ks * 16 + 8 * fh), g1 = *(const float4*)(wgs + ks * 16 + 8 * fh + 4);
      const bf16x8 kts = __builtin_bit_cast(bf16x8, (u32x4){pack2(lo16(kraw[0]) * g0.x, hi16(kraw[0]) * g0.y), pack2(lo16(kraw[1]) * g0.z, hi16(kraw[1]) * g0.w),
                                                             pack2(lo16(kraw[2]) * g1.x, hi16(kraw[2]) * g1.y), pack2(lo16(kraw[3]) * g1.z, hi16(kraw[3]) * g1.w)});
#pragma unroll
      for (int eb = 0; eb < 2; ++eb) {
        const bf16x8 vt = *(const bf16x8*)(smem + 49152 + (eb * 32 + fr) * 128 + (((ks * 2 + fh) ^ sw8) << 4));
        CT[eb] = __builtin_amdgcn_mfma_f32_32x32x16_bf16(kts, vt, CT[eb], 0, 0, 0);
      }
    }
    {
      const int d = tid & 127, sh = tid >> 7;
      float a = 0.f;
#pragma unroll 8
      for (int s = sh * 32; s < sh * 32 + 32; ++s) {
        const bf16_t kv = *(const bf16_t*)(smem + 16384 + s * 256 + ((((d >> 3)) ^ (s & 15)) << 4) + (d & 7) * 2);
        a = fmaf(wgs[s], bf2f(kv), a);
      }
      npart[sh * 128 + d] = a;
    }
    __syncthreads();
#pragma unroll
    for (int eb = 0; eb < 2; ++eb)
#pragma unroll
      for (int q = 0; q < 4; ++q)
        *(u32x2*)(smem + 57344 + (eb * 32 + fr) * 256 + ((((w * 4 + q)) ^ sw16) << 4) + 8 * fh) =
            (u32x2){pack2(CT[eb][4 * q], CT[eb][4 * q + 1]), pack2(CT[eb][4 * q + 2], CT[eb][4 * q + 3])};
    if (tid < 128) nprev[tid] = decay * nprev[tid] + npart[tid] + npart[128 + tid];
  }
#undef ML_LOAD
  __syncthreads();
}

#define S5SEG 128
#define S5NSEG 34
__device__ __forceinline__ int s5_row(int dir, int step) {
  return (dir == 0) ? ((step < NCTX) ? NLAT + step : step - NCTX)
                    : ((step < NCTX) ? NLAT + (NCTX - 1 - step) : (NLAT - 1) - (step - NCTX));
}
__device__ __forceinline__ bf16x8 pack8(const float* f) {
  return __builtin_bit_cast(bf16x8, (u32x4){pack2(f[0], f[1]), pack2(f[2], f[3]), pack2(f[4], f[5]), pack2(f[6], f[7])});
}
struct S5M { float abr, abi, a128r, a128i; bf16x8 bbf[4]; };
__device__ __forceinline__ void s5m_setup(const Params& p, int pg, int lane, S5M& m) {
  const int fr = lane & 31, fh = lane >> 5;
  const float dt = expf(p.in[I_S5DT][pg]);
  m.abr = 0.f; m.abi = 0.f; m.a128r = 0.f; m.a128i = 0.f;
#pragma unroll
  for (int c = 0; c < 2; ++c) {
    const int n = fr + 32 * c;
    const float lre = p.in[I_S5LRE][pg * 64 + n], lim = p.in[I_S5LIM][pg * 64 + n];
    const float mag = expf(lre * dt);
    const float abr = mag * cosf(lim * dt), abi = mag * sinf(lim * dt);
    const float den = lre * lre + lim * lim;
    const float zr = ((abr - 1.0f) * lre + abi * lim) / den;
    const float zi = (abi * lre - (abr - 1.0f) * lim) / den;
    const float4* br4 = (const float4*)(p.in[I_S5BRE] + ((size_t)pg * 64 + n) * 16 + 8 * fh);
    const float4* bi4 = (const float4*)(p.in[I_S5BIM] + ((size_t)pg * 64 + n) * 16 + 8 * fh);
    const float4 b0 = br4[0], b1 = br4[1], c0 = bi4[0], c1 = bi4[1];
    const float br[8] = {b0.x, b0.y, b0.z, b0.w, b1.x, b1.y, b1.z, b1.w}, bi[8] = {c0.x, c0.y, c0.z, c0.w, c1.x, c1.y, c1.z, c1.w};
    float rr[8], ii[8];
#pragma unroll
    for (int j = 0; j < 8; ++j) { rr[j] = zr * br[j] - zi * bi[j]; ii[j] = zr * bi[j] + zi * br[j]; }
    m.bbf[c] = pack8(rr); m.bbf[2 + c] = pack8(ii);
    if (fh == c) {
      m.abr = abr; m.abi = abi;
      const float mg = expf(lre * dt * (float)S5SEG);
      m.a128r = mg * cosf(lim * dt * (float)S5SEG); m.a128i = mg * sinf(lim * dt * (float)S5SEG);
    }
  }
}
template <bool STORE>
__device__ __forceinline__ void s5m_block(const S5M& m, const bf16x8 uf, float& xr, float& xi, char* xs, int lane) {
  f32x16 T[4];
#pragma unroll
  for (int k = 0; k < 4; ++k) {
#pragma unroll
    for (int i = 0; i < 16; ++i) T[k][i] = 0.f;
    T[k] = __builtin_amdgcn_mfma_f32_32x32x16_bf16(uf, m.bbf[k], T[k], 0, 0, 0);
  }
#pragma unroll
  for (int r = 0; r < 16; ++r) {
    auto a = __builtin_amdgcn_permlane32_swap(__float_as_uint(T[0][r]), __float_as_uint(T[1][r]), false, false);
    T[0][r] = __uint_as_float(a[0]); T[1][r] = __uint_as_float(a[1]);
    auto b = __builtin_amdgcn_permlane32_swap(__float_as_uint(T[2][r]), __float_as_uint(T[3][r]), false, false);
    T[2][r] = __uint_as_float(b[0]); T[3][r] = __uint_as_float(b[1]);
  }
#pragma unroll
  for (int q = 0; q < 4; ++q)
#pragma unroll
    for (int hh = 0; hh < 2; ++hh)
#pragma unroll
      for (int j = 0; j < 4; ++j) {
        const int t = 8 * q + 4 * hh + j, r = 4 * q + j;
        const float bre = hh ? T[1][r] : T[0][r], bim = hh ? T[3][r] : T[2][r];
        const float nr = fmaf(m.abr, xr, fmaf(-m.abi, xi, bre));
        const float ni = fmaf(m.abr, xi, fmaf(m.abi, xr, bim));
        xr = nr; xi = ni;
        if (STORE) *(unsigned*)(xs + t * 256 + (((lane >> 2) ^ (t & 15)) << 4) + (lane & 3) * 4) = pack2(xr, xi);
      }
}
__device__ __forceinline__ void stage_s5_pass1(const Params& p, int l, const bf16_t* Z, float* XE) {
  const int tid = otid(), w = tid >> 6, lane = tid & 63, fr = lane & 31, fh = lane >> 5;
  const int nitems = GB * 32 * 2 * (S5NSEG - 1);
  for (int idx = blockIdx.x * 4 + w; idx < nitems; idx += gridDim.x * 4) {
    const int seg = idx % (S5NSEG - 1), r1 = idx / (S5NSEG - 1), dir = r1 & 1, g = (r1 >> 1) & 31, bl = r1 >> 6;
    S5M m;
    s5m_setup(p, (l * 2 + dir) * 32 + g, lane, m);
    float xr = 0.f, xi = 0.f;
    bf16x8 ufs[S5SEG / 32];
#pragma unroll
    for (int sub = 0; sub < S5SEG / 32; ++sub) {
      const int row = s5_row(dir, seg * S5SEG + sub * 32 + fr);
      ufs[sub] = *(const bf16x8*)(Z + ((size_t)bl * NTOK + row) * ZW + 3072 + g * 16 + 8 * fh);
    }
#pragma unroll
    for (int sub = 0; sub < S5SEG / 32; ++sub) s5m_block<false>(m, ufs[sub], xr, xi, nullptr, lane);
    float* xe = XE + ((((size_t)bl * 32 + g) * 2 + dir) * (S5NSEG - 1) + seg) * 128;
    xe[lane] = xr; xe[64 + lane] = xi;
  }
}
__device__ __forceinline__ void s5_item(const Params& p, int l, const bf16_t* Zb, const float* XEc, float* Yb, int g, int dir, int sq, char* smem) {
  const int tid = otid(), w = tid >> 6, lane = tid & 63, fr = lane & 31, fh = lane >> 5;
  const int seg = sq * 4 + w;
  char* xs = smem + w * 8192;
  const int pg = (l * 2 + dir) * 32 + g;
  __syncthreads();
  if (seg < S5NSEG) {
    S5M m;
    s5m_setup(p, pg, lane, m);
    bf16x8 ccf[8];
#pragma unroll
    for (int ks = 0; ks < 8; ++ks) {
      float f[8] = {0.f, 0.f, 0.f, 0.f, 0.f, 0.f, 0.f, 0.f};
      if (fr < 16) {
        const float4 cr = *(const float4*)(p.in[I_S5CRE] + ((size_t)pg * 16 + fr) * 64 + ks * 8 + 4 * fh);
        const float4 ci = *(const float4*)(p.in[I_S5CIM] + ((size_t)pg * 16 + fr) * 64 + ks * 8 + 4 * fh);
        f[0] = cr.x; f[1] = -ci.x; f[2] = cr.y; f[3] = -ci.y; f[4] = cr.z; f[5] = -ci.z; f[6] = cr.w; f[7] = -ci.w;
      }
      ccf[ks] = pack8(f);
    }
    float xr = 0.f, xi = 0.f;
    for (int j = 0; j < seg; ++j) {
      const float er = XEc[j * 128 + lane], ei = XEc[j * 128 + 64 + lane];
      const float nr = m.a128r * xr - m.a128i * xi + er, ni = m.a128r * xi + m.a128i * xr + ei;
      xr = nr; xi = ni;
    }
    bf16x8 ufs[S5SEG / 32];
#pragma unroll
    for (int sub = 0; sub < S5SEG / 32; ++sub) {
      const int row = s5_row(dir, seg * S5SEG + sub * 32 + fr);
      ufs[sub] = *(const bf16x8*)(Zb + (size_t)row * ZW + 3072 + g * 16 + 8 * fh);
    }
#pragma unroll
    for (int sub = 0; sub < S5SEG / 32; ++sub) {
      const int row = s5_row(dir, seg * S5SEG + sub * 32 + fr);
      const bf16x8 uf = ufs[sub];
      s5m_block<true>(m, uf, xr, xi, xs, lane);
      f32x16 Y;
#pragma unroll
      for (int i = 0; i < 16; ++i) Y[i] = 0.f;
#pragma unroll
      for (int ks = 0; ks < 8; ++ks) {
        const bf16x8 xf = *(const bf16x8*)(xs + fr * 256 + (((ks * 2 + fh) ^ (fr & 15)) << 4));
        Y = __builtin_amdgcn_mfma_f32_32x32x16_bf16(ccf[ks], xf, Y, 0, 0, 0);
      }
      float* yp = Yb + (size_t)row * 512 + g * 16 + 4 * fh;
      *(float4*)yp = make_float4(Y[0], Y[1], Y[2], Y[3]);
      *(float4*)(yp + 8) = make_float4(Y[4], Y[5], Y[6], Y[7]);
    }
  }
}

__device__ __forceinline__ void stage_post(const Params& p, int l, int rr_lim, const bf16_t* Z, const bf16_t* HF, const bf16_t* HB,
                                           const float* YSF, const float* YSB, bf16_t* YB, bf16_t* GG) {
  const int tid = otid();
  const int c0 = tid * 2;
  const float2 gml = *(const float2*)(p.in[I_MLNG] + l * 512 + c0);
  const float2 dsk = *(const float2*)(p.in[I_S5D] + l * 512 + c0);
  const int n = GB * rr_lim;
  for (int i0 = blockIdx.x * 4; i0 < n; i0 += gridDim.x * 4) {
    unsigned a0[4], a1[4], og[4], uu[4];
    float2 f[4], b[4];
    size_t r[4];
#pragma unroll
    for (int u = 0; u < 4; ++u) {
      const int i = i0 + u;
      r[u] = (size_t)(i / rr_lim) * NTOK + (i % rr_lim);
      a0[u] = *(const unsigned*)(HF + r[u] * 512 + c0); a1[u] = *(const unsigned*)(HB + r[u] * 512 + c0);
      og[u] = *(const unsigned*)(Z + r[u] * ZW + 2560 + c0); uu[u] = *(const unsigned*)(Z + r[u] * ZW + 3072 + c0);
      f[u] = *(const float2*)(YSF + r[u] * 512 + c0); b[u] = *(const float2*)(YSB + r[u] * 512 + c0);
    }
#pragma unroll
    for (int u = 0; u < 4; ++u) {
      const float h0 = lo16(a0[u]) + lo16(a1[u]), h1 = hi16(a0[u]) + hi16(a1[u]);
      const float ss = wave_sum(h0 * h0 + h1 * h1);
      const float rs = rsqrtf(ss * (1.0f / 128.0f) + EPSF);
      *(unsigned*)(YB + r[u] * 512 + c0) = pack2(h0 * rs * gml.x * sigmoidf_(lo16(og[u])), h1 * rs * gml.y * sigmoidf_(hi16(og[u])));
      *(unsigned*)(GG + r[u] * 512 + c0) = pack2(geluf_(dsk.x * lo16(uu[u]) + f[u].x + b[u].x), geluf_(dsk.y * hi16(uu[u]) + f[u].y + b[u].y));
    }
  }
}

__device__ __forceinline__ void stage_glu_mfma(const Params& p, int l, int tpb, const bf16_t* GG, const bf16_t* GLUT, bf16_t* YS, char* smem) {
  EPI_DECL
  const int tm = GB * tpb;
  TileIter ti(tm, 4);
  int mt_, nt_; bool valid;
  while (ti.next(mt_, nt_, valid)) {
    if (!valid) continue;
    const int m0 = MT_LR0(mt_, tpb), n0 = nt_ * 128;
    f32x16 acc[2][2];
    gemm_tile(GG + (size_t)m0 * 512, 512, GLUT + (size_t)n0 * 512, 512, 512, smem, acc);
#pragma unroll
    for (int mi = 0; mi < 2; ++mi)
#pragma unroll
      for (int ni = 0; ni < 2; ++ni)
#pragma unroll
        for (int q = 0; q < 4; ++q) {
          const int row = m0 + EPI_ROW(mi), c = n0 + EPI_COL(ni, q);
          const float4 b = *(const float4*)(p.in[I_GLUB] + l * 512 + c);
          const u32x2 g2 = *(const u32x2*)(GG + (size_t)row * 512 + c);
          const float o0 = lo16(g2[0]) * sigmoidf_(acc[mi][ni][4 * q] + b.x), o1 = hi16(g2[0]) * sigmoidf_(acc[mi][ni][4 * q + 1] + b.y);
          const float o2 = lo16(g2[1]) * sigmoidf_(acc[mi][ni][4 * q + 2] + b.z), o3 = hi16(g2[1]) * sigmoidf_(acc[mi][ni][4 * q + 3] + b.w);
          *(u32x2*)(YS + (size_t)row * 512 + c) = (u32x2){pack2(o0, o1), pack2(o2, o3)};
        }
  }
}

__device__ __forceinline__ void stage_merge_mfma(int tpb, const bf16_t* YA, const bf16_t* YB, const bf16_t* YS, const bf16_t* WBR, const bf16_t* Z, bf16_t* MG, char* smem) {
  EPI_DECL
  const int tm = GB * tpb;
  TileIter ti(tm, 8);
  int mt_, nt_; bool valid;
  while (ti.next(mt_, nt_, valid)) {
    if (!valid) continue;
    const int m0 = MT_LR0(mt_, tpb), n0 = nt_ * 128;
    f32x16 macc[2][2];
#pragma unroll
    for (int a = 0; a < 2; ++a)
#pragma unroll
      for (int b = 0; b < 2; ++b)
#pragma unroll
        for (int i = 0; i < 16; ++i) macc[a][b][i] = 0.f;
#pragma unroll 1
    for (int r = 0; r < 3; ++r) {
      const bf16_t* Y = (r == 0) ? YA : (r == 1 ? YB : YS);
      f32x16 acc[2][2];
      gemm_tile(Y + (size_t)m0 * 512, 512, WBR + (size_t)r * 1024 * 512 + (size_t)n0 * 512, 512, 512, smem, acc);
#pragma unroll
      for (int mi = 0; mi < 2; ++mi)
#pragma unroll
        for (int ni = 0; ni < 2; ++ni)
#pragma unroll
          for (int q = 0; q < 4; ++q) {
            const int row = m0 + EPI_ROW(mi), c = n0 + EPI_COL(ni, q);
            const u32x2 e = *(const u32x2*)(Z + (size_t)row * ZW + 3584 + r * 1024 + c);
            macc[mi][ni][4 * q] += lo16(e[0]) * acc[mi][ni][4 * q];
            macc[mi][ni][4 * q + 1] += hi16(e[0]) * acc[mi][ni][4 * q + 1];
            macc[mi][ni][4 * q + 2] += lo16(e[1]) * acc[mi][ni][4 * q + 2];
            macc[mi][ni][4 * q + 3] += hi16(e[1]) * acc[mi][ni][4 * q + 3];
          }
    }
#pragma unroll
    for (int mi = 0; mi < 2; ++mi)
#pragma unroll
      for (int ni = 0; ni < 2; ++ni)
#pragma unroll
        for (int q = 0; q < 4; ++q) {
          const int row = m0 + EPI_ROW(mi), c = n0 + EPI_COL(ni, q);
          *(u32x2*)(MG + (size_t)row * DM + c) = (u32x2){pack2(macc[mi][ni][4 * q], macc[mi][ni][4 * q + 1]), pack2(macc[mi][ni][4 * q + 2], macc[mi][ni][4 * q + 3])};
        }
  }
}

__device__ __forceinline__ void stage_outproj_mfma(const Params& p, int l, int g, int tpb, const bf16_t* MG, const bf16_t* WOUT, char* smem) {
  EPI_DECL
  const int tm = GB * tpb;
  const float* mod = (const float*)(p.ws + WB_MOD) + (size_t)l * 9 * 6144;
  TileIter ti(tm, 8);
  int mt, nt_; bool valid;
  while (ti.next(mt, nt_, valid)) {
    if (!valid) continue;
    const int n0 = nt_ * 128;
    const int m0 = MT_LR0(mt, tpb), bl = mt / tpb, rr0 = (mt % tpb) * 128, b = g * GB + bl;
    f32x16 acc[2][2];
    gemm_tile(MG + (size_t)m0 * DM, DM, WOUT + (size_t)n0 * DM, DM, DM, smem, acc);
    const float* gv = mod + (size_t)((rr0 < NLAT) ? b : 8) * 6144 + 2 * 1024;
#pragma unroll
    for (int mi = 0; mi < 2; ++mi)
#pragma unroll
      for (int ni = 0; ni < 2; ++ni)
#pragma unroll
        for (int q = 0; q < 4; ++q) {
          const int rr = rr0 + EPI_ROW(mi), c = n0 + EPI_COL(ni, q);
          const float4 gg = *(const float4*)(gv + c);
          float4* xp = (float4*)(xrow(p, b, rr) + c);
          float4 x = (l == 0) ? *(const float4*)(xrow_in(p, b, rr) + c) : *xp;
          x.x += gg.x * acc[mi][ni][4 * q]; x.y += gg.y * acc[mi][ni][4 * q + 1]; x.z += gg.z * acc[mi][ni][4 * q + 2]; x.w += gg.w * acc[mi][ni][4 * q + 3];
          *xp = x;
        }
  }
}

#define CH_SW(m_, chunk_) ((((chunk_) ^ ((m_) & 15))) << 4)
template <int KC, class BF, class AF, class PF, class EF>
__device__ __forceinline__ void cphase(const int nseg, const int lane, const bf16_t* __restrict__ Wb, BF bofs, AF abase, PF pre, EF epi) {
  const int half = lane >> 5, sw = lane & 15;
  bf16x8 bs[4][2][4];
  const int S = nseg * KC;
  const int crot = ((blockIdx.x >> 3) * 3 + (lane >> 6) + (otid() >> 6) * 5) & (KC - 1);
#define CH_LD(ST, s_) { const int sg_ = (s_) / KC, c_ = ((s_) + crot) % KC; unsigned o0_ = bofs(sg_) + 4096u * c_ + lane * 16; asm volatile("" : "+v"(o0_)); \
    unsigned o1_ = o0_ + KC * 4096u; asm volatile("" : "+v"(o1_)); \
    _Pragma("unroll") for (int ks_ = 0; ks_ < 4; ++ks_) { bs[ST][0][ks_] = *(const bf16x8*)((const char*)Wb + o0_ + 1024 * ks_); bs[ST][1][ks_] = *(const bf16x8*)((const char*)Wb + o1_ + 1024 * ks_); } }
#define CH_LA(DST, s_) { const int sg_ = (s_) / KC, c_ = ((s_) + crot) % KC; const char* ap_ = abase(sg_); \
    _Pragma("unroll") for (int ks_ = 0; ks_ < 4; ++ks_) DST[ks_] = *(const bf16x8*)(ap_ + (((8 * c_ + 4 * half + ks_) ^ sw) << 4)); }
  CH_LD(0, 0) CH_LD(1, 1) CH_LD(2, 2)
  bf16x8 ac[4];
  CH_LA(ac, 0)
  f32x16 acc[2];
#pragma unroll
  for (int f = 0; f < 2; ++f)
#pragma unroll
    for (int i = 0; i < 16; ++i) acc[f][i] = 0.f;
#pragma unroll 1
  for (int s0 = 0; s0 < S; s0 += 4) {
#pragma unroll
    for (int j = 0; j < 4; ++j) {
      const int s = s0 + j;
      if (s + 3 < S) CH_LD((j + 3) & 3, s + 3)
      bf16x8 an[4];
      { const int sn = (s + 1 < S) ? s + 1 : s; CH_LA(an, sn) }
      const int sg = s / KC, c = s % KC;
#pragma unroll
      for (int ks = 0; ks < 4; ++ks)
#pragma unroll
        for (int f = 0; f < 2; ++f) acc[f] = __builtin_amdgcn_mfma_f32_32x32x16_bf16(bs[j][f][ks], ac[ks], acc[f], 0, 0, 0);
      if (j == 3 && c == KC - 5) pre(sg);
      if (j == 3 && c == KC - 1) {
        epi(sg, acc);
#pragma unroll
        for (int f = 0; f < 2; ++f)
#pragma unroll
          for (int i = 0; i < 16; ++i) acc[f][i] = 0.f;
      }
#pragma unroll
      for (int ks = 0; ks < 4; ++ks) ac[ks] = an[ks];
    }
  }
#undef CH_LD
#undef CH_LA
}

__device__ __forceinline__ void stage_chain1(const Params& p, int l, int g, int rr_lim, const bf16_t* Z, const bf16_t* HF, const bf16_t* HB,
                                             const float* YSF, const float* YSB, const bf16_t* YA, bf16_t* MG, bf16_t* H2, const bf16_t* W, char* smem) {
  const int tid = otid(), w = tid >> 6, lane = tid & 63, m = lane & 31, half = lane >> 5;
  const int tpb32 = rr_lim >> 5, ntile = GB * tpb32;
  const float* mod = (const float*)(p.ws + WB_MOD) + (size_t)l * 9 * 6144;
  const bf16_t* GLUT = W + WT_GLU; const bf16_t* WBR = W + WT_WBR; const bf16_t* WOUT = W + WT_WOUT;
  char* R0 = smem; char* R1 = smem + 32768; char* R2 = smem + 65536;
  const int c0 = tid * 2;
  const float2 gml = *(const float2*)(p.in[I_MLNG] + l * 512 + c0);
  const float2 dsk = *(const float2*)(p.in[I_S5D] + l * 512 + c0);
  const int rot = blockIdx.x >> 3;
  for (int t = blockIdx.x; t < ntile; t += gridDim.x) {
    const int bl = t / tpb32, rr0 = (t % tpb32) * 32, b = g * GB + bl;
    const size_t lr0 = (size_t)bl * NTOK + rr0;
    __syncthreads();
    for (int i0 = 0; i0 < 32; i0 += 8) {
      unsigned a0[8], a1[8], og[8], uu[8];
      float2 f[8], bb[8];
#pragma unroll
      for (int u = 0; u < 8; ++u) {
        const size_t r = lr0 + i0 + u;
        a0[u] = *(const unsigned*)(HF + r * 512 + c0); a1[u] = *(const unsigned*)(HB + r * 512 + c0);
        og[u] = *(const unsigned*)(Z + r * ZW + 2560 + c0); uu[u] = *(const unsigned*)(Z + r * ZW + 3072 + c0);
        f[u] = *(const float2*)(YSF + r * 512 + c0); bb[u] = *(const float2*)(YSB + r * 512 + c0);
      }
#pragma unroll
      for (int u = 0; u < 8; ++u) {
        const float h0 = lo16(a0[u]) + lo16(a1[u]), h1 = hi16(a0[u]) + hi16(a1[u]);
        const float ss = wave_sum(h0 * h0 + h1 * h1);
        const float rs = rsqrtf(ss * (1.0f / 128.0f) + EPSF);
        const int mm = i0 + u, off = mm * 1024 + CH_SW(mm, c0 >> 3) + (c0 & 7) * 2;
        *(unsigned*)(R1 + off) = pack2(h0 * rs * gml.x * sigmoidf_(lo16(og[u])), h1 * rs * gml.y * sigmoidf_(hi16(og[u])));
        *(unsigned*)(R0 + off) = pack2(geluf_(dsk.x * lo16(uu[u]) + f[u].x + bb[u].x), geluf_(dsk.y * hi16(uu[u]) + f[u].y + bb[u].y));
      }
    }
    __syncthreads();
    {
      float4 bv[2][4];
      cphase<8>(2, lane, GLUT,
        [&](int sg) __attribute__((always_inline)) { const int cb = (w * 2 + sg + rot) & 7; return (unsigned)(cb * 2) * (8u * 4096u); },
        [&](int sg) __attribute__((always_inline)) { return (const char*)(R0 + m * 1024); },
        [&](int sg) __attribute__((always_inline)) {
          const int n0 = ((w * 2 + sg + rot) & 7) * 64;
#pragma unroll
          for (int f = 0; f < 2; ++f)
#pragma unroll
            for (int q = 0; q < 4; ++q) bv[f][q] = *(const float4*)(p.in[I_GLUB] + l * 512 + n0 + f * 32 + 8 * q + 4 * half);
        },
        [&](int sg, f32x16 (&acc)[2]) __attribute__((always_inline)) {
          const int n0 = ((w * 2 + sg + rot) & 7) * 64;
#pragma unroll
          for (int f = 0; f < 2; ++f)
#pragma unroll
            for (int q = 0; q < 4; ++q) {
              const int c = n0 + f * 32 + 8 * q + 4 * half;
              const int off = m * 1024 + CH_SW(m, c >> 3) + 8 * half;
              const u32x2 g2 = *(const u32x2*)(R0 + off);
              const float o0 = lo16(g2[0]) * sigmoidf_(acc[f][4 * q] + bv[f][q].x), o1 = hi16(g2[0]) * sigmoidf_(acc[f][4 * q + 1] + bv[f][q].y);
              const float o2 = lo16(g2[1]) * sigmoidf_(acc[f][4 * q + 2] + bv[f][q].z), o3 = hi16(g2[1]) * sigmoidf_(acc[f][4 * q + 3] + bv[f][q].w);
              *(u32x2*)(R2 + off) = (u32x2){pack2(o0, o1), pack2(o2, o3)};
            }
        });
    }
    __syncthreads();
    for (int i = tid; i < 32 * 64; i += 256) {
      const int mm = i >> 6, ch = i & 63;
      *(u32x4*)(R0 + mm * 1024 + CH_SW(mm, ch)) = *(const u32x4*)(YA + (lr0 + mm) * 512 + ch * 8);
    }
    __syncthreads();
    {
      f32x16 macc[2];
#pragma unroll
      for (int f = 0; f < 2; ++f)
#pragma unroll
        for (int i = 0; i < 16; ++i) macc[f][i] = 0.f;
      u32x2 e[2][4];
      const size_t row = lr0 + m;
      cphase<8>(12, lane, WBR,
        [&](int sg) __attribute__((always_inline)) { const int pass = sg / 3, r = sg % 3, cb = (w * 4 + pass + rot) & 15; return (unsigned)r * (1024u * 512u * 2u) + (unsigned)(cb * 2) * (8u * 4096u); },
        [&](int sg) __attribute__((always_inline)) { const int r = sg % 3; return (const char*)(smem + r * 32768 + m * 1024); },
        [&](int sg) __attribute__((always_inline)) {
          const int pass = sg / 3, r = sg % 3, n0 = ((w * 4 + pass + rot) & 15) * 64;
#pragma unroll
          for (int f = 0; f < 2; ++f)
#pragma unroll
            for (int q = 0; q < 4; ++q) e[f][q] = *(const u32x2*)(Z + row * ZW + 3584 + r * 1024 + n0 + f * 32 + 8 * q + 4 * half);
        },
        [&](int sg, f32x16 (&acc)[2]) __attribute__((always_inline)) {
          const int pass = sg / 3, r = sg % 3, n0 = ((w * 4 + pass + rot) & 15) * 64;
#pragma unroll
          for (int f = 0; f < 2; ++f)
#pragma unroll
            for (int q = 0; q < 4; ++q) {
              macc[f][4 * q] += lo16(e[f][q][0]) * acc[f][4 * q];
              macc[f][4 * q + 1] += hi16(e[f][q][0]) * acc[f][4 * q + 1];
              macc[f][4 * q + 2] += lo16(e[f][q][1]) * acc[f][4 * q + 2];
              macc[f][4 * q + 3] += hi16(e[f][q][1]) * acc[f][4 * q + 3];
            }
          if (r == 2) {
#pragma unroll
            for (int f = 0; f < 2; ++f)
#pragma unroll
              for (int q = 0; q < 4; ++q) {
                const int c = n0 + f * 32 + 8 * q + 4 * half;
                *(u32x2*)(MG + row * DM + c) = (u32x2){pack2(macc[f][4 * q], macc[f][4 * q + 1]), pack2(macc[f][4 * q + 2], macc[f][4 * q + 3])};
              }
#pragma unroll
            for (int f = 0; f < 2; ++f)
#pragma unroll
              for (int i = 0; i < 16; ++i) macc[f][i] = 0.f;
          }
        });
    }
    __syncthreads();
    for (int i = tid; i < 32 * 128; i += 256) {
      const int mm = i >> 7, ch = i & 127;
      *(u32x4*)(smem + mm * 2048 + CH_SW(mm, ch)) = *(const u32x4*)(MG + (lr0 + mm) * DM + ch * 8);
    }
    __syncthreads();
    {
      const float* gv = mod + (size_t)((rr0 < NLAT) ? b : 8) * 6144 + 2 * 1024;
      const int rr = rr0 + m;
      float4 xg[2][4], xx[2][4];
      cphase<16>(4, lane, WOUT,
        [&](int sg) __attribute__((always_inline)) { const int cb = (w * 4 + sg + rot) & 15; return (unsigned)(cb * 2) * (16u * 4096u); },
        [&](int sg) __attribute__((always_inline)) { return (const char*)(smem + m * 2048); },
        [&](int sg) __attribute__((always_inline)) {
          const int n0 = ((w * 4 + sg + rot) & 15) * 64;
#pragma unroll
          for (int f = 0; f < 2; ++f)
#pragma unroll
            for (int q = 0; q < 4; ++q) {
              const int c = n0 + f * 32 + 8 * q + 4 * half;
              xg[f][q] = *(const float4*)(gv + c);
              xx[f][q] = (l == 0) ? *(const float4*)(xrow_in(p, b, rr) + c) : *(const float4*)(xrow(p, b, rr) + c);
            }
        },
        [&](int sg, f32x16 (&acc)[2]) __attribute__((always_inline)) {
          const int n0 = ((w * 4 + sg + rot) & 15) * 64;
#pragma unroll
          for (int f = 0; f < 2; ++f)
#pragma unroll
            for (int q = 0; q < 4; ++q) {
              const int c = n0 + f * 32 + 8 * q + 4 * half;
              float4 x = xx[f][q];
              const float4 gg = xg[f][q];
              x.x += gg.x * acc[f][4 * q]; x.y += gg.y * acc[f][4 * q + 1]; x.z += gg.z * acc[f][4 * q + 2]; x.w += gg.w * acc[f][4 * q + 3];
              *(float4*)(xrow(p, b, rr) + c) = x;
            }
        });
    }
    __syncthreads();
    {
      const float* ng = p.in[I_N2G] + l * DM;
      const float* mm_ = mod + (size_t)((rr0 < NLAT) ? b : 8) * 6144;
#pragma unroll 1
      for (int i0 = w * 8; i0 < w * 8 + 8; i0 += 2) {
        float4 v[2][4];
#pragma unroll
        for (int u = 0; u < 2; ++u) {
          const float4* X = (const float4*)xrow(p, b, rr0 + i0 + u);
#pragma unroll
          for (int q = 0; q < 4; ++q) v[u][q] = X[q * 64 + lane];
        }
#pragma unroll
        for (int u = 0; u < 2; ++u) {
          float s = 0.f;
#pragma unroll
          for (int q = 0; q < 4; ++q) s += v[u][q].x * v[u][q].x + v[u][q].y * v[u][q].y + v[u][q].z * v[u][q].z + v[u][q].w * v[u][q].w;
          s = wave_sum(s);
          const float rs = rsqrtf(s * (1.0f / DM) + EPSF);
          u32x2* hp = (u32x2*)(H2 + (lr0 + i0 + u) * DM);
#pragma unroll
          for (int q = 0; q < 4; ++q) {
            const float4 gg = ((const float4*)ng)[q * 64 + lane];
            const float4 sc = ((const float4*)(mm_ + 4096))[q * 64 + lane];
            const float4 sh = ((const float4*)(mm_ + 3072))[q * 64 + lane];
            const float4 x = v[u][q];
            hp[q * 64 + lane] = (u32x2){pack2(x.x * rs * gg.x * (1.f + sc.x) + sh.x, x.y * rs * gg.y * (1.f + sc.y) + sh.y),
                                        pack2(x.z * rs * gg.z * (1.f + sc.z) + sh.z, x.w * rs * gg.w * (1.f + sc.w) + sh.w)};
          }
        }
      }
    }
  }
}

__device__ __forceinline__ void stage_peerq_mfma(int tpb, const bf16_t* H2, const bf16_t* WQ, bf16_t* PQ, char* smem) {
  EPI_DECL
  const int tm = GB * tpb;
  TileIter ti(tm, 16);
  int mt_, nt_; bool valid;
  while (ti.next(mt_, nt_, valid)) {
    if (!valid) continue;
    const int m0 = MT_LR0(mt_, tpb), n0 = nt_ * 128;
    f32x16 acc[2][2];
    gemm_tile(H2 + (size_t)m0 * DM, DM, WQ + (size_t)n0 * DM, DM, DM, smem, acc);
#pragma unroll
    for (int mi = 0; mi < 2; ++mi)
#pragma unroll
      for (int ni = 0; ni < 2; ++ni)
#pragma unroll
        for (int q = 0; q < 4; ++q) {
          const int row = m0 + EPI_ROW(mi), c = n0 + EPI_COL(ni, q);
          *(u32x2*)(PQ + (size_t)row * 2048 + c) = (u32x2){pack2(acc[mi][ni][4 * q], acc[mi][ni][4 * q + 1]), pack2(acc[mi][ni][4 * q + 2], acc[mi][ni][4 * q + 3])};
        }
  }
}

__device__ __forceinline__ unsigned f2sortable(float x) { const unsigned u = __float_as_uint(x); return (u & 0x80000000u) ? ~u : (u | 0x80000000u); }
__device__ __forceinline__ float sortable2f(unsigned k) { return __uint_as_float((k & 0x80000000u) ? (k & 0x7fffffffu) : ~k); }
#define TOPK_INSERT(v, key) { unsigned t_ = (key); _Pragma("unroll") for (int s_ = 0; s_ < 16; ++s_) { const unsigned hi_ = max(v[s_], t_); t_ = min(v[s_], t_); v[s_] = hi_; } }
__device__ __forceinline__ void stage_scores_topk(int tpb, const bf16_t* PQ, const bf16_t* SUBK, int* EI, float* EG, char* smem) {
  EPI_DECL
  const int tid = tid_;
  const int item = tid & 127, kpart = tid >> 7;
  float* S = (float*)smem;
  unsigned* xk = (unsigned*)(smem + 128 * 129 * 4);
  const int tm = GB * tpb * 8;
  for (int mt = blockIdx.x; mt < tm; mt += gridDim.x) {
    const size_t m0 = (size_t)MT_LR0(mt >> 3, tpb) * 8 + (size_t)(mt & 7) * 128;
    unsigned vh[2][16];
#pragma unroll
    for (int half = 0; half < 2; ++half) {
      f32x16 acc[2][2];
      gemm_tile(PQ + m0 * 256 + half * 128, 256, SUBK + (size_t)half * 16384, 128, 128, smem, acc);
#pragma unroll
      for (int mi = 0; mi < 2; ++mi)
#pragma unroll
        for (int ni = 0; ni < 2; ++ni)
#pragma unroll
          for (int i = 0; i < 16; ++i)
            S[EPI_ROW(mi) * 129 + wn * 64 + ni * 32 + 8 * (i >> 2) + 4 * fh + (i & 3)] = acc[mi][ni][i];
      __syncthreads();
      unsigned v[16];
#pragma unroll
      for (int s = 0; s < 16; ++s) v[s] = 0u;
      const float* sr = S + item * 129 + kpart * 64;
#pragma unroll 8
      for (int k = 0; k < 64; ++k) {
        const unsigned key = (f2sortable(sr[k]) & ~127u) | (unsigned)(127 - (kpart * 64 + k));
        TOPK_INSERT(v, key)
      }
      if (kpart == 1) {
#pragma unroll
        for (int s = 0; s < 16; ++s) xk[item * 17 + s] = v[s];
      }
      __syncthreads();
      if (kpart == 0) {
#pragma unroll
        for (int s = 0; s < 16; ++s) { const unsigned key = xk[item * 17 + s]; TOPK_INSERT(v, key) }
      }
#pragma unroll
      for (int s = 0; s < 16; ++s) vh[half][s] = v[s];
      __syncthreads();
    }
    if (kpart == 0) {
      float v1[16], v2[16];
#pragma unroll
      for (int s = 0; s < 16; ++s) { v1[s] = sortable2f((vh[0][s] & ~127u) | 64u); v2[s] = sortable2f((vh[1][s] & ~127u) | 64u); }
      unsigned c[16];
#pragma unroll
      for (int s = 0; s < 16; ++s) c[s] = 0u;
      {
        int o = 0;
#pragma unroll
        for (int i = 0; i < 16; ++i)
#pragma unroll
          for (int j = 0; j < 16 / (i + 1); ++j) {
            const unsigned key = (f2sortable(v1[i] + v2[j]) & ~63u) | (unsigned)(63 - o);
            TOPK_INSERT(c, key)
            ++o;
          }
      }
      const float vmax = sortable2f((c[0] & ~63u) | 32u);
      float sum = 0.f;
#pragma unroll
      for (int s = 0; s < 16; ++s) sum += expf(sortable2f((c[s] & ~63u) | 32u) - vmax);
      const float isum = 1.0f / sum;
      const unsigned thr = c[15];
      int* ei = EI + (m0 + item) * 16;
      float* eg = EG + (m0 + item) * 16;
      int cntw = 0;
      {
        int o = 0;
#pragma unroll
        for (int i = 0; i < 16; ++i)
#pragma unroll
          for (int j = 0; j < 16 / (i + 1); ++j) {
            const unsigned key = (f2sortable(v1[i] + v2[j]) & ~63u) | (unsigned)(63 - o);
            if (key >= thr) {
              ei[cntw] = (int)((127u - (vh[0][i] & 127u)) * 128u + (127u - (vh[1][j] & 127u)));
              eg[cntw] = expf(sortable2f((key & ~63u) | 32u) - vmax) * isum;
              ++cntw;
            }
            ++o;
          }
      }
    }
  }
  __syncthreads();
}

#define DPPF(x, ctrl) __uint_as_float((unsigned)__builtin_amdgcn_update_dpp(0, (int)__float_as_uint(x), (ctrl), 0xf, 0xf, true))
#define XP_HALVE(n, bit, ctrl) { _Pragma("unroll") for (int j_ = 0; j_ < (n); ++j_) { const float keep_ = (bit) ? a[j_ + (n)] : a[j_]; const float send_ = (bit) ? a[j_] : a[j_ + (n)]; a[j_] = keep_ + DPPF(send_, ctrl); } }
#define XP_ROW(TAB, E, PR) { const int e0_ = __builtin_amdgcn_readlane((E), 2 * (PR)), e1_ = __builtin_amdgcn_readlane((E), 2 * (PR) + 1); \
    const char* rp_ = (TAB) + (size_t)(hw ? e1_ : e0_) * 768 + hl * 24; \
    const u32x4_u x_ = *(const u32x4_u*)rp_; const u32x2 y_ = *(const u32x2*)(rp_ + 16); \
    ra[PR] = (v6u){x_[0], x_[1], x_[2], x_[3], y_[0], y_[1]}; }
#define XP_META(PAR, T, E, G, HP) { const size_t mo_ = ((size_t)(PAR) * RPG + (T)) * 128 + w * 32 + hl; \
    E = ((const int*)(p.ws + WB_EI))[mo_]; G = ((const float*)(p.ws + WB_EG))[mo_]; \
    const u32x4* hr_ = (const u32x4*)((const bf16_t*)(p.ws + WB_H2) + ((size_t)(PAR) * RPG + (T)) * DM + hl * 32); \
    _Pragma("unroll") for (int c_ = 0; c_ < 4; ++c_) HP[c_] = hr_[c_]; }
__device__ __forceinline__ void unpack8(const u32x4 v, float* f) {
#pragma unroll
  for (int k = 0; k < 4; ++k) { f[2 * k] = lo16(v[k]); f[2 * k + 1] = hi16(v[k]); }
}
__device__ __forceinline__ int xp_pool_n(int q) { return GB * ((q < NG) ? NTOK : NLAT); }
__device__ __forceinline__ int xp_claim(int* pool, int& qa, int hi) {
  while (qa <= hi) {
    const int n = xp_pool_n(qa);
    if (__hip_atomic_load(pool + qa, __ATOMIC_RELAXED, __HIP_MEMORY_SCOPE_AGENT) < n) {
      const int i = atomicAdd(pool + qa, 1);
      if (i < n) return qa * 65536 + i;
    }
    ++qa;
  }
  return -1;
}
__device__ __forceinline__ void xp_decode(int tok, int& l, int& par, int& b, int& rr, int& t) {
  const int q = tok >> 16, i = tok & 65535;
  l = q / NG;
  const int g = q % NG, rr_lim = (l == 0) ? NTOK : NLAT, bl = i / rr_lim;
  rr = i % rr_lim; b = g * GB + bl; t = bl * NTOK + rr; par = q % 3;
}
__device__ __forceinline__ void expert_run(const Params& p, int lo, int hi, unsigned* ctr, unsigned epoch, const bool steal, int& pend, float* smem) {
  if (lo < 0) lo = 0;
  if (hi < lo) return;
  const int tid = otid(), w = tid >> 6, lane = tid & 63, hl = lane & 31, hw = lane >> 5;
  int* s_tok = (int*)(smem + SMEM_FLOATS - 8);
  int* pool = (int*)(p.ws + WB_POOL);
  float* part = smem;
  int qa = lo, ci = 0;
  bool cpend = false;
  unsigned cb = 0;
  int cur = pend; pend = -1;
  if (cur < 0) {
    __syncthreads();
    if (tid == 0) s_tok[2] = xp_claim(pool, qa, hi);
    __syncthreads();
    cur = __builtin_amdgcn_readfirstlane(s_tok[2]);
  }
  if (cur < 0) return;
  if (tid == 0 && qa <= hi) { ci = atomicAdd(pool + qa, 1); cpend = true; }
  int l, par, b, rr, t;
  xp_decode(cur, l, par, b, rr, t);
  int e_c; float g_c; u32x4 hp[4];
  XP_META(par, t, e_c, g_c, hp)
  v6u ra[16];
  {
    const char* U = p.ws + WB_U16 + (size_t)l * 16384 * 768;
#pragma unroll
    for (int pr = 0; pr < 16; ++pr) XP_ROW(U, e_c, pr)
  }
  for (;;) {
    const float* mod = (const float*)(p.ws + WB_MOD) + (size_t)l * 9 * 6144;
    const float4 g2 = ((const float4*)(mod + (size_t)((rr < NLAT) ? b : 8) * 6144 + 5 * 1024))[tid];
    float4* xp = (float4*)xrow(p, b, rr) + tid;
    float4 xv = *xp;
    if (tid == 0) {
      int r = -1;
      if (cpend) {
        if (ci < xp_pool_n(qa)) r = qa * 65536 + ci;
        else { ++qa; r = xp_claim(pool, qa, hi); }
      }
      const int st = (steal && cb + 31u >= epoch) ? 1 : 0;
      s_tok[0] = r; s_tok[1] = st;
      cpend = false;
      if (!st && r >= 0 && qa <= hi) { ci = atomicAdd(pool + qa, 1); cpend = true; }
    }
    __syncthreads();
    const int nxt = __builtin_amdgcn_readfirstlane(s_tok[0]);
    const bool pf = nxt >= 0 && __builtin_amdgcn_readfirstlane(s_tok[1]) == 0;
    int ln = l, parn = 0, bn = 0, rrn = 0, tn = 0, e_n = 0;
    float g_n = 0.f;
    u32x4 hn[4];
#pragma unroll
    for (int c = 0; c < 4; ++c) hn[c] = (u32x4){0u, 0u, 0u, 0u};
    if (pf) {
      xp_decode(nxt, ln, parn, bn, rrn, tn);
      XP_META(parn, tn, e_n, g_n, hn)
    }
    const char* V = p.ws + WB_V16 + (size_t)l * 16384 * 768;
    f32x2 hq2[16];
#pragma unroll
    for (int c = 0; c < 4; ++c)
#pragma unroll
      for (int k = 0; k < 4; ++k) hq2[4 * c + k] = (f32x2){lo16(hp[c][k]), hi16(hp[c][k])};
    float a[16];
#pragma unroll
    for (int pr = 0; pr < 16; ++pr) {
      const v32f f = __builtin_amdgcn_cvt_scalef32_pk32_f32_fp6(ra[pr], 1.0f);
      f32x2 sa = {0.f, 0.f}, sb = {0.f, 0.f};
#pragma unroll
      for (int k = 0; k < 16; k += 2) {
        sa = __builtin_elementwise_fma(hq2[k], (f32x2){f[2 * k], f[2 * k + 1]}, sa);
        sb = __builtin_elementwise_fma(hq2[k + 1], (f32x2){f[2 * k + 2], f[2 * k + 3]}, sb);
      }
      a[pr] = (sa[0] + sb[0]) + (sa[1] + sb[1]);
      XP_ROW(V, e_c, pr)
    }
    {
      const bool b3 = (lane & 8) != 0, b2 = (lane & 4) != 0, b1 = (lane & 2) != 0, b0 = (lane & 1) != 0;
      XP_HALVE(8, b3, 0x128)
      XP_HALVE(4, b2, 0x141)
      XP_HALVE(2, b1, 0x4E)
      XP_HALVE(1, b0, 0xB1)
    }
    float dsum = a[0];
    dsum += __shfl_xor(dsum, 16);
    const float my_dot = __shfl(dsum, 32 * (hl & 1) + (hl >> 1));
    const float my_c = g_c * geluf_(my_dot * (1.0f / 64.0f));
    f32x2 acc2[16];
#pragma unroll
    for (int k = 0; k < 16; ++k) acc2[k] = (f32x2){0.f, 0.f};
    {
      const char* Un = p.ws + WB_U16 + (size_t)ln * 16384 * 768;
#pragma unroll
      for (int pr = 0; pr < 16; ++pr) {
        const float c0 = __uint_as_float(__builtin_amdgcn_readlane(__float_as_uint(my_c), 2 * pr)), c1 = __uint_as_float(__builtin_amdgcn_readlane(__float_as_uint(my_c), 2 * pr + 1));
        const float c = hw ? c1 : c0;
        const f32x2 cc = {c, c};
        const v32f f = __builtin_amdgcn_cvt_scalef32_pk32_f32_fp6(ra[pr], 1.0f);
#pragma unroll
        for (int k = 0; k < 16; ++k) acc2[k] = __builtin_elementwise_fma(cc, (f32x2){f[2 * k], f[2 * k + 1]}, acc2[k]);
        XP_ROW(Un, e_n, pr)
      }
    }
    if (steal && tid == 0) cb = __hip_atomic_load(ctr, __ATOMIC_RELAXED, __HIP_MEMORY_SCOPE_AGENT);
    __syncthreads();
    {
      float4* pw = (float4*)(part + (w * 2 + hw) * 1024 + hl * 32);
#pragma unroll
      for (int c = 0; c < 8; ++c) pw[c] = make_float4(acc2[2 * c][0], acc2[2 * c][1], acc2[2 * c + 1][0], acc2[2 * c + 1][1]);
    }
    __syncthreads();
    float4 s = ((const float4*)part)[tid];
#pragma unroll
    for (int c = 1; c < 8; ++c) { const float4 x = ((const float4*)(part + c * 1024))[tid]; s.x += x.x; s.y += x.y; s.z += x.z; s.w += x.w; }
    xv.x += 0.5f * g2.x * s.x; xv.y += 0.5f * g2.y * s.y; xv.z += 0.5f * g2.z * s.z; xv.w += 0.5f * g2.w * s.w;
    *xp = xv;
    if (!pf) { pend = nxt; break; }
    l = ln; par = parn; b = bn; rr = rrn; t = tn; e_c = e_n; g_c = g_n;
#pragma unroll
    for (int c = 0; c < 4; ++c) hp[c] = hn[c];
  }
}
__device__ __forceinline__ void expert_drain(const Params& p, int lo, int hi, int& pend, float* smem) {
  expert_run(p, lo, hi, nullptr, 0u, false, pend, smem);
}

__device__ __forceinline__ void stage_final(const Params& p, float* smem) {
  const int tid = otid(), w = tid >> 6, lane = tid & 63;
  const int n = NB * NLAT;
  for (int r0 = (blockIdx.x * 4 + w) * 2; r0 < n; r0 += gridDim.x * 8) {
    float4 v[2][4];
#pragma unroll
    for (int u = 0; u < 2; ++u)
#pragma unroll
      for (int q = 0; q < 4; ++q) v[u][q] = ((const float4*)(p.out + (size_t)(r0 + u) * DM))[q * 64 + lane];
#pragma unroll
    for (int u = 0; u < 2; ++u) {
      float s = 0.f;
#pragma unroll
      for (int q = 0; q < 4; ++q) s += v[u][q].x * v[u][q].x + v[u][q].y * v[u][q].y + v[u][q].z * v[u][q].z + v[u][q].w * v[u][q].w;
      s = wave_sum(s);
      const float rs = rsqrtf(s * (1.0f / DM) + EPSF);
#pragma unroll
      for (int q = 0; q < 4; ++q) {
        const float4 g = ((const float4*)p.in[I_FG])[q * 64 + lane];
        const float4 x = v[u][q];
        ((float4*)(p.out + (size_t)(r0 + u) * DM))[q * 64 + lane] = make_float4(x.x * rs * g.x, x.y * rs * g.y, x.z * rs * g.z, x.w * rs * g.w);
      }
    }
  }
}

__device__ __forceinline__ void gbar(const Params& p, unsigned* ctr, unsigned& epoch, int lo, int hi, int& pend, float* smem) {
  asm volatile("s_waitcnt vmcnt(0)" ::: "memory");
  __syncthreads();
  epoch += gridDim.x;
  int* s_flag = (int*)(smem + SMEM_FLOATS - 12);
  if (threadIdx.x == 0) {
    __builtin_amdgcn_fence(__ATOMIC_RELEASE, "agent");
    asm volatile("s_waitcnt vmcnt(0)" ::: "memory");
    __hip_atomic_fetch_add(ctr, 1u, __ATOMIC_RELAXED, __HIP_MEMORY_SCOPE_AGENT);
  }
  if (hi >= lo && hi >= 0) {
    if (threadIdx.x == 0) {
      const unsigned c = __hip_atomic_load(ctr, __ATOMIC_RELAXED, __HIP_MEMORY_SCOPE_AGENT);
      *s_flag = (c + 31u < epoch) ? 1 : 0;
    }
    __syncthreads();
    if (*s_flag) expert_run(p, lo, hi, ctr, epoch, true, pend, smem);
  }
  if (threadIdx.x == 0) {
    while (__hip_atomic_load(ctr, __ATOMIC_RELAXED, __HIP_MEMORY_SCOPE_AGENT) < epoch) __builtin_amdgcn_s_sleep(2);
    __builtin_amdgcn_fence(__ATOMIC_ACQUIRE, "agent");
    asm volatile("s_waitcnt vmcnt(0)" ::: "memory");
  }
  __syncthreads();
}

__global__ void __launch_bounds__(256) mega(Params p) {
  cg::grid_group grid = cg::this_grid();
  __shared__ __attribute__((aligned(16))) float smem[SMEM_FLOATS];
  char* smc = (char*)smem;
  char* ws = p.ws;
  bf16_t* H = (bf16_t*)(ws + WB_H); bf16_t* Z = (bf16_t*)(ws + WB_Z); float* MGT = (float*)(ws + WB_MGT); bf16_t* XC = (bf16_t*)(ws + WB_XC);
  bf16_t* QM = (bf16_t*)(ws + WB_QM); bf16_t* KM = (bf16_t*)(ws + WB_KM); bf16_t* KMT = (bf16_t*)(ws + WB_KMT); bf16_t* MVT = (bf16_t*)(ws + WB_MVT);
  bf16_t* HF = (bf16_t*)(ws + WB_HF); bf16_t* HB = (bf16_t*)(ws + WB_HB);
  bf16_t* VT = (bf16_t*)(ws + WB_VT); float* YSF = (float*)(ws + WB_YSF); float* YSB = (float*)(ws + WB_YSB);
  bf16_t* YA = (bf16_t*)(ws + WB_YA); bf16_t* YB = (bf16_t*)(ws + WB_YB); bf16_t* YS = (bf16_t*)(ws + WB_YS); bf16_t* GG = (bf16_t*)(ws + WB_GG);
  bf16_t* MG = (bf16_t*)(ws + WB_MG); bf16_t* PQ = (bf16_t*)(ws + WB_PQ); float* SC = (float*)(ws + WB_SC);
  float* XE = (float*)(ws + WB_XE); float* GA = (float*)(ws + WB_GA);
  const bf16_t* WT = (const bf16_t*)(ws + WB_WT);

  unsigned* bar = (unsigned*)(ws + WB_BAR);
  unsigned epoch = 0;
  int pend = -1;
  stage_init(p, smem);
  grid.sync();

  for (int l = 0; l < 2; ++l) {
    const bool need_ctx = (l == 0);
    const int rr_lim = need_ctx ? NTOK : NLAT;
    const int tpb = need_ctx ? 34 : 32;
    const bf16_t* W = WT + (size_t)l * WT_LAYER;
    const float lam_init = 0.8f - 0.6f * expf(-0.3f * (float)l);
    float lam;
    {
      float s1 = 0.f, s2 = 0.f;
      for (int i = 0; i < 64; ++i) {
        s1 += p.in[I_LQ1][l * 64 + i] * p.in[I_LK1][l * 64 + i];
        s2 += p.in[I_LQ2][l * 64 + i] * p.in[I_LK2][l * 64 + i];
      }
      lam = expf(s1) - expf(s2) + lam_init;
    }
    for (int g = 0; g < NG; ++g) {
      const int q = l * NG + g;
      int plo = q - 3, phi = q - 1;
      int* EI = (int*)(ws + WB_EI) + (size_t)(q % 3) * RPG * 128; float* EG = (float*)(ws + WB_EG) + (size_t)(q % 3) * RPG * 128;
      bf16_t* H2 = (bf16_t*)(ws + WB_H2) + (size_t)(q % 3) * RPG * DM;
      stage_normmod(p, l, g, 0, NTOK, H, smem);
      gbar(p, bar, epoch, plo, phi, pend, smem);
      stage_inproj(p, H, W + WT_WIN, Z, MGT, VT, MVT, smc);
      gbar(p, bar, epoch, plo, phi, pend, smem);
      stage_conv(p, l, Z, XC);
      stage_s5_pass1(p, l, Z, XE);
      gbar(p, bar, epoch, plo, phi, pend, smem);
      stage_mlqk(XC, W + WT_WQK, QM, KM, KMT, smc);
      stage_mlgates(p, l, MGT, GA);
      gbar(p, bar, epoch, plo, phi, pend, smem);
      {
        const int n_attn = 4 * 64 + (need_ctx ? 4 * 4 : 0);
        const int n_s5 = 32 * 2 * 9;
        const int n_items = GB * (16 + n_attn + n_s5);
        int* cnt = (int*)(ws + WB_CNT) + (l * NG + g);
        int* s_item = (int*)(smem + SMEM_FLOATS - 4);
        for (;;) {
          __syncthreads();
          if (otid() == 0) *s_item = atomicAdd(cnt, 1);
          __syncthreads();
          const int it = *s_item;
          if (it >= n_items) break;
          int bl, k;
          if (it < GB * 16) { bl = it / 16; k = it % 16; }
          else if (it < GB * (16 + n_attn)) { bl = (it - GB * 16) / n_attn; k = 16 + (it - GB * 16) % n_attn; }
          else { bl = (it - GB * (16 + n_attn)) / n_s5; k = 16 + n_attn + (it - GB * (16 + n_attn)) % n_s5; }
          const bf16_t* Zb = Z + (size_t)bl * NTOK * ZW;
          const size_t ro = (size_t)bl * NTOK;
          if (k < 16) {
            const int hh = k & 3, dd = (k >> 2) & 1, eh = k >> 3;
            mlstm_chain_item(p, l, QM + ro * 512, KM + ro * 512, KMT + (size_t)bl * 4 * 128 * NTOK, MVT + (size_t)bl * 4 * 128 * NTOK, GA + (size_t)(((bl * 4 + hh) * 2 + dd) * 68) * 272,
                             (dd ? HB : HF) + ro * 512, hh, dd, eh, smc);
          } else if (k < 16 + n_attn) {
            const int a = k - 16;
            const bf16_t* VTb = VT + (size_t)bl * 4 * 128 * NTOK;
            if (a < 256) attn_mfma_item(p, l, Zb, VTb, YA + ro * 512, a & 3, (a >> 2) * 64, 0, NTOK, lam, lam_init, smc);
            else attn_mfma_item(p, l, Zb, VTb, YA + ro * 512, (a - 256) & 3, NLAT + ((a - 256) >> 2) * 64, NLAT, NCTX, lam, lam_init, smc);
          } else {
            const int a = k - 16 - n_attn;
            const int sq = a % 9, dir = (a / 9) & 1, gg = a / 18;
            s5_item(p, l, Zb, XE + (((size_t)bl * 32 + gg) * 2 + dir) * (S5NSEG - 1) * 128, (dir ? YSB : YSF) + ro * 512, gg, dir, sq, smc);
          }
        }
      }
      expert_drain(p, plo, plo, pend, smem);
      plo = q - 2;
      gbar(p, bar, epoch, plo, phi, pend, smem);
      stage_chain1(p, l, g, rr_lim, Z, HF, HB, YSF, YSB, YA, MG, H2, W, smc);
      gbar(p, bar, epoch, plo, phi, pend, smem);
      stage_peerq_mfma(tpb, H2, W + WT_WQ, PQ, smc);
      gbar(p, bar, epoch, plo, phi, pend, smem);
      stage_scores_topk(tpb, PQ, W + WT_SUBK, EI, EG, smc);
      gbar(p, bar, epoch, plo, phi, pend, smem);
    }
  }
  expert_drain(p, 2 * NG - 3, 2 * NG - 1, pend, smem);
  gbar(p, bar, epoch, 0, -1, pend, smem);
  stage_final(p, smem);
}

extern "C" void kernel_launch(void* const* d_in, const int* in_sizes, int n_in, void* d_out,
                              int out_size, void* d_ws, size_t ws_size, hipStream_t stream) {
  static int grid_blocks = 0;
  if (!grid_blocks) {
    int dev = 0, cus = 0, per_cu = 0;
    (void)hipGetDevice(&dev);
    (void)hipDeviceGetAttribute(&cus, hipDeviceAttributeMultiprocessorCount, dev);
    (void)hipOccupancyMaxActiveBlocksPerMultiprocessor(&per_cu, mega, 256, 0);
    if (per_cu > 1) per_cu = 1;
    grid_blocks = cus * per_cu;
  }
  if (ws_size < WB_END) {
    fprintf(stderr, "workspace too small: %zu < %zu\n", ws_size, (size_t)WB_END);
    return;
  }
  Params p{};
  for (int i = 0; i < N_IN; ++i) p.in[i] = (const float*)d_in[i];
  p.out = (float*)d_out;
  p.ws = (char*)d_ws;
  (void)hipMemsetAsync((char*)d_ws + WB_BAR, 0, 256, stream);
  void* args[] = {&p};
  hipError_t e = hipLaunchCooperativeKernel((void*)mega, dim3(grid_blocks), dim3(256), args, 0, stream);
  if (e != hipSuccess) fprintf(stderr, "cooperative launch failed: %s (grid %d)\n", hipGetErrorString(e), grid_blocks);
}
```

```cpp
#include <hip/hip_runtime.h>
#include <hip/hip_cooperative_groups.h>
#include <cstdio>
#include <cstdint>
namespace cg = cooperative_groups;

#define NLAT 4096
#define NCTX 256
#define NTOK 4352
#define DM 1024
#define INW 6672
#define NB 8
#define GB 2
#define NG (NB / GB)
#define RPG (GB * NTOK)
#define ZW 6656
#define EPSF 1e-6f

enum { I_X = 0, I_C, I_CTX, I_CCTX, I_WMOD, I_BMOD, I_N1G, I_N2G, I_WIN, I_LQ1, I_LK1, I_LQ2, I_LK2, I_SUBG,
       I_CONVW, I_CONVB, I_MLWQ, I_MLWK, I_GATEB, I_MLNG, I_S5LRE, I_S5LIM, I_S5DT, I_S5BRE, I_S5BIM,
       I_S5CRE, I_S5CIM, I_S5D, I_GLUW, I_GLUB, I_WBR, I_WOUT, I_PWQ, I_PSUBK, I_PU, I_PV, I_FG, N_IN };

struct Params {
  const float* in[N_IN];
  float* out;
  char* ws;
};

typedef unsigned short bf16_t;
typedef short bf16x8 __attribute__((ext_vector_type(8)));
typedef float f32x16 __attribute__((ext_vector_type(16)));
typedef unsigned u32x4 __attribute__((ext_vector_type(4)));
typedef unsigned u32x2 __attribute__((ext_vector_type(2)));
typedef unsigned u32x4_u __attribute__((ext_vector_type(4), aligned(8)));
typedef float v16f __attribute__((ext_vector_type(16)));
typedef float v32f __attribute__((ext_vector_type(32)));
typedef unsigned v6u __attribute__((ext_vector_type(6)));

#define AL(x) (((x) + 255) & ~(size_t)255)
#define WB_XCX   ((size_t)0)
#define WB_MOD   AL(WB_XCX + (size_t)NB * NCTX * DM * 4)
#define WB_ROPE  AL(WB_MOD + (size_t)2 * 9 * 6144 * 4)
#define WB_WT    AL(WB_ROPE + (size_t)NLAT * 32 * 2 * 4)
#define WT_WIN   ((size_t)0)
#define WT_WQK   (WT_WIN + (size_t)6784 * 1024)
#define WT_GLU   (WT_WQK + (size_t)4 * 256 * 128)
#define WT_WBR   (WT_GLU + (size_t)512 * 512)
#define WT_WOUT  (WT_WBR + (size_t)3 * 1024 * 512)
#define WT_WQ    (WT_WOUT + (size_t)1024 * 1024)
#define WT_SUBK  (WT_WQ + (size_t)2048 * 1024)
#define WT_LAYER (WT_SUBK + (size_t)2 * 128 * 128)
#define WB_H     AL(WB_WT + WT_LAYER * 2 * 2)
#define WB_Z     AL(WB_H + (size_t)RPG * DM * 2)
#define WB_MGT   AL(WB_Z + (size_t)RPG * ZW * 2)
#define WB_XC    AL(WB_MGT + (size_t)RPG * 16 * 4)
#define WB_QM    AL(WB_XC + (size_t)RPG * 512 * 2)
#define WB_KM    AL(WB_QM + (size_t)RPG * 512 * 2)
#define WB_KMT   AL(WB_KM + (size_t)RPG * 512 * 2)
#define WB_MVT   AL(WB_KMT + (size_t)RPG * 512 * 2)
#define WB_HF    AL(WB_MVT + (size_t)RPG * 512 * 2)
#define WB_HB    AL(WB_HF + (size_t)RPG * 512 * 2)
#define WB_YSF   AL(WB_HB + (size_t)RPG * 512 * 2)
#define WB_YSB   AL(WB_YSF + (size_t)RPG * 512 * 4)
#define WB_YA    AL(WB_YSB + (size_t)RPG * 512 * 4)
#define WB_YB    AL(WB_YA + (size_t)RPG * 512 * 2)
#define WB_YS    AL(WB_YB + (size_t)RPG * 512 * 2)
#define WB_GG    AL(WB_YS + (size_t)RPG * 512 * 2)
#define WB_MG    AL(WB_GG + (size_t)RPG * 512 * 2)
#define WB_EI    AL(WB_MG + (size_t)RPG * DM * 2)
#define WB_EG    AL(WB_EI + (size_t)3 * RPG * 128 * 4)
#define WB_H2    AL(WB_EG + (size_t)3 * RPG * 128 * 4)
#define WB_U16   AL(WB_H2 + (size_t)3 * RPG * DM * 2)
#define WB_V16   AL(WB_U16 + (size_t)2 * 16384 * 768)
#define WB_VT    AL(WB_V16 + (size_t)2 * 16384 * 768)
#define WB_CNT   AL(WB_VT + (size_t)GB * 4 * 128 * NTOK * 2)
#define WB_XE    AL(WB_CNT + 256)
#define WB_BAR   AL(WB_XE + (size_t)GB * 32 * 2 * 33 * 128 * 4)
#define WB_GA    AL(WB_BAR + 256)
#define WB_POOL  AL(WB_GA + (size_t)GB * 4 * 2 * 68 * 272 * 4)
#define WB_END   AL(WB_POOL + 256)
#define WB_PQ    (WB_Z)
#define WB_SC    AL(WB_PQ + (size_t)RPG * 2048 * 2)

#define SMEM_FLOATS (26 * 1024)

__device__ __forceinline__ float sigmoidf_(float x) { return __builtin_amdgcn_rcpf(1.0f + __builtin_amdgcn_exp2f(-1.4426950408889634f * x)); }
__device__ __forceinline__ float siluf_(float x) { return x * __builtin_amdgcn_rcpf(1.0f + __builtin_amdgcn_exp2f(-1.4426950408889634f * x)); }
__device__ __forceinline__ float geluf_(float x) { return 0.5f * x * (1.0f + erff(x * 0.70710678118654752f)); }
__device__ __forceinline__ int otid() { int t = threadIdx.x; asm volatile("" : "+v"(t)); return t; }
__device__ __forceinline__ float wave_sum(float v) {
  for (int o = 32; o > 0; o >>= 1) v += __shfl_xor(v, o);
  return v;
}
__device__ __forceinline__ bf16_t f2bf(float x) { unsigned u = __float_as_uint(x); u += 0x7fffu + ((u >> 16) & 1u); return (bf16_t)(u >> 16); }
__device__ __forceinline__ float bf2f(bf16_t h) { return __uint_as_float(((unsigned)h) << 16); }
typedef float f32x2 __attribute__((ext_vector_type(2)));
typedef __bf16 bf16x2_t __attribute__((ext_vector_type(2)));
__device__ __forceinline__ unsigned pack2(float a, float b) { f32x2 v = {a, b}; return __builtin_bit_cast(unsigned, __builtin_convertvector(v, bf16x2_t)); }
__device__ __forceinline__ float lo16(unsigned u) { return __uint_as_float(u << 16); }
__device__ __forceinline__ float hi16(unsigned u) { return __uint_as_float(u & 0xffff0000u); }

__device__ __forceinline__ float* xrow(const Params& p, int b, int rr) {
  return (rr < NLAT) ? p.out + ((size_t)b * NLAT + rr) * DM : (float*)(p.ws + WB_XCX) + ((size_t)b * NCTX + (rr - NLAT)) * DM;
}

__device__ __forceinline__ const float* xrow_in(const Params& p, int b, int rr) {
  return (rr < NLAT) ? p.in[I_X] + ((size_t)b * NLAT + rr) * DM : p.in[I_CTX] + ((size_t)b * NCTX + (rr - NLAT)) * DM;
}

__device__ __forceinline__ void gemm_tile(const bf16_t* __restrict__ Ag, int lda, const bf16_t* __restrict__ Bg, int ldb, int K,
                                          char* smem, f32x16 (&acc)[2][2]) {
  const int tid = otid(), lane = tid & 63, w = tid >> 6, wm = w >> 1, wn = w & 1;
#pragma unroll
  for (int a = 0; a < 2; ++a)
#pragma unroll
    for (int b = 0; b < 2; ++b)
#pragma unroll
      for (int i = 0; i < 16; ++i) acc[a][b][i] = 0.f;
  const int srow = tid >> 3, sch = tid & 7;
  const bf16_t* ap = Ag + (size_t)srow * lda + sch * 8;
  const bf16_t* bp = Bg + (size_t)srow * ldb + sch * 8;
  const int wofs = srow * 128 + ((sch ^ ((srow >> 1) & 7)) << 4);
  const int fr = lane & 31, fh = lane >> 5, fsw = (fr >> 1) & 7;
  const int aofs = (wm * 64 + fr) * 128, bofs = 16384 + (wn * 64 + fr) * 128;
  u32x4 ra0[4], rb0[4], ra1[4], rb1[4];
  const int nk = K >> 6;
#define G_LOAD(RA, RB, KT) { _Pragma("unroll") for (int i = 0; i < 4; ++i) { RA[i] = *(const u32x4*)(ap + (size_t)i * 32 * lda + (KT) * 64); RB[i] = *(const u32x4*)(bp + (size_t)i * 32 * ldb + (KT) * 64); } }
#define G_STORE(RA, RB, BUF) { char* nb_ = smem + (BUF) * 32768; _Pragma("unroll") for (int i = 0; i < 4; ++i) { *(u32x4*)(nb_ + wofs + i * 4096) = RA[i]; *(u32x4*)(nb_ + 16384 + wofs + i * 4096) = RB[i]; } }
#define G_COMPUTE(BUF) { const char* base = smem + (BUF) * 32768; _Pragma("unroll") for (int ks = 0; ks < 4; ++ks) { \
      const int coff = ((ks * 2 + fh) ^ fsw) << 4; bf16x8 af[2], bfr[2]; \
      _Pragma("unroll") for (int mi = 0; mi < 2; ++mi) af[mi] = *(const bf16x8*)(base + aofs + mi * 4096 + coff); \
      _Pragma("unroll") for (int ni = 0; ni < 2; ++ni) bfr[ni] = *(const bf16x8*)(base + bofs + ni * 4096 + coff); \
      _Pragma("unroll") for (int mi = 0; mi < 2; ++mi) _Pragma("unroll") for (int ni = 0; ni < 2; ++ni) \
          acc[mi][ni] = __builtin_amdgcn_mfma_f32_32x32x16_bf16(bfr[ni], af[mi], acc[mi][ni], 0, 0, 0); } }
  G_LOAD(ra0, rb0, 0)
  G_LOAD(ra1, rb1, 1)
  __syncthreads();
  G_STORE(ra0, rb0, 0)
  __syncthreads();
  for (int kt = 0; kt < nk; kt += 2) {
    if (kt + 2 < nk) G_LOAD(ra0, rb0, kt + 2)
    G_COMPUTE(0)
    G_STORE(ra1, rb1, 1)
    __syncthreads();
    if (kt + 3 < nk) G_LOAD(ra1, rb1, kt + 3)
    G_COMPUTE(1)
    if (kt + 2 < nk) G_STORE(ra0, rb0, 0)
    __syncthreads();
  }
#undef G_LOAD
#undef G_STORE
#undef G_COMPUTE
}
#define EPI_DECL const int tid_ = otid(); const int lane = tid_ & 63, w_ = tid_ >> 6, wm = w_ >> 1, wn = w_ & 1, fr = lane & 31, fh = lane >> 5; (void)fr; (void)fh; (void)wm; (void)wn;
#define EPI_ROW(mi) (wm * 64 + (mi) * 32 + fr)
#define EPI_COL(ni, q) (wn * 64 + (ni) * 32 + 8 * (q) + 4 * fh)
#define MT_LR0(mt, tpb) (((mt) / (tpb)) * NTOK + ((mt) % (tpb)) * 128)


struct TileIter {
  int tm, tn, pw, ph, PN, NP, x, i, it;
  __device__ __forceinline__ TileIter(int tm_, int tn_) : tm(tm_), tn(tn_) {
    pw = tn < 8 ? tn : 8; ph = 32 / pw; PN = (tn + pw - 1) / pw; NP = ((tm + ph - 1) / ph) * PN;
    x = blockIdx.x & 7; i = blockIdx.x >> 3; it = 0;
  }
  __device__ __forceinline__ bool next(int& mt, int& nt, bool& valid) {
    if (gridDim.x != 256) {
      const int t = blockIdx.x + it * gridDim.x; ++it;
      if (t >= tm * tn) return false;
      mt = t / tn; nt = t % tn; valid = true; return true;
    }
    const int P = it * 8 + x; ++it;
    if (P >= NP) return false;
    mt = (P / PN) * ph + i / pw; nt = (P % PN) * pw + i % pw;
    valid = (mt < tm) && (nt < tn);
    return true;
  }
};

template <class F>
__device__ __forceinline__ void transpose_cvt(const float* __restrict__ src, int ld, F srccol, int K, int Ndst, bf16_t* __restrict__ dst, float* smem) {
  float (*T)[65] = (float (*)[65])smem;
  const int tid = otid();
  const int tk = K >> 6, tn = Ndst >> 6;
  for (int t = blockIdx.x; t < tn * tk; t += gridDim.x) {
    const int n0 = (t / tk) * 64, k0 = (t % tk) * 64;
    __syncthreads();
    const int sc = srccol(n0 + (tid & 63));
#pragma unroll
    for (int i = 0; i < 16; ++i) {
      const int ky = (tid >> 6) + 4 * i;
      T[ky][tid & 63] = (sc >= 0) ? src[(size_t)(k0 + ky) * ld + sc] : 0.f;
    }
    __syncthreads();
#pragma unroll
    for (int i = 0; i < 16; ++i) {
      const int ny = (tid >> 6) + 4 * i;
      dst[(size_t)(n0 + ny) * K + k0 + (tid & 63)] = f2bf(T[tid & 63][ny]);
    }
  }
  __syncthreads();
}
__device__ __forceinline__ void fragpack(const float* __restrict__ src, int ld, int K, int N, bf16_t* __restrict__ dst) {
  const int kc = K >> 6, total = (N >> 5) * kc * 256;
  for (int idx = blockIdx.x * 256 + otid(); idx < total; idx += gridDim.x * 256) {
    const int lane = idx & 63, ks = (idx >> 6) & 3, c = (idx >> 8) % kc, nf = (idx >> 8) / kc;
    const int n = 32 * nf + (lane & 31), k0 = 64 * c + 32 * (lane >> 5) + 8 * ks;
    float f[8];
#pragma unroll
    for (int j = 0; j < 8; ++j) f[j] = src[(size_t)(k0 + j) * ld + n];
    *(u32x4*)(dst + (size_t)idx * 8) = (u32x4){pack2(f[0], f[1]), pack2(f[2], f[3]), pack2(f[4], f[5]), pack2(f[6], f[7])};
  }
}
__device__ __forceinline__ int win_srccol(int n) {
  if (n < 3072) return n;
  if (n < 6656) return n + 16;
  if (n < 6672) return n - 3584;
  return -1;
}

__device__ __forceinline__ void stage_init(const Params& p, float* smem) {
  const int tid = otid();
  if (blockIdx.x == 0 && tid < 64) { ((int*)(p.ws + WB_CNT))[tid] = 0; if (tid < 16) ((int*)(p.ws + WB_POOL))[tid] = 0; }
  {
    float* lx = smem + tid * 33;
    int perm[32];
    {
      v16f a, b;
#pragma unroll
      for (int j = 0; j < 16; ++j) { a[j] = (float)(j & 7); b[j] = (float)((j + 16) & 7); }
      const v32f u1 = __builtin_amdgcn_cvt_scalef32_pk32_f32_fp6(__builtin_amdgcn_cvt_scalef32_2xpk16_fp6_f32(a, b, 1.0f), 1.0f);
#pragma unroll
      for (int j = 0; j < 16; ++j) { a[j] = (float)(j >> 3); b[j] = (float)((j + 16) >> 3); }
      const v32f u2 = __builtin_amdgcn_cvt_scalef32_pk32_f32_fp6(__builtin_amdgcn_cvt_scalef32_2xpk16_fp6_f32(a, b, 1.0f), 1.0f);
#pragma unroll
      for (int k = 0; k < 32; ++k) perm[k] = ((int)(u1[k] + 0.5f) + 8 * (int)(u2[k] + 0.5f)) & 31;
    }
    const size_t ngrp = (size_t)2 * 16384 * 32;
    for (size_t i = (size_t)blockIdx.x * 256 + tid; i < 2 * ngrp; i += (size_t)gridDim.x * 256) {
      const bool isv = i >= ngrp;
      const size_t gi = isv ? i - ngrp : i;
      const float4* s4 = (const float4*)((isv ? p.in[I_PV] : p.in[I_PU]) + gi * 32);
      const float sc = isv ? 2.0f : 64.0f;
      float o[32];
#pragma unroll
      for (int q = 0; q < 8; ++q) { const float4 t = s4[q]; o[4 * q] = t.x * sc; o[4 * q + 1] = t.y * sc; o[4 * q + 2] = t.z * sc; o[4 * q + 3] = t.w * sc; }
#pragma unroll
      for (int k = 0; k < 32; ++k) lx[perm[k]] = o[k];
      v16f a, b;
#pragma unroll
      for (int j = 0; j < 16; ++j) { a[j] = lx[j]; b[j] = lx[16 + j]; }
      const v6u pk = __builtin_amdgcn_cvt_scalef32_2xpk16_fp6_f32(a, b, 1.0f);
      u32x2* d = (u32x2*)(p.ws + (isv ? WB_V16 : WB_U16) + gi * 24);
      d[0] = (u32x2){pk[0], pk[1]}; d[1] = (u32x2){pk[2], pk[3]}; d[2] = (u32x2){pk[4], pk[5]};
    }
    __syncthreads();
  }
  {
    float2* rt = (float2*)(p.ws + WB_ROPE);
    for (int i = blockIdx.x * 256 + tid; i < NLAT * 32; i += gridDim.x * 256) {
      const int pos = i >> 5, j = i & 31;
      const float inv = powf(10000.0f, -(float)(j & 15) / 16.0f);
      const float ang = (float)((j < 16) ? (pos >> 6) : (pos & 63)) * inv;
      rt[i] = make_float2(cosf(ang), sinf(ang));
    }
  }
  {
    float* sc = smem;
    float* red = smem + 9 * 1024;
    for (int i = tid; i < 9 * 1024; i += 256) {
      int r = i >> 10, k = i & 1023;
      float v = (r < 8) ? p.in[I_C][r * 1024 + k] : p.in[I_CCTX][k];
      sc[i] = siluf_(v);
    }
    __syncthreads();
    float* mod = (float*)(p.ws + WB_MOD);
    const int jc = tid & 63, ksl = tid >> 6;
    for (int cb = blockIdx.x; cb < 2 * 6144 / 64; cb += gridDim.x) {
      const int col = cb * 64 + jc;
      const int l = col / 6144, j = col % 6144;
      const float* w = p.in[I_WMOD] + (size_t)l * 1024 * 6144 + j;
      float acc[9];
#pragma unroll
      for (int r = 0; r < 9; ++r) acc[r] = 0.f;
#pragma unroll 8
      for (int k = ksl * 256; k < ksl * 256 + 256; ++k) {
        const float wv = w[(size_t)k * 6144];
#pragma unroll
        for (int r = 0; r < 9; ++r) acc[r] = fmaf(sc[r * 1024 + k], wv, acc[r]);
      }
      __syncthreads();
#pragma unroll
      for (int r = 0; r < 9; ++r) red[(ksl * 64 + jc) * 9 + r] = acc[r];
      __syncthreads();
      if (ksl == 0) {
        const float bv = p.in[I_BMOD][l * 6144 + j];
#pragma unroll
        for (int r = 0; r < 9; ++r)
          mod[((size_t)l * 9 + r) * 6144 + j] = red[jc * 9 + r] + red[(64 + jc) * 9 + r] + red[(128 + jc) * 9 + r] + red[(192 + jc) * 9 + r] + bv;
      }
    }
    __syncthreads();
  }
  bf16_t* WT = (bf16_t*)(p.ws + WB_WT);
  for (int l = 0; l < 2; ++l) {
    bf16_t* W = WT + (size_t)l * WT_LAYER;
    transpose_cvt(p.in[I_WIN] + (size_t)l * DM * INW, INW, [](int n) { return win_srccol(n); }, DM, 6784, W + WT_WIN, smem);
    for (int h = 0; h < 4; ++h) {
      transpose_cvt(p.in[I_MLWQ] + ((size_t)l * 4 + h) * 16384, 128, [](int n) { return n; }, 128, 128, W + WT_WQK + (size_t)h * 256 * 128, smem);
      transpose_cvt(p.in[I_MLWK] + ((size_t)l * 4 + h) * 16384, 128, [](int n) { return n; }, 128, 128, W + WT_WQK + (size_t)h * 256 * 128 + 128 * 128, smem);
    }
    fragpack(p.in[I_GLUW] + (size_t)l * 512 * 512, 512, 512, 512, W + WT_GLU);
    for (int r = 0; r < 3; ++r) fragpack(p.in[I_WBR] + ((size_t)l * 3 + r) * 512 * DM, DM, 512, DM, W + WT_WBR + (size_t)r * 1024 * 512);
    fragpack(p.in[I_WOUT] + (size_t)l * DM * DM, DM, DM, DM, W + WT_WOUT);
    transpose_cvt(p.in[I_PWQ] + (size_t)l * DM * 2048, 2048, [](int n) { return n; }, DM, 2048, W + WT_WQ, smem);
    const float* sk = p.in[I_PSUBK] + (size_t)l * 2 * 128 * 128;
    for (int i = blockIdx.x * 256 + tid; i < 2 * 128 * 128; i += gridDim.x * 256) W[WT_SUBK + i] = f2bf(sk[i]);
  }
}

__device__ __forceinline__ void stage_normmod(const Params& p, int l, int g, int which, int rr_lim, bf16_t* H, float* smem) {
  const int tid = otid(), w = tid >> 6, lane = tid & 63;
  const float* ng = p.in[which ? I_N2G : I_N1G] + l * DM;
  const float* mod = (const float*)(p.ws + WB_MOD) + (size_t)l * 9 * 6144;
  const int off_sh = which ? 3072 : 0, off_sc = which ? 4096 : 1024;
  const int n = GB * rr_lim;
  for (int i0 = (blockIdx.x * 4 + w) * 2; i0 < n; i0 += gridDim.x * 8) {
    float4 v[2][4];
    int bl[2], rr[2];
#pragma unroll
    for (int u = 0; u < 2; ++u) {
      const int i = (i0 + u < n) ? i0 + u : i0;
      bl[u] = i / rr_lim; rr[u] = i % rr_lim;
      const float4* X = (const float4*)((l == 0 && which == 0) ? xrow_in(p, g * GB + bl[u], rr[u]) : xrow(p, g * GB + bl[u], rr[u]));
#pragma unroll
      for (int q = 0; q < 4; ++q) v[u][q] = X[q * 64 + lane];
    }
#pragma unroll
    for (int u = 0; u < 2; ++u) {
      if (i0 + u >= n) break;
      float s = 0.f;
#pragma unroll
      for (int q = 0; q < 4; ++q) s += v[u][q].x * v[u][q].x + v[u][q].y * v[u][q].y + v[u][q].z * v[u][q].z + v[u][q].w * v[u][q].w;
      s = wave_sum(s);
      const float rs = rsqrtf(s * (1.0f / DM) + EPSF);
      const float* m = mod + (size_t)((rr[u] < NLAT) ? (g * GB + bl[u]) : 8) * 6144;
      u32x2* hp = (u32x2*)(H + ((size_t)bl[u] * NTOK + rr[u]) * DM);
#pragma unroll
      for (int q = 0; q < 4; ++q) {
        const float4 gg = ((const float4*)ng)[q * 64 + lane];
        const float4 sc = ((const float4*)(m + off_sc))[q * 64 + lane];
        const float4 sh = ((const float4*)(m + off_sh))[q * 64 + lane];
        const float4 x = v[u][q];
        hp[q * 64 + lane] = (u32x2){pack2(x.x * rs * gg.x * (1.f + sc.x) + sh.x, x.y * rs * gg.y * (1.f + sc.y) + sh.y),
                                    pack2(x.z * rs * gg.z * (1.f + sc.z) + sh.z, x.w * rs * gg.w * (1.f + sc.w) + sh.w)};
      }
    }
  }
}

__device__ __forceinline__ void stage_inproj(const Params& p, const bf16_t* H, const bf16_t* WinT, bf16_t* Z, float* MGT, bf16_t* VT, bf16_t* MVT, char* smem) {
  EPI_DECL
  const int tm = GB * 34, tn = 53;
  const float2* rt = (const float2*)(p.ws + WB_ROPE);
  TileIter ti(tm, tn);
  int mt, j; bool valid;
  while (ti.next(mt, j, valid)) {
    if (!valid) continue;
    const int n0 = j * 128;
    const int lr0 = MT_LR0(mt, 34), rr0 = (mt % 34) * 128;
    f32x16 acc[2][2];
    if ((j >= 8 && j < 12) || (j >= 16 && j < 20)) {
      gemm_tile(WinT + (size_t)n0 * DM, DM, H + (size_t)lr0 * DM, DM, DM, smem, acc);
      bf16_t* vt = ((j < 12) ? VT : MVT) + ((size_t)(mt / 34) * 4 + (j & 3)) * 128 * NTOK;
#pragma unroll
      for (int mi = 0; mi < 2; ++mi)
#pragma unroll
        for (int ni = 0; ni < 2; ++ni)
#pragma unroll
          for (int q = 0; q < 4; ++q) {
            const int e = EPI_ROW(mi), tok = rr0 + EPI_COL(ni, q);
            *(u32x2*)(vt + (size_t)e * NTOK + tok) = (u32x2){pack2(acc[mi][ni][4 * q], acc[mi][ni][4 * q + 1]), pack2(acc[mi][ni][4 * q + 2], acc[mi][ni][4 * q + 3])};
          }
      continue;
    }
    gemm_tile(H + (size_t)lr0 * DM, DM, WinT + (size_t)n0 * DM, DM, DM, smem, acc);
    if (j < 8 && rr0 < NLAT) {
#pragma unroll
      for (int mi = 0; mi < 2; ++mi) {
        const int pos = rr0 + EPI_ROW(mi);
#pragma unroll
        for (int i = 0; i < 16; ++i) {
          const int jj = 8 * (i >> 2) + 4 * fh + (i & 3);
          const float2 cs = rt[pos * 32 + jj];
          const float x1 = acc[mi][0][i], x2 = acc[mi][1][i];
          acc[mi][0][i] = x1 * cs.x - x2 * cs.y;
          acc[mi][1][i] = x1 * cs.y + x2 * cs.x;
        }
      }
    }
    if (j < 52) {
      const bool sg = (j >= 28);
#pragma unroll
      for (int mi = 0; mi < 2; ++mi)
#pragma unroll
        for (int ni = 0; ni < 2; ++ni)
#pragma unroll
          for (int q = 0; q < 4; ++q) {
            const int row = lr0 + EPI_ROW(mi), c = n0 + EPI_COL(ni, q);
            float v0 = acc[mi][ni][4 * q], v1 = acc[mi][ni][4 * q + 1], v2 = acc[mi][ni][4 * q + 2], v3 = acc[mi][ni][4 * q + 3];
            if (sg) { v0 = sigmoidf_(v0); v1 = sigmoidf_(v1); v2 = sigmoidf_(v2); v3 = sigmoidf_(v3); }
            *(u32x2*)(Z + (size_t)row * ZW + c) = (u32x2){pack2(v0, v1), pack2(v2, v3)};
          }
    } else {
#pragma unroll
      for (int mi = 0; mi < 2; ++mi)
#pragma unroll
        for (int q = 0; q < 2; ++q) {
          const int row = lr0 + EPI_ROW(mi), c = EPI_COL(0, q);
          if (wn == 0) *(float4*)(MGT + (size_t)row * 16 + c) = make_float4(acc[mi][0][4 * q], acc[mi][0][4 * q + 1], acc[mi][0][4 * q + 2], acc[mi][0][4 * q + 3]);
        }
    }
  }
}

__device__ __forceinline__ void stage_conv(const Params& p, int l, const bf16_t* Z, bf16_t* XC) {
  const int tid = otid();
  const float* cw = p.in[I_CONVW] + (size_t)l * 3 * 512;
  const float* cb = p.in[I_CONVB] + (size_t)l * 512;
  const int c = tid * 2;
  const float2 w0 = *(const float2*)(cw + c), w1 = *(const float2*)(cw + 512 + c), w2 = *(const float2*)(cw + 1024 + c), bb = *(const float2*)(cb + c);
  for (int lr0 = blockIdx.x * 4; lr0 < RPG; lr0 += gridDim.x * 4) {
    unsigned xc[4], xp[4], xn[4];
#pragma unroll
    for (int u = 0; u < 4; ++u) {
      const int lr = lr0 + u, rr = lr % NTOK;
      const bool has_prev = (rr < NLAT) ? (rr > 0) : (rr > NLAT);
      const bool has_next = (rr < NLAT) ? (rr < NLAT - 1) : (rr < NTOK - 1);
      const bf16_t* z = Z + (size_t)lr * ZW + 1536 + c;
      xc[u] = *(const unsigned*)z;
      xp[u] = has_prev ? *(const unsigned*)(z - ZW) : 0u;
      xn[u] = has_next ? *(const unsigned*)(z + ZW) : 0u;
    }
#pragma unroll
    for (int u = 0; u < 4; ++u) {
      const float a0 = bb.x + w1.x * lo16(xc[u]) + w0.x * lo16(xp[u]) + w2.x * lo16(xn[u]);
      const float a1 = bb.y + w1.y * hi16(xc[u]) + w0.y * hi16(xp[u]) + w2.y * hi16(xn[u]);
      *(unsigned*)(XC + (size_t)(lr0 + u) * 512 + c) = pack2(siluf_(a0), siluf_(a1));
    }
  }
}

__device__ __forceinline__ void stage_mlqk(const bf16_t* XC, const bf16_t* WQK, bf16_t* QM, bf16_t* KM, bf16_t* KMT, char* smem) {
  EPI_DECL
  const int tm = RPG >> 7;
  TileIter ti(tm, 12);
  int mt, r12; bool valid;
  while (ti.next(mt, r12, valid)) {
    if (!valid) continue;
    const int h = r12 & 3, kind = r12 >> 2;
    const int m0 = mt * 128;
    f32x16 acc[2][2];
    const bf16_t* Wt = WQK + (size_t)h * 256 * 128 + (size_t)(kind ? 1 : 0) * 128 * 128;
    const bf16_t* Xt = XC + (size_t)m0 * 512 + h * 128;
    if (kind < 2) {
      gemm_tile(Xt, 512, Wt, 128, 128, smem, acc);
      bf16_t* O = kind ? KM : QM;
      const float alpha = kind ? 1.0f : 0.08838834764831845f;
#pragma unroll
      for (int mi = 0; mi < 2; ++mi)
#pragma unroll
        for (int ni = 0; ni < 2; ++ni)
#pragma unroll
          for (int q = 0; q < 4; ++q) {
            const int row = m0 + EPI_ROW(mi), c = EPI_COL(ni, q);
            *(u32x2*)(O + (size_t)row * 512 + h * 128 + c) = (u32x2){pack2(alpha * acc[mi][ni][4 * q], alpha * acc[mi][ni][4 * q + 1]), pack2(alpha * acc[mi][ni][4 * q + 2], alpha * acc[mi][ni][4 * q + 3])};
          }
    } else {
      gemm_tile(Wt, 128, Xt, 512, 128, smem, acc);
      bf16_t* kt = KMT + ((size_t)(mt / 34) * 4 + h) * 128 * NTOK + (mt % 34) * 128;
#pragma unroll
      for (int mi = 0; mi < 2; ++mi)
#pragma unroll
        for (int ni = 0; ni < 2; ++ni)
#pragma unroll
          for (int q = 0; q < 4; ++q) {
            const int d = EPI_ROW(mi), tok = EPI_COL(ni, q);
            *(u32x2*)(kt + (size_t)d * NTOK + tok) = (u32x2){pack2(acc[mi][ni][4 * q], acc[mi][ni][4 * q + 1]), pack2(acc[mi][ni][4 * q + 2], acc[mi][ni][4 * q + 3])};
          }
    }
  }
}

__device__ __forceinline__ void attn_mfma_item(const Params& p, int l, const bf16_t* Zb, const bf16_t* VTb, bf16_t* YAb, int h, int qrow0, int key0, int nkeys,
                                               float lam, float lam_init, char* smem) {
  const int tid = otid(), lane = tid & 63, w = tid >> 6, fr = lane & 31, fh = lane >> 5;
  const int rb = w & 1, m = w >> 1;
  const int ntiles = nkeys >> 6;
  const int myrow = qrow0 + rb * 32 + fr;
  bf16x8 qf[4];
  {
    const bf16_t* qp = Zb + (size_t)myrow * ZW + h * 128 + m * 64 + fh * 8;
#pragma unroll
    for (int ks = 0; ks < 4; ++ks) qf[ks] = *(const bf16x8*)(qp + ks * 16);
  }
  f32x16 O[4];
#pragma unroll
  for (int eb = 0; eb < 4; ++eb)
#pragma unroll
    for (int i = 0; i < 16; ++i) O[eb][i] = 0.f;
  float mrun = -1e30f, lrun = 0.f;
  const float cs = 0.125f * 1.4426950408889634f;
  const int skey = tid >> 4, sch = tid & 15;
  const bf16_t* ksrc = Zb + (size_t)(key0 + skey) * ZW + 512 + h * 128 + sch * 8;
  const int kdst = skey * 256 + ((sch ^ (skey & 15)) << 4);
  const int se = tid >> 3, svc = tid & 7;
  const bf16_t* vsrc = VTb + ((size_t)h * 128 + se) * NTOK + key0 + svc * 8;
  const int vsw = (se >> 1) & 15;
  const int vdst0 = se * 128 + (((2 * svc) ^ vsw) << 3), vdst1 = se * 128 + (((2 * svc + 1) ^ vsw) << 3);
  const int kfo = fr * 256, kfs = fr & 15;
  const int vfo = fr * 128, vfs = (fr >> 1) & 15;
  u32x4 rk[4], rv[4];
#pragma unroll
  for (int i = 0; i < 4; ++i) rk[i] = *(const u32x4*)(ksrc + (size_t)i * 16 * ZW);
  __syncthreads();
#pragma unroll
  for (int i = 0; i < 4; ++i) *(u32x4*)(smem + kdst + i * 4096) = rk[i];
  __syncthreads();
  bf16x8 pf[4];
#define ATT_S(T) { const char* kb_ = smem + ((T) & 1) * 16384; _Pragma("unroll") for (int kb = 0; kb < 2; ++kb) { \
      _Pragma("unroll") for (int i = 0; i < 16; ++i) S[kb][i] = 0.f; \
      _Pragma("unroll") for (int ks = 0; ks < 4; ++ks) { \
        const bf16x8 kf = *(const bf16x8*)(kb_ + kb * 8192 + kfo + (((m * 8 + ks * 2 + fh) ^ kfs) << 4)); \
        S[kb] = __builtin_amdgcn_mfma_f32_32x32x16_bf16(kf, qf[ks], S[kb], 0, 0, 0); } } }
#define ATT_MAX() { float tm = S[0][0]; \
      _Pragma("unroll") for (int i = 1; i < 16; ++i) tm = fmaxf(tm, S[0][i]); \
      _Pragma("unroll") for (int i = 0; i < 16; ++i) tm = fmaxf(tm, S[1][i]); \
      tm = fmaxf(tm, __shfl_xor(tm, 32)) * cs; alpha = 1.f; \
      if (tm > mrun + 8.0f) { alpha = __builtin_amdgcn_exp2f(mrun - tm); mrun = tm; } }
#define ATT_EXP(PF) { const float mc = mrun; float rs = 0.f; \
      _Pragma("unroll") for (int kb = 0; kb < 2; ++kb) { float pv[16]; \
        _Pragma("unroll") for (int i = 0; i < 16; ++i) { pv[i] = __builtin_amdgcn_exp2f(fmaf(S[kb][i], cs, -mc)); rs += pv[i]; } \
        _Pragma("unroll") for (int hh = 0; hh < 2; ++hh) \
          PF[kb * 2 + hh] = __builtin_bit_cast(bf16x8, (u32x4){pack2(pv[8 * hh], pv[8 * hh + 1]), pack2(pv[8 * hh + 2], pv[8 * hh + 3]), \
                                                               pack2(pv[8 * hh + 4], pv[8 * hh + 5]), pack2(pv[8 * hh + 6], pv[8 * hh + 7])}); } \
      lrun += rs; }
#define ATT_PV(T) { const char* vb_ = smem + 32768 + ((T) & 1) * 16384; _Pragma("unroll") for (int eb = 0; eb < 4; ++eb) _Pragma("unroll") for (int s = 0; s < 4; ++s) { \
        const u32x2 v0 = *(const u32x2*)(vb_ + eb * 4096 + vfo + (((4 * s + fh) ^ vfs) << 3)); \
        const u32x2 v1 = *(const u32x2*)(vb_ + eb * 4096 + vfo + (((4 * s + fh + 2) ^ vfs) << 3)); \
        const bf16x8 vf = __builtin_bit_cast(bf16x8, (u32x4){v0[0], v0[1], v1[0], v1[1]}); \
        O[eb] = __builtin_amdgcn_mfma_f32_32x32x16_bf16(vf, pf[s], O[eb], 0, 0, 0); } }
  f32x16 S[2];
  float alpha;
  {
#pragma unroll
    for (int i = 0; i < 4; ++i) rk[i] = *(const u32x4*)(ksrc + (size_t)(64 + i * 16) * ZW);
#pragma unroll
    for (int i = 0; i < 4; ++i) rv[i] = *(const u32x4*)(vsrc + (size_t)i * 32 * NTOK);
    ATT_S(0)
    ATT_MAX()
    ATT_EXP(pf)
#pragma unroll
    for (int i = 0; i < 4; ++i) *(u32x4*)(smem + 16384 + kdst + i * 4096) = rk[i];
#pragma unroll
    for (int i = 0; i < 4; ++i) {
      *(u32x2*)(smem + 32768 + vdst0 + i * 4096) = (u32x2){rv[i][0], rv[i][1]};
      *(u32x2*)(smem + 32768 + vdst1 + i * 4096) = (u32x2){rv[i][2], rv[i][3]};
    }
    __syncthreads();
  }
#pragma unroll 1
  for (int t = 1; t < ntiles; ++t) {
    const int tn = (t + 1 < ntiles) ? t + 1 : t;
#pragma unroll
    for (int i = 0; i < 4; ++i) rk[i] = *(const u32x4*)(ksrc + (size_t)(tn * 64 + i * 16) * ZW);
#pragma unroll
    for (int i = 0; i < 4; ++i) rv[i] = *(const u32x4*)(vsrc + (size_t)i * 32 * NTOK + t * 64);
    ATT_S(t)
    ATT_MAX()
    if (__any(alpha != 1.f)) {
#pragma unroll
      for (int eb = 0; eb < 4; ++eb)
#pragma unroll
        for (int i = 0; i < 16; ++i) O[eb][i] *= alpha;
      lrun *= alpha;
#pragma unroll
      for (int s = 0; s < 4; ++s) {
        const u32x4 r_ = __builtin_bit_cast(u32x4, pf[s]);
        pf[s] = __builtin_bit_cast(bf16x8, (u32x4){pack2(lo16(r_[0]) * alpha, hi16(r_[0]) * alpha), pack2(lo16(r_[1]) * alpha, hi16(r_[1]) * alpha),
                                                   pack2(lo16(r_[2]) * alpha, hi16(r_[2]) * alpha), pack2(lo16(r_[3]) * alpha, hi16(r_[3]) * alpha)});
      }
    }
    bf16x8 pn[4];
    {
      ATT_PV(t - 1)
      ATT_EXP(pn)
#pragma unroll
      for (int i = 0; i < 16; ++i) {
        __builtin_amdgcn_sched_group_barrier(0x100, 1, 0);
        __builtin_amdgcn_sched_group_barrier(0x008, 1, 0);
        __builtin_amdgcn_sched_group_barrier(0x002, 9, 0);
      }
    }
#pragma unroll
    for (int s = 0; s < 4; ++s) pf[s] = pn[s];
    if (t + 1 < ntiles) {
      char* kd = smem + ((t + 1) & 1) * 16384;
#pragma unroll
      for (int i = 0; i < 4; ++i) *(u32x4*)(kd + kdst + i * 4096) = rk[i];
    }
    {
      char* vd = smem + 32768 + (t & 1) * 16384;
#pragma unroll
      for (int i = 0; i < 4; ++i) {
        *(u32x2*)(vd + vdst0 + i * 4096) = (u32x2){rv[i][0], rv[i][1]};
        *(u32x2*)(vd + vdst1 + i * 4096) = (u32x2){rv[i][2], rv[i][3]};
      }
    }
    __syncthreads();
  }
  ATT_PV(ntiles - 1)
  __syncthreads();
#undef ATT_S
#undef ATT_MAX
#undef ATT_EXP
#undef ATT_PV
  const float lt = lrun + __shfl_xor(lrun, 32);
  const float sc = (m ? lam : 1.0f) / lt;
  float* xo = (float*)smem + rb * 4096;
  if (m == 1) {
#pragma unroll
    for (int eb = 0; eb < 4; ++eb)
#pragma unroll
      for (int i = 0; i < 16; ++i) xo[(eb * 32 + (i & 3) + 8 * (i >> 2) + 4 * fh) * 32 + fr] = O[eb][i] * sc;
  }
  __syncthreads();
  if (m == 0) {
    float ss = 0.f;
#pragma unroll
    for (int eb = 0; eb < 4; ++eb)
#pragma unroll
      for (int i = 0; i < 16; ++i) {
        const float o = O[eb][i] * sc - xo[(eb * 32 + (i & 3) + 8 * (i >> 2) + 4 * fh) * 32 + fr];
        O[eb][i] = o; ss = fmaf(o, o, ss);
      }
    ss += __shfl_xor(ss, 32);
    const float rn = rsqrtf(ss * (1.0f / 128.0f) + EPSF) * (1.0f - lam_init);
    const float* sg = p.in[I_SUBG] + l * 512 + h * 128;
    bf16_t* yp = YAb + (size_t)myrow * 512 + h * 128;
#pragma unroll
    for (int eb = 0; eb < 4; ++eb)
#pragma unroll
      for (int q = 0; q < 4; ++q) {
        const int e = eb * 32 + 8 * q + 4 * fh;
        const float4 g = *(const float4*)(sg + e);
        *(u32x2*)(yp + e) = (u32x2){pack2(O[eb][4 * q] * rn * g.x, O[eb][4 * q + 1] * rn * g.y), pack2(O[eb][4 * q + 2] * rn * g.z, O[eb][4 * q + 3] * rn * g.w)};
      }
  }
  __syncthreads();
}

__device__ __forceinline__ int mlstm_row0(int dir, int c) {
  return (dir == 0) ? ((c < 4) ? NLAT + 64 * c : 64 * (c - 4)) : ((c < 4) ? NLAT + 64 * (3 - c) : 64 * (67 - c));
}
__device__ __forceinline__ void stage_mlgates(const Params& p, int l, const float* MGT, float* GA) {
  const int tid = otid(), w = tid >> 6, lane = tid & 63;
  const int nitems = GB * 4 * 2 * 68;
  for (int idx = blockIdx.x * 4 + w; idx < nitems; idx += gridDim.x * 4) {
    const int c = idx % 68, r1 = idx / 68, dir = r1 & 1, h = (r1 >> 1) & 3, bl = r1 >> 3;
    const int row = mlstm_row0(dir, c) + lane;
    const float* mg = MGT + ((size_t)bl * NTOK + row) * 16;
    const float li = mg[dir * 8 + h] + p.in[I_GATEB][l * 16 + dir * 8 + h];
    const float x = mg[dir * 8 + 4 + h] + p.in[I_GATEB][l * 16 + dir * 8 + 4 + h];
    const float lf = fminf(x, 0.f) - log1pf(expf(-fabsf(x)));
    float b = lf;
#pragma unroll
    for (int o = 1; o < 64; o <<= 1) {
      const float v = (dir == 0) ? __shfl_up(b, o) : __shfl_down(b, o);
      const bool ok = (dir == 0) ? (lane >= o) : (lane + o < 64);
      if (ok) b += v;
    }
    const float tot = (dir == 0) ? __shfl(b, 63) : __shfl(b, 0);
    float* ga = GA + (size_t)idx * 272;
    ga[lane] = b * 1.4426950408889634f; ga[64 + lane] = (li - b) * 1.4426950408889634f; ga[128 + lane] = expf(tot + li - b); ga[192 + lane] = expf(b);
    if (lane < 4) ga[256 + lane] = expf(tot);
  }
}

__device__ __forceinline__ void mlstm_chain_item(const Params& p, int l, const bf16_t* QMb, const bf16_t* KMb, const bf16_t* KMTb, const bf16_t* MVTb,
                                                 const float* GAc, bf16_t* HXb, int h, int dir, int ehalf, char* smem) {
  const int tid = otid(), lane = tid & 63, w = tid >> 6, fr = lane & 31, fh = lane >> 5;
  const int tb = w & 1, xb = w >> 1;
  float* fl = (float*)(smem + 73728);
  float* bs = fl; float* as_ = fl + 64; float* wgs = fl + 128; float* ebs = fl + 192; float* dec_s = fl + 256; float* nprev = fl + 272; float* npart = fl + 400;
  f32x16 CT[2];
#pragma unroll
  for (int eb = 0; eb < 2; ++eb)
#pragma unroll
    for (int i = 0; i < 16; ++i) CT[eb][i] = 0.f;
  __syncthreads();
  { u32x4 z_ = (u32x4){0u, 0u, 0u, 0u}; asm volatile("" : "+v"(z_));
    for (int i = tid; i < 1024; i += 256) ((u32x4*)(smem + 57344))[i] = z_; }
  if (tid < 128) nprev[tid] = 0.f;
  const int qr = tid >> 4, qc = tid & 15;
  const int qdst = qr * 256 + ((qc ^ (qr & 15)) << 4);
  const int tr = tid >> 3, tc = tid & 7;
  const int tdst = tr * 128 + ((tc ^ ((tr >> 1) & 7)) << 4);
  const int sw16 = fr & 15, sw8 = (fr >> 1) & 7;
  u32x4 ra[4], rb[4], rc[4], rd[2];
  float4 rg = make_float4(0.f, 0.f, 0.f, 0.f);
#define ML_LOAD(C_) { const int r0_ = mlstm_row0(dir, (C_)); \
    const bf16_t* qs = QMb + (size_t)(r0_ + qr) * 512 + h * 128 + qc * 8; \
    const bf16_t* ks = KMb + (size_t)(r0_ + qr) * 512 + h * 128 + qc * 8; \
    const bf16_t* kts = KMTb + ((size_t)h * 128 + tr) * NTOK + r0_ + tc * 8; \
    const bf16_t* vts = MVTb + ((size_t)h * 128 + ehalf * 64 + tr) * NTOK + r0_ + tc * 8; \
    _Pragma("unroll") for (int i = 0; i < 4; ++i) { ra[i] = *(const u32x4*)(qs + (size_t)i * 16 * 512); rb[i] = *(const u32x4*)(ks + (size_t)i * 16 * 512); \
                                                    rc[i] = *(const u32x4*)(kts + (size_t)i * 32 * NTOK); } \
    _Pragma("unroll") for (int i = 0; i < 2; ++i) rd[i] = *(const u32x4*)(vts + (size_t)i * 32 * NTOK); \
    if (tid < 68) rg = ((const float4*)(GAc + (size_t)(C_) * 272))[tid]; }
  ML_LOAD(0)
#pragma unroll 1
  for (int c = 0; c < 68; ++c) {
    const int row0 = mlstm_row0(dir, c);
    __syncthreads();
#pragma unroll
    for (int i = 0; i < 4; ++i) {
      *(u32x4*)(smem + qdst + i * 4096) = ra[i];
      *(u32x4*)(smem + 16384 + qdst + i * 4096) = rb[i];
      *(u32x4*)(smem + 32768 + tdst + i * 4096) = rc[i];
    }
#pragma unroll
    for (int i = 0; i < 2; ++i) *(u32x4*)(smem + 49152 + tdst + i * 4096) = rd[i];
    if (tid < 68) ((float4*)fl)[tid] = rg;
    if (c + 1 < 68) ML_LOAD(c + 1)
    __syncthreads();
    const int t = tb * 32 + fr;
    bf16x8 qf[8];
#pragma unroll
    for (int ks = 0; ks < 8; ++ks) qf[ks] = *(const bf16x8*)(smem + t * 256 + (((ks * 2 + fh) ^ sw16) << 4));
    const float bt = bs[t], ebt = ebs[t];
    f32x16 S[2];
    float dsum = 0.f;
#pragma unroll
    for (int sb = 0; sb < 2; ++sb) {
#pragma unroll
      for (int i = 0; i < 16; ++i) S[sb][i] = 0.f;
      const bool valid = (dir == 0) ? (sb <= tb) : (sb >= tb);
      if (valid) {
#pragma unroll
        for (int ks = 0; ks < 8; ++ks) {
          const bf16x8 kf = *(const bf16x8*)(smem + 16384 + (sb * 32 + fr) * 256 + (((ks * 2 + fh) ^ sw16) << 4));
          S[sb] = __builtin_amdgcn_mfma_f32_32x32x16_bf16(kf, qf[ks], S[sb], 0, 0, 0);
        }
#pragma unroll
        for (int q = 0; q < 4; ++q) {
          const float4 a4 = *(const float4*)(as_ + sb * 32 + 8 * q + 4 * fh);
          const float av[4] = {a4.x, a4.y, a4.z, a4.w};
#pragma unroll
          for (int j = 0; j < 4; ++j) {
            const int s = sb * 32 + 8 * q + 4 * fh + j;
            const bool ok = (dir == 0) ? (s <= t) : (s >= t);
            const float v = ok ? S[sb][4 * q + j] * __builtin_amdgcn_exp2f(bt + av[j]) : 0.f;
            S[sb][4 * q + j] = v;
            dsum += v;
          }
        }
      }
    }
    bf16x8 pf[4];
#pragma unroll
    for (int sb = 0; sb < 2; ++sb)
#pragma unroll
      for (int hh = 0; hh < 2; ++hh)
        pf[sb * 2 + hh] = __builtin_bit_cast(bf16x8, (u32x4){pack2(S[sb][8 * hh], S[sb][8 * hh + 1]), pack2(S[sb][8 * hh + 2], S[sb][8 * hh + 3]),
                                                                 pack2(S[sb][8 * hh + 4], S[sb][8 * hh + 5]), pack2(S[sb][8 * hh + 6], S[sb][8 * hh + 7])});
    float nq = 0.f;
#pragma unroll
    for (int c8 = 0; c8 < 8; ++c8) {
      const u32x4 qv = *(const u32x4*)(smem + t * 256 + (((fh * 8 + c8) ^ sw16) << 4));
      const float4 n0 = *(const float4*)(nprev + fh * 64 + c8 * 8), n1 = *(const float4*)(nprev + fh * 64 + c8 * 8 + 4);
      nq = fmaf(lo16(qv[0]), n0.x, nq); nq = fmaf(hi16(qv[0]), n0.y, nq); nq = fmaf(lo16(qv[1]), n0.z, nq); nq = fmaf(hi16(qv[1]), n0.w, nq);
      nq = fmaf(lo16(qv[2]), n1.x, nq); nq = fmaf(hi16(qv[2]), n1.y, nq); nq = fmaf(lo16(qv[3]), n1.z, nq); nq = fmaf(hi16(qv[3]), n1.w, nq);
    }
    dsum += __shfl_xor(dsum, 32);
    nq += __shfl_xor(nq, 32);
    const float den = dsum + ebt * nq;
    const float inv = 1.0f / fmaxf(fabsf(den), 1.0f);
    {
      f32x16 N;
#pragma unroll
      for (int i = 0; i < 16; ++i) N[i] = 0.f;
#pragma unroll
      for (int ks = 0; ks < 8; ++ks) {
        const bf16x8 cf = *(const bf16x8*)(smem + 57344 + (xb * 32 + fr) * 256 + (((ks * 2 + fh) ^ sw16) << 4));
        N = __builtin_amdgcn_mfma_f32_32x32x16_bf16(cf, qf[ks], N, 0, 0, 0);
      }
#pragma unroll
      for (int i = 0; i < 16; ++i) N[i] *= ebt;
#pragma unroll
      for (int s4 = 0; s4 < 4; ++s4) {
        const bool valid = (dir == 0) ? ((s4 >> 1) <= tb) : ((s4 >> 1) >= tb);
        if (valid) {
          const int u0 = 4 * s4 + fh, u1 = u0 + 2;
          const char* vrow = smem + 49152 + (xb * 32 + fr) * 128;
          const u32x2 v0 = *(const u32x2*)(vrow + (((u0 >> 1) ^ sw8) << 4) + (u0 & 1) * 8);
          const u32x2 v1 = *(const u32x2*)(vrow + (((u1 >> 1) ^ sw8) << 4) + (u1 & 1) * 8);
          const bf16x8 vf = __builtin_bit_cast(bf16x8, (u32x4){v0[0], v0[1], v1[0], v1[1]});
          N = __builtin_amdgcn_mfma_f32_32x32x16_bf16(vf, pf[s4], N, 0, 0, 0);
        }
      }
      bf16_t* hp = HXb + (size_t)(row0 + t) * 512 + h * 128 + (2 * ehalf + xb) * 32 + 4 * fh;
#pragma unroll
      for (int q = 0; q < 4; ++q)
        *(u32x2*)(hp + 8 * q) = (u32x2){pack2(N[4 * q] * inv, N[4 * q + 1] * inv), pack2(N[4 * q + 2] * inv, N[4 * q + 3] * inv)};
    }
    const float decay = *dec_s;
#pragma unroll
    for (int eb = 0; eb < 2; ++eb)
#pragma unroll
      for (int i = 0; i < 16; ++i) CT[eb][i] *= decay;
#pragma unroll
    for (int ks = 0; ks < 4; ++ks) {
      const u32x4 kraw = *(const u32x4*)(smem + 32768 + (w * 32 + fr) * 128 + (((ks * 2 + fh) ^ sw8) << 4));
      const float4 g0 = *(const float4*)(wgs + ks * 16 + 8 * fh), g1 = *(const float4*)(wgs + ks * 16 + 8 * fh + 4);
      const bf16x8 kts = __builtin_bit_cast(bf16x8, (u32x4){pack2(lo16(kraw[0]) * g0.x, hi16(kraw[0]) * g0.y), pack2(lo16(kraw[1]) * g0.z, hi16(kraw[1]) * g0.w),
                                                             pack2(lo16(kraw[2]) * g1.x, hi16(kraw[2]) * g1.y), pack2(lo16(kraw[3]) * g1.z, hi16(kraw[3]) * g1.w)});
#pragma unroll
      for (int eb = 0; eb < 2; ++eb) {
        const bf16x8 vt = *(const bf16x8*)(smem + 49152 + (eb * 32 + fr) * 128 + (((ks * 2 + fh) ^ sw8) << 4));
        CT[eb] = __builtin_amdgcn_mfma_f32_32x32x16_bf16(kts, vt, CT[eb], 0, 0, 0);
      }
    }
    {
      const int d = tid & 127, sh = tid >> 7;
      float a = 0.f;
#pragma unroll 8
      for (int s = sh * 32; s < sh * 32 + 32; ++s) {
        const bf16_t kv = *(const bf16_t*)(smem + 16384 + s * 256 + ((((d >> 3)) ^ (s & 15)) << 4) + (d & 7) * 2);
        a = fmaf(wgs[s], bf2f(kv), a);
      }
      npart[sh * 128 + d] = a;
    }
    __syncthreads();
#pragma unroll
    for (int eb = 0; eb < 2; ++eb)
#pragma unroll
      for (int q = 0; q < 4; ++q)
        *(u32x2*)(smem + 57344 + (eb * 32 + fr) * 256 + ((((w * 4 + q)) ^ sw16) << 4) + 8 * fh) =
            (u32x2){pack2(CT[eb][4 * q], CT[eb][4 * q + 1]), pack2(CT[eb][4 * q + 2], CT[eb][4 * q + 3])};
    if (tid < 128) nprev[tid] = decay * nprev[tid] + npart[tid] + npart[128 + tid];
  }
#undef ML_LOAD
  __syncthreads();
}

#define S5SEG 128
#define S5NSEG 34
__device__ __forceinline__ int s5_row(int dir, int step) {
  return (dir == 0) ? ((step < NCTX) ? NLAT + step : step - NCTX)
                    : ((step < NCTX) ? NLAT + (NCTX - 1 - step) : (NLAT - 1) - (step - NCTX));
}
__device__ __forceinline__ bf16x8 pack8(const float* f) {
  return __builtin_bit_cast(bf16x8, (u32x4){pack2(f[0], f[1]), pack2(f[2], f[3]), pack2(f[4], f[5]), pack2(f[6], f[7])});
}
struct S5M { float abr, abi, a128r, a128i; bf16x8 bbf[4]; };
__device__ __forceinline__ void s5m_setup(const Params& p, int pg, int lane, S5M& m) {
  const int fr = lane & 31, fh = lane >> 5;
  const float dt = expf(p.in[I_S5DT][pg]);
  m.abr = 0.f; m.abi = 0.f; m.a128r = 0.f; m.a128i = 0.f;
#pragma unroll
  for (int c = 0; c < 2; ++c) {
    const int n = fr + 32 * c;
    const float lre = p.in[I_S5LRE][pg * 64 + n], lim = p.in[I_S5LIM][pg * 64 + n];
    const float mag = expf(lre * dt);
    const float abr = mag * cosf(lim * dt), abi = mag * sinf(lim * dt);
    const float den = lre * lre + lim * lim;
    const float zr = ((abr - 1.0f) * lre + abi * lim) / den;
    const float zi = (abi * lre - (abr - 1.0f) * lim) / den;
    const float4* br4 = (const float4*)(p.in[I_S5BRE] + ((size_t)pg * 64 + n) * 16 + 8 * fh);
    const float4* bi4 = (const float4*)(p.in[I_S5BIM] + ((size_t)pg * 64 + n) * 16 + 8 * fh);
    const float4 b0 = br4[0], b1 = br4[1], c0 = bi4[0], c1 = bi4[1];
    const float br[8] = {b0.x, b0.y, b0.z, b0.w, b1.x, b1.y, b1.z, b1.w}, bi[8] = {c0.x, c0.y, c0.z, c0.w, c1.x, c1.y, c1.z, c1.w};
    float rr[8], ii[8];
#pragma unroll
    for (int j = 0; j < 8; ++j) { rr[j] = zr * br[j] - zi * bi[j]; ii[j] = zr * bi[j] + zi * br[j]; }
    m.bbf[c] = pack8(rr); m.bbf[2 + c] = pack8(ii);
    if (fh == c) {
      m.abr = abr; m.abi = abi;
      const float mg = expf(lre * dt * (float)S5SEG);
      m.a128r = mg * cosf(lim * dt * (float)S5SEG); m.a128i = mg * sinf(lim * dt * (float)S5SEG);
    }
  }
}
template <bool STORE>
__device__ __forceinline__ void s5m_block(const S5M& m, const bf16x8 uf, float& xr, float& xi, char* xs, int lane) {
  f32x16 T[4];
#pragma unroll
  for (int k = 0; k < 4; ++k) {
#pragma unroll
    for (int i = 0; i < 16; ++i) T[k][i] = 0.f;
    T[k] = __builtin_amdgcn_mfma_f32_32x32x16_bf16(uf, m.bbf[k], T[k], 0, 0, 0);
  }
#pragma unroll
  for (int r = 0; r < 16; ++r) {
    auto a = __builtin_amdgcn_permlane32_swap(__float_as_uint(T[0][r]), __float_as_uint(T[1][r]), false, false);
    T[0][r] = __uint_as_float(a[0]); T[1][r] = __uint_as_float(a[1]);
    auto b = __builtin_amdgcn_permlane32_swap(__float_as_uint(T[2][r]), __float_as_uint(T[3][r]), false, false);
    T[2][r] = __uint_as_float(b[0]); T[3][r] = __uint_as_float(b[1]);
  }
#pragma unroll
  for (int q = 0; q < 4; ++q)
#pragma unroll
    for (int hh = 0; hh < 2; ++hh)
#pragma unroll
      for (int j = 0; j < 4; ++j) {
        const int t = 8 * q + 4 * hh + j, r = 4 * q + j;
        const float bre = hh ? T[1][r] : T[0][r], bim = hh ? T[3][r] : T[2][r];
        const float nr = fmaf(m.abr, xr, fmaf(-m.abi, xi, bre));
        const float ni = fmaf(m.abr, xi, fmaf(m.abi, xr, bim));
        xr = nr; xi = ni;
        if (STORE) *(unsigned*)(xs + t * 256 + (((lane >> 2) ^ (t & 15)) << 4) + (lane & 3) * 4) = pack2(xr, xi);
      }
}
__device__ __forceinline__ void stage_s5_pass1(const Params& p, int l, const bf16_t* Z, float* XE) {
  const int tid = otid(), w = tid >> 6, lane = tid & 63, fr = lane & 31, fh = lane >> 5;
  const int nitems = GB * 32 * 2 * (S5NSEG - 1);
  for (int idx = blockIdx.x * 4 + w; idx < nitems; idx += gridDim.x * 4) {
    const int seg = idx % (S5NSEG - 1), r1 = idx / (S5NSEG - 1), dir = r1 & 1, g = (r1 >> 1) & 31, bl = r1 >> 6;
    S5M m;
    s5m_setup(p, (l * 2 + dir) * 32 + g, lane, m);
    float xr = 0.f, xi = 0.f;
    bf16x8 ufs[S5SEG / 32];
#pragma unroll
    for (int sub = 0; sub < S5SEG / 32; ++sub) {
      const int row = s5_row(dir, seg * S5SEG + sub * 32 + fr);
      ufs[sub] = *(const bf16x8*)(Z + ((size_t)bl * NTOK + row) * ZW + 3072 + g * 16 + 8 * fh);
    }
#pragma unroll
    for (int sub = 0; sub < S5SEG / 32; ++sub) s5m_block<false>(m, ufs[sub], xr, xi, nullptr, lane);
    float* xe = XE + ((((size_t)bl * 32 + g) * 2 + dir) * (S5NSEG - 1) + seg) * 128;
    xe[lane] = xr; xe[64 + lane] = xi;
  }
}
__device__ __forceinline__ void s5_item(const Params& p, int l, const bf16_t* Zb, const float* XEc, float* Yb, int g, int dir, int sq, char* smem) {
  const int tid = otid(), w = tid >> 6, lane = tid & 63, fr = lane & 31, fh = lane >> 5;
  const int seg = sq * 4 + w;
  char* xs = smem + w * 8192;
  const int pg = (l * 2 + dir) * 32 + g;
  __syncthreads();
  if (seg < S5NSEG) {
    S5M m;
    s5m_setup(p, pg, lane, m);
    bf16x8 ccf[8];
#pragma unroll
    for (int ks = 0; ks < 8; ++ks) {
      float f[8] = {0.f, 0.f, 0.f, 0.f, 0.f, 0.f, 0.f, 0.f};
      if (fr < 16) {
        const float4 cr = *(const float4*)(p.in[I_S5CRE] + ((size_t)pg * 16 + fr) * 64 + ks * 8 + 4 * fh);
        const float4 ci = *(const float4*)(p.in[I_S5CIM] + ((size_t)pg * 16 + fr) * 64 + ks * 8 + 4 * fh);
        f[0] = cr.x; f[1] = -ci.x; f[2] = cr.y; f[3] = -ci.y; f[4] = cr.z; f[5] = -ci.z; f[6] = cr.w; f[7] = -ci.w;
      }
      ccf[ks] = pack8(f);
    }
    float xr = 0.f, xi = 0.f;
    for (int j = 0; j < seg; ++j) {
      const float er = XEc[j * 128 + lane], ei = XEc[j * 128 + 64 + lane];
      const float nr = m.a128r * xr - m.a128i * xi + er, ni = m.a128r * xi + m.a128i * xr + ei;
      xr = nr; xi = ni;
    }
    bf16x8 ufs[S5SEG / 32];
#pragma unroll
    for (int sub = 0; sub < S5SEG / 32; ++sub) {
      const int row = s5_row(dir, seg * S5SEG + sub * 32 + fr);
      ufs[sub] = *(const bf16x8*)(Zb + (size_t)row * ZW + 3072 + g * 16 + 8 * fh);
    }
#pragma unroll
    for (int sub = 0; sub < S5SEG / 32; ++sub) {
      const int row = s5_row(dir, seg * S5SEG + sub * 32 + fr);
      const bf16x8 uf = ufs[sub];
      s5m_block<true>(m, uf, xr, xi, xs, lane);
      f32x16 Y;
#pragma unroll
      for (int i = 0; i < 16; ++i) Y[i] = 0.f;
#pragma unroll
      for (int ks = 0; ks < 8; ++ks) {
        const bf16x8 xf = *(const bf16x8*)(xs + fr * 256 + (((ks * 2 + fh) ^ (fr & 15)) << 4));
        Y = __builtin_amdgcn_mfma_f32_32x32x16_bf16(ccf[ks], xf, Y, 0, 0, 0);
      }
      float* yp = Yb + (size_t)row * 512 + g * 16 + 4 * fh;
      *(float4*)yp = make_float4(Y[0], Y[1], Y[2], Y[3]);
      *(float4*)(yp + 8) = make_float4(Y[4], Y[5], Y[6], Y[7]);
    }
  }
}

__device__ __forceinline__ void stage_post(const Params& p, int l, int rr_lim, const bf16_t* Z, const bf16_t* HF, const bf16_t* HB,
                                           const float* YSF, const float* YSB, bf16_t* YB, bf16_t* GG) {
  const int tid = otid();
  const int c0 = tid * 2;
  const float2 gml = *(const float2*)(p.in[I_MLNG] + l * 512 + c0);
  const float2 dsk = *(const float2*)(p.in[I_S5D] + l * 512 + c0);
  const int n = GB * rr_lim;
  for (int i0 = blockIdx.x * 4; i0 < n; i0 += gridDim.x * 4) {
    unsigned a0[4], a1[4], og[4], uu[4];
    float2 f[4], b[4];
    size_t r[4];
#pragma unroll
    for (int u = 0; u < 4; ++u) {
      const int i = i0 + u;
      r[u] = (size_t)(i / rr_lim) * NTOK + (i % rr_lim);
      a0[u] = *(const unsigned*)(HF + r[u] * 512 + c0); a1[u] = *(const unsigned*)(HB + r[u] * 512 + c0);
      og[u] = *(const unsigned*)(Z + r[u] * ZW + 2560 + c0); uu[u] = *(const unsigned*)(Z + r[u] * ZW + 3072 + c0);
      f[u] = *(const float2*)(YSF + r[u] * 512 + c0); b[u] = *(const float2*)(YSB + r[u] * 512 + c0);
    }
#pragma unroll
    for (int u = 0; u < 4; ++u) {
      const float h0 = lo16(a0[u]) + lo16(a1[u]), h1 = hi16(a0[u]) + hi16(a1[u]);
      const float ss = wave_sum(h0 * h0 + h1 * h1);
      const float rs = rsqrtf(ss * (1.0f / 128.0f) + EPSF);
      *(unsigned*)(YB + r[u] * 512 + c0) = pack2(h0 * rs * gml.x * sigmoidf_(lo16(og[u])), h1 * rs * gml.y * sigmoidf_(hi16(og[u])));
      *(unsigned*)(GG + r[u] * 512 + c0) = pack2(geluf_(dsk.x * lo16(uu[u]) + f[u].x + b[u].x), geluf_(dsk.y * hi16(uu[u]) + f[u].y + b[u].y));
    }
  }
}

__device__ __forceinline__ void stage_glu_mfma(const Params& p, int l, int tpb, const bf16_t* GG, const bf16_t* GLUT, bf16_t* YS, char* smem) {
  EPI_DECL
  const int tm = GB * tpb;
  TileIter ti(tm, 4);
  int mt_, nt_; bool valid;
  while (ti.next(mt_, nt_, valid)) {
    if (!valid) continue;
    const int m0 = MT_LR0(mt_, tpb), n0 = nt_ * 128;
    f32x16 acc[2][2];
    gemm_tile(GG + (size_t)m0 * 512, 512, GLUT + (size_t)n0 * 512, 512, 512, smem, acc);
#pragma unroll
    for (int mi = 0; mi < 2; ++mi)
#pragma unroll
      for (int ni = 0; ni < 2; ++ni)
#pragma unroll
        for (int q = 0; q < 4; ++q) {
          const int row = m0 + EPI_ROW(mi), c = n0 + EPI_COL(ni, q);
          const float4 b = *(const float4*)(p.in[I_GLUB] + l * 512 + c);
          const u32x2 g2 = *(const u32x2*)(GG + (size_t)row * 512 + c);
          const float o0 = lo16(g2[0]) * sigmoidf_(acc[mi][ni][4 * q] + b.x), o1 = hi16(g2[0]) * sigmoidf_(acc[mi][ni][4 * q + 1] + b.y);
          const float o2 = lo16(g2[1]) * sigmoidf_(acc[mi][ni][4 * q + 2] + b.z), o3 = hi16(g2[1]) * sigmoidf_(acc[mi][ni][4 * q + 3] + b.w);
          *(u32x2*)(YS + (size_t)row * 512 + c) = (u32x2){pack2(o0, o1), pack2(o2, o3)};
        }
  }
}

__device__ __forceinline__ void stage_merge_mfma(int tpb, const bf16_t* YA, const bf16_t* YB, const bf16_t* YS, const bf16_t* WBR, const bf16_t* Z, bf16_t* MG, char* smem) {
  EPI_DECL
  const int tm = GB * tpb;
  TileIter ti(tm, 8);
  int mt_, nt_; bool valid;
  while (ti.next(mt_, nt_, valid)) {
    if (!valid) continue;
    const int m0 = MT_LR0(mt_, tpb), n0 = nt_ * 128;
    f32x16 macc[2][2];
#pragma unroll
    for (int a = 0; a < 2; ++a)
#pragma unroll
      for (int b = 0; b < 2; ++b)
#pragma unroll
        for (int i = 0; i < 16; ++i) macc[a][b][i] = 0.f;
#pragma unroll 1
    for (int r = 0; r < 3; ++r) {
      const bf16_t* Y = (r == 0) ? YA : (r == 1 ? YB : YS);
      f32x16 acc[2][2];
      gemm_tile(Y + (size_t)m0 * 512, 512, WBR + (size_t)r * 1024 * 512 + (size_t)n0 * 512, 512, 512, smem, acc);
#pragma unroll
      for (int mi = 0; mi < 2; ++mi)
#pragma unroll
        for (int ni = 0; ni < 2; ++ni)
#pragma unroll
          for (int q = 0; q < 4; ++q) {
            const int row = m0 + EPI_ROW(mi), c = n0 + EPI_COL(ni, q);
            const u32x2 e = *(const u32x2*)(Z + (size_t)row * ZW + 3584 + r * 1024 + c);
            macc[mi][ni][4 * q] += lo16(e[0]) * acc[mi][ni][4 * q];
            macc[mi][ni][4 * q + 1] += hi16(e[0]) * acc[mi][ni][4 * q + 1];
            macc[mi][ni][4 * q + 2] += lo16(e[1]) * acc[mi][ni][4 * q + 2];
            macc[mi][ni][4 * q + 3] += hi16(e[1]) * acc[mi][ni][4 * q + 3];
          }
    }
#pragma unroll
    for (int mi = 0; mi < 2; ++mi)
#pragma unroll
      for (int ni = 0; ni < 2; ++ni)
#pragma unroll
        for (int q = 0; q < 4; ++q) {
          const int row = m0 + EPI_ROW(mi), c = n0 + EPI_COL(ni, q);
          *(u32x2*)(MG + (size_t)row * DM + c) = (u32x2){pack2(macc[mi][ni][4 * q], macc[mi][ni][4 * q + 1]), pack2(macc[mi][ni][4 * q + 2], macc[mi][ni][4 * q + 3])};
        }
  }
}

__device__ __forceinline__ void stage_outproj_mfma(const Params& p, int l, int g, int tpb, const bf16_t* MG, const bf16_t* WOUT, char* smem) {
  EPI_DECL
  const int tm = GB * tpb;
  const float* mod = (const float*)(p.ws + WB_MOD) + (size_t)l * 9 * 6144;
  TileIter ti(tm, 8);
  int mt, nt_; bool valid;
  while (ti.next(mt, nt_, valid)) {
    if (!valid) continue;
    const int n0 = nt_ * 128;
    const int m0 = MT_LR0(mt, tpb), bl = mt / tpb, rr0 = (mt % tpb) * 128, b = g * GB + bl;
    f32x16 acc[2][2];
    gemm_tile(MG + (size_t)m0 * DM, DM, WOUT + (size_t)n0 * DM, DM, DM, smem, acc);
    const float* gv = mod + (size_t)((rr0 < NLAT) ? b : 8) * 6144 + 2 * 1024;
#pragma unroll
    for (int mi = 0; mi < 2; ++mi)
#pragma unroll
      for (int ni = 0; ni < 2; ++ni)
#pragma unroll
        for (int q = 0; q < 4; ++q) {
          const int rr = rr0 + EPI_ROW(mi), c = n0 + EPI_COL(ni, q);
          const float4 gg = *(const float4*)(gv + c);
          float4* xp = (float4*)(xrow(p, b, rr) + c);
          float4 x = (l == 0) ? *(const float4*)(xrow_in(p, b, rr) + c) : *xp;
          x.x += gg.x * acc[mi][ni][4 * q]; x.y += gg.y * acc[mi][ni][4 * q + 1]; x.z += gg.z * acc[mi][ni][4 * q + 2]; x.w += gg.w * acc[mi][ni][4 * q + 3];
          *xp = x;
        }
  }
}

#define CH_SW(m_, chunk_) ((((chunk_) ^ ((m_) & 15))) << 4)
template <int KC, bool X2, class BF, class AF, class PF, class EF>
__device__ __forceinline__ void cphase(const int nseg, const int lane, const bf16_t* __restrict__ Wb, BF bofs, AF abase, PF pre, EF epi) {
  const int half = lane >> 5, m = lane & 31, sw = lane & 15, sw2 = lane & 1;
  bf16x8 bs[4][2][4];
  const int S = nseg * KC;
  const int crot = ((blockIdx.x >> 3) * 3 + (otid() >> 6) * 5) & (KC - 1);
#define CH_LD(ST, s_) { const int sg_ = (s_) / KC, c_ = ((s_) + crot) % KC; unsigned o0_ = bofs(sg_) + 4096u * c_ + lane * 16; asm volatile("" : "+v"(o0_)); \
    unsigned o1_ = o0_ + KC * 4096u; asm volatile("" : "+v"(o1_)); \
    _Pragma("unroll") for (int ks_ = 0; ks_ < 4; ++ks_) { bs[ST][0][ks_] = *(const bf16x8*)((const char*)Wb + o0_ + 1024 * ks_); bs[ST][1][ks_] = *(const bf16x8*)((const char*)Wb + o1_ + 1024 * ks_); } }
#define CH_LA(DST, s_) { const int sg_ = (s_) / KC, c_ = ((s_) + crot) % KC; const char* ab_ = abase(sg_); \
    _Pragma("unroll") for (int ks_ = 0; ks_ < 4; ++ks_) DST[ks_] = *(const bf16x8*)(ab_ + m * (KC * 128) + (((8 * c_ + 4 * half + ks_) ^ sw) << 4)); }
#define CH_LA2(DST2, s_) { const int sg_ = (s_) / KC, c_ = ((s_) + crot) % KC; const char* ab_ = abase(sg_); \
    _Pragma("unroll") for (int ks_ = 0; ks_ < 4; ++ks_) DST2[ks_] = *(const bf16x8*)(ab_ + (32 + sw2) * (KC * 128) + (((8 * c_ + 4 * half + ks_) ^ sw2) << 4)); }
  CH_LD(0, 0) CH_LD(1, 1) CH_LD(2, 2)
  bf16x8 ac[4];
  CH_LA(ac, 0)
  f32x16 acc[2], acc2[2];
#pragma unroll
  for (int f = 0; f < 2; ++f)
#pragma unroll
    for (int i = 0; i < 16; ++i) { acc[f][i] = 0.f; acc2[f][i] = 0.f; }
#pragma unroll 1
  for (int s0 = 0; s0 < S; s0 += 4) {
#pragma unroll
    for (int j = 0; j < 4; ++j) {
      const int s = s0 + j;
      if (s + 3 < S) CH_LD((j + 3) & 3, s + 3)
      bf16x8 an[4], ac2[4];
      if (X2) CH_LA2(ac2, s)
      { const int sn = (s + 1 < S) ? s + 1 : s; CH_LA(an, sn) }
      const int sg = s / KC, c = s % KC;
#pragma unroll
      for (int ks = 0; ks < 4; ++ks)
#pragma unroll
        for (int f = 0; f < 2; ++f) acc[f] = __builtin_amdgcn_mfma_f32_32x32x16_bf16(bs[j][f][ks], ac[ks], acc[f], 0, 0, 0);
      if (X2) {
#pragma unroll
        for (int ks = 0; ks < 4; ++ks)
#pragma unroll
          for (int f = 0; f < 2; ++f) acc2[f] = __builtin_amdgcn_mfma_f32_32x32x16_bf16(bs[j][f][ks], ac2[ks], acc2[f], 0, 0, 0);
      }
      if (j == 3 && c == KC - 5) pre(sg);
      if (j == 3 && c == KC - 1) {
        epi(sg, acc, acc2);
#pragma unroll
        for (int f = 0; f < 2; ++f)
#pragma unroll
          for (int i = 0; i < 16; ++i) { acc[f][i] = 0.f; acc2[f][i] = 0.f; }
      }
#pragma unroll
      for (int ks = 0; ks < 4; ++ks) ac[ks] = an[ks];
    }
  }
#undef CH_LD
#undef CH_LA
#undef CH_LA2
}

template <bool X2>
__device__ __forceinline__ void stage_chain1(const Params& p, int l, int g, const bf16_t* Z, const bf16_t* HF, const bf16_t* HB,
                                             const float* YSF, const float* YSB, const bf16_t* YA, bf16_t* MG, bf16_t* H2, const bf16_t* W, char* smem) {
  constexpr int RT = X2 ? 34 : 32;
#define CH_LANE const int tid = otid(), w = tid >> 6, lane = tid & 63, m = lane & 31, half = lane >> 5, m2 = 32 + (lane & 1), rot = blockIdx.x >> 3; const bool v2 = X2 && m < 2; \
    (void)w; (void)m; (void)half; (void)m2; (void)rot; (void)v2;
  const int tpb = (X2 ? NTOK : NLAT) / RT, ntile = GB * tpb;
  const float* mod = (const float*)(p.ws + WB_MOD) + (size_t)l * 9 * 6144;
  const bf16_t* GLUT = W + WT_GLU; const bf16_t* WBR = W + WT_WBR; const bf16_t* WOUT = W + WT_WOUT;
  char* R0 = smem; char* R1 = smem + RT * 1024; char* R2 = smem + 2 * RT * 1024;
  for (int t = blockIdx.x; t < ntile; t += gridDim.x) {
#define CH_TILE int t_ = t; asm volatile("" : "+s"(t_)); const int bl = t_ / tpb, rr0 = (t_ % tpb) * RT, b = g * GB + bl; const size_t lr0 = (size_t)bl * NTOK + rr0; (void)b; (void)lr0; (void)rr0;
    __syncthreads();
    for (int i0 = 0; i0 < RT; i0 += 8) {
      CH_TILE
      CH_LANE
      const int c0 = tid * 2;
      const float2 gml = *(const float2*)(p.in[I_MLNG] + l * 512 + c0);
      const float2 dsk = *(const float2*)(p.in[I_S5D] + l * 512 + c0);
      unsigned a0[8], a1[8], og[8], uu[8];
      float2 f[8], bb[8];
#pragma unroll
      for (int u = 0; u < 8; ++u) {
        const int mm = (i0 + u < RT) ? i0 + u : RT - 1;
        const size_t r = lr0 + mm;
        a0[u] = *(const unsigned*)(HF + r * 512 + c0); a1[u] = *(const unsigned*)(HB + r * 512 + c0);
        og[u] = *(const unsigned*)(Z + r * ZW + 2560 + c0); uu[u] = *(const unsigned*)(Z + r * ZW + 3072 + c0);
        f[u] = *(const float2*)(YSF + r * 512 + c0); bb[u] = *(const float2*)(YSB + r * 512 + c0);
      }
#pragma unroll
      for (int u = 0; u < 8; ++u) {
        const float h0 = lo16(a0[u]) + lo16(a1[u]), h1 = hi16(a0[u]) + hi16(a1[u]);
        const float ss = wave_sum(h0 * h0 + h1 * h1);
        const float rs = rsqrtf(ss * (1.0f / 128.0f) + EPSF);
        const int mm = (i0 + u < RT) ? i0 + u : RT - 1, off = mm * 1024 + CH_SW(mm, c0 >> 3) + (c0 & 7) * 2;
        *(unsigned*)(R1 + off) = pack2(h0 * rs * gml.x * sigmoidf_(lo16(og[u])), h1 * rs * gml.y * sigmoidf_(hi16(og[u])));
        *(unsigned*)(R0 + off) = pack2(geluf_(dsk.x * lo16(uu[u]) + f[u].x + bb[u].x), geluf_(dsk.y * hi16(uu[u]) + f[u].y + bb[u].y));
      }
    }
    __syncthreads();
    {
      CH_LANE
      float4 bv[2][4];
      cphase<8, X2>(2, lane, GLUT,
        [&](int sg) __attribute__((always_inline)) { const int cb = (w * 2 + sg + rot) & 7; return (unsigned)(cb * 2) * (8u * 4096u); },
        [&](int sg) __attribute__((always_inline)) { return (const char*)R0; },
        [&](int sg) __attribute__((always_inline)) {
          const int n0 = ((w * 2 + sg + rot) & 7) * 64;
#pragma unroll
          for (int f = 0; f < 2; ++f)
#pragma unroll
            for (int q = 0; q < 4; ++q) bv[f][q] = *(const float4*)(p.in[I_GLUB] + l * 512 + n0 + f * 32 + 8 * q + 4 * half);
        },
        [&](int sg, f32x16 (&acc)[2], f32x16 (&acc2)[2]) __attribute__((always_inline)) {
          const int n0 = ((w * 2 + sg + rot) & 7) * 64;
          auto body = [&](f32x16 (&a)[2], int mr) __attribute__((always_inline)) {
#pragma unroll
            for (int f = 0; f < 2; ++f)
#pragma unroll
              for (int q = 0; q < 4; ++q) {
                const int c = n0 + f * 32 + 8 * q + 4 * half;
                const int off = mr * 1024 + CH_SW(mr, c >> 3) + 8 * half;
                const u32x2 g2 = *(const u32x2*)(R0 + off);
                const float o0 = lo16(g2[0]) * sigmoidf_(a[f][4 * q] + bv[f][q].x), o1 = hi16(g2[0]) * sigmoidf_(a[f][4 * q + 1] + bv[f][q].y);
                const float o2 = lo16(g2[1]) * sigmoidf_(a[f][4 * q + 2] + bv[f][q].z), o3 = hi16(g2[1]) * sigmoidf_(a[f][4 * q + 3] + bv[f][q].w);
                *(u32x2*)(R2 + off) = (u32x2){pack2(o0, o1), pack2(o2, o3)};
              }
          };
          body(acc, m);
          if (v2) body(acc2, m2);
        });
    }
    __syncthreads();
    for (int i = otid(); i < RT * 64; i += 256) {
      CH_TILE
      const int mm = i >> 6, ch = i & 63;
      *(u32x4*)(R0 + mm * 1024 + CH_SW(mm, ch)) = *(const u32x4*)(YA + (lr0 + mm) * 512 + ch * 8);
    }
    __syncthreads();
    {
      CH_TILE
      CH_LANE
      f32x16 macc[2], macc2[2];
#pragma unroll
      for (int f = 0; f < 2; ++f)
#pragma unroll
        for (int i = 0; i < 16; ++i) { macc[f][i] = 0.f; macc2[f][i] = 0.f; }
      u32x2 e[2][4], e2[2][4];
      const size_t row = lr0 + m, row2 = lr0 + m2;
      cphase<8, X2>(12, lane, WBR,
        [&](int sg) __attribute__((always_inline)) { const int pass = sg / 3, r = sg % 3, cb = (w * 4 + pass + rot) & 15; return (unsigned)r * (1024u * 512u * 2u) + (unsigned)(cb * 2) * (8u * 4096u); },
        [&](int sg) __attribute__((always_inline)) { const int r = sg % 3; return (const char*)(smem + r * (RT * 1024)); },
        [&](int sg) __attribute__((always_inline)) {
          const int pass = sg / 3, r = sg % 3, n0 = ((w * 4 + pass + rot) & 15) * 64;
#pragma unroll
          for (int f = 0; f < 2; ++f)
#pragma unroll
            for (int q = 0; q < 4; ++q) {
              e[f][q] = *(const u32x2*)(Z + row * ZW + 3584 + r * 1024 + n0 + f * 32 + 8 * q + 4 * half);
            }
        },
        [&](int sg, f32x16 (&acc)[2], f32x16 (&acc2)[2]) __attribute__((always_inline)) {
          const int pass = sg / 3, r = sg % 3, n0 = ((w * 4 + pass + rot) & 15) * 64;
          auto body = [&](f32x16 (&a)[2], f32x16 (&ma)[2], u32x2 (&ee)[2][4], size_t rw, bool valid) __attribute__((always_inline)) {
#pragma unroll
            for (int f = 0; f < 2; ++f)
#pragma unroll
              for (int q = 0; q < 4; ++q) {
                ma[f][4 * q] += lo16(ee[f][q][0]) * a[f][4 * q];
                ma[f][4 * q + 1] += hi16(ee[f][q][0]) * a[f][4 * q + 1];
                ma[f][4 * q + 2] += lo16(ee[f][q][1]) * a[f][4 * q + 2];
                ma[f][4 * q + 3] += hi16(ee[f][q][1]) * a[f][4 * q + 3];
              }
            if (r == 2) {
              if (valid) {
#pragma unroll
                for (int f = 0; f < 2; ++f)
#pragma unroll
                  for (int q = 0; q < 4; ++q) {
                    const int c = n0 + f * 32 + 8 * q + 4 * half;
                    *(u32x2*)(MG + rw * DM + c) = (u32x2){pack2(ma[f][4 * q], ma[f][4 * q + 1]), pack2(ma[f][4 * q + 2], ma[f][4 * q + 3])};
                  }
              }
#pragma unroll
              for (int f = 0; f < 2; ++f)
#pragma unroll
                for (int i = 0; i < 16; ++i) ma[f][i] = 0.f;
            }
          };
          body(acc, macc, e, row, true);
          if (X2) {
#pragma unroll
            for (int f = 0; f < 2; ++f)
#pragma unroll
              for (int q = 0; q < 4; ++q) e2[f][q] = *(const u32x2*)(Z + row2 * ZW + 3584 + r * 1024 + n0 + f * 32 + 8 * q + 4 * half);
            body(acc2, macc2, e2, row2, v2);
          }
        });
    }
    __syncthreads();
    for (int i = otid(); i < RT * 128; i += 256) {
      CH_TILE
      const int mm = i >> 7, ch = i & 127;
      *(u32x4*)(smem + mm * 2048 + CH_SW(mm, ch)) = *(const u32x4*)(MG + (lr0 + mm) * DM + ch * 8);
    }
    __syncthreads();
    {
      CH_TILE
      CH_LANE
      const int rr = rr0 + m, rr2 = rr0 + m2;
      const float* gv = mod + (size_t)((rr < NLAT) ? b : 8) * 6144 + 2 * 1024;
      const float* gv2 = mod + (size_t)((rr2 < NLAT) ? b : 8) * 6144 + 2 * 1024;
      float4 xx[2][4];
      cphase<16, X2>(4, lane, WOUT,
        [&](int sg) __attribute__((always_inline)) { const int cb = (w * 4 + sg + rot) & 15; return (unsigned)(cb * 2) * (16u * 4096u); },
        [&](int sg) __attribute__((always_inline)) { return (const char*)smem; },
        [&](int sg) __attribute__((always_inline)) {
          const int n0 = ((w * 4 + sg + rot) & 15) * 64;
#pragma unroll
          for (int f = 0; f < 2; ++f)
#pragma unroll
            for (int q = 0; q < 4; ++q) {
              const int c = n0 + f * 32 + 8 * q + 4 * half;
              xx[f][q] = (l == 0) ? *(const float4*)(xrow_in(p, b, rr) + c) : *(const float4*)(xrow(p, b, rr) + c);
            }
        },
        [&](int sg, f32x16 (&acc)[2], f32x16 (&acc2)[2]) __attribute__((always_inline)) {
          const int n0 = ((w * 4 + sg + rot) & 15) * 64;
#pragma unroll
          for (int f = 0; f < 2; ++f)
#pragma unroll
            for (int q = 0; q < 4; ++q) {
              const int c = n0 + f * 32 + 8 * q + 4 * half;
              float4 x = xx[f][q];
              const float4 gg = *(const float4*)(gv + c);
              x.x += gg.x * acc[f][4 * q]; x.y += gg.y * acc[f][4 * q + 1]; x.z += gg.z * acc[f][4 * q + 2]; x.w += gg.w * acc[f][4 * q + 3];
              *(float4*)(xrow(p, b, rr) + c) = x;
            }
          if (v2) {
#pragma unroll
            for (int f = 0; f < 2; ++f)
#pragma unroll
              for (int q = 0; q < 4; ++q) {
                const int c = n0 + f * 32 + 8 * q + 4 * half;
                const float4 gg = *(const float4*)(gv2 + c);
                float4 x = (l == 0) ? *(const float4*)(xrow_in(p, b, rr2) + c) : *(const float4*)(xrow(p, b, rr2) + c);
                x.x += gg.x * acc2[f][4 * q]; x.y += gg.y * acc2[f][4 * q + 1]; x.z += gg.z * acc2[f][4 * q + 2]; x.w += gg.w * acc2[f][4 * q + 3];
                *(float4*)(xrow(p, b, rr2) + c) = x;
              }
          }
        });
    }
    __syncthreads();
    {
      CH_TILE
      CH_LANE
      const float* ng = p.in[I_N2G] + l * DM;
#pragma unroll 1
      for (int i0 = w * 2; i0 < RT; i0 += 8) {
        float4 v[2][4];
#pragma unroll
        for (int u = 0; u < 2; ++u) {
          const float4* X = (const float4*)xrow(p, b, rr0 + i0 + u);
#pragma unroll
          for (int q = 0; q < 4; ++q) v[u][q] = X[q * 64 + lane];
        }
#pragma unroll
        for (int u = 0; u < 2; ++u) {
          float s = 0.f;
#pragma unroll
          for (int q = 0; q < 4; ++q) s += v[u][q].x * v[u][q].x + v[u][q].y * v[u][q].y + v[u][q].z * v[u][q].z + v[u][q].w * v[u][q].w;
          s = wave_sum(s);
          const float rs = rsqrtf(s * (1.0f / DM) + EPSF);
          const float* mm_ = mod + (size_t)((rr0 + i0 + u < NLAT) ? b : 8) * 6144;
          u32x2* hp = (u32x2*)(H2 + (lr0 + i0 + u) * DM);
#pragma unroll
          for (int q = 0; q < 4; ++q) {
            const float4 gg = ((const float4*)ng)[q * 64 + lane];
            const float4 sc = ((const float4*)(mm_ + 4096))[q * 64 + lane];
            const float4 sh = ((const float4*)(mm_ + 3072))[q * 64 + lane];
            const float4 x = v[u][q];
            hp[q * 64 + lane] = (u32x2){pack2(x.x * rs * gg.x * (1.f + sc.x) + sh.x, x.y * rs * gg.y * (1.f + sc.y) + sh.y),
                                        pack2(x.z * rs * gg.z * (1.f + sc.z) + sh.z, x.w * rs * gg.w * (1.f + sc.w) + sh.w)};
          }
        }
      }
    }
#undef CH_TILE
#undef CH_LANE
  }
}

__device__ __forceinline__ void stage_peerq_mfma(int tpb, const bf16_t* H2, const bf16_t* WQ, bf16_t* PQ, char* smem) {
  EPI_DECL
  const int tm = GB * tpb;
  TileIter ti(tm, 16);
  int mt_, nt_; bool valid;
  while (ti.next(mt_, nt_, valid)) {
    if (!valid) continue;
    const int m0 = MT_LR0(mt_, tpb), n0 = nt_ * 128;
    f32x16 acc[2][2];
    gemm_tile(H2 + (size_t)m0 * DM, DM, WQ + (size_t)n0 * DM, DM, DM, smem, acc);
#pragma unroll
    for (int mi = 0; mi < 2; ++mi)
#pragma unroll
      for (int ni = 0; ni < 2; ++ni)
#pragma unroll
        for (int q = 0; q < 4; ++q) {
          const int row = m0 + EPI_ROW(mi), c = n0 + EPI_COL(ni, q);
          *(u32x2*)(PQ + (size_t)row * 2048 + c) = (u32x2){pack2(acc[mi][ni][4 * q], acc[mi][ni][4 * q + 1]), pack2(acc[mi][ni][4 * q + 2], acc[mi][ni][4 * q + 3])};
        }
  }
}

__device__ __forceinline__ unsigned f2sortable(float x) { const unsigned u = __float_as_uint(x); return (u & 0x80000000u) ? ~u : (u | 0x80000000u); }
__device__ __forceinline__ float sortable2f(unsigned k) { return __uint_as_float((k & 0x80000000u) ? (k & 0x7fffffffu) : ~k); }
#define TOPK_INSERT(v, key) { unsigned t_ = (key); _Pragma("unroll") for (int s_ = 0; s_ < 16; ++s_) { const unsigned hi_ = max(v[s_], t_); t_ = min(v[s_], t_); v[s_] = hi_; } }
__device__ __forceinline__ void stage_scores_topk(int tpb, const bf16_t* PQ, const bf16_t* SUBK, int* EI, float* EG, char* smem) {
  EPI_DECL
  const int tid = tid_;
  const int item = tid & 127, kpart = tid >> 7;
  float* S = (float*)smem;
  unsigned* xk = (unsigned*)(smem + 128 * 129 * 4);
  const int tm = GB * tpb * 8;
  for (int mt = blockIdx.x; mt < tm; mt += gridDim.x) {
    const size_t m0 = (size_t)MT_LR0(mt >> 3, tpb) * 8 + (size_t)(mt & 7) * 128;
    unsigned vh[2][16];
#pragma unroll
    for (int half = 0; half < 2; ++half) {
      f32x16 acc[2][2];
      gemm_tile(PQ + m0 * 256 + half * 128, 256, SUBK + (size_t)half * 16384, 128, 128, smem, acc);
#pragma unroll
      for (int mi = 0; mi < 2; ++mi)
#pragma unroll
        for (int ni = 0; ni < 2; ++ni)
#pragma unroll
          for (int i = 0; i < 16; ++i)
            S[EPI_ROW(mi) * 129 + wn * 64 + ni * 32 + 8 * (i >> 2) + 4 * fh + (i & 3)] = acc[mi][ni][i];
      __syncthreads();
      unsigned v[16];
#pragma unroll
      for (int s = 0; s < 16; ++s) v[s] = 0u;
      const float* sr = S + item * 129 + kpart * 64;
#pragma unroll 8
      for (int k = 0; k < 64; ++k) {
        const unsigned key = (f2sortable(sr[k]) & ~127u) | (unsigned)(127 - (kpart * 64 + k));
        TOPK_INSERT(v, key)
      }
      if (kpart == 1) {
#pragma unroll
        for (int s = 0; s < 16; ++s) xk[item * 17 + s] = v[s];
      }
      __syncthreads();
      if (kpart == 0) {
#pragma unroll
        for (int s = 0; s < 16; ++s) { const unsigned key = xk[item * 17 + s]; TOPK_INSERT(v, key) }
      }
#pragma unroll
      for (int s = 0; s < 16; ++s) vh[half][s] = v[s];
      __syncthreads();
    }
    if (kpart == 0) {
      float v1[16], v2[16];
#pragma unroll
      for (int s = 0; s < 16; ++s) { v1[s] = sortable2f((vh[0][s] & ~127u) | 64u); v2[s] = sortable2f((vh[1][s] & ~127u) | 64u); }
      unsigned c[16];
#pragma unroll
      for (int s = 0; s < 16; ++s) c[s] = 0u;
      {
        int o = 0;
#pragma unroll
        for (int i = 0; i < 16; ++i)
#pragma unroll
          for (int j = 0; j < 16 / (i + 1); ++j) {
            const unsigned key = (f2sortable(v1[i] + v2[j]) & ~63u) | (unsigned)(63 - o);
            TOPK_INSERT(c, key)
            ++o;
          }
      }
      const float vmax = sortable2f((c[0] & ~63u) | 32u);
      float sum = 0.f;
#pragma unroll
      for (int s = 0; s < 16; ++s) sum += expf(sortable2f((c[s] & ~63u) | 32u) - vmax);
      const float isum = 1.0f / sum;
      const unsigned thr = c[15];
      int* ei = EI + (m0 + item) * 16;
      float* eg = EG + (m0 + item) * 16;
      int cntw = 0;
      {
        int o = 0;
#pragma unroll
        for (int i = 0; i < 16; ++i)
#pragma unroll
          for (int j = 0; j < 16 / (i + 1); ++j) {
            const unsigned key = (f2sortable(v1[i] + v2[j]) & ~63u) | (unsigned)(63 - o);
            if (key >= thr) {
              ei[cntw] = (int)((127u - (vh[0][i] & 127u)) * 128u + (127u - (vh[1][j] & 127u)));
              eg[cntw] = expf(sortable2f((key & ~63u) | 32u) - vmax) * isum;
              ++cntw;
            }
            ++o;
          }
      }
    }
  }
  __syncthreads();
}

#define DPPF(x, ctrl) __uint_as_float((unsigned)__builtin_amdgcn_update_dpp(0, (int)__float_as_uint(x), (ctrl), 0xf, 0xf, true))
#define XP_HALVE(n, bit, ctrl) { _Pragma("unroll") for (int j_ = 0; j_ < (n); ++j_) { const float keep_ = (bit) ? a[j_ + (n)] : a[j_]; const float send_ = (bit) ? a[j_] : a[j_ + (n)]; a[j_] = keep_ + DPPF(send_, ctrl); } }
#define XP_ROW(TAB, E, PR) { const int e0_ = __builtin_amdgcn_readlane((E), 2 * (PR)), e1_ = __builtin_amdgcn_readlane((E), 2 * (PR) + 1); \
    const char* rp_ = (TAB) + (size_t)(hw ? e1_ : e0_) * 768 + hl * 24; \
    const u32x4_u x_ = *(const u32x4_u*)rp_; const u32x2 y_ = *(const u32x2*)(rp_ + 16); \
    ra[PR] = (v6u){x_[0], x_[1], x_[2], x_[3], y_[0], y_[1]}; }
#define XP_META(PAR, T, E, G, HP) { const size_t mo_ = ((size_t)(PAR) * RPG + (T)) * 128 + w * 32 + hl; \
    E = ((const int*)(p.ws + WB_EI))[mo_]; G = ((const float*)(p.ws + WB_EG))[mo_]; \
    const u32x4* hr_ = (const u32x4*)((const bf16_t*)(p.ws + WB_H2) + ((size_t)(PAR) * RPG + (T)) * DM + hl * 32); \
    _Pragma("unroll") for (int c_ = 0; c_ < 4; ++c_) HP[c_] = hr_[c_]; }
__device__ __forceinline__ void unpack8(const u32x4 v, float* f) {
#pragma unroll
  for (int k = 0; k < 4; ++k) { f[2 * k] = lo16(v[k]); f[2 * k + 1] = hi16(v[k]); }
}
__device__ __forceinline__ int xp_pool_n(int q) { return GB * ((q < NG) ? NTOK : NLAT); }
__device__ __forceinline__ int xp_claim(int* pool, int& qa, int hi) {
  while (qa <= hi) {
    const int n = xp_pool_n(qa);
    if (__hip_atomic_load(pool + qa, __ATOMIC_RELAXED, __HIP_MEMORY_SCOPE_AGENT) < n) {
      const int i = atomicAdd(pool + qa, 1);
      if (i < n) return qa * 65536 + i;
    }
    ++qa;
  }
  return -1;
}
__device__ __forceinline__ void xp_decode(int tok, int& l, int& par, int& b, int& rr, int& t) {
  const int q = tok >> 16, i = tok & 65535;
  l = q / NG;
  const int g = q % NG, rr_lim = (l == 0) ? NTOK : NLAT, bl = i / rr_lim;
  rr = i % rr_lim; b = g * GB + bl; t = bl * NTOK + rr; par = q % 3;
}
__device__ __forceinline__ void expert_run(const Params& p, int lo, int hi, unsigned* ctr, unsigned epoch, const bool steal, int& pend, float* smem) {
  if (lo < 0) lo = 0;
  if (hi < lo) return;
  const int tid = otid(), w = tid >> 6, lane = tid & 63, hl = lane & 31, hw = lane >> 5;
  int* s_tok = (int*)(smem + SMEM_FLOATS - 8);
  int* pool = (int*)(p.ws + WB_POOL);
  float* part = smem;
  int qa = lo, ci = 0;
  bool cpend = false;
  unsigned cb = 0;
  int cur = pend; pend = -1;
  if (cur < 0) {
    __syncthreads();
    if (tid == 0) s_tok[2] = xp_claim(pool, qa, hi);
    __syncthreads();
    cur = __builtin_amdgcn_readfirstlane(s_tok[2]);
  }
  if (cur < 0) return;
  if (tid == 0 && qa <= hi) { ci = atomicAdd(pool + qa, 1); cpend = true; }
  int l, par, b, rr, t;
  xp_decode(cur, l, par, b, rr, t);
  int e_c; float g_c; u32x4 hp[4];
  XP_META(par, t, e_c, g_c, hp)
  v6u ra[16];
  {
    const char* U = p.ws + WB_U16 + (size_t)l * 16384 * 768;
#pragma unroll
    for (int pr = 0; pr < 16; ++pr) XP_ROW(U, e_c, pr)
  }
  for (;;) {
    const float* mod = (const float*)(p.ws + WB_MOD) + (size_t)l * 9 * 6144;
    const float4 g2 = ((const float4*)(mod + (size_t)((rr < NLAT) ? b : 8) * 6144 + 5 * 1024))[tid];
    float4* xp = (float4*)xrow(p, b, rr) + tid;
    float4 xv = *xp;
    if (tid == 0) {
      int r = -1;
      if (cpend) {
        if (ci < xp_pool_n(qa)) r = qa * 65536 + ci;
        else { ++qa; r = xp_claim(pool, qa, hi); }
      }
      const int st = (steal && cb + 31u >= epoch) ? 1 : 0;
      s_tok[0] = r; s_tok[1] = st;
      cpend = false;
      if (!st && r >= 0 && qa <= hi) { ci = atomicAdd(pool + qa, 1); cpend = true; }
    }
    __syncthreads();
    const int nxt = __builtin_amdgcn_readfirstlane(s_tok[0]);
    const bool pf = nxt >= 0 && __builtin_amdgcn_readfirstlane(s_tok[1]) == 0;
    int ln = l, parn = 0, bn = 0, rrn = 0, tn = 0, e_n = 0;
    float g_n = 0.f;
    u32x4 hn[4];
#pragma unroll
    for (int c = 0; c < 4; ++c) hn[c] = (u32x4){0u, 0u, 0u, 0u};
    if (pf) {
      xp_decode(nxt, ln, parn, bn, rrn, tn);
      XP_META(parn, tn, e_n, g_n, hn)
    }
    const char* V = p.ws + WB_V16 + (size_t)l * 16384 * 768;
    f32x2 hq2[16];
#pragma unroll
    for (int c = 0; c < 4; ++c)
#pragma unroll
      for (int k = 0; k < 4; ++k) hq2[4 * c + k] = (f32x2){lo16(hp[c][k]), hi16(hp[c][k])};
    float a[16];
#pragma unroll
    for (int pr = 0; pr < 16; ++pr) {
      const v32f f = __builtin_amdgcn_cvt_scalef32_pk32_f32_fp6(ra[pr], 1.0f);
      f32x2 sa = {0.f, 0.f}, sb = {0.f, 0.f};
#pragma unroll
      for (int k = 0; k < 16; k += 2) {
        sa = __builtin_elementwise_fma(hq2[k], (f32x2){f[2 * k], f[2 * k + 1]}, sa);
        sb = __builtin_elementwise_fma(hq2[k + 1], (f32x2){f[2 * k + 2], f[2 * k + 3]}, sb);
      }
      a[pr] = (sa[0] + sb[0]) + (sa[1] + sb[1]);
      XP_ROW(V, e_c, pr)
    }
    {
      const bool b3 = (lane & 8) != 0, b2 = (lane & 4) != 0, b1 = (lane & 2) != 0, b0 = (lane & 1) != 0;
      XP_HALVE(8, b3, 0x128)
      XP_HALVE(4, b2, 0x141)
      XP_HALVE(2, b1, 0x4E)
      XP_HALVE(1, b0, 0xB1)
    }
    float dsum = a[0];
    dsum += __shfl_xor(dsum, 16);
    const float my_dot = __shfl(dsum, 32 * (hl & 1) + (hl >> 1));
    const float my_c = g_c * geluf_(my_dot * (1.0f / 64.0f));
    f32x2 acc2[16];
#pragma unroll
    for (int k = 0; k < 16; ++k) acc2[k] = (f32x2){0.f, 0.f};
    {
      const char* Un = p.ws + WB_U16 + (size_t)ln * 16384 * 768;
#pragma unroll
      for (int pr = 0; pr < 16; ++pr) {
        const float c0 = __uint_as_float(__builtin_amdgcn_readlane(__float_as_uint(my_c), 2 * pr)), c1 = __uint_as_float(__builtin_amdgcn_readlane(__float_as_uint(my_c), 2 * pr + 1));
        const float c = hw ? c1 : c0;
        const f32x2 cc = {c, c};
        const v32f f = __builtin_amdgcn_cvt_scalef32_pk32_f32_fp6(ra[pr], 1.0f);
#pragma unroll
        for (int k = 0; k < 16; ++k) acc2[k] = __builtin_elementwise_fma(cc, (f32x2){f[2 * k], f[2 * k + 1]}, acc2[k]);
        XP_ROW(Un, e_n, pr)
      }
    }
    if (steal && tid == 0) cb = __hip_atomic_load(ctr, __ATOMIC_RELAXED, __HIP_MEMORY_SCOPE_AGENT);
    __syncthreads();
    {
      float4* pw = (float4*)(part + (w * 2 + hw) * 1024 + hl * 32);
#pragma unroll
      for (int c = 0; c < 8; ++c) pw[c] = make_float4(acc2[2 * c][0], acc2[2 * c][1], acc2[2 * c + 1][0], acc2[2 * c + 1][1]);
    }
    __syncthreads();
    float4 s = ((const float4*)part)[tid];
#pragma unroll
    for (int c = 1; c < 8; ++c) { const float4 x = ((const float4*)(part + c * 1024))[tid]; s.x += x.x; s.y += x.y; s.z += x.z; s.w += x.w; }
    xv.x += 0.5f * g2.x * s.x; xv.y += 0.5f * g2.y * s.y; xv.z += 0.5f * g2.z * s.z; xv.w += 0.5f * g2.w * s.w;
    *xp = xv;
    if (!pf) { pend = nxt; break; }
    l = ln; par = parn; b = bn; rr = rrn; t = tn; e_c = e_n; g_c = g_n;
#pragma unroll
    for (int c = 0; c < 4; ++c) hp[c] = hn[c];
  }
}
__device__ __forceinline__ void expert_drain(const Params& p, int lo, int hi, int& pend, float* smem) {
  expert_run(p, lo, hi, nullptr, 0u, false, pend, smem);
}

__device__ __forceinline__ void stage_final(const Params& p, float* smem) {
  const int tid = otid(), w = tid >> 6, lane = tid & 63;
  const int n = NB * NLAT;
  for (int r0 = (blockIdx.x * 4 + w) * 2; r0 < n; r0 += gridDim.x * 8) {
    float4 v[2][4];
#pragma unroll
    for (int u = 0; u < 2; ++u)
#pragma unroll
      for (int q = 0; q < 4; ++q) v[u][q] = ((const float4*)(p.out + (size_t)(r0 + u) * DM))[q * 64 + lane];
#pragma unroll
    for (int u = 0; u < 2; ++u) {
      float s = 0.f;
#pragma unroll
      for (int q = 0; q < 4; ++q) s += v[u][q].x * v[u][q].x + v[u][q].y * v[u][q].y + v[u][q].z * v[u][q].z + v[u][q].w * v[u][q].w;
      s = wave_sum(s);
      const float rs = rsqrtf(s * (1.0f / DM) + EPSF);
#pragma unroll
      for (int q = 0; q < 4; ++q) {
        const float4 g = ((const float4*)p.in[I_FG])[q * 64 + lane];
        const float4 x = v[u][q];
        ((float4*)(p.out + (size_t)(r0 + u) * DM))[q * 64 + lane] = make_float4(x.x * rs * g.x, x.y * rs * g.y, x.z * rs * g.z, x.w * rs * g.w);
      }
    }
  }
}

__device__ __forceinline__ void gbar(const Params& p, unsigned* ctr, unsigned& epoch, int lo, int hi, int& pend, float* smem) {
  asm volatile("s_waitcnt vmcnt(0)" ::: "memory");
  __syncthreads();
  epoch += gridDim.x;
  int* s_flag = (int*)(smem + SMEM_FLOATS - 12);
  if (threadIdx.x == 0) {
    __builtin_amdgcn_fence(__ATOMIC_RELEASE, "agent");
    asm volatile("s_waitcnt vmcnt(0)" ::: "memory");
    __hip_atomic_fetch_add(ctr, 1u, __ATOMIC_RELAXED, __HIP_MEMORY_SCOPE_AGENT);
  }
  if (hi >= lo && hi >= 0) {
    if (threadIdx.x == 0) {
      const unsigned c = __hip_atomic_load(ctr, __ATOMIC_RELAXED, __HIP_MEMORY_SCOPE_AGENT);
      *s_flag = (c + 31u < epoch) ? 1 : 0;
    }
    __syncthreads();
    if (*s_flag) expert_run(p, lo, hi, ctr, epoch, true, pend, smem);
  }
  if (threadIdx.x == 0) {
    while (__hip_atomic_load(ctr, __ATOMIC_RELAXED, __HIP_MEMORY_SCOPE_AGENT) < epoch) __builtin_amdgcn_s_sleep(2);
    __builtin_amdgcn_fence(__ATOMIC_ACQUIRE, "agent");
    asm volatile("s_waitcnt vmcnt(0)" ::: "memory");
  }
  __syncthreads();
}

__global__ void __launch_bounds__(256) mega(Params p) {
  cg::grid_group grid = cg::this_grid();
  __shared__ __attribute__((aligned(16))) float smem[SMEM_FLOATS];
  char* smc = (char*)smem;
  char* ws = p.ws;
  bf16_t* H = (bf16_t*)(ws + WB_H); bf16_t* Z = (bf16_t*)(ws + WB_Z); float* MGT = (float*)(ws + WB_MGT); bf16_t* XC = (bf16_t*)(ws + WB_XC);
  bf16_t* QM = (bf16_t*)(ws + WB_QM); bf16_t* KM = (bf16_t*)(ws + WB_KM); bf16_t* KMT = (bf16_t*)(ws + WB_KMT); bf16_t* MVT = (bf16_t*)(ws + WB_MVT);
  bf16_t* HF = (bf16_t*)(ws + WB_HF); bf16_t* HB = (bf16_t*)(ws + WB_HB);
  bf16_t* VT = (bf16_t*)(ws + WB_VT); float* YSF = (float*)(ws + WB_YSF); float* YSB = (float*)(ws + WB_YSB);
  bf16_t* YA = (bf16_t*)(ws + WB_YA); bf16_t* YB = (bf16_t*)(ws + WB_YB); bf16_t* YS = (bf16_t*)(ws + WB_YS); bf16_t* GG = (bf16_t*)(ws + WB_GG);
  bf16_t* MG = (bf16_t*)(ws + WB_MG); bf16_t* PQ = (bf16_t*)(ws + WB_PQ); float* SC = (float*)(ws + WB_SC);
  float* XE = (float*)(ws + WB_XE); float* GA = (float*)(ws + WB_GA);
  const bf16_t* WT = (const bf16_t*)(ws + WB_WT);

  unsigned* bar = (unsigned*)(ws + WB_BAR);
  unsigned epoch = 0;
  int pend = -1;
  stage_init(p, smem);
  grid.sync();

  for (int l = 0; l < 2; ++l) {
    const bool need_ctx = (l == 0);
    const int rr_lim = need_ctx ? NTOK : NLAT;
    const int tpb = need_ctx ? 34 : 32;
    const bf16_t* W = WT + (size_t)l * WT_LAYER;
    const float lam_init = 0.8f - 0.6f * expf(-0.3f * (float)l);
    float lam;
    {
      float s1 = 0.f, s2 = 0.f;
      for (int i = 0; i < 64; ++i) {
        s1 += p.in[I_LQ1][l * 64 + i] * p.in[I_LK1][l * 64 + i];
        s2 += p.in[I_LQ2][l * 64 + i] * p.in[I_LK2][l * 64 + i];
      }
      lam = expf(s1) - expf(s2) + lam_init;
    }
    for (int g = 0; g < NG; ++g) {
      const int q = l * NG + g;
      int plo = q - 3, phi = q - 1;
      int* EI = (int*)(ws + WB_EI) + (size_t)(q % 3) * RPG * 128; float* EG = (float*)(ws + WB_EG) + (size_t)(q % 3) * RPG * 128;
      bf16_t* H2 = (bf16_t*)(ws + WB_H2) + (size_t)(q % 3) * RPG * DM;
      stage_normmod(p, l, g, 0, NTOK, H, smem);
      gbar(p, bar, epoch, plo, phi, pend, smem);
      stage_inproj(p, H, W + WT_WIN, Z, MGT, VT, MVT, smc);
      gbar(p, bar, epoch, plo, phi, pend, smem);
      stage_conv(p, l, Z, XC);
      stage_s5_pass1(p, l, Z, XE);
      gbar(p, bar, epoch, plo, phi, pend, smem);
      stage_mlqk(XC, W + WT_WQK, QM, KM, KMT, smc);
      stage_mlgates(p, l, MGT, GA);
      gbar(p, bar, epoch, plo, phi, pend, smem);
      {
        const int n_attn = 4 * 64 + (need_ctx ? 4 * 4 : 0);
        const int n_s5 = 32 * 2 * 9;
        const int n_items = GB * (16 + n_attn + n_s5);
        int* cnt = (int*)(ws + WB_CNT) + (l * NG + g);
        int* s_item = (int*)(smem + SMEM_FLOATS - 4);
        for (;;) {
          __syncthreads();
          if (otid() == 0) *s_item = atomicAdd(cnt, 1);
          __syncthreads();
          const int it = *s_item;
          if (it >= n_items) break;
          int bl, k;
          if (it < GB * 16) { bl = it / 16; k = it % 16; }
          else if (it < GB * (16 + n_attn)) { bl = (it - GB * 16) / n_attn; k = 16 + (it - GB * 16) % n_attn; }
          else { bl = (it - GB * (16 + n_attn)) / n_s5; k = 16 + n_attn + (it - GB * (16 + n_attn)) % n_s5; }
          const bf16_t* Zb = Z + (size_t)bl * NTOK * ZW;
          const size_t ro = (size_t)bl * NTOK;
          if (k < 16) {
            const int hh = k & 3, dd = (k >> 2) & 1, eh = k >> 3;
            mlstm_chain_item(p, l, QM + ro * 512, KM + ro * 512, KMT + (size_t)bl * 4 * 128 * NTOK, MVT + (size_t)bl * 4 * 128 * NTOK, GA + (size_t)(((bl * 4 + hh) * 2 + dd) * 68) * 272,
                             (dd ? HB : HF) + ro * 512, hh, dd, eh, smc);
          } else if (k < 16 + n_attn) {
            const int a = k - 16;
            const bf16_t* VTb = VT + (size_t)bl * 4 * 128 * NTOK;
            if (a < 256) attn_mfma_item(p, l, Zb, VTb, YA + ro * 512, a & 3, (a >> 2) * 64, 0, NTOK, lam, lam_init, smc);
            else attn_mfma_item(p, l, Zb, VTb, YA + ro * 512, (a - 256) & 3, NLAT + ((a - 256) >> 2) * 64, NLAT, NCTX, lam, lam_init, smc);
          } else {
            const int a = k - 16 - n_attn;
            const int sq = a % 9, dir = (a / 9) & 1, gg = a / 18;
            s5_item(p, l, Zb, XE + (((size_t)bl * 32 + gg) * 2 + dir) * (S5NSEG - 1) * 128, (dir ? YSB : YSF) + ro * 512, gg, dir, sq, smc);
          }
        }
      }
      expert_drain(p, plo, plo, pend, smem);
      plo = q - 2;
      gbar(p, bar, epoch, plo, phi, pend, smem);
      if (need_ctx) stage_chain1<true>(p, l, g, Z, HF, HB, YSF, YSB, YA, MG, H2, W, smc);
      else stage_chain1<false>(p, l, g, Z, HF, HB, YSF, YSB, YA, MG, H2, W, smc);
      gbar(p, bar, epoch, plo, phi, pend, smem);
      stage_peerq_mfma(tpb, H2, W + WT_WQ, PQ, smc);
      gbar(p, bar, epoch, plo, phi, pend, smem);
      stage_scores_topk(tpb, PQ, W + WT_SUBK, EI, EG, smc);
      gbar(p, bar, epoch, plo, phi, pend, smem);
    }
  }
  expert_drain(p, 2 * NG - 3, 2 * NG - 1, pend, smem);
  gbar(p, bar, epoch, 0, -1, pend, smem);
  stage_final(p, smem);
}

extern "C" void kernel_launch(void* const* d_in, const int* in_sizes, int n_in, void* d_out,
                              int out_size, void* d_ws, size_t ws_size, hipStream_t stream) {
  static int grid_blocks = 0;
  if (!grid_blocks) {
    int dev = 0, cus = 0, per_cu = 0;
    (void)hipGetDevice(&dev);
    (void)hipDeviceGetAttribute(&cus, hipDeviceAttributeMultiprocessorCount, dev);
    (void)hipOccupancyMaxActiveBlocksPerMultiprocessor(&per_cu, mega, 256, 0);
    if (per_cu > 1) per_cu = 1;
    grid_blocks = cus * per_cu;
  }
  if (ws_size < WB_END) {
    fprintf(stderr, "workspace too small: %zu < %zu\n", ws_size, (size_t)WB_END);
    return;
  }
  Params p{};
  for (int i = 0; i < N_IN; ++i) p.in[i] = (const float*)d_in[i];
  p.out = (float*)d_out;
  p.ws = (char*)d_ws;
  (void)hipMemsetAsync((char*)d_ws + WB_BAR, 0, 256, stream);
  void* args[] = {&p};
  hipError_t e = hipLaunchCooperativeKernel((void*)mega, dim3(grid_blocks), dim3(256), args, 0, stream);
  if (e != hipSuccess) fprintf(stderr, "cooperative launch failed: %s (grid %d)\n", hipGetErrorString(e), grid_blocks);
}
```

```cpp
#include <hip/hip_runtime.h>
#include <hip/hip_cooperative_groups.h>
#include <cstdio>
#include <cstdint>
namespace cg = cooperative_groups;

#define NLAT 4096
#define NCTX 256
#define NTOK 4352
#define DM 1024
#define INW 6672
#define NB 8
#define GB 2
#define NG (NB / GB)
#define RPG (GB * NTOK)
#define ZW 6656
#define EPSF 1e-6f

enum { I_X = 0, I_C, I_CTX, I_CCTX, I_WMOD, I_BMOD, I_N1G, I_N2G, I_WIN, I_LQ1, I_LK1, I_LQ2, I_LK2, I_SUBG,
       I_CONVW, I_CONVB, I_MLWQ, I_MLWK, I_GATEB, I_MLNG, I_S5LRE, I_S5LIM, I_S5DT, I_S5BRE, I_S5BIM,
       I_S5CRE, I_S5CIM, I_S5D, I_GLUW, I_GLUB, I_WBR, I_WOUT, I_PWQ, I_PSUBK, I_PU, I_PV, I_FG, N_IN };

struct Params {
  const float* in[N_IN];
  float* out;
  char* ws;
};

typedef unsigned short bf16_t;
typedef short bf16x8 __attribute__((ext_vector_type(8)));
typedef float f32x16 __attribute__((ext_vector_type(16)));
typedef unsigned u32x4 __attribute__((ext_vector_type(4)));
typedef unsigned u32x2 __attribute__((ext_vector_type(2)));
typedef unsigned u32x4_u __attribute__((ext_vector_type(4), aligned(8)));
typedef float v16f __attribute__((ext_vector_type(16)));
typedef float v32f __attribute__((ext_vector_type(32)));
typedef unsigned v6u __attribute__((ext_vector_type(6)));

#define AL(x) (((x) + 255) & ~(size_t)255)
#define WB_XCX   ((size_t)0)
#define WB_MOD   AL(WB_XCX + (size_t)NB * NCTX * DM * 4)
#define WB_ROPE  AL(WB_MOD + (size_t)2 * 9 * 6144 * 4)
#define WB_WT    AL(WB_ROPE + (size_t)NLAT * 32 * 2 * 4)
#define WT_WIN   ((size_t)0)
#define WT_WQK   (WT_WIN + (size_t)6784 * 1024)
#define WT_GLU   (WT_WQK + (size_t)4 * 256 * 128)
#define WT_WBR   (WT_GLU + (size_t)512 * 512)
#define WT_WOUT  (WT_WBR + (size_t)3 * 1024 * 512)
#define WT_WQ    (WT_WOUT + (size_t)1024 * 1024)
#define WT_SUBK  (WT_WQ + (size_t)2048 * 1024)
#define WT_LAYER (WT_SUBK + (size_t)2 * 128 * 128)
#define WB_H     AL(WB_WT + WT_LAYER * 2 * 2)
#define WB_Z     AL(WB_H + (size_t)RPG * DM * 2)
#define WB_MGT   AL(WB_Z + (size_t)RPG * ZW * 2)
#define WB_XC    AL(WB_MGT + (size_t)RPG * 16 * 4)
#define WB_QM    AL(WB_XC + (size_t)RPG * 512 * 2)
#define WB_KM    AL(WB_QM + (size_t)RPG * 512 * 2)
#define WB_KMT   AL(WB_KM + (size_t)RPG * 512 * 2)
#define WB_MVT   AL(WB_KMT + (size_t)RPG * 512 * 2)
#define WB_HF    AL(WB_MVT + (size_t)RPG * 512 * 2)
#define WB_HB    AL(WB_HF + (size_t)RPG * 512 * 2)
#define WB_YSF   AL(WB_HB + (size_t)RPG * 512 * 2)
#define WB_YSB   AL(WB_YSF + (size_t)RPG * 512 * 4)
#define WB_YA    AL(WB_YSB + (size_t)RPG * 512 * 4)
#define WB_YB    AL(WB_YA + (size_t)RPG * 512 * 2)
#define WB_YS    AL(WB_YB + (size_t)RPG * 512 * 2)
#define WB_GG    AL(WB_YS + (size_t)RPG * 512 * 2)
#define WB_MG    AL(WB_GG + (size_t)RPG * 512 * 2)
#define WB_EI    AL(WB_MG + (size_t)RPG * DM * 2)
#define WB_EG    AL(WB_EI + (size_t)3 * RPG * 128 * 4)
#define WB_H2    AL(WB_EG + (size_t)3 * RPG * 128 * 4)
#define WB_U16   AL(WB_H2 + (size_t)3 * RPG * DM * 2)
#define WB_V16   AL(WB_U16 + (size_t)2 * 16384 * 768)
#define WB_VT    AL(WB_V16 + (size_t)2 * 16384 * 768)
#define WB_CNT   AL(WB_VT + (size_t)GB * 4 * 128 * NTOK * 2)
#define WB_XE    AL(WB_CNT + 256)
#define WB_BAR   AL(WB_XE + (size_t)GB * 32 * 2 * 33 * 128 * 4)
#define WB_GA    AL(WB_BAR + 256)
#define WB_POOL  AL(WB_GA + (size_t)GB * 4 * 2 * 68 * 272 * 4)
#define WB_END   AL(WB_POOL + 256)
#define WB_PQ    (WB_Z)
#define WB_SC    AL(WB_PQ + (size_t)RPG * 2048 * 2)

#define SMEM_FLOATS (26 * 1024)

__device__ __forceinline__ float sigmoidf_(float x) { return __builtin_amdgcn_rcpf(1.0f + __builtin_amdgcn_exp2f(-1.4426950408889634f * x)); }
__device__ __forceinline__ float siluf_(float x) { return x * __builtin_amdgcn_rcpf(1.0f + __builtin_amdgcn_exp2f(-1.4426950408889634f * x)); }
__device__ __forceinline__ float geluf_(float x) { return 0.5f * x * (1.0f + erff(x * 0.70710678118654752f)); }
__device__ __forceinline__ int otid() { int t = threadIdx.x; asm volatile("" : "+v"(t)); return t; }
__device__ __forceinline__ float wave_sum(float v) {
  for (int o = 32; o > 0; o >>= 1) v += __shfl_xor(v, o);
  return v;
}
__device__ __forceinline__ bf16_t f2bf(float x) { unsigned u = __float_as_uint(x); u += 0x7fffu + ((u >> 16) & 1u); return (bf16_t)(u >> 16); }
__device__ __forceinline__ float bf2f(bf16_t h) { return __uint_as_float(((unsigned)h) << 16); }
typedef float f32x2 __attribute__((ext_vector_type(2)));
typedef __bf16 bf16x2_t __attribute__((ext_vector_type(2)));
__device__ __forceinline__ unsigned pack2(float a, float b) { f32x2 v = {a, b}; return __builtin_bit_cast(unsigned, __builtin_convertvector(v, bf16x2_t)); }
__device__ __forceinline__ float lo16(unsigned u) { return __uint_as_float(u << 16); }
__device__ __forceinline__ float hi16(unsigned u) { return __uint_as_float(u & 0xffff0000u); }

__device__ __forceinline__ float* xrow(const Params& p, int b, int rr) {
  return (rr < NLAT) ? p.out + ((size_t)b * NLAT + rr) * DM : (float*)(p.ws + WB_XCX) + ((size_t)b * NCTX + (rr - NLAT)) * DM;
}

__device__ __forceinline__ const float* xrow_in(const Params& p, int b, int rr) {
  return (rr < NLAT) ? p.in[I_X] + ((size_t)b * NLAT + rr) * DM : p.in[I_CTX] + ((size_t)b * NCTX + (rr - NLAT)) * DM;
}

__device__ __forceinline__ void gemm_tile(const bf16_t* __restrict__ Ag, int lda, const bf16_t* __restrict__ Bg, int ldb, int K,
                                          char* smem, f32x16 (&acc)[2][2]) {
  const int tid = otid(), lane = tid & 63, w = tid >> 6, wm = w >> 1, wn = w & 1;
#pragma unroll
  for (int a = 0; a < 2; ++a)
#pragma unroll
    for (int b = 0; b < 2; ++b)
#pragma unroll
      for (int i = 0; i < 16; ++i) acc[a][b][i] = 0.f;
  const int srow = tid >> 3, sch = tid & 7;
  const bf16_t* ap = Ag + (size_t)srow * lda + sch * 8;
  const bf16_t* bp = Bg + (size_t)srow * ldb + sch * 8;
  const int wofs = srow * 128 + ((sch ^ ((srow >> 1) & 7)) << 4);
  const int fr = lane & 31, fh = lane >> 5, fsw = (fr >> 1) & 7;
  const int aofs = (wm * 64 + fr) * 128, bofs = 16384 + (wn * 64 + fr) * 128;
  u32x4 ra0[4], rb0[4], ra1[4], rb1[4];
  const int nk = K >> 6;
#define G_LOAD(RA, RB, KT) { _Pragma("unroll") for (int i = 0; i < 4; ++i) { RA[i] = *(const u32x4*)(ap + (size_t)i * 32 * lda + (KT) * 64); RB[i] = *(const u32x4*)(bp + (size_t)i * 32 * ldb + (KT) * 64); } }
#define G_STORE(RA, RB, BUF) { char* nb_ = smem + (BUF) * 32768; _Pragma("unroll") for (int i = 0; i < 4; ++i) { *(u32x4*)(nb_ + wofs + i * 4096) = RA[i]; *(u32x4*)(nb_ + 16384 + wofs + i * 4096) = RB[i]; } }
#define G_COMPUTE(BUF) { const char* base = smem + (BUF) * 32768; _Pragma("unroll") for (int ks = 0; ks < 4; ++ks) { \
      const int coff = ((ks * 2 + fh) ^ fsw) << 4; bf16x8 af[2], bfr[2]; \
      _Pragma("unroll") for (int mi = 0; mi < 2; ++mi) af[mi] = *(const bf16x8*)(base + aofs + mi * 4096 + coff); \
      _Pragma("unroll") for (int ni = 0; ni < 2; ++ni) bfr[ni] = *(const bf16x8*)(base + bofs + ni * 4096 + coff); \
      _Pragma("unroll") for (int mi = 0; mi < 2; ++mi) _Pragma("unroll") for (int ni = 0; ni < 2; ++ni) \
          acc[mi][ni] = __builtin_amdgcn_mfma_f32_32x32x16_bf16(bfr[ni], af[mi], acc[mi][ni], 0, 0, 0); } }
  G_LOAD(ra0, rb0, 0)
  G_LOAD(ra1, rb1, 1)
  __syncthreads();
  G_STORE(ra0, rb0, 0)
  __syncthreads();
  for (int kt = 0; kt < nk; kt += 2) {
    if (kt + 2 < nk) G_LOAD(ra0, rb0, kt + 2)
    G_COMPUTE(0)
    G_STORE(ra1, rb1, 1)
    __syncthreads();
    if (kt + 3 < nk) G_LOAD(ra1, rb1, kt + 3)
    G_COMPUTE(1)
    if (kt + 2 < nk) G_STORE(ra0, rb0, 0)
    __syncthreads();
  }
#undef G_LOAD
#undef G_STORE
#undef G_COMPUTE
}
#define EPI_DECL const int tid_ = otid(); const int lane = tid_ & 63, w_ = tid_ >> 6, wm = w_ >> 1, wn = w_ & 1, fr = lane & 31, fh = lane >> 5; (void)fr; (void)fh; (void)wm; (void)wn;
#define EPI_ROW(mi) (wm * 64 + (mi) * 32 + fr)
#define EPI_COL(ni, q) (wn * 64 + (ni) * 32 + 8 * (q) + 4 * fh)
#define MT_LR0(mt, tpb) (((mt) / (tpb)) * NTOK + ((mt) % (tpb)) * 128)


struct TileIter {
  int tm, tn, pw, ph, PN, NP, x, i, it;
  __device__ __forceinline__ TileIter(int tm_, int tn_) : tm(tm_), tn(tn_) {
    pw = tn < 8 ? tn : 8; ph = 32 / pw; PN = (tn + pw - 1) / pw; NP = ((tm + ph - 1) / ph) * PN;
    x = blockIdx.x & 7; i = blockIdx.x >> 3; it = 0;
  }
  __device__ __forceinline__ bool next(int& mt, int& nt, bool& valid) {
    if (gridDim.x != 256) {
      const int t = blockIdx.x + it * gridDim.x; ++it;
      if (t >= tm * tn) return false;
      mt = t / tn; nt = t % tn; valid = true; return true;
    }
    const int P = it * 8 + x; ++it;
    if (P >= NP) return false;
    mt = (P / PN) * ph + i / pw; nt = (P % PN) * pw + i % pw;
    valid = (mt < tm) && (nt < tn);
    return true;
  }
};

template <class F>
__device__ __forceinline__ void transpose_cvt(const float* __restrict__ src, int ld, F srccol, int K, int Ndst, bf16_t* __restrict__ dst, float* smem) {
  float (*T)[65] = (float (*)[65])smem;
  const int tid = otid();
  const int tk = K >> 6, tn = Ndst >> 6;
  for (int t = blockIdx.x; t < tn * tk; t += gridDim.x) {
    const int n0 = (t / tk) * 64, k0 = (t % tk) * 64;
    __syncthreads();
    const int sc = srccol(n0 + (tid & 63));
#pragma unroll
    for (int i = 0; i < 16; ++i) {
      const int ky = (tid >> 6) + 4 * i;
      T[ky][tid & 63] = (sc >= 0) ? src[(size_t)(k0 + ky) * ld + sc] : 0.f;
    }
    __syncthreads();
#pragma unroll
    for (int i = 0; i < 16; ++i) {
      const int ny = (tid >> 6) + 4 * i;
      dst[(size_t)(n0 + ny) * K + k0 + (tid & 63)] = f2bf(T[tid & 63][ny]);
    }
  }
  __syncthreads();
}
__device__ __forceinline__ void fragpack(const float* __restrict__ src, int ld, int K, int N, bf16_t* __restrict__ dst) {
  const int kc = K >> 6, total = (N >> 5) * kc * 256;
  for (int idx = blockIdx.x * 256 + otid(); idx < total; idx += gridDim.x * 256) {
    const int lane = idx & 63, ks = (idx >> 6) & 3, c = (idx >> 8) % kc, nf = (idx >> 8) / kc;
    const int n = 32 * nf + (lane & 31), k0 = 64 * c + 32 * (lane >> 5) + 8 * ks;
    float f[8];
#pragma unroll
    for (int j = 0; j < 8; ++j) f[j] = src[(size_t)(k0 + j) * ld + n];
    *(u32x4*)(dst + (size_t)idx * 8) = (u32x4){pack2(f[0], f[1]), pack2(f[2], f[3]), pack2(f[4], f[5]), pack2(f[6], f[7])};
  }
}
__device__ __forceinline__ int win_srccol(int n) {
  if (n < 3072) return n;
  if (n < 6656) return n + 16;
  if (n < 6672) return n - 3584;
  return -1;
}

__device__ __forceinline__ void stage_init(const Params& p, float* smem) {
  const int tid = otid();
  if (blockIdx.x == 0 && tid < 64) { ((int*)(p.ws + WB_CNT))[tid] = 0; if (tid < 16) ((int*)(p.ws + WB_POOL))[tid] = 0; }
  {
    float* lx = smem + tid * 33;
    int perm[32];
    {
      v16f a, b;
#pragma unroll
      for (int j = 0; j < 16; ++j) { a[j] = (float)(j & 7); b[j] = (float)((j + 16) & 7); }
      const v32f u1 = __builtin_amdgcn_cvt_scalef32_pk32_f32_fp6(__builtin_amdgcn_cvt_scalef32_2xpk16_fp6_f32(a, b, 1.0f), 1.0f);
#pragma unroll
      for (int j = 0; j < 16; ++j) { a[j] = (float)(j >> 3); b[j] = (float)((j + 16) >> 3); }
      const v32f u2 = __builtin_amdgcn_cvt_scalef32_pk32_f32_fp6(__builtin_amdgcn_cvt_scalef32_2xpk16_fp6_f32(a, b, 1.0f), 1.0f);
#pragma unroll
      for (int k = 0; k < 32; ++k) perm[k] = ((int)(u1[k] + 0.5f) + 8 * (int)(u2[k] + 0.5f)) & 31;
    }
    const size_t ngrp = (size_t)2 * 16384 * 32;
    for (size_t i = (size_t)blockIdx.x * 256 + tid; i < 2 * ngrp; i += (size_t)gridDim.x * 256) {
      const bool isv = i >= ngrp;
      const size_t gi = isv ? i - ngrp : i;
      const float4* s4 = (const float4*)((isv ? p.in[I_PV] : p.in[I_PU]) + gi * 32);
      const float sc = isv ? 2.0f : 64.0f;
      float o[32];
#pragma unroll
      for (int q = 0; q < 8; ++q) { const float4 t = s4[q]; o[4 * q] = t.x * sc; o[4 * q + 1] = t.y * sc; o[4 * q + 2] = t.z * sc; o[4 * q + 3] = t.w * sc; }
#pragma unroll
      for (int k = 0; k < 32; ++k) lx[perm[k]] = o[k];
      v16f a, b;
#pragma unroll
      for (int j = 0; j < 16; ++j) { a[j] = lx[j]; b[j] = lx[16 + j]; }
      const v6u pk = __builtin_amdgcn_cvt_scalef32_2xpk16_fp6_f32(a, b, 1.0f);
      u32x2* d = (u32x2*)(p.ws + (isv ? WB_V16 : WB_U16) + gi * 24);
      d[0] = (u32x2){pk[0], pk[1]}; d[1] = (u32x2){pk[2], pk[3]}; d[2] = (u32x2){pk[4], pk[5]};
    }
    __syncthreads();
  }
  {
    float2* rt = (float2*)(p.ws + WB_ROPE);
    for (int i = blockIdx.x * 256 + tid; i < NLAT * 32; i += gridDim.x * 256) {
      const int pos = i >> 5, j = i & 31;
      const float inv = powf(10000.0f, -(float)(j & 15) / 16.0f);
      const float ang = (float)((j < 16) ? (pos >> 6) : (pos & 63)) * inv;
      rt[i] = make_float2(cosf(ang), sinf(ang));
    }
  }
  {
    float* sc = smem;
    float* red = smem + 9 * 1024;
    for (int i = tid; i < 9 * 1024; i += 256) {
      int r = i >> 10, k = i & 1023;
      float v = (r < 8) ? p.in[I_C][r * 1024 + k] : p.in[I_CCTX][k];
      sc[i] = siluf_(v);
    }
    __syncthreads();
    float* mod = (float*)(p.ws + WB_MOD);
    const int jc = tid & 63, ksl = tid >> 6;
    for (int cb = blockIdx.x; cb < 2 * 6144 / 64; cb += gridDim.x) {
      const int col = cb * 64 + jc;
      const int l = col / 6144, j = col % 6144;
      const float* w = p.in[I_WMOD] + (size_t)l * 1024 * 6144 + j;
      float acc[9];
#pragma unroll
      for (int r = 0; r < 9; ++r) acc[r] = 0.f;
#pragma unroll 8
      for (int k = ksl * 256; k < ksl * 256 + 256; ++k) {
        const float wv = w[(size_t)k * 6144];
#pragma unroll
        for (int r = 0; r < 9; ++r) acc[r] = fmaf(sc[r * 1024 + k], wv, acc[r]);
      }
      __syncthreads();
#pragma unroll
      for (int r = 0; r < 9; ++r) red[(ksl * 64 + jc) * 9 + r] = acc[r];
      __syncthreads();
      if (ksl == 0) {
        const float bv = p.in[I_BMOD][l * 6144 + j];
#pragma unroll
        for (int r = 0; r < 9; ++r)
          mod[((size_t)l * 9 + r) * 6144 + j] = red[jc * 9 + r] + red[(64 + jc) * 9 + r] + red[(128 + jc) * 9 + r] + red[(192 + jc) * 9 + r] + bv;
      }
    }
    __syncthreads();
  }
  bf16_t* WT = (bf16_t*)(p.ws + WB_WT);
  for (int l = 0; l < 2; ++l) {
    bf16_t* W = WT + (size_t)l * WT_LAYER;
    transpose_cvt(p.in[I_WIN] + (size_t)l * DM * INW, INW, [](int n) { return win_srccol(n); }, DM, 6784, W + WT_WIN, smem);
    for (int h = 0; h < 4; ++h) {
      transpose_cvt(p.in[I_MLWQ] + ((size_t)l * 4 + h) * 16384, 128, [](int n) { return n; }, 128, 128, W + WT_WQK + (size_t)h * 256 * 128, smem);
      transpose_cvt(p.in[I_MLWK] + ((size_t)l * 4 + h) * 16384, 128, [](int n) { return n; }, 128, 128, W + WT_WQK + (size_t)h * 256 * 128 + 128 * 128, smem);
    }
    fragpack(p.in[I_GLUW] + (size_t)l * 512 * 512, 512, 512, 512, W + WT_GLU);
    for (int r = 0; r < 3; ++r) fragpack(p.in[I_WBR] + ((size_t)l * 3 + r) * 512 * DM, DM, 512, DM, W + WT_WBR + (size_t)r * 1024 * 512);
    fragpack(p.in[I_WOUT] + (size_t)l * DM * DM, DM, DM, DM, W + WT_WOUT);
    transpose_cvt(p.in[I_PWQ] + (size_t)l * DM * 2048, 2048, [](int n) { return n; }, DM, 2048, W + WT_WQ, smem);
    const float* sk = p.in[I_PSUBK] + (size_t)l * 2 * 128 * 128;
    for (int i = blockIdx.x * 256 + tid; i < 2 * 128 * 128; i += gridDim.x * 256) W[WT_SUBK + i] = f2bf(sk[i]);
  }
}

__device__ __forceinline__ void stage_normmod(const Params& p, int l, int g, int which, int rr_lim, bf16_t* H, float* smem) {
  const int tid = otid(), w = tid >> 6, lane = tid & 63;
  const float* ng = p.in[which ? I_N2G : I_N1G] + l * DM;
  const float* mod = (const float*)(p.ws + WB_MOD) + (size_t)l * 9 * 6144;
  const int off_sh = which ? 3072 : 0, off_sc = which ? 4096 : 1024;
  const int n = GB * rr_lim;
  for (int i0 = (blockIdx.x * 4 + w) * 2; i0 < n; i0 += gridDim.x * 8) {
    float4 v[2][4];
    int bl[2], rr[2];
#pragma unroll
    for (int u = 0; u < 2; ++u) {
      const int i = (i0 + u < n) ? i0 + u : i0;
      bl[u] = i / rr_lim; rr[u] = i % rr_lim;
      const float4* X = (const float4*)((l == 0 && which == 0) ? xrow_in(p, g * GB + bl[u], rr[u]) : xrow(p, g * GB + bl[u], rr[u]));
#pragma unroll
      for (int q = 0; q < 4; ++q) v[u][q] = X[q * 64 + lane];
    }
#pragma unroll
    for (int u = 0; u < 2; ++u) {
      if (i0 + u >= n) break;
      float s = 0.f;
#pragma unroll
      for (int q = 0; q < 4; ++q) s += v[u][q].x * v[u][q].x + v[u][q].y * v[u][q].y + v[u][q].z * v[u][q].z + v[u][q].w * v[u][q].w;
      s = wave_sum(s);
      const float rs = rsqrtf(s * (1.0f / DM) + EPSF);
      const float* m = mod + (size_t)((rr[u] < NLAT) ? (g * GB + bl[u]) : 8) * 6144;
      u32x2* hp = (u32x2*)(H + ((size_t)bl[u] * NTOK + rr[u]) * DM);
#pragma unroll
      for (int q = 0; q < 4; ++q) {
        const float4 gg = ((const float4*)ng)[q * 64 + lane];
        const float4 sc = ((const float4*)(m + off_sc))[q * 64 + lane];
        const float4 sh = ((const float4*)(m + off_sh))[q * 64 + lane];
        const float4 x = v[u][q];
        hp[q * 64 + lane] = (u32x2){pack2(x.x * rs * gg.x * (1.f + sc.x) + sh.x, x.y * rs * gg.y * (1.f + sc.y) + sh.y),
                                    pack2(x.z * rs * gg.z * (1.f + sc.z) + sh.z, x.w * rs * gg.w * (1.f + sc.w) + sh.w)};
      }
    }
  }
}

__device__ __forceinline__ void stage_inproj(const Params& p, const bf16_t* H, const bf16_t* WinT, bf16_t* Z, float* MGT, bf16_t* VT, bf16_t* MVT, char* smem) {
  EPI_DECL
  const int tm = GB * 34, tn = 53;
  const float2* rt = (const float2*)(p.ws + WB_ROPE);
  TileIter ti(tm, tn);
  int mt, j; bool valid;
  while (ti.next(mt, j, valid)) {
    if (!valid) continue;
    const int n0 = j * 128;
    const int lr0 = MT_LR0(mt, 34), rr0 = (mt % 34) * 128;
    f32x16 acc[2][2];
    if ((j >= 8 && j < 12) || (j >= 16 && j < 20)) {
      gemm_tile(WinT + (size_t)n0 * DM, DM, H + (size_t)lr0 * DM, DM, DM, smem, acc);
      bf16_t* vt = ((j < 12) ? VT : MVT) + ((size_t)(mt / 34) * 4 + (j & 3)) * 128 * NTOK;
#pragma unroll
      for (int mi = 0; mi < 2; ++mi)
#pragma unroll
        for (int ni = 0; ni < 2; ++ni)
#pragma unroll
          for (int q = 0; q < 4; ++q) {
            const int e = EPI_ROW(mi), tok = rr0 + EPI_COL(ni, q);
            *(u32x2*)(vt + (size_t)e * NTOK + tok) = (u32x2){pack2(acc[mi][ni][4 * q], acc[mi][ni][4 * q + 1]), pack2(acc[mi][ni][4 * q + 2], acc[mi][ni][4 * q + 3])};
          }
      continue;
    }
    gemm_tile(H + (size_t)lr0 * DM, DM, WinT + (size_t)n0 * DM, DM, DM, smem, acc);
    if (j < 8 && rr0 < NLAT) {
#pragma unroll
      for (int mi = 0; mi < 2; ++mi) {
        const int pos = rr0 + EPI_ROW(mi);
#pragma unroll
        for (int i = 0; i < 16; ++i) {
          const int jj = 8 * (i >> 2) + 4 * fh + (i & 3);
          const float2 cs = rt[pos * 32 + jj];
          const float x1 = acc[mi][0][i], x2 = acc[mi][1][i];
          acc[mi][0][i] = x1 * cs.x - x2 * cs.y;
          acc[mi][1][i] = x1 * cs.y + x2 * cs.x;
        }
      }
    }
    if (j < 52) {
      const bool sg = (j >= 28);
#pragma unroll
      for (int mi = 0; mi < 2; ++mi)
#pragma unroll
        for (int ni = 0; ni < 2; ++ni)
#pragma unroll
          for (int q = 0; q < 4; ++q) {
            const int row = lr0 + EPI_ROW(mi), c = n0 + EPI_COL(ni, q);
            float v0 = acc[mi][ni][4 * q], v1 = acc[mi][ni][4 * q + 1], v2 = acc[mi][ni][4 * q + 2], v3 = acc[mi][ni][4 * q + 3];
            if (sg) { v0 = sigmoidf_(v0); v1 = sigmoidf_(v1); v2 = sigmoidf_(v2); v3 = sigmoidf_(v3); }
            *(u32x2*)(Z + (size_t)row * ZW + c) = (u32x2){pack2(v0, v1), pack2(v2, v3)};
          }
    } else {
#pragma unroll
      for (int mi = 0; mi < 2; ++mi)
#pragma unroll
        for (int q = 0; q < 2; ++q) {
          const int row = lr0 + EPI_ROW(mi), c = EPI_COL(0, q);
          if (wn == 0) *(float4*)(MGT + (size_t)row * 16 + c) = make_float4(acc[mi][0][4 * q], acc[mi][0][4 * q + 1], acc[mi][0][4 * q + 2], acc[mi][0][4 * q + 3]);
        }
    }
  }
}

__device__ __forceinline__ void stage_conv(const Params& p, int l, const bf16_t* Z, bf16_t* XC) {
  const int tid = otid();
  const float* cw = p.in[I_CONVW] + (size_t)l * 3 * 512;
  const float* cb = p.in[I_CONVB] + (size_t)l * 512;
  const int c = tid * 2;
  const float2 w0 = *(const float2*)(cw + c), w1 = *(const float2*)(cw + 512 + c), w2 = *(const float2*)(cw + 1024 + c), bb = *(const float2*)(cb + c);
  for (int lr0 = blockIdx.x * 4; lr0 < RPG; lr0 += gridDim.x * 4) {
    unsigned xc[4], xp[4], xn[4];
#pragma unroll
    for (int u = 0; u < 4; ++u) {
      const int lr = lr0 + u, rr = lr % NTOK;
      const bool has_prev = (rr < NLAT) ? (rr > 0) : (rr > NLAT);
      const bool has_next = (rr < NLAT) ? (rr < NLAT - 1) : (rr < NTOK - 1);
      const bf16_t* z = Z + (size_t)lr * ZW + 1536 + c;
      xc[u] = *(const unsigned*)z;
      xp[u] = has_prev ? *(const unsigned*)(z - ZW) : 0u;
      xn[u] = has_next ? *(const unsigned*)(z + ZW) : 0u;
    }
#pragma unroll
    for (int u = 0; u < 4; ++u) {
      const float a0 = bb.x + w1.x * lo16(xc[u]) + w0.x * lo16(xp[u]) + w2.x * lo16(xn[u]);
      const float a1 = bb.y + w1.y * hi16(xc[u]) + w0.y * hi16(xp[u]) + w2.y * hi16(xn[u]);
      *(unsigned*)(XC + (size_t)(lr0 + u) * 512 + c) = pack2(siluf_(a0), siluf_(a1));
    }
  }
}

__device__ __forceinline__ void stage_mlqk(const Params& p, int l, const bf16_t* Z, bf16_t* XC, const bf16_t* WQK, bf16_t* QM, bf16_t* KM, bf16_t* KMT, char* smem) {
  EPI_DECL
  const int tm = RPG >> 7;
  TileIter ti(tm, 12);
  int mt, r12; bool valid;
  while (ti.next(mt, r12, valid)) {
    if (!valid) continue;
    const int h = r12 & 3, kind = r12 >> 2;
    const int m0 = mt * 128;
    {
      const int ct = otid(), c = h * 128 + (ct & 15) * 8, r0 = ct >> 4;
      const float* cw = p.in[I_CONVW] + (size_t)l * 3 * 512 + c;
      const float* cb = p.in[I_CONVB] + (size_t)l * 512 + c;
      float w0[8], w1[8], w2[8], bb[8];
#pragma unroll
      for (int j = 0; j < 8; ++j) { w0[j] = cw[j]; w1[j] = cw[512 + j]; w2[j] = cw[1024 + j]; bb[j] = cb[j]; }
      u32x4 xc[8], xp[8], xn[8];
#pragma unroll
      for (int u = 0; u < 8; ++u) {
        const int lr = m0 + r0 + 16 * u, rr = lr % NTOK;
        const bool has_prev = (rr < NLAT) ? (rr > 0) : (rr > NLAT);
        const bool has_next = (rr < NLAT) ? (rr < NLAT - 1) : (rr < NTOK - 1);
        const bf16_t* z = Z + (size_t)lr * ZW + 1536 + c;
        xc[u] = *(const u32x4*)z;
        xp[u] = has_prev ? *(const u32x4*)(z - ZW) : (u32x4){0u, 0u, 0u, 0u};
        xn[u] = has_next ? *(const u32x4*)(z + ZW) : (u32x4){0u, 0u, 0u, 0u};
      }
#pragma unroll
      for (int u = 0; u < 8; ++u) {
        u32x4 o;
#pragma unroll
        for (int k = 0; k < 4; ++k) {
          const float a0 = bb[2 * k] + w1[2 * k] * lo16(xc[u][k]) + w0[2 * k] * lo16(xp[u][k]) + w2[2 * k] * lo16(xn[u][k]);
          const float a1 = bb[2 * k + 1] + w1[2 * k + 1] * hi16(xc[u][k]) + w0[2 * k + 1] * hi16(xp[u][k]) + w2[2 * k + 1] * hi16(xn[u][k]);
          o[k] = pack2(siluf_(a0), siluf_(a1));
        }
        *(u32x4*)(XC + (size_t)(m0 + r0 + 16 * u) * 512 + c) = o;
      }
      __syncthreads();
    }
    f32x16 acc[2][2];
    const bf16_t* Wt = WQK + (size_t)h * 256 * 128 + (size_t)(kind ? 1 : 0) * 128 * 128;
    const bf16_t* Xt = XC + (size_t)m0 * 512 + h * 128;
    if (kind < 2) {
      gemm_tile(Xt, 512, Wt, 128, 128, smem, acc);
      bf16_t* O = kind ? KM : QM;
      const float alpha = kind ? 1.0f : 0.08838834764831845f;
#pragma unroll
      for (int mi = 0; mi < 2; ++mi)
#pragma unroll
        for (int ni = 0; ni < 2; ++ni)
#pragma unroll
          for (int q = 0; q < 4; ++q) {
            const int row = m0 + EPI_ROW(mi), c = EPI_COL(ni, q);
            *(u32x2*)(O + (size_t)row * 512 + h * 128 + c) = (u32x2){pack2(alpha * acc[mi][ni][4 * q], alpha * acc[mi][ni][4 * q + 1]), pack2(alpha * acc[mi][ni][4 * q + 2], alpha * acc[mi][ni][4 * q + 3])};
          }
    } else {
      gemm_tile(Wt, 128, Xt, 512, 128, smem, acc);
      bf16_t* kt = KMT + ((size_t)(mt / 34) * 4 + h) * 128 * NTOK + (mt % 34) * 128;
#pragma unroll
      for (int mi = 0; mi < 2; ++mi)
#pragma unroll
        for (int ni = 0; ni < 2; ++ni)
#pragma unroll
          for (int q = 0; q < 4; ++q) {
            const int d = EPI_ROW(mi), tok = EPI_COL(ni, q);
            *(u32x2*)(kt + (size_t)d * NTOK + tok) = (u32x2){pack2(acc[mi][ni][4 * q], acc[mi][ni][4 * q + 1]), pack2(acc[mi][ni][4 * q + 2], acc[mi][ni][4 * q + 3])};
          }
    }
  }
}

__device__ __forceinline__ void attn_mfma_item(const Params& p, int l, const bf16_t* Zb, const bf16_t* VTb, bf16_t* YAb, int h, int qrow0, int key0, int nkeys,
                                               float lam, float lam_init, char* smem) {
  const int tid = otid(), lane = tid & 63, w = tid >> 6, fr = lane & 31, fh = lane >> 5;
  const int rb = w & 1, m = w >> 1;
  const int ntiles = nkeys >> 6;
  const int myrow = qrow0 + rb * 32 + fr;
  bf16x8 qf[4];
  {
    const bf16_t* qp = Zb + (size_t)myrow * ZW + h * 128 + m * 64 + fh * 8;
#pragma unroll
    for (int ks = 0; ks < 4; ++ks) qf[ks] = *(const bf16x8*)(qp + ks * 16);
  }
  f32x16 O[4];
#pragma unroll
  for (int eb = 0; eb < 4; ++eb)
#pragma unroll
    for (int i = 0; i < 16; ++i) O[eb][i] = 0.f;
  float mrun = -1e30f, lrun = 0.f;
  const float cs = 0.125f * 1.4426950408889634f;
  const int skey = tid >> 4, sch = tid & 15;
  const bf16_t* ksrc = Zb + (size_t)(key0 + skey) * ZW + 512 + h * 128 + sch * 8;
  const int kdst = skey * 256 + ((sch ^ (skey & 15)) << 4);
  const int se = tid >> 3, svc = tid & 7;
  const bf16_t* vsrc = VTb + ((size_t)h * 128 + se) * NTOK + key0 + svc * 8;
  const int vsw = (se >> 1) & 15;
  const int vdst0 = se * 128 + (((2 * svc) ^ vsw) << 3), vdst1 = se * 128 + (((2 * svc + 1) ^ vsw) << 3);
  const int kfo = fr * 256, kfs = fr & 15;
  const int vfo = fr * 128, vfs = (fr >> 1) & 15;
  u32x4 rk[4], rv[4];
#pragma unroll
  for (int i = 0; i < 4; ++i) rk[i] = *(const u32x4*)(ksrc + (size_t)i * 16 * ZW);
  __syncthreads();
#pragma unroll
  for (int i = 0; i < 4; ++i) *(u32x4*)(smem + kdst + i * 4096) = rk[i];
  __syncthreads();
  bf16x8 pf[4];
#define ATT_S(T) { const char* kb_ = smem + ((T) & 1) * 16384; _Pragma("unroll") for (int kb = 0; kb < 2; ++kb) { \
      _Pragma("unroll") for (int i = 0; i < 16; ++i) S[kb][i] = 0.f; \
      _Pragma("unroll") for (int ks = 0; ks < 4; ++ks) { \
        const bf16x8 kf = *(const bf16x8*)(kb_ + kb * 8192 + kfo + (((m * 8 + ks * 2 + fh) ^ kfs) << 4)); \
        S[kb] = __builtin_amdgcn_mfma_f32_32x32x16_bf16(kf, qf[ks], S[kb], 0, 0, 0); } } }
#define ATT_MAX() { float tm = S[0][0]; \
      _Pragma("unroll") for (int i = 1; i < 16; ++i) tm = fmaxf(tm, S[0][i]); \
      _Pragma("unroll") for (int i = 0; i < 16; ++i) tm = fmaxf(tm, S[1][i]); \
      tm = fmaxf(tm, __shfl_xor(tm, 32)) * cs; alpha = 1.f; \
      if (tm > mrun + 8.0f) { alpha = __builtin_amdgcn_exp2f(mrun - tm); mrun = tm; } }
#define ATT_EXP(PF) { const float mc = mrun; float rs = 0.f; \
      _Pragma("unroll") for (int kb = 0; kb < 2; ++kb) { float pv[16]; \
        _Pragma("unroll") for (int i = 0; i < 16; ++i) { pv[i] = __builtin_amdgcn_exp2f(fmaf(S[kb][i], cs, -mc)); rs += pv[i]; } \
        _Pragma("unroll") for (int hh = 0; hh < 2; ++hh) \
          PF[kb * 2 + hh] = __builtin_bit_cast(bf16x8, (u32x4){pack2(pv[8 * hh], pv[8 * hh + 1]), pack2(pv[8 * hh + 2], pv[8 * hh + 3]), \
                                                               pack2(pv[8 * hh + 4], pv[8 * hh + 5]), pack2(pv[8 * hh + 6], pv[8 * hh + 7])}); } \
      lrun += rs; }
#define ATT_PV(T) { const char* vb_ = smem + 32768 + ((T) & 1) * 16384; _Pragma("unroll") for (int eb = 0; eb < 4; ++eb) _Pragma("unroll") for (int s = 0; s < 4; ++s) { \
        const u32x2 v0 = *(const u32x2*)(vb_ + eb * 4096 + vfo + (((4 * s + fh) ^ vfs) << 3)); \
        const u32x2 v1 = *(const u32x2*)(vb_ + eb * 4096 + vfo + (((4 * s + fh + 2) ^ vfs) << 3)); \
        const bf16x8 vf = __builtin_bit_cast(bf16x8, (u32x4){v0[0], v0[1], v1[0], v1[1]}); \
        O[eb] = __builtin_amdgcn_mfma_f32_32x32x16_bf16(vf, pf[s], O[eb], 0, 0, 0); } }
  f32x16 S[2];
  float alpha;
  {
#pragma unroll
    for (int i = 0; i < 4; ++i) rk[i] = *(const u32x4*)(ksrc + (size_t)(64 + i * 16) * ZW);
#pragma unroll
    for (int i = 0; i < 4; ++i) rv[i] = *(const u32x4*)(vsrc + (size_t)i * 32 * NTOK);
    ATT_S(0)
    ATT_MAX()
    ATT_EXP(pf)
#pragma unroll
    for (int i = 0; i < 4; ++i) *(u32x4*)(smem + 16384 + kdst + i * 4096) = rk[i];
#pragma unroll
    for (int i = 0; i < 4; ++i) {
      *(u32x2*)(smem + 32768 + vdst0 + i * 4096) = (u32x2){rv[i][0], rv[i][1]};
      *(u32x2*)(smem + 32768 + vdst1 + i * 4096) = (u32x2){rv[i][2], rv[i][3]};
    }
    __syncthreads();
  }
#pragma unroll 1
  for (int t = 1; t < ntiles; ++t) {
    const int tn = (t + 1 < ntiles) ? t + 1 : t;
#pragma unroll
    for (int i = 0; i < 4; ++i) rk[i] = *(const u32x4*)(ksrc + (size_t)(tn * 64 + i * 16) * ZW);
#pragma unroll
    for (int i = 0; i < 4; ++i) rv[i] = *(const u32x4*)(vsrc + (size_t)i * 32 * NTOK + t * 64);
    ATT_S(t)
    ATT_MAX()
    if (__any(alpha != 1.f)) {
#pragma unroll
      for (int eb = 0; eb < 4; ++eb)
#pragma unroll
        for (int i = 0; i < 16; ++i) O[eb][i] *= alpha;
      lrun *= alpha;
#pragma unroll
      for (int s = 0; s < 4; ++s) {
        const u32x4 r_ = __builtin_bit_cast(u32x4, pf[s]);
        pf[s] = __builtin_bit_cast(bf16x8, (u32x4){pack2(lo16(r_[0]) * alpha, hi16(r_[0]) * alpha), pack2(lo16(r_[1]) * alpha, hi16(r_[1]) * alpha),
                                                   pack2(lo16(r_[2]) * alpha, hi16(r_[2]) * alpha), pack2(lo16(r_[3]) * alpha, hi16(r_[3]) * alpha)});
      }
    }
    bf16x8 pn[4];
    {
      ATT_PV(t - 1)
      ATT_EXP(pn)
#pragma unroll
      for (int i = 0; i < 16; ++i) {
        __builtin_amdgcn_sched_group_barrier(0x100, 1, 0);
        __builtin_amdgcn_sched_group_barrier(0x008, 1, 0);
        __builtin_amdgcn_sched_group_barrier(0x002, 9, 0);
      }
    }
#pragma unroll
    for (int s = 0; s < 4; ++s) pf[s] = pn[s];
    if (t + 1 < ntiles) {
      char* kd = smem + ((t + 1) & 1) * 16384;
#pragma unroll
      for (int i = 0; i < 4; ++i) *(u32x4*)(kd + kdst + i * 4096) = rk[i];
    }
    {
      char* vd = smem + 32768 + (t & 1) * 16384;
#pragma unroll
      for (int i = 0; i < 4; ++i) {
        *(u32x2*)(vd + vdst0 + i * 4096) = (u32x2){rv[i][0], rv[i][1]};
        *(u32x2*)(vd + vdst1 + i * 4096) = (u32x2){rv[i][2], rv[i][3]};
      }
    }
    __syncthreads();
  }
  ATT_PV(ntiles - 1)
  __syncthreads();
#undef ATT_S
#undef ATT_MAX
#undef ATT_EXP
#undef ATT_PV
  const float lt = lrun + __shfl_xor(lrun, 32);
  const float sc = (m ? lam : 1.0f) / lt;
  float* xo = (float*)smem + rb * 4096;
  if (m == 1) {
#pragma unroll
    for (int eb = 0; eb < 4; ++eb)
#pragma unroll
      for (int i = 0; i < 16; ++i) xo[(eb * 32 + (i & 3) + 8 * (i >> 2) + 4 * fh) * 32 + fr] = O[eb][i] * sc;
  }
  __syncthreads();
  if (m == 0) {
    float ss = 0.f;
#pragma unroll
    for (int eb = 0; eb < 4; ++eb)
#pragma unroll
      for (int i = 0; i < 16; ++i) {
        const float o = O[eb][i] * sc - xo[(eb * 32 + (i & 3) + 8 * (i >> 2) + 4 * fh) * 32 + fr];
        O[eb][i] = o; ss = fmaf(o, o, ss);
      }
    ss += __shfl_xor(ss, 32);
    const float rn = rsqrtf(ss * (1.0f / 128.0f) + EPSF) * (1.0f - lam_init);
    const float* sg = p.in[I_SUBG] + l * 512 + h * 128;
    bf16_t* yp = YAb + (size_t)myrow * 512 + h * 128;
#pragma unroll
    for (int eb = 0; eb < 4; ++eb)
#pragma unroll
      for (int q = 0; q < 4; ++q) {
        const int e = eb * 32 + 8 * q + 4 * fh;
        const float4 g = *(const float4*)(sg + e);
        *(u32x2*)(yp + e) = (u32x2){pack2(O[eb][4 * q] * rn * g.x, O[eb][4 * q + 1] * rn * g.y), pack2(O[eb][4 * q + 2] * rn * g.z, O[eb][4 * q + 3] * rn * g.w)};
      }
  }
  __syncthreads();
}

__device__ __forceinline__ int mlstm_row0(int dir, int c) {
  return (dir == 0) ? ((c < 4) ? NLAT + 64 * c : 64 * (c - 4)) : ((c < 4) ? NLAT + 64 * (3 - c) : 64 * (67 - c));
}
__device__ __forceinline__ void stage_mlgates(const Params& p, int l, const float* MGT, float* GA) {
  const int tid = otid(), w = tid >> 6, lane = tid & 63;
  const int nitems = GB * 4 * 2 * 68;
  for (int idx = blockIdx.x * 4 + w; idx < nitems; idx += gridDim.x * 4) {
    const int c = idx % 68, r1 = idx / 68, dir = r1 & 1, h = (r1 >> 1) & 3, bl = r1 >> 3;
    const int row = mlstm_row0(dir, c) + lane;
    const float* mg = MGT + ((size_t)bl * NTOK + row) * 16;
    const float li = mg[dir * 8 + h] + p.in[I_GATEB][l * 16 + dir * 8 + h];
    const float x = mg[dir * 8 + 4 + h] + p.in[I_GATEB][l * 16 + dir * 8 + 4 + h];
    const float lf = fminf(x, 0.f) - log1pf(expf(-fabsf(x)));
    float b = lf;
#pragma unroll
    for (int o = 1; o < 64; o <<= 1) {
      const float v = (dir == 0) ? __shfl_up(b, o) : __shfl_down(b, o);
      const bool ok = (dir == 0) ? (lane >= o) : (lane + o < 64);
      if (ok) b += v;
    }
    const float tot = (dir == 0) ? __shfl(b, 63) : __shfl(b, 0);
    float* ga = GA + (size_t)idx * 272;
    ga[lane] = b * 1.4426950408889634f; ga[64 + lane] = (li - b) * 1.4426950408889634f; ga[128 + lane] = expf(tot + li - b); ga[192 + lane] = expf(b);
    if (lane < 4) ga[256 + lane] = expf(tot);
  }
}

__device__ __forceinline__ void mlstm_chain_item(const Params& p, int l, const bf16_t* QMb, const bf16_t* KMb, const bf16_t* KMTb, const bf16_t* MVTb,
                                                 const float* GAc, bf16_t* HXb, int h, int dir, int ehalf, char* smem) {
  const int tid = otid(), lane = tid & 63, w = tid >> 6, fr = lane & 31, fh = lane >> 5;
  const int tb = w & 1, xb = w >> 1;
  float* fl = (float*)(smem + 73728);
  float* bs = fl; float* as_ = fl + 64; float* wgs = fl + 128; float* ebs = fl + 192; float* dec_s = fl + 256; float* nprev = fl + 272; float* npart = fl + 400;
  f32x16 CT[2];
#pragma unroll
  for (int eb = 0; eb < 2; ++eb)
#pragma unroll
    for (int i = 0; i < 16; ++i) CT[eb][i] = 0.f;
  __syncthreads();
  { u32x4 z_ = (u32x4){0u, 0u, 0u, 0u}; asm volatile("" : "+v"(z_));
    for (int i = tid; i < 1024; i += 256) ((u32x4*)(smem + 57344))[i] = z_; }
  if (tid < 128) nprev[tid] = 0.f;
  const int qr = tid >> 4, qc = tid & 15;
  const int qdst = qr * 256 + ((qc ^ (qr & 15)) << 4);
  const int tr = tid >> 3, tc = tid & 7;
  const int tdst = tr * 128 + ((tc ^ ((tr >> 1) & 7)) << 4);
  const int sw16 = fr & 15, sw8 = (fr >> 1) & 7;
  u32x4 ra[4], rb[4], rc[4], rd[2];
  float4 rg = make_float4(0.f, 0.f, 0.f, 0.f);
#define ML_LOAD(C_) { const int r0_ = mlstm_row0(dir, (C_)); \
    const bf16_t* qs = QMb + (size_t)(r0_ + qr) * 512 + h * 128 + qc * 8; \
    const bf16_t* ks = KMb + (size_t)(r0_ + qr) * 512 + h * 128 + qc * 8; \
    const bf16_t* kts = KMTb + ((size_t)h * 128 + tr) * NTOK + r0_ + tc * 8; \
    const bf16_t* vts = MVTb + ((size_t)h * 128 + ehalf * 64 + tr) * NTOK + r0_ + tc * 8; \
    _Pragma("unroll") for (int i = 0; i < 4; ++i) { ra[i] = *(const u32x4*)(qs + (size_t)i * 16 * 512); rb[i] = *(const u32x4*)(ks + (size_t)i * 16 * 512); \
                                                    rc[i] = *(const u32x4*)(kts + (size_t)i * 32 * NTOK); } \
    _Pragma("unroll") for (int i = 0; i < 2; ++i) rd[i] = *(const u32x4*)(vts + (size_t)i * 32 * NTOK); \
    if (tid < 68) rg = ((const float4*)(GAc + (size_t)(C_) * 272))[tid]; }
  ML_LOAD(0)
#pragma unroll 1
  for (int c = 0; c < 68; ++c) {
    const int row0 = mlstm_row0(dir, c);
    __syncthreads();
#pragma unroll
    for (int i = 0; i < 4; ++i) {
      *(u32x4*)(smem + qdst + i * 4096) = ra[i];
      *(u32x4*)(smem + 16384 + qdst + i * 4096) = rb[i];
      *(u32x4*)(smem + 32768 + tdst + i * 4096) = rc[i];
    }
#pragma unroll
    for (int i = 0; i < 2; ++i) *(u32x4*)(smem + 49152 + tdst + i * 4096) = rd[i];
    if (tid < 68) ((float4*)fl)[tid] = rg;
    if (c + 1 < 68) ML_LOAD(c + 1)
    __syncthreads();
    const int t = tb * 32 + fr;
    bf16x8 qf[8];
#pragma unroll
    for (int ks = 0; ks < 8; ++ks) qf[ks] = *(const bf16x8*)(smem + t * 256 + (((ks * 2 + fh) ^ sw16) << 4));
    const float bt = bs[t], ebt = ebs[t];
    f32x16 S[2];
    float dsum = 0.f;
#pragma unroll
    for (int sb = 0; sb < 2; ++sb) {
#pragma unroll
      for (int i = 0; i < 16; ++i) S[sb][i] = 0.f;
      const bool valid = (dir == 0) ? (sb <= tb) : (sb >= tb);
      if (valid) {
#pragma unroll
        for (int ks = 0; ks < 8; ++ks) {
          const bf16x8 kf = *(const bf16x8*)(smem + 16384 + (sb * 32 + fr) * 256 + (((ks * 2 + fh) ^ sw16) << 4));
          S[sb] = __builtin_amdgcn_mfma_f32_32x32x16_bf16(kf, qf[ks], S[sb], 0, 0, 0);
        }
#pragma unroll
        for (int q = 0; q < 4; ++q) {
          const float4 a4 = *(const float4*)(as_ + sb * 32 + 8 * q + 4 * fh);
          const float av[4] = {a4.x, a4.y, a4.z, a4.w};
#pragma unroll
          for (int j = 0; j < 4; ++j) {
            const int s = sb * 32 + 8 * q + 4 * fh + j;
            const bool ok = (dir == 0) ? (s <= t) : (s >= t);
            const float v = ok ? S[sb][4 * q + j] * __builtin_amdgcn_exp2f(bt + av[j]) : 0.f;
            S[sb][4 * q + j] = v;
            dsum += v;
          }
        }
      }
    }
    bf16x8 pf[4];
#pragma unroll
    for (int sb = 0; sb < 2; ++sb)
#pragma unroll
      for (int hh = 0; hh < 2; ++hh)
        pf[sb * 2 + hh] = __builtin_bit_cast(bf16x8, (u32x4){pack2(S[sb][8 * hh], S[sb][8 * hh + 1]), pack2(S[sb][8 * hh + 2], S[sb][8 * hh + 3]),
                                                                 pack2(S[sb][8 * hh + 4], S[sb][8 * hh + 5]), pack2(S[sb][8 * hh + 6], S[sb][8 * hh + 7])});
    float nq = 0.f;
#pragma unroll
    for (int c8 = 0; c8 < 8; ++c8) {
      const u32x4 qv = *(const u32x4*)(smem + t * 256 + (((fh * 8 + c8) ^ sw16) << 4));
      const float4 n0 = *(const float4*)(nprev + fh * 64 + c8 * 8), n1 = *(const float4*)(nprev + fh * 64 + c8 * 8 + 4);
      nq = fmaf(lo16(qv[0]), n0.x, nq); nq = fmaf(hi16(qv[0]), n0.y, nq); nq = fmaf(lo16(qv[1]), n0.z, nq); nq = fmaf(hi16(qv[1]), n0.w, nq);
      nq = fmaf(lo16(qv[2]), n1.x, nq); nq = fmaf(hi16(qv[2]), n1.y, nq); nq = fmaf(lo16(qv[3]), n1.z, nq); nq = fmaf(hi16(qv[3]), n1.w, nq);
    }
    dsum += __shfl_xor(dsum, 32);
    nq += __shfl_xor(nq, 32);
    const float den = dsum + ebt * nq;
    const float inv = 1.0f / fmaxf(fabsf(den), 1.0f);
    {
      f32x16 N;
#pragma unroll
      for (int i = 0; i < 16; ++i) N[i] = 0.f;
#pragma unroll
      for (int ks = 0; ks < 8; ++ks) {
        const bf16x8 cf = *(const bf16x8*)(smem + 57344 + (xb * 32 + fr) * 256 + (((ks * 2 + fh) ^ sw16) << 4));
        N = __builtin_amdgcn_mfma_f32_32x32x16_bf16(cf, qf[ks], N, 0, 0, 0);
      }
#pragma unroll
      for (int i = 0; i < 16; ++i) N[i] *= ebt;
#pragma unroll
      for (int s4 = 0; s4 < 4; ++s4) {
        const bool valid = (dir == 0) ? ((s4 >> 1) <= tb) : ((s4 >> 1) >= tb);
        if (valid) {
          const int u0 = 4 * s4 + fh, u1 = u0 + 2;
          const char* vrow = smem + 49152 + (xb * 32 + fr) * 128;
          const u32x2 v0 = *(const u32x2*)(vrow + (((u0 >> 1) ^ sw8) << 4) + (u0 & 1) * 8);
          const u32x2 v1 = *(const u32x2*)(vrow + (((u1 >> 1) ^ sw8) << 4) + (u1 & 1) * 8);
          const bf16x8 vf = __builtin_bit_cast(bf16x8, (u32x4){v0[0], v0[1], v1[0], v1[1]});
          N = __builtin_amdgcn_mfma_f32_32x32x16_bf16(vf, pf[s4], N, 0, 0, 0);
        }
      }
      bf16_t* hp = HXb + (size_t)(row0 + t) * 512 + h * 128 + (2 * ehalf + xb) * 32 + 4 * fh;
#pragma unroll
      for (int q = 0; q < 4; ++q)
        *(u32x2*)(hp + 8 * q) = (u32x2){pack2(N[4 * q] * inv, N[4 * q + 1] * inv), pack2(N[4 * q + 2] * inv, N[4 * q + 3] * inv)};
    }
    const float decay = *dec_s;
#pragma unroll
    for (int eb = 0; eb < 2; ++eb)
#pragma unroll
      for (int i = 0; i < 16; ++i) CT[eb][i] *= decay;
#pragma unroll
    for (int ks = 0; ks < 4; ++ks) {
      const u32x4 kraw = *(const u32x4*)(smem + 32768 + (w * 32 + fr) * 128 + (((ks * 2 + fh) ^ sw8) << 4));
      const float4 g0 = *(const float4*)(wgs + ks * 16 + 8 * fh), g1 = *(const float4*)(wgs + ks * 16 + 8 * fh + 4);
      const bf16x8 kts = __builtin_bit_cast(bf16x8, (u32x4){pack2(lo16(kraw[0]) * g0.x, hi16(kraw[0]) * g0.y), pack2(lo16(kraw[1]) * g0.z, hi16(kraw[1]) * g0.w),
                                                             pack2(lo16(kraw[2]) * g1.x, hi16(kraw[2]) * g1.y), pack2(lo16(kraw[3]) * g1.z, hi16(kraw[3]) * g1.w)});
#pragma unroll
      for (int eb = 0; eb < 2; ++eb) {
        const bf16x8 vt = *(const bf16x8*)(smem + 49152 + (eb * 32 + fr) * 128 + (((ks * 2 + fh) ^ sw8) << 4));
        CT[eb] = __builtin_amdgcn_mfma_f32_32x32x16_bf16(kts, vt, CT[eb], 0, 0, 0);
      }
    }
    {
      const int d = tid & 127, sh = tid >> 7;
      float a = 0.f;
#pragma unroll 8
      for (int s = sh * 32; s < sh * 32 + 32; ++s) {
        const bf16_t kv = *(const bf16_t*)(smem + 16384 + s * 256 + ((((d >> 3)) ^ (s & 15)) << 4) + (d & 7) * 2);
        a = fmaf(wgs[s], bf2f(kv), a);
      }
      npart[sh * 128 + d] = a;
    }
    __syncthreads();
#pragma unroll
    for (int eb = 0; eb < 2; ++eb)
#pragma unroll
      for (int q = 0; q < 4; ++q)
        *(u32x2*)(smem + 57344 + (eb * 32 + fr) * 256 + ((((w * 4 + q)) ^ sw16) << 4) + 8 * fh) =
            (u32x2){pack2(CT[eb][4 * q], CT[eb][4 * q + 1]), pack2(CT[eb][4 * q + 2], CT[eb][4 * q + 3])};
    if (tid < 128) nprev[tid] = decay * nprev[tid] + npart[tid] + npart[128 + tid];
  }
#undef ML_LOAD
  __syncthreads();
}

#define S5SEG 128
#define S5NSEG 34
__device__ __forceinline__ int s5_row(int dir, int step) {
  return (dir == 0) ? ((step < NCTX) ? NLAT + step : step - NCTX)
                    : ((step < NCTX) ? NLAT + (NCTX - 1 - step) : (NLAT - 1) - (step - NCTX));
}
__device__ __forceinline__ bf16x8 pack8(const float* f) {
  return __builtin_bit_cast(bf16x8, (u32x4){pack2(f[0], f[1]), pack2(f[2], f[3]), pack2(f[4], f[5]), pack2(f[6], f[7])});
}
struct S5M { float abr, abi, a128r, a128i; bf16x8 bbf[4]; };
__device__ __forceinline__ void s5m_setup(const Params& p, int pg, int lane, S5M& m) {
  const int fr = lane & 31, fh = lane >> 5;
  const float dt = expf(p.in[I_S5DT][pg]);
  m.abr = 0.f; m.abi = 0.f; m.a128r = 0.f; m.a128i = 0.f;
#pragma unroll
  for (int c = 0; c < 2; ++c) {
    const int n = fr + 32 * c;
    const float lre = p.in[I_S5LRE][pg * 64 + n], lim = p.in[I_S5LIM][pg * 64 + n];
    const float mag = expf(lre * dt);
    const float abr = mag * cosf(lim * dt), abi = mag * sinf(lim * dt);
    const float den = lre * lre + lim * lim;
    const float zr = ((abr - 1.0f) * lre + abi * lim) / den;
    const float zi = (abi * lre - (abr - 1.0f) * lim) / den;
    const float4* br4 = (const float4*)(p.in[I_S5BRE] + ((size_t)pg * 64 + n) * 16 + 8 * fh);
    const float4* bi4 = (const float4*)(p.in[I_S5BIM] + ((size_t)pg * 64 + n) * 16 + 8 * fh);
    const float4 b0 = br4[0], b1 = br4[1], c0 = bi4[0], c1 = bi4[1];
    const float br[8] = {b0.x, b0.y, b0.z, b0.w, b1.x, b1.y, b1.z, b1.w}, bi[8] = {c0.x, c0.y, c0.z, c0.w, c1.x, c1.y, c1.z, c1.w};
    float rr[8], ii[8];
#pragma unroll
    for (int j = 0; j < 8; ++j) { rr[j] = zr * br[j] - zi * bi[j]; ii[j] = zr * bi[j] + zi * br[j]; }
    m.bbf[c] = pack8(rr); m.bbf[2 + c] = pack8(ii);
    if (fh == c) {
      m.abr = abr; m.abi = abi;
      const float mg = expf(lre * dt * (float)S5SEG);
      m.a128r = mg * cosf(lim * dt * (float)S5SEG); m.a128i = mg * sinf(lim * dt * (float)S5SEG);
    }
  }
}
template <bool STORE>
__device__ __forceinline__ void s5m_block(const S5M& m, const bf16x8 uf, float& xr, float& xi, char* xs, int lane) {
  f32x16 T[4];
#pragma unroll
  for (int k = 0; k < 4; ++k) {
#pragma unroll
    for (int i = 0; i < 16; ++i) T[k][i] = 0.f;
    T[k] = __builtin_amdgcn_mfma_f32_32x32x16_bf16(uf, m.bbf[k], T[k], 0, 0, 0);
  }
#pragma unroll
  for (int r = 0; r < 16; ++r) {
    auto a = __builtin_amdgcn_permlane32_swap(__float_as_uint(T[0][r]), __float_as_uint(T[1][r]), false, false);
    T[0][r] = __uint_as_float(a[0]); T[1][r] = __uint_as_float(a[1]);
    auto b = __builtin_amdgcn_permlane32_swap(__float_as_uint(T[2][r]), __float_as_uint(T[3][r]), false, false);
    T[2][r] = __uint_as_float(b[0]); T[3][r] = __uint_as_float(b[1]);
  }
#pragma unroll
  for (int q = 0; q < 4; ++q)
#pragma unroll
    for (int hh = 0; hh < 2; ++hh)
#pragma unroll
      for (int j = 0; j < 4; ++j) {
        const int t = 8 * q + 4 * hh + j, r = 4 * q + j;
        const float bre = hh ? T[1][r] : T[0][r], bim = hh ? T[3][r] : T[2][r];
        const float nr = fmaf(m.abr, xr, fmaf(-m.abi, xi, bre));
        const float ni = fmaf(m.abr, xi, fmaf(m.abi, xr, bim));
        xr = nr; xi = ni;
        if (STORE) *(unsigned*)(xs + t * 256 + (((lane >> 2) ^ (t & 15)) << 4) + (lane & 3) * 4) = pack2(xr, xi);
      }
}
__device__ __forceinline__ void stage_s5_pass1(const Params& p, int l, const bf16_t* Z, float* XE) {
  const int tid = otid(), w = tid >> 6, lane = tid & 63, fr = lane & 31, fh = lane >> 5;
  const int nitems = GB * 32 * 2 * (S5NSEG - 1);
  for (int idx = blockIdx.x * 4 + w; idx < nitems; idx += gridDim.x * 4) {
    const int seg = idx % (S5NSEG - 1), r1 = idx / (S5NSEG - 1), dir = r1 & 1, g = (r1 >> 1) & 31, bl = r1 >> 6;
    S5M m;
    s5m_setup(p, (l * 2 + dir) * 32 + g, lane, m);
    float xr = 0.f, xi = 0.f;
    bf16x8 ufs[S5SEG / 32];
#pragma unroll
    for (int sub = 0; sub < S5SEG / 32; ++sub) {
      const int row = s5_row(dir, seg * S5SEG + sub * 32 + fr);
      ufs[sub] = *(const bf16x8*)(Z + ((size_t)bl * NTOK + row) * ZW + 3072 + g * 16 + 8 * fh);
    }
#pragma unroll
    for (int sub = 0; sub < S5SEG / 32; ++sub) s5m_block<false>(m, ufs[sub], xr, xi, nullptr, lane);
    float* xe = XE + ((((size_t)bl * 32 + g) * 2 + dir) * (S5NSEG - 1) + seg) * 128;
    xe[lane] = xr; xe[64 + lane] = xi;
  }
}
__device__ __forceinline__ void s5_item(const Params& p, int l, const bf16_t* Zb, const float* XEc, float* Yb, int g, int dir, int sq, char* smem) {
  const int tid = otid(), w = tid >> 6, lane = tid & 63, fr = lane & 31, fh = lane >> 5;
  const int seg = sq * 4 + w;
  char* xs = smem + w * 8192;
  const int pg = (l * 2 + dir) * 32 + g;
  __syncthreads();
  if (seg < S5NSEG) {
    S5M m;
    s5m_setup(p, pg, lane, m);
    bf16x8 ccf[8];
#pragma unroll
    for (int ks = 0; ks < 8; ++ks) {
      float f[8] = {0.f, 0.f, 0.f, 0.f, 0.f, 0.f, 0.f, 0.f};
      if (fr < 16) {
        const float4 cr = *(const float4*)(p.in[I_S5CRE] + ((size_t)pg * 16 + fr) * 64 + ks * 8 + 4 * fh);
        const float4 ci = *(const float4*)(p.in[I_S5CIM] + ((size_t)pg * 16 + fr) * 64 + ks * 8 + 4 * fh);
        f[0] = cr.x; f[1] = -ci.x; f[2] = cr.y; f[3] = -ci.y; f[4] = cr.z; f[5] = -ci.z; f[6] = cr.w; f[7] = -ci.w;
      }
      ccf[ks] = pack8(f);
    }
    float xr = 0.f, xi = 0.f;
    for (int j = 0; j < seg; ++j) {
      const float er = XEc[j * 128 + lane], ei = XEc[j * 128 + 64 + lane];
      const float nr = m.a128r * xr - m.a128i * xi + er, ni = m.a128r * xi + m.a128i * xr + ei;
      xr = nr; xi = ni;
    }
    bf16x8 ufs[S5SEG / 32];
#pragma unroll
    for (int sub = 0; sub < S5SEG / 32; ++sub) {
      const int row = s5_row(dir, seg * S5SEG + sub * 32 + fr);
      ufs[sub] = *(const bf16x8*)(Zb + (size_t)row * ZW + 3072 + g * 16 + 8 * fh);
    }
#pragma unroll
    for (int sub = 0; sub < S5SEG / 32; ++sub) {
      const int row = s5_row(dir, seg * S5SEG + sub * 32 + fr);
      const bf16x8 uf = ufs[sub];
      s5m_block<true>(m, uf, xr, xi, xs, lane);
      f32x16 Y;
#pragma unroll
      for (int i = 0; i < 16; ++i) Y[i] = 0.f;
#pragma unroll
      for (int ks = 0; ks < 8; ++ks) {
        const bf16x8 xf = *(const bf16x8*)(xs + fr * 256 + (((ks * 2 + fh) ^ (fr & 15)) << 4));
        Y = __builtin_amdgcn_mfma_f32_32x32x16_bf16(ccf[ks], xf, Y, 0, 0, 0);
      }
      float* yp = Yb + (size_t)row * 512 + g * 16 + 4 * fh;
      *(float4*)yp = make_float4(Y[0], Y[1], Y[2], Y[3]);
      *(float4*)(yp + 8) = make_float4(Y[4], Y[5], Y[6], Y[7]);
    }
  }
}

__device__ __forceinline__ void stage_post(const Params& p, int l, int rr_lim, const bf16_t* Z, const bf16_t* HF, const bf16_t* HB,
                                           const float* YSF, const float* YSB, bf16_t* YB, bf16_t* GG) {
  const int tid = otid();
  const int c0 = tid * 2;
  const float2 gml = *(const float2*)(p.in[I_MLNG] + l * 512 + c0);
  const float2 dsk = *(const float2*)(p.in[I_S5D] + l * 512 + c0);
  const int n = GB * rr_lim;
  for (int i0 = blockIdx.x * 4; i0 < n; i0 += gridDim.x * 4) {
    unsigned a0[4], a1[4], og[4], uu[4];
    float2 f[4], b[4];
    size_t r[4];
#pragma unroll
    for (int u = 0; u < 4; ++u) {
      const int i = i0 + u;
      r[u] = (size_t)(i / rr_lim) * NTOK + (i % rr_lim);
      a0[u] = *(const unsigned*)(HF + r[u] * 512 + c0); a1[u] = *(const unsigned*)(HB + r[u] * 512 + c0);
      og[u] = *(const unsigned*)(Z + r[u] * ZW + 2560 + c0); uu[u] = *(const unsigned*)(Z + r[u] * ZW + 3072 + c0);
      f[u] = *(const float2*)(YSF + r[u] * 512 + c0); b[u] = *(const float2*)(YSB + r[u] * 512 + c0);
    }
#pragma unroll
    for (int u = 0; u < 4; ++u) {
      const float h0 = lo16(a0[u]) + lo16(a1[u]), h1 = hi16(a0[u]) + hi16(a1[u]);
      const float ss = wave_sum(h0 * h0 + h1 * h1);
      const float rs = rsqrtf(ss * (1.0f / 128.0f) + EPSF);
      *(unsigned*)(YB + r[u] * 512 + c0) = pack2(h0 * rs * gml.x * sigmoidf_(lo16(og[u])), h1 * rs * gml.y * sigmoidf_(hi16(og[u])));
      *(unsigned*)(GG + r[u] * 512 + c0) = pack2(geluf_(dsk.x * lo16(uu[u]) + f[u].x + b[u].x), geluf_(dsk.y * hi16(uu[u]) + f[u].y + b[u].y));
    }
  }
}

__device__ __forceinline__ void stage_glu_mfma(const Params& p, int l, int tpb, const bf16_t* GG, const bf16_t* GLUT, bf16_t* YS, char* smem) {
  EPI_DECL
  const int tm = GB * tpb;
  TileIter ti(tm, 4);
  int mt_, nt_; bool valid;
  while (ti.next(mt_, nt_, valid)) {
    if (!valid) continue;
    const int m0 = MT_LR0(mt_, tpb), n0 = nt_ * 128;
    f32x16 acc[2][2];
    gemm_tile(GG + (size_t)m0 * 512, 512, GLUT + (size_t)n0 * 512, 512, 512, smem, acc);
#pragma unroll
    for (int mi = 0; mi < 2; ++mi)
#pragma unroll
      for (int ni = 0; ni < 2; ++ni)
#pragma unroll
        for (int q = 0; q < 4; ++q) {
          const int row = m0 + EPI_ROW(mi), c = n0 + EPI_COL(ni, q);
          const float4 b = *(const float4*)(p.in[I_GLUB] + l * 512 + c);
          const u32x2 g2 = *(const u32x2*)(GG + (size_t)row * 512 + c);
          const float o0 = lo16(g2[0]) * sigmoidf_(acc[mi][ni][4 * q] + b.x), o1 = hi16(g2[0]) * sigmoidf_(acc[mi][ni][4 * q + 1] + b.y);
          const float o2 = lo16(g2[1]) * sigmoidf_(acc[mi][ni][4 * q + 2] + b.z), o3 = hi16(g2[1]) * sigmoidf_(acc[mi][ni][4 * q + 3] + b.w);
          *(u32x2*)(YS + (size_t)row * 512 + c) = (u32x2){pack2(o0, o1), pack2(o2, o3)};
        }
  }
}

__device__ __forceinline__ void stage_merge_mfma(int tpb, const bf16_t* YA, const bf16_t* YB, const bf16_t* YS, const bf16_t* WBR, const bf16_t* Z, bf16_t* MG, char* smem) {
  EPI_DECL
  const int tm = GB * tpb;
  TileIter ti(tm, 8);
  int mt_, nt_; bool valid;
  while (ti.next(mt_, nt_, valid)) {
    if (!valid) continue;
    const int m0 = MT_LR0(mt_, tpb), n0 = nt_ * 128;
    f32x16 macc[2][2];
#pragma unroll
    for (int a = 0; a < 2; ++a)
#pragma unroll
      for (int b = 0; b < 2; ++b)
#pragma unroll
        for (int i = 0; i < 16; ++i) macc[a][b][i] = 0.f;
#pragma unroll 1
    for (int r = 0; r < 3; ++r) {
      const bf16_t* Y = (r == 0) ? YA : (r == 1 ? YB : YS);
      f32x16 acc[2][2];
      gemm_tile(Y + (size_t)m0 * 512, 512, WBR + (size_t)r * 1024 * 512 + (size_t)n0 * 512, 512, 512, smem, acc);
#pragma unroll
      for (int mi = 0; mi < 2; ++mi)
#pragma unroll
        for (int ni = 0; ni < 2; ++ni)
#pragma unroll
          for (int q = 0; q < 4; ++q) {
            const int row = m0 + EPI_ROW(mi), c = n0 + EPI_COL(ni, q);
            const u32x2 e = *(const u32x2*)(Z + (size_t)row * ZW + 3584 + r * 1024 + c);
            macc[mi][ni][4 * q] += lo16(e[0]) * acc[mi][ni][4 * q];
            macc[mi][ni][4 * q + 1] += hi16(e[0]) * acc[mi][ni][4 * q + 1];
            macc[mi][ni][4 * q + 2] += lo16(e[1]) * acc[mi][ni][4 * q + 2];
            macc[mi][ni][4 * q + 3] += hi16(e[1]) * acc[mi][ni][4 * q + 3];
          }
    }
#pragma unroll
    for (int mi = 0; mi < 2; ++mi)
#pragma unroll
      for (int ni = 0; ni < 2; ++ni)
#pragma unroll
        for (int q = 0; q < 4; ++q) {
          const int row = m0 + EPI_ROW(mi), c = n0 + EPI_COL(ni, q);
          *(u32x2*)(MG + (size_t)row * DM + c) = (u32x2){pack2(macc[mi][ni][4 * q], macc[mi][ni][4 * q + 1]), pack2(macc[mi][ni][4 * q + 2], macc[mi][ni][4 * q + 3])};
        }
  }
}

__device__ __forceinline__ void stage_outproj_mfma(const Params& p, int l, int g, int tpb, const bf16_t* MG, const bf16_t* WOUT, char* smem) {
  EPI_DECL
  const int tm = GB * tpb;
  const float* mod = (const float*)(p.ws + WB_MOD) + (size_t)l * 9 * 6144;
  TileIter ti(tm, 8);
  int mt, nt_; bool valid;
  while (ti.next(mt, nt_, valid)) {
    if (!valid) continue;
    const int n0 = nt_ * 128;
    const int m0 = MT_LR0(mt, tpb), bl = mt / tpb, rr0 = (mt % tpb) * 128, b = g * GB + bl;
    f32x16 acc[2][2];
    gemm_tile(MG + (size_t)m0 * DM, DM, WOUT + (size_t)n0 * DM, DM, DM, smem, acc);
    const float* gv = mod + (size_t)((rr0 < NLAT) ? b : 8) * 6144 + 2 * 1024;
#pragma unroll
    for (int mi = 0; mi < 2; ++mi)
#pragma unroll
      for (int ni = 0; ni < 2; ++ni)
#pragma unroll
        for (int q = 0; q < 4; ++q) {
          const int rr = rr0 + EPI_ROW(mi), c = n0 + EPI_COL(ni, q);
          const float4 gg = *(const float4*)(gv + c);
          float4* xp = (float4*)(xrow(p, b, rr) + c);
          float4 x = (l == 0) ? *(const float4*)(xrow_in(p, b, rr) + c) : *xp;
          x.x += gg.x * acc[mi][ni][4 * q]; x.y += gg.y * acc[mi][ni][4 * q + 1]; x.z += gg.z * acc[mi][ni][4 * q + 2]; x.w += gg.w * acc[mi][ni][4 * q + 3];
          *xp = x;
        }
  }
}

#define CH_SW(m_, chunk_) ((((chunk_) ^ ((m_) & 15))) << 4)
template <int KC, bool X2, class BF, class AF, class PF, class EF>
__device__ __forceinline__ void cphase(const int nseg, const int lane, const bf16_t* __restrict__ Wb, BF bofs, AF abase, PF pre, EF epi) {
  const int half = lane >> 5, m = lane & 31, sw = lane & 15, sw2 = lane & 1;
  bf16x8 bs[4][2][4];
  const int S = nseg * KC;
  const int crot = ((blockIdx.x >> 3) * 3 + (otid() >> 6) * 5) & (KC - 1);
#define CH_LD(ST, s_) { const int sg_ = (s_) / KC, c_ = ((s_) + crot) % KC; unsigned o0_ = bofs(sg_) + 4096u * c_ + lane * 16; asm volatile("" : "+v"(o0_)); \
    unsigned o1_ = o0_ + KC * 4096u; asm volatile("" : "+v"(o1_)); \
    _Pragma("unroll") for (int ks_ = 0; ks_ < 4; ++ks_) { bs[ST][0][ks_] = *(const bf16x8*)((const char*)Wb + o0_ + 1024 * ks_); bs[ST][1][ks_] = *(const bf16x8*)((const char*)Wb + o1_ + 1024 * ks_); } }
#define CH_LA(DST, s_) { const int sg_ = (s_) / KC, c_ = ((s_) + crot) % KC; const char* ab_ = abase(sg_); \
    _Pragma("unroll") for (int ks_ = 0; ks_ < 4; ++ks_) DST[ks_] = *(const bf16x8*)(ab_ + m * (KC * 128) + (((8 * c_ + 4 * half + ks_) ^ sw) << 4)); }
#define CH_LA2(DST2, s_) { const int sg_ = (s_) / KC, c_ = ((s_) + crot) % KC; const char* ab_ = abase(sg_); \
    _Pragma("unroll") for (int ks_ = 0; ks_ < 4; ++ks_) DST2[ks_] = *(const bf16x8*)(ab_ + (32 + sw2) * (KC * 128) + (((8 * c_ + 4 * half + ks_) ^ sw2) << 4)); }
  CH_LD(0, 0) CH_LD(1, 1) CH_LD(2, 2)
  bf16x8 ac[4];
  CH_LA(ac, 0)
  f32x16 acc[2], acc2[2];
#pragma unroll
  for (int f = 0; f < 2; ++f)
#pragma unroll
    for (int i = 0; i < 16; ++i) { acc[f][i] = 0.f; acc2[f][i] = 0.f; }
#pragma unroll 1
  for (int s0 = 0; s0 < S; s0 += 4) {
#pragma unroll
    for (int j = 0; j < 4; ++j) {
      const int s = s0 + j;
      if (s + 3 < S) CH_LD((j + 3) & 3, s + 3)
      bf16x8 an[4], ac2[4];
      if (X2) CH_LA2(ac2, s)
      { const int sn = (s + 1 < S) ? s + 1 : s; CH_LA(an, sn) }
      const int sg = s / KC, c = s % KC;
#pragma unroll
      for (int ks = 0; ks < 4; ++ks)
#pragma unroll
        for (int f = 0; f < 2; ++f) acc[f] = __builtin_amdgcn_mfma_f32_32x32x16_bf16(bs[j][f][ks], ac[ks], acc[f], 0, 0, 0);
      if (X2) {
#pragma unroll
        for (int ks = 0; ks < 4; ++ks)
#pragma unroll
          for (int f = 0; f < 2; ++f) acc2[f] = __builtin_amdgcn_mfma_f32_32x32x16_bf16(bs[j][f][ks], ac2[ks], acc2[f], 0, 0, 0);
      }
      if (j == 3 && c == KC - 5) pre(sg);
      if (j == 3 && c == KC - 1) {
        epi(sg, acc, acc2);
#pragma unroll
        for (int f = 0; f < 2; ++f)
#pragma unroll
          for (int i = 0; i < 16; ++i) { acc[f][i] = 0.f; acc2[f][i] = 0.f; }
      }
#pragma unroll
      for (int ks = 0; ks < 4; ++ks) ac[ks] = an[ks];
    }
  }
#undef CH_LD
#undef CH_LA
#undef CH_LA2
}

template <bool X2>
__device__ __forceinline__ void stage_chain1(const Params& p, int l, int g, const bf16_t* Z, const bf16_t* HF, const bf16_t* HB,
                                             const float* YSF, const float* YSB, const bf16_t* YA, bf16_t* MG, bf16_t* H2, const bf16_t* W, char* smem) {
  constexpr int RT = X2 ? 34 : 32;
#define CH_LANE const int tid = otid(), w = tid >> 6, lane = tid & 63, m = lane & 31, half = lane >> 5, m2 = 32 + (lane & 1), rot = blockIdx.x >> 3; const bool v2 = X2 && m < 2; \
    (void)w; (void)m; (void)half; (void)m2; (void)rot; (void)v2;
  const int tpb = (X2 ? NTOK : NLAT) / RT, ntile = GB * tpb;
  const float* mod = (const float*)(p.ws + WB_MOD) + (size_t)l * 9 * 6144;
  const bf16_t* GLUT = W + WT_GLU; const bf16_t* WBR = W + WT_WBR; const bf16_t* WOUT = W + WT_WOUT;
  char* R0 = smem; char* R1 = smem + RT * 1024; char* R2 = smem + 2 * RT * 1024;
  for (int t = blockIdx.x; t < ntile; t += gridDim.x) {
#define CH_TILE int t_ = t; asm volatile("" : "+s"(t_)); const int bl = t_ / tpb, rr0 = (t_ % tpb) * RT, b = g * GB + bl; const size_t lr0 = (size_t)bl * NTOK + rr0; (void)b; (void)lr0; (void)rr0;
    __syncthreads();
    for (int i0 = 0; i0 < RT; i0 += 8) {
      CH_TILE
      CH_LANE
      const int c0 = tid * 2;
      const float2 gml = *(const float2*)(p.in[I_MLNG] + l * 512 + c0);
      const float2 dsk = *(const float2*)(p.in[I_S5D] + l * 512 + c0);
      unsigned a0[8], a1[8], og[8], uu[8];
      float2 f[8], bb[8];
#pragma unroll
      for (int u = 0; u < 8; ++u) {
        const int mm = (i0 + u < RT) ? i0 + u : RT - 1;
        const size_t r = lr0 + mm;
        a0[u] = *(const unsigned*)(HF + r * 512 + c0); a1[u] = *(const unsigned*)(HB + r * 512 + c0);
        og[u] = *(const unsigned*)(Z + r * ZW + 2560 + c0); uu[u] = *(const unsigned*)(Z + r * ZW + 3072 + c0);
        f[u] = *(const float2*)(YSF + r * 512 + c0); bb[u] = *(const float2*)(YSB + r * 512 + c0);
      }
#pragma unroll
      for (int u = 0; u < 8; ++u) {
        const float h0 = lo16(a0[u]) + lo16(a1[u]), h1 = hi16(a0[u]) + hi16(a1[u]);
        const float ss = wave_sum(h0 * h0 + h1 * h1);
        const float rs = rsqrtf(ss * (1.0f / 128.0f) + EPSF);
        const int mm = (i0 + u < RT) ? i0 + u : RT - 1, off = mm * 1024 + CH_SW(mm, c0 >> 3) + (c0 & 7) * 2;
        *(unsigned*)(R1 + off) = pack2(h0 * rs * gml.x * sigmoidf_(lo16(og[u])), h1 * rs * gml.y * sigmoidf_(hi16(og[u])));
        *(unsigned*)(R0 + off) = pack2(geluf_(dsk.x * lo16(uu[u]) + f[u].x + bb[u].x), geluf_(dsk.y * hi16(uu[u]) + f[u].y + bb[u].y));
      }
    }
    __syncthreads();
    {
      CH_LANE
      float4 bv[2][4];
      cphase<8, X2>(2, lane, GLUT,
        [&](int sg) __attribute__((always_inline)) { const int cb = (w * 2 + sg + rot) & 7; return (unsigned)(cb * 2) * (8u * 4096u); },
        [&](int sg) __attribute__((always_inline)) { return (const char*)R0; },
        [&](int sg) __attribute__((always_inline)) {
          const int n0 = ((w * 2 + sg + rot) & 7) * 64;
#pragma unroll
          for (int f = 0; f < 2; ++f)
#pragma unroll
            for (int q = 0; q < 4; ++q) bv[f][q] = *(const float4*)(p.in[I_GLUB] + l * 512 + n0 + f * 32 + 8 * q + 4 * half);
        },
        [&](int sg, f32x16 (&acc)[2], f32x16 (&acc2)[2]) __attribute__((always_inline)) {
          const int n0 = ((w * 2 + sg + rot) & 7) * 64;
          auto body = [&](f32x16 (&a)[2], int mr) __attribute__((always_inline)) {
#pragma unroll
            for (int f = 0; f < 2; ++f)
#pragma unroll
              for (int q = 0; q < 4; ++q) {
                const int c = n0 + f * 32 + 8 * q + 4 * half;
                const int off = mr * 1024 + CH_SW(mr, c >> 3) + 8 * half;
                const u32x2 g2 = *(const u32x2*)(R0 + off);
                const float o0 = lo16(g2[0]) * sigmoidf_(a[f][4 * q] + bv[f][q].x), o1 = hi16(g2[0]) * sigmoidf_(a[f][4 * q + 1] + bv[f][q].y);
                const float o2 = lo16(g2[1]) * sigmoidf_(a[f][4 * q + 2] + bv[f][q].z), o3 = hi16(g2[1]) * sigmoidf_(a[f][4 * q + 3] + bv[f][q].w);
                *(u32x2*)(R2 + off) = (u32x2){pack2(o0, o1), pack2(o2, o3)};
              }
          };
          body(acc, m);
          if (v2) body(acc2, m2);
        });
    }
    __syncthreads();
    for (int i = otid(); i < RT * 64; i += 256) {
      CH_TILE
      const int mm = i >> 6, ch = i & 63;
      *(u32x4*)(R0 + mm * 1024 + CH_SW(mm, ch)) = *(const u32x4*)(YA + (lr0 + mm) * 512 + ch * 8);
    }
    __syncthreads();
    {
      CH_TILE
      CH_LANE
      f32x16 macc[2], macc2[2];
#pragma unroll
      for (int f = 0; f < 2; ++f)
#pragma unroll
        for (int i = 0; i < 16; ++i) { macc[f][i] = 0.f; macc2[f][i] = 0.f; }
      u32x2 e[2][4], e2[2][4];
      const size_t row = lr0 + m, row2 = lr0 + m2;
      cphase<8, X2>(12, lane, WBR,
        [&](int sg) __attribute__((always_inline)) { const int pass = sg / 3, r = sg % 3, cb = (w * 4 + pass + rot) & 15; return (unsigned)r * (1024u * 512u * 2u) + (unsigned)(cb * 2) * (8u * 4096u); },
        [&](int sg) __attribute__((always_inline)) { const int r = sg % 3; return (const char*)(smem + r * (RT * 1024)); },
        [&](int sg) __attribute__((always_inline)) {
          const int pass = sg / 3, r = sg % 3, n0 = ((w * 4 + pass + rot) & 15) * 64;
#pragma unroll
          for (int f = 0; f < 2; ++f)
#pragma unroll
            for (int q = 0; q < 4; ++q) {
              e[f][q] = *(const u32x2*)(Z + row * ZW + 3584 + r * 1024 + n0 + f * 32 + 8 * q + 4 * half);
            }
        },
        [&](int sg, f32x16 (&acc)[2], f32x16 (&acc2)[2]) __attribute__((always_inline)) {
          const int pass = sg / 3, r = sg % 3, n0 = ((w * 4 + pass + rot) & 15) * 64;
          auto body = [&](f32x16 (&a)[2], f32x16 (&ma)[2], u32x2 (&ee)[2][4], size_t rw, bool valid) __attribute__((always_inline)) {
#pragma unroll
            for (int f = 0; f < 2; ++f)
#pragma unroll
              for (int q = 0; q < 4; ++q) {
                ma[f][4 * q] += lo16(ee[f][q][0]) * a[f][4 * q];
                ma[f][4 * q + 1] += hi16(ee[f][q][0]) * a[f][4 * q + 1];
                ma[f][4 * q + 2] += lo16(ee[f][q][1]) * a[f][4 * q + 2];
                ma[f][4 * q + 3] += hi16(ee[f][q][1]) * a[f][4 * q + 3];
              }
            if (r == 2) {
              if (valid) {
#pragma unroll
                for (int f = 0; f < 2; ++f)
#pragma unroll
                  for (int q = 0; q < 4; ++q) {
                    const int c = n0 + f * 32 + 8 * q + 4 * half;
                    *(u32x2*)(MG + rw * DM + c) = (u32x2){pack2(ma[f][4 * q], ma[f][4 * q + 1]), pack2(ma[f][4 * q + 2], ma[f][4 * q + 3])};
                  }
              }
#pragma unroll
              for (int f = 0; f < 2; ++f)
#pragma unroll
                for (int i = 0; i < 16; ++i) ma[f][i] = 0.f;
            }
          };
          body(acc, macc, e, row, true);
          if (X2) {
#pragma unroll
            for (int f = 0; f < 2; ++f)
#pragma unroll
              for (int q = 0; q < 4; ++q) e2[f][q] = *(const u32x2*)(Z + row2 * ZW + 3584 + r * 1024 + n0 + f * 32 + 8 * q + 4 * half);
            body(acc2, macc2, e2, row2, v2);
          }
        });
    }
    __syncthreads();
    for (int i = otid(); i < RT * 128; i += 256) {
      CH_TILE
      const int mm = i >> 7, ch = i & 127;
      *(u32x4*)(smem + mm * 2048 + CH_SW(mm, ch)) = *(const u32x4*)(MG + (lr0 + mm) * DM + ch * 8);
    }
    __syncthreads();
    {
      CH_TILE
      CH_LANE
      const int rr = rr0 + m, rr2 = rr0 + m2;
      const float* gv = mod + (size_t)((rr < NLAT) ? b : 8) * 6144 + 2 * 1024;
      const float* gv2 = mod + (size_t)((rr2 < NLAT) ? b : 8) * 6144 + 2 * 1024;
      float4 xx[2][4];
      cphase<16, X2>(4, lane, WOUT,
        [&](int sg) __attribute__((always_inline)) { const int cb = (w * 4 + sg + rot) & 15; return (unsigned)(cb * 2) * (16u * 4096u); },
        [&](int sg) __attribute__((always_inline)) { return (const char*)smem; },
        [&](int sg) __attribute__((always_inline)) {
          const int n0 = ((w * 4 + sg + rot) & 15) * 64;
#pragma unroll
          for (int f = 0; f < 2; ++f)
#pragma unroll
            for (int q = 0; q < 4; ++q) {
              const int c = n0 + f * 32 + 8 * q + 4 * half;
              xx[f][q] = (l == 0) ? *(const float4*)(xrow_in(p, b, rr) + c) : *(const float4*)(xrow(p, b, rr) + c);
            }
        },
        [&](int sg, f32x16 (&acc)[2], f32x16 (&acc2)[2]) __attribute__((always_inline)) {
          const int n0 = ((w * 4 + sg + rot) & 15) * 64;
#pragma unroll
          for (int f = 0; f < 2; ++f)
#pragma unroll
            for (int q = 0; q < 4; ++q) {
              const int c = n0 + f * 32 + 8 * q + 4 * half;
              float4 x = xx[f][q];
              const float4 gg = *(const float4*)(gv + c);
              x.x += gg.x * acc[f][4 * q]; x.y += gg.y * acc[f][4 * q + 1]; x.z += gg.z * acc[f][4 * q + 2]; x.w += gg.w * acc[f][4 * q + 3];
              *(float4*)(xrow(p, b, rr) + c) = x;
            }
          if (v2) {
#pragma unroll
            for (int f = 0; f < 2; ++f)
#pragma unroll
              for (int q = 0; q < 4; ++q) {
                const int c = n0 + f * 32 + 8 * q + 4 * half;
                const float4 gg = *(const float4*)(gv2 + c);
                float4 x = (l == 0) ? *(const float4*)(xrow_in(p, b, rr2) + c) : *(const float4*)(xrow(p, b, rr2) + c);
                x.x += gg.x * acc2[f][4 * q]; x.y += gg.y * acc2[f][4 * q + 1]; x.z += gg.z * acc2[f][4 * q + 2]; x.w += gg.w * acc2[f][4 * q + 3];
                *(float4*)(xrow(p, b, rr2) + c) = x;
              }
          }
        });
    }
    __syncthreads();
    {
      CH_TILE
      CH_LANE
      const float* ng = p.in[I_N2G] + l * DM;
#pragma unroll 1
      for (int i0 = w * 2; i0 < RT; i0 += 8) {
        float4 v[2][4];
#pragma unroll
        for (int u = 0; u < 2; ++u) {
          const float4* X = (const float4*)xrow(p, b, rr0 + i0 + u);
#pragma unroll
          for (int q = 0; q < 4; ++q) v[u][q] = X[q * 64 + lane];
        }
#pragma unroll
        for (int u = 0; u < 2; ++u) {
          float s = 0.f;
#pragma unroll
          for (int q = 0; q < 4; ++q) s += v[u][q].x * v[u][q].x + v[u][q].y * v[u][q].y + v[u][q].z * v[u][q].z + v[u][q].w * v[u][q].w;
          s = wave_sum(s);
          const float rs = rsqrtf(s * (1.0f / DM) + EPSF);
          const float* mm_ = mod + (size_t)((rr0 + i0 + u < NLAT) ? b : 8) * 6144;
          u32x2* hp = (u32x2*)(H2 + (lr0 + i0 + u) * DM);
#pragma unroll
          for (int q = 0; q < 4; ++q) {
            const float4 gg = ((const float4*)ng)[q * 64 + lane];
            const float4 sc = ((const float4*)(mm_ + 4096))[q * 64 + lane];
            const float4 sh = ((const float4*)(mm_ + 3072))[q * 64 + lane];
            const float4 x = v[u][q];
            hp[q * 64 + lane] = (u32x2){pack2(x.x * rs * gg.x * (1.f + sc.x) + sh.x, x.y * rs * gg.y * (1.f + sc.y) + sh.y),
                                        pack2(x.z * rs * gg.z * (1.f + sc.z) + sh.z, x.w * rs * gg.w * (1.f + sc.w) + sh.w)};
          }
        }
      }
    }
#undef CH_TILE
#undef CH_LANE
  }
}

__device__ __forceinline__ void stage_peerq_mfma(int tpb, const bf16_t* H2, const bf16_t* WQ, bf16_t* PQ, char* smem) {
  EPI_DECL
  const int tm = GB * tpb;
  TileIter ti(tm, 16);
  int mt_, nt_; bool valid;
  while (ti.next(mt_, nt_, valid)) {
    if (!valid) continue;
    const int m0 = MT_LR0(mt_, tpb), n0 = nt_ * 128;
    f32x16 acc[2][2];
    gemm_tile(H2 + (size_t)m0 * DM, DM, WQ + (size_t)n0 * DM, DM, DM, smem, acc);
#pragma unroll
    for (int mi = 0; mi < 2; ++mi)
#pragma unroll
      for (int ni = 0; ni < 2; ++ni)
#pragma unroll
        for (int q = 0; q < 4; ++q) {
          const int row = m0 + EPI_ROW(mi), c = n0 + EPI_COL(ni, q);
          *(u32x2*)(PQ + (size_t)row * 2048 + c) = (u32x2){pack2(acc[mi][ni][4 * q], acc[mi][ni][4 * q + 1]), pack2(acc[mi][ni][4 * q + 2], acc[mi][ni][4 * q + 3])};
        }
  }
}

__device__ __forceinline__ unsigned f2sortable(float x) { const unsigned u = __float_as_uint(x); return (u & 0x80000000u) ? ~u : (u | 0x80000000u); }
__device__ __forceinline__ float sortable2f(unsigned k) { return __uint_as_float((k & 0x80000000u) ? (k & 0x7fffffffu) : ~k); }
#define TOPK_INSERT(v, key) { unsigned t_ = (key); _Pragma("unroll") for (int s_ = 0; s_ < 16; ++s_) { const unsigned hi_ = max(v[s_], t_); t_ = min(v[s_], t_); v[s_] = hi_; } }
__device__ __forceinline__ void stage_scores_topk(int tpb, const bf16_t* PQ, const bf16_t* SUBK, int* EI, float* EG, char* smem) {
  EPI_DECL
  const int tid = tid_;
  const int item = tid & 127, kpart = tid >> 7;
  float* S = (float*)smem;
  unsigned* xk = (unsigned*)(smem + 128 * 129 * 4);
  const int tm = GB * tpb * 8;
  for (int mt = blockIdx.x; mt < tm; mt += gridDim.x) {
    const size_t m0 = (size_t)MT_LR0(mt >> 3, tpb) * 8 + (size_t)(mt & 7) * 128;
    unsigned vh[2][16];
#pragma unroll
    for (int half = 0; half < 2; ++half) {
      f32x16 acc[2][2];
      gemm_tile(PQ + m0 * 256 + half * 128, 256, SUBK + (size_t)half * 16384, 128, 128, smem, acc);
#pragma unroll
      for (int mi = 0; mi < 2; ++mi)
#pragma unroll
        for (int ni = 0; ni < 2; ++ni)
#pragma unroll
          for (int i = 0; i < 16; ++i)
            S[EPI_ROW(mi) * 129 + wn * 64 + ni * 32 + 8 * (i >> 2) + 4 * fh + (i & 3)] = acc[mi][ni][i];
      __syncthreads();
      unsigned v[16];
#pragma unroll
      for (int s = 0; s < 16; ++s) v[s] = 0u;
      const float* sr = S + item * 129 + kpart * 64;
#pragma unroll 8
      for (int k = 0; k < 64; ++k) {
        const unsigned key = (f2sortable(sr[k]) & ~127u) | (unsigned)(127 - (kpart * 64 + k));
        TOPK_INSERT(v, key)
      }
      if (kpart == 1) {
#pragma unroll
        for (int s = 0; s < 16; ++s) xk[item * 17 + s] = v[s];
      }
      __syncthreads();
      if (kpart == 0) {
#pragma unroll
        for (int s = 0; s < 16; ++s) { const unsigned key = xk[item * 17 + s]; TOPK_INSERT(v, key) }
      }
#pragma unroll
      for (int s = 0; s < 16; ++s) vh[half][s] = v[s];
      __syncthreads();
    }
    if (kpart == 0) {
      float v1[16], v2[16];
#pragma unroll
      for (int s = 0; s < 16; ++s) { v1[s] = sortable2f((vh[0][s] & ~127u) | 64u); v2[s] = sortable2f((vh[1][s] & ~127u) | 64u); }
      unsigned c[16];
#pragma unroll
      for (int s = 0; s < 16; ++s) c[s] = 0u;
      {
        int o = 0;
#pragma unroll
        for (int i = 0; i < 16; ++i)
#pragma unroll
          for (int j = 0; j < 16 / (i + 1); ++j) {
            const unsigned key = (f2sortable(v1[i] + v2[j]) & ~63u) | (unsigned)(63 - o);
            TOPK_INSERT(c, key)
            ++o;
          }
      }
      const float vmax = sortable2f((c[0] & ~63u) | 32u);
      float sum = 0.f;
#pragma unroll
      for (int s = 0; s < 16; ++s) sum += expf(sortable2f((c[s] & ~63u) | 32u) - vmax);
      const float isum = 1.0f / sum;
      const unsigned thr = c[15];
      int* ei = EI + (m0 + item) * 16;
      float* eg = EG + (m0 + item) * 16;
      int cntw = 0;
      {
        int o = 0;
#pragma unroll
        for (int i = 0; i < 16; ++i)
#pragma unroll
          for (int j = 0; j < 16 / (i + 1); ++j) {
            const unsigned key = (f2sortable(v1[i] + v2[j]) & ~63u) | (unsigned)(63 - o);
            if (key >= thr) {
              ei[cntw] = (int)((127u - (vh[0][i] & 127u)) * 128u + (127u - (vh[1][j] & 127u)));
              eg[cntw] = expf(sortable2f((key & ~63u) | 32u) - vmax) * isum;
              ++cntw;
            }
            ++o;
          }
      }
    }
  }
  __syncthreads();
}

#define DPPF(x, ctrl) __uint_as_float((unsigned)__builtin_amdgcn_update_dpp(0, (int)__float_as_uint(x), (ctrl), 0xf, 0xf, true))
#define XP_HALVE(n, bit, ctrl) { _Pragma("unroll") for (int j_ = 0; j_ < (n); ++j_) { const float keep_ = (bit) ? a[j_ + (n)] : a[j_]; const float send_ = (bit) ? a[j_] : a[j_ + (n)]; a[j_] = keep_ + DPPF(send_, ctrl); } }
#define XP_ROW(TAB, E, PR) { const int e0_ = __builtin_amdgcn_readlane((E), 2 * (PR)), e1_ = __builtin_amdgcn_readlane((E), 2 * (PR) + 1); \
    const char* rp_ = (TAB) + (size_t)(hw ? e1_ : e0_) * 768 + hl * 24; \
    const u32x4_u x_ = *(const u32x4_u*)rp_; const u32x2 y_ = *(const u32x2*)(rp_ + 16); \
    ra[PR] = (v6u){x_[0], x_[1], x_[2], x_[3], y_[0], y_[1]}; }
#define XP_META(PAR, T, E, G, HP) { const size_t mo_ = ((size_t)(PAR) * RPG + (T)) * 128 + w * 32 + hl; \
    E = ((const int*)(p.ws + WB_EI))[mo_]; G = ((const float*)(p.ws + WB_EG))[mo_]; \
    const u32x4* hr_ = (const u32x4*)((const bf16_t*)(p.ws + WB_H2) + ((size_t)(PAR) * RPG + (T)) * DM + hl * 32); \
    _Pragma("unroll") for (int c_ = 0; c_ < 4; ++c_) HP[c_] = hr_[c_]; }
__device__ __forceinline__ void unpack8(const u32x4 v, float* f) {
#pragma unroll
  for (int k = 0; k < 4; ++k) { f[2 * k] = lo16(v[k]); f[2 * k + 1] = hi16(v[k]); }
}
__device__ __forceinline__ int xp_pool_n(int q) { return GB * ((q < NG) ? NTOK : NLAT); }
__device__ __forceinline__ int xp_claim(int* pool, int& qa, int hi) {
  while (qa <= hi) {
    const int n = xp_pool_n(qa);
    if (__hip_atomic_load(pool + qa, __ATOMIC_RELAXED, __HIP_MEMORY_SCOPE_AGENT) < n) {
      const int i = atomicAdd(pool + qa, 1);
      if (i < n) return qa * 65536 + i;
    }
    ++qa;
  }
  return -1;
}
__device__ __forceinline__ void xp_decode(int tok, int& l, int& par, int& b, int& rr, int& t) {
  const int q = tok >> 16, i = tok & 65535;
  l = q / NG;
  const int g = q % NG, rr_lim = (l == 0) ? NTOK : NLAT, bl = i / rr_lim;
  rr = i % rr_lim; b = g * GB + bl; t = bl * NTOK + rr; par = q % 3;
}
__device__ __forceinline__ void expert_run(const Params& p, int lo, int hi, unsigned* ctr, unsigned epoch, const bool steal, int& pend, float* smem) {
  if (lo < 0) lo = 0;
  if (hi < lo) return;
  const int tid = otid(), w = tid >> 6, lane = tid & 63, hl = lane & 31, hw = lane >> 5;
  int* s_tok = (int*)(smem + SMEM_FLOATS - 8);
  int* pool = (int*)(p.ws + WB_POOL);
  float* part = smem;
  int qa = lo, ci = 0;
  bool cpend = false;
  unsigned cb = 0;
  int cur = pend; pend = -1;
  if (cur < 0) {
    __syncthreads();
    if (tid == 0) s_tok[2] = xp_claim(pool, qa, hi);
    __syncthreads();
    cur = __builtin_amdgcn_readfirstlane(s_tok[2]);
  }
  if (cur < 0) return;
  if (tid == 0 && qa <= hi) { ci = atomicAdd(pool + qa, 1); cpend = true; }
  int l, par, b, rr, t;
  xp_decode(cur, l, par, b, rr, t);
  int e_c; float g_c; u32x4 hp[4];
  XP_META(par, t, e_c, g_c, hp)
  v6u ra[16];
  {
    const char* U = p.ws + WB_U16 + (size_t)l * 16384 * 768;
#pragma unroll
    for (int pr = 0; pr < 16; ++pr) XP_ROW(U, e_c, pr)
  }
  for (;;) {
    const float* mod = (const float*)(p.ws + WB_MOD) + (size_t)l * 9 * 6144;
    const float4 g2 = ((const float4*)(mod + (size_t)((rr < NLAT) ? b : 8) * 6144 + 5 * 1024))[tid];
    float4* xp = (float4*)xrow(p, b, rr) + tid;
    float4 xv = *xp;
    if (tid == 0) {
      int r = -1;
      if (cpend) {
        if (ci < xp_pool_n(qa)) r = qa * 65536 + ci;
        else { ++qa; r = xp_claim(pool, qa, hi); }
      }
      const int st = (steal && cb + 31u >= epoch) ? 1 : 0;
      s_tok[0] = r; s_tok[1] = st;
      cpend = false;
      if (!st && r >= 0 && qa <= hi) { ci = atomicAdd(pool + qa, 1); cpend = true; }
    }
    __syncthreads();
    const int nxt = __builtin_amdgcn_readfirstlane(s_tok[0]);
    const bool pf = nxt >= 0 && __builtin_amdgcn_readfirstlane(s_tok[1]) == 0;
    int ln = l, parn = 0, bn = 0, rrn = 0, tn = 0, e_n = 0;
    float g_n = 0.f;
    u32x4 hn[4];
#pragma unroll
    for (int c = 0; c < 4; ++c) hn[c] = (u32x4){0u, 0u, 0u, 0u};
    if (pf) {
      xp_decode(nxt, ln, parn, bn, rrn, tn);
      XP_META(parn, tn, e_n, g_n, hn)
    }
    const char* V = p.ws + WB_V16 + (size_t)l * 16384 * 768;
    f32x2 hq2[16];
#pragma unroll
    for (int c = 0; c < 4; ++c)
#pragma unroll
      for (int k = 0; k < 4; ++k) hq2[4 * c + k] = (f32x2){lo16(hp[c][k]), hi16(hp[c][k])};
    float a[16];
#pragma unroll
    for (int pr = 0; pr < 16; ++pr) {
      const v32f f = __builtin_amdgcn_cvt_scalef32_pk32_f32_fp6(ra[pr], 1.0f);
      f32x2 sa = {0.f, 0.f}, sb = {0.f, 0.f};
#pragma unroll
      for (int k = 0; k < 16; k += 2) {
        sa = __builtin_elementwise_fma(hq2[k], (f32x2){f[2 * k], f[2 * k + 1]}, sa);
        sb = __builtin_elementwise_fma(hq2[k + 1], (f32x2){f[2 * k + 2], f[2 * k + 3]}, sb);
      }
      a[pr] = (sa[0] + sb[0]) + (sa[1] + sb[1]);
      XP_ROW(V, e_c, pr)
    }
    {
      const bool b3 = (lane & 8) != 0, b2 = (lane & 4) != 0, b1 = (lane & 2) != 0, b0 = (lane & 1) != 0;
      XP_HALVE(8, b3, 0x128)
      XP_HALVE(4, b2, 0x141)
      XP_HALVE(2, b1, 0x4E)
      XP_HALVE(1, b0, 0xB1)
    }
    float dsum = a[0];
    dsum += __shfl_xor(dsum, 16);
    const float my_dot = __shfl(dsum, 32 * (hl & 1) + (hl >> 1));
    const float my_c = g_c * geluf_(my_dot * (1.0f / 64.0f));
    f32x2 acc2[16];
#pragma unroll
    for (int k = 0; k < 16; ++k) acc2[k] = (f32x2){0.f, 0.f};
    {
      const char* Un = p.ws + WB_U16 + (size_t)ln * 16384 * 768;
#pragma unroll
      for (int pr = 0; pr < 16; ++pr) {
        const float c0 = __uint_as_float(__builtin_amdgcn_readlane(__float_as_uint(my_c), 2 * pr)), c1 = __uint_as_float(__builtin_amdgcn_readlane(__float_as_uint(my_c), 2 * pr + 1));
        const float c = hw ? c1 : c0;
        const f32x2 cc = {c, c};
        const v32f f = __builtin_amdgcn_cvt_scalef32_pk32_f32_fp6(ra[pr], 1.0f);
#pragma unroll
        for (int k = 0; k < 16; ++k) acc2[k] = __builtin_elementwise_fma(cc, (f32x2){f[2 * k], f[2 * k + 1]}, acc2[k]);
        XP_ROW(Un, e_n, pr)
      }
    }
    if (steal && tid == 0) cb = __hip_atomic_load(ctr, __ATOMIC_RELAXED, __HIP_MEMORY_SCOPE_AGENT);
    __syncthreads();
    {
      float4* pw = (float4*)(part + (w * 2 + hw) * 1024 + hl * 32);
#pragma unroll
      for (int c = 0; c < 8; ++c) pw[c] = make_float4(acc2[2 * c][0], acc2[2 * c][1], acc2[2 * c + 1][0], acc2[2 * c + 1][1]);
    }
    __syncthreads();
    float4 s = ((const float4*)part)[tid];
#pragma unroll
    for (int c = 1; c < 8; ++c) { const float4 x = ((const float4*)(part + c * 1024))[tid]; s.x += x.x; s.y += x.y; s.z += x.z; s.w += x.w; }
    xv.x += 0.5f * g2.x * s.x; xv.y += 0.5f * g2.y * s.y; xv.z += 0.5f * g2.z * s.z; xv.w += 0.5f * g2.w * s.w;
    *xp = xv;
    if (!pf) { pend = nxt; break; }
    l = ln; par = parn; b = bn; rr = rrn; t = tn; e_c = e_n; g_c = g_n;
#pragma unroll
    for (int c = 0; c < 4; ++c) hp[c] = hn[c];
  }
}
__device__ __forceinline__ void expert_drain(const Params& p, int lo, int hi, int& pend, float* smem) {
  expert_run(p, lo, hi, nullptr, 0u, false, pend, smem);
}

__device__ __forceinline__ void stage_final(const Params& p, float* smem) {
  const int tid = otid(), w = tid >> 6, lane = tid & 63;
  const int n = NB * NLAT;
  for (int r0 = (blockIdx.x * 4 + w) * 2; r0 < n; r0 += gridDim.x * 8) {
    float4 v[2][4];
#pragma unroll
    for (int u = 0; u < 2; ++u)
#pragma unroll
      for (int q = 0; q < 4; ++q) v[u][q] = ((const float4*)(p.out + (size_t)(r0 + u) * DM))[q * 64 + lane];
#pragma unroll
    for (int u = 0; u < 2; ++u) {
      float s = 0.f;
#pragma unroll
      for (int q = 0; q < 4; ++q) s += v[u][q].x * v[u][q].x + v[u][q].y * v[u][q].y + v[u][q].z * v[u][q].z + v[u][q].w * v[u][q].w;
      s = wave_sum(s);
      const float rs = rsqrtf(s * (1.0f / DM) + EPSF);
#pragma unroll
      for (int q = 0; q < 4; ++q) {
        const float4 g = ((const float4*)p.in[I_FG])[q * 64 + lane];
        const float4 x = v[u][q];
        ((float4*)(p.out + (size_t)(r0 + u) * DM))[q * 64 + lane] = make_float4(x.x * rs * g.x, x.y * rs * g.y, x.z * rs * g.z, x.w * rs * g.w);
      }
    }
  }
}

__device__ __forceinline__ void gbar(const Params& p, unsigned* ctr, unsigned& epoch, int lo, int hi, int& pend, float* smem) {
  asm volatile("s_waitcnt vmcnt(0)" ::: "memory");
  __syncthreads();
  epoch += gridDim.x;
  int* s_flag = (int*)(smem + SMEM_FLOATS - 12);
  if (threadIdx.x == 0) {
    __builtin_amdgcn_fence(__ATOMIC_RELEASE, "agent");
    asm volatile("s_waitcnt vmcnt(0)" ::: "memory");
    __hip_atomic_fetch_add(ctr, 1u, __ATOMIC_RELAXED, __HIP_MEMORY_SCOPE_AGENT);
  }
  if (hi >= lo && hi >= 0) {
    if (threadIdx.x == 0) {
      const unsigned c = __hip_atomic_load(ctr, __ATOMIC_RELAXED, __HIP_MEMORY_SCOPE_AGENT);
      *s_flag = (c + 31u < epoch) ? 1 : 0;
    }
    __syncthreads();
    if (*s_flag) expert_run(p, lo, hi, ctr, epoch, true, pend, smem);
  }
  if (threadIdx.x == 0) {
    while (__hip_atomic_load(ctr, __ATOMIC_RELAXED, __HIP_MEMORY_SCOPE_AGENT) < epoch) __builtin_amdgcn_s_sleep(2);
    __builtin_amdgcn_fence(__ATOMIC_ACQUIRE, "agent");
    asm volatile("s_waitcnt vmcnt(0)" ::: "memory");
  }
  __syncthreads();
}

__global__ void __launch_bounds__(256) mega(Params p) {
  cg::grid_group grid = cg::this_grid();
  __shared__ __attribute__((aligned(16))) float smem[SMEM_FLOATS];
  char* smc = (char*)smem;
  char* ws = p.ws;
  bf16_t* H = (bf16_t*)(ws + WB_H); bf16_t* Z = (bf16_t*)(ws + WB_Z); float* MGT = (float*)(ws + WB_MGT); bf16_t* XC = (bf16_t*)(ws + WB_XC);
  bf16_t* QM = (bf16_t*)(ws + WB_QM); bf16_t* KM = (bf16_t*)(ws + WB_KM); bf16_t* KMT = (bf16_t*)(ws + WB_KMT); bf16_t* MVT = (bf16_t*)(ws + WB_MVT);
  bf16_t* HF = (bf16_t*)(ws + WB_HF); bf16_t* HB = (bf16_t*)(ws + WB_HB);
  bf16_t* VT = (bf16_t*)(ws + WB_VT); float* YSF = (float*)(ws + WB_YSF); float* YSB = (float*)(ws + WB_YSB);
  bf16_t* YA = (bf16_t*)(ws + WB_YA); bf16_t* YB = (bf16_t*)(ws + WB_YB); bf16_t* YS = (bf16_t*)(ws + WB_YS); bf16_t* GG = (bf16_t*)(ws + WB_GG);
  bf16_t* MG = (bf16_t*)(ws + WB_MG); bf16_t* PQ = (bf16_t*)(ws + WB_PQ); float* SC = (float*)(ws + WB_SC);
  float* XE = (float*)(ws + WB_XE); float* GA = (float*)(ws + WB_GA);
  const bf16_t* WT = (const bf16_t*)(ws + WB_WT);

  unsigned* bar = (unsigned*)(ws + WB_BAR);
  unsigned epoch = 0;
  int pend = -1;
  stage_init(p, smem);
  grid.sync();

  for (int l = 0; l < 2; ++l) {
    const bool need_ctx = (l == 0);
    const int rr_lim = need_ctx ? NTOK : NLAT;
    const int tpb = need_ctx ? 34 : 32;
    const bf16_t* W = WT + (size_t)l * WT_LAYER;
    const float lam_init = __uint_as_float(__builtin_amdgcn_readfirstlane(__float_as_uint(0.8f - 0.6f * expf(-0.3f * (float)l))));
    float lam;
    {
      float s1 = 0.f, s2 = 0.f;
      for (int i = 0; i < 64; ++i) {
        s1 += p.in[I_LQ1][l * 64 + i] * p.in[I_LK1][l * 64 + i];
        s2 += p.in[I_LQ2][l * 64 + i] * p.in[I_LK2][l * 64 + i];
      }
      lam = expf(s1) - expf(s2) + lam_init;
      lam = __uint_as_float(__builtin_amdgcn_readfirstlane(__float_as_uint(lam)));
    }
    for (int g = 0; g < NG; ++g) {
      const int q = l * NG + g;
      int plo = q - 3, phi = q - 1;
      int* EI = (int*)(ws + WB_EI) + (size_t)(q % 3) * RPG * 128; float* EG = (float*)(ws + WB_EG) + (size_t)(q % 3) * RPG * 128;
      bf16_t* H2 = (bf16_t*)(ws + WB_H2) + (size_t)(q % 3) * RPG * DM;
      if (q == 0) {
        stage_normmod(p, l, g, 0, NTOK, H, smem);
        gbar(p, bar, epoch, plo, phi, pend, smem);
      }
      stage_inproj(p, H, W + WT_WIN, Z, MGT, VT, MVT, smc);
      gbar(p, bar, epoch, plo, phi, pend, smem);
      stage_s5_pass1(p, l, Z, XE);
      stage_mlgates(p, l, MGT, GA);
      stage_mlqk(p, l, Z, XC, W + WT_WQK, QM, KM, KMT, smc);
      gbar(p, bar, epoch, plo, phi, pend, smem);
      {
        const int n_attn = 4 * 64 + (need_ctx ? 4 * 4 : 0);
        const int n_s5 = 32 * 2 * 9;
        const int n_items = GB * (16 + n_attn + n_s5);
        int* cnt = (int*)(ws + WB_CNT) + (l * NG + g);
        int* s_item = (int*)(smem + SMEM_FLOATS - 4);
        for (;;) {
          __syncthreads();
          if (otid() == 0) *s_item = atomicAdd(cnt, 1);
          __syncthreads();
          const int it = *s_item;
          if (it >= n_items) break;
          int bl, k;
          if (it < GB * 16) { bl = it / 16; k = it % 16; }
          else if (it < GB * (16 + n_attn)) { bl = (it - GB * 16) / n_attn; k = 16 + (it - GB * 16) % n_attn; }
          else { bl = (it - GB * (16 + n_attn)) / n_s5; k = 16 + n_attn + (it - GB * (16 + n_attn)) % n_s5; }
          const bf16_t* Zb = Z + (size_t)bl * NTOK * ZW;
          const size_t ro = (size_t)bl * NTOK;
          if (k < 16) {
            const int hh = k & 3, dd = (k >> 2) & 1, eh = k >> 3;
            mlstm_chain_item(p, l, QM + ro * 512, KM + ro * 512, KMT + (size_t)bl * 4 * 128 * NTOK, MVT + (size_t)bl * 4 * 128 * NTOK, GA + (size_t)(((bl * 4 + hh) * 2 + dd) * 68) * 272,
                             (dd ? HB : HF) + ro * 512, hh, dd, eh, smc);
          } else if (k < 16 + n_attn) {
            const int a = k - 16;
            const bf16_t* VTb = VT + (size_t)bl * 4 * 128 * NTOK;
            if (a < 256) attn_mfma_item(p, l, Zb, VTb, YA + ro * 512, a & 3, (a >> 2) * 64, 0, NTOK, lam, lam_init, smc);
            else attn_mfma_item(p, l, Zb, VTb, YA + ro * 512, (a - 256) & 3, NLAT + ((a - 256) >> 2) * 64, NLAT, NCTX, lam, lam_init, smc);
          } else {
            const int a = k - 16 - n_attn;
            const int sq = a % 9, dir = (a / 9) & 1, gg = a / 18;
            s5_item(p, l, Zb, XE + (((size_t)bl * 32 + gg) * 2 + dir) * (S5NSEG - 1) * 128, (dir ? YSB : YSF) + ro * 512, gg, dir, sq, smc);
          }
        }
      }
      expert_drain(p, plo, plo, pend, smem);
      plo = q - 2;
      gbar(p, bar, epoch, plo, phi, pend, smem);
      if (need_ctx) stage_chain1<true>(p, l, g, Z, HF, HB, YSF, YSB, YA, MG, H2, W, smc);
      else stage_chain1<false>(p, l, g, Z, HF, HB, YSF, YSB, YA, MG, H2, W, smc);
      gbar(p, bar, epoch, plo, phi, pend, smem);
      stage_peerq_mfma(tpb, H2, W + WT_WQ, PQ, smc);
      gbar(p, bar, epoch, plo, phi, pend, smem);
      stage_scores_topk(tpb, PQ, W + WT_SUBK, EI, EG, smc);
      if (q + 1 < 2 * NG) stage_normmod(p, (q + 1) / NG, (q + 1) % NG, 0, NTOK, H, smem);
      gbar(p, bar, epoch, plo, phi, pend, smem);
    }
  }
  expert_drain(p, 2 * NG - 3, 2 * NG - 1, pend, smem);
  gbar(p, bar, epoch, 0, -1, pend, smem);
  stage_final(p, smem);
}

extern "C" void kernel_launch(void* const* d_in, const int* in_sizes, int n_in, void* d_out,
                              int out_size, void* d_ws, size_t ws_size, hipStream_t stream) {
  static int grid_blocks = 0;
  if (!grid_blocks) {
    int dev = 0, cus = 0, per_cu = 0;
    (void)hipGetDevice(&dev);
    (void)hipDeviceGetAttribute(&cus, hipDeviceAttributeMultiprocessorCount, dev);
    (void)hipOccupancyMaxActiveBlocksPerMultiprocessor(&per_cu, mega, 256, 0);
    if (per_cu > 1) per_cu = 1;
    grid_blocks = cus * per_cu;
  }
  if (ws_size < WB_END) {
    fprintf(stderr, "workspace too small: %zu < %zu\n", ws_size, (size_t)WB_END);
    return;
  }
  Params p{};
  for (int i = 0; i < N_IN; ++i) p.in[i] = (const float*)d_in[i];
  p.out = (float*)d_out;
  p.ws = (char*)d_ws;
  (void)hipMemsetAsync((char*)d_ws + WB_BAR, 0, 256, stream);
  void* args[] = {&p};
  hipError_t e = hipLaunchCooperativeKernel((void*)mega, dim3(grid_blocks), dim3(256), args, 0, stream);
  if (e != hipSuccess) fprintf(stderr, "cooperative launch failed: %s (grid %d)\n", hipGetErrorString(e), grid_blocks);
}
```

```cpp
#include <hip/hip_runtime.h>
#include <hip/hip_cooperative_groups.h>
#include <cstdio>
#include <cstdint>
namespace cg = cooperative_groups;

#define NLAT 4096
#define NCTX 256
#define NTOK 4352
#define DM 1024
#define INW 6672
#define NB 8
#define GB 2
#define NG (NB / GB)
#define RPG (GB * NTOK)
#define ZW 6656
#define EPSF 1e-6f

enum { I_X = 0, I_C, I_CTX, I_CCTX, I_WMOD, I_BMOD, I_N1G, I_N2G, I_WIN, I_LQ1, I_LK1, I_LQ2, I_LK2, I_SUBG,
       I_CONVW, I_CONVB, I_MLWQ, I_MLWK, I_GATEB, I_MLNG, I_S5LRE, I_S5LIM, I_S5DT, I_S5BRE, I_S5BIM,
       I_S5CRE, I_S5CIM, I_S5D, I_GLUW, I_GLUB, I_WBR, I_WOUT, I_PWQ, I_PSUBK, I_PU, I_PV, I_FG, N_IN };

struct Params {
  const float* in[N_IN];
  float* out;
  char* ws;
};

typedef unsigned short bf16_t;
typedef short bf16x8 __attribute__((ext_vector_type(8)));
typedef float f32x16 __attribute__((ext_vector_type(16)));
typedef unsigned u32x4 __attribute__((ext_vector_type(4)));
typedef unsigned u32x2 __attribute__((ext_vector_type(2)));
typedef unsigned u32x4_u __attribute__((ext_vector_type(4), aligned(8)));
typedef float v16f __attribute__((ext_vector_type(16)));
typedef float v32f __attribute__((ext_vector_type(32)));
typedef unsigned v6u __attribute__((ext_vector_type(6)));

#define AL(x) (((x) + 255) & ~(size_t)255)
#define WB_XCX   ((size_t)0)
#define WB_MOD   AL(WB_XCX + (size_t)NB * NCTX * DM * 4)
#define WB_ROPE  AL(WB_MOD + (size_t)2 * 9 * 6144 * 4)
#define WB_WT    AL(WB_ROPE + (size_t)NLAT * 32 * 2 * 4)
#define WT_WIN   ((size_t)0)
#define WT_WQK   (WT_WIN + (size_t)6784 * 1024)
#define WT_GLU   (WT_WQK + (size_t)4 * 256 * 128)
#define WT_WBR   (WT_GLU + (size_t)512 * 512)
#define WT_WOUT  (WT_WBR + (size_t)3 * 1024 * 512)
#define WT_WQ    (WT_WOUT + (size_t)1024 * 1024)
#define WT_SUBK  (WT_WQ + (size_t)2048 * 1024)
#define WT_LAYER (WT_SUBK + (size_t)2 * 128 * 128)
#define WB_H     AL(WB_WT + WT_LAYER * 2 * 2)
#define WB_Z     AL(WB_H + (size_t)RPG * DM * 2)
#define WB_MGT   AL(WB_Z + (size_t)RPG * ZW * 2)
#define WB_XC    AL(WB_MGT + (size_t)RPG * 16 * 4)
#define WB_QM    AL(WB_XC + (size_t)RPG * 512 * 2)
#define WB_KM    AL(WB_QM + (size_t)RPG * 512 * 2)
#define WB_KMT   AL(WB_KM + (size_t)RPG * 512 * 2)
#define WB_MVT   AL(WB_KMT + (size_t)RPG * 512 * 2)
#define WB_HF    AL(WB_MVT + (size_t)RPG * 512 * 2)
#define WB_HB    AL(WB_HF + (size_t)RPG * 512 * 2)
#define WB_YSF   AL(WB_HB + (size_t)RPG * 512 * 2)
#define WB_YSB   AL(WB_YSF + (size_t)RPG * 512 * 4)
#define WB_YA    AL(WB_YSB + (size_t)RPG * 512 * 4)
#define WB_YB    AL(WB_YA + (size_t)RPG * 512 * 2)
#define WB_YS    AL(WB_YB + (size_t)RPG * 512 * 2)
#define WB_GG    AL(WB_YS + (size_t)RPG * 512 * 2)
#define WB_MG    AL(WB_GG + (size_t)RPG * 512 * 2)
#define WB_EI    AL(WB_MG + (size_t)RPG * DM * 2)
#define WB_EG    AL(WB_EI + (size_t)3 * RPG * 128 * 4)
#define WB_H2    AL(WB_EG + (size_t)3 * RPG * 128 * 4)
#define WB_U16   AL(WB_H2 + (size_t)3 * RPG * DM * 2)
#define WB_V16   AL(WB_U16 + (size_t)2 * 16384 * 768)
#define WB_VT    AL(WB_V16 + (size_t)2 * 16384 * 768)
#define WB_CNT   AL(WB_VT + (size_t)GB * 4 * 128 * NTOK * 2)
#define WB_XE    AL(WB_CNT + 256)
#define WB_BAR   AL(WB_XE + (size_t)GB * 32 * 2 * 33 * 128 * 4)
#define WB_GA    AL(WB_BAR + 256)
#define WB_POOL  AL(WB_GA + (size_t)GB * 4 * 2 * 68 * 272 * 4)
#define WB_END   AL(WB_POOL + 256)
#define WB_PQ    (WB_Z)
#define WB_SC    AL(WB_PQ + (size_t)RPG * 2048 * 2)

#define SMEM_FLOATS (26 * 1024)

__device__ __forceinline__ float sigmoidf_(float x) { return __builtin_amdgcn_rcpf(1.0f + __builtin_amdgcn_exp2f(-1.4426950408889634f * x)); }
__device__ __forceinline__ float siluf_(float x) { return x * __builtin_amdgcn_rcpf(1.0f + __builtin_amdgcn_exp2f(-1.4426950408889634f * x)); }
__device__ __forceinline__ float geluf_(float x) { return 0.5f * x * (1.0f + erff(x * 0.70710678118654752f)); }
__device__ __forceinline__ int otid() { int t = threadIdx.x; asm volatile("" : "+v"(t)); return t; }
__device__ __forceinline__ float wave_sum(float v) {
  for (int o = 32; o > 0; o >>= 1) v += __shfl_xor(v, o);
  return v;
}
__device__ __forceinline__ bf16_t f2bf(float x) { unsigned u = __float_as_uint(x); u += 0x7fffu + ((u >> 16) & 1u); return (bf16_t)(u >> 16); }
__device__ __forceinline__ float bf2f(bf16_t h) { return __uint_as_float(((unsigned)h) << 16); }
typedef float f32x2 __attribute__((ext_vector_type(2)));
typedef __bf16 bf16x2_t __attribute__((ext_vector_type(2)));
__device__ __forceinline__ unsigned pack2(float a, float b) { f32x2 v = {a, b}; return __builtin_bit_cast(unsigned, __builtin_convertvector(v, bf16x2_t)); }
__device__ __forceinline__ float lo16(unsigned u) { return __uint_as_float(u << 16); }
__device__ __forceinline__ float hi16(unsigned u) { return __uint_as_float(u & 0xffff0000u); }

__device__ __forceinline__ float* xrow(const Params& p, int b, int rr) {
  return (rr < NLAT) ? p.out + ((size_t)b * NLAT + rr) * DM : (float*)(p.ws + WB_XCX) + ((size_t)b * NCTX + (rr - NLAT)) * DM;
}

__device__ __forceinline__ const float* xrow_in(const Params& p, int b, int rr) {
  return (rr < NLAT) ? p.in[I_X] + ((size_t)b * NLAT + rr) * DM : p.in[I_CTX] + ((size_t)b * NCTX + (rr - NLAT)) * DM;
}

__device__ __forceinline__ void gemm_tile(const bf16_t* __restrict__ Ag, int lda, const bf16_t* __restrict__ Bg, int ldb, int K,
                                          char* smem, f32x16 (&acc)[2][2]) {
  const int tid = otid(), lane = tid & 63, w = tid >> 6, wm = w >> 1, wn = w & 1;
#pragma unroll
  for (int a = 0; a < 2; ++a)
#pragma unroll
    for (int b = 0; b < 2; ++b)
#pragma unroll
      for (int i = 0; i < 16; ++i) acc[a][b][i] = 0.f;
  const int srow = tid >> 3, sch = tid & 7;
  const bf16_t* ap = Ag + (size_t)srow * lda + sch * 8;
  const bf16_t* bp = Bg + (size_t)srow * ldb + sch * 8;
  const int wofs = srow * 128 + ((sch ^ ((srow >> 1) & 7)) << 4);
  const int fr = lane & 31, fh = lane >> 5, fsw = (fr >> 1) & 7;
  const int aofs = (wm * 64 + fr) * 128, bofs = 16384 + (wn * 64 + fr) * 128;
  u32x4 ra0[4], rb0[4], ra1[4], rb1[4];
  const int nk = K >> 6;
#define G_LOAD(RA, RB, KT) { _Pragma("unroll") for (int i = 0; i < 4; ++i) { RA[i] = *(const u32x4*)(ap + (size_t)i * 32 * lda + (KT) * 64); RB[i] = *(const u32x4*)(bp + (size_t)i * 32 * ldb + (KT) * 64); } }
#define G_STORE(RA, RB, BUF) { char* nb_ = smem + (BUF) * 32768; _Pragma("unroll") for (int i = 0; i < 4; ++i) { *(u32x4*)(nb_ + wofs + i * 4096) = RA[i]; *(u32x4*)(nb_ + 16384 + wofs + i * 4096) = RB[i]; } }
#define G_COMPUTE(BUF) { const char* base = smem + (BUF) * 32768; _Pragma("unroll") for (int ks = 0; ks < 4; ++ks) { \
      const int coff = ((ks * 2 + fh) ^ fsw) << 4; bf16x8 af[2], bfr[2]; \
      _Pragma("unroll") for (int mi = 0; mi < 2; ++mi) af[mi] = *(const bf16x8*)(base + aofs + mi * 4096 + coff); \
      _Pragma("unroll") for (int ni = 0; ni < 2; ++ni) bfr[ni] = *(const bf16x8*)(base + bofs + ni * 4096 + coff); \
      _Pragma("unroll") for (int mi = 0; mi < 2; ++mi) _Pragma("unroll") for (int ni = 0; ni < 2; ++ni) \
          acc[mi][ni] = __builtin_amdgcn_mfma_f32_32x32x16_bf16(bfr[ni], af[mi], acc[mi][ni], 0, 0, 0); } }
  G_LOAD(ra0, rb0, 0)
  G_LOAD(ra1, rb1, 1)
  __syncthreads();
  G_STORE(ra0, rb0, 0)
  __syncthreads();
  for (int kt = 0; kt < nk; kt += 2) {
    if (kt + 2 < nk) G_LOAD(ra0, rb0, kt + 2)
    G_COMPUTE(0)
    G_STORE(ra1, rb1, 1)
    __syncthreads();
    if (kt + 3 < nk) G_LOAD(ra1, rb1, kt + 3)
    G_COMPUTE(1)
    if (kt + 2 < nk) G_STORE(ra0, rb0, 0)
    __syncthreads();
  }
#undef G_LOAD
#undef G_STORE
#undef G_COMPUTE
}
#define EPI_DECL const int tid_ = otid(); const int lane = tid_ & 63, w_ = tid_ >> 6, wm = w_ >> 1, wn = w_ & 1, fr = lane & 31, fh = lane >> 5; (void)fr; (void)fh; (void)wm; (void)wn;
#define EPI_ROW(mi) (wm * 64 + (mi) * 32 + fr)
#define EPI_COL(ni, q) (wn * 64 + (ni) * 32 + 8 * (q) + 4 * fh)
#define MT_LR0(mt, tpb) (((mt) / (tpb)) * NTOK + ((mt) % (tpb)) * 128)


struct TileIter {
  int tm, tn, pw, ph, PN, NP, x, i, it;
  __device__ __forceinline__ TileIter(int tm_, int tn_) : tm(tm_), tn(tn_) {
    pw = tn < 8 ? tn : 8; ph = 32 / pw; PN = (tn + pw - 1) / pw; NP = ((tm + ph - 1) / ph) * PN;
    x = blockIdx.x & 7; i = blockIdx.x >> 3; it = 0;
  }
  __device__ __forceinline__ bool next(int& mt, int& nt, bool& valid) {
    if (gridDim.x != 256) {
      const int t = blockIdx.x + it * gridDim.x; ++it;
      if (t >= tm * tn) return false;
      mt = t / tn; nt = t % tn; valid = true; return true;
    }
    const int P = it * 8 + x; ++it;
    if (P >= NP) return false;
    mt = (P / PN) * ph + i / pw; nt = (P % PN) * pw + i % pw;
    valid = (mt < tm) && (nt < tn);
    return true;
  }
};

template <class F>
__device__ __forceinline__ void transpose_cvt(const float* __restrict__ src, int ld, F srccol, int K, int Ndst, bf16_t* __restrict__ dst, float* smem) {
  float (*T)[65] = (float (*)[65])smem;
  const int tid = otid();
  const int tk = K >> 6, tn = Ndst >> 6;
  for (int t = blockIdx.x; t < tn * tk; t += gridDim.x) {
    const int n0 = (t / tk) * 64, k0 = (t % tk) * 64;
    __syncthreads();
    const int sc = srccol(n0 + (tid & 63));
#pragma unroll
    for (int i = 0; i < 16; ++i) {
      const int ky = (tid >> 6) + 4 * i;
      T[ky][tid & 63] = (sc >= 0) ? src[(size_t)(k0 + ky) * ld + sc] : 0.f;
    }
    __syncthreads();
#pragma unroll
    for (int i = 0; i < 16; ++i) {
      const int ny = (tid >> 6) + 4 * i;
      dst[(size_t)(n0 + ny) * K + k0 + (tid & 63)] = f2bf(T[tid & 63][ny]);
    }
  }
  __syncthreads();
}
__device__ __forceinline__ void fragpack(const float* __restrict__ src, int ld, int K, int N, bf16_t* __restrict__ dst) {
  const int kc = K >> 6, total = (N >> 5) * kc * 256;
  for (int idx = blockIdx.x * 256 + otid(); idx < total; idx += gridDim.x * 256) {
    const int lane = idx & 63, ks = (idx >> 6) & 3, c = (idx >> 8) % kc, nf = (idx >> 8) / kc;
    const int n = 32 * nf + (lane & 31), k0 = 64 * c + 32 * (lane >> 5) + 8 * ks;
    float f[8];
#pragma unroll
    for (int j = 0; j < 8; ++j) f[j] = src[(size_t)(k0 + j) * ld + n];
    *(u32x4*)(dst + (size_t)idx * 8) = (u32x4){pack2(f[0], f[1]), pack2(f[2], f[3]), pack2(f[4], f[5]), pack2(f[6], f[7])};
  }
}
__device__ __forceinline__ int win_srccol(int n) {
  if (n < 3072) return n;
  if (n < 6656) return n + 16;
  if (n < 6672) return n - 3584;
  return -1;
}

__device__ __forceinline__ void stage_init(const Params& p, float* smem) {
  const int tid = otid();
  if (blockIdx.x == 0 && tid < 64) { ((int*)(p.ws + WB_CNT))[tid] = 0; if (tid < 16) ((int*)(p.ws + WB_POOL))[tid] = 0; }
  {
    float* lx = smem + tid * 33;
    int perm[32];
    {
      v16f a, b;
#pragma unroll
      for (int j = 0; j < 16; ++j) { a[j] = (float)(j & 7); b[j] = (float)((j + 16) & 7); }
      const v32f u1 = __builtin_amdgcn_cvt_scalef32_pk32_f32_fp6(__builtin_amdgcn_cvt_scalef32_2xpk16_fp6_f32(a, b, 1.0f), 1.0f);
#pragma unroll
      for (int j = 0; j < 16; ++j) { a[j] = (float)(j >> 3); b[j] = (float)((j + 16) >> 3); }
      const v32f u2 = __builtin_amdgcn_cvt_scalef32_pk32_f32_fp6(__builtin_amdgcn_cvt_scalef32_2xpk16_fp6_f32(a, b, 1.0f), 1.0f);
#pragma unroll
      for (int k = 0; k < 32; ++k) perm[k] = ((int)(u1[k] + 0.5f) + 8 * (int)(u2[k] + 0.5f)) & 31;
    }
    const size_t ngrp = (size_t)2 * 16384 * 32;
    for (size_t i = (size_t)blockIdx.x * 256 + tid; i < 2 * ngrp; i += (size_t)gridDim.x * 256) {
      const bool isv = i >= ngrp;
      const size_t gi = isv ? i - ngrp : i;
      const float4* s4 = (const float4*)((isv ? p.in[I_PV] : p.in[I_PU]) + gi * 32);
      const float sc = isv ? 2.0f : 64.0f;
      float o[32];
#pragma unroll
      for (int q = 0; q < 8; ++q) { const float4 t = s4[q]; o[4 * q] = t.x * sc; o[4 * q + 1] = t.y * sc; o[4 * q + 2] = t.z * sc; o[4 * q + 3] = t.w * sc; }
#pragma unroll
      for (int k = 0; k < 32; ++k) lx[perm[k]] = o[k];
      v16f a, b;
#pragma unroll
      for (int j = 0; j < 16; ++j) { a[j] = lx[j]; b[j] = lx[16 + j]; }
      const v6u pk = __builtin_amdgcn_cvt_scalef32_2xpk16_fp6_f32(a, b, 1.0f);
      u32x2* d = (u32x2*)(p.ws + (isv ? WB_V16 : WB_U16) + gi * 24);
      d[0] = (u32x2){pk[0], pk[1]}; d[1] = (u32x2){pk[2], pk[3]}; d[2] = (u32x2){pk[4], pk[5]};
    }
    __syncthreads();
  }
  {
    float2* rt = (float2*)(p.ws + WB_ROPE);
    for (int i = blockIdx.x * 256 + tid; i < NLAT * 32; i += gridDim.x * 256) {
      const int pos = i >> 5, j = i & 31;
      const float inv = powf(10000.0f, -(float)(j & 15) / 16.0f);
      const float ang = (float)((j < 16) ? (pos >> 6) : (pos & 63)) * inv;
      rt[i] = make_float2(cosf(ang), sinf(ang));
    }
  }
  {
    float* sc = smem;
    float* red = smem + 9 * 1024;
    for (int i = tid; i < 9 * 1024; i += 256) {
      int r = i >> 10, k = i & 1023;
      float v = (r < 8) ? p.in[I_C][r * 1024 + k] : p.in[I_CCTX][k];
      sc[i] = siluf_(v);
    }
    __syncthreads();
    float* mod = (float*)(p.ws + WB_MOD);
    const int jc = tid & 63, ksl = tid >> 6;
    for (int cb = blockIdx.x; cb < 2 * 6144 / 64; cb += gridDim.x) {
      const int col = cb * 64 + jc;
      const int l = col / 6144, j = col % 6144;
      const float* w = p.in[I_WMOD] + (size_t)l * 1024 * 6144 + j;
      float acc[9];
#pragma unroll
      for (int r = 0; r < 9; ++r) acc[r] = 0.f;
#pragma unroll 8
      for (int k = ksl * 256; k < ksl * 256 + 256; ++k) {
        const float wv = w[(size_t)k * 6144];
#pragma unroll
        for (int r = 0; r < 9; ++r) acc[r] = fmaf(sc[r * 1024 + k], wv, acc[r]);
      }
      __syncthreads();
#pragma unroll
      for (int r = 0; r < 9; ++r) red[(ksl * 64 + jc) * 9 + r] = acc[r];
      __syncthreads();
      if (ksl == 0) {
        const float bv = p.in[I_BMOD][l * 6144 + j];
#pragma unroll
        for (int r = 0; r < 9; ++r)
          mod[((size_t)l * 9 + r) * 6144 + j] = red[jc * 9 + r] + red[(64 + jc) * 9 + r] + red[(128 + jc) * 9 + r] + red[(192 + jc) * 9 + r] + bv;
      }
    }
    __syncthreads();
  }
  bf16_t* WT = (bf16_t*)(p.ws + WB_WT);
  for (int l = 0; l < 2; ++l) {
    bf16_t* W = WT + (size_t)l * WT_LAYER;
    transpose_cvt(p.in[I_WIN] + (size_t)l * DM * INW, INW, [](int n) { return win_srccol(n); }, DM, 6784, W + WT_WIN, smem);
    for (int h = 0; h < 4; ++h) {
      transpose_cvt(p.in[I_MLWQ] + ((size_t)l * 4 + h) * 16384, 128, [](int n) { return n; }, 128, 128, W + WT_WQK + (size_t)h * 256 * 128, smem);
      transpose_cvt(p.in[I_MLWK] + ((size_t)l * 4 + h) * 16384, 128, [](int n) { return n; }, 128, 128, W + WT_WQK + (size_t)h * 256 * 128 + 128 * 128, smem);
    }
    fragpack(p.in[I_GLUW] + (size_t)l * 512 * 512, 512, 512, 512, W + WT_GLU);
    for (int r = 0; r < 3; ++r) fragpack(p.in[I_WBR] + ((size_t)l * 3 + r) * 512 * DM, DM, 512, DM, W + WT_WBR + (size_t)r * 1024 * 512);
    fragpack(p.in[I_WOUT] + (size_t)l * DM * DM, DM, DM, DM, W + WT_WOUT);
    transpose_cvt(p.in[I_PWQ] + (size_t)l * DM * 2048, 2048, [](int n) { return n; }, DM, 2048, W + WT_WQ, smem);
    const float* sk = p.in[I_PSUBK] + (size_t)l * 2 * 128 * 128;
    for (int i = blockIdx.x * 256 + tid; i < 2 * 128 * 128; i += gridDim.x * 256) W[WT_SUBK + i] = f2bf(sk[i]);
  }
}

__device__ __forceinline__ void stage_normmod(const Params& p, int l, int g, int which, int rr_lim, bf16_t* H, float* smem) {
  const int tid = otid(), w = tid >> 6, lane = tid & 63;
  const float* ng = p.in[which ? I_N2G : I_N1G] + l * DM;
  const float* mod = (const float*)(p.ws + WB_MOD) + (size_t)l * 9 * 6144;
  const int off_sh = which ? 3072 : 0, off_sc = which ? 4096 : 1024;
  const int n = GB * rr_lim;
  for (int i0 = (blockIdx.x * 4 + w) * 2; i0 < n; i0 += gridDim.x * 8) {
    float4 v[2][4];
    int bl[2], rr[2];
#pragma unroll
    for (int u = 0; u < 2; ++u) {
      const int i = (i0 + u < n) ? i0 + u : i0;
      bl[u] = i / rr_lim; rr[u] = i % rr_lim;
      const float4* X = (const float4*)((l == 0 && which == 0) ? xrow_in(p, g * GB + bl[u], rr[u]) : xrow(p, g * GB + bl[u], rr[u]));
#pragma unroll
      for (int q = 0; q < 4; ++q) v[u][q] = X[q * 64 + lane];
    }
#pragma unroll
    for (int u = 0; u < 2; ++u) {
      if (i0 + u >= n) break;
      float s = 0.f;
#pragma unroll
      for (int q = 0; q < 4; ++q) s += v[u][q].x * v[u][q].x + v[u][q].y * v[u][q].y + v[u][q].z * v[u][q].z + v[u][q].w * v[u][q].w;
      s = wave_sum(s);
      const float rs = rsqrtf(s * (1.0f / DM) + EPSF);
      const float* m = mod + (size_t)((rr[u] < NLAT) ? (g * GB + bl[u]) : 8) * 6144;
      u32x2* hp = (u32x2*)(H + ((size_t)bl[u] * NTOK + rr[u]) * DM);
#pragma unroll
      for (int q = 0; q < 4; ++q) {
        const float4 gg = ((const float4*)ng)[q * 64 + lane];
        const float4 sc = ((const float4*)(m + off_sc))[q * 64 + lane];
        const float4 sh = ((const float4*)(m + off_sh))[q * 64 + lane];
        const float4 x = v[u][q];
        hp[q * 64 + lane] = (u32x2){pack2(x.x * rs * gg.x * (1.f + sc.x) + sh.x, x.y * rs * gg.y * (1.f + sc.y) + sh.y),
                                    pack2(x.z * rs * gg.z * (1.f + sc.z) + sh.z, x.w * rs * gg.w * (1.f + sc.w) + sh.w)};
      }
    }
  }
}

__device__ __forceinline__ void stage_inproj(const Params& p, const bf16_t* H, const bf16_t* WinT, bf16_t* Z, float* MGT, bf16_t* VT, bf16_t* MVT, char* smem) {
  EPI_DECL
  const int tm = GB * 34, tn = 53;
  const float2* rt = (const float2*)(p.ws + WB_ROPE);
  TileIter ti(tm, tn);
  int mt, j; bool valid;
  while (ti.next(mt, j, valid)) {
    if (!valid) continue;
    const int n0 = j * 128;
    const int lr0 = MT_LR0(mt, 34), rr0 = (mt % 34) * 128;
    f32x16 acc[2][2];
    if ((j >= 8 && j < 12) || (j >= 16 && j < 20)) {
      gemm_tile(WinT + (size_t)n0 * DM, DM, H + (size_t)lr0 * DM, DM, DM, smem, acc);
      bf16_t* vt = ((j < 12) ? VT : MVT) + ((size_t)(mt / 34) * 4 + (j & 3)) * 128 * NTOK;
#pragma unroll
      for (int mi = 0; mi < 2; ++mi)
#pragma unroll
        for (int ni = 0; ni < 2; ++ni)
#pragma unroll
          for (int q = 0; q < 4; ++q) {
            const int e = EPI_ROW(mi), tok = rr0 + EPI_COL(ni, q);
            *(u32x2*)(vt + (size_t)e * NTOK + tok) = (u32x2){pack2(acc[mi][ni][4 * q], acc[mi][ni][4 * q + 1]), pack2(acc[mi][ni][4 * q + 2], acc[mi][ni][4 * q + 3])};
          }
      continue;
    }
    gemm_tile(H + (size_t)lr0 * DM, DM, WinT + (size_t)n0 * DM, DM, DM, smem, acc);
    if (j < 8 && rr0 < NLAT) {
#pragma unroll
      for (int mi = 0; mi < 2; ++mi) {
        const int pos = rr0 + EPI_ROW(mi);
#pragma unroll
        for (int i = 0; i < 16; ++i) {
          const int jj = 8 * (i >> 2) + 4 * fh + (i & 3);
          const float2 cs = rt[pos * 32 + jj];
          const float x1 = acc[mi][0][i], x2 = acc[mi][1][i];
          acc[mi][0][i] = x1 * cs.x - x2 * cs.y;
          acc[mi][1][i] = x1 * cs.y + x2 * cs.x;
        }
      }
    }
    if (j < 52) {
      const bool sg = (j >= 28);
#pragma unroll
      for (int mi = 0; mi < 2; ++mi)
#pragma unroll
        for (int ni = 0; ni < 2; ++ni)
#pragma unroll
          for (int q = 0; q < 4; ++q) {
            const int row = lr0 + EPI_ROW(mi), c = n0 + EPI_COL(ni, q);
            float v0 = acc[mi][ni][4 * q], v1 = acc[mi][ni][4 * q + 1], v2 = acc[mi][ni][4 * q + 2], v3 = acc[mi][ni][4 * q + 3];
            if (sg) { v0 = sigmoidf_(v0); v1 = sigmoidf_(v1); v2 = sigmoidf_(v2); v3 = sigmoidf_(v3); }
            *(u32x2*)(Z + (size_t)row * ZW + c) = (u32x2){pack2(v0, v1), pack2(v2, v3)};
          }
    } else {
#pragma unroll
      for (int mi = 0; mi < 2; ++mi)
#pragma unroll
        for (int q = 0; q < 2; ++q) {
          const int row = lr0 + EPI_ROW(mi), c = EPI_COL(0, q);
          if (wn == 0) *(float4*)(MGT + (size_t)row * 16 + c) = make_float4(acc[mi][0][4 * q], acc[mi][0][4 * q + 1], acc[mi][0][4 * q + 2], acc[mi][0][4 * q + 3]);
        }
    }
  }
}

__device__ __forceinline__ void stage_conv(const Params& p, int l, const bf16_t* Z, bf16_t* XC) {
  const int tid = otid();
  const float* cw = p.in[I_CONVW] + (size_t)l * 3 * 512;
  const float* cb = p.in[I_CONVB] + (size_t)l * 512;
  const int c = tid * 2;
  const float2 w0 = *(const float2*)(cw + c), w1 = *(const float2*)(cw + 512 + c), w2 = *(const float2*)(cw + 1024 + c), bb = *(const float2*)(cb + c);
  for (int lr0 = blockIdx.x * 4; lr0 < RPG; lr0 += gridDim.x * 4) {
    unsigned xc[4], xp[4], xn[4];
#pragma unroll
    for (int u = 0; u < 4; ++u) {
      const int lr = lr0 + u, rr = lr % NTOK;
      const bool has_prev = (rr < NLAT) ? (rr > 0) : (rr > NLAT);
      const bool has_next = (rr < NLAT) ? (rr < NLAT - 1) : (rr < NTOK - 1);
      const bf16_t* z = Z + (size_t)lr * ZW + 1536 + c;
      xc[u] = *(const unsigned*)z;
      xp[u] = has_prev ? *(const unsigned*)(z - ZW) : 0u;
      xn[u] = has_next ? *(const unsigned*)(z + ZW) : 0u;
    }
#pragma unroll
    for (int u = 0; u < 4; ++u) {
      const float a0 = bb.x + w1.x * lo16(xc[u]) + w0.x * lo16(xp[u]) + w2.x * lo16(xn[u]);
      const float a1 = bb.y + w1.y * hi16(xc[u]) + w0.y * hi16(xp[u]) + w2.y * hi16(xn[u]);
      *(unsigned*)(XC + (size_t)(lr0 + u) * 512 + c) = pack2(siluf_(a0), siluf_(a1));
    }
  }
}

__device__ __forceinline__ void stage_mlqk(const Params& p, int l, const bf16_t* Z, bf16_t* XC, const bf16_t* WQK, bf16_t* QM, bf16_t* KM, bf16_t* KMT, char* smem) {
  EPI_DECL
  const int tm = RPG >> 7;
  TileIter ti(tm, 12);
  int mt, r12; bool valid;
  while (ti.next(mt, r12, valid)) {
    if (!valid) continue;
    const int h = r12 & 3, kind = r12 >> 2;
    const int m0 = mt * 128;
    {
      const int ct = otid(), c = h * 128 + (ct & 15) * 8, r0 = ct >> 4;
      const float* cw = p.in[I_CONVW] + (size_t)l * 3 * 512 + c;
      const float* cb = p.in[I_CONVB] + (size_t)l * 512 + c;
      float w0[8], w1[8], w2[8], bb[8];
#pragma unroll
      for (int j = 0; j < 8; ++j) { w0[j] = cw[j]; w1[j] = cw[512 + j]; w2[j] = cw[1024 + j]; bb[j] = cb[j]; }
      u32x4 xc[8], xp[8], xn[8];
#pragma unroll
      for (int u = 0; u < 8; ++u) {
        const int lr = m0 + r0 + 16 * u, rr = lr % NTOK;
        const bool has_prev = (rr < NLAT) ? (rr > 0) : (rr > NLAT);
        const bool has_next = (rr < NLAT) ? (rr < NLAT - 1) : (rr < NTOK - 1);
        const bf16_t* z = Z + (size_t)lr * ZW + 1536 + c;
        xc[u] = *(const u32x4*)z;
        xp[u] = has_prev ? *(const u32x4*)(z - ZW) : (u32x4){0u, 0u, 0u, 0u};
        xn[u] = has_next ? *(const u32x4*)(z + ZW) : (u32x4){0u, 0u, 0u, 0u};
      }
#pragma unroll
      for (int u = 0; u < 8; ++u) {
        u32x4 o;
#pragma unroll
        for (int k = 0; k < 4; ++k) {
          const float a0 = bb[2 * k] + w1[2 * k] * lo16(xc[u][k]) + w0[2 * k] * lo16(xp[u][k]) + w2[2 * k] * lo16(xn[u][k]);
          const float a1 = bb[2 * k + 1] + w1[2 * k + 1] * hi16(xc[u][k]) + w0[2 * k + 1] * hi16(xp[u][k]) + w2[2 * k + 1] * hi16(xn[u][k]);
          o[k] = pack2(siluf_(a0), siluf_(a1));
        }
        *(u32x4*)(XC + (size_t)(m0 + r0 + 16 * u) * 512 + c) = o;
      }
      __syncthreads();
    }
    f32x16 acc[2][2];
    const bf16_t* Wt = WQK + (size_t)h * 256 * 128 + (size_t)(kind ? 1 : 0) * 128 * 128;
    const bf16_t* Xt = XC + (size_t)m0 * 512 + h * 128;
    if (kind < 2) {
      gemm_tile(Xt, 512, Wt, 128, 128, smem, acc);
      bf16_t* O = kind ? KM : QM;
      const float alpha = kind ? 1.0f : 0.08838834764831845f;
#pragma unroll
      for (int mi = 0; mi < 2; ++mi)
#pragma unroll
        for (int ni = 0; ni < 2; ++ni)
#pragma unroll
          for (int q = 0; q < 4; ++q) {
            const int row = m0 + EPI_ROW(mi), c = EPI_COL(ni, q);
            *(u32x2*)(O + (size_t)row * 512 + h * 128 + c) = (u32x2){pack2(alpha * acc[mi][ni][4 * q], alpha * acc[mi][ni][4 * q + 1]), pack2(alpha * acc[mi][ni][4 * q + 2], alpha * acc[mi][ni][4 * q + 3])};
          }
    } else {
      gemm_tile(Wt, 128, Xt, 512, 128, smem, acc);
      bf16_t* kt = KMT + ((size_t)(mt / 34) * 4 + h) * 128 * NTOK + (mt % 34) * 128;
#pragma unroll
      for (int mi = 0; mi < 2; ++mi)
#pragma unroll
        for (int ni = 0; ni < 2; ++ni)
#pragma unroll
          for (int q = 0; q < 4; ++q) {
            const int d = EPI_ROW(mi), tok = EPI_COL(ni, q);
            *(u32x2*)(kt + (size_t)d * NTOK + tok) = (u32x2){pack2(acc[mi][ni][4 * q], acc[mi][ni][4 * q + 1]), pack2(acc[mi][ni][4 * q + 2], acc[mi][ni][4 * q + 3])};
          }
    }
  }
}

__device__ __forceinline__ void attn_mfma_item(const Params& p, int l, const bf16_t* Zb, const bf16_t* VTb, bf16_t* YAb, int h, int qrow0, int key0, int nkeys,
                                               float lam, float lam_init, char* smem) {
  const int tid = otid(), lane = tid & 63, w = tid >> 6, fr = lane & 31, fh = lane >> 5;
  const int rb = w & 1, m = w >> 1;
  const int ntiles = nkeys >> 6;
  const int myrow = qrow0 + rb * 32 + fr;
  bf16x8 qf[4];
  {
    const bf16_t* qp = Zb + (size_t)myrow * ZW + h * 128 + m * 64 + fh * 8;
#pragma unroll
    for (int ks = 0; ks < 4; ++ks) qf[ks] = *(const bf16x8*)(qp + ks * 16);
  }
  f32x16 O[4];
#pragma unroll
  for (int eb = 0; eb < 4; ++eb)
#pragma unroll
    for (int i = 0; i < 16; ++i) O[eb][i] = 0.f;
  float mrun = -1e30f, lrun = 0.f;
  const float cs = 0.125f * 1.4426950408889634f;
  const int skey = tid >> 4, sch = tid & 15;
  const bf16_t* ksrc = Zb + (size_t)(key0 + skey) * ZW + 512 + h * 128 + sch * 8;
  const int kdst = skey * 256 + ((sch ^ (skey & 15)) << 4);
  const int se = tid >> 3, svc = tid & 7;
  const bf16_t* vsrc = VTb + ((size_t)h * 128 + se) * NTOK + key0 + svc * 8;
  const int vsw = (se >> 1) & 7;
  const int vdst0 = se * 128 + ((((svc & ~1)) ^ vsw) << 4) + (svc & 1) * 8, vdst1 = se * 128 + ((((svc & ~1) + 1) ^ vsw) << 4) + (svc & 1) * 8;
  const int kfo = fr * 256, kfs = fr & 15;
  const int vfo = fr * 128, vfs = (fr >> 1) & 7;
  u32x4 rk[4], rv[4];
#pragma unroll
  for (int i = 0; i < 4; ++i) rk[i] = *(const u32x4*)(ksrc + (size_t)i * 16 * ZW);
  __syncthreads();
#pragma unroll
  for (int i = 0; i < 4; ++i) *(u32x4*)(smem + kdst + i * 4096) = rk[i];
  __syncthreads();
  bf16x8 pf[4];
#define ATT_S(T) { const char* kb_ = smem + ((T) & 1) * 16384; _Pragma("unroll") for (int kb = 0; kb < 2; ++kb) { \
      _Pragma("unroll") for (int i = 0; i < 16; ++i) S[kb][i] = 0.f; \
      _Pragma("unroll") for (int ks = 0; ks < 4; ++ks) { \
        const bf16x8 kf = *(const bf16x8*)(kb_ + kb * 8192 + kfo + (((m * 8 + ks * 2 + fh) ^ kfs) << 4)); \
        S[kb] = __builtin_amdgcn_mfma_f32_32x32x16_bf16(kf, qf[ks], S[kb], 0, 0, 0); } } }
#define ATT_MAX() { float tm = S[0][0]; \
      _Pragma("unroll") for (int i = 1; i < 16; ++i) tm = fmaxf(tm, S[0][i]); \
      _Pragma("unroll") for (int i = 0; i < 16; ++i) tm = fmaxf(tm, S[1][i]); \
      tm = fmaxf(tm, __shfl_xor(tm, 32)) * cs; alpha = 1.f; \
      if (tm > mrun + 8.0f) { alpha = __builtin_amdgcn_exp2f(mrun - tm); mrun = tm; } }
#define ATT_EXP(PF) { const float mc = mrun; float rs = 0.f; \
      _Pragma("unroll") for (int kb = 0; kb < 2; ++kb) { float pv[16]; \
        _Pragma("unroll") for (int i = 0; i < 16; ++i) { pv[i] = __builtin_amdgcn_exp2f(fmaf(S[kb][i], cs, -mc)); rs += pv[i]; } \
        _Pragma("unroll") for (int hh = 0; hh < 2; ++hh) \
          PF[kb * 2 + hh] = __builtin_bit_cast(bf16x8, (u32x4){pack2(pv[8 * hh], pv[8 * hh + 1]), pack2(pv[8 * hh + 2], pv[8 * hh + 3]), \
                                                               pack2(pv[8 * hh + 4], pv[8 * hh + 5]), pack2(pv[8 * hh + 6], pv[8 * hh + 7])}); } \
      lrun += rs; }
#define ATT_PV(T) { const char* vb_ = smem + 32768 + ((T) & 1) * 16384; _Pragma("unroll") for (int eb = 0; eb < 4; ++eb) _Pragma("unroll") for (int s = 0; s < 4; ++s) { \
        const bf16x8 vf = *(const bf16x8*)(vb_ + eb * 4096 + vfo + (((2 * s + fh) ^ vfs) << 4)); \
        O[eb] = __builtin_amdgcn_mfma_f32_32x32x16_bf16(vf, pf[s], O[eb], 0, 0, 0); } }
  f32x16 S[2];
  float alpha;
  u32x4 rk2[4], rv2[4];
#define ATT_LOAD(RK, RV, KT, VT_) { const int kt_ = ((KT) < ntiles) ? (KT) : ntiles - 1, vt_ = ((VT_) < ntiles) ? (VT_) : ntiles - 1; \
    _Pragma("unroll") for (int i = 0; i < 4; ++i) RK[i] = *(const u32x4*)(ksrc + (size_t)(kt_ * 64 + i * 16) * ZW); \
    _Pragma("unroll") for (int i = 0; i < 4; ++i) RV[i] = *(const u32x4*)(vsrc + (size_t)i * 32 * NTOK + vt_ * 64); }
#define ATT_STORE(RK, RV, T) { if ((T) + 1 < ntiles) { char* kd = smem + (((T) + 1) & 1) * 16384; \
      _Pragma("unroll") for (int i = 0; i < 4; ++i) *(u32x4*)(kd + kdst + i * 4096) = RK[i]; } \
    { char* vd = smem + 32768 + ((T) & 1) * 16384; \
      _Pragma("unroll") for (int i = 0; i < 4; ++i) { *(u32x2*)(vd + vdst0 + i * 4096) = (u32x2){RV[i][0], RV[i][1]}; *(u32x2*)(vd + vdst1 + i * 4096) = (u32x2){RV[i][2], RV[i][3]}; } } }
  {
    ATT_LOAD(rk, rv, 1, 0)
    ATT_LOAD(rk2, rv2, 2, 1)
    ATT_S(0)
    ATT_MAX()
    ATT_EXP(pf)
    ATT_STORE(rk, rv, 0)
    __syncthreads();
  }
#define ATT_ITER(T, LK, LV, SK, SV) { \
    ATT_LOAD(LK, LV, (T) + 2, (T) + 1) \
    ATT_S(T) \
    ATT_MAX() \
    if (__any(alpha != 1.f)) { \
        \
      _Pragma("unroll") for (int eb = 0; eb < 4; ++eb) _Pragma("unroll") for (int i = 0; i < 16; ++i) O[eb][i] *= alpha; \
      lrun *= alpha; \
      _Pragma("unroll") for (int s = 0; s < 4; ++s) { \
        const u32x4 r_ = __builtin_bit_cast(u32x4, pf[s]); \
        pf[s] = __builtin_bit_cast(bf16x8, (u32x4){pack2(lo16(r_[0]) * alpha, hi16(r_[0]) * alpha), pack2(lo16(r_[1]) * alpha, hi16(r_[1]) * alpha), \
                                                   pack2(lo16(r_[2]) * alpha, hi16(r_[2]) * alpha), pack2(lo16(r_[3]) * alpha, hi16(r_[3]) * alpha)}); \
      } \
    } \
    bf16x8 pn[4]; \
    {   \
      ATT_PV((T) - 1) \
      ATT_EXP(pn) \
      _Pragma("unroll") for (int i = 0; i < 16; ++i) { \
        __builtin_amdgcn_sched_group_barrier(0x100, 1, 0); \
        __builtin_amdgcn_sched_group_barrier(0x008, 1, 0); \
        __builtin_amdgcn_sched_group_barrier(0x002, 9, 0); \
      } \
    } \
    _Pragma("unroll") for (int s = 0; s < 4; ++s) pf[s] = pn[s]; \
    ATT_STORE(SK, SV, T) \
    __syncthreads(); }
  {
    int t = 1;
#pragma unroll 1
    for (; t + 1 < ntiles; t += 2) {
      ATT_ITER(t, rk, rv, rk2, rv2)
      ATT_ITER(t + 1, rk2, rv2, rk, rv)
    }
    if (t < ntiles) ATT_ITER(t, rk, rv, rk2, rv2)
  }
#undef ATT_ITER
#undef ATT_LOAD
#undef ATT_STORE
  ATT_PV(ntiles - 1)
  __syncthreads();
#undef ATT_S
#undef ATT_MAX
#undef ATT_EXP
#undef ATT_PV
  const float lt = lrun + __shfl_xor(lrun, 32);
  const float sc = (m ? lam : 1.0f) / lt;
  float* xo = (float*)smem + rb * 4096;
  if (m == 1) {
#pragma unroll
    for (int eb = 0; eb < 4; ++eb)
#pragma unroll
      for (int i = 0; i < 16; ++i) xo[(eb * 32 + (i & 3) + 8 * (i >> 2) + 4 * fh) * 32 + fr] = O[eb][i] * sc;
  }
  __syncthreads();
  if (m == 0) {
    float ss = 0.f;
#pragma unroll
    for (int eb = 0; eb < 4; ++eb)
#pragma unroll
      for (int i = 0; i < 16; ++i) {
        const float o = O[eb][i] * sc - xo[(eb * 32 + (i & 3) + 8 * (i >> 2) + 4 * fh) * 32 + fr];
        O[eb][i] = o; ss = fmaf(o, o, ss);
      }
    ss += __shfl_xor(ss, 32);
    const float rn = rsqrtf(ss * (1.0f / 128.0f) + EPSF) * (1.0f - lam_init);
    const float* sg = p.in[I_SUBG] + l * 512 + h * 128;
    bf16_t* yp = YAb + (size_t)myrow * 512 + h * 128;
#pragma unroll
    for (int eb = 0; eb < 4; ++eb)
#pragma unroll
      for (int q = 0; q < 4; ++q) {
        const int e = eb * 32 + 8 * q + 4 * fh;
        const float4 g = *(const float4*)(sg + e);
        *(u32x2*)(yp + e) = (u32x2){pack2(O[eb][4 * q] * rn * g.x, O[eb][4 * q + 1] * rn * g.y), pack2(O[eb][4 * q + 2] * rn * g.z, O[eb][4 * q + 3] * rn * g.w)};
      }
  }
  __syncthreads();
}

__device__ __forceinline__ int mlstm_row0(int dir, int c) {
  return (dir == 0) ? ((c < 4) ? NLAT + 64 * c : 64 * (c - 4)) : ((c < 4) ? NLAT + 64 * (3 - c) : 64 * (67 - c));
}
__device__ __forceinline__ void stage_mlgates(const Params& p, int l, const float* MGT, float* GA) {
  const int tid = otid(), w = tid >> 6, lane = tid & 63;
  const int nitems = GB * 4 * 2 * 68;
  for (int idx = blockIdx.x * 4 + w; idx < nitems; idx += gridDim.x * 4) {
    const int c = idx % 68, r1 = idx / 68, dir = r1 & 1, h = (r1 >> 1) & 3, bl = r1 >> 3;
    const int row = mlstm_row0(dir, c) + lane;
    const float* mg = MGT + ((size_t)bl * NTOK + row) * 16;
    const float li = mg[dir * 8 + h] + p.in[I_GATEB][l * 16 + dir * 8 + h];
    const float x = mg[dir * 8 + 4 + h] + p.in[I_GATEB][l * 16 + dir * 8 + 4 + h];
    const float lf = fminf(x, 0.f) - log1pf(expf(-fabsf(x)));
    float b = lf;
#pragma unroll
    for (int o = 1; o < 64; o <<= 1) {
      const float v = (dir == 0) ? __shfl_up(b, o) : __shfl_down(b, o);
      const bool ok = (dir == 0) ? (lane >= o) : (lane + o < 64);
      if (ok) b += v;
    }
    const float tot = (dir == 0) ? __shfl(b, 63) : __shfl(b, 0);
    float* ga = GA + (size_t)idx * 272;
    ga[lane] = b * 1.4426950408889634f; ga[64 + lane] = (li - b) * 1.4426950408889634f; ga[128 + lane] = expf(tot + li - b); ga[192 + lane] = expf(b);
    if (lane < 4) ga[256 + lane] = expf(tot);
  }
}

__device__ __forceinline__ void mlstm_chain_item(const Params& p, int l, const bf16_t* QMb, const bf16_t* KMb, const bf16_t* KMTb, const bf16_t* MVTb,
                                                 const float* GAc, bf16_t* HXb, int h, int dir, int ehalf, char* smem) {
  const int tid = otid(), lane = tid & 63, w = tid >> 6, fr = lane & 31, fh = lane >> 5;
  const int tb = w & 1, xb = w >> 1;
  float* fl = (float*)(smem + 73728);
  float* bs = fl; float* as_ = fl + 64; float* wgs = fl + 128; float* ebs = fl + 192; float* dec_s = fl + 256; float* nprev = fl + 272; float* npart = fl + 400;
  f32x16 CT[2];
#pragma unroll
  for (int eb = 0; eb < 2; ++eb)
#pragma unroll
    for (int i = 0; i < 16; ++i) CT[eb][i] = 0.f;
  __syncthreads();
  { u32x4 z_ = (u32x4){0u, 0u, 0u, 0u}; asm volatile("" : "+v"(z_));
    for (int i = tid; i < 1024; i += 256) ((u32x4*)(smem + 57344))[i] = z_; }
  if (tid < 128) nprev[tid] = 0.f;
  const int qr = tid >> 4, qc = tid & 15;
  const int qdst = qr * 256 + ((qc ^ (qr & 15)) << 4);
  const int tr = tid >> 3, tc = tid & 7;
  const int tdst = tr * 128 + ((tc ^ ((tr >> 1) & 7)) << 4);
  const int sw16 = fr & 15, sw8 = (fr >> 1) & 7;
  u32x4 ra[4], rb[4], rc[4], rd[2];
  float4 rg = make_float4(0.f, 0.f, 0.f, 0.f);
#define ML_LOAD(C_) { const int r0_ = mlstm_row0(dir, (C_)); \
    const bf16_t* qs = QMb + (size_t)(r0_ + qr) * 512 + h * 128 + qc * 8; \
    const bf16_t* ks = KMb + (size_t)(r0_ + qr) * 512 + h * 128 + qc * 8; \
    const bf16_t* kts = KMTb + ((size_t)h * 128 + tr) * NTOK + r0_ + tc * 8; \
    const bf16_t* vts = MVTb + ((size_t)h * 128 + ehalf * 64 + tr) * NTOK + r0_ + tc * 8; \
    _Pragma("unroll") for (int i = 0; i < 4; ++i) { ra[i] = *(const u32x4*)(qs + (size_t)i * 16 * 512); rb[i] = *(const u32x4*)(ks + (size_t)i * 16 * 512); \
                                                    rc[i] = *(const u32x4*)(kts + (size_t)i * 32 * NTOK); } \
    _Pragma("unroll") for (int i = 0; i < 2; ++i) rd[i] = *(const u32x4*)(vts + (size_t)i * 32 * NTOK); \
    if (tid < 68) rg = ((const float4*)(GAc + (size_t)(C_) * 272))[tid]; }
  ML_LOAD(0)
#pragma unroll 1
  for (int c = 0; c < 68; ++c) {
    const int row0 = mlstm_row0(dir, c);
    __syncthreads();
#pragma unroll
    for (int i = 0; i < 4; ++i) {
      *(u32x4*)(smem + qdst + i * 4096) = ra[i];
      *(u32x4*)(smem + 16384 + qdst + i * 4096) = rb[i];
      *(u32x4*)(smem + 32768 + tdst + i * 4096) = rc[i];
    }
#pragma unroll
    for (int i = 0; i < 2; ++i) *(u32x4*)(smem + 49152 + tdst + i * 4096) = rd[i];
    if (tid < 68) ((float4*)fl)[tid] = rg;
    if (c + 1 < 68) ML_LOAD(c + 1)
    __syncthreads();
    const int t = tb * 32 + fr;
    bf16x8 qf[8];
#pragma unroll
    for (int ks = 0; ks < 8; ++ks) qf[ks] = *(const bf16x8*)(smem + t * 256 + (((ks * 2 + fh) ^ sw16) << 4));
    const float bt = bs[t], ebt = ebs[t];
    f32x16 S[2];
    float dsum = 0.f;
#pragma unroll
    for (int sb = 0; sb < 2; ++sb) {
#pragma unroll
      for (int i = 0; i < 16; ++i) S[sb][i] = 0.f;
      const bool valid = (dir == 0) ? (sb <= tb) : (sb >= tb);
      if (valid) {
#pragma unroll
        for (int ks = 0; ks < 8; ++ks) {
          const bf16x8 kf = *(const bf16x8*)(smem + 16384 + (sb * 32 + fr) * 256 + (((ks * 2 + fh) ^ sw16) << 4));
          S[sb] = __builtin_amdgcn_mfma_f32_32x32x16_bf16(kf, qf[ks], S[sb], 0, 0, 0);
        }
#pragma unroll
        for (int q = 0; q < 4; ++q) {
          const float4 a4 = *(const float4*)(as_ + sb * 32 + 8 * q + 4 * fh);
          const float av[4] = {a4.x, a4.y, a4.z, a4.w};
#pragma unroll
          for (int j = 0; j < 4; ++j) {
            const int s = sb * 32 + 8 * q + 4 * fh + j;
            const bool ok = (dir == 0) ? (s <= t) : (s >= t);
            const float v = ok ? S[sb][4 * q + j] * __builtin_amdgcn_exp2f(bt + av[j]) : 0.f;
            S[sb][4 * q + j] = v;
            dsum += v;
          }
        }
      }
    }
    bf16x8 pf[4];
#pragma unroll
    for (int sb = 0; sb < 2; ++sb)
#pragma unroll
      for (int hh = 0; hh < 2; ++hh)
        pf[sb * 2 + hh] = __builtin_bit_cast(bf16x8, (u32x4){pack2(S[sb][8 * hh], S[sb][8 * hh + 1]), pack2(S[sb][8 * hh + 2], S[sb][8 * hh + 3]),
                                                                 pack2(S[sb][8 * hh + 4], S[sb][8 * hh + 5]), pack2(S[sb][8 * hh + 6], S[sb][8 * hh + 7])});
    float nq = 0.f;
#pragma unroll
    for (int c8 = 0; c8 < 8; ++c8) {
      const u32x4 qv = *(const u32x4*)(smem + t * 256 + (((fh * 8 + c8) ^ sw16) << 4));
      const float4 n0 = *(const float4*)(nprev + fh * 64 + c8 * 8), n1 = *(const float4*)(nprev + fh * 64 + c8 * 8 + 4);
      nq = fmaf(lo16(qv[0]), n0.x, nq); nq = fmaf(hi16(qv[0]), n0.y, nq); nq = fmaf(lo16(qv[1]), n0.z, nq); nq = fmaf(hi16(qv[1]), n0.w, nq);
      nq = fmaf(lo16(qv[2]), n1.x, nq); nq = fmaf(hi16(qv[2]), n1.y, nq); nq = fmaf(lo16(qv[3]), n1.z, nq); nq = fmaf(hi16(qv[3]), n1.w, nq);
    }
    dsum += __shfl_xor(dsum, 32);
    nq += __shfl_xor(nq, 32);
    const float den = dsum + ebt * nq;
    const float inv = 1.0f / fmaxf(fabsf(den), 1.0f);
    {
      f32x16 N;
#pragma unroll
      for (int i = 0; i < 16; ++i) N[i] = 0.f;
#pragma unroll
      for (int ks = 0; ks < 8; ++ks) {
        const bf16x8 cf = *(const bf16x8*)(smem + 57344 + (xb * 32 + fr) * 256 + (((ks * 2 + fh) ^ sw16) << 4));
        N = __builtin_amdgcn_mfma_f32_32x32x16_bf16(cf, qf[ks], N, 0, 0, 0);
      }
#pragma unroll
      for (int i = 0; i < 16; ++i) N[i] *= ebt;
#pragma unroll
      for (int s4 = 0; s4 < 4; ++s4) {
        const bool valid = (dir == 0) ? ((s4 >> 1) <= tb) : ((s4 >> 1) >= tb);
        if (valid) {
          const int u0 = 4 * s4 + fh, u1 = u0 + 2;
          const char* vrow = smem + 49152 + (xb * 32 + fr) * 128;
          const u32x2 v0 = *(const u32x2*)(vrow + (((u0 >> 1) ^ sw8) << 4) + (u0 & 1) * 8);
          const u32x2 v1 = *(const u32x2*)(vrow + (((u1 >> 1) ^ sw8) << 4) + (u1 & 1) * 8);
          const bf16x8 vf = __builtin_bit_cast(bf16x8, (u32x4){v0[0], v0[1], v1[0], v1[1]});
          N = __builtin_amdgcn_mfma_f32_32x32x16_bf16(vf, pf[s4], N, 0, 0, 0);
        }
      }
      bf16_t* hp = HXb + (size_t)(row0 + t) * 512 + h * 128 + (2 * ehalf + xb) * 32 + 4 * fh;
#pragma unroll
      for (int q = 0; q < 4; ++q)
        *(u32x2*)(hp + 8 * q) = (u32x2){pack2(N[4 * q] * inv, N[4 * q + 1] * inv), pack2(N[4 * q + 2] * inv, N[4 * q + 3] * inv)};
    }
    const float decay = *dec_s;
#pragma unroll
    for (int eb = 0; eb < 2; ++eb)
#pragma unroll
      for (int i = 0; i < 16; ++i) CT[eb][i] *= decay;
#pragma unroll
    for (int ks = 0; ks < 4; ++ks) {
      const u32x4 kraw = *(const u32x4*)(smem + 32768 + (w * 32 + fr) * 128 + (((ks * 2 + fh) ^ sw8) << 4));
      const float4 g0 = *(const float4*)(wgs + ks * 16 + 8 * fh), g1 = *(const float4*)(wgs + ks * 16 + 8 * fh + 4);
      const bf16x8 kts = __builtin_bit_cast(bf16x8, (u32x4){pack2(lo16(kraw[0]) * g0.x, hi16(kraw[0]) * g0.y), pack2(lo16(kraw[1]) * g0.z, hi16(kraw[1]) * g0.w),
                                                             pack2(lo16(kraw[2]) * g1.x, hi16(kraw[2]) * g1.y), pack2(lo16(kraw[3]) * g1.z, hi16(kraw[3]) * g1.w)});
#pragma unroll
      for (int eb = 0; eb < 2; ++eb) {
        const bf16x8 vt = *(const bf16x8*)(smem + 49152 + (eb * 32 + fr) * 128 + (((ks * 2 + fh) ^ sw8) << 4));
        CT[eb] = __builtin_amdgcn_mfma_f32_32x32x16_bf16(kts, vt, CT[eb], 0, 0, 0);
      }
    }
    {
      const int d = tid & 127, sh = tid >> 7;
      float a = 0.f;
#pragma unroll 8
      for (int s = sh * 32; s < sh * 32 + 32; ++s) {
        const bf16_t kv = *(const bf16_t*)(smem + 16384 + s * 256 + ((((d >> 3)) ^ (s & 15)) << 4) + (d & 7) * 2);
        a = fmaf(wgs[s], bf2f(kv), a);
      }
      npart[sh * 128 + d] = a;
    }
    __syncthreads();
#pragma unroll
    for (int eb = 0; eb < 2; ++eb)
#pragma unroll
      for (int q = 0; q < 4; ++q)
        *(u32x2*)(smem + 57344 + (eb * 32 + fr) * 256 + ((((w * 4 + q)) ^ sw16) << 4) + 8 * fh) =
            (u32x2){pack2(CT[eb][4 * q], CT[eb][4 * q + 1]), pack2(CT[eb][4 * q + 2], CT[eb][4 * q + 3])};
    if (tid < 128) nprev[tid] = decay * nprev[tid] + npart[tid] + npart[128 + tid];
  }
#undef ML_LOAD
  __syncthreads();
}

#define S5SEG 128
#define S5NSEG 34
__device__ __forceinline__ int s5_row(int dir, int step) {
  return (dir == 0) ? ((step < NCTX) ? NLAT + step : step - NCTX)
                    : ((step < NCTX) ? NLAT + (NCTX - 1 - step) : (NLAT - 1) - (step - NCTX));
}
__device__ __forceinline__ bf16x8 pack8(const float* f) {
  return __builtin_bit_cast(bf16x8, (u32x4){pack2(f[0], f[1]), pack2(f[2], f[3]), pack2(f[4], f[5]), pack2(f[6], f[7])});
}
struct S5M { float abr, abi, a128r, a128i; bf16x8 bbf[4]; };
__device__ __forceinline__ void s5m_setup(const Params& p, int pg, int lane, S5M& m) {
  const int fr = lane & 31, fh = lane >> 5;
  const float dt = expf(p.in[I_S5DT][pg]);
  m.abr = 0.f; m.abi = 0.f; m.a128r = 0.f; m.a128i = 0.f;
#pragma unroll
  for (int c = 0; c < 2; ++c) {
    const int n = fr + 32 * c;
    const float lre = p.in[I_S5LRE][pg * 64 + n], lim = p.in[I_S5LIM][pg * 64 + n];
    const float mag = expf(lre * dt);
    const float abr = mag * cosf(lim * dt), abi = mag * sinf(lim * dt);
    const float den = lre * lre + lim * lim;
    const float zr = ((abr - 1.0f) * lre + abi * lim) / den;
    const float zi = (abi * lre - (abr - 1.0f) * lim) / den;
    const float4* br4 = (const float4*)(p.in[I_S5BRE] + ((size_t)pg * 64 + n) * 16 + 8 * fh);
    const float4* bi4 = (const float4*)(p.in[I_S5BIM] + ((size_t)pg * 64 + n) * 16 + 8 * fh);
    const float4 b0 = br4[0], b1 = br4[1], c0 = bi4[0], c1 = bi4[1];
    const float br[8] = {b0.x, b0.y, b0.z, b0.w, b1.x, b1.y, b1.z, b1.w}, bi[8] = {c0.x, c0.y, c0.z, c0.w, c1.x, c1.y, c1.z, c1.w};
    float rr[8], ii[8];
#pragma unroll
    for (int j = 0; j < 8; ++j) { rr[j] = zr * br[j] - zi * bi[j]; ii[j] = zr * bi[j] + zi * br[j]; }
    m.bbf[c] = pack8(rr); m.bbf[2 + c] = pack8(ii);
    if (fh == c) {
      m.abr = abr; m.abi = abi;
      const float mg = expf(lre * dt * (float)S5SEG);
      m.a128r = mg * cosf(lim * dt * (float)S5SEG); m.a128i = mg * sinf(lim * dt * (float)S5SEG);
    }
  }
}
template <bool STORE>
__device__ __forceinline__ void s5m_block(const S5M& m, const bf16x8 uf, float& xr, float& xi, char* xs, int lane) {
  f32x16 T[4];
#pragma unroll
  for (int k = 0; k < 4; ++k) {
#pragma unroll
    for (int i = 0; i < 16; ++i) T[k][i] = 0.f;
    T[k] = __builtin_amdgcn_mfma_f32_32x32x16_bf16(uf, m.bbf[k], T[k], 0, 0, 0);
  }
#pragma unroll
  for (int r = 0; r < 16; ++r) {
    auto a = __builtin_amdgcn_permlane32_swap(__float_as_uint(T[0][r]), __float_as_uint(T[1][r]), false, false);
    T[0][r] = __uint_as_float(a[0]); T[1][r] = __uint_as_float(a[1]);
    auto b = __builtin_amdgcn_permlane32_swap(__float_as_uint(T[2][r]), __float_as_uint(T[3][r]), false, false);
    T[2][r] = __uint_as_float(b[0]); T[3][r] = __uint_as_float(b[1]);
  }
#pragma unroll
  for (int q = 0; q < 4; ++q)
#pragma unroll
    for (int hh = 0; hh < 2; ++hh)
#pragma unroll
      for (int j = 0; j < 4; ++j) {
        const int t = 8 * q + 4 * hh + j, r = 4 * q + j;
        const float bre = hh ? T[1][r] : T[0][r], bim = hh ? T[3][r] : T[2][r];
        const float nr = fmaf(m.abr, xr, fmaf(-m.abi, xi, bre));
        const float ni = fmaf(m.abr, xi, fmaf(m.abi, xr, bim));
        xr = nr; xi = ni;
        if (STORE) *(unsigned*)(xs + t * 256 + (((lane >> 2) ^ (t & 15)) << 4) + (lane & 3) * 4) = pack2(xr, xi);
      }
}
__device__ __forceinline__ void stage_s5_pass1(const Params& p, int l, const bf16_t* Z, float* XE) {
  const int tid = otid(), w = tid >> 6, lane = tid & 63, fr = lane & 31, fh = lane >> 5;
  const int nitems = GB * 32 * 2 * (S5NSEG - 1);
  for (int idx = blockIdx.x * 4 + w; idx < nitems; idx += gridDim.x * 4) {
    const int seg = idx % (S5NSEG - 1), r1 = idx / (S5NSEG - 1), dir = r1 & 1, g = (r1 >> 1) & 31, bl = r1 >> 6;
    S5M m;
    s5m_setup(p, (l * 2 + dir) * 32 + g, lane, m);
    float xr = 0.f, xi = 0.f;
    bf16x8 ufs[S5SEG / 32];
#pragma unroll
    for (int sub = 0; sub < S5SEG / 32; ++sub) {
      const int row = s5_row(dir, seg * S5SEG + sub * 32 + fr);
      ufs[sub] = *(const bf16x8*)(Z + ((size_t)bl * NTOK + row) * ZW + 3072 + g * 16 + 8 * fh);
    }
#pragma unroll
    for (int sub = 0; sub < S5SEG / 32; ++sub) s5m_block<false>(m, ufs[sub], xr, xi, nullptr, lane);
    float* xe = XE + ((((size_t)bl * 32 + g) * 2 + dir) * (S5NSEG - 1) + seg) * 128;
    xe[lane] = xr; xe[64 + lane] = xi;
  }
}
__device__ __forceinline__ void s5_item(const Params& p, int l, const bf16_t* Zb, const float* XEc, float* Yb, int g, int dir, int sq, char* smem) {
  const int tid = otid(), w = tid >> 6, lane = tid & 63, fr = lane & 31, fh = lane >> 5;
  const int seg = sq * 4 + w;
  char* xs = smem + w * 8192;
  const int pg = (l * 2 + dir) * 32 + g;
  __syncthreads();
  if (seg < S5NSEG) {
    S5M m;
    s5m_setup(p, pg, lane, m);
    bf16x8 ccf[8];
#pragma unroll
    for (int ks = 0; ks < 8; ++ks) {
      float f[8] = {0.f, 0.f, 0.f, 0.f, 0.f, 0.f, 0.f, 0.f};
      if (fr < 16) {
        const float4 cr = *(const float4*)(p.in[I_S5CRE] + ((size_t)pg * 16 + fr) * 64 + ks * 8 + 4 * fh);
        const float4 ci = *(const float4*)(p.in[I_S5CIM] + ((size_t)pg * 16 + fr) * 64 + ks * 8 + 4 * fh);
        f[0] = cr.x; f[1] = -ci.x; f[2] = cr.y; f[3] = -ci.y; f[4] = cr.z; f[5] = -ci.z; f[6] = cr.w; f[7] = -ci.w;
      }
      ccf[ks] = pack8(f);
    }
    float xr = 0.f, xi = 0.f;
    for (int j = 0; j < seg; ++j) {
      const float er = XEc[j * 128 + lane], ei = XEc[j * 128 + 64 + lane];
      const float nr = m.a128r * xr - m.a128i * xi + er, ni = m.a128r * xi + m.a128i * xr + ei;
      xr = nr; xi = ni;
    }
    bf16x8 ufs[S5SEG / 32];
#pragma unroll
    for (int sub = 0; sub < S5SEG / 32; ++sub) {
      const int row = s5_row(dir, seg * S5SEG + sub * 32 + fr);
      ufs[sub] = *(const bf16x8*)(Zb + (size_t)row * ZW + 3072 + g * 16 + 8 * fh);
    }
#pragma unroll
    for (int sub = 0; sub < S5SEG / 32; ++sub) {
      const int row = s5_row(dir, seg * S5SEG + sub * 32 + fr);
      const bf16x8 uf = ufs[sub];
      s5m_block<true>(m, uf, xr, xi, xs, lane);
      f32x16 Y;
#pragma unroll
      for (int i = 0; i < 16; ++i) Y[i] = 0.f;
#pragma unroll
      for (int ks = 0; ks < 8; ++ks) {
        const bf16x8 xf = *(const bf16x8*)(xs + fr * 256 + (((ks * 2 + fh) ^ (fr & 15)) << 4));
        Y = __builtin_amdgcn_mfma_f32_32x32x16_bf16(ccf[ks], xf, Y, 0, 0, 0);
      }
      float* yp = Yb + (size_t)row * 512 + g * 16 + 4 * fh;
      *(float4*)yp = make_float4(Y[0], Y[1], Y[2], Y[3]);
      *(float4*)(yp + 8) = make_float4(Y[4], Y[5], Y[6], Y[7]);
    }
  }
}

__device__ __forceinline__ void stage_post(const Params& p, int l, int rr_lim, const bf16_t* Z, const bf16_t* HF, const bf16_t* HB,
                                           const float* YSF, const float* YSB, bf16_t* YB, bf16_t* GG) {
  const int tid = otid();
  const int c0 = tid * 2;
  const float2 gml = *(const float2*)(p.in[I_MLNG] + l * 512 + c0);
  const float2 dsk = *(const float2*)(p.in[I_S5D] + l * 512 + c0);
  const int n = GB * rr_lim;
  for (int i0 = blockIdx.x * 4; i0 < n; i0 += gridDim.x * 4) {
    unsigned a0[4], a1[4], og[4], uu[4];
    float2 f[4], b[4];
    size_t r[4];
#pragma unroll
    for (int u = 0; u < 4; ++u) {
      const int i = i0 + u;
      r[u] = (size_t)(i / rr_lim) * NTOK + (i % rr_lim);
      a0[u] = *(const unsigned*)(HF + r[u] * 512 + c0); a1[u] = *(const unsigned*)(HB + r[u] * 512 + c0);
      og[u] = *(const unsigned*)(Z + r[u] * ZW + 2560 + c0); uu[u] = *(const unsigned*)(Z + r[u] * ZW + 3072 + c0);
      f[u] = *(const float2*)(YSF + r[u] * 512 + c0); b[u] = *(const float2*)(YSB + r[u] * 512 + c0);
    }
#pragma unroll
    for (int u = 0; u < 4; ++u) {
      const float h0 = lo16(a0[u]) + lo16(a1[u]), h1 = hi16(a0[u]) + hi16(a1[u]);
      const float ss = wave_sum(h0 * h0 + h1 * h1);
      const float rs = rsqrtf(ss * (1.0f / 128.0f) + EPSF);
      *(unsigned*)(YB + r[u] * 512 + c0) = pack2(h0 * rs * gml.x * sigmoidf_(lo16(og[u])), h1 * rs * gml.y * sigmoidf_(hi16(og[u])));
      *(unsigned*)(GG + r[u] * 512 + c0) = pack2(geluf_(dsk.x * lo16(uu[u]) + f[u].x + b[u].x), geluf_(dsk.y * hi16(uu[u]) + f[u].y + b[u].y));
    }
  }
}

__device__ __forceinline__ void stage_glu_mfma(const Params& p, int l, int tpb, const bf16_t* GG, const bf16_t* GLUT, bf16_t* YS, char* smem) {
  EPI_DECL
  const int tm = GB * tpb;
  TileIter ti(tm, 4);
  int mt_, nt_; bool valid;
  while (ti.next(mt_, nt_, valid)) {
    if (!valid) continue;
    const int m0 = MT_LR0(mt_, tpb), n0 = nt_ * 128;
    f32x16 acc[2][2];
    gemm_tile(GG + (size_t)m0 * 512, 512, GLUT + (size_t)n0 * 512, 512, 512, smem, acc);
#pragma unroll
    for (int mi = 0; mi < 2; ++mi)
#pragma unroll
      for (int ni = 0; ni < 2; ++ni)
#pragma unroll
        for (int q = 0; q < 4; ++q) {
          const int row = m0 + EPI_ROW(mi), c = n0 + EPI_COL(ni, q);
          const float4 b = *(const float4*)(p.in[I_GLUB] + l * 512 + c);
          const u32x2 g2 = *(const u32x2*)(GG + (size_t)row * 512 + c);
          const float o0 = lo16(g2[0]) * sigmoidf_(acc[mi][ni][4 * q] + b.x), o1 = hi16(g2[0]) * sigmoidf_(acc[mi][ni][4 * q + 1] + b.y);
          const float o2 = lo16(g2[1]) * sigmoidf_(acc[mi][ni][4 * q + 2] + b.z), o3 = hi16(g2[1]) * sigmoidf_(acc[mi][ni][4 * q + 3] + b.w);
          *(u32x2*)(YS + (size_t)row * 512 + c) = (u32x2){pack2(o0, o1), pack2(o2, o3)};
        }
  }
}

__device__ __forceinline__ void stage_merge_mfma(int tpb, const bf16_t* YA, const bf16_t* YB, const bf16_t* YS, const bf16_t* WBR, const bf16_t* Z, bf16_t* MG, char* smem) {
  EPI_DECL
  const int tm = GB * tpb;
  TileIter ti(tm, 8);
  int mt_, nt_; bool valid;
  while (ti.next(mt_, nt_, valid)) {
    if (!valid) continue;
    const int m0 = MT_LR0(mt_, tpb), n0 = nt_ * 128;
    f32x16 macc[2][2];
#pragma unroll
    for (int a = 0; a < 2; ++a)
#pragma unroll
      for (int b = 0; b < 2; ++b)
#pragma unroll
        for (int i = 0; i < 16; ++i) macc[a][b][i] = 0.f;
#pragma unroll 1
    for (int r = 0; r < 3; ++r) {
      const bf16_t* Y = (r == 0) ? YA : (r == 1 ? YB : YS);
      f32x16 acc[2][2];
      gemm_tile(Y + (size_t)m0 * 512, 512, WBR + (size_t)r * 1024 * 512 + (size_t)n0 * 512, 512, 512, smem, acc);
#pragma unroll
      for (int mi = 0; mi < 2; ++mi)
#pragma unroll
        for (int ni = 0; ni < 2; ++ni)
#pragma unroll
          for (int q = 0; q < 4; ++q) {
            const int row = m0 + EPI_ROW(mi), c = n0 + EPI_COL(ni, q);
            const u32x2 e = *(const u32x2*)(Z + (size_t)row * ZW + 3584 + r * 1024 + c);
            macc[mi][ni][4 * q] += lo16(e[0]) * acc[mi][ni][4 * q];
            macc[mi][ni][4 * q + 1] += hi16(e[0]) * acc[mi][ni][4 * q + 1];
            macc[mi][ni][4 * q + 2] += lo16(e[1]) * acc[mi][ni][4 * q + 2];
            macc[mi][ni][4 * q + 3] += hi16(e[1]) * acc[mi][ni][4 * q + 3];
          }
    }
#pragma unroll
    for (int mi = 0; mi < 2; ++mi)
#pragma unroll
      for (int ni = 0; ni < 2; ++ni)
#pragma unroll
        for (int q = 0; q < 4; ++q) {
          const int row = m0 + EPI_ROW(mi), c = n0 + EPI_COL(ni, q);
          *(u32x2*)(MG + (size_t)row * DM + c) = (u32x2){pack2(macc[mi][ni][4 * q], macc[mi][ni][4 * q + 1]), pack2(macc[mi][ni][4 * q + 2], macc[mi][ni][4 * q + 3])};
        }
  }
}

__device__ __forceinline__ void stage_outproj_mfma(const Params& p, int l, int g, int tpb, const bf16_t* MG, const bf16_t* WOUT, char* smem) {
  EPI_DECL
  const int tm = GB * tpb;
  const float* mod = (const float*)(p.ws + WB_MOD) + (size_t)l * 9 * 6144;
  TileIter ti(tm, 8);
  int mt, nt_; bool valid;
  while (ti.next(mt, nt_, valid)) {
    if (!valid) continue;
    const int n0 = nt_ * 128;
    const int m0 = MT_LR0(mt, tpb), bl = mt / tpb, rr0 = (mt % tpb) * 128, b = g * GB + bl;
    f32x16 acc[2][2];
    gemm_tile(MG + (size_t)m0 * DM, DM, WOUT + (size_t)n0 * DM, DM, DM, smem, acc);
    const float* gv = mod + (size_t)((rr0 < NLAT) ? b : 8) * 6144 + 2 * 1024;
#pragma unroll
    for (int mi = 0; mi < 2; ++mi)
#pragma unroll
      for (int ni = 0; ni < 2; ++ni)
#pragma unroll
        for (int q = 0; q < 4; ++q) {
          const int rr = rr0 + EPI_ROW(mi), c = n0 + EPI_COL(ni, q);
          const float4 gg = *(const float4*)(gv + c);
          float4* xp = (float4*)(xrow(p, b, rr) + c);
          float4 x = (l == 0) ? *(const float4*)(xrow_in(p, b, rr) + c) : *xp;
          x.x += gg.x * acc[mi][ni][4 * q]; x.y += gg.y * acc[mi][ni][4 * q + 1]; x.z += gg.z * acc[mi][ni][4 * q + 2]; x.w += gg.w * acc[mi][ni][4 * q + 3];
          *xp = x;
        }
  }
}

#define CH_SW(m_, chunk_) ((((chunk_) ^ ((m_) & 15))) << 4)
template <int KC, bool X2, class BF, class AF, class PF, class EF>
__device__ __forceinline__ void cphase(const int nseg, const int lane, const bf16_t* __restrict__ Wb, BF bofs, AF abase, PF pre, EF epi) {
  const int half = lane >> 5, m = lane & 31, sw = lane & 15, sw2 = lane & 1;
  bf16x8 bs[4][2][4];
  const int S = nseg * KC;
  const int crot = ((blockIdx.x >> 3) * 3 + (otid() >> 6) * 5) & (KC - 1);
#define CH_LD(ST, s_) { const int sg_ = (s_) / KC, c_ = ((s_) + crot) % KC; unsigned o0_ = bofs(sg_) + 4096u * c_ + lane * 16; asm volatile("" : "+v"(o0_)); \
    unsigned o1_ = o0_ + KC * 4096u; asm volatile("" : "+v"(o1_)); \
    _Pragma("unroll") for (int ks_ = 0; ks_ < 4; ++ks_) { bs[ST][0][ks_] = *(const bf16x8*)((const char*)Wb + o0_ + 1024 * ks_); bs[ST][1][ks_] = *(const bf16x8*)((const char*)Wb + o1_ + 1024 * ks_); } }
#define CH_LA(DST, s_) { const int sg_ = (s_) / KC, c_ = ((s_) + crot) % KC; const char* ab_ = abase(sg_); \
    _Pragma("unroll") for (int ks_ = 0; ks_ < 4; ++ks_) DST[ks_] = *(const bf16x8*)(ab_ + m * (KC * 128) + (((8 * c_ + 4 * half + ks_) ^ sw) << 4)); }
#define CH_LA2(DST2, s_) { const int sg_ = (s_) / KC, c_ = ((s_) + crot) % KC; const char* ab_ = abase(sg_); \
    _Pragma("unroll") for (int ks_ = 0; ks_ < 4; ++ks_) DST2[ks_] = *(const bf16x8*)(ab_ + (32 + sw2) * (KC * 128) + (((8 * c_ + 4 * half + ks_) ^ sw2) << 4)); }
  CH_LD(0, 0) CH_LD(1, 1) CH_LD(2, 2)
  bf16x8 ac[4];
  CH_LA(ac, 0)
  f32x16 acc[2], acc2[2];
#pragma unroll
  for (int f = 0; f < 2; ++f)
#pragma unroll
    for (int i = 0; i < 16; ++i) { acc[f][i] = 0.f; acc2[f][i] = 0.f; }
#pragma unroll 1
  for (int s0 = 0; s0 < S; s0 += 4) {
#pragma unroll
    for (int j = 0; j < 4; ++j) {
      const int s = s0 + j;
      if (s + 3 < S) CH_LD((j + 3) & 3, s + 3)
      bf16x8 an[4], ac2[4];
      if (X2) CH_LA2(ac2, s)
      { const int sn = (s + 1 < S) ? s + 1 : s; CH_LA(an, sn) }
      const int sg = s / KC, c = s % KC;
#pragma unroll
      for (int ks = 0; ks < 4; ++ks)
#pragma unroll
        for (int f = 0; f < 2; ++f) acc[f] = __builtin_amdgcn_mfma_f32_32x32x16_bf16(bs[j][f][ks], ac[ks], acc[f], 0, 0, 0);
      if (X2) {
#pragma unroll
        for (int ks = 0; ks < 4; ++ks)
#pragma unroll
          for (int f = 0; f < 2; ++f) acc2[f] = __builtin_amdgcn_mfma_f32_32x32x16_bf16(bs[j][f][ks], ac2[ks], acc2[f], 0, 0, 0);
      }
      if (j == 3 && c == KC - 5) pre(sg);
      if (j == 3 && c == KC - 1) {
        epi(sg, acc, acc2);
#pragma unroll
        for (int f = 0; f < 2; ++f)
#pragma unroll
          for (int i = 0; i < 16; ++i) { acc[f][i] = 0.f; acc2[f][i] = 0.f; }
      }
#pragma unroll
      for (int ks = 0; ks < 4; ++ks) ac[ks] = an[ks];
    }
  }
#undef CH_LD
#undef CH_LA
#undef CH_LA2
}

template <bool X2>
__device__ __forceinline__ void stage_chain1(const Params& p, int l, int g, const bf16_t* Z, const bf16_t* HF, const bf16_t* HB,
                                             const float* YSF, const float* YSB, const bf16_t* YA, bf16_t* MG, bf16_t* H2, const bf16_t* W, char* smem) {
  constexpr int RT = X2 ? 34 : 32;
#define CH_LANE const int tid = otid(), w = tid >> 6, lane = tid & 63, m = lane & 31, half = lane >> 5, m2 = 32 + (lane & 1), rot = blockIdx.x >> 3; const bool v2 = X2 && m < 2; \
    (void)w; (void)m; (void)half; (void)m2; (void)rot; (void)v2;
  const int tpb = (X2 ? NTOK : NLAT) / RT, ntile = GB * tpb;
  const float* mod = (const float*)(p.ws + WB_MOD) + (size_t)l * 9 * 6144;
  const bf16_t* GLUT = W + WT_GLU; const bf16_t* WBR = W + WT_WBR; const bf16_t* WOUT = W + WT_WOUT;
  char* R0 = smem; char* R1 = smem + RT * 1024; char* R2 = smem + 2 * RT * 1024;
  for (int t = blockIdx.x; t < ntile; t += gridDim.x) {
#define CH_TILE int t_ = t; asm volatile("" : "+s"(t_)); const int bl = t_ / tpb, rr0 = (t_ % tpb) * RT, b = g * GB + bl; const size_t lr0 = (size_t)bl * NTOK + rr0; (void)b; (void)lr0; (void)rr0;
    __syncthreads();
    for (int i0 = 0; i0 < RT; i0 += 8) {
      CH_TILE
      CH_LANE
      const int c0 = tid * 2;
      const float2 gml = *(const float2*)(p.in[I_MLNG] + l * 512 + c0);
      const float2 dsk = *(const float2*)(p.in[I_S5D] + l * 512 + c0);
      unsigned a0[8], a1[8], og[8], uu[8];
      float2 f[8], bb[8];
#pragma unroll
      for (int u = 0; u < 8; ++u) {
        const int mm = (i0 + u < RT) ? i0 + u : RT - 1;
        const size_t r = lr0 + mm;
        a0[u] = *(const unsigned*)(HF + r * 512 + c0); a1[u] = *(const unsigned*)(HB + r * 512 + c0);
        og[u] = *(const unsigned*)(Z + r * ZW + 2560 + c0); uu[u] = *(const unsigned*)(Z + r * ZW + 3072 + c0);
        f[u] = *(const float2*)(YSF + r * 512 + c0); bb[u] = *(const float2*)(YSB + r * 512 + c0);
      }
#pragma unroll
      for (int u = 0; u < 8; ++u) {
        const float h0 = lo16(a0[u]) + lo16(a1[u]), h1 = hi16(a0[u]) + hi16(a1[u]);
        const float ss = wave_sum(h0 * h0 + h1 * h1);
        const float rs = rsqrtf(ss * (1.0f / 128.0f) + EPSF);
        const int mm = (i0 + u < RT) ? i0 + u : RT - 1, off = mm * 1024 + CH_SW(mm, c0 >> 3) + (c0 & 7) * 2;
        *(unsigned*)(R1 + off) = pack2(h0 * rs * gml.x * sigmoidf_(lo16(og[u])), h1 * rs * gml.y * sigmoidf_(hi16(og[u])));
        *(unsigned*)(R0 + off) = pack2(geluf_(dsk.x * lo16(uu[u]) + f[u].x + bb[u].x), geluf_(dsk.y * hi16(uu[u]) + f[u].y + bb[u].y));
      }
    }
    __syncthreads();
    {
      CH_LANE
      float4 bv[2][4];
      cphase<8, X2>(2, lane, GLUT,
        [&](int sg) __attribute__((always_inline)) { const int cb = (w * 2 + sg + rot) & 7; return (unsigned)(cb * 2) * (8u * 4096u); },
        [&](int sg) __attribute__((always_inline)) { return (const char*)R0; },
        [&](int sg) __attribute__((always_inline)) {
          const int n0 = ((w * 2 + sg + rot) & 7) * 64;
#pragma unroll
          for (int f = 0; f < 2; ++f)
#pragma unroll
            for (int q = 0; q < 4; ++q) bv[f][q] = *(const float4*)(p.in[I_GLUB] + l * 512 + n0 + f * 32 + 8 * q + 4 * half);
        },
        [&](int sg, f32x16 (&acc)[2], f32x16 (&acc2)[2]) __attribute__((always_inline)) {
          const int n0 = ((w * 2 + sg + rot) & 7) * 64;
          auto body = [&](f32x16 (&a)[2], int mr) __attribute__((always_inline)) {
#pragma unroll
            for (int f = 0; f < 2; ++f)
#pragma unroll
              for (int q = 0; q < 4; ++q) {
                const int c = n0 + f * 32 + 8 * q + 4 * half;
                const int off = mr * 1024 + CH_SW(mr, c >> 3) + 8 * half;
                const u32x2 g2 = *(const u32x2*)(R0 + off);
                const float o0 = lo16(g2[0]) * sigmoidf_(a[f][4 * q] + bv[f][q].x), o1 = hi16(g2[0]) * sigmoidf_(a[f][4 * q + 1] + bv[f][q].y);
                const float o2 = lo16(g2[1]) * sigmoidf_(a[f][4 * q + 2] + bv[f][q].z), o3 = hi16(g2[1]) * sigmoidf_(a[f][4 * q + 3] + bv[f][q].w);
                *(u32x2*)(R2 + off) = (u32x2){pack2(o0, o1), pack2(o2, o3)};
              }
          };
          body(acc, m);
          if (v2) body(acc2, m2);
        });
    }
    __syncthreads();
    for (int i = otid(); i < RT * 64; i += 256) {
      CH_TILE
      const int mm = i >> 6, ch = i & 63;
      *(u32x4*)(R0 + mm * 1024 + CH_SW(mm, ch)) = *(const u32x4*)(YA + (lr0 + mm) * 512 + ch * 8);
    }
    __syncthreads();
    {
      CH_TILE
      CH_LANE
      f32x16 macc[2], macc2[2];
#pragma unroll
      for (int f = 0; f < 2; ++f)
#pragma unroll
        for (int i = 0; i < 16; ++i) { macc[f][i] = 0.f; macc2[f][i] = 0.f; }
      u32x2 e[2][4], e2[2][4];
      const size_t row = lr0 + m, row2 = lr0 + m2;
      cphase<8, X2>(12, lane, WBR,
        [&](int sg) __attribute__((always_inline)) { const int pass = sg / 3, r = sg % 3, cb = (w * 4 + pass + rot) & 15; return (unsigned)r * (1024u * 512u * 2u) + (unsigned)(cb * 2) * (8u * 4096u); },
        [&](int sg) __attribute__((always_inline)) { const int r = sg % 3; return (const char*)(smem + r * (RT * 1024)); },
        [&](int sg) __attribute__((always_inline)) {
          const int pass = sg / 3, r = sg % 3, n0 = ((w * 4 + pass + rot) & 15) * 64;
#pragma unroll
          for (int f = 0; f < 2; ++f)
#pragma unroll
            for (int q = 0; q < 4; ++q) {
              e[f][q] = *(const u32x2*)(Z + row * ZW + 3584 + r * 1024 + n0 + f * 32 + 8 * q + 4 * half);
            }
        },
        [&](int sg, f32x16 (&acc)[2], f32x16 (&acc2)[2]) __attribute__((always_inline)) {
          const int pass = sg / 3, r = sg % 3, n0 = ((w * 4 + pass + rot) & 15) * 64;
          auto body = [&](f32x16 (&a)[2], f32x16 (&ma)[2], u32x2 (&ee)[2][4], size_t rw, bool valid) __attribute__((always_inline)) {
#pragma unroll
            for (int f = 0; f < 2; ++f)
#pragma unroll
              for (int q = 0; q < 4; ++q) {
                ma[f][4 * q] += lo16(ee[f][q][0]) * a[f][4 * q];
                ma[f][4 * q + 1] += hi16(ee[f][q][0]) * a[f][4 * q + 1];
                ma[f][4 * q + 2] += lo16(ee[f][q][1]) * a[f][4 * q + 2];
                ma[f][4 * q + 3] += hi16(ee[f][q][1]) * a[f][4 * q + 3];
              }
            if (r == 2) {
              if (valid) {
#pragma unroll
                for (int f = 0; f < 2; ++f)
#pragma unroll
                  for (int q = 0; q < 4; ++q) {
                    const int c = n0 + f * 32 + 8 * q + 4 * half;
                    *(u32x2*)(MG + rw * DM + c) = (u32x2){pack2(ma[f][4 * q], ma[f][4 * q + 1]), pack2(ma[f][4 * q + 2], ma[f][4 * q + 3])};
                  }
              }
#pragma unroll
              for (int f = 0; f < 2; ++f)
#pragma unroll
                for (int i = 0; i < 16; ++i) ma[f][i] = 0.f;
            }
          };
          body(acc, macc, e, row, true);
          if (X2) {
#pragma unroll
            for (int f = 0; f < 2; ++f)
#pragma unroll
              for (int q = 0; q < 4; ++q) e2[f][q] = *(const u32x2*)(Z + row2 * ZW + 3584 + r * 1024 + n0 + f * 32 + 8 * q + 4 * half);
            body(acc2, macc2, e2, row2, v2);
          }
        });
    }
    __syncthreads();
    for (int i = otid(); i < RT * 128; i += 256) {
      CH_TILE
      const int mm = i >> 7, ch = i & 127;
      *(u32x4*)(smem + mm * 2048 + CH_SW(mm, ch)) = *(const u32x4*)(MG + (lr0 + mm) * DM + ch * 8);
    }
    __syncthreads();
    {
      CH_TILE
      CH_LANE
      const int rr = rr0 + m, rr2 = rr0 + m2;
      const float* gv = mod + (size_t)((rr < NLAT) ? b : 8) * 6144 + 2 * 1024;
      const float* gv2 = mod + (size_t)((rr2 < NLAT) ? b : 8) * 6144 + 2 * 1024;
      float4 xx[2][4];
      cphase<16, X2>(4, lane, WOUT,
        [&](int sg) __attribute__((always_inline)) { const int cb = (w * 4 + sg + rot) & 15; return (unsigned)(cb * 2) * (16u * 4096u); },
        [&](int sg) __attribute__((always_inline)) { return (const char*)smem; },
        [&](int sg) __attribute__((always_inline)) {
          const int n0 = ((w * 4 + sg + rot) & 15) * 64;
#pragma unroll
          for (int f = 0; f < 2; ++f)
#pragma unroll
            for (int q = 0; q < 4; ++q) {
              const int c = n0 + f * 32 + 8 * q + 4 * half;
              xx[f][q] = (l == 0) ? *(const float4*)(xrow_in(p, b, rr) + c) : *(const float4*)(xrow(p, b, rr) + c);
            }
        },
        [&](int sg, f32x16 (&acc)[2], f32x16 (&acc2)[2]) __attribute__((always_inline)) {
          const int n0 = ((w * 4 + sg + rot) & 15) * 64;
#pragma unroll
          for (int f = 0; f < 2; ++f)
#pragma unroll
            for (int q = 0; q < 4; ++q) {
              const int c = n0 + f * 32 + 8 * q + 4 * half;
              float4 x = xx[f][q];
              const float4 gg = *(const float4*)(gv + c);
              x.x += gg.x * acc[f][4 * q]; x.y += gg.y * acc[f][4 * q + 1]; x.z += gg.z * acc[f][4 * q + 2]; x.w += gg.w * acc[f][4 * q + 3];
              *(float4*)(xrow(p, b, rr) + c) = x;
            }
          if (v2) {
#pragma unroll
            for (int f = 0; f < 2; ++f)
#pragma unroll
              for (int q = 0; q < 4; ++q) {
                const int c = n0 + f * 32 + 8 * q + 4 * half;
                const float4 gg = *(const float4*)(gv2 + c);
                float4 x = (l == 0) ? *(const float4*)(xrow_in(p, b, rr2) + c) : *(const float4*)(xrow(p, b, rr2) + c);
                x.x += gg.x * acc2[f][4 * q]; x.y += gg.y * acc2[f][4 * q + 1]; x.z += gg.z * acc2[f][4 * q + 2]; x.w += gg.w * acc2[f][4 * q + 3];
                *(float4*)(xrow(p, b, rr2) + c) = x;
              }
          }
        });
    }
    __syncthreads();
    {
      CH_TILE
      CH_LANE
      const float* ng = p.in[I_N2G] + l * DM;
#pragma unroll 1
      for (int i0 = w * 2; i0 < RT; i0 += 8) {
        float4 v[2][4];
#pragma unroll
        for (int u = 0; u < 2; ++u) {
          const float4* X = (const float4*)xrow(p, b, rr0 + i0 + u);
#pragma unroll
          for (int q = 0; q < 4; ++q) v[u][q] = X[q * 64 + lane];
        }
#pragma unroll
        for (int u = 0; u < 2; ++u) {
          float s = 0.f;
#pragma unroll
          for (int q = 0; q < 4; ++q) s += v[u][q].x * v[u][q].x + v[u][q].y * v[u][q].y + v[u][q].z * v[u][q].z + v[u][q].w * v[u][q].w;
          s = wave_sum(s);
          const float rs = rsqrtf(s * (1.0f / DM) + EPSF);
          const float* mm_ = mod + (size_t)((rr0 + i0 + u < NLAT) ? b : 8) * 6144;
          u32x2* hp = (u32x2*)(H2 + (lr0 + i0 + u) * DM);
#pragma unroll
          for (int q = 0; q < 4; ++q) {
            const float4 gg = ((const float4*)ng)[q * 64 + lane];
            const float4 sc = ((const float4*)(mm_ + 4096))[q * 64 + lane];
            const float4 sh = ((const float4*)(mm_ + 3072))[q * 64 + lane];
            const float4 x = v[u][q];
            hp[q * 64 + lane] = (u32x2){pack2(x.x * rs * gg.x * (1.f + sc.x) + sh.x, x.y * rs * gg.y * (1.f + sc.y) + sh.y),
                                        pack2(x.z * rs * gg.z * (1.f + sc.z) + sh.z, x.w * rs * gg.w * (1.f + sc.w) + sh.w)};
          }
        }
      }
    }
#undef CH_TILE
#undef CH_LANE
  }
}

__device__ __forceinline__ void stage_peerq_mfma(int tpb, const bf16_t* H2, const bf16_t* WQ, bf16_t* PQ, char* smem) {
  EPI_DECL
  const int tm = GB * tpb;
  TileIter ti(tm, 16);
  int mt_, nt_; bool valid;
  while (ti.next(mt_, nt_, valid)) {
    if (!valid) continue;
    const int m0 = MT_LR0(mt_, tpb), n0 = nt_ * 128;
    f32x16 acc[2][2];
    gemm_tile(H2 + (size_t)m0 * DM, DM, WQ + (size_t)n0 * DM, DM, DM, smem, acc);
#pragma unroll
    for (int mi = 0; mi < 2; ++mi)
#pragma unroll
      for (int ni = 0; ni < 2; ++ni)
#pragma unroll
        for (int q = 0; q < 4; ++q) {
          const int row = m0 + EPI_ROW(mi), c = n0 + EPI_COL(ni, q);
          *(u32x2*)(PQ + (size_t)row * 2048 + c) = (u32x2){pack2(acc[mi][ni][4 * q], acc[mi][ni][4 * q + 1]), pack2(acc[mi][ni][4 * q + 2], acc[mi][ni][4 * q + 3])};
        }
  }
}

__device__ __forceinline__ unsigned f2sortable(float x) { const unsigned u = __float_as_uint(x); return (u & 0x80000000u) ? ~u : (u | 0x80000000u); }
__device__ __forceinline__ float sortable2f(unsigned k) { return __uint_as_float((k & 0x80000000u) ? (k & 0x7fffffffu) : ~k); }
#define TOPK_INSERT(v, key) { unsigned t_ = (key); _Pragma("unroll") for (int s_ = 0; s_ < 16; ++s_) { const unsigned hi_ = max(v[s_], t_); t_ = min(v[s_], t_); v[s_] = hi_; } }
__device__ __forceinline__ void stage_scores_topk(int tpb, const bf16_t* PQ, const bf16_t* SUBK, int* EI, float* EG, char* smem) {
  EPI_DECL
  const int tid = tid_;
  const int item = tid & 127, kpart = tid >> 7;
  float* S = (float*)smem;
  unsigned* xk = (unsigned*)(smem + 128 * 129 * 4);
  const int tm = GB * tpb * 8;
  for (int mt = blockIdx.x; mt < tm; mt += gridDim.x) {
    const size_t m0 = (size_t)MT_LR0(mt >> 3, tpb) * 8 + (size_t)(mt & 7) * 128;
    unsigned vh[2][16];
#pragma unroll
    for (int half = 0; half < 2; ++half) {
      f32x16 acc[2][2];
      gemm_tile(PQ + m0 * 256 + half * 128, 256, SUBK + (size_t)half * 16384, 128, 128, smem, acc);
#pragma unroll
      for (int mi = 0; mi < 2; ++mi)
#pragma unroll
        for (int ni = 0; ni < 2; ++ni)
#pragma unroll
          for (int i = 0; i < 16; ++i)
            S[EPI_ROW(mi) * 129 + wn * 64 + ni * 32 + 8 * (i >> 2) + 4 * fh + (i & 3)] = acc[mi][ni][i];
      __syncthreads();
      unsigned v[16];
#pragma unroll
      for (int s = 0; s < 16; ++s) v[s] = 0u;
      const float* sr = S + item * 129 + kpart * 64;
#pragma unroll 8
      for (int k = 0; k < 64; ++k) {
        const unsigned key = (f2sortable(sr[k]) & ~127u) | (unsigned)(127 - (kpart * 64 + k));
        TOPK_INSERT(v, key)
      }
      if (kpart == 1) {
#pragma unroll
        for (int s = 0; s < 16; ++s) xk[item * 17 + s] = v[s];
      }
      __syncthreads();
      if (kpart == 0) {
#pragma unroll
        for (int s = 0; s < 16; ++s) { const unsigned key = xk[item * 17 + s]; TOPK_INSERT(v, key) }
      }
#pragma unroll
      for (int s = 0; s < 16; ++s) vh[half][s] = v[s];
      __syncthreads();
    }
    if (kpart == 0) {
      float v1[16], v2[16];
#pragma unroll
      for (int s = 0; s < 16; ++s) { v1[s] = sortable2f((vh[0][s] & ~127u) | 64u); v2[s] = sortable2f((vh[1][s] & ~127u) | 64u); }
      unsigned c[16];
#pragma unroll
      for (int s = 0; s < 16; ++s) c[s] = 0u;
      {
        int o = 0;
#pragma unroll
        for (int i = 0; i < 16; ++i)
#pragma unroll
          for (int j = 0; j < 16 / (i + 1); ++j) {
            const unsigned key = (f2sortable(v1[i] + v2[j]) & ~63u) | (unsigned)(63 - o);
            TOPK_INSERT(c, key)
            ++o;
          }
      }
      const float vmax = sortable2f((c[0] & ~63u) | 32u);
      float sum = 0.f;
#pragma unroll
      for (int s = 0; s < 16; ++s) sum += expf(sortable2f((c[s] & ~63u) | 32u) - vmax);
      const float isum = 1.0f / sum;
      const unsigned thr = c[15];
      int* ei = EI + (m0 + item) * 16;
      float* eg = EG + (m0 + item) * 16;
      int cntw = 0;
      {
        int o = 0;
#pragma unroll
        for (int i = 0; i < 16; ++i)
#pragma unroll
          for (int j = 0; j < 16 / (i + 1); ++j) {
            const unsigned key = (f2sortable(v1[i] + v2[j]) & ~63u) | (unsigned)(63 - o);
            if (key >= thr) {
              ei[cntw] = (int)((127u - (vh[0][i] & 127u)) * 128u + (127u - (vh[1][j] & 127u)));
              eg[cntw] = expf(sortable2f((key & ~63u) | 32u) - vmax) * isum;
              ++cntw;
            }
            ++o;
          }
      }
    }
  }
  __syncthreads();
}

#define DPPF(x, ctrl) __uint_as_float((unsigned)__builtin_amdgcn_update_dpp(0, (int)__float_as_uint(x), (ctrl), 0xf, 0xf, true))
#define XP_HALVE(n, bit, ctrl) { _Pragma("unroll") for (int j_ = 0; j_ < (n); ++j_) { const float keep_ = (bit) ? a[j_ + (n)] : a[j_]; const float send_ = (bit) ? a[j_] : a[j_ + (n)]; a[j_] = keep_ + DPPF(send_, ctrl); } }
#define XP_ROW(TAB, E, PR) { const int e0_ = __builtin_amdgcn_readlane((E), 2 * (PR)), e1_ = __builtin_amdgcn_readlane((E), 2 * (PR) + 1); \
    const char* rp_ = (TAB) + (size_t)(hw ? e1_ : e0_) * 768 + hl * 24; \
    const u32x4_u x_ = *(const u32x4_u*)rp_; const u32x2 y_ = *(const u32x2*)(rp_ + 16); \
    ra[PR] = (v6u){x_[0], x_[1], x_[2], x_[3], y_[0], y_[1]}; }
#define XP_META(PAR, T, E, G, HP) { const size_t mo_ = ((size_t)(PAR) * RPG + (T)) * 128 + w * 32 + hl; \
    E = ((const int*)(p.ws + WB_EI))[mo_]; G = ((const float*)(p.ws + WB_EG))[mo_]; \
    const u32x4* hr_ = (const u32x4*)((const bf16_t*)(p.ws + WB_H2) + ((size_t)(PAR) * RPG + (T)) * DM + hl * 32); \
    _Pragma("unroll") for (int c_ = 0; c_ < 4; ++c_) HP[c_] = hr_[c_]; }
__device__ __forceinline__ void unpack8(const u32x4 v, float* f) {
#pragma unroll
  for (int k = 0; k < 4; ++k) { f[2 * k] = lo16(v[k]); f[2 * k + 1] = hi16(v[k]); }
}
__device__ __forceinline__ int xp_pool_n(int q) { return GB * ((q < NG) ? NTOK : NLAT); }
__device__ __forceinline__ int xp_claim(int* pool, int& qa, int hi) {
  while (qa <= hi) {
    const int n = xp_pool_n(qa);
    if (__hip_atomic_load(pool + qa, __ATOMIC_RELAXED, __HIP_MEMORY_SCOPE_AGENT) < n) {
      const int i = atomicAdd(pool + qa, 1);
      if (i < n) return qa * 65536 + i;
    }
    ++qa;
  }
  return -1;
}
__device__ __forceinline__ void xp_decode(int tok, int& l, int& par, int& b, int& rr, int& t) {
  const int q = tok >> 16, i = tok & 65535;
  l = q / NG;
  const int g = q % NG, rr_lim = (l == 0) ? NTOK : NLAT, bl = i / rr_lim;
  rr = i % rr_lim; b = g * GB + bl; t = bl * NTOK + rr; par = q % 3;
}
__device__ __forceinline__ void expert_run(const Params& p, int lo, int hi, unsigned* ctr, unsigned epoch, const bool steal, int& pend, float* smem) {
  if (lo < 0) lo = 0;
  if (hi < lo) return;
  const int tid = otid(), w = tid >> 6, lane = tid & 63, hl = lane & 31, hw = lane >> 5;
  int* s_tok = (int*)(smem + SMEM_FLOATS - 8);
  int* pool = (int*)(p.ws + WB_POOL);
  float* part = smem;
  int qa = lo, ci = 0;
  bool cpend = false;
  unsigned cb = 0;
  int cur = pend; pend = -1;
  if (cur < 0) {
    __syncthreads();
    if (tid == 0) s_tok[2] = xp_claim(pool, qa, hi);
    __syncthreads();
    cur = __builtin_amdgcn_readfirstlane(s_tok[2]);
  }
  if (cur < 0) return;
  if (tid == 0 && qa <= hi) { ci = atomicAdd(pool + qa, 1); cpend = true; }
  int l, par, b, rr, t;
  xp_decode(cur, l, par, b, rr, t);
  int e_c; float g_c; u32x4 hp[4];
  XP_META(par, t, e_c, g_c, hp)
  v6u ra[16];
  {
    const char* U = p.ws + WB_U16 + (size_t)l * 16384 * 768;
#pragma unroll
    for (int pr = 0; pr < 16; ++pr) XP_ROW(U, e_c, pr)
  }
  for (;;) {
    const float* mod = (const float*)(p.ws + WB_MOD) + (size_t)l * 9 * 6144;
    const float4 g2 = ((const float4*)(mod + (size_t)((rr < NLAT) ? b : 8) * 6144 + 5 * 1024))[tid];
    float4* xp = (float4*)xrow(p, b, rr) + tid;
    float4 xv = *xp;
    if (tid == 0) {
      int r = -1;
      if (cpend) {
        if (ci < xp_pool_n(qa)) r = qa * 65536 + ci;
        else { ++qa; r = xp_claim(pool, qa, hi); }
      }
      const int st = (steal && cb + 31u >= epoch) ? 1 : 0;
      s_tok[0] = r; s_tok[1] = st;
      cpend = false;
      if (!st && r >= 0 && qa <= hi) { ci = atomicAdd(pool + qa, 1); cpend = true; }
    }
    __syncthreads();
    const int nxt = __builtin_amdgcn_readfirstlane(s_tok[0]);
    const bool pf = nxt >= 0 && __builtin_amdgcn_readfirstlane(s_tok[1]) == 0;
    int ln = l, parn = 0, bn = 0, rrn = 0, tn = 0, e_n = 0;
    float g_n = 0.f;
    u32x4 hn[4];
#pragma unroll
    for (int c = 0; c < 4; ++c) hn[c] = (u32x4){0u, 0u, 0u, 0u};
    if (pf) {
      xp_decode(nxt, ln, parn, bn, rrn, tn);
      XP_META(parn, tn, e_n, g_n, hn)
    }
    const char* V = p.ws + WB_V16 + (size_t)l * 16384 * 768;
    f32x2 hq2[16];
#pragma unroll
    for (int c = 0; c < 4; ++c)
#pragma unroll
      for (int k = 0; k < 4; ++k) hq2[4 * c + k] = (f32x2){lo16(hp[c][k]), hi16(hp[c][k])};
    float a[16];
#pragma unroll
    for (int pr = 0; pr < 16; ++pr) {
      const v32f f = __builtin_amdgcn_cvt_scalef32_pk32_f32_fp6(ra[pr], 1.0f);
      f32x2 sa = {0.f, 0.f}, sb = {0.f, 0.f};
#pragma unroll
      for (int k = 0; k < 16; k += 2) {
        sa = __builtin_elementwise_fma(hq2[k], (f32x2){f[2 * k], f[2 * k + 1]}, sa);
        sb = __builtin_elementwise_fma(hq2[k + 1], (f32x2){f[2 * k + 2], f[2 * k + 3]}, sb);
      }
      a[pr] = (sa[0] + sb[0]) + (sa[1] + sb[1]);
      XP_ROW(V, e_c, pr)
    }
    {
      const bool b3 = (lane & 8) != 0, b2 = (lane & 4) != 0, b1 = (lane & 2) != 0, b0 = (lane & 1) != 0;
      XP_HALVE(8, b3, 0x128)
      XP_HALVE(4, b2, 0x141)
      XP_HALVE(2, b1, 0x4E)
      XP_HALVE(1, b0, 0xB1)
    }
    float dsum = a[0];
    dsum += __shfl_xor(dsum, 16);
    const float my_dot = __shfl(dsum, 32 * (hl & 1) + (hl >> 1));
    const float my_c = g_c * geluf_(my_dot * (1.0f / 64.0f));
    f32x2 acc2[16];
#pragma unroll
    for (int k = 0; k < 16; ++k) acc2[k] = (f32x2){0.f, 0.f};
    {
      const char* Un = p.ws + WB_U16 + (size_t)ln * 16384 * 768;
#pragma unroll
      for (int pr = 0; pr < 16; ++pr) {
        const float c0 = __uint_as_float(__builtin_amdgcn_readlane(__float_as_uint(my_c), 2 * pr)), c1 = __uint_as_float(__builtin_amdgcn_readlane(__float_as_uint(my_c), 2 * pr + 1));
        const float c = hw ? c1 : c0;
        const f32x2 cc = {c, c};
        const v32f f = __builtin_amdgcn_cvt_scalef32_pk32_f32_fp6(ra[pr], 1.0f);
#pragma unroll
        for (int k = 0; k < 16; ++k) acc2[k] = __builtin_elementwise_fma(cc, (f32x2){f[2 * k], f[2 * k + 1]}, acc2[k]);
        XP_ROW(Un, e_n, pr)
      }
    }
    if (steal && tid == 0) cb = __hip_atomic_load(ctr, __ATOMIC_RELAXED, __HIP_MEMORY_SCOPE_AGENT);
    __syncthreads();
    {
      float4* pw = (float4*)(part + (w * 2 + hw) * 1024 + hl * 32);
#pragma unroll
      for (int c = 0; c < 8; ++c) pw[c] = make_float4(acc2[2 * c][0], acc2[2 * c][1], acc2[2 * c + 1][0], acc2[2 * c + 1][1]);
    }
    __syncthreads();
    float4 s = ((const float4*)part)[tid];
#pragma unroll
    for (int c = 1; c < 8; ++c) { const float4 x = ((const float4*)(part + c * 1024))[tid]; s.x += x.x; s.y += x.y; s.z += x.z; s.w += x.w; }
    xv.x += 0.5f * g2.x * s.x; xv.y += 0.5f * g2.y * s.y; xv.z += 0.5f * g2.z * s.z; xv.w += 0.5f * g2.w * s.w;
    *xp = xv;
    if (!pf) { pend = nxt; break; }
    l = ln; par = parn; b = bn; rr = rrn; t = tn; e_c = e_n; g_c = g_n;
#pragma unroll
    for (int c = 0; c < 4; ++c) hp[c] = hn[c];
  }
}
__device__ __forceinline__ void expert_drain(const Params& p, int lo, int hi, int& pend, float* smem) {
  expert_run(p, lo, hi, nullptr, 0u, false, pend, smem);
}

__device__ __forceinline__ void stage_final(const Params& p, float* smem) {
  const int tid = otid(), w = tid >> 6, lane = tid & 63;
  const int n = NB * NLAT;
  for (int r0 = (blockIdx.x * 4 + w) * 2; r0 < n; r0 += gridDim.x * 8) {
    float4 v[2][4];
#pragma unroll
    for (int u = 0; u < 2; ++u)
#pragma unroll
      for (int q = 0; q < 4; ++q) v[u][q] = ((const float4*)(p.out + (size_t)(r0 + u) * DM))[q * 64 + lane];
#pragma unroll
    for (int u = 0; u < 2; ++u) {
      float s = 0.f;
#pragma unroll
      for (int q = 0; q < 4; ++q) s += v[u][q].x * v[u][q].x + v[u][q].y * v[u][q].y + v[u][q].z * v[u][q].z + v[u][q].w * v[u][q].w;
      s = wave_sum(s);
      const float rs = rsqrtf(s * (1.0f / DM) + EPSF);
#pragma unroll
      for (int q = 0; q < 4; ++q) {
        const float4 g = ((const float4*)p.in[I_FG])[q * 64 + lane];
        const float4 x = v[u][q];
        ((float4*)(p.out + (size_t)(r0 + u) * DM))[q * 64 + lane] = make_float4(x.x * rs * g.x, x.y * rs * g.y, x.z * rs * g.z, x.w * rs * g.w);
      }
    }
  }
}

__device__ __forceinline__ void gbar(const Params& p, unsigned* ctr, unsigned& epoch, int lo, int hi, int& pend, float* smem) {
  asm volatile("s_waitcnt vmcnt(0)" ::: "memory");
  __syncthreads();
  epoch += gridDim.x;
  int* s_flag = (int*)(smem + SMEM_FLOATS - 12);
  if (threadIdx.x == 0) {
    __builtin_amdgcn_fence(__ATOMIC_RELEASE, "agent");
    asm volatile("s_waitcnt vmcnt(0)" ::: "memory");
    __hip_atomic_fetch_add(ctr, 1u, __ATOMIC_RELAXED, __HIP_MEMORY_SCOPE_AGENT);
  }
  if (hi >= lo && hi >= 0) {
    if (threadIdx.x == 0) {
      const unsigned c = __hip_atomic_load(ctr, __ATOMIC_RELAXED, __HIP_MEMORY_SCOPE_AGENT);
      *s_flag = (c + 31u < epoch) ? 1 : 0;
    }
    __syncthreads();
    if (*s_flag) expert_run(p, lo, hi, ctr, epoch, true, pend, smem);
  }
  if (threadIdx.x == 0) {
    while (__hip_atomic_load(ctr, __ATOMIC_RELAXED, __HIP_MEMORY_SCOPE_AGENT) < epoch) __builtin_amdgcn_s_sleep(2);
    __builtin_amdgcn_fence(__ATOMIC_ACQUIRE, "agent");
    asm volatile("s_waitcnt vmcnt(0)" ::: "memory");
  }
  __syncthreads();
}

__global__ void __launch_bounds__(256) mega(Params p) {
  cg::grid_group grid = cg::this_grid();
  __shared__ __attribute__((aligned(16))) float smem[SMEM_FLOATS];
  char* smc = (char*)smem;
  char* ws = p.ws;
  bf16_t* H = (bf16_t*)(ws + WB_H); bf16_t* Z = (bf16_t*)(ws + WB_Z); float* MGT = (float*)(ws + WB_MGT); bf16_t* XC = (bf16_t*)(ws + WB_XC);
  bf16_t* QM = (bf16_t*)(ws + WB_QM); bf16_t* KM = (bf16_t*)(ws + WB_KM); bf16_t* KMT = (bf16_t*)(ws + WB_KMT); bf16_t* MVT = (bf16_t*)(ws + WB_MVT);
  bf16_t* HF = (bf16_t*)(ws + WB_HF); bf16_t* HB = (bf16_t*)(ws + WB_HB);
  bf16_t* VT = (bf16_t*)(ws + WB_VT); float* YSF = (float*)(ws + WB_YSF); float* YSB = (float*)(ws + WB_YSB);
  bf16_t* YA = (bf16_t*)(ws + WB_YA); bf16_t* YB = (bf16_t*)(ws + WB_YB); bf16_t* YS = (bf16_t*)(ws + WB_YS); bf16_t* GG = (bf16_t*)(ws + WB_GG);
  bf16_t* MG = (bf16_t*)(ws + WB_MG); bf16_t* PQ = (bf16_t*)(ws + WB_PQ); float* SC = (float*)(ws + WB_SC);
  float* XE = (float*)(ws + WB_XE); float* GA = (float*)(ws + WB_GA);
  const bf16_t* WT = (const bf16_t*)(ws + WB_WT);

  unsigned* bar = (unsigned*)(ws + WB_BAR);
  unsigned epoch = 0;
  int pend = -1;
  stage_init(p, smem);
  grid.sync();

  for (int l = 0; l < 2; ++l) {
    const bool need_ctx = (l == 0);
    const int rr_lim = need_ctx ? NTOK : NLAT;
    const int tpb = need_ctx ? 34 : 32;
    const bf16_t* W = WT + (size_t)l * WT_LAYER;
    const float lam_init = __uint_as_float(__builtin_amdgcn_readfirstlane(__float_as_uint(0.8f - 0.6f * expf(-0.3f * (float)l))));
    float lam;
    {
      float s1 = 0.f, s2 = 0.f;
      for (int i = 0; i < 64; ++i) {
        s1 += p.in[I_LQ1][l * 64 + i] * p.in[I_LK1][l * 64 + i];
        s2 += p.in[I_LQ2][l * 64 + i] * p.in[I_LK2][l * 64 + i];
      }
      lam = expf(s1) - expf(s2) + lam_init;
      lam = __uint_as_float(__builtin_amdgcn_readfirstlane(__float_as_uint(lam)));
    }
    for (int g = 0; g < NG; ++g) {
      const int q = l * NG + g;
      int plo = q - 3, phi = q - 1;
      int* EI = (int*)(ws + WB_EI) + (size_t)(q % 3) * RPG * 128; float* EG = (float*)(ws + WB_EG) + (size_t)(q % 3) * RPG * 128;
      bf16_t* H2 = (bf16_t*)(ws + WB_H2) + (size_t)(q % 3) * RPG * DM;
      if (q == 0) {
        stage_normmod(p, l, g, 0, NTOK, H, smem);
        gbar(p, bar, epoch, plo, phi, pend, smem);
      }
      stage_inproj(p, H, W + WT_WIN, Z, MGT, VT, MVT, smc);
      gbar(p, bar, epoch, plo, phi, pend, smem);
      stage_s5_pass1(p, l, Z, XE);
      stage_mlgates(p, l, MGT, GA);
      stage_mlqk(p, l, Z, XC, W + WT_WQK, QM, KM, KMT, smc);
      gbar(p, bar, epoch, plo, phi, pend, smem);
      {
        const int n_attn = 4 * 64 + (need_ctx ? 4 * 4 : 0);
        const int n_s5 = 32 * 2 * 9;
        const int n_items = GB * (16 + n_attn + n_s5);
        int* cnt = (int*)(ws + WB_CNT) + (l * NG + g);
        int* s_item = (int*)(smem + SMEM_FLOATS - 4);
        for (;;) {
          __syncthreads();
          if (otid() == 0) *s_item = atomicAdd(cnt, 1);
          __syncthreads();
          const int it = *s_item;
          if (it >= n_items) break;
          int bl, k;
          if (it < GB * 16) { bl = it / 16; k = it % 16; }
          else if (it < GB * (16 + n_attn)) { bl = (it - GB * 16) / n_attn; k = 16 + (it - GB * 16) % n_attn; }
          else { bl = (it - GB * (16 + n_attn)) / n_s5; k = 16 + n_attn + (it - GB * (16 + n_attn)) % n_s5; }
          const bf16_t* Zb = Z + (size_t)bl * NTOK * ZW;
          const size_t ro = (size_t)bl * NTOK;
          if (k < 16) {
            const int hh = k & 3, dd = (k >> 2) & 1, eh = k >> 3;
            mlstm_chain_item(p, l, QM + ro * 512, KM + ro * 512, KMT + (size_t)bl * 4 * 128 * NTOK, MVT + (size_t)bl * 4 * 128 * NTOK, GA + (size_t)(((bl * 4 + hh) * 2 + dd) * 68) * 272,
                             (dd ? HB : HF) + ro * 512, hh, dd, eh, smc);
          } else if (k < 16 + n_attn) {
            const int a = k - 16;
            const bf16_t* VTb = VT + (size_t)bl * 4 * 128 * NTOK;
            if (a < 256) attn_mfma_item(p, l, Zb, VTb, YA + ro * 512, a & 3, (a >> 2) * 64, 0, NTOK, lam, lam_init, smc);
            else attn_mfma_item(p, l, Zb, VTb, YA + ro * 512, (a - 256) & 3, NLAT + ((a - 256) >> 2) * 64, NLAT, NCTX, lam, lam_init, smc);
          } else {
            const int a = k - 16 - n_attn;
            const int sq = a % 9, dir = (a / 9) & 1, gg = a / 18;
            s5_item(p, l, Zb, XE + (((size_t)bl * 32 + gg) * 2 + dir) * (S5NSEG - 1) * 128, (dir ? YSB : YSF) + ro * 512, gg, dir, sq, smc);
          }
        }
      }
      expert_drain(p, plo, plo, pend, smem);
      plo = q - 2;
      gbar(p, bar, epoch, plo, phi, pend, smem);
      if (need_ctx) stage_chain1<true>(p, l, g, Z, HF, HB, YSF, YSB, YA, MG, H2, W, smc);
      else stage_chain1<false>(p, l, g, Z, HF, HB, YSF, YSB, YA, MG, H2, W, smc);
      gbar(p, bar, epoch, plo, phi, pend, smem);
      stage_peerq_mfma(tpb, H2, W + WT_WQ, PQ, smc);
      gbar(p, bar, epoch, plo, phi, pend, smem);
      stage_scores_topk(tpb, PQ, W + WT_SUBK, EI, EG, smc);
      if (q + 1 < 2 * NG) stage_normmod(p, (q + 1) / NG, (q + 1) % NG, 0, NTOK, H, smem);
      gbar(p, bar, epoch, plo, phi, pend, smem);
    }
  }
  expert_drain(p, 2 * NG - 3, 2 * NG - 1, pend, smem);
  gbar(p, bar, epoch, 0, -1, pend, smem);
  stage_final(p, smem);
}

extern "C" void kernel_launch(void* const* d_in, const int* in_sizes, int n_in, void* d_out,
                              int out_size, void* d_ws, size_t ws_size, hipStream_t stream) {
  static int grid_blocks = 0;
  if (!grid_blocks) {
    int dev = 0, cus = 0, per_cu = 0;
    (void)hipGetDevice(&dev);
    (void)hipDeviceGetAttribute(&cus, hipDeviceAttributeMultiprocessorCount, dev);
    (void)hipOccupancyMaxActiveBlocksPerMultiprocessor(&per_cu, mega, 256, 0);
    if (per_cu > 1) per_cu = 1;
    grid_blocks = cus * per_cu;
  }
  if (ws_size < WB_END) {
    fprintf(stderr, "workspace too small: %zu < %zu\n", ws_size, (size_t)WB_END);
    return;
  }
  Params p{};
  for (int i = 0; i < N_IN; ++i) p.in[i] = (const float*)d_in[i];
  p.out = (float*)d_out;
  p.ws = (char*)d_ws;
  (void)hipMemsetAsync((char*)d_ws + WB_BAR, 0, 256, stream);
  void* args[] = {&p};
  hipError_t e = hipLaunchCooperativeKernel((void*)mega, dim3(grid_blocks), dim3(256), args, 0, stream);
  if (e != hipSuccess) fprintf(stderr, "cooperative launch failed: %s (grid %d)\n", hipGetErrorString(e), grid_blocks);
}
```
